# Optimizing an MI355X kernel written in HIP

```python
import math
import jax
import jax.numpy as jnp
from jax import lax
import numpy as np

D_MODEL = 1024
BATCH = 32
SEQ = 2048
DEPTH = 4

CHUNK = 64
EPS = 1e-6
GROUP_WIDTH = 256
N_MIXERS = 4
MIX_WIDTH = GROUP_WIDTH * N_MIXERS
SSD_HEADS = 4
SSD_HEAD_DIM = 64
SSD_INNER = SSD_HEADS * SSD_HEAD_DIM
SSD_GROUPS = 2
SSD_STATE = 64
SSD_CONV = 4
SSD_CONV_DIM = SSD_INNER + 2 * SSD_GROUPS * SSD_STATE
GDN_HEADS = 4
GDN_HEAD_DIM = 64
GDN_INNER = GDN_HEADS * GDN_HEAD_DIM
GDN_CONV = 4
GLA_HEADS = 4
GLA_KEY_DIM = 32
GLA_VAL_DIM = 64
GLA_KEY_WIDTH = GLA_HEADS * GLA_KEY_DIM
GLA_VAL_WIDTH = GLA_HEADS * GLA_VAL_DIM
GLA_GATE_RANK = 16
GLA_GATE_NORMALIZER = 16.0
DSA_HEADS = 4
DSA_HEAD_DIM = 64
IDX_HEADS = 8
IDX_DIM = 32
DSA_TOPK_MAX = 256
DSA_QBLOCK = 128
MEM_TOKENS = 256
MEM_HEADS = 4
MEM_HEAD_DIM = 64
MEM_WIDTH = MEM_HEADS * MEM_HEAD_DIM
PEER_HEADS = 8
PEER_NKEYS = 128
PEER_EXPERTS = PEER_NKEYS * PEER_NKEYS
PEER_QDIM = 128
PEER_TOPK = 16
PEER_BLOCK = 32

IN_SIZES = (
    SSD_INNER, SSD_CONV_DIM, SSD_HEADS,
    3 * GDN_INNER, GDN_HEADS, GDN_HEADS, GDN_INNER,
    GLA_KEY_WIDTH, GLA_KEY_WIDTH, GLA_VAL_WIDTH, GLA_GATE_RANK, GLA_VAL_WIDTH,
    DSA_HEADS * DSA_HEAD_DIM, DSA_HEAD_DIM, DSA_HEAD_DIM,
    IDX_HEADS * IDX_DIM, IDX_DIM, IDX_HEADS,
)
IN_WIDTH = sum(IN_SIZES)

kernel_name = "hybrid_chunk_causal_trunk"


def rms_norm(x, g):
    xf = x.astype(jnp.float32)
    y = xf * lax.rsqrt(jnp.mean(xf * xf, axis=-1, keepdims=True) + EPS)
    return (y * g.astype(jnp.float32)).astype(x.dtype)


def l2_norm(x):
    xf = x.astype(jnp.float32)
    return xf * lax.rsqrt(jnp.sum(xf * xf, axis=-1, keepdims=True) + EPS)


def causal_dwconv(x, w):
    k = w.shape[0]
    return lax.conv_general_dilated(
        x, w[:, None, :].astype(x.dtype), window_strides=(1,), padding=[(k - 1, 0)],
        dimension_numbers=("NWC", "WIO", "NWC"), feature_group_count=x.shape[-1])


def to_chunks(t):
    bsz, seq, nh = t.shape[:3]
    t = t.reshape((bsz, seq // CHUNK, CHUNK, nh) + t.shape[3:])
    return jnp.moveaxis(jnp.moveaxis(t, 3, 2), 1, 0)


def from_chunks(t):
    nc, bsz, nh, q = t.shape[:4]
    t = jnp.moveaxis(jnp.moveaxis(t, 0, 1), 2, 3)
    return t.reshape((bsz, nc * q, nh) + t.shape[4:])


def ssd_scan(xs, dt, a, bm, cm):
    bsz, seq, nh, hp = xs.shape
    nc = seq // CHUNK
    xc = xs.reshape(bsz, nc, CHUNK, nh, hp)
    bc = bm.reshape(bsz, nc, CHUNK, nh, -1)
    cc = cm.reshape(bsz, nc, CHUNK, nh, -1)
    dtc = jnp.moveaxis(dt.reshape(bsz, nc, CHUNK, nh), 2, 3)
    acum = jnp.cumsum(dtc * a[:, None], axis=-1)
    causal = jnp.tril(jnp.ones((CHUNK, CHUNK), bool))
    seg = jnp.exp(jnp.where(causal, acum[..., :, None] - acum[..., None, :], -jnp.inf))
    cb = jnp.einsum("bcthn,bcshn->bchts", cc, bc)
    y_diag = jnp.einsum("bchts,bcshp->bcthp", cb * seg * dtc[..., None, :], xc)
    decay_end = jnp.exp(acum[..., -1:] - acum) * dtc
    states = jnp.einsum("bcshn,bchs,bcshp->bchpn", bc, decay_end, xc)
    chunk_decay = jnp.exp(acum[..., -1])

    def step(h, inp):
        st, dec = inp
        return h * dec[..., None, None] + st, h

    h0 = jnp.zeros((bsz, nh, hp, bc.shape[-1]), states.dtype)
    _, h_in = lax.scan(step, h0, (jnp.moveaxis(states, 1, 0), jnp.moveaxis(chunk_decay, 1, 0)))
    h_in = jnp.moveaxis(h_in, 0, 1)
    y_off = jnp.einsum("bcthn,bchpn,bcht->bcthp", cc, h_in, jnp.exp(acum))
    return (y_diag + y_off).reshape(bsz, seq, nh, hp)


def ssd_mixer(z, xbc, dt, conv_w, conv_b, dt_bias, a_log, d_skip, norm_g):
    bsz, seq, _ = z.shape
    f32 = jnp.float32
    xbc = jax.nn.silu(causal_dwconv(xbc, conv_w) + conv_b).astype(f32)
    gs = SSD_GROUPS * SSD_STATE
    rep = SSD_HEADS // SSD_GROUPS
    xs = xbc[..., :SSD_INNER].reshape(bsz, seq, SSD_HEADS, SSD_HEAD_DIM)
    bm = jnp.repeat(xbc[..., SSD_INNER:SSD_INNER + gs].reshape(bsz, seq, SSD_GROUPS, SSD_STATE), rep, axis=2)
    cm = jnp.repeat(xbc[..., SSD_INNER + gs:].reshape(bsz, seq, SSD_GROUPS, SSD_STATE), rep, axis=2)
    dt = jax.nn.softplus(dt.astype(f32) + dt_bias.astype(f32))
    a = -jnp.exp(a_log.astype(f32))
    y = ssd_scan(xs, dt, a, bm, cm) + xs * d_skip.astype(f32)[:, None]
    y = y.reshape(bsz, seq, SSD_INNER) * jax.nn.silu(z.astype(f32))
    return rms_norm(y, norm_g).astype(z.dtype)


def gated_delta_scan(q, k, v, beta, g):
    bsz, seq, nh, dk = q.shape
    dv = v.shape[-1]
    qc, kc, vc = to_chunks(q), to_chunks(k), to_chunks(v)
    bc, gcum = to_chunks(beta), jnp.cumsum(to_chunks(g), axis=-1)
    incl = jnp.tril(jnp.ones((CHUNK, CHUNK), bool))
    strict = jnp.tril(jnp.ones((CHUNK, CHUNK), bool), k=-1)
    decay = jnp.exp(jnp.where(incl, gcum[..., :, None] - gcum[..., None, :], -jnp.inf))
    kb = kc * bc[..., None]
    a_mat = jnp.where(strict, jnp.einsum("nbhid,nbhjd->nbhij", kb, kc) * decay, 0.0)
    eye = jnp.eye(CHUNK, dtype=jnp.float32)
    t_mat = lax.linalg.triangular_solve(eye + a_mat, jnp.broadcast_to(eye, a_mat.shape),
                                        left_side=True, lower=True)
    u = jnp.einsum("nbhij,nbhjd->nbhid", t_mat, vc * bc[..., None])
    w = jnp.einsum("nbhij,nbhjd->nbhid", t_mat, kb * jnp.exp(gcum)[..., None])
    qk = jnp.where(incl, jnp.einsum("nbhid,nbhjd->nbhij", qc, kc) * decay, 0.0)
    q_dec = qc * jnp.exp(gcum)[..., None]
    k_dec = kc * jnp.exp(gcum[..., -1:] - gcum)[..., None]
    last = jnp.exp(gcum[..., -1])

    def step(s, inp):
        u_c, w_c, qk_c, qd_c, kd_c, l_c = inp
        v_new = u_c - jnp.einsum("bhid,bhde->bhie", w_c, s)
        o = jnp.einsum("bhid,bhde->bhie", qd_c, s) + jnp.einsum("bhij,bhje->bhie", qk_c, v_new)
        s = s * l_c[..., None, None] + jnp.einsum("bhjd,bhje->bhde", kd_c, v_new)
        return s, o

    s0 = jnp.zeros((bsz, nh, dk, dv), jnp.float32)
    _, o = lax.scan(step, s0, (u, w, qk, q_dec, k_dec, last))
    return from_chunks(o)


def gdn_mixer(qkv, a, b, gate, conv_w, a_log, dt_bias, norm_g):
    bsz, seq, _ = qkv.shape
    f32 = jnp.float32
    out_dtype = qkv.dtype
    shp = (bsz, seq, GDN_HEADS, GDN_HEAD_DIM)
    qkv = jax.nn.silu(causal_dwconv(qkv, conv_w)).astype(f32)
    q = l2_norm(qkv[..., :GDN_INNER].reshape(shp)) * GDN_HEAD_DIM ** -0.5
    k = l2_norm(qkv[..., GDN_INNER:2 * GDN_INNER].reshape(shp))
    v = qkv[..., 2 * GDN_INNER:].reshape(shp)
    beta = jax.nn.sigmoid(b.astype(f32))
    g = -jnp.exp(a_log.astype(f32)) * jax.nn.softplus(a.astype(f32) + dt_bias.astype(f32))
    o = gated_delta_scan(q, k, v, beta, g)
    o = rms_norm(o, norm_g) * jax.nn.silu(gate.astype(f32).reshape(shp))
    return o.reshape(bsz, seq, GDN_INNER).astype(out_dtype)


def gla_scan(q, k, v, gk):
    bsz, seq, nh, dk = q.shape
    dv = v.shape[-1]
    gcum = jnp.cumsum(to_chunks(gk), axis=-2)
    incl = jnp.tril(jnp.ones((CHUNK, CHUNK), bool))[:, :, None]

    def step(s, inp):
        qc, kc, vc, gc = inp
        diff = gc[:, :, :, None, :] - gc[:, :, None, :, :]
        dec = jnp.exp(jnp.where(incl, diff, -jnp.inf))
        att = jnp.einsum("bhtd,bhsd,bhtsd->bhts", qc, kc, dec)
        o = jnp.einsum("bhts,bhse->bhte", att, vc) + jnp.einsum("bhtd,bhde->bhte", qc * jnp.exp(gc), s)
        s = s * jnp.exp(gc[:, :, -1, :])[..., None] + jnp.einsum(
            "bhsd,bhse->bhde", kc * jnp.exp(gc[:, :, -1:, :] - gc), vc)
        return s, o

    s0 = jnp.zeros((bsz, nh, dk, dv), jnp.float32)
    _, o = lax.scan(step, s0, (to_chunks(q), to_chunks(k), to_chunks(v), gcum))
    return from_chunks(o)


def gla_mixer(q, k, v, glr, r, w_gate2, b_gate, norm_g):
    bsz, seq, _ = q.shape
    f32 = jnp.float32
    kshape = (bsz, seq, GLA_HEADS, GLA_KEY_DIM)
    vshape = (bsz, seq, GLA_HEADS, GLA_VAL_DIM)
    gk = jax.nn.log_sigmoid((glr @ w_gate2 + b_gate).astype(f32)) / GLA_GATE_NORMALIZER
    o = gla_scan(q.astype(f32).reshape(kshape) * GLA_KEY_DIM ** -0.5, k.astype(f32).reshape(kshape),
                 v.astype(f32).reshape(vshape), gk.reshape(kshape))
    o = rms_norm(o, norm_g) * jax.nn.silu(r.astype(f32).reshape(vshape))
    return o.reshape(bsz, seq, GLA_VAL_WIDTH).astype(q.dtype)


def dsa_mixer(q, k, v, iq, ik, iw, q_norm, k_norm, ik_norm):
    bsz, seq, _ = q.shape
    q = rms_norm(q.reshape(bsz, seq, DSA_HEADS, DSA_HEAD_DIM), q_norm)
    k = rms_norm(k, k_norm)
    iq = iq.reshape(bsz, seq, IDX_HEADS, IDX_DIM)
    ik = rms_norm(ik, ik_norm)
    iw = iw * (IDX_HEADS ** -0.5 * IDX_DIM ** -0.5)
    topk = min(DSA_TOPK_MAX, seq // 4)
    key_chunk = jnp.arange(seq) // CHUNK
    gather = jax.vmap(lambda t, i: t[i])

    def block(i):
        start = i * DSA_QBLOCK
        qb = lax.dynamic_slice_in_dim(q, start, DSA_QBLOCK, axis=1)
        iqb = lax.dynamic_slice_in_dim(iq, start, DSA_QBLOCK, axis=1)
        iwb = lax.dynamic_slice_in_dim(iw, start, DSA_QBLOCK, axis=1)
        q_chunk = (start + jnp.arange(DSA_QBLOCK)) // CHUNK
        score = jnp.einsum("bths,bth->bts", jax.nn.relu(jnp.einsum("bthd,bsd->bths", iqb, ik)),
                           iwb).astype(jnp.float32)
        score = jnp.where(key_chunk[None, None, :] <= q_chunk[None, :, None], score, -jnp.inf)
        _, idx = lax.top_k(score, topk)
        valid = key_chunk[idx] <= q_chunk[None, :, None]
        kg = gather(k, idx)
        vg = gather(v, idx)
        s = jnp.einsum("bthd,btkd->bhtk", qb, kg).astype(jnp.float32) * DSA_HEAD_DIM ** -0.5
        s = jnp.where(valid[:, None], s, -jnp.inf)
        p = jax.nn.softmax(s, axis=-1).astype(v.dtype)
        return jnp.einsum("bhtk,btkd->bthd", p, vg)

    out = lax.map(block, jnp.arange(seq // DSA_QBLOCK))
    return jnp.moveaxis(out, 0, 1).reshape(bsz, seq, DSA_HEADS * DSA_HEAD_DIM)


def memory_xattn(h, m, wq, wk, wv, wo, q_norm, k_norm):
    bsz, seq, _ = h.shape
    nm = m.shape[1]
    q = rms_norm((h @ wq).reshape(bsz, seq, MEM_HEADS, MEM_HEAD_DIM), q_norm)
    k = rms_norm((m @ wk).reshape(bsz, nm, MEM_HEADS, MEM_HEAD_DIM), k_norm)
    v = (m @ wv).reshape(bsz, nm, MEM_HEADS, MEM_HEAD_DIM)
    s = jnp.einsum("bthd,bshd->bhts", q, k).astype(jnp.float32) * MEM_HEAD_DIM ** -0.5
    p = jax.nn.softmax(s, axis=-1).astype(v.dtype)
    o = jnp.einsum("bhts,bshd->bthd", p, v).reshape(bsz, seq, MEM_WIDTH)
    return o @ wo


def peer_ffn(h, w_query, sub_keys, u_tab, v_tab):
    bsz, seq, dm = h.shape
    half = PEER_QDIM // 2
    ncand = PEER_TOPK * PEER_TOPK

    def block(i):
        hb = lax.dynamic_slice_in_dim(h, i * PEER_BLOCK, PEER_BLOCK, axis=1)
        q = (hb @ w_query).reshape(bsz, PEER_BLOCK, PEER_HEADS, 2, half)
        s = jnp.einsum("bthpd,hpnd->bthpn", q, sub_keys).astype(jnp.float32)
        s1, i1 = lax.top_k(s[..., 0, :], PEER_TOPK)
        s2, i2 = lax.top_k(s[..., 1, :], PEER_TOPK)
        cand = (s1[..., :, None] + s2[..., None, :]).reshape(bsz, PEER_BLOCK, PEER_HEADS, ncand)
        cidx = (i1[..., :, None] * PEER_NKEYS + i2[..., None, :]).reshape(bsz, PEER_BLOCK, PEER_HEADS, ncand)
        top, pos = lax.top_k(cand, PEER_TOPK)
        eidx = jnp.take_along_axis(cidx, pos, axis=-1)
        gate = jax.nn.softmax(top, axis=-1)
        act = jax.nn.gelu(jnp.einsum("bthkd,btd->bthk", u_tab[eidx], hb).astype(jnp.float32))
        coef = (gate * act).astype(hb.dtype)
        return jnp.einsum("bthk,bthkd->btd", coef, v_tab[eidx])

    out = lax.map(block, jnp.arange(seq // PEER_BLOCK))
    return jnp.moveaxis(out, 0, 1).reshape(bsz, seq, dm)


def _split_points():
    return np.cumsum(np.array(IN_SIZES))[:-1].tolist()


def setup_inputs(seed: int = 0) -> dict:
    key = jax.random.key(seed)
    keys = iter(jax.random.split(key, 48))
    f32 = jnp.float32

    def nrm(shape, scale):
        return scale * jax.random.normal(next(keys), shape, f32)

    def gain(shape):
        return 1.0 + 0.02 * jax.random.normal(next(keys), shape, f32)

    def dt_bias_init(shape):
        dt = jnp.exp(jax.random.uniform(next(keys), shape, f32, math.log(1e-3), math.log(1e-1)))
        return dt + jnp.log(-jnp.expm1(-dt))

    def a_log_init(shape):
        return jnp.log(jax.random.uniform(next(keys), shape, f32, 1.0, 16.0))

    L = DEPTH
    return {
        "x": nrm((BATCH, SEQ, D_MODEL), 1.0),
        "mem": nrm((BATCH, MEM_TOKENS, D_MODEL), 1.0),
        "mix_norm": gain((L, D_MODEL)),
        "w_in": nrm((L, D_MODEL, IN_WIDTH), D_MODEL ** -0.5),
        "ssd_conv_w": nrm((L, SSD_CONV, SSD_CONV_DIM), SSD_CONV ** -0.5),
        "ssd_conv_b": nrm((L, SSD_CONV_DIM), 0.01),
        "ssd_dt_bias": dt_bias_init((L, SSD_HEADS)),
        "ssd_a_log": a_log_init((L, SSD_HEADS)),
        "ssd_d": gain((L, SSD_HEADS)),
        "ssd_norm": gain((L, SSD_INNER)),
        "gdn_conv_w": nrm((L, GDN_CONV, 3 * GDN_INNER), GDN_CONV ** -0.5),
        "gdn_a_log": a_log_init((L, GDN_HEADS)),
        "gdn_dt_bias": dt_bias_init((L, GDN_HEADS)),
        "gdn_norm": gain((L, GDN_HEAD_DIM)),
        "gla_w_gate": nrm((L, GLA_GATE_RANK, GLA_KEY_WIDTH), GLA_GATE_RANK ** -0.5),
        "gla_b_gate": nrm((L, GLA_KEY_WIDTH), 0.1),
        "gla_norm": gain((L, GLA_VAL_DIM)),
        "dsa_q_norm": gain((L, DSA_HEAD_DIM)),
        "dsa_k_norm": gain((L, DSA_HEAD_DIM)),
        "idx_k_norm": gain((L, IDX_DIM)),
        "w_out": nrm((L, MIX_WIDTH, D_MODEL), 0.5 * MIX_WIDTH ** -0.5),
        "xattn_norm": gain((L, D_MODEL)),
        "mem_norm": gain((L, D_MODEL)),
        "xattn_wq": nrm((L, D_MODEL, MEM_WIDTH), D_MODEL ** -0.5),
        "xattn_wk": nrm((L, D_MODEL, MEM_WIDTH), D_MODEL ** -0.5),
        "xattn_wv": nrm((L, D_MODEL, MEM_WIDTH), D_MODEL ** -0.5),
        "xattn_wo": nrm((L, MEM_WIDTH, D_MODEL), 0.5 * MEM_WIDTH ** -0.5),
        "xattn_q_norm": gain((L, MEM_HEAD_DIM)),
        "xattn_k_norm": gain((L, MEM_HEAD_DIM)),
        "ffn_norm": gain((L, D_MODEL)),
        "peer_w_query": nrm((L, D_MODEL, PEER_HEADS * PEER_QDIM), D_MODEL ** -0.5),
        "peer_sub_keys": nrm((L, PEER_HEADS, 2, PEER_NKEYS, PEER_QDIM // 2), (PEER_QDIM // 2) ** -0.5),
        "peer_u": nrm((L, PEER_EXPERTS, D_MODEL), D_MODEL ** -0.5),
        "peer_v": nrm((L, PEER_EXPERTS, D_MODEL), 0.5 * PEER_HEADS ** -0.5),
    }


def reference(x, mem, mix_norm, w_in, ssd_conv_w, ssd_conv_b, ssd_dt_bias, ssd_a_log, ssd_d, ssd_norm,
              gdn_conv_w, gdn_a_log, gdn_dt_bias, gdn_norm, gla_w_gate, gla_b_gate, gla_norm,
              dsa_q_norm, dsa_k_norm, idx_k_norm, w_out, xattn_norm, mem_norm, xattn_wq, xattn_wk,
              xattn_wv, xattn_wo, xattn_q_norm, xattn_k_norm, ffn_norm, peer_w_query, peer_sub_keys,
              peer_u, peer_v):
    splits = _split_points()
    for l in range(DEPTH):
        h = rms_norm(x, mix_norm[l])
        (ssd_z, ssd_xbc, ssd_dt, gdn_qkv, gdn_a, gdn_b, gdn_g, gla_q, gla_k, gla_v, gla_glr, gla_r,
         dsa_q, dsa_k, dsa_v, idx_q, idx_k, idx_w) = jnp.split(h @ w_in[l], splits, axis=-1)
        y_a = ssd_mixer(ssd_z, ssd_xbc, ssd_dt, ssd_conv_w[l], ssd_conv_b[l], ssd_dt_bias[l],
                        ssd_a_log[l], ssd_d[l], ssd_norm[l])
        y_b = gdn_mixer(gdn_qkv, gdn_a, gdn_b, gdn_g, gdn_conv_w[l], gdn_a_log[l], gdn_dt_bias[l], gdn_norm[l])
        y_c = gla_mixer(gla_q, gla_k, gla_v, gla_glr, gla_r, gla_w_gate[l], gla_b_gate[l], gla_norm[l])
        y_d = dsa_mixer(dsa_q, dsa_k, dsa_v, idx_q, idx_k, idx_w, dsa_q_norm[l], dsa_k_norm[l], idx_k_norm[l])
        x = x + jnp.concatenate([y_a, y_b, y_c, y_d], axis=-1).astype(x.dtype) @ w_out[l]
        x = x + memory_xattn(rms_norm(x, xattn_norm[l]), rms_norm(mem, mem_norm[l]), xattn_wq[l],
                             xattn_wk[l], xattn_wv[l], xattn_wo[l], xattn_q_norm[l], xattn_k_norm[l])
        x = x + peer_ffn(rms_norm(x, ffn_norm[l]), peer_w_query[l], peer_sub_keys[l], peer_u[l], peer_v[l])
    return x
```

```cpp
#include <hip/hip_runtime.h>
#include <stdint.h>
#include <stdio.h>
#include <string.h>

#define NB 32
#define SEQ 2048
#define DM 1024
#define MTOK (NB * SEQ)
#define DEPTH 4
#define NMEM 256
#define MMEM (NB * NMEM)
#define LDP 3328
#define NEXP 16384
#define EPS 1e-6f
#define PC_Z 0
#define PC_XBC 256
#define PC_GQKV 768
#define PC_GG 1536
#define PC_LQ 1792
#define PC_LK 1920
#define PC_LV 2048
#define PC_LR 2304
#define PC_DQ 2560
#define PC_DK 2816
#define PC_DV 2880
#define PC_IQ 2944
#define PC_IK 3200
#define PC_GLR 3232
#define PC_IW 3248
#define PC_DT 3256
#define PC_GA 3260
#define PC_GB 3264

typedef unsigned short bf16_t;

#define WS_P 0ull
#define SZ_P ((size_t)MTOK * LDP * 2)
#define WS_H (WS_P + SZ_P)
#define SZ_H ((size_t)MTOK * DM * 2)
#define WS_Y (WS_H + SZ_H)
#define SZ_Y ((size_t)MTOK * DM * 2)
#define WS_WP (WS_Y + SZ_Y)
#define SZ_WP ((size_t)DEPTH * DM * LDP * 4)
#define WS_QN (WS_WP + SZ_WP)
#define SZ_QN ((size_t)MTOK * 256 * 4)
#define WS_KN (WS_QN + SZ_QN)
#define SZ_KN ((size_t)MTOK * 64 * 4)
#define WS_IKN (WS_KN + SZ_KN)
#define SZ_IKN ((size_t)MTOK * 32 * 4)
#define WS_YPRE (WS_IKN + SZ_IKN)
#define SZ_YPRE ((size_t)MTOK * 256 * 4)
#define WS_HM (WS_YPRE + SZ_YPRE)
#define SZ_HM ((size_t)MMEM * DM * 2)
#define WS_KM (WS_HM + SZ_HM)
#define SZ_KM ((size_t)MMEM * 256 * 4)
#define WS_VM (WS_KM + SZ_KM)
#define SZ_VM ((size_t)MMEM * 256 * 4)
#define WS_END (WS_VM + SZ_VM)
#define WS_QX (WS_P)
#define WS_OX (WS_P + (size_t)MTOK * 256 * 4)
#define WS_QP (WS_P)

struct Params {
    const float* in[34];
    float* out;
    char* ws;
};

__device__ __forceinline__ float bf2f(bf16_t v) { return __uint_as_float(((unsigned)v) << 16); }
__device__ __forceinline__ bf16_t f2bf(float f) { unsigned u = __float_as_uint(f); u += 0x7FFFu + ((u >> 16) & 1u); return (bf16_t)(u >> 16); }
__device__ __forceinline__ float wave_sum(float v) {
#pragma unroll
    for (int o = 32; o >= 1; o >>= 1) v += __shfl_xor(v, o, 64);
    return v;
}
__device__ __forceinline__ float wave_max(float v) {
#pragma unroll
    for (int o = 32; o >= 1; o >>= 1) v = fmaxf(v, __shfl_xor(v, o, 64));
    return v;
}
__device__ __forceinline__ float silu_f(float x) { return x / (1.f + __expf(-x)); }
__device__ __forceinline__ float sigmoid_f(float x) { return 1.f / (1.f + __expf(-x)); }
__device__ __forceinline__ float softplus_f(float x) { return x > 20.f ? x : log1pf(__expf(x)); }
__device__ __forceinline__ float logsigmoid_f(float x) { return -softplus_f(-x); }
__device__ __forceinline__ float gelu_tanh_f(float x) { const float u = 0.7978845608028654f * (x + 0.044715f * x * x * x); return 0.5f * x * (1.f + tanhf(u)); }
__device__ __forceinline__ unsigned ford(float f) { f = f + 0.0f; unsigned u = __float_as_uint(f); return (u & 0x80000000u) ? ~u : (u | 0x80000000u); }
__device__ __forceinline__ float funord(unsigned k) { unsigned u = (k & 0x80000000u) ? (k & 0x7fffffffu) : ~k; return __uint_as_float(u); }
__device__ __forceinline__ unsigned long long wave_max_u64(unsigned long long v) {
#pragma unroll
    for (int o = 32; o >= 1; o >>= 1) {
        unsigned lo = __shfl_xor((unsigned)v, o, 64), hi = __shfl_xor((unsigned)(v >> 32), o, 64);
        unsigned long long w = ((unsigned long long)hi << 32) | lo;
        v = w > v ? w : v;
    }
    return v;
}
__device__ __forceinline__ int gwave() { return (int)((blockIdx.x * blockDim.x + threadIdx.x) >> 6); }
__device__ __forceinline__ int nwaves() { return (int)((gridDim.x * blockDim.x) >> 6); }

__device__ __forceinline__ int pcol_to_orig(int c) {
    if (c < 768) return c;
    if (c < 1536) return c - 768 + 772;
    if (c < 1792) return c - 1536 + 1548;
    if (c < 1920) return c - 1792 + 1804;
    if (c < 2048) return c - 1920 + 1932;
    if (c < 2304) return c - 2048 + 2060;
    if (c < 2560) return c - 2304 + 2332;
    if (c < 2816) return c - 2560 + 2588;
    if (c < 2880) return c - 2816 + 2844;
    if (c < 2944) return c - 2880 + 2908;
    if (c < 3200) return c - 2944 + 2972;
    if (c < 3232) return c - 3200 + 3228;
    if (c < 3248) return c - 3232 + 2316;
    if (c < 3256) return c - 3248 + 3260;
    if (c < 3260) return c - 3256 + 768;
    if (c < 3264) return c - 3260 + 1540;
    if (c < 3268) return c - 3264 + 1544;
    return -1;
}
__device__ void ph_permute_win(const Params& p) {
    const float* w = p.in[3];
    float* wp = (float*)(p.ws + WS_WP);
    const size_t total = (size_t)DEPTH * DM * LDP;
    for (size_t i = (size_t)blockIdx.x * blockDim.x + threadIdx.x; i < total; i += (size_t)gridDim.x * blockDim.x) {
        const int c = (int)(i % LDP); const size_t lk = i / LDP;
        const int oc = pcol_to_orig(c);
        wp[i] = oc >= 0 ? w[lk * 3268 + oc] : 0.f;
    }
}

__device__ void ph_rmsnorm(const float* __restrict__ x, const float* __restrict__ g, bf16_t* __restrict__ out, int rows) {
    const int lane = threadIdx.x & 63;
    for (int r = gwave(); r < rows; r += nwaves()) {
        const float4* xr = (const float4*)(x + (size_t)r * DM);
        float4 v[4]; float ss = 0.f;
#pragma unroll
        for (int i = 0; i < 4; ++i) { v[i] = xr[lane + 64 * i]; ss += v[i].x * v[i].x + v[i].y * v[i].y + v[i].z * v[i].z + v[i].w * v[i].w; }
        ss = wave_sum(ss);
        const float rs = rsqrtf(ss * (1.f / DM) + EPS);
#pragma unroll
        for (int i = 0; i < 4; ++i) {
            const float4 gg = ((const float4*)g)[lane + 64 * i];
            ushort4 o; o.x = f2bf(v[i].x * rs * gg.x); o.y = f2bf(v[i].y * rs * gg.y); o.z = f2bf(v[i].z * rs * gg.z); o.w = f2bf(v[i].w * rs * gg.w);
            *(ushort4*)(out + (size_t)r * DM + (size_t)(lane + 64 * i) * 4) = o;
        }
    }
}

template <int OUTMODE>
__device__ void ph_sgemm(const bf16_t* __restrict__ A, int lda, const float* __restrict__ B, int ldb, void* Cv, int ldc, const float* R, int ldr,
                         int M, int N, int K, float* smem) {
    float* As = smem;
    float* Bs = smem + 16 * 132;
    const int tid = threadIdx.x, tx = tid & 31, ty = tid >> 5;
    const int ntn = N / 128, ntiles = (M / 128) * ntn;
    for (int tile = blockIdx.x; tile < ntiles; tile += gridDim.x) {
        const int tm = tile / ntn, tn = tile % ntn;
        float acc[8][4];
#pragma unroll
        for (int i = 0; i < 8; ++i)
#pragma unroll
            for (int j = 0; j < 4; ++j) acc[i][j] = 0.f;
        const int arow = tid >> 2, akq = (tid & 3) * 4;
        const int bk = tid >> 5, bn = (tid & 31) * 4;
        for (int k0 = 0; k0 < K; k0 += 16) {
            const ushort4 av = *(const ushort4*)(A + (size_t)(tm * 128 + arow) * lda + k0 + akq);
            const float4 bv = *(const float4*)(B + (size_t)(k0 + bk) * ldb + tn * 128 + bn);
            __syncthreads();
            As[(akq + 0) * 132 + arow] = bf2f(av.x); As[(akq + 1) * 132 + arow] = bf2f(av.y);
            As[(akq + 2) * 132 + arow] = bf2f(av.z); As[(akq + 3) * 132 + arow] = bf2f(av.w);
            *(float4*)(Bs + bk * 132 + bn) = bv;
            __syncthreads();
#pragma unroll
            for (int k = 0; k < 16; ++k) {
                const float4 a0 = *(const float4*)(As + k * 132 + ty * 8), a1 = *(const float4*)(As + k * 132 + ty * 8 + 4);
                const float4 b = *(const float4*)(Bs + k * 132 + tx * 4);
                const float a[8] = {a0.x, a0.y, a0.z, a0.w, a1.x, a1.y, a1.z, a1.w};
#pragma unroll
                for (int i = 0; i < 8; ++i) { acc[i][0] += a[i] * b.x; acc[i][1] += a[i] * b.y; acc[i][2] += a[i] * b.z; acc[i][3] += a[i] * b.w; }
            }
        }
#pragma unroll
        for (int i = 0; i < 8; ++i) {
            const size_t row = (size_t)tm * 128 + ty * 8 + i; const int col = tn * 128 + tx * 4;
            if (OUTMODE == 0) {
                ushort4 o; o.x = f2bf(acc[i][0]); o.y = f2bf(acc[i][1]); o.z = f2bf(acc[i][2]); o.w = f2bf(acc[i][3]);
                *(ushort4*)((bf16_t*)Cv + row * ldc + col) = o;
            } else if (OUTMODE == 1) {
                *(float4*)((float*)Cv + row * ldc + col) = make_float4(acc[i][0], acc[i][1], acc[i][2], acc[i][3]);
            } else {
                const float4 r = *(const float4*)(R + row * ldr + col);
                *(float4*)((float*)Cv + row * ldc + col) = make_float4(r.x + acc[i][0], r.y + acc[i][1], r.z + acc[i][2], r.w + acc[i][3]);
            }
        }
    }
}

__device__ void ph_ssd_scan(const Params& p, int l, float* smem) {
    const bf16_t* P = (const bf16_t*)(p.ws + WS_P);
    float* Ypre = (float*)(p.ws + WS_YPRE);
    const float* cw = p.in[4] + (size_t)l * 4 * 512;
    const float* cb = p.in[5] + (size_t)l * 512;
    float* xs = smem;
    float* Bs = xs + 4096;
    float* Cs = Bs + 4096;
    float* yb = Cs + 4096;
    float* dts = yb + 4096;
    const int tid = threadIdx.x, pp = tid >> 3, ng = tid & 7;
    for (int item = blockIdx.x; item < NB * 4; item += gridDim.x) {
        const int b = item >> 2, h = item & 3, g = h >> 1;
        const float a = -__expf(p.in[7][l * 4 + h]);
        const float dtb = p.in[6][l * 4 + h];
        const float Dh = p.in[8][l * 4 + h];
        float hst[8];
#pragma unroll
        for (int i = 0; i < 8; ++i) hst[i] = 0.f;
        for (int c = 0; c < SEQ / 64; ++c) {
            const int t0 = c * 64;
            __syncthreads();
            for (int idx = tid; idx < 64 * 192; idx += 512) {
                const int tl = idx / 192, ch = idx % 192, which = ch >> 6, cl = ch & 63;
                const int cc = which == 0 ? h * 64 + cl : (which == 1 ? 256 + g * 64 + cl : 384 + g * 64 + cl);
                float acc = cb[cc];
#pragma unroll
                for (int j = 0; j < 4; ++j) { const int tt = t0 + tl - 3 + j; if (tt >= 0) acc += cw[j * 512 + cc] * bf2f(P[((size_t)b * SEQ + tt) * LDP + PC_XBC + cc]); }
                const float v = silu_f(acc);
                (which == 0 ? xs : (which == 1 ? Bs : Cs))[tl * 64 + cl] = v;
            }
            if (tid < 64) dts[tid] = softplus_f(bf2f(P[((size_t)b * SEQ + t0 + tid) * LDP + PC_DT + h]) + dtb);
            __syncthreads();
            for (int tl = 0; tl < 64; ++tl) {
                const float dt = dts[tl], dA = __expf(dt * a), xv = xs[tl * 64 + pp];
                const float xdt = xv * dt;
                const float4 b0 = *(const float4*)(Bs + tl * 64 + ng * 8), b1 = *(const float4*)(Bs + tl * 64 + ng * 8 + 4);
                const float4 c0 = *(const float4*)(Cs + tl * 64 + ng * 8), c1 = *(const float4*)(Cs + tl * 64 + ng * 8 + 4);
                const float bb[8] = {b0.x, b0.y, b0.z, b0.w, b1.x, b1.y, b1.z, b1.w};
                const float cc8[8] = {c0.x, c0.y, c0.z, c0.w, c1.x, c1.y, c1.z, c1.w};
                float part = 0.f;
#pragma unroll
                for (int i = 0; i < 8; ++i) { hst[i] = hst[i] * dA + xdt * bb[i]; part += cc8[i] * hst[i]; }
                part += __shfl_xor(part, 1, 64); part += __shfl_xor(part, 2, 64); part += __shfl_xor(part, 4, 64);
                if (ng == 0) yb[tl * 64 + pp] = part + Dh * xv;
            }
            __syncthreads();
            for (int idx = tid; idx < 4096; idx += 512) { const int tl = idx >> 6, q = idx & 63; Ypre[((size_t)b * SEQ + t0 + tl) * 256 + h * 64 + q] = yb[idx]; }
        }
    }
}
__device__ void ph_ssd_finish(const Params& p, int l) {
    const bf16_t* P = (const bf16_t*)(p.ws + WS_P);
    const float* Ypre = (const float*)(p.ws + WS_YPRE);
    bf16_t* Y = (bf16_t*)(p.ws + WS_Y);
    const float* gn = p.in[9] + (size_t)l * 256;
    const int lane = threadIdx.x & 63;
    for (int tok = gwave(); tok < MTOK; tok += nwaves()) {
        float v[4]; float ss = 0.f;
#pragma unroll
        for (int i = 0; i < 4; ++i) { const int c = lane + 64 * i; const float z = bf2f(P[(size_t)tok * LDP + PC_Z + c]); v[i] = Ypre[(size_t)tok * 256 + c] * silu_f(z); ss += v[i] * v[i]; }
        ss = wave_sum(ss);
        const float rs = rsqrtf(ss * (1.f / 256.f) + EPS);
#pragma unroll
        for (int i = 0; i < 4; ++i) { const int c = lane + 64 * i; Y[(size_t)tok * DM + c] = f2bf(v[i] * rs * gn[c]); }
    }
}

__device__ void ph_gdn_scan(const Params& p, int l, float* smem) {
    const bf16_t* P = (const bf16_t*)(p.ws + WS_P);
    bf16_t* Y = (bf16_t*)(p.ws + WS_Y);
    const float* cw = p.in[10] + (size_t)l * 4 * 768;
    const float* gn = p.in[13] + (size_t)l * 64;
    float* qs = smem;
    float* ks = qs + 4096;
    float* vs = ks + 4096;
    float* ob = vs + 4096;
    float* al = ob + 4096;
    float* be = al + 64;
    const int tid = threadIdx.x, lane = tid & 63, wave = tid >> 6;
    const int e = wave * 8 + (lane & 7), dg = lane >> 3;
    for (int item = blockIdx.x; item < NB * 4; item += gridDim.x) {
        const int b = item >> 2, h = item & 3;
        const float A = -__expf(p.in[11][l * 4 + h]);
        const float dtb = p.in[12][l * 4 + h];
        float S[8];
#pragma unroll
        for (int i = 0; i < 8; ++i) S[i] = 0.f;
        for (int c = 0; c < SEQ / 64; ++c) {
            const int t0 = c * 64;
            __syncthreads();
            for (int idx = tid; idx < 64 * 192; idx += 512) {
                const int tl = idx / 192, ch = idx % 192, which = ch >> 6, cl = ch & 63;
                const int cc = which * 256 + h * 64 + cl;
                float acc = 0.f;
#pragma unroll
                for (int j = 0; j < 4; ++j) { const int tt = t0 + tl - 3 + j; if (tt >= 0) acc += cw[j * 768 + cc] * bf2f(P[((size_t)b * SEQ + tt) * LDP + PC_GQKV + cc]); }
                (which == 0 ? qs : (which == 1 ? ks : vs))[tl * 64 + cl] = silu_f(acc);
            }
            if (tid < 64) {
                const size_t row = ((size_t)b * SEQ + t0 + tid) * LDP;
                const float ga = bf2f(P[row + PC_GA + h]), gb = bf2f(P[row + PC_GB + h]);
                al[tid] = __expf(A * softplus_f(ga + dtb));
                be[tid] = sigmoid_f(gb);
            }
            __syncthreads();
            for (int r = wave; r < 128; r += 8) {
                float* rowp = (r < 64 ? qs + r * 64 : ks + (r - 64) * 64);
                const float v = rowp[lane];
                const float ss = wave_sum(v * v);
                const float sc = rsqrtf(ss + EPS) * (r < 64 ? 0.125f : 1.f);
                rowp[lane] = v * sc;
            }
            __syncthreads();
            for (int tl = 0; tl < 64; ++tl) {
                const float alpha = al[tl], beta = be[tl];
                const float4 k0 = *(const float4*)(ks + tl * 64 + dg * 8), k1 = *(const float4*)(ks + tl * 64 + dg * 8 + 4);
                const float4 q0 = *(const float4*)(qs + tl * 64 + dg * 8), q1 = *(const float4*)(qs + tl * 64 + dg * 8 + 4);
                const float kk[8] = {k0.x, k0.y, k0.z, k0.w, k1.x, k1.y, k1.z, k1.w};
                const float qq[8] = {q0.x, q0.y, q0.z, q0.w, q1.x, q1.y, q1.z, q1.w};
                float r = 0.f;
#pragma unroll
                for (int i = 0; i < 8; ++i) { S[i] *= alpha; r += S[i] * kk[i]; }
                r += __shfl_xor(r, 8, 64); r += __shfl_xor(r, 16, 64); r += __shfl_xor(r, 32, 64);
                const float vn = beta * (vs[tl * 64 + e] - r);
                float o = 0.f;
#pragma unroll
                for (int i = 0; i < 8; ++i) { S[i] += kk[i] * vn; o += S[i] * qq[i]; }
                o += __shfl_xor(o, 8, 64); o += __shfl_xor(o, 16, 64); o += __shfl_xor(o, 32, 64);
                if (dg == 0) ob[tl * 64 + e] = o;
            }
            __syncthreads();
            for (int r = wave; r < 64; r += 8) {
                const float v = ob[r * 64 + lane];
                const float ss = wave_sum(v * v);
                const float rs = rsqrtf(ss * (1.f / 64.f) + EPS);
                const size_t tok = (size_t)b * SEQ + t0 + r;
                const float gate = bf2f(P[tok * LDP + PC_GG + h * 64 + lane]);
                Y[tok * DM + 256 + h * 64 + lane] = f2bf(v * rs * gn[lane] * silu_f(gate));
            }
        }
    }
}

__device__ void ph_gla_scan(const Params& p, int l, float* smem) {
    const bf16_t* P = (const bf16_t*)(p.ws + WS_P);
    bf16_t* Y = (bf16_t*)(p.ws + WS_Y);
    const float* wg = p.in[14] + (size_t)l * 16 * 128;
    const float* bg = p.in[15] + (size_t)l * 128;
    const float* gn = p.in[16] + (size_t)l * 64;
    float* qs = smem;
    float* ks = qs + 2048;
    float* ds = ks + 2048;
    float* vs = ds + 2048;
    float* ob = vs + 4096;
    const int tid = threadIdx.x, lane = tid & 63, wave = tid >> 6;
    const int e = wave * 8 + (lane & 7), dg = lane >> 3;
    for (int item = blockIdx.x; item < NB * 4; item += gridDim.x) {
        const int b = item >> 2, h = item & 3;
        float S[4];
#pragma unroll
        for (int i = 0; i < 4; ++i) S[i] = 0.f;
        for (int c = 0; c < SEQ / 64; ++c) {
            const int t0 = c * 64;
            __syncthreads();
            for (int idx = tid; idx < 64 * 32; idx += 512) {
                const int tl = idx >> 5, d = idx & 31;
                const size_t row = ((size_t)b * SEQ + t0 + tl) * LDP;
                qs[idx] = bf2f(P[row + PC_LQ + h * 32 + d]) * 0.17677669529663687f;
                ks[idx] = bf2f(P[row + PC_LK + h * 32 + d]);
                float acc = bg[h * 32 + d];
#pragma unroll
                for (int r = 0; r < 16; ++r) acc += bf2f(P[row + PC_GLR + r]) * wg[r * 128 + h * 32 + d];
                ds[idx] = __expf(logsigmoid_f(acc) * (1.f / 16.f));
            }
            for (int idx = tid; idx < 4096; idx += 512) { const int tl = idx >> 6, q = idx & 63; vs[idx] = bf2f(P[((size_t)b * SEQ + t0 + tl) * LDP + PC_LV + h * 64 + q]); }
            __syncthreads();
            for (int tl = 0; tl < 64; ++tl) {
                const float4 k4 = *(const float4*)(ks + tl * 32 + dg * 4), q4 = *(const float4*)(qs + tl * 32 + dg * 4), d4 = *(const float4*)(ds + tl * 32 + dg * 4);
                const float kk[4] = {k4.x, k4.y, k4.z, k4.w}, qq[4] = {q4.x, q4.y, q4.z, q4.w}, dd[4] = {d4.x, d4.y, d4.z, d4.w};
                const float v = vs[tl * 64 + e];
                float o = 0.f;
#pragma unroll
                for (int i = 0; i < 4; ++i) { S[i] = dd[i] * S[i] + kk[i] * v; o += S[i] * qq[i]; }
                o += __shfl_xor(o, 8, 64); o += __shfl_xor(o, 16, 64); o += __shfl_xor(o, 32, 64);
                if (dg == 0) ob[tl * 64 + e] = o;
            }
            __syncthreads();
            for (int r = wave; r < 64; r += 8) {
                const float v = ob[r * 64 + lane];
                const float ss = wave_sum(v * v);
                const float rs = rsqrtf(ss * (1.f / 64.f) + EPS);
                const size_t tok = (size_t)b * SEQ + t0 + r;
                const float gate = bf2f(P[tok * LDP + PC_LR + h * 64 + lane]);
                Y[tok * DM + 512 + h * 64 + lane] = f2bf(v * rs * gn[lane] * silu_f(gate));
            }
        }
    }
}

__device__ void ph_dsa_prep(const Params& p, int l) {
    const bf16_t* P = (const bf16_t*)(p.ws + WS_P);
    float* qn = (float*)(p.ws + WS_QN);
    float* kn = (float*)(p.ws + WS_KN);
    float* ikn = (float*)(p.ws + WS_IKN);
    const float* qg = p.in[17] + (size_t)l * 64;
    const float* kg = p.in[18] + (size_t)l * 64;
    const float* ig = p.in[19] + (size_t)l * 32;
    const int lane = threadIdx.x & 63;
    for (int tok = gwave(); tok < MTOK; tok += nwaves()) {
        const size_t row = (size_t)tok * LDP;
#pragma unroll
        for (int h = 0; h < 4; ++h) {
            const float v = bf2f(P[row + PC_DQ + h * 64 + lane]);
            const float ss = wave_sum(v * v);
            qn[(size_t)tok * 256 + h * 64 + lane] = v * rsqrtf(ss * (1.f / 64.f) + EPS) * qg[lane];
        }
        {
            const float v = bf2f(P[row + PC_DK + lane]);
            const float ss = wave_sum(v * v);
            kn[(size_t)tok * 64 + lane] = v * rsqrtf(ss * (1.f / 64.f) + EPS) * kg[lane];
        }
        {
            const float v = lane < 32 ? bf2f(P[row + PC_IK + lane]) : 0.f;
            const float ss = wave_sum(v * v);
            if (lane < 32) ikn[(size_t)tok * 32 + lane] = v * rsqrtf(ss * (1.f / 32.f) + EPS) * ig[lane];
        }
    }
}

__device__ void ph_dsa_main(const Params& p, int l, float* smem) {
    const bf16_t* P = (const bf16_t*)(p.ws + WS_P);
    bf16_t* Y = (bf16_t*)(p.ws + WS_Y);
    const float* qn = (const float*)(p.ws + WS_QN);
    const float* kn = (const float*)(p.ws + WS_KN);
    const float* ikn = (const float*)(p.ws + WS_IKN);
    const int tid = threadIdx.x, lane = tid & 63, wave = tid >> 6;
    float* wbase = smem + wave * 1792;
    float* iqs = wbase;
    float* qhs = wbase + 256;
    int* list = (int*)(wbase + 512);
    float* pl = wbase + 768;
    const unsigned long long lt_mask = (lane == 0) ? 0ull : (~0ull >> (64 - lane));
    for (int item = gwave(); item < MTOK; item += nwaves()) {
        const int t = SEQ - 1 - (item / NB), b = item % NB;
        const size_t tok = (size_t)b * SEQ + t;
        const int nk = ((t >> 6) + 1) * 64, nj = nk >> 6;
#pragma unroll
        for (int i = 0; i < 4; ++i) { iqs[lane + 64 * i] = bf2f(P[tok * LDP + PC_IQ + lane + 64 * i]); qhs[lane + 64 * i] = qn[tok * 256 + lane + 64 * i]; }
        float wh[8];
#pragma unroll
        for (int h = 0; h < 8; ++h) wh[h] = bf2f(P[tok * LDP + PC_IW + h]) * 0.0625f;
        int nsel;
        if (nk > 256) {
            unsigned key[32];
#pragma unroll
            for (int j = 0; j < 32; ++j) {
                key[j] = 0u;
                if (j < nj) {
                    const float4* kr = (const float4*)(ikn + ((size_t)b * SEQ + j * 64 + lane) * 32);
                    float4 kv[8];
#pragma unroll
                    for (int q = 0; q < 8; ++q) kv[q] = kr[q];
                    float acc = 0.f;
#pragma unroll
                    for (int h = 0; h < 8; ++h) {
                        float d = 0.f;
#pragma unroll
                        for (int q = 0; q < 8; ++q) { const float4 iq4 = *(const float4*)(iqs + h * 32 + q * 4); d += iq4.x * kv[q].x + iq4.y * kv[q].y + iq4.z * kv[q].z + iq4.w * kv[q].w; }
                        acc += wh[h] * fmaxf(d, 0.f);
                    }
                    key[j] = ford(acc);
                }
            }
            unsigned T = 0u; bool exact = false;
            for (int bit = 31; bit >= 0; --bit) {
                const unsigned cand = T | (1u << bit);
                int cnt = 0;
#pragma unroll
                for (int j = 0; j < 32; ++j) if (j < nj) cnt += __popcll(__ballot(key[j] >= cand));
                if (cnt >= 256) { T = cand; if (cnt == 256) { exact = true; break; } }
            }
            int cut = 0x7fffffff;
            if (!exact) {
                int cgt = 0, ceq = 0;
#pragma unroll
                for (int j = 0; j < 32; ++j) if (j < nj) { cgt += __popcll(__ballot(key[j] > T)); ceq += __popcll(__ballot(key[j] == T)); }
                int need = 256 - cgt;
                if (ceq > need) {
                    bool found = false;
#pragma unroll
                    for (int j = 0; j < 32; ++j) if (j < nj && !found) {
                        unsigned long long m = __ballot(key[j] == T);
                        const int c = __popcll(m);
                        if (need <= c) { for (int bpos = 0; bpos < 64; ++bpos) if ((m >> bpos) & 1ull) { if (--need == 0) { cut = j * 64 + bpos; break; } } found = true; }
                        else need -= c;
                    }
                }
            }
            int base = 0;
#pragma unroll
            for (int j = 0; j < 32; ++j) if (j < nj) {
                const int s = j * 64 + lane;
                const bool sel = key[j] > T || (key[j] == T && s <= cut);
                const unsigned long long m = __ballot(sel);
                if (sel) { const int pos = base + __popcll(m & lt_mask); if (pos < 256) list[pos] = s; }
                base += __popcll(m);
            }
            nsel = base < 256 ? base : 256;
        } else {
#pragma unroll
            for (int i = 0; i < 4; ++i) list[lane + 64 * i] = lane + 64 * i;
            nsel = nk;
        }
        float lg[4][4]; float mx[4] = {-3.0e38f, -3.0e38f, -3.0e38f, -3.0e38f};
#pragma unroll
        for (int r = 0; r < 4; ++r) {
            const int i = r * 64 + lane;
#pragma unroll
            for (int h = 0; h < 4; ++h) lg[r][h] = -3.0e38f;
            if (r * 64 < nsel) {
                if (i < nsel) {
                    const int s = list[i];
                    const float4* kr = (const float4*)(kn + ((size_t)b * SEQ + s) * 64);
                    float d[4] = {0.f, 0.f, 0.f, 0.f};
#pragma unroll
                    for (int q = 0; q < 16; ++q) {
                        const float4 kv = kr[q];
#pragma unroll
                        for (int h = 0; h < 4; ++h) { const float4 q4 = *(const float4*)(qhs + h * 64 + q * 4); d[h] += q4.x * kv.x + q4.y * kv.y + q4.z * kv.z + q4.w * kv.w; }
                    }
#pragma unroll
                    for (int h = 0; h < 4; ++h) { lg[r][h] = d[h] * 0.125f; mx[h] = fmaxf(mx[h], lg[r][h]); }
                }
            }
        }
        float lsum[4];
#pragma unroll
        for (int h = 0; h < 4; ++h) { mx[h] = wave_max(mx[h]); lsum[h] = 0.f; }
#pragma unroll
        for (int r = 0; r < 4; ++r) {
            const int i = r * 64 + lane;
#pragma unroll
            for (int h = 0; h < 4; ++h) { const float pv = (i < nsel) ? __expf(lg[r][h] - mx[h]) : 0.f; lsum[h] += pv; pl[h * 256 + i] = pv; }
        }
#pragma unroll
        for (int h = 0; h < 4; ++h) lsum[h] = wave_sum(lsum[h]);
        float acc[4] = {0.f, 0.f, 0.f, 0.f};
        for (int i = 0; i < nsel; ++i) {
            const int s = list[i];
            const float vv = bf2f(P[((size_t)b * SEQ + s) * LDP + PC_DV + lane]);
#pragma unroll
            for (int h = 0; h < 4; ++h) acc[h] += pl[h * 256 + i] * vv;
        }
#pragma unroll
        for (int h = 0; h < 4; ++h) Y[tok * DM + 768 + h * 64 + lane] = f2bf(acc[h] / lsum[h]);
    }
}

__device__ void ph_knorm(const Params& p, int l) {
    float* Km = (float*)(p.ws + WS_KM);
    const float* kg = p.in[28] + (size_t)l * 64;
    const int lane = threadIdx.x & 63;
    for (int r = gwave(); r < MMEM; r += nwaves()) {
#pragma unroll
        for (int h = 0; h < 4; ++h) {
            const float v = Km[(size_t)r * 256 + h * 64 + lane];
            const float ss = wave_sum(v * v);
            Km[(size_t)r * 256 + h * 64 + lane] = v * rsqrtf(ss * (1.f / 64.f) + EPS) * kg[lane];
        }
    }
}
__device__ void ph_xattn(const Params& p, int l, float* smem) {
    const float* Qx = (const float*)(p.ws + WS_QX);
    bf16_t* Ox = (bf16_t*)(p.ws + WS_OX);
    const float* Km = (const float*)(p.ws + WS_KM);
    const float* Vm = (const float*)(p.ws + WS_VM);
    const float* qg = p.in[27] + (size_t)l * 64;
    const int tid = threadIdx.x, lane = tid & 63, wave = tid >> 6;
    float* qs = smem + wave * 1280;
    float* pl = qs + 256;
    for (int tok = gwave(); tok < MTOK; tok += nwaves()) {
        const int b = tok / SEQ;
#pragma unroll
        for (int h = 0; h < 4; ++h) {
            const float v = Qx[(size_t)tok * 256 + h * 64 + lane];
            const float ss = wave_sum(v * v);
            qs[h * 64 + lane] = v * rsqrtf(ss * (1.f / 64.f) + EPS) * qg[lane];
        }
        float lg[4][4]; float mx[4] = {-3.0e38f, -3.0e38f, -3.0e38f, -3.0e38f};
#pragma unroll
        for (int r = 0; r < 4; ++r) {
            const int j = r * 64 + lane;
            const float4* kr = (const float4*)(Km + ((size_t)b * NMEM + j) * 256);
#pragma unroll
            for (int h = 0; h < 4; ++h) {
                float d = 0.f;
#pragma unroll 4
                for (int q = 0; q < 16; ++q) { const float4 kv = kr[h * 16 + q]; const float4 q4 = *(const float4*)(qs + h * 64 + q * 4); d += q4.x * kv.x + q4.y * kv.y + q4.z * kv.z + q4.w * kv.w; }
                lg[r][h] = d * 0.125f; mx[h] = fmaxf(mx[h], lg[r][h]);
                asm volatile("" : "+v"(d));
            }
        }
        float lsum[4];
#pragma unroll
        for (int h = 0; h < 4; ++h) { mx[h] = wave_max(mx[h]); lsum[h] = 0.f; }
#pragma unroll
        for (int r = 0; r < 4; ++r)
#pragma unroll
            for (int h = 0; h < 4; ++h) { const float pv = __expf(lg[r][h] - mx[h]); lsum[h] += pv; pl[h * 256 + r * 64 + lane] = pv; }
#pragma unroll
        for (int h = 0; h < 4; ++h) lsum[h] = wave_sum(lsum[h]);
        float acc[4] = {0.f, 0.f, 0.f, 0.f};
        for (int j = 0; j < NMEM; ++j) {
            const float* vr = Vm + ((size_t)b * NMEM + j) * 256;
#pragma unroll
            for (int h = 0; h < 4; ++h) acc[h] += pl[h * 256 + j] * vr[h * 64 + lane];
        }
#pragma unroll
        for (int h = 0; h < 4; ++h) Ox[(size_t)tok * 256 + h * 64 + lane] = f2bf(acc[h] / lsum[h]);
    }
}

__device__ void ph_peer(const Params& p, int l, float* smem) {
    const float* Qp = (const float*)(p.ws + WS_QP);
    const bf16_t* H = (const bf16_t*)(p.ws + WS_H);
    const float* sk = p.in[31] + (size_t)l * 8 * 2 * 128 * 64;
    const float* ut = p.in[32] + (size_t)l * NEXP * DM;
    const float* vt = p.in[33] + (size_t)l * NEXP * DM;
    float* x = p.out;
    const int tid = threadIdx.x, lane = tid & 63, wave = tid >> 6;
    float* qs = smem + wave * 1024;
    for (int tok = gwave(); tok < MTOK; tok += nwaves()) {
#pragma unroll
        for (int i = 0; i < 4; ++i) *(float4*)(qs + (lane + 64 * i) * 4) = *(const float4*)(Qp + (size_t)tok * DM + (lane + 64 * i) * 4);
        float hreg[16];
#pragma unroll
        for (int i = 0; i < 4; ++i) { const ushort4 hv = *(const ushort4*)(H + (size_t)tok * DM + (lane + 64 * i) * 4); hreg[4 * i] = bf2f(hv.x); hreg[4 * i + 1] = bf2f(hv.y); hreg[4 * i + 2] = bf2f(hv.z); hreg[4 * i + 3] = bf2f(hv.w); }
        float out[16];
#pragma unroll
        for (int i = 0; i < 16; ++i) out[i] = 0.f;
        for (int h = 0; h < 8; ++h) {
            float ts[2]; int ti[2];
#pragma unroll
            for (int pp = 0; pp < 2; ++pp) {
                const float* qv = qs + h * 128 + pp * 64;
                unsigned long long k0, k1;
                {
                    const float4* r0 = (const float4*)(sk + ((size_t)(h * 2 + pp) * 128 + lane) * 64);
                    const float4* r1 = (const float4*)(sk + ((size_t)(h * 2 + pp) * 128 + lane + 64) * 64);
                    float d0 = 0.f, d1 = 0.f;
#pragma unroll
                    for (int q = 0; q < 16; ++q) { const float4 q4 = *(const float4*)(qv + q * 4); const float4 a = r0[q], c = r1[q]; d0 += q4.x * a.x + q4.y * a.y + q4.z * a.z + q4.w * a.w; d1 += q4.x * c.x + q4.y * c.y + q4.z * c.z + q4.w * c.w; }
                    k0 = ((unsigned long long)ford(d0) << 32) | (unsigned)(127 - lane);
                    k1 = ((unsigned long long)ford(d1) << 32) | (unsigned)(127 - (lane + 64));
                }
                float mys = 0.f; int myi = 0;
                for (int it = 0; it < 16; ++it) {
                    const unsigned long long m = wave_max_u64(k0 > k1 ? k0 : k1);
                    if (lane == it) { mys = funord((unsigned)(m >> 32)); myi = 127 - (int)(m & 0xffffffffu); }
                    if (k0 == m) k0 = 0ull;
                    if (k1 == m) k1 = 0ull;
                }
                ts[pp] = mys; ti[pp] = myi;
            }
            unsigned long long ck[4];
#pragma unroll
            for (int c = 0; c < 4; ++c) {
                const int f = lane * 4 + c, a = f >> 4, bq = f & 15;
                const float s = __shfl(ts[0], a, 64) + __shfl(ts[1], bq, 64);
                ck[c] = ((unsigned long long)ford(s) << 32) | (unsigned)(255 - f);
            }
            float top = -3.0e38f; int eidx = 0;
            for (int it = 0; it < 16; ++it) {
                unsigned long long m = ck[0] > ck[1] ? ck[0] : ck[1]; const unsigned long long m2 = ck[2] > ck[3] ? ck[2] : ck[3]; m = m > m2 ? m : m2;
                m = wave_max_u64(m);
                const int f = 255 - (int)(m & 0xffffffffu), a = f >> 4, bq = f & 15;
                const int e = __shfl(ti[0], a, 64) * 128 + __shfl(ti[1], bq, 64);
                if (lane == it) { top = funord((unsigned)(m >> 32)); eidx = e; }
#pragma unroll
                for (int c = 0; c < 4; ++c) if (ck[c] == m) ck[c] = 0ull;
            }
            const float mxv = __shfl(top, 0, 64);
            float ev = lane < 16 ? __expf(top - mxv) : 0.f;
            const float den = wave_sum(ev);
            const float gate = ev / den;
            for (int k = 0; k < 16; ++k) {
                const int e = __shfl(eidx, k, 64); const float g = __shfl(gate, k, 64);
                const float4* ur = (const float4*)(ut + (size_t)e * DM);
                float d = 0.f;
#pragma unroll
                for (int i = 0; i < 4; ++i) { const float4 u4 = ur[lane + 64 * i]; d += u4.x * hreg[4 * i] + u4.y * hreg[4 * i + 1] + u4.z * hreg[4 * i + 2] + u4.w * hreg[4 * i + 3]; }
                d = wave_sum(d);
                const float coef = g * gelu_tanh_f(d);
                const float4* vr = (const float4*)(vt + (size_t)e * DM);
#pragma unroll
                for (int i = 0; i < 4; ++i) { const float4 v4 = vr[lane + 64 * i]; out[4 * i] += coef * v4.x; out[4 * i + 1] += coef * v4.y; out[4 * i + 2] += coef * v4.z; out[4 * i + 3] += coef * v4.w; }
            }
        }
#pragma unroll
        for (int i = 0; i < 4; ++i) {
            float4* xp = (float4*)(x + (size_t)tok * DM + (lane + 64 * i) * 4);
            float4 xv = *xp; xv.x += out[4 * i]; xv.y += out[4 * i + 1]; xv.z += out[4 * i + 2]; xv.w += out[4 * i + 3]; *xp = xv;
        }
    }
}

#define KB __launch_bounds__(512)
extern __shared__ __attribute__((aligned(16))) float dynsmem[];
__global__ void KB k_permute(Params p) { ph_permute_win(p); }
__global__ void KB k_rmsnorm_x(Params p, int l, int which) {
    if (which == 0) ph_rmsnorm(l == 0 ? p.in[0] : p.out, p.in[2] + (size_t)l * DM, (bf16_t*)(p.ws + WS_H), MTOK);
    else if (which == 1) ph_rmsnorm(p.out, p.in[21] + (size_t)l * DM, (bf16_t*)(p.ws + WS_H), MTOK);
    else if (which == 2) ph_rmsnorm(p.out, p.in[29] + (size_t)l * DM, (bf16_t*)(p.ws + WS_H), MTOK);
    else ph_rmsnorm(p.in[1], p.in[22] + (size_t)l * DM, (bf16_t*)(p.ws + WS_HM), MMEM);
}
__global__ void KB k_gemm(Params p, int l, int which) {
    float* sm = dynsmem;
    const bf16_t* H = (const bf16_t*)(p.ws + WS_H);
    if (which == 0) ph_sgemm<0>(H, DM, (const float*)(p.ws + WS_WP) + (size_t)l * DM * LDP, LDP, p.ws + WS_P, LDP, nullptr, 0, MTOK, LDP, DM, sm);
    else if (which == 1) ph_sgemm<2>((const bf16_t*)(p.ws + WS_Y), DM, p.in[20] + (size_t)l * DM * DM, DM, p.out, DM, l == 0 ? p.in[0] : p.out, DM, MTOK, DM, DM, sm);
    else if (which == 2) ph_sgemm<1>((const bf16_t*)(p.ws + WS_HM), DM, p.in[24] + (size_t)l * DM * 256, 256, p.ws + WS_KM, 256, nullptr, 0, MMEM, 256, DM, sm);
    else if (which == 3) ph_sgemm<1>((const bf16_t*)(p.ws + WS_HM), DM, p.in[25] + (size_t)l * DM * 256, 256, p.ws + WS_VM, 256, nullptr, 0, MMEM, 256, DM, sm);
    else if (which == 4) ph_sgemm<1>(H, DM, p.in[23] + (size_t)l * DM * 256, 256, p.ws + WS_QX, 256, nullptr, 0, MTOK, 256, DM, sm);
    else if (which == 5) ph_sgemm<2>((const bf16_t*)(p.ws + WS_OX), 256, p.in[26] + (size_t)l * 256 * DM, DM, p.out, DM, p.out, DM, MTOK, DM, 256, sm);
    else if (which == 6) ph_sgemm<1>(H, DM, p.in[30] + (size_t)l * DM * DM, DM, p.ws + WS_QP, DM, nullptr, 0, MTOK, DM, DM, sm);
}
__global__ void KB k_ssd_scan(Params p, int l) { ph_ssd_scan(p, l, dynsmem); }
__global__ void KB k_ssd_finish(Params p, int l) { ph_ssd_finish(p, l); }
__global__ void KB k_gdn_scan(Params p, int l) { ph_gdn_scan(p, l, dynsmem); }
__global__ void KB k_gla_scan(Params p, int l) { ph_gla_scan(p, l, dynsmem); }
__global__ void KB k_dsa_prep(Params p, int l) { ph_dsa_prep(p, l); }
__global__ void KB k_dsa_main(Params p, int l) { ph_dsa_main(p, l, dynsmem); }
__global__ void KB k_knorm(Params p, int l) { ph_knorm(p, l); }
__global__ void KB k_xattn(Params p, int l) { ph_xattn(p, l, dynsmem); }
__global__ void KB k_peer(Params p, int l) { ph_peer(p, l, dynsmem); }

extern "C" void kernel_launch(void* const* d_in, const int* in_sizes, int n_in, void* d_out, int out_size, void* d_ws, size_t ws_size, hipStream_t stream) {
    if (n_in != 34 || out_size != MTOK * DM || ws_size < WS_END) {
        fprintf(stderr, "kernel_launch: unexpected shapes (n_in %d out %d ws %zu need %zu)\n", n_in, out_size, ws_size, (size_t)WS_END);
        return;
    }
    Params p; memset(&p, 0, sizeof(p));
    for (int i = 0; i < 34; ++i) p.in[i] = (const float*)d_in[i];
    p.out = (float*)d_out; p.ws = (char*)d_ws;
    const dim3 blk(512);
    const int G = 1024;
    static int attr_done = 0;
    if (!attr_done) {
        (void)hipFuncSetAttribute((const void*)k_ssd_scan, hipFuncAttributeMaxDynamicSharedMemorySize, 80 * 1024);
        (void)hipFuncSetAttribute((const void*)k_gdn_scan, hipFuncAttributeMaxDynamicSharedMemorySize, 80 * 1024);
        attr_done = 1;
    }
    const size_t LDS_G = 2 * 16 * 132 * 4, LDS_SSD = (4 * 4096 + 64) * 4, LDS_GDN = (4 * 4096 + 128) * 4, LDS_GLA = (3 * 2048 + 2 * 4096) * 4,
                 LDS_DSA = 8 * 1792 * 4, LDS_XA = 8 * 1280 * 4, LDS_PE = 8 * 1024 * 4;
    hipLaunchKernelGGL(k_permute, dim3(G), blk, 0, stream, p);
    for (int l = 0; l < DEPTH; ++l) {
        hipLaunchKernelGGL(k_rmsnorm_x, dim3(G), blk, 0, stream, p, l, 0);
        hipLaunchKernelGGL(k_gemm, dim3(G), blk, LDS_G, stream, p, l, 0);
        hipLaunchKernelGGL(k_ssd_scan, dim3(128), blk, LDS_SSD, stream, p, l);
        hipLaunchKernelGGL(k_ssd_finish, dim3(G), blk, 0, stream, p, l);
        hipLaunchKernelGGL(k_gdn_scan, dim3(128), blk, LDS_GDN, stream, p, l);
        hipLaunchKernelGGL(k_gla_scan, dim3(128), blk, LDS_GLA, stream, p, l);
        hipLaunchKernelGGL(k_dsa_prep, dim3(G), blk, 0, stream, p, l);
        hipLaunchKernelGGL(k_dsa_main, dim3(G), blk, LDS_DSA, stream, p, l);
        hipLaunchKernelGGL(k_gemm, dim3(G), blk, LDS_G, stream, p, l, 1);
        hipLaunchKernelGGL(k_rmsnorm_x, dim3(G), blk, 0, stream, p, l, 3);
        hipLaunchKernelGGL(k_gemm, dim3(G), blk, LDS_G, stream, p, l, 2);
        hipLaunchKernelGGL(k_gemm, dim3(G), blk, LDS_G, stream, p, l, 3);
        hipLaunchKernelGGL(k_knorm, dim3(G), blk, 0, stream, p, l);
        hipLaunchKernelGGL(k_rmsnorm_x, dim3(G), blk, 0, stream, p, l, 1);
        hipLaunchKernelGGL(k_gemm, dim3(G), blk, LDS_G, stream, p, l, 4);
        hipLaunchKernelGGL(k_xattn, dim3(G), blk, LDS_XA, stream, p, l);
        hipLaunchKernelGGL(k_gemm, dim3(G), blk, LDS_G, stream, p, l, 5);
        hipLaunchKernelGGL(k_rmsnorm_x, dim3(G), blk, 0, stream, p, l, 2);
        hipLaunchKernelGGL(k_gemm, dim3(G), blk, LDS_G, stream, p, l, 6);
        hipLaunchKernelGGL(k_peer, dim3(G), blk, LDS_PE, stream, p, l);
    }
}
```

```cpp
#include <hip/hip_runtime.h>
#include <stdint.h>
#include <stdio.h>
#include <string.h>

#define NB 32
#define SEQ 2048
#define DM 1024
#define MTOK (NB * SEQ)
#define DEPTH 4
#define NMEM 256
#define MMEM (NB * NMEM)
#define LDP 3328
#define NEXP 16384
#define EPS 1e-6f
#define PC_Z 0
#define PC_XBC 256
#define PC_GQKV 768
#define PC_GG 1536
#define PC_LQ 1792
#define PC_LK 1920
#define PC_LV 2048
#define PC_LR 2304
#define PC_DQ 2560
#define PC_DK 2816
#define PC_DV 2880
#define PC_IQ 2944
#define PC_IK 3200
#define PC_GLR 3232
#define PC_IW 3248
#define PC_DT 3256
#define PC_GA 3260
#define PC_GB 3264

typedef unsigned short bf16_t;

#define WS_BAR 0ull
#define WS_P 16384ull
#define SZ_P ((size_t)MTOK * LDP * 2)
#define WS_H (WS_P + SZ_P)
#define SZ_H ((size_t)MTOK * DM * 2)
#define WS_Y (WS_H + SZ_H)
#define SZ_Y ((size_t)MTOK * DM * 2)
#define WS_WP (WS_Y + SZ_Y)
#define SZ_WP ((size_t)DEPTH * DM * LDP * 4)
#define WS_QN (WS_WP + SZ_WP)
#define SZ_QN ((size_t)MTOK * 256 * 4)
#define WS_KN (WS_QN + SZ_QN)
#define SZ_KN ((size_t)MTOK * 64 * 4)
#define WS_IKN (WS_KN + SZ_KN)
#define SZ_IKN ((size_t)MTOK * 32 * 4)
#define WS_YPRE (WS_IKN + SZ_IKN)
#define SZ_YPRE ((size_t)MTOK * 256 * 4)
#define WS_HM (WS_YPRE + SZ_YPRE)
#define SZ_HM ((size_t)DEPTH * MMEM * DM * 2)
#define WS_KM (WS_HM + SZ_HM)
#define SZ_KM ((size_t)DEPTH * MMEM * 256 * 4)
#define WS_VM (WS_KM + SZ_KM)
#define SZ_VM ((size_t)DEPTH * MMEM * 256 * 4)
#define WS_END (WS_VM + SZ_VM)
#define WS_QX (WS_P)
#define WS_OX (WS_P + (size_t)MTOK * 256 * 4)
#define WS_QP (WS_P)

struct Params {
    const float* in[34];
    float* out;
    char* ws;
};

#define XB_TMO      128
#define XB_XCNT(j)  (256  + 64 * (j))
#define XB_XSUB(j)  (1280 + 64 * (j))
#define XB_XGEN(j)  (2304 + 64 * (j))
#define XB_TOP      3328
#define XB_TOPGEN   3392
#define XCD_BAR_WORDS 3456
#define XB_SPIN_CAP (1u << 18)
#define LAS __attribute__((address_space(3)))

__device__ __forceinline__ unsigned xb_ld(unsigned* p)              { return __hip_atomic_load(p, __ATOMIC_RELAXED, __HIP_MEMORY_SCOPE_AGENT); }
__device__ __forceinline__ unsigned xb_add(unsigned* p, unsigned v) { return __hip_atomic_fetch_add(p, v, __ATOMIC_RELAXED, __HIP_MEMORY_SCOPE_AGENT); }
__device__ __forceinline__ unsigned xb_xcc_id() { return (unsigned)__builtin_amdgcn_s_getreg((3 << 11) | 20) & 0xFu; }
#define XB_SPIN(cond, bar) do { unsigned _sp = 0; while (cond) { __builtin_amdgcn_s_sleep(1); \
    if ((++_sp & 255u) == 0u) { if (xb_ld(&(bar)[XB_TMO])) break; if (_sp > XB_SPIN_CAP) { atomicAdd(&(bar)[XB_TMO], 1u); break; } } } } while (0)

struct XcdBarrier {
    unsigned* bar; unsigned x;
    volatile LAS unsigned* st;
};

__device__ __forceinline__ XcdBarrier xcd_barrier_post(unsigned* bar, volatile LAS unsigned* st) {
    XcdBarrier b; b.bar = bar; b.x = xb_xcc_id(); b.st = st;
    if (threadIdx.x == 0) (void)xb_add(&bar[XB_XCNT(b.x)], 1u);
    return b;
}
__device__ __forceinline__ void xcd_barrier_complete(unsigned* bar, unsigned x, unsigned& nloc, unsigned& nx) {
    const unsigned G = gridDim.x * gridDim.y * gridDim.z;
    unsigned sum, cnt, mine, sp = 0u;
    for (;;) {
        sum = 0u; cnt = 0u; mine = 0u;
#pragma unroll
        for (unsigned j = 0; j < 16; ++j) { const unsigned c = xb_ld(&bar[XB_XCNT(j)]); sum += c; cnt += (c > 0u) ? 1u : 0u; mine = (j == x) ? c : mine; }
        if (sum == G) break;
        __builtin_amdgcn_s_sleep(1);
        if ((++sp & 255u) == 0u) { if (xb_ld(&bar[XB_TMO])) break; if (sp > XB_SPIN_CAP) { atomicAdd(&bar[XB_TMO], 1u); break; } }
    }
    nloc = mine > 0u ? mine : 1u; nx = cnt > 0u ? cnt : 1u;
}

__device__ __forceinline__ void xcd_barrier(const XcdBarrier& b) {
    asm volatile("s_waitcnt vmcnt(0)" ::: "memory");
    __syncthreads();
    if (threadIdx.x == 0) {
        unsigned* bar = b.bar;
        __builtin_amdgcn_s_waitcnt(0);
        unsigned nloc = b.st[0], nx = b.st[1];
        if (nloc == 0u) { xcd_barrier_complete(bar, b.x, nloc, nx); b.st[0] = nloc; b.st[1] = nx; }
        const unsigned old = xb_add(&bar[XB_XSUB(b.x)], 1u);
        const unsigned gen = old / nloc;
        if (old + 1u == (gen + 1u) * nloc) {
            __builtin_amdgcn_fence(__ATOMIC_RELEASE, "agent");
            asm volatile("s_waitcnt vmcnt(0)" ::: "memory");
            const unsigned og = xb_add(&bar[XB_TOP], 1u);
            const unsigned tg = og / nx;
            if (og + 1u == (tg + 1u) * nx) xb_add(&bar[XB_TOPGEN], 1u);
            else XB_SPIN(xb_ld(&bar[XB_TOPGEN]) == tg, bar);
            __builtin_amdgcn_fence(__ATOMIC_ACQUIRE, "agent");
            xb_add(&bar[XB_XGEN(b.x)], 1u);
            asm volatile("s_waitcnt vmcnt(0)" ::: "memory");
        } else {
            XB_SPIN(xb_ld(&bar[XB_XGEN(b.x)]) == gen, bar);
            __builtin_amdgcn_fence(__ATOMIC_ACQUIRE, "agent");
            asm volatile("s_waitcnt vmcnt(0)" ::: "memory");
        }
    }
    __syncthreads();
}


#define LDS_BYTES (128 * 1024)
#define PTAB_OFF (LDS_BYTES - 1024)
extern __shared__ __attribute__((aligned(16))) float dynsmem[];
__device__ __forceinline__ unsigned long long ptab_get(int i) {
    const uint2 v = *(const uint2*)((const char*)dynsmem + PTAB_OFF + i * 8);
    const unsigned lo = __builtin_amdgcn_readfirstlane(v.x), hi = __builtin_amdgcn_readfirstlane(v.y);
    return ((unsigned long long)hi << 32) | lo;
}
__device__ __forceinline__ const float* pin_(int i) { return (const float*)ptab_get(i); }
__device__ __forceinline__ float* pout_() { return (float*)ptab_get(34); }
__device__ __forceinline__ char* pws_() { return (char*)ptab_get(35); }
struct Ctx { int dummy; };

__device__ __forceinline__ float bf2f(bf16_t v) { return __uint_as_float(((unsigned)v) << 16); }
__device__ __forceinline__ bf16_t f2bf(float f) { unsigned u = __float_as_uint(f); u += 0x7FFFu + ((u >> 16) & 1u); return (bf16_t)(u >> 16); }
__device__ __forceinline__ float wave_sum(float v) {
#pragma unroll
    for (int o = 32; o >= 1; o >>= 1) v += __shfl_xor(v, o, 64);
    return v;
}
__device__ __forceinline__ float wave_max(float v) {
#pragma unroll
    for (int o = 32; o >= 1; o >>= 1) v = fmaxf(v, __shfl_xor(v, o, 64));
    return v;
}
__device__ __forceinline__ float silu_f(float x) { return x / (1.f + __expf(-x)); }
__device__ __forceinline__ float sigmoid_f(float x) { return 1.f / (1.f + __expf(-x)); }
__device__ __forceinline__ float softplus_f(float x) { return x > 20.f ? x : log1pf(__expf(x)); }
__device__ __forceinline__ float logsigmoid_f(float x) { return -softplus_f(-x); }
__device__ __forceinline__ float gelu_tanh_f(float x) { const float u = 0.7978845608028654f * (x + 0.044715f * x * x * x); return 0.5f * x * (1.f + tanhf(u)); }
__device__ __forceinline__ unsigned ford(float f) { f = f + 0.0f; unsigned u = __float_as_uint(f); return (u & 0x80000000u) ? ~u : (u | 0x80000000u); }
__device__ __forceinline__ float funord(unsigned k) { unsigned u = (k & 0x80000000u) ? (k & 0x7fffffffu) : ~k; return __uint_as_float(u); }
__device__ __forceinline__ unsigned long long wave_max_u64(unsigned long long v) {
#pragma unroll
    for (int o = 32; o >= 1; o >>= 1) {
        unsigned lo = __shfl_xor((unsigned)v, o, 64), hi = __shfl_xor((unsigned)(v >> 32), o, 64);
        unsigned long long w = ((unsigned long long)hi << 32) | lo;
        v = w > v ? w : v;
    }
    return v;
}
__device__ __forceinline__ int tid_() { int t = threadIdx.x; asm volatile("" : "+v"(t)); return t; }
__device__ __forceinline__ int bid_() { int b = blockIdx.x; asm volatile("" : "+s"(b)); return b; }
__device__ __forceinline__ int nblk_() { int g = gridDim.x; asm volatile("" : "+s"(g)); return g; }
__device__ __forceinline__ int gwave() { return (bid_() * 512 + tid_()) >> 6; }
__device__ __forceinline__ int nwaves() { return nblk_() * 8; }

__device__ __forceinline__ int pcol_to_orig(int c) {
    if (c < 768) return c;
    if (c < 1536) return c - 768 + 772;
    if (c < 1792) return c - 1536 + 1548;
    if (c < 1920) return c - 1792 + 1804;
    if (c < 2048) return c - 1920 + 1932;
    if (c < 2304) return c - 2048 + 2060;
    if (c < 2560) return c - 2304 + 2332;
    if (c < 2816) return c - 2560 + 2588;
    if (c < 2880) return c - 2816 + 2844;
    if (c < 2944) return c - 2880 + 2908;
    if (c < 3200) return c - 2944 + 2972;
    if (c < 3232) return c - 3200 + 3228;
    if (c < 3248) return c - 3232 + 2316;
    if (c < 3256) return c - 3248 + 3260;
    if (c < 3260) return c - 3256 + 768;
    if (c < 3264) return c - 3260 + 1540;
    if (c < 3268) return c - 3264 + 1544;
    return -1;
}
__device__ __forceinline__ void ph_permute_win(const Ctx& p) {
    const float* w = pin_(3);
    float* wp = (float*)(pws_() + WS_WP);
    const size_t total = (size_t)DEPTH * DM * LDP;
    for (size_t i = (size_t)bid_() * 512 + tid_(); i < total; i += (size_t)nblk_() * 512) {
        const int c = (int)(i % LDP); const size_t lk = i / LDP;
        const int oc = pcol_to_orig(c);
        wp[i] = oc >= 0 ? w[lk * 3268 + oc] : 0.f;
    }
}

__device__ __forceinline__ void ph_rmsnorm(const float* __restrict__ x, const float* __restrict__ g, bf16_t* __restrict__ out, int rows) {
    const int lane = tid_() & 63;
    for (int r = gwave(); r < rows; r += nwaves()) {
        const float4* xr = (const float4*)(x + (size_t)r * DM);
        float4 v[4]; float ss = 0.f;
#pragma unroll
        for (int i = 0; i < 4; ++i) { v[i] = xr[lane + 64 * i]; ss += v[i].x * v[i].x + v[i].y * v[i].y + v[i].z * v[i].z + v[i].w * v[i].w; }
        ss = wave_sum(ss);
        const float rs = rsqrtf(ss * (1.f / DM) + EPS);
#pragma unroll
        for (int i = 0; i < 4; ++i) {
            const float4 gg = ((const float4*)g)[lane + 64 * i];
            ushort4 o; o.x = f2bf(v[i].x * rs * gg.x); o.y = f2bf(v[i].y * rs * gg.y); o.z = f2bf(v[i].z * rs * gg.z); o.w = f2bf(v[i].w * rs * gg.w);
            *(ushort4*)(out + (size_t)r * DM + (size_t)(lane + 64 * i) * 4) = o;
        }
    }
}

template <int OUTMODE>
__device__ __forceinline__ void ph_sgemm(const bf16_t* __restrict__ A, int lda, const float* __restrict__ B, int ldb, void* Cv, int ldc, const float* R, int ldr,
                         int M, int N, int K, float* smem) {
    float* As = smem;
    float* Bs = smem + 16 * 132;
    const int tid = tid_(), tx = tid & 31, ty = tid >> 5;
    const int ntn = N / 128, ntiles = (M / 128) * ntn;
    for (int tile = bid_(); tile < ntiles; tile += nblk_()) {
        const int tm = tile / ntn, tn = tile % ntn;
        float acc[8][4];
#pragma unroll
        for (int i = 0; i < 8; ++i)
#pragma unroll
            for (int j = 0; j < 4; ++j) acc[i][j] = 0.f;
        const int arow = tid >> 2, akq = (tid & 3) * 4;
        const int bk = tid >> 5, bn = (tid & 31) * 4;
        for (int k0 = 0; k0 < K; k0 += 16) {
            const ushort4 av = *(const ushort4*)(A + (size_t)(tm * 128 + arow) * lda + k0 + akq);
            const float4 bv = *(const float4*)(B + (size_t)(k0 + bk) * ldb + tn * 128 + bn);
            __syncthreads();
            As[(akq + 0) * 132 + arow] = bf2f(av.x); As[(akq + 1) * 132 + arow] = bf2f(av.y);
            As[(akq + 2) * 132 + arow] = bf2f(av.z); As[(akq + 3) * 132 + arow] = bf2f(av.w);
            *(float4*)(Bs + bk * 132 + bn) = bv;
            __syncthreads();
#pragma unroll
            for (int k = 0; k < 16; ++k) {
                const float4 a0 = *(const float4*)(As + k * 132 + ty * 8), a1 = *(const float4*)(As + k * 132 + ty * 8 + 4);
                const float4 b = *(const float4*)(Bs + k * 132 + tx * 4);
                const float a[8] = {a0.x, a0.y, a0.z, a0.w, a1.x, a1.y, a1.z, a1.w};
#pragma unroll
                for (int i = 0; i < 8; ++i) { acc[i][0] += a[i] * b.x; acc[i][1] += a[i] * b.y; acc[i][2] += a[i] * b.z; acc[i][3] += a[i] * b.w; }
            }
        }
#pragma unroll
        for (int i = 0; i < 8; ++i) {
            const size_t row = (size_t)tm * 128 + ty * 8 + i; const int col = tn * 128 + tx * 4;
            if (OUTMODE == 0) {
                ushort4 o; o.x = f2bf(acc[i][0]); o.y = f2bf(acc[i][1]); o.z = f2bf(acc[i][2]); o.w = f2bf(acc[i][3]);
                *(ushort4*)((bf16_t*)Cv + row * ldc + col) = o;
            } else if (OUTMODE == 1) {
                *(float4*)((float*)Cv + row * ldc + col) = make_float4(acc[i][0], acc[i][1], acc[i][2], acc[i][3]);
            } else {
                const float4 r = *(const float4*)(R + row * ldr + col);
                *(float4*)((float*)Cv + row * ldc + col) = make_float4(r.x + acc[i][0], r.y + acc[i][1], r.z + acc[i][2], r.w + acc[i][3]);
            }
        }
    }
}

__device__ __forceinline__ void ph_ssd_scan(const Ctx& p, int l, float* smem) {
    const bf16_t* P = (const bf16_t*)(pws_() + WS_P);
    float* Ypre = (float*)(pws_() + WS_YPRE);
    const float* cw = pin_(4) + (size_t)l * 4 * 512;
    const float* cb = pin_(5) + (size_t)l * 512;
    float* xs = smem;
    float* Bs = xs + 4096;
    float* Cs = Bs + 4096;
    float* yb = Cs + 4096;
    float* dts = yb + 4096;
    const int tid = tid_(), pp = tid >> 3, ng = tid & 7;
    for (int item = bid_(); item < NB * 4; item += nblk_()) {
        const int b = item >> 2, h = item & 3, g = h >> 1;
        const float a = -__expf(pin_(7)[l * 4 + h]);
        const float dtb = pin_(6)[l * 4 + h];
        const float Dh = pin_(8)[l * 4 + h];
        float hst[8];
#pragma unroll
        for (int i = 0; i < 8; ++i) hst[i] = 0.f;
        for (int c = 0; c < SEQ / 64; ++c) {
            const int t0 = c * 64;
            __syncthreads();
            for (int idx = tid; idx < 64 * 192; idx += 512) {
                const int tl = idx / 192, ch = idx % 192, which = ch >> 6, cl = ch & 63;
                const int cc = which == 0 ? h * 64 + cl : (which == 1 ? 256 + g * 64 + cl : 384 + g * 64 + cl);
                float acc = cb[cc];
#pragma unroll
                for (int j = 0; j < 4; ++j) { const int tt = t0 + tl - 3 + j; if (tt >= 0) acc += cw[j * 512 + cc] * bf2f(P[((size_t)b * SEQ + tt) * LDP + PC_XBC + cc]); }
                const float v = silu_f(acc);
                (which == 0 ? xs : (which == 1 ? Bs : Cs))[tl * 64 + cl] = v;
            }
            if (tid < 64) dts[tid] = softplus_f(bf2f(P[((size_t)b * SEQ + t0 + tid) * LDP + PC_DT + h]) + dtb);
            __syncthreads();
            for (int tl = 0; tl < 64; ++tl) {
                const float dt = dts[tl], dA = __expf(dt * a), xv = xs[tl * 64 + pp];
                const float xdt = xv * dt;
                const float4 b0 = *(const float4*)(Bs + tl * 64 + ng * 8), b1 = *(const float4*)(Bs + tl * 64 + ng * 8 + 4);
                const float4 c0 = *(const float4*)(Cs + tl * 64 + ng * 8), c1 = *(const float4*)(Cs + tl * 64 + ng * 8 + 4);
                const float bb[8] = {b0.x, b0.y, b0.z, b0.w, b1.x, b1.y, b1.z, b1.w};
                const float cc8[8] = {c0.x, c0.y, c0.z, c0.w, c1.x, c1.y, c1.z, c1.w};
                float part = 0.f;
#pragma unroll
                for (int i = 0; i < 8; ++i) { hst[i] = hst[i] * dA + xdt * bb[i]; part += cc8[i] * hst[i]; }
                part += __shfl_xor(part, 1, 64); part += __shfl_xor(part, 2, 64); part += __shfl_xor(part, 4, 64);
                if (ng == 0) yb[tl * 64 + pp] = part + Dh * xv;
            }
            __syncthreads();
            for (int idx = tid; idx < 4096; idx += 512) { const int tl = idx >> 6, q = idx & 63; Ypre[((size_t)b * SEQ + t0 + tl) * 256 + h * 64 + q] = yb[idx]; }
        }
    }
}
__device__ __forceinline__ void ph_ssd_finish(const Ctx& p, int l) {
    const bf16_t* P = (const bf16_t*)(pws_() + WS_P);
    const float* Ypre = (const float*)(pws_() + WS_YPRE);
    bf16_t* Y = (bf16_t*)(pws_() + WS_Y);
    const float* gn = pin_(9) + (size_t)l * 256;
    const int lane = tid_() & 63;
    for (int tok = gwave(); tok < MTOK; tok += nwaves()) {
        float v[4]; float ss = 0.f;
#pragma unroll
        for (int i = 0; i < 4; ++i) { const int c = lane + 64 * i; const float z = bf2f(P[(size_t)tok * LDP + PC_Z + c]); v[i] = Ypre[(size_t)tok * 256 + c] * silu_f(z); ss += v[i] * v[i]; }
        ss = wave_sum(ss);
        const float rs = rsqrtf(ss * (1.f / 256.f) + EPS);
#pragma unroll
        for (int i = 0; i < 4; ++i) { const int c = lane + 64 * i; Y[(size_t)tok * DM + c] = f2bf(v[i] * rs * gn[c]); }
    }
}

__device__ __forceinline__ void ph_gdn_scan(const Ctx& p, int l, float* smem) {
    const bf16_t* P = (const bf16_t*)(pws_() + WS_P);
    bf16_t* Y = (bf16_t*)(pws_() + WS_Y);
    const float* cw = pin_(10) + (size_t)l * 4 * 768;
    const float* gn = pin_(13) + (size_t)l * 64;
    float* qs = smem;
    float* ks = qs + 4096;
    float* vs = ks + 4096;
    float* ob = vs + 4096;
    float* al = ob + 4096;
    float* be = al + 64;
    const int tid = tid_(), lane = tid & 63, wave = tid >> 6;
    const int e = wave * 8 + (lane & 7), dg = lane >> 3;
    for (int item = bid_(); item < NB * 4; item += nblk_()) {
        const int b = item >> 2, h = item & 3;
        const float A = -__expf(pin_(11)[l * 4 + h]);
        const float dtb = pin_(12)[l * 4 + h];
        float S[8];
#pragma unroll
        for (int i = 0; i < 8; ++i) S[i] = 0.f;
        for (int c = 0; c < SEQ / 64; ++c) {
            const int t0 = c * 64;
            __syncthreads();
            for (int idx = tid; idx < 64 * 192; idx += 512) {
                const int tl = idx / 192, ch = idx % 192, which = ch >> 6, cl = ch & 63;
                const int cc = which * 256 + h * 64 + cl;
                float acc = 0.f;
#pragma unroll
                for (int j = 0; j < 4; ++j) { const int tt = t0 + tl - 3 + j; if (tt >= 0) acc += cw[j * 768 + cc] * bf2f(P[((size_t)b * SEQ + tt) * LDP + PC_GQKV + cc]); }
                (which == 0 ? qs : (which == 1 ? ks : vs))[tl * 64 + cl] = silu_f(acc);
            }
            if (tid < 64) {
                const size_t row = ((size_t)b * SEQ + t0 + tid) * LDP;
                const float ga = bf2f(P[row + PC_GA + h]), gb = bf2f(P[row + PC_GB + h]);
                al[tid] = __expf(A * softplus_f(ga + dtb));
                be[tid] = sigmoid_f(gb);
            }
            __syncthreads();
            for (int r = wave; r < 128; r += 8) {
                float* rowp = (r < 64 ? qs + r * 64 : ks + (r - 64) * 64);
                const float v = rowp[lane];
                const float ss = wave_sum(v * v);
                const float sc = rsqrtf(ss + EPS) * (r < 64 ? 0.125f : 1.f);
                rowp[lane] = v * sc;
            }
            __syncthreads();
            for (int tl = 0; tl < 64; ++tl) {
                const float alpha = al[tl], beta = be[tl];
                const float4 k0 = *(const float4*)(ks + tl * 64 + dg * 8), k1 = *(const float4*)(ks + tl * 64 + dg * 8 + 4);
                const float4 q0 = *(const float4*)(qs + tl * 64 + dg * 8), q1 = *(const float4*)(qs + tl * 64 + dg * 8 + 4);
                const float kk[8] = {k0.x, k0.y, k0.z, k0.w, k1.x, k1.y, k1.z, k1.w};
                const float qq[8] = {q0.x, q0.y, q0.z, q0.w, q1.x, q1.y, q1.z, q1.w};
                float r = 0.f;
#pragma unroll
                for (int i = 0; i < 8; ++i) { S[i] *= alpha; r += S[i] * kk[i]; }
                r += __shfl_xor(r, 8, 64); r += __shfl_xor(r, 16, 64); r += __shfl_xor(r, 32, 64);
                const float vn = beta * (vs[tl * 64 + e] - r);
                float o = 0.f;
#pragma unroll
                for (int i = 0; i < 8; ++i) { S[i] += kk[i] * vn; o += S[i] * qq[i]; }
                o += __shfl_xor(o, 8, 64); o += __shfl_xor(o, 16, 64); o += __shfl_xor(o, 32, 64);
                if (dg == 0) ob[tl * 64 + e] = o;
            }
            __syncthreads();
            for (int r = wave; r < 64; r += 8) {
                const float v = ob[r * 64 + lane];
                const float ss = wave_sum(v * v);
                const float rs = rsqrtf(ss * (1.f / 64.f) + EPS);
                const size_t tok = (size_t)b * SEQ + t0 + r;
                const float gate = bf2f(P[tok * LDP + PC_GG + h * 64 + lane]);
                Y[tok * DM + 256 + h * 64 + lane] = f2bf(v * rs * gn[lane] * silu_f(gate));
            }
        }
    }
}

__device__ __forceinline__ void ph_gla_scan(const Ctx& p, int l, float* smem) {
    const bf16_t* P = (const bf16_t*)(pws_() + WS_P);
    bf16_t* Y = (bf16_t*)(pws_() + WS_Y);
    const float* wg = pin_(14) + (size_t)l * 16 * 128;
    const float* bg = pin_(15) + (size_t)l * 128;
    const float* gn = pin_(16) + (size_t)l * 64;
    float* qs = smem;
    float* ks = qs + 2048;
    float* ds = ks + 2048;
    float* vs = ds + 2048;
    float* ob = vs + 4096;
    const int tid = tid_(), lane = tid & 63, wave = tid >> 6;
    const int e = wave * 8 + (lane & 7), dg = lane >> 3;
    for (int item = bid_(); item < NB * 4; item += nblk_()) {
        const int b = item >> 2, h = item & 3;
        float S[4];
#pragma unroll
        for (int i = 0; i < 4; ++i) S[i] = 0.f;
        for (int c = 0; c < SEQ / 64; ++c) {
            const int t0 = c * 64;
            __syncthreads();
            for (int idx = tid; idx < 64 * 32; idx += 512) {
                const int tl = idx >> 5, d = idx & 31;
                const size_t row = ((size_t)b * SEQ + t0 + tl) * LDP;
                qs[idx] = bf2f(P[row + PC_LQ + h * 32 + d]) * 0.17677669529663687f;
                ks[idx] = bf2f(P[row + PC_LK + h * 32 + d]);
                float acc = bg[h * 32 + d];
#pragma unroll
                for (int r = 0; r < 16; ++r) acc += bf2f(P[row + PC_GLR + r]) * wg[r * 128 + h * 32 + d];
                ds[idx] = __expf(logsigmoid_f(acc) * (1.f / 16.f));
            }
            for (int idx = tid; idx < 4096; idx += 512) { const int tl = idx >> 6, q = idx & 63; vs[idx] = bf2f(P[((size_t)b * SEQ + t0 + tl) * LDP + PC_LV + h * 64 + q]); }
            __syncthreads();
            for (int tl = 0; tl < 64; ++tl) {
                const float4 k4 = *(const float4*)(ks + tl * 32 + dg * 4), q4 = *(const float4*)(qs + tl * 32 + dg * 4), d4 = *(const float4*)(ds + tl * 32 + dg * 4);
                const float kk[4] = {k4.x, k4.y, k4.z, k4.w}, qq[4] = {q4.x, q4.y, q4.z, q4.w}, dd[4] = {d4.x, d4.y, d4.z, d4.w};
                const float v = vs[tl * 64 + e];
                float o = 0.f;
#pragma unroll
                for (int i = 0; i < 4; ++i) { S[i] = dd[i] * S[i] + kk[i] * v; o += S[i] * qq[i]; }
                o += __shfl_xor(o, 8, 64); o += __shfl_xor(o, 16, 64); o += __shfl_xor(o, 32, 64);
                if (dg == 0) ob[tl * 64 + e] = o;
            }
            __syncthreads();
            for (int r = wave; r < 64; r += 8) {
                const float v = ob[r * 64 + lane];
                const float ss = wave_sum(v * v);
                const float rs = rsqrtf(ss * (1.f / 64.f) + EPS);
                const size_t tok = (size_t)b * SEQ + t0 + r;
                const float gate = bf2f(P[tok * LDP + PC_LR + h * 64 + lane]);
                Y[tok * DM + 512 + h * 64 + lane] = f2bf(v * rs * gn[lane] * silu_f(gate));
            }
        }
    }
}

__device__ __forceinline__ void ph_dsa_prep(const Ctx& p, int l) {
    const bf16_t* P = (const bf16_t*)(pws_() + WS_P);
    float* qn = (float*)(pws_() + WS_QN);
    float* kn = (float*)(pws_() + WS_KN);
    float* ikn = (float*)(pws_() + WS_IKN);
    const float* qg = pin_(17) + (size_t)l * 64;
    const float* kg = pin_(18) + (size_t)l * 64;
    const float* ig = pin_(19) + (size_t)l * 32;
    const int lane = tid_() & 63;
    for (int tok = gwave(); tok < MTOK; tok += nwaves()) {
        const size_t row = (size_t)tok * LDP;
#pragma unroll
        for (int h = 0; h < 4; ++h) {
            const float v = bf2f(P[row + PC_DQ + h * 64 + lane]);
            const float ss = wave_sum(v * v);
            qn[(size_t)tok * 256 + h * 64 + lane] = v * rsqrtf(ss * (1.f / 64.f) + EPS) * qg[lane];
        }
        {
            const float v = bf2f(P[row + PC_DK + lane]);
            const float ss = wave_sum(v * v);
            kn[(size_t)tok * 64 + lane] = v * rsqrtf(ss * (1.f / 64.f) + EPS) * kg[lane];
        }
        {
            const float v = lane < 32 ? bf2f(P[row + PC_IK + lane]) : 0.f;
            const float ss = wave_sum(v * v);
            if (lane < 32) ikn[(size_t)tok * 32 + lane] = v * rsqrtf(ss * (1.f / 32.f) + EPS) * ig[lane];
        }
    }
}

__device__ __forceinline__ void ph_dsa_main(const Ctx& p, int l, float* smem) {
    const bf16_t* P = (const bf16_t*)(pws_() + WS_P);
    bf16_t* Y = (bf16_t*)(pws_() + WS_Y);
    const float* qn = (const float*)(pws_() + WS_QN);
    const float* kn = (const float*)(pws_() + WS_KN);
    const float* ikn = (const float*)(pws_() + WS_IKN);
    const int tid = tid_(), lane = tid & 63, wave = tid >> 6;
    float* wbase = smem + wave * 3840;
    float* iqs = wbase;
    float* qhs = wbase + 256;
    int* list = (int*)(wbase + 512);
    float* pl = wbase + 768;
    unsigned* kb = (unsigned*)(wbase + 1792);
    const unsigned long long lt_mask = (lane == 0) ? 0ull : (~0ull >> (64 - lane));
    for (int item = gwave(); item < MTOK; item += nwaves()) {
        const int t = SEQ - 1 - (item / NB), b = item % NB;
        const size_t tok = (size_t)b * SEQ + t;
        const int nk = ((t >> 6) + 1) * 64, nj = nk >> 6;
#pragma unroll
        for (int i = 0; i < 4; ++i) { iqs[lane + 64 * i] = bf2f(P[tok * LDP + PC_IQ + lane + 64 * i]); qhs[lane + 64 * i] = qn[tok * 256 + lane + 64 * i]; }
        float wh[8];
#pragma unroll
        for (int h = 0; h < 8; ++h) wh[h] = bf2f(P[tok * LDP + PC_IW + h]) * 0.0625f;
        int nsel;
        if (nk > 256) {
            for (int j = 0; j < nj; ++j) {
                const float4* kr = (const float4*)(ikn + ((size_t)b * SEQ + j * 64 + lane) * 32);
                float4 kv[8];
#pragma unroll
                for (int q = 0; q < 8; ++q) kv[q] = kr[q];
                float acc = 0.f;
#pragma unroll
                for (int h = 0; h < 8; ++h) {
                    float d = 0.f;
#pragma unroll
                    for (int q = 0; q < 8; ++q) { const float4 iq4 = *(const float4*)(iqs + h * 32 + q * 4); d += iq4.x * kv[q].x + iq4.y * kv[q].y + iq4.z * kv[q].z + iq4.w * kv[q].w; }
                    acc += wh[h] * fmaxf(d, 0.f);
                }
                kb[j * 64 + lane] = ford(acc);
            }
            unsigned T = 0u; bool exact = false;
            for (int bit = 31; bit >= 0; --bit) {
                const unsigned cand = T | (1u << bit);
                int cnt = 0;
                for (int j = 0; j < nj; ++j) cnt += __popcll(__ballot(kb[j * 64 + lane] >= cand));
                if (cnt >= 256) { T = cand; if (cnt == 256) { exact = true; break; } }
            }
            int cut = 0x7fffffff;
            if (!exact) {
                int cgt = 0, ceq = 0;
                for (int j = 0; j < nj; ++j) { const unsigned kk = kb[j * 64 + lane]; cgt += __popcll(__ballot(kk > T)); ceq += __popcll(__ballot(kk == T)); }
                int need = 256 - cgt;
                if (ceq > need) {
                    for (int j = 0; j < nj; ++j) {
                        const unsigned long long m = __ballot(kb[j * 64 + lane] == T);
                        const int c = __popcll(m);
                        if (need <= c) { for (int bpos = 0; bpos < 64; ++bpos) if ((m >> bpos) & 1ull) { if (--need == 0) { cut = j * 64 + bpos; break; } } break; }
                        need -= c;
                    }
                }
            }
            int base = 0;
            for (int j = 0; j < nj; ++j) {
                const int s = j * 64 + lane;
                const unsigned kk = kb[s];
                const bool sel = kk > T || (kk == T && s <= cut);
                const unsigned long long m = __ballot(sel);
                if (sel) { const int pos = base + __popcll(m & lt_mask); if (pos < 256) list[pos] = s; }
                base += __popcll(m);
            }
            nsel = base < 256 ? base : 256;
        } else {
#pragma unroll
            for (int i = 0; i < 4; ++i) list[lane + 64 * i] = lane + 64 * i;
            nsel = nk;
        }
        float mx[4] = {-3.0e38f, -3.0e38f, -3.0e38f, -3.0e38f};
        for (int r = 0; r * 64 < nsel; ++r) {
            const int i = r * 64 + lane;
            if (i < nsel) {
                const int s = list[i];
                const float4* kr = (const float4*)(kn + ((size_t)b * SEQ + s) * 64);
                float d[4] = {0.f, 0.f, 0.f, 0.f};
#pragma unroll 4
                for (int q = 0; q < 16; ++q) {
                    const float4 kv = kr[q];
#pragma unroll
                    for (int h = 0; h < 4; ++h) { const float4 q4 = *(const float4*)(qhs + h * 64 + q * 4); d[h] += q4.x * kv.x + q4.y * kv.y + q4.z * kv.z + q4.w * kv.w; }
                }
#pragma unroll
                for (int h = 0; h < 4; ++h) { const float v = d[h] * 0.125f; pl[h * 256 + i] = v; mx[h] = fmaxf(mx[h], v); }
            }
        }
        float lsum[4];
#pragma unroll
        for (int h = 0; h < 4; ++h) { mx[h] = wave_max(mx[h]); lsum[h] = 0.f; }
        for (int r = 0; r * 64 < nsel; ++r) {
            const int i = r * 64 + lane;
            if (i < nsel) {
#pragma unroll
                for (int h = 0; h < 4; ++h) { const float pv = __expf(pl[h * 256 + i] - mx[h]); lsum[h] += pv; pl[h * 256 + i] = pv; }
            }
        }
#pragma unroll
        for (int h = 0; h < 4; ++h) lsum[h] = wave_sum(lsum[h]);
        float acc[4] = {0.f, 0.f, 0.f, 0.f};
        for (int i = 0; i < nsel; ++i) {
            const int s = list[i];
            const float vv = bf2f(P[((size_t)b * SEQ + s) * LDP + PC_DV + lane]);
#pragma unroll
            for (int h = 0; h < 4; ++h) acc[h] += pl[h * 256 + i] * vv;
        }
#pragma unroll
        for (int h = 0; h < 4; ++h) Y[tok * DM + 768 + h * 64 + lane] = f2bf(acc[h] / lsum[h]);
    }
}

__device__ __forceinline__ void ph_knorm(const Ctx& p, int l) {
    float* Km = (float*)(pws_() + WS_KM) + (size_t)l * MMEM * 256;
    const float* kg = pin_(28) + (size_t)l * 64;
    const int lane = tid_() & 63;
    for (int r = gwave(); r < MMEM; r += nwaves()) {
#pragma unroll
        for (int h = 0; h < 4; ++h) {
            const float v = Km[(size_t)r * 256 + h * 64 + lane];
            const float ss = wave_sum(v * v);
            Km[(size_t)r * 256 + h * 64 + lane] = v * rsqrtf(ss * (1.f / 64.f) + EPS) * kg[lane];
        }
    }
}
__device__ __forceinline__ void ph_xattn(const Ctx& p, int l, float* smem) {
    const float* Qx = (const float*)(pws_() + WS_QX);
    bf16_t* Ox = (bf16_t*)(pws_() + WS_OX);
    const float* Km = (const float*)(pws_() + WS_KM) + (size_t)l * MMEM * 256;
    const float* Vm = (const float*)(pws_() + WS_VM) + (size_t)l * MMEM * 256;
    const float* qg = pin_(27) + (size_t)l * 64;
    const int tid = tid_(), lane = tid & 63, wave = tid >> 6;
    float* qs = smem + wave * 1280;
    float* pl = qs + 256;
    for (int tok = gwave(); tok < MTOK; tok += nwaves()) {
        const int b = tok / SEQ;
#pragma unroll
        for (int h = 0; h < 4; ++h) {
            const float v = Qx[(size_t)tok * 256 + h * 64 + lane];
            const float ss = wave_sum(v * v);
            qs[h * 64 + lane] = v * rsqrtf(ss * (1.f / 64.f) + EPS) * qg[lane];
        }
        float lg[4][4]; float mx[4] = {-3.0e38f, -3.0e38f, -3.0e38f, -3.0e38f};
#pragma unroll
        for (int r = 0; r < 4; ++r) {
            const int j = r * 64 + lane;
            const float4* kr = (const float4*)(Km + ((size_t)b * NMEM + j) * 256);
#pragma unroll
            for (int h = 0; h < 4; ++h) {
                float d = 0.f;
#pragma unroll 4
                for (int q = 0; q < 16; ++q) { const float4 kv = kr[h * 16 + q]; const float4 q4 = *(const float4*)(qs + h * 64 + q * 4); d += q4.x * kv.x + q4.y * kv.y + q4.z * kv.z + q4.w * kv.w; }
                lg[r][h] = d * 0.125f; mx[h] = fmaxf(mx[h], lg[r][h]);
                asm volatile("" : "+v"(d));
            }
        }
        float lsum[4];
#pragma unroll
        for (int h = 0; h < 4; ++h) { mx[h] = wave_max(mx[h]); lsum[h] = 0.f; }
#pragma unroll
        for (int r = 0; r < 4; ++r)
#pragma unroll
            for (int h = 0; h < 4; ++h) { const float pv = __expf(lg[r][h] - mx[h]); lsum[h] += pv; pl[h * 256 + r * 64 + lane] = pv; }
#pragma unroll
        for (int h = 0; h < 4; ++h) lsum[h] = wave_sum(lsum[h]);
        float acc[4] = {0.f, 0.f, 0.f, 0.f};
        for (int j = 0; j < NMEM; ++j) {
            const float* vr = Vm + ((size_t)b * NMEM + j) * 256;
#pragma unroll
            for (int h = 0; h < 4; ++h) acc[h] += pl[h * 256 + j] * vr[h * 64 + lane];
        }
#pragma unroll
        for (int h = 0; h < 4; ++h) Ox[(size_t)tok * 256 + h * 64 + lane] = f2bf(acc[h] / lsum[h]);
    }
}

__device__ __forceinline__ void ph_peer(const Ctx& p, int l, float* smem) {
    const float* Qp = (const float*)(pws_() + WS_QP);
    const bf16_t* H = (const bf16_t*)(pws_() + WS_H);
    const float* sk = pin_(31) + (size_t)l * 8 * 2 * 128 * 64;
    const float* ut = pin_(32) + (size_t)l * NEXP * DM;
    const float* vt = pin_(33) + (size_t)l * NEXP * DM;
    float* x = pout_();
    const int tid = tid_(), lane = tid & 63, wave = tid >> 6;
    float* qs = smem + wave * 1024;
    for (int tok = gwave(); tok < MTOK; tok += nwaves()) {
#pragma unroll
        for (int i = 0; i < 4; ++i) *(float4*)(qs + (lane + 64 * i) * 4) = *(const float4*)(Qp + (size_t)tok * DM + (lane + 64 * i) * 4);
        float hreg[16];
#pragma unroll
        for (int i = 0; i < 4; ++i) { const ushort4 hv = *(const ushort4*)(H + (size_t)tok * DM + (lane + 64 * i) * 4); hreg[4 * i] = bf2f(hv.x); hreg[4 * i + 1] = bf2f(hv.y); hreg[4 * i + 2] = bf2f(hv.z); hreg[4 * i + 3] = bf2f(hv.w); }
        float out[16];
#pragma unroll
        for (int i = 0; i < 16; ++i) out[i] = 0.f;
#pragma unroll 1
        for (int h = 0; h < 8; ++h) {
            float ts[2]; int ti[2];
#pragma unroll
            for (int pp = 0; pp < 2; ++pp) {
                const float* qv = qs + h * 128 + pp * 64;
                unsigned long long k0, k1;
                {
                    const float4* r0 = (const float4*)(sk + ((size_t)(h * 2 + pp) * 128 + lane) * 64);
                    const float4* r1 = (const float4*)(sk + ((size_t)(h * 2 + pp) * 128 + lane + 64) * 64);
                    float d0 = 0.f, d1 = 0.f;
#pragma unroll
                    for (int q = 0; q < 16; ++q) { const float4 q4 = *(const float4*)(qv + q * 4); const float4 a = r0[q], c = r1[q]; d0 += q4.x * a.x + q4.y * a.y + q4.z * a.z + q4.w * a.w; d1 += q4.x * c.x + q4.y * c.y + q4.z * c.z + q4.w * c.w; }
                    k0 = ((unsigned long long)ford(d0) << 32) | (unsigned)(127 - lane);
                    k1 = ((unsigned long long)ford(d1) << 32) | (unsigned)(127 - (lane + 64));
                }
                float mys = 0.f; int myi = 0;
#pragma unroll 1
                for (int it = 0; it < 16; ++it) {
                    const unsigned long long m = wave_max_u64(k0 > k1 ? k0 : k1);
                    if (lane == it) { mys = funord((unsigned)(m >> 32)); myi = 127 - (int)(m & 0xffffffffu); }
                    if (k0 == m) k0 = 0ull;
                    if (k1 == m) k1 = 0ull;
                }
                ts[pp] = mys; ti[pp] = myi;
            }
            unsigned long long ck[4];
#pragma unroll
            for (int c = 0; c < 4; ++c) {
                const int f = lane * 4 + c, a = f >> 4, bq = f & 15;
                const float s = __shfl(ts[0], a, 64) + __shfl(ts[1], bq, 64);
                ck[c] = ((unsigned long long)ford(s) << 32) | (unsigned)(255 - f);
            }
            float top = -3.0e38f; int eidx = 0;
#pragma unroll 1
            for (int it = 0; it < 16; ++it) {
                unsigned long long m = ck[0] > ck[1] ? ck[0] : ck[1]; const unsigned long long m2 = ck[2] > ck[3] ? ck[2] : ck[3]; m = m > m2 ? m : m2;
                m = wave_max_u64(m);
                const int f = 255 - (int)(m & 0xffffffffu), a = f >> 4, bq = f & 15;
                const int e = __shfl(ti[0], a, 64) * 128 + __shfl(ti[1], bq, 64);
                if (lane == it) { top = funord((unsigned)(m >> 32)); eidx = e; }
#pragma unroll
                for (int c = 0; c < 4; ++c) if (ck[c] == m) ck[c] = 0ull;
            }
            const float mxv = __shfl(top, 0, 64);
            float ev = lane < 16 ? __expf(top - mxv) : 0.f;
            const float den = wave_sum(ev);
            const float gate = ev / den;
#pragma unroll 2
            for (int k = 0; k < 16; ++k) {
                const int e = __shfl(eidx, k, 64); const float g = __shfl(gate, k, 64);
                const float4* ur = (const float4*)(ut + (size_t)e * DM);
                float d = 0.f;
#pragma unroll
                for (int i = 0; i < 4; ++i) { const float4 u4 = ur[lane + 64 * i]; d += u4.x * hreg[4 * i] + u4.y * hreg[4 * i + 1] + u4.z * hreg[4 * i + 2] + u4.w * hreg[4 * i + 3]; }
                d = wave_sum(d);
                const float coef = g * gelu_tanh_f(d);
                const float4* vr = (const float4*)(vt + (size_t)e * DM);
#pragma unroll
                for (int i = 0; i < 4; ++i) { const float4 v4 = vr[lane + 64 * i]; out[4 * i] += coef * v4.x; out[4 * i + 1] += coef * v4.y; out[4 * i + 2] += coef * v4.z; out[4 * i + 3] += coef * v4.w; }
            }
        }
#pragma unroll
        for (int i = 0; i < 4; ++i) {
            float4* xp = (float4*)(x + (size_t)tok * DM + (lane + 64 * i) * 4);
            float4 xv = *xp; xv.x += out[4 * i]; xv.y += out[4 * i + 1]; xv.z += out[4 * i + 2]; xv.w += out[4 * i + 3]; *xp = xv;
        }
    }
}


__global__ void __launch_bounds__(512, 2) k_mega(Params kp) {
    float* sm = dynsmem;
    {
        unsigned long long* tab = (unsigned long long*)((char*)dynsmem + PTAB_OFF);
        if (threadIdx.x < 34) tab[threadIdx.x] = (unsigned long long)kp.in[threadIdx.x];
        if (threadIdx.x == 34) tab[34] = (unsigned long long)kp.out;
        if (threadIdx.x == 35) tab[35] = (unsigned long long)kp.ws;
        if (threadIdx.x == 36) { tab[36] = 0ull; tab[37] = 0ull; }
    }
    __syncthreads();
    Ctx p; p.dummy = 0;
    XcdBarrier bar = xcd_barrier_post((unsigned*)(pws_() + WS_BAR), (volatile LAS unsigned*)((char*)dynsmem + PTAB_OFF + 36 * 8));
    ph_permute_win(p);
#pragma unroll 1
    for (int l = 0; l < DEPTH; ++l) ph_rmsnorm(pin_(1), pin_(22) + (size_t)l * DM, (bf16_t*)(pws_() + WS_HM) + (size_t)l * MMEM * DM, MMEM);
    xcd_barrier(bar);
#pragma unroll 1
    for (int l = 0; l < DEPTH; ++l) {
        const float* xin = l == 0 ? pin_(0) : pout_();
        const bf16_t* H = (const bf16_t*)(pws_() + WS_H);
        ph_rmsnorm(xin, pin_(2) + (size_t)l * DM, (bf16_t*)(pws_() + WS_H), MTOK);
        xcd_barrier(bar);
        ph_sgemm<0>(H, DM, (const float*)(pws_() + WS_WP) + (size_t)l * DM * LDP, LDP, pws_() + WS_P, LDP, nullptr, 0, MTOK, LDP, DM, sm);
        ph_sgemm<1>((const bf16_t*)(pws_() + WS_HM) + (size_t)l * MMEM * DM, DM, pin_(24) + (size_t)l * DM * 256, 256, (float*)(pws_() + WS_KM) + (size_t)l * MMEM * 256, 256, nullptr, 0, MMEM, 256, DM, sm);
        ph_sgemm<1>((const bf16_t*)(pws_() + WS_HM) + (size_t)l * MMEM * DM, DM, pin_(25) + (size_t)l * DM * 256, 256, (float*)(pws_() + WS_VM) + (size_t)l * MMEM * 256, 256, nullptr, 0, MMEM, 256, DM, sm);
        xcd_barrier(bar);
        ph_knorm(p, l);
        ph_dsa_prep(p, l);
        ph_ssd_scan(p, l, sm);
        ph_gdn_scan(p, l, sm);
        ph_gla_scan(p, l, sm);
        xcd_barrier(bar);
        ph_ssd_finish(p, l);
        ph_dsa_main(p, l, sm);
        xcd_barrier(bar);
        ph_sgemm<2>((const bf16_t*)(pws_() + WS_Y), DM, pin_(20) + (size_t)l * DM * DM, DM, pout_(), DM, xin, DM, MTOK, DM, DM, sm);
        xcd_barrier(bar);
        ph_rmsnorm(pout_(), pin_(21) + (size_t)l * DM, (bf16_t*)(pws_() + WS_H), MTOK);
        xcd_barrier(bar);
        ph_sgemm<1>(H, DM, pin_(23) + (size_t)l * DM * 256, 256, pws_() + WS_QX, 256, nullptr, 0, MTOK, 256, DM, sm);
        xcd_barrier(bar);
        ph_xattn(p, l, sm);
        xcd_barrier(bar);
        ph_sgemm<2>((const bf16_t*)(pws_() + WS_OX), 256, pin_(26) + (size_t)l * 256 * DM, DM, pout_(), DM, pout_(), DM, MTOK, DM, 256, sm);
        xcd_barrier(bar);
        ph_rmsnorm(pout_(), pin_(29) + (size_t)l * DM, (bf16_t*)(pws_() + WS_H), MTOK);
        xcd_barrier(bar);
        ph_sgemm<1>(H, DM, pin_(30) + (size_t)l * DM * DM, DM, pws_() + WS_QP, DM, nullptr, 0, MTOK, DM, DM, sm);
        xcd_barrier(bar);
        ph_peer(p, l, sm);
        xcd_barrier(bar);
    }
}

extern "C" void kernel_launch(void* const* d_in, const int* in_sizes, int n_in, void* d_out, int out_size, void* d_ws, size_t ws_size, hipStream_t stream) {
    if (n_in != 34 || out_size != MTOK * DM || ws_size < WS_END) {
        fprintf(stderr, "kernel_launch: unexpected shapes (n_in %d out %d ws %zu need %zu)\n", n_in, out_size, ws_size, (size_t)WS_END);
        return;
    }
    static int grid = 0;
    if (!grid) {
        int dev = 0, cus = 0, per_cu = 0;
        (void)hipGetDevice(&dev);
        (void)hipDeviceGetAttribute(&cus, hipDeviceAttributeMultiprocessorCount, dev);
        (void)hipFuncSetAttribute((const void*)k_mega, hipFuncAttributeMaxDynamicSharedMemorySize, LDS_BYTES);
        (void)hipOccupancyMaxActiveBlocksPerMultiprocessor(&per_cu, (const void*)k_mega, 512, LDS_BYTES);
        if (per_cu < 1) fprintf(stderr, "kernel_launch: occupancy query reports %d blocks per CU\n", per_cu);
        grid = cus > 0 ? cus : 256;
    }
    Params p; memset(&p, 0, sizeof(p));
    for (int i = 0; i < 34; ++i) p.in[i] = (const float*)d_in[i];
    p.out = (float*)d_out; p.ws = (char*)d_ws;
    (void)hipMemsetAsync((char*)d_ws + WS_BAR, 0, XCD_BAR_WORDS * sizeof(unsigned), stream);
    hipLaunchKernelGGL(k_mega, dim3(grid), dim3(512), LDS_BYTES, stream, p);
}
```

```cpp
#include <hip/hip_runtime.h>
#include <stdint.h>
#include <stdio.h>
#include <string.h>

#define NB 32
#define SEQ 2048
#define DM 1024
#define MTOK (NB * SEQ)
#define DEPTH 4
#define NMEM 256
#define MMEM (NB * NMEM)
#define LDP 3328
#define NEXP 16384
#define EPS 1e-6f
#define PC_Z 0
#define PC_XBC 256
#define PC_GQKV 768
#define PC_GG 1536
#define PC_LQ 1792
#define PC_LK 1920
#define PC_LV 2048
#define PC_LR 2304
#define PC_DQ 2560
#define PC_DK 2816
#define PC_DV 2880
#define PC_IQ 2944
#define PC_IK 3200
#define PC_GLR 3232
#define PC_IW 3248
#define PC_DT 3256
#define PC_GA 3260
#define PC_GB 3264

typedef unsigned short bf16_t;

#define WS_BAR 0ull
#define WS_P 16384ull
#define SZ_P ((size_t)MTOK * LDP * 2)
#define WS_H (WS_P + SZ_P)
#define SZ_H ((size_t)MTOK * DM * 2)
#define WS_Y (WS_H + SZ_H)
#define SZ_Y ((size_t)MTOK * DM * 2)
#define WS_WP (WS_Y + SZ_Y)
#define SZ_WP ((size_t)DEPTH * DM * LDP * 4)
#define WT_IN (WS_WP)
#define WT_OUT (WT_IN + (size_t)DEPTH * LDP * DM * 2)
#define WT_XQ (WT_OUT + (size_t)DEPTH * DM * DM * 2)
#define WT_XK (WT_XQ + (size_t)DEPTH * 256 * DM * 2)
#define WT_XV (WT_XK + (size_t)DEPTH * 256 * DM * 2)
#define WT_XO (WT_XV + (size_t)DEPTH * 256 * DM * 2)
#define WT_PQ (WT_XO + (size_t)DEPTH * DM * 256 * 2)
#define WT_END (WT_PQ + (size_t)DEPTH * DM * DM * 2)
#define WS_QN (WS_WP + SZ_WP)
#define SZ_QN ((size_t)MTOK * 256 * 4)
#define WS_KN (WS_QN + SZ_QN)
#define SZ_KN ((size_t)MTOK * 64 * 4)
#define WS_IKN (WS_KN + SZ_KN)
#define SZ_IKN ((size_t)MTOK * 32 * 4)
#define WS_YPRE (WS_IKN + SZ_IKN)
#define SZ_YPRE ((size_t)MTOK * 256 * 4)
#define WS_HM (WS_YPRE + SZ_YPRE)
#define SZ_HM ((size_t)MMEM * DM * 2)
#define WS_KM (WS_HM + SZ_HM)
#define SZ_KM ((size_t)MMEM * 256 * 4)
#define WS_VM (WS_KM + SZ_KM)
#define SZ_VM ((size_t)MMEM * 256 * 4)
#define WS_KB (WS_VM + SZ_VM)
#define SZ_KB ((size_t)MMEM * 256 * 2)
#define WS_VTB (WS_KB + SZ_KB)
#define SZ_VTB ((size_t)MMEM * 256 * 2)
#define WS_VT (WS_VTB + SZ_VTB)
#define SZ_VT ((size_t)MTOK * 64 * 2)
#define WS_END (WS_VT + SZ_VT)
#define WS_QX (WS_P)
#define WS_OX (WS_P + (size_t)MTOK * 256 * 4)
#define WS_QP (WS_P)
#define WS_UT16 (WS_P + 260ull * 1024 * 1024)
#define WS_VT16 (WS_UT16 + (size_t)NEXP * DM * 2)
#define WS_PEI (WS_VT16 + (size_t)NEXP * DM * 2)
#define WS_PEG (WS_PEI + (size_t)MTOK * 128 * 4)
#define WS_PEND (WS_PEG + (size_t)MTOK * 128 * 4)
static_assert(WS_PEND <= WS_P + SZ_P, "P region aliases");

struct Params {
    const float* in[34];
    float* out;
    char* ws;
};

#define XB_TMO      128
#define XB_XCNT(j)  (256  + 64 * (j))
#define XB_XSUB(j)  (1280 + 64 * (j))
#define XB_XGEN(j)  (2304 + 64 * (j))
#define XB_TOP      3328
#define XB_TOPGEN   3392
#define XCD_BAR_WORDS 3456
#define XB_SPIN_CAP (1u << 18)
#define LAS __attribute__((address_space(3)))

__device__ __forceinline__ unsigned xb_ld(unsigned* p)              { return __hip_atomic_load(p, __ATOMIC_RELAXED, __HIP_MEMORY_SCOPE_AGENT); }
__device__ __forceinline__ unsigned xb_add(unsigned* p, unsigned v) { return __hip_atomic_fetch_add(p, v, __ATOMIC_RELAXED, __HIP_MEMORY_SCOPE_AGENT); }
__device__ __forceinline__ unsigned xb_xcc_id() { return (unsigned)__builtin_amdgcn_s_getreg((3 << 11) | 20) & 0xFu; }
#define XB_SPIN(cond, bar) do { unsigned _sp = 0; while (cond) { __builtin_amdgcn_s_sleep(1); \
    if ((++_sp & 255u) == 0u) { if (xb_ld(&(bar)[XB_TMO])) break; if (_sp > XB_SPIN_CAP) { atomicAdd(&(bar)[XB_TMO], 1u); break; } } } } while (0)

struct XcdBarrier {
    unsigned* bar; unsigned x;
    volatile LAS unsigned* st;
};

__device__ __forceinline__ XcdBarrier xcd_barrier_post(unsigned* bar, volatile LAS unsigned* st) {
    XcdBarrier b; b.bar = bar; b.x = xb_xcc_id(); b.st = st;
    if (threadIdx.x == 0) (void)xb_add(&bar[XB_XCNT(b.x)], 1u);
    return b;
}
__device__ __forceinline__ void xcd_barrier_complete(unsigned* bar, unsigned x, unsigned& nloc, unsigned& nx) {
    const unsigned G = gridDim.x * gridDim.y * gridDim.z;
    unsigned sum, cnt, mine, sp = 0u;
    for (;;) {
        sum = 0u; cnt = 0u; mine = 0u;
#pragma unroll
        for (unsigned j = 0; j < 16; ++j) { const unsigned c = xb_ld(&bar[XB_XCNT(j)]); sum += c; cnt += (c > 0u) ? 1u : 0u; mine = (j == x) ? c : mine; }
        if (sum == G) break;
        __builtin_amdgcn_s_sleep(1);
        if ((++sp & 255u) == 0u) { if (xb_ld(&bar[XB_TMO])) break; if (sp > XB_SPIN_CAP) { atomicAdd(&bar[XB_TMO], 1u); break; } }
    }
    nloc = mine > 0u ? mine : 1u; nx = cnt > 0u ? cnt : 1u;
}

__device__ __forceinline__ void xcd_barrier(const XcdBarrier& b) {
    asm volatile("s_waitcnt vmcnt(0)" ::: "memory");
    __syncthreads();
    if (threadIdx.x == 0) {
        unsigned* bar = b.bar;
        __builtin_amdgcn_s_waitcnt(0);
        unsigned nloc = b.st[0], nx = b.st[1];
        if (nloc == 0u) { xcd_barrier_complete(bar, b.x, nloc, nx); b.st[0] = nloc; b.st[1] = nx; }
        const unsigned old = xb_add(&bar[XB_XSUB(b.x)], 1u);
        const unsigned gen = old / nloc;
        if (old + 1u == (gen + 1u) * nloc) {
            __builtin_amdgcn_fence(__ATOMIC_RELEASE, "agent");
            asm volatile("s_waitcnt vmcnt(0)" ::: "memory");
            const unsigned og = xb_add(&bar[XB_TOP], 1u);
            const unsigned tg = og / nx;
            if (og + 1u == (tg + 1u) * nx) xb_add(&bar[XB_TOPGEN], 1u);
            else XB_SPIN(xb_ld(&bar[XB_TOPGEN]) == tg, bar);
            __builtin_amdgcn_fence(__ATOMIC_ACQUIRE, "agent");
            xb_add(&bar[XB_XGEN(b.x)], 1u);
            asm volatile("s_waitcnt vmcnt(0)" ::: "memory");
        } else {
            XB_SPIN(xb_ld(&bar[XB_XGEN(b.x)]) == gen, bar);
            __builtin_amdgcn_fence(__ATOMIC_ACQUIRE, "agent");
            asm volatile("s_waitcnt vmcnt(0)" ::: "memory");
        }
    }
    __syncthreads();
}


#define LDS_BYTES (144 * 1024)
#define PTAB_OFF (LDS_BYTES - 1024)
extern __shared__ __attribute__((aligned(16))) float dynsmem[];
__device__ __forceinline__ unsigned long long ptab_get(int i) {
    unsigned off = PTAB_OFF; asm volatile("" : "+v"(off));
    const uint2 v = *(const uint2*)((const char*)dynsmem + off + i * 8);
    const unsigned lo = __builtin_amdgcn_readfirstlane(v.x), hi = __builtin_amdgcn_readfirstlane(v.y);
    return ((unsigned long long)hi << 32) | lo;
}
__device__ __forceinline__ const float* pin_(int i) { return (const float*)ptab_get(i); }
__device__ __forceinline__ float* pout_() { return (float*)ptab_get(34); }
__device__ __forceinline__ char* pws_() { return (char*)ptab_get(35); }
struct Ctx { int dummy; };

__device__ __forceinline__ float bf2f(bf16_t v) { return __uint_as_float(((unsigned)v) << 16); }
__device__ __forceinline__ bf16_t f2bf(float f) { unsigned u = __float_as_uint(f); u += 0x7FFFu + ((u >> 16) & 1u); return (bf16_t)(u >> 16); }
__device__ __forceinline__ float wave_sum(float v) {
#pragma unroll
    for (int o = 32; o >= 1; o >>= 1) v += __shfl_xor(v, o, 64);
    return v;
}
__device__ __forceinline__ float wave_max(float v) {
#pragma unroll
    for (int o = 32; o >= 1; o >>= 1) v = fmaxf(v, __shfl_xor(v, o, 64));
    return v;
}
__device__ __forceinline__ float silu_f(float x) { return x / (1.f + __expf(-x)); }
__device__ __forceinline__ float sigmoid_f(float x) { return 1.f / (1.f + __expf(-x)); }
__device__ __forceinline__ float softplus_f(float x) { return x > 20.f ? x : log1pf(__expf(x)); }
__device__ __forceinline__ float logsigmoid_f(float x) { return -softplus_f(-x); }
__device__ __forceinline__ float gelu_tanh_f(float x) { const float u = 0.7978845608028654f * (x + 0.044715f * x * x * x); return 0.5f * x * (1.f + tanhf(u)); }
__device__ __forceinline__ unsigned ford(float f) { f = f + 0.0f; unsigned u = __float_as_uint(f); return (u & 0x80000000u) ? ~u : (u | 0x80000000u); }
__device__ __forceinline__ float funord(unsigned k) { unsigned u = (k & 0x80000000u) ? (k & 0x7fffffffu) : ~k; return __uint_as_float(u); }
__device__ __forceinline__ unsigned long long wave_max_u64(unsigned long long v) {
#pragma unroll
    for (int o = 32; o >= 1; o >>= 1) {
        unsigned lo = __shfl_xor((unsigned)v, o, 64), hi = __shfl_xor((unsigned)(v >> 32), o, 64);
        unsigned long long w = ((unsigned long long)hi << 32) | lo;
        v = w > v ? w : v;
    }
    return v;
}
__device__ __forceinline__ int tid_() { int t = threadIdx.x; asm volatile("" : "+v"(t)); return t; }
__device__ __forceinline__ int bid_() { int b = blockIdx.x; asm volatile("" : "+s"(b)); return b; }
__device__ __forceinline__ int nblk_() { int g = gridDim.x; asm volatile("" : "+s"(g)); return g; }
__device__ __forceinline__ int gwave() { return (bid_() * 512 + tid_()) >> 6; }
__device__ __forceinline__ int nwaves() { return nblk_() * 8; }

namespace pg8 {
#define PG8_LAS __attribute__((address_space(3)))
typedef unsigned short bf16_t;
typedef short bf16x8 __attribute__((ext_vector_type(8)));
typedef float f32x4 __attribute__((ext_vector_type(4)));
typedef unsigned u32x4 __attribute__((ext_vector_type(4)));
constexpr int BM = 256, BK = 64, HALF = 128, HTB = HALF * BK * 2  , STAGE_BYTES = 8 * HTB, NXCD = 8, WGM = 8;

__host__ __device__ __forceinline__ int lds_byte(int r, int c) { const int st = (r >> 4) * 2 + (c >> 5), rr = r & 15, cc = c & 31, ob = rr * 64 + cc * 2; return st * 1024 + (ob ^ (((ob >> 9) & 1) << 5)); }
__host__ __device__ __forceinline__ void stage_rc(int b, int& R, int& C) { const int st = b / 1024, sb = b % 1024, swz = sb ^ (((sb >> 9) & 1) << 5); R = (st >> 1) * 16 + swz / 64; C = (st & 1) * 32 + (swz % 64) / 2; }
__host__ __device__ __forceinline__ int perm32(int rho) { const int n = rho >> 4, i = rho & 15; return 8 * (i >> 2) + 4 * n + (i & 3); }

struct Unit { int pm, pn; };
struct Gemm { const bf16_t* A; const bf16_t* Bt; int M, N, K; };

struct StaticOrder {
    int nM, nN, nwg, G, c;
    __host__ __device__ void init(int M, int N, int G_, int c_) { nM = M / BM; nN = N / BM; nwg = nM * nN; G = G_; c = c_; }
    __host__ __device__ bool next(int i, Unit& u) const {
        const long L = (long)i * G + c; if (L >= nwg) return false;
        int wgid = (int)L; { const int q = nwg / NXCD, r = nwg % NXCD, xcd = wgid % NXCD, off = wgid / NXCD; wgid = (xcd < r ? xcd * (q + 1) : r * (q + 1) + (xcd - r) * q) + off; }
        const int nig = WGM * nN, gid = wgid / nig, fm = gid * WGM, gsz = (nM - fm) < WGM ? (nM - fm) : WGM;
        u.pm = fm + ((wgid % nig) % gsz); u.pn = (wgid % nig) / gsz; return true;
    }
    __device__ __forceinline__ void a_ready(const Unit&) const {}
    __device__ __forceinline__ void done(const Unit&) const {}
};

__device__ __forceinline__ unsigned cvt_pk_bf16(float lo, float hi) { unsigned r; asm volatile("v_cvt_pk_bf16_f32 %0, %1, %2" : "=v"(r) : "v"(lo), "v"(hi)); return r; }
struct EpiF32 {
    static constexpr bool PERM = false, AFTER_DRAIN = false;
    float* C; const float* R; int ldc;
    __device__ __forceinline__ void operator()(const f32x4 (&acc)[2][2][4][2], const Unit& u, int wr, int wc, int fr, int fq) const {
        const int row0 = u.pm * BM + wr * 64 + fr, col0 = u.pn * BM + wc * 32 + 4 * fq;
#pragma unroll
        for (int ai = 0; ai < 2; ++ai)
#pragma unroll
            for (int m = 0; m < 4; ++m) { const size_t off = (size_t)(row0 + ai * HALF + m * 16) * ldc + col0;
#pragma unroll
                for (int bj = 0; bj < 2; ++bj)
#pragma unroll
                    for (int n = 0; n < 2; ++n) { f32x4 v = acc[ai][bj][m][n]; if (R) v += *(const f32x4*)(R + off + bj * HALF + n * 16); *(f32x4*)(C + off + bj * HALF + n * 16) = v; } }
    }
};
struct EpiBf16 {
    static constexpr bool PERM = true, AFTER_DRAIN = false;
    bf16_t* O; int ldc;
    __device__ __forceinline__ void operator()(const f32x4 (&acc)[2][2][4][2], const Unit& u, int wr, int wc, int fr, int fq) const {
        const int row0 = u.pm * BM + wr * 64 + fr, col0 = u.pn * BM + wc * 32 + 8 * fq;
#pragma unroll
        for (int ai = 0; ai < 2; ++ai)
#pragma unroll
            for (int m = 0; m < 4; ++m) { bf16_t* rowp = O + (size_t)(row0 + ai * HALF + m * 16) * ldc + col0;
#pragma unroll
                for (int bj = 0; bj < 2; ++bj) { const f32x4 v0 = acc[ai][bj][m][0], v1 = acc[ai][bj][m][1];
                    u32x4 w; w.x = cvt_pk_bf16(v0[0], v0[1]); w.y = cvt_pk_bf16(v0[2], v0[3]); w.z = cvt_pk_bf16(v1[0], v1[1]); w.w = cvt_pk_bf16(v1[2], v1[3]);
                    *(u32x4*)(rowp + bj * HALF) = w; } }
    }
};

template <class Epi, class Sched, bool STAMP = false>
__device__ __forceinline__ void gemm_phase(PG8_LAS unsigned char* lds, const Gemm g, const Sched& S, const Epi& E, unsigned long long* stamps, const int tid) {
    const int wid = __builtin_amdgcn_readfirstlane(tid >> 6), lane = tid & 63, wr = wid >> 2, wc = wid & 3, fr = lane & 15, fq = lane >> 4;
    const int K = g.K, nt = K / BK;
    int ts_lo = 0, ts_hi = 0, nts = 0; const unsigned long long rt_entry = STAMP ? (unsigned long long)wall_clock64() : 0ull;
#define PG8_STAMP() do { if (STAMP && wid == 0 && nts < 64) { const unsigned long long _c = (unsigned long long)clock64(); \
        ts_lo = (lane == nts) ? (int)(unsigned)_c : ts_lo; ts_hi = (lane == nts) ? (int)(unsigned)(_c >> 32) : ts_hi; ++nts; } } while (0)
    PG8_STAMP();
    unsigned voffA[2], voffB[2];
#pragma unroll
    for (int i = 0; i < 2; ++i) { int R, C; stage_rc(tid * 16 + i * 8192, R, C); const int Rb = Epi::PERM ? ((R & ~31) + perm32(R & 31)) : R;
        voffA[i] = (unsigned)(R * K + C) * 2u; voffB[i] = (unsigned)(Rb * K + C) * 2u; }
    const size_t kstep = (size_t)(BK * 2);
    const size_t hstep = (size_t)HALF * K * 2;
    const size_t tstep = 2 * hstep;
    const unsigned ldsw = (unsigned)wid * 1024u;
    const int aoff = lds_byte(wr * 64 + fr, fq * 8), boff = lds_byte(wc * 32 + fr, fq * 8);
#define PG8_SA(b, h) (((b) * 2 + (h)) * HTB)
#define PG8_SB(b, h) ((4 + (b) * 2 + (h)) * HTB)
#define PG8_STAGE(bufoff, gbase, voff) do { _Pragma("unroll") for (int _i = 0; _i < 2; ++_i) \
        __builtin_amdgcn_global_load_lds((const unsigned*)((const char*)(gbase) + (voff)[_i]), (PG8_LAS unsigned*)(lds + (bufoff) + ldsw + _i * 8192), 16, 0, 0); } while (0)
#define PG8_LDA(dst, b, h) do { _Pragma("unroll") for (int m = 0; m < 4; ++m) _Pragma("unroll") for (int k = 0; k < 2; ++k) dst[m][k] = *(const PG8_LAS bf16x8*)(lds + PG8_SA(b, h) + aoff + m * 2048 + k * 1024); } while (0)
#define PG8_LDB(dst, b, h) do { _Pragma("unroll") for (int n = 0; n < 2; ++n) _Pragma("unroll") for (int k = 0; k < 2; ++k) dst[n][k] = *(const PG8_LAS bf16x8*)(lds + PG8_SB(b, h) + boff + n * 2048 + k * 1024); } while (0)
#define PG8_MMA(ai, bj, At, Bt) do { __builtin_amdgcn_s_setprio(1); _Pragma("unroll") for (int m = 0; m < 4; ++m) _Pragma("unroll") for (int n = 0; n < 2; ++n) _Pragma("unroll") for (int k = 0; k < 2; ++k) \
        acc[ai][bj][m][n] = __builtin_amdgcn_mfma_f32_16x16x32_bf16(Bt[n][k], At[m][k], acc[ai][bj][m][n], 0, 0, 0); __builtin_amdgcn_s_setprio(0); } while (0)
#define PG8_WAIT_V(n) asm volatile("s_waitcnt vmcnt(" #n ")" ::: "memory")
#define PG8_WAIT_L(n) asm volatile("s_waitcnt lgkmcnt(" #n ")" ::: "memory")
#define PG8_BAR __builtin_amdgcn_s_barrier()
#define PG8_SCHED __builtin_amdgcn_sched_barrier(0)
    Unit cur, nxt; int ui = 0;
    if (!S.next(0, cur)) return;
    f32x4 acc[2][2][4][2];
#pragma unroll
    for (int a = 0; a < 2; ++a)
#pragma unroll
        for (int b = 0; b < 2; ++b)
#pragma unroll
            for (int m = 0; m < 4; ++m)
#pragma unroll
                for (int n = 0; n < 2; ++n) acc[a][b][m][n] = (f32x4){0.f, 0.f, 0.f, 0.f};
    bf16x8 At[4][2], B0[2][2], B1[2][2];
    const char* cA = (const char*)g.A + (size_t)cur.pm * tstep; const char* cB = (const char*)g.Bt + (size_t)cur.pn * tstep;
    S.a_ready(cur);
    PG8_STAGE(PG8_SB(0, 0), cB, voffB); PG8_STAGE(PG8_SA(0, 0), cA, voffA); PG8_STAGE(PG8_SB(0, 1), cB + hstep, voffB); PG8_STAGE(PG8_SA(0, 1), cA + hstep, voffA);
    if (wr == 1) PG8_BAR;
    PG8_WAIT_V(4); PG8_BAR;
    PG8_STAGE(PG8_SB(1, 0), cB + kstep, voffB); PG8_STAGE(PG8_SA(1, 0), cA + kstep, voffA); PG8_STAGE(PG8_SB(1, 1), cB + hstep + kstep, voffB);
    PG8_WAIT_V(6); PG8_BAR;
    PG8_STAMP();
    for (;;) {
        const bool has_next = S.next(ui + 1, nxt);
        const char* nA = has_next ? (const char*)g.A + (size_t)nxt.pm * tstep : cA; const char* nB = has_next ? (const char*)g.Bt + (size_t)nxt.pn * tstep : cB;
        for (int t = 0; t < nt; t += 2) {
            const bool last = (t == nt - 2);
            const char* a1 = cA + (size_t)(t + 1) * kstep;
            const char* a2 = last ? nA : cA + (size_t)(t + 2) * kstep; const char* b2 = last ? nB : cB + (size_t)(t + 2) * kstep;
            const char* a3 = a2 + kstep; const char* b3 = b2 + kstep;
            if (last && has_next) S.a_ready(nxt);
            PG8_LDB(B0, 0, 0); PG8_SCHED; PG8_LDA(At, 0, 0); PG8_STAGE(PG8_SA(1, 1), a1 + hstep, voffA);
            PG8_WAIT_L(8); PG8_BAR; PG8_WAIT_L(0); PG8_MMA(0, 0, At, B0); PG8_BAR; PG8_SCHED;
            PG8_LDB(B1, 0, 1); PG8_STAGE(PG8_SB(0, 0), b2, voffB);
            PG8_BAR; PG8_WAIT_L(0); PG8_MMA(0, 1, At, B1); PG8_BAR;
            PG8_LDA(At, 0, 1); PG8_STAGE(PG8_SA(0, 0), a2, voffA);
            PG8_BAR; PG8_WAIT_L(0); PG8_MMA(1, 0, At, B0); PG8_BAR; PG8_SCHED;
            PG8_STAGE(PG8_SB(0, 1), b2 + hstep, voffB);
            PG8_WAIT_V(6); PG8_BAR; PG8_MMA(1, 1, At, B1); PG8_BAR;
            PG8_LDB(B0, 1, 0); PG8_SCHED; PG8_LDA(At, 1, 0); PG8_STAGE(PG8_SA(0, 1), a2 + hstep, voffA);
            PG8_WAIT_L(8); PG8_BAR; PG8_WAIT_L(0); PG8_MMA(0, 0, At, B0); PG8_BAR; PG8_SCHED;
            PG8_LDB(B1, 1, 1); PG8_STAGE(PG8_SB(1, 0), b3, voffB);
            PG8_BAR; PG8_WAIT_L(0); PG8_MMA(0, 1, At, B1); PG8_BAR;
            PG8_LDA(At, 1, 1); PG8_STAGE(PG8_SA(1, 0), a3, voffA);
            PG8_BAR; PG8_WAIT_L(0); PG8_MMA(1, 0, At, B0); PG8_BAR; PG8_SCHED;
            PG8_STAGE(PG8_SB(1, 1), b3 + hstep, voffB);
            PG8_WAIT_V(6); PG8_BAR; PG8_MMA(1, 1, At, B1); PG8_BAR;
        }
        PG8_STAMP();
        if constexpr (!Epi::AFTER_DRAIN) { E(acc, cur, wr, wc, fr, fq); S.done(cur); }
        PG8_STAMP();
        if (!has_next) break;
#pragma unroll
        for (int a = 0; a < 2; ++a)
#pragma unroll
            for (int b = 0; b < 2; ++b)
#pragma unroll
                for (int m = 0; m < 4; ++m)
#pragma unroll
                    for (int n = 0; n < 2; ++n) acc[a][b][m][n] = (f32x4){0.f, 0.f, 0.f, 0.f};
        cur = nxt; cA = nA; cB = nB; ++ui;
    }
    PG8_WAIT_V(0);
    if (wr == 0) PG8_BAR;
    PG8_BAR;
    if constexpr (Epi::AFTER_DRAIN) { E.fused(acc, cur, wr, wc, fr, fq, lds, wid, lane); S.done(cur); }
    PG8_STAMP();
    if (STAMP && wid == 0) { stamps[lane] = lane < nts ? (((unsigned long long)(unsigned)ts_hi << 32) | (unsigned)ts_lo) : 0ull;
        if (lane == 62) stamps[62] = rt_entry; if (lane == 63) stamps[63] = (unsigned long long)wall_clock64(); }
#undef PG8_STAMP
#undef PG8_SA
#undef PG8_SB
#undef PG8_STAGE
#undef PG8_LDA
#undef PG8_LDB
#undef PG8_MMA
#undef PG8_WAIT_V
#undef PG8_WAIT_L
#undef PG8_BAR
#undef PG8_SCHED
}
}

template <class Epi> __device__ __forceinline__ void ph_gemm(const bf16_t* A, const bf16_t* Bt, int M, int N, int K, const Epi& E) {
    pg8::Gemm g; g.A = A; g.Bt = Bt; g.M = M; g.N = N; g.K = K;
    pg8::StaticOrder S; S.init(M, N, nblk_(), bid_());
    pg8::gemm_phase<Epi, pg8::StaticOrder, false>((PG8_LAS unsigned char*)dynsmem, g, S, E, nullptr, tid_());
}

__device__ __forceinline__ int pcol_to_orig(int c) {
    if (c < 768) return c;
    if (c < 1536) return c - 768 + 772;
    if (c < 1792) return c - 1536 + 1548;
    if (c < 1920) return c - 1792 + 1804;
    if (c < 2048) return c - 1920 + 1932;
    if (c < 2304) return c - 2048 + 2060;
    if (c < 2560) return c - 2304 + 2332;
    if (c < 2816) return c - 2560 + 2588;
    if (c < 2880) return c - 2816 + 2844;
    if (c < 2944) return c - 2880 + 2908;
    if (c < 3200) return c - 2944 + 2972;
    if (c < 3232) return c - 3200 + 3228;
    if (c < 3248) return c - 3232 + 2316;
    if (c < 3256) return c - 3248 + 3260;
    if (c < 3260) return c - 3256 + 768;
    if (c < 3264) return c - 3260 + 1540;
    if (c < 3268) return c - 3264 + 1544;
    return -1;
}
__device__ __forceinline__ void wtrans_job(const float* W, int K, int ldw, bf16_t* Wt, int Npad, bool mapped, float* tile) {
    const int tid = tid_();
    const int tn = Npad / 64, tk = K / 64;
    for (int t = bid_(); t < tn * tk; t += nblk_()) {
        const int n0 = (t / tk) * 64, k0 = (t % tk) * 64;
        __syncthreads();
        for (int idx = tid; idx < 4096; idx += 512) {
            const int kk = idx >> 6, nn = idx & 63;
            const int col = mapped ? pcol_to_orig(n0 + nn) : (n0 + nn);
            tile[kk * 65 + nn] = col >= 0 ? W[(size_t)(k0 + kk) * ldw + col] : 0.f;
        }
        __syncthreads();
        for (int idx = tid; idx < 4096; idx += 512) {
            const int nn = idx >> 6, kk = idx & 63;
            Wt[(size_t)(n0 + nn) * K + k0 + kk] = f2bf(tile[kk * 65 + nn]);
        }
    }
}
__device__ __forceinline__ void ph_weight_prep(const Ctx& p, float* sm) {
#pragma unroll 1
    for (int j = 0; j < 7 * DEPTH; ++j) {
        const int l = j / 7, w = j % 7;
        const float* W; int K, ldw, Npad; bf16_t* Wt; bool mapped = false;
        if (w == 0) { W = pin_(3) + (size_t)l * DM * 3268; K = DM; ldw = 3268; Npad = LDP; Wt = (bf16_t*)(pws_() + WT_IN) + (size_t)l * LDP * DM; mapped = true; }
        else if (w == 1) { W = pin_(20) + (size_t)l * DM * DM; K = DM; ldw = DM; Npad = DM; Wt = (bf16_t*)(pws_() + WT_OUT) + (size_t)l * DM * DM; }
        else if (w == 2) { W = pin_(23) + (size_t)l * DM * 256; K = DM; ldw = 256; Npad = 256; Wt = (bf16_t*)(pws_() + WT_XQ) + (size_t)l * 256 * DM; }
        else if (w == 3) { W = pin_(24) + (size_t)l * DM * 256; K = DM; ldw = 256; Npad = 256; Wt = (bf16_t*)(pws_() + WT_XK) + (size_t)l * 256 * DM; }
        else if (w == 4) { W = pin_(25) + (size_t)l * DM * 256; K = DM; ldw = 256; Npad = 256; Wt = (bf16_t*)(pws_() + WT_XV) + (size_t)l * 256 * DM; }
        else if (w == 5) { W = pin_(26) + (size_t)l * 256 * DM; K = 256; ldw = DM; Npad = DM; Wt = (bf16_t*)(pws_() + WT_XO) + (size_t)l * DM * 256; }
        else { W = pin_(30) + (size_t)l * DM * DM; K = DM; ldw = DM; Npad = DM; Wt = (bf16_t*)(pws_() + WT_PQ) + (size_t)l * DM * DM; }
        wtrans_job(W, K, ldw, Wt, Npad, mapped, sm);
    }
}

__device__ __forceinline__ void ph_rmsnorm(const float* __restrict__ x, const float* __restrict__ g, bf16_t* __restrict__ out, int rows) {
    const int lane = tid_() & 63;
    for (int r = gwave(); r < rows; r += nwaves()) {
        const float4* xr = (const float4*)(x + (size_t)r * DM);
        float4 v[4]; float ss = 0.f;
#pragma unroll
        for (int i = 0; i < 4; ++i) { v[i] = xr[lane + 64 * i]; ss += v[i].x * v[i].x + v[i].y * v[i].y + v[i].z * v[i].z + v[i].w * v[i].w; }
        ss = wave_sum(ss);
        const float rs = rsqrtf(ss * (1.f / DM) + EPS);
#pragma unroll
        for (int i = 0; i < 4; ++i) {
            const float4 gg = ((const float4*)g)[lane + 64 * i];
            ushort4 o; o.x = f2bf(v[i].x * rs * gg.x); o.y = f2bf(v[i].y * rs * gg.y); o.z = f2bf(v[i].z * rs * gg.z); o.w = f2bf(v[i].w * rs * gg.w);
            *(ushort4*)(out + (size_t)r * DM + (size_t)(lane + 64 * i) * 4) = o;
        }
    }
}

template <int OUTMODE>
__device__ __forceinline__ void ph_sgemm(const bf16_t* __restrict__ A, int lda, const float* __restrict__ B, int ldb, void* Cv, int ldc, const float* R, int ldr,
                         int M, int N, int K, float* smem) {
    float* As = smem;
    float* Bs = smem + 16 * 132;
    const int tid = tid_(), tx = tid & 31, ty = tid >> 5;
    const int ntn = N / 128, ntiles = (M / 128) * ntn;
    for (int tile = bid_(); tile < ntiles; tile += nblk_()) {
        const int tm = tile / ntn, tn = tile % ntn;
        float acc[8][4];
#pragma unroll
        for (int i = 0; i < 8; ++i)
#pragma unroll
            for (int j = 0; j < 4; ++j) acc[i][j] = 0.f;
        const int arow = tid >> 2, akq = (tid & 3) * 4;
        const int bk = tid >> 5, bn = (tid & 31) * 4;
        for (int k0 = 0; k0 < K; k0 += 16) {
            const ushort4 av = *(const ushort4*)(A + (size_t)(tm * 128 + arow) * lda + k0 + akq);
            const float4 bv = *(const float4*)(B + (size_t)(k0 + bk) * ldb + tn * 128 + bn);
            __syncthreads();
            As[(akq + 0) * 132 + arow] = bf2f(av.x); As[(akq + 1) * 132 + arow] = bf2f(av.y);
            As[(akq + 2) * 132 + arow] = bf2f(av.z); As[(akq + 3) * 132 + arow] = bf2f(av.w);
            *(float4*)(Bs + bk * 132 + bn) = bv;
            __syncthreads();
#pragma unroll
            for (int k = 0; k < 16; ++k) {
                const float4 a0 = *(const float4*)(As + k * 132 + ty * 8), a1 = *(const float4*)(As + k * 132 + ty * 8 + 4);
                const float4 b = *(const float4*)(Bs + k * 132 + tx * 4);
                const float a[8] = {a0.x, a0.y, a0.z, a0.w, a1.x, a1.y, a1.z, a1.w};
#pragma unroll
                for (int i = 0; i < 8; ++i) { acc[i][0] += a[i] * b.x; acc[i][1] += a[i] * b.y; acc[i][2] += a[i] * b.z; acc[i][3] += a[i] * b.w; }
            }
        }
#pragma unroll
        for (int i = 0; i < 8; ++i) {
            const size_t row = (size_t)tm * 128 + ty * 8 + i; const int col = tn * 128 + tx * 4;
            if (OUTMODE == 0) {
                ushort4 o; o.x = f2bf(acc[i][0]); o.y = f2bf(acc[i][1]); o.z = f2bf(acc[i][2]); o.w = f2bf(acc[i][3]);
                *(ushort4*)((bf16_t*)Cv + row * ldc + col) = o;
            } else if (OUTMODE == 1) {
                *(float4*)((float*)Cv + row * ldc + col) = make_float4(acc[i][0], acc[i][1], acc[i][2], acc[i][3]);
            } else {
                const float4 r = *(const float4*)(R + row * ldr + col);
                *(float4*)((float*)Cv + row * ldc + col) = make_float4(r.x + acc[i][0], r.y + acc[i][1], r.z + acc[i][2], r.w + acc[i][3]);
            }
        }
    }
}

__device__ __forceinline__ void ph_ssd_scan(const Ctx& p, int l, float* smem) {
    const bf16_t* P = (const bf16_t*)(pws_() + WS_P);
    float* Ypre = (float*)(pws_() + WS_YPRE);
    const float* cw = pin_(4) + (size_t)l * 4 * 512;
    const float* cb = pin_(5) + (size_t)l * 512;
    float* xs = smem;
    float* Bs = xs + 4096;
    float* Cs = Bs + 4096;
    float* yb = Cs + 4096;
    float* dts = yb + 4096;
    const int tid = tid_(), pp = tid >> 3, ng = tid & 7;
    for (int item = bid_(); item < NB * 4; item += nblk_()) {
        const int b = item >> 2, h = item & 3, g = h >> 1;
        const float a = -__expf(pin_(7)[l * 4 + h]);
        const float dtb = pin_(6)[l * 4 + h];
        const float Dh = pin_(8)[l * 4 + h];
        float hst[8];
#pragma unroll
        for (int i = 0; i < 8; ++i) hst[i] = 0.f;
        for (int c = 0; c < SEQ / 64; ++c) {
            const int t0 = c * 64;
            __syncthreads();
            for (int idx = tid; idx < 64 * 192; idx += 512) {
                const int tl = idx / 192, ch = idx % 192, which = ch >> 6, cl = ch & 63;
                const int cc = which == 0 ? h * 64 + cl : (which == 1 ? 256 + g * 64 + cl : 384 + g * 64 + cl);
                float acc = cb[cc];
#pragma unroll
                for (int j = 0; j < 4; ++j) { const int tt = t0 + tl - 3 + j; if (tt >= 0) acc += cw[j * 512 + cc] * bf2f(P[((size_t)b * SEQ + tt) * LDP + PC_XBC + cc]); }
                const float v = silu_f(acc);
                (which == 0 ? xs : (which == 1 ? Bs : Cs))[tl * 64 + cl] = v;
            }
            if (tid < 64) dts[tid] = softplus_f(bf2f(P[((size_t)b * SEQ + t0 + tid) * LDP + PC_DT + h]) + dtb);
            __syncthreads();
            for (int tl = 0; tl < 64; ++tl) {
                const float dt = dts[tl], dA = __expf(dt * a), xv = xs[tl * 64 + pp];
                const float xdt = xv * dt;
                const float4 b0 = *(const float4*)(Bs + tl * 64 + ng * 8), b1 = *(const float4*)(Bs + tl * 64 + ng * 8 + 4);
                const float4 c0 = *(const float4*)(Cs + tl * 64 + ng * 8), c1 = *(const float4*)(Cs + tl * 64 + ng * 8 + 4);
                const float bb[8] = {b0.x, b0.y, b0.z, b0.w, b1.x, b1.y, b1.z, b1.w};
                const float cc8[8] = {c0.x, c0.y, c0.z, c0.w, c1.x, c1.y, c1.z, c1.w};
                float part = 0.f;
#pragma unroll
                for (int i = 0; i < 8; ++i) { hst[i] = hst[i] * dA + xdt * bb[i]; part += cc8[i] * hst[i]; }
                part += __shfl_xor(part, 1, 64); part += __shfl_xor(part, 2, 64); part += __shfl_xor(part, 4, 64);
                if (ng == 0) yb[tl * 64 + pp] = part + Dh * xv;
            }
            __syncthreads();
            for (int idx = tid; idx < 4096; idx += 512) { const int tl = idx >> 6, q = idx & 63; Ypre[((size_t)b * SEQ + t0 + tl) * 256 + h * 64 + q] = yb[idx]; }
        }
    }
}
__device__ __forceinline__ void ph_ssd_finish(const Ctx& p, int l) {
    const bf16_t* P = (const bf16_t*)(pws_() + WS_P);
    const float* Ypre = (const float*)(pws_() + WS_YPRE);
    bf16_t* Y = (bf16_t*)(pws_() + WS_Y);
    const float* gn = pin_(9) + (size_t)l * 256;
    const int lane = tid_() & 63;
    for (int tok = gwave(); tok < MTOK; tok += nwaves()) {
        float v[4]; float ss = 0.f;
#pragma unroll
        for (int i = 0; i < 4; ++i) { const int c = lane + 64 * i; const float z = bf2f(P[(size_t)tok * LDP + PC_Z + c]); v[i] = Ypre[(size_t)tok * 256 + c] * silu_f(z); ss += v[i] * v[i]; }
        ss = wave_sum(ss);
        const float rs = rsqrtf(ss * (1.f / 256.f) + EPS);
#pragma unroll
        for (int i = 0; i < 4; ++i) { const int c = lane + 64 * i; Y[(size_t)tok * DM + c] = f2bf(v[i] * rs * gn[c]); }
    }
}

__device__ __forceinline__ void ph_gdn_scan(const Ctx& p, int l, float* smem) {
    const bf16_t* P = (const bf16_t*)(pws_() + WS_P);
    bf16_t* Y = (bf16_t*)(pws_() + WS_Y);
    const float* cw = pin_(10) + (size_t)l * 4 * 768;
    const float* gn = pin_(13) + (size_t)l * 64;
    float* qs = smem;
    float* ks = qs + 4096;
    float* vs = ks + 4096;
    float* ob = vs + 4096;
    float* al = ob + 4096;
    float* be = al + 64;
    const int tid = tid_(), lane = tid & 63, wave = tid >> 6;
    const int e = wave * 8 + (lane & 7), dg = lane >> 3;
    for (int item = bid_(); item < NB * 4; item += nblk_()) {
        const int b = item >> 2, h = item & 3;
        const float A = -__expf(pin_(11)[l * 4 + h]);
        const float dtb = pin_(12)[l * 4 + h];
        float S[8];
#pragma unroll
        for (int i = 0; i < 8; ++i) S[i] = 0.f;
        for (int c = 0; c < SEQ / 64; ++c) {
            const int t0 = c * 64;
            __syncthreads();
            for (int idx = tid; idx < 64 * 192; idx += 512) {
                const int tl = idx / 192, ch = idx % 192, which = ch >> 6, cl = ch & 63;
                const int cc = which * 256 + h * 64 + cl;
                float acc = 0.f;
#pragma unroll
                for (int j = 0; j < 4; ++j) { const int tt = t0 + tl - 3 + j; if (tt >= 0) acc += cw[j * 768 + cc] * bf2f(P[((size_t)b * SEQ + tt) * LDP + PC_GQKV + cc]); }
                (which == 0 ? qs : (which == 1 ? ks : vs))[tl * 64 + cl] = silu_f(acc);
            }
            if (tid < 64) {
                const size_t row = ((size_t)b * SEQ + t0 + tid) * LDP;
                const float ga = bf2f(P[row + PC_GA + h]), gb = bf2f(P[row + PC_GB + h]);
                al[tid] = __expf(A * softplus_f(ga + dtb));
                be[tid] = sigmoid_f(gb);
            }
            __syncthreads();
            for (int r = wave; r < 128; r += 8) {
                float* rowp = (r < 64 ? qs + r * 64 : ks + (r - 64) * 64);
                const float v = rowp[lane];
                const float ss = wave_sum(v * v);
                const float sc = rsqrtf(ss + EPS) * (r < 64 ? 0.125f : 1.f);
                rowp[lane] = v * sc;
            }
            __syncthreads();
            for (int tl = 0; tl < 64; ++tl) {
                const float alpha = al[tl], beta = be[tl];
                const float4 k0 = *(const float4*)(ks + tl * 64 + dg * 8), k1 = *(const float4*)(ks + tl * 64 + dg * 8 + 4);
                const float4 q0 = *(const float4*)(qs + tl * 64 + dg * 8), q1 = *(const float4*)(qs + tl * 64 + dg * 8 + 4);
                const float kk[8] = {k0.x, k0.y, k0.z, k0.w, k1.x, k1.y, k1.z, k1.w};
                const float qq[8] = {q0.x, q0.y, q0.z, q0.w, q1.x, q1.y, q1.z, q1.w};
                float r = 0.f;
#pragma unroll
                for (int i = 0; i < 8; ++i) { S[i] *= alpha; r += S[i] * kk[i]; }
                r += __shfl_xor(r, 8, 64); r += __shfl_xor(r, 16, 64); r += __shfl_xor(r, 32, 64);
                const float vn = beta * (vs[tl * 64 + e] - r);
                float o = 0.f;
#pragma unroll
                for (int i = 0; i < 8; ++i) { S[i] += kk[i] * vn; o += S[i] * qq[i]; }
                o += __shfl_xor(o, 8, 64); o += __shfl_xor(o, 16, 64); o += __shfl_xor(o, 32, 64);
                if (dg == 0) ob[tl * 64 + e] = o;
            }
            __syncthreads();
            for (int r = wave; r < 64; r += 8) {
                const float v = ob[r * 64 + lane];
                const float ss = wave_sum(v * v);
                const float rs = rsqrtf(ss * (1.f / 64.f) + EPS);
                const size_t tok = (size_t)b * SEQ + t0 + r;
                const float gate = bf2f(P[tok * LDP + PC_GG + h * 64 + lane]);
                Y[tok * DM + 256 + h * 64 + lane] = f2bf(v * rs * gn[lane] * silu_f(gate));
            }
        }
    }
}

__device__ __forceinline__ void ph_gla_scan(const Ctx& p, int l, float* smem) {
    const bf16_t* P = (const bf16_t*)(pws_() + WS_P);
    bf16_t* Y = (bf16_t*)(pws_() + WS_Y);
    const float* wg = pin_(14) + (size_t)l * 16 * 128;
    const float* bg = pin_(15) + (size_t)l * 128;
    const float* gn = pin_(16) + (size_t)l * 64;
    float* qs = smem;
    float* ks = qs + 2048;
    float* ds = ks + 2048;
    float* vs = ds + 2048;
    float* ob = vs + 4096;
    const int tid = tid_(), lane = tid & 63, wave = tid >> 6;
    const int e = wave * 8 + (lane & 7), dg = lane >> 3;
    for (int item = bid_(); item < NB * 4; item += nblk_()) {
        const int b = item >> 2, h = item & 3;
        float S[4];
#pragma unroll
        for (int i = 0; i < 4; ++i) S[i] = 0.f;
        for (int c = 0; c < SEQ / 64; ++c) {
            const int t0 = c * 64;
            __syncthreads();
            for (int idx = tid; idx < 64 * 32; idx += 512) {
                const int tl = idx >> 5, d = idx & 31;
                const size_t row = ((size_t)b * SEQ + t0 + tl) * LDP;
                qs[idx] = bf2f(P[row + PC_LQ + h * 32 + d]) * 0.17677669529663687f;
                ks[idx] = bf2f(P[row + PC_LK + h * 32 + d]);
                float acc = bg[h * 32 + d];
#pragma unroll
                for (int r = 0; r < 16; ++r) acc += bf2f(P[row + PC_GLR + r]) * wg[r * 128 + h * 32 + d];
                ds[idx] = __expf(logsigmoid_f(acc) * (1.f / 16.f));
            }
            for (int idx = tid; idx < 4096; idx += 512) { const int tl = idx >> 6, q = idx & 63; vs[idx] = bf2f(P[((size_t)b * SEQ + t0 + tl) * LDP + PC_LV + h * 64 + q]); }
            __syncthreads();
            for (int tl = 0; tl < 64; ++tl) {
                const float4 k4 = *(const float4*)(ks + tl * 32 + dg * 4), q4 = *(const float4*)(qs + tl * 32 + dg * 4), d4 = *(const float4*)(ds + tl * 32 + dg * 4);
                const float kk[4] = {k4.x, k4.y, k4.z, k4.w}, qq[4] = {q4.x, q4.y, q4.z, q4.w}, dd[4] = {d4.x, d4.y, d4.z, d4.w};
                const float v = vs[tl * 64 + e];
                float o = 0.f;
#pragma unroll
                for (int i = 0; i < 4; ++i) { S[i] = dd[i] * S[i] + kk[i] * v; o += S[i] * qq[i]; }
                o += __shfl_xor(o, 8, 64); o += __shfl_xor(o, 16, 64); o += __shfl_xor(o, 32, 64);
                if (dg == 0) ob[tl * 64 + e] = o;
            }
            __syncthreads();
            for (int r = wave; r < 64; r += 8) {
                const float v = ob[r * 64 + lane];
                const float ss = wave_sum(v * v);
                const float rs = rsqrtf(ss * (1.f / 64.f) + EPS);
                const size_t tok = (size_t)b * SEQ + t0 + r;
                const float gate = bf2f(P[tok * LDP + PC_LR + h * 64 + lane]);
                Y[tok * DM + 512 + h * 64 + lane] = f2bf(v * rs * gn[lane] * silu_f(gate));
            }
        }
    }
}

typedef short bf16x8_t __attribute__((ext_vector_type(8)));
typedef float f32x4_t __attribute__((ext_vector_type(4)));
__device__ __forceinline__ unsigned pk_bf16(float lo, float hi) { return (unsigned)f2bf(lo) | ((unsigned)f2bf(hi) << 16); }
union BF8 { bf16x8_t v; uint4 u; unsigned w[4]; };


__device__ __forceinline__ void ph_dsa_prep(const Ctx& p, int l) {
    const bf16_t* P = (const bf16_t*)(pws_() + WS_P);
    bf16_t* qn = (bf16_t*)(pws_() + WS_QN);
    bf16_t* kn = (bf16_t*)(pws_() + WS_KN);
    bf16_t* ikn = (bf16_t*)(pws_() + WS_IKN);
    bf16_t* vt = (bf16_t*)(pws_() + WS_VT);
    const float* qg = pin_(17) + (size_t)l * 64;
    const float* kg = pin_(18) + (size_t)l * 64;
    const float* ig = pin_(19) + (size_t)l * 32;
    const int lane = tid_() & 63;
    for (int tok = gwave(); tok < MTOK; tok += nwaves()) {
        const size_t row = (size_t)tok * LDP;
        const int b = tok / SEQ, t = tok % SEQ;
#pragma unroll
        for (int h = 0; h < 4; ++h) {
            const float v = bf2f(P[row + PC_DQ + h * 64 + lane]);
            const float ss = wave_sum(v * v);
            qn[(size_t)tok * 256 + h * 64 + lane] = f2bf(v * rsqrtf(ss * (1.f / 64.f) + EPS) * qg[lane] * 0.125f);
        }
        {
            const float v = bf2f(P[row + PC_DK + lane]);
            const float ss = wave_sum(v * v);
            kn[(size_t)tok * 64 + lane] = f2bf(v * rsqrtf(ss * (1.f / 64.f) + EPS) * kg[lane]);
        }
        {
            const float v = lane < 32 ? bf2f(P[row + PC_IK + lane]) : 0.f;
            const float ss = wave_sum(v * v);
            if (lane < 32) ikn[(size_t)tok * 32 + lane] = f2bf(v * rsqrtf(ss * (1.f / 32.f) + EPS) * ig[lane]);
        }
        vt[((size_t)b * 64 + lane) * SEQ + t] = P[row + PC_DV + lane];
    }
}

#define DSA_STRIDE 2052
__device__ __forceinline__ void ph_dsa_main(const Ctx& p, int l, float* smem) {
    const bf16_t* P = (const bf16_t*)(pws_() + WS_P);
    bf16_t* Y = (bf16_t*)(pws_() + WS_Y);
    const bf16_t* QN = (const bf16_t*)(pws_() + WS_QN);
    const bf16_t* KN = (const bf16_t*)(pws_() + WS_KN);
    const bf16_t* IKN = (const bf16_t*)(pws_() + WS_IKN);
    const bf16_t* VT = (const bf16_t*)(pws_() + WS_VT);
    unsigned* sc = (unsigned*)smem;
    float* part = smem;
    float* plsum = smem + 8 * 64 * 64;
    unsigned* thr = (unsigned*)(smem + 35000);
    const int tid = tid_(), lane = tid & 63, w = tid >> 6, qi = lane & 15, g = lane >> 4;
    for (int task = bid_(); task < MTOK / 16; task += nblk_()) {
        const int c = 31 - task / 128, b = (task >> 2) & 31, sub = task & 3;
        const int t0 = c * 64 + sub * 16, nk = (c + 1) * 64;
        const size_t tok0 = (size_t)b * SEQ + t0;
        const bool dosel = nk > 256;
        if (dosel) {
            BF8 iqf[8]; float wq[8];
#pragma unroll
            for (int h = 0; h < 8; ++h) {
                iqf[h].u = *(const uint4*)(P + (tok0 + qi) * LDP + PC_IQ + h * 32 + 8 * g);
                wq[h] = bf2f(P[(tok0 + qi) * LDP + PC_IW + h]) * 0.0625f;
            }
            for (int kt = w; kt < nk / 16; kt += 8) {
                const int s0 = kt * 16;
                BF8 ka; ka.u = *(const uint4*)(IKN + ((size_t)b * SEQ + s0 + qi) * 32 + 8 * g);
                float acc[4] = {0.f, 0.f, 0.f, 0.f};
#pragma unroll
                for (int h = 0; h < 8; ++h) {
                    const f32x4_t d = __builtin_amdgcn_mfma_f32_16x16x32_bf16(ka.v, iqf[h].v, (f32x4_t){0.f, 0.f, 0.f, 0.f}, 0, 0, 0);
#pragma unroll
                    for (int r = 0; r < 4; ++r) acc[r] = __builtin_fmaf(wq[h], fmaxf(d[r], 0.f), acc[r]);
                }
                uint4 kv; kv.x = ford(acc[0]); kv.y = ford(acc[1]); kv.z = ford(acc[2]); kv.w = ford(acc[3]);
                *(uint4*)(sc + qi * DSA_STRIDE + s0 + 4 * g) = kv;
            }
        }
        __syncthreads();
        if (dosel) {
            const int nj = nk >> 6;
#pragma unroll 1
            for (int qq = 0; qq < 2; ++qq) {
                const int q = 2 * w + qq;
                unsigned kreg[32];
#pragma unroll
                for (int j = 0; j < 32; ++j) kreg[j] = (j < nj) ? sc[q * DSA_STRIDE + j * 64 + lane] : 0u;
                unsigned T = 0u; bool exact = false;
                for (int bit = 31; bit >= 0; --bit) {
                    const unsigned cand = T | (1u << bit);
                    int cnt = 0;
#pragma unroll
                    for (int j = 0; j < 32; ++j) cnt += __popcll(__ballot(kreg[j] >= cand));
                    if (cnt >= 256) { T = cand; if (cnt == 256) { exact = true; break; } }
                }
                int cut = 0x7fffffff;
                if (!exact) {
                    int cgt = 0, ceq = 0;
#pragma unroll
                    for (int j = 0; j < 32; ++j) { cgt += __popcll(__ballot(kreg[j] > T)); ceq += __popcll(__ballot(kreg[j] == T)); }
                    int need = 256 - cgt;
                    if (ceq > need) {
                        bool found = false;
#pragma unroll
                        for (int j = 0; j < 32; ++j) {
                            const unsigned long long m = __ballot(kreg[j] == T);
                            const int cj = __popcll(m);
                            if (!found) {
                                if (need <= cj) { for (int bpos = 0; bpos < 64; ++bpos) if ((m >> bpos) & 1ull) { if (--need == 0) { cut = j * 64 + bpos; break; } } found = true; }
                                else need -= cj;
                            }
                        }
                    }
                }
                if (lane == 0) { thr[q] = T; thr[16 + q] = (unsigned)cut; }
            }
        }
        __syncthreads();
        unsigned Tq = 0u; int cutq = 0x7fffffff;
        if (dosel) { Tq = thr[qi]; cutq = (int)thr[16 + qi]; }
        f32x4_t oacc[4][4]; float lsum[4];
#pragma unroll
        for (int h = 0; h < 4; ++h) { lsum[h] = 0.f;
#pragma unroll
            for (int dt = 0; dt < 4; ++dt) oacc[h][dt] = (f32x4_t){0.f, 0.f, 0.f, 0.f}; }
        const int krow = 8 * (qi >> 2) + (qi & 3);
        for (int st = w; st < nk / 32; st += 8) {
            const int s0 = st * 32;
            BF8 ka[2][2], va[4];
#pragma unroll
            for (int t = 0; t < 2; ++t)
#pragma unroll
                for (int s2 = 0; s2 < 2; ++s2) ka[t][s2].u = *(const uint4*)(KN + ((size_t)b * SEQ + s0 + krow + 4 * t) * 64 + 32 * s2 + 8 * g);
#pragma unroll
            for (int dt = 0; dt < 4; ++dt) va[dt].u = *(const uint4*)(VT + ((size_t)b * 64 + 16 * dt + qi) * SEQ + s0 + 8 * g);
            float mk[8];
            if (dosel) {
                const uint4 k0 = *(const uint4*)(sc + qi * DSA_STRIDE + s0 + 8 * g), k1 = *(const uint4*)(sc + qi * DSA_STRIDE + s0 + 8 * g + 4);
                const unsigned kk[8] = {k0.x, k0.y, k0.z, k0.w, k1.x, k1.y, k1.z, k1.w};
#pragma unroll
                for (int j = 0; j < 8; ++j) mk[j] = (kk[j] > Tq || (kk[j] == Tq && (s0 + 8 * g + j) <= cutq)) ? 1.f : 0.f;
            } else {
#pragma unroll
                for (int j = 0; j < 8; ++j) mk[j] = 1.f;
            }
#pragma unroll
            for (int h = 0; h < 4; ++h) {
                BF8 q0, q1;
                q0.u = *(const uint4*)(QN + (tok0 + qi) * 256 + h * 64 + 8 * g);
                q1.u = *(const uint4*)(QN + (tok0 + qi) * 256 + h * 64 + 32 + 8 * g);
                f32x4_t sacc[2];
#pragma unroll
                for (int t = 0; t < 2; ++t) {
                    sacc[t] = __builtin_amdgcn_mfma_f32_16x16x32_bf16(ka[t][0].v, q0.v, (f32x4_t){0.f, 0.f, 0.f, 0.f}, 0, 0, 0);
                    sacc[t] = __builtin_amdgcn_mfma_f32_16x16x32_bf16(ka[t][1].v, q1.v, sacc[t], 0, 0, 0);
                }
                float pe[8];
#pragma unroll
                for (int t = 0; t < 2; ++t)
#pragma unroll
                    for (int r = 0; r < 4; ++r) { pe[4 * t + r] = __expf(sacc[t][r]) * mk[4 * t + r]; lsum[h] += pe[4 * t + r]; }
                BF8 pf;
#pragma unroll
                for (int j = 0; j < 4; ++j) pf.w[j] = pk_bf16(pe[2 * j], pe[2 * j + 1]);
#pragma unroll
                for (int dt = 0; dt < 4; ++dt) oacc[h][dt] = __builtin_amdgcn_mfma_f32_16x16x32_bf16(va[dt].v, pf.v, oacc[h][dt], 0, 0, 0);
            }
        }
        __syncthreads();
#pragma unroll
        for (int h = 0; h < 4; ++h) {
            plsum[(w * 4 + h) * 64 + lane] = lsum[h];
#pragma unroll
            for (int dt = 0; dt < 4; ++dt)
#pragma unroll
                for (int r = 0; r < 4; ++r) part[(w * 64 + h * 16 + dt * 4 + r) * 64 + lane] = oacc[h][dt][r];
        }
        __syncthreads();
        {
            const int h = w >> 1;
            float lq = 0.f;
#pragma unroll
            for (int w2 = 0; w2 < 8; ++w2)
#pragma unroll
                for (int g2 = 0; g2 < 4; ++g2) lq += plsum[(w2 * 4 + h) * 64 + qi + 16 * g2];
            const float inv = 1.f / lq;
#pragma unroll
            for (int dd = 0; dd < 2; ++dd) {
                const int dt = (w & 1) * 2 + dd;
                float o[4];
#pragma unroll
                for (int r = 0; r < 4; ++r) {
                    float sacc = 0.f;
#pragma unroll
                    for (int w2 = 0; w2 < 8; ++w2) sacc += part[(w2 * 64 + h * 16 + dt * 4 + r) * 64 + lane];
                    o[r] = sacc * inv;
                }
                uint2 ov; ov.x = pk_bf16(o[0], o[1]); ov.y = pk_bf16(o[2], o[3]);
                *(uint2*)(Y + (tok0 + qi) * DM + 768 + h * 64 + 16 * dt + 4 * g) = ov;
            }
        }
        __syncthreads();
    }
}

__device__ __forceinline__ void ph_mem_prep(const Ctx& p, int l) {
    const float* Km = (const float*)(pws_() + WS_KM);
    const float* Vm = (const float*)(pws_() + WS_VM);
    bf16_t* KB = (bf16_t*)(pws_() + WS_KB);
    bf16_t* VTB = (bf16_t*)(pws_() + WS_VTB);
    const float* kg = pin_(28) + (size_t)l * 64;
    const int lane = tid_() & 63;
    for (int r = gwave(); r < MMEM; r += nwaves()) {
        const int b = r / NMEM, j = r % NMEM;
#pragma unroll
        for (int h = 0; h < 4; ++h) {
            const float v = Km[(size_t)r * 256 + h * 64 + lane];
            const float ss = wave_sum(v * v);
            KB[(((size_t)b * 4 + h) * NMEM + j) * 64 + lane] = f2bf(v * rsqrtf(ss * (1.f / 64.f) + EPS) * kg[lane]);
            VTB[(((size_t)b * 4 + h) * 64 + lane) * NMEM + j] = f2bf(Vm[(size_t)r * 256 + h * 64 + lane]);
        }
    }
}
__device__ __forceinline__ void ph_xattn(const Ctx& p, int l) {
    const float* Qx = (const float*)(pws_() + WS_QX);
    bf16_t* Ox = (bf16_t*)(pws_() + WS_OX);
    const bf16_t* KB = (const bf16_t*)(pws_() + WS_KB);
    const bf16_t* VTB = (const bf16_t*)(pws_() + WS_VTB);
    const float* qg = pin_(27) + (size_t)l * 64;
    const int lane = tid_() & 63, qi = lane & 15, g = lane >> 4;
    for (int task = gwave(); task < MTOK / 16; task += nwaves()) {
        const int tok0 = task * 16, b = tok0 / SEQ;
#pragma unroll 1
        for (int h = 0; h < 4; ++h) {
            BF8 qf[2];
            {
                float qv[2][8]; float ss = 0.f;
#pragma unroll
                for (int s2 = 0; s2 < 2; ++s2) {
                    const float4* qp = (const float4*)(Qx + (size_t)(tok0 + qi) * 256 + h * 64 + 32 * s2 + 8 * g);
                    const float4 a = qp[0], c = qp[1];
                    qv[s2][0] = a.x; qv[s2][1] = a.y; qv[s2][2] = a.z; qv[s2][3] = a.w; qv[s2][4] = c.x; qv[s2][5] = c.y; qv[s2][6] = c.z; qv[s2][7] = c.w;
#pragma unroll
                    for (int j = 0; j < 8; ++j) ss += qv[s2][j] * qv[s2][j];
                }
                ss += __shfl_xor(ss, 16, 64); ss += __shfl_xor(ss, 32, 64);
                const float rs = rsqrtf(ss * (1.f / 64.f) + EPS) * 0.125f;
#pragma unroll
                for (int s2 = 0; s2 < 2; ++s2) {
                    const float4 g0 = *(const float4*)(qg + 32 * s2 + 8 * g), g1 = *(const float4*)(qg + 32 * s2 + 8 * g + 4);
                    qf[s2].w[0] = pk_bf16(qv[s2][0] * rs * g0.x, qv[s2][1] * rs * g0.y); qf[s2].w[1] = pk_bf16(qv[s2][2] * rs * g0.z, qv[s2][3] * rs * g0.w);
                    qf[s2].w[2] = pk_bf16(qv[s2][4] * rs * g1.x, qv[s2][5] * rs * g1.y); qf[s2].w[3] = pk_bf16(qv[s2][6] * rs * g1.z, qv[s2][7] * rs * g1.w);
                }
            }
            const bf16_t* Kh = KB + ((size_t)b * 4 + h) * NMEM * 64;
            const bf16_t* Vh = VTB + ((size_t)b * 4 + h) * 64 * NMEM;
            f32x4_t oacc[4];
#pragma unroll
            for (int dt = 0; dt < 4; ++dt) oacc[dt] = (f32x4_t){0.f, 0.f, 0.f, 0.f};
            float lsum = 0.f;
            const int krow = 8 * (qi >> 2) + (qi & 3);
#pragma unroll 2
            for (int s0 = 0; s0 < NMEM; s0 += 32) {
                BF8 ka[2][2], va[4];
#pragma unroll
                for (int t = 0; t < 2; ++t)
#pragma unroll
                    for (int s2 = 0; s2 < 2; ++s2) ka[t][s2].u = *(const uint4*)(Kh + (size_t)(s0 + krow + 4 * t) * 64 + 32 * s2 + 8 * g);
#pragma unroll
                for (int dt = 0; dt < 4; ++dt) va[dt].u = *(const uint4*)(Vh + (size_t)(16 * dt + qi) * NMEM + s0 + 8 * g);
                f32x4_t sacc[2];
#pragma unroll
                for (int t = 0; t < 2; ++t) {
                    sacc[t] = (f32x4_t){0.f, 0.f, 0.f, 0.f};
                    sacc[t] = __builtin_amdgcn_mfma_f32_16x16x32_bf16(ka[t][0].v, qf[0].v, sacc[t], 0, 0, 0);
                    sacc[t] = __builtin_amdgcn_mfma_f32_16x16x32_bf16(ka[t][1].v, qf[1].v, sacc[t], 0, 0, 0);
                }
                float pe[8];
#pragma unroll
                for (int t = 0; t < 2; ++t)
#pragma unroll
                    for (int r = 0; r < 4; ++r) { pe[4 * t + r] = __expf(sacc[t][r]); lsum += pe[4 * t + r]; }
                BF8 pf;
#pragma unroll
                for (int j = 0; j < 4; ++j) pf.w[j] = pk_bf16(pe[2 * j], pe[2 * j + 1]);
#pragma unroll
                for (int dt = 0; dt < 4; ++dt) oacc[dt] = __builtin_amdgcn_mfma_f32_16x16x32_bf16(va[dt].v, pf.v, oacc[dt], 0, 0, 0);
            }
            lsum += __shfl_xor(lsum, 16, 64); lsum += __shfl_xor(lsum, 32, 64);
            const float inv = 1.f / lsum;
#pragma unroll
            for (int dt = 0; dt < 4; ++dt) {
                uint2 o; o.x = pk_bf16(oacc[dt][0] * inv, oacc[dt][1] * inv); o.y = pk_bf16(oacc[dt][2] * inv, oacc[dt][3] * inv);
                *(uint2*)(Ox + (size_t)(tok0 + qi) * 256 + h * 64 + 16 * dt + 4 * g) = o;
            }
        }
    }
}

__device__ __forceinline__ void ph_peer_topk(const Ctx& p, int l, float* smem) {
    const float* Qp = (const float*)(pws_() + WS_QP);
    const float* sk = pin_(31) + (size_t)l * 8 * 2 * 128 * 64;
    int* pidx = (int*)(pws_() + WS_PEI);
    float* pgt = (float*)(pws_() + WS_PEG);
    const int tid = tid_(), lane = tid & 63, wave = tid >> 6;
    float* qs = smem + wave * 1024;
    for (int tok = gwave(); tok < MTOK; tok += nwaves()) {
#pragma unroll
        for (int i = 0; i < 4; ++i) *(float4*)(qs + (lane + 64 * i) * 4) = *(const float4*)(Qp + (size_t)tok * DM + (lane + 64 * i) * 4);
#pragma unroll 1
        for (int h = 0; h < 8; ++h) {
            float ts[2]; int ti[2];
#pragma unroll
            for (int pp = 0; pp < 2; ++pp) {
                const float* qv = qs + h * 128 + pp * 64;
                unsigned long long k0, k1;
                {
                    const float4* r0 = (const float4*)(sk + ((size_t)(h * 2 + pp) * 128 + lane) * 64);
                    const float4* r1 = (const float4*)(sk + ((size_t)(h * 2 + pp) * 128 + lane + 64) * 64);
                    float d0 = 0.f, d1 = 0.f;
#pragma unroll
                    for (int q = 0; q < 16; ++q) { const float4 q4 = *(const float4*)(qv + q * 4); const float4 a = r0[q], c = r1[q]; d0 += q4.x * a.x + q4.y * a.y + q4.z * a.z + q4.w * a.w; d1 += q4.x * c.x + q4.y * c.y + q4.z * c.z + q4.w * c.w; }
                    k0 = ((unsigned long long)ford(d0) << 32) | (unsigned)(127 - lane);
                    k1 = ((unsigned long long)ford(d1) << 32) | (unsigned)(127 - (lane + 64));
                }
                float mys = 0.f; int myi = 0;
#pragma unroll 1
                for (int it = 0; it < 16; ++it) {
                    const unsigned long long m = wave_max_u64(k0 > k1 ? k0 : k1);
                    if (lane == it) { mys = funord((unsigned)(m >> 32)); myi = 127 - (int)(m & 0xffffffffu); }
                    if (k0 == m) k0 = 0ull;
                    if (k1 == m) k1 = 0ull;
                }
                ts[pp] = mys; ti[pp] = myi;
            }
            unsigned long long ck[4];
#pragma unroll
            for (int c = 0; c < 4; ++c) {
                const int f = lane * 4 + c, a = f >> 4, bq = f & 15;
                const float s = __shfl(ts[0], a, 64) + __shfl(ts[1], bq, 64);
                ck[c] = ((unsigned long long)ford(s) << 32) | (unsigned)(255 - f);
            }
            float top = -3.0e38f; int eidx = 0;
#pragma unroll 1
            for (int it = 0; it < 16; ++it) {
                unsigned long long m = ck[0] > ck[1] ? ck[0] : ck[1]; const unsigned long long m2 = ck[2] > ck[3] ? ck[2] : ck[3]; m = m > m2 ? m : m2;
                m = wave_max_u64(m);
                const int f = 255 - (int)(m & 0xffffffffu), a = f >> 4, bq = f & 15;
                const int e = __shfl(ti[0], a, 64) * 128 + __shfl(ti[1], bq, 64);
                if (lane == it) { top = funord((unsigned)(m >> 32)); eidx = e; }
#pragma unroll
                for (int c = 0; c < 4; ++c) if (ck[c] == m) ck[c] = 0ull;
            }
            const float mxv = __shfl(top, 0, 64);
            float ev = lane < 16 ? __expf(top - mxv) : 0.f;
            const float den = wave_sum(ev);
            const float gate = ev / den;
            if (lane < 16) { pidx[(size_t)tok * 128 + h * 16 + lane] = eidx; pgt[(size_t)tok * 128 + h * 16 + lane] = gate; }
        }
    }
}


typedef _Float16 h2_t __attribute__((ext_vector_type(2)));
__device__ __forceinline__ h2_t as_h2(unsigned u) { union { unsigned u; h2_t h; } c; c.u = u; return c.h; }
__device__ __forceinline__ void ph_tab_convert(const Ctx& p, int l) {
    const float4* u = (const float4*)(pin_(32) + (size_t)l * NEXP * DM);
    const float4* v = (const float4*)(pin_(33) + (size_t)l * NEXP * DM);
    uint2* uo = (uint2*)(pws_() + WS_UT16);
    uint2* vo = (uint2*)(pws_() + WS_VT16);
    const size_t n4 = (size_t)NEXP * DM / 4;
    for (size_t i = (size_t)bid_() * 512 + tid_(); i < n4; i += (size_t)nblk_() * 512) {
        const float4 a = u[i], b = v[i];
        union { h2_t h[2]; uint2 w; } ca, cb;
        ca.h[0] = (h2_t){(_Float16)a.x, (_Float16)a.y}; ca.h[1] = (h2_t){(_Float16)a.z, (_Float16)a.w};
        cb.h[0] = (h2_t){(_Float16)b.x, (_Float16)b.y}; cb.h[1] = (h2_t){(_Float16)b.z, (_Float16)b.w};
        uo[i] = ca.w; vo[i] = cb.w;
    }
}
__device__ __forceinline__ void ph_peer_gather(const Ctx& p, int l) {
    const _Float16* ut = (const _Float16*)(pws_() + WS_UT16);
    const _Float16* vt = (const _Float16*)(pws_() + WS_VT16);
    const int* pidx = (const int*)(pws_() + WS_PEI);
    const float* pgt = (const float*)(pws_() + WS_PEG);
    const bf16_t* H = (const bf16_t*)(pws_() + WS_H);
    float* x = pout_();
    const int lane = tid_() & 63;
    const bool bit5 = lane & 32, bit4 = lane & 16, bit3 = lane & 8;
    const int jmine = ((lane >> 5) & 1) * 4 + ((lane >> 4) & 1) * 2 + ((lane >> 3) & 1);
    for (int tok = gwave(); tok < MTOK; tok += nwaves()) {
        h2_t hh[2][4];
#pragma unroll
        for (int c = 0; c < 2; ++c) {
            const uint4 raw = *(const uint4*)(H + (size_t)tok * DM + c * 512 + lane * 8);
            const unsigned w[4] = {raw.x, raw.y, raw.z, raw.w};
#pragma unroll
            for (int q = 0; q < 4; ++q) hh[c][q] = (h2_t){(_Float16)__uint_as_float(w[q] << 16), (_Float16)__uint_as_float(w[q] & 0xffff0000u)};
        }
        const int e0 = pidx[(size_t)tok * 128 + lane], e1 = pidx[(size_t)tok * 128 + 64 + lane];
        const float g0 = pgt[(size_t)tok * 128 + lane], g1 = pgt[(size_t)tok * 128 + 64 + lane];
        float out[16];
#pragma unroll
        for (int i = 0; i < 16; ++i) out[i] = 0.f;
#pragma unroll 1
        for (int hb = 0; hb < 16; ++hb) {
            const int esrc = hb < 8 ? e0 : e1;
            const float gsrc = hb < 8 ? g0 : g1;
            const int lb = (hb & 7) * 8;
            uint4 ur[8][2], vr[8][2];
#pragma unroll
            for (int j = 0; j < 8; ++j) {
                const int e = __builtin_amdgcn_readlane(esrc, lb + j);
#pragma unroll
                for (int c = 0; c < 2; ++c) {
                    ur[j][c] = *(const uint4*)(ut + (size_t)e * DM + c * 512 + lane * 8);
                    vr[j][c] = *(const uint4*)(vt + (size_t)e * DM + c * 512 + lane * 8);
                }
            }
            float pd[8];
#pragma unroll
            for (int j = 0; j < 8; ++j) {
                float d = 0.f;
#pragma unroll
                for (int c = 0; c < 2; ++c) {
                    d = __builtin_amdgcn_fdot2(as_h2(ur[j][c].x), hh[c][0], d, false);
                    d = __builtin_amdgcn_fdot2(as_h2(ur[j][c].y), hh[c][1], d, false);
                    d = __builtin_amdgcn_fdot2(as_h2(ur[j][c].z), hh[c][2], d, false);
                    d = __builtin_amdgcn_fdot2(as_h2(ur[j][c].w), hh[c][3], d, false);
                }
                pd[j] = d;
            }
            float r4[4], r2[2], r1;
#pragma unroll
            for (int i = 0; i < 4; ++i) { const float mine = bit5 ? pd[i + 4] : pd[i], send = bit5 ? pd[i] : pd[i + 4]; r4[i] = mine + __shfl_xor(send, 32, 64); }
#pragma unroll
            for (int i = 0; i < 2; ++i) { const float mine = bit4 ? r4[i + 2] : r4[i], send = bit4 ? r4[i] : r4[i + 2]; r2[i] = mine + __shfl_xor(send, 16, 64); }
            { const float mine = bit3 ? r2[1] : r2[0], send = bit3 ? r2[0] : r2[1]; r1 = mine + __shfl_xor(send, 8, 64); }
            r1 += __shfl_xor(r1, 4, 64); r1 += __shfl_xor(r1, 2, 64); r1 += __shfl_xor(r1, 1, 64);
            const float gmine = __shfl(gsrc, lb + jmine, 64);
            const float coef = gmine * gelu_tanh_f(r1);
#pragma unroll
            for (int j = 0; j < 8; ++j) {
                const float cj = __uint_as_float(__builtin_amdgcn_readlane(__float_as_uint(coef), (j >> 2) * 32 + ((j >> 1) & 1) * 16 + (j & 1) * 8));
#pragma unroll
                for (int c = 0; c < 2; ++c) {
                    const unsigned w[4] = {vr[j][c].x, vr[j][c].y, vr[j][c].z, vr[j][c].w};
#pragma unroll
                    for (int q = 0; q < 4; ++q) { const h2_t vv = as_h2(w[q]); out[c * 8 + 2 * q] = __builtin_fmaf((float)vv.x, cj, out[c * 8 + 2 * q]); out[c * 8 + 2 * q + 1] = __builtin_fmaf((float)vv.y, cj, out[c * 8 + 2 * q + 1]); }
                }
            }
        }
#pragma unroll
        for (int c = 0; c < 2; ++c) {
            float4* xp = (float4*)(x + (size_t)tok * DM + c * 512 + lane * 8);
            float4 a = xp[0], b = xp[1];
            a.x += out[c * 8]; a.y += out[c * 8 + 1]; a.z += out[c * 8 + 2]; a.w += out[c * 8 + 3];
            b.x += out[c * 8 + 4]; b.y += out[c * 8 + 5]; b.z += out[c * 8 + 6]; b.w += out[c * 8 + 7];
            xp[0] = a; xp[1] = b;
        }
    }
}

__global__ void __launch_bounds__(512, 2) k_mega(Params kp) {
    float* sm = dynsmem;
    {
        unsigned long long* tab = (unsigned long long*)((char*)dynsmem + PTAB_OFF);
        if (threadIdx.x < 34) tab[threadIdx.x] = (unsigned long long)kp.in[threadIdx.x];
        if (threadIdx.x == 34) tab[34] = (unsigned long long)kp.out;
        if (threadIdx.x == 35) tab[35] = (unsigned long long)kp.ws;
        if (threadIdx.x == 36) { tab[36] = 0ull; tab[37] = 0ull; }
    }
    __syncthreads();
    Ctx p; p.dummy = 0;
    XcdBarrier bar = xcd_barrier_post((unsigned*)(pws_() + WS_BAR), (volatile LAS unsigned*)((char*)dynsmem + PTAB_OFF + 36 * 8));
    ph_weight_prep(p, sm);
    xcd_barrier(bar);
#pragma unroll 1
    for (int l = 0; l < DEPTH; ++l) {
        const float* xin = l == 0 ? pin_(0) : pout_();
        const bf16_t* H = (const bf16_t*)(pws_() + WS_H);
        ph_rmsnorm(xin, pin_(2) + (size_t)l * DM, (bf16_t*)(pws_() + WS_H), MTOK);
        ph_rmsnorm(pin_(1), pin_(22) + (size_t)l * DM, (bf16_t*)(pws_() + WS_HM), MMEM);
        xcd_barrier(bar);
        { pg8::EpiBf16 E; E.O = (bf16_t*)(pws_() + WS_P); E.ldc = LDP; ph_gemm(H, (const bf16_t*)(pws_() + WT_IN) + (size_t)l * LDP * DM, MTOK, LDP, DM, E); }
        { pg8::EpiF32 E; E.C = (float*)(pws_() + WS_KM); E.R = nullptr; E.ldc = 256; ph_gemm((const bf16_t*)(pws_() + WS_HM), (const bf16_t*)(pws_() + WT_XK) + (size_t)l * 256 * DM, MMEM, 256, DM, E); }
        { pg8::EpiF32 E; E.C = (float*)(pws_() + WS_VM); E.R = nullptr; E.ldc = 256; ph_gemm((const bf16_t*)(pws_() + WS_HM), (const bf16_t*)(pws_() + WT_XV) + (size_t)l * 256 * DM, MMEM, 256, DM, E); }
        xcd_barrier(bar);
        ph_mem_prep(p, l);
        ph_dsa_prep(p, l);
        ph_ssd_scan(p, l, sm);
        ph_gdn_scan(p, l, sm);
        ph_gla_scan(p, l, sm);
        xcd_barrier(bar);
        ph_ssd_finish(p, l);
        ph_dsa_main(p, l, sm);
        xcd_barrier(bar);
        { pg8::EpiF32 E; E.C = pout_(); E.R = xin; E.ldc = DM; ph_gemm((const bf16_t*)(pws_() + WS_Y), (const bf16_t*)(pws_() + WT_OUT) + (size_t)l * DM * DM, MTOK, DM, DM, E); }
        xcd_barrier(bar);
        ph_rmsnorm(pout_(), pin_(21) + (size_t)l * DM, (bf16_t*)(pws_() + WS_H), MTOK);
        xcd_barrier(bar);
        { pg8::EpiF32 E; E.C = (float*)(pws_() + WS_QX); E.R = nullptr; E.ldc = 256; ph_gemm(H, (const bf16_t*)(pws_() + WT_XQ) + (size_t)l * 256 * DM, MTOK, 256, DM, E); }
        xcd_barrier(bar);
        ph_xattn(p, l);
        xcd_barrier(bar);
        { pg8::EpiF32 E; E.C = pout_(); E.R = pout_(); E.ldc = DM; ph_gemm((const bf16_t*)(pws_() + WS_OX), (const bf16_t*)(pws_() + WT_XO) + (size_t)l * DM * 256, MTOK, DM, 256, E); }
        xcd_barrier(bar);
        ph_rmsnorm(pout_(), pin_(29) + (size_t)l * DM, (bf16_t*)(pws_() + WS_H), MTOK);
        ph_tab_convert(p, l);
        xcd_barrier(bar);
        { pg8::EpiF32 E; E.C = (float*)(pws_() + WS_QP); E.R = nullptr; E.ldc = DM; ph_gemm(H, (const bf16_t*)(pws_() + WT_PQ) + (size_t)l * DM * DM, MTOK, DM, DM, E); }
        xcd_barrier(bar);
        ph_peer_topk(p, l, sm);
        xcd_barrier(bar);
        ph_peer_gather(p, l);
        xcd_barrier(bar);
    }
}

extern "C" void kernel_launch(void* const* d_in, const int* in_sizes, int n_in, void* d_out, int out_size, void* d_ws, size_t ws_size, hipStream_t stream) {
    if (n_in != 34 || out_size != MTOK * DM || ws_size < WS_END) {
        fprintf(stderr, "kernel_launch: unexpected shapes (n_in %d out %d ws %zu need %zu)\n", n_in, out_size, ws_size, (size_t)WS_END);
        return;
    }
    static int grid = 0;
    if (!grid) {
        int dev = 0, cus = 0, per_cu = 0;
        (void)hipGetDevice(&dev);
        (void)hipDeviceGetAttribute(&cus, hipDeviceAttributeMultiprocessorCount, dev);
        (void)hipFuncSetAttribute((const void*)k_mega, hipFuncAttributeMaxDynamicSharedMemorySize, LDS_BYTES);
        (void)hipOccupancyMaxActiveBlocksPerMultiprocessor(&per_cu, (const void*)k_mega, 512, LDS_BYTES);
        if (per_cu < 1) fprintf(stderr, "kernel_launch: occupancy query reports %d blocks per CU\n", per_cu);
        grid = cus > 0 ? cus : 256;
    }
    Params p; memset(&p, 0, sizeof(p));
    for (int i = 0; i < 34; ++i) p.in[i] = (const float*)d_in[i];
    p.out = (float*)d_out; p.ws = (char*)d_ws;
    (void)hipMemsetAsync((char*)d_ws + WS_BAR, 0, XCD_BAR_WORDS * sizeof(unsigned), stream);
    hipLaunchKernelGGL(k_mega, dim3(grid), dim3(512), LDS_BYTES, stream, p);
}
```

```cpp
#include <hip/hip_runtime.h>
#include <stdint.h>
#include <stdio.h>
#include <string.h>

#define NB 32
#define SEQ 2048
#define DM 1024
#define MTOK (NB * SEQ)
#define DEPTH 4
#define NMEM 256
#define MMEM (NB * NMEM)
#define LDP 3328
#define NEXP 16384
#define EPS 1e-6f
#define PC_Z 0
#define PC_XBC 256
#define PC_GQKV 768
#define PC_GG 1536
#define PC_LQ 1792
#define PC_LK 1920
#define PC_LV 2048
#define PC_LR 2304
#define PC_DQ 2560
#define PC_DK 2816
#define PC_DV 2880
#define PC_IQ 2944
#define PC_IK 3200
#define PC_GLR 3232
#define PC_IW 3248
#define PC_DT 3256
#define PC_GA 3260
#define PC_GB 3264

typedef unsigned short bf16_t;

#define WS_BAR 0ull
#define WS_P 16384ull
#define SZ_P ((size_t)MTOK * LDP * 2)
#define WS_H (WS_P + SZ_P)
#define SZ_H ((size_t)MTOK * DM * 2)
#define WS_Y (WS_H + SZ_H)
#define SZ_Y ((size_t)MTOK * DM * 2)
#define WS_WP (WS_Y + SZ_Y)
#define SZ_WP ((size_t)DEPTH * DM * LDP * 4)
#define WT_IN (WS_WP)
#define WT_OUT (WT_IN + (size_t)DEPTH * LDP * DM * 2)
#define WT_XQ (WT_OUT + (size_t)DEPTH * DM * DM * 2)
#define WT_XK (WT_XQ + (size_t)DEPTH * 256 * DM * 2)
#define WT_XV (WT_XK + (size_t)DEPTH * 256 * DM * 2)
#define WT_XO (WT_XV + (size_t)DEPTH * 256 * DM * 2)
#define WT_PQ (WT_XO + (size_t)DEPTH * DM * 256 * 2)
#define WT_END (WT_PQ + (size_t)DEPTH * DM * DM * 2)
#define WS_QN (WS_WP + SZ_WP)
#define SZ_QN ((size_t)MTOK * 256 * 4)
#define WS_KN (WS_QN + SZ_QN)
#define SZ_KN ((size_t)MTOK * 64 * 4)
#define WS_IKN (WS_KN + SZ_KN)
#define SZ_IKN ((size_t)MTOK * 32 * 4)
#define WS_YPRE (WS_IKN + SZ_IKN)
#define SZ_YPRE ((size_t)MTOK * 256 * 4)
#define WS_HM (WS_YPRE + SZ_YPRE)
#define SZ_HM ((size_t)MMEM * DM * 2)
#define WS_KM (WS_HM + SZ_HM)
#define SZ_KM ((size_t)MMEM * 256 * 4)
#define WS_VM (WS_KM + SZ_KM)
#define SZ_VM ((size_t)MMEM * 256 * 4)
#define WS_KB (WS_VM + SZ_VM)
#define SZ_KB ((size_t)MMEM * 256 * 2)
#define WS_VTB (WS_KB + SZ_KB)
#define SZ_VTB ((size_t)MMEM * 256 * 2)
#define WS_VT (WS_VTB + SZ_VTB)
#define SZ_VT ((size_t)MTOK * 64 * 2)
#define WS_SKB (WS_VT + SZ_VT)
#define SZ_SKB ((size_t)DEPTH * 8 * 2 * 128 * 64 * 2)
#define WS_SC (WS_SKB + SZ_SKB)
#define SZ_SC ((size_t)MTOK * 16 * 4)
#define WS_END (WS_SC + SZ_SC)
#define WS_QX (WS_P)
#define WS_OX (WS_P + (size_t)MTOK * 256 * 4)
#define WS_QP (WS_P)
#define WS_UT16 (WS_P + 260ull * 1024 * 1024)
#define WS_VT16 (WS_UT16 + (size_t)NEXP * DM * 2)
#define WS_PEI (WS_VT16 + (size_t)NEXP * DM * 2)
#define WS_PEG (WS_PEI + (size_t)MTOK * 128 * 4)
#define WS_PEND (WS_PEG + (size_t)MTOK * 128 * 4)
static_assert(WS_PEND <= WS_P + SZ_P, "P region aliases");

struct Params {
    const float* in[34];
    float* out;
    char* ws;
};

#define XB_TMO      128
#define XB_XCNT(j)  (256  + 64 * (j))
#define XB_XSUB(j)  (1280 + 64 * (j))
#define XB_XGEN(j)  (2304 + 64 * (j))
#define XB_TOP      3328
#define XB_TOPGEN   3392
#define XCD_BAR_WORDS 3456
#define XB_SPIN_CAP (1u << 18)
#define LAS __attribute__((address_space(3)))

__device__ __forceinline__ unsigned xb_ld(unsigned* p)              { return __hip_atomic_load(p, __ATOMIC_RELAXED, __HIP_MEMORY_SCOPE_AGENT); }
__device__ __forceinline__ unsigned xb_add(unsigned* p, unsigned v) { return __hip_atomic_fetch_add(p, v, __ATOMIC_RELAXED, __HIP_MEMORY_SCOPE_AGENT); }
__device__ __forceinline__ unsigned xb_xcc_id() { return (unsigned)__builtin_amdgcn_s_getreg((3 << 11) | 20) & 0xFu; }
#define XB_SPIN(cond, bar) do { unsigned _sp = 0; while (cond) { __builtin_amdgcn_s_sleep(1); \
    if ((++_sp & 255u) == 0u) { if (xb_ld(&(bar)[XB_TMO])) break; if (_sp > XB_SPIN_CAP) { atomicAdd(&(bar)[XB_TMO], 1u); break; } } } } while (0)

struct XcdBarrier {
    unsigned* bar; unsigned x;
    volatile LAS unsigned* st;
};

__device__ __forceinline__ XcdBarrier xcd_barrier_post(unsigned* bar, volatile LAS unsigned* st) {
    XcdBarrier b; b.bar = bar; b.x = xb_xcc_id(); b.st = st;
    if (threadIdx.x == 0) (void)xb_add(&bar[XB_XCNT(b.x)], 1u);
    return b;
}
__device__ __forceinline__ void xcd_barrier_complete(unsigned* bar, unsigned x, unsigned& nloc, unsigned& nx) {
    const unsigned G = gridDim.x * gridDim.y * gridDim.z;
    unsigned sum, cnt, mine, sp = 0u;
    for (;;) {
        sum = 0u; cnt = 0u; mine = 0u;
#pragma unroll
        for (unsigned j = 0; j < 16; ++j) { const unsigned c = xb_ld(&bar[XB_XCNT(j)]); sum += c; cnt += (c > 0u) ? 1u : 0u; mine = (j == x) ? c : mine; }
        if (sum == G) break;
        __builtin_amdgcn_s_sleep(1);
        if ((++sp & 255u) == 0u) { if (xb_ld(&bar[XB_TMO])) break; if (sp > XB_SPIN_CAP) { atomicAdd(&bar[XB_TMO], 1u); break; } }
    }
    nloc = mine > 0u ? mine : 1u; nx = cnt > 0u ? cnt : 1u;
}

__device__ __forceinline__ void xcd_barrier(const XcdBarrier& b) {
    asm volatile("s_waitcnt vmcnt(0)" ::: "memory");
    __syncthreads();
    if (threadIdx.x == 0) {
        unsigned* bar = b.bar;
        __builtin_amdgcn_s_waitcnt(0);
        unsigned nloc = b.st[0], nx = b.st[1];
        if (nloc == 0u) { xcd_barrier_complete(bar, b.x, nloc, nx); b.st[0] = nloc; b.st[1] = nx; }
        const unsigned old = xb_add(&bar[XB_XSUB(b.x)], 1u);
        const unsigned gen = old / nloc;
        if (old + 1u == (gen + 1u) * nloc) {
            __builtin_amdgcn_fence(__ATOMIC_RELEASE, "agent");
            asm volatile("s_waitcnt vmcnt(0)" ::: "memory");
            const unsigned og = xb_add(&bar[XB_TOP], 1u);
            const unsigned tg = og / nx;
            if (og + 1u == (tg + 1u) * nx) xb_add(&bar[XB_TOPGEN], 1u);
            else XB_SPIN(xb_ld(&bar[XB_TOPGEN]) == tg, bar);
            __builtin_amdgcn_fence(__ATOMIC_ACQUIRE, "agent");
            xb_add(&bar[XB_XGEN(b.x)], 1u);
            asm volatile("s_waitcnt vmcnt(0)" ::: "memory");
        } else {
            XB_SPIN(xb_ld(&bar[XB_XGEN(b.x)]) == gen, bar);
            __builtin_amdgcn_fence(__ATOMIC_ACQUIRE, "agent");
            asm volatile("s_waitcnt vmcnt(0)" ::: "memory");
        }
    }
    __syncthreads();
}


#define LDS_BYTES (144 * 1024)
#define PTAB_OFF (LDS_BYTES - 1024)
extern __shared__ __attribute__((aligned(16))) float dynsmem[];
__device__ __forceinline__ unsigned long long ptab_get(int i) {
    unsigned off = PTAB_OFF; asm volatile("" : "+v"(off));
    const uint2 v = *(const uint2*)((const char*)dynsmem + off + i * 8);
    const unsigned lo = __builtin_amdgcn_readfirstlane(v.x), hi = __builtin_amdgcn_readfirstlane(v.y);
    return ((unsigned long long)hi << 32) | lo;
}
__device__ __forceinline__ const float* pin_(int i) { return (const float*)ptab_get(i); }
__device__ __forceinline__ float* pout_() { return (float*)ptab_get(34); }
__device__ __forceinline__ char* pws_() { return (char*)ptab_get(35); }
struct Ctx { int dummy; };

__device__ __forceinline__ float bf2f(bf16_t v) { return __uint_as_float(((unsigned)v) << 16); }
__device__ __forceinline__ bf16_t f2bf(float f) { unsigned u = __float_as_uint(f); u += 0x7FFFu + ((u >> 16) & 1u); return (bf16_t)(u >> 16); }
__device__ __forceinline__ float wave_sum(float v) {
#pragma unroll
    for (int o = 32; o >= 1; o >>= 1) v += __shfl_xor(v, o, 64);
    return v;
}
__device__ __forceinline__ float wave_max(float v) {
#pragma unroll
    for (int o = 32; o >= 1; o >>= 1) v = fmaxf(v, __shfl_xor(v, o, 64));
    return v;
}
__device__ __forceinline__ float silu_f(float x) { return x / (1.f + __expf(-x)); }
__device__ __forceinline__ float sigmoid_f(float x) { return 1.f / (1.f + __expf(-x)); }
__device__ __forceinline__ float softplus_f(float x) { return x > 20.f ? x : log1pf(__expf(x)); }
__device__ __forceinline__ float logsigmoid_f(float x) { return -softplus_f(-x); }
__device__ __forceinline__ float gelu_tanh_f(float x) { const float u = 0.7978845608028654f * (x + 0.044715f * x * x * x); return 0.5f * x * (1.f + tanhf(u)); }
__device__ __forceinline__ unsigned ford(float f) { f = f + 0.0f; unsigned u = __float_as_uint(f); return (u & 0x80000000u) ? ~u : (u | 0x80000000u); }
__device__ __forceinline__ float funord(unsigned k) { unsigned u = (k & 0x80000000u) ? (k & 0x7fffffffu) : ~k; return __uint_as_float(u); }
__device__ __forceinline__ unsigned long long wave_max_u64(unsigned long long v) {
#pragma unroll
    for (int o = 32; o >= 1; o >>= 1) {
        unsigned lo = __shfl_xor((unsigned)v, o, 64), hi = __shfl_xor((unsigned)(v >> 32), o, 64);
        unsigned long long w = ((unsigned long long)hi << 32) | lo;
        v = w > v ? w : v;
    }
    return v;
}
__device__ __forceinline__ int tid_() { int t = threadIdx.x; asm volatile("" : "+v"(t)); return t; }
__device__ __forceinline__ int bid_() { int b = blockIdx.x; asm volatile("" : "+s"(b)); return b; }
__device__ __forceinline__ int nblk_() { int g = gridDim.x; asm volatile("" : "+s"(g)); return g; }
__device__ __forceinline__ int gwave() { return (bid_() * 512 + tid_()) >> 6; }
__device__ __forceinline__ int nwaves() { return nblk_() * 8; }

namespace pg8 {
#define PG8_LAS __attribute__((address_space(3)))
typedef unsigned short bf16_t;
typedef short bf16x8 __attribute__((ext_vector_type(8)));
typedef float f32x4 __attribute__((ext_vector_type(4)));
typedef unsigned u32x4 __attribute__((ext_vector_type(4)));
constexpr int BM = 256, BK = 64, HALF = 128, HTB = HALF * BK * 2  , STAGE_BYTES = 8 * HTB, NXCD = 8, WGM = 8;

__host__ __device__ __forceinline__ int lds_byte(int r, int c) { const int st = (r >> 4) * 2 + (c >> 5), rr = r & 15, cc = c & 31, ob = rr * 64 + cc * 2; return st * 1024 + (ob ^ (((ob >> 9) & 1) << 5)); }
__host__ __device__ __forceinline__ void stage_rc(int b, int& R, int& C) { const int st = b / 1024, sb = b % 1024, swz = sb ^ (((sb >> 9) & 1) << 5); R = (st >> 1) * 16 + swz / 64; C = (st & 1) * 32 + (swz % 64) / 2; }
__host__ __device__ __forceinline__ int perm32(int rho) { const int n = rho >> 4, i = rho & 15; return 8 * (i >> 2) + 4 * n + (i & 3); }

struct Unit { int pm, pn; };
struct Gemm { const bf16_t* A; const bf16_t* Bt; int M, N, K; };

struct StaticOrder {
    int nM, nN, nwg, G, c;
    __host__ __device__ void init(int M, int N, int G_, int c_) { nM = M / BM; nN = N / BM; nwg = nM * nN; G = G_; c = c_; }
    __host__ __device__ bool next(int i, Unit& u) const {
        const long L = (long)i * G + c; if (L >= nwg) return false;
        int wgid = (int)L; { const int q = nwg / NXCD, r = nwg % NXCD, xcd = wgid % NXCD, off = wgid / NXCD; wgid = (xcd < r ? xcd * (q + 1) : r * (q + 1) + (xcd - r) * q) + off; }
        const int nig = WGM * nN, gid = wgid / nig, fm = gid * WGM, gsz = (nM - fm) < WGM ? (nM - fm) : WGM;
        u.pm = fm + ((wgid % nig) % gsz); u.pn = (wgid % nig) / gsz; return true;
    }
    __device__ __forceinline__ void a_ready(const Unit&) const {}
    __device__ __forceinline__ void done(const Unit&) const {}
};

__device__ __forceinline__ unsigned cvt_pk_bf16(float lo, float hi) { unsigned r; asm volatile("v_cvt_pk_bf16_f32 %0, %1, %2" : "=v"(r) : "v"(lo), "v"(hi)); return r; }
struct EpiF32 {
    static constexpr bool PERM = false, AFTER_DRAIN = false;
    float* C; const float* R; int ldc;
    __device__ __forceinline__ void operator()(const f32x4 (&acc)[2][2][4][2], const Unit& u, int wr, int wc, int fr, int fq) const {
        const int row0 = u.pm * BM + wr * 64 + fr, col0 = u.pn * BM + wc * 32 + 4 * fq;
#pragma unroll
        for (int ai = 0; ai < 2; ++ai)
#pragma unroll
            for (int m = 0; m < 4; ++m) { const size_t off = (size_t)(row0 + ai * HALF + m * 16) * ldc + col0;
#pragma unroll
                for (int bj = 0; bj < 2; ++bj)
#pragma unroll
                    for (int n = 0; n < 2; ++n) { f32x4 v = acc[ai][bj][m][n]; if (R) v += *(const f32x4*)(R + off + bj * HALF + n * 16); *(f32x4*)(C + off + bj * HALF + n * 16) = v; } }
    }
};
struct EpiBf16 {
    static constexpr bool PERM = true, AFTER_DRAIN = false;
    bf16_t* O; int ldc;
    __device__ __forceinline__ void operator()(const f32x4 (&acc)[2][2][4][2], const Unit& u, int wr, int wc, int fr, int fq) const {
        const int row0 = u.pm * BM + wr * 64 + fr, col0 = u.pn * BM + wc * 32 + 8 * fq;
#pragma unroll
        for (int ai = 0; ai < 2; ++ai)
#pragma unroll
            for (int m = 0; m < 4; ++m) { bf16_t* rowp = O + (size_t)(row0 + ai * HALF + m * 16) * ldc + col0;
#pragma unroll
                for (int bj = 0; bj < 2; ++bj) { const f32x4 v0 = acc[ai][bj][m][0], v1 = acc[ai][bj][m][1];
                    u32x4 w; w.x = cvt_pk_bf16(v0[0], v0[1]); w.y = cvt_pk_bf16(v0[2], v0[3]); w.z = cvt_pk_bf16(v1[0], v1[1]); w.w = cvt_pk_bf16(v1[2], v1[3]);
                    *(u32x4*)(rowp + bj * HALF) = w; } }
    }
};

template <class Epi, class Sched, bool STAMP = false>
__device__ __forceinline__ void gemm_phase(PG8_LAS unsigned char* lds, const Gemm g, const Sched& S, const Epi& E, unsigned long long* stamps, const int tid) {
    const int wid = __builtin_amdgcn_readfirstlane(tid >> 6), lane = tid & 63, wr = wid >> 2, wc = wid & 3, fr = lane & 15, fq = lane >> 4;
    const int K = g.K, nt = K / BK;
    int ts_lo = 0, ts_hi = 0, nts = 0; const unsigned long long rt_entry = STAMP ? (unsigned long long)wall_clock64() : 0ull;
#define PG8_STAMP() do { if (STAMP && wid == 0 && nts < 64) { const unsigned long long _c = (unsigned long long)clock64(); \
        ts_lo = (lane == nts) ? (int)(unsigned)_c : ts_lo; ts_hi = (lane == nts) ? (int)(unsigned)(_c >> 32) : ts_hi; ++nts; } } while (0)
    PG8_STAMP();
    unsigned voffA[2], voffB[2];
#pragma unroll
    for (int i = 0; i < 2; ++i) { int R, C; stage_rc(tid * 16 + i * 8192, R, C); const int Rb = Epi::PERM ? ((R & ~31) + perm32(R & 31)) : R;
        voffA[i] = (unsigned)(R * K + C) * 2u; voffB[i] = (unsigned)(Rb * K + C) * 2u; }
    const size_t kstep = (size_t)(BK * 2);
    const size_t hstep = (size_t)HALF * K * 2;
    const size_t tstep = 2 * hstep;
    const unsigned ldsw = (unsigned)wid * 1024u;
    const int aoff = lds_byte(wr * 64 + fr, fq * 8), boff = lds_byte(wc * 32 + fr, fq * 8);
#define PG8_SA(b, h) (((b) * 2 + (h)) * HTB)
#define PG8_SB(b, h) ((4 + (b) * 2 + (h)) * HTB)
#define PG8_STAGE(bufoff, gbase, voff) do { _Pragma("unroll") for (int _i = 0; _i < 2; ++_i) \
        __builtin_amdgcn_global_load_lds((const unsigned*)((const char*)(gbase) + (voff)[_i]), (PG8_LAS unsigned*)(lds + (bufoff) + ldsw + _i * 8192), 16, 0, 0); } while (0)
#define PG8_LDA(dst, b, h) do { _Pragma("unroll") for (int m = 0; m < 4; ++m) _Pragma("unroll") for (int k = 0; k < 2; ++k) dst[m][k] = *(const PG8_LAS bf16x8*)(lds + PG8_SA(b, h) + aoff + m * 2048 + k * 1024); } while (0)
#define PG8_LDB(dst, b, h) do { _Pragma("unroll") for (int n = 0; n < 2; ++n) _Pragma("unroll") for (int k = 0; k < 2; ++k) dst[n][k] = *(const PG8_LAS bf16x8*)(lds + PG8_SB(b, h) + boff + n * 2048 + k * 1024); } while (0)
#define PG8_MMA(ai, bj, At, Bt) do { __builtin_amdgcn_s_setprio(1); _Pragma("unroll") for (int m = 0; m < 4; ++m) _Pragma("unroll") for (int n = 0; n < 2; ++n) _Pragma("unroll") for (int k = 0; k < 2; ++k) \
        acc[ai][bj][m][n] = __builtin_amdgcn_mfma_f32_16x16x32_bf16(Bt[n][k], At[m][k], acc[ai][bj][m][n], 0, 0, 0); __builtin_amdgcn_s_setprio(0); } while (0)
#define PG8_WAIT_V(n) asm volatile("s_waitcnt vmcnt(" #n ")" ::: "memory")
#define PG8_WAIT_L(n) asm volatile("s_waitcnt lgkmcnt(" #n ")" ::: "memory")
#define PG8_BAR __builtin_amdgcn_s_barrier()
#define PG8_SCHED __builtin_amdgcn_sched_barrier(0)
    Unit cur, nxt; int ui = 0;
    if (!S.next(0, cur)) return;
    f32x4 acc[2][2][4][2];
#pragma unroll
    for (int a = 0; a < 2; ++a)
#pragma unroll
        for (int b = 0; b < 2; ++b)
#pragma unroll
            for (int m = 0; m < 4; ++m)
#pragma unroll
                for (int n = 0; n < 2; ++n) acc[a][b][m][n] = (f32x4){0.f, 0.f, 0.f, 0.f};
    bf16x8 At[4][2], B0[2][2], B1[2][2];
    const char* cA = (const char*)g.A + (size_t)cur.pm * tstep; const char* cB = (const char*)g.Bt + (size_t)cur.pn * tstep;
    S.a_ready(cur);
    PG8_STAGE(PG8_SB(0, 0), cB, voffB); PG8_STAGE(PG8_SA(0, 0), cA, voffA); PG8_STAGE(PG8_SB(0, 1), cB + hstep, voffB); PG8_STAGE(PG8_SA(0, 1), cA + hstep, voffA);
    if (wr == 1) PG8_BAR;
    PG8_WAIT_V(4); PG8_BAR;
    PG8_STAGE(PG8_SB(1, 0), cB + kstep, voffB); PG8_STAGE(PG8_SA(1, 0), cA + kstep, voffA); PG8_STAGE(PG8_SB(1, 1), cB + hstep + kstep, voffB);
    PG8_WAIT_V(6); PG8_BAR;
    PG8_STAMP();
    for (;;) {
        const bool has_next = S.next(ui + 1, nxt);
        const char* nA = has_next ? (const char*)g.A + (size_t)nxt.pm * tstep : cA; const char* nB = has_next ? (const char*)g.Bt + (size_t)nxt.pn * tstep : cB;
        for (int t = 0; t < nt; t += 2) {
            const bool last = (t == nt - 2);
            const char* a1 = cA + (size_t)(t + 1) * kstep;
            const char* a2 = last ? nA : cA + (size_t)(t + 2) * kstep; const char* b2 = last ? nB : cB + (size_t)(t + 2) * kstep;
            const char* a3 = a2 + kstep; const char* b3 = b2 + kstep;
            if (last && has_next) S.a_ready(nxt);
            PG8_LDB(B0, 0, 0); PG8_SCHED; PG8_LDA(At, 0, 0); PG8_STAGE(PG8_SA(1, 1), a1 + hstep, voffA);
            PG8_WAIT_L(8); PG8_BAR; PG8_WAIT_L(0); PG8_MMA(0, 0, At, B0); PG8_BAR; PG8_SCHED;
            PG8_LDB(B1, 0, 1); PG8_STAGE(PG8_SB(0, 0), b2, voffB);
            PG8_BAR; PG8_WAIT_L(0); PG8_MMA(0, 1, At, B1); PG8_BAR;
            PG8_LDA(At, 0, 1); PG8_STAGE(PG8_SA(0, 0), a2, voffA);
            PG8_BAR; PG8_WAIT_L(0); PG8_MMA(1, 0, At, B0); PG8_BAR; PG8_SCHED;
            PG8_STAGE(PG8_SB(0, 1), b2 + hstep, voffB);
            PG8_WAIT_V(6); PG8_BAR; PG8_MMA(1, 1, At, B1); PG8_BAR;
            PG8_LDB(B0, 1, 0); PG8_SCHED; PG8_LDA(At, 1, 0); PG8_STAGE(PG8_SA(0, 1), a2 + hstep, voffA);
            PG8_WAIT_L(8); PG8_BAR; PG8_WAIT_L(0); PG8_MMA(0, 0, At, B0); PG8_BAR; PG8_SCHED;
            PG8_LDB(B1, 1, 1); PG8_STAGE(PG8_SB(1, 0), b3, voffB);
            PG8_BAR; PG8_WAIT_L(0); PG8_MMA(0, 1, At, B1); PG8_BAR;
            PG8_LDA(At, 1, 1); PG8_STAGE(PG8_SA(1, 0), a3, voffA);
            PG8_BAR; PG8_WAIT_L(0); PG8_MMA(1, 0, At, B0); PG8_BAR; PG8_SCHED;
            PG8_STAGE(PG8_SB(1, 1), b3 + hstep, voffB);
            PG8_WAIT_V(6); PG8_BAR; PG8_MMA(1, 1, At, B1); PG8_BAR;
        }
        PG8_STAMP();
        if constexpr (!Epi::AFTER_DRAIN) { E(acc, cur, wr, wc, fr, fq); S.done(cur); }
        PG8_STAMP();
        if (!has_next) break;
#pragma unroll
        for (int a = 0; a < 2; ++a)
#pragma unroll
            for (int b = 0; b < 2; ++b)
#pragma unroll
                for (int m = 0; m < 4; ++m)
#pragma unroll
                    for (int n = 0; n < 2; ++n) acc[a][b][m][n] = (f32x4){0.f, 0.f, 0.f, 0.f};
        cur = nxt; cA = nA; cB = nB; ++ui;
    }
    PG8_WAIT_V(0);
    if (wr == 0) PG8_BAR;
    PG8_BAR;
    if constexpr (Epi::AFTER_DRAIN) { E.fused(acc, cur, wr, wc, fr, fq, lds, wid, lane); S.done(cur); }
    PG8_STAMP();
    if (STAMP && wid == 0) { stamps[lane] = lane < nts ? (((unsigned long long)(unsigned)ts_hi << 32) | (unsigned)ts_lo) : 0ull;
        if (lane == 62) stamps[62] = rt_entry; if (lane == 63) stamps[63] = (unsigned long long)wall_clock64(); }
#undef PG8_STAMP
#undef PG8_SA
#undef PG8_SB
#undef PG8_STAGE
#undef PG8_LDA
#undef PG8_LDB
#undef PG8_MMA
#undef PG8_WAIT_V
#undef PG8_WAIT_L
#undef PG8_BAR
#undef PG8_SCHED
}
}

template <class Epi> __device__ __forceinline__ void ph_gemm(const bf16_t* A, const bf16_t* Bt, int M, int N, int K, const Epi& E) {
    pg8::Gemm g; g.A = A; g.Bt = Bt; g.M = M; g.N = N; g.K = K;
    pg8::StaticOrder S; S.init(M, N, nblk_(), bid_());
    pg8::gemm_phase<Epi, pg8::StaticOrder, false>((PG8_LAS unsigned char*)dynsmem, g, S, E, nullptr, tid_());
}

__device__ __forceinline__ int pcol_to_orig(int c) {
    if (c < 768) return c;
    if (c < 1536) return c - 768 + 772;
    if (c < 1792) return c - 1536 + 1548;
    if (c < 1920) return c - 1792 + 1804;
    if (c < 2048) return c - 1920 + 1932;
    if (c < 2304) return c - 2048 + 2060;
    if (c < 2560) return c - 2304 + 2332;
    if (c < 2816) return c - 2560 + 2588;
    if (c < 2880) return c - 2816 + 2844;
    if (c < 2944) return c - 2880 + 2908;
    if (c < 3200) return c - 2944 + 2972;
    if (c < 3232) return c - 3200 + 3228;
    if (c < 3248) return c - 3232 + 2316;
    if (c < 3256) return c - 3248 + 3260;
    if (c < 3260) return c - 3256 + 768;
    if (c < 3264) return c - 3260 + 1540;
    if (c < 3268) return c - 3264 + 1544;
    return -1;
}
__device__ __forceinline__ void wtrans_job(const float* W, int K, int ldw, bf16_t* Wt, int Npad, bool mapped, float* tile) {
    const int tid = tid_();
    const int tn = Npad / 64, tk = K / 64;
    for (int t = bid_(); t < tn * tk; t += nblk_()) {
        const int n0 = (t / tk) * 64, k0 = (t % tk) * 64;
        __syncthreads();
        for (int idx = tid; idx < 4096; idx += 512) {
            const int kk = idx >> 6, nn = idx & 63;
            const int col = mapped ? pcol_to_orig(n0 + nn) : (n0 + nn);
            tile[kk * 65 + nn] = col >= 0 ? W[(size_t)(k0 + kk) * ldw + col] : 0.f;
        }
        __syncthreads();
        for (int idx = tid; idx < 4096; idx += 512) {
            const int nn = idx >> 6, kk = idx & 63;
            Wt[(size_t)(n0 + nn) * K + k0 + kk] = f2bf(tile[kk * 65 + nn]);
        }
    }
}
__device__ __forceinline__ void ph_weight_prep(const Ctx& p, float* sm) {
#pragma unroll 1
    for (int j = 0; j < 7 * DEPTH; ++j) {
        const int l = j / 7, w = j % 7;
        const float* W; int K, ldw, Npad; bf16_t* Wt; bool mapped = false;
        if (w == 0) { W = pin_(3) + (size_t)l * DM * 3268; K = DM; ldw = 3268; Npad = LDP; Wt = (bf16_t*)(pws_() + WT_IN) + (size_t)l * LDP * DM; mapped = true; }
        else if (w == 1) { W = pin_(20) + (size_t)l * DM * DM; K = DM; ldw = DM; Npad = DM; Wt = (bf16_t*)(pws_() + WT_OUT) + (size_t)l * DM * DM; }
        else if (w == 2) { W = pin_(23) + (size_t)l * DM * 256; K = DM; ldw = 256; Npad = 256; Wt = (bf16_t*)(pws_() + WT_XQ) + (size_t)l * 256 * DM; }
        else if (w == 3) { W = pin_(24) + (size_t)l * DM * 256; K = DM; ldw = 256; Npad = 256; Wt = (bf16_t*)(pws_() + WT_XK) + (size_t)l * 256 * DM; }
        else if (w == 4) { W = pin_(25) + (size_t)l * DM * 256; K = DM; ldw = 256; Npad = 256; Wt = (bf16_t*)(pws_() + WT_XV) + (size_t)l * 256 * DM; }
        else if (w == 5) { W = pin_(26) + (size_t)l * 256 * DM; K = 256; ldw = DM; Npad = DM; Wt = (bf16_t*)(pws_() + WT_XO) + (size_t)l * DM * 256; }
        else { W = pin_(30) + (size_t)l * DM * DM; K = DM; ldw = DM; Npad = DM; Wt = (bf16_t*)(pws_() + WT_PQ) + (size_t)l * DM * DM; }
        wtrans_job(W, K, ldw, Wt, Npad, mapped, sm);
    }
}

__device__ __forceinline__ void ph_rmsnorm(const float* __restrict__ x, const float* __restrict__ g, bf16_t* __restrict__ out, int rows) {
    const int lane = tid_() & 63;
    for (int r = gwave(); r < rows; r += nwaves()) {
        const float4* xr = (const float4*)(x + (size_t)r * DM);
        float4 v[4]; float ss = 0.f;
#pragma unroll
        for (int i = 0; i < 4; ++i) { v[i] = xr[lane + 64 * i]; ss += v[i].x * v[i].x + v[i].y * v[i].y + v[i].z * v[i].z + v[i].w * v[i].w; }
        ss = wave_sum(ss);
        const float rs = rsqrtf(ss * (1.f / DM) + EPS);
#pragma unroll
        for (int i = 0; i < 4; ++i) {
            const float4 gg = ((const float4*)g)[lane + 64 * i];
            ushort4 o; o.x = f2bf(v[i].x * rs * gg.x); o.y = f2bf(v[i].y * rs * gg.y); o.z = f2bf(v[i].z * rs * gg.z); o.w = f2bf(v[i].w * rs * gg.w);
            *(ushort4*)(out + (size_t)r * DM + (size_t)(lane + 64 * i) * 4) = o;
        }
    }
}

template <int OUTMODE>
__device__ __forceinline__ void ph_sgemm(const bf16_t* __restrict__ A, int lda, const float* __restrict__ B, int ldb, void* Cv, int ldc, const float* R, int ldr,
                         int M, int N, int K, float* smem) {
    float* As = smem;
    float* Bs = smem + 16 * 132;
    const int tid = tid_(), tx = tid & 31, ty = tid >> 5;
    const int ntn = N / 128, ntiles = (M / 128) * ntn;
    for (int tile = bid_(); tile < ntiles; tile += nblk_()) {
        const int tm = tile / ntn, tn = tile % ntn;
        float acc[8][4];
#pragma unroll
        for (int i = 0; i < 8; ++i)
#pragma unroll
            for (int j = 0; j < 4; ++j) acc[i][j] = 0.f;
        const int arow = tid >> 2, akq = (tid & 3) * 4;
        const int bk = tid >> 5, bn = (tid & 31) * 4;
        for (int k0 = 0; k0 < K; k0 += 16) {
            const ushort4 av = *(const ushort4*)(A + (size_t)(tm * 128 + arow) * lda + k0 + akq);
            const float4 bv = *(const float4*)(B + (size_t)(k0 + bk) * ldb + tn * 128 + bn);
            __syncthreads();
            As[(akq + 0) * 132 + arow] = bf2f(av.x); As[(akq + 1) * 132 + arow] = bf2f(av.y);
            As[(akq + 2) * 132 + arow] = bf2f(av.z); As[(akq + 3) * 132 + arow] = bf2f(av.w);
            *(float4*)(Bs + bk * 132 + bn) = bv;
            __syncthreads();
#pragma unroll
            for (int k = 0; k < 16; ++k) {
                const float4 a0 = *(const float4*)(As + k * 132 + ty * 8), a1 = *(const float4*)(As + k * 132 + ty * 8 + 4);
                const float4 b = *(const float4*)(Bs + k * 132 + tx * 4);
                const float a[8] = {a0.x, a0.y, a0.z, a0.w, a1.x, a1.y, a1.z, a1.w};
#pragma unroll
                for (int i = 0; i < 8; ++i) { acc[i][0] += a[i] * b.x; acc[i][1] += a[i] * b.y; acc[i][2] += a[i] * b.z; acc[i][3] += a[i] * b.w; }
            }
        }
#pragma unroll
        for (int i = 0; i < 8; ++i) {
            const size_t row = (size_t)tm * 128 + ty * 8 + i; const int col = tn * 128 + tx * 4;
            if (OUTMODE == 0) {
                ushort4 o; o.x = f2bf(acc[i][0]); o.y = f2bf(acc[i][1]); o.z = f2bf(acc[i][2]); o.w = f2bf(acc[i][3]);
                *(ushort4*)((bf16_t*)Cv + row * ldc + col) = o;
            } else if (OUTMODE == 1) {
                *(float4*)((float*)Cv + row * ldc + col) = make_float4(acc[i][0], acc[i][1], acc[i][2], acc[i][3]);
            } else {
                const float4 r = *(const float4*)(R + row * ldr + col);
                *(float4*)((float*)Cv + row * ldc + col) = make_float4(r.x + acc[i][0], r.y + acc[i][1], r.z + acc[i][2], r.w + acc[i][3]);
            }
        }
    }
}

#define WS_HS WS_H
#define WS_VG WS_YPRE
#define WS_DEC (WS_YPRE + (size_t)MTOK * 256 * 2)

__device__ __forceinline__ float quad_sum(float v) {
    v += __int_as_float(__builtin_amdgcn_mov_dpp(__float_as_int(v), 0xB1, 0xF, 0xF, true));
    v += __int_as_float(__builtin_amdgcn_mov_dpp(__float_as_int(v), 0x4E, 0xF, 0xF, true));
    return v;
}
__device__ __forceinline__ float bflo(unsigned w) { return __uint_as_float(w << 16); }
__device__ __forceinline__ float bfhi(unsigned w) { return __uint_as_float(w & 0xffff0000u); }

__device__ __forceinline__ void ph_scan_prep(const Ctx& p, int l) {
    const bf16_t* P = (const bf16_t*)(pws_() + WS_P);
    bf16_t* HS = (bf16_t*)(pws_() + WS_HS);
    bf16_t* VG = (bf16_t*)(pws_() + WS_VG);
    float* DEC = (float*)(pws_() + WS_DEC);
    float* SC = (float*)(pws_() + WS_SC);
    const float* scw = pin_(4) + (size_t)l * 4 * 512;
    const float* scb = pin_(5) + (size_t)l * 512;
    const float* gcw = pin_(10) + (size_t)l * 4 * 768;
    const float* wg = pin_(14) + (size_t)l * 16 * 128;
    const float* bg = pin_(15) + (size_t)l * 128;
    const int lane = tid_() & 63;
    for (int tok = gwave(); tok < MTOK; tok += nwaves()) {
        const int t = tok % SEQ;
        const size_t row = (size_t)tok * LDP;
#pragma unroll
        for (int i = 0; i < 8; ++i) {
            const int cc = lane + 64 * i;
            float acc = scb[cc];
#pragma unroll
            for (int j = 0; j < 4; ++j) if (t - 3 + j >= 0) acc += scw[j * 512 + cc] * bf2f(P[row + (size_t)(j - 3) * LDP + PC_XBC + cc]);
            HS[(size_t)tok * 1024 + cc] = f2bf(silu_f(acc));
        }
#pragma unroll
        for (int i = 0; i < 12; ++i) {
            const int cc = lane + 64 * i;
            float acc = 0.f;
#pragma unroll
            for (int j = 0; j < 4; ++j) if (t - 3 + j >= 0) acc += gcw[j * 768 + cc] * bf2f(P[row + (size_t)(j - 3) * LDP + PC_GQKV + cc]);
            float v = silu_f(acc);
            if (i < 8) {
                const float ss = wave_sum(v * v);
                v *= rsqrtf(ss + EPS) * (i < 4 ? 0.125f : 1.f);
                HS[(size_t)tok * 1024 + 512 + cc] = f2bf(v);
            } else {
                VG[(size_t)tok * 256 + (cc - 512)] = f2bf(v);
            }
        }
        if (lane < 16) {
            const int h = lane & 3, which = lane >> 2;
            float v;
            if (which < 2) {
                const float dt = softplus_f(bf2f(P[row + PC_DT + h]) + pin_(6)[l * 4 + h]);
                v = which == 0 ? dt : __expf(-dt * __expf(pin_(7)[l * 4 + h]));
            } else if (which == 2) {
                v = __expf(-__expf(pin_(11)[l * 4 + h]) * softplus_f(bf2f(P[row + PC_GA + h]) + pin_(12)[l * 4 + h]));
            } else {
                v = sigmoid_f(bf2f(P[row + PC_GB + h]));
            }
            SC[(size_t)tok * 16 + lane] = v;
        }
#pragma unroll
        for (int i = 0; i < 2; ++i) {
            const int c = lane + 64 * i;
            float acc = bg[c];
#pragma unroll
            for (int r = 0; r < 16; ++r) acc += bf2f(P[row + PC_GLR + r]) * wg[r * 128 + c];
            DEC[(size_t)tok * 128 + c] = __expf(logsigmoid_f(acc) * (1.f / 16.f));
        }
    }
}

struct SsdOps { uint4 b0, b1, c0, c1; float x, dt, dA; };
struct GdnOps { uint4 k0, k1, q0, q1; float v, al, be; };
struct GlaOps { float4 d0, d1; uint4 k, q; float v; };

__device__ __forceinline__ void ph_scans(const Ctx& p, int l) {
    const bf16_t* P = (const bf16_t*)(pws_() + WS_P);
    const bf16_t* HS = (const bf16_t*)(pws_() + WS_HS);
    const bf16_t* VG = (const bf16_t*)(pws_() + WS_VG);
    const float* DEC = (const float*)(pws_() + WS_DEC);
    const float* SC = (const float*)(pws_() + WS_SC);
    bf16_t* Y = (bf16_t*)(pws_() + WS_Y);
    const int tid = tid_(), lane = tid & 63, wave = tid >> 6;
    const int gw = wave * nblk_() + bid_();
    const int role = gw / 512, idx = gw % 512;
    if (nblk_() != 256 || role > 2) return;
    const int bh = idx >> 2, quarter = idx & 3, b = bh >> 2, h = bh & 3;
    const int col = quarter * 16 + (lane >> 2), sq = lane & 3;
    const size_t tb = (size_t)b * SEQ;
    if (role == 0) {
        const int g = h >> 1;
        const float Dh = pin_(8)[l * 4 + h];
        float st[16];
#pragma unroll
        for (int i = 0; i < 16; ++i) st[i] = 0.f;
        auto ld = [&](SsdOps& o, int t) {
            const size_t tok = tb + t;
            const bf16_t* hr = HS + tok * 1024;
            o.b0 = *(const uint4*)(hr + 256 + g * 64 + sq * 16); o.b1 = *(const uint4*)(hr + 256 + g * 64 + sq * 16 + 8);
            o.c0 = *(const uint4*)(hr + 384 + g * 64 + sq * 16); o.c1 = *(const uint4*)(hr + 384 + g * 64 + sq * 16 + 8);
            o.x = bf2f(hr[h * 64 + col]); o.dt = SC[tok * 16 + h]; o.dA = SC[tok * 16 + 4 + h];
        };
        auto step = [&](const SsdOps& o, int t) {
            const unsigned bw[8] = {o.b0.x, o.b0.y, o.b0.z, o.b0.w, o.b1.x, o.b1.y, o.b1.z, o.b1.w};
            const unsigned cw[8] = {o.c0.x, o.c0.y, o.c0.z, o.c0.w, o.c1.x, o.c1.y, o.c1.z, o.c1.w};
            const float xdt = o.x * o.dt;
            float y0 = 0.f, y1 = 0.f;
#pragma unroll
            for (int i = 0; i < 8; ++i) {
                st[2 * i] = __builtin_fmaf(st[2 * i], o.dA, xdt * bflo(bw[i]));
                st[2 * i + 1] = __builtin_fmaf(st[2 * i + 1], o.dA, xdt * bfhi(bw[i]));
                y0 = __builtin_fmaf(bflo(cw[i]), st[2 * i], y0);
                y1 = __builtin_fmaf(bfhi(cw[i]), st[2 * i + 1], y1);
            }
            const float y = quad_sum(y0 + y1);
            if (sq == 0) Y[(tb + t) * DM + h * 64 + col] = f2bf(y + Dh * o.x);
        };
        SsdOps A[4], B4[4];
#pragma unroll
        for (int i = 0; i < 4; ++i) ld(A[i], i);
        for (int t = 0; t < SEQ; t += 8) {
#pragma unroll
            for (int i = 0; i < 4; ++i) ld(B4[i], t + 4 + i);
#pragma unroll
            for (int i = 0; i < 4; ++i) step(A[i], t + i);
            if (t + 8 < SEQ) {
#pragma unroll
                for (int i = 0; i < 4; ++i) ld(A[i], t + 8 + i);
            }
#pragma unroll
            for (int i = 0; i < 4; ++i) step(B4[i], t + 4 + i);
        }
    } else if (role == 1) {
        float S[16];
#pragma unroll
        for (int i = 0; i < 16; ++i) S[i] = 0.f;
        auto ld = [&](GdnOps& o, int t) {
            const size_t tok = tb + t;
            const bf16_t* hr = HS + tok * 1024;
            o.q0 = *(const uint4*)(hr + 512 + h * 64 + sq * 16); o.q1 = *(const uint4*)(hr + 512 + h * 64 + sq * 16 + 8);
            o.k0 = *(const uint4*)(hr + 768 + h * 64 + sq * 16); o.k1 = *(const uint4*)(hr + 768 + h * 64 + sq * 16 + 8);
            o.v = bf2f(VG[tok * 256 + h * 64 + col]); o.al = SC[tok * 16 + 8 + h]; o.be = SC[tok * 16 + 12 + h];
        };
        auto step = [&](const GdnOps& o, int t) {
            const unsigned kw[8] = {o.k0.x, o.k0.y, o.k0.z, o.k0.w, o.k1.x, o.k1.y, o.k1.z, o.k1.w};
            const unsigned qw[8] = {o.q0.x, o.q0.y, o.q0.z, o.q0.w, o.q1.x, o.q1.y, o.q1.z, o.q1.w};
            float r0 = 0.f, r1 = 0.f;
#pragma unroll
            for (int i = 0; i < 8; ++i) {
                S[2 * i] *= o.al; S[2 * i + 1] *= o.al;
                r0 = __builtin_fmaf(S[2 * i], bflo(kw[i]), r0);
                r1 = __builtin_fmaf(S[2 * i + 1], bfhi(kw[i]), r1);
            }
            const float r = quad_sum(r0 + r1);
            const float vn = o.be * (o.v - r);
            float o0 = 0.f, o1 = 0.f;
#pragma unroll
            for (int i = 0; i < 8; ++i) {
                S[2 * i] = __builtin_fmaf(bflo(kw[i]), vn, S[2 * i]);
                S[2 * i + 1] = __builtin_fmaf(bfhi(kw[i]), vn, S[2 * i + 1]);
                o0 = __builtin_fmaf(S[2 * i], bflo(qw[i]), o0);
                o1 = __builtin_fmaf(S[2 * i + 1], bfhi(qw[i]), o1);
            }
            const float ov = quad_sum(o0 + o1);
            if (sq == 0) Y[(tb + t) * DM + 256 + h * 64 + col] = f2bf(ov);
        };
        GdnOps A[4], B4[4];
#pragma unroll
        for (int i = 0; i < 4; ++i) ld(A[i], i);
        for (int t = 0; t < SEQ; t += 8) {
#pragma unroll
            for (int i = 0; i < 4; ++i) ld(B4[i], t + 4 + i);
#pragma unroll
            for (int i = 0; i < 4; ++i) step(A[i], t + i);
            if (t + 8 < SEQ) {
#pragma unroll
                for (int i = 0; i < 4; ++i) ld(A[i], t + 8 + i);
            }
#pragma unroll
            for (int i = 0; i < 4; ++i) step(B4[i], t + 4 + i);
        }
    } else {
        float S[8];
#pragma unroll
        for (int i = 0; i < 8; ++i) S[i] = 0.f;
        auto ld = [&](GlaOps& o, int t) {
            const size_t tok = tb + t;
            const float* dr = DEC + tok * 128 + h * 32 + sq * 8;
            o.d0 = *(const float4*)dr; o.d1 = *(const float4*)(dr + 4);
            o.k = *(const uint4*)(P + tok * LDP + PC_LK + h * 32 + sq * 8);
            o.q = *(const uint4*)(P + tok * LDP + PC_LQ + h * 32 + sq * 8);
            o.v = bf2f(P[tok * LDP + PC_LV + h * 64 + col]);
        };
        auto step = [&](const GlaOps& o, int t) {
            const unsigned kw[4] = {o.k.x, o.k.y, o.k.z, o.k.w}, qw[4] = {o.q.x, o.q.y, o.q.z, o.q.w};
            const float dd[8] = {o.d0.x, o.d0.y, o.d0.z, o.d0.w, o.d1.x, o.d1.y, o.d1.z, o.d1.w};
            float o0 = 0.f, o1 = 0.f;
#pragma unroll
            for (int i = 0; i < 4; ++i) {
                S[2 * i] = __builtin_fmaf(dd[2 * i], S[2 * i], bflo(kw[i]) * o.v);
                S[2 * i + 1] = __builtin_fmaf(dd[2 * i + 1], S[2 * i + 1], bfhi(kw[i]) * o.v);
                o0 = __builtin_fmaf(S[2 * i], bflo(qw[i]), o0);
                o1 = __builtin_fmaf(S[2 * i + 1], bfhi(qw[i]), o1);
            }
            const float ov = quad_sum(o0 + o1);
            if (sq == 0) Y[(tb + t) * DM + 512 + h * 64 + col] = f2bf(ov * 0.17677669529663687f);
        };
        GlaOps A[4], B4[4];
#pragma unroll
        for (int i = 0; i < 4; ++i) ld(A[i], i);
        for (int t = 0; t < SEQ; t += 8) {
#pragma unroll
            for (int i = 0; i < 4; ++i) ld(B4[i], t + 4 + i);
#pragma unroll
            for (int i = 0; i < 4; ++i) step(A[i], t + i);
            if (t + 8 < SEQ) {
#pragma unroll
                for (int i = 0; i < 4; ++i) ld(A[i], t + 8 + i);
            }
#pragma unroll
            for (int i = 0; i < 4; ++i) step(B4[i], t + 4 + i);
        }
    }
}

__device__ __forceinline__ void ph_mixer_finish(const Ctx& p, int l) {
    const bf16_t* P = (const bf16_t*)(pws_() + WS_P);
    bf16_t* Y = (bf16_t*)(pws_() + WS_Y);
    const float* sn = pin_(9) + (size_t)l * 256;
    const float* gn = pin_(13) + (size_t)l * 64;
    const float* ln = pin_(16) + (size_t)l * 64;
    const int lane = tid_() & 63;
    for (int tok = gwave(); tok < MTOK; tok += nwaves()) {
        const size_t row = (size_t)tok * LDP;
        {
            float v[4]; float ss = 0.f;
#pragma unroll
            for (int i = 0; i < 4; ++i) { const int c = lane + 64 * i; v[i] = bf2f(Y[(size_t)tok * DM + c]) * silu_f(bf2f(P[row + PC_Z + c])); ss += v[i] * v[i]; }
            ss = wave_sum(ss);
            const float rs = rsqrtf(ss * (1.f / 256.f) + EPS);
#pragma unroll
            for (int i = 0; i < 4; ++i) { const int c = lane + 64 * i; Y[(size_t)tok * DM + c] = f2bf(v[i] * rs * sn[c]); }
        }
#pragma unroll
        for (int h = 0; h < 4; ++h) {
            const float v = bf2f(Y[(size_t)tok * DM + 256 + h * 64 + lane]);
            const float ss = wave_sum(v * v);
            Y[(size_t)tok * DM + 256 + h * 64 + lane] = f2bf(v * rsqrtf(ss * (1.f / 64.f) + EPS) * gn[lane] * silu_f(bf2f(P[row + PC_GG + h * 64 + lane])));
        }
#pragma unroll
        for (int h = 0; h < 4; ++h) {
            const float v = bf2f(Y[(size_t)tok * DM + 512 + h * 64 + lane]);
            const float ss = wave_sum(v * v);
            Y[(size_t)tok * DM + 512 + h * 64 + lane] = f2bf(v * rsqrtf(ss * (1.f / 64.f) + EPS) * ln[lane] * silu_f(bf2f(P[row + PC_LR + h * 64 + lane])));
        }
    }
}

typedef short bf16x8_t __attribute__((ext_vector_type(8)));
typedef float f32x4_t __attribute__((ext_vector_type(4)));
__device__ __forceinline__ unsigned pk_bf16(float lo, float hi) { return (unsigned)f2bf(lo) | ((unsigned)f2bf(hi) << 16); }
union BF8 { bf16x8_t v; uint4 u; unsigned w[4]; };


__device__ __forceinline__ void ph_dsa_prep(const Ctx& p, int l) {
    const bf16_t* P = (const bf16_t*)(pws_() + WS_P);
    bf16_t* qn = (bf16_t*)(pws_() + WS_QN);
    bf16_t* kn = (bf16_t*)(pws_() + WS_KN);
    bf16_t* ikn = (bf16_t*)(pws_() + WS_IKN);
    bf16_t* vt = (bf16_t*)(pws_() + WS_VT);
    const float* qg = pin_(17) + (size_t)l * 64;
    const float* kg = pin_(18) + (size_t)l * 64;
    const float* ig = pin_(19) + (size_t)l * 32;
    const int lane = tid_() & 63;
    for (int tok = gwave(); tok < MTOK; tok += nwaves()) {
        const size_t row = (size_t)tok * LDP;
        const int b = tok / SEQ, t = tok % SEQ;
#pragma unroll
        for (int h = 0; h < 4; ++h) {
            const float v = bf2f(P[row + PC_DQ + h * 64 + lane]);
            const float ss = wave_sum(v * v);
            qn[(size_t)tok * 256 + h * 64 + lane] = f2bf(v * rsqrtf(ss * (1.f / 64.f) + EPS) * qg[lane] * 0.125f);
        }
        {
            const float v = bf2f(P[row + PC_DK + lane]);
            const float ss = wave_sum(v * v);
            kn[(size_t)tok * 64 + lane] = f2bf(v * rsqrtf(ss * (1.f / 64.f) + EPS) * kg[lane]);
        }
        {
            const float v = lane < 32 ? bf2f(P[row + PC_IK + lane]) : 0.f;
            const float ss = wave_sum(v * v);
            if (lane < 32) ikn[(size_t)tok * 32 + lane] = f2bf(v * rsqrtf(ss * (1.f / 32.f) + EPS) * ig[lane]);
        }
        vt[((size_t)b * 64 + lane) * SEQ + t] = P[row + PC_DV + lane];
    }
}

#define DSA_STRIDE 2052
__device__ __forceinline__ void ph_dsa_main(const Ctx& p, int l, float* smem) {
    const bf16_t* P = (const bf16_t*)(pws_() + WS_P);
    bf16_t* Y = (bf16_t*)(pws_() + WS_Y);
    const bf16_t* QN = (const bf16_t*)(pws_() + WS_QN);
    const bf16_t* KN = (const bf16_t*)(pws_() + WS_KN);
    const bf16_t* IKN = (const bf16_t*)(pws_() + WS_IKN);
    const bf16_t* VT = (const bf16_t*)(pws_() + WS_VT);
    unsigned* sc = (unsigned*)smem;
    float* part = smem;
    float* plsum = smem + 8 * 64 * 64;
    unsigned* thr = (unsigned*)(smem + 35000);
    const int tid = tid_(), lane = tid & 63, w = tid >> 6, qi = lane & 15, g = lane >> 4;
    for (int task = bid_(); task < MTOK / 16; task += nblk_()) {
        const int c = 31 - task / 128, b = (task >> 2) & 31, sub = task & 3;
        const int t0 = c * 64 + sub * 16, nk = (c + 1) * 64;
        const size_t tok0 = (size_t)b * SEQ + t0;
        const bool dosel = nk > 256;
        if (dosel) {
            BF8 iqf[8]; float wq[8];
#pragma unroll
            for (int h = 0; h < 8; ++h) {
                iqf[h].u = *(const uint4*)(P + (tok0 + qi) * LDP + PC_IQ + h * 32 + 8 * g);
                wq[h] = bf2f(P[(tok0 + qi) * LDP + PC_IW + h]) * 0.0625f;
            }
            for (int kt = w; kt < nk / 16; kt += 8) {
                const int s0 = kt * 16;
                BF8 ka; ka.u = *(const uint4*)(IKN + ((size_t)b * SEQ + s0 + qi) * 32 + 8 * g);
                float acc[4] = {0.f, 0.f, 0.f, 0.f};
#pragma unroll
                for (int h = 0; h < 8; ++h) {
                    const f32x4_t d = __builtin_amdgcn_mfma_f32_16x16x32_bf16(ka.v, iqf[h].v, (f32x4_t){0.f, 0.f, 0.f, 0.f}, 0, 0, 0);
#pragma unroll
                    for (int r = 0; r < 4; ++r) acc[r] = __builtin_fmaf(wq[h], fmaxf(d[r], 0.f), acc[r]);
                }
                uint4 kv; kv.x = ford(acc[0]); kv.y = ford(acc[1]); kv.z = ford(acc[2]); kv.w = ford(acc[3]);
                *(uint4*)(sc + qi * DSA_STRIDE + s0 + 4 * g) = kv;
            }
        }
        __syncthreads();
        if (dosel) {
            const int nj = nk >> 6;
#pragma unroll 1
            for (int qq = 0; qq < 2; ++qq) {
                const int q = 2 * w + qq;
                unsigned kreg[32];
#pragma unroll
                for (int j = 0; j < 32; ++j) kreg[j] = (j < nj) ? sc[q * DSA_STRIDE + j * 64 + lane] : 0u;
                unsigned T = 0u; bool exact = false;
                for (int bit = 31; bit >= 0; --bit) {
                    const unsigned cand = T | (1u << bit);
                    int cnt = 0;
#pragma unroll
                    for (int j = 0; j < 32; ++j) cnt += __popcll(__ballot(kreg[j] >= cand));
                    if (cnt >= 256) { T = cand; if (cnt == 256) { exact = true; break; } }
                }
                int cut = 0x7fffffff;
                if (!exact) {
                    int cgt = 0, ceq = 0;
#pragma unroll
                    for (int j = 0; j < 32; ++j) { cgt += __popcll(__ballot(kreg[j] > T)); ceq += __popcll(__ballot(kreg[j] == T)); }
                    int need = 256 - cgt;
                    if (ceq > need) {
                        bool found = false;
#pragma unroll
                        for (int j = 0; j < 32; ++j) {
                            const unsigned long long m = __ballot(kreg[j] == T);
                            const int cj = __popcll(m);
                            if (!found) {
                                if (need <= cj) { for (int bpos = 0; bpos < 64; ++bpos) if ((m >> bpos) & 1ull) { if (--need == 0) { cut = j * 64 + bpos; break; } } found = true; }
                                else need -= cj;
                            }
                        }
                    }
                }
                if (lane == 0) { thr[q] = T; thr[16 + q] = (unsigned)cut; }
            }
        }
        __syncthreads();
        unsigned Tq = 0u; int cutq = 0x7fffffff;
        if (dosel) { Tq = thr[qi]; cutq = (int)thr[16 + qi]; }
        f32x4_t oacc[4][4]; float lsum[4];
#pragma unroll
        for (int h = 0; h < 4; ++h) { lsum[h] = 0.f;
#pragma unroll
            for (int dt = 0; dt < 4; ++dt) oacc[h][dt] = (f32x4_t){0.f, 0.f, 0.f, 0.f}; }
        const int krow = 8 * (qi >> 2) + (qi & 3);
        for (int st = w; st < nk / 32; st += 8) {
            const int s0 = st * 32;
            BF8 ka[2][2], va[4];
#pragma unroll
            for (int t = 0; t < 2; ++t)
#pragma unroll
                for (int s2 = 0; s2 < 2; ++s2) ka[t][s2].u = *(const uint4*)(KN + ((size_t)b * SEQ + s0 + krow + 4 * t) * 64 + 32 * s2 + 8 * g);
#pragma unroll
            for (int dt = 0; dt < 4; ++dt) va[dt].u = *(const uint4*)(VT + ((size_t)b * 64 + 16 * dt + qi) * SEQ + s0 + 8 * g);
            float mk[8];
            if (dosel) {
                const uint4 k0 = *(const uint4*)(sc + qi * DSA_STRIDE + s0 + 8 * g), k1 = *(const uint4*)(sc + qi * DSA_STRIDE + s0 + 8 * g + 4);
                const unsigned kk[8] = {k0.x, k0.y, k0.z, k0.w, k1.x, k1.y, k1.z, k1.w};
#pragma unroll
                for (int j = 0; j < 8; ++j) mk[j] = (kk[j] > Tq || (kk[j] == Tq && (s0 + 8 * g + j) <= cutq)) ? 1.f : 0.f;
            } else {
#pragma unroll
                for (int j = 0; j < 8; ++j) mk[j] = 1.f;
            }
#pragma unroll
            for (int h = 0; h < 4; ++h) {
                BF8 q0, q1;
                q0.u = *(const uint4*)(QN + (tok0 + qi) * 256 + h * 64 + 8 * g);
                q1.u = *(const uint4*)(QN + (tok0 + qi) * 256 + h * 64 + 32 + 8 * g);
                f32x4_t sacc[2];
#pragma unroll
                for (int t = 0; t < 2; ++t) {
                    sacc[t] = __builtin_amdgcn_mfma_f32_16x16x32_bf16(ka[t][0].v, q0.v, (f32x4_t){0.f, 0.f, 0.f, 0.f}, 0, 0, 0);
                    sacc[t] = __builtin_amdgcn_mfma_f32_16x16x32_bf16(ka[t][1].v, q1.v, sacc[t], 0, 0, 0);
                }
                float pe[8];
#pragma unroll
                for (int t = 0; t < 2; ++t)
#pragma unroll
                    for (int r = 0; r < 4; ++r) { pe[4 * t + r] = __expf(sacc[t][r]) * mk[4 * t + r]; lsum[h] += pe[4 * t + r]; }
                BF8 pf;
#pragma unroll
                for (int j = 0; j < 4; ++j) pf.w[j] = pk_bf16(pe[2 * j], pe[2 * j + 1]);
#pragma unroll
                for (int dt = 0; dt < 4; ++dt) oacc[h][dt] = __builtin_amdgcn_mfma_f32_16x16x32_bf16(va[dt].v, pf.v, oacc[h][dt], 0, 0, 0);
            }
        }
        __syncthreads();
#pragma unroll
        for (int h = 0; h < 4; ++h) {
            plsum[(w * 4 + h) * 64 + lane] = lsum[h];
#pragma unroll
            for (int dt = 0; dt < 4; ++dt)
#pragma unroll
                for (int r = 0; r < 4; ++r) part[(w * 64 + h * 16 + dt * 4 + r) * 64 + lane] = oacc[h][dt][r];
        }
        __syncthreads();
        {
            const int h = w >> 1;
            float lq = 0.f;
#pragma unroll
            for (int w2 = 0; w2 < 8; ++w2)
#pragma unroll
                for (int g2 = 0; g2 < 4; ++g2) lq += plsum[(w2 * 4 + h) * 64 + qi + 16 * g2];
            const float inv = 1.f / lq;
#pragma unroll
            for (int dd = 0; dd < 2; ++dd) {
                const int dt = (w & 1) * 2 + dd;
                float o[4];
#pragma unroll
                for (int r = 0; r < 4; ++r) {
                    float sacc = 0.f;
#pragma unroll
                    for (int w2 = 0; w2 < 8; ++w2) sacc += part[(w2 * 64 + h * 16 + dt * 4 + r) * 64 + lane];
                    o[r] = sacc * inv;
                }
                uint2 ov; ov.x = pk_bf16(o[0], o[1]); ov.y = pk_bf16(o[2], o[3]);
                *(uint2*)(Y + (tok0 + qi) * DM + 768 + h * 64 + 16 * dt + 4 * g) = ov;
            }
        }
        __syncthreads();
    }
}

__device__ __forceinline__ void ph_mem_prep(const Ctx& p, int l) {
    const float* Km = (const float*)(pws_() + WS_KM);
    const float* Vm = (const float*)(pws_() + WS_VM);
    bf16_t* KB = (bf16_t*)(pws_() + WS_KB);
    bf16_t* VTB = (bf16_t*)(pws_() + WS_VTB);
    const float* kg = pin_(28) + (size_t)l * 64;
    const int lane = tid_() & 63;
    for (int r = gwave(); r < MMEM; r += nwaves()) {
        const int b = r / NMEM, j = r % NMEM;
#pragma unroll
        for (int h = 0; h < 4; ++h) {
            const float v = Km[(size_t)r * 256 + h * 64 + lane];
            const float ss = wave_sum(v * v);
            KB[(((size_t)b * 4 + h) * NMEM + j) * 64 + lane] = f2bf(v * rsqrtf(ss * (1.f / 64.f) + EPS) * kg[lane]);
            VTB[(((size_t)b * 4 + h) * 64 + lane) * NMEM + j] = f2bf(Vm[(size_t)r * 256 + h * 64 + lane]);
        }
    }
}
__device__ __forceinline__ void ph_xattn(const Ctx& p, int l) {
    const float* Qx = (const float*)(pws_() + WS_QX);
    bf16_t* Ox = (bf16_t*)(pws_() + WS_OX);
    const bf16_t* KB = (const bf16_t*)(pws_() + WS_KB);
    const bf16_t* VTB = (const bf16_t*)(pws_() + WS_VTB);
    const float* qg = pin_(27) + (size_t)l * 64;
    const int lane = tid_() & 63, qi = lane & 15, g = lane >> 4;
    for (int task = gwave(); task < MTOK / 16; task += nwaves()) {
        const int tok0 = task * 16, b = tok0 / SEQ;
#pragma unroll 1
        for (int h = 0; h < 4; ++h) {
            BF8 qf[2];
            {
                float qv[2][8]; float ss = 0.f;
#pragma unroll
                for (int s2 = 0; s2 < 2; ++s2) {
                    const float4* qp = (const float4*)(Qx + (size_t)(tok0 + qi) * 256 + h * 64 + 32 * s2 + 8 * g);
                    const float4 a = qp[0], c = qp[1];
                    qv[s2][0] = a.x; qv[s2][1] = a.y; qv[s2][2] = a.z; qv[s2][3] = a.w; qv[s2][4] = c.x; qv[s2][5] = c.y; qv[s2][6] = c.z; qv[s2][7] = c.w;
#pragma unroll
                    for (int j = 0; j < 8; ++j) ss += qv[s2][j] * qv[s2][j];
                }
                ss += __shfl_xor(ss, 16, 64); ss += __shfl_xor(ss, 32, 64);
                const float rs = rsqrtf(ss * (1.f / 64.f) + EPS) * 0.125f;
#pragma unroll
                for (int s2 = 0; s2 < 2; ++s2) {
                    const float4 g0 = *(const float4*)(qg + 32 * s2 + 8 * g), g1 = *(const float4*)(qg + 32 * s2 + 8 * g + 4);
                    qf[s2].w[0] = pk_bf16(qv[s2][0] * rs * g0.x, qv[s2][1] * rs * g0.y); qf[s2].w[1] = pk_bf16(qv[s2][2] * rs * g0.z, qv[s2][3] * rs * g0.w);
                    qf[s2].w[2] = pk_bf16(qv[s2][4] * rs * g1.x, qv[s2][5] * rs * g1.y); qf[s2].w[3] = pk_bf16(qv[s2][6] * rs * g1.z, qv[s2][7] * rs * g1.w);
                }
            }
            const bf16_t* Kh = KB + ((size_t)b * 4 + h) * NMEM * 64;
            const bf16_t* Vh = VTB + ((size_t)b * 4 + h) * 64 * NMEM;
            f32x4_t oacc[4];
#pragma unroll
            for (int dt = 0; dt < 4; ++dt) oacc[dt] = (f32x4_t){0.f, 0.f, 0.f, 0.f};
            float lsum = 0.f;
            const int krow = 8 * (qi >> 2) + (qi & 3);
#pragma unroll 2
            for (int s0 = 0; s0 < NMEM; s0 += 32) {
                BF8 ka[2][2], va[4];
#pragma unroll
                for (int t = 0; t < 2; ++t)
#pragma unroll
                    for (int s2 = 0; s2 < 2; ++s2) ka[t][s2].u = *(const uint4*)(Kh + (size_t)(s0 + krow + 4 * t) * 64 + 32 * s2 + 8 * g);
#pragma unroll
                for (int dt = 0; dt < 4; ++dt) va[dt].u = *(const uint4*)(Vh + (size_t)(16 * dt + qi) * NMEM + s0 + 8 * g);
                f32x4_t sacc[2];
#pragma unroll
                for (int t = 0; t < 2; ++t) {
                    sacc[t] = (f32x4_t){0.f, 0.f, 0.f, 0.f};
                    sacc[t] = __builtin_amdgcn_mfma_f32_16x16x32_bf16(ka[t][0].v, qf[0].v, sacc[t], 0, 0, 0);
                    sacc[t] = __builtin_amdgcn_mfma_f32_16x16x32_bf16(ka[t][1].v, qf[1].v, sacc[t], 0, 0, 0);
                }
                float pe[8];
#pragma unroll
                for (int t = 0; t < 2; ++t)
#pragma unroll
                    for (int r = 0; r < 4; ++r) { pe[4 * t + r] = __expf(sacc[t][r]); lsum += pe[4 * t + r]; }
                BF8 pf;
#pragma unroll
                for (int j = 0; j < 4; ++j) pf.w[j] = pk_bf16(pe[2 * j], pe[2 * j + 1]);
#pragma unroll
                for (int dt = 0; dt < 4; ++dt) oacc[dt] = __builtin_amdgcn_mfma_f32_16x16x32_bf16(va[dt].v, pf.v, oacc[dt], 0, 0, 0);
            }
            lsum += __shfl_xor(lsum, 16, 64); lsum += __shfl_xor(lsum, 32, 64);
            const float inv = 1.f / lsum;
#pragma unroll
            for (int dt = 0; dt < 4; ++dt) {
                uint2 o; o.x = pk_bf16(oacc[dt][0] * inv, oacc[dt][1] * inv); o.y = pk_bf16(oacc[dt][2] * inv, oacc[dt][3] * inv);
                *(uint2*)(Ox + (size_t)(tok0 + qi) * 256 + h * 64 + 16 * dt + 4 * g) = o;
            }
        }
    }
}

template <int N> __device__ __forceinline__ void bitonic_sort_desc(unsigned (&a)[N]) {
#pragma unroll
    for (int k = 2; k <= N; k <<= 1)
#pragma unroll
        for (int j = k >> 1; j > 0; j >>= 1)
#pragma unroll
            for (int i = 0; i < N; ++i) {
                const int o = i ^ j;
                if (o > i) {
                    const bool desc = ((i & k) == 0);
                    const unsigned x = a[i], y = a[o];
                    const unsigned mx = x > y ? x : y, mn = x > y ? y : x;
                    a[i] = desc ? mx : mn; a[o] = desc ? mn : mx;
                }
            }
}
__device__ __forceinline__ void bitonic_merge16_desc(unsigned (&a)[16]) {
#pragma unroll
    for (int j = 8; j > 0; j >>= 1)
#pragma unroll
        for (int i = 0; i < 16; ++i) {
            const int o = i ^ j;
            if (o > i) { const unsigned x = a[i], y = a[o]; a[i] = x > y ? x : y; a[o] = x > y ? y : x; }
        }
}
__device__ __forceinline__ void top16_merge(unsigned (&a)[16], const unsigned (&b)[16]) {
#pragma unroll
    for (int i = 0; i < 16; ++i) a[i] = a[i] > b[15 - i] ? a[i] : b[15 - i];
    bitonic_merge16_desc(a);
}
__device__ __forceinline__ void top16_xlane(unsigned (&a)[16], int xm) {
    unsigned b[16];
#pragma unroll
    for (int i = 0; i < 16; ++i) b[i] = (unsigned)__shfl_xor((int)a[i], xm, 64);
    top16_merge(a, b);
}
__device__ __forceinline__ void ph_subkeys_convert(const Ctx& p) {
    const float* sk = pin_(31);
    bf16_t* o = (bf16_t*)(pws_() + WS_SKB);
    const size_t n = (size_t)DEPTH * 8 * 2 * 128 * 64;
    for (size_t i = (size_t)bid_() * 512 + tid_(); i < n; i += (size_t)nblk_() * 512) o[i] = f2bf(sk[i]);
}
__device__ __forceinline__ void ph_peer_topk(const Ctx& p, int l, float* smem) {
    const bf16_t* Qp = (const bf16_t*)(pws_() + WS_QP);
    const bf16_t* SK = (const bf16_t*)(pws_() + WS_SKB) + (size_t)l * 8 * 2 * 128 * 64;
    int* pidx = (int*)(pws_() + WS_PEI);
    float* pgt = (float*)(pws_() + WS_PEG);
    const int tid = tid_(), lane = tid & 63, wave = tid >> 6, qi = lane & 15, g = lane >> 4;
    int* tabw = (int*)smem + wave * 512 + qi * 32;
    for (int task = gwave(); task < MTOK / 16; task += nwaves()) {
        const size_t tok = (size_t)task * 16 + qi;
#pragma unroll 1
        for (int h = 0; h < 8; ++h) {
            unsigned L[2][16];
#pragma unroll
            for (int pp = 0; pp < 2; ++pp) {
                BF8 qf[2];
#pragma unroll
                for (int s2 = 0; s2 < 2; ++s2) qf[s2].u = *(const uint4*)(Qp + tok * DM + h * 128 + pp * 64 + 32 * s2 + 8 * g);
                const bf16_t* skp = SK + (size_t)(h * 2 + pp) * 128 * 64;
                unsigned va[16], vb[16];
#pragma unroll
                for (int tile = 0; tile < 8; ++tile) {
                    BF8 ka[2];
#pragma unroll
                    for (int s2 = 0; s2 < 2; ++s2) ka[s2].u = *(const uint4*)(skp + (size_t)(16 * tile + qi) * 64 + 32 * s2 + 8 * g);
                    f32x4_t d = __builtin_amdgcn_mfma_f32_16x16x32_bf16(ka[0].v, qf[0].v, (f32x4_t){0.f, 0.f, 0.f, 0.f}, 0, 0, 0);
                    d = __builtin_amdgcn_mfma_f32_16x16x32_bf16(ka[1].v, qf[1].v, d, 0, 0, 0);
#pragma unroll
                    for (int r = 0; r < 4; ++r) {
                        const unsigned key = (ford(d[r]) & ~127u) | (unsigned)(127 - (16 * tile + 4 * g + r));
                        if (tile < 4) va[tile * 4 + r] = key; else vb[(tile - 4) * 4 + r] = key;
                    }
                }
                bitonic_sort_desc<16>(va);
                bitonic_sort_desc<16>(vb);
                top16_merge(va, vb);
                top16_xlane(va, 16);
                top16_xlane(va, 32);
#pragma unroll
                for (int i = 0; i < 16; ++i) L[pp][i] = va[i];
            }
            if (g < 2) {
#pragma unroll
                for (int i = 0; i < 16; ++i) tabw[g * 16 + i] = 127 - (int)((g == 0 ? L[0][i] : L[1][i]) & 127u);
            }
            float s1[16], s2v[16];
#pragma unroll
            for (int i = 0; i < 16; ++i) { s1[i] = funord(L[0][i] & ~127u); s2v[i] = funord(L[1][i] & ~127u); }
            unsigned ca[16], cb[16];
#pragma unroll
            for (int i = 0; i < 16; ++i) { ca[i] = 0u; cb[i] = 0u; }
            {
                const float r0 = g == 0 ? s1[0] : (g == 1 ? s1[1] : (g == 2 ? s1[2] : s1[3]));
                const int nb0 = g == 0 ? 16 : (g == 1 ? 8 : (g == 2 ? 5 : 4));
#pragma unroll
                for (int bq = 0; bq < 16; ++bq) if (bq < nb0) ca[bq] = (ford(r0 + s2v[bq]) & ~255u) | (unsigned)(255 - (g * 16 + bq));
                const float r1 = g == 0 ? s1[4] : (g == 1 ? s1[5] : (g == 2 ? s1[6] : s1[7]));
                const int nb1 = g == 0 ? 3 : 2;
#pragma unroll
                for (int bq = 0; bq < 3; ++bq) if (bq < nb1) cb[bq] = (ford(r1 + s2v[bq]) & ~255u) | (unsigned)(255 - ((g + 4) * 16 + bq));
                const float r2 = g == 0 ? s1[8] : (g == 1 ? s1[9] : (g == 2 ? s1[10] : s1[11]));
                cb[3] = (ford(r2 + s2v[0]) & ~255u) | (unsigned)(255 - ((g + 8) * 16));
                const float r3 = g == 0 ? s1[12] : (g == 1 ? s1[13] : (g == 2 ? s1[14] : s1[15]));
                cb[4] = (ford(r3 + s2v[0]) & ~255u) | (unsigned)(255 - ((g + 12) * 16));
            }
            bitonic_sort_desc<16>(ca);
            bitonic_sort_desc<16>(cb);
            top16_merge(ca, cb);
            top16_xlane(ca, 16);
            top16_xlane(ca, 32);
            float tv[16]; float den = 0.f;
#pragma unroll
            for (int i = 0; i < 16; ++i) {
                const int f = 255 - (int)(ca[i] & 255u);
                const int a = f >> 4, bq = f & 15;
                tv[i] = funord(ca[i] & ~255u);
                (void)a; (void)bq;
            }
#pragma unroll
            for (int i = 0; i < 16; ++i) { tv[i] = __expf(tv[i] - funord(ca[0] & ~255u)); den += tv[i]; }
            const float inv = 1.f / den;
            int ev[4]; float gv[4];
#pragma unroll
            for (int r = 0; r < 4; ++r) {
                const unsigned key = g == 0 ? ca[r] : (g == 1 ? ca[4 + r] : (g == 2 ? ca[8 + r] : ca[12 + r]));
                const float tvv = g == 0 ? tv[r] : (g == 1 ? tv[4 + r] : (g == 2 ? tv[8 + r] : tv[12 + r]));
                const int f = 255 - (int)(key & 255u);
                ev[r] = tabw[f >> 4] * 128 + tabw[16 + (f & 15)];
                gv[r] = tvv * inv;
            }
            *(int4*)(pidx + tok * 128 + h * 16 + 4 * g) = make_int4(ev[0], ev[1], ev[2], ev[3]);
            *(float4*)(pgt + tok * 128 + h * 16 + 4 * g) = make_float4(gv[0], gv[1], gv[2], gv[3]);
        }
    }
}

typedef _Float16 h2_t __attribute__((ext_vector_type(2)));
__device__ __forceinline__ h2_t as_h2(unsigned u) { union { unsigned u; h2_t h; } c; c.u = u; return c.h; }
#define U_SCALE 1024.f
#define V_SCALE 256.f
typedef float f32x2_t __attribute__((ext_vector_type(2)));
__device__ __forceinline__ unsigned pack4_fp8(float4 a, float sc) {
    const float x = fminf(fmaxf(a.x * sc, -448.f), 448.f), y = fminf(fmaxf(a.y * sc, -448.f), 448.f);
    const float z = fminf(fmaxf(a.z * sc, -448.f), 448.f), w = fminf(fmaxf(a.w * sc, -448.f), 448.f);
    int r = __builtin_amdgcn_cvt_pk_fp8_f32(x, y, 0, false);
    r = __builtin_amdgcn_cvt_pk_fp8_f32(z, w, r, true);
    return (unsigned)r;
}
__device__ __forceinline__ void ph_tab_convert(const Ctx& p, int l) {
    const float4* u = (const float4*)(pin_(32) + (size_t)l * NEXP * DM);
    const float4* v = (const float4*)(pin_(33) + (size_t)l * NEXP * DM);
    unsigned* uo = (unsigned*)(pws_() + WS_UT16);
    unsigned* vo = (unsigned*)(pws_() + WS_VT16);
    const size_t n4 = (size_t)NEXP * DM / 4;
    for (size_t i = (size_t)bid_() * 512 + tid_(); i < n4; i += (size_t)nblk_() * 512) {
        uo[i] = pack4_fp8(u[i], U_SCALE);
        vo[i] = pack4_fp8(v[i], V_SCALE);
    }
}
__device__ __forceinline__ void ph_peer_gather(const Ctx& p, int l) {
    const unsigned char* ut = (const unsigned char*)(pws_() + WS_UT16);
    const unsigned char* vt = (const unsigned char*)(pws_() + WS_VT16);
    const int* pidx = (const int*)(pws_() + WS_PEI);
    const float* pgt = (const float*)(pws_() + WS_PEG);
    const bf16_t* H = (const bf16_t*)(pws_() + WS_H);
    float* x = pout_();
    const int lane = tid_() & 63;
    const bool bit5 = lane & 32, bit4 = lane & 16, bit3 = lane & 8, bit2 = lane & 4;
    const int jmine = ((lane >> 5) & 1) * 8 + ((lane >> 4) & 1) * 4 + ((lane >> 3) & 1) * 2 + ((lane >> 2) & 1);
    for (int tok = gwave(); tok < MTOK; tok += nwaves()) {
        float hh[16];
        {
            const uint4 r0 = *(const uint4*)(H + (size_t)tok * DM + lane * 16), r1 = *(const uint4*)(H + (size_t)tok * DM + lane * 16 + 8);
            const unsigned w[8] = {r0.x, r0.y, r0.z, r0.w, r1.x, r1.y, r1.z, r1.w};
#pragma unroll
            for (int q = 0; q < 8; ++q) { hh[2 * q] = __uint_as_float(w[q] << 16); hh[2 * q + 1] = __uint_as_float(w[q] & 0xffff0000u); }
        }
        const int e0 = pidx[(size_t)tok * 128 + lane], e1 = pidx[(size_t)tok * 128 + 64 + lane];
        const float g0 = pgt[(size_t)tok * 128 + lane], g1 = pgt[(size_t)tok * 128 + 64 + lane];
        float out[16];
#pragma unroll
        for (int i = 0; i < 16; ++i) out[i] = 0.f;
#pragma unroll 1
        for (int hb = 0; hb < 8; ++hb) {
            const int esrc = hb < 4 ? e0 : e1;
            const float gsrc = hb < 4 ? g0 : g1;
            const int lb = (hb & 3) * 16;
            uint4 ur[16], vr[16];
#pragma unroll
            for (int j = 0; j < 16; ++j) {
                const int e = __builtin_amdgcn_readlane(esrc, lb + j);
                ur[j] = *(const uint4*)(ut + (size_t)e * DM + lane * 16);
                vr[j] = *(const uint4*)(vt + (size_t)e * DM + lane * 16);
            }
            float pd[16];
#pragma unroll
            for (int j = 0; j < 16; ++j) {
                const unsigned w[4] = {ur[j].x, ur[j].y, ur[j].z, ur[j].w};
                float d0 = 0.f, d1 = 0.f;
#pragma unroll
                for (int q = 0; q < 4; ++q) {
                    const f32x2_t a = __builtin_amdgcn_cvt_pk_f32_fp8((int)w[q], false), c = __builtin_amdgcn_cvt_pk_f32_fp8((int)w[q], true);
                    d0 = __builtin_fmaf(a.x, hh[4 * q], d0); d1 = __builtin_fmaf(a.y, hh[4 * q + 1], d1);
                    d0 = __builtin_fmaf(c.x, hh[4 * q + 2], d0); d1 = __builtin_fmaf(c.y, hh[4 * q + 3], d1);
                }
                pd[j] = d0 + d1;
            }
            float r8[8], r4[4], r2[2], r1;
#pragma unroll
            for (int i = 0; i < 8; ++i) { const float mine = bit5 ? pd[i + 8] : pd[i], send = bit5 ? pd[i] : pd[i + 8]; r8[i] = mine + __shfl_xor(send, 32, 64); }
#pragma unroll
            for (int i = 0; i < 4; ++i) { const float mine = bit4 ? r8[i + 4] : r8[i], send = bit4 ? r8[i] : r8[i + 4]; r4[i] = mine + __shfl_xor(send, 16, 64); }
#pragma unroll
            for (int i = 0; i < 2; ++i) { const float mine = bit3 ? r4[i + 2] : r4[i], send = bit3 ? r4[i] : r4[i + 2]; r2[i] = mine + __shfl_xor(send, 8, 64); }
            { const float mine = bit2 ? r2[1] : r2[0], send = bit2 ? r2[0] : r2[1]; r1 = mine + __shfl_xor(send, 4, 64); }
            r1 += __shfl_xor(r1, 2, 64); r1 += __shfl_xor(r1, 1, 64);
            const float gmine = __shfl(gsrc, lb + jmine, 64);
            const float coef = gmine * gelu_tanh_f(r1 * (1.f / U_SCALE)) * (1.f / V_SCALE);
#pragma unroll
            for (int j = 0; j < 16; ++j) {
                const float cj = __uint_as_float(__builtin_amdgcn_readlane(__float_as_uint(coef), (j >> 3) * 32 + ((j >> 2) & 1) * 16 + ((j >> 1) & 1) * 8 + (j & 1) * 4));
                const unsigned w[4] = {vr[j].x, vr[j].y, vr[j].z, vr[j].w};
#pragma unroll
                for (int q = 0; q < 4; ++q) {
                    const f32x2_t a = __builtin_amdgcn_cvt_pk_f32_fp8((int)w[q], false), c = __builtin_amdgcn_cvt_pk_f32_fp8((int)w[q], true);
                    out[4 * q] = __builtin_fmaf(a.x, cj, out[4 * q]); out[4 * q + 1] = __builtin_fmaf(a.y, cj, out[4 * q + 1]);
                    out[4 * q + 2] = __builtin_fmaf(c.x, cj, out[4 * q + 2]); out[4 * q + 3] = __builtin_fmaf(c.y, cj, out[4 * q + 3]);
                }
            }
        }
        float4* xp = (float4*)(x + (size_t)tok * DM + lane * 16);
#pragma unroll
        for (int q = 0; q < 4; ++q) {
            float4 a = xp[q];
            a.x += out[4 * q]; a.y += out[4 * q + 1]; a.z += out[4 * q + 2]; a.w += out[4 * q + 3];
            xp[q] = a;
        }
    }
}


#ifndef PROBE_MASK
#define PROBE_MASK 0
#endif
#if PROBE_MASK
#define GB(k) do { GRID_BARRIER(); const unsigned long long now_ = wall_clock64(); if ((PROBE_MASK >> (k)) & 1) { const unsigned long long dt_ = now_ - tprev_; while (wall_clock64() - now_ < 3ull * dt_) __builtin_amdgcn_s_sleep(8); } GRID_BARRIER(); tprev_ = wall_clock64(); } while (0)
#else
#define GB(k) GRID_BARRIER()
#endif
__global__ void __launch_bounds__(512, 2) k_mega(Params kp) {
    float* sm = dynsmem;
    {
        unsigned long long* tab = (unsigned long long*)((char*)dynsmem + PTAB_OFF);
        if (threadIdx.x < 34) tab[threadIdx.x] = (unsigned long long)kp.in[threadIdx.x];
        if (threadIdx.x == 34) tab[34] = (unsigned long long)kp.out;
        if (threadIdx.x == 35) tab[35] = (unsigned long long)kp.ws;
        if (threadIdx.x == 36) { tab[36] = 0ull; tab[37] = 0ull; }
    }
    __syncthreads();
    Ctx p; p.dummy = 0;
    (void)xcd_barrier_post((unsigned*)(pws_() + WS_BAR), (volatile LAS unsigned*)((char*)dynsmem + PTAB_OFF + 36 * 8));
#define GRID_BARRIER() do { XcdBarrier bar_; bar_.bar = (unsigned*)(pws_() + WS_BAR); bar_.x = xb_xcc_id(); bar_.st = (volatile LAS unsigned*)((char*)dynsmem + PTAB_OFF + 36 * 8); xcd_barrier(bar_); } while (0)
    ph_weight_prep(p, sm);
    ph_subkeys_convert(p);
    GRID_BARRIER();
#if PROBE_MASK
    unsigned long long tprev_ = wall_clock64();
#endif
#pragma unroll 1
    for (int l = 0; l < DEPTH; ++l) {
#define XIN_ (l == 0 ? pin_(0) : pout_())
#define HBUF_ ((const bf16_t*)(pws_() + WS_H))
        ph_rmsnorm(XIN_, pin_(2) + (size_t)l * DM, (bf16_t*)(pws_() + WS_H), MTOK);
        ph_rmsnorm(pin_(1), pin_(22) + (size_t)l * DM, (bf16_t*)(pws_() + WS_HM), MMEM);
        GB(1);
        { pg8::EpiBf16 E; E.O = (bf16_t*)(pws_() + WS_P); E.ldc = LDP; ph_gemm(HBUF_, (const bf16_t*)(pws_() + WT_IN) + (size_t)l * LDP * DM, MTOK, LDP, DM, E); }
        { pg8::EpiF32 E; E.C = (float*)(pws_() + WS_KM); E.R = nullptr; E.ldc = 256; ph_gemm((const bf16_t*)(pws_() + WS_HM), (const bf16_t*)(pws_() + WT_XK) + (size_t)l * 256 * DM, MMEM, 256, DM, E); }
        { pg8::EpiF32 E; E.C = (float*)(pws_() + WS_VM); E.R = nullptr; E.ldc = 256; ph_gemm((const bf16_t*)(pws_() + WS_HM), (const bf16_t*)(pws_() + WT_XV) + (size_t)l * 256 * DM, MMEM, 256, DM, E); }
        GB(2);
        ph_mem_prep(p, l);
        ph_dsa_prep(p, l);
        ph_scan_prep(p, l);
        GB(3);
        ph_scans(p, l);
        GB(4);
        ph_mixer_finish(p, l);
        ph_dsa_main(p, l, sm);
        GB(5);
        { pg8::EpiF32 E; E.C = pout_(); E.R = XIN_; E.ldc = DM; ph_gemm((const bf16_t*)(pws_() + WS_Y), (const bf16_t*)(pws_() + WT_OUT) + (size_t)l * DM * DM, MTOK, DM, DM, E); }
        GB(6);
        ph_rmsnorm(pout_(), pin_(21) + (size_t)l * DM, (bf16_t*)(pws_() + WS_H), MTOK);
        GB(7);
        { pg8::EpiF32 E; E.C = (float*)(pws_() + WS_QX); E.R = nullptr; E.ldc = 256; ph_gemm(HBUF_, (const bf16_t*)(pws_() + WT_XQ) + (size_t)l * 256 * DM, MTOK, 256, DM, E); }
        GB(8);
        ph_xattn(p, l);
        GB(9);
        { pg8::EpiF32 E; E.C = pout_(); E.R = pout_(); E.ldc = DM; ph_gemm((const bf16_t*)(pws_() + WS_OX), (const bf16_t*)(pws_() + WT_XO) + (size_t)l * DM * 256, MTOK, DM, 256, E); }
        GB(10);
        ph_rmsnorm(pout_(), pin_(29) + (size_t)l * DM, (bf16_t*)(pws_() + WS_H), MTOK);
        ph_tab_convert(p, l);
        GB(11);
        { pg8::EpiBf16 E; E.O = (bf16_t*)(pws_() + WS_QP); E.ldc = DM; ph_gemm(HBUF_, (const bf16_t*)(pws_() + WT_PQ) + (size_t)l * DM * DM, MTOK, DM, DM, E); }
        GB(12);
        ph_peer_topk(p, l, sm);
        GB(13);
        ph_peer_gather(p, l);
        GB(14);
    }
}

extern "C" void kernel_launch(void* const* d_in, const int* in_sizes, int n_in, void* d_out, int out_size, void* d_ws, size_t ws_size, hipStream_t stream) {
    if (n_in != 34 || out_size != MTOK * DM || ws_size < WS_END) {
        fprintf(stderr, "kernel_launch: unexpected shapes (n_in %d out %d ws %zu need %zu)\n", n_in, out_size, ws_size, (size_t)WS_END);
        return;
    }
    static int grid = 0;
    if (!grid) {
        int dev = 0, cus = 0, per_cu = 0;
        (void)hipGetDevice(&dev);
        (void)hipDeviceGetAttribute(&cus, hipDeviceAttributeMultiprocessorCount, dev);
        (void)hipFuncSetAttribute((const void*)k_mega, hipFuncAttributeMaxDynamicSharedMemorySize, LDS_BYTES);
        (void)hipOccupancyMaxActiveBlocksPerMultiprocessor(&per_cu, (const void*)k_mega, 512, LDS_BYTES);
        if (per_cu < 1) fprintf(stderr, "kernel_launch: occupancy query reports %d blocks per CU\n", per_cu);
        grid = cus > 0 ? cus : 256;
    }
    Params p; memset(&p, 0, sizeof(p));
    for (int i = 0; i < 34; ++i) p.in[i] = (const float*)d_in[i];
    p.out = (float*)d_out; p.ws = (char*)d_ws;
    (void)hipMemsetAsync((char*)d_ws + WS_BAR, 0, XCD_BAR_WORDS * sizeof(unsigned), stream);
    hipLaunchKernelGGL(k_mega, dim3(grid), dim3(512), LDS_BYTES, stream, p);
}
```

```cpp
#include <hip/hip_runtime.h>
#include <stdint.h>
#include <stdio.h>
#include <string.h>

#define NB 32
#define SEQ 2048
#define DM 1024
#define MTOK (NB * SEQ)
#define DEPTH 4
#define NMEM 256
#define MMEM (NB * NMEM)
#define LDP 3328
#define NEXP 16384
#define EPS 1e-6f
#define PC_Z 0
#define PC_XBC 256
#define PC_GQKV 768
#define PC_GG 1536
#define PC_LQ 1792
#define PC_LK 1920
#define PC_LV 2048
#define PC_LR 2304
#define PC_DQ 2560
#define PC_DK 2816
#define PC_DV 2880
#define PC_IQ 2944
#define PC_IK 3200
#define PC_GLR 3232
#define PC_IW 3248
#define PC_DT 3256
#define PC_GA 3260
#define PC_GB 3264

typedef unsigned short bf16_t;

#define WS_BAR 0ull
#define WS_P 16384ull
#define SZ_P ((size_t)MTOK * LDP * 2)
#define WS_H (WS_P + SZ_P)
#define SZ_H ((size_t)MTOK * DM * 2)
#define WS_Y (WS_H + SZ_H)
#define SZ_Y ((size_t)MTOK * DM * 2)
#define WS_WP (WS_Y + SZ_Y)
#define SZ_WP ((size_t)DEPTH * DM * LDP * 4)
#define WT_IN (WS_WP)
#define WT_OUT (WT_IN + (size_t)DEPTH * LDP * DM * 2)
#define WT_XQ (WT_OUT + (size_t)DEPTH * DM * DM * 2)
#define WT_XK (WT_XQ + (size_t)DEPTH * 256 * DM * 2)
#define WT_XV (WT_XK + (size_t)DEPTH * 256 * DM * 2)
#define WT_XO (WT_XV + (size_t)DEPTH * 256 * DM * 2)
#define WT_PQ (WT_XO + (size_t)DEPTH * DM * 256 * 2)
#define WT_END (WT_PQ + (size_t)DEPTH * DM * DM * 2)
#define WS_QN (WS_WP + SZ_WP)
#define SZ_QN ((size_t)MTOK * 256 * 4)
#define WS_KN (WS_QN + SZ_QN)
#define SZ_KN ((size_t)MTOK * 64 * 4)
#define WS_IKN (WS_KN + SZ_KN)
#define SZ_IKN ((size_t)MTOK * 32 * 4)
#define WS_YPRE (WS_IKN + SZ_IKN)
#define SZ_YPRE ((size_t)MTOK * 256 * 4)
#define WS_HM (WS_YPRE + SZ_YPRE)
#define SZ_HM ((size_t)MMEM * DM * 2)
#define WS_KM (WS_HM + SZ_HM)
#define SZ_KM ((size_t)MMEM * 256 * 4)
#define WS_VM (WS_KM + SZ_KM)
#define SZ_VM ((size_t)MMEM * 256 * 4)
#define WS_KB (WS_VM + SZ_VM)
#define SZ_KB ((size_t)MMEM * 256 * 2)
#define WS_VTB (WS_KB + SZ_KB)
#define SZ_VTB ((size_t)MMEM * 256 * 2)
#define WS_VT (WS_VTB + SZ_VTB)
#define SZ_VT ((size_t)MTOK * 64 * 2)
#define WS_SKB (WS_VT + SZ_VT)
#define SZ_SKB ((size_t)DEPTH * 8 * 2 * 128 * 64 * 2)
#define WS_SC (WS_SKB + SZ_SKB)
#define SZ_SC ((size_t)MTOK * 16 * 4)
#define WS_END (WS_SC + SZ_SC)
#define WS_QX (WS_P)
#define WS_OX (WS_P + (size_t)MTOK * 256 * 4)
#define WS_QP (WS_P)
#define WS_UT16 (WS_P + 260ull * 1024 * 1024)
#define WS_VT16 (WS_UT16 + (size_t)NEXP * DM * 2)
#define WS_PEI (WS_VT16 + (size_t)NEXP * DM * 2)
#define WS_PEG (WS_PEI + (size_t)MTOK * 128 * 4)
#define WS_PEND (WS_PEG + (size_t)MTOK * 128 * 4)
static_assert(WS_PEND <= WS_P + SZ_P, "P region aliases");

struct Params {
    const float* in[34];
    float* out;
    char* ws;
};

#define XB_TMO      128
#define XB_XCNT(j)  (256  + 64 * (j))
#define XB_XSUB(j)  (1280 + 64 * (j))
#define XB_XGEN(j)  (2304 + 64 * (j))
#define XB_TOP      3328
#define XB_TOPGEN   3392
#define XCD_BAR_WORDS 3456
#define XB_SPIN_CAP (1u << 18)
#define LAS __attribute__((address_space(3)))

__device__ __forceinline__ unsigned xb_ld(unsigned* p)              { return __hip_atomic_load(p, __ATOMIC_RELAXED, __HIP_MEMORY_SCOPE_AGENT); }
__device__ __forceinline__ unsigned xb_add(unsigned* p, unsigned v) { return __hip_atomic_fetch_add(p, v, __ATOMIC_RELAXED, __HIP_MEMORY_SCOPE_AGENT); }
__device__ __forceinline__ unsigned xb_xcc_id() { return (unsigned)__builtin_amdgcn_s_getreg((3 << 11) | 20) & 0xFu; }
#define XB_SPIN(cond, bar) do { unsigned _sp = 0; while (cond) { __builtin_amdgcn_s_sleep(1); \
    if ((++_sp & 255u) == 0u) { if (xb_ld(&(bar)[XB_TMO])) break; if (_sp > XB_SPIN_CAP) { atomicAdd(&(bar)[XB_TMO], 1u); break; } } } } while (0)

struct XcdBarrier {
    unsigned* bar; unsigned x;
    volatile LAS unsigned* st;
};

__device__ __forceinline__ XcdBarrier xcd_barrier_post(unsigned* bar, volatile LAS unsigned* st) {
    XcdBarrier b; b.bar = bar; b.x = xb_xcc_id(); b.st = st;
    if (threadIdx.x == 0) (void)xb_add(&bar[XB_XCNT(b.x)], 1u);
    return b;
}
__device__ __forceinline__ void xcd_barrier_complete(unsigned* bar, unsigned x, unsigned& nloc, unsigned& nx) {
    const unsigned G = gridDim.x * gridDim.y * gridDim.z;
    unsigned sum, cnt, mine, sp = 0u;
    for (;;) {
        sum = 0u; cnt = 0u; mine = 0u;
#pragma unroll
        for (unsigned j = 0; j < 16; ++j) { const unsigned c = xb_ld(&bar[XB_XCNT(j)]); sum += c; cnt += (c > 0u) ? 1u : 0u; mine = (j == x) ? c : mine; }
        if (sum == G) break;
        __builtin_amdgcn_s_sleep(1);
        if ((++sp & 255u) == 0u) { if (xb_ld(&bar[XB_TMO])) break; if (sp > XB_SPIN_CAP) { atomicAdd(&bar[XB_TMO], 1u); break; } }
    }
    nloc = mine > 0u ? mine : 1u; nx = cnt > 0u ? cnt : 1u;
}

__device__ __forceinline__ void xcd_barrier(const XcdBarrier& b) {
    asm volatile("s_waitcnt vmcnt(0)" ::: "memory");
    __syncthreads();
    if (threadIdx.x == 0) {
        unsigned* bar = b.bar;
        __builtin_amdgcn_s_waitcnt(0);
        unsigned nloc = b.st[0], nx = b.st[1];
        if (nloc == 0u) { xcd_barrier_complete(bar, b.x, nloc, nx); b.st[0] = nloc; b.st[1] = nx; }
        const unsigned old = xb_add(&bar[XB_XSUB(b.x)], 1u);
        const unsigned gen = old / nloc;
        if (old + 1u == (gen + 1u) * nloc) {
            __builtin_amdgcn_fence(__ATOMIC_RELEASE, "agent");
            asm volatile("s_waitcnt vmcnt(0)" ::: "memory");
            const unsigned og = xb_add(&bar[XB_TOP], 1u);
            const unsigned tg = og / nx;
            if (og + 1u == (tg + 1u) * nx) xb_add(&bar[XB_TOPGEN], 1u);
            else XB_SPIN(xb_ld(&bar[XB_TOPGEN]) == tg, bar);
            __builtin_amdgcn_fence(__ATOMIC_ACQUIRE, "agent");
            xb_add(&bar[XB_XGEN(b.x)], 1u);
            asm volatile("s_waitcnt vmcnt(0)" ::: "memory");
        } else {
            XB_SPIN(xb_ld(&bar[XB_XGEN(b.x)]) == gen, bar);
            __builtin_amdgcn_fence(__ATOMIC_ACQUIRE, "agent");
            asm volatile("s_waitcnt vmcnt(0)" ::: "memory");
        }
    }
    __syncthreads();
}


#define LDS_BYTES (144 * 1024)
#define PTAB_OFF (LDS_BYTES - 1024)
extern __shared__ __attribute__((aligned(16))) float dynsmem[];
struct Ctx { const Params* kp; };
#define pin_(i) (p.kp->in[i])
#define pout_() (p.kp->out)
#define pws_() (p.kp->ws)

__device__ __forceinline__ float bf2f(bf16_t v) { return __uint_as_float(((unsigned)v) << 16); }
__device__ __forceinline__ bf16_t f2bf(float f) { unsigned u = __float_as_uint(f); u += 0x7FFFu + ((u >> 16) & 1u); return (bf16_t)(u >> 16); }
__device__ __forceinline__ unsigned pk_bf16(float lo, float hi) { return (unsigned)f2bf(lo) | ((unsigned)f2bf(hi) << 16); }
__device__ __forceinline__ float wave_sum(float v) {
#pragma unroll
    for (int o = 32; o >= 1; o >>= 1) v += __shfl_xor(v, o, 64);
    return v;
}
__device__ __forceinline__ float wave_max(float v) {
#pragma unroll
    for (int o = 32; o >= 1; o >>= 1) v = fmaxf(v, __shfl_xor(v, o, 64));
    return v;
}
__device__ __forceinline__ float silu_f(float x) { return x / (1.f + __expf(-x)); }
__device__ __forceinline__ float sigmoid_f(float x) { return 1.f / (1.f + __expf(-x)); }
__device__ __forceinline__ float softplus_f(float x) { return x > 20.f ? x : log1pf(__expf(x)); }
__device__ __forceinline__ float logsigmoid_f(float x) { return -softplus_f(-x); }
__device__ __forceinline__ float gelu_tanh_f(float x) { const float u = 0.7978845608028654f * (x + 0.044715f * x * x * x); return 0.5f * x * (1.f + tanhf(u)); }
__device__ __forceinline__ unsigned ford(float f) { f = f + 0.0f; unsigned u = __float_as_uint(f); return (u & 0x80000000u) ? ~u : (u | 0x80000000u); }
__device__ __forceinline__ float funord(unsigned k) { unsigned u = (k & 0x80000000u) ? (k & 0x7fffffffu) : ~k; return __uint_as_float(u); }
__device__ __forceinline__ unsigned long long wave_max_u64(unsigned long long v) {
#pragma unroll
    for (int o = 32; o >= 1; o >>= 1) {
        unsigned lo = __shfl_xor((unsigned)v, o, 64), hi = __shfl_xor((unsigned)(v >> 32), o, 64);
        unsigned long long w = ((unsigned long long)hi << 32) | lo;
        v = w > v ? w : v;
    }
    return v;
}
__device__ __forceinline__ int tid_() { int t = threadIdx.x; asm volatile("" : "+v"(t)); return t; }
__device__ __forceinline__ int bid_() { int b = blockIdx.x; asm volatile("" : "+s"(b)); return b; }
__device__ __forceinline__ int nblk_() { int g = gridDim.x; asm volatile("" : "+s"(g)); return g; }
__device__ __forceinline__ int gwave() { return (bid_() * 512 + tid_()) >> 6; }
__device__ __forceinline__ int nwaves() { return nblk_() * 8; }

namespace pg8 {
#define PG8_LAS __attribute__((address_space(3)))
typedef unsigned short bf16_t;
typedef short bf16x8 __attribute__((ext_vector_type(8)));
typedef float f32x4 __attribute__((ext_vector_type(4)));
typedef unsigned u32x4 __attribute__((ext_vector_type(4)));
constexpr int BM = 256, BK = 64, HALF = 128, HTB = HALF * BK * 2  , STAGE_BYTES = 8 * HTB, NXCD = 8, WGM = 8;

__host__ __device__ __forceinline__ int lds_byte(int r, int c) { const int st = (r >> 4) * 2 + (c >> 5), rr = r & 15, cc = c & 31, ob = rr * 64 + cc * 2; return st * 1024 + (ob ^ (((ob >> 9) & 1) << 5)); }
__host__ __device__ __forceinline__ void stage_rc(int b, int& R, int& C) { const int st = b / 1024, sb = b % 1024, swz = sb ^ (((sb >> 9) & 1) << 5); R = (st >> 1) * 16 + swz / 64; C = (st & 1) * 32 + (swz % 64) / 2; }
__host__ __device__ __forceinline__ int perm32(int rho) { const int n = rho >> 4, i = rho & 15; return 8 * (i >> 2) + 4 * n + (i & 3); }

struct Unit { int pm, pn; };
struct Gemm { const bf16_t* A; const bf16_t* Bt; int M, N, K; };

struct StaticOrder {
    int nM, nN, nwg, G, c;
    __host__ __device__ void init(int M, int N, int G_, int c_) { nM = M / BM; nN = N / BM; nwg = nM * nN; G = G_; c = c_; }
    __host__ __device__ bool next(int i, Unit& u) const {
        const long L = (long)i * G + c; if (L >= nwg) return false;
        int wgid = (int)L; { const int q = nwg / NXCD, r = nwg % NXCD, xcd = wgid % NXCD, off = wgid / NXCD; wgid = (xcd < r ? xcd * (q + 1) : r * (q + 1) + (xcd - r) * q) + off; }
        const int nig = WGM * nN, gid = wgid / nig, fm = gid * WGM, gsz = (nM - fm) < WGM ? (nM - fm) : WGM;
        u.pm = fm + ((wgid % nig) % gsz); u.pn = (wgid % nig) / gsz; return true;
    }
    __device__ __forceinline__ void a_ready(const Unit&) const {}
    __device__ __forceinline__ void done(const Unit&) const {}
};

__device__ __forceinline__ unsigned cvt_pk_bf16(float lo, float hi) { unsigned r; asm volatile("v_cvt_pk_bf16_f32 %0, %1, %2" : "=v"(r) : "v"(lo), "v"(hi)); return r; }
struct EpiF32 {
    static constexpr bool PERM = false, AFTER_DRAIN = false;
    float* C; const float* R; int ldc;
    __device__ __forceinline__ void operator()(const f32x4 (&acc)[2][2][4][2], const Unit& u, int wr, int wc, int fr, int fq) const {
        const int row0 = u.pm * BM + wr * 64 + fr, col0 = u.pn * BM + wc * 32 + 4 * fq;
#pragma unroll
        for (int ai = 0; ai < 2; ++ai)
#pragma unroll
            for (int m = 0; m < 4; ++m) { const size_t off = (size_t)(row0 + ai * HALF + m * 16) * ldc + col0;
#pragma unroll
                for (int bj = 0; bj < 2; ++bj)
#pragma unroll
                    for (int n = 0; n < 2; ++n) { f32x4 v = acc[ai][bj][m][n]; if (R) v += *(const f32x4*)(R + off + bj * HALF + n * 16); *(f32x4*)(C + off + bj * HALF + n * 16) = v; } }
    }
};
struct EpiBf16 {
    static constexpr bool PERM = true, AFTER_DRAIN = false;
    bf16_t* O; int ldc;
    __device__ __forceinline__ void operator()(const f32x4 (&acc)[2][2][4][2], const Unit& u, int wr, int wc, int fr, int fq) const {
        const int row0 = u.pm * BM + wr * 64 + fr, col0 = u.pn * BM + wc * 32 + 8 * fq;
#pragma unroll
        for (int ai = 0; ai < 2; ++ai)
#pragma unroll
            for (int m = 0; m < 4; ++m) { bf16_t* rowp = O + (size_t)(row0 + ai * HALF + m * 16) * ldc + col0;
#pragma unroll
                for (int bj = 0; bj < 2; ++bj) { const f32x4 v0 = acc[ai][bj][m][0], v1 = acc[ai][bj][m][1];
                    u32x4 w; w.x = cvt_pk_bf16(v0[0], v0[1]); w.y = cvt_pk_bf16(v0[2], v0[3]); w.z = cvt_pk_bf16(v1[0], v1[1]); w.w = cvt_pk_bf16(v1[2], v1[3]);
                    *(u32x4*)(rowp + bj * HALF) = w; } }
    }
};

template <class Epi, class Sched, bool STAMP = false>
__device__ __forceinline__ void gemm_phase(PG8_LAS unsigned char* lds, const Gemm g, const Sched& S, const Epi& E, unsigned long long* stamps, const int tid) {
    const int wid = __builtin_amdgcn_readfirstlane(tid >> 6), lane = tid & 63, wr = wid >> 2, wc = wid & 3, fr = lane & 15, fq = lane >> 4;
    const int K = g.K, nt = K / BK;
    int ts_lo = 0, ts_hi = 0, nts = 0; const unsigned long long rt_entry = STAMP ? (unsigned long long)wall_clock64() : 0ull;
#define PG8_STAMP() do { if (STAMP && wid == 0 && nts < 64) { const unsigned long long _c = (unsigned long long)clock64(); \
        ts_lo = (lane == nts) ? (int)(unsigned)_c : ts_lo; ts_hi = (lane == nts) ? (int)(unsigned)(_c >> 32) : ts_hi; ++nts; } } while (0)
    PG8_STAMP();
    unsigned voffA[2], voffB[2];
#pragma unroll
    for (int i = 0; i < 2; ++i) { int R, C; stage_rc(tid * 16 + i * 8192, R, C); const int Rb = Epi::PERM ? ((R & ~31) + perm32(R & 31)) : R;
        voffA[i] = (unsigned)(R * K + C) * 2u; voffB[i] = (unsigned)(Rb * K + C) * 2u; }
    const size_t kstep = (size_t)(BK * 2);
    const size_t hstep = (size_t)HALF * K * 2;
    const size_t tstep = 2 * hstep;
    const unsigned ldsw = (unsigned)wid * 1024u;
    const int aoff = lds_byte(wr * 64 + fr, fq * 8), boff = lds_byte(wc * 32 + fr, fq * 8);
#define PG8_SA(b, h) (((b) * 2 + (h)) * HTB)
#define PG8_SB(b, h) ((4 + (b) * 2 + (h)) * HTB)
#define PG8_STAGE(bufoff, gbase, voff) do { _Pragma("unroll") for (int _i = 0; _i < 2; ++_i) \
        __builtin_amdgcn_global_load_lds((const unsigned*)((const char*)(gbase) + (voff)[_i]), (PG8_LAS unsigned*)(lds + (bufoff) + ldsw + _i * 8192), 16, 0, 0); } while (0)
#define PG8_LDA(dst, b, h) do { _Pragma("unroll") for (int m = 0; m < 4; ++m) _Pragma("unroll") for (int k = 0; k < 2; ++k) dst[m][k] = *(const PG8_LAS bf16x8*)(lds + PG8_SA(b, h) + aoff + m * 2048 + k * 1024); } while (0)
#define PG8_LDB(dst, b, h) do { _Pragma("unroll") for (int n = 0; n < 2; ++n) _Pragma("unroll") for (int k = 0; k < 2; ++k) dst[n][k] = *(const PG8_LAS bf16x8*)(lds + PG8_SB(b, h) + boff + n * 2048 + k * 1024); } while (0)
#define PG8_MMA(ai, bj, At, Bt) do { __builtin_amdgcn_s_setprio(1); _Pragma("unroll") for (int m = 0; m < 4; ++m) _Pragma("unroll") for (int n = 0; n < 2; ++n) _Pragma("unroll") for (int k = 0; k < 2; ++k) \
        acc[ai][bj][m][n] = __builtin_amdgcn_mfma_f32_16x16x32_bf16(Bt[n][k], At[m][k], acc[ai][bj][m][n], 0, 0, 0); __builtin_amdgcn_s_setprio(0); } while (0)
#define PG8_WAIT_V(n) asm volatile("s_waitcnt vmcnt(" #n ")" ::: "memory")
#define PG8_WAIT_L(n) asm volatile("s_waitcnt lgkmcnt(" #n ")" ::: "memory")
#define PG8_BAR __builtin_amdgcn_s_barrier()
#define PG8_SCHED __builtin_amdgcn_sched_barrier(0)
    Unit cur, nxt; int ui = 0;
    if (!S.next(0, cur)) return;
    f32x4 acc[2][2][4][2];
#pragma unroll
    for (int a = 0; a < 2; ++a)
#pragma unroll
        for (int b = 0; b < 2; ++b)
#pragma unroll
            for (int m = 0; m < 4; ++m)
#pragma unroll
                for (int n = 0; n < 2; ++n) acc[a][b][m][n] = (f32x4){0.f, 0.f, 0.f, 0.f};
    bf16x8 At[4][2], B0[2][2], B1[2][2];
    const char* cA = (const char*)g.A + (size_t)cur.pm * tstep; const char* cB = (const char*)g.Bt + (size_t)cur.pn * tstep;
    S.a_ready(cur);
    PG8_STAGE(PG8_SB(0, 0), cB, voffB); PG8_STAGE(PG8_SA(0, 0), cA, voffA); PG8_STAGE(PG8_SB(0, 1), cB + hstep, voffB); PG8_STAGE(PG8_SA(0, 1), cA + hstep, voffA);
    if (wr == 1) PG8_BAR;
    PG8_WAIT_V(4); PG8_BAR;
    PG8_STAGE(PG8_SB(1, 0), cB + kstep, voffB); PG8_STAGE(PG8_SA(1, 0), cA + kstep, voffA); PG8_STAGE(PG8_SB(1, 1), cB + hstep + kstep, voffB);
    PG8_WAIT_V(6); PG8_BAR;
    PG8_STAMP();
    for (;;) {
        const bool has_next = S.next(ui + 1, nxt);
        const char* nA = has_next ? (const char*)g.A + (size_t)nxt.pm * tstep : cA; const char* nB = has_next ? (const char*)g.Bt + (size_t)nxt.pn * tstep : cB;
        for (int t = 0; t < nt; t += 2) {
            const bool last = (t == nt - 2);
            const char* a1 = cA + (size_t)(t + 1) * kstep;
            const char* a2 = last ? nA : cA + (size_t)(t + 2) * kstep; const char* b2 = last ? nB : cB + (size_t)(t + 2) * kstep;
            const char* a3 = a2 + kstep; const char* b3 = b2 + kstep;
            if (last && has_next) S.a_ready(nxt);
            PG8_LDB(B0, 0, 0); PG8_SCHED; PG8_LDA(At, 0, 0); PG8_STAGE(PG8_SA(1, 1), a1 + hstep, voffA);
            PG8_WAIT_L(8); PG8_BAR; PG8_WAIT_L(0); PG8_MMA(0, 0, At, B0); PG8_BAR; PG8_SCHED;
            PG8_LDB(B1, 0, 1); PG8_STAGE(PG8_SB(0, 0), b2, voffB);
            PG8_BAR; PG8_WAIT_L(0); PG8_MMA(0, 1, At, B1); PG8_BAR;
            PG8_LDA(At, 0, 1); PG8_STAGE(PG8_SA(0, 0), a2, voffA);
            PG8_BAR; PG8_WAIT_L(0); PG8_MMA(1, 0, At, B0); PG8_BAR; PG8_SCHED;
            PG8_STAGE(PG8_SB(0, 1), b2 + hstep, voffB);
            PG8_WAIT_V(6); PG8_BAR; PG8_MMA(1, 1, At, B1); PG8_BAR;
            PG8_LDB(B0, 1, 0); PG8_SCHED; PG8_LDA(At, 1, 0); PG8_STAGE(PG8_SA(0, 1), a2 + hstep, voffA);
            PG8_WAIT_L(8); PG8_BAR; PG8_WAIT_L(0); PG8_MMA(0, 0, At, B0); PG8_BAR; PG8_SCHED;
            PG8_LDB(B1, 1, 1); PG8_STAGE(PG8_SB(1, 0), b3, voffB);
            PG8_BAR; PG8_WAIT_L(0); PG8_MMA(0, 1, At, B1); PG8_BAR;
            PG8_LDA(At, 1, 1); PG8_STAGE(PG8_SA(1, 0), a3, voffA);
            PG8_BAR; PG8_WAIT_L(0); PG8_MMA(1, 0, At, B0); PG8_BAR; PG8_SCHED;
            PG8_STAGE(PG8_SB(1, 1), b3 + hstep, voffB);
            PG8_WAIT_V(6); PG8_BAR; PG8_MMA(1, 1, At, B1); PG8_BAR;
        }
        PG8_STAMP();
        if constexpr (!Epi::AFTER_DRAIN) { E(acc, cur, wr, wc, fr, fq); S.done(cur); }
        PG8_STAMP();
        if (!has_next) break;
#pragma unroll
        for (int a = 0; a < 2; ++a)
#pragma unroll
            for (int b = 0; b < 2; ++b)
#pragma unroll
                for (int m = 0; m < 4; ++m)
#pragma unroll
                    for (int n = 0; n < 2; ++n) acc[a][b][m][n] = (f32x4){0.f, 0.f, 0.f, 0.f};
        cur = nxt; cA = nA; cB = nB; ++ui;
    }
    PG8_WAIT_V(0);
    if (wr == 0) PG8_BAR;
    PG8_BAR;
    if constexpr (Epi::AFTER_DRAIN) { E.fused(acc, cur, wr, wc, fr, fq, lds, wid, lane); S.done(cur); }
    PG8_STAMP();
    if (STAMP && wid == 0) { stamps[lane] = lane < nts ? (((unsigned long long)(unsigned)ts_hi << 32) | (unsigned)ts_lo) : 0ull;
        if (lane == 62) stamps[62] = rt_entry; if (lane == 63) stamps[63] = (unsigned long long)wall_clock64(); }
#undef PG8_STAMP
#undef PG8_SA
#undef PG8_SB
#undef PG8_STAGE
#undef PG8_LDA
#undef PG8_LDB
#undef PG8_MMA
#undef PG8_WAIT_V
#undef PG8_WAIT_L
#undef PG8_BAR
#undef PG8_SCHED
}
}

template <class Epi> __device__ __forceinline__ void ph_gemm(const bf16_t* A, const bf16_t* Bt, int M, int N, int K, const Epi& E) {
    pg8::Gemm g; g.A = A; g.Bt = Bt; g.M = M; g.N = N; g.K = K;
    pg8::StaticOrder S; S.init(M, N, nblk_(), bid_());
    pg8::gemm_phase<Epi, pg8::StaticOrder, false>((PG8_LAS unsigned char*)dynsmem, g, S, E, nullptr, tid_());
}

__device__ __forceinline__ int pcol_to_orig(int c) {
    if (c < 768) return c;
    if (c < 1536) return c - 768 + 772;
    if (c < 1792) return c - 1536 + 1548;
    if (c < 1920) return c - 1792 + 1804;
    if (c < 2048) return c - 1920 + 1932;
    if (c < 2304) return c - 2048 + 2060;
    if (c < 2560) return c - 2304 + 2332;
    if (c < 2816) return c - 2560 + 2588;
    if (c < 2880) return c - 2816 + 2844;
    if (c < 2944) return c - 2880 + 2908;
    if (c < 3200) return c - 2944 + 2972;
    if (c < 3232) return c - 3200 + 3228;
    if (c < 3248) return c - 3232 + 2316;
    if (c < 3256) return c - 3248 + 3260;
    if (c < 3260) return c - 3256 + 768;
    if (c < 3264) return c - 3260 + 1540;
    if (c < 3268) return c - 3264 + 1544;
    return -1;
}
__device__ __forceinline__ void wtrans_job(const float* W, int K, int ldw, bf16_t* Wt, int Npad, bool mapped, float* tile) {
    const int tid = tid_();
    const int tn = Npad / 64, tk = K / 64;
    for (int t = bid_(); t < tn * tk; t += nblk_()) {
        const int n0 = (t / tk) * 64, k0 = (t % tk) * 64;
        __syncthreads();
        for (int idx = tid; idx < 4096; idx += 512) {
            const int kk = idx >> 6, nn = idx & 63;
            const int col = mapped ? pcol_to_orig(n0 + nn) : (n0 + nn);
            tile[kk * 65 + nn] = col >= 0 ? W[(size_t)(k0 + kk) * ldw + col] : 0.f;
        }
        __syncthreads();
        for (int idx = tid; idx < 4096; idx += 512) {
            const int nn = idx >> 6, kk = idx & 63;
            Wt[(size_t)(n0 + nn) * K + k0 + kk] = f2bf(tile[kk * 65 + nn]);
        }
    }
}
__device__ __forceinline__ void ph_weight_prep(const Ctx& p, float* sm) {
#pragma unroll 1
    for (int j = 0; j < 7 * DEPTH; ++j) {
        const int l = j / 7, w = j % 7;
        const float* W; int K, ldw, Npad; bf16_t* Wt; bool mapped = false;
        if (w == 0) { W = pin_(3) + (size_t)l * DM * 3268; K = DM; ldw = 3268; Npad = LDP; Wt = (bf16_t*)(pws_() + WT_IN) + (size_t)l * LDP * DM; mapped = true; }
        else if (w == 1) { W = pin_(20) + (size_t)l * DM * DM; K = DM; ldw = DM; Npad = DM; Wt = (bf16_t*)(pws_() + WT_OUT) + (size_t)l * DM * DM; }
        else if (w == 2) { W = pin_(23) + (size_t)l * DM * 256; K = DM; ldw = 256; Npad = 256; Wt = (bf16_t*)(pws_() + WT_XQ) + (size_t)l * 256 * DM; }
        else if (w == 3) { W = pin_(24) + (size_t)l * DM * 256; K = DM; ldw = 256; Npad = 256; Wt = (bf16_t*)(pws_() + WT_XK) + (size_t)l * 256 * DM; }
        else if (w == 4) { W = pin_(25) + (size_t)l * DM * 256; K = DM; ldw = 256; Npad = 256; Wt = (bf16_t*)(pws_() + WT_XV) + (size_t)l * 256 * DM; }
        else if (w == 5) { W = pin_(26) + (size_t)l * 256 * DM; K = 256; ldw = DM; Npad = DM; Wt = (bf16_t*)(pws_() + WT_XO) + (size_t)l * DM * 256; }
        else { W = pin_(30) + (size_t)l * DM * DM; K = DM; ldw = DM; Npad = DM; Wt = (bf16_t*)(pws_() + WT_PQ) + (size_t)l * DM * DM; }
        wtrans_job(W, K, ldw, Wt, Npad, mapped, sm);
    }
}

__device__ __forceinline__ void ph_rmsnorm(const float* __restrict__ x, const float* __restrict__ g, bf16_t* __restrict__ out, int rows) {
    const int lane = tid_() & 63;
    for (int r = gwave(); r < rows; r += nwaves()) {
        const float4* xr = (const float4*)(x + (size_t)r * DM);
        float4 v[4]; float ss = 0.f;
#pragma unroll
        for (int i = 0; i < 4; ++i) { v[i] = xr[lane + 64 * i]; ss += v[i].x * v[i].x + v[i].y * v[i].y + v[i].z * v[i].z + v[i].w * v[i].w; }
        ss = wave_sum(ss);
        const float rs = rsqrtf(ss * (1.f / DM) + EPS);
#pragma unroll
        for (int i = 0; i < 4; ++i) {
            const float4 gg = ((const float4*)g)[lane + 64 * i];
            ushort4 o; o.x = f2bf(v[i].x * rs * gg.x); o.y = f2bf(v[i].y * rs * gg.y); o.z = f2bf(v[i].z * rs * gg.z); o.w = f2bf(v[i].w * rs * gg.w);
            *(ushort4*)(out + (size_t)r * DM + (size_t)(lane + 64 * i) * 4) = o;
        }
    }
}

template <int OUTMODE>
__device__ __forceinline__ void ph_sgemm(const bf16_t* __restrict__ A, int lda, const float* __restrict__ B, int ldb, void* Cv, int ldc, const float* R, int ldr,
                         int M, int N, int K, float* smem) {
    float* As = smem;
    float* Bs = smem + 16 * 132;
    const int tid = tid_(), tx = tid & 31, ty = tid >> 5;
    const int ntn = N / 128, ntiles = (M / 128) * ntn;
    for (int tile = bid_(); tile < ntiles; tile += nblk_()) {
        const int tm = tile / ntn, tn = tile % ntn;
        float acc[8][4];
#pragma unroll
        for (int i = 0; i < 8; ++i)
#pragma unroll
            for (int j = 0; j < 4; ++j) acc[i][j] = 0.f;
        const int arow = tid >> 2, akq = (tid & 3) * 4;
        const int bk = tid >> 5, bn = (tid & 31) * 4;
        for (int k0 = 0; k0 < K; k0 += 16) {
            const ushort4 av = *(const ushort4*)(A + (size_t)(tm * 128 + arow) * lda + k0 + akq);
            const float4 bv = *(const float4*)(B + (size_t)(k0 + bk) * ldb + tn * 128 + bn);
            __syncthreads();
            As[(akq + 0) * 132 + arow] = bf2f(av.x); As[(akq + 1) * 132 + arow] = bf2f(av.y);
            As[(akq + 2) * 132 + arow] = bf2f(av.z); As[(akq + 3) * 132 + arow] = bf2f(av.w);
            *(float4*)(Bs + bk * 132 + bn) = bv;
            __syncthreads();
#pragma unroll
            for (int k = 0; k < 16; ++k) {
                const float4 a0 = *(const float4*)(As + k * 132 + ty * 8), a1 = *(const float4*)(As + k * 132 + ty * 8 + 4);
                const float4 b = *(const float4*)(Bs + k * 132 + tx * 4);
                const float a[8] = {a0.x, a0.y, a0.z, a0.w, a1.x, a1.y, a1.z, a1.w};
#pragma unroll
                for (int i = 0; i < 8; ++i) { acc[i][0] += a[i] * b.x; acc[i][1] += a[i] * b.y; acc[i][2] += a[i] * b.z; acc[i][3] += a[i] * b.w; }
            }
        }
#pragma unroll
        for (int i = 0; i < 8; ++i) {
            const size_t row = (size_t)tm * 128 + ty * 8 + i; const int col = tn * 128 + tx * 4;
            if (OUTMODE == 0) {
                ushort4 o; o.x = f2bf(acc[i][0]); o.y = f2bf(acc[i][1]); o.z = f2bf(acc[i][2]); o.w = f2bf(acc[i][3]);
                *(ushort4*)((bf16_t*)Cv + row * ldc + col) = o;
            } else if (OUTMODE == 1) {
                *(float4*)((float*)Cv + row * ldc + col) = make_float4(acc[i][0], acc[i][1], acc[i][2], acc[i][3]);
            } else {
                const float4 r = *(const float4*)(R + row * ldr + col);
                *(float4*)((float*)Cv + row * ldc + col) = make_float4(r.x + acc[i][0], r.y + acc[i][1], r.z + acc[i][2], r.w + acc[i][3]);
            }
        }
    }
}

#define WS_HS WS_H
#define WS_VG WS_YPRE
#define WS_DEC (WS_YPRE + (size_t)MTOK * 256 * 2)

__device__ __forceinline__ float quad_sum(float v) {
    v += __int_as_float(__builtin_amdgcn_mov_dpp(__float_as_int(v), 0xB1, 0xF, 0xF, true));
    v += __int_as_float(__builtin_amdgcn_mov_dpp(__float_as_int(v), 0x4E, 0xF, 0xF, true));
    return v;
}
__device__ __forceinline__ float bflo(unsigned w) { return __uint_as_float(w << 16); }
__device__ __forceinline__ float bfhi(unsigned w) { return __uint_as_float(w & 0xffff0000u); }

__device__ __forceinline__ float oct_sum(float v) {
    v += __int_as_float(__builtin_amdgcn_mov_dpp(__float_as_int(v), 0xB1, 0xF, 0xF, true));
    v += __int_as_float(__builtin_amdgcn_mov_dpp(__float_as_int(v), 0x4E, 0xF, 0xF, true));
    v += __int_as_float(__builtin_amdgcn_mov_dpp(__float_as_int(v), 0x141, 0xF, 0xF, true));
    return v;
}
__device__ __forceinline__ void unpack8(const uint4 r, float (&o)[8]) {
    o[0] = bflo(r.x); o[1] = bfhi(r.x); o[2] = bflo(r.y); o[3] = bfhi(r.y); o[4] = bflo(r.z); o[5] = bfhi(r.z); o[6] = bflo(r.w); o[7] = bfhi(r.w);
}
__device__ __forceinline__ uint4 pack8(const float (&v)[8]) {
    uint4 o; o.x = pk_bf16(v[0], v[1]); o.y = pk_bf16(v[2], v[3]); o.z = pk_bf16(v[4], v[5]); o.w = pk_bf16(v[6], v[7]); return o;
}
__device__ __forceinline__ void load8f(const float* p, float (&o)[8]) {
    const float4 a = *(const float4*)p, b = *(const float4*)(p + 4);
    o[0] = a.x; o[1] = a.y; o[2] = a.z; o[3] = a.w; o[4] = b.x; o[5] = b.y; o[6] = b.z; o[7] = b.w;
}
__device__ __forceinline__ void conv8(const bf16_t* P, size_t tok, int t, int pcol, const float* w, int ldw, int cc, float (&acc)[8]) {
#pragma unroll
    for (int j = 0; j < 4; ++j) {
        if (t - 3 + j >= 0) {
            float xv[8], wv[8];
            unpack8(*(const uint4*)(P + (tok - (size_t)(3 - j)) * LDP + pcol), xv);
            load8f(w + j * ldw + cc, wv);
#pragma unroll
            for (int i = 0; i < 8; ++i) acc[i] = __builtin_fmaf(wv[i], xv[i], acc[i]);
        }
    }
}
__device__ __forceinline__ void ph_scan_prep(const Ctx& p, int l) {
    const bf16_t* P = (const bf16_t*)(pws_() + WS_P);
    bf16_t* HS = (bf16_t*)(pws_() + WS_HS);
    bf16_t* VG = (bf16_t*)(pws_() + WS_VG);
    float* DEC = (float*)(pws_() + WS_DEC);
    float* SC = (float*)(pws_() + WS_SC);
    const float* scw = pin_(4) + (size_t)l * 4 * 512;
    const float* scb = pin_(5) + (size_t)l * 512;
    const float* gcw = pin_(10) + (size_t)l * 4 * 768;
    const float* wg = pin_(14) + (size_t)l * 16 * 128;
    const float* bg = pin_(15) + (size_t)l * 128;
    const int lane = tid_() & 63;
    for (int tok = gwave(); tok < MTOK; tok += nwaves()) {
        const int t = tok % SEQ;
        const size_t row = (size_t)tok * LDP;
        {
            float acc[8];
            load8f(scb + 8 * lane, acc);
            conv8(P, (size_t)tok, t, PC_XBC + 8 * lane, scw, 512, 8 * lane, acc);
#pragma unroll
            for (int i = 0; i < 8; ++i) acc[i] = silu_f(acc[i]);
            *(uint4*)(HS + (size_t)tok * 1024 + 8 * lane) = pack8(acc);
        }
        {
            float acc[8];
#pragma unroll
            for (int i = 0; i < 8; ++i) acc[i] = 0.f;
            conv8(P, (size_t)tok, t, PC_GQKV + 8 * lane, gcw, 768, 8 * lane, acc);
            float ss = 0.f;
#pragma unroll
            for (int i = 0; i < 8; ++i) { acc[i] = silu_f(acc[i]); ss += acc[i] * acc[i]; }
            ss = oct_sum(ss);
            const float sc = rsqrtf(ss + EPS) * (lane < 32 ? 0.125f : 1.f);
#pragma unroll
            for (int i = 0; i < 8; ++i) acc[i] *= sc;
            *(uint4*)(HS + (size_t)tok * 1024 + 512 + 8 * lane) = pack8(acc);
        }
        if (lane < 32) {
            float acc[8];
#pragma unroll
            for (int i = 0; i < 8; ++i) acc[i] = 0.f;
            conv8(P, (size_t)tok, t, PC_GQKV + 512 + 8 * lane, gcw, 768, 512 + 8 * lane, acc);
#pragma unroll
            for (int i = 0; i < 8; ++i) acc[i] = silu_f(acc[i]);
            *(uint4*)(VG + (size_t)tok * 256 + 8 * lane) = pack8(acc);
        }
        if (lane < 16) {
            const int h = lane & 3, which = lane >> 2;
            float v;
            if (which < 2) {
                const float dt = softplus_f(bf2f(P[row + PC_DT + h]) + pin_(6)[l * 4 + h]);
                v = which == 0 ? dt : __expf(-dt * __expf(pin_(7)[l * 4 + h]));
            } else if (which == 2) {
                v = __expf(-__expf(pin_(11)[l * 4 + h]) * softplus_f(bf2f(P[row + PC_GA + h]) + pin_(12)[l * 4 + h]));
            } else {
                v = sigmoid_f(bf2f(P[row + PC_GB + h]));
            }
            SC[(size_t)tok * 16 + lane] = v;
        }
        {
            float gl[16];
            { float a8[8], b8[8]; unpack8(*(const uint4*)(P + row + PC_GLR), a8); unpack8(*(const uint4*)(P + row + PC_GLR + 8), b8);
#pragma unroll
              for (int i = 0; i < 8; ++i) { gl[i] = a8[i]; gl[8 + i] = b8[i]; } }
#pragma unroll
            for (int i = 0; i < 2; ++i) {
                const int c = lane + 64 * i;
                float acc = bg[c];
#pragma unroll
                for (int r = 0; r < 16; ++r) acc = __builtin_fmaf(gl[r], wg[r * 128 + c], acc);
                DEC[(size_t)tok * 128 + c] = __expf(logsigmoid_f(acc) * (1.f / 16.f));
            }
        }
    }
}

#define SCAN_LDS_WAVE 2560
__device__ __forceinline__ void ph_scans(const Ctx& p, int l, float* smem) {
    const bf16_t* P = (const bf16_t*)(pws_() + WS_P);
    const bf16_t* HS = (const bf16_t*)(pws_() + WS_HS);
    const bf16_t* VG = (const bf16_t*)(pws_() + WS_VG);
    const float* DEC = (const float*)(pws_() + WS_DEC);
    const float* SC = (const float*)(pws_() + WS_SC);
    bf16_t* Y = (bf16_t*)(pws_() + WS_Y);
    const int tid = tid_(), lane = tid & 63, wave = tid >> 6;
    if (nblk_() != 256) return;
    const int role = wave < 2 ? 0 : (wave < 6 ? 1 : 2);
    const int idx = (role == 0 ? wave : (role == 1 ? wave - 2 : wave - 6)) * 256 + bid_();
    const int bh = role == 1 ? (idx >> 3) : (idx >> 2), b = bh >> 2, h = bh & 3;
    const int colbase = role == 1 ? (idx & 7) * 8 : (idx & 3) * 16;
    const int cl = role == 1 ? (lane >> 3) : (lane >> 2);
    const int col = colbase + cl;
    const int sq = role == 1 ? (lane & 7) : (lane & 3);
    const size_t tb = (size_t)b * SEQ;
    char* lw = (char*)smem + wave * SCAN_LDS_WAVE;
    char* lrow = lw;
    char* lcol = lw + 2048;
    float* lsc = (float*)(lw + 2304);
    const int fs = lane >> 3, fp = lane & 7;
    uint4 f0, f1; unsigned fc = 0u; float fsc = 0.f;
    if (role == 0) {
        const int g = h >> 1;
        const float Dh = pin_(8)[l * 4 + h];
        float st[16];
#pragma unroll
        for (int i = 0; i < 16; ++i) st[i] = 0.f;
        auto fetch = [&](int t0) {
            const size_t tok = tb + t0 + fs;
            const bf16_t* src = HS + tok * 1024 + (fp < 4 ? 256 + g * 64 + fp * 16 : 384 + g * 64 + (fp - 4) * 16);
            f0 = *(const uint4*)src; f1 = *(const uint4*)(src + 8);
            fc = *(const unsigned*)(HS + tok * 1024 + h * 64 + colbase + fp * 2);
            if (lane < 16) fsc = SC[(tb + t0 + (lane >> 1)) * 16 + (lane & 1) * 4 + h];
        };
        fetch(0);
        for (int t0 = 0; t0 < SEQ; t0 += 8) {
            *(uint4*)(lrow + fs * 256 + fp * 32) = f0; *(uint4*)(lrow + fs * 256 + fp * 32 + 16) = f1;
            *(unsigned*)(lcol + fs * 32 + fp * 4) = fc;
            if (lane < 16) lsc[lane] = fsc;
            if (t0 + 8 < SEQ) fetch(t0 + 8);
#pragma unroll
            for (int i = 0; i < 8; ++i) {
                const uint4 b0 = *(const uint4*)(lrow + i * 256 + sq * 32), b1 = *(const uint4*)(lrow + i * 256 + sq * 32 + 16);
                const uint4 c0 = *(const uint4*)(lrow + i * 256 + 128 + sq * 32), c1 = *(const uint4*)(lrow + i * 256 + 128 + sq * 32 + 16);
                const float xv = bf2f(*(const bf16_t*)(lcol + i * 32 + cl * 2));
                const float2 sc2 = *(const float2*)(lsc + i * 2);
                const unsigned bw[8] = {b0.x, b0.y, b0.z, b0.w, b1.x, b1.y, b1.z, b1.w};
                const unsigned cw[8] = {c0.x, c0.y, c0.z, c0.w, c1.x, c1.y, c1.z, c1.w};
                const float xdt = xv * sc2.x, dA = sc2.y;
                float y0 = 0.f, y1 = 0.f;
#pragma unroll
                for (int q = 0; q < 8; ++q) {
                    st[2 * q] = __builtin_fmaf(st[2 * q], dA, xdt * bflo(bw[q]));
                    st[2 * q + 1] = __builtin_fmaf(st[2 * q + 1], dA, xdt * bfhi(bw[q]));
                    y0 = __builtin_fmaf(bflo(cw[q]), st[2 * q], y0);
                    y1 = __builtin_fmaf(bfhi(cw[q]), st[2 * q + 1], y1);
                }
                const float y = quad_sum(y0 + y1);
                if (sq == 0) Y[(tb + t0 + i) * DM + h * 64 + col] = f2bf(y + Dh * xv);
            }
        }
    } else if (role == 1) {
        float S[8];
#pragma unroll
        for (int i = 0; i < 8; ++i) S[i] = 0.f;
        auto fetch = [&](int t0) {
            const size_t tok = tb + t0 + fs;
            const bf16_t* src = HS + tok * 1024 + (fp < 4 ? 512 + h * 64 + fp * 16 : 768 + h * 64 + (fp - 4) * 16);
            f0 = *(const uint4*)src; f1 = *(const uint4*)(src + 8);
            if (fp < 4) fc = *(const unsigned*)(VG + tok * 256 + h * 64 + colbase + fp * 2);
            if (lane < 16) fsc = SC[(tb + t0 + (lane >> 1)) * 16 + 8 + (lane & 1) * 4 + h];
        };
        fetch(0);
        for (int t0 = 0; t0 < SEQ; t0 += 8) {
            *(uint4*)(lrow + fs * 256 + fp * 32) = f0; *(uint4*)(lrow + fs * 256 + fp * 32 + 16) = f1;
            if (fp < 4) *(unsigned*)(lcol + fs * 32 + fp * 4) = fc;
            if (lane < 16) lsc[lane] = fsc;
            if (t0 + 8 < SEQ) fetch(t0 + 8);
#pragma unroll
            for (int i = 0; i < 8; ++i) {
                const uint4 q0 = *(const uint4*)(lrow + i * 256 + sq * 16);
                const uint4 k0 = *(const uint4*)(lrow + i * 256 + 128 + sq * 16);
                const float vv = bf2f(*(const bf16_t*)(lcol + i * 32 + cl * 2));
                const float2 sc2 = *(const float2*)(lsc + i * 2);
                const unsigned kw[4] = {k0.x, k0.y, k0.z, k0.w}, qw[4] = {q0.x, q0.y, q0.z, q0.w};
                float r0 = 0.f, r1 = 0.f;
#pragma unroll
                for (int q = 0; q < 4; ++q) {
                    S[2 * q] *= sc2.x; S[2 * q + 1] *= sc2.x;
                    r0 = __builtin_fmaf(S[2 * q], bflo(kw[q]), r0);
                    r1 = __builtin_fmaf(S[2 * q + 1], bfhi(kw[q]), r1);
                }
                const float r = oct_sum(r0 + r1);
                const float vn = sc2.y * (vv - r);
                float o0 = 0.f, o1 = 0.f;
#pragma unroll
                for (int q = 0; q < 4; ++q) {
                    S[2 * q] = __builtin_fmaf(bflo(kw[q]), vn, S[2 * q]);
                    S[2 * q + 1] = __builtin_fmaf(bfhi(kw[q]), vn, S[2 * q + 1]);
                    o0 = __builtin_fmaf(S[2 * q], bflo(qw[q]), o0);
                    o1 = __builtin_fmaf(S[2 * q + 1], bfhi(qw[q]), o1);
                }
                const float ov = oct_sum(o0 + o1);
                if (sq == 0) Y[(tb + t0 + i) * DM + 256 + h * 64 + col] = f2bf(ov);
            }
        }
    } else {
        float S[8];
#pragma unroll
        for (int i = 0; i < 8; ++i) S[i] = 0.f;
        auto fetch = [&](int t0) {
            const size_t tok = tb + t0 + fs;
            if (fp < 4) { const float* src = DEC + tok * 128 + h * 32 + fp * 8; f0 = *(const uint4*)src; f1 = *(const uint4*)(src + 4); }
            else { const bf16_t* src = P + tok * LDP + (fp < 6 ? PC_LK + h * 32 + (fp - 4) * 16 : PC_LQ + h * 32 + (fp - 6) * 16); f0 = *(const uint4*)src; f1 = *(const uint4*)(src + 8); }
            fc = *(const unsigned*)(P + tok * LDP + PC_LV + h * 64 + colbase + fp * 2);
        };
        fetch(0);
        for (int t0 = 0; t0 < SEQ; t0 += 8) {
            *(uint4*)(lrow + fs * 256 + fp * 32) = f0; *(uint4*)(lrow + fs * 256 + fp * 32 + 16) = f1;
            *(unsigned*)(lcol + fs * 32 + fp * 4) = fc;
            if (t0 + 8 < SEQ) fetch(t0 + 8);
#pragma unroll
            for (int i = 0; i < 8; ++i) {
                const float4 d0 = *(const float4*)(lrow + i * 256 + sq * 32), d1 = *(const float4*)(lrow + i * 256 + sq * 32 + 16);
                const uint4 k0 = *(const uint4*)(lrow + i * 256 + 128 + sq * 16);
                const uint4 q0 = *(const uint4*)(lrow + i * 256 + 192 + sq * 16);
                const float vv = bf2f(*(const bf16_t*)(lcol + i * 32 + cl * 2));
                const unsigned kw[4] = {k0.x, k0.y, k0.z, k0.w}, qw[4] = {q0.x, q0.y, q0.z, q0.w};
                const float dd[8] = {d0.x, d0.y, d0.z, d0.w, d1.x, d1.y, d1.z, d1.w};
                float o0 = 0.f, o1 = 0.f;
#pragma unroll
                for (int q = 0; q < 4; ++q) {
                    S[2 * q] = __builtin_fmaf(dd[2 * q], S[2 * q], bflo(kw[q]) * vv);
                    S[2 * q + 1] = __builtin_fmaf(dd[2 * q + 1], S[2 * q + 1], bfhi(kw[q]) * vv);
                    o0 = __builtin_fmaf(S[2 * q], bflo(qw[q]), o0);
                    o1 = __builtin_fmaf(S[2 * q + 1], bfhi(qw[q]), o1);
                }
                const float ov = quad_sum(o0 + o1);
                if (sq == 0) Y[(tb + t0 + i) * DM + 512 + h * 64 + col] = f2bf(ov * 0.17677669529663687f);
            }
        }
    }
}

__device__ __forceinline__ void ph_mixer_finish(const Ctx& p, int l) {
    const bf16_t* P = (const bf16_t*)(pws_() + WS_P);
    bf16_t* Y = (bf16_t*)(pws_() + WS_Y);
    const float* sn = pin_(9) + (size_t)l * 256;
    const float* gn = pin_(13) + (size_t)l * 64;
    const float* ln = pin_(16) + (size_t)l * 64;
    const int lane = tid_() & 63;
    for (int tok = gwave(); tok < MTOK; tok += nwaves()) {
        const size_t row = (size_t)tok * LDP;
        {
            float v[8], gt[8], gw[8];
            unpack8(*(const uint4*)(Y + (size_t)tok * DM + 8 * lane), v);
            unpack8(*(const uint4*)(P + row + (lane < 32 ? PC_Z + 8 * lane : PC_GG + 8 * (lane - 32))), gt);
            load8f(lane < 32 ? sn + 8 * lane : gn + 8 * (lane & 7), gw);
            float ss = 0.f;
            if (lane < 32) {
#pragma unroll
                for (int i = 0; i < 8; ++i) { v[i] *= silu_f(gt[i]); ss += v[i] * v[i]; }
            } else {
#pragma unroll
                for (int i = 0; i < 8; ++i) ss += v[i] * v[i];
            }
            const float s8 = oct_sum(ss);
            float s32 = s8 + __int_as_float(__builtin_amdgcn_mov_dpp(__float_as_int(s8), 0x140, 0xF, 0xF, true));
            s32 += __shfl_xor(s32, 16, 64);
            const float rs = lane < 32 ? rsqrtf(s32 * (1.f / 256.f) + EPS) : rsqrtf(s8 * (1.f / 64.f) + EPS);
            float o[8];
#pragma unroll
            for (int i = 0; i < 8; ++i) o[i] = lane < 32 ? v[i] * rs * gw[i] : v[i] * rs * gw[i] * silu_f(gt[i]);
            *(uint4*)(Y + (size_t)tok * DM + 8 * lane) = pack8(o);
        }
        if (lane < 32) {
            float v[8], gt[8], gw[8];
            unpack8(*(const uint4*)(Y + (size_t)tok * DM + 512 + 8 * lane), v);
            unpack8(*(const uint4*)(P + row + PC_LR + 8 * lane), gt);
            load8f(ln + 8 * (lane & 7), gw);
            float ss = 0.f;
#pragma unroll
            for (int i = 0; i < 8; ++i) ss += v[i] * v[i];
            const float rs = rsqrtf(oct_sum(ss) * (1.f / 64.f) + EPS);
            float o[8];
#pragma unroll
            for (int i = 0; i < 8; ++i) o[i] = v[i] * rs * gw[i] * silu_f(gt[i]);
            *(uint4*)(Y + (size_t)tok * DM + 512 + 8 * lane) = pack8(o);
        }
    }
}

typedef short bf16x8_t __attribute__((ext_vector_type(8)));
typedef float f32x4_t __attribute__((ext_vector_type(4)));
union BF8 { bf16x8_t v; uint4 u; unsigned w[4]; };


__device__ __forceinline__ void ph_dsa_prep(const Ctx& p, int l) {
    const bf16_t* P = (const bf16_t*)(pws_() + WS_P);
    bf16_t* qn = (bf16_t*)(pws_() + WS_QN);
    bf16_t* kn = (bf16_t*)(pws_() + WS_KN);
    bf16_t* ikn = (bf16_t*)(pws_() + WS_IKN);
    bf16_t* vt = (bf16_t*)(pws_() + WS_VT);
    const float* qg = pin_(17) + (size_t)l * 64;
    const float* kg = pin_(18) + (size_t)l * 64;
    const float* ig = pin_(19) + (size_t)l * 32;
    const int lane = tid_() & 63;
    const int pcol = lane < 40 ? PC_DQ + 8 * lane : PC_IK + 8 * (lane & 3);
    float gw[8];
    load8f(lane < 32 ? qg + 8 * (lane & 7) : (lane < 40 ? kg + 8 * (lane & 7) : ig + 8 * (lane & 3)), gw);
    for (int grp = gwave(); grp < MTOK / 8; grp += nwaves()) {
        const size_t tok0 = (size_t)grp * 8;
        const int b = (int)(tok0 / SEQ), t0 = (int)(tok0 % SEQ);
        unsigned short vv[8];
#pragma unroll
        for (int i = 0; i < 8; ++i) {
            const size_t row = (tok0 + i) * LDP;
            vv[i] = P[row + PC_DV + lane];
            if (lane < 44) {
                float v[8];
                unpack8(*(const uint4*)(P + row + pcol), v);
                float ss = 0.f;
#pragma unroll
                for (int q = 0; q < 8; ++q) ss += v[q] * v[q];
                const float s4 = ss + __int_as_float(__builtin_amdgcn_mov_dpp(__float_as_int(ss), 0xB1, 0xF, 0xF, true));
                const float s4b = s4 + __int_as_float(__builtin_amdgcn_mov_dpp(__float_as_int(s4), 0x4E, 0xF, 0xF, true));
                const float s8 = s4b + __int_as_float(__builtin_amdgcn_mov_dpp(__float_as_int(s4b), 0x141, 0xF, 0xF, true));
                const float rs = lane < 40 ? rsqrtf(s8 * (1.f / 64.f) + EPS) * (lane < 32 ? 0.125f : 1.f) : rsqrtf(s4b * (1.f / 32.f) + EPS);
                float o[8];
#pragma unroll
                for (int q = 0; q < 8; ++q) o[q] = v[q] * rs * gw[q];
                const uint4 pk = pack8(o);
                if (lane < 32) *(uint4*)(qn + (tok0 + i) * 256 + 8 * lane) = pk;
                else if (lane < 40) *(uint4*)(kn + (tok0 + i) * 64 + 8 * (lane - 32)) = pk;
                else *(uint4*)(ikn + (tok0 + i) * 32 + 8 * (lane - 40)) = pk;
            }
        }
        uint4 o; o.x = (unsigned)vv[0] | ((unsigned)vv[1] << 16); o.y = (unsigned)vv[2] | ((unsigned)vv[3] << 16);
        o.z = (unsigned)vv[4] | ((unsigned)vv[5] << 16); o.w = (unsigned)vv[6] | ((unsigned)vv[7] << 16);
        *(uint4*)(vt + ((size_t)b * 64 + lane) * SEQ + t0) = o;
    }
}

#define DSA_STRIDE 2052
__device__ __forceinline__ void ph_dsa_main(const Ctx& p, int l, float* smem) {
    const bf16_t* P = (const bf16_t*)(pws_() + WS_P);
    bf16_t* Y = (bf16_t*)(pws_() + WS_Y);
    const bf16_t* QN = (const bf16_t*)(pws_() + WS_QN);
    const bf16_t* KN = (const bf16_t*)(pws_() + WS_KN);
    const bf16_t* IKN = (const bf16_t*)(pws_() + WS_IKN);
    const bf16_t* VT = (const bf16_t*)(pws_() + WS_VT);
    unsigned* sc = (unsigned*)smem;
    float* part = smem;
    float* plsum = smem + 8 * 64 * 64;
    unsigned* thr = (unsigned*)(smem + 35000);
    const int tid = tid_(), lane = tid & 63, w = tid >> 6, qi = lane & 15, g = lane >> 4;
    for (int task = bid_(); task < MTOK / 16; task += nblk_()) {
        const int c = 31 - task / 128, b = (task >> 2) & 31, sub = task & 3;
        const int t0 = c * 64 + sub * 16, nk = (c + 1) * 64;
        const size_t tok0 = (size_t)b * SEQ + t0;
        const bool dosel = nk > 256;
        if (dosel) {
            BF8 iqf[8]; float wq[8];
#pragma unroll
            for (int h = 0; h < 8; ++h) {
                iqf[h].u = *(const uint4*)(P + (tok0 + qi) * LDP + PC_IQ + h * 32 + 8 * g);
                wq[h] = bf2f(P[(tok0 + qi) * LDP + PC_IW + h]) * 0.0625f;
            }
            for (int kt = w; kt < nk / 16; kt += 8) {
                const int s0 = kt * 16;
                BF8 ka; ka.u = *(const uint4*)(IKN + ((size_t)b * SEQ + s0 + qi) * 32 + 8 * g);
                float acc[4] = {0.f, 0.f, 0.f, 0.f};
#pragma unroll
                for (int h = 0; h < 8; ++h) {
                    const f32x4_t d = __builtin_amdgcn_mfma_f32_16x16x32_bf16(ka.v, iqf[h].v, (f32x4_t){0.f, 0.f, 0.f, 0.f}, 0, 0, 0);
#pragma unroll
                    for (int r = 0; r < 4; ++r) acc[r] = __builtin_fmaf(wq[h], fmaxf(d[r], 0.f), acc[r]);
                }
                uint4 kv; kv.x = ford(acc[0]); kv.y = ford(acc[1]); kv.z = ford(acc[2]); kv.w = ford(acc[3]);
                *(uint4*)(sc + qi * DSA_STRIDE + s0 + 4 * g) = kv;
            }
        }
        __syncthreads();
        if (dosel) {
            const int nj = nk >> 6;
#pragma unroll 1
            for (int qq = 0; qq < 2; ++qq) {
                const int q = 2 * w + qq;
                unsigned kreg[32];
#pragma unroll
                for (int j = 0; j < 32; ++j) kreg[j] = (j < nj) ? sc[q * DSA_STRIDE + j * 64 + lane] : 0u;
                unsigned T = 0u; bool exact = false;
                for (int bit = 31; bit >= 0; --bit) {
                    const unsigned cand = T | (1u << bit);
                    int cnt = 0;
#pragma unroll
                    for (int j = 0; j < 32; ++j) cnt += __popcll(__ballot(kreg[j] >= cand));
                    if (cnt >= 256) { T = cand; if (cnt == 256) { exact = true; break; } }
                }
                int cut = 0x7fffffff;
                if (!exact) {
                    int cgt = 0, ceq = 0;
#pragma unroll
                    for (int j = 0; j < 32; ++j) { cgt += __popcll(__ballot(kreg[j] > T)); ceq += __popcll(__ballot(kreg[j] == T)); }
                    int need = 256 - cgt;
                    if (ceq > need) {
                        bool found = false;
#pragma unroll
                        for (int j = 0; j < 32; ++j) {
                            const unsigned long long m = __ballot(kreg[j] == T);
                            const int cj = __popcll(m);
                            if (!found) {
                                if (need <= cj) { for (int bpos = 0; bpos < 64; ++bpos) if ((m >> bpos) & 1ull) { if (--need == 0) { cut = j * 64 + bpos; break; } } found = true; }
                                else need -= cj;
                            }
                        }
                    }
                }
                if (lane == 0) { thr[q] = T; thr[16 + q] = (unsigned)cut; }
            }
        }
        __syncthreads();
        unsigned Tq = 0u; int cutq = 0x7fffffff;
        if (dosel) { Tq = thr[qi]; cutq = (int)thr[16 + qi]; }
        f32x4_t oacc[4][4]; float lsum[4];
#pragma unroll
        for (int h = 0; h < 4; ++h) { lsum[h] = 0.f;
#pragma unroll
            for (int dt = 0; dt < 4; ++dt) oacc[h][dt] = (f32x4_t){0.f, 0.f, 0.f, 0.f}; }
        const int krow = 8 * (qi >> 2) + (qi & 3);
        for (int st = w; st < nk / 32; st += 8) {
            const int s0 = st * 32;
            BF8 ka[2][2], va[4];
#pragma unroll
            for (int t = 0; t < 2; ++t)
#pragma unroll
                for (int s2 = 0; s2 < 2; ++s2) ka[t][s2].u = *(const uint4*)(KN + ((size_t)b * SEQ + s0 + krow + 4 * t) * 64 + 32 * s2 + 8 * g);
#pragma unroll
            for (int dt = 0; dt < 4; ++dt) va[dt].u = *(const uint4*)(VT + ((size_t)b * 64 + 16 * dt + qi) * SEQ + s0 + 8 * g);
            float mk[8];
            if (dosel) {
                const uint4 k0 = *(const uint4*)(sc + qi * DSA_STRIDE + s0 + 8 * g), k1 = *(const uint4*)(sc + qi * DSA_STRIDE + s0 + 8 * g + 4);
                const unsigned kk[8] = {k0.x, k0.y, k0.z, k0.w, k1.x, k1.y, k1.z, k1.w};
#pragma unroll
                for (int j = 0; j < 8; ++j) mk[j] = (kk[j] > Tq || (kk[j] == Tq && (s0 + 8 * g + j) <= cutq)) ? 1.f : 0.f;
            } else {
#pragma unroll
                for (int j = 0; j < 8; ++j) mk[j] = 1.f;
            }
#pragma unroll
            for (int h = 0; h < 4; ++h) {
                BF8 q0, q1;
                q0.u = *(const uint4*)(QN + (tok0 + qi) * 256 + h * 64 + 8 * g);
                q1.u = *(const uint4*)(QN + (tok0 + qi) * 256 + h * 64 + 32 + 8 * g);
                f32x4_t sacc[2];
#pragma unroll
                for (int t = 0; t < 2; ++t) {
                    sacc[t] = __builtin_amdgcn_mfma_f32_16x16x32_bf16(ka[t][0].v, q0.v, (f32x4_t){0.f, 0.f, 0.f, 0.f}, 0, 0, 0);
                    sacc[t] = __builtin_amdgcn_mfma_f32_16x16x32_bf16(ka[t][1].v, q1.v, sacc[t], 0, 0, 0);
                }
                float pe[8];
#pragma unroll
                for (int t = 0; t < 2; ++t)
#pragma unroll
                    for (int r = 0; r < 4; ++r) { pe[4 * t + r] = __expf(sacc[t][r]) * mk[4 * t + r]; lsum[h] += pe[4 * t + r]; }
                BF8 pf;
#pragma unroll
                for (int j = 0; j < 4; ++j) pf.w[j] = pk_bf16(pe[2 * j], pe[2 * j + 1]);
#pragma unroll
                for (int dt = 0; dt < 4; ++dt) oacc[h][dt] = __builtin_amdgcn_mfma_f32_16x16x32_bf16(va[dt].v, pf.v, oacc[h][dt], 0, 0, 0);
            }
        }
        __syncthreads();
#pragma unroll
        for (int h = 0; h < 4; ++h) {
            plsum[(w * 4 + h) * 64 + lane] = lsum[h];
#pragma unroll
            for (int dt = 0; dt < 4; ++dt)
#pragma unroll
                for (int r = 0; r < 4; ++r) part[(w * 64 + h * 16 + dt * 4 + r) * 64 + lane] = oacc[h][dt][r];
        }
        __syncthreads();
        {
            const int h = w >> 1;
            float lq = 0.f;
#pragma unroll
            for (int w2 = 0; w2 < 8; ++w2)
#pragma unroll
                for (int g2 = 0; g2 < 4; ++g2) lq += plsum[(w2 * 4 + h) * 64 + qi + 16 * g2];
            const float inv = 1.f / lq;
#pragma unroll
            for (int dd = 0; dd < 2; ++dd) {
                const int dt = (w & 1) * 2 + dd;
                float o[4];
#pragma unroll
                for (int r = 0; r < 4; ++r) {
                    float sacc = 0.f;
#pragma unroll
                    for (int w2 = 0; w2 < 8; ++w2) sacc += part[(w2 * 64 + h * 16 + dt * 4 + r) * 64 + lane];
                    o[r] = sacc * inv;
                }
                uint2 ov; ov.x = pk_bf16(o[0], o[1]); ov.y = pk_bf16(o[2], o[3]);
                *(uint2*)(Y + (tok0 + qi) * DM + 768 + h * 64 + 16 * dt + 4 * g) = ov;
            }
        }
        __syncthreads();
    }
}

__device__ __forceinline__ void ph_mem_prep(const Ctx& p, int l) {
    const float* Km = (const float*)(pws_() + WS_KM);
    const float* Vm = (const float*)(pws_() + WS_VM);
    bf16_t* KB = (bf16_t*)(pws_() + WS_KB);
    bf16_t* VTB = (bf16_t*)(pws_() + WS_VTB);
    const float* kg = pin_(28) + (size_t)l * 64;
    const int lane = tid_() & 63;
    for (int r = gwave(); r < MMEM; r += nwaves()) {
        const int b = r / NMEM, j = r % NMEM;
#pragma unroll
        for (int h = 0; h < 4; ++h) {
            const float v = Km[(size_t)r * 256 + h * 64 + lane];
            const float ss = wave_sum(v * v);
            KB[(((size_t)b * 4 + h) * NMEM + j) * 64 + lane] = f2bf(v * rsqrtf(ss * (1.f / 64.f) + EPS) * kg[lane]);
            VTB[(((size_t)b * 4 + h) * 64 + lane) * NMEM + j] = f2bf(Vm[(size_t)r * 256 + h * 64 + lane]);
        }
    }
}
__device__ __forceinline__ void ph_xattn(const Ctx& p, int l) {
    const float* Qx = (const float*)(pws_() + WS_QX);
    bf16_t* Ox = (bf16_t*)(pws_() + WS_OX);
    const bf16_t* KB = (const bf16_t*)(pws_() + WS_KB);
    const bf16_t* VTB = (const bf16_t*)(pws_() + WS_VTB);
    const float* qg = pin_(27) + (size_t)l * 64;
    const int lane = tid_() & 63, qi = lane & 15, g = lane >> 4;
    for (int task = gwave(); task < MTOK / 16; task += nwaves()) {
        const int tok0 = task * 16, b = tok0 / SEQ;
#pragma unroll 1
        for (int h = 0; h < 4; ++h) {
            BF8 qf[2];
            {
                float qv[2][8]; float ss = 0.f;
#pragma unroll
                for (int s2 = 0; s2 < 2; ++s2) {
                    const float4* qp = (const float4*)(Qx + (size_t)(tok0 + qi) * 256 + h * 64 + 32 * s2 + 8 * g);
                    const float4 a = qp[0], c = qp[1];
                    qv[s2][0] = a.x; qv[s2][1] = a.y; qv[s2][2] = a.z; qv[s2][3] = a.w; qv[s2][4] = c.x; qv[s2][5] = c.y; qv[s2][6] = c.z; qv[s2][7] = c.w;
#pragma unroll
                    for (int j = 0; j < 8; ++j) ss += qv[s2][j] * qv[s2][j];
                }
                ss += __shfl_xor(ss, 16, 64); ss += __shfl_xor(ss, 32, 64);
                const float rs = rsqrtf(ss * (1.f / 64.f) + EPS) * 0.125f;
#pragma unroll
                for (int s2 = 0; s2 < 2; ++s2) {
                    const float4 g0 = *(const float4*)(qg + 32 * s2 + 8 * g), g1 = *(const float4*)(qg + 32 * s2 + 8 * g + 4);
                    qf[s2].w[0] = pk_bf16(qv[s2][0] * rs * g0.x, qv[s2][1] * rs * g0.y); qf[s2].w[1] = pk_bf16(qv[s2][2] * rs * g0.z, qv[s2][3] * rs * g0.w);
                    qf[s2].w[2] = pk_bf16(qv[s2][4] * rs * g1.x, qv[s2][5] * rs * g1.y); qf[s2].w[3] = pk_bf16(qv[s2][6] * rs * g1.z, qv[s2][7] * rs * g1.w);
                }
            }
            const bf16_t* Kh = KB + ((size_t)b * 4 + h) * NMEM * 64;
            const bf16_t* Vh = VTB + ((size_t)b * 4 + h) * 64 * NMEM;
            f32x4_t oacc[4];
#pragma unroll
            for (int dt = 0; dt < 4; ++dt) oacc[dt] = (f32x4_t){0.f, 0.f, 0.f, 0.f};
            float lsum = 0.f;
            const int krow = 8 * (qi >> 2) + (qi & 3);
#pragma unroll 2
            for (int s0 = 0; s0 < NMEM; s0 += 32) {
                BF8 ka[2][2], va[4];
#pragma unroll
                for (int t = 0; t < 2; ++t)
#pragma unroll
                    for (int s2 = 0; s2 < 2; ++s2) ka[t][s2].u = *(const uint4*)(Kh + (size_t)(s0 + krow + 4 * t) * 64 + 32 * s2 + 8 * g);
#pragma unroll
                for (int dt = 0; dt < 4; ++dt) va[dt].u = *(const uint4*)(Vh + (size_t)(16 * dt + qi) * NMEM + s0 + 8 * g);
                f32x4_t sacc[2];
#pragma unroll
                for (int t = 0; t < 2; ++t) {
                    sacc[t] = (f32x4_t){0.f, 0.f, 0.f, 0.f};
                    sacc[t] = __builtin_amdgcn_mfma_f32_16x16x32_bf16(ka[t][0].v, qf[0].v, sacc[t], 0, 0, 0);
                    sacc[t] = __builtin_amdgcn_mfma_f32_16x16x32_bf16(ka[t][1].v, qf[1].v, sacc[t], 0, 0, 0);
                }
                float pe[8];
#pragma unroll
                for (int t = 0; t < 2; ++t)
#pragma unroll
                    for (int r = 0; r < 4; ++r) { pe[4 * t + r] = __expf(sacc[t][r]); lsum += pe[4 * t + r]; }
                BF8 pf;
#pragma unroll
                for (int j = 0; j < 4; ++j) pf.w[j] = pk_bf16(pe[2 * j], pe[2 * j + 1]);
#pragma unroll
                for (int dt = 0; dt < 4; ++dt) oacc[dt] = __builtin_amdgcn_mfma_f32_16x16x32_bf16(va[dt].v, pf.v, oacc[dt], 0, 0, 0);
            }
            lsum += __shfl_xor(lsum, 16, 64); lsum += __shfl_xor(lsum, 32, 64);
            const float inv = 1.f / lsum;
#pragma unroll
            for (int dt = 0; dt < 4; ++dt) {
                uint2 o; o.x = pk_bf16(oacc[dt][0] * inv, oacc[dt][1] * inv); o.y = pk_bf16(oacc[dt][2] * inv, oacc[dt][3] * inv);
                *(uint2*)(Ox + (size_t)(tok0 + qi) * 256 + h * 64 + 16 * dt + 4 * g) = o;
            }
        }
    }
}

template <int N> __device__ __forceinline__ void bitonic_sort_desc(unsigned (&a)[N]) {
#pragma unroll
    for (int k = 2; k <= N; k <<= 1)
#pragma unroll
        for (int j = k >> 1; j > 0; j >>= 1)
#pragma unroll
            for (int i = 0; i < N; ++i) {
                const int o = i ^ j;
                if (o > i) {
                    const bool desc = ((i & k) == 0);
                    const unsigned x = a[i], y = a[o];
                    const unsigned mx = x > y ? x : y, mn = x > y ? y : x;
                    a[i] = desc ? mx : mn; a[o] = desc ? mn : mx;
                }
            }
}
__device__ __forceinline__ void bitonic_merge16_desc(unsigned (&a)[16]) {
#pragma unroll
    for (int j = 8; j > 0; j >>= 1)
#pragma unroll
        for (int i = 0; i < 16; ++i) {
            const int o = i ^ j;
            if (o > i) { const unsigned x = a[i], y = a[o]; a[i] = x > y ? x : y; a[o] = x > y ? y : x; }
        }
}
__device__ __forceinline__ void top16_merge(unsigned (&a)[16], const unsigned (&b)[16]) {
#pragma unroll
    for (int i = 0; i < 16; ++i) a[i] = a[i] > b[15 - i] ? a[i] : b[15 - i];
    bitonic_merge16_desc(a);
}
__device__ __forceinline__ void top16_xlane(unsigned (&a)[16], int xm) {
    unsigned b[16];
#pragma unroll
    for (int i = 0; i < 16; ++i) b[i] = (unsigned)__shfl_xor((int)a[i], xm, 64);
    top16_merge(a, b);
}
__device__ __forceinline__ void ph_subkeys_convert(const Ctx& p) {
    const float* sk = pin_(31);
    bf16_t* o = (bf16_t*)(pws_() + WS_SKB);
    const size_t n = (size_t)DEPTH * 8 * 2 * 128 * 64;
    for (size_t i = (size_t)bid_() * 512 + tid_(); i < n; i += (size_t)nblk_() * 512) o[i] = f2bf(sk[i]);
}
__device__ __forceinline__ void ph_peer_topk(const Ctx& p, int l, float* smem) {
    const bf16_t* Qp = (const bf16_t*)(pws_() + WS_QP);
    const bf16_t* SK = (const bf16_t*)(pws_() + WS_SKB) + (size_t)l * 8 * 2 * 128 * 64;
    int* pidx = (int*)(pws_() + WS_PEI);
    float* pgt = (float*)(pws_() + WS_PEG);
    const int tid = tid_(), lane = tid & 63, wave = tid >> 6, qi = lane & 15, g = lane >> 4;
    int* tabw = (int*)smem + wave * 512 + qi * 32;
    for (int task = gwave(); task < MTOK / 16; task += nwaves()) {
        const size_t tok = (size_t)task * 16 + qi;
#pragma unroll 1
        for (int h = 0; h < 8; ++h) {
            unsigned L[2][16];
#pragma unroll
            for (int pp = 0; pp < 2; ++pp) {
                BF8 qf[2];
#pragma unroll
                for (int s2 = 0; s2 < 2; ++s2) qf[s2].u = *(const uint4*)(Qp + tok * DM + h * 128 + pp * 64 + 32 * s2 + 8 * g);
                const bf16_t* skp = SK + (size_t)(h * 2 + pp) * 128 * 64;
                unsigned va[16], vb[16];
#pragma unroll
                for (int tile = 0; tile < 8; ++tile) {
                    BF8 ka[2];
#pragma unroll
                    for (int s2 = 0; s2 < 2; ++s2) ka[s2].u = *(const uint4*)(skp + (size_t)(16 * tile + qi) * 64 + 32 * s2 + 8 * g);
                    f32x4_t d = __builtin_amdgcn_mfma_f32_16x16x32_bf16(ka[0].v, qf[0].v, (f32x4_t){0.f, 0.f, 0.f, 0.f}, 0, 0, 0);
                    d = __builtin_amdgcn_mfma_f32_16x16x32_bf16(ka[1].v, qf[1].v, d, 0, 0, 0);
#pragma unroll
                    for (int r = 0; r < 4; ++r) {
                        const unsigned key = (ford(d[r]) & ~127u) | (unsigned)(127 - (16 * tile + 4 * g + r));
                        if (tile < 4) va[tile * 4 + r] = key; else vb[(tile - 4) * 4 + r] = key;
                    }
                }
                bitonic_sort_desc<16>(va);
                bitonic_sort_desc<16>(vb);
                top16_merge(va, vb);
                top16_xlane(va, 16);
                top16_xlane(va, 32);
#pragma unroll
                for (int i = 0; i < 16; ++i) L[pp][i] = va[i];
            }
            if (g < 2) {
#pragma unroll
                for (int i = 0; i < 16; ++i) tabw[g * 16 + i] = 127 - (int)((g == 0 ? L[0][i] : L[1][i]) & 127u);
            }
            float s1[16], s2v[16];
#pragma unroll
            for (int i = 0; i < 16; ++i) { s1[i] = funord(L[0][i] & ~127u); s2v[i] = funord(L[1][i] & ~127u); }
            unsigned ca[16], cb[16];
#pragma unroll
            for (int i = 0; i < 16; ++i) { ca[i] = 0u; cb[i] = 0u; }
            {
                const float r0 = g == 0 ? s1[0] : (g == 1 ? s1[1] : (g == 2 ? s1[2] : s1[3]));
                const int nb0 = g == 0 ? 16 : (g == 1 ? 8 : (g == 2 ? 5 : 4));
#pragma unroll
                for (int bq = 0; bq < 16; ++bq) if (bq < nb0) ca[bq] = (ford(r0 + s2v[bq]) & ~255u) | (unsigned)(255 - (g * 16 + bq));
                const float r1 = g == 0 ? s1[4] : (g == 1 ? s1[5] : (g == 2 ? s1[6] : s1[7]));
                const int nb1 = g == 0 ? 3 : 2;
#pragma unroll
                for (int bq = 0; bq < 3; ++bq) if (bq < nb1) cb[bq] = (ford(r1 + s2v[bq]) & ~255u) | (unsigned)(255 - ((g + 4) * 16 + bq));
                const float r2 = g == 0 ? s1[8] : (g == 1 ? s1[9] : (g == 2 ? s1[10] : s1[11]));
                cb[3] = (ford(r2 + s2v[0]) & ~255u) | (unsigned)(255 - ((g + 8) * 16));
                const float r3 = g == 0 ? s1[12] : (g == 1 ? s1[13] : (g == 2 ? s1[14] : s1[15]));
                cb[4] = (ford(r3 + s2v[0]) & ~255u) | (unsigned)(255 - ((g + 12) * 16));
            }
            bitonic_sort_desc<16>(ca);
            bitonic_sort_desc<16>(cb);
            top16_merge(ca, cb);
            top16_xlane(ca, 16);
            top16_xlane(ca, 32);
            float tv[16]; float den = 0.f;
#pragma unroll
            for (int i = 0; i < 16; ++i) {
                const int f = 255 - (int)(ca[i] & 255u);
                const int a = f >> 4, bq = f & 15;
                tv[i] = funord(ca[i] & ~255u);
                (void)a; (void)bq;
            }
#pragma unroll
            for (int i = 0; i < 16; ++i) { tv[i] = __expf(tv[i] - funord(ca[0] & ~255u)); den += tv[i]; }
            const float inv = 1.f / den;
            int ev[4]; float gv[4];
#pragma unroll
            for (int r = 0; r < 4; ++r) {
                const unsigned key = g == 0 ? ca[r] : (g == 1 ? ca[4 + r] : (g == 2 ? ca[8 + r] : ca[12 + r]));
                const float tvv = g == 0 ? tv[r] : (g == 1 ? tv[4 + r] : (g == 2 ? tv[8 + r] : tv[12 + r]));
                const int f = 255 - (int)(key & 255u);
                ev[r] = tabw[f >> 4] * 128 + tabw[16 + (f & 15)];
                gv[r] = tvv * inv;
            }
            *(int4*)(pidx + tok * 128 + h * 16 + 4 * g) = make_int4(ev[0], ev[1], ev[2], ev[3]);
            *(float4*)(pgt + tok * 128 + h * 16 + 4 * g) = make_float4(gv[0], gv[1], gv[2], gv[3]);
        }
    }
}

typedef _Float16 h2_t __attribute__((ext_vector_type(2)));
__device__ __forceinline__ h2_t as_h2(unsigned u) { union { unsigned u; h2_t h; } c; c.u = u; return c.h; }
#define U_SCALE 1024.f
#define V_SCALE 256.f
typedef float f32x2_t __attribute__((ext_vector_type(2)));
__device__ __forceinline__ unsigned pack4_fp8(float4 a, float sc) {
    const float x = fminf(fmaxf(a.x * sc, -448.f), 448.f), y = fminf(fmaxf(a.y * sc, -448.f), 448.f);
    const float z = fminf(fmaxf(a.z * sc, -448.f), 448.f), w = fminf(fmaxf(a.w * sc, -448.f), 448.f);
    int r = __builtin_amdgcn_cvt_pk_fp8_f32(x, y, 0, false);
    r = __builtin_amdgcn_cvt_pk_fp8_f32(z, w, r, true);
    return (unsigned)r;
}
__device__ __forceinline__ void ph_tab_convert(const Ctx& p, int l) {
    const float4* u = (const float4*)(pin_(32) + (size_t)l * NEXP * DM);
    const float4* v = (const float4*)(pin_(33) + (size_t)l * NEXP * DM);
    unsigned* uo = (unsigned*)(pws_() + WS_UT16);
    unsigned* vo = (unsigned*)(pws_() + WS_VT16);
    const size_t n4 = (size_t)NEXP * DM / 4;
    for (size_t i = (size_t)bid_() * 512 + tid_(); i < n4; i += (size_t)nblk_() * 512) {
        uo[i] = pack4_fp8(u[i], U_SCALE);
        vo[i] = pack4_fp8(v[i], V_SCALE);
    }
}
__device__ __forceinline__ void ph_peer_gather(const Ctx& p, int l) {
    const unsigned char* ut = (const unsigned char*)(pws_() + WS_UT16);
    const unsigned char* vt = (const unsigned char*)(pws_() + WS_VT16);
    const int* pidx = (const int*)(pws_() + WS_PEI);
    const float* pgt = (const float*)(pws_() + WS_PEG);
    const bf16_t* H = (const bf16_t*)(pws_() + WS_H);
    float* x = pout_();
    const int lane = tid_() & 63;
    const bool bit5 = lane & 32, bit4 = lane & 16, bit3 = lane & 8, bit2 = lane & 4;
    const int jmine = ((lane >> 5) & 1) * 8 + ((lane >> 4) & 1) * 4 + ((lane >> 3) & 1) * 2 + ((lane >> 2) & 1);
    for (int tok = gwave(); tok < MTOK; tok += nwaves()) {
        float hh[16];
        {
            const uint4 r0 = *(const uint4*)(H + (size_t)tok * DM + lane * 16), r1 = *(const uint4*)(H + (size_t)tok * DM + lane * 16 + 8);
            const unsigned w[8] = {r0.x, r0.y, r0.z, r0.w, r1.x, r1.y, r1.z, r1.w};
#pragma unroll
            for (int q = 0; q < 8; ++q) { hh[2 * q] = __uint_as_float(w[q] << 16); hh[2 * q + 1] = __uint_as_float(w[q] & 0xffff0000u); }
        }
        const int e0 = pidx[(size_t)tok * 128 + lane], e1 = pidx[(size_t)tok * 128 + 64 + lane];
        const float g0 = pgt[(size_t)tok * 128 + lane], g1 = pgt[(size_t)tok * 128 + 64 + lane];
        float out[16];
#pragma unroll
        for (int i = 0; i < 16; ++i) out[i] = 0.f;
#pragma unroll 1
        for (int hb = 0; hb < 8; ++hb) {
            const int esrc = hb < 4 ? e0 : e1;
            const float gsrc = hb < 4 ? g0 : g1;
            const int lb = (hb & 3) * 16;
            uint4 ur[16], vr[16];
#pragma unroll
            for (int j = 0; j < 16; ++j) {
                const int e = __builtin_amdgcn_readlane(esrc, lb + j);
                ur[j] = *(const uint4*)(ut + (size_t)e * DM + lane * 16);
                vr[j] = *(const uint4*)(vt + (size_t)e * DM + lane * 16);
            }
            float pd[16];
#pragma unroll
            for (int j = 0; j < 16; ++j) {
                const unsigned w[4] = {ur[j].x, ur[j].y, ur[j].z, ur[j].w};
                float d0 = 0.f, d1 = 0.f;
#pragma unroll
                for (int q = 0; q < 4; ++q) {
                    const f32x2_t a = __builtin_amdgcn_cvt_pk_f32_fp8((int)w[q], false), c = __builtin_amdgcn_cvt_pk_f32_fp8((int)w[q], true);
                    d0 = __builtin_fmaf(a.x, hh[4 * q], d0); d1 = __builtin_fmaf(a.y, hh[4 * q + 1], d1);
                    d0 = __builtin_fmaf(c.x, hh[4 * q + 2], d0); d1 = __builtin_fmaf(c.y, hh[4 * q + 3], d1);
                }
                pd[j] = d0 + d1;
            }
            float r8[8], r4[4], r2[2], r1;
#pragma unroll
            for (int i = 0; i < 8; ++i) { const float mine = bit5 ? pd[i + 8] : pd[i], send = bit5 ? pd[i] : pd[i + 8]; r8[i] = mine + __shfl_xor(send, 32, 64); }
#pragma unroll
            for (int i = 0; i < 4; ++i) { const float mine = bit4 ? r8[i + 4] : r8[i], send = bit4 ? r8[i] : r8[i + 4]; r4[i] = mine + __shfl_xor(send, 16, 64); }
#pragma unroll
            for (int i = 0; i < 2; ++i) { const float mine = bit3 ? r4[i + 2] : r4[i], send = bit3 ? r4[i] : r4[i + 2]; r2[i] = mine + __shfl_xor(send, 8, 64); }
            { const float mine = bit2 ? r2[1] : r2[0], send = bit2 ? r2[0] : r2[1]; r1 = mine + __shfl_xor(send, 4, 64); }
            r1 += __shfl_xor(r1, 2, 64); r1 += __shfl_xor(r1, 1, 64);
            const float gmine = __shfl(gsrc, lb + jmine, 64);
            const float coef = gmine * gelu_tanh_f(r1 * (1.f / U_SCALE)) * (1.f / V_SCALE);
#pragma unroll
            for (int j = 0; j < 16; ++j) {
                const float cj = __uint_as_float(__builtin_amdgcn_readlane(__float_as_uint(coef), (j >> 3) * 32 + ((j >> 2) & 1) * 16 + ((j >> 1) & 1) * 8 + (j & 1) * 4));
                const unsigned w[4] = {vr[j].x, vr[j].y, vr[j].z, vr[j].w};
#pragma unroll
                for (int q = 0; q < 4; ++q) {
                    const f32x2_t a = __builtin_amdgcn_cvt_pk_f32_fp8((int)w[q], false), c = __builtin_amdgcn_cvt_pk_f32_fp8((int)w[q], true);
                    out[4 * q] = __builtin_fmaf(a.x, cj, out[4 * q]); out[4 * q + 1] = __builtin_fmaf(a.y, cj, out[4 * q + 1]);
                    out[4 * q + 2] = __builtin_fmaf(c.x, cj, out[4 * q + 2]); out[4 * q + 3] = __builtin_fmaf(c.y, cj, out[4 * q + 3]);
                }
            }
        }
        float4* xp = (float4*)(x + (size_t)tok * DM + lane * 16);
#pragma unroll
        for (int q = 0; q < 4; ++q) {
            float4 a = xp[q];
            a.x += out[4 * q]; a.y += out[4 * q + 1]; a.z += out[4 * q + 2]; a.w += out[4 * q + 3];
            xp[q] = a;
        }
    }
}


#ifndef PROBE_MASK
#define PROBE_MASK 0
#endif
#if PROBE_MASK
#define GB(k) do { GRID_BARRIER(); const unsigned long long now_ = wall_clock64(); if ((PROBE_MASK >> (k)) & 1) { const unsigned long long dt_ = now_ - tprev_; while (wall_clock64() - now_ < 3ull * dt_) __builtin_amdgcn_s_sleep(8); } GRID_BARRIER(); tprev_ = wall_clock64(); } while (0)
#else
#define GB(k) GRID_BARRIER()
#endif
__global__ void __launch_bounds__(512, 2) k_mega(Params kp) {
    float* sm = dynsmem;
    {
        unsigned long long* tab = (unsigned long long*)((char*)dynsmem + PTAB_OFF);
        if (threadIdx.x < 34) tab[threadIdx.x] = (unsigned long long)kp.in[threadIdx.x];
        if (threadIdx.x == 34) tab[34] = (unsigned long long)kp.out;
        if (threadIdx.x == 35) tab[35] = (unsigned long long)kp.ws;
        if (threadIdx.x == 36) { tab[36] = 0ull; tab[37] = 0ull; }
    }
    __syncthreads();
    Ctx p; p.kp = &kp;
    (void)xcd_barrier_post((unsigned*)(pws_() + WS_BAR), (volatile LAS unsigned*)((char*)dynsmem + PTAB_OFF + 36 * 8));
#define GRID_BARRIER() do { XcdBarrier bar_; bar_.bar = (unsigned*)(pws_() + WS_BAR); bar_.x = xb_xcc_id(); bar_.st = (volatile LAS unsigned*)((char*)dynsmem + PTAB_OFF + 36 * 8); xcd_barrier(bar_); } while (0)
    ph_weight_prep(p, sm);
    ph_subkeys_convert(p);
    GRID_BARRIER();
#if PROBE_MASK
    unsigned long long tprev_ = wall_clock64();
#endif
#pragma unroll 1
    for (int l = 0; l < DEPTH; ++l) {
#define XIN_ (l == 0 ? pin_(0) : pout_())
#define HBUF_ ((const bf16_t*)(pws_() + WS_H))
        ph_rmsnorm(XIN_, pin_(2) + (size_t)l * DM, (bf16_t*)(pws_() + WS_H), MTOK);
        ph_rmsnorm(pin_(1), pin_(22) + (size_t)l * DM, (bf16_t*)(pws_() + WS_HM), MMEM);
        GB(1);
        { pg8::EpiBf16 E; E.O = (bf16_t*)(pws_() + WS_P); E.ldc = LDP; ph_gemm(HBUF_, (const bf16_t*)(pws_() + WT_IN) + (size_t)l * LDP * DM, MTOK, LDP, DM, E); }
        { pg8::EpiF32 E; E.C = (float*)(pws_() + WS_KM); E.R = nullptr; E.ldc = 256; ph_gemm((const bf16_t*)(pws_() + WS_HM), (const bf16_t*)(pws_() + WT_XK) + (size_t)l * 256 * DM, MMEM, 256, DM, E); }
        { pg8::EpiF32 E; E.C = (float*)(pws_() + WS_VM); E.R = nullptr; E.ldc = 256; ph_gemm((const bf16_t*)(pws_() + WS_HM), (const bf16_t*)(pws_() + WT_XV) + (size_t)l * 256 * DM, MMEM, 256, DM, E); }
        GB(2);
        ph_mem_prep(p, l);
        ph_dsa_prep(p, l);
        ph_scan_prep(p, l);
        GB(3);
        ph_scans(p, l, sm);
        GB(4);
        ph_mixer_finish(p, l);
        ph_dsa_main(p, l, sm);
        GB(5);
        { pg8::EpiF32 E; E.C = pout_(); E.R = XIN_; E.ldc = DM; ph_gemm((const bf16_t*)(pws_() + WS_Y), (const bf16_t*)(pws_() + WT_OUT) + (size_t)l * DM * DM, MTOK, DM, DM, E); }
        GB(6);
        ph_rmsnorm(pout_(), pin_(21) + (size_t)l * DM, (bf16_t*)(pws_() + WS_H), MTOK);
        GB(7);
        { pg8::EpiF32 E; E.C = (float*)(pws_() + WS_QX); E.R = nullptr; E.ldc = 256; ph_gemm(HBUF_, (const bf16_t*)(pws_() + WT_XQ) + (size_t)l * 256 * DM, MTOK, 256, DM, E); }
        GB(8);
        ph_xattn(p, l);
        GB(9);
        { pg8::EpiF32 E; E.C = pout_(); E.R = pout_(); E.ldc = DM; ph_gemm((const bf16_t*)(pws_() + WS_OX), (const bf16_t*)(pws_() + WT_XO) + (size_t)l * DM * 256, MTOK, DM, 256, E); }
        GB(10);
        ph_rmsnorm(pout_(), pin_(29) + (size_t)l * DM, (bf16_t*)(pws_() + WS_H), MTOK);
        ph_tab_convert(p, l);
        GB(11);
        { pg8::EpiBf16 E; E.O = (bf16_t*)(pws_() + WS_QP); E.ldc = DM; ph_gemm(HBUF_, (const bf16_t*)(pws_() + WT_PQ) + (size_t)l * DM * DM, MTOK, DM, DM, E); }
        GB(12);
        ph_peer_topk(p, l, sm);
        GB(13);
        ph_peer_gather(p, l);
        GB(14);
    }
}

extern "C" void kernel_launch(void* const* d_in, const int* in_sizes, int n_in, void* d_out, int out_size, void* d_ws, size_t ws_size, hipStream_t stream) {
    if (n_in != 34 || out_size != MTOK * DM || ws_size < WS_END) {
        fprintf(stderr, "kernel_launch: unexpected shapes (n_in %d out %d ws %zu need %zu)\n", n_in, out_size, ws_size, (size_t)WS_END);
        return;
    }
    static int grid = 0;
    if (!grid) {
        int dev = 0, cus = 0, per_cu = 0;
        (void)hipGetDevice(&dev);
        (void)hipDeviceGetAttribute(&cus, hipDeviceAttributeMultiprocessorCount, dev);
        (void)hipFuncSetAttribute((const void*)k_mega, hipFuncAttributeMaxDynamicSharedMemorySize, LDS_BYTES);
        (void)hipOccupancyMaxActiveBlocksPerMultiprocessor(&per_cu, (const void*)k_mega, 512, LDS_BYTES);
        if (per_cu < 1) fprintf(stderr, "kernel_launch: occupancy query reports %d blocks per CU\n", per_cu);
        grid = cus > 0 ? cus : 256;
    }
    Params p; memset(&p, 0, sizeof(p));
    for (int i = 0; i < 34; ++i) p.in[i] = (const float*)d_in[i];
    p.out = (float*)d_out; p.ws = (char*)d_ws;
    (void)hipMemsetAsync((char*)d_ws + WS_BAR, 0, XCD_BAR_WORDS * sizeof(unsigned), stream);
    hipLaunchKernelGGL(k_mega, dim3(grid), dim3(512), LDS_BYTES, stream, p);
}
```

```cpp
#include <hip/hip_runtime.h>
#include <stdint.h>
#include <stdio.h>
#include <string.h>

#define NB 32
#define SEQ 2048
#define DM 1024
#define MTOK (NB * SEQ)
#define DEPTH 4
#define NMEM 256
#define MMEM (NB * NMEM)
#define LDP 3328
#define NEXP 16384
#define EPS 1e-6f
#define PC_Z 0
#define PC_XBC 256
#define PC_GQKV 768
#define PC_GG 1536
#define PC_LQ 1792
#define PC_LK 1920
#define PC_LV 2048
#define PC_LR 2304
#define PC_DQ 2560
#define PC_DK 2816
#define PC_DV 2880
#define PC_IQ 2944
#define PC_IK 3200
#define PC_GLR 3232
#define PC_IW 3248
#define PC_DT 3256
#define PC_GA 3260
#define PC_GB 3264

typedef unsigned short bf16_t;

#define WS_BAR 0ull
#define WS_P 16384ull
#define SZ_P ((size_t)MTOK * LDP * 2)
#define WS_H (WS_P + SZ_P)
#define SZ_H ((size_t)MTOK * DM * 2)
#define WS_Y (WS_H + SZ_H)
#define SZ_Y ((size_t)MTOK * DM * 2)
#define WS_WP (WS_Y + SZ_Y)
#define SZ_WP ((size_t)DEPTH * DM * LDP * 4)
#define WT_IN (WS_WP)
#define WT_OUT (WT_IN + (size_t)DEPTH * LDP * DM * 2)
#define WT_XQ (WT_OUT + (size_t)DEPTH * DM * DM * 2)
#define WT_XK (WT_XQ + (size_t)DEPTH * 256 * DM * 2)
#define WT_XV (WT_XK + (size_t)DEPTH * 256 * DM * 2)
#define WT_XO (WT_XV + (size_t)DEPTH * 256 * DM * 2)
#define WT_PQ (WT_XO + (size_t)DEPTH * DM * 256 * 2)
#define WT_END (WT_PQ + (size_t)DEPTH * DM * DM * 2)
#define WS_QN (WS_WP + SZ_WP)
#define SZ_QN ((size_t)MTOK * 256 * 4)
#define WS_KN (WS_QN + SZ_QN)
#define SZ_KN ((size_t)MTOK * 64 * 4)
#define WS_IKN (WS_KN + SZ_KN)
#define SZ_IKN ((size_t)MTOK * 32 * 4)
#define WS_YPRE (WS_IKN + SZ_IKN)
#define SZ_YPRE ((size_t)MTOK * 256 * 4)
#define WS_HM (WS_YPRE + SZ_YPRE)
#define SZ_HM ((size_t)MMEM * DM * 2)
#define WS_KM (WS_HM + SZ_HM)
#define SZ_KM ((size_t)MMEM * 256 * 4)
#define WS_VM (WS_KM + SZ_KM)
#define SZ_VM ((size_t)MMEM * 256 * 4)
#define WS_KB (WS_VM + SZ_VM)
#define SZ_KB ((size_t)MMEM * 256 * 2)
#define WS_VTB (WS_KB + SZ_KB)
#define SZ_VTB ((size_t)MMEM * 256 * 2)
#define WS_VT (WS_VTB + SZ_VTB)
#define SZ_VT ((size_t)MTOK * 64 * 2)
#define WS_SKB (WS_VT + SZ_VT)
#define SZ_SKB ((size_t)DEPTH * 8 * 2 * 128 * 64 * 2)
#define WS_SC (WS_SKB + SZ_SKB)
#define SZ_SC ((size_t)MTOK * 16 * 4)
#define WS_DUMMY (WS_SC + SZ_SC)
#define SZ_DUMMY (65536ull)
#define WS_END (WS_DUMMY + SZ_DUMMY)
#define WS_QX (WS_P)
#define WS_OX (WS_P + (size_t)MTOK * 256 * 4)
#define WS_QP (WS_P)
#define WS_UT16 (WS_P + 260ull * 1024 * 1024)
#define WS_VT16 (WS_UT16 + (size_t)NEXP * DM * 2)
#define WS_PEI (WS_VT16 + (size_t)NEXP * DM * 2)
#define WS_PEG (WS_PEI + (size_t)MTOK * 128 * 4)
#define WS_PEND (WS_PEG + (size_t)MTOK * 128 * 4)
static_assert(WS_PEND <= WS_P + SZ_P, "P region aliases");

struct Params {
    const float* in[34];
    float* out;
    char* ws;
};

#define XB_TMO      128
#define XB_XCNT(j)  (256  + 64 * (j))
#define XB_XSUB(j)  (1280 + 64 * (j))
#define XB_XGEN(j)  (2304 + 64 * (j))
#define XB_TOP      3328
#define XB_TOPGEN   3392
#define XCD_BAR_WORDS 3456
#define XB_SPIN_CAP (1u << 18)
#define LAS __attribute__((address_space(3)))

__device__ __forceinline__ unsigned xb_ld(unsigned* p)              { return __hip_atomic_load(p, __ATOMIC_RELAXED, __HIP_MEMORY_SCOPE_AGENT); }
__device__ __forceinline__ unsigned xb_add(unsigned* p, unsigned v) { return __hip_atomic_fetch_add(p, v, __ATOMIC_RELAXED, __HIP_MEMORY_SCOPE_AGENT); }
__device__ __forceinline__ unsigned xb_xcc_id() { return (unsigned)__builtin_amdgcn_s_getreg((3 << 11) | 20) & 0xFu; }
#define XB_SPIN(cond, bar) do { unsigned _sp = 0; while (cond) { __builtin_amdgcn_s_sleep(1); \
    if ((++_sp & 255u) == 0u) { if (xb_ld(&(bar)[XB_TMO])) break; if (_sp > XB_SPIN_CAP) { atomicAdd(&(bar)[XB_TMO], 1u); break; } } } } while (0)

struct XcdBarrier {
    unsigned* bar; unsigned x;
    volatile LAS unsigned* st;
};

__device__ __forceinline__ XcdBarrier xcd_barrier_post(unsigned* bar, volatile LAS unsigned* st) {
    XcdBarrier b; b.bar = bar; b.x = xb_xcc_id(); b.st = st;
    if (threadIdx.x == 0) (void)xb_add(&bar[XB_XCNT(b.x)], 1u);
    return b;
}
__device__ __forceinline__ void xcd_barrier_complete(unsigned* bar, unsigned x, unsigned& nloc, unsigned& nx) {
    const unsigned G = gridDim.x * gridDim.y * gridDim.z;
    unsigned sum, cnt, mine, sp = 0u;
    for (;;) {
        sum = 0u; cnt = 0u; mine = 0u;
#pragma unroll
        for (unsigned j = 0; j < 16; ++j) { const unsigned c = xb_ld(&bar[XB_XCNT(j)]); sum += c; cnt += (c > 0u) ? 1u : 0u; mine = (j == x) ? c : mine; }
        if (sum == G) break;
        __builtin_amdgcn_s_sleep(1);
        if ((++sp & 255u) == 0u) { if (xb_ld(&bar[XB_TMO])) break; if (sp > XB_SPIN_CAP) { atomicAdd(&bar[XB_TMO], 1u); break; } }
    }
    nloc = mine > 0u ? mine : 1u; nx = cnt > 0u ? cnt : 1u;
}

__device__ __forceinline__ void xcd_barrier(const XcdBarrier& b) {
    asm volatile("s_waitcnt vmcnt(0)" ::: "memory");
    __syncthreads();
    if (threadIdx.x == 0) {
        unsigned* bar = b.bar;
        __builtin_amdgcn_s_waitcnt(0);
        unsigned nloc = b.st[0], nx = b.st[1];
        if (nloc == 0u) { xcd_barrier_complete(bar, b.x, nloc, nx); b.st[0] = nloc; b.st[1] = nx; }
        const unsigned old = xb_add(&bar[XB_XSUB(b.x)], 1u);
        const unsigned gen = old / nloc;
        if (old + 1u == (gen + 1u) * nloc) {
            __builtin_amdgcn_fence(__ATOMIC_RELEASE, "agent");
            asm volatile("s_waitcnt vmcnt(0)" ::: "memory");
            const unsigned og = xb_add(&bar[XB_TOP], 1u);
            const unsigned tg = og / nx;
            if (og + 1u == (tg + 1u) * nx) xb_add(&bar[XB_TOPGEN], 1u);
            else XB_SPIN(xb_ld(&bar[XB_TOPGEN]) == tg, bar);
            __builtin_amdgcn_fence(__ATOMIC_ACQUIRE, "agent");
            xb_add(&bar[XB_XGEN(b.x)], 1u);
            asm volatile("s_waitcnt vmcnt(0)" ::: "memory");
        } else {
            XB_SPIN(xb_ld(&bar[XB_XGEN(b.x)]) == gen, bar);
            __builtin_amdgcn_fence(__ATOMIC_ACQUIRE, "agent");
            asm volatile("s_waitcnt vmcnt(0)" ::: "memory");
        }
    }
    __syncthreads();
}


#define LDS_BYTES (144 * 1024)
#define PTAB_OFF (LDS_BYTES - 1024)
extern __shared__ __attribute__((aligned(16))) float dynsmem[];
struct Ctx { const Params* kp; };
#define pin_(i) (p.kp->in[i])
#define pout_() (p.kp->out)
#define pws_() (p.kp->ws)

__device__ __forceinline__ float bf2f(bf16_t v) { return __uint_as_float(((unsigned)v) << 16); }
__device__ __forceinline__ bf16_t f2bf(float f) { unsigned u = __float_as_uint(f); u += 0x7FFFu + ((u >> 16) & 1u); return (bf16_t)(u >> 16); }
__device__ __forceinline__ unsigned pk_bf16(float lo, float hi) { return (unsigned)f2bf(lo) | ((unsigned)f2bf(hi) << 16); }
__device__ __forceinline__ float wave_sum(float v) {
#pragma unroll
    for (int o = 32; o >= 1; o >>= 1) v += __shfl_xor(v, o, 64);
    return v;
}
__device__ __forceinline__ float wave_max(float v) {
#pragma unroll
    for (int o = 32; o >= 1; o >>= 1) v = fmaxf(v, __shfl_xor(v, o, 64));
    return v;
}
__device__ __forceinline__ float silu_f(float x) { return x / (1.f + __expf(-x)); }
__device__ __forceinline__ float sigmoid_f(float x) { return 1.f / (1.f + __expf(-x)); }
__device__ __forceinline__ float softplus_f(float x) { return x > 20.f ? x : log1pf(__expf(x)); }
__device__ __forceinline__ float logsigmoid_f(float x) { return -softplus_f(-x); }
__device__ __forceinline__ float gelu_tanh_f(float x) { const float u = 0.7978845608028654f * (x + 0.044715f * x * x * x); return 0.5f * x * (1.f + tanhf(u)); }
__device__ __forceinline__ unsigned ford(float f) { f = f + 0.0f; unsigned u = __float_as_uint(f); return (u & 0x80000000u) ? ~u : (u | 0x80000000u); }
__device__ __forceinline__ float funord(unsigned k) { unsigned u = (k & 0x80000000u) ? (k & 0x7fffffffu) : ~k; return __uint_as_float(u); }
__device__ __forceinline__ unsigned long long wave_max_u64(unsigned long long v) {
#pragma unroll
    for (int o = 32; o >= 1; o >>= 1) {
        unsigned lo = __shfl_xor((unsigned)v, o, 64), hi = __shfl_xor((unsigned)(v >> 32), o, 64);
        unsigned long long w = ((unsigned long long)hi << 32) | lo;
        v = w > v ? w : v;
    }
    return v;
}
__device__ __forceinline__ int tid_() { int t = threadIdx.x; asm volatile("" : "+v"(t)); return t; }
__device__ __forceinline__ int bid_() { int b = blockIdx.x; asm volatile("" : "+s"(b)); return b; }
__device__ __forceinline__ int nblk_() { int g = gridDim.x; asm volatile("" : "+s"(g)); return g; }
__device__ __forceinline__ int gwave() { return (bid_() * 512 + tid_()) >> 6; }
__device__ __forceinline__ int nwaves() { return nblk_() * 8; }

namespace pg8 {
#define PG8_LAS __attribute__((address_space(3)))
typedef unsigned short bf16_t;
typedef short bf16x8 __attribute__((ext_vector_type(8)));
typedef float f32x4 __attribute__((ext_vector_type(4)));
typedef unsigned u32x4 __attribute__((ext_vector_type(4)));
constexpr int BM = 256, BK = 64, HALF = 128, HTB = HALF * BK * 2  , STAGE_BYTES = 8 * HTB, NXCD = 8, WGM = 8;

__host__ __device__ __forceinline__ int lds_byte(int r, int c) { const int st = (r >> 4) * 2 + (c >> 5), rr = r & 15, cc = c & 31, ob = rr * 64 + cc * 2; return st * 1024 + (ob ^ (((ob >> 9) & 1) << 5)); }
__host__ __device__ __forceinline__ void stage_rc(int b, int& R, int& C) { const int st = b / 1024, sb = b % 1024, swz = sb ^ (((sb >> 9) & 1) << 5); R = (st >> 1) * 16 + swz / 64; C = (st & 1) * 32 + (swz % 64) / 2; }
__host__ __device__ __forceinline__ int perm32(int rho) { const int n = rho >> 4, i = rho & 15; return 8 * (i >> 2) + 4 * n + (i & 3); }

struct Unit { int pm, pn; };
struct Gemm { const bf16_t* A; const bf16_t* Bt; int M, N, K; };

struct StaticOrder {
    int nM, nN, nwg, G, c;
    __host__ __device__ void init(int M, int N, int G_, int c_) { nM = M / BM; nN = N / BM; nwg = nM * nN; G = G_; c = c_; }
    __host__ __device__ bool next(int i, Unit& u) const {
        const long L = (long)i * G + c; if (L >= nwg) return false;
        int wgid = (int)L; { const int q = nwg / NXCD, r = nwg % NXCD, xcd = wgid % NXCD, off = wgid / NXCD; wgid = (xcd < r ? xcd * (q + 1) : r * (q + 1) + (xcd - r) * q) + off; }
        const int nig = WGM * nN, gid = wgid / nig, fm = gid * WGM, gsz = (nM - fm) < WGM ? (nM - fm) : WGM;
        u.pm = fm + ((wgid % nig) % gsz); u.pn = (wgid % nig) / gsz; return true;
    }
    __device__ __forceinline__ void a_ready(const Unit&) const {}
    __device__ __forceinline__ void done(const Unit&) const {}
};

__device__ __forceinline__ unsigned cvt_pk_bf16(float lo, float hi) { unsigned r; asm volatile("v_cvt_pk_bf16_f32 %0, %1, %2" : "=v"(r) : "v"(lo), "v"(hi)); return r; }
struct EpiF32 {
    static constexpr bool PERM = false, AFTER_DRAIN = false;
    float* C; const float* R; int ldc;
    __device__ __forceinline__ void operator()(const f32x4 (&acc)[2][2][4][2], const Unit& u, int wr, int wc, int fr, int fq) const {
        const int row0 = u.pm * BM + wr * 64 + fr, col0 = u.pn * BM + wc * 32 + 4 * fq;
#pragma unroll
        for (int ai = 0; ai < 2; ++ai)
#pragma unroll
            for (int m = 0; m < 4; ++m) { const size_t off = (size_t)(row0 + ai * HALF + m * 16) * ldc + col0;
#pragma unroll
                for (int bj = 0; bj < 2; ++bj)
#pragma unroll
                    for (int n = 0; n < 2; ++n) { f32x4 v = acc[ai][bj][m][n]; if (R) v += *(const f32x4*)(R + off + bj * HALF + n * 16); *(f32x4*)(C + off + bj * HALF + n * 16) = v; } }
    }
};
struct EpiBf16 {
    static constexpr bool PERM = true, AFTER_DRAIN = false;
    bf16_t* O; int ldc;
    __device__ __forceinline__ void operator()(const f32x4 (&acc)[2][2][4][2], const Unit& u, int wr, int wc, int fr, int fq) const {
        const int row0 = u.pm * BM + wr * 64 + fr, col0 = u.pn * BM + wc * 32 + 8 * fq;
#pragma unroll
        for (int ai = 0; ai < 2; ++ai)
#pragma unroll
            for (int m = 0; m < 4; ++m) { bf16_t* rowp = O + (size_t)(row0 + ai * HALF + m * 16) * ldc + col0;
#pragma unroll
                for (int bj = 0; bj < 2; ++bj) { const f32x4 v0 = acc[ai][bj][m][0], v1 = acc[ai][bj][m][1];
                    u32x4 w; w.x = cvt_pk_bf16(v0[0], v0[1]); w.y = cvt_pk_bf16(v0[2], v0[3]); w.z = cvt_pk_bf16(v1[0], v1[1]); w.w = cvt_pk_bf16(v1[2], v1[3]);
                    *(u32x4*)(rowp + bj * HALF) = w; } }
    }
};

template <class Epi, class Sched, bool STAMP = false>
__device__ __forceinline__ void gemm_phase(PG8_LAS unsigned char* lds, const Gemm g, const Sched& S, const Epi& E, unsigned long long* stamps, const int tid) {
    const int wid = __builtin_amdgcn_readfirstlane(tid >> 6), lane = tid & 63, wr = wid >> 2, wc = wid & 3, fr = lane & 15, fq = lane >> 4;
    const int K = g.K, nt = K / BK;
    int ts_lo = 0, ts_hi = 0, nts = 0; const unsigned long long rt_entry = STAMP ? (unsigned long long)wall_clock64() : 0ull;
#define PG8_STAMP() do { if (STAMP && wid == 0 && nts < 64) { const unsigned long long _c = (unsigned long long)clock64(); \
        ts_lo = (lane == nts) ? (int)(unsigned)_c : ts_lo; ts_hi = (lane == nts) ? (int)(unsigned)(_c >> 32) : ts_hi; ++nts; } } while (0)
    PG8_STAMP();
    unsigned voffA[2], voffB[2];
#pragma unroll
    for (int i = 0; i < 2; ++i) { int R, C; stage_rc(tid * 16 + i * 8192, R, C); const int Rb = Epi::PERM ? ((R & ~31) + perm32(R & 31)) : R;
        voffA[i] = (unsigned)(R * K + C) * 2u; voffB[i] = (unsigned)(Rb * K + C) * 2u; }
    const size_t kstep = (size_t)(BK * 2);
    const size_t hstep = (size_t)HALF * K * 2;
    const size_t tstep = 2 * hstep;
    const unsigned ldsw = (unsigned)wid * 1024u;
    const int aoff = lds_byte(wr * 64 + fr, fq * 8), boff = lds_byte(wc * 32 + fr, fq * 8);
#define PG8_SA(b, h) (((b) * 2 + (h)) * HTB)
#define PG8_SB(b, h) ((4 + (b) * 2 + (h)) * HTB)
#define PG8_STAGE(bufoff, gbase, voff) do { _Pragma("unroll") for (int _i = 0; _i < 2; ++_i) \
        __builtin_amdgcn_global_load_lds((const unsigned*)((const char*)(gbase) + (voff)[_i]), (PG8_LAS unsigned*)(lds + (bufoff) + ldsw + _i * 8192), 16, 0, 0); } while (0)
#define PG8_LDA(dst, b, h) do { _Pragma("unroll") for (int m = 0; m < 4; ++m) _Pragma("unroll") for (int k = 0; k < 2; ++k) dst[m][k] = *(const PG8_LAS bf16x8*)(lds + PG8_SA(b, h) + aoff + m * 2048 + k * 1024); } while (0)
#define PG8_LDB(dst, b, h) do { _Pragma("unroll") for (int n = 0; n < 2; ++n) _Pragma("unroll") for (int k = 0; k < 2; ++k) dst[n][k] = *(const PG8_LAS bf16x8*)(lds + PG8_SB(b, h) + boff + n * 2048 + k * 1024); } while (0)
#define PG8_MMA(ai, bj, At, Bt) do { __builtin_amdgcn_s_setprio(1); _Pragma("unroll") for (int m = 0; m < 4; ++m) _Pragma("unroll") for (int n = 0; n < 2; ++n) _Pragma("unroll") for (int k = 0; k < 2; ++k) \
        acc[ai][bj][m][n] = __builtin_amdgcn_mfma_f32_16x16x32_bf16(Bt[n][k], At[m][k], acc[ai][bj][m][n], 0, 0, 0); __builtin_amdgcn_s_setprio(0); } while (0)
#define PG8_WAIT_V(n) asm volatile("s_waitcnt vmcnt(" #n ")" ::: "memory")
#define PG8_WAIT_L(n) asm volatile("s_waitcnt lgkmcnt(" #n ")" ::: "memory")
#define PG8_BAR __builtin_amdgcn_s_barrier()
#define PG8_SCHED __builtin_amdgcn_sched_barrier(0)
    Unit cur, nxt; int ui = 0;
    if (!S.next(0, cur)) return;
    f32x4 acc[2][2][4][2];
#pragma unroll
    for (int a = 0; a < 2; ++a)
#pragma unroll
        for (int b = 0; b < 2; ++b)
#pragma unroll
            for (int m = 0; m < 4; ++m)
#pragma unroll
                for (int n = 0; n < 2; ++n) acc[a][b][m][n] = (f32x4){0.f, 0.f, 0.f, 0.f};
    bf16x8 At[4][2], B0[2][2], B1[2][2];
    const char* cA = (const char*)g.A + (size_t)cur.pm * tstep; const char* cB = (const char*)g.Bt + (size_t)cur.pn * tstep;
    S.a_ready(cur);
    PG8_STAGE(PG8_SB(0, 0), cB, voffB); PG8_STAGE(PG8_SA(0, 0), cA, voffA); PG8_STAGE(PG8_SB(0, 1), cB + hstep, voffB); PG8_STAGE(PG8_SA(0, 1), cA + hstep, voffA);
    if (wr == 1) PG8_BAR;
    PG8_WAIT_V(4); PG8_BAR;
    PG8_STAGE(PG8_SB(1, 0), cB + kstep, voffB); PG8_STAGE(PG8_SA(1, 0), cA + kstep, voffA); PG8_STAGE(PG8_SB(1, 1), cB + hstep + kstep, voffB);
    PG8_WAIT_V(6); PG8_BAR;
    PG8_STAMP();
    for (;;) {
        const bool has_next = S.next(ui + 1, nxt);
        const char* nA = has_next ? (const char*)g.A + (size_t)nxt.pm * tstep : cA; const char* nB = has_next ? (const char*)g.Bt + (size_t)nxt.pn * tstep : cB;
        for (int t = 0; t < nt; t += 2) {
            const bool last = (t == nt - 2);
            const char* a1 = cA + (size_t)(t + 1) * kstep;
            const char* a2 = last ? nA : cA + (size_t)(t + 2) * kstep; const char* b2 = last ? nB : cB + (size_t)(t + 2) * kstep;
            const char* a3 = a2 + kstep; const char* b3 = b2 + kstep;
            if (last && has_next) S.a_ready(nxt);
            PG8_LDB(B0, 0, 0); PG8_SCHED; PG8_LDA(At, 0, 0); PG8_STAGE(PG8_SA(1, 1), a1 + hstep, voffA);
            PG8_WAIT_L(8); PG8_BAR; PG8_WAIT_L(0); PG8_MMA(0, 0, At, B0); PG8_BAR; PG8_SCHED;
            PG8_LDB(B1, 0, 1); PG8_STAGE(PG8_SB(0, 0), b2, voffB);
            PG8_BAR; PG8_WAIT_L(0); PG8_MMA(0, 1, At, B1); PG8_BAR;
            PG8_LDA(At, 0, 1); PG8_STAGE(PG8_SA(0, 0), a2, voffA);
            PG8_BAR; PG8_WAIT_L(0); PG8_MMA(1, 0, At, B0); PG8_BAR; PG8_SCHED;
            PG8_STAGE(PG8_SB(0, 1), b2 + hstep, voffB);
            PG8_WAIT_V(6); PG8_BAR; PG8_MMA(1, 1, At, B1); PG8_BAR;
            PG8_LDB(B0, 1, 0); PG8_SCHED; PG8_LDA(At, 1, 0); PG8_STAGE(PG8_SA(0, 1), a2 + hstep, voffA);
            PG8_WAIT_L(8); PG8_BAR; PG8_WAIT_L(0); PG8_MMA(0, 0, At, B0); PG8_BAR; PG8_SCHED;
            PG8_LDB(B1, 1, 1); PG8_STAGE(PG8_SB(1, 0), b3, voffB);
            PG8_BAR; PG8_WAIT_L(0); PG8_MMA(0, 1, At, B1); PG8_BAR;
            PG8_LDA(At, 1, 1); PG8_STAGE(PG8_SA(1, 0), a3, voffA);
            PG8_BAR; PG8_WAIT_L(0); PG8_MMA(1, 0, At, B0); PG8_BAR; PG8_SCHED;
            PG8_STAGE(PG8_SB(1, 1), b3 + hstep, voffB);
            PG8_WAIT_V(6); PG8_BAR; PG8_MMA(1, 1, At, B1); PG8_BAR;
        }
        PG8_STAMP();
        if constexpr (!Epi::AFTER_DRAIN) { E(acc, cur, wr, wc, fr, fq); S.done(cur); }
        PG8_STAMP();
        if (!has_next) break;
#pragma unroll
        for (int a = 0; a < 2; ++a)
#pragma unroll
            for (int b = 0; b < 2; ++b)
#pragma unroll
                for (int m = 0; m < 4; ++m)
#pragma unroll
                    for (int n = 0; n < 2; ++n) acc[a][b][m][n] = (f32x4){0.f, 0.f, 0.f, 0.f};
        cur = nxt; cA = nA; cB = nB; ++ui;
    }
    PG8_WAIT_V(0);
    if (wr == 0) PG8_BAR;
    PG8_BAR;
    if constexpr (Epi::AFTER_DRAIN) { E.fused(acc, cur, wr, wc, fr, fq, lds, wid, lane); S.done(cur); }
    PG8_STAMP();
    if (STAMP && wid == 0) { stamps[lane] = lane < nts ? (((unsigned long long)(unsigned)ts_hi << 32) | (unsigned)ts_lo) : 0ull;
        if (lane == 62) stamps[62] = rt_entry; if (lane == 63) stamps[63] = (unsigned long long)wall_clock64(); }
#undef PG8_STAMP
#undef PG8_SA
#undef PG8_SB
#undef PG8_STAGE
#undef PG8_LDA
#undef PG8_LDB
#undef PG8_MMA
#undef PG8_WAIT_V
#undef PG8_WAIT_L
#undef PG8_BAR
#undef PG8_SCHED
}
}

template <class Epi> __device__ __forceinline__ void ph_gemm(const bf16_t* A, const bf16_t* Bt, int M, int N, int K, const Epi& E) {
    pg8::Gemm g; g.A = A; g.Bt = Bt; g.M = M; g.N = N; g.K = K;
    pg8::StaticOrder S; S.init(M, N, nblk_(), bid_());
    pg8::gemm_phase<Epi, pg8::StaticOrder, false>((PG8_LAS unsigned char*)dynsmem, g, S, E, nullptr, tid_());
}

__device__ __forceinline__ int pcol_to_orig(int c) {
    if (c < 768) return c;
    if (c < 1536) return c - 768 + 772;
    if (c < 1792) return c - 1536 + 1548;
    if (c < 1920) return c - 1792 + 1804;
    if (c < 2048) return c - 1920 + 1932;
    if (c < 2304) return c - 2048 + 2060;
    if (c < 2560) return c - 2304 + 2332;
    if (c < 2816) return c - 2560 + 2588;
    if (c < 2880) return c - 2816 + 2844;
    if (c < 2944) return c - 2880 + 2908;
    if (c < 3200) return c - 2944 + 2972;
    if (c < 3232) return c - 3200 + 3228;
    if (c < 3248) return c - 3232 + 2316;
    if (c < 3256) return c - 3248 + 3260;
    if (c < 3260) return c - 3256 + 768;
    if (c < 3264) return c - 3260 + 1540;
    if (c < 3268) return c - 3264 + 1544;
    return -1;
}
__device__ __forceinline__ void wtrans_job(const float* W, int K, int ldw, bf16_t* Wt, int Npad, bool mapped, float* tile) {
    const int tid = tid_();
    const int tn = Npad / 64, tk = K / 64;
    for (int t = bid_(); t < tn * tk; t += nblk_()) {
        const int n0 = (t / tk) * 64, k0 = (t % tk) * 64;
        __syncthreads();
        for (int idx = tid; idx < 4096; idx += 512) {
            const int kk = idx >> 6, nn = idx & 63;
            const int col = mapped ? pcol_to_orig(n0 + nn) : (n0 + nn);
            tile[kk * 65 + nn] = col >= 0 ? W[(size_t)(k0 + kk) * ldw + col] : 0.f;
        }
        __syncthreads();
        for (int idx = tid; idx < 4096; idx += 512) {
            const int nn = idx >> 6, kk = idx & 63;
            Wt[(size_t)(n0 + nn) * K + k0 + kk] = f2bf(tile[kk * 65 + nn]);
        }
    }
}
__device__ __forceinline__ void ph_weight_prep(const Ctx& p, float* sm) {
#pragma unroll 1
    for (int j = 0; j < 7 * DEPTH; ++j) {
        const int l = j / 7, w = j % 7;
        const float* W; int K, ldw, Npad; bf16_t* Wt; bool mapped = false;
        if (w == 0) { W = pin_(3) + (size_t)l * DM * 3268; K = DM; ldw = 3268; Npad = LDP; Wt = (bf16_t*)(pws_() + WT_IN) + (size_t)l * LDP * DM; mapped = true; }
        else if (w == 1) { W = pin_(20) + (size_t)l * DM * DM; K = DM; ldw = DM; Npad = DM; Wt = (bf16_t*)(pws_() + WT_OUT) + (size_t)l * DM * DM; }
        else if (w == 2) { W = pin_(23) + (size_t)l * DM * 256; K = DM; ldw = 256; Npad = 256; Wt = (bf16_t*)(pws_() + WT_XQ) + (size_t)l * 256 * DM; }
        else if (w == 3) { W = pin_(24) + (size_t)l * DM * 256; K = DM; ldw = 256; Npad = 256; Wt = (bf16_t*)(pws_() + WT_XK) + (size_t)l * 256 * DM; }
        else if (w == 4) { W = pin_(25) + (size_t)l * DM * 256; K = DM; ldw = 256; Npad = 256; Wt = (bf16_t*)(pws_() + WT_XV) + (size_t)l * 256 * DM; }
        else if (w == 5) { W = pin_(26) + (size_t)l * 256 * DM; K = 256; ldw = DM; Npad = DM; Wt = (bf16_t*)(pws_() + WT_XO) + (size_t)l * DM * 256; }
        else { W = pin_(30) + (size_t)l * DM * DM; K = DM; ldw = DM; Npad = DM; Wt = (bf16_t*)(pws_() + WT_PQ) + (size_t)l * DM * DM; }
        wtrans_job(W, K, ldw, Wt, Npad, mapped, sm);
    }
}

__device__ __forceinline__ void ph_rmsnorm(const float* __restrict__ x, const float* __restrict__ g, bf16_t* __restrict__ out, int rows) {
    const int lane = tid_() & 63;
    for (int r = gwave(); r < rows; r += nwaves()) {
        const float4* xr = (const float4*)(x + (size_t)r * DM);
        float4 v[4]; float ss = 0.f;
#pragma unroll
        for (int i = 0; i < 4; ++i) { v[i] = xr[lane + 64 * i]; ss += v[i].x * v[i].x + v[i].y * v[i].y + v[i].z * v[i].z + v[i].w * v[i].w; }
        ss = wave_sum(ss);
        const float rs = rsqrtf(ss * (1.f / DM) + EPS);
#pragma unroll
        for (int i = 0; i < 4; ++i) {
            const float4 gg = ((const float4*)g)[lane + 64 * i];
            ushort4 o; o.x = f2bf(v[i].x * rs * gg.x); o.y = f2bf(v[i].y * rs * gg.y); o.z = f2bf(v[i].z * rs * gg.z); o.w = f2bf(v[i].w * rs * gg.w);
            *(ushort4*)(out + (size_t)r * DM + (size_t)(lane + 64 * i) * 4) = o;
        }
    }
}

template <int OUTMODE>
__device__ __forceinline__ void ph_sgemm(const bf16_t* __restrict__ A, int lda, const float* __restrict__ B, int ldb, void* Cv, int ldc, const float* R, int ldr,
                         int M, int N, int K, float* smem) {
    float* As = smem;
    float* Bs = smem + 16 * 132;
    const int tid = tid_(), tx = tid & 31, ty = tid >> 5;
    const int ntn = N / 128, ntiles = (M / 128) * ntn;
    for (int tile = bid_(); tile < ntiles; tile += nblk_()) {
        const int tm = tile / ntn, tn = tile % ntn;
        float acc[8][4];
#pragma unroll
        for (int i = 0; i < 8; ++i)
#pragma unroll
            for (int j = 0; j < 4; ++j) acc[i][j] = 0.f;
        const int arow = tid >> 2, akq = (tid & 3) * 4;
        const int bk = tid >> 5, bn = (tid & 31) * 4;
        for (int k0 = 0; k0 < K; k0 += 16) {
            const ushort4 av = *(const ushort4*)(A + (size_t)(tm * 128 + arow) * lda + k0 + akq);
            const float4 bv = *(const float4*)(B + (size_t)(k0 + bk) * ldb + tn * 128 + bn);
            __syncthreads();
            As[(akq + 0) * 132 + arow] = bf2f(av.x); As[(akq + 1) * 132 + arow] = bf2f(av.y);
            As[(akq + 2) * 132 + arow] = bf2f(av.z); As[(akq + 3) * 132 + arow] = bf2f(av.w);
            *(float4*)(Bs + bk * 132 + bn) = bv;
            __syncthreads();
#pragma unroll
            for (int k = 0; k < 16; ++k) {
                const float4 a0 = *(const float4*)(As + k * 132 + ty * 8), a1 = *(const float4*)(As + k * 132 + ty * 8 + 4);
                const float4 b = *(const float4*)(Bs + k * 132 + tx * 4);
                const float a[8] = {a0.x, a0.y, a0.z, a0.w, a1.x, a1.y, a1.z, a1.w};
#pragma unroll
                for (int i = 0; i < 8; ++i) { acc[i][0] += a[i] * b.x; acc[i][1] += a[i] * b.y; acc[i][2] += a[i] * b.z; acc[i][3] += a[i] * b.w; }
            }
        }
#pragma unroll
        for (int i = 0; i < 8; ++i) {
            const size_t row = (size_t)tm * 128 + ty * 8 + i; const int col = tn * 128 + tx * 4;
            if (OUTMODE == 0) {
                ushort4 o; o.x = f2bf(acc[i][0]); o.y = f2bf(acc[i][1]); o.z = f2bf(acc[i][2]); o.w = f2bf(acc[i][3]);
                *(ushort4*)((bf16_t*)Cv + row * ldc + col) = o;
            } else if (OUTMODE == 1) {
                *(float4*)((float*)Cv + row * ldc + col) = make_float4(acc[i][0], acc[i][1], acc[i][2], acc[i][3]);
            } else {
                const float4 r = *(const float4*)(R + row * ldr + col);
                *(float4*)((float*)Cv + row * ldc + col) = make_float4(r.x + acc[i][0], r.y + acc[i][1], r.z + acc[i][2], r.w + acc[i][3]);
            }
        }
    }
}

#define WS_HS WS_H
#define WS_VG WS_YPRE
#define WS_DEC (WS_YPRE + (size_t)MTOK * 256 * 2)

__device__ __forceinline__ float quad_sum(float v) {
    v += __int_as_float(__builtin_amdgcn_mov_dpp(__float_as_int(v), 0xB1, 0xF, 0xF, true));
    v += __int_as_float(__builtin_amdgcn_mov_dpp(__float_as_int(v), 0x4E, 0xF, 0xF, true));
    return v;
}
__device__ __forceinline__ float bflo(unsigned w) { return __uint_as_float(w << 16); }
__device__ __forceinline__ float bfhi(unsigned w) { return __uint_as_float(w & 0xffff0000u); }

__device__ __forceinline__ float oct_sum(float v) {
    v += __int_as_float(__builtin_amdgcn_mov_dpp(__float_as_int(v), 0xB1, 0xF, 0xF, true));
    v += __int_as_float(__builtin_amdgcn_mov_dpp(__float_as_int(v), 0x4E, 0xF, 0xF, true));
    v += __int_as_float(__builtin_amdgcn_mov_dpp(__float_as_int(v), 0x141, 0xF, 0xF, true));
    return v;
}
__device__ __forceinline__ void unpack8(const uint4 r, float (&o)[8]) {
    o[0] = bflo(r.x); o[1] = bfhi(r.x); o[2] = bflo(r.y); o[3] = bfhi(r.y); o[4] = bflo(r.z); o[5] = bfhi(r.z); o[6] = bflo(r.w); o[7] = bfhi(r.w);
}
__device__ __forceinline__ uint4 pack8(const float (&v)[8]) {
    uint4 o; o.x = pk_bf16(v[0], v[1]); o.y = pk_bf16(v[2], v[3]); o.z = pk_bf16(v[4], v[5]); o.w = pk_bf16(v[6], v[7]); return o;
}
__device__ __forceinline__ void load8f(const float* p, float (&o)[8]) {
    const float4 a = *(const float4*)p, b = *(const float4*)(p + 4);
    o[0] = a.x; o[1] = a.y; o[2] = a.z; o[3] = a.w; o[4] = b.x; o[5] = b.y; o[6] = b.z; o[7] = b.w;
}
__device__ __forceinline__ void conv8(const bf16_t* P, size_t tok, int t, int pcol, const float* w, int ldw, int cc, float (&acc)[8]) {
#pragma unroll
    for (int j = 0; j < 4; ++j) {
        if (t - 3 + j >= 0) {
            float xv[8], wv[8];
            unpack8(*(const uint4*)(P + (tok - (size_t)(3 - j)) * LDP + pcol), xv);
            load8f(w + j * ldw + cc, wv);
#pragma unroll
            for (int i = 0; i < 8; ++i) acc[i] = __builtin_fmaf(wv[i], xv[i], acc[i]);
        }
    }
}
__device__ __forceinline__ void conv8r(const uint4 (&xt)[4], int t, const float* w, int ldw, int cc, float (&acc)[8]) {
#pragma unroll
    for (int j = 0; j < 4; ++j) {
        float xv[8], wv[8];
        unpack8(xt[j], xv);
        load8f(w + j * ldw + cc, wv);
        const float m = (t - 3 + j >= 0) ? 1.f : 0.f;
#pragma unroll
        for (int i = 0; i < 8; ++i) acc[i] = __builtin_fmaf(wv[i] * m, xv[i], acc[i]);
    }
}
__device__ __forceinline__ void ph_scan_prep(const Ctx& p, int l) {
    const bf16_t* P = (const bf16_t*)(pws_() + WS_P);
    bf16_t* HS = (bf16_t*)(pws_() + WS_HS);
    bf16_t* VG = (bf16_t*)(pws_() + WS_VG);
    float* DEC = (float*)(pws_() + WS_DEC);
    float* SC = (float*)(pws_() + WS_SC);
    const float* scw = pin_(4) + (size_t)l * 4 * 512;
    const float* scb = pin_(5) + (size_t)l * 512;
    const float* gcw = pin_(10) + (size_t)l * 4 * 768;
    const float* wg = pin_(14) + (size_t)l * 16 * 128;
    const float* bg = pin_(15) + (size_t)l * 128;
    const int lane = tid_() & 63;
    const int hsc = lane & 3, wsc = (lane >> 2) & 3;
    const float k_dtb = pin_(6)[l * 4 + hsc], k_alog = __expf(pin_(7)[l * 4 + hsc]), k_galog = __expf(pin_(11)[l * 4 + hsc]), k_gdtb = pin_(12)[l * 4 + hsc];
    const int sccol = wsc < 2 ? PC_DT + hsc : (wsc == 2 ? PC_GA + hsc : PC_GB + hsc);
    for (int tok = gwave(); tok < MTOK; tok += nwaves()) {
        const int t = tok % SEQ;
        const size_t row = (size_t)tok * LDP;
        uint4 xa[4], xq[4], xv4[4];
#pragma unroll
        for (int j = 0; j < 4; ++j) {
            const size_t rj = (t - 3 + j >= 0) ? row - (size_t)(3 - j) * LDP : row;
            xa[j] = *(const uint4*)(P + rj + PC_XBC + 8 * lane);
            xq[j] = *(const uint4*)(P + rj + PC_GQKV + 8 * lane);
            xv4[j] = *(const uint4*)(P + rj + PC_GQKV + 512 + 8 * (lane & 31));
        }
        const uint4 gl0 = *(const uint4*)(P + row + PC_GLR), gl1 = *(const uint4*)(P + row + PC_GLR + 8);
        const float scraw = bf2f(P[row + sccol]);
        {
            float acc[8];
            load8f(scb + 8 * lane, acc);
            conv8r(xa, t, scw, 512, 8 * lane, acc);
#pragma unroll
            for (int i = 0; i < 8; ++i) acc[i] = silu_f(acc[i]);
            *(uint4*)(HS + (size_t)tok * 1024 + 8 * lane) = pack8(acc);
        }
        {
            float acc[8];
#pragma unroll
            for (int i = 0; i < 8; ++i) acc[i] = 0.f;
            conv8r(xq, t, gcw, 768, 8 * lane, acc);
            float ss = 0.f;
#pragma unroll
            for (int i = 0; i < 8; ++i) { acc[i] = silu_f(acc[i]); ss += acc[i] * acc[i]; }
            ss = oct_sum(ss);
            const float sc = rsqrtf(ss + EPS) * (lane < 32 ? 0.125f : 1.f);
#pragma unroll
            for (int i = 0; i < 8; ++i) acc[i] *= sc;
            *(uint4*)(HS + (size_t)tok * 1024 + 512 + 8 * lane) = pack8(acc);
        }
        {
            float acc[8];
#pragma unroll
            for (int i = 0; i < 8; ++i) acc[i] = 0.f;
            conv8r(xv4, t, gcw, 768, 512 + 8 * (lane & 31), acc);
#pragma unroll
            for (int i = 0; i < 8; ++i) acc[i] = silu_f(acc[i]);
            if (lane < 32) *(uint4*)(VG + (size_t)tok * 256 + 8 * lane) = pack8(acc);
        }
        {
            float v;
            if (wsc < 2) { const float dt = softplus_f(scraw + k_dtb); v = wsc == 0 ? dt : __expf(-dt * k_alog); }
            else if (wsc == 2) v = __expf(-k_galog * softplus_f(scraw + k_gdtb));
            else v = sigmoid_f(scraw);
            if (lane < 16) SC[(size_t)tok * 16 + lane] = v;
        }
        {
            float gl[16];
            { float a8[8], b8[8]; unpack8(gl0, a8); unpack8(gl1, b8);
#pragma unroll
              for (int i = 0; i < 8; ++i) { gl[i] = a8[i]; gl[8 + i] = b8[i]; } }
#pragma unroll
            for (int i = 0; i < 2; ++i) {
                const int c = lane + 64 * i;
                float acc = bg[c];
#pragma unroll
                for (int r = 0; r < 16; ++r) acc = __builtin_fmaf(gl[r], wg[r * 128 + c], acc);
                DEC[(size_t)tok * 128 + c] = __expf(logsigmoid_f(acc) * (1.f / 16.f));
            }
        }
    }
}

#define SCAN_LDS_WAVE 4608
typedef float f2_t __attribute__((ext_vector_type(2)));
__device__ __forceinline__ f2_t mk2(float a, float b) { f2_t r; r.x = a; r.y = b; return r; }
__device__ __forceinline__ void st8f(char* dst, const uint4 v) {
    *(float4*)dst = make_float4(bflo(v.x), bfhi(v.x), bflo(v.y), bfhi(v.y));
    *(float4*)(dst + 16) = make_float4(bflo(v.z), bfhi(v.z), bflo(v.w), bfhi(v.w));
}
__device__ __forceinline__ void ph_scans(const Ctx& p, int l, float* smem) {
    const bf16_t* P = (const bf16_t*)(pws_() + WS_P);
    const bf16_t* HS = (const bf16_t*)(pws_() + WS_HS);
    const bf16_t* VG = (const bf16_t*)(pws_() + WS_VG);
    const float* DEC = (const float*)(pws_() + WS_DEC);
    const float* SC = (const float*)(pws_() + WS_SC);
    bf16_t* Y = (bf16_t*)(pws_() + WS_Y);
    const int tid = tid_(), lane = tid & 63, wave = tid >> 6;
    if (nblk_() != 256) return;
    const int role = wave < 2 ? 0 : (wave < 6 ? 1 : 2);
    const int idx = (role == 0 ? wave : (role == 1 ? wave - 2 : wave - 6)) * 256 + bid_();
    const int bh = role == 1 ? (idx >> 3) : (idx >> 2), b = bh >> 2, h = bh & 3;
    const int colbase = role == 1 ? (idx & 7) * 8 : (idx & 3) * 16;
    const int cl = role == 1 ? (lane >> 3) : (lane >> 2);
    const int col = colbase + cl;
    const int sq = role == 1 ? (lane & 7) : (lane & 3);
    const size_t tb = (size_t)b * SEQ;
    bf16_t* dummy = (bf16_t*)(pws_() + WS_DUMMY) + (tid & 511) * 8;
    char* lw = (char*)smem + wave * SCAN_LDS_WAVE;
    char* lrow = lw;
    char* lcol = lw + 4096;
    float* lsc = (float*)(lw + 4352);
    const int fs = lane >> 3, fp = lane & 7;
    if (role == 0) {
        const int g = h >> 1;
        const float Dh = pin_(8)[l * 4 + h];
        uint4 f0, f1; unsigned fc = 0u; float fsc = 0.f;
        f2_t st[8];
#pragma unroll
        for (int i = 0; i < 8; ++i) st[i] = mk2(0.f, 0.f);
        auto fetch = [&](int t0) {
            const size_t tok = tb + t0 + fs;
            const bf16_t* src = HS + tok * 1024 + (fp < 4 ? 256 + g * 64 + fp * 16 : 384 + g * 64 + (fp - 4) * 16);
            f0 = *(const uint4*)src; f1 = *(const uint4*)(src + 8);
            fc = *(const unsigned*)(HS + tok * 1024 + h * 64 + colbase + fp * 2);
            if (lane < 16) fsc = SC[(tb + t0 + (lane >> 1)) * 16 + (lane & 1) * 4 + h];
        };
        fetch(0);
        for (int t0 = 0; t0 < SEQ; t0 += 8) {
            st8f(lrow + fs * 512 + fp * 64, f0); st8f(lrow + fs * 512 + fp * 64 + 32, f1);
            *(unsigned*)(lcol + fs * 32 + fp * 4) = fc;
            if (lane < 16) lsc[lane] = fsc;
            if (t0 + 8 < SEQ) fetch(t0 + 8);
#pragma unroll
            for (int i = 0; i < 8; ++i) {
                const char* rb = lrow + i * 512 + sq * 64;
                const float4 b0 = *(const float4*)rb, b1 = *(const float4*)(rb + 16), b2 = *(const float4*)(rb + 32), b3 = *(const float4*)(rb + 48);
                const float4 c0 = *(const float4*)(rb + 256), c1 = *(const float4*)(rb + 272), c2 = *(const float4*)(rb + 288), c3 = *(const float4*)(rb + 304);
                const float xv = bf2f(*(const bf16_t*)(lcol + i * 32 + cl * 2));
                const float2 sc2 = *(const float2*)(lsc + i * 2);
                const float xdt = xv * sc2.x;
                const f2_t xd2 = mk2(xdt, xdt), dA2 = mk2(sc2.y, sc2.y);
                const f2_t bb[8] = {mk2(b0.x, b0.y), mk2(b0.z, b0.w), mk2(b1.x, b1.y), mk2(b1.z, b1.w), mk2(b2.x, b2.y), mk2(b2.z, b2.w), mk2(b3.x, b3.y), mk2(b3.z, b3.w)};
                const f2_t cc[8] = {mk2(c0.x, c0.y), mk2(c0.z, c0.w), mk2(c1.x, c1.y), mk2(c1.z, c1.w), mk2(c2.x, c2.y), mk2(c2.z, c2.w), mk2(c3.x, c3.y), mk2(c3.z, c3.w)};
                f2_t ya = mk2(0.f, 0.f), yb = mk2(0.f, 0.f);
#pragma unroll
                for (int q = 0; q < 8; q += 2) {
                    st[q] = st[q] * dA2 + xd2 * bb[q]; st[q + 1] = st[q + 1] * dA2 + xd2 * bb[q + 1];
                    ya = cc[q] * st[q] + ya; yb = cc[q + 1] * st[q + 1] + yb;
                }
                const f2_t ys = ya + yb;
                const float y = quad_sum(ys.x + ys.y);
                *(sq == 0 ? Y + (tb + t0 + i) * DM + h * 64 + col : dummy + i) = f2bf(y + Dh * xv);
                if (i & 1) __builtin_amdgcn_sched_barrier(0);
            }
        }
    } else if (role == 1) {
        uint4 f0, f1; unsigned fc = 0u; float fsc = 0.f;
        f2_t S[4];
#pragma unroll
        for (int i = 0; i < 4; ++i) S[i] = mk2(0.f, 0.f);
        auto fetch = [&](int t0) {
            const size_t tok = tb + t0 + fs;
            const bf16_t* src = HS + tok * 1024 + (fp < 4 ? 512 + h * 64 + fp * 16 : 768 + h * 64 + (fp - 4) * 16);
            f0 = *(const uint4*)src; f1 = *(const uint4*)(src + 8);
            if (fp < 4) fc = *(const unsigned*)(VG + tok * 256 + h * 64 + colbase + fp * 2);
            if (lane < 16) fsc = SC[(tb + t0 + (lane >> 1)) * 16 + 8 + (lane & 1) * 4 + h];
        };
        fetch(0);
        for (int t0 = 0; t0 < SEQ; t0 += 8) {
            st8f(lrow + fs * 512 + fp * 64, f0); st8f(lrow + fs * 512 + fp * 64 + 32, f1);
            if (fp < 4) *(unsigned*)(lcol + fs * 32 + fp * 4) = fc;
            if (lane < 16) lsc[lane] = fsc;
            if (t0 + 8 < SEQ) fetch(t0 + 8);
#pragma unroll
            for (int i = 0; i < 8; ++i) {
                const char* rb = lrow + i * 512 + sq * 32;
                const float4 q0 = *(const float4*)rb, q1 = *(const float4*)(rb + 16);
                const float4 k0 = *(const float4*)(rb + 256), k1 = *(const float4*)(rb + 272);
                const float vv = bf2f(*(const bf16_t*)(lcol + i * 32 + cl * 2));
                const float2 sc2 = *(const float2*)(lsc + i * 2);
                const f2_t al2 = mk2(sc2.x, sc2.x);
                const f2_t kk[4] = {mk2(k0.x, k0.y), mk2(k0.z, k0.w), mk2(k1.x, k1.y), mk2(k1.z, k1.w)};
                const f2_t qq[4] = {mk2(q0.x, q0.y), mk2(q0.z, q0.w), mk2(q1.x, q1.y), mk2(q1.z, q1.w)};
                f2_t ra = mk2(0.f, 0.f), rb2 = mk2(0.f, 0.f);
#pragma unroll
                for (int q = 0; q < 4; q += 2) {
                    S[q] = S[q] * al2; S[q + 1] = S[q + 1] * al2;
                    ra = S[q] * kk[q] + ra; rb2 = S[q + 1] * kk[q + 1] + rb2;
                }
                const f2_t rs = ra + rb2;
                const float r = oct_sum(rs.x + rs.y);
                const float vn = sc2.y * (vv - r);
                const f2_t vn2 = mk2(vn, vn);
                f2_t oa2 = mk2(0.f, 0.f), ob2 = mk2(0.f, 0.f);
#pragma unroll
                for (int q = 0; q < 4; q += 2) {
                    S[q] = kk[q] * vn2 + S[q]; S[q + 1] = kk[q + 1] * vn2 + S[q + 1];
                    oa2 = S[q] * qq[q] + oa2; ob2 = S[q + 1] * qq[q + 1] + ob2;
                }
                const f2_t os = oa2 + ob2;
                const float ov = oct_sum(os.x + os.y);
                *(sq == 0 ? Y + (tb + t0 + i) * DM + 256 + h * 64 + col : dummy + i) = f2bf(ov);
                if (i & 1) __builtin_amdgcn_sched_barrier(0);
            }
        }
    } else {
        uint4 f0, f1; unsigned fc = 0u;
        f2_t S[4];
#pragma unroll
        for (int i = 0; i < 4; ++i) S[i] = mk2(0.f, 0.f);
        auto fetch = [&](int t0) {
            const size_t tok = tb + t0 + fs;
            if (fp < 4) { const float* src = DEC + tok * 128 + h * 32 + fp * 8; f0 = *(const uint4*)src; f1 = *(const uint4*)(src + 4); }
            else { const bf16_t* src = P + tok * LDP + (fp < 6 ? PC_LK + h * 32 + (fp - 4) * 16 : PC_LQ + h * 32 + (fp - 6) * 16); f0 = *(const uint4*)src; f1 = *(const uint4*)(src + 8); }
            fc = *(const unsigned*)(P + tok * LDP + PC_LV + h * 64 + colbase + fp * 2);
        };
        fetch(0);
        for (int t0 = 0; t0 < SEQ; t0 += 8) {
            if (fp < 4) { *(uint4*)(lrow + fs * 512 + fp * 32) = f0; *(uint4*)(lrow + fs * 512 + fp * 32 + 16) = f1; }
            else { st8f(lrow + fs * 512 + 128 + (fp - 4) * 64, f0); st8f(lrow + fs * 512 + 128 + (fp - 4) * 64 + 32, f1); }
            *(unsigned*)(lcol + fs * 32 + fp * 4) = fc;
            if (t0 + 8 < SEQ) fetch(t0 + 8);
#pragma unroll
            for (int i = 0; i < 8; ++i) {
                const char* rb = lrow + i * 512 + sq * 32;
                const float4 d0 = *(const float4*)rb, d1 = *(const float4*)(rb + 16);
                const float4 k0 = *(const float4*)(rb + 128), k1 = *(const float4*)(rb + 144);
                const float4 q0 = *(const float4*)(rb + 256), q1 = *(const float4*)(rb + 272);
                const float vv = bf2f(*(const bf16_t*)(lcol + i * 32 + cl * 2));
                const f2_t v2 = mk2(vv, vv);
                const f2_t dd[4] = {mk2(d0.x, d0.y), mk2(d0.z, d0.w), mk2(d1.x, d1.y), mk2(d1.z, d1.w)};
                const f2_t kk[4] = {mk2(k0.x, k0.y), mk2(k0.z, k0.w), mk2(k1.x, k1.y), mk2(k1.z, k1.w)};
                const f2_t qq[4] = {mk2(q0.x, q0.y), mk2(q0.z, q0.w), mk2(q1.x, q1.y), mk2(q1.z, q1.w)};
                f2_t oa2 = mk2(0.f, 0.f), ob2 = mk2(0.f, 0.f);
#pragma unroll
                for (int q = 0; q < 4; q += 2) {
                    S[q] = dd[q] * S[q] + kk[q] * v2; S[q + 1] = dd[q + 1] * S[q + 1] + kk[q + 1] * v2;
                    oa2 = S[q] * qq[q] + oa2; ob2 = S[q + 1] * qq[q + 1] + ob2;
                }
                const f2_t os = oa2 + ob2;
                const float ov = quad_sum(os.x + os.y);
                *(sq == 0 ? Y + (tb + t0 + i) * DM + 512 + h * 64 + col : dummy + i) = f2bf(ov * 0.17677669529663687f);
                if (i & 1) __builtin_amdgcn_sched_barrier(0);
            }
        }
    }
}

__device__ __forceinline__ void ph_mixer_finish(const Ctx& p, int l) {
    const bf16_t* P = (const bf16_t*)(pws_() + WS_P);
    bf16_t* Y = (bf16_t*)(pws_() + WS_Y);
    const float* sn = pin_(9) + (size_t)l * 256;
    const float* gn = pin_(13) + (size_t)l * 64;
    const float* ln = pin_(16) + (size_t)l * 64;
    const int lane = tid_() & 63;
    for (int tok = gwave(); tok < MTOK; tok += nwaves()) {
        const size_t row = (size_t)tok * LDP;
        {
            float v[8], gt[8], gw[8];
            unpack8(*(const uint4*)(Y + (size_t)tok * DM + 8 * lane), v);
            unpack8(*(const uint4*)(P + row + (lane < 32 ? PC_Z + 8 * lane : PC_GG + 8 * (lane - 32))), gt);
            load8f(lane < 32 ? sn + 8 * lane : gn + 8 * (lane & 7), gw);
            float ss = 0.f;
            if (lane < 32) {
#pragma unroll
                for (int i = 0; i < 8; ++i) { v[i] *= silu_f(gt[i]); ss += v[i] * v[i]; }
            } else {
#pragma unroll
                for (int i = 0; i < 8; ++i) ss += v[i] * v[i];
            }
            const float s8 = oct_sum(ss);
            float s32 = s8 + __int_as_float(__builtin_amdgcn_mov_dpp(__float_as_int(s8), 0x140, 0xF, 0xF, true));
            s32 += __shfl_xor(s32, 16, 64);
            const float rs = lane < 32 ? rsqrtf(s32 * (1.f / 256.f) + EPS) : rsqrtf(s8 * (1.f / 64.f) + EPS);
            float o[8];
#pragma unroll
            for (int i = 0; i < 8; ++i) o[i] = lane < 32 ? v[i] * rs * gw[i] : v[i] * rs * gw[i] * silu_f(gt[i]);
            *(uint4*)(Y + (size_t)tok * DM + 8 * lane) = pack8(o);
        }
        if (lane < 32) {
            float v[8], gt[8], gw[8];
            unpack8(*(const uint4*)(Y + (size_t)tok * DM + 512 + 8 * lane), v);
            unpack8(*(const uint4*)(P + row + PC_LR + 8 * lane), gt);
            load8f(ln + 8 * (lane & 7), gw);
            float ss = 0.f;
#pragma unroll
            for (int i = 0; i < 8; ++i) ss += v[i] * v[i];
            const float rs = rsqrtf(oct_sum(ss) * (1.f / 64.f) + EPS);
            float o[8];
#pragma unroll
            for (int i = 0; i < 8; ++i) o[i] = v[i] * rs * gw[i] * silu_f(gt[i]);
            *(uint4*)(Y + (size_t)tok * DM + 512 + 8 * lane) = pack8(o);
        }
    }
}

typedef short bf16x8_t __attribute__((ext_vector_type(8)));
typedef float f32x4_t __attribute__((ext_vector_type(4)));
union BF8 { bf16x8_t v; uint4 u; unsigned w[4]; };


__device__ __forceinline__ void ph_dsa_prep(const Ctx& p, int l) {
    const bf16_t* P = (const bf16_t*)(pws_() + WS_P);
    bf16_t* qn = (bf16_t*)(pws_() + WS_QN);
    bf16_t* kn = (bf16_t*)(pws_() + WS_KN);
    bf16_t* ikn = (bf16_t*)(pws_() + WS_IKN);
    bf16_t* vt = (bf16_t*)(pws_() + WS_VT);
    const float* qg = pin_(17) + (size_t)l * 64;
    const float* kg = pin_(18) + (size_t)l * 64;
    const float* ig = pin_(19) + (size_t)l * 32;
    const int lane = tid_() & 63;
    const int pcol = lane < 40 ? PC_DQ + 8 * lane : PC_IK + 8 * (lane & 3);
    float gw[8];
    load8f(lane < 32 ? qg + 8 * (lane & 7) : (lane < 40 ? kg + 8 * (lane & 7) : ig + 8 * (lane & 3)), gw);
    for (int grp = gwave(); grp < MTOK / 8; grp += nwaves()) {
        const size_t tok0 = (size_t)grp * 8;
        const int b = (int)(tok0 / SEQ), t0 = (int)(tok0 % SEQ);
        unsigned short vv[8];
#pragma unroll
        for (int i = 0; i < 8; ++i) {
            const size_t row = (tok0 + i) * LDP;
            vv[i] = P[row + PC_DV + lane];
            if (lane < 44) {
                float v[8];
                unpack8(*(const uint4*)(P + row + pcol), v);
                float ss = 0.f;
#pragma unroll
                for (int q = 0; q < 8; ++q) ss += v[q] * v[q];
                const float s4 = ss + __int_as_float(__builtin_amdgcn_mov_dpp(__float_as_int(ss), 0xB1, 0xF, 0xF, true));
                const float s4b = s4 + __int_as_float(__builtin_amdgcn_mov_dpp(__float_as_int(s4), 0x4E, 0xF, 0xF, true));
                const float s8 = s4b + __int_as_float(__builtin_amdgcn_mov_dpp(__float_as_int(s4b), 0x141, 0xF, 0xF, true));
                const float rs = lane < 40 ? rsqrtf(s8 * (1.f / 64.f) + EPS) * (lane < 32 ? 0.125f : 1.f) : rsqrtf(s4b * (1.f / 32.f) + EPS);
                float o[8];
#pragma unroll
                for (int q = 0; q < 8; ++q) o[q] = v[q] * rs * gw[q];
                const uint4 pk = pack8(o);
                if (lane < 32) *(uint4*)(qn + (tok0 + i) * 256 + 8 * lane) = pk;
                else if (lane < 40) *(uint4*)(kn + (tok0 + i) * 64 + 8 * (lane - 32)) = pk;
                else *(uint4*)(ikn + (tok0 + i) * 32 + 8 * (lane - 40)) = pk;
            }
        }
        uint4 o; o.x = (unsigned)vv[0] | ((unsigned)vv[1] << 16); o.y = (unsigned)vv[2] | ((unsigned)vv[3] << 16);
        o.z = (unsigned)vv[4] | ((unsigned)vv[5] << 16); o.w = (unsigned)vv[6] | ((unsigned)vv[7] << 16);
        *(uint4*)(vt + ((size_t)b * 64 + lane) * SEQ + t0) = o;
    }
}

#define DSA_STRIDE 2052
__device__ __forceinline__ void ph_dsa_main(const Ctx& p, int l, float* smem) {
    const bf16_t* P = (const bf16_t*)(pws_() + WS_P);
    bf16_t* Y = (bf16_t*)(pws_() + WS_Y);
    const bf16_t* QN = (const bf16_t*)(pws_() + WS_QN);
    const bf16_t* KN = (const bf16_t*)(pws_() + WS_KN);
    const bf16_t* IKN = (const bf16_t*)(pws_() + WS_IKN);
    const bf16_t* VT = (const bf16_t*)(pws_() + WS_VT);
    unsigned* sc = (unsigned*)smem;
    float* part = smem;
    float* plsum = smem + 8 * 64 * 64;
    unsigned* thr = (unsigned*)(smem + 35000);
    const int tid = tid_(), lane = tid & 63, w = tid >> 6, qi = lane & 15, g = lane >> 4;
    for (int task = bid_(); task < MTOK / 16; task += nblk_()) {
        const int c = 31 - task / 128, b = (task >> 2) & 31, sub = task & 3;
        const int t0 = c * 64 + sub * 16, nk = (c + 1) * 64;
        const size_t tok0 = (size_t)b * SEQ + t0;
        const bool dosel = nk > 256;
        if (dosel) {
            BF8 iqf[8]; float wq[8];
#pragma unroll
            for (int h = 0; h < 8; ++h) {
                iqf[h].u = *(const uint4*)(P + (tok0 + qi) * LDP + PC_IQ + h * 32 + 8 * g);
                wq[h] = bf2f(P[(tok0 + qi) * LDP + PC_IW + h]) * 0.0625f;
            }
            for (int kt = w; kt < nk / 16; kt += 8) {
                const int s0 = kt * 16;
                BF8 ka; ka.u = *(const uint4*)(IKN + ((size_t)b * SEQ + s0 + qi) * 32 + 8 * g);
                float acc[4] = {0.f, 0.f, 0.f, 0.f};
#pragma unroll
                for (int h = 0; h < 8; ++h) {
                    const f32x4_t d = __builtin_amdgcn_mfma_f32_16x16x32_bf16(ka.v, iqf[h].v, (f32x4_t){0.f, 0.f, 0.f, 0.f}, 0, 0, 0);
#pragma unroll
                    for (int r = 0; r < 4; ++r) acc[r] = __builtin_fmaf(wq[h], fmaxf(d[r], 0.f), acc[r]);
                }
                uint4 kv; kv.x = ford(acc[0]); kv.y = ford(acc[1]); kv.z = ford(acc[2]); kv.w = ford(acc[3]);
                *(uint4*)(sc + qi * DSA_STRIDE + s0 + 4 * g) = kv;
            }
        }
        __syncthreads();
        if (dosel) {
            const int nj = nk >> 6;
#pragma unroll 1
            for (int qq = 0; qq < 2; ++qq) {
                const int q = 2 * w + qq;
                unsigned kreg[32];
#pragma unroll
                for (int j = 0; j < 32; ++j) kreg[j] = (j < nj) ? sc[q * DSA_STRIDE + j * 64 + lane] : 0u;
                unsigned T = 0u; bool exact = false;
                for (int bit = 31; bit >= 0; --bit) {
                    const unsigned cand = T | (1u << bit);
                    int cnt = 0;
#pragma unroll
                    for (int j = 0; j < 32; ++j) cnt += __popcll(__ballot(kreg[j] >= cand));
                    if (cnt >= 256) { T = cand; if (cnt == 256) { exact = true; break; } }
                }
                int cut = 0x7fffffff;
                if (!exact) {
                    int cgt = 0, ceq = 0;
#pragma unroll
                    for (int j = 0; j < 32; ++j) { cgt += __popcll(__ballot(kreg[j] > T)); ceq += __popcll(__ballot(kreg[j] == T)); }
                    int need = 256 - cgt;
                    if (ceq > need) {
                        bool found = false;
#pragma unroll
                        for (int j = 0; j < 32; ++j) {
                            const unsigned long long m = __ballot(kreg[j] == T);
                            const int cj = __popcll(m);
                            if (!found) {
                                if (need <= cj) { for (int bpos = 0; bpos < 64; ++bpos) if ((m >> bpos) & 1ull) { if (--need == 0) { cut = j * 64 + bpos; break; } } found = true; }
                                else need -= cj;
                            }
                        }
                    }
                }
                if (lane == 0) { thr[q] = T; thr[16 + q] = (unsigned)cut; }
            }
        }
        __syncthreads();
        unsigned Tq = 0u; int cutq = 0x7fffffff;
        if (dosel) { Tq = thr[qi]; cutq = (int)thr[16 + qi]; }
        f32x4_t oacc[4][4]; float lsum[4];
#pragma unroll
        for (int h = 0; h < 4; ++h) { lsum[h] = 0.f;
#pragma unroll
            for (int dt = 0; dt < 4; ++dt) oacc[h][dt] = (f32x4_t){0.f, 0.f, 0.f, 0.f}; }
        const int krow = 8 * (qi >> 2) + (qi & 3);
        for (int st = w; st < nk / 32; st += 8) {
            const int s0 = st * 32;
            BF8 ka[2][2], va[4];
#pragma unroll
            for (int t = 0; t < 2; ++t)
#pragma unroll
                for (int s2 = 0; s2 < 2; ++s2) ka[t][s2].u = *(const uint4*)(KN + ((size_t)b * SEQ + s0 + krow + 4 * t) * 64 + 32 * s2 + 8 * g);
#pragma unroll
            for (int dt = 0; dt < 4; ++dt) va[dt].u = *(const uint4*)(VT + ((size_t)b * 64 + 16 * dt + qi) * SEQ + s0 + 8 * g);
            float mk[8];
            if (dosel) {
                const uint4 k0 = *(const uint4*)(sc + qi * DSA_STRIDE + s0 + 8 * g), k1 = *(const uint4*)(sc + qi * DSA_STRIDE + s0 + 8 * g + 4);
                const unsigned kk[8] = {k0.x, k0.y, k0.z, k0.w, k1.x, k1.y, k1.z, k1.w};
#pragma unroll
                for (int j = 0; j < 8; ++j) mk[j] = (kk[j] > Tq || (kk[j] == Tq && (s0 + 8 * g + j) <= cutq)) ? 1.f : 0.f;
            } else {
#pragma unroll
                for (int j = 0; j < 8; ++j) mk[j] = 1.f;
            }
#pragma unroll
            for (int h = 0; h < 4; ++h) {
                BF8 q0, q1;
                q0.u = *(const uint4*)(QN + (tok0 + qi) * 256 + h * 64 + 8 * g);
                q1.u = *(const uint4*)(QN + (tok0 + qi) * 256 + h * 64 + 32 + 8 * g);
                f32x4_t sacc[2];
#pragma unroll
                for (int t = 0; t < 2; ++t) {
                    sacc[t] = __builtin_amdgcn_mfma_f32_16x16x32_bf16(ka[t][0].v, q0.v, (f32x4_t){0.f, 0.f, 0.f, 0.f}, 0, 0, 0);
                    sacc[t] = __builtin_amdgcn_mfma_f32_16x16x32_bf16(ka[t][1].v, q1.v, sacc[t], 0, 0, 0);
                }
                float pe[8];
#pragma unroll
                for (int t = 0; t < 2; ++t)
#pragma unroll
                    for (int r = 0; r < 4; ++r) { pe[4 * t + r] = __expf(sacc[t][r]) * mk[4 * t + r]; lsum[h] += pe[4 * t + r]; }
                BF8 pf;
#pragma unroll
                for (int j = 0; j < 4; ++j) pf.w[j] = pk_bf16(pe[2 * j], pe[2 * j + 1]);
#pragma unroll
                for (int dt = 0; dt < 4; ++dt) oacc[h][dt] = __builtin_amdgcn_mfma_f32_16x16x32_bf16(va[dt].v, pf.v, oacc[h][dt], 0, 0, 0);
            }
        }
        __syncthreads();
#pragma unroll
        for (int h = 0; h < 4; ++h) {
            plsum[(w * 4 + h) * 64 + lane] = lsum[h];
#pragma unroll
            for (int dt = 0; dt < 4; ++dt)
#pragma unroll
                for (int r = 0; r < 4; ++r) part[(w * 64 + h * 16 + dt * 4 + r) * 64 + lane] = oacc[h][dt][r];
        }
        __syncthreads();
        {
            const int h = w >> 1;
            float lq = 0.f;
#pragma unroll
            for (int w2 = 0; w2 < 8; ++w2)
#pragma unroll
                for (int g2 = 0; g2 < 4; ++g2) lq += plsum[(w2 * 4 + h) * 64 + qi + 16 * g2];
            const float inv = 1.f / lq;
#pragma unroll
            for (int dd = 0; dd < 2; ++dd) {
                const int dt = (w & 1) * 2 + dd;
                float o[4];
#pragma unroll
                for (int r = 0; r < 4; ++r) {
                    float sacc = 0.f;
#pragma unroll
                    for (int w2 = 0; w2 < 8; ++w2) sacc += part[(w2 * 64 + h * 16 + dt * 4 + r) * 64 + lane];
                    o[r] = sacc * inv;
                }
                uint2 ov; ov.x = pk_bf16(o[0], o[1]); ov.y = pk_bf16(o[2], o[3]);
                *(uint2*)(Y + (tok0 + qi) * DM + 768 + h * 64 + 16 * dt + 4 * g) = ov;
            }
        }
        __syncthreads();
    }
}

__device__ __forceinline__ void ph_mem_prep(const Ctx& p, int l) {
    const float* Km = (const float*)(pws_() + WS_KM);
    const float* Vm = (const float*)(pws_() + WS_VM);
    bf16_t* KB = (bf16_t*)(pws_() + WS_KB);
    bf16_t* VTB = (bf16_t*)(pws_() + WS_VTB);
    const float* kg = pin_(28) + (size_t)l * 64;
    const int lane = tid_() & 63;
    for (int r = gwave(); r < MMEM; r += nwaves()) {
        const int b = r / NMEM, j = r % NMEM;
#pragma unroll
        for (int h = 0; h < 4; ++h) {
            const float v = Km[(size_t)r * 256 + h * 64 + lane];
            const float ss = wave_sum(v * v);
            KB[(((size_t)b * 4 + h) * NMEM + j) * 64 + lane] = f2bf(v * rsqrtf(ss * (1.f / 64.f) + EPS) * kg[lane]);
            VTB[(((size_t)b * 4 + h) * 64 + lane) * NMEM + j] = f2bf(Vm[(size_t)r * 256 + h * 64 + lane]);
        }
    }
}
__device__ __forceinline__ void ph_xattn(const Ctx& p, int l) {
    const float* Qx = (const float*)(pws_() + WS_QX);
    bf16_t* Ox = (bf16_t*)(pws_() + WS_OX);
    const bf16_t* KB = (const bf16_t*)(pws_() + WS_KB);
    const bf16_t* VTB = (const bf16_t*)(pws_() + WS_VTB);
    const float* qg = pin_(27) + (size_t)l * 64;
    const int lane = tid_() & 63, qi = lane & 15, g = lane >> 4;
    for (int task = gwave(); task < MTOK / 16; task += nwaves()) {
        const int tok0 = task * 16, b = tok0 / SEQ;
#pragma unroll 1
        for (int h = 0; h < 4; ++h) {
            BF8 qf[2];
            {
                float qv[2][8]; float ss = 0.f;
#pragma unroll
                for (int s2 = 0; s2 < 2; ++s2) {
                    const float4* qp = (const float4*)(Qx + (size_t)(tok0 + qi) * 256 + h * 64 + 32 * s2 + 8 * g);
                    const float4 a = qp[0], c = qp[1];
                    qv[s2][0] = a.x; qv[s2][1] = a.y; qv[s2][2] = a.z; qv[s2][3] = a.w; qv[s2][4] = c.x; qv[s2][5] = c.y; qv[s2][6] = c.z; qv[s2][7] = c.w;
#pragma unroll
                    for (int j = 0; j < 8; ++j) ss += qv[s2][j] * qv[s2][j];
                }
                ss += __shfl_xor(ss, 16, 64); ss += __shfl_xor(ss, 32, 64);
                const float rs = rsqrtf(ss * (1.f / 64.f) + EPS) * 0.125f;
#pragma unroll
                for (int s2 = 0; s2 < 2; ++s2) {
                    const float4 g0 = *(const float4*)(qg + 32 * s2 + 8 * g), g1 = *(const float4*)(qg + 32 * s2 + 8 * g + 4);
                    qf[s2].w[0] = pk_bf16(qv[s2][0] * rs * g0.x, qv[s2][1] * rs * g0.y); qf[s2].w[1] = pk_bf16(qv[s2][2] * rs * g0.z, qv[s2][3] * rs * g0.w);
                    qf[s2].w[2] = pk_bf16(qv[s2][4] * rs * g1.x, qv[s2][5] * rs * g1.y); qf[s2].w[3] = pk_bf16(qv[s2][6] * rs * g1.z, qv[s2][7] * rs * g1.w);
                }
            }
            const bf16_t* Kh = KB + ((size_t)b * 4 + h) * NMEM * 64;
            const bf16_t* Vh = VTB + ((size_t)b * 4 + h) * 64 * NMEM;
            f32x4_t oacc[4];
#pragma unroll
            for (int dt = 0; dt < 4; ++dt) oacc[dt] = (f32x4_t){0.f, 0.f, 0.f, 0.f};
            float lsum = 0.f;
            const int krow = 8 * (qi >> 2) + (qi & 3);
#pragma unroll 2
            for (int s0 = 0; s0 < NMEM; s0 += 32) {
                BF8 ka[2][2], va[4];
#pragma unroll
                for (int t = 0; t < 2; ++t)
#pragma unroll
                    for (int s2 = 0; s2 < 2; ++s2) ka[t][s2].u = *(const uint4*)(Kh + (size_t)(s0 + krow + 4 * t) * 64 + 32 * s2 + 8 * g);
#pragma unroll
                for (int dt = 0; dt < 4; ++dt) va[dt].u = *(const uint4*)(Vh + (size_t)(16 * dt + qi) * NMEM + s0 + 8 * g);
                f32x4_t sacc[2];
#pragma unroll
                for (int t = 0; t < 2; ++t) {
                    sacc[t] = (f32x4_t){0.f, 0.f, 0.f, 0.f};
                    sacc[t] = __builtin_amdgcn_mfma_f32_16x16x32_bf16(ka[t][0].v, qf[0].v, sacc[t], 0, 0, 0);
                    sacc[t] = __builtin_amdgcn_mfma_f32_16x16x32_bf16(ka[t][1].v, qf[1].v, sacc[t], 0, 0, 0);
                }
                float pe[8];
#pragma unroll
                for (int t = 0; t < 2; ++t)
#pragma unroll
                    for (int r = 0; r < 4; ++r) { pe[4 * t + r] = __expf(sacc[t][r]); lsum += pe[4 * t + r]; }
                BF8 pf;
#pragma unroll
                for (int j = 0; j < 4; ++j) pf.w[j] = pk_bf16(pe[2 * j], pe[2 * j + 1]);
#pragma unroll
                for (int dt = 0; dt < 4; ++dt) oacc[dt] = __builtin_amdgcn_mfma_f32_16x16x32_bf16(va[dt].v, pf.v, oacc[dt], 0, 0, 0);
            }
            lsum += __shfl_xor(lsum, 16, 64); lsum += __shfl_xor(lsum, 32, 64);
            const float inv = 1.f / lsum;
#pragma unroll
            for (int dt = 0; dt < 4; ++dt) {
                uint2 o; o.x = pk_bf16(oacc[dt][0] * inv, oacc[dt][1] * inv); o.y = pk_bf16(oacc[dt][2] * inv, oacc[dt][3] * inv);
                *(uint2*)(Ox + (size_t)(tok0 + qi) * 256 + h * 64 + 16 * dt + 4 * g) = o;
            }
        }
    }
}

template <int N> __device__ __forceinline__ void bitonic_sort_desc(unsigned (&a)[N]) {
#pragma unroll
    for (int k = 2; k <= N; k <<= 1)
#pragma unroll
        for (int j = k >> 1; j > 0; j >>= 1)
#pragma unroll
            for (int i = 0; i < N; ++i) {
                const int o = i ^ j;
                if (o > i) {
                    const bool desc = ((i & k) == 0);
                    const unsigned x = a[i], y = a[o];
                    const unsigned mx = x > y ? x : y, mn = x > y ? y : x;
                    a[i] = desc ? mx : mn; a[o] = desc ? mn : mx;
                }
            }
}
__device__ __forceinline__ void bitonic_merge16_desc(unsigned (&a)[16]) {
#pragma unroll
    for (int j = 8; j > 0; j >>= 1)
#pragma unroll
        for (int i = 0; i < 16; ++i) {
            const int o = i ^ j;
            if (o > i) { const unsigned x = a[i], y = a[o]; a[i] = x > y ? x : y; a[o] = x > y ? y : x; }
        }
}
__device__ __forceinline__ void top16_merge(unsigned (&a)[16], const unsigned (&b)[16]) {
#pragma unroll
    for (int i = 0; i < 16; ++i) a[i] = a[i] > b[15 - i] ? a[i] : b[15 - i];
    bitonic_merge16_desc(a);
}
__device__ __forceinline__ void top16_xlane(unsigned (&a)[16], int xm) {
    unsigned b[16];
#pragma unroll
    for (int i = 0; i < 16; ++i) b[i] = (unsigned)__shfl_xor((int)a[i], xm, 64);
    top16_merge(a, b);
}
__device__ __forceinline__ void ph_subkeys_convert(const Ctx& p) {
    const float* sk = pin_(31);
    bf16_t* o = (bf16_t*)(pws_() + WS_SKB);
    const size_t n = (size_t)DEPTH * 8 * 2 * 128 * 64;
    for (size_t i = (size_t)bid_() * 512 + tid_(); i < n; i += (size_t)nblk_() * 512) o[i] = f2bf(sk[i]);
}
__device__ __forceinline__ void ph_peer_topk(const Ctx& p, int l, float* smem) {
    const bf16_t* Qp = (const bf16_t*)(pws_() + WS_QP);
    const bf16_t* SK = (const bf16_t*)(pws_() + WS_SKB) + (size_t)l * 8 * 2 * 128 * 64;
    int* pidx = (int*)(pws_() + WS_PEI);
    float* pgt = (float*)(pws_() + WS_PEG);
    const int tid = tid_(), lane = tid & 63, wave = tid >> 6, qi = lane & 15, g = lane >> 4;
    int* tabw = (int*)smem + wave * 512 + qi * 32;
    for (int task = gwave(); task < MTOK / 16; task += nwaves()) {
        const size_t tok = (size_t)task * 16 + qi;
#pragma unroll 1
        for (int h = 0; h < 8; ++h) {
            unsigned L[2][16];
#pragma unroll
            for (int pp = 0; pp < 2; ++pp) {
                BF8 qf[2];
#pragma unroll
                for (int s2 = 0; s2 < 2; ++s2) qf[s2].u = *(const uint4*)(Qp + tok * DM + h * 128 + pp * 64 + 32 * s2 + 8 * g);
                const bf16_t* skp = SK + (size_t)(h * 2 + pp) * 128 * 64;
                unsigned va[16], vb[16];
#pragma unroll
                for (int tile = 0; tile < 8; ++tile) {
                    BF8 ka[2];
#pragma unroll
                    for (int s2 = 0; s2 < 2; ++s2) ka[s2].u = *(const uint4*)(skp + (size_t)(16 * tile + qi) * 64 + 32 * s2 + 8 * g);
                    f32x4_t d = __builtin_amdgcn_mfma_f32_16x16x32_bf16(ka[0].v, qf[0].v, (f32x4_t){0.f, 0.f, 0.f, 0.f}, 0, 0, 0);
                    d = __builtin_amdgcn_mfma_f32_16x16x32_bf16(ka[1].v, qf[1].v, d, 0, 0, 0);
#pragma unroll
                    for (int r = 0; r < 4; ++r) {
                        const unsigned key = (ford(d[r]) & ~127u) | (unsigned)(127 - (16 * tile + 4 * g + r));
                        if (tile < 4) va[tile * 4 + r] = key; else vb[(tile - 4) * 4 + r] = key;
                    }
                }
                bitonic_sort_desc<16>(va);
                bitonic_sort_desc<16>(vb);
                top16_merge(va, vb);
                top16_xlane(va, 16);
                top16_xlane(va, 32);
#pragma unroll
                for (int i = 0; i < 16; ++i) L[pp][i] = va[i];
            }
            if (g < 2) {
#pragma unroll
                for (int i = 0; i < 16; ++i) tabw[g * 16 + i] = 127 - (int)((g == 0 ? L[0][i] : L[1][i]) & 127u);
            }
            float s1[16], s2v[16];
#pragma unroll
            for (int i = 0; i < 16; ++i) { s1[i] = funord(L[0][i] & ~127u); s2v[i] = funord(L[1][i] & ~127u); }
            unsigned ca[16], cb[16];
#pragma unroll
            for (int i = 0; i < 16; ++i) { ca[i] = 0u; cb[i] = 0u; }
            {
                const float r0 = g == 0 ? s1[0] : (g == 1 ? s1[1] : (g == 2 ? s1[2] : s1[3]));
                const int nb0 = g == 0 ? 16 : (g == 1 ? 8 : (g == 2 ? 5 : 4));
#pragma unroll
                for (int bq = 0; bq < 16; ++bq) if (bq < nb0) ca[bq] = (ford(r0 + s2v[bq]) & ~255u) | (unsigned)(255 - (g * 16 + bq));
                const float r1 = g == 0 ? s1[4] : (g == 1 ? s1[5] : (g == 2 ? s1[6] : s1[7]));
                const int nb1 = g == 0 ? 3 : 2;
#pragma unroll
                for (int bq = 0; bq < 3; ++bq) if (bq < nb1) cb[bq] = (ford(r1 + s2v[bq]) & ~255u) | (unsigned)(255 - ((g + 4) * 16 + bq));
                const float r2 = g == 0 ? s1[8] : (g == 1 ? s1[9] : (g == 2 ? s1[10] : s1[11]));
                cb[3] = (ford(r2 + s2v[0]) & ~255u) | (unsigned)(255 - ((g + 8) * 16));
                const float r3 = g == 0 ? s1[12] : (g == 1 ? s1[13] : (g == 2 ? s1[14] : s1[15]));
                cb[4] = (ford(r3 + s2v[0]) & ~255u) | (unsigned)(255 - ((g + 12) * 16));
            }
            bitonic_sort_desc<16>(ca);
            bitonic_sort_desc<16>(cb);
            top16_merge(ca, cb);
            top16_xlane(ca, 16);
            top16_xlane(ca, 32);
            float tv[16]; float den = 0.f;
#pragma unroll
            for (int i = 0; i < 16; ++i) {
                const int f = 255 - (int)(ca[i] & 255u);
                const int a = f >> 4, bq = f & 15;
                tv[i] = funord(ca[i] & ~255u);
                (void)a; (void)bq;
            }
#pragma unroll
            for (int i = 0; i < 16; ++i) { tv[i] = __expf(tv[i] - funord(ca[0] & ~255u)); den += tv[i]; }
            const float inv = 1.f / den;
            int ev[4]; float gv[4];
#pragma unroll
            for (int r = 0; r < 4; ++r) {
                const unsigned key = g == 0 ? ca[r] : (g == 1 ? ca[4 + r] : (g == 2 ? ca[8 + r] : ca[12 + r]));
                const float tvv = g == 0 ? tv[r] : (g == 1 ? tv[4 + r] : (g == 2 ? tv[8 + r] : tv[12 + r]));
                const int f = 255 - (int)(key & 255u);
                ev[r] = tabw[f >> 4] * 128 + tabw[16 + (f & 15)];
                gv[r] = tvv * inv;
            }
            *(int4*)(pidx + tok * 128 + h * 16 + 4 * g) = make_int4(ev[0], ev[1], ev[2], ev[3]);
            *(float4*)(pgt + tok * 128 + h * 16 + 4 * g) = make_float4(gv[0], gv[1], gv[2], gv[3]);
        }
    }
}

typedef _Float16 h2_t __attribute__((ext_vector_type(2)));
__device__ __forceinline__ h2_t as_h2(unsigned u) { union { unsigned u; h2_t h; } c; c.u = u; return c.h; }
#define U_SCALE 1024.f
#define V_SCALE 256.f
typedef float f32x2_t __attribute__((ext_vector_type(2)));
__device__ __forceinline__ unsigned pack4_fp8(float4 a, float sc) {
    const float x = fminf(fmaxf(a.x * sc, -448.f), 448.f), y = fminf(fmaxf(a.y * sc, -448.f), 448.f);
    const float z = fminf(fmaxf(a.z * sc, -448.f), 448.f), w = fminf(fmaxf(a.w * sc, -448.f), 448.f);
    int r = __builtin_amdgcn_cvt_pk_fp8_f32(x, y, 0, false);
    r = __builtin_amdgcn_cvt_pk_fp8_f32(z, w, r, true);
    return (unsigned)r;
}
__device__ __forceinline__ void ph_tab_convert(const Ctx& p, int l) {
    const float4* u = (const float4*)(pin_(32) + (size_t)l * NEXP * DM);
    const float4* v = (const float4*)(pin_(33) + (size_t)l * NEXP * DM);
    unsigned* uo = (unsigned*)(pws_() + WS_UT16);
    unsigned* vo = (unsigned*)(pws_() + WS_VT16);
    const size_t n4 = (size_t)NEXP * DM / 4;
    for (size_t i = (size_t)bid_() * 512 + tid_(); i < n4; i += (size_t)nblk_() * 512) {
        uo[i] = pack4_fp8(u[i], U_SCALE);
        vo[i] = pack4_fp8(v[i], V_SCALE);
    }
}
__device__ __forceinline__ void ph_peer_gather(const Ctx& p, int l) {
    const unsigned char* ut = (const unsigned char*)(pws_() + WS_UT16);
    const unsigned char* vt = (const unsigned char*)(pws_() + WS_VT16);
    const int* pidx = (const int*)(pws_() + WS_PEI);
    const float* pgt = (const float*)(pws_() + WS_PEG);
    const bf16_t* H = (const bf16_t*)(pws_() + WS_H);
    float* x = pout_();
    const int lane = tid_() & 63;
    const bool bit5 = lane & 32, bit4 = lane & 16, bit3 = lane & 8, bit2 = lane & 4;
    const int jmine = ((lane >> 5) & 1) * 8 + ((lane >> 4) & 1) * 4 + ((lane >> 3) & 1) * 2 + ((lane >> 2) & 1);
    for (int tok = gwave(); tok < MTOK; tok += nwaves()) {
        float hh[16];
        {
            const uint4 r0 = *(const uint4*)(H + (size_t)tok * DM + lane * 16), r1 = *(const uint4*)(H + (size_t)tok * DM + lane * 16 + 8);
            const unsigned w[8] = {r0.x, r0.y, r0.z, r0.w, r1.x, r1.y, r1.z, r1.w};
#pragma unroll
            for (int q = 0; q < 8; ++q) { hh[2 * q] = __uint_as_float(w[q] << 16); hh[2 * q + 1] = __uint_as_float(w[q] & 0xffff0000u); }
        }
        const int e0 = pidx[(size_t)tok * 128 + lane], e1 = pidx[(size_t)tok * 128 + 64 + lane];
        const float g0 = pgt[(size_t)tok * 128 + lane], g1 = pgt[(size_t)tok * 128 + 64 + lane];
        float out[16];
#pragma unroll
        for (int i = 0; i < 16; ++i) out[i] = 0.f;
#pragma unroll 1
        for (int hb = 0; hb < 8; ++hb) {
            const int esrc = hb < 4 ? e0 : e1;
            const float gsrc = hb < 4 ? g0 : g1;
            const int lb = (hb & 3) * 16;
            uint4 ur[16], vr[16];
#pragma unroll
            for (int j = 0; j < 16; ++j) {
                const int e = __builtin_amdgcn_readlane(esrc, lb + j);
                ur[j] = *(const uint4*)(ut + (size_t)e * DM + lane * 16);
                vr[j] = *(const uint4*)(vt + (size_t)e * DM + lane * 16);
            }
            float pd[16];
#pragma unroll
            for (int j = 0; j < 16; ++j) {
                const unsigned w[4] = {ur[j].x, ur[j].y, ur[j].z, ur[j].w};
                float d0 = 0.f, d1 = 0.f;
#pragma unroll
                for (int q = 0; q < 4; ++q) {
                    const f32x2_t a = __builtin_amdgcn_cvt_pk_f32_fp8((int)w[q], false), c = __builtin_amdgcn_cvt_pk_f32_fp8((int)w[q], true);
                    d0 = __builtin_fmaf(a.x, hh[4 * q], d0); d1 = __builtin_fmaf(a.y, hh[4 * q + 1], d1);
                    d0 = __builtin_fmaf(c.x, hh[4 * q + 2], d0); d1 = __builtin_fmaf(c.y, hh[4 * q + 3], d1);
                }
                pd[j] = d0 + d1;
            }
            float r8[8], r4[4], r2[2], r1;
#pragma unroll
            for (int i = 0; i < 8; ++i) { const float mine = bit5 ? pd[i + 8] : pd[i], send = bit5 ? pd[i] : pd[i + 8]; r8[i] = mine + __shfl_xor(send, 32, 64); }
#pragma unroll
            for (int i = 0; i < 4; ++i) { const float mine = bit4 ? r8[i + 4] : r8[i], send = bit4 ? r8[i] : r8[i + 4]; r4[i] = mine + __shfl_xor(send, 16, 64); }
#pragma unroll
            for (int i = 0; i < 2; ++i) { const float mine = bit3 ? r4[i + 2] : r4[i], send = bit3 ? r4[i] : r4[i + 2]; r2[i] = mine + __shfl_xor(send, 8, 64); }
            { const float mine = bit2 ? r2[1] : r2[0], send = bit2 ? r2[0] : r2[1]; r1 = mine + __shfl_xor(send, 4, 64); }
            r1 += __shfl_xor(r1, 2, 64); r1 += __shfl_xor(r1, 1, 64);
            const float gmine = __shfl(gsrc, lb + jmine, 64);
            const float coef = gmine * gelu_tanh_f(r1 * (1.f / U_SCALE)) * (1.f / V_SCALE);
#pragma unroll
            for (int j = 0; j < 16; ++j) {
                const float cj = __uint_as_float(__builtin_amdgcn_readlane(__float_as_uint(coef), (j >> 3) * 32 + ((j >> 2) & 1) * 16 + ((j >> 1) & 1) * 8 + (j & 1) * 4));
                const unsigned w[4] = {vr[j].x, vr[j].y, vr[j].z, vr[j].w};
#pragma unroll
                for (int q = 0; q < 4; ++q) {
                    const f32x2_t a = __builtin_amdgcn_cvt_pk_f32_fp8((int)w[q], false), c = __builtin_amdgcn_cvt_pk_f32_fp8((int)w[q], true);
                    out[4 * q] = __builtin_fmaf(a.x, cj, out[4 * q]); out[4 * q + 1] = __builtin_fmaf(a.y, cj, out[4 * q + 1]);
                    out[4 * q + 2] = __builtin_fmaf(c.x, cj, out[4 * q + 2]); out[4 * q + 3] = __builtin_fmaf(c.y, cj, out[4 * q + 3]);
                }
            }
        }
        float4* xp = (float4*)(x + (size_t)tok * DM + lane * 16);
        float ss = 0.f;
#pragma unroll
        for (int q = 0; q < 4; ++q) {
            float4 a = xp[q];
            a.x += out[4 * q]; a.y += out[4 * q + 1]; a.z += out[4 * q + 2]; a.w += out[4 * q + 3];
            xp[q] = a;
            ss += a.x * a.x + a.y * a.y + a.z * a.z + a.w * a.w;
        }
        if (l + 1 < DEPTH) {
            const float rs = rsqrtf(wave_sum(ss) * (1.f / DM) + EPS);
            asm volatile("" ::: "memory");
            const float* gnx = pin_(2) + (size_t)(l + 1) * DM + lane * 16;
            bf16_t* hp = (bf16_t*)(pws_() + WS_H) + (size_t)tok * DM + lane * 16;
#pragma unroll
            for (int hq = 0; hq < 2; ++hq) {
                const float4 a = xp[2 * hq], b4 = xp[2 * hq + 1];
                float g8v[8], o8[8];
                load8f(gnx + 8 * hq, g8v);
                o8[0] = a.x * rs * g8v[0]; o8[1] = a.y * rs * g8v[1]; o8[2] = a.z * rs * g8v[2]; o8[3] = a.w * rs * g8v[3];
                o8[4] = b4.x * rs * g8v[4]; o8[5] = b4.y * rs * g8v[5]; o8[6] = b4.z * rs * g8v[6]; o8[7] = b4.w * rs * g8v[7];
                *(uint4*)(hp + 8 * hq) = pack8(o8);
            }
        }
    }
}


#ifndef PROBE_MASK
#define PROBE_MASK 0
#endif
#if PROBE_MASK
#define GB(k) do { GRID_BARRIER(); const unsigned long long now_ = wall_clock64(); if ((PROBE_MASK >> (k)) & 1) { const unsigned long long dt_ = now_ - tprev_; while (wall_clock64() - now_ < 3ull * dt_) __builtin_amdgcn_s_sleep(8); } GRID_BARRIER(); tprev_ = wall_clock64(); } while (0)
#else
#define GB(k) GRID_BARRIER()
#endif
__global__ void __launch_bounds__(512, 2) k_mega(Params kp) {
    float* sm = dynsmem;
    {
        unsigned long long* tab = (unsigned long long*)((char*)dynsmem + PTAB_OFF);
        if (threadIdx.x < 34) tab[threadIdx.x] = (unsigned long long)kp.in[threadIdx.x];
        if (threadIdx.x == 34) tab[34] = (unsigned long long)kp.out;
        if (threadIdx.x == 35) tab[35] = (unsigned long long)kp.ws;
        if (threadIdx.x == 36) { tab[36] = 0ull; tab[37] = 0ull; }
    }
    __syncthreads();
    Ctx p; p.kp = &kp;
    (void)xcd_barrier_post((unsigned*)(pws_() + WS_BAR), (volatile LAS unsigned*)((char*)dynsmem + PTAB_OFF + 36 * 8));
#define GRID_BARRIER() do { XcdBarrier bar_; bar_.bar = (unsigned*)(pws_() + WS_BAR); bar_.x = xb_xcc_id(); bar_.st = (volatile LAS unsigned*)((char*)dynsmem + PTAB_OFF + 36 * 8); xcd_barrier(bar_); } while (0)
    ph_weight_prep(p, sm);
    ph_subkeys_convert(p);
    GRID_BARRIER();
#if PROBE_MASK
    unsigned long long tprev_ = wall_clock64();
#endif
#pragma unroll 1
    for (int l = 0; l < DEPTH; ++l) {
#define XIN_ (l == 0 ? pin_(0) : pout_())
#define HBUF_ ((const bf16_t*)(pws_() + WS_H))
        if (l == 0) ph_rmsnorm(XIN_, pin_(2) + (size_t)l * DM, (bf16_t*)(pws_() + WS_H), MTOK);
        ph_rmsnorm(pin_(1), pin_(22) + (size_t)l * DM, (bf16_t*)(pws_() + WS_HM), MMEM);
        GB(1);
        { pg8::EpiBf16 E; E.O = (bf16_t*)(pws_() + WS_P); E.ldc = LDP; ph_gemm(HBUF_, (const bf16_t*)(pws_() + WT_IN) + (size_t)l * LDP * DM, MTOK, LDP, DM, E); }
        { pg8::EpiF32 E; E.C = (float*)(pws_() + WS_KM); E.R = nullptr; E.ldc = 256; ph_gemm((const bf16_t*)(pws_() + WS_HM), (const bf16_t*)(pws_() + WT_XK) + (size_t)l * 256 * DM, MMEM, 256, DM, E); }
        { pg8::EpiF32 E; E.C = (float*)(pws_() + WS_VM); E.R = nullptr; E.ldc = 256; ph_gemm((const bf16_t*)(pws_() + WS_HM), (const bf16_t*)(pws_() + WT_XV) + (size_t)l * 256 * DM, MMEM, 256, DM, E); }
        GB(2);
        ph_mem_prep(p, l);
        ph_dsa_prep(p, l);
        ph_scan_prep(p, l);
        GB(3);
        ph_scans(p, l, sm);
        GB(4);
        ph_mixer_finish(p, l);
        ph_dsa_main(p, l, sm);
        GB(5);
        { pg8::EpiF32 E; E.C = pout_(); E.R = XIN_; E.ldc = DM; ph_gemm((const bf16_t*)(pws_() + WS_Y), (const bf16_t*)(pws_() + WT_OUT) + (size_t)l * DM * DM, MTOK, DM, DM, E); }
        GB(6);
        ph_rmsnorm(pout_(), pin_(21) + (size_t)l * DM, (bf16_t*)(pws_() + WS_H), MTOK);
        GB(7);
        { pg8::EpiF32 E; E.C = (float*)(pws_() + WS_QX); E.R = nullptr; E.ldc = 256; ph_gemm(HBUF_, (const bf16_t*)(pws_() + WT_XQ) + (size_t)l * 256 * DM, MTOK, 256, DM, E); }
        GB(8);
        ph_xattn(p, l);
        GB(9);
        { pg8::EpiF32 E; E.C = pout_(); E.R = pout_(); E.ldc = DM; ph_gemm((const bf16_t*)(pws_() + WS_OX), (const bf16_t*)(pws_() + WT_XO) + (size_t)l * DM * 256, MTOK, DM, 256, E); }
        GB(10);
        ph_rmsnorm(pout_(), pin_(29) + (size_t)l * DM, (bf16_t*)(pws_() + WS_H), MTOK);
        ph_tab_convert(p, l);
        GB(11);
        { pg8::EpiBf16 E; E.O = (bf16_t*)(pws_() + WS_QP); E.ldc = DM; ph_gemm(HBUF_, (const bf16_t*)(pws_() + WT_PQ) + (size_t)l * DM * DM, MTOK, DM, DM, E); }
        GB(12);
        ph_peer_topk(p, l, sm);
        GB(13);
        ph_peer_gather(p, l);
        GB(14);
    }
}

extern "C" void kernel_launch(void* const* d_in, const int* in_sizes, int n_in, void* d_out, int out_size, void* d_ws, size_t ws_size, hipStream_t stream) {
    if (n_in != 34 || out_size != MTOK * DM || ws_size < WS_END) {
        fprintf(stderr, "kernel_launch: unexpected shapes (n_in %d out %d ws %zu need %zu)\n", n_in, out_size, ws_size, (size_t)WS_END);
        return;
    }
    static int grid = 0;
    if (!grid) {
        int dev = 0, cus = 0, per_cu = 0;
        (void)hipGetDevice(&dev);
        (void)hipDeviceGetAttribute(&cus, hipDeviceAttributeMultiprocessorCount, dev);
        (void)hipFuncSetAttribute((const void*)k_mega, hipFuncAttributeMaxDynamicSharedMemorySize, LDS_BYTES);
        (void)hipOccupancyMaxActiveBlocksPerMultiprocessor(&per_cu, (const void*)k_mega, 512, LDS_BYTES);
        if (per_cu < 1) fprintf(stderr, "kernel_launch: occupancy query reports %d blocks per CU\n", per_cu);
        grid = cus > 0 ? cus : 256;
    }
    Params p; memset(&p, 0, sizeof(p));
    for (int i = 0; i < 34; ++i) p.in[i] = (const float*)d_in[i];
    p.out = (float*)d_out; p.ws = (char*)d_ws;
    (void)hipMemsetAsync((char*)d_ws + WS_BAR, 0, XCD_BAR_WORDS * sizeof(unsigned), stream);
    hipLaunchKernelGGL(k_mega, dim3(grid), dim3(512), LDS_BYTES, stream, p);
}
```

```cpp
#include <hip/hip_runtime.h>
#include <stdint.h>
#include <stdio.h>
#include <string.h>

#define NB 32
#define SEQ 2048
#define DM 1024
#define MTOK (NB * SEQ)
#define DEPTH 4
#define NMEM 256
#define MMEM (NB * NMEM)
#define LDP 3328
#define NEXP 16384
#define EPS 1e-6f
#define PC_Z 0
#define PC_XBC 256
#define PC_GQKV 768
#define PC_GG 1536
#define PC_LQ 1792
#define PC_LK 1920
#define PC_LV 2048
#define PC_LR 2304
#define PC_DQ 2560
#define PC_DK 2816
#define PC_DV 2880
#define PC_IQ 2944
#define PC_IK 3200
#define PC_GLR 3232
#define PC_IW 3248
#define PC_DT 3256
#define PC_GA 3260
#define PC_GB 3264

typedef unsigned short bf16_t;

#define WS_BAR 0ull
#define WS_P 16384ull
#define SZ_P ((size_t)MTOK * LDP * 2)
#define WS_H (WS_P + SZ_P)
#define SZ_H ((size_t)MTOK * DM * 2)
#define WS_Y (WS_H + SZ_H)
#define SZ_Y ((size_t)MTOK * DM * 2)
#define WS_WP (WS_Y + SZ_Y)
#define SZ_WP ((size_t)DEPTH * DM * LDP * 4)
#define WT_IN (WS_WP)
#define WT_OUT (WT_IN + (size_t)DEPTH * LDP * DM * 2)
#define WT_XQ (WT_OUT + (size_t)DEPTH * DM * DM * 2)
#define WT_XK (WT_XQ + (size_t)DEPTH * 256 * DM * 2)
#define WT_XV (WT_XK + (size_t)DEPTH * 256 * DM * 2)
#define WT_XO (WT_XV + (size_t)DEPTH * 256 * DM * 2)
#define WT_PQ (WT_XO + (size_t)DEPTH * DM * 256 * 2)
#define WT_END (WT_PQ + (size_t)DEPTH * DM * DM * 2)
#define WS_QN (WS_WP + SZ_WP)
#define SZ_QN ((size_t)MTOK * 256 * 4)
#define WS_KN (WS_QN + SZ_QN)
#define SZ_KN ((size_t)MTOK * 64 * 4)
#define WS_IKN (WS_KN + SZ_KN)
#define SZ_IKN ((size_t)MTOK * 32 * 4)
#define WS_YPRE (WS_IKN + SZ_IKN)
#define SZ_YPRE ((size_t)MTOK * 256 * 4)
#define WS_HM (WS_YPRE + SZ_YPRE)
#define SZ_HM ((size_t)MMEM * DM * 2)
#define WS_KM (WS_HM + SZ_HM)
#define SZ_KM ((size_t)MMEM * 256 * 4)
#define WS_VM (WS_KM + SZ_KM)
#define SZ_VM ((size_t)MMEM * 256 * 4)
#define WS_KB (WS_VM + SZ_VM)
#define SZ_KB ((size_t)MMEM * 256 * 2)
#define WS_VTB (WS_KB + SZ_KB)
#define SZ_VTB ((size_t)MMEM * 256 * 2)
#define WS_VT (WS_VTB + SZ_VTB)
#define SZ_VT ((size_t)MTOK * 64 * 2)
#define WS_SKB (WS_VT + SZ_VT)
#define SZ_SKB ((size_t)DEPTH * 8 * 2 * 128 * 64 * 2)
#define WS_SC (WS_SKB + SZ_SKB)
#define SZ_SC ((size_t)MTOK * 16 * 4)
#define WS_DUMMY (WS_SC + SZ_SC)
#define SZ_DUMMY (65536ull)
#define WS_END (WS_DUMMY + SZ_DUMMY)
#define WS_QX (WS_P)
#define WS_OX (WS_P + (size_t)MTOK * 256 * 4)
#define WS_QP (WS_P)
#define WS_UT16 (WS_P + 260ull * 1024 * 1024)
#define WS_VT16 (WS_UT16 + (size_t)NEXP * DM * 2)
#define WS_PEI (WS_VT16 + (size_t)NEXP * DM * 2)
#define WS_PEG (WS_PEI + (size_t)MTOK * 128 * 4)
#define WS_PEND (WS_PEG + (size_t)MTOK * 128 * 4)
static_assert(WS_PEND <= WS_P + SZ_P, "P region aliases");

struct Params {
    const float* in[34];
    float* out;
    char* ws;
};

#define XB_TMO      128
#define XB_XCNT(j)  (256  + 64 * (j))
#define XB_XSUB(j)  (1280 + 64 * (j))
#define XB_XGEN(j)  (2304 + 64 * (j))
#define XB_TOP      3328
#define XB_TOPGEN   3392
#define XCD_BAR_WORDS 3456
#define XB_SPIN_CAP (1u << 18)
#define LAS __attribute__((address_space(3)))

__device__ __forceinline__ unsigned xb_ld(unsigned* p)              { return __hip_atomic_load(p, __ATOMIC_RELAXED, __HIP_MEMORY_SCOPE_AGENT); }
__device__ __forceinline__ unsigned xb_add(unsigned* p, unsigned v) { return __hip_atomic_fetch_add(p, v, __ATOMIC_RELAXED, __HIP_MEMORY_SCOPE_AGENT); }
__device__ __forceinline__ unsigned xb_xcc_id() { return (unsigned)__builtin_amdgcn_s_getreg((3 << 11) | 20) & 0xFu; }
#define XB_SPIN(cond, bar) do { unsigned _sp = 0; while (cond) { __builtin_amdgcn_s_sleep(1); \
    if ((++_sp & 255u) == 0u) { if (xb_ld(&(bar)[XB_TMO])) break; if (_sp > XB_SPIN_CAP) { atomicAdd(&(bar)[XB_TMO], 1u); break; } } } } while (0)

struct XcdBarrier {
    unsigned* bar; unsigned x;
    volatile LAS unsigned* st;
};

__device__ __forceinline__ XcdBarrier xcd_barrier_post(unsigned* bar, volatile LAS unsigned* st) {
    XcdBarrier b; b.bar = bar; b.x = xb_xcc_id(); b.st = st;
    if (threadIdx.x == 0) (void)xb_add(&bar[XB_XCNT(b.x)], 1u);
    return b;
}
__device__ __forceinline__ void xcd_barrier_complete(unsigned* bar, unsigned x, unsigned& nloc, unsigned& nx) {
    const unsigned G = gridDim.x * gridDim.y * gridDim.z;
    unsigned sum, cnt, mine, sp = 0u;
    for (;;) {
        sum = 0u; cnt = 0u; mine = 0u;
#pragma unroll
        for (unsigned j = 0; j < 16; ++j) { const unsigned c = xb_ld(&bar[XB_XCNT(j)]); sum += c; cnt += (c > 0u) ? 1u : 0u; mine = (j == x) ? c : mine; }
        if (sum == G) break;
        __builtin_amdgcn_s_sleep(1);
        if ((++sp & 255u) == 0u) { if (xb_ld(&bar[XB_TMO])) break; if (sp > XB_SPIN_CAP) { atomicAdd(&bar[XB_TMO], 1u); break; } }
    }
    nloc = mine > 0u ? mine : 1u; nx = cnt > 0u ? cnt : 1u;
}

__device__ __forceinline__ void xcd_barrier(const XcdBarrier& b) {
    asm volatile("s_waitcnt vmcnt(0)" ::: "memory");
    __syncthreads();
    if (threadIdx.x == 0) {
        unsigned* bar = b.bar;
        __builtin_amdgcn_s_waitcnt(0);
        unsigned nloc = b.st[0], nx = b.st[1];
        if (nloc == 0u) { xcd_barrier_complete(bar, b.x, nloc, nx); b.st[0] = nloc; b.st[1] = nx; }
        const unsigned old = xb_add(&bar[XB_XSUB(b.x)], 1u);
        const unsigned gen = old / nloc;
        if (old + 1u == (gen + 1u) * nloc) {
            __builtin_amdgcn_fence(__ATOMIC_RELEASE, "agent");
            asm volatile("s_waitcnt vmcnt(0)" ::: "memory");
            const unsigned og = xb_add(&bar[XB_TOP], 1u);
            const unsigned tg = og / nx;
            if (og + 1u == (tg + 1u) * nx) xb_add(&bar[XB_TOPGEN], 1u);
            else XB_SPIN(xb_ld(&bar[XB_TOPGEN]) == tg, bar);
            __builtin_amdgcn_fence(__ATOMIC_ACQUIRE, "agent");
            xb_add(&bar[XB_XGEN(b.x)], 1u);
            asm volatile("s_waitcnt vmcnt(0)" ::: "memory");
        } else {
            XB_SPIN(xb_ld(&bar[XB_XGEN(b.x)]) == gen, bar);
            __builtin_amdgcn_fence(__ATOMIC_ACQUIRE, "agent");
            asm volatile("s_waitcnt vmcnt(0)" ::: "memory");
        }
    }
    __syncthreads();
}


#define LDS_BYTES (144 * 1024)
#define PTAB_OFF (LDS_BYTES - 1024)
extern __shared__ __attribute__((aligned(16))) float dynsmem[];
struct Ctx { const Params* kp; };
#define pin_(i) (p.kp->in[i])
#define pout_() (p.kp->out)
#define pws_() (p.kp->ws)

__device__ __forceinline__ float bf2f(bf16_t v) { return __uint_as_float(((unsigned)v) << 16); }
__device__ __forceinline__ bf16_t f2bf(float f) { unsigned u = __float_as_uint(f); u += 0x7FFFu + ((u >> 16) & 1u); return (bf16_t)(u >> 16); }
__device__ __forceinline__ unsigned pk_bf16(float lo, float hi) { return (unsigned)f2bf(lo) | ((unsigned)f2bf(hi) << 16); }
__device__ __forceinline__ float wave_sum(float v) {
#pragma unroll
    for (int o = 32; o >= 1; o >>= 1) v += __shfl_xor(v, o, 64);
    return v;
}
__device__ __forceinline__ float wave_max(float v) {
#pragma unroll
    for (int o = 32; o >= 1; o >>= 1) v = fmaxf(v, __shfl_xor(v, o, 64));
    return v;
}
__device__ __forceinline__ float silu_f(float x) { return x / (1.f + __expf(-x)); }
__device__ __forceinline__ float sigmoid_f(float x) { return 1.f / (1.f + __expf(-x)); }
__device__ __forceinline__ float softplus_f(float x) { return x > 20.f ? x : log1pf(__expf(x)); }
__device__ __forceinline__ float logsigmoid_f(float x) { return -softplus_f(-x); }
__device__ __forceinline__ float gelu_tanh_f(float x) { const float u = 0.7978845608028654f * (x + 0.044715f * x * x * x); return 0.5f * x * (1.f + tanhf(u)); }
__device__ __forceinline__ unsigned ford(float f) { f = f + 0.0f; unsigned u = __float_as_uint(f); return (u & 0x80000000u) ? ~u : (u | 0x80000000u); }
__device__ __forceinline__ float funord(unsigned k) { unsigned u = (k & 0x80000000u) ? (k & 0x7fffffffu) : ~k; return __uint_as_float(u); }
__device__ __forceinline__ unsigned long long wave_max_u64(unsigned long long v) {
#pragma unroll
    for (int o = 32; o >= 1; o >>= 1) {
        unsigned lo = __shfl_xor((unsigned)v, o, 64), hi = __shfl_xor((unsigned)(v >> 32), o, 64);
        unsigned long long w = ((unsigned long long)hi << 32) | lo;
        v = w > v ? w : v;
    }
    return v;
}
__device__ __forceinline__ int tid_() { int t = threadIdx.x; asm volatile("" : "+v"(t)); return t; }
__device__ __forceinline__ int bid_() { int b = blockIdx.x; asm volatile("" : "+s"(b)); return b; }
__device__ __forceinline__ int nblk_() { int g = gridDim.x; asm volatile("" : "+s"(g)); return g; }
__device__ __forceinline__ int gwave() { return (bid_() * 512 + tid_()) >> 6; }
__device__ __forceinline__ int nwaves() { return nblk_() * 8; }

namespace pg8 {
#define PG8_LAS __attribute__((address_space(3)))
typedef unsigned short bf16_t;
typedef short bf16x8 __attribute__((ext_vector_type(8)));
typedef float f32x4 __attribute__((ext_vector_type(4)));
typedef unsigned u32x4 __attribute__((ext_vector_type(4)));
constexpr int BM = 256, BK = 64, HALF = 128, HTB = HALF * BK * 2  , STAGE_BYTES = 8 * HTB, NXCD = 8, WGM = 8;

__host__ __device__ __forceinline__ int lds_byte(int r, int c) { const int st = (r >> 4) * 2 + (c >> 5), rr = r & 15, cc = c & 31, ob = rr * 64 + cc * 2; return st * 1024 + (ob ^ (((ob >> 9) & 1) << 5)); }
__host__ __device__ __forceinline__ void stage_rc(int b, int& R, int& C) { const int st = b / 1024, sb = b % 1024, swz = sb ^ (((sb >> 9) & 1) << 5); R = (st >> 1) * 16 + swz / 64; C = (st & 1) * 32 + (swz % 64) / 2; }
__host__ __device__ __forceinline__ int perm32(int rho) { const int n = rho >> 4, i = rho & 15; return 8 * (i >> 2) + 4 * n + (i & 3); }

struct Unit { int pm, pn; };
struct Gemm { const bf16_t* A; const bf16_t* Bt; int M, N, K; };

struct StaticOrder {
    int nM, nN, nwg, G, c;
    __host__ __device__ void init(int M, int N, int G_, int c_) { nM = M / BM; nN = N / BM; nwg = nM * nN; G = G_; c = c_; }
    __host__ __device__ bool next(int i, Unit& u) const {
        const long L = (long)i * G + c; if (L >= nwg) return false;
        int wgid = (int)L; { const int q = nwg / NXCD, r = nwg % NXCD, xcd = wgid % NXCD, off = wgid / NXCD; wgid = (xcd < r ? xcd * (q + 1) : r * (q + 1) + (xcd - r) * q) + off; }
        const int nig = WGM * nN, gid = wgid / nig, fm = gid * WGM, gsz = (nM - fm) < WGM ? (nM - fm) : WGM;
        u.pm = fm + ((wgid % nig) % gsz); u.pn = (wgid % nig) / gsz; return true;
    }
    __device__ __forceinline__ void a_ready(const Unit&) const {}
    __device__ __forceinline__ void done(const Unit&) const {}
};

__device__ __forceinline__ unsigned cvt_pk_bf16(float lo, float hi) { unsigned r; asm volatile("v_cvt_pk_bf16_f32 %0, %1, %2" : "=v"(r) : "v"(lo), "v"(hi)); return r; }
struct EpiF32 {
    static constexpr bool PERM = false, AFTER_DRAIN = false;
    float* C; const float* R; int ldc;
    __device__ __forceinline__ void operator()(const f32x4 (&acc)[2][2][4][2], const Unit& u, int wr, int wc, int fr, int fq) const {
        const int row0 = u.pm * BM + wr * 64 + fr, col0 = u.pn * BM + wc * 32 + 4 * fq;
#pragma unroll
        for (int ai = 0; ai < 2; ++ai)
#pragma unroll
            for (int m = 0; m < 4; ++m) { const size_t off = (size_t)(row0 + ai * HALF + m * 16) * ldc + col0;
#pragma unroll
                for (int bj = 0; bj < 2; ++bj)
#pragma unroll
                    for (int n = 0; n < 2; ++n) { f32x4 v = acc[ai][bj][m][n]; if (R) v += *(const f32x4*)(R + off + bj * HALF + n * 16); *(f32x4*)(C + off + bj * HALF + n * 16) = v; } }
    }
};
struct EpiBf16 {
    static constexpr bool PERM = true, AFTER_DRAIN = false;
    bf16_t* O; int ldc;
    __device__ __forceinline__ void operator()(const f32x4 (&acc)[2][2][4][2], const Unit& u, int wr, int wc, int fr, int fq) const {
        const int row0 = u.pm * BM + wr * 64 + fr, col0 = u.pn * BM + wc * 32 + 8 * fq;
#pragma unroll
        for (int ai = 0; ai < 2; ++ai)
#pragma unroll
            for (int m = 0; m < 4; ++m) { bf16_t* rowp = O + (size_t)(row0 + ai * HALF + m * 16) * ldc + col0;
#pragma unroll
                for (int bj = 0; bj < 2; ++bj) { const f32x4 v0 = acc[ai][bj][m][0], v1 = acc[ai][bj][m][1];
                    u32x4 w; w.x = cvt_pk_bf16(v0[0], v0[1]); w.y = cvt_pk_bf16(v0[2], v0[3]); w.z = cvt_pk_bf16(v1[0], v1[1]); w.w = cvt_pk_bf16(v1[2], v1[3]);
                    *(u32x4*)(rowp + bj * HALF) = w; } }
    }
};

template <class Epi, class Sched, bool STAMP = false>
__device__ __forceinline__ void gemm_phase(PG8_LAS unsigned char* lds, const Gemm g, const Sched& S, const Epi& E, unsigned long long* stamps, const int tid) {
    const int wid = __builtin_amdgcn_readfirstlane(tid >> 6), lane = tid & 63, wr = wid >> 2, wc = wid & 3, fr = lane & 15, fq = lane >> 4;
    const int K = g.K, nt = K / BK;
    int ts_lo = 0, ts_hi = 0, nts = 0; const unsigned long long rt_entry = STAMP ? (unsigned long long)wall_clock64() : 0ull;
#define PG8_STAMP() do { if (STAMP && wid == 0 && nts < 64) { const unsigned long long _c = (unsigned long long)clock64(); \
        ts_lo = (lane == nts) ? (int)(unsigned)_c : ts_lo; ts_hi = (lane == nts) ? (int)(unsigned)(_c >> 32) : ts_hi; ++nts; } } while (0)
    PG8_STAMP();
    unsigned voffA[2], voffB[2];
#pragma unroll
    for (int i = 0; i < 2; ++i) { int R, C; stage_rc(tid * 16 + i * 8192, R, C); const int Rb = Epi::PERM ? ((R & ~31) + perm32(R & 31)) : R;
        voffA[i] = (unsigned)(R * K + C) * 2u; voffB[i] = (unsigned)(Rb * K + C) * 2u; }
    const size_t kstep = (size_t)(BK * 2);
    const size_t hstep = (size_t)HALF * K * 2;
    const size_t tstep = 2 * hstep;
    const unsigned ldsw = (unsigned)wid * 1024u;
    const int aoff = lds_byte(wr * 64 + fr, fq * 8), boff = lds_byte(wc * 32 + fr, fq * 8);
#define PG8_SA(b, h) (((b) * 2 + (h)) * HTB)
#define PG8_SB(b, h) ((4 + (b) * 2 + (h)) * HTB)
#define PG8_STAGE(bufoff, gbase, voff) do { _Pragma("unroll") for (int _i = 0; _i < 2; ++_i) \
        __builtin_amdgcn_global_load_lds((const unsigned*)((const char*)(gbase) + (voff)[_i]), (PG8_LAS unsigned*)(lds + (bufoff) + ldsw + _i * 8192), 16, 0, 0); } while (0)
#define PG8_LDA(dst, b, h) do { _Pragma("unroll") for (int m = 0; m < 4; ++m) _Pragma("unroll") for (int k = 0; k < 2; ++k) dst[m][k] = *(const PG8_LAS bf16x8*)(lds + PG8_SA(b, h) + aoff + m * 2048 + k * 1024); } while (0)
#define PG8_LDB(dst, b, h) do { _Pragma("unroll") for (int n = 0; n < 2; ++n) _Pragma("unroll") for (int k = 0; k < 2; ++k) dst[n][k] = *(const PG8_LAS bf16x8*)(lds + PG8_SB(b, h) + boff + n * 2048 + k * 1024); } while (0)
#define PG8_MMA(ai, bj, At, Bt) do { __builtin_amdgcn_s_setprio(1); _Pragma("unroll") for (int m = 0; m < 4; ++m) _Pragma("unroll") for (int n = 0; n < 2; ++n) _Pragma("unroll") for (int k = 0; k < 2; ++k) \
        acc[ai][bj][m][n] = __builtin_amdgcn_mfma_f32_16x16x32_bf16(Bt[n][k], At[m][k], acc[ai][bj][m][n], 0, 0, 0); __builtin_amdgcn_s_setprio(0); } while (0)
#define PG8_WAIT_V(n) asm volatile("s_waitcnt vmcnt(" #n ")" ::: "memory")
#define PG8_WAIT_L(n) asm volatile("s_waitcnt lgkmcnt(" #n ")" ::: "memory")
#define PG8_BAR __builtin_amdgcn_s_barrier()
#define PG8_SCHED __builtin_amdgcn_sched_barrier(0)
    Unit cur, nxt; int ui = 0;
    if (!S.next(0, cur)) return;
    f32x4 acc[2][2][4][2];
#pragma unroll
    for (int a = 0; a < 2; ++a)
#pragma unroll
        for (int b = 0; b < 2; ++b)
#pragma unroll
            for (int m = 0; m < 4; ++m)
#pragma unroll
                for (int n = 0; n < 2; ++n) acc[a][b][m][n] = (f32x4){0.f, 0.f, 0.f, 0.f};
    bf16x8 At[4][2], B0[2][2], B1[2][2];
    const char* cA = (const char*)g.A + (size_t)cur.pm * tstep; const char* cB = (const char*)g.Bt + (size_t)cur.pn * tstep;
    S.a_ready(cur);
    PG8_STAGE(PG8_SB(0, 0), cB, voffB); PG8_STAGE(PG8_SA(0, 0), cA, voffA); PG8_STAGE(PG8_SB(0, 1), cB + hstep, voffB); PG8_STAGE(PG8_SA(0, 1), cA + hstep, voffA);
    if (wr == 1) PG8_BAR;
    PG8_WAIT_V(4); PG8_BAR;
    PG8_STAGE(PG8_SB(1, 0), cB + kstep, voffB); PG8_STAGE(PG8_SA(1, 0), cA + kstep, voffA); PG8_STAGE(PG8_SB(1, 1), cB + hstep + kstep, voffB);
    PG8_WAIT_V(6); PG8_BAR;
    PG8_STAMP();
    for (;;) {
        const bool has_next = S.next(ui + 1, nxt);
        const char* nA = has_next ? (const char*)g.A + (size_t)nxt.pm * tstep : cA; const char* nB = has_next ? (const char*)g.Bt + (size_t)nxt.pn * tstep : cB;
        for (int t = 0; t < nt; t += 2) {
            const bool last = (t == nt - 2);
            const char* a1 = cA + (size_t)(t + 1) * kstep;
            const char* a2 = last ? nA : cA + (size_t)(t + 2) * kstep; const char* b2 = last ? nB : cB + (size_t)(t + 2) * kstep;
            const char* a3 = a2 + kstep; const char* b3 = b2 + kstep;
            if (last && has_next) S.a_ready(nxt);
            PG8_LDB(B0, 0, 0); PG8_SCHED; PG8_LDA(At, 0, 0); PG8_STAGE(PG8_SA(1, 1), a1 + hstep, voffA);
            PG8_WAIT_L(8); PG8_BAR; PG8_WAIT_L(0); PG8_MMA(0, 0, At, B0); PG8_BAR; PG8_SCHED;
            PG8_LDB(B1, 0, 1); PG8_STAGE(PG8_SB(0, 0), b2, voffB);
            PG8_BAR; PG8_WAIT_L(0); PG8_MMA(0, 1, At, B1); PG8_BAR;
            PG8_LDA(At, 0, 1); PG8_STAGE(PG8_SA(0, 0), a2, voffA);
            PG8_BAR; PG8_WAIT_L(0); PG8_MMA(1, 0, At, B0); PG8_BAR; PG8_SCHED;
            PG8_STAGE(PG8_SB(0, 1), b2 + hstep, voffB);
            PG8_WAIT_V(6); PG8_BAR; PG8_MMA(1, 1, At, B1); PG8_BAR;
            PG8_LDB(B0, 1, 0); PG8_SCHED; PG8_LDA(At, 1, 0); PG8_STAGE(PG8_SA(0, 1), a2 + hstep, voffA);
            PG8_WAIT_L(8); PG8_BAR; PG8_WAIT_L(0); PG8_MMA(0, 0, At, B0); PG8_BAR; PG8_SCHED;
            PG8_LDB(B1, 1, 1); PG8_STAGE(PG8_SB(1, 0), b3, voffB);
            PG8_BAR; PG8_WAIT_L(0); PG8_MMA(0, 1, At, B1); PG8_BAR;
            PG8_LDA(At, 1, 1); PG8_STAGE(PG8_SA(1, 0), a3, voffA);
            PG8_BAR; PG8_WAIT_L(0); PG8_MMA(1, 0, At, B0); PG8_BAR; PG8_SCHED;
            PG8_STAGE(PG8_SB(1, 1), b3 + hstep, voffB);
            PG8_WAIT_V(6); PG8_BAR; PG8_MMA(1, 1, At, B1); PG8_BAR;
        }
        PG8_STAMP();
        if constexpr (!Epi::AFTER_DRAIN) { E(acc, cur, wr, wc, fr, fq); S.done(cur); }
        PG8_STAMP();
        if (!has_next) break;
#pragma unroll
        for (int a = 0; a < 2; ++a)
#pragma unroll
            for (int b = 0; b < 2; ++b)
#pragma unroll
                for (int m = 0; m < 4; ++m)
#pragma unroll
                    for (int n = 0; n < 2; ++n) acc[a][b][m][n] = (f32x4){0.f, 0.f, 0.f, 0.f};
        cur = nxt; cA = nA; cB = nB; ++ui;
    }
    PG8_WAIT_V(0);
    if (wr == 0) PG8_BAR;
    PG8_BAR;
    if constexpr (Epi::AFTER_DRAIN) { E.fused(acc, cur, wr, wc, fr, fq, lds, wid, lane); S.done(cur); }
    PG8_STAMP();
    if (STAMP && wid == 0) { stamps[lane] = lane < nts ? (((unsigned long long)(unsigned)ts_hi << 32) | (unsigned)ts_lo) : 0ull;
        if (lane == 62) stamps[62] = rt_entry; if (lane == 63) stamps[63] = (unsigned long long)wall_clock64(); }
#undef PG8_STAMP
#undef PG8_SA
#undef PG8_SB
#undef PG8_STAGE
#undef PG8_LDA
#undef PG8_LDB
#undef PG8_MMA
#undef PG8_WAIT_V
#undef PG8_WAIT_L
#undef PG8_BAR
#undef PG8_SCHED
}
}

template <class Epi> __device__ __forceinline__ void ph_gemm(const bf16_t* A, const bf16_t* Bt, int M, int N, int K, const Epi& E) {
    pg8::Gemm g; g.A = A; g.Bt = Bt; g.M = M; g.N = N; g.K = K;
    pg8::StaticOrder S; S.init(M, N, nblk_(), bid_());
    pg8::gemm_phase<Epi, pg8::StaticOrder, false>((PG8_LAS unsigned char*)dynsmem, g, S, E, nullptr, tid_());
}

__device__ __forceinline__ int pcol_to_orig(int c) {
    if (c < 768) return c;
    if (c < 1536) return c - 768 + 772;
    if (c < 1792) return c - 1536 + 1548;
    if (c < 1920) return c - 1792 + 1804;
    if (c < 2048) return c - 1920 + 1932;
    if (c < 2304) return c - 2048 + 2060;
    if (c < 2560) return c - 2304 + 2332;
    if (c < 2816) return c - 2560 + 2588;
    if (c < 2880) return c - 2816 + 2844;
    if (c < 2944) return c - 2880 + 2908;
    if (c < 3200) return c - 2944 + 2972;
    if (c < 3232) return c - 3200 + 3228;
    if (c < 3248) return c - 3232 + 2316;
    if (c < 3256) return c - 3248 + 3260;
    if (c < 3260) return c - 3256 + 768;
    if (c < 3264) return c - 3260 + 1540;
    if (c < 3268) return c - 3264 + 1544;
    return -1;
}
__device__ __forceinline__ void wtrans_job(const float* W, int K, int ldw, bf16_t* Wt, int Npad, bool mapped, float* tile) {
    const int tid = tid_();
    const int tn = Npad / 64, tk = K / 64;
    for (int t = bid_(); t < tn * tk; t += nblk_()) {
        const int n0 = (t / tk) * 64, k0 = (t % tk) * 64;
        __syncthreads();
        for (int idx = tid; idx < 4096; idx += 512) {
            const int kk = idx >> 6, nn = idx & 63;
            const int col = mapped ? pcol_to_orig(n0 + nn) : (n0 + nn);
            tile[kk * 65 + nn] = col >= 0 ? W[(size_t)(k0 + kk) * ldw + col] : 0.f;
        }
        __syncthreads();
        for (int idx = tid; idx < 4096; idx += 512) {
            const int nn = idx >> 6, kk = idx & 63;
            Wt[(size_t)(n0 + nn) * K + k0 + kk] = f2bf(tile[kk * 65 + nn]);
        }
    }
}
__device__ __forceinline__ void ph_weight_prep(const Ctx& p, float* sm) {
#pragma unroll 1
    for (int j = 0; j < 7 * DEPTH; ++j) {
        const int l = j / 7, w = j % 7;
        const float* W; int K, ldw, Npad; bf16_t* Wt; bool mapped = false;
        if (w == 0) { W = pin_(3) + (size_t)l * DM * 3268; K = DM; ldw = 3268; Npad = LDP; Wt = (bf16_t*)(pws_() + WT_IN) + (size_t)l * LDP * DM; mapped = true; }
        else if (w == 1) { W = pin_(20) + (size_t)l * DM * DM; K = DM; ldw = DM; Npad = DM; Wt = (bf16_t*)(pws_() + WT_OUT) + (size_t)l * DM * DM; }
        else if (w == 2) { W = pin_(23) + (size_t)l * DM * 256; K = DM; ldw = 256; Npad = 256; Wt = (bf16_t*)(pws_() + WT_XQ) + (size_t)l * 256 * DM; }
        else if (w == 3) { W = pin_(24) + (size_t)l * DM * 256; K = DM; ldw = 256; Npad = 256; Wt = (bf16_t*)(pws_() + WT_XK) + (size_t)l * 256 * DM; }
        else if (w == 4) { W = pin_(25) + (size_t)l * DM * 256; K = DM; ldw = 256; Npad = 256; Wt = (bf16_t*)(pws_() + WT_XV) + (size_t)l * 256 * DM; }
        else if (w == 5) { W = pin_(26) + (size_t)l * 256 * DM; K = 256; ldw = DM; Npad = DM; Wt = (bf16_t*)(pws_() + WT_XO) + (size_t)l * DM * 256; }
        else { W = pin_(30) + (size_t)l * DM * DM; K = DM; ldw = DM; Npad = DM; Wt = (bf16_t*)(pws_() + WT_PQ) + (size_t)l * DM * DM; }
        wtrans_job(W, K, ldw, Wt, Npad, mapped, sm);
    }
}

__device__ __forceinline__ void ph_rmsnorm(const float* __restrict__ x, const float* __restrict__ g, bf16_t* __restrict__ out, int rows) {
    const int lane = tid_() & 63;
    for (int r = gwave(); r < rows; r += nwaves()) {
        const float4* xr = (const float4*)(x + (size_t)r * DM);
        float4 v[4]; float ss = 0.f;
#pragma unroll
        for (int i = 0; i < 4; ++i) { v[i] = xr[lane + 64 * i]; ss += v[i].x * v[i].x + v[i].y * v[i].y + v[i].z * v[i].z + v[i].w * v[i].w; }
        ss = wave_sum(ss);
        const float rs = rsqrtf(ss * (1.f / DM) + EPS);
#pragma unroll
        for (int i = 0; i < 4; ++i) {
            const float4 gg = ((const float4*)g)[lane + 64 * i];
            ushort4 o; o.x = f2bf(v[i].x * rs * gg.x); o.y = f2bf(v[i].y * rs * gg.y); o.z = f2bf(v[i].z * rs * gg.z); o.w = f2bf(v[i].w * rs * gg.w);
            *(ushort4*)(out + (size_t)r * DM + (size_t)(lane + 64 * i) * 4) = o;
        }
    }
}

template <int OUTMODE>
__device__ __forceinline__ void ph_sgemm(const bf16_t* __restrict__ A, int lda, const float* __restrict__ B, int ldb, void* Cv, int ldc, const float* R, int ldr,
                         int M, int N, int K, float* smem) {
    float* As = smem;
    float* Bs = smem + 16 * 132;
    const int tid = tid_(), tx = tid & 31, ty = tid >> 5;
    const int ntn = N / 128, ntiles = (M / 128) * ntn;
    for (int tile = bid_(); tile < ntiles; tile += nblk_()) {
        const int tm = tile / ntn, tn = tile % ntn;
        float acc[8][4];
#pragma unroll
        for (int i = 0; i < 8; ++i)
#pragma unroll
            for (int j = 0; j < 4; ++j) acc[i][j] = 0.f;
        const int arow = tid >> 2, akq = (tid & 3) * 4;
        const int bk = tid >> 5, bn = (tid & 31) * 4;
        for (int k0 = 0; k0 < K; k0 += 16) {
            const ushort4 av = *(const ushort4*)(A + (size_t)(tm * 128 + arow) * lda + k0 + akq);
            const float4 bv = *(const float4*)(B + (size_t)(k0 + bk) * ldb + tn * 128 + bn);
            __syncthreads();
            As[(akq + 0) * 132 + arow] = bf2f(av.x); As[(akq + 1) * 132 + arow] = bf2f(av.y);
            As[(akq + 2) * 132 + arow] = bf2f(av.z); As[(akq + 3) * 132 + arow] = bf2f(av.w);
            *(float4*)(Bs + bk * 132 + bn) = bv;
            __syncthreads();
#pragma unroll
            for (int k = 0; k < 16; ++k) {
                const float4 a0 = *(const float4*)(As + k * 132 + ty * 8), a1 = *(const float4*)(As + k * 132 + ty * 8 + 4);
                const float4 b = *(const float4*)(Bs + k * 132 + tx * 4);
                const float a[8] = {a0.x, a0.y, a0.z, a0.w, a1.x, a1.y, a1.z, a1.w};
#pragma unroll
                for (int i = 0; i < 8; ++i) { acc[i][0] += a[i] * b.x; acc[i][1] += a[i] * b.y; acc[i][2] += a[i] * b.z; acc[i][3] += a[i] * b.w; }
            }
        }
#pragma unroll
        for (int i = 0; i < 8; ++i) {
            const size_t row = (size_t)tm * 128 + ty * 8 + i; const int col = tn * 128 + tx * 4;
            if (OUTMODE == 0) {
                ushort4 o; o.x = f2bf(acc[i][0]); o.y = f2bf(acc[i][1]); o.z = f2bf(acc[i][2]); o.w = f2bf(acc[i][3]);
                *(ushort4*)((bf16_t*)Cv + row * ldc + col) = o;
            } else if (OUTMODE == 1) {
                *(float4*)((float*)Cv + row * ldc + col) = make_float4(acc[i][0], acc[i][1], acc[i][2], acc[i][3]);
            } else {
                const float4 r = *(const float4*)(R + row * ldr + col);
                *(float4*)((float*)Cv + row * ldc + col) = make_float4(r.x + acc[i][0], r.y + acc[i][1], r.z + acc[i][2], r.w + acc[i][3]);
            }
        }
    }
}

#define WS_HS WS_H
#define WS_VG WS_YPRE
#define WS_DEC (WS_YPRE + (size_t)MTOK * 256 * 2)

__device__ __forceinline__ float quad_sum(float v) {
    v += __int_as_float(__builtin_amdgcn_mov_dpp(__float_as_int(v), 0xB1, 0xF, 0xF, true));
    v += __int_as_float(__builtin_amdgcn_mov_dpp(__float_as_int(v), 0x4E, 0xF, 0xF, true));
    return v;
}
__device__ __forceinline__ float bflo(unsigned w) { return __uint_as_float(w << 16); }
__device__ __forceinline__ float bfhi(unsigned w) { return __uint_as_float(w & 0xffff0000u); }

__device__ __forceinline__ float oct_sum(float v) {
    v += __int_as_float(__builtin_amdgcn_mov_dpp(__float_as_int(v), 0xB1, 0xF, 0xF, true));
    v += __int_as_float(__builtin_amdgcn_mov_dpp(__float_as_int(v), 0x4E, 0xF, 0xF, true));
    v += __int_as_float(__builtin_amdgcn_mov_dpp(__float_as_int(v), 0x141, 0xF, 0xF, true));
    return v;
}
__device__ __forceinline__ void unpack8(const uint4 r, float (&o)[8]) {
    o[0] = bflo(r.x); o[1] = bfhi(r.x); o[2] = bflo(r.y); o[3] = bfhi(r.y); o[4] = bflo(r.z); o[5] = bfhi(r.z); o[6] = bflo(r.w); o[7] = bfhi(r.w);
}
__device__ __forceinline__ uint4 pack8(const float (&v)[8]) {
    uint4 o; o.x = pk_bf16(v[0], v[1]); o.y = pk_bf16(v[2], v[3]); o.z = pk_bf16(v[4], v[5]); o.w = pk_bf16(v[6], v[7]); return o;
}
__device__ __forceinline__ void load8f(const float* p, float (&o)[8]) {
    const float4 a = *(const float4*)p, b = *(const float4*)(p + 4);
    o[0] = a.x; o[1] = a.y; o[2] = a.z; o[3] = a.w; o[4] = b.x; o[5] = b.y; o[6] = b.z; o[7] = b.w;
}
__device__ __forceinline__ void conv8(const bf16_t* P, size_t tok, int t, int pcol, const float* w, int ldw, int cc, float (&acc)[8]) {
#pragma unroll
    for (int j = 0; j < 4; ++j) {
        if (t - 3 + j >= 0) {
            float xv[8], wv[8];
            unpack8(*(const uint4*)(P + (tok - (size_t)(3 - j)) * LDP + pcol), xv);
            load8f(w + j * ldw + cc, wv);
#pragma unroll
            for (int i = 0; i < 8; ++i) acc[i] = __builtin_fmaf(wv[i], xv[i], acc[i]);
        }
    }
}
__device__ __forceinline__ void conv8r(const uint4 (&xt)[4], int t, const float* w, int ldw, int cc, float (&acc)[8]) {
#pragma unroll
    for (int j = 0; j < 4; ++j) {
        float xv[8], wv[8];
        unpack8(xt[j], xv);
        load8f(w + j * ldw + cc, wv);
        const float m = (t - 3 + j >= 0) ? 1.f : 0.f;
#pragma unroll
        for (int i = 0; i < 8; ++i) acc[i] = __builtin_fmaf(wv[i] * m, xv[i], acc[i]);
    }
}
__device__ __forceinline__ void ph_scan_prep(const Ctx& p, int l) {
    const bf16_t* P = (const bf16_t*)(pws_() + WS_P);
    bf16_t* HS = (bf16_t*)(pws_() + WS_HS);
    bf16_t* VG = (bf16_t*)(pws_() + WS_VG);
    float* DEC = (float*)(pws_() + WS_DEC);
    float* SC = (float*)(pws_() + WS_SC);
    const float* scw = pin_(4) + (size_t)l * 4 * 512;
    const float* scb = pin_(5) + (size_t)l * 512;
    const float* gcw = pin_(10) + (size_t)l * 4 * 768;
    const float* wg = pin_(14) + (size_t)l * 16 * 128;
    const float* bg = pin_(15) + (size_t)l * 128;
    const int lane = tid_() & 63;
    const int hsc = lane & 3, wsc = (lane >> 2) & 3;
    const float k_dtb = pin_(6)[l * 4 + hsc], k_alog = __expf(pin_(7)[l * 4 + hsc]), k_galog = __expf(pin_(11)[l * 4 + hsc]), k_gdtb = pin_(12)[l * 4 + hsc];
    const int sccol = wsc < 2 ? PC_DT + hsc : (wsc == 2 ? PC_GA + hsc : PC_GB + hsc);
    for (int tok = gwave(); tok < MTOK; tok += nwaves()) {
        const int t = tok % SEQ;
        const size_t row = (size_t)tok * LDP;
        uint4 xa[4], xq[4], xv4[4];
#pragma unroll
        for (int j = 0; j < 4; ++j) {
            const size_t rj = (t - 3 + j >= 0) ? row - (size_t)(3 - j) * LDP : row;
            xa[j] = *(const uint4*)(P + rj + PC_XBC + 8 * lane);
            xq[j] = *(const uint4*)(P + rj + PC_GQKV + 8 * lane);
            xv4[j] = *(const uint4*)(P + rj + PC_GQKV + 512 + 8 * (lane & 31));
        }
        const uint4 gl0 = *(const uint4*)(P + row + PC_GLR), gl1 = *(const uint4*)(P + row + PC_GLR + 8);
        const float scraw = bf2f(P[row + sccol]);
        {
            float acc[8];
            load8f(scb + 8 * lane, acc);
            conv8r(xa, t, scw, 512, 8 * lane, acc);
#pragma unroll
            for (int i = 0; i < 8; ++i) acc[i] = silu_f(acc[i]);
            *(uint4*)(HS + (size_t)tok * 1024 + 8 * lane) = pack8(acc);
        }
        {
            float acc[8];
#pragma unroll
            for (int i = 0; i < 8; ++i) acc[i] = 0.f;
            conv8r(xq, t, gcw, 768, 8 * lane, acc);
            float ss = 0.f;
#pragma unroll
            for (int i = 0; i < 8; ++i) { acc[i] = silu_f(acc[i]); ss += acc[i] * acc[i]; }
            ss = oct_sum(ss);
            const float sc = rsqrtf(ss + EPS) * (lane < 32 ? 0.125f : 1.f);
#pragma unroll
            for (int i = 0; i < 8; ++i) acc[i] *= sc;
            *(uint4*)(HS + (size_t)tok * 1024 + 512 + 8 * lane) = pack8(acc);
        }
        {
            float acc[8];
#pragma unroll
            for (int i = 0; i < 8; ++i) acc[i] = 0.f;
            conv8r(xv4, t, gcw, 768, 512 + 8 * (lane & 31), acc);
#pragma unroll
            for (int i = 0; i < 8; ++i) acc[i] = silu_f(acc[i]);
            if (lane < 32) *(uint4*)(VG + (size_t)tok * 256 + 8 * lane) = pack8(acc);
        }
        {
            float v;
            if (wsc < 2) { const float dt = softplus_f(scraw + k_dtb); v = wsc == 0 ? dt : __expf(-dt * k_alog); }
            else if (wsc == 2) v = __expf(-k_galog * softplus_f(scraw + k_gdtb));
            else v = sigmoid_f(scraw);
            if (lane < 16) SC[(size_t)tok * 16 + lane] = v;
        }
        {
            float gl[16];
            { float a8[8], b8[8]; unpack8(gl0, a8); unpack8(gl1, b8);
#pragma unroll
              for (int i = 0; i < 8; ++i) { gl[i] = a8[i]; gl[8 + i] = b8[i]; } }
#pragma unroll
            for (int i = 0; i < 2; ++i) {
                const int c = lane + 64 * i;
                float acc = bg[c];
#pragma unroll
                for (int r = 0; r < 16; ++r) acc = __builtin_fmaf(gl[r], wg[r * 128 + c], acc);
                DEC[(size_t)tok * 128 + c] = __expf(logsigmoid_f(acc) * (1.f / 16.f));
            }
        }
    }
}

#define SCAN_LDS_WAVE 4608
typedef float f2_t __attribute__((ext_vector_type(2)));
__device__ __forceinline__ f2_t mk2(float a, float b) { f2_t r; r.x = a; r.y = b; return r; }
__device__ __forceinline__ void st8f(char* dst, const uint4 v) {
    *(float4*)dst = make_float4(bflo(v.x), bfhi(v.x), bflo(v.y), bfhi(v.y));
    *(float4*)(dst + 16) = make_float4(bflo(v.z), bfhi(v.z), bflo(v.w), bfhi(v.w));
}
__device__ __forceinline__ void ph_scans(const Ctx& p, int l, float* smem) {
    const bf16_t* P = (const bf16_t*)(pws_() + WS_P);
    const bf16_t* HS = (const bf16_t*)(pws_() + WS_HS);
    const bf16_t* VG = (const bf16_t*)(pws_() + WS_VG);
    const float* DEC = (const float*)(pws_() + WS_DEC);
    const float* SC = (const float*)(pws_() + WS_SC);
    bf16_t* Y = (bf16_t*)(pws_() + WS_Y);
    const int tid = tid_(), lane = tid & 63, wave = tid >> 6;
    if (nblk_() != 256) return;
    const int role = wave < 2 ? 0 : (wave < 6 ? 1 : 2);
    const int idx = (role == 0 ? wave : (role == 1 ? wave - 2 : wave - 6)) * 256 + bid_();
    const int bh = role == 1 ? (idx >> 3) : (idx >> 2), b = bh >> 2, h = bh & 3;
    const int colbase = role == 1 ? (idx & 7) * 8 : (idx & 3) * 16;
    const int cl = role == 1 ? (lane >> 3) : (lane >> 2);
    const int col = colbase + cl;
    const int sq = role == 1 ? (lane & 7) : (lane & 3);
    const size_t tb = (size_t)b * SEQ;
    bf16_t* dummy = (bf16_t*)(pws_() + WS_DUMMY) + (tid & 511) * 8;
    char* lw = (char*)smem + wave * SCAN_LDS_WAVE;
    char* lrow = lw;
    char* lcol = lw + 4096;
    float* lsc = (float*)(lw + 4352);
    const int fs = lane >> 3, fp = lane & 7;
    if (role == 0) {
        const int g = h >> 1;
        const float Dh = pin_(8)[l * 4 + h];
        uint4 f0, f1; unsigned fc = 0u; float fsc = 0.f;
        f2_t st[8];
#pragma unroll
        for (int i = 0; i < 8; ++i) st[i] = mk2(0.f, 0.f);
        auto fetch = [&](int t0) {
            const size_t tok = tb + t0 + fs;
            const bf16_t* src = HS + tok * 1024 + (fp < 4 ? 256 + g * 64 + fp * 16 : 384 + g * 64 + (fp - 4) * 16);
            f0 = *(const uint4*)src; f1 = *(const uint4*)(src + 8);
            fc = *(const unsigned*)(HS + tok * 1024 + h * 64 + colbase + fp * 2);
            if (lane < 16) fsc = SC[(tb + t0 + (lane >> 1)) * 16 + (lane & 1) * 4 + h];
        };
        fetch(0);
        for (int t0 = 0; t0 < SEQ; t0 += 8) {
            st8f(lrow + fs * 512 + fp * 64, f0); st8f(lrow + fs * 512 + fp * 64 + 32, f1);
            *(unsigned*)(lcol + fs * 32 + fp * 4) = fc;
            if (lane < 16) lsc[lane] = fsc;
            if (t0 + 8 < SEQ) fetch(t0 + 8);
#pragma unroll
            for (int i = 0; i < 8; ++i) {
                const char* rb = lrow + i * 512 + sq * 64;
                const float4 b0 = *(const float4*)rb, b1 = *(const float4*)(rb + 16), b2 = *(const float4*)(rb + 32), b3 = *(const float4*)(rb + 48);
                const float4 c0 = *(const float4*)(rb + 256), c1 = *(const float4*)(rb + 272), c2 = *(const float4*)(rb + 288), c3 = *(const float4*)(rb + 304);
                const float xv = bf2f(*(const bf16_t*)(lcol + i * 32 + cl * 2));
                const float2 sc2 = *(const float2*)(lsc + i * 2);
                const float xdt = xv * sc2.x;
                const f2_t xd2 = mk2(xdt, xdt), dA2 = mk2(sc2.y, sc2.y);
                const f2_t bb[8] = {mk2(b0.x, b0.y), mk2(b0.z, b0.w), mk2(b1.x, b1.y), mk2(b1.z, b1.w), mk2(b2.x, b2.y), mk2(b2.z, b2.w), mk2(b3.x, b3.y), mk2(b3.z, b3.w)};
                const f2_t cc[8] = {mk2(c0.x, c0.y), mk2(c0.z, c0.w), mk2(c1.x, c1.y), mk2(c1.z, c1.w), mk2(c2.x, c2.y), mk2(c2.z, c2.w), mk2(c3.x, c3.y), mk2(c3.z, c3.w)};
                f2_t ya = mk2(0.f, 0.f), yb = mk2(0.f, 0.f);
#pragma unroll
                for (int q = 0; q < 8; q += 2) {
                    st[q] = st[q] * dA2 + xd2 * bb[q]; st[q + 1] = st[q + 1] * dA2 + xd2 * bb[q + 1];
                    ya = cc[q] * st[q] + ya; yb = cc[q + 1] * st[q + 1] + yb;
                }
                const f2_t ys = ya + yb;
                const float y = quad_sum(ys.x + ys.y);
                *(sq == 0 ? Y + (tb + t0 + i) * DM + h * 64 + col : dummy + i) = f2bf(y + Dh * xv);
                if (i & 1) __builtin_amdgcn_sched_barrier(0);
            }
        }
    } else if (role == 1) {
        uint4 f0, f1; unsigned fc = 0u; float fsc = 0.f;
        f2_t S[4];
#pragma unroll
        for (int i = 0; i < 4; ++i) S[i] = mk2(0.f, 0.f);
        auto fetch = [&](int t0) {
            const size_t tok = tb + t0 + fs;
            const bf16_t* src = HS + tok * 1024 + (fp < 4 ? 512 + h * 64 + fp * 16 : 768 + h * 64 + (fp - 4) * 16);
            f0 = *(const uint4*)src; f1 = *(const uint4*)(src + 8);
            if (fp < 4) fc = *(const unsigned*)(VG + tok * 256 + h * 64 + colbase + fp * 2);
            if (lane < 16) fsc = SC[(tb + t0 + (lane >> 1)) * 16 + 8 + (lane & 1) * 4 + h];
        };
        fetch(0);
        for (int t0 = 0; t0 < SEQ; t0 += 8) {
            st8f(lrow + fs * 512 + fp * 64, f0); st8f(lrow + fs * 512 + fp * 64 + 32, f1);
            if (fp < 4) *(unsigned*)(lcol + fs * 32 + fp * 4) = fc;
            if (lane < 16) lsc[lane] = fsc;
            if (t0 + 8 < SEQ) fetch(t0 + 8);
#pragma unroll
            for (int i = 0; i < 8; ++i) {
                const char* rb = lrow + i * 512 + sq * 32;
                const float4 q0 = *(const float4*)rb, q1 = *(const float4*)(rb + 16);
                const float4 k0 = *(const float4*)(rb + 256), k1 = *(const float4*)(rb + 272);
                const float vv = bf2f(*(const bf16_t*)(lcol + i * 32 + cl * 2));
                const float2 sc2 = *(const float2*)(lsc + i * 2);
                const f2_t al2 = mk2(sc2.x, sc2.x);
                const f2_t kk[4] = {mk2(k0.x, k0.y), mk2(k0.z, k0.w), mk2(k1.x, k1.y), mk2(k1.z, k1.w)};
                const f2_t qq[4] = {mk2(q0.x, q0.y), mk2(q0.z, q0.w), mk2(q1.x, q1.y), mk2(q1.z, q1.w)};
                f2_t ra = mk2(0.f, 0.f), rb2 = mk2(0.f, 0.f);
#pragma unroll
                for (int q = 0; q < 4; q += 2) {
                    S[q] = S[q] * al2; S[q + 1] = S[q + 1] * al2;
                    ra = S[q] * kk[q] + ra; rb2 = S[q + 1] * kk[q + 1] + rb2;
                }
                const f2_t rs = ra + rb2;
                const float r = oct_sum(rs.x + rs.y);
                const float vn = sc2.y * (vv - r);
                const f2_t vn2 = mk2(vn, vn);
                f2_t oa2 = mk2(0.f, 0.f), ob2 = mk2(0.f, 0.f);
#pragma unroll
                for (int q = 0; q < 4; q += 2) {
                    S[q] = kk[q] * vn2 + S[q]; S[q + 1] = kk[q + 1] * vn2 + S[q + 1];
                    oa2 = S[q] * qq[q] + oa2; ob2 = S[q + 1] * qq[q + 1] + ob2;
                }
                const f2_t os = oa2 + ob2;
                const float ov = oct_sum(os.x + os.y);
                *(sq == 0 ? Y + (tb + t0 + i) * DM + 256 + h * 64 + col : dummy + i) = f2bf(ov);
                if (i & 1) __builtin_amdgcn_sched_barrier(0);
            }
        }
    } else {
        uint4 f0, f1; unsigned fc = 0u;
        f2_t S[4];
#pragma unroll
        for (int i = 0; i < 4; ++i) S[i] = mk2(0.f, 0.f);
        auto fetch = [&](int t0) {
            const size_t tok = tb + t0 + fs;
            if (fp < 4) { const float* src = DEC + tok * 128 + h * 32 + fp * 8; f0 = *(const uint4*)src; f1 = *(const uint4*)(src + 4); }
            else { const bf16_t* src = P + tok * LDP + (fp < 6 ? PC_LK + h * 32 + (fp - 4) * 16 : PC_LQ + h * 32 + (fp - 6) * 16); f0 = *(const uint4*)src; f1 = *(const uint4*)(src + 8); }
            fc = *(const unsigned*)(P + tok * LDP + PC_LV + h * 64 + colbase + fp * 2);
        };
        fetch(0);
        for (int t0 = 0; t0 < SEQ; t0 += 8) {
            if (fp < 4) { *(uint4*)(lrow + fs * 512 + fp * 32) = f0; *(uint4*)(lrow + fs * 512 + fp * 32 + 16) = f1; }
            else { st8f(lrow + fs * 512 + 128 + (fp - 4) * 64, f0); st8f(lrow + fs * 512 + 128 + (fp - 4) * 64 + 32, f1); }
            *(unsigned*)(lcol + fs * 32 + fp * 4) = fc;
            if (t0 + 8 < SEQ) fetch(t0 + 8);
#pragma unroll
            for (int i = 0; i < 8; ++i) {
                const char* rb = lrow + i * 512 + sq * 32;
                const float4 d0 = *(const float4*)rb, d1 = *(const float4*)(rb + 16);
                const float4 k0 = *(const float4*)(rb + 128), k1 = *(const float4*)(rb + 144);
                const float4 q0 = *(const float4*)(rb + 256), q1 = *(const float4*)(rb + 272);
                const float vv = bf2f(*(const bf16_t*)(lcol + i * 32 + cl * 2));
                const f2_t v2 = mk2(vv, vv);
                const f2_t dd[4] = {mk2(d0.x, d0.y), mk2(d0.z, d0.w), mk2(d1.x, d1.y), mk2(d1.z, d1.w)};
                const f2_t kk[4] = {mk2(k0.x, k0.y), mk2(k0.z, k0.w), mk2(k1.x, k1.y), mk2(k1.z, k1.w)};
                const f2_t qq[4] = {mk2(q0.x, q0.y), mk2(q0.z, q0.w), mk2(q1.x, q1.y), mk2(q1.z, q1.w)};
                f2_t oa2 = mk2(0.f, 0.f), ob2 = mk2(0.f, 0.f);
#pragma unroll
                for (int q = 0; q < 4; q += 2) {
                    S[q] = dd[q] * S[q] + kk[q] * v2; S[q + 1] = dd[q + 1] * S[q + 1] + kk[q + 1] * v2;
                    oa2 = S[q] * qq[q] + oa2; ob2 = S[q + 1] * qq[q + 1] + ob2;
                }
                const f2_t os = oa2 + ob2;
                const float ov = quad_sum(os.x + os.y);
                *(sq == 0 ? Y + (tb + t0 + i) * DM + 512 + h * 64 + col : dummy + i) = f2bf(ov * 0.17677669529663687f);
                if (i & 1) __builtin_amdgcn_sched_barrier(0);
            }
        }
    }
}

__device__ __forceinline__ void ph_mixer_finish(const Ctx& p, int l) {
    const bf16_t* P = (const bf16_t*)(pws_() + WS_P);
    bf16_t* Y = (bf16_t*)(pws_() + WS_Y);
    const float* sn = pin_(9) + (size_t)l * 256;
    const float* gn = pin_(13) + (size_t)l * 64;
    const float* ln = pin_(16) + (size_t)l * 64;
    const int lane = tid_() & 63;
    for (int tok = gwave(); tok < MTOK; tok += nwaves()) {
        const size_t row = (size_t)tok * LDP;
        {
            float v[8], gt[8], gw[8];
            unpack8(*(const uint4*)(Y + (size_t)tok * DM + 8 * lane), v);
            unpack8(*(const uint4*)(P + row + (lane < 32 ? PC_Z + 8 * lane : PC_GG + 8 * (lane - 32))), gt);
            load8f(lane < 32 ? sn + 8 * lane : gn + 8 * (lane & 7), gw);
            float ss = 0.f;
            if (lane < 32) {
#pragma unroll
                for (int i = 0; i < 8; ++i) { v[i] *= silu_f(gt[i]); ss += v[i] * v[i]; }
            } else {
#pragma unroll
                for (int i = 0; i < 8; ++i) ss += v[i] * v[i];
            }
            const float s8 = oct_sum(ss);
            float s32 = s8 + __int_as_float(__builtin_amdgcn_mov_dpp(__float_as_int(s8), 0x140, 0xF, 0xF, true));
            s32 += __shfl_xor(s32, 16, 64);
            const float rs = lane < 32 ? rsqrtf(s32 * (1.f / 256.f) + EPS) : rsqrtf(s8 * (1.f / 64.f) + EPS);
            float o[8];
#pragma unroll
            for (int i = 0; i < 8; ++i) o[i] = lane < 32 ? v[i] * rs * gw[i] : v[i] * rs * gw[i] * silu_f(gt[i]);
            *(uint4*)(Y + (size_t)tok * DM + 8 * lane) = pack8(o);
        }
        if (lane < 32) {
            float v[8], gt[8], gw[8];
            unpack8(*(const uint4*)(Y + (size_t)tok * DM + 512 + 8 * lane), v);
            unpack8(*(const uint4*)(P + row + PC_LR + 8 * lane), gt);
            load8f(ln + 8 * (lane & 7), gw);
            float ss = 0.f;
#pragma unroll
            for (int i = 0; i < 8; ++i) ss += v[i] * v[i];
            const float rs = rsqrtf(oct_sum(ss) * (1.f / 64.f) + EPS);
            float o[8];
#pragma unroll
            for (int i = 0; i < 8; ++i) o[i] = v[i] * rs * gw[i] * silu_f(gt[i]);
            *(uint4*)(Y + (size_t)tok * DM + 512 + 8 * lane) = pack8(o);
        }
    }
}

typedef short bf16x8_t __attribute__((ext_vector_type(8)));
typedef float f32x4_t __attribute__((ext_vector_type(4)));
union BF8 { bf16x8_t v; uint4 u; unsigned w[4]; };


__device__ __forceinline__ void ph_dsa_prep(const Ctx& p, int l) {
    const bf16_t* P = (const bf16_t*)(pws_() + WS_P);
    bf16_t* qn = (bf16_t*)(pws_() + WS_QN);
    bf16_t* kn = (bf16_t*)(pws_() + WS_KN);
    bf16_t* ikn = (bf16_t*)(pws_() + WS_IKN);
    bf16_t* vt = (bf16_t*)(pws_() + WS_VT);
    const float* qg = pin_(17) + (size_t)l * 64;
    const float* kg = pin_(18) + (size_t)l * 64;
    const float* ig = pin_(19) + (size_t)l * 32;
    const int lane = tid_() & 63;
    const int pcol = lane < 40 ? PC_DQ + 8 * lane : PC_IK + 8 * (lane & 3);
    float gw[8];
    load8f(lane < 32 ? qg + 8 * (lane & 7) : (lane < 40 ? kg + 8 * (lane & 7) : ig + 8 * (lane & 3)), gw);
    for (int grp = gwave(); grp < MTOK / 8; grp += nwaves()) {
        const size_t tok0 = (size_t)grp * 8;
        const int b = (int)(tok0 / SEQ), t0 = (int)(tok0 % SEQ);
        unsigned short vv[8];
#pragma unroll
        for (int i = 0; i < 8; ++i) {
            const size_t row = (tok0 + i) * LDP;
            vv[i] = P[row + PC_DV + lane];
            if (lane < 44) {
                float v[8];
                unpack8(*(const uint4*)(P + row + pcol), v);
                float ss = 0.f;
#pragma unroll
                for (int q = 0; q < 8; ++q) ss += v[q] * v[q];
                const float s4 = ss + __int_as_float(__builtin_amdgcn_mov_dpp(__float_as_int(ss), 0xB1, 0xF, 0xF, true));
                const float s4b = s4 + __int_as_float(__builtin_amdgcn_mov_dpp(__float_as_int(s4), 0x4E, 0xF, 0xF, true));
                const float s8 = s4b + __int_as_float(__builtin_amdgcn_mov_dpp(__float_as_int(s4b), 0x141, 0xF, 0xF, true));
                const float rs = lane < 40 ? rsqrtf(s8 * (1.f / 64.f) + EPS) * (lane < 32 ? 0.125f : 1.f) : rsqrtf(s4b * (1.f / 32.f) + EPS);
                float o[8];
#pragma unroll
                for (int q = 0; q < 8; ++q) o[q] = v[q] * rs * gw[q];
                const uint4 pk = pack8(o);
                if (lane < 32) *(uint4*)(qn + (tok0 + i) * 256 + 8 * lane) = pk;
                else if (lane < 40) *(uint4*)(kn + (tok0 + i) * 64 + 8 * (lane - 32)) = pk;
                else *(uint4*)(ikn + (tok0 + i) * 32 + 8 * (lane - 40)) = pk;
            }
        }
        uint4 o; o.x = (unsigned)vv[0] | ((unsigned)vv[1] << 16); o.y = (unsigned)vv[2] | ((unsigned)vv[3] << 16);
        o.z = (unsigned)vv[4] | ((unsigned)vv[5] << 16); o.w = (unsigned)vv[6] | ((unsigned)vv[7] << 16);
        *(uint4*)(vt + ((size_t)b * 64 + lane) * SEQ + t0) = o;
    }
}

#define DSA_STRIDE 2052
__device__ __forceinline__ void ph_dsa_main(const Ctx& p, int l, float* smem) {
    const bf16_t* P = (const bf16_t*)(pws_() + WS_P);
    bf16_t* Y = (bf16_t*)(pws_() + WS_Y);
    const bf16_t* QN = (const bf16_t*)(pws_() + WS_QN);
    const bf16_t* KN = (const bf16_t*)(pws_() + WS_KN);
    const bf16_t* IKN = (const bf16_t*)(pws_() + WS_IKN);
    const bf16_t* VT = (const bf16_t*)(pws_() + WS_VT);
    unsigned* sc = (unsigned*)smem;
    float* part = smem;
    float* plsum = smem + 8 * 64 * 64;
    unsigned* thr = (unsigned*)(smem + 35000);
    const int tid = tid_(), lane = tid & 63, w = tid >> 6, qi = lane & 15, g = lane >> 4;
    for (int task = bid_(); task < MTOK / 16; task += nblk_()) {
        const int c = 31 - task / 128, b = (task >> 2) & 31, sub = task & 3;
        const int t0 = c * 64 + sub * 16, nk = (c + 1) * 64;
        const size_t tok0 = (size_t)b * SEQ + t0;
        const bool dosel = nk > 256;
        if (dosel) {
            BF8 iqf[8]; float wq[8];
#pragma unroll
            for (int h = 0; h < 8; ++h) {
                iqf[h].u = *(const uint4*)(P + (tok0 + qi) * LDP + PC_IQ + h * 32 + 8 * g);
                wq[h] = bf2f(P[(tok0 + qi) * LDP + PC_IW + h]) * 0.0625f;
            }
            for (int kt = w; kt < nk / 16; kt += 8) {
                const int s0 = kt * 16;
                BF8 ka; ka.u = *(const uint4*)(IKN + ((size_t)b * SEQ + s0 + qi) * 32 + 8 * g);
                float acc[4] = {0.f, 0.f, 0.f, 0.f};
#pragma unroll
                for (int h = 0; h < 8; ++h) {
                    const f32x4_t d = __builtin_amdgcn_mfma_f32_16x16x32_bf16(ka.v, iqf[h].v, (f32x4_t){0.f, 0.f, 0.f, 0.f}, 0, 0, 0);
#pragma unroll
                    for (int r = 0; r < 4; ++r) acc[r] = __builtin_fmaf(wq[h], fmaxf(d[r], 0.f), acc[r]);
                }
                uint4 kv; kv.x = ford(acc[0]); kv.y = ford(acc[1]); kv.z = ford(acc[2]); kv.w = ford(acc[3]);
                *(uint4*)(sc + qi * DSA_STRIDE + s0 + 4 * g) = kv;
            }
        }
        __syncthreads();
        if (dosel) {
            const int nj = nk >> 6;
#pragma unroll 1
            for (int qq = 0; qq < 2; ++qq) {
                const int q = 2 * w + qq;
                unsigned kreg[32];
#pragma unroll
                for (int j = 0; j < 32; ++j) kreg[j] = (j < nj) ? sc[q * DSA_STRIDE + j * 64 + lane] : 0u;
                unsigned T = 0u; bool exact = false;
                for (int bit = 31; bit >= 0; --bit) {
                    const unsigned cand = T | (1u << bit);
                    int cnt = 0;
#pragma unroll
                    for (int j = 0; j < 32; ++j) cnt += __popcll(__ballot(kreg[j] >= cand));
                    if (cnt >= 256) { T = cand; if (cnt == 256) { exact = true; break; } }
                }
                int cut = 0x7fffffff;
                if (!exact) {
                    int cgt = 0, ceq = 0;
#pragma unroll
                    for (int j = 0; j < 32; ++j) { cgt += __popcll(__ballot(kreg[j] > T)); ceq += __popcll(__ballot(kreg[j] == T)); }
                    int need = 256 - cgt;
                    if (ceq > need) {
                        bool found = false;
#pragma unroll
                        for (int j = 0; j < 32; ++j) {
                            const unsigned long long m = __ballot(kreg[j] == T);
                            const int cj = __popcll(m);
                            if (!found) {
                                if (need <= cj) { for (int bpos = 0; bpos < 64; ++bpos) if ((m >> bpos) & 1ull) { if (--need == 0) { cut = j * 64 + bpos; break; } } found = true; }
                                else need -= cj;
                            }
                        }
                    }
                }
                if (lane == 0) { thr[q] = T; thr[16 + q] = (unsigned)cut; }
            }
        }
        __syncthreads();
        unsigned Tq = 0u; int cutq = 0x7fffffff;
        if (dosel) { Tq = thr[qi]; cutq = (int)thr[16 + qi]; }
        f32x4_t oacc[4][4]; float lsum[4];
#pragma unroll
        for (int h = 0; h < 4; ++h) { lsum[h] = 0.f;
#pragma unroll
            for (int dt = 0; dt < 4; ++dt) oacc[h][dt] = (f32x4_t){0.f, 0.f, 0.f, 0.f}; }
        const int krow = 8 * (qi >> 2) + (qi & 3);
        for (int st = w; st < nk / 32; st += 8) {
            const int s0 = st * 32;
            BF8 ka[2][2], va[4];
#pragma unroll
            for (int t = 0; t < 2; ++t)
#pragma unroll
                for (int s2 = 0; s2 < 2; ++s2) ka[t][s2].u = *(const uint4*)(KN + ((size_t)b * SEQ + s0 + krow + 4 * t) * 64 + 32 * s2 + 8 * g);
#pragma unroll
            for (int dt = 0; dt < 4; ++dt) va[dt].u = *(const uint4*)(VT + ((size_t)b * 64 + 16 * dt + qi) * SEQ + s0 + 8 * g);
            float mk[8];
            if (dosel) {
                const uint4 k0 = *(const uint4*)(sc + qi * DSA_STRIDE + s0 + 8 * g), k1 = *(const uint4*)(sc + qi * DSA_STRIDE + s0 + 8 * g + 4);
                const unsigned kk[8] = {k0.x, k0.y, k0.z, k0.w, k1.x, k1.y, k1.z, k1.w};
#pragma unroll
                for (int j = 0; j < 8; ++j) mk[j] = (kk[j] > Tq || (kk[j] == Tq && (s0 + 8 * g + j) <= cutq)) ? 1.f : 0.f;
            } else {
#pragma unroll
                for (int j = 0; j < 8; ++j) mk[j] = 1.f;
            }
#pragma unroll
            for (int h = 0; h < 4; ++h) {
                BF8 q0, q1;
                q0.u = *(const uint4*)(QN + (tok0 + qi) * 256 + h * 64 + 8 * g);
                q1.u = *(const uint4*)(QN + (tok0 + qi) * 256 + h * 64 + 32 + 8 * g);
                f32x4_t sacc[2];
#pragma unroll
                for (int t = 0; t < 2; ++t) {
                    sacc[t] = __builtin_amdgcn_mfma_f32_16x16x32_bf16(ka[t][0].v, q0.v, (f32x4_t){0.f, 0.f, 0.f, 0.f}, 0, 0, 0);
                    sacc[t] = __builtin_amdgcn_mfma_f32_16x16x32_bf16(ka[t][1].v, q1.v, sacc[t], 0, 0, 0);
                }
                float pe[8];
#pragma unroll
                for (int t = 0; t < 2; ++t)
#pragma unroll
                    for (int r = 0; r < 4; ++r) { pe[4 * t + r] = __expf(sacc[t][r]) * mk[4 * t + r]; lsum[h] += pe[4 * t + r]; }
                BF8 pf;
#pragma unroll
                for (int j = 0; j < 4; ++j) pf.w[j] = pk_bf16(pe[2 * j], pe[2 * j + 1]);
#pragma unroll
                for (int dt = 0; dt < 4; ++dt) oacc[h][dt] = __builtin_amdgcn_mfma_f32_16x16x32_bf16(va[dt].v, pf.v, oacc[h][dt], 0, 0, 0);
            }
        }
        __syncthreads();
#pragma unroll
        for (int h = 0; h < 4; ++h) {
            plsum[(w * 4 + h) * 64 + lane] = lsum[h];
#pragma unroll
            for (int dt = 0; dt < 4; ++dt)
#pragma unroll
                for (int r = 0; r < 4; ++r) part[(w * 64 + h * 16 + dt * 4 + r) * 64 + lane] = oacc[h][dt][r];
        }
        __syncthreads();
        {
            const int h = w >> 1;
            float lq = 0.f;
#pragma unroll
            for (int w2 = 0; w2 < 8; ++w2)
#pragma unroll
                for (int g2 = 0; g2 < 4; ++g2) lq += plsum[(w2 * 4 + h) * 64 + qi + 16 * g2];
            const float inv = 1.f / lq;
#pragma unroll
            for (int dd = 0; dd < 2; ++dd) {
                const int dt = (w & 1) * 2 + dd;
                float o[4];
#pragma unroll
                for (int r = 0; r < 4; ++r) {
                    float sacc = 0.f;
#pragma unroll
                    for (int w2 = 0; w2 < 8; ++w2) sacc += part[(w2 * 64 + h * 16 + dt * 4 + r) * 64 + lane];
                    o[r] = sacc * inv;
                }
                uint2 ov; ov.x = pk_bf16(o[0], o[1]); ov.y = pk_bf16(o[2], o[3]);
                *(uint2*)(Y + (tok0 + qi) * DM + 768 + h * 64 + 16 * dt + 4 * g) = ov;
            }
        }
        __syncthreads();
    }
}

__device__ __forceinline__ void ph_mem_prep(const Ctx& p, int l) {
    const float* Km = (const float*)(pws_() + WS_KM);
    const float* Vm = (const float*)(pws_() + WS_VM);
    bf16_t* KB = (bf16_t*)(pws_() + WS_KB);
    bf16_t* VTB = (bf16_t*)(pws_() + WS_VTB);
    const float* kg = pin_(28) + (size_t)l * 64;
    const int lane = tid_() & 63;
    for (int r = gwave(); r < MMEM; r += nwaves()) {
        const int b = r / NMEM, j = r % NMEM;
#pragma unroll
        for (int h = 0; h < 4; ++h) {
            const float v = Km[(size_t)r * 256 + h * 64 + lane];
            const float ss = wave_sum(v * v);
            KB[(((size_t)b * 4 + h) * NMEM + j) * 64 + lane] = f2bf(v * rsqrtf(ss * (1.f / 64.f) + EPS) * kg[lane]);
            VTB[(((size_t)b * 4 + h) * 64 + lane) * NMEM + j] = f2bf(Vm[(size_t)r * 256 + h * 64 + lane]);
        }
    }
}
__device__ __forceinline__ void ph_xattn(const Ctx& p, int l) {
    const float* Qx = (const float*)(pws_() + WS_QX);
    bf16_t* Ox = (bf16_t*)(pws_() + WS_OX);
    const bf16_t* KB = (const bf16_t*)(pws_() + WS_KB);
    const bf16_t* VTB = (const bf16_t*)(pws_() + WS_VTB);
    const float* qg = pin_(27) + (size_t)l * 64;
    const int lane = tid_() & 63, qi = lane & 15, g = lane >> 4;
    for (int task = gwave(); task < MTOK / 16; task += nwaves()) {
        const int tok0 = task * 16, b = tok0 / SEQ;
#pragma unroll 1
        for (int h = 0; h < 4; ++h) {
            BF8 qf[2];
            {
                float qv[2][8]; float ss = 0.f;
#pragma unroll
                for (int s2 = 0; s2 < 2; ++s2) {
                    const float4* qp = (const float4*)(Qx + (size_t)(tok0 + qi) * 256 + h * 64 + 32 * s2 + 8 * g);
                    const float4 a = qp[0], c = qp[1];
                    qv[s2][0] = a.x; qv[s2][1] = a.y; qv[s2][2] = a.z; qv[s2][3] = a.w; qv[s2][4] = c.x; qv[s2][5] = c.y; qv[s2][6] = c.z; qv[s2][7] = c.w;
#pragma unroll
                    for (int j = 0; j < 8; ++j) ss += qv[s2][j] * qv[s2][j];
                }
                ss += __shfl_xor(ss, 16, 64); ss += __shfl_xor(ss, 32, 64);
                const float rs = rsqrtf(ss * (1.f / 64.f) + EPS) * 0.125f;
#pragma unroll
                for (int s2 = 0; s2 < 2; ++s2) {
                    const float4 g0 = *(const float4*)(qg + 32 * s2 + 8 * g), g1 = *(const float4*)(qg + 32 * s2 + 8 * g + 4);
                    qf[s2].w[0] = pk_bf16(qv[s2][0] * rs * g0.x, qv[s2][1] * rs * g0.y); qf[s2].w[1] = pk_bf16(qv[s2][2] * rs * g0.z, qv[s2][3] * rs * g0.w);
                    qf[s2].w[2] = pk_bf16(qv[s2][4] * rs * g1.x, qv[s2][5] * rs * g1.y); qf[s2].w[3] = pk_bf16(qv[s2][6] * rs * g1.z, qv[s2][7] * rs * g1.w);
                }
            }
            const bf16_t* Kh = KB + ((size_t)b * 4 + h) * NMEM * 64;
            const bf16_t* Vh = VTB + ((size_t)b * 4 + h) * 64 * NMEM;
            f32x4_t oacc[4];
#pragma unroll
            for (int dt = 0; dt < 4; ++dt) oacc[dt] = (f32x4_t){0.f, 0.f, 0.f, 0.f};
            float lsum = 0.f;
            const int krow = 8 * (qi >> 2) + (qi & 3);
#pragma unroll 2
            for (int s0 = 0; s0 < NMEM; s0 += 32) {
                BF8 ka[2][2], va[4];
#pragma unroll
                for (int t = 0; t < 2; ++t)
#pragma unroll
                    for (int s2 = 0; s2 < 2; ++s2) ka[t][s2].u = *(const uint4*)(Kh + (size_t)(s0 + krow + 4 * t) * 64 + 32 * s2 + 8 * g);
#pragma unroll
                for (int dt = 0; dt < 4; ++dt) va[dt].u = *(const uint4*)(Vh + (size_t)(16 * dt + qi) * NMEM + s0 + 8 * g);
                f32x4_t sacc[2];
#pragma unroll
                for (int t = 0; t < 2; ++t) {
                    sacc[t] = (f32x4_t){0.f, 0.f, 0.f, 0.f};
                    sacc[t] = __builtin_amdgcn_mfma_f32_16x16x32_bf16(ka[t][0].v, qf[0].v, sacc[t], 0, 0, 0);
                    sacc[t] = __builtin_amdgcn_mfma_f32_16x16x32_bf16(ka[t][1].v, qf[1].v, sacc[t], 0, 0, 0);
                }
                float pe[8];
#pragma unroll
                for (int t = 0; t < 2; ++t)
#pragma unroll
                    for (int r = 0; r < 4; ++r) { pe[4 * t + r] = __expf(sacc[t][r]); lsum += pe[4 * t + r]; }
                BF8 pf;
#pragma unroll
                for (int j = 0; j < 4; ++j) pf.w[j] = pk_bf16(pe[2 * j], pe[2 * j + 1]);
#pragma unroll
                for (int dt = 0; dt < 4; ++dt) oacc[dt] = __builtin_amdgcn_mfma_f32_16x16x32_bf16(va[dt].v, pf.v, oacc[dt], 0, 0, 0);
            }
            lsum += __shfl_xor(lsum, 16, 64); lsum += __shfl_xor(lsum, 32, 64);
            const float inv = 1.f / lsum;
#pragma unroll
            for (int dt = 0; dt < 4; ++dt) {
                uint2 o; o.x = pk_bf16(oacc[dt][0] * inv, oacc[dt][1] * inv); o.y = pk_bf16(oacc[dt][2] * inv, oacc[dt][3] * inv);
                *(uint2*)(Ox + (size_t)(tok0 + qi) * 256 + h * 64 + 16 * dt + 4 * g) = o;
            }
        }
    }
}

template <int N> __device__ __forceinline__ void bitonic_sort_desc(unsigned (&a)[N]) {
#pragma unroll
    for (int k = 2; k <= N; k <<= 1)
#pragma unroll
        for (int j = k >> 1; j > 0; j >>= 1)
#pragma unroll
            for (int i = 0; i < N; ++i) {
                const int o = i ^ j;
                if (o > i) {
                    const bool desc = ((i & k) == 0);
                    const unsigned x = a[i], y = a[o];
                    const unsigned mx = x > y ? x : y, mn = x > y ? y : x;
                    a[i] = desc ? mx : mn; a[o] = desc ? mn : mx;
                }
            }
}
__device__ __forceinline__ void bitonic_merge16_desc(unsigned (&a)[16]) {
#pragma unroll
    for (int j = 8; j > 0; j >>= 1)
#pragma unroll
        for (int i = 0; i < 16; ++i) {
            const int o = i ^ j;
            if (o > i) { const unsigned x = a[i], y = a[o]; a[i] = x > y ? x : y; a[o] = x > y ? y : x; }
        }
}
__device__ __forceinline__ void top16_merge(unsigned (&a)[16], const unsigned (&b)[16]) {
#pragma unroll
    for (int i = 0; i < 16; ++i) a[i] = a[i] > b[15 - i] ? a[i] : b[15 - i];
    bitonic_merge16_desc(a);
}
__device__ __forceinline__ void top16_xlane(unsigned (&a)[16], int xm) {
    unsigned b[16];
#pragma unroll
    for (int i = 0; i < 16; ++i) b[i] = (unsigned)__shfl_xor((int)a[i], xm, 64);
    top16_merge(a, b);
}
__device__ __forceinline__ void ph_subkeys_convert(const Ctx& p) {
    const float* sk = pin_(31);
    bf16_t* o = (bf16_t*)(pws_() + WS_SKB);
    const size_t n = (size_t)DEPTH * 8 * 2 * 128 * 64;
    for (size_t i = (size_t)bid_() * 512 + tid_(); i < n; i += (size_t)nblk_() * 512) o[i] = f2bf(sk[i]);
}
__device__ __forceinline__ void ph_peer_topk(const Ctx& p, int l, float* smem) {
    const bf16_t* Qp = (const bf16_t*)(pws_() + WS_QP);
    const bf16_t* SK = (const bf16_t*)(pws_() + WS_SKB) + (size_t)l * 8 * 2 * 128 * 64;
    int* pidx = (int*)(pws_() + WS_PEI);
    float* pgt = (float*)(pws_() + WS_PEG);
    const int tid = tid_(), lane = tid & 63, wave = tid >> 6, qi = lane & 15, g = lane >> 4;
    int* tabw = (int*)smem + wave * 512 + qi * 32;
    for (int task = gwave(); task < MTOK / 16; task += nwaves()) {
        const size_t tok = (size_t)task * 16 + qi;
#pragma unroll 1
        for (int h = 0; h < 8; ++h) {
            unsigned L[2][16];
#pragma unroll
            for (int pp = 0; pp < 2; ++pp) {
                BF8 qf[2];
#pragma unroll
                for (int s2 = 0; s2 < 2; ++s2) qf[s2].u = *(const uint4*)(Qp + tok * DM + h * 128 + pp * 64 + 32 * s2 + 8 * g);
                const bf16_t* skp = SK + (size_t)(h * 2 + pp) * 128 * 64;
                unsigned va[16], vb[16];
#pragma unroll
                for (int tile = 0; tile < 8; ++tile) {
                    BF8 ka[2];
#pragma unroll
                    for (int s2 = 0; s2 < 2; ++s2) ka[s2].u = *(const uint4*)(skp + (size_t)(16 * tile + qi) * 64 + 32 * s2 + 8 * g);
                    f32x4_t d = __builtin_amdgcn_mfma_f32_16x16x32_bf16(ka[0].v, qf[0].v, (f32x4_t){0.f, 0.f, 0.f, 0.f}, 0, 0, 0);
                    d = __builtin_amdgcn_mfma_f32_16x16x32_bf16(ka[1].v, qf[1].v, d, 0, 0, 0);
#pragma unroll
                    for (int r = 0; r < 4; ++r) {
                        const unsigned key = (ford(d[r]) & ~127u) | (unsigned)(127 - (16 * tile + 4 * g + r));
                        if (tile < 4) va[tile * 4 + r] = key; else vb[(tile - 4) * 4 + r] = key;
                    }
                }
                bitonic_sort_desc<16>(va);
                bitonic_sort_desc<16>(vb);
                top16_merge(va, vb);
                top16_xlane(va, 16);
                top16_xlane(va, 32);
#pragma unroll
                for (int i = 0; i < 16; ++i) L[pp][i] = va[i];
            }
            if (g < 2) {
#pragma unroll
                for (int i = 0; i < 16; ++i) tabw[g * 16 + i] = 127 - (int)((g == 0 ? L[0][i] : L[1][i]) & 127u);
            }
            float s1[16], s2v[16];
#pragma unroll
            for (int i = 0; i < 16; ++i) { s1[i] = funord(L[0][i] & ~127u); s2v[i] = funord(L[1][i] & ~127u); }
            unsigned ca[16], cb[16];
#pragma unroll
            for (int i = 0; i < 16; ++i) { ca[i] = 0u; cb[i] = 0u; }
            {
                const float r0 = g == 0 ? s1[0] : (g == 1 ? s1[1] : (g == 2 ? s1[2] : s1[3]));
                const int nb0 = g == 0 ? 16 : (g == 1 ? 8 : (g == 2 ? 5 : 4));
#pragma unroll
                for (int bq = 0; bq < 16; ++bq) if (bq < nb0) ca[bq] = (ford(r0 + s2v[bq]) & ~255u) | (unsigned)(255 - (g * 16 + bq));
                const float r1 = g == 0 ? s1[4] : (g == 1 ? s1[5] : (g == 2 ? s1[6] : s1[7]));
                const int nb1 = g == 0 ? 3 : 2;
#pragma unroll
                for (int bq = 0; bq < 3; ++bq) if (bq < nb1) cb[bq] = (ford(r1 + s2v[bq]) & ~255u) | (unsigned)(255 - ((g + 4) * 16 + bq));
                const float r2 = g == 0 ? s1[8] : (g == 1 ? s1[9] : (g == 2 ? s1[10] : s1[11]));
                cb[3] = (ford(r2 + s2v[0]) & ~255u) | (unsigned)(255 - ((g + 8) * 16));
                const float r3 = g == 0 ? s1[12] : (g == 1 ? s1[13] : (g == 2 ? s1[14] : s1[15]));
                cb[4] = (ford(r3 + s2v[0]) & ~255u) | (unsigned)(255 - ((g + 12) * 16));
            }
            bitonic_sort_desc<16>(ca);
            bitonic_sort_desc<16>(cb);
            top16_merge(ca, cb);
            top16_xlane(ca, 16);
            top16_xlane(ca, 32);
            float tv[16]; float den = 0.f;
#pragma unroll
            for (int i = 0; i < 16; ++i) {
                const int f = 255 - (int)(ca[i] & 255u);
                const int a = f >> 4, bq = f & 15;
                tv[i] = funord(ca[i] & ~255u);
                (void)a; (void)bq;
            }
#pragma unroll
            for (int i = 0; i < 16; ++i) { tv[i] = __expf(tv[i] - funord(ca[0] & ~255u)); den += tv[i]; }
            const float inv = 1.f / den;
            int ev[4]; float gv[4];
#pragma unroll
            for (int r = 0; r < 4; ++r) {
                const unsigned key = g == 0 ? ca[r] : (g == 1 ? ca[4 + r] : (g == 2 ? ca[8 + r] : ca[12 + r]));
                const float tvv = g == 0 ? tv[r] : (g == 1 ? tv[4 + r] : (g == 2 ? tv[8 + r] : tv[12 + r]));
                const int f = 255 - (int)(key & 255u);
                ev[r] = tabw[f >> 4] * 128 + tabw[16 + (f & 15)];
                gv[r] = tvv * inv;
            }
            *(int4*)(pidx + tok * 128 + h * 16 + 4 * g) = make_int4(ev[0], ev[1], ev[2], ev[3]);
            *(float4*)(pgt + tok * 128 + h * 16 + 4 * g) = make_float4(gv[0], gv[1], gv[2], gv[3]);
        }
    }
}

typedef _Float16 h2_t __attribute__((ext_vector_type(2)));
__device__ __forceinline__ h2_t as_h2(unsigned u) { union { unsigned u; h2_t h; } c; c.u = u; return c.h; }
#define U_SCALE 1024.f
#define V_SCALE 256.f
typedef float f32x2_t __attribute__((ext_vector_type(2)));
__device__ __forceinline__ unsigned pack4_fp8(float4 a, float sc) {
    const float x = fminf(fmaxf(a.x * sc, -448.f), 448.f), y = fminf(fmaxf(a.y * sc, -448.f), 448.f);
    const float z = fminf(fmaxf(a.z * sc, -448.f), 448.f), w = fminf(fmaxf(a.w * sc, -448.f), 448.f);
    int r = __builtin_amdgcn_cvt_pk_fp8_f32(x, y, 0, false);
    r = __builtin_amdgcn_cvt_pk_fp8_f32(z, w, r, true);
    return (unsigned)r;
}
__device__ __forceinline__ void ph_tab_convert(const Ctx& p, int l) {
    const float4* u = (const float4*)(pin_(32) + (size_t)l * NEXP * DM);
    const float4* v = (const float4*)(pin_(33) + (size_t)l * NEXP * DM);
    unsigned* uo = (unsigned*)(pws_() + WS_UT16);
    unsigned* vo = (unsigned*)(pws_() + WS_VT16);
    const size_t n4 = (size_t)NEXP * DM / 4;
    for (size_t i = (size_t)bid_() * 512 + tid_(); i < n4; i += (size_t)nblk_() * 512) {
        uo[i] = pack4_fp8(u[i], U_SCALE);
        vo[i] = pack4_fp8(v[i], V_SCALE);
    }
}
__device__ __forceinline__ void ph_peer_u(const Ctx& p, int l) {
    const unsigned char* ut = (const unsigned char*)(pws_() + WS_UT16);
    const int* pidx = (const int*)(pws_() + WS_PEI);
    float* pgt = (float*)(pws_() + WS_PEG);
    const bf16_t* H = (const bf16_t*)(pws_() + WS_H);
    const int lane = tid_() & 63;
    const bool bit5 = lane & 32, bit4 = lane & 16, bit3 = lane & 8, bit2 = lane & 4;
    const int jmine = ((lane >> 5) & 1) * 8 + ((lane >> 4) & 1) * 4 + ((lane >> 3) & 1) * 2 + ((lane >> 2) & 1);
    for (int tok = gwave(); tok < MTOK; tok += nwaves()) {
        float hh[16];
        {
            const uint4 r0 = *(const uint4*)(H + (size_t)tok * DM + lane * 16), r1 = *(const uint4*)(H + (size_t)tok * DM + lane * 16 + 8);
            const unsigned w[8] = {r0.x, r0.y, r0.z, r0.w, r1.x, r1.y, r1.z, r1.w};
#pragma unroll
            for (int q = 0; q < 8; ++q) { hh[2 * q] = __uint_as_float(w[q] << 16); hh[2 * q + 1] = __uint_as_float(w[q] & 0xffff0000u); }
        }
        const int e0 = pidx[(size_t)tok * 128 + lane], e1 = pidx[(size_t)tok * 128 + 64 + lane];
        const float g0 = pgt[(size_t)tok * 128 + lane], g1 = pgt[(size_t)tok * 128 + 64 + lane];
#pragma unroll 1
        for (int hb = 0; hb < 8; ++hb) {
            const int esrc = hb < 4 ? e0 : e1;
            const float gsrc = hb < 4 ? g0 : g1;
            const int lb = (hb & 3) * 16;
            uint4 ur[16];
#pragma unroll
            for (int j = 0; j < 16; ++j) {
                const int e = __builtin_amdgcn_readlane(esrc, lb + j);
                ur[j] = *(const uint4*)(ut + (size_t)e * DM + lane * 16);
            }
            float pd[16];
#pragma unroll
            for (int j = 0; j < 16; ++j) {
                const unsigned w[4] = {ur[j].x, ur[j].y, ur[j].z, ur[j].w};
                float d0 = 0.f, d1 = 0.f;
#pragma unroll
                for (int q = 0; q < 4; ++q) {
                    const f32x2_t a = __builtin_amdgcn_cvt_pk_f32_fp8((int)w[q], false), c = __builtin_amdgcn_cvt_pk_f32_fp8((int)w[q], true);
                    d0 = __builtin_fmaf(a.x, hh[4 * q], d0); d1 = __builtin_fmaf(a.y, hh[4 * q + 1], d1);
                    d0 = __builtin_fmaf(c.x, hh[4 * q + 2], d0); d1 = __builtin_fmaf(c.y, hh[4 * q + 3], d1);
                }
                pd[j] = d0 + d1;
            }
            float r8[8], r4[4], r2[2], r1;
#pragma unroll
            for (int i = 0; i < 8; ++i) { const float mine = bit5 ? pd[i + 8] : pd[i], send = bit5 ? pd[i] : pd[i + 8]; r8[i] = mine + __shfl_xor(send, 32, 64); }
#pragma unroll
            for (int i = 0; i < 4; ++i) { const float mine = bit4 ? r8[i + 4] : r8[i], send = bit4 ? r8[i] : r8[i + 4]; r4[i] = mine + __shfl_xor(send, 16, 64); }
#pragma unroll
            for (int i = 0; i < 2; ++i) { const float mine = bit3 ? r4[i + 2] : r4[i], send = bit3 ? r4[i] : r4[i + 2]; r2[i] = mine + __shfl_xor(send, 8, 64); }
            { const float mine = bit2 ? r2[1] : r2[0], send = bit2 ? r2[0] : r2[1]; r1 = mine + __shfl_xor(send, 4, 64); }
            r1 += __shfl_xor(r1, 2, 64); r1 += __shfl_xor(r1, 1, 64);
            const float gmine = __shfl(gsrc, lb + jmine, 64);
            const float coef = gmine * gelu_tanh_f(r1 * (1.f / U_SCALE)) * (1.f / V_SCALE);
            if ((lane & 3) == 0) pgt[(size_t)tok * 128 + hb * 16 + jmine] = coef;
        }
    }
}
__device__ __forceinline__ void ph_peer_v(const Ctx& p, int l) {
    const unsigned char* vt = (const unsigned char*)(pws_() + WS_VT16);
    const int* pidx = (const int*)(pws_() + WS_PEI);
    const float* pgt = (const float*)(pws_() + WS_PEG);
    float* x = pout_();
    const int lane = tid_() & 63;
    for (int tok = gwave(); tok < MTOK; tok += nwaves()) {
        const int e0 = pidx[(size_t)tok * 128 + lane], e1 = pidx[(size_t)tok * 128 + 64 + lane];
        const float c0 = pgt[(size_t)tok * 128 + lane], c1 = pgt[(size_t)tok * 128 + 64 + lane];
        float out[16];
#pragma unroll
        for (int i = 0; i < 16; ++i) out[i] = 0.f;
#pragma unroll 1
        for (int hb = 0; hb < 6; ++hb) {
            const int esrc = hb < 3 ? e0 : e1;
            const float csrc = hb < 3 ? c0 : c1;
            const int lb = (hb % 3) * 24, nb = (hb % 3) == 2 ? 16 : 24;
            uint4 vr[24];
#pragma unroll
            for (int j = 0; j < 24; ++j) {
                if (j < nb) {
                    const int e = __builtin_amdgcn_readlane(esrc, lb + j);
                    vr[j] = *(const uint4*)(vt + (size_t)e * DM + lane * 16);
                } else vr[j] = make_uint4(0u, 0u, 0u, 0u);
            }
#pragma unroll
            for (int j = 0; j < 24; ++j) {
                if (j >= nb) continue;
                const float cj = __uint_as_float(__builtin_amdgcn_readlane(__float_as_uint(csrc), lb + j));
                const unsigned w[4] = {vr[j].x, vr[j].y, vr[j].z, vr[j].w};
#pragma unroll
                for (int q = 0; q < 4; ++q) {
                    const f32x2_t a = __builtin_amdgcn_cvt_pk_f32_fp8((int)w[q], false), c = __builtin_amdgcn_cvt_pk_f32_fp8((int)w[q], true);
                    out[4 * q] = __builtin_fmaf(a.x, cj, out[4 * q]); out[4 * q + 1] = __builtin_fmaf(a.y, cj, out[4 * q + 1]);
                    out[4 * q + 2] = __builtin_fmaf(c.x, cj, out[4 * q + 2]); out[4 * q + 3] = __builtin_fmaf(c.y, cj, out[4 * q + 3]);
                }
            }
        }
        float4* xp = (float4*)(x + (size_t)tok * DM + lane * 16);
        float ss = 0.f;
#pragma unroll
        for (int q = 0; q < 4; ++q) {
            float4 a = xp[q];
            a.x += out[4 * q]; a.y += out[4 * q + 1]; a.z += out[4 * q + 2]; a.w += out[4 * q + 3];
            xp[q] = a;
            ss += a.x * a.x + a.y * a.y + a.z * a.z + a.w * a.w;
        }
        if (l + 1 < DEPTH) {
            const float rs = rsqrtf(wave_sum(ss) * (1.f / DM) + EPS);
            asm volatile("" ::: "memory");
            const float* gnx = pin_(2) + (size_t)(l + 1) * DM + lane * 16;
            bf16_t* hp = (bf16_t*)(pws_() + WS_H) + (size_t)tok * DM + lane * 16;
#pragma unroll
            for (int hq = 0; hq < 2; ++hq) {
                const float4 a = xp[2 * hq], b4 = xp[2 * hq + 1];
                float g8v[8], o8[8];
                load8f(gnx + 8 * hq, g8v);
                o8[0] = a.x * rs * g8v[0]; o8[1] = a.y * rs * g8v[1]; o8[2] = a.z * rs * g8v[2]; o8[3] = a.w * rs * g8v[3];
                o8[4] = b4.x * rs * g8v[4]; o8[5] = b4.y * rs * g8v[5]; o8[6] = b4.z * rs * g8v[6]; o8[7] = b4.w * rs * g8v[7];
                *(uint4*)(hp + 8 * hq) = pack8(o8);
            }
        }
    }
}


#ifndef PROBE_MASK
#define PROBE_MASK 0
#endif
#if PROBE_MASK
#define GB(k) do { GRID_BARRIER(); const unsigned long long now_ = wall_clock64(); if ((PROBE_MASK >> (k)) & 1) { const unsigned long long dt_ = now_ - tprev_; while (wall_clock64() - now_ < 3ull * dt_) __builtin_amdgcn_s_sleep(8); } GRID_BARRIER(); tprev_ = wall_clock64(); } while (0)
#else
#define GB(k) GRID_BARRIER()
#endif
__global__ void __launch_bounds__(512, 2) k_mega(Params kp) {
    float* sm = dynsmem;
    {
        unsigned long long* tab = (unsigned long long*)((char*)dynsmem + PTAB_OFF);
        if (threadIdx.x < 34) tab[threadIdx.x] = (unsigned long long)kp.in[threadIdx.x];
        if (threadIdx.x == 34) tab[34] = (unsigned long long)kp.out;
        if (threadIdx.x == 35) tab[35] = (unsigned long long)kp.ws;
        if (threadIdx.x == 36) { tab[36] = 0ull; tab[37] = 0ull; }
    }
    __syncthreads();
    Ctx p; p.kp = &kp;
    (void)xcd_barrier_post((unsigned*)(pws_() + WS_BAR), (volatile LAS unsigned*)((char*)dynsmem + PTAB_OFF + 36 * 8));
#define GRID_BARRIER() do { XcdBarrier bar_; bar_.bar = (unsigned*)(pws_() + WS_BAR); bar_.x = xb_xcc_id(); bar_.st = (volatile LAS unsigned*)((char*)dynsmem + PTAB_OFF + 36 * 8); xcd_barrier(bar_); } while (0)
    ph_weight_prep(p, sm);
    ph_subkeys_convert(p);
    GRID_BARRIER();
#if PROBE_MASK
    unsigned long long tprev_ = wall_clock64();
#endif
#pragma unroll 1
    for (int l = 0; l < DEPTH; ++l) {
#define XIN_ (l == 0 ? pin_(0) : pout_())
#define HBUF_ ((const bf16_t*)(pws_() + WS_H))
        if (l == 0) ph_rmsnorm(XIN_, pin_(2) + (size_t)l * DM, (bf16_t*)(pws_() + WS_H), MTOK);
        ph_rmsnorm(pin_(1), pin_(22) + (size_t)l * DM, (bf16_t*)(pws_() + WS_HM), MMEM);
        GB(1);
        { pg8::EpiBf16 E; E.O = (bf16_t*)(pws_() + WS_P); E.ldc = LDP; ph_gemm(HBUF_, (const bf16_t*)(pws_() + WT_IN) + (size_t)l * LDP * DM, MTOK, LDP, DM, E); }
        { pg8::EpiF32 E; E.C = (float*)(pws_() + WS_KM); E.R = nullptr; E.ldc = 256; ph_gemm((const bf16_t*)(pws_() + WS_HM), (const bf16_t*)(pws_() + WT_XK) + (size_t)l * 256 * DM, MMEM, 256, DM, E); }
        { pg8::EpiF32 E; E.C = (float*)(pws_() + WS_VM); E.R = nullptr; E.ldc = 256; ph_gemm((const bf16_t*)(pws_() + WS_HM), (const bf16_t*)(pws_() + WT_XV) + (size_t)l * 256 * DM, MMEM, 256, DM, E); }
        GB(2);
        ph_mem_prep(p, l);
        ph_dsa_prep(p, l);
        ph_scan_prep(p, l);
        GB(3);
        ph_scans(p, l, sm);
        GB(4);
        ph_mixer_finish(p, l);
        ph_dsa_main(p, l, sm);
        GB(5);
        { pg8::EpiF32 E; E.C = pout_(); E.R = XIN_; E.ldc = DM; ph_gemm((const bf16_t*)(pws_() + WS_Y), (const bf16_t*)(pws_() + WT_OUT) + (size_t)l * DM * DM, MTOK, DM, DM, E); }
        GB(6);
        ph_rmsnorm(pout_(), pin_(21) + (size_t)l * DM, (bf16_t*)(pws_() + WS_H), MTOK);
        GB(7);
        { pg8::EpiF32 E; E.C = (float*)(pws_() + WS_QX); E.R = nullptr; E.ldc = 256; ph_gemm(HBUF_, (const bf16_t*)(pws_() + WT_XQ) + (size_t)l * 256 * DM, MTOK, 256, DM, E); }
        GB(8);
        ph_xattn(p, l);
        GB(9);
        { pg8::EpiF32 E; E.C = pout_(); E.R = pout_(); E.ldc = DM; ph_gemm((const bf16_t*)(pws_() + WS_OX), (const bf16_t*)(pws_() + WT_XO) + (size_t)l * DM * 256, MTOK, DM, 256, E); }
        GB(10);
        ph_rmsnorm(pout_(), pin_(29) + (size_t)l * DM, (bf16_t*)(pws_() + WS_H), MTOK);
        ph_tab_convert(p, l);
        GB(11);
        { pg8::EpiBf16 E; E.O = (bf16_t*)(pws_() + WS_QP); E.ldc = DM; ph_gemm(HBUF_, (const bf16_t*)(pws_() + WT_PQ) + (size_t)l * DM * DM, MTOK, DM, DM, E); }
        GB(12);
        ph_peer_topk(p, l, sm);
        GB(13);
        ph_peer_u(p, l);
        GB(14);
        ph_peer_v(p, l);
        GB(15);
    }
}

extern "C" void kernel_launch(void* const* d_in, const int* in_sizes, int n_in, void* d_out, int out_size, void* d_ws, size_t ws_size, hipStream_t stream) {
    if (n_in != 34 || out_size != MTOK * DM || ws_size < WS_END) {
        fprintf(stderr, "kernel_launch: unexpected shapes (n_in %d out %d ws %zu need %zu)\n", n_in, out_size, ws_size, (size_t)WS_END);
        return;
    }
    static int grid = 0;
    if (!grid) {
        int dev = 0, cus = 0, per_cu = 0;
        (void)hipGetDevice(&dev);
        (void)hipDeviceGetAttribute(&cus, hipDeviceAttributeMultiprocessorCount, dev);
        (void)hipFuncSetAttribute((const void*)k_mega, hipFuncAttributeMaxDynamicSharedMemorySize, LDS_BYTES);
        (void)hipOccupancyMaxActiveBlocksPerMultiprocessor(&per_cu, (const void*)k_mega, 512, LDS_BYTES);
        if (per_cu < 1) fprintf(stderr, "kernel_launch: occupancy query reports %d blocks per CU\n", per_cu);
        grid = cus > 0 ? cus : 256;
    }
    Params p; memset(&p, 0, sizeof(p));
    for (int i = 0; i < 34; ++i) p.in[i] = (const float*)d_in[i];
    p.out = (float*)d_out; p.ws = (char*)d_ws;
    (void)hipMemsetAsync((char*)d_ws + WS_BAR, 0, XCD_BAR_WORDS * sizeof(unsigned), stream);
    hipLaunchKernelGGL(k_mega, dim3(grid), dim3(512), LDS_BYTES, stream, p);
}
```

```cpp
#include <hip/hip_runtime.h>
#include <stdint.h>
#include <stdio.h>
#include <string.h>

#define NB 32
#define SEQ 2048
#define DM 1024
#define MTOK (NB * SEQ)
#define DEPTH 4
#define NMEM 256
#define MMEM (NB * NMEM)
#define LDP 3328
#define NEXP 16384
#define EPS 1e-6f
#define PC_Z 0
#define PC_XBC 256
#define PC_GQKV 768
#define PC_GG 1536
#define PC_LQ 1792
#define PC_LK 1920
#define PC_LV 2048
#define PC_LR 2304
#define PC_DQ 2560
#define PC_DK 2816
#define PC_DV 2880
#define PC_IQ 2944
#define PC_IK 3200
#define PC_GLR 3232
#define PC_IW 3248
#define PC_DT 3256
#define PC_GA 3260
#define PC_GB 3264

typedef unsigned short bf16_t;

#define WS_BAR 0ull
#define WS_P 16384ull
#define SZ_P ((size_t)MTOK * LDP * 2)
#define WS_H (WS_P + SZ_P)
#define SZ_H ((size_t)MTOK * DM * 2)
#define WS_Y (WS_H + SZ_H)
#define SZ_Y ((size_t)MTOK * DM * 2)
#define WS_WP (WS_Y + SZ_Y)
#define SZ_WP ((size_t)DEPTH * DM * LDP * 4)
#define WT_IN (WS_WP)
#define WT_OUT (WT_IN + (size_t)DEPTH * LDP * DM * 2)
#define WT_XQ (WT_OUT + (size_t)DEPTH * DM * DM * 2)
#define WT_XK (WT_XQ + (size_t)DEPTH * 256 * DM * 2)
#define WT_XV (WT_XK + (size_t)DEPTH * 256 * DM * 2)
#define WT_XO (WT_XV + (size_t)DEPTH * 256 * DM * 2)
#define WT_PQ (WT_XO + (size_t)DEPTH * DM * 256 * 2)
#define WT_END (WT_PQ + (size_t)DEPTH * DM * DM * 2)
#define WS_QN (WS_WP + SZ_WP)
#define SZ_QN ((size_t)MTOK * 256 * 4)
#define WS_KN (WS_QN + SZ_QN)
#define SZ_KN ((size_t)MTOK * 64 * 4)
#define WS_IKN (WS_KN + SZ_KN)
#define SZ_IKN ((size_t)MTOK * 32 * 4)
#define WS_YPRE (WS_IKN + SZ_IKN)
#define SZ_YPRE ((size_t)MTOK * 256 * 4)
#define WS_HM (WS_YPRE + SZ_YPRE)
#define SZ_HM ((size_t)MMEM * DM * 2)
#define WS_KM (WS_HM + SZ_HM)
#define SZ_KM ((size_t)MMEM * 256 * 4)
#define WS_VM (WS_KM + SZ_KM)
#define SZ_VM ((size_t)MMEM * 256 * 4)
#define WS_KB (WS_VM + SZ_VM)
#define SZ_KB ((size_t)MMEM * 256 * 2)
#define WS_VTB (WS_KB + SZ_KB)
#define SZ_VTB ((size_t)MMEM * 256 * 2)
#define WS_VT (WS_VTB + SZ_VTB)
#define SZ_VT ((size_t)MTOK * 64 * 2)
#define WS_SKB (WS_VT + SZ_VT)
#define SZ_SKB ((size_t)DEPTH * 8 * 2 * 128 * 64 * 2)
#define WS_SC (WS_SKB + SZ_SKB)
#define SZ_SC ((size_t)MTOK * 16 * 4)
#define WS_DUMMY (WS_SC + SZ_SC)
#define SZ_DUMMY (65536ull)
#define WS_END (WS_DUMMY + SZ_DUMMY)
#define WS_QX (WS_P)
#define WS_OX (WS_P + (size_t)MTOK * 256 * 4)
#define WS_QP (WS_P)
#define WS_UT16 (WS_P + 260ull * 1024 * 1024)
#define WS_VT16 (WS_UT16 + (size_t)NEXP * DM * 2)
#define WS_PEI (WS_VT16 + (size_t)NEXP * DM * 2)
#define WS_PEG (WS_PEI + (size_t)MTOK * 128 * 4)
#define WS_PEND (WS_PEG + (size_t)MTOK * 128 * 4)
static_assert(WS_PEND <= WS_P + SZ_P, "P region aliases");

struct Params {
    const float* in[34];
    float* out;
    char* ws;
};

#define XB_TMO      128
#define XB_XCNT(j)  (256  + 64 * (j))
#define XB_XSUB(j)  (1280 + 64 * (j))
#define XB_XGEN(j)  (2304 + 64 * (j))
#define XB_TOP      3328
#define XB_TOPGEN   3392
#define XCD_BAR_WORDS 3456
#define XB_SPIN_CAP (1u << 18)
#define LAS __attribute__((address_space(3)))

__device__ __forceinline__ unsigned xb_ld(unsigned* p)              { return __hip_atomic_load(p, __ATOMIC_RELAXED, __HIP_MEMORY_SCOPE_AGENT); }
__device__ __forceinline__ unsigned xb_add(unsigned* p, unsigned v) { return __hip_atomic_fetch_add(p, v, __ATOMIC_RELAXED, __HIP_MEMORY_SCOPE_AGENT); }
__device__ __forceinline__ unsigned xb_xcc_id() { return (unsigned)__builtin_amdgcn_s_getreg((3 << 11) | 20) & 0xFu; }
#define XB_SPIN(cond, bar) do { unsigned _sp = 0; while (cond) { __builtin_amdgcn_s_sleep(1); \
    if ((++_sp & 255u) == 0u) { if (xb_ld(&(bar)[XB_TMO])) break; if (_sp > XB_SPIN_CAP) { atomicAdd(&(bar)[XB_TMO], 1u); break; } } } } while (0)

struct XcdBarrier {
    unsigned* bar; unsigned x;
    volatile LAS unsigned* st;
};

__device__ __forceinline__ XcdBarrier xcd_barrier_post(unsigned* bar, volatile LAS unsigned* st) {
    XcdBarrier b; b.bar = bar; b.x = xb_xcc_id(); b.st = st;
    if (threadIdx.x == 0) (void)xb_add(&bar[XB_XCNT(b.x)], 1u);
    return b;
}
__device__ __forceinline__ void xcd_barrier_complete(unsigned* bar, unsigned x, unsigned& nloc, unsigned& nx) {
    const unsigned G = gridDim.x * gridDim.y * gridDim.z;
    unsigned sum, cnt, mine, sp = 0u;
    for (;;) {
        sum = 0u; cnt = 0u; mine = 0u;
#pragma unroll
        for (unsigned j = 0; j < 16; ++j) { const unsigned c = xb_ld(&bar[XB_XCNT(j)]); sum += c; cnt += (c > 0u) ? 1u : 0u; mine = (j == x) ? c : mine; }
        if (sum == G) break;
        __builtin_amdgcn_s_sleep(1);
        if ((++sp & 255u) == 0u) { if (xb_ld(&bar[XB_TMO])) break; if (sp > XB_SPIN_CAP) { atomicAdd(&bar[XB_TMO], 1u); break; } }
    }
    nloc = mine > 0u ? mine : 1u; nx = cnt > 0u ? cnt : 1u;
}

__device__ __forceinline__ void xcd_barrier(const XcdBarrier& b) {
    asm volatile("s_waitcnt vmcnt(0)" ::: "memory");
    __syncthreads();
    if (threadIdx.x == 0) {
        unsigned* bar = b.bar;
        __builtin_amdgcn_s_waitcnt(0);
        unsigned nloc = b.st[0], nx = b.st[1];
        if (nloc == 0u) { xcd_barrier_complete(bar, b.x, nloc, nx); b.st[0] = nloc; b.st[1] = nx; }
        const unsigned old = xb_add(&bar[XB_XSUB(b.x)], 1u);
        const unsigned gen = old / nloc;
        if (old + 1u == (gen + 1u) * nloc) {
            __builtin_amdgcn_fence(__ATOMIC_RELEASE, "agent");
            asm volatile("s_waitcnt vmcnt(0)" ::: "memory");
            const unsigned og = xb_add(&bar[XB_TOP], 1u);
            const unsigned tg = og / nx;
            if (og + 1u == (tg + 1u) * nx) xb_add(&bar[XB_TOPGEN], 1u);
            else XB_SPIN(xb_ld(&bar[XB_TOPGEN]) == tg, bar);
            __builtin_amdgcn_fence(__ATOMIC_ACQUIRE, "agent");
            xb_add(&bar[XB_XGEN(b.x)], 1u);
            asm volatile("s_waitcnt vmcnt(0)" ::: "memory");
        } else {
            XB_SPIN(xb_ld(&bar[XB_XGEN(b.x)]) == gen, bar);
            __builtin_amdgcn_fence(__ATOMIC_ACQUIRE, "agent");
            asm volatile("s_waitcnt vmcnt(0)" ::: "memory");
        }
    }
    __syncthreads();
}


#define LDS_BYTES (144 * 1024)
#define PTAB_OFF (LDS_BYTES - 1024)
extern __shared__ __attribute__((aligned(16))) float dynsmem[];
struct Ctx { const Params* kp; };
#define pin_(i) (p.kp->in[i])
#define pout_() (p.kp->out)
#define pws_() (p.kp->ws)

__device__ __forceinline__ float bf2f(bf16_t v) { return __uint_as_float(((unsigned)v) << 16); }
__device__ __forceinline__ bf16_t f2bf(float f) { unsigned u = __float_as_uint(f); u += 0x7FFFu + ((u >> 16) & 1u); return (bf16_t)(u >> 16); }
__device__ __forceinline__ unsigned pk_bf16(float lo, float hi) { return (unsigned)f2bf(lo) | ((unsigned)f2bf(hi) << 16); }
__device__ __forceinline__ float wave_sum(float v) {
#pragma unroll
    for (int o = 32; o >= 1; o >>= 1) v += __shfl_xor(v, o, 64);
    return v;
}
__device__ __forceinline__ float wave_max(float v) {
#pragma unroll
    for (int o = 32; o >= 1; o >>= 1) v = fmaxf(v, __shfl_xor(v, o, 64));
    return v;
}
__device__ __forceinline__ float silu_f(float x) { return x / (1.f + __expf(-x)); }
__device__ __forceinline__ float sigmoid_f(float x) { return 1.f / (1.f + __expf(-x)); }
__device__ __forceinline__ float softplus_f(float x) { return x > 20.f ? x : log1pf(__expf(x)); }
__device__ __forceinline__ float logsigmoid_f(float x) { return -softplus_f(-x); }
__device__ __forceinline__ float gelu_tanh_f(float x) { const float u = 0.7978845608028654f * (x + 0.044715f * x * x * x); return 0.5f * x * (1.f + tanhf(u)); }
__device__ __forceinline__ unsigned ford(float f) { f = f + 0.0f; unsigned u = __float_as_uint(f); return (u & 0x80000000u) ? ~u : (u | 0x80000000u); }
__device__ __forceinline__ float funord(unsigned k) { unsigned u = (k & 0x80000000u) ? (k & 0x7fffffffu) : ~k; return __uint_as_float(u); }
__device__ __forceinline__ unsigned long long wave_max_u64(unsigned long long v) {
#pragma unroll
    for (int o = 32; o >= 1; o >>= 1) {
        unsigned lo = __shfl_xor((unsigned)v, o, 64), hi = __shfl_xor((unsigned)(v >> 32), o, 64);
        unsigned long long w = ((unsigned long long)hi << 32) | lo;
        v = w > v ? w : v;
    }
    return v;
}
__device__ __forceinline__ int tid_() { int t = threadIdx.x; asm volatile("" : "+v"(t)); return t; }
__device__ __forceinline__ int bid_() { int b = blockIdx.x; asm volatile("" : "+s"(b)); return b; }
__device__ __forceinline__ int nblk_() { int g = gridDim.x; asm volatile("" : "+s"(g)); return g; }
__device__ __forceinline__ int gwave() { return (bid_() * 512 + tid_()) >> 6; }
__device__ __forceinline__ int nwaves() { return nblk_() * 8; }

namespace pg8 {
#define PG8_LAS __attribute__((address_space(3)))
typedef unsigned short bf16_t;
typedef short bf16x8 __attribute__((ext_vector_type(8)));
typedef float f32x4 __attribute__((ext_vector_type(4)));
typedef unsigned u32x4 __attribute__((ext_vector_type(4)));
constexpr int BM = 256, BK = 64, HALF = 128, HTB = HALF * BK * 2  , STAGE_BYTES = 8 * HTB, NXCD = 8, WGM = 8;

__host__ __device__ __forceinline__ int lds_byte(int r, int c) { const int st = (r >> 4) * 2 + (c >> 5), rr = r & 15, cc = c & 31, ob = rr * 64 + cc * 2; return st * 1024 + (ob ^ (((ob >> 9) & 1) << 5)); }
__host__ __device__ __forceinline__ void stage_rc(int b, int& R, int& C) { const int st = b / 1024, sb = b % 1024, swz = sb ^ (((sb >> 9) & 1) << 5); R = (st >> 1) * 16 + swz / 64; C = (st & 1) * 32 + (swz % 64) / 2; }
__host__ __device__ __forceinline__ int perm32(int rho) { const int n = rho >> 4, i = rho & 15; return 8 * (i >> 2) + 4 * n + (i & 3); }

struct Unit { int pm, pn; };
struct Gemm { const bf16_t* A; const bf16_t* Bt; int M, N, K; };

struct StaticOrder {
    int nM, nN, nwg, G, c;
    __host__ __device__ void init(int M, int N, int G_, int c_) { nM = M / BM; nN = N / BM; nwg = nM * nN; G = G_; c = c_; }
    __host__ __device__ bool next(int i, Unit& u) const {
        const long L = (long)i * G + c; if (L >= nwg) return false;
        int wgid = (int)L; { const int q = nwg / NXCD, r = nwg % NXCD, xcd = wgid % NXCD, off = wgid / NXCD; wgid = (xcd < r ? xcd * (q + 1) : r * (q + 1) + (xcd - r) * q) + off; }
        const int nig = WGM * nN, gid = wgid / nig, fm = gid * WGM, gsz = (nM - fm) < WGM ? (nM - fm) : WGM;
        u.pm = fm + ((wgid % nig) % gsz); u.pn = (wgid % nig) / gsz; return true;
    }
    __device__ __forceinline__ void a_ready(const Unit&) const {}
    __device__ __forceinline__ void done(const Unit&) const {}
};

__device__ __forceinline__ unsigned cvt_pk_bf16(float lo, float hi) { unsigned r; asm volatile("v_cvt_pk_bf16_f32 %0, %1, %2" : "=v"(r) : "v"(lo), "v"(hi)); return r; }
struct EpiF32 {
    static constexpr bool PERM = false, AFTER_DRAIN = false;
    float* C; const float* R; int ldc;
    __device__ __forceinline__ void operator()(const f32x4 (&acc)[2][2][4][2], const Unit& u, int wr, int wc, int fr, int fq) const {
        const int row0 = u.pm * BM + wr * 64 + fr, col0 = u.pn * BM + wc * 32 + 4 * fq;
#pragma unroll
        for (int ai = 0; ai < 2; ++ai)
#pragma unroll
            for (int m = 0; m < 4; ++m) { const size_t off = (size_t)(row0 + ai * HALF + m * 16) * ldc + col0;
#pragma unroll
                for (int bj = 0; bj < 2; ++bj)
#pragma unroll
                    for (int n = 0; n < 2; ++n) { f32x4 v = acc[ai][bj][m][n]; if (R) v += *(const f32x4*)(R + off + bj * HALF + n * 16); *(f32x4*)(C + off + bj * HALF + n * 16) = v; } }
    }
};
struct EpiBf16 {
    static constexpr bool PERM = true, AFTER_DRAIN = false;
    bf16_t* O; int ldc;
    __device__ __forceinline__ void operator()(const f32x4 (&acc)[2][2][4][2], const Unit& u, int wr, int wc, int fr, int fq) const {
        const int row0 = u.pm * BM + wr * 64 + fr, col0 = u.pn * BM + wc * 32 + 8 * fq;
#pragma unroll
        for (int ai = 0; ai < 2; ++ai)
#pragma unroll
            for (int m = 0; m < 4; ++m) { bf16_t* rowp = O + (size_t)(row0 + ai * HALF + m * 16) * ldc + col0;
#pragma unroll
                for (int bj = 0; bj < 2; ++bj) { const f32x4 v0 = acc[ai][bj][m][0], v1 = acc[ai][bj][m][1];
                    u32x4 w; w.x = cvt_pk_bf16(v0[0], v0[1]); w.y = cvt_pk_bf16(v0[2], v0[3]); w.z = cvt_pk_bf16(v1[0], v1[1]); w.w = cvt_pk_bf16(v1[2], v1[3]);
                    *(u32x4*)(rowp + bj * HALF) = w; } }
    }
};

template <class Epi, class Sched, bool STAMP = false>
__device__ __forceinline__ void gemm_phase(PG8_LAS unsigned char* lds, const Gemm g, const Sched& S, const Epi& E, unsigned long long* stamps, const int tid) {
    const int wid = __builtin_amdgcn_readfirstlane(tid >> 6), lane = tid & 63, wr = wid >> 2, wc = wid & 3, fr = lane & 15, fq = lane >> 4;
    const int K = g.K, nt = K / BK;
    int ts_lo = 0, ts_hi = 0, nts = 0; const unsigned long long rt_entry = STAMP ? (unsigned long long)wall_clock64() : 0ull;
#define PG8_STAMP() do { if (STAMP && wid == 0 && nts < 64) { const unsigned long long _c = (unsigned long long)clock64(); \
        ts_lo = (lane == nts) ? (int)(unsigned)_c : ts_lo; ts_hi = (lane == nts) ? (int)(unsigned)(_c >> 32) : ts_hi; ++nts; } } while (0)
    PG8_STAMP();
    unsigned voffA[2], voffB[2];
#pragma unroll
    for (int i = 0; i < 2; ++i) { int R, C; stage_rc(tid * 16 + i * 8192, R, C); const int Rb = Epi::PERM ? ((R & ~31) + perm32(R & 31)) : R;
        voffA[i] = (unsigned)(R * K + C) * 2u; voffB[i] = (unsigned)(Rb * K + C) * 2u; }
    const size_t kstep = (size_t)(BK * 2);
    const size_t hstep = (size_t)HALF * K * 2;
    const size_t tstep = 2 * hstep;
    const unsigned ldsw = (unsigned)wid * 1024u;
    const int aoff = lds_byte(wr * 64 + fr, fq * 8), boff = lds_byte(wc * 32 + fr, fq * 8);
#define PG8_SA(b, h) (((b) * 2 + (h)) * HTB)
#define PG8_SB(b, h) ((4 + (b) * 2 + (h)) * HTB)
#define PG8_STAGE(bufoff, gbase, voff) do { _Pragma("unroll") for (int _i = 0; _i < 2; ++_i) \
        __builtin_amdgcn_global_load_lds((const unsigned*)((const char*)(gbase) + (voff)[_i]), (PG8_LAS unsigned*)(lds + (bufoff) + ldsw + _i * 8192), 16, 0, 0); } while (0)
#define PG8_LDA(dst, b, h) do { _Pragma("unroll") for (int m = 0; m < 4; ++m) _Pragma("unroll") for (int k = 0; k < 2; ++k) dst[m][k] = *(const PG8_LAS bf16x8*)(lds + PG8_SA(b, h) + aoff + m * 2048 + k * 1024); } while (0)
#define PG8_LDB(dst, b, h) do { _Pragma("unroll") for (int n = 0; n < 2; ++n) _Pragma("unroll") for (int k = 0; k < 2; ++k) dst[n][k] = *(const PG8_LAS bf16x8*)(lds + PG8_SB(b, h) + boff + n * 2048 + k * 1024); } while (0)
#define PG8_MMA(ai, bj, At, Bt) do { __builtin_amdgcn_s_setprio(1); _Pragma("unroll") for (int m = 0; m < 4; ++m) _Pragma("unroll") for (int n = 0; n < 2; ++n) _Pragma("unroll") for (int k = 0; k < 2; ++k) \
        acc[ai][bj][m][n] = __builtin_amdgcn_mfma_f32_16x16x32_bf16(Bt[n][k], At[m][k], acc[ai][bj][m][n], 0, 0, 0); __builtin_amdgcn_s_setprio(0); } while (0)
#define PG8_WAIT_V(n) asm volatile("s_waitcnt vmcnt(" #n ")" ::: "memory")
#define PG8_WAIT_L(n) asm volatile("s_waitcnt lgkmcnt(" #n ")" ::: "memory")
#define PG8_BAR __builtin_amdgcn_s_barrier()
#define PG8_SCHED __builtin_amdgcn_sched_barrier(0)
    Unit cur, nxt; int ui = 0;
    if (!S.next(0, cur)) return;
    f32x4 acc[2][2][4][2];
#pragma unroll
    for (int a = 0; a < 2; ++a)
#pragma unroll
        for (int b = 0; b < 2; ++b)
#pragma unroll
            for (int m = 0; m < 4; ++m)
#pragma unroll
                for (int n = 0; n < 2; ++n) acc[a][b][m][n] = (f32x4){0.f, 0.f, 0.f, 0.f};
    bf16x8 At[4][2], B0[2][2], B1[2][2];
    const char* cA = (const char*)g.A + (size_t)cur.pm * tstep; const char* cB = (const char*)g.Bt + (size_t)cur.pn * tstep;
    S.a_ready(cur);
    PG8_STAGE(PG8_SB(0, 0), cB, voffB); PG8_STAGE(PG8_SA(0, 0), cA, voffA); PG8_STAGE(PG8_SB(0, 1), cB + hstep, voffB); PG8_STAGE(PG8_SA(0, 1), cA + hstep, voffA);
    if (wr == 1) PG8_BAR;
    PG8_WAIT_V(4); PG8_BAR;
    PG8_STAGE(PG8_SB(1, 0), cB + kstep, voffB); PG8_STAGE(PG8_SA(1, 0), cA + kstep, voffA); PG8_STAGE(PG8_SB(1, 1), cB + hstep + kstep, voffB);
    PG8_WAIT_V(6); PG8_BAR;
    PG8_STAMP();
    for (;;) {
        const bool has_next = S.next(ui + 1, nxt);
        const char* nA = has_next ? (const char*)g.A + (size_t)nxt.pm * tstep : cA; const char* nB = has_next ? (const char*)g.Bt + (size_t)nxt.pn * tstep : cB;
        for (int t = 0; t < nt; t += 2) {
            const bool last = (t == nt - 2);
            const char* a1 = cA + (size_t)(t + 1) * kstep;
            const char* a2 = last ? nA : cA + (size_t)(t + 2) * kstep; const char* b2 = last ? nB : cB + (size_t)(t + 2) * kstep;
            const char* a3 = a2 + kstep; const char* b3 = b2 + kstep;
            if (last && has_next) S.a_ready(nxt);
            PG8_LDB(B0, 0, 0); PG8_SCHED; PG8_LDA(At, 0, 0); PG8_STAGE(PG8_SA(1, 1), a1 + hstep, voffA);
            PG8_WAIT_L(8); PG8_BAR; PG8_WAIT_L(0); PG8_MMA(0, 0, At, B0); PG8_BAR; PG8_SCHED;
            PG8_LDB(B1, 0, 1); PG8_STAGE(PG8_SB(0, 0), b2, voffB);
            PG8_BAR; PG8_WAIT_L(0); PG8_MMA(0, 1, At, B1); PG8_BAR;
            PG8_LDA(At, 0, 1); PG8_STAGE(PG8_SA(0, 0), a2, voffA);
            PG8_BAR; PG8_WAIT_L(0); PG8_MMA(1, 0, At, B0); PG8_BAR; PG8_SCHED;
            PG8_STAGE(PG8_SB(0, 1), b2 + hstep, voffB);
            PG8_WAIT_V(6); PG8_BAR; PG8_MMA(1, 1, At, B1); PG8_BAR;
            PG8_LDB(B0, 1, 0); PG8_SCHED; PG8_LDA(At, 1, 0); PG8_STAGE(PG8_SA(0, 1), a2 + hstep, voffA);
            PG8_WAIT_L(8); PG8_BAR; PG8_WAIT_L(0); PG8_MMA(0, 0, At, B0); PG8_BAR; PG8_SCHED;
            PG8_LDB(B1, 1, 1); PG8_STAGE(PG8_SB(1, 0), b3, voffB);
            PG8_BAR; PG8_WAIT_L(0); PG8_MMA(0, 1, At, B1); PG8_BAR;
            PG8_LDA(At, 1, 1); PG8_STAGE(PG8_SA(1, 0), a3, voffA);
            PG8_BAR; PG8_WAIT_L(0); PG8_MMA(1, 0, At, B0); PG8_BAR; PG8_SCHED;
            PG8_STAGE(PG8_SB(1, 1), b3 + hstep, voffB);
            PG8_WAIT_V(6); PG8_BAR; PG8_MMA(1, 1, At, B1); PG8_BAR;
        }
        PG8_STAMP();
        if constexpr (!Epi::AFTER_DRAIN) { E(acc, cur, wr, wc, fr, fq); S.done(cur); }
        PG8_STAMP();
        if (!has_next) break;
#pragma unroll
        for (int a = 0; a < 2; ++a)
#pragma unroll
            for (int b = 0; b < 2; ++b)
#pragma unroll
                for (int m = 0; m < 4; ++m)
#pragma unroll
                    for (int n = 0; n < 2; ++n) acc[a][b][m][n] = (f32x4){0.f, 0.f, 0.f, 0.f};
        cur = nxt; cA = nA; cB = nB; ++ui;
    }
    PG8_WAIT_V(0);
    if (wr == 0) PG8_BAR;
    PG8_BAR;
    if constexpr (Epi::AFTER_DRAIN) { E.fused(acc, cur, wr, wc, fr, fq, lds, wid, lane); S.done(cur); }
    PG8_STAMP();
    if (STAMP && wid == 0) { stamps[lane] = lane < nts ? (((unsigned long long)(unsigned)ts_hi << 32) | (unsigned)ts_lo) : 0ull;
        if (lane == 62) stamps[62] = rt_entry; if (lane == 63) stamps[63] = (unsigned long long)wall_clock64(); }
#undef PG8_STAMP
#undef PG8_SA
#undef PG8_SB
#undef PG8_STAGE
#undef PG8_LDA
#undef PG8_LDB
#undef PG8_MMA
#undef PG8_WAIT_V
#undef PG8_WAIT_L
#undef PG8_BAR
#undef PG8_SCHED
}
}

template <class Epi> __device__ __forceinline__ void ph_gemm(const bf16_t* A, const bf16_t* Bt, int M, int N, int K, const Epi& E) {
    pg8::Gemm g; g.A = A; g.Bt = Bt; g.M = M; g.N = N; g.K = K;
    pg8::StaticOrder S; S.init(M, N, nblk_(), bid_());
    pg8::gemm_phase<Epi, pg8::StaticOrder, false>((PG8_LAS unsigned char*)dynsmem, g, S, E, nullptr, tid_());
}

__device__ __forceinline__ int pcol_to_orig(int c) {
    if (c < 768) return c;
    if (c < 1536) return c - 768 + 772;
    if (c < 1792) return c - 1536 + 1548;
    if (c < 1920) return c - 1792 + 1804;
    if (c < 2048) return c - 1920 + 1932;
    if (c < 2304) return c - 2048 + 2060;
    if (c < 2560) return c - 2304 + 2332;
    if (c < 2816) return c - 2560 + 2588;
    if (c < 2880) return c - 2816 + 2844;
    if (c < 2944) return c - 2880 + 2908;
    if (c < 3200) return c - 2944 + 2972;
    if (c < 3232) return c - 3200 + 3228;
    if (c < 3248) return c - 3232 + 2316;
    if (c < 3256) return c - 3248 + 3260;
    if (c < 3260) return c - 3256 + 768;
    if (c < 3264) return c - 3260 + 1540;
    if (c < 3268) return c - 3264 + 1544;
    return -1;
}
__device__ __forceinline__ void wtrans_job(const float* W, int K, int ldw, bf16_t* Wt, int Npad, bool mapped, float* tile) {
    const int tid = tid_();
    const int tn = Npad / 64, tk = K / 64;
    for (int t = bid_(); t < tn * tk; t += nblk_()) {
        const int n0 = (t / tk) * 64, k0 = (t % tk) * 64;
        __syncthreads();
        for (int idx = tid; idx < 4096; idx += 512) {
            const int kk = idx >> 6, nn = idx & 63;
            const int col = mapped ? pcol_to_orig(n0 + nn) : (n0 + nn);
            tile[kk * 65 + nn] = col >= 0 ? W[(size_t)(k0 + kk) * ldw + col] : 0.f;
        }
        __syncthreads();
        for (int idx = tid; idx < 4096; idx += 512) {
            const int nn = idx >> 6, kk = idx & 63;
            Wt[(size_t)(n0 + nn) * K + k0 + kk] = f2bf(tile[kk * 65 + nn]);
        }
    }
}
__device__ __forceinline__ void ph_weight_prep(const Ctx& p, float* sm) {
#pragma unroll 1
    for (int j = 0; j < 7 * DEPTH; ++j) {
        const int l = j / 7, w = j % 7;
        const float* W; int K, ldw, Npad; bf16_t* Wt; bool mapped = false;
        if (w == 0) { W = pin_(3) + (size_t)l * DM * 3268; K = DM; ldw = 3268; Npad = LDP; Wt = (bf16_t*)(pws_() + WT_IN) + (size_t)l * LDP * DM; mapped = true; }
        else if (w == 1) { W = pin_(20) + (size_t)l * DM * DM; K = DM; ldw = DM; Npad = DM; Wt = (bf16_t*)(pws_() + WT_OUT) + (size_t)l * DM * DM; }
        else if (w == 2) { W = pin_(23) + (size_t)l * DM * 256; K = DM; ldw = 256; Npad = 256; Wt = (bf16_t*)(pws_() + WT_XQ) + (size_t)l * 256 * DM; }
        else if (w == 3) { W = pin_(24) + (size_t)l * DM * 256; K = DM; ldw = 256; Npad = 256; Wt = (bf16_t*)(pws_() + WT_XK) + (size_t)l * 256 * DM; }
        else if (w == 4) { W = pin_(25) + (size_t)l * DM * 256; K = DM; ldw = 256; Npad = 256; Wt = (bf16_t*)(pws_() + WT_XV) + (size_t)l * 256 * DM; }
        else if (w == 5) { W = pin_(26) + (size_t)l * 256 * DM; K = 256; ldw = DM; Npad = DM; Wt = (bf16_t*)(pws_() + WT_XO) + (size_t)l * DM * 256; }
        else { W = pin_(30) + (size_t)l * DM * DM; K = DM; ldw = DM; Npad = DM; Wt = (bf16_t*)(pws_() + WT_PQ) + (size_t)l * DM * DM; }
        wtrans_job(W, K, ldw, Wt, Npad, mapped, sm);
    }
}

__device__ __forceinline__ void ph_rmsnorm(const float* __restrict__ x, const float* __restrict__ g, bf16_t* __restrict__ out, int rows) {
    const int lane = tid_() & 63;
    for (int r = gwave(); r < rows; r += nwaves()) {
        const float4* xr = (const float4*)(x + (size_t)r * DM);
        float4 v[4]; float ss = 0.f;
#pragma unroll
        for (int i = 0; i < 4; ++i) { v[i] = xr[lane + 64 * i]; ss += v[i].x * v[i].x + v[i].y * v[i].y + v[i].z * v[i].z + v[i].w * v[i].w; }
        ss = wave_sum(ss);
        const float rs = rsqrtf(ss * (1.f / DM) + EPS);
#pragma unroll
        for (int i = 0; i < 4; ++i) {
            const float4 gg = ((const float4*)g)[lane + 64 * i];
            ushort4 o; o.x = f2bf(v[i].x * rs * gg.x); o.y = f2bf(v[i].y * rs * gg.y); o.z = f2bf(v[i].z * rs * gg.z); o.w = f2bf(v[i].w * rs * gg.w);
            *(ushort4*)(out + (size_t)r * DM + (size_t)(lane + 64 * i) * 4) = o;
        }
    }
}

template <int OUTMODE>
__device__ __forceinline__ void ph_sgemm(const bf16_t* __restrict__ A, int lda, const float* __restrict__ B, int ldb, void* Cv, int ldc, const float* R, int ldr,
                         int M, int N, int K, float* smem) {
    float* As = smem;
    float* Bs = smem + 16 * 132;
    const int tid = tid_(), tx = tid & 31, ty = tid >> 5;
    const int ntn = N / 128, ntiles = (M / 128) * ntn;
    for (int tile = bid_(); tile < ntiles; tile += nblk_()) {
        const int tm = tile / ntn, tn = tile % ntn;
        float acc[8][4];
#pragma unroll
        for (int i = 0; i < 8; ++i)
#pragma unroll
            for (int j = 0; j < 4; ++j) acc[i][j] = 0.f;
        const int arow = tid >> 2, akq = (tid & 3) * 4;
        const int bk = tid >> 5, bn = (tid & 31) * 4;
        for (int k0 = 0; k0 < K; k0 += 16) {
            const ushort4 av = *(const ushort4*)(A + (size_t)(tm * 128 + arow) * lda + k0 + akq);
            const float4 bv = *(const float4*)(B + (size_t)(k0 + bk) * ldb + tn * 128 + bn);
            __syncthreads();
            As[(akq + 0) * 132 + arow] = bf2f(av.x); As[(akq + 1) * 132 + arow] = bf2f(av.y);
            As[(akq + 2) * 132 + arow] = bf2f(av.z); As[(akq + 3) * 132 + arow] = bf2f(av.w);
            *(float4*)(Bs + bk * 132 + bn) = bv;
            __syncthreads();
#pragma unroll
            for (int k = 0; k < 16; ++k) {
                const float4 a0 = *(const float4*)(As + k * 132 + ty * 8), a1 = *(const float4*)(As + k * 132 + ty * 8 + 4);
                const float4 b = *(const float4*)(Bs + k * 132 + tx * 4);
                const float a[8] = {a0.x, a0.y, a0.z, a0.w, a1.x, a1.y, a1.z, a1.w};
#pragma unroll
                for (int i = 0; i < 8; ++i) { acc[i][0] += a[i] * b.x; acc[i][1] += a[i] * b.y; acc[i][2] += a[i] * b.z; acc[i][3] += a[i] * b.w; }
            }
        }
#pragma unroll
        for (int i = 0; i < 8; ++i) {
            const size_t row = (size_t)tm * 128 + ty * 8 + i; const int col = tn * 128 + tx * 4;
            if (OUTMODE == 0) {
                ushort4 o; o.x = f2bf(acc[i][0]); o.y = f2bf(acc[i][1]); o.z = f2bf(acc[i][2]); o.w = f2bf(acc[i][3]);
                *(ushort4*)((bf16_t*)Cv + row * ldc + col) = o;
            } else if (OUTMODE == 1) {
                *(float4*)((float*)Cv + row * ldc + col) = make_float4(acc[i][0], acc[i][1], acc[i][2], acc[i][3]);
            } else {
                const float4 r = *(const float4*)(R + row * ldr + col);
                *(float4*)((float*)Cv + row * ldc + col) = make_float4(r.x + acc[i][0], r.y + acc[i][1], r.z + acc[i][2], r.w + acc[i][3]);
            }
        }
    }
}

#define WS_HS WS_H
#define WS_VG WS_YPRE
#define WS_DEC (WS_YPRE + (size_t)MTOK * 256 * 2)

__device__ __forceinline__ float quad_sum(float v) {
    v += __int_as_float(__builtin_amdgcn_mov_dpp(__float_as_int(v), 0xB1, 0xF, 0xF, true));
    v += __int_as_float(__builtin_amdgcn_mov_dpp(__float_as_int(v), 0x4E, 0xF, 0xF, true));
    return v;
}
__device__ __forceinline__ float bflo(unsigned w) { return __uint_as_float(w << 16); }
__device__ __forceinline__ float bfhi(unsigned w) { return __uint_as_float(w & 0xffff0000u); }

__device__ __forceinline__ float oct_sum(float v) {
    v += __int_as_float(__builtin_amdgcn_mov_dpp(__float_as_int(v), 0xB1, 0xF, 0xF, true));
    v += __int_as_float(__builtin_amdgcn_mov_dpp(__float_as_int(v), 0x4E, 0xF, 0xF, true));
    v += __int_as_float(__builtin_amdgcn_mov_dpp(__float_as_int(v), 0x141, 0xF, 0xF, true));
    return v;
}
__device__ __forceinline__ void unpack8(const uint4 r, float (&o)[8]) {
    o[0] = bflo(r.x); o[1] = bfhi(r.x); o[2] = bflo(r.y); o[3] = bfhi(r.y); o[4] = bflo(r.z); o[5] = bfhi(r.z); o[6] = bflo(r.w); o[7] = bfhi(r.w);
}
__device__ __forceinline__ uint4 pack8(const float (&v)[8]) {
    uint4 o; o.x = pk_bf16(v[0], v[1]); o.y = pk_bf16(v[2], v[3]); o.z = pk_bf16(v[4], v[5]); o.w = pk_bf16(v[6], v[7]); return o;
}
__device__ __forceinline__ void load8f(const float* p, float (&o)[8]) {
    const float4 a = *(const float4*)p, b = *(const float4*)(p + 4);
    o[0] = a.x; o[1] = a.y; o[2] = a.z; o[3] = a.w; o[4] = b.x; o[5] = b.y; o[6] = b.z; o[7] = b.w;
}
__device__ __forceinline__ void conv8(const bf16_t* P, size_t tok, int t, int pcol, const float* w, int ldw, int cc, float (&acc)[8]) {
#pragma unroll
    for (int j = 0; j < 4; ++j) {
        if (t - 3 + j >= 0) {
            float xv[8], wv[8];
            unpack8(*(const uint4*)(P + (tok - (size_t)(3 - j)) * LDP + pcol), xv);
            load8f(w + j * ldw + cc, wv);
#pragma unroll
            for (int i = 0; i < 8; ++i) acc[i] = __builtin_fmaf(wv[i], xv[i], acc[i]);
        }
    }
}
__device__ __forceinline__ void conv8r(const uint4 (&xt)[4], int t, const float* w, int ldw, int cc, float (&acc)[8]) {
#pragma unroll
    for (int j = 0; j < 4; ++j) {
        float xv[8], wv[8];
        unpack8(xt[j], xv);
        load8f(w + j * ldw + cc, wv);
        const float m = (t - 3 + j >= 0) ? 1.f : 0.f;
#pragma unroll
        for (int i = 0; i < 8; ++i) acc[i] = __builtin_fmaf(wv[i] * m, xv[i], acc[i]);
    }
}
__device__ __forceinline__ void ph_scan_prep(const Ctx& p, int l) {
    const bf16_t* P = (const bf16_t*)(pws_() + WS_P);
    bf16_t* HS = (bf16_t*)(pws_() + WS_HS);
    bf16_t* VG = (bf16_t*)(pws_() + WS_VG);
    float* DEC = (float*)(pws_() + WS_DEC);
    float* SC = (float*)(pws_() + WS_SC);
    const float* scw = pin_(4) + (size_t)l * 4 * 512;
    const float* scb = pin_(5) + (size_t)l * 512;
    const float* gcw = pin_(10) + (size_t)l * 4 * 768;
    const float* wg = pin_(14) + (size_t)l * 16 * 128;
    const float* bg = pin_(15) + (size_t)l * 128;
    const int lane = tid_() & 63;
    const int hsc = lane & 3, wsc = (lane >> 2) & 3;
    const float k_dtb = pin_(6)[l * 4 + hsc], k_alog = __expf(pin_(7)[l * 4 + hsc]), k_galog = __expf(pin_(11)[l * 4 + hsc]), k_gdtb = pin_(12)[l * 4 + hsc];
    const int sccol = wsc < 2 ? PC_DT + hsc : (wsc == 2 ? PC_GA + hsc : PC_GB + hsc);
    for (int tok = gwave(); tok < MTOK; tok += nwaves()) {
        const int t = tok % SEQ;
        const size_t row = (size_t)tok * LDP;
        uint4 xa[4], xq[4], xv4[4];
#pragma unroll
        for (int j = 0; j < 4; ++j) {
            const size_t rj = (t - 3 + j >= 0) ? row - (size_t)(3 - j) * LDP : row;
            xa[j] = *(const uint4*)(P + rj + PC_XBC + 8 * lane);
            xq[j] = *(const uint4*)(P + rj + PC_GQKV + 8 * lane);
            xv4[j] = *(const uint4*)(P + rj + PC_GQKV + 512 + 8 * (lane & 31));
        }
        const uint4 gl0 = *(const uint4*)(P + row + PC_GLR), gl1 = *(const uint4*)(P + row + PC_GLR + 8);
        const float scraw = bf2f(P[row + sccol]);
        {
            float acc[8];
            load8f(scb + 8 * lane, acc);
            conv8r(xa, t, scw, 512, 8 * lane, acc);
#pragma unroll
            for (int i = 0; i < 8; ++i) acc[i] = silu_f(acc[i]);
            *(uint4*)(HS + (size_t)tok * 1024 + 8 * lane) = pack8(acc);
        }
        {
            float acc[8];
#pragma unroll
            for (int i = 0; i < 8; ++i) acc[i] = 0.f;
            conv8r(xq, t, gcw, 768, 8 * lane, acc);
            float ss = 0.f;
#pragma unroll
            for (int i = 0; i < 8; ++i) { acc[i] = silu_f(acc[i]); ss += acc[i] * acc[i]; }
            ss = oct_sum(ss);
            const float sc = rsqrtf(ss + EPS) * (lane < 32 ? 0.125f : 1.f);
#pragma unroll
            for (int i = 0; i < 8; ++i) acc[i] *= sc;
            *(uint4*)(HS + (size_t)tok * 1024 + 512 + 8 * lane) = pack8(acc);
        }
        {
            float acc[8];
#pragma unroll
            for (int i = 0; i < 8; ++i) acc[i] = 0.f;
            conv8r(xv4, t, gcw, 768, 512 + 8 * (lane & 31), acc);
#pragma unroll
            for (int i = 0; i < 8; ++i) acc[i] = silu_f(acc[i]);
            if (lane < 32) *(uint4*)(VG + (size_t)tok * 256 + 8 * lane) = pack8(acc);
        }
        {
            float v;
            if (wsc < 2) { const float dt = softplus_f(scraw + k_dtb); v = wsc == 0 ? dt : __expf(-dt * k_alog); }
            else if (wsc == 2) v = __expf(-k_galog * softplus_f(scraw + k_gdtb));
            else v = sigmoid_f(scraw);
            if (lane < 16) SC[(size_t)tok * 16 + lane] = v;
        }
        {
            float gl[16];
            { float a8[8], b8[8]; unpack8(gl0, a8); unpack8(gl1, b8);
#pragma unroll
              for (int i = 0; i < 8; ++i) { gl[i] = a8[i]; gl[8 + i] = b8[i]; } }
#pragma unroll
            for (int i = 0; i < 2; ++i) {
                const int c = lane + 64 * i;
                float acc = bg[c];
#pragma unroll
                for (int r = 0; r < 16; ++r) acc = __builtin_fmaf(gl[r], wg[r * 128 + c], acc);
                DEC[(size_t)tok * 128 + c] = __expf(logsigmoid_f(acc) * (1.f / 16.f));
            }
        }
    }
}

#define SCAN_LDS_WAVE 4608
typedef float f2_t __attribute__((ext_vector_type(2)));
__device__ __forceinline__ f2_t mk2(float a, float b) { f2_t r; r.x = a; r.y = b; return r; }
__device__ __forceinline__ void st8f(char* dst, const uint4 v) {
    *(float4*)dst = make_float4(bflo(v.x), bfhi(v.x), bflo(v.y), bfhi(v.y));
    *(float4*)(dst + 16) = make_float4(bflo(v.z), bfhi(v.z), bflo(v.w), bfhi(v.w));
}
__device__ __forceinline__ void ph_scans(const Ctx& p, int l, float* smem) {
    const bf16_t* P = (const bf16_t*)(pws_() + WS_P);
    const bf16_t* HS = (const bf16_t*)(pws_() + WS_HS);
    const bf16_t* VG = (const bf16_t*)(pws_() + WS_VG);
    const float* DEC = (const float*)(pws_() + WS_DEC);
    const float* SC = (const float*)(pws_() + WS_SC);
    bf16_t* Y = (bf16_t*)(pws_() + WS_Y);
    const int tid = tid_(), lane = tid & 63, wave = tid >> 6;
    if (nblk_() != 256) return;
    const int role = wave < 2 ? 0 : (wave < 6 ? 1 : 2);
    const int idx = (role == 0 ? wave : (role == 1 ? wave - 2 : wave - 6)) * 256 + bid_();
    const int bh = role == 1 ? (idx >> 3) : (idx >> 2), b = bh >> 2, h = bh & 3;
    const int colbase = role == 1 ? (idx & 7) * 8 : (idx & 3) * 16;
    const int cl = role == 1 ? (lane >> 3) : (lane >> 2);
    const int col = colbase + cl;
    const int sq = role == 1 ? (lane & 7) : (lane & 3);
    const size_t tb = (size_t)b * SEQ;
    bf16_t* dummy = (bf16_t*)(pws_() + WS_DUMMY) + (tid & 511) * 8;
    char* lw = (char*)smem + wave * SCAN_LDS_WAVE;
    char* lrow = lw;
    char* lcol = lw + 4096;
    float* lsc = (float*)(lw + 4352);
    const int fs = lane >> 3, fp = lane & 7;
    if (role == 0) {
        const int g = h >> 1;
        const float Dh = pin_(8)[l * 4 + h];
        uint4 f0, f1; unsigned fc = 0u; float fsc = 0.f;
        f2_t st[8];
#pragma unroll
        for (int i = 0; i < 8; ++i) st[i] = mk2(0.f, 0.f);
        auto fetch = [&](int t0) {
            const size_t tok = tb + t0 + fs;
            const bf16_t* src = HS + tok * 1024 + (fp < 4 ? 256 + g * 64 + fp * 16 : 384 + g * 64 + (fp - 4) * 16);
            f0 = *(const uint4*)src; f1 = *(const uint4*)(src + 8);
            fc = *(const unsigned*)(HS + tok * 1024 + h * 64 + colbase + fp * 2);
            if (lane < 16) fsc = SC[(tb + t0 + (lane >> 1)) * 16 + (lane & 1) * 4 + h];
        };
        fetch(0);
        for (int t0 = 0; t0 < SEQ; t0 += 8) {
            st8f(lrow + fs * 512 + fp * 64, f0); st8f(lrow + fs * 512 + fp * 64 + 32, f1);
            *(unsigned*)(lcol + fs * 32 + fp * 4) = fc;
            if (lane < 16) lsc[lane] = fsc;
            if (t0 + 8 < SEQ) fetch(t0 + 8);
#pragma unroll
            for (int i = 0; i < 8; ++i) {
                const char* rb = lrow + i * 512 + sq * 64;
                const float4 b0 = *(const float4*)rb, b1 = *(const float4*)(rb + 16), b2 = *(const float4*)(rb + 32), b3 = *(const float4*)(rb + 48);
                const float4 c0 = *(const float4*)(rb + 256), c1 = *(const float4*)(rb + 272), c2 = *(const float4*)(rb + 288), c3 = *(const float4*)(rb + 304);
                const float xv = bf2f(*(const bf16_t*)(lcol + i * 32 + cl * 2));
                const float2 sc2 = *(const float2*)(lsc + i * 2);
                const float xdt = xv * sc2.x;
                const f2_t xd2 = mk2(xdt, xdt), dA2 = mk2(sc2.y, sc2.y);
                const f2_t bb[8] = {mk2(b0.x, b0.y), mk2(b0.z, b0.w), mk2(b1.x, b1.y), mk2(b1.z, b1.w), mk2(b2.x, b2.y), mk2(b2.z, b2.w), mk2(b3.x, b3.y), mk2(b3.z, b3.w)};
                const f2_t cc[8] = {mk2(c0.x, c0.y), mk2(c0.z, c0.w), mk2(c1.x, c1.y), mk2(c1.z, c1.w), mk2(c2.x, c2.y), mk2(c2.z, c2.w), mk2(c3.x, c3.y), mk2(c3.z, c3.w)};
                f2_t ya = mk2(0.f, 0.f), yb = mk2(0.f, 0.f);
#pragma unroll
                for (int q = 0; q < 8; q += 2) {
                    st[q] = st[q] * dA2 + xd2 * bb[q]; st[q + 1] = st[q + 1] * dA2 + xd2 * bb[q + 1];
                    ya = cc[q] * st[q] + ya; yb = cc[q + 1] * st[q + 1] + yb;
                }
                const f2_t ys = ya + yb;
                const float y = quad_sum(ys.x + ys.y);
                *(sq == 0 ? Y + (tb + t0 + i) * DM + h * 64 + col : dummy + i) = f2bf(y + Dh * xv);
                if (i & 1) __builtin_amdgcn_sched_barrier(0);
            }
        }
    } else if (role == 1) {
        uint4 f0, f1; unsigned fc = 0u; float fsc = 0.f;
        f2_t S[4];
#pragma unroll
        for (int i = 0; i < 4; ++i) S[i] = mk2(0.f, 0.f);
        auto fetch = [&](int t0) {
            const size_t tok = tb + t0 + fs;
            const bf16_t* src = HS + tok * 1024 + (fp < 4 ? 512 + h * 64 + fp * 16 : 768 + h * 64 + (fp - 4) * 16);
            f0 = *(const uint4*)src; f1 = *(const uint4*)(src + 8);
            if (fp < 4) fc = *(const unsigned*)(VG + tok * 256 + h * 64 + colbase + fp * 2);
            if (lane < 16) fsc = SC[(tb + t0 + (lane >> 1)) * 16 + 8 + (lane & 1) * 4 + h];
        };
        fetch(0);
        for (int t0 = 0; t0 < SEQ; t0 += 8) {
            st8f(lrow + fs * 512 + fp * 64, f0); st8f(lrow + fs * 512 + fp * 64 + 32, f1);
            if (fp < 4) *(unsigned*)(lcol + fs * 32 + fp * 4) = fc;
            if (lane < 16) lsc[lane] = fsc;
            if (t0 + 8 < SEQ) fetch(t0 + 8);
#pragma unroll
            for (int i = 0; i < 8; ++i) {
                const char* rb = lrow + i * 512 + sq * 32;
                const float4 q0 = *(const float4*)rb, q1 = *(const float4*)(rb + 16);
                const float4 k0 = *(const float4*)(rb + 256), k1 = *(const float4*)(rb + 272);
                const float vv = bf2f(*(const bf16_t*)(lcol + i * 32 + cl * 2));
                const float2 sc2 = *(const float2*)(lsc + i * 2);
                const f2_t al2 = mk2(sc2.x, sc2.x);
                const f2_t kk[4] = {mk2(k0.x, k0.y), mk2(k0.z, k0.w), mk2(k1.x, k1.y), mk2(k1.z, k1.w)};
                const f2_t qq[4] = {mk2(q0.x, q0.y), mk2(q0.z, q0.w), mk2(q1.x, q1.y), mk2(q1.z, q1.w)};
                f2_t ra = mk2(0.f, 0.f), rb2 = mk2(0.f, 0.f);
#pragma unroll
                for (int q = 0; q < 4; q += 2) {
                    S[q] = S[q] * al2; S[q + 1] = S[q + 1] * al2;
                    ra = S[q] * kk[q] + ra; rb2 = S[q + 1] * kk[q + 1] + rb2;
                }
                const f2_t rs = ra + rb2;
                const float r = oct_sum(rs.x + rs.y);
                const float vn = sc2.y * (vv - r);
                const f2_t vn2 = mk2(vn, vn);
                f2_t oa2 = mk2(0.f, 0.f), ob2 = mk2(0.f, 0.f);
#pragma unroll
                for (int q = 0; q < 4; q += 2) {
                    S[q] = kk[q] * vn2 + S[q]; S[q + 1] = kk[q + 1] * vn2 + S[q + 1];
                    oa2 = S[q] * qq[q] + oa2; ob2 = S[q + 1] * qq[q + 1] + ob2;
                }
                const f2_t os = oa2 + ob2;
                const float ov = oct_sum(os.x + os.y);
                *(sq == 0 ? Y + (tb + t0 + i) * DM + 256 + h * 64 + col : dummy + i) = f2bf(ov);
                if (i & 1) __builtin_amdgcn_sched_barrier(0);
            }
        }
    } else {
        uint4 f0, f1; unsigned fc = 0u;
        f2_t S[4];
#pragma unroll
        for (int i = 0; i < 4; ++i) S[i] = mk2(0.f, 0.f);
        auto fetch = [&](int t0) {
            const size_t tok = tb + t0 + fs;
            if (fp < 4) { const float* src = DEC + tok * 128 + h * 32 + fp * 8; f0 = *(const uint4*)src; f1 = *(const uint4*)(src + 4); }
            else { const bf16_t* src = P + tok * LDP + (fp < 6 ? PC_LK + h * 32 + (fp - 4) * 16 : PC_LQ + h * 32 + (fp - 6) * 16); f0 = *(const uint4*)src; f1 = *(const uint4*)(src + 8); }
            fc = *(const unsigned*)(P + tok * LDP + PC_LV + h * 64 + colbase + fp * 2);
        };
        fetch(0);
        for (int t0 = 0; t0 < SEQ; t0 += 8) {
            if (fp < 4) { *(uint4*)(lrow + fs * 512 + fp * 32) = f0; *(uint4*)(lrow + fs * 512 + fp * 32 + 16) = f1; }
            else { st8f(lrow + fs * 512 + 128 + (fp - 4) * 64, f0); st8f(lrow + fs * 512 + 128 + (fp - 4) * 64 + 32, f1); }
            *(unsigned*)(lcol + fs * 32 + fp * 4) = fc;
            if (t0 + 8 < SEQ) fetch(t0 + 8);
#pragma unroll
            for (int i = 0; i < 8; ++i) {
                const char* rb = lrow + i * 512 + sq * 32;
                const float4 d0 = *(const float4*)rb, d1 = *(const float4*)(rb + 16);
                const float4 k0 = *(const float4*)(rb + 128), k1 = *(const float4*)(rb + 144);
                const float4 q0 = *(const float4*)(rb + 256), q1 = *(const float4*)(rb + 272);
                const float vv = bf2f(*(const bf16_t*)(lcol + i * 32 + cl * 2));
                const f2_t v2 = mk2(vv, vv);
                const f2_t dd[4] = {mk2(d0.x, d0.y), mk2(d0.z, d0.w), mk2(d1.x, d1.y), mk2(d1.z, d1.w)};
                const f2_t kk[4] = {mk2(k0.x, k0.y), mk2(k0.z, k0.w), mk2(k1.x, k1.y), mk2(k1.z, k1.w)};
                const f2_t qq[4] = {mk2(q0.x, q0.y), mk2(q0.z, q0.w), mk2(q1.x, q1.y), mk2(q1.z, q1.w)};
                f2_t oa2 = mk2(0.f, 0.f), ob2 = mk2(0.f, 0.f);
#pragma unroll
                for (int q = 0; q < 4; q += 2) {
                    S[q] = dd[q] * S[q] + kk[q] * v2; S[q + 1] = dd[q + 1] * S[q + 1] + kk[q + 1] * v2;
                    oa2 = S[q] * qq[q] + oa2; ob2 = S[q + 1] * qq[q + 1] + ob2;
                }
                const f2_t os = oa2 + ob2;
                const float ov = quad_sum(os.x + os.y);
                *(sq == 0 ? Y + (tb + t0 + i) * DM + 512 + h * 64 + col : dummy + i) = f2bf(ov * 0.17677669529663687f);
                if (i & 1) __builtin_amdgcn_sched_barrier(0);
            }
        }
    }
}

__device__ __forceinline__ void ph_mixer_finish(const Ctx& p, int l) {
    const bf16_t* P = (const bf16_t*)(pws_() + WS_P);
    bf16_t* Y = (bf16_t*)(pws_() + WS_Y);
    const float* sn = pin_(9) + (size_t)l * 256;
    const float* gn = pin_(13) + (size_t)l * 64;
    const float* ln = pin_(16) + (size_t)l * 64;
    const int lane = tid_() & 63;
    for (int tok = gwave(); tok < MTOK; tok += nwaves()) {
        const size_t row = (size_t)tok * LDP;
        {
            float v[8], gt[8], gw[8];
            unpack8(*(const uint4*)(Y + (size_t)tok * DM + 8 * lane), v);
            unpack8(*(const uint4*)(P + row + (lane < 32 ? PC_Z + 8 * lane : PC_GG + 8 * (lane - 32))), gt);
            load8f(lane < 32 ? sn + 8 * lane : gn + 8 * (lane & 7), gw);
            float ss = 0.f;
            if (lane < 32) {
#pragma unroll
                for (int i = 0; i < 8; ++i) { v[i] *= silu_f(gt[i]); ss += v[i] * v[i]; }
            } else {
#pragma unroll
                for (int i = 0; i < 8; ++i) ss += v[i] * v[i];
            }
            const float s8 = oct_sum(ss);
            float s32 = s8 + __int_as_float(__builtin_amdgcn_mov_dpp(__float_as_int(s8), 0x140, 0xF, 0xF, true));
            s32 += __shfl_xor(s32, 16, 64);
            const float rs = lane < 32 ? rsqrtf(s32 * (1.f / 256.f) + EPS) : rsqrtf(s8 * (1.f / 64.f) + EPS);
            float o[8];
#pragma unroll
            for (int i = 0; i < 8; ++i) o[i] = lane < 32 ? v[i] * rs * gw[i] : v[i] * rs * gw[i] * silu_f(gt[i]);
            *(uint4*)(Y + (size_t)tok * DM + 8 * lane) = pack8(o);
        }
        if (lane < 32) {
            float v[8], gt[8], gw[8];
            unpack8(*(const uint4*)(Y + (size_t)tok * DM + 512 + 8 * lane), v);
            unpack8(*(const uint4*)(P + row + PC_LR + 8 * lane), gt);
            load8f(ln + 8 * (lane & 7), gw);
            float ss = 0.f;
#pragma unroll
            for (int i = 0; i < 8; ++i) ss += v[i] * v[i];
            const float rs = rsqrtf(oct_sum(ss) * (1.f / 64.f) + EPS);
            float o[8];
#pragma unroll
            for (int i = 0; i < 8; ++i) o[i] = v[i] * rs * gw[i] * silu_f(gt[i]);
            *(uint4*)(Y + (size_t)tok * DM + 512 + 8 * lane) = pack8(o);
        }
    }
}

typedef short bf16x8_t __attribute__((ext_vector_type(8)));
typedef float f32x4_t __attribute__((ext_vector_type(4)));
union BF8 { bf16x8_t v; uint4 u; unsigned w[4]; };


__device__ __forceinline__ void ph_dsa_prep(const Ctx& p, int l) {
    const bf16_t* P = (const bf16_t*)(pws_() + WS_P);
    bf16_t* qn = (bf16_t*)(pws_() + WS_QN);
    bf16_t* kn = (bf16_t*)(pws_() + WS_KN);
    bf16_t* ikn = (bf16_t*)(pws_() + WS_IKN);
    bf16_t* vt = (bf16_t*)(pws_() + WS_VT);
    const float* qg = pin_(17) + (size_t)l * 64;
    const float* kg = pin_(18) + (size_t)l * 64;
    const float* ig = pin_(19) + (size_t)l * 32;
    const int lane = tid_() & 63;
    const int pcol = lane < 40 ? PC_DQ + 8 * lane : PC_IK + 8 * (lane & 3);
    float gw[8];
    load8f(lane < 32 ? qg + 8 * (lane & 7) : (lane < 40 ? kg + 8 * (lane & 7) : ig + 8 * (lane & 3)), gw);
    for (int grp = gwave(); grp < MTOK / 8; grp += nwaves()) {
        const size_t tok0 = (size_t)grp * 8;
        const int b = (int)(tok0 / SEQ), t0 = (int)(tok0 % SEQ);
        unsigned short vv[8];
#pragma unroll
        for (int i = 0; i < 8; ++i) {
            const size_t row = (tok0 + i) * LDP;
            vv[i] = P[row + PC_DV + lane];
            if (lane < 44) {
                float v[8];
                unpack8(*(const uint4*)(P + row + pcol), v);
                float ss = 0.f;
#pragma unroll
                for (int q = 0; q < 8; ++q) ss += v[q] * v[q];
                const float s4 = ss + __int_as_float(__builtin_amdgcn_mov_dpp(__float_as_int(ss), 0xB1, 0xF, 0xF, true));
                const float s4b = s4 + __int_as_float(__builtin_amdgcn_mov_dpp(__float_as_int(s4), 0x4E, 0xF, 0xF, true));
                const float s8 = s4b + __int_as_float(__builtin_amdgcn_mov_dpp(__float_as_int(s4b), 0x141, 0xF, 0xF, true));
                const float rs = lane < 40 ? rsqrtf(s8 * (1.f / 64.f) + EPS) * (lane < 32 ? 0.125f : 1.f) : rsqrtf(s4b * (1.f / 32.f) + EPS);
                float o[8];
#pragma unroll
                for (int q = 0; q < 8; ++q) o[q] = v[q] * rs * gw[q];
                const uint4 pk = pack8(o);
                if (lane < 32) *(uint4*)(qn + (tok0 + i) * 256 + 8 * lane) = pk;
                else if (lane < 40) *(uint4*)(kn + (tok0 + i) * 64 + 8 * (lane - 32)) = pk;
                else *(uint4*)(ikn + (tok0 + i) * 32 + 8 * (lane - 40)) = pk;
            }
        }
        uint4 o; o.x = (unsigned)vv[0] | ((unsigned)vv[1] << 16); o.y = (unsigned)vv[2] | ((unsigned)vv[3] << 16);
        o.z = (unsigned)vv[4] | ((unsigned)vv[5] << 16); o.w = (unsigned)vv[6] | ((unsigned)vv[7] << 16);
        *(uint4*)(vt + ((size_t)b * 64 + lane) * SEQ + t0) = o;
    }
}

#define DSA_STRIDE 2052
__device__ __forceinline__ void ph_dsa_main(const Ctx& p, int l, float* smem) {
    const bf16_t* P = (const bf16_t*)(pws_() + WS_P);
    bf16_t* Y = (bf16_t*)(pws_() + WS_Y);
    const bf16_t* QN = (const bf16_t*)(pws_() + WS_QN);
    const bf16_t* KN = (const bf16_t*)(pws_() + WS_KN);
    const bf16_t* IKN = (const bf16_t*)(pws_() + WS_IKN);
    const bf16_t* VT = (const bf16_t*)(pws_() + WS_VT);
    unsigned* sc = (unsigned*)smem;
    float* part = smem;
    float* plsum = smem + 8 * 64 * 64;
    unsigned* thr = (unsigned*)(smem + 35000);
    const int tid = tid_(), lane = tid & 63, w = tid >> 6, qi = lane & 15, g = lane >> 4;
    for (int task = bid_(); task < MTOK / 16; task += nblk_()) {
        const int c = 31 - task / 128, b = (task >> 2) & 31, sub = task & 3;
        const int t0 = c * 64 + sub * 16, nk = (c + 1) * 64;
        const size_t tok0 = (size_t)b * SEQ + t0;
        const bool dosel = nk > 256;
        if (dosel) {
            BF8 iqf[8]; float wq[8];
#pragma unroll
            for (int h = 0; h < 8; ++h) {
                iqf[h].u = *(const uint4*)(P + (tok0 + qi) * LDP + PC_IQ + h * 32 + 8 * g);
                wq[h] = bf2f(P[(tok0 + qi) * LDP + PC_IW + h]) * 0.0625f;
            }
            for (int kt = w; kt < nk / 16; kt += 8) {
                const int s0 = kt * 16;
                BF8 ka; ka.u = *(const uint4*)(IKN + ((size_t)b * SEQ + s0 + qi) * 32 + 8 * g);
                float acc[4] = {0.f, 0.f, 0.f, 0.f};
#pragma unroll
                for (int h = 0; h < 8; ++h) {
                    const f32x4_t d = __builtin_amdgcn_mfma_f32_16x16x32_bf16(ka.v, iqf[h].v, (f32x4_t){0.f, 0.f, 0.f, 0.f}, 0, 0, 0);
#pragma unroll
                    for (int r = 0; r < 4; ++r) acc[r] = __builtin_fmaf(wq[h], fmaxf(d[r], 0.f), acc[r]);
                }
                uint4 kv; kv.x = ford(acc[0]); kv.y = ford(acc[1]); kv.z = ford(acc[2]); kv.w = ford(acc[3]);
                *(uint4*)(sc + qi * DSA_STRIDE + s0 + 4 * g) = kv;
            }
        }
        __syncthreads();
        if (dosel) {
            const int nj = nk >> 6;
#pragma unroll 1
            for (int qq = 0; qq < 2; ++qq) {
                const int q = 2 * w + qq;
                unsigned kreg[32];
#pragma unroll
                for (int j = 0; j < 32; ++j) kreg[j] = (j < nj) ? sc[q * DSA_STRIDE + j * 64 + lane] : 0u;
                unsigned T = 0u; bool exact = false;
                for (int bit = 31; bit >= 0; --bit) {
                    const unsigned cand = T | (1u << bit);
                    int cnt = 0;
#pragma unroll
                    for (int j = 0; j < 32; ++j) cnt += __popcll(__ballot(kreg[j] >= cand));
                    if (cnt >= 256) { T = cand; if (cnt == 256) { exact = true; break; } }
                }
                int cut = 0x7fffffff;
                if (!exact) {
                    int cgt = 0, ceq = 0;
#pragma unroll
                    for (int j = 0; j < 32; ++j) { cgt += __popcll(__ballot(kreg[j] > T)); ceq += __popcll(__ballot(kreg[j] == T)); }
                    int need = 256 - cgt;
                    if (ceq > need) {
                        bool found = false;
#pragma unroll
                        for (int j = 0; j < 32; ++j) {
                            const unsigned long long m = __ballot(kreg[j] == T);
                            const int cj = __popcll(m);
                            if (!found) {
                                if (need <= cj) { for (int bpos = 0; bpos < 64; ++bpos) if ((m >> bpos) & 1ull) { if (--need == 0) { cut = j * 64 + bpos; break; } } found = true; }
                                else need -= cj;
                            }
                        }
                    }
                }
                if (lane == 0) { thr[q] = T; thr[16 + q] = (unsigned)cut; }
            }
        }
        __syncthreads();
        unsigned Tq = 0u; int cutq = 0x7fffffff;
        if (dosel) { Tq = thr[qi]; cutq = (int)thr[16 + qi]; }
        f32x4_t oacc[4][4]; float lsum[4];
#pragma unroll
        for (int h = 0; h < 4; ++h) { lsum[h] = 0.f;
#pragma unroll
            for (int dt = 0; dt < 4; ++dt) oacc[h][dt] = (f32x4_t){0.f, 0.f, 0.f, 0.f}; }
        const int krow = 8 * (qi >> 2) + (qi & 3);
        for (int st = w; st < nk / 32; st += 8) {
            const int s0 = st * 32;
            BF8 ka[2][2], va[4];
#pragma unroll
            for (int t = 0; t < 2; ++t)
#pragma unroll
                for (int s2 = 0; s2 < 2; ++s2) ka[t][s2].u = *(const uint4*)(KN + ((size_t)b * SEQ + s0 + krow + 4 * t) * 64 + 32 * s2 + 8 * g);
#pragma unroll
            for (int dt = 0; dt < 4; ++dt) va[dt].u = *(const uint4*)(VT + ((size_t)b * 64 + 16 * dt + qi) * SEQ + s0 + 8 * g);
            float mk[8];
            if (dosel) {
                const uint4 k0 = *(const uint4*)(sc + qi * DSA_STRIDE + s0 + 8 * g), k1 = *(const uint4*)(sc + qi * DSA_STRIDE + s0 + 8 * g + 4);
                const unsigned kk[8] = {k0.x, k0.y, k0.z, k0.w, k1.x, k1.y, k1.z, k1.w};
#pragma unroll
                for (int j = 0; j < 8; ++j) mk[j] = (kk[j] > Tq || (kk[j] == Tq && (s0 + 8 * g + j) <= cutq)) ? 1.f : 0.f;
            } else {
#pragma unroll
                for (int j = 0; j < 8; ++j) mk[j] = 1.f;
            }
#pragma unroll
            for (int h = 0; h < 4; ++h) {
                BF8 q0, q1;
                q0.u = *(const uint4*)(QN + (tok0 + qi) * 256 + h * 64 + 8 * g);
                q1.u = *(const uint4*)(QN + (tok0 + qi) * 256 + h * 64 + 32 + 8 * g);
                f32x4_t sacc[2];
#pragma unroll
                for (int t = 0; t < 2; ++t) {
                    sacc[t] = __builtin_amdgcn_mfma_f32_16x16x32_bf16(ka[t][0].v, q0.v, (f32x4_t){0.f, 0.f, 0.f, 0.f}, 0, 0, 0);
                    sacc[t] = __builtin_amdgcn_mfma_f32_16x16x32_bf16(ka[t][1].v, q1.v, sacc[t], 0, 0, 0);
                }
                float pe[8];
#pragma unroll
                for (int t = 0; t < 2; ++t)
#pragma unroll
                    for (int r = 0; r < 4; ++r) { pe[4 * t + r] = __expf(sacc[t][r]) * mk[4 * t + r]; lsum[h] += pe[4 * t + r]; }
                BF8 pf;
#pragma unroll
                for (int j = 0; j < 4; ++j) pf.w[j] = pk_bf16(pe[2 * j], pe[2 * j + 1]);
#pragma unroll
                for (int dt = 0; dt < 4; ++dt) oacc[h][dt] = __builtin_amdgcn_mfma_f32_16x16x32_bf16(va[dt].v, pf.v, oacc[h][dt], 0, 0, 0);
            }
        }
        __syncthreads();
#pragma unroll
        for (int h = 0; h < 4; ++h) {
            plsum[(w * 4 + h) * 64 + lane] = lsum[h];
#pragma unroll
            for (int dt = 0; dt < 4; ++dt)
#pragma unroll
                for (int r = 0; r < 4; ++r) part[(w * 64 + h * 16 + dt * 4 + r) * 64 + lane] = oacc[h][dt][r];
        }
        __syncthreads();
        {
            const int h = w >> 1;
            float lq = 0.f;
#pragma unroll
            for (int w2 = 0; w2 < 8; ++w2)
#pragma unroll
                for (int g2 = 0; g2 < 4; ++g2) lq += plsum[(w2 * 4 + h) * 64 + qi + 16 * g2];
            const float inv = 1.f / lq;
#pragma unroll
            for (int dd = 0; dd < 2; ++dd) {
                const int dt = (w & 1) * 2 + dd;
                float o[4];
#pragma unroll
                for (int r = 0; r < 4; ++r) {
                    float sacc = 0.f;
#pragma unroll
                    for (int w2 = 0; w2 < 8; ++w2) sacc += part[(w2 * 64 + h * 16 + dt * 4 + r) * 64 + lane];
                    o[r] = sacc * inv;
                }
                uint2 ov; ov.x = pk_bf16(o[0], o[1]); ov.y = pk_bf16(o[2], o[3]);
                *(uint2*)(Y + (tok0 + qi) * DM + 768 + h * 64 + 16 * dt + 4 * g) = ov;
            }
        }
        __syncthreads();
    }
}

__device__ __forceinline__ void ph_mem_prep(const Ctx& p, int l) {
    const float* Km = (const float*)(pws_() + WS_KM);
    const float* Vm = (const float*)(pws_() + WS_VM);
    bf16_t* KB = (bf16_t*)(pws_() + WS_KB);
    bf16_t* VTB = (bf16_t*)(pws_() + WS_VTB);
    const float* kg = pin_(28) + (size_t)l * 64;
    const int lane = tid_() & 63;
    for (int r = gwave(); r < MMEM; r += nwaves()) {
        const int b = r / NMEM, j = r % NMEM;
#pragma unroll
        for (int h = 0; h < 4; ++h) {
            const float v = Km[(size_t)r * 256 + h * 64 + lane];
            const float ss = wave_sum(v * v);
            KB[(((size_t)b * 4 + h) * NMEM + j) * 64 + lane] = f2bf(v * rsqrtf(ss * (1.f / 64.f) + EPS) * kg[lane]);
            VTB[(((size_t)b * 4 + h) * 64 + lane) * NMEM + j] = f2bf(Vm[(size_t)r * 256 + h * 64 + lane]);
        }
    }
}
__device__ __forceinline__ void ph_xattn(const Ctx& p, int l) {
    const float* Qx = (const float*)(pws_() + WS_QX);
    bf16_t* Ox = (bf16_t*)(pws_() + WS_OX);
    const bf16_t* KB = (const bf16_t*)(pws_() + WS_KB);
    const bf16_t* VTB = (const bf16_t*)(pws_() + WS_VTB);
    const float* qg = pin_(27) + (size_t)l * 64;
    const int lane = tid_() & 63, qi = lane & 15, g = lane >> 4;
    for (int task = gwave(); task < MTOK / 16; task += nwaves()) {
        const int tok0 = task * 16, b = tok0 / SEQ;
#pragma unroll 1
        for (int h = 0; h < 4; ++h) {
            BF8 qf[2];
            {
                float qv[2][8]; float ss = 0.f;
#pragma unroll
                for (int s2 = 0; s2 < 2; ++s2) {
                    const float4* qp = (const float4*)(Qx + (size_t)(tok0 + qi) * 256 + h * 64 + 32 * s2 + 8 * g);
                    const float4 a = qp[0], c = qp[1];
                    qv[s2][0] = a.x; qv[s2][1] = a.y; qv[s2][2] = a.z; qv[s2][3] = a.w; qv[s2][4] = c.x; qv[s2][5] = c.y; qv[s2][6] = c.z; qv[s2][7] = c.w;
#pragma unroll
                    for (int j = 0; j < 8; ++j) ss += qv[s2][j] * qv[s2][j];
                }
                ss += __shfl_xor(ss, 16, 64); ss += __shfl_xor(ss, 32, 64);
                const float rs = rsqrtf(ss * (1.f / 64.f) + EPS) * 0.125f;
#pragma unroll
                for (int s2 = 0; s2 < 2; ++s2) {
                    const float4 g0 = *(const float4*)(qg + 32 * s2 + 8 * g), g1 = *(const float4*)(qg + 32 * s2 + 8 * g + 4);
                    qf[s2].w[0] = pk_bf16(qv[s2][0] * rs * g0.x, qv[s2][1] * rs * g0.y); qf[s2].w[1] = pk_bf16(qv[s2][2] * rs * g0.z, qv[s2][3] * rs * g0.w);
                    qf[s2].w[2] = pk_bf16(qv[s2][4] * rs * g1.x, qv[s2][5] * rs * g1.y); qf[s2].w[3] = pk_bf16(qv[s2][6] * rs * g1.z, qv[s2][7] * rs * g1.w);
                }
            }
            const bf16_t* Kh = KB + ((size_t)b * 4 + h) * NMEM * 64;
            const bf16_t* Vh = VTB + ((size_t)b * 4 + h) * 64 * NMEM;
            f32x4_t oacc[4];
#pragma unroll
            for (int dt = 0; dt < 4; ++dt) oacc[dt] = (f32x4_t){0.f, 0.f, 0.f, 0.f};
            float lsum = 0.f;
            const int krow = 8 * (qi >> 2) + (qi & 3);
#pragma unroll 2
            for (int s0 = 0; s0 < NMEM; s0 += 32) {
                BF8 ka[2][2], va[4];
#pragma unroll
                for (int t = 0; t < 2; ++t)
#pragma unroll
                    for (int s2 = 0; s2 < 2; ++s2) ka[t][s2].u = *(const uint4*)(Kh + (size_t)(s0 + krow + 4 * t) * 64 + 32 * s2 + 8 * g);
#pragma unroll
                for (int dt = 0; dt < 4; ++dt) va[dt].u = *(const uint4*)(Vh + (size_t)(16 * dt + qi) * NMEM + s0 + 8 * g);
                f32x4_t sacc[2];
#pragma unroll
                for (int t = 0; t < 2; ++t) {
                    sacc[t] = (f32x4_t){0.f, 0.f, 0.f, 0.f};
                    sacc[t] = __builtin_amdgcn_mfma_f32_16x16x32_bf16(ka[t][0].v, qf[0].v, sacc[t], 0, 0, 0);
                    sacc[t] = __builtin_amdgcn_mfma_f32_16x16x32_bf16(ka[t][1].v, qf[1].v, sacc[t], 0, 0, 0);
                }
                float pe[8];
#pragma unroll
                for (int t = 0; t < 2; ++t)
#pragma unroll
                    for (int r = 0; r < 4; ++r) { pe[4 * t + r] = __expf(sacc[t][r]); lsum += pe[4 * t + r]; }
                BF8 pf;
#pragma unroll
                for (int j = 0; j < 4; ++j) pf.w[j] = pk_bf16(pe[2 * j], pe[2 * j + 1]);
#pragma unroll
                for (int dt = 0; dt < 4; ++dt) oacc[dt] = __builtin_amdgcn_mfma_f32_16x16x32_bf16(va[dt].v, pf.v, oacc[dt], 0, 0, 0);
            }
            lsum += __shfl_xor(lsum, 16, 64); lsum += __shfl_xor(lsum, 32, 64);
            const float inv = 1.f / lsum;
#pragma unroll
            for (int dt = 0; dt < 4; ++dt) {
                uint2 o; o.x = pk_bf16(oacc[dt][0] * inv, oacc[dt][1] * inv); o.y = pk_bf16(oacc[dt][2] * inv, oacc[dt][3] * inv);
                *(uint2*)(Ox + (size_t)(tok0 + qi) * 256 + h * 64 + 16 * dt + 4 * g) = o;
            }
        }
    }
}

template <int N> __device__ __forceinline__ void bitonic_sort_desc(unsigned (&a)[N]) {
#pragma unroll
    for (int k = 2; k <= N; k <<= 1)
#pragma unroll
        for (int j = k >> 1; j > 0; j >>= 1)
#pragma unroll
            for (int i = 0; i < N; ++i) {
                const int o = i ^ j;
                if (o > i) {
                    const bool desc = ((i & k) == 0);
                    const unsigned x = a[i], y = a[o];
                    const unsigned mx = x > y ? x : y, mn = x > y ? y : x;
                    a[i] = desc ? mx : mn; a[o] = desc ? mn : mx;
                }
            }
}
__device__ __forceinline__ void bitonic_merge16_desc(unsigned (&a)[16]) {
#pragma unroll
    for (int j = 8; j > 0; j >>= 1)
#pragma unroll
        for (int i = 0; i < 16; ++i) {
            const int o = i ^ j;
            if (o > i) { const unsigned x = a[i], y = a[o]; a[i] = x > y ? x : y; a[o] = x > y ? y : x; }
        }
}
__device__ __forceinline__ void top16_merge(unsigned (&a)[16], const unsigned (&b)[16]) {
#pragma unroll
    for (int i = 0; i < 16; ++i) a[i] = a[i] > b[15 - i] ? a[i] : b[15 - i];
    bitonic_merge16_desc(a);
}
__device__ __forceinline__ void top16_xlane(unsigned (&a)[16], int xm) {
    unsigned b[16];
#pragma unroll
    for (int i = 0; i < 16; ++i) b[i] = (unsigned)__shfl_xor((int)a[i], xm, 64);
    top16_merge(a, b);
}
__device__ __forceinline__ void ph_subkeys_convert(const Ctx& p) {
    const float* sk = pin_(31);
    bf16_t* o = (bf16_t*)(pws_() + WS_SKB);
    const size_t n = (size_t)DEPTH * 8 * 2 * 128 * 64;
    for (size_t i = (size_t)bid_() * 512 + tid_(); i < n; i += (size_t)nblk_() * 512) o[i] = f2bf(sk[i]);
}
__device__ __forceinline__ void ph_peer_topk(const Ctx& p, int l, float* smem) {
    const bf16_t* Qp = (const bf16_t*)(pws_() + WS_QP);
    const bf16_t* SK = (const bf16_t*)(pws_() + WS_SKB) + (size_t)l * 8 * 2 * 128 * 64;
    int* pidx = (int*)(pws_() + WS_PEI);
    float* pgt = (float*)(pws_() + WS_PEG);
    const int tid = tid_(), lane = tid & 63, wave = tid >> 6, qi = lane & 15, g = lane >> 4;
    int* tabw = (int*)smem + wave * 512 + qi * 32;
    for (int task = gwave(); task < MTOK / 16; task += nwaves()) {
        const size_t tok = (size_t)task * 16 + qi;
#pragma unroll 1
        for (int h = 0; h < 8; ++h) {
            unsigned L[2][16];
#pragma unroll
            for (int pp = 0; pp < 2; ++pp) {
                BF8 qf[2];
#pragma unroll
                for (int s2 = 0; s2 < 2; ++s2) qf[s2].u = *(const uint4*)(Qp + tok * DM + h * 128 + pp * 64 + 32 * s2 + 8 * g);
                const bf16_t* skp = SK + (size_t)(h * 2 + pp) * 128 * 64;
                unsigned va[16], vb[16];
#pragma unroll
                for (int tile = 0; tile < 8; ++tile) {
                    BF8 ka[2];
#pragma unroll
                    for (int s2 = 0; s2 < 2; ++s2) ka[s2].u = *(const uint4*)(skp + (size_t)(16 * tile + qi) * 64 + 32 * s2 + 8 * g);
                    f32x4_t d = __builtin_amdgcn_mfma_f32_16x16x32_bf16(ka[0].v, qf[0].v, (f32x4_t){0.f, 0.f, 0.f, 0.f}, 0, 0, 0);
                    d = __builtin_amdgcn_mfma_f32_16x16x32_bf16(ka[1].v, qf[1].v, d, 0, 0, 0);
#pragma unroll
                    for (int r = 0; r < 4; ++r) {
                        const unsigned key = (ford(d[r]) & ~127u) | (unsigned)(127 - (16 * tile + 4 * g + r));
                        if (tile < 4) va[tile * 4 + r] = key; else vb[(tile - 4) * 4 + r] = key;
                    }
                }
                bitonic_sort_desc<16>(va);
                bitonic_sort_desc<16>(vb);
                top16_merge(va, vb);
                top16_xlane(va, 16);
                top16_xlane(va, 32);
#pragma unroll
                for (int i = 0; i < 16; ++i) L[pp][i] = va[i];
            }
            if (g < 2) {
#pragma unroll
                for (int i = 0; i < 16; ++i) tabw[g * 16 + i] = 127 - (int)((g == 0 ? L[0][i] : L[1][i]) & 127u);
            }
            float s1[16], s2v[16];
#pragma unroll
            for (int i = 0; i < 16; ++i) { s1[i] = funord(L[0][i] & ~127u); s2v[i] = funord(L[1][i] & ~127u); }
            unsigned ca[16], cb[16];
#pragma unroll
            for (int i = 0; i < 16; ++i) { ca[i] = 0u; cb[i] = 0u; }
            {
                const float r0 = g == 0 ? s1[0] : (g == 1 ? s1[1] : (g == 2 ? s1[2] : s1[3]));
                const int nb0 = g == 0 ? 16 : (g == 1 ? 8 : (g == 2 ? 5 : 4));
#pragma unroll
                for (int bq = 0; bq < 16; ++bq) if (bq < nb0) ca[bq] = (ford(r0 + s2v[bq]) & ~255u) | (unsigned)(255 - (g * 16 + bq));
                const float r1 = g == 0 ? s1[4] : (g == 1 ? s1[5] : (g == 2 ? s1[6] : s1[7]));
                const int nb1 = g == 0 ? 3 : 2;
#pragma unroll
                for (int bq = 0; bq < 3; ++bq) if (bq < nb1) cb[bq] = (ford(r1 + s2v[bq]) & ~255u) | (unsigned)(255 - ((g + 4) * 16 + bq));
                const float r2 = g == 0 ? s1[8] : (g == 1 ? s1[9] : (g == 2 ? s1[10] : s1[11]));
                cb[3] = (ford(r2 + s2v[0]) & ~255u) | (unsigned)(255 - ((g + 8) * 16));
                const float r3 = g == 0 ? s1[12] : (g == 1 ? s1[13] : (g == 2 ? s1[14] : s1[15]));
                cb[4] = (ford(r3 + s2v[0]) & ~255u) | (unsigned)(255 - ((g + 12) * 16));
            }
            bitonic_sort_desc<16>(ca);
            bitonic_sort_desc<16>(cb);
            top16_merge(ca, cb);
            top16_xlane(ca, 16);
            top16_xlane(ca, 32);
            float tv[16]; float den = 0.f;
#pragma unroll
            for (int i = 0; i < 16; ++i) {
                const int f = 255 - (int)(ca[i] & 255u);
                const int a = f >> 4, bq = f & 15;
                tv[i] = funord(ca[i] & ~255u);
                (void)a; (void)bq;
            }
#pragma unroll
            for (int i = 0; i < 16; ++i) { tv[i] = __expf(tv[i] - funord(ca[0] & ~255u)); den += tv[i]; }
            const float inv = 1.f / den;
            int ev[4]; float gv[4];
#pragma unroll
            for (int r = 0; r < 4; ++r) {
                const unsigned key = g == 0 ? ca[r] : (g == 1 ? ca[4 + r] : (g == 2 ? ca[8 + r] : ca[12 + r]));
                const float tvv = g == 0 ? tv[r] : (g == 1 ? tv[4 + r] : (g == 2 ? tv[8 + r] : tv[12 + r]));
                const int f = 255 - (int)(key & 255u);
                ev[r] = tabw[f >> 4] * 128 + tabw[16 + (f & 15)];
                gv[r] = tvv * inv;
            }
            *(int4*)(pidx + tok * 128 + h * 16 + 4 * g) = make_int4(ev[0], ev[1], ev[2], ev[3]);
            *(float4*)(pgt + tok * 128 + h * 16 + 4 * g) = make_float4(gv[0], gv[1], gv[2], gv[3]);
        }
    }
}

typedef _Float16 h2_t __attribute__((ext_vector_type(2)));
__device__ __forceinline__ h2_t as_h2(unsigned u) { union { unsigned u; h2_t h; } c; c.u = u; return c.h; }
#define U_SCALE 1024.f
#define V_SCALE 256.f
typedef float f32x2_t __attribute__((ext_vector_type(2)));
__device__ __forceinline__ unsigned pack4_fp8(float4 a, float sc) {
    const float x = fminf(fmaxf(a.x * sc, -448.f), 448.f), y = fminf(fmaxf(a.y * sc, -448.f), 448.f);
    const float z = fminf(fmaxf(a.z * sc, -448.f), 448.f), w = fminf(fmaxf(a.w * sc, -448.f), 448.f);
    int r = __builtin_amdgcn_cvt_pk_fp8_f32(x, y, 0, false);
    r = __builtin_amdgcn_cvt_pk_fp8_f32(z, w, r, true);
    return (unsigned)r;
}
__device__ __forceinline__ void ph_tab_convert(const Ctx& p, int l) {
    const float4* u = (const float4*)(pin_(32) + (size_t)l * NEXP * DM);
    const float4* v = (const float4*)(pin_(33) + (size_t)l * NEXP * DM);
    unsigned* uo = (unsigned*)(pws_() + WS_UT16);
    unsigned* vo = (unsigned*)(pws_() + WS_VT16);
    const size_t n4 = (size_t)NEXP * DM / 4;
    for (size_t i = (size_t)bid_() * 512 + tid_(); i < n4; i += (size_t)nblk_() * 512) {
        uo[i] = pack4_fp8(u[i], U_SCALE);
        vo[i] = pack4_fp8(v[i], V_SCALE);
    }
}
#define WS_PD (WS_P)
template <int HALF>
__device__ __forceinline__ void ph_peer_u(const Ctx& p, int l) {
    const unsigned char* ut = (const unsigned char*)(pws_() + WS_UT16);
    const int* pidx = (const int*)(pws_() + WS_PEI);
    float* pgt = (float*)(pws_() + WS_PEG);
    float* pd_ = (float*)(pws_() + WS_PD);
    const bf16_t* H = (const bf16_t*)(pws_() + WS_H);
    const int lane = tid_() & 63;
    const bool r = lane & 32, bit4 = lane & 16, bit3 = lane & 8, bit2 = lane & 4, bit1 = lane & 2;
    const int coff = 512 * HALF + 16 * (lane & 31);
    const int pmine = 2 * (((lane >> 4) & 1) * 8 + ((lane >> 3) & 1) * 4 + ((lane >> 2) & 1) * 2 + ((lane >> 1) & 1)) + (lane >> 5);
    for (int tok = gwave(); tok < MTOK; tok += nwaves()) {
        float hh[16];
        {
            const uint4 r0 = *(const uint4*)(H + (size_t)tok * DM + coff), r1 = *(const uint4*)(H + (size_t)tok * DM + coff + 8);
            const unsigned w[8] = {r0.x, r0.y, r0.z, r0.w, r1.x, r1.y, r1.z, r1.w};
#pragma unroll
            for (int q = 0; q < 8; ++q) { hh[2 * q] = __uint_as_float(w[q] << 16); hh[2 * q + 1] = __uint_as_float(w[q] & 0xffff0000u); }
        }
        const int e0 = pidx[(size_t)tok * 128 + lane], e1 = pidx[(size_t)tok * 128 + 64 + lane];
#pragma unroll 1
        for (int hb = 0; hb < 4; ++hb) {
            const int esrc = hb < 2 ? e0 : e1;
            const int lb = (hb & 1) * 32;
            uint4 ur[16];
#pragma unroll
            for (int i = 0; i < 16; ++i) {
                const int ea = __builtin_amdgcn_readlane(esrc, lb + 2 * i), eb = __builtin_amdgcn_readlane(esrc, lb + 2 * i + 1);
                const int e = r ? eb : ea;
                ur[i] = *(const uint4*)(ut + (size_t)e * DM + coff);
            }
            float pd[16];
#pragma unroll
            for (int i = 0; i < 16; ++i) {
                const unsigned w[4] = {ur[i].x, ur[i].y, ur[i].z, ur[i].w};
                float d0 = 0.f, d1 = 0.f;
#pragma unroll
                for (int q = 0; q < 4; ++q) {
                    const f32x2_t a = __builtin_amdgcn_cvt_pk_f32_fp8((int)w[q], false), c = __builtin_amdgcn_cvt_pk_f32_fp8((int)w[q], true);
                    d0 = __builtin_fmaf(a.x, hh[4 * q], d0); d1 = __builtin_fmaf(a.y, hh[4 * q + 1], d1);
                    d0 = __builtin_fmaf(c.x, hh[4 * q + 2], d0); d1 = __builtin_fmaf(c.y, hh[4 * q + 3], d1);
                }
                pd[i] = d0 + d1;
            }
            float r8[8], r4[4], r2[2], r1;
#pragma unroll
            for (int i = 0; i < 8; ++i) { const float mine = bit4 ? pd[i + 8] : pd[i], send = bit4 ? pd[i] : pd[i + 8]; r8[i] = mine + __shfl_xor(send, 16, 64); }
#pragma unroll
            for (int i = 0; i < 4; ++i) { const float mine = bit3 ? r8[i + 4] : r8[i], send = bit3 ? r8[i] : r8[i + 4]; r4[i] = mine + __shfl_xor(send, 8, 64); }
#pragma unroll
            for (int i = 0; i < 2; ++i) { const float mine = bit2 ? r4[i + 2] : r4[i], send = bit2 ? r4[i] : r4[i + 2]; r2[i] = mine + __shfl_xor(send, 4, 64); }
            { const float mine = bit1 ? r2[1] : r2[0], send = bit1 ? r2[0] : r2[1]; r1 = mine + __shfl_xor(send, 2, 64); }
            r1 += __shfl_xor(r1, 1, 64);
            const size_t pi = (size_t)tok * 128 + hb * 32 + pmine;
            if (HALF == 0) { if ((lane & 1) == 0) pd_[pi] = r1; }
            else if ((lane & 1) == 0) pgt[pi] = pgt[pi] * gelu_tanh_f((r1 + pd_[pi]) * (1.f / U_SCALE)) * (1.f / V_SCALE);
        }
    }
}
template <int HALF>
__device__ __forceinline__ void ph_peer_v(const Ctx& p, int l) {
    const unsigned char* vt = (const unsigned char*)(pws_() + WS_VT16);
    const int* pidx = (const int*)(pws_() + WS_PEI);
    const float* pgt = (const float*)(pws_() + WS_PEG);
    float* x = pout_();
    const int lane = tid_() & 63;
    const bool r = lane & 32;
    const int coff = 512 * HALF + 16 * (lane & 31);
    for (int tok = gwave(); tok < MTOK; tok += nwaves()) {
        const int e0 = pidx[(size_t)tok * 128 + lane], e1 = pidx[(size_t)tok * 128 + 64 + lane];
        const float c0 = pgt[(size_t)tok * 128 + lane], c1 = pgt[(size_t)tok * 128 + 64 + lane];
        float out[16];
#pragma unroll
        for (int i = 0; i < 16; ++i) out[i] = 0.f;
#pragma unroll 1
        for (int hb = 0; hb < 4; ++hb) {
            const int esrc = hb < 2 ? e0 : e1;
            const float csrc = hb < 2 ? c0 : c1;
            const int lb = (hb & 1) * 32;
            uint4 vr[16];
#pragma unroll
            for (int i = 0; i < 16; ++i) {
                const int ea = __builtin_amdgcn_readlane(esrc, lb + 2 * i), eb = __builtin_amdgcn_readlane(esrc, lb + 2 * i + 1);
                const int e = r ? eb : ea;
                vr[i] = *(const uint4*)(vt + (size_t)e * DM + coff);
            }
#pragma unroll
            for (int i = 0; i < 16; ++i) {
                const float ca = __uint_as_float(__builtin_amdgcn_readlane(__float_as_uint(csrc), lb + 2 * i));
                const float cb = __uint_as_float(__builtin_amdgcn_readlane(__float_as_uint(csrc), lb + 2 * i + 1));
                const float cj = r ? cb : ca;
                const unsigned w[4] = {vr[i].x, vr[i].y, vr[i].z, vr[i].w};
#pragma unroll
                for (int q = 0; q < 4; ++q) {
                    const f32x2_t a = __builtin_amdgcn_cvt_pk_f32_fp8((int)w[q], false), c = __builtin_amdgcn_cvt_pk_f32_fp8((int)w[q], true);
                    out[4 * q] = __builtin_fmaf(a.x, cj, out[4 * q]); out[4 * q + 1] = __builtin_fmaf(a.y, cj, out[4 * q + 1]);
                    out[4 * q + 2] = __builtin_fmaf(c.x, cj, out[4 * q + 2]); out[4 * q + 3] = __builtin_fmaf(c.y, cj, out[4 * q + 3]);
                }
            }
        }
#pragma unroll
        for (int i = 0; i < 16; ++i) out[i] += __shfl_xor(out[i], 32, 64);
        if (!r) {
            float4* xp = (float4*)(x + (size_t)tok * DM + coff);
#pragma unroll
            for (int q = 0; q < 4; ++q) {
                float4 a = xp[q];
                a.x += out[4 * q]; a.y += out[4 * q + 1]; a.z += out[4 * q + 2]; a.w += out[4 * q + 3];
                xp[q] = a;
            }
        }
    }
}


#ifndef PROBE_MASK
#define PROBE_MASK 0
#endif
#if PROBE_MASK
#define GB(k) do { GRID_BARRIER(); const unsigned long long now_ = wall_clock64(); if ((PROBE_MASK >> (k)) & 1) { const unsigned long long dt_ = now_ - tprev_; while (wall_clock64() - now_ < 3ull * dt_) __builtin_amdgcn_s_sleep(8); } GRID_BARRIER(); tprev_ = wall_clock64(); } while (0)
#else
#define GB(k) GRID_BARRIER()
#endif
__global__ void __launch_bounds__(512, 2) k_mega(Params kp) {
    float* sm = dynsmem;
    {
        unsigned long long* tab = (unsigned long long*)((char*)dynsmem + PTAB_OFF);
        if (threadIdx.x < 34) tab[threadIdx.x] = (unsigned long long)kp.in[threadIdx.x];
        if (threadIdx.x == 34) tab[34] = (unsigned long long)kp.out;
        if (threadIdx.x == 35) tab[35] = (unsigned long long)kp.ws;
        if (threadIdx.x == 36) { tab[36] = 0ull; tab[37] = 0ull; }
    }
    __syncthreads();
    Ctx p; p.kp = &kp;
    (void)xcd_barrier_post((unsigned*)(pws_() + WS_BAR), (volatile LAS unsigned*)((char*)dynsmem + PTAB_OFF + 36 * 8));
#define GRID_BARRIER() do { XcdBarrier bar_; bar_.bar = (unsigned*)(pws_() + WS_BAR); bar_.x = xb_xcc_id(); bar_.st = (volatile LAS unsigned*)((char*)dynsmem + PTAB_OFF + 36 * 8); xcd_barrier(bar_); } while (0)
    ph_weight_prep(p, sm);
    ph_subkeys_convert(p);
    GRID_BARRIER();
#if PROBE_MASK
    unsigned long long tprev_ = wall_clock64();
#endif
#pragma unroll 1
    for (int l = 0; l < DEPTH; ++l) {
#define XIN_ (l == 0 ? pin_(0) : pout_())
#define HBUF_ ((const bf16_t*)(pws_() + WS_H))
        ph_rmsnorm(XIN_, pin_(2) + (size_t)l * DM, (bf16_t*)(pws_() + WS_H), MTOK);
        ph_rmsnorm(pin_(1), pin_(22) + (size_t)l * DM, (bf16_t*)(pws_() + WS_HM), MMEM);
        GB(1);
        { pg8::EpiBf16 E; E.O = (bf16_t*)(pws_() + WS_P); E.ldc = LDP; ph_gemm(HBUF_, (const bf16_t*)(pws_() + WT_IN) + (size_t)l * LDP * DM, MTOK, LDP, DM, E); }
        { pg8::EpiF32 E; E.C = (float*)(pws_() + WS_KM); E.R = nullptr; E.ldc = 256; ph_gemm((const bf16_t*)(pws_() + WS_HM), (const bf16_t*)(pws_() + WT_XK) + (size_t)l * 256 * DM, MMEM, 256, DM, E); }
        { pg8::EpiF32 E; E.C = (float*)(pws_() + WS_VM); E.R = nullptr; E.ldc = 256; ph_gemm((const bf16_t*)(pws_() + WS_HM), (const bf16_t*)(pws_() + WT_XV) + (size_t)l * 256 * DM, MMEM, 256, DM, E); }
        GB(2);
        ph_mem_prep(p, l);
        ph_dsa_prep(p, l);
        ph_scan_prep(p, l);
        GB(3);
        ph_scans(p, l, sm);
        GB(4);
        ph_mixer_finish(p, l);
        ph_dsa_main(p, l, sm);
        GB(5);
        { pg8::EpiF32 E; E.C = pout_(); E.R = XIN_; E.ldc = DM; ph_gemm((const bf16_t*)(pws_() + WS_Y), (const bf16_t*)(pws_() + WT_OUT) + (size_t)l * DM * DM, MTOK, DM, DM, E); }
        GB(6);
        ph_rmsnorm(pout_(), pin_(21) + (size_t)l * DM, (bf16_t*)(pws_() + WS_H), MTOK);
        GB(7);
        { pg8::EpiF32 E; E.C = (float*)(pws_() + WS_QX); E.R = nullptr; E.ldc = 256; ph_gemm(HBUF_, (const bf16_t*)(pws_() + WT_XQ) + (size_t)l * 256 * DM, MTOK, 256, DM, E); }
        GB(8);
        ph_xattn(p, l);
        GB(9);
        { pg8::EpiF32 E; E.C = pout_(); E.R = pout_(); E.ldc = DM; ph_gemm((const bf16_t*)(pws_() + WS_OX), (const bf16_t*)(pws_() + WT_XO) + (size_t)l * DM * 256, MTOK, DM, 256, E); }
        GB(10);
        ph_rmsnorm(pout_(), pin_(29) + (size_t)l * DM, (bf16_t*)(pws_() + WS_H), MTOK);
        ph_tab_convert(p, l);
        GB(11);
        { pg8::EpiBf16 E; E.O = (bf16_t*)(pws_() + WS_QP); E.ldc = DM; ph_gemm(HBUF_, (const bf16_t*)(pws_() + WT_PQ) + (size_t)l * DM * DM, MTOK, DM, DM, E); }
        GB(12);
        ph_peer_topk(p, l, sm);
        GB(13);
        ph_peer_u<0>(p, l);
        GB(14);
        ph_peer_u<1>(p, l);
        GB(15);
        ph_peer_v<0>(p, l);
        GB(16);
        ph_peer_v<1>(p, l);
        GB(17);
    }
}

extern "C" void kernel_launch(void* const* d_in, const int* in_sizes, int n_in, void* d_out, int out_size, void* d_ws, size_t ws_size, hipStream_t stream) {
    if (n_in != 34 || out_size != MTOK * DM || ws_size < WS_END) {
        fprintf(stderr, "kernel_launch: unexpected shapes (n_in %d out %d ws %zu need %zu)\n", n_in, out_size, ws_size, (size_t)WS_END);
        return;
    }
    static int grid = 0;
    if (!grid) {
        int dev = 0, cus = 0, per_cu = 0;
        (void)hipGetDevice(&dev);
        (void)hipDeviceGetAttribute(&cus, hipDeviceAttributeMultiprocessorCount, dev);
        (void)hipFuncSetAttribute((const void*)k_mega, hipFuncAttributeMaxDynamicSharedMemorySize, LDS_BYTES);
        (void)hipOccupancyMaxActiveBlocksPerMultiprocessor(&per_cu, (const void*)k_mega, 512, LDS_BYTES);
        if (per_cu < 1) fprintf(stderr, "kernel_launch: occupancy query reports %d blocks per CU\n", per_cu);
        grid = cus > 0 ? cus : 256;
    }
    Params p; memset(&p, 0, sizeof(p));
    for (int i = 0; i < 34; ++i) p.in[i] = (const float*)d_in[i];
    p.out = (float*)d_out; p.ws = (char*)d_ws;
    (void)hipMemsetAsync((char*)d_ws + WS_BAR, 0, XCD_BAR_WORDS * sizeof(unsigned), stream);
    hipLaunchKernelGGL(k_mega, dim3(grid), dim3(512), LDS_BYTES, stream, p);
}
```

```cpp
#include <hip/hip_runtime.h>
#include <stdint.h>
#include <stdio.h>
#include <string.h>

#define NB 32
#define SEQ 2048
#define DM 1024
#define MTOK (NB * SEQ)
#define DEPTH 4
#define NMEM 256
#define MMEM (NB * NMEM)
#define LDP 3328
#define NEXP 16384
#define EPS 1e-6f
#define PC_Z 0
#define PC_XBC 256
#define PC_GQKV 768
#define PC_GG 1536
#define PC_LQ 1792
#define PC_LK 1920
#define PC_LV 2048
#define PC_LR 2304
#define PC_DQ 2560
#define PC_DK 2816
#define PC_DV 2880
#define PC_IQ 2944
#define PC_IK 3200
#define PC_GLR 3232
#define PC_IW 3248
#define PC_DT 3256
#define PC_GA 3260
#define PC_GB 3264

typedef unsigned short bf16_t;

#define WS_BAR 0ull
#define WS_P 16384ull
#define SZ_P ((size_t)MTOK * LDP * 2)
#define WS_H (WS_P + SZ_P)
#define SZ_H ((size_t)MTOK * DM * 2)
#define WS_Y (WS_H + SZ_H)
#define SZ_Y ((size_t)MTOK * DM * 2)
#define WS_WP (WS_Y + SZ_Y)
#define SZ_WP ((size_t)DEPTH * DM * LDP * 4)
#define WT_IN (WS_WP)
#define WT_OUT (WT_IN + (size_t)DEPTH * LDP * DM * 2)
#define WT_XQ (WT_OUT + (size_t)DEPTH * DM * DM * 2)
#define WT_XK (WT_XQ + (size_t)DEPTH * 256 * DM * 2)
#define WT_XV (WT_XK + (size_t)DEPTH * 256 * DM * 2)
#define WT_XO (WT_XV + (size_t)DEPTH * 256 * DM * 2)
#define WT_PQ (WT_XO + (size_t)DEPTH * DM * 256 * 2)
#define WT_END (WT_PQ + (size_t)DEPTH * DM * DM * 2)
#define WS_QN (WS_WP + SZ_WP)
#define SZ_QN ((size_t)MTOK * 256 * 4)
#define WS_KN (WS_QN + SZ_QN)
#define SZ_KN ((size_t)MTOK * 64 * 4)
#define WS_IKN (WS_KN + SZ_KN)
#define SZ_IKN ((size_t)MTOK * 32 * 4)
#define WS_YPRE (WS_IKN + SZ_IKN)
#define SZ_YPRE ((size_t)MTOK * 256 * 4)
#define WS_HM (WS_YPRE + SZ_YPRE)
#define SZ_HM ((size_t)MMEM * DM * 2)
#define WS_KM (WS_HM + SZ_HM)
#define SZ_KM ((size_t)MMEM * 256 * 4)
#define WS_VM (WS_KM + SZ_KM)
#define SZ_VM ((size_t)MMEM * 256 * 4)
#define WS_KB (WS_VM + SZ_VM)
#define SZ_KB ((size_t)MMEM * 256 * 2)
#define WS_VTB (WS_KB + SZ_KB)
#define SZ_VTB ((size_t)MMEM * 256 * 2)
#define WS_VT (WS_VTB + SZ_VTB)
#define SZ_VT ((size_t)MTOK * 64 * 2)
#define WS_SKB (WS_VT + SZ_VT)
#define SZ_SKB ((size_t)DEPTH * 8 * 2 * 128 * 64 * 2)
#define WS_SC (WS_SKB + SZ_SKB)
#define SZ_SC ((size_t)MTOK * 16 * 4)
#define WS_DUMMY (WS_SC + SZ_SC)
#define SZ_DUMMY (65536ull)
#define WS_END (WS_DUMMY + SZ_DUMMY)
#define WS_QX (WS_P)
#define WS_OX (WS_P + (size_t)MTOK * 256 * 4)
#define WS_QP (WS_P)
#define WS_UT16 (WS_P + 260ull * 1024 * 1024)
#define WS_VT16 (WS_UT16 + (size_t)NEXP * DM * 2)
#define WS_PEI (WS_VT16 + (size_t)NEXP * DM * 2)
#define WS_PEG (WS_PEI + (size_t)MTOK * 128 * 4)
#define WS_PEND (WS_PEG + (size_t)MTOK * 128 * 4)
static_assert(WS_PEND <= WS_P + SZ_P, "P region aliases");

struct Params {
    const float* in[34];
    float* out;
    char* ws;
};

#define XB_TMO      128
#define XB_XCNT(j)  (256  + 64 * (j))
#define XB_XSUB(j)  (1280 + 64 * (j))
#define XB_XGEN(j)  (2304 + 64 * (j))
#define XB_TOP      3328
#define XB_TOPGEN   3392
#define XCD_BAR_WORDS 3456
#define XB_SPIN_CAP (1u << 18)
#define LAS __attribute__((address_space(3)))

__device__ __forceinline__ unsigned xb_ld(unsigned* p)              { return __hip_atomic_load(p, __ATOMIC_RELAXED, __HIP_MEMORY_SCOPE_AGENT); }
__device__ __forceinline__ unsigned xb_add(unsigned* p, unsigned v) { return __hip_atomic_fetch_add(p, v, __ATOMIC_RELAXED, __HIP_MEMORY_SCOPE_AGENT); }
__device__ __forceinline__ unsigned xb_xcc_id() { return (unsigned)__builtin_amdgcn_s_getreg((3 << 11) | 20) & 0xFu; }
#define XB_SPIN(cond, bar) do { unsigned _sp = 0; while (cond) { __builtin_amdgcn_s_sleep(1); \
    if ((++_sp & 255u) == 0u) { if (xb_ld(&(bar)[XB_TMO])) break; if (_sp > XB_SPIN_CAP) { atomicAdd(&(bar)[XB_TMO], 1u); break; } } } } while (0)

struct XcdBarrier {
    unsigned* bar; unsigned x;
    volatile LAS unsigned* st;
};

__device__ __forceinline__ XcdBarrier xcd_barrier_post(unsigned* bar, volatile LAS unsigned* st) {
    XcdBarrier b; b.bar = bar; b.x = xb_xcc_id(); b.st = st;
    if (threadIdx.x == 0) (void)xb_add(&bar[XB_XCNT(b.x)], 1u);
    return b;
}
__device__ __forceinline__ void xcd_barrier_complete(unsigned* bar, unsigned x, unsigned& nloc, unsigned& nx) {
    const unsigned G = gridDim.x * gridDim.y * gridDim.z;
    unsigned sum, cnt, mine, sp = 0u;
    for (;;) {
        sum = 0u; cnt = 0u; mine = 0u;
#pragma unroll
        for (unsigned j = 0; j < 16; ++j) { const unsigned c = xb_ld(&bar[XB_XCNT(j)]); sum += c; cnt += (c > 0u) ? 1u : 0u; mine = (j == x) ? c : mine; }
        if (sum == G) break;
        __builtin_amdgcn_s_sleep(1);
        if ((++sp & 255u) == 0u) { if (xb_ld(&bar[XB_TMO])) break; if (sp > XB_SPIN_CAP) { atomicAdd(&bar[XB_TMO], 1u); break; } }
    }
    nloc = mine > 0u ? mine : 1u; nx = cnt > 0u ? cnt : 1u;
}

__device__ __forceinline__ void xcd_barrier(const XcdBarrier& b) {
    asm volatile("s_waitcnt vmcnt(0)" ::: "memory");
    __syncthreads();
    if (threadIdx.x == 0) {
        unsigned* bar = b.bar;
        __builtin_amdgcn_s_waitcnt(0);
        unsigned nloc = b.st[0], nx = b.st[1];
        if (nloc == 0u) { xcd_barrier_complete(bar, b.x, nloc, nx); b.st[0] = nloc; b.st[1] = nx; }
        const unsigned old = xb_add(&bar[XB_XSUB(b.x)], 1u);
        const unsigned gen = old / nloc;
        if (old + 1u == (gen + 1u) * nloc) {
            __builtin_amdgcn_fence(__ATOMIC_RELEASE, "agent");
            asm volatile("s_waitcnt vmcnt(0)" ::: "memory");
            const unsigned og = xb_add(&bar[XB_TOP], 1u);
            const unsigned tg = og / nx;
            if (og + 1u == (tg + 1u) * nx) xb_add(&bar[XB_TOPGEN], 1u);
            else XB_SPIN(xb_ld(&bar[XB_TOPGEN]) == tg, bar);
            __builtin_amdgcn_fence(__ATOMIC_ACQUIRE, "agent");
            xb_add(&bar[XB_XGEN(b.x)], 1u);
            asm volatile("s_waitcnt vmcnt(0)" ::: "memory");
        } else {
            XB_SPIN(xb_ld(&bar[XB_XGEN(b.x)]) == gen, bar);
            __builtin_amdgcn_fence(__ATOMIC_ACQUIRE, "agent");
            asm volatile("s_waitcnt vmcnt(0)" ::: "memory");
        }
    }
    __syncthreads();
}


#define LDS_BYTES (144 * 1024)
#define PTAB_OFF (LDS_BYTES - 1024)
extern __shared__ __attribute__((aligned(16))) float dynsmem[];
struct Ctx { const Params* kp; };
#define pin_(i) (p.kp->in[i])
#define pout_() (p.kp->out)
#define pws_() (p.kp->ws)

__device__ __forceinline__ float bf2f(bf16_t v) { return __uint_as_float(((unsigned)v) << 16); }
__device__ __forceinline__ bf16_t f2bf(float f) { unsigned u = __float_as_uint(f); u += 0x7FFFu + ((u >> 16) & 1u); return (bf16_t)(u >> 16); }
__device__ __forceinline__ unsigned pk_bf16(float lo, float hi) { return (unsigned)f2bf(lo) | ((unsigned)f2bf(hi) << 16); }
__device__ __forceinline__ float wave_sum(float v) {
#pragma unroll
    for (int o = 32; o >= 1; o >>= 1) v += __shfl_xor(v, o, 64);
    return v;
}
__device__ __forceinline__ float wave_max(float v) {
#pragma unroll
    for (int o = 32; o >= 1; o >>= 1) v = fmaxf(v, __shfl_xor(v, o, 64));
    return v;
}
__device__ __forceinline__ float silu_f(float x) { return x / (1.f + __expf(-x)); }
__device__ __forceinline__ float sigmoid_f(float x) { return 1.f / (1.f + __expf(-x)); }
__device__ __forceinline__ float softplus_f(float x) { return x > 20.f ? x : log1pf(__expf(x)); }
__device__ __forceinline__ float logsigmoid_f(float x) { return -softplus_f(-x); }
__device__ __forceinline__ float gelu_tanh_f(float x) { const float u = 0.7978845608028654f * (x + 0.044715f * x * x * x); return 0.5f * x * (1.f + tanhf(u)); }
__device__ __forceinline__ unsigned ford(float f) { f = f + 0.0f; unsigned u = __float_as_uint(f); return (u & 0x80000000u) ? ~u : (u | 0x80000000u); }
__device__ __forceinline__ float funord(unsigned k) { unsigned u = (k & 0x80000000u) ? (k & 0x7fffffffu) : ~k; return __uint_as_float(u); }
__device__ __forceinline__ unsigned long long wave_max_u64(unsigned long long v) {
#pragma unroll
    for (int o = 32; o >= 1; o >>= 1) {
        unsigned lo = __shfl_xor((unsigned)v, o, 64), hi = __shfl_xor((unsigned)(v >> 32), o, 64);
        unsigned long long w = ((unsigned long long)hi << 32) | lo;
        v = w > v ? w : v;
    }
    return v;
}
__device__ __forceinline__ int tid_() { int t = threadIdx.x; asm volatile("" : "+v"(t)); return t; }
__device__ __forceinline__ int bid_() { int b = blockIdx.x; asm volatile("" : "+s"(b)); return b; }
__device__ __forceinline__ int nblk_() { int g = gridDim.x; asm volatile("" : "+s"(g)); return g; }
__device__ __forceinline__ int gwave() { return (bid_() * 512 + tid_()) >> 6; }
__device__ __forceinline__ int nwaves() { return nblk_() * 8; }

namespace pg8 {
#define PG8_LAS __attribute__((address_space(3)))
typedef unsigned short bf16_t;
typedef short bf16x8 __attribute__((ext_vector_type(8)));
typedef float f32x4 __attribute__((ext_vector_type(4)));
typedef unsigned u32x4 __attribute__((ext_vector_type(4)));
constexpr int BM = 256, BK = 64, HALF = 128, HTB = HALF * BK * 2  , STAGE_BYTES = 8 * HTB, NXCD = 8, WGM = 8;

__host__ __device__ __forceinline__ int lds_byte(int r, int c) { const int st = (r >> 4) * 2 + (c >> 5), rr = r & 15, cc = c & 31, ob = rr * 64 + cc * 2; return st * 1024 + (ob ^ (((ob >> 9) & 1) << 5)); }
__host__ __device__ __forceinline__ void stage_rc(int b, int& R, int& C) { const int st = b / 1024, sb = b % 1024, swz = sb ^ (((sb >> 9) & 1) << 5); R = (st >> 1) * 16 + swz / 64; C = (st & 1) * 32 + (swz % 64) / 2; }
__host__ __device__ __forceinline__ int perm32(int rho) { const int n = rho >> 4, i = rho & 15; return 8 * (i >> 2) + 4 * n + (i & 3); }

struct Unit { int pm, pn; };
struct Gemm { const bf16_t* A; const bf16_t* Bt; int M, N, K; };

struct StaticOrder {
    int nM, nN, nwg, G, c;
    __host__ __device__ void init(int M, int N, int G_, int c_) { nM = M / BM; nN = N / BM; nwg = nM * nN; G = G_; c = c_; }
    __host__ __device__ bool next(int i, Unit& u) const {
        const long L = (long)i * G + c; if (L >= nwg) return false;
        int wgid = (int)L; { const int q = nwg / NXCD, r = nwg % NXCD, xcd = wgid % NXCD, off = wgid / NXCD; wgid = (xcd < r ? xcd * (q + 1) : r * (q + 1) + (xcd - r) * q) + off; }
        const int nig = WGM * nN, gid = wgid / nig, fm = gid * WGM, gsz = (nM - fm) < WGM ? (nM - fm) : WGM;
        u.pm = fm + ((wgid % nig) % gsz); u.pn = (wgid % nig) / gsz; return true;
    }
    __device__ __forceinline__ void a_ready(const Unit&) const {}
    __device__ __forceinline__ void done(const Unit&) const {}
};

__device__ __forceinline__ unsigned cvt_pk_bf16(float lo, float hi) { unsigned r; asm volatile("v_cvt_pk_bf16_f32 %0, %1, %2" : "=v"(r) : "v"(lo), "v"(hi)); return r; }
struct EpiF32 {
    static constexpr bool PERM = false, AFTER_DRAIN = false;
    float* C; const float* R; int ldc;
    __device__ __forceinline__ void operator()(const f32x4 (&acc)[2][2][4][2], const Unit& u, int wr, int wc, int fr, int fq) const {
        const int row0 = u.pm * BM + wr * 64 + fr, col0 = u.pn * BM + wc * 32 + 4 * fq;
#pragma unroll
        for (int ai = 0; ai < 2; ++ai)
#pragma unroll
            for (int m = 0; m < 4; ++m) { const size_t off = (size_t)(row0 + ai * HALF + m * 16) * ldc + col0;
#pragma unroll
                for (int bj = 0; bj < 2; ++bj)
#pragma unroll
                    for (int n = 0; n < 2; ++n) { f32x4 v = acc[ai][bj][m][n]; if (R) v += *(const f32x4*)(R + off + bj * HALF + n * 16); *(f32x4*)(C + off + bj * HALF + n * 16) = v; } }
    }
};
struct EpiBf16 {
    static constexpr bool PERM = true, AFTER_DRAIN = false;
    bf16_t* O; int ldc;
    __device__ __forceinline__ void operator()(const f32x4 (&acc)[2][2][4][2], const Unit& u, int wr, int wc, int fr, int fq) const {
        const int row0 = u.pm * BM + wr * 64 + fr, col0 = u.pn * BM + wc * 32 + 8 * fq;
#pragma unroll
        for (int ai = 0; ai < 2; ++ai)
#pragma unroll
            for (int m = 0; m < 4; ++m) { bf16_t* rowp = O + (size_t)(row0 + ai * HALF + m * 16) * ldc + col0;
#pragma unroll
                for (int bj = 0; bj < 2; ++bj) { const f32x4 v0 = acc[ai][bj][m][0], v1 = acc[ai][bj][m][1];
                    u32x4 w; w.x = cvt_pk_bf16(v0[0], v0[1]); w.y = cvt_pk_bf16(v0[2], v0[3]); w.z = cvt_pk_bf16(v1[0], v1[1]); w.w = cvt_pk_bf16(v1[2], v1[3]);
                    *(u32x4*)(rowp + bj * HALF) = w; } }
    }
};

template <class Epi, class Sched, bool STAMP = false>
__device__ __forceinline__ void gemm_phase(PG8_LAS unsigned char* lds, const Gemm g, const Sched& S, const Epi& E, unsigned long long* stamps, const int tid) {
    const int wid = __builtin_amdgcn_readfirstlane(tid >> 6), lane = tid & 63, wr = wid >> 2, wc = wid & 3, fr = lane & 15, fq = lane >> 4;
    const int K = g.K, nt = K / BK;
    int ts_lo = 0, ts_hi = 0, nts = 0; const unsigned long long rt_entry = STAMP ? (unsigned long long)wall_clock64() : 0ull;
#define PG8_STAMP() do { if (STAMP && wid == 0 && nts < 64) { const unsigned long long _c = (unsigned long long)clock64(); \
        ts_lo = (lane == nts) ? (int)(unsigned)_c : ts_lo; ts_hi = (lane == nts) ? (int)(unsigned)(_c >> 32) : ts_hi; ++nts; } } while (0)
    PG8_STAMP();
    unsigned voffA[2], voffB[2];
#pragma unroll
    for (int i = 0; i < 2; ++i) { int R, C; stage_rc(tid * 16 + i * 8192, R, C); const int Rb = Epi::PERM ? ((R & ~31) + perm32(R & 31)) : R;
        voffA[i] = (unsigned)(R * K + C) * 2u; voffB[i] = (unsigned)(Rb * K + C) * 2u; }
    const size_t kstep = (size_t)(BK * 2);
    const size_t hstep = (size_t)HALF * K * 2;
    const size_t tstep = 2 * hstep;
    const unsigned ldsw = (unsigned)wid * 1024u;
    const int aoff = lds_byte(wr * 64 + fr, fq * 8), boff = lds_byte(wc * 32 + fr, fq * 8);
#define PG8_SA(b, h) (((b) * 2 + (h)) * HTB)
#define PG8_SB(b, h) ((4 + (b) * 2 + (h)) * HTB)
#define PG8_STAGE(bufoff, gbase, voff) do { _Pragma("unroll") for (int _i = 0; _i < 2; ++_i) \
        __builtin_amdgcn_global_load_lds((const unsigned*)((const char*)(gbase) + (voff)[_i]), (PG8_LAS unsigned*)(lds + (bufoff) + ldsw + _i * 8192), 16, 0, 0); } while (0)
#define PG8_LDA(dst, b, h) do { _Pragma("unroll") for (int m = 0; m < 4; ++m) _Pragma("unroll") for (int k = 0; k < 2; ++k) dst[m][k] = *(const PG8_LAS bf16x8*)(lds + PG8_SA(b, h) + aoff + m * 2048 + k * 1024); } while (0)
#define PG8_LDB(dst, b, h) do { _Pragma("unroll") for (int n = 0; n < 2; ++n) _Pragma("unroll") for (int k = 0; k < 2; ++k) dst[n][k] = *(const PG8_LAS bf16x8*)(lds + PG8_SB(b, h) + boff + n * 2048 + k * 1024); } while (0)
#define PG8_MMA(ai, bj, At, Bt) do { __builtin_amdgcn_s_setprio(1); _Pragma("unroll") for (int m = 0; m < 4; ++m) _Pragma("unroll") for (int n = 0; n < 2; ++n) _Pragma("unroll") for (int k = 0; k < 2; ++k) \
        acc[ai][bj][m][n] = __builtin_amdgcn_mfma_f32_16x16x32_bf16(Bt[n][k], At[m][k], acc[ai][bj][m][n], 0, 0, 0); __builtin_amdgcn_s_setprio(0); } while (0)
#define PG8_WAIT_V(n) asm volatile("s_waitcnt vmcnt(" #n ")" ::: "memory")
#define PG8_WAIT_L(n) asm volatile("s_waitcnt lgkmcnt(" #n ")" ::: "memory")
#define PG8_BAR __builtin_amdgcn_s_barrier()
#define PG8_SCHED __builtin_amdgcn_sched_barrier(0)
    Unit cur, nxt; int ui = 0;
    if (!S.next(0, cur)) return;
    f32x4 acc[2][2][4][2];
#pragma unroll
    for (int a = 0; a < 2; ++a)
#pragma unroll
        for (int b = 0; b < 2; ++b)
#pragma unroll
            for (int m = 0; m < 4; ++m)
#pragma unroll
                for (int n = 0; n < 2; ++n) acc[a][b][m][n] = (f32x4){0.f, 0.f, 0.f, 0.f};
    bf16x8 At[4][2], B0[2][2], B1[2][2];
    const char* cA = (const char*)g.A + (size_t)cur.pm * tstep; const char* cB = (const char*)g.Bt + (size_t)cur.pn * tstep;
    S.a_ready(cur);
    PG8_STAGE(PG8_SB(0, 0), cB, voffB); PG8_STAGE(PG8_SA(0, 0), cA, voffA); PG8_STAGE(PG8_SB(0, 1), cB + hstep, voffB); PG8_STAGE(PG8_SA(0, 1), cA + hstep, voffA);
    if (wr == 1) PG8_BAR;
    PG8_WAIT_V(4); PG8_BAR;
    PG8_STAGE(PG8_SB(1, 0), cB + kstep, voffB); PG8_STAGE(PG8_SA(1, 0), cA + kstep, voffA); PG8_STAGE(PG8_SB(1, 1), cB + hstep + kstep, voffB);
    PG8_WAIT_V(6); PG8_BAR;
    PG8_STAMP();
    for (;;) {
        const bool has_next = S.next(ui + 1, nxt);
        const char* nA = has_next ? (const char*)g.A + (size_t)nxt.pm * tstep : cA; const char* nB = has_next ? (const char*)g.Bt + (size_t)nxt.pn * tstep : cB;
        for (int t = 0; t < nt; t += 2) {
            const bool last = (t == nt - 2);
            const char* a1 = cA + (size_t)(t + 1) * kstep;
            const char* a2 = last ? nA : cA + (size_t)(t + 2) * kstep; const char* b2 = last ? nB : cB + (size_t)(t + 2) * kstep;
            const char* a3 = a2 + kstep; const char* b3 = b2 + kstep;
            if (last && has_next) S.a_ready(nxt);
            PG8_LDB(B0, 0, 0); PG8_SCHED; PG8_LDA(At, 0, 0); PG8_STAGE(PG8_SA(1, 1), a1 + hstep, voffA);
            PG8_WAIT_L(8); PG8_BAR; PG8_WAIT_L(0); PG8_MMA(0, 0, At, B0); PG8_BAR; PG8_SCHED;
            PG8_LDB(B1, 0, 1); PG8_STAGE(PG8_SB(0, 0), b2, voffB);
            PG8_BAR; PG8_WAIT_L(0); PG8_MMA(0, 1, At, B1); PG8_BAR;
            PG8_LDA(At, 0, 1); PG8_STAGE(PG8_SA(0, 0), a2, voffA);
            PG8_BAR; PG8_WAIT_L(0); PG8_MMA(1, 0, At, B0); PG8_BAR; PG8_SCHED;
            PG8_STAGE(PG8_SB(0, 1), b2 + hstep, voffB);
            PG8_WAIT_V(6); PG8_BAR; PG8_MMA(1, 1, At, B1); PG8_BAR;
            PG8_LDB(B0, 1, 0); PG8_SCHED; PG8_LDA(At, 1, 0); PG8_STAGE(PG8_SA(0, 1), a2 + hstep, voffA);
            PG8_WAIT_L(8); PG8_BAR; PG8_WAIT_L(0); PG8_MMA(0, 0, At, B0); PG8_BAR; PG8_SCHED;
            PG8_LDB(B1, 1, 1); PG8_STAGE(PG8_SB(1, 0), b3, voffB);
            PG8_BAR; PG8_WAIT_L(0); PG8_MMA(0, 1, At, B1); PG8_BAR;
            PG8_LDA(At, 1, 1); PG8_STAGE(PG8_SA(1, 0), a3, voffA);
            PG8_BAR; PG8_WAIT_L(0); PG8_MMA(1, 0, At, B0); PG8_BAR; PG8_SCHED;
            PG8_STAGE(PG8_SB(1, 1), b3 + hstep, voffB);
            PG8_WAIT_V(6); PG8_BAR; PG8_MMA(1, 1, At, B1); PG8_BAR;
        }
        PG8_STAMP();
        if constexpr (!Epi::AFTER_DRAIN) { E(acc, cur, wr, wc, fr, fq); S.done(cur); }
        PG8_STAMP();
        if (!has_next) break;
#pragma unroll
        for (int a = 0; a < 2; ++a)
#pragma unroll
            for (int b = 0; b < 2; ++b)
#pragma unroll
                for (int m = 0; m < 4; ++m)
#pragma unroll
                    for (int n = 0; n < 2; ++n) acc[a][b][m][n] = (f32x4){0.f, 0.f, 0.f, 0.f};
        cur = nxt; cA = nA; cB = nB; ++ui;
    }
    PG8_WAIT_V(0);
    if (wr == 0) PG8_BAR;
    PG8_BAR;
    if constexpr (Epi::AFTER_DRAIN) { E.fused(acc, cur, wr, wc, fr, fq, lds, wid, lane); S.done(cur); }
    PG8_STAMP();
    if (STAMP && wid == 0) { stamps[lane] = lane < nts ? (((unsigned long long)(unsigned)ts_hi << 32) | (unsigned)ts_lo) : 0ull;
        if (lane == 62) stamps[62] = rt_entry; if (lane == 63) stamps[63] = (unsigned long long)wall_clock64(); }
#undef PG8_STAMP
#undef PG8_SA
#undef PG8_SB
#undef PG8_STAGE
#undef PG8_LDA
#undef PG8_LDB
#undef PG8_MMA
#undef PG8_WAIT_V
#undef PG8_WAIT_L
#undef PG8_BAR
#undef PG8_SCHED
}
}

template <class Epi> __device__ __forceinline__ void ph_gemm(const bf16_t* A, const bf16_t* Bt, int M, int N, int K, const Epi& E) {
    pg8::Gemm g; g.A = A; g.Bt = Bt; g.M = M; g.N = N; g.K = K;
    pg8::StaticOrder S; S.init(M, N, nblk_(), bid_());
    pg8::gemm_phase<Epi, pg8::StaticOrder, false>((PG8_LAS unsigned char*)dynsmem, g, S, E, nullptr, tid_());
}

__device__ __forceinline__ int pcol_to_orig(int c) {
    if (c < 768) return c;
    if (c < 1536) return c - 768 + 772;
    if (c < 1792) return c - 1536 + 1548;
    if (c < 1920) return c - 1792 + 1804;
    if (c < 2048) return c - 1920 + 1932;
    if (c < 2304) return c - 2048 + 2060;
    if (c < 2560) return c - 2304 + 2332;
    if (c < 2816) return c - 2560 + 2588;
    if (c < 2880) return c - 2816 + 2844;
    if (c < 2944) return c - 2880 + 2908;
    if (c < 3200) return c - 2944 + 2972;
    if (c < 3232) return c - 3200 + 3228;
    if (c < 3248) return c - 3232 + 2316;
    if (c < 3256) return c - 3248 + 3260;
    if (c < 3260) return c - 3256 + 768;
    if (c < 3264) return c - 3260 + 1540;
    if (c < 3268) return c - 3264 + 1544;
    return -1;
}
__device__ __forceinline__ void wtrans_job(const float* W, int K, int ldw, bf16_t* Wt, int Npad, bool mapped, float* tile) {
    const int tid = tid_();
    const int tn = Npad / 64, tk = K / 64;
    for (int t = bid_(); t < tn * tk; t += nblk_()) {
        const int n0 = (t / tk) * 64, k0 = (t % tk) * 64;
        __syncthreads();
        for (int idx = tid; idx < 4096; idx += 512) {
            const int kk = idx >> 6, nn = idx & 63;
            const int col = mapped ? pcol_to_orig(n0 + nn) : (n0 + nn);
            tile[kk * 65 + nn] = col >= 0 ? W[(size_t)(k0 + kk) * ldw + col] : 0.f;
        }
        __syncthreads();
        for (int idx = tid; idx < 4096; idx += 512) {
            const int nn = idx >> 6, kk = idx & 63;
            Wt[(size_t)(n0 + nn) * K + k0 + kk] = f2bf(tile[kk * 65 + nn]);
        }
    }
}
__device__ __forceinline__ void ph_weight_prep(const Ctx& p, float* sm) {
#pragma unroll 1
    for (int j = 0; j < 7 * DEPTH; ++j) {
        const int l = j / 7, w = j % 7;
        const float* W; int K, ldw, Npad; bf16_t* Wt; bool mapped = false;
        if (w == 0) { W = pin_(3) + (size_t)l * DM * 3268; K = DM; ldw = 3268; Npad = LDP; Wt = (bf16_t*)(pws_() + WT_IN) + (size_t)l * LDP * DM; mapped = true; }
        else if (w == 1) { W = pin_(20) + (size_t)l * DM * DM; K = DM; ldw = DM; Npad = DM; Wt = (bf16_t*)(pws_() + WT_OUT) + (size_t)l * DM * DM; }
        else if (w == 2) { W = pin_(23) + (size_t)l * DM * 256; K = DM; ldw = 256; Npad = 256; Wt = (bf16_t*)(pws_() + WT_XQ) + (size_t)l * 256 * DM; }
        else if (w == 3) { W = pin_(24) + (size_t)l * DM * 256; K = DM; ldw = 256; Npad = 256; Wt = (bf16_t*)(pws_() + WT_XK) + (size_t)l * 256 * DM; }
        else if (w == 4) { W = pin_(25) + (size_t)l * DM * 256; K = DM; ldw = 256; Npad = 256; Wt = (bf16_t*)(pws_() + WT_XV) + (size_t)l * 256 * DM; }
        else if (w == 5) { W = pin_(26) + (size_t)l * 256 * DM; K = 256; ldw = DM; Npad = DM; Wt = (bf16_t*)(pws_() + WT_XO) + (size_t)l * DM * 256; }
        else { W = pin_(30) + (size_t)l * DM * DM; K = DM; ldw = DM; Npad = DM; Wt = (bf16_t*)(pws_() + WT_PQ) + (size_t)l * DM * DM; }
        wtrans_job(W, K, ldw, Wt, Npad, mapped, sm);
    }
}

__device__ __forceinline__ void ph_rmsnorm(const float* __restrict__ x, const float* __restrict__ g, bf16_t* __restrict__ out, int rows) {
    const int lane = tid_() & 63;
    for (int r = gwave(); r < rows; r += nwaves()) {
        const float4* xr = (const float4*)(x + (size_t)r * DM);
        float4 v[4]; float ss = 0.f;
#pragma unroll
        for (int i = 0; i < 4; ++i) { v[i] = xr[lane + 64 * i]; ss += v[i].x * v[i].x + v[i].y * v[i].y + v[i].z * v[i].z + v[i].w * v[i].w; }
        ss = wave_sum(ss);
        const float rs = rsqrtf(ss * (1.f / DM) + EPS);
#pragma unroll
        for (int i = 0; i < 4; ++i) {
            const float4 gg = ((const float4*)g)[lane + 64 * i];
            ushort4 o; o.x = f2bf(v[i].x * rs * gg.x); o.y = f2bf(v[i].y * rs * gg.y); o.z = f2bf(v[i].z * rs * gg.z); o.w = f2bf(v[i].w * rs * gg.w);
            *(ushort4*)(out + (size_t)r * DM + (size_t)(lane + 64 * i) * 4) = o;
        }
    }
}

template <int OUTMODE>
__device__ __forceinline__ void ph_sgemm(const bf16_t* __restrict__ A, int lda, const float* __restrict__ B, int ldb, void* Cv, int ldc, const float* R, int ldr,
                         int M, int N, int K, float* smem) {
    float* As = smem;
    float* Bs = smem + 16 * 132;
    const int tid = tid_(), tx = tid & 31, ty = tid >> 5;
    const int ntn = N / 128, ntiles = (M / 128) * ntn;
    for (int tile = bid_(); tile < ntiles; tile += nblk_()) {
        const int tm = tile / ntn, tn = tile % ntn;
        float acc[8][4];
#pragma unroll
        for (int i = 0; i < 8; ++i)
#pragma unroll
            for (int j = 0; j < 4; ++j) acc[i][j] = 0.f;
        const int arow = tid >> 2, akq = (tid & 3) * 4;
        const int bk = tid >> 5, bn = (tid & 31) * 4;
        for (int k0 = 0; k0 < K; k0 += 16) {
            const ushort4 av = *(const ushort4*)(A + (size_t)(tm * 128 + arow) * lda + k0 + akq);
            const float4 bv = *(const float4*)(B + (size_t)(k0 + bk) * ldb + tn * 128 + bn);
            __syncthreads();
            As[(akq + 0) * 132 + arow] = bf2f(av.x); As[(akq + 1) * 132 + arow] = bf2f(av.y);
            As[(akq + 2) * 132 + arow] = bf2f(av.z); As[(akq + 3) * 132 + arow] = bf2f(av.w);
            *(float4*)(Bs + bk * 132 + bn) = bv;
            __syncthreads();
#pragma unroll
            for (int k = 0; k < 16; ++k) {
                const float4 a0 = *(const float4*)(As + k * 132 + ty * 8), a1 = *(const float4*)(As + k * 132 + ty * 8 + 4);
                const float4 b = *(const float4*)(Bs + k * 132 + tx * 4);
                const float a[8] = {a0.x, a0.y, a0.z, a0.w, a1.x, a1.y, a1.z, a1.w};
#pragma unroll
                for (int i = 0; i < 8; ++i) { acc[i][0] += a[i] * b.x; acc[i][1] += a[i] * b.y; acc[i][2] += a[i] * b.z; acc[i][3] += a[i] * b.w; }
            }
        }
#pragma unroll
        for (int i = 0; i < 8; ++i) {
            const size_t row = (size_t)tm * 128 + ty * 8 + i; const int col = tn * 128 + tx * 4;
            if (OUTMODE == 0) {
                ushort4 o; o.x = f2bf(acc[i][0]); o.y = f2bf(acc[i][1]); o.z = f2bf(acc[i][2]); o.w = f2bf(acc[i][3]);
                *(ushort4*)((bf16_t*)Cv + row * ldc + col) = o;
            } else if (OUTMODE == 1) {
                *(float4*)((float*)Cv + row * ldc + col) = make_float4(acc[i][0], acc[i][1], acc[i][2], acc[i][3]);
            } else {
                const float4 r = *(const float4*)(R + row * ldr + col);
                *(float4*)((float*)Cv + row * ldc + col) = make_float4(r.x + acc[i][0], r.y + acc[i][1], r.z + acc[i][2], r.w + acc[i][3]);
            }
        }
    }
}

#define WS_HS WS_H
#define WS_VG WS_YPRE
#define WS_DEC (WS_YPRE + (size_t)MTOK * 256 * 2)

__device__ __forceinline__ float quad_sum(float v) {
    v += __int_as_float(__builtin_amdgcn_mov_dpp(__float_as_int(v), 0xB1, 0xF, 0xF, true));
    v += __int_as_float(__builtin_amdgcn_mov_dpp(__float_as_int(v), 0x4E, 0xF, 0xF, true));
    return v;
}
__device__ __forceinline__ float bflo(unsigned w) { return __uint_as_float(w << 16); }
__device__ __forceinline__ float bfhi(unsigned w) { return __uint_as_float(w & 0xffff0000u); }

__device__ __forceinline__ float oct_sum(float v) {
    v += __int_as_float(__builtin_amdgcn_mov_dpp(__float_as_int(v), 0xB1, 0xF, 0xF, true));
    v += __int_as_float(__builtin_amdgcn_mov_dpp(__float_as_int(v), 0x4E, 0xF, 0xF, true));
    v += __int_as_float(__builtin_amdgcn_mov_dpp(__float_as_int(v), 0x141, 0xF, 0xF, true));
    return v;
}
__device__ __forceinline__ void unpack8(const uint4 r, float (&o)[8]) {
    o[0] = bflo(r.x); o[1] = bfhi(r.x); o[2] = bflo(r.y); o[3] = bfhi(r.y); o[4] = bflo(r.z); o[5] = bfhi(r.z); o[6] = bflo(r.w); o[7] = bfhi(r.w);
}
__device__ __forceinline__ uint4 pack8(const float (&v)[8]) {
    uint4 o; o.x = pk_bf16(v[0], v[1]); o.y = pk_bf16(v[2], v[3]); o.z = pk_bf16(v[4], v[5]); o.w = pk_bf16(v[6], v[7]); return o;
}
__device__ __forceinline__ void load8f(const float* p, float (&o)[8]) {
    const float4 a = *(const float4*)p, b = *(const float4*)(p + 4);
    o[0] = a.x; o[1] = a.y; o[2] = a.z; o[3] = a.w; o[4] = b.x; o[5] = b.y; o[6] = b.z; o[7] = b.w;
}
__device__ __forceinline__ void conv8(const bf16_t* P, size_t tok, int t, int pcol, const float* w, int ldw, int cc, float (&acc)[8]) {
#pragma unroll
    for (int j = 0; j < 4; ++j) {
        if (t - 3 + j >= 0) {
            float xv[8], wv[8];
            unpack8(*(const uint4*)(P + (tok - (size_t)(3 - j)) * LDP + pcol), xv);
            load8f(w + j * ldw + cc, wv);
#pragma unroll
            for (int i = 0; i < 8; ++i) acc[i] = __builtin_fmaf(wv[i], xv[i], acc[i]);
        }
    }
}
__device__ __forceinline__ void conv8r(const uint4 (&xt)[4], int t, const float* w, int ldw, int cc, float (&acc)[8]) {
#pragma unroll
    for (int j = 0; j < 4; ++j) {
        float xv[8], wv[8];
        unpack8(xt[j], xv);
        load8f(w + j * ldw + cc, wv);
        const float m = (t - 3 + j >= 0) ? 1.f : 0.f;
#pragma unroll
        for (int i = 0; i < 8; ++i) acc[i] = __builtin_fmaf(wv[i] * m, xv[i], acc[i]);
    }
}
__device__ __forceinline__ void ph_scan_prep(const Ctx& p, int l) {
    const bf16_t* P = (const bf16_t*)(pws_() + WS_P);
    bf16_t* HS = (bf16_t*)(pws_() + WS_HS);
    bf16_t* VG = (bf16_t*)(pws_() + WS_VG);
    float* DEC = (float*)(pws_() + WS_DEC);
    float* SC = (float*)(pws_() + WS_SC);
    const float* scw = pin_(4) + (size_t)l * 4 * 512;
    const float* scb = pin_(5) + (size_t)l * 512;
    const float* gcw = pin_(10) + (size_t)l * 4 * 768;
    const float* wg = pin_(14) + (size_t)l * 16 * 128;
    const float* bg = pin_(15) + (size_t)l * 128;
    const int lane = tid_() & 63;
    const int hsc = lane & 3, wsc = (lane >> 2) & 3;
    const float k_dtb = pin_(6)[l * 4 + hsc], k_alog = __expf(pin_(7)[l * 4 + hsc]), k_galog = __expf(pin_(11)[l * 4 + hsc]), k_gdtb = pin_(12)[l * 4 + hsc];
    const int sccol = wsc < 2 ? PC_DT + hsc : (wsc == 2 ? PC_GA + hsc : PC_GB + hsc);
    for (int tok = gwave(); tok < MTOK; tok += nwaves()) {
        const int t = tok % SEQ;
        const size_t row = (size_t)tok * LDP;
        uint4 xa[4], xq[4], xv4[4];
#pragma unroll
        for (int j = 0; j < 4; ++j) {
            const size_t rj = (t - 3 + j >= 0) ? row - (size_t)(3 - j) * LDP : row;
            xa[j] = *(const uint4*)(P + rj + PC_XBC + 8 * lane);
            xq[j] = *(const uint4*)(P + rj + PC_GQKV + 8 * lane);
            xv4[j] = *(const uint4*)(P + rj + PC_GQKV + 512 + 8 * (lane & 31));
        }
        const uint4 gl0 = *(const uint4*)(P + row + PC_GLR), gl1 = *(const uint4*)(P + row + PC_GLR + 8);
        const float scraw = bf2f(P[row + sccol]);
        {
            float acc[8];
            load8f(scb + 8 * lane, acc);
            conv8r(xa, t, scw, 512, 8 * lane, acc);
#pragma unroll
            for (int i = 0; i < 8; ++i) acc[i] = silu_f(acc[i]);
            *(uint4*)(HS + (size_t)tok * 1024 + 8 * lane) = pack8(acc);
        }
        {
            float acc[8];
#pragma unroll
            for (int i = 0; i < 8; ++i) acc[i] = 0.f;
            conv8r(xq, t, gcw, 768, 8 * lane, acc);
            float ss = 0.f;
#pragma unroll
            for (int i = 0; i < 8; ++i) { acc[i] = silu_f(acc[i]); ss += acc[i] * acc[i]; }
            ss = oct_sum(ss);
            const float sc = rsqrtf(ss + EPS) * (lane < 32 ? 0.125f : 1.f);
#pragma unroll
            for (int i = 0; i < 8; ++i) acc[i] *= sc;
            *(uint4*)(HS + (size_t)tok * 1024 + 512 + 8 * lane) = pack8(acc);
        }
        {
            float acc[8];
#pragma unroll
            for (int i = 0; i < 8; ++i) acc[i] = 0.f;
            conv8r(xv4, t, gcw, 768, 512 + 8 * (lane & 31), acc);
#pragma unroll
            for (int i = 0; i < 8; ++i) acc[i] = silu_f(acc[i]);
            if (lane < 32) *(uint4*)(VG + (size_t)tok * 256 + 8 * lane) = pack8(acc);
        }
        {
            float v;
            if (wsc < 2) { const float dt = softplus_f(scraw + k_dtb); v = wsc == 0 ? dt : __expf(-dt * k_alog); }
            else if (wsc == 2) v = __expf(-k_galog * softplus_f(scraw + k_gdtb));
            else v = sigmoid_f(scraw);
            if (lane < 16) SC[(size_t)tok * 16 + lane] = v;
        }
        {
            float gl[16];
            { float a8[8], b8[8]; unpack8(gl0, a8); unpack8(gl1, b8);
#pragma unroll
              for (int i = 0; i < 8; ++i) { gl[i] = a8[i]; gl[8 + i] = b8[i]; } }
#pragma unroll
            for (int i = 0; i < 2; ++i) {
                const int c = lane + 64 * i;
                float acc = bg[c];
#pragma unroll
                for (int r = 0; r < 16; ++r) acc = __builtin_fmaf(gl[r], wg[r * 128 + c], acc);
                DEC[(size_t)tok * 128 + c] = __expf(logsigmoid_f(acc) * (1.f / 16.f));
            }
        }
    }
}

#define SCAN_LDS_WAVE 4608
typedef float f2_t __attribute__((ext_vector_type(2)));
__device__ __forceinline__ f2_t mk2(float a, float b) { f2_t r; r.x = a; r.y = b; return r; }
__device__ __forceinline__ void st8f(char* dst, const uint4 v) {
    *(float4*)dst = make_float4(bflo(v.x), bfhi(v.x), bflo(v.y), bfhi(v.y));
    *(float4*)(dst + 16) = make_float4(bflo(v.z), bfhi(v.z), bflo(v.w), bfhi(v.w));
}
__device__ __forceinline__ void ph_scans(const Ctx& p, int l, float* smem) {
    const bf16_t* P = (const bf16_t*)(pws_() + WS_P);
    const bf16_t* HS = (const bf16_t*)(pws_() + WS_HS);
    const bf16_t* VG = (const bf16_t*)(pws_() + WS_VG);
    const float* DEC = (const float*)(pws_() + WS_DEC);
    const float* SC = (const float*)(pws_() + WS_SC);
    bf16_t* Y = (bf16_t*)(pws_() + WS_Y);
    const int tid = tid_(), lane = tid & 63, wave = tid >> 6;
    if (nblk_() != 256) return;
    const int role = wave < 2 ? 0 : (wave < 6 ? 1 : 2);
    const int idx = (role == 0 ? wave : (role == 1 ? wave - 2 : wave - 6)) * 256 + bid_();
    const int bh = role == 1 ? (idx >> 3) : (idx >> 2), b = bh >> 2, h = bh & 3;
    const int colbase = role == 1 ? (idx & 7) * 8 : (idx & 3) * 16;
    const int cl = role == 1 ? (lane >> 3) : (lane >> 2);
    const int col = colbase + cl;
    const int sq = role == 1 ? (lane & 7) : (lane & 3);
    const size_t tb = (size_t)b * SEQ;
    bf16_t* dummy = (bf16_t*)(pws_() + WS_DUMMY) + (tid & 511) * 8;
    char* lw = (char*)smem + wave * SCAN_LDS_WAVE;
    char* lrow = lw;
    char* lcol = lw + 4096;
    float* lsc = (float*)(lw + 4352);
    const int fs = lane >> 3, fp = lane & 7;
    if (role == 0) {
        const int g = h >> 1;
        const float Dh = pin_(8)[l * 4 + h];
        uint4 f0, f1; unsigned fc = 0u; float fsc = 0.f;
        f2_t st[8];
#pragma unroll
        for (int i = 0; i < 8; ++i) st[i] = mk2(0.f, 0.f);
        auto fetch = [&](int t0) {
            const size_t tok = tb + t0 + fs;
            const bf16_t* src = HS + tok * 1024 + (fp < 4 ? 256 + g * 64 + fp * 16 : 384 + g * 64 + (fp - 4) * 16);
            f0 = *(const uint4*)src; f1 = *(const uint4*)(src + 8);
            fc = *(const unsigned*)(HS + tok * 1024 + h * 64 + colbase + fp * 2);
            if (lane < 16) fsc = SC[(tb + t0 + (lane >> 1)) * 16 + (lane & 1) * 4 + h];
        };
        fetch(0);
        for (int t0 = 0; t0 < SEQ; t0 += 8) {
            st8f(lrow + fs * 512 + fp * 64, f0); st8f(lrow + fs * 512 + fp * 64 + 32, f1);
            *(unsigned*)(lcol + fs * 32 + fp * 4) = fc;
            if (lane < 16) lsc[lane] = fsc;
            if (t0 + 8 < SEQ) fetch(t0 + 8);
#pragma unroll
            for (int i = 0; i < 8; ++i) {
                const char* rb = lrow + i * 512 + sq * 64;
                const float4 b0 = *(const float4*)rb, b1 = *(const float4*)(rb + 16), b2 = *(const float4*)(rb + 32), b3 = *(const float4*)(rb + 48);
                const float4 c0 = *(const float4*)(rb + 256), c1 = *(const float4*)(rb + 272), c2 = *(const float4*)(rb + 288), c3 = *(const float4*)(rb + 304);
                const float xv = bf2f(*(const bf16_t*)(lcol + i * 32 + cl * 2));
                const float2 sc2 = *(const float2*)(lsc + i * 2);
                const float xdt = xv * sc2.x;
                const f2_t xd2 = mk2(xdt, xdt), dA2 = mk2(sc2.y, sc2.y);
                const f2_t bb[8] = {mk2(b0.x, b0.y), mk2(b0.z, b0.w), mk2(b1.x, b1.y), mk2(b1.z, b1.w), mk2(b2.x, b2.y), mk2(b2.z, b2.w), mk2(b3.x, b3.y), mk2(b3.z, b3.w)};
                const f2_t cc[8] = {mk2(c0.x, c0.y), mk2(c0.z, c0.w), mk2(c1.x, c1.y), mk2(c1.z, c1.w), mk2(c2.x, c2.y), mk2(c2.z, c2.w), mk2(c3.x, c3.y), mk2(c3.z, c3.w)};
                f2_t ya = mk2(0.f, 0.f), yb = mk2(0.f, 0.f);
#pragma unroll
                for (int q = 0; q < 8; q += 2) {
                    st[q] = st[q] * dA2 + xd2 * bb[q]; st[q + 1] = st[q + 1] * dA2 + xd2 * bb[q + 1];
                    ya = cc[q] * st[q] + ya; yb = cc[q + 1] * st[q + 1] + yb;
                }
                const f2_t ys = ya + yb;
                const float y = quad_sum(ys.x + ys.y);
                *(sq == 0 ? Y + (tb + t0 + i) * DM + h * 64 + col : dummy + i) = f2bf(y + Dh * xv);
                if (i & 1) __builtin_amdgcn_sched_barrier(0);
            }
        }
    } else if (role == 1) {
        uint4 f0, f1; unsigned fc = 0u; float fsc = 0.f;
        f2_t S[4];
#pragma unroll
        for (int i = 0; i < 4; ++i) S[i] = mk2(0.f, 0.f);
        auto fetch = [&](int t0) {
            const size_t tok = tb + t0 + fs;
            const bf16_t* src = HS + tok * 1024 + (fp < 4 ? 512 + h * 64 + fp * 16 : 768 + h * 64 + (fp - 4) * 16);
            f0 = *(const uint4*)src; f1 = *(const uint4*)(src + 8);
            if (fp < 4) fc = *(const unsigned*)(VG + tok * 256 + h * 64 + colbase + fp * 2);
            if (lane < 16) fsc = SC[(tb + t0 + (lane >> 1)) * 16 + 8 + (lane & 1) * 4 + h];
        };
        fetch(0);
        for (int t0 = 0; t0 < SEQ; t0 += 8) {
            st8f(lrow + fs * 512 + fp * 64, f0); st8f(lrow + fs * 512 + fp * 64 + 32, f1);
            if (fp < 4) *(unsigned*)(lcol + fs * 32 + fp * 4) = fc;
            if (lane < 16) lsc[lane] = fsc;
            if (t0 + 8 < SEQ) fetch(t0 + 8);
#pragma unroll
            for (int i = 0; i < 8; ++i) {
                const char* rb = lrow + i * 512 + sq * 32;
                const float4 q0 = *(const float4*)rb, q1 = *(const float4*)(rb + 16);
                const float4 k0 = *(const float4*)(rb + 256), k1 = *(const float4*)(rb + 272);
                const float vv = bf2f(*(const bf16_t*)(lcol + i * 32 + cl * 2));
                const float2 sc2 = *(const float2*)(lsc + i * 2);
                const f2_t al2 = mk2(sc2.x, sc2.x);
                const f2_t kk[4] = {mk2(k0.x, k0.y), mk2(k0.z, k0.w), mk2(k1.x, k1.y), mk2(k1.z, k1.w)};
                const f2_t qq[4] = {mk2(q0.x, q0.y), mk2(q0.z, q0.w), mk2(q1.x, q1.y), mk2(q1.z, q1.w)};
                f2_t ra = mk2(0.f, 0.f), rb2 = mk2(0.f, 0.f);
#pragma unroll
                for (int q = 0; q < 4; q += 2) {
                    S[q] = S[q] * al2; S[q + 1] = S[q + 1] * al2;
                    ra = S[q] * kk[q] + ra; rb2 = S[q + 1] * kk[q + 1] + rb2;
                }
                const f2_t rs = ra + rb2;
                const float r = oct_sum(rs.x + rs.y);
                const float vn = sc2.y * (vv - r);
                const f2_t vn2 = mk2(vn, vn);
                f2_t oa2 = mk2(0.f, 0.f), ob2 = mk2(0.f, 0.f);
#pragma unroll
                for (int q = 0; q < 4; q += 2) {
                    S[q] = kk[q] * vn2 + S[q]; S[q + 1] = kk[q + 1] * vn2 + S[q + 1];
                    oa2 = S[q] * qq[q] + oa2; ob2 = S[q + 1] * qq[q + 1] + ob2;
                }
                const f2_t os = oa2 + ob2;
                const float ov = oct_sum(os.x + os.y);
                *(sq == 0 ? Y + (tb + t0 + i) * DM + 256 + h * 64 + col : dummy + i) = f2bf(ov);
                if (i & 1) __builtin_amdgcn_sched_barrier(0);
            }
        }
    } else {
        uint4 f0, f1; unsigned fc = 0u;
        f2_t S[4];
#pragma unroll
        for (int i = 0; i < 4; ++i) S[i] = mk2(0.f, 0.f);
        auto fetch = [&](int t0) {
            const size_t tok = tb + t0 + fs;
            if (fp < 4) { const float* src = DEC + tok * 128 + h * 32 + fp * 8; f0 = *(const uint4*)src; f1 = *(const uint4*)(src + 4); }
            else { const bf16_t* src = P + tok * LDP + (fp < 6 ? PC_LK + h * 32 + (fp - 4) * 16 : PC_LQ + h * 32 + (fp - 6) * 16); f0 = *(const uint4*)src; f1 = *(const uint4*)(src + 8); }
            fc = *(const unsigned*)(P + tok * LDP + PC_LV + h * 64 + colbase + fp * 2);
        };
        fetch(0);
        for (int t0 = 0; t0 < SEQ; t0 += 8) {
            if (fp < 4) { *(uint4*)(lrow + fs * 512 + fp * 32) = f0; *(uint4*)(lrow + fs * 512 + fp * 32 + 16) = f1; }
            else { st8f(lrow + fs * 512 + 128 + (fp - 4) * 64, f0); st8f(lrow + fs * 512 + 128 + (fp - 4) * 64 + 32, f1); }
            *(unsigned*)(lcol + fs * 32 + fp * 4) = fc;
            if (t0 + 8 < SEQ) fetch(t0 + 8);
#pragma unroll
            for (int i = 0; i < 8; ++i) {
                const char* rb = lrow + i * 512 + sq * 32;
                const float4 d0 = *(const float4*)rb, d1 = *(const float4*)(rb + 16);
                const float4 k0 = *(const float4*)(rb + 128), k1 = *(const float4*)(rb + 144);
                const float4 q0 = *(const float4*)(rb + 256), q1 = *(const float4*)(rb + 272);
                const float vv = bf2f(*(const bf16_t*)(lcol + i * 32 + cl * 2));
                const f2_t v2 = mk2(vv, vv);
                const f2_t dd[4] = {mk2(d0.x, d0.y), mk2(d0.z, d0.w), mk2(d1.x, d1.y), mk2(d1.z, d1.w)};
                const f2_t kk[4] = {mk2(k0.x, k0.y), mk2(k0.z, k0.w), mk2(k1.x, k1.y), mk2(k1.z, k1.w)};
                const f2_t qq[4] = {mk2(q0.x, q0.y), mk2(q0.z, q0.w), mk2(q1.x, q1.y), mk2(q1.z, q1.w)};
                f2_t oa2 = mk2(0.f, 0.f), ob2 = mk2(0.f, 0.f);
#pragma unroll
                for (int q = 0; q < 4; q += 2) {
                    S[q] = dd[q] * S[q] + kk[q] * v2; S[q + 1] = dd[q + 1] * S[q + 1] + kk[q + 1] * v2;
                    oa2 = S[q] * qq[q] + oa2; ob2 = S[q + 1] * qq[q + 1] + ob2;
                }
                const f2_t os = oa2 + ob2;
                const float ov = quad_sum(os.x + os.y);
                *(sq == 0 ? Y + (tb + t0 + i) * DM + 512 + h * 64 + col : dummy + i) = f2bf(ov * 0.17677669529663687f);
                if (i & 1) __builtin_amdgcn_sched_barrier(0);
            }
        }
    }
}

__device__ __forceinline__ void ph_mixer_finish(const Ctx& p, int l) {
    const bf16_t* P = (const bf16_t*)(pws_() + WS_P);
    bf16_t* Y = (bf16_t*)(pws_() + WS_Y);
    const float* sn = pin_(9) + (size_t)l * 256;
    const float* gn = pin_(13) + (size_t)l * 64;
    const float* ln = pin_(16) + (size_t)l * 64;
    const int lane = tid_() & 63;
    for (int tok = gwave(); tok < MTOK; tok += nwaves()) {
        const size_t row = (size_t)tok * LDP;
        {
            float v[8], gt[8], gw[8];
            unpack8(*(const uint4*)(Y + (size_t)tok * DM + 8 * lane), v);
            unpack8(*(const uint4*)(P + row + (lane < 32 ? PC_Z + 8 * lane : PC_GG + 8 * (lane - 32))), gt);
            load8f(lane < 32 ? sn + 8 * lane : gn + 8 * (lane & 7), gw);
            float ss = 0.f;
            if (lane < 32) {
#pragma unroll
                for (int i = 0; i < 8; ++i) { v[i] *= silu_f(gt[i]); ss += v[i] * v[i]; }
            } else {
#pragma unroll
                for (int i = 0; i < 8; ++i) ss += v[i] * v[i];
            }
            const float s8 = oct_sum(ss);
            float s32 = s8 + __int_as_float(__builtin_amdgcn_mov_dpp(__float_as_int(s8), 0x140, 0xF, 0xF, true));
            s32 += __shfl_xor(s32, 16, 64);
            const float rs = lane < 32 ? rsqrtf(s32 * (1.f / 256.f) + EPS) : rsqrtf(s8 * (1.f / 64.f) + EPS);
            float o[8];
#pragma unroll
            for (int i = 0; i < 8; ++i) o[i] = lane < 32 ? v[i] * rs * gw[i] : v[i] * rs * gw[i] * silu_f(gt[i]);
            *(uint4*)(Y + (size_t)tok * DM + 8 * lane) = pack8(o);
        }
        if (lane < 32) {
            float v[8], gt[8], gw[8];
            unpack8(*(const uint4*)(Y + (size_t)tok * DM + 512 + 8 * lane), v);
            unpack8(*(const uint4*)(P + row + PC_LR + 8 * lane), gt);
            load8f(ln + 8 * (lane & 7), gw);
            float ss = 0.f;
#pragma unroll
            for (int i = 0; i < 8; ++i) ss += v[i] * v[i];
            const float rs = rsqrtf(oct_sum(ss) * (1.f / 64.f) + EPS);
            float o[8];
#pragma unroll
            for (int i = 0; i < 8; ++i) o[i] = v[i] * rs * gw[i] * silu_f(gt[i]);
            *(uint4*)(Y + (size_t)tok * DM + 512 + 8 * lane) = pack8(o);
        }
    }
}

typedef short bf16x8_t __attribute__((ext_vector_type(8)));
typedef float f32x4_t __attribute__((ext_vector_type(4)));
union BF8 { bf16x8_t v; uint4 u; unsigned w[4]; };


__device__ __forceinline__ void ph_dsa_prep(const Ctx& p, int l) {
    const bf16_t* P = (const bf16_t*)(pws_() + WS_P);
    bf16_t* qn = (bf16_t*)(pws_() + WS_QN);
    bf16_t* kn = (bf16_t*)(pws_() + WS_KN);
    bf16_t* ikn = (bf16_t*)(pws_() + WS_IKN);
    bf16_t* vt = (bf16_t*)(pws_() + WS_VT);
    const float* qg = pin_(17) + (size_t)l * 64;
    const float* kg = pin_(18) + (size_t)l * 64;
    const float* ig = pin_(19) + (size_t)l * 32;
    const int lane = tid_() & 63;
    const int pcol = lane < 40 ? PC_DQ + 8 * lane : PC_IK + 8 * (lane & 3);
    float gw[8];
    load8f(lane < 32 ? qg + 8 * (lane & 7) : (lane < 40 ? kg + 8 * (lane & 7) : ig + 8 * (lane & 3)), gw);
    for (int grp = gwave(); grp < MTOK / 8; grp += nwaves()) {
        const size_t tok0 = (size_t)grp * 8;
        const int b = (int)(tok0 / SEQ), t0 = (int)(tok0 % SEQ);
        unsigned short vv[8];
#pragma unroll
        for (int i = 0; i < 8; ++i) {
            const size_t row = (tok0 + i) * LDP;
            vv[i] = P[row + PC_DV + lane];
            if (lane < 44) {
                float v[8];
                unpack8(*(const uint4*)(P + row + pcol), v);
                float ss = 0.f;
#pragma unroll
                for (int q = 0; q < 8; ++q) ss += v[q] * v[q];
                const float s4 = ss + __int_as_float(__builtin_amdgcn_mov_dpp(__float_as_int(ss), 0xB1, 0xF, 0xF, true));
                const float s4b = s4 + __int_as_float(__builtin_amdgcn_mov_dpp(__float_as_int(s4), 0x4E, 0xF, 0xF, true));
                const float s8 = s4b + __int_as_float(__builtin_amdgcn_mov_dpp(__float_as_int(s4b), 0x141, 0xF, 0xF, true));
                const float rs = lane < 40 ? rsqrtf(s8 * (1.f / 64.f) + EPS) * (lane < 32 ? 0.125f : 1.f) : rsqrtf(s4b * (1.f / 32.f) + EPS);
                float o[8];
#pragma unroll
                for (int q = 0; q < 8; ++q) o[q] = v[q] * rs * gw[q];
                const uint4 pk = pack8(o);
                if (lane < 32) *(uint4*)(qn + (tok0 + i) * 256 + 8 * lane) = pk;
                else if (lane < 40) *(uint4*)(kn + (tok0 + i) * 64 + 8 * (lane - 32)) = pk;
                else *(uint4*)(ikn + (tok0 + i) * 32 + 8 * (lane - 40)) = pk;
            }
        }
        uint4 o; o.x = (unsigned)vv[0] | ((unsigned)vv[1] << 16); o.y = (unsigned)vv[2] | ((unsigned)vv[3] << 16);
        o.z = (unsigned)vv[4] | ((unsigned)vv[5] << 16); o.w = (unsigned)vv[6] | ((unsigned)vv[7] << 16);
        *(uint4*)(vt + ((size_t)b * 64 + lane) * SEQ + t0) = o;
    }
}

#define DSA_STRIDE 2052
__device__ __forceinline__ void ph_dsa_main(const Ctx& p, int l, float* smem) {
    const bf16_t* P = (const bf16_t*)(pws_() + WS_P);
    bf16_t* Y = (bf16_t*)(pws_() + WS_Y);
    const bf16_t* QN = (const bf16_t*)(pws_() + WS_QN);
    const bf16_t* KN = (const bf16_t*)(pws_() + WS_KN);
    const bf16_t* IKN = (const bf16_t*)(pws_() + WS_IKN);
    const bf16_t* VT = (const bf16_t*)(pws_() + WS_VT);
    unsigned* sc = (unsigned*)smem;
    float* part = smem;
    float* plsum = smem + 8 * 64 * 64;
    unsigned* thr = (unsigned*)(smem + 35000);
    const int tid = tid_(), lane = tid & 63, w = tid >> 6, qi = lane & 15, g = lane >> 4;
    for (int task = bid_(); task < MTOK / 16; task += nblk_()) {
        const int c = 31 - task / 128, b = (task >> 2) & 31, sub = task & 3;
        const int t0 = c * 64 + sub * 16, nk = (c + 1) * 64;
        const size_t tok0 = (size_t)b * SEQ + t0;
        const bool dosel = nk > 256;
        if (dosel) {
            BF8 iqf[8]; float wq[8];
#pragma unroll
            for (int h = 0; h < 8; ++h) {
                iqf[h].u = *(const uint4*)(P + (tok0 + qi) * LDP + PC_IQ + h * 32 + 8 * g);
                wq[h] = bf2f(P[(tok0 + qi) * LDP + PC_IW + h]) * 0.0625f;
            }
            for (int kt = w; kt < nk / 16; kt += 8) {
                const int s0 = kt * 16;
                BF8 ka; ka.u = *(const uint4*)(IKN + ((size_t)b * SEQ + s0 + qi) * 32 + 8 * g);
                float acc[4] = {0.f, 0.f, 0.f, 0.f};
#pragma unroll
                for (int h = 0; h < 8; ++h) {
                    const f32x4_t d = __builtin_amdgcn_mfma_f32_16x16x32_bf16(ka.v, iqf[h].v, (f32x4_t){0.f, 0.f, 0.f, 0.f}, 0, 0, 0);
#pragma unroll
                    for (int r = 0; r < 4; ++r) acc[r] = __builtin_fmaf(wq[h], fmaxf(d[r], 0.f), acc[r]);
                }
                uint4 kv; kv.x = ford(acc[0]); kv.y = ford(acc[1]); kv.z = ford(acc[2]); kv.w = ford(acc[3]);
                *(uint4*)(sc + qi * DSA_STRIDE + s0 + 4 * g) = kv;
            }
        }
        __syncthreads();
        if (dosel) {
            const int nj = nk >> 6;
#pragma unroll 1
            for (int qq = 0; qq < 2; ++qq) {
                const int q = 2 * w + qq;
                unsigned kreg[32];
#pragma unroll
                for (int j = 0; j < 32; ++j) kreg[j] = (j < nj) ? sc[q * DSA_STRIDE + j * 64 + lane] : 0u;
                unsigned T = 0u; bool exact = false;
                for (int bit = 31; bit >= 0; --bit) {
                    const unsigned cand = T | (1u << bit);
                    int cnt = 0;
#pragma unroll
                    for (int j = 0; j < 32; ++j) cnt += __popcll(__ballot(kreg[j] >= cand));
                    if (cnt >= 256) { T = cand; if (cnt == 256) { exact = true; break; } }
                }
                int cut = 0x7fffffff;
                if (!exact) {
                    int cgt = 0, ceq = 0;
#pragma unroll
                    for (int j = 0; j < 32; ++j) { cgt += __popcll(__ballot(kreg[j] > T)); ceq += __popcll(__ballot(kreg[j] == T)); }
                    int need = 256 - cgt;
                    if (ceq > need) {
                        bool found = false;
#pragma unroll
                        for (int j = 0; j < 32; ++j) {
                            const unsigned long long m = __ballot(kreg[j] == T);
                            const int cj = __popcll(m);
                            if (!found) {
                                if (need <= cj) { for (int bpos = 0; bpos < 64; ++bpos) if ((m >> bpos) & 1ull) { if (--need == 0) { cut = j * 64 + bpos; break; } } found = true; }
                                else need -= cj;
                            }
                        }
                    }
                }
                if (lane == 0) { thr[q] = T; thr[16 + q] = (unsigned)cut; }
            }
        }
        __syncthreads();
        unsigned Tq = 0u; int cutq = 0x7fffffff;
        if (dosel) { Tq = thr[qi]; cutq = (int)thr[16 + qi]; }
        f32x4_t oacc[4][4]; float lsum[4];
#pragma unroll
        for (int h = 0; h < 4; ++h) { lsum[h] = 0.f;
#pragma unroll
            for (int dt = 0; dt < 4; ++dt) oacc[h][dt] = (f32x4_t){0.f, 0.f, 0.f, 0.f}; }
        const int krow = 8 * (qi >> 2) + (qi & 3);
        for (int st = w; st < nk / 32; st += 8) {
            const int s0 = st * 32;
            BF8 ka[2][2], va[4];
#pragma unroll
            for (int t = 0; t < 2; ++t)
#pragma unroll
                for (int s2 = 0; s2 < 2; ++s2) ka[t][s2].u = *(const uint4*)(KN + ((size_t)b * SEQ + s0 + krow + 4 * t) * 64 + 32 * s2 + 8 * g);
#pragma unroll
            for (int dt = 0; dt < 4; ++dt) va[dt].u = *(const uint4*)(VT + ((size_t)b * 64 + 16 * dt + qi) * SEQ + s0 + 8 * g);
            float mk[8];
            if (dosel) {
                const uint4 k0 = *(const uint4*)(sc + qi * DSA_STRIDE + s0 + 8 * g), k1 = *(const uint4*)(sc + qi * DSA_STRIDE + s0 + 8 * g + 4);
                const unsigned kk[8] = {k0.x, k0.y, k0.z, k0.w, k1.x, k1.y, k1.z, k1.w};
#pragma unroll
                for (int j = 0; j < 8; ++j) mk[j] = (kk[j] > Tq || (kk[j] == Tq && (s0 + 8 * g + j) <= cutq)) ? 1.f : 0.f;
            } else {
#pragma unroll
                for (int j = 0; j < 8; ++j) mk[j] = 1.f;
            }
#pragma unroll
            for (int h = 0; h < 4; ++h) {
                BF8 q0, q1;
                q0.u = *(const uint4*)(QN + (tok0 + qi) * 256 + h * 64 + 8 * g);
                q1.u = *(const uint4*)(QN + (tok0 + qi) * 256 + h * 64 + 32 + 8 * g);
                f32x4_t sacc[2];
#pragma unroll
                for (int t = 0; t < 2; ++t) {
                    sacc[t] = __builtin_amdgcn_mfma_f32_16x16x32_bf16(ka[t][0].v, q0.v, (f32x4_t){0.f, 0.f, 0.f, 0.f}, 0, 0, 0);
                    sacc[t] = __builtin_amdgcn_mfma_f32_16x16x32_bf16(ka[t][1].v, q1.v, sacc[t], 0, 0, 0);
                }
                float pe[8];
#pragma unroll
                for (int t = 0; t < 2; ++t)
#pragma unroll
                    for (int r = 0; r < 4; ++r) { pe[4 * t + r] = __expf(sacc[t][r]) * mk[4 * t + r]; lsum[h] += pe[4 * t + r]; }
                BF8 pf;
#pragma unroll
                for (int j = 0; j < 4; ++j) pf.w[j] = pk_bf16(pe[2 * j], pe[2 * j + 1]);
#pragma unroll
                for (int dt = 0; dt < 4; ++dt) oacc[h][dt] = __builtin_amdgcn_mfma_f32_16x16x32_bf16(va[dt].v, pf.v, oacc[h][dt], 0, 0, 0);
            }
        }
        __syncthreads();
#pragma unroll
        for (int h = 0; h < 4; ++h) {
            plsum[(w * 4 + h) * 64 + lane] = lsum[h];
#pragma unroll
            for (int dt = 0; dt < 4; ++dt)
#pragma unroll
                for (int r = 0; r < 4; ++r) part[(w * 64 + h * 16 + dt * 4 + r) * 64 + lane] = oacc[h][dt][r];
        }
        __syncthreads();
        {
            const int h = w >> 1;
            float lq = 0.f;
#pragma unroll
            for (int w2 = 0; w2 < 8; ++w2)
#pragma unroll
                for (int g2 = 0; g2 < 4; ++g2) lq += plsum[(w2 * 4 + h) * 64 + qi + 16 * g2];
            const float inv = 1.f / lq;
#pragma unroll
            for (int dd = 0; dd < 2; ++dd) {
                const int dt = (w & 1) * 2 + dd;
                float o[4];
#pragma unroll
                for (int r = 0; r < 4; ++r) {
                    float sacc = 0.f;
#pragma unroll
                    for (int w2 = 0; w2 < 8; ++w2) sacc += part[(w2 * 64 + h * 16 + dt * 4 + r) * 64 + lane];
                    o[r] = sacc * inv;
                }
                uint2 ov; ov.x = pk_bf16(o[0], o[1]); ov.y = pk_bf16(o[2], o[3]);
                *(uint2*)(Y + (tok0 + qi) * DM + 768 + h * 64 + 16 * dt + 4 * g) = ov;
            }
        }
        __syncthreads();
    }
}

__device__ __forceinline__ void ph_mem_prep(const Ctx& p, int l) {
    const float* Km = (const float*)(pws_() + WS_KM);
    const float* Vm = (const float*)(pws_() + WS_VM);
    bf16_t* KB = (bf16_t*)(pws_() + WS_KB);
    bf16_t* VTB = (bf16_t*)(pws_() + WS_VTB);
    const float* kg = pin_(28) + (size_t)l * 64;
    const int lane = tid_() & 63;
    for (int r = gwave(); r < MMEM; r += nwaves()) {
        const int b = r / NMEM, j = r % NMEM;
#pragma unroll
        for (int h = 0; h < 4; ++h) {
            const float v = Km[(size_t)r * 256 + h * 64 + lane];
            const float ss = wave_sum(v * v);
            KB[(((size_t)b * 4 + h) * NMEM + j) * 64 + lane] = f2bf(v * rsqrtf(ss * (1.f / 64.f) + EPS) * kg[lane]);
            VTB[(((size_t)b * 4 + h) * 64 + lane) * NMEM + j] = f2bf(Vm[(size_t)r * 256 + h * 64 + lane]);
        }
    }
}
__device__ __forceinline__ void ph_xattn(const Ctx& p, int l) {
    const float* Qx = (const float*)(pws_() + WS_QX);
    bf16_t* Ox = (bf16_t*)(pws_() + WS_OX);
    const bf16_t* KB = (const bf16_t*)(pws_() + WS_KB);
    const bf16_t* VTB = (const bf16_t*)(pws_() + WS_VTB);
    const float* qg = pin_(27) + (size_t)l * 64;
    const int lane = tid_() & 63, qi = lane & 15, g = lane >> 4;
    for (int task = gwave(); task < MTOK / 16; task += nwaves()) {
        const int tok0 = task * 16, b = tok0 / SEQ;
#pragma unroll 1
        for (int h = 0; h < 4; ++h) {
            BF8 qf[2];
            {
                float qv[2][8]; float ss = 0.f;
#pragma unroll
                for (int s2 = 0; s2 < 2; ++s2) {
                    const float4* qp = (const float4*)(Qx + (size_t)(tok0 + qi) * 256 + h * 64 + 32 * s2 + 8 * g);
                    const float4 a = qp[0], c = qp[1];
                    qv[s2][0] = a.x; qv[s2][1] = a.y; qv[s2][2] = a.z; qv[s2][3] = a.w; qv[s2][4] = c.x; qv[s2][5] = c.y; qv[s2][6] = c.z; qv[s2][7] = c.w;
#pragma unroll
                    for (int j = 0; j < 8; ++j) ss += qv[s2][j] * qv[s2][j];
                }
                ss += __shfl_xor(ss, 16, 64); ss += __shfl_xor(ss, 32, 64);
                const float rs = rsqrtf(ss * (1.f / 64.f) + EPS) * 0.125f;
#pragma unroll
                for (int s2 = 0; s2 < 2; ++s2) {
                    const float4 g0 = *(const float4*)(qg + 32 * s2 + 8 * g), g1 = *(const float4*)(qg + 32 * s2 + 8 * g + 4);
                    qf[s2].w[0] = pk_bf16(qv[s2][0] * rs * g0.x, qv[s2][1] * rs * g0.y); qf[s2].w[1] = pk_bf16(qv[s2][2] * rs * g0.z, qv[s2][3] * rs * g0.w);
                    qf[s2].w[2] = pk_bf16(qv[s2][4] * rs * g1.x, qv[s2][5] * rs * g1.y); qf[s2].w[3] = pk_bf16(qv[s2][6] * rs * g1.z, qv[s2][7] * rs * g1.w);
                }
            }
            const bf16_t* Kh = KB + ((size_t)b * 4 + h) * NMEM * 64;
            const bf16_t* Vh = VTB + ((size_t)b * 4 + h) * 64 * NMEM;
            f32x4_t oacc[4];
#pragma unroll
            for (int dt = 0; dt < 4; ++dt) oacc[dt] = (f32x4_t){0.f, 0.f, 0.f, 0.f};
            float lsum = 0.f;
            const int krow = 8 * (qi >> 2) + (qi & 3);
#pragma unroll 2
            for (int s0 = 0; s0 < NMEM; s0 += 32) {
                BF8 ka[2][2], va[4];
#pragma unroll
                for (int t = 0; t < 2; ++t)
#pragma unroll
                    for (int s2 = 0; s2 < 2; ++s2) ka[t][s2].u = *(const uint4*)(Kh + (size_t)(s0 + krow + 4 * t) * 64 + 32 * s2 + 8 * g);
#pragma unroll
                for (int dt = 0; dt < 4; ++dt) va[dt].u = *(const uint4*)(Vh + (size_t)(16 * dt + qi) * NMEM + s0 + 8 * g);
                f32x4_t sacc[2];
#pragma unroll
                for (int t = 0; t < 2; ++t) {
                    sacc[t] = (f32x4_t){0.f, 0.f, 0.f, 0.f};
                    sacc[t] = __builtin_amdgcn_mfma_f32_16x16x32_bf16(ka[t][0].v, qf[0].v, sacc[t], 0, 0, 0);
                    sacc[t] = __builtin_amdgcn_mfma_f32_16x16x32_bf16(ka[t][1].v, qf[1].v, sacc[t], 0, 0, 0);
                }
                float pe[8];
#pragma unroll
                for (int t = 0; t < 2; ++t)
#pragma unroll
                    for (int r = 0; r < 4; ++r) { pe[4 * t + r] = __expf(sacc[t][r]); lsum += pe[4 * t + r]; }
                BF8 pf;
#pragma unroll
                for (int j = 0; j < 4; ++j) pf.w[j] = pk_bf16(pe[2 * j], pe[2 * j + 1]);
#pragma unroll
                for (int dt = 0; dt < 4; ++dt) oacc[dt] = __builtin_amdgcn_mfma_f32_16x16x32_bf16(va[dt].v, pf.v, oacc[dt], 0, 0, 0);
            }
            lsum += __shfl_xor(lsum, 16, 64); lsum += __shfl_xor(lsum, 32, 64);
            const float inv = 1.f / lsum;
#pragma unroll
            for (int dt = 0; dt < 4; ++dt) {
                uint2 o; o.x = pk_bf16(oacc[dt][0] * inv, oacc[dt][1] * inv); o.y = pk_bf16(oacc[dt][2] * inv, oacc[dt][3] * inv);
                *(uint2*)(Ox + (size_t)(tok0 + qi) * 256 + h * 64 + 16 * dt + 4 * g) = o;
            }
        }
    }
}

template <int N> __device__ __forceinline__ void bitonic_sort_desc(unsigned (&a)[N]) {
#pragma unroll
    for (int k = 2; k <= N; k <<= 1)
#pragma unroll
        for (int j = k >> 1; j > 0; j >>= 1)
#pragma unroll
            for (int i = 0; i < N; ++i) {
                const int o = i ^ j;
                if (o > i) {
                    const bool desc = ((i & k) == 0);
                    const unsigned x = a[i], y = a[o];
                    const unsigned mx = x > y ? x : y, mn = x > y ? y : x;
                    a[i] = desc ? mx : mn; a[o] = desc ? mn : mx;
                }
            }
}
__device__ __forceinline__ void bitonic_merge16_desc(unsigned (&a)[16]) {
#pragma unroll
    for (int j = 8; j > 0; j >>= 1)
#pragma unroll
        for (int i = 0; i < 16; ++i) {
            const int o = i ^ j;
            if (o > i) { const unsigned x = a[i], y = a[o]; a[i] = x > y ? x : y; a[o] = x > y ? y : x; }
        }
}
__device__ __forceinline__ void top16_merge(unsigned (&a)[16], const unsigned (&b)[16]) {
#pragma unroll
    for (int i = 0; i < 16; ++i) a[i] = a[i] > b[15 - i] ? a[i] : b[15 - i];
    bitonic_merge16_desc(a);
}
__device__ __forceinline__ void top16_xlane(unsigned (&a)[16], int xm) {
    unsigned b[16];
#pragma unroll
    for (int i = 0; i < 16; ++i) b[i] = (unsigned)__shfl_xor((int)a[i], xm, 64);
    top16_merge(a, b);
}
__device__ __forceinline__ void ph_subkeys_convert(const Ctx& p) {
    const float* sk = pin_(31);
    bf16_t* o = (bf16_t*)(pws_() + WS_SKB);
    const size_t n = (size_t)DEPTH * 8 * 2 * 128 * 64;
    for (size_t i = (size_t)bid_() * 512 + tid_(); i < n; i += (size_t)nblk_() * 512) o[i] = f2bf(sk[i]);
}
__device__ __forceinline__ void ph_peer_topk(const Ctx& p, int l, float* smem) {
    const bf16_t* Qp = (const bf16_t*)(pws_() + WS_QP);
    const bf16_t* SK = (const bf16_t*)(pws_() + WS_SKB) + (size_t)l * 8 * 2 * 128 * 64;
    int* pidx = (int*)(pws_() + WS_PEI);
    float* pgt = (float*)(pws_() + WS_PEG);
    const int tid = tid_(), lane = tid & 63, wave = tid >> 6, qi = lane & 15, g = lane >> 4;
    int* tabw = (int*)smem + wave * 512 + qi * 32;
    for (int task = gwave(); task < MTOK / 16; task += nwaves()) {
        const size_t tok = (size_t)task * 16 + qi;
#pragma unroll 1
        for (int h = 0; h < 8; ++h) {
            unsigned L[2][16];
#pragma unroll
            for (int pp = 0; pp < 2; ++pp) {
                BF8 qf[2];
#pragma unroll
                for (int s2 = 0; s2 < 2; ++s2) qf[s2].u = *(const uint4*)(Qp + tok * DM + h * 128 + pp * 64 + 32 * s2 + 8 * g);
                const bf16_t* skp = SK + (size_t)(h * 2 + pp) * 128 * 64;
                unsigned va[16], vb[16];
#pragma unroll
                for (int tile = 0; tile < 8; ++tile) {
                    BF8 ka[2];
#pragma unroll
                    for (int s2 = 0; s2 < 2; ++s2) ka[s2].u = *(const uint4*)(skp + (size_t)(16 * tile + qi) * 64 + 32 * s2 + 8 * g);
                    f32x4_t d = __builtin_amdgcn_mfma_f32_16x16x32_bf16(ka[0].v, qf[0].v, (f32x4_t){0.f, 0.f, 0.f, 0.f}, 0, 0, 0);
                    d = __builtin_amdgcn_mfma_f32_16x16x32_bf16(ka[1].v, qf[1].v, d, 0, 0, 0);
#pragma unroll
                    for (int r = 0; r < 4; ++r) {
                        const unsigned key = (ford(d[r]) & ~127u) | (unsigned)(127 - (16 * tile + 4 * g + r));
                        if (tile < 4) va[tile * 4 + r] = key; else vb[(tile - 4) * 4 + r] = key;
                    }
                }
                bitonic_sort_desc<16>(va);
                bitonic_sort_desc<16>(vb);
                top16_merge(va, vb);
                top16_xlane(va, 16);
                top16_xlane(va, 32);
#pragma unroll
                for (int i = 0; i < 16; ++i) L[pp][i] = va[i];
            }
            if (g < 2) {
#pragma unroll
                for (int i = 0; i < 16; ++i) tabw[g * 16 + i] = 127 - (int)((g == 0 ? L[0][i] : L[1][i]) & 127u);
            }
            float s1[16], s2v[16];
#pragma unroll
            for (int i = 0; i < 16; ++i) { s1[i] = funord(L[0][i] & ~127u); s2v[i] = funord(L[1][i] & ~127u); }
            unsigned ca[16], cb[16];
#pragma unroll
            for (int i = 0; i < 16; ++i) { ca[i] = 0u; cb[i] = 0u; }
            {
                const float r0 = g == 0 ? s1[0] : (g == 1 ? s1[1] : (g == 2 ? s1[2] : s1[3]));
                const int nb0 = g == 0 ? 16 : (g == 1 ? 8 : (g == 2 ? 5 : 4));
#pragma unroll
                for (int bq = 0; bq < 16; ++bq) if (bq < nb0) ca[bq] = (ford(r0 + s2v[bq]) & ~255u) | (unsigned)(255 - (g * 16 + bq));
                const float r1 = g == 0 ? s1[4] : (g == 1 ? s1[5] : (g == 2 ? s1[6] : s1[7]));
                const int nb1 = g == 0 ? 3 : 2;
#pragma unroll
                for (int bq = 0; bq < 3; ++bq) if (bq < nb1) cb[bq] = (ford(r1 + s2v[bq]) & ~255u) | (unsigned)(255 - ((g + 4) * 16 + bq));
                const float r2 = g == 0 ? s1[8] : (g == 1 ? s1[9] : (g == 2 ? s1[10] : s1[11]));
                cb[3] = (ford(r2 + s2v[0]) & ~255u) | (unsigned)(255 - ((g + 8) * 16));
                const float r3 = g == 0 ? s1[12] : (g == 1 ? s1[13] : (g == 2 ? s1[14] : s1[15]));
                cb[4] = (ford(r3 + s2v[0]) & ~255u) | (unsigned)(255 - ((g + 12) * 16));
            }
            bitonic_sort_desc<16>(ca);
            bitonic_sort_desc<16>(cb);
            top16_merge(ca, cb);
            top16_xlane(ca, 16);
            top16_xlane(ca, 32);
            float tv[16]; float den = 0.f;
#pragma unroll
            for (int i = 0; i < 16; ++i) {
                const int f = 255 - (int)(ca[i] & 255u);
                const int a = f >> 4, bq = f & 15;
                tv[i] = funord(ca[i] & ~255u);
                (void)a; (void)bq;
            }
#pragma unroll
            for (int i = 0; i < 16; ++i) { tv[i] = __expf(tv[i] - funord(ca[0] & ~255u)); den += tv[i]; }
            const float inv = 1.f / den;
            int ev[4]; float gv[4];
#pragma unroll
            for (int r = 0; r < 4; ++r) {
                const unsigned key = g == 0 ? ca[r] : (g == 1 ? ca[4 + r] : (g == 2 ? ca[8 + r] : ca[12 + r]));
                const float tvv = g == 0 ? tv[r] : (g == 1 ? tv[4 + r] : (g == 2 ? tv[8 + r] : tv[12 + r]));
                const int f = 255 - (int)(key & 255u);
                ev[r] = tabw[f >> 4] * 128 + tabw[16 + (f & 15)];
                gv[r] = tvv * inv;
            }
            *(int4*)(pidx + tok * 128 + h * 16 + 4 * g) = make_int4(ev[0], ev[1], ev[2], ev[3]);
            *(float4*)(pgt + tok * 128 + h * 16 + 4 * g) = make_float4(gv[0], gv[1], gv[2], gv[3]);
        }
    }
}

typedef _Float16 h2_t __attribute__((ext_vector_type(2)));
__device__ __forceinline__ h2_t as_h2(unsigned u) { union { unsigned u; h2_t h; } c; c.u = u; return c.h; }
#define U_SCALE 1024.f
#define V_SCALE 256.f
typedef float f32x2_t __attribute__((ext_vector_type(2)));
__device__ __forceinline__ unsigned pack4_fp8(float4 a, float sc) {
    const float x = fminf(fmaxf(a.x * sc, -448.f), 448.f), y = fminf(fmaxf(a.y * sc, -448.f), 448.f);
    const float z = fminf(fmaxf(a.z * sc, -448.f), 448.f), w = fminf(fmaxf(a.w * sc, -448.f), 448.f);
    int r = __builtin_amdgcn_cvt_pk_fp8_f32(x, y, 0, false);
    r = __builtin_amdgcn_cvt_pk_fp8_f32(z, w, r, true);
    return (unsigned)r;
}
__device__ __forceinline__ void ph_tab_convert(const Ctx& p, int l) {
    const float4* u = (const float4*)(pin_(32) + (size_t)l * NEXP * DM);
    const float4* v = (const float4*)(pin_(33) + (size_t)l * NEXP * DM);
    unsigned* uo = (unsigned*)(pws_() + WS_UT16);
    unsigned* vo = (unsigned*)(pws_() + WS_VT16);
    const size_t n4 = (size_t)NEXP * DM / 4;
    for (size_t i = (size_t)bid_() * 512 + tid_(); i < n4; i += (size_t)nblk_() * 512) {
        uo[i] = pack4_fp8(u[i], U_SCALE);
        vo[i] = pack4_fp8(v[i], V_SCALE);
    }
}
#define WS_PD (WS_P)
template <int HALF>
__device__ __forceinline__ void ph_peer_u(const Ctx& p, int l) {
    const unsigned char* ut = (const unsigned char*)(pws_() + WS_UT16);
    const int* pidx = (const int*)(pws_() + WS_PEI);
    float* pgt = (float*)(pws_() + WS_PEG);
    float* pd_ = (float*)(pws_() + WS_PD);
    const bf16_t* H = (const bf16_t*)(pws_() + WS_H);
    const int lane = tid_() & 63;
    const bool r = lane & 32, bit4 = lane & 16, bit3 = lane & 8, bit2 = lane & 4, bit1 = lane & 2;
    const int coff = 512 * HALF + 16 * (lane & 31);
    const int pmine = 2 * (((lane >> 4) & 1) * 8 + ((lane >> 3) & 1) * 4 + ((lane >> 2) & 1) * 2 + ((lane >> 1) & 1)) + (lane >> 5);
    const int nw = nwaves();
    int tok = gwave();
    uint4 nr0 = *(const uint4*)(H + (size_t)tok * DM + coff), nr1 = *(const uint4*)(H + (size_t)tok * DM + coff + 8);
    int ne0 = pidx[(size_t)tok * 128 + lane], ne1 = pidx[(size_t)tok * 128 + 64 + lane];
    for (; tok < MTOK; tok += nw) {
        float hh[16];
        {
            const unsigned w[8] = {nr0.x, nr0.y, nr0.z, nr0.w, nr1.x, nr1.y, nr1.z, nr1.w};
#pragma unroll
            for (int q = 0; q < 8; ++q) { hh[2 * q] = __uint_as_float(w[q] << 16); hh[2 * q + 1] = __uint_as_float(w[q] & 0xffff0000u); }
        }
        const int e0 = ne0, e1 = ne1;
        if (tok + nw < MTOK) {
            const size_t tn = (size_t)(tok + nw);
            nr0 = *(const uint4*)(H + tn * DM + coff); nr1 = *(const uint4*)(H + tn * DM + coff + 8);
            ne0 = pidx[tn * 128 + lane]; ne1 = pidx[tn * 128 + 64 + lane];
        }
#pragma unroll 1
        for (int hb = 0; hb < 4; ++hb) {
            const int esrc = hb < 2 ? e0 : e1;
            const int lb = (hb & 1) * 32;
            uint4 ur[16];
#pragma unroll
            for (int i = 0; i < 16; ++i) {
                const int ea = __builtin_amdgcn_readlane(esrc, lb + 2 * i), eb = __builtin_amdgcn_readlane(esrc, lb + 2 * i + 1);
                const int e = r ? eb : ea;
                ur[i] = *(const uint4*)(ut + (size_t)e * DM + coff);
            }
            float pd[16];
#pragma unroll
            for (int i = 0; i < 16; ++i) {
                const unsigned w[4] = {ur[i].x, ur[i].y, ur[i].z, ur[i].w};
                float d0 = 0.f, d1 = 0.f;
#pragma unroll
                for (int q = 0; q < 4; ++q) {
                    const f32x2_t a = __builtin_amdgcn_cvt_pk_f32_fp8((int)w[q], false), c = __builtin_amdgcn_cvt_pk_f32_fp8((int)w[q], true);
                    d0 = __builtin_fmaf(a.x, hh[4 * q], d0); d1 = __builtin_fmaf(a.y, hh[4 * q + 1], d1);
                    d0 = __builtin_fmaf(c.x, hh[4 * q + 2], d0); d1 = __builtin_fmaf(c.y, hh[4 * q + 3], d1);
                }
                pd[i] = d0 + d1;
            }
            float r8[8], r4[4], r2[2], r1;
#pragma unroll
            for (int i = 0; i < 8; ++i) { const float mine = bit4 ? pd[i + 8] : pd[i], send = bit4 ? pd[i] : pd[i + 8]; r8[i] = mine + __shfl_xor(send, 16, 64); }
#pragma unroll
            for (int i = 0; i < 4; ++i) { const float mine = bit3 ? r8[i + 4] : r8[i], send = bit3 ? r8[i] : r8[i + 4]; r4[i] = mine + __shfl_xor(send, 8, 64); }
#pragma unroll
            for (int i = 0; i < 2; ++i) { const float mine = bit2 ? r4[i + 2] : r4[i], send = bit2 ? r4[i] : r4[i + 2]; r2[i] = mine + __shfl_xor(send, 4, 64); }
            { const float mine = bit1 ? r2[1] : r2[0], send = bit1 ? r2[0] : r2[1]; r1 = mine + __shfl_xor(send, 2, 64); }
            r1 += __shfl_xor(r1, 1, 64);
            const size_t pi = (size_t)tok * 128 + hb * 32 + pmine;
            if (HALF == 0) { if ((lane & 1) == 0) pd_[pi] = r1; }
            else if ((lane & 1) == 0) pgt[pi] = pgt[pi] * gelu_tanh_f((r1 + pd_[pi]) * (1.f / U_SCALE)) * (1.f / V_SCALE);
        }
    }
}
template <int HALF>
__device__ __forceinline__ void ph_peer_v(const Ctx& p, int l) {
    const unsigned char* vt = (const unsigned char*)(pws_() + WS_VT16);
    const int* pidx = (const int*)(pws_() + WS_PEI);
    const float* pgt = (const float*)(pws_() + WS_PEG);
    float* x = pout_();
    const int lane = tid_() & 63;
    const bool r = lane & 32;
    const int coff = 512 * HALF + 16 * (lane & 31);
    const int nw = nwaves();
    int tok = gwave();
    int ne0 = pidx[(size_t)tok * 128 + lane], ne1 = pidx[(size_t)tok * 128 + 64 + lane];
    float nc0 = pgt[(size_t)tok * 128 + lane], nc1 = pgt[(size_t)tok * 128 + 64 + lane];
    for (; tok < MTOK; tok += nw) {
        const int e0 = ne0, e1 = ne1;
        const float c0 = nc0, c1 = nc1;
        if (tok + nw < MTOK) {
            const size_t tn = (size_t)(tok + nw);
            ne0 = pidx[tn * 128 + lane]; ne1 = pidx[tn * 128 + 64 + lane];
            nc0 = pgt[tn * 128 + lane]; nc1 = pgt[tn * 128 + 64 + lane];
        }
        float out[16];
#pragma unroll
        for (int i = 0; i < 16; ++i) out[i] = 0.f;
#pragma unroll 1
        for (int hb = 0; hb < 4; ++hb) {
            const int esrc = hb < 2 ? e0 : e1;
            const float csrc = hb < 2 ? c0 : c1;
            const int lb = (hb & 1) * 32;
            uint4 vr[16];
#pragma unroll
            for (int i = 0; i < 16; ++i) {
                const int ea = __builtin_amdgcn_readlane(esrc, lb + 2 * i), eb = __builtin_amdgcn_readlane(esrc, lb + 2 * i + 1);
                const int e = r ? eb : ea;
                vr[i] = *(const uint4*)(vt + (size_t)e * DM + coff);
            }
#pragma unroll
            for (int i = 0; i < 16; ++i) {
                const float ca = __uint_as_float(__builtin_amdgcn_readlane(__float_as_uint(csrc), lb + 2 * i));
                const float cb = __uint_as_float(__builtin_amdgcn_readlane(__float_as_uint(csrc), lb + 2 * i + 1));
                const float cj = r ? cb : ca;
                const unsigned w[4] = {vr[i].x, vr[i].y, vr[i].z, vr[i].w};
#pragma unroll
                for (int q = 0; q < 4; ++q) {
                    const f32x2_t a = __builtin_amdgcn_cvt_pk_f32_fp8((int)w[q], false), c = __builtin_amdgcn_cvt_pk_f32_fp8((int)w[q], true);
                    out[4 * q] = __builtin_fmaf(a.x, cj, out[4 * q]); out[4 * q + 1] = __builtin_fmaf(a.y, cj, out[4 * q + 1]);
                    out[4 * q + 2] = __builtin_fmaf(c.x, cj, out[4 * q + 2]); out[4 * q + 3] = __builtin_fmaf(c.y, cj, out[4 * q + 3]);
                }
            }
        }
#pragma unroll
        for (int i = 0; i < 16; ++i) out[i] += __shfl_xor(out[i], 32, 64);
        if (!r) {
            float4* xp = (float4*)(x + (size_t)tok * DM + coff);
#pragma unroll
            for (int q = 0; q < 4; ++q) {
                float4 a = xp[q];
                a.x += out[4 * q]; a.y += out[4 * q + 1]; a.z += out[4 * q + 2]; a.w += out[4 * q + 3];
                xp[q] = a;
            }
        }
    }
}


#ifndef PROBE_MASK
#define PROBE_MASK 0
#endif
#if PROBE_MASK
#define GB(k) do { GRID_BARRIER(); const unsigned long long now_ = wall_clock64(); if ((PROBE_MASK >> (k)) & 1) { const unsigned long long dt_ = now_ - tprev_; while (wall_clock64() - now_ < 3ull * dt_) __builtin_amdgcn_s_sleep(8); } GRID_BARRIER(); tprev_ = wall_clock64(); } while (0)
#else
#define GB(k) GRID_BARRIER()
#endif
__global__ void __launch_bounds__(512, 2) k_mega(Params kp) {
    float* sm = dynsmem;
    {
        unsigned long long* tab = (unsigned long long*)((char*)dynsmem + PTAB_OFF);
        if (threadIdx.x < 34) tab[threadIdx.x] = (unsigned long long)kp.in[threadIdx.x];
        if (threadIdx.x == 34) tab[34] = (unsigned long long)kp.out;
        if (threadIdx.x == 35) tab[35] = (unsigned long long)kp.ws;
        if (threadIdx.x == 36) { tab[36] = 0ull; tab[37] = 0ull; }
    }
    __syncthreads();
    Ctx p; p.kp = &kp;
    (void)xcd_barrier_post((unsigned*)(pws_() + WS_BAR), (volatile LAS unsigned*)((char*)dynsmem + PTAB_OFF + 36 * 8));
#define GRID_BARRIER() do { XcdBarrier bar_; bar_.bar = (unsigned*)(pws_() + WS_BAR); bar_.x = xb_xcc_id(); bar_.st = (volatile LAS unsigned*)((char*)dynsmem + PTAB_OFF + 36 * 8); xcd_barrier(bar_); } while (0)
    ph_weight_prep(p, sm);
    ph_subkeys_convert(p);
    GRID_BARRIER();
#if PROBE_MASK
    unsigned long long tprev_ = wall_clock64();
#endif
#pragma unroll 1
    for (int l = 0; l < DEPTH; ++l) {
#define XIN_ (l == 0 ? pin_(0) : pout_())
#define HBUF_ ((const bf16_t*)(pws_() + WS_H))
        ph_rmsnorm(XIN_, pin_(2) + (size_t)l * DM, (bf16_t*)(pws_() + WS_H), MTOK);
        ph_rmsnorm(pin_(1), pin_(22) + (size_t)l * DM, (bf16_t*)(pws_() + WS_HM), MMEM);
        GB(1);
        { pg8::EpiBf16 E; E.O = (bf16_t*)(pws_() + WS_P); E.ldc = LDP; ph_gemm(HBUF_, (const bf16_t*)(pws_() + WT_IN) + (size_t)l * LDP * DM, MTOK, LDP, DM, E); }
        { pg8::EpiF32 E; E.C = (float*)(pws_() + WS_KM); E.R = nullptr; E.ldc = 256; ph_gemm((const bf16_t*)(pws_() + WS_HM), (const bf16_t*)(pws_() + WT_XK) + (size_t)l * 256 * DM, MMEM, 256, DM, E); }
        { pg8::EpiF32 E; E.C = (float*)(pws_() + WS_VM); E.R = nullptr; E.ldc = 256; ph_gemm((const bf16_t*)(pws_() + WS_HM), (const bf16_t*)(pws_() + WT_XV) + (size_t)l * 256 * DM, MMEM, 256, DM, E); }
        GB(2);
        ph_mem_prep(p, l);
        ph_dsa_prep(p, l);
        ph_scan_prep(p, l);
        GB(3);
        ph_scans(p, l, sm);
        GB(4);
        ph_mixer_finish(p, l);
        ph_dsa_main(p, l, sm);
        GB(5);
        { pg8::EpiF32 E; E.C = pout_(); E.R = XIN_; E.ldc = DM; ph_gemm((const bf16_t*)(pws_() + WS_Y), (const bf16_t*)(pws_() + WT_OUT) + (size_t)l * DM * DM, MTOK, DM, DM, E); }
        GB(6);
        ph_rmsnorm(pout_(), pin_(21) + (size_t)l * DM, (bf16_t*)(pws_() + WS_H), MTOK);
        GB(7);
        { pg8::EpiF32 E; E.C = (float*)(pws_() + WS_QX); E.R = nullptr; E.ldc = 256; ph_gemm(HBUF_, (const bf16_t*)(pws_() + WT_XQ) + (size_t)l * 256 * DM, MTOK, 256, DM, E); }
        GB(8);
        ph_xattn(p, l);
        GB(9);
        { pg8::EpiF32 E; E.C = pout_(); E.R = pout_(); E.ldc = DM; ph_gemm((const bf16_t*)(pws_() + WS_OX), (const bf16_t*)(pws_() + WT_XO) + (size_t)l * DM * 256, MTOK, DM, 256, E); }
        GB(10);
        ph_rmsnorm(pout_(), pin_(29) + (size_t)l * DM, (bf16_t*)(pws_() + WS_H), MTOK);
        ph_tab_convert(p, l);
        GB(11);
        { pg8::EpiBf16 E; E.O = (bf16_t*)(pws_() + WS_QP); E.ldc = DM; ph_gemm(HBUF_, (const bf16_t*)(pws_() + WT_PQ) + (size_t)l * DM * DM, MTOK, DM, DM, E); }
        GB(12);
        ph_peer_topk(p, l, sm);
        GB(13);
        ph_peer_u<0>(p, l);
        GB(14);
        ph_peer_u<1>(p, l);
        GB(15);
        ph_peer_v<0>(p, l);
        GB(16);
        ph_peer_v<1>(p, l);
        GB(17);
    }
}

extern "C" void kernel_launch(void* const* d_in, const int* in_sizes, int n_in, void* d_out, int out_size, void* d_ws, size_t ws_size, hipStream_t stream) {
    if (n_in != 34 || out_size != MTOK * DM || ws_size < WS_END) {
        fprintf(stderr, "kernel_launch: unexpected shapes (n_in %d out %d ws %zu need %zu)\n", n_in, out_size, ws_size, (size_t)WS_END);
        return;
    }
    static int grid = 0;
    if (!grid) {
        int dev = 0, cus = 0, per_cu = 0;
        (void)hipGetDevice(&dev);
        (void)hipDeviceGetAttribute(&cus, hipDeviceAttributeMultiprocessorCount, dev);
        (void)hipFuncSetAttribute((const void*)k_mega, hipFuncAttributeMaxDynamicSharedMemorySize, LDS_BYTES);
        (void)hipOccupancyMaxActiveBlocksPerMultiprocessor(&per_cu, (const void*)k_mega, 512, LDS_BYTES);
        if (per_cu < 1) fprintf(stderr, "kernel_launch: occupancy query reports %d blocks per CU\n", per_cu);
        grid = cus > 0 ? cus : 256;
    }
    Params p; memset(&p, 0, sizeof(p));
    for (int i = 0; i < 34; ++i) p.in[i] = (const float*)d_in[i];
    p.out = (float*)d_out; p.ws = (char*)d_ws;
    (void)hipMemsetAsync((char*)d_ws + WS_BAR, 0, XCD_BAR_WORDS * sizeof(unsigned), stream);
    hipLaunchKernelGGL(k_mega, dim3(grid), dim3(512), LDS_BYTES, stream, p);
}
```

```cpp
#include <hip/hip_runtime.h>
#include <stdint.h>
#include <stdio.h>
#include <string.h>

#define NB 32
#define SEQ 2048
#define DM 1024
#define MTOK (NB * SEQ)
#define DEPTH 4
#define NMEM 256
#define MMEM (NB * NMEM)
#define LDP 3328
#define NEXP 16384
#define EPS 1e-6f
#define PC_Z 0
#define PC_XBC 256
#define PC_GQKV 768
#define PC_GG 1536
#define PC_LQ 1792
#define PC_LK 1920
#define PC_LV 2048
#define PC_LR 2304
#define PC_DQ 2560
#define PC_DK 2816
#define PC_DV 2880
#define PC_IQ 2944
#define PC_IK 3200
#define PC_GLR 3232
#define PC_IW 3248
#define PC_DT 3256
#define PC_GA 3260
#define PC_GB 3264

typedef unsigned short bf16_t;

#define WS_BAR 0ull
#define WS_P 16384ull
#define SZ_P ((size_t)MTOK * LDP * 2)
#define WS_H (WS_P + SZ_P)
#define SZ_H ((size_t)MTOK * DM * 2)
#define WS_Y (WS_H + SZ_H)
#define SZ_Y ((size_t)MTOK * DM * 2)
#define WS_WP (WS_Y + SZ_Y)
#define SZ_WP ((size_t)DEPTH * DM * LDP * 4)
#define WT_IN (WS_WP)
#define WT_OUT (WT_IN + (size_t)DEPTH * LDP * DM * 2)
#define WT_XQ (WT_OUT + (size_t)DEPTH * DM * DM * 2)
#define WT_XK (WT_XQ + (size_t)DEPTH * 256 * DM * 2)
#define WT_XV (WT_XK + (size_t)DEPTH * 256 * DM * 2)
#define WT_XO (WT_XV + (size_t)DEPTH * 256 * DM * 2)
#define WT_PQ (WT_XO + (size_t)DEPTH * DM * 256 * 2)
#define WT_END (WT_PQ + (size_t)DEPTH * DM * DM * 2)
#define WS_QN (WS_WP + SZ_WP)
#define SZ_QN ((size_t)MTOK * 256 * 4)
#define WS_KN (WS_QN + SZ_QN)
#define SZ_KN ((size_t)MTOK * 64 * 4)
#define WS_IKN (WS_KN + SZ_KN)
#define SZ_IKN ((size_t)MTOK * 32 * 4)
#define WS_YPRE (WS_IKN + SZ_IKN)
#define SZ_YPRE ((size_t)MTOK * 256 * 4)
#define WS_HM (WS_YPRE + SZ_YPRE)
#define SZ_HM ((size_t)MMEM * DM * 2)
#define WS_KM (WS_HM + SZ_HM)
#define SZ_KM ((size_t)MMEM * 256 * 4)
#define WS_VM (WS_KM + SZ_KM)
#define SZ_VM ((size_t)MMEM * 256 * 4)
#define WS_KB (WS_VM + SZ_VM)
#define SZ_KB ((size_t)MMEM * 256 * 2)
#define WS_VTB (WS_KB + SZ_KB)
#define SZ_VTB ((size_t)MMEM * 256 * 2)
#define WS_VT (WS_VTB + SZ_VTB)
#define SZ_VT ((size_t)MTOK * 64 * 2)
#define WS_SKB (WS_VT + SZ_VT)
#define SZ_SKB ((size_t)DEPTH * 8 * 2 * 128 * 64 * 2)
#define WS_SC (WS_SKB + SZ_SKB)
#define SZ_SC ((size_t)MTOK * 16 * 4)
#define WS_DUMMY (WS_SC + SZ_SC)
#define SZ_DUMMY (65536ull)
#define WS_END (WS_DUMMY + SZ_DUMMY)
#define WS_QX (WS_P)
#define WS_OX (WS_P + (size_t)MTOK * 256 * 4)
#define WS_QP (WS_P)
#define WS_UT16 (WS_P + 260ull * 1024 * 1024)
#define WS_VT16 (WS_UT16 + (size_t)NEXP * DM * 2)
#define WS_PEI (WS_VT16 + (size_t)NEXP * DM * 2)
#define WS_PEG (WS_PEI + (size_t)MTOK * 128 * 4)
#define WS_PEND (WS_PEG + (size_t)MTOK * 128 * 4)
static_assert(WS_PEND <= WS_P + SZ_P, "P region aliases");

struct Params {
    const float* in[34];
    float* out;
    char* ws;
};

#define XB_TMO      128
#define XB_XCNT(j)  (256  + 64 * (j))
#define XB_XSUB(j)  (1280 + 64 * (j))
#define XB_XGEN(j)  (2304 + 64 * (j))
#define XB_TOP      3328
#define XB_TOPGEN   3392
#define XCD_BAR_WORDS 3456
#define XB_SPIN_CAP (1u << 18)
#define LAS __attribute__((address_space(3)))

__device__ __forceinline__ unsigned xb_ld(unsigned* p)              { return __hip_atomic_load(p, __ATOMIC_RELAXED, __HIP_MEMORY_SCOPE_AGENT); }
__device__ __forceinline__ unsigned xb_add(unsigned* p, unsigned v) { return __hip_atomic_fetch_add(p, v, __ATOMIC_RELAXED, __HIP_MEMORY_SCOPE_AGENT); }
__device__ __forceinline__ unsigned xb_xcc_id() { return (unsigned)__builtin_amdgcn_s_getreg((3 << 11) | 20) & 0xFu; }
#define XB_SPIN(cond, bar) do { unsigned _sp = 0; while (cond) { __builtin_amdgcn_s_sleep(1); \
    if ((++_sp & 255u) == 0u) { if (xb_ld(&(bar)[XB_TMO])) break; if (_sp > XB_SPIN_CAP) { atomicAdd(&(bar)[XB_TMO], 1u); break; } } } } while (0)

struct XcdBarrier {
    unsigned* bar; unsigned x;
    volatile LAS unsigned* st;
};

__device__ __forceinline__ XcdBarrier xcd_barrier_post(unsigned* bar, volatile LAS unsigned* st) {
    XcdBarrier b; b.bar = bar; b.x = xb_xcc_id(); b.st = st;
    if (threadIdx.x == 0) (void)xb_add(&bar[XB_XCNT(b.x)], 1u);
    return b;
}
__device__ __forceinline__ void xcd_barrier_complete(unsigned* bar, unsigned x, unsigned& nloc, unsigned& nx) {
    const unsigned G = gridDim.x * gridDim.y * gridDim.z;
    unsigned sum, cnt, mine, sp = 0u;
    for (;;) {
        sum = 0u; cnt = 0u; mine = 0u;
#pragma unroll
        for (unsigned j = 0; j < 16; ++j) { const unsigned c = xb_ld(&bar[XB_XCNT(j)]); sum += c; cnt += (c > 0u) ? 1u : 0u; mine = (j == x) ? c : mine; }
        if (sum == G) break;
        __builtin_amdgcn_s_sleep(1);
        if ((++sp & 255u) == 0u) { if (xb_ld(&bar[XB_TMO])) break; if (sp > XB_SPIN_CAP) { atomicAdd(&bar[XB_TMO], 1u); break; } }
    }
    nloc = mine > 0u ? mine : 1u; nx = cnt > 0u ? cnt : 1u;
}

__device__ __forceinline__ void xcd_barrier(const XcdBarrier& b) {
    asm volatile("s_waitcnt vmcnt(0)" ::: "memory");
    __syncthreads();
    if (threadIdx.x == 0) {
        unsigned* bar = b.bar;
        __builtin_amdgcn_s_waitcnt(0);
        unsigned nloc = b.st[0], nx = b.st[1];
        if (nloc == 0u) { xcd_barrier_complete(bar, b.x, nloc, nx); b.st[0] = nloc; b.st[1] = nx; }
        const unsigned old = xb_add(&bar[XB_XSUB(b.x)], 1u);
        const unsigned gen = old / nloc;
        if (old + 1u == (gen + 1u) * nloc) {
            __builtin_amdgcn_fence(__ATOMIC_RELEASE, "agent");
            asm volatile("s_waitcnt vmcnt(0)" ::: "memory");
            const unsigned og = xb_add(&bar[XB_TOP], 1u);
            const unsigned tg = og / nx;
            if (og + 1u == (tg + 1u) * nx) xb_add(&bar[XB_TOPGEN], 1u);
            else XB_SPIN(xb_ld(&bar[XB_TOPGEN]) == tg, bar);
            __builtin_amdgcn_fence(__ATOMIC_ACQUIRE, "agent");
            xb_add(&bar[XB_XGEN(b.x)], 1u);
            asm volatile("s_waitcnt vmcnt(0)" ::: "memory");
        } else {
            XB_SPIN(xb_ld(&bar[XB_XGEN(b.x)]) == gen, bar);
            __builtin_amdgcn_fence(__ATOMIC_ACQUIRE, "agent");
            asm volatile("s_waitcnt vmcnt(0)" ::: "memory");
        }
    }
    __syncthreads();
}


#define LDS_BYTES (144 * 1024)
#define PTAB_OFF (LDS_BYTES - 1024)
extern __shared__ __attribute__((aligned(16))) float dynsmem[];
struct Ctx { const Params* kp; };
#define pin_(i) (p.kp->in[i])
#define pout_() (p.kp->out)
#define pws_() (p.kp->ws)

__device__ __forceinline__ float bf2f(bf16_t v) { return __uint_as_float(((unsigned)v) << 16); }
__device__ __forceinline__ bf16_t f2bf(float f) { unsigned u = __float_as_uint(f); u += 0x7FFFu + ((u >> 16) & 1u); return (bf16_t)(u >> 16); }
__device__ __forceinline__ unsigned pk_bf16(float lo, float hi) { return (unsigned)f2bf(lo) | ((unsigned)f2bf(hi) << 16); }
__device__ __forceinline__ float wave_sum(float v) {
#pragma unroll
    for (int o = 32; o >= 1; o >>= 1) v += __shfl_xor(v, o, 64);
    return v;
}
__device__ __forceinline__ float wave_max(float v) {
#pragma unroll
    for (int o = 32; o >= 1; o >>= 1) v = fmaxf(v, __shfl_xor(v, o, 64));
    return v;
}
__device__ __forceinline__ float silu_f(float x) { return x / (1.f + __expf(-x)); }
__device__ __forceinline__ float sigmoid_f(float x) { return 1.f / (1.f + __expf(-x)); }
__device__ __forceinline__ float softplus_f(float x) { return x > 20.f ? x : log1pf(__expf(x)); }
__device__ __forceinline__ float logsigmoid_f(float x) { return -softplus_f(-x); }
__device__ __forceinline__ float gelu_tanh_f(float x) { const float u = 0.7978845608028654f * (x + 0.044715f * x * x * x); return 0.5f * x * (1.f + tanhf(u)); }
__device__ __forceinline__ unsigned ford(float f) { f = f + 0.0f; unsigned u = __float_as_uint(f); return (u & 0x80000000u) ? ~u : (u | 0x80000000u); }
__device__ __forceinline__ float funord(unsigned k) { unsigned u = (k & 0x80000000u) ? (k & 0x7fffffffu) : ~k; return __uint_as_float(u); }
__device__ __forceinline__ unsigned long long wave_max_u64(unsigned long long v) {
#pragma unroll
    for (int o = 32; o >= 1; o >>= 1) {
        unsigned lo = __shfl_xor((unsigned)v, o, 64), hi = __shfl_xor((unsigned)(v >> 32), o, 64);
        unsigned long long w = ((unsigned long long)hi << 32) | lo;
        v = w > v ? w : v;
    }
    return v;
}
__device__ __forceinline__ int tid_() { int t = threadIdx.x; asm volatile("" : "+v"(t)); return t; }
__device__ __forceinline__ int bid_() { int b = blockIdx.x; asm volatile("" : "+s"(b)); return b; }
__device__ __forceinline__ int nblk_() { int g = gridDim.x; asm volatile("" : "+s"(g)); return g; }
__device__ __forceinline__ int gwave() { return (bid_() * 512 + tid_()) >> 6; }
__device__ __forceinline__ int nwaves() { return nblk_() * 8; }

namespace pg8 {
#define PG8_LAS __attribute__((address_space(3)))
typedef unsigned short bf16_t;
typedef short bf16x8 __attribute__((ext_vector_type(8)));
typedef float f32x4 __attribute__((ext_vector_type(4)));
typedef unsigned u32x4 __attribute__((ext_vector_type(4)));
constexpr int BM = 256, BK = 64, HALF = 128, HTB = HALF * BK * 2  , STAGE_BYTES = 8 * HTB, NXCD = 8, WGM = 8;

__host__ __device__ __forceinline__ int lds_byte(int r, int c) { const int st = (r >> 4) * 2 + (c >> 5), rr = r & 15, cc = c & 31, ob = rr * 64 + cc * 2; return st * 1024 + (ob ^ (((ob >> 9) & 1) << 5)); }
__host__ __device__ __forceinline__ void stage_rc(int b, int& R, int& C) { const int st = b / 1024, sb = b % 1024, swz = sb ^ (((sb >> 9) & 1) << 5); R = (st >> 1) * 16 + swz / 64; C = (st & 1) * 32 + (swz % 64) / 2; }
__host__ __device__ __forceinline__ int perm32(int rho) { const int n = rho >> 4, i = rho & 15; return 8 * (i >> 2) + 4 * n + (i & 3); }

struct Unit { int pm, pn; };
struct Gemm { const bf16_t* A; const bf16_t* Bt; int M, N, K; };

struct StaticOrder {
    int nM, nN, nwg, G, c;
    __host__ __device__ void init(int M, int N, int G_, int c_) { nM = M / BM; nN = N / BM; nwg = nM * nN; G = G_; c = c_; }
    __host__ __device__ bool next(int i, Unit& u) const {
        const long L = (long)i * G + c; if (L >= nwg) return false;
        int wgid = (int)L; { const int q = nwg / NXCD, r = nwg % NXCD, xcd = wgid % NXCD, off = wgid / NXCD; wgid = (xcd < r ? xcd * (q + 1) : r * (q + 1) + (xcd - r) * q) + off; }
        const int nig = WGM * nN, gid = wgid / nig, fm = gid * WGM, gsz = (nM - fm) < WGM ? (nM - fm) : WGM;
        u.pm = fm + ((wgid % nig) % gsz); u.pn = (wgid % nig) / gsz; return true;
    }
    __device__ __forceinline__ void a_ready(const Unit&) const {}
    __device__ __forceinline__ void done(const Unit&) const {}
};

__device__ __forceinline__ unsigned cvt_pk_bf16(float lo, float hi) { unsigned r; asm volatile("v_cvt_pk_bf16_f32 %0, %1, %2" : "=v"(r) : "v"(lo), "v"(hi)); return r; }
struct EpiF32 {
    static constexpr bool PERM = false, AFTER_DRAIN = false;
    float* C; const float* R; int ldc;
    __device__ __forceinline__ void operator()(const f32x4 (&acc)[2][2][4][2], const Unit& u, int wr, int wc, int fr, int fq) const {
        const int row0 = u.pm * BM + wr * 64 + fr, col0 = u.pn * BM + wc * 32 + 4 * fq;
#pragma unroll
        for (int ai = 0; ai < 2; ++ai)
#pragma unroll
            for (int m = 0; m < 4; ++m) { const size_t off = (size_t)(row0 + ai * HALF + m * 16) * ldc + col0;
#pragma unroll
                for (int bj = 0; bj < 2; ++bj)
#pragma unroll
                    for (int n = 0; n < 2; ++n) { f32x4 v = acc[ai][bj][m][n]; if (R) v += *(const f32x4*)(R + off + bj * HALF + n * 16); *(f32x4*)(C + off + bj * HALF + n * 16) = v; } }
    }
};
struct EpiBf16 {
    static constexpr bool PERM = true, AFTER_DRAIN = false;
    bf16_t* O; int ldc;
    __device__ __forceinline__ void operator()(const f32x4 (&acc)[2][2][4][2], const Unit& u, int wr, int wc, int fr, int fq) const {
        const int row0 = u.pm * BM + wr * 64 + fr, col0 = u.pn * BM + wc * 32 + 8 * fq;
#pragma unroll
        for (int ai = 0; ai < 2; ++ai)
#pragma unroll
            for (int m = 0; m < 4; ++m) { bf16_t* rowp = O + (size_t)(row0 + ai * HALF + m * 16) * ldc + col0;
#pragma unroll
                for (int bj = 0; bj < 2; ++bj) { const f32x4 v0 = acc[ai][bj][m][0], v1 = acc[ai][bj][m][1];
                    u32x4 w; w.x = cvt_pk_bf16(v0[0], v0[1]); w.y = cvt_pk_bf16(v0[2], v0[3]); w.z = cvt_pk_bf16(v1[0], v1[1]); w.w = cvt_pk_bf16(v1[2], v1[3]);
                    *(u32x4*)(rowp + bj * HALF) = w; } }
    }
};

template <class Epi, class Sched, bool STAMP = false>
__device__ __forceinline__ void gemm_phase(PG8_LAS unsigned char* lds, const Gemm g, const Sched& S, const Epi& E, unsigned long long* stamps, const int tid) {
    const int wid = __builtin_amdgcn_readfirstlane(tid >> 6), lane = tid & 63, wr = wid >> 2, wc = wid & 3, fr = lane & 15, fq = lane >> 4;
    const int K = g.K, nt = K / BK;
    int ts_lo = 0, ts_hi = 0, nts = 0; const unsigned long long rt_entry = STAMP ? (unsigned long long)wall_clock64() : 0ull;
#define PG8_STAMP() do { if (STAMP && wid == 0 && nts < 64) { const unsigned long long _c = (unsigned long long)clock64(); \
        ts_lo = (lane == nts) ? (int)(unsigned)_c : ts_lo; ts_hi = (lane == nts) ? (int)(unsigned)(_c >> 32) : ts_hi; ++nts; } } while (0)
    PG8_STAMP();
    unsigned voffA[2], voffB[2];
#pragma unroll
    for (int i = 0; i < 2; ++i) { int R, C; stage_rc(tid * 16 + i * 8192, R, C); const int Rb = Epi::PERM ? ((R & ~31) + perm32(R & 31)) : R;
        voffA[i] = (unsigned)(R * K + C) * 2u; voffB[i] = (unsigned)(Rb * K + C) * 2u; }
    const size_t kstep = (size_t)(BK * 2);
    const size_t hstep = (size_t)HALF * K * 2;
    const size_t tstep = 2 * hstep;
    const unsigned ldsw = (unsigned)wid * 1024u;
    const int aoff = lds_byte(wr * 64 + fr, fq * 8), boff = lds_byte(wc * 32 + fr, fq * 8);
#define PG8_SA(b, h) (((b) * 2 + (h)) * HTB)
#define PG8_SB(b, h) ((4 + (b) * 2 + (h)) * HTB)
#define PG8_STAGE(bufoff, gbase, voff) do { _Pragma("unroll") for (int _i = 0; _i < 2; ++_i) \
        __builtin_amdgcn_global_load_lds((const unsigned*)((const char*)(gbase) + (voff)[_i]), (PG8_LAS unsigned*)(lds + (bufoff) + ldsw + _i * 8192), 16, 0, 0); } while (0)
#define PG8_LDA(dst, b, h) do { _Pragma("unroll") for (int m = 0; m < 4; ++m) _Pragma("unroll") for (int k = 0; k < 2; ++k) dst[m][k] = *(const PG8_LAS bf16x8*)(lds + PG8_SA(b, h) + aoff + m * 2048 + k * 1024); } while (0)
#define PG8_LDB(dst, b, h) do { _Pragma("unroll") for (int n = 0; n < 2; ++n) _Pragma("unroll") for (int k = 0; k < 2; ++k) dst[n][k] = *(const PG8_LAS bf16x8*)(lds + PG8_SB(b, h) + boff + n * 2048 + k * 1024); } while (0)
#define PG8_MMA(ai, bj, At, Bt) do { __builtin_amdgcn_s_setprio(1); _Pragma("unroll") for (int m = 0; m < 4; ++m) _Pragma("unroll") for (int n = 0; n < 2; ++n) _Pragma("unroll") for (int k = 0; k < 2; ++k) \
        acc[ai][bj][m][n] = __builtin_amdgcn_mfma_f32_16x16x32_bf16(Bt[n][k], At[m][k], acc[ai][bj][m][n], 0, 0, 0); __builtin_amdgcn_s_setprio(0); } while (0)
#define PG8_WAIT_V(n) asm volatile("s_waitcnt vmcnt(" #n ")" ::: "memory")
#define PG8_WAIT_L(n) asm volatile("s_waitcnt lgkmcnt(" #n ")" ::: "memory")
#define PG8_BAR __builtin_amdgcn_s_barrier()
#define PG8_SCHED __builtin_amdgcn_sched_barrier(0)
    Unit cur, nxt; int ui = 0;
    if (!S.next(0, cur)) return;
    f32x4 acc[2][2][4][2];
#pragma unroll
    for (int a = 0; a < 2; ++a)
#pragma unroll
        for (int b = 0; b < 2; ++b)
#pragma unroll
            for (int m = 0; m < 4; ++m)
#pragma unroll
                for (int n = 0; n < 2; ++n) acc[a][b][m][n] = (f32x4){0.f, 0.f, 0.f, 0.f};
    bf16x8 At[4][2], B0[2][2], B1[2][2];
    const char* cA = (const char*)g.A + (size_t)cur.pm * tstep; const char* cB = (const char*)g.Bt + (size_t)cur.pn * tstep;
    S.a_ready(cur);
    PG8_STAGE(PG8_SB(0, 0), cB, voffB); PG8_STAGE(PG8_SA(0, 0), cA, voffA); PG8_STAGE(PG8_SB(0, 1), cB + hstep, voffB); PG8_STAGE(PG8_SA(0, 1), cA + hstep, voffA);
    if (wr == 1) PG8_BAR;
    PG8_WAIT_V(4); PG8_BAR;
    PG8_STAGE(PG8_SB(1, 0), cB + kstep, voffB); PG8_STAGE(PG8_SA(1, 0), cA + kstep, voffA); PG8_STAGE(PG8_SB(1, 1), cB + hstep + kstep, voffB);
    PG8_WAIT_V(6); PG8_BAR;
    PG8_STAMP();
    for (;;) {
        const bool has_next = S.next(ui + 1, nxt);
        const char* nA = has_next ? (const char*)g.A + (size_t)nxt.pm * tstep : cA; const char* nB = has_next ? (const char*)g.Bt + (size_t)nxt.pn * tstep : cB;
        for (int t = 0; t < nt; t += 2) {
            const bool last = (t == nt - 2);
            const char* a1 = cA + (size_t)(t + 1) * kstep;
            const char* a2 = last ? nA : cA + (size_t)(t + 2) * kstep; const char* b2 = last ? nB : cB + (size_t)(t + 2) * kstep;
            const char* a3 = a2 + kstep; const char* b3 = b2 + kstep;
            if (last && has_next) S.a_ready(nxt);
            PG8_LDB(B0, 0, 0); PG8_SCHED; PG8_LDA(At, 0, 0); PG8_STAGE(PG8_SA(1, 1), a1 + hstep, voffA);
            PG8_WAIT_L(8); PG8_BAR; PG8_WAIT_L(0); PG8_MMA(0, 0, At, B0); PG8_BAR; PG8_SCHED;
            PG8_LDB(B1, 0, 1); PG8_STAGE(PG8_SB(0, 0), b2, voffB);
            PG8_BAR; PG8_WAIT_L(0); PG8_MMA(0, 1, At, B1); PG8_BAR;
            PG8_LDA(At, 0, 1); PG8_STAGE(PG8_SA(0, 0), a2, voffA);
            PG8_BAR; PG8_WAIT_L(0); PG8_MMA(1, 0, At, B0); PG8_BAR; PG8_SCHED;
            PG8_STAGE(PG8_SB(0, 1), b2 + hstep, voffB);
            PG8_WAIT_V(6); PG8_BAR; PG8_MMA(1, 1, At, B1); PG8_BAR;
            PG8_LDB(B0, 1, 0); PG8_SCHED; PG8_LDA(At, 1, 0); PG8_STAGE(PG8_SA(0, 1), a2 + hstep, voffA);
            PG8_WAIT_L(8); PG8_BAR; PG8_WAIT_L(0); PG8_MMA(0, 0, At, B0); PG8_BAR; PG8_SCHED;
            PG8_LDB(B1, 1, 1); PG8_STAGE(PG8_SB(1, 0), b3, voffB);
            PG8_BAR; PG8_WAIT_L(0); PG8_MMA(0, 1, At, B1); PG8_BAR;
            PG8_LDA(At, 1, 1); PG8_STAGE(PG8_SA(1, 0), a3, voffA);
            PG8_BAR; PG8_WAIT_L(0); PG8_MMA(1, 0, At, B0); PG8_BAR; PG8_SCHED;
            PG8_STAGE(PG8_SB(1, 1), b3 + hstep, voffB);
            PG8_WAIT_V(6); PG8_BAR; PG8_MMA(1, 1, At, B1); PG8_BAR;
        }
        PG8_STAMP();
        if constexpr (!Epi::AFTER_DRAIN) { E(acc, cur, wr, wc, fr, fq); S.done(cur); }
        PG8_STAMP();
        if (!has_next) break;
#pragma unroll
        for (int a = 0; a < 2; ++a)
#pragma unroll
            for (int b = 0; b < 2; ++b)
#pragma unroll
                for (int m = 0; m < 4; ++m)
#pragma unroll
                    for (int n = 0; n < 2; ++n) acc[a][b][m][n] = (f32x4){0.f, 0.f, 0.f, 0.f};
        cur = nxt; cA = nA; cB = nB; ++ui;
    }
    PG8_WAIT_V(0);
    if (wr == 0) PG8_BAR;
    PG8_BAR;
    if constexpr (Epi::AFTER_DRAIN) { E.fused(acc, cur, wr, wc, fr, fq, lds, wid, lane); S.done(cur); }
    PG8_STAMP();
    if (STAMP && wid == 0) { stamps[lane] = lane < nts ? (((unsigned long long)(unsigned)ts_hi << 32) | (unsigned)ts_lo) : 0ull;
        if (lane == 62) stamps[62] = rt_entry; if (lane == 63) stamps[63] = (unsigned long long)wall_clock64(); }
#undef PG8_STAMP
#undef PG8_SA
#undef PG8_SB
#undef PG8_STAGE
#undef PG8_LDA
#undef PG8_LDB
#undef PG8_MMA
#undef PG8_WAIT_V
#undef PG8_WAIT_L
#undef PG8_BAR
#undef PG8_SCHED
}
}

template <class Epi> __device__ __forceinline__ void ph_gemm(const bf16_t* A, const bf16_t* Bt, int M, int N, int K, const Epi& E, int crot = 0) {
    pg8::Gemm g; g.A = A; g.Bt = Bt; g.M = M; g.N = N; g.K = K;
    const int nb_ = nblk_();
    pg8::StaticOrder S; S.init(M, N, nb_, (bid_() + nb_ - crot) % nb_);
    pg8::gemm_phase<Epi, pg8::StaticOrder, false>((PG8_LAS unsigned char*)dynsmem, g, S, E, nullptr, tid_());
}

__device__ __forceinline__ int pcol_to_orig(int c) {
    if (c < 768) return c;
    if (c < 1536) return c - 768 + 772;
    if (c < 1792) return c - 1536 + 1548;
    if (c < 1920) return c - 1792 + 1804;
    if (c < 2048) return c - 1920 + 1932;
    if (c < 2304) return c - 2048 + 2060;
    if (c < 2560) return c - 2304 + 2332;
    if (c < 2816) return c - 2560 + 2588;
    if (c < 2880) return c - 2816 + 2844;
    if (c < 2944) return c - 2880 + 2908;
    if (c < 3200) return c - 2944 + 2972;
    if (c < 3232) return c - 3200 + 3228;
    if (c < 3248) return c - 3232 + 2316;
    if (c < 3256) return c - 3248 + 3260;
    if (c < 3260) return c - 3256 + 768;
    if (c < 3264) return c - 3260 + 1540;
    if (c < 3268) return c - 3264 + 1544;
    return -1;
}
__device__ __forceinline__ void wtrans_job(const float* W, int K, int ldw, bf16_t* Wt, int Npad, bool mapped, float* tile) {
    const int tid = tid_();
    const int tn = Npad / 64, tk = K / 64;
    for (int t = bid_(); t < tn * tk; t += nblk_()) {
        const int n0 = (t / tk) * 64, k0 = (t % tk) * 64;
        __syncthreads();
        for (int idx = tid; idx < 4096; idx += 512) {
            const int kk = idx >> 6, nn = idx & 63;
            const int col = mapped ? pcol_to_orig(n0 + nn) : (n0 + nn);
            tile[kk * 65 + nn] = col >= 0 ? W[(size_t)(k0 + kk) * ldw + col] : 0.f;
        }
        __syncthreads();
        for (int idx = tid; idx < 4096; idx += 512) {
            const int nn = idx >> 6, kk = idx & 63;
            Wt[(size_t)(n0 + nn) * K + k0 + kk] = f2bf(tile[kk * 65 + nn]);
        }
    }
}
__device__ __forceinline__ void ph_weight_prep(const Ctx& p, float* sm) {
#pragma unroll 1
    for (int j = 0; j < 7 * DEPTH; ++j) {
        const int l = j / 7, w = j % 7;
        const float* W; int K, ldw, Npad; bf16_t* Wt; bool mapped = false;
        if (w == 0) { W = pin_(3) + (size_t)l * DM * 3268; K = DM; ldw = 3268; Npad = LDP; Wt = (bf16_t*)(pws_() + WT_IN) + (size_t)l * LDP * DM; mapped = true; }
        else if (w == 1) { W = pin_(20) + (size_t)l * DM * DM; K = DM; ldw = DM; Npad = DM; Wt = (bf16_t*)(pws_() + WT_OUT) + (size_t)l * DM * DM; }
        else if (w == 2) { W = pin_(23) + (size_t)l * DM * 256; K = DM; ldw = 256; Npad = 256; Wt = (bf16_t*)(pws_() + WT_XQ) + (size_t)l * 256 * DM; }
        else if (w == 3) { W = pin_(24) + (size_t)l * DM * 256; K = DM; ldw = 256; Npad = 256; Wt = (bf16_t*)(pws_() + WT_XK) + (size_t)l * 256 * DM; }
        else if (w == 4) { W = pin_(25) + (size_t)l * DM * 256; K = DM; ldw = 256; Npad = 256; Wt = (bf16_t*)(pws_() + WT_XV) + (size_t)l * 256 * DM; }
        else if (w == 5) { W = pin_(26) + (size_t)l * 256 * DM; K = 256; ldw = DM; Npad = DM; Wt = (bf16_t*)(pws_() + WT_XO) + (size_t)l * DM * 256; }
        else { W = pin_(30) + (size_t)l * DM * DM; K = DM; ldw = DM; Npad = DM; Wt = (bf16_t*)(pws_() + WT_PQ) + (size_t)l * DM * DM; }
        wtrans_job(W, K, ldw, Wt, Npad, mapped, sm);
    }
}

__device__ __forceinline__ void ph_rmsnorm(const float* __restrict__ x, const float* __restrict__ g, bf16_t* __restrict__ out, int rows) {
    const int lane = tid_() & 63;
    for (int r = gwave(); r < rows; r += nwaves()) {
        const float4* xr = (const float4*)(x + (size_t)r * DM);
        float4 v[4]; float ss = 0.f;
#pragma unroll
        for (int i = 0; i < 4; ++i) { v[i] = xr[lane + 64 * i]; ss += v[i].x * v[i].x + v[i].y * v[i].y + v[i].z * v[i].z + v[i].w * v[i].w; }
        ss = wave_sum(ss);
        const float rs = rsqrtf(ss * (1.f / DM) + EPS);
#pragma unroll
        for (int i = 0; i < 4; ++i) {
            const float4 gg = ((const float4*)g)[lane + 64 * i];
            ushort4 o; o.x = f2bf(v[i].x * rs * gg.x); o.y = f2bf(v[i].y * rs * gg.y); o.z = f2bf(v[i].z * rs * gg.z); o.w = f2bf(v[i].w * rs * gg.w);
            *(ushort4*)(out + (size_t)r * DM + (size_t)(lane + 64 * i) * 4) = o;
        }
    }
}

template <int OUTMODE>
__device__ __forceinline__ void ph_sgemm(const bf16_t* __restrict__ A, int lda, const float* __restrict__ B, int ldb, void* Cv, int ldc, const float* R, int ldr,
                         int M, int N, int K, float* smem) {
    float* As = smem;
    float* Bs = smem + 16 * 132;
    const int tid = tid_(), tx = tid & 31, ty = tid >> 5;
    const int ntn = N / 128, ntiles = (M / 128) * ntn;
    for (int tile = bid_(); tile < ntiles; tile += nblk_()) {
        const int tm = tile / ntn, tn = tile % ntn;
        float acc[8][4];
#pragma unroll
        for (int i = 0; i < 8; ++i)
#pragma unroll
            for (int j = 0; j < 4; ++j) acc[i][j] = 0.f;
        const int arow = tid >> 2, akq = (tid & 3) * 4;
        const int bk = tid >> 5, bn = (tid & 31) * 4;
        for (int k0 = 0; k0 < K; k0 += 16) {
            const ushort4 av = *(const ushort4*)(A + (size_t)(tm * 128 + arow) * lda + k0 + akq);
            const float4 bv = *(const float4*)(B + (size_t)(k0 + bk) * ldb + tn * 128 + bn);
            __syncthreads();
            As[(akq + 0) * 132 + arow] = bf2f(av.x); As[(akq + 1) * 132 + arow] = bf2f(av.y);
            As[(akq + 2) * 132 + arow] = bf2f(av.z); As[(akq + 3) * 132 + arow] = bf2f(av.w);
            *(float4*)(Bs + bk * 132 + bn) = bv;
            __syncthreads();
#pragma unroll
            for (int k = 0; k < 16; ++k) {
                const float4 a0 = *(const float4*)(As + k * 132 + ty * 8), a1 = *(const float4*)(As + k * 132 + ty * 8 + 4);
                const float4 b = *(const float4*)(Bs + k * 132 + tx * 4);
                const float a[8] = {a0.x, a0.y, a0.z, a0.w, a1.x, a1.y, a1.z, a1.w};
#pragma unroll
                for (int i = 0; i < 8; ++i) { acc[i][0] += a[i] * b.x; acc[i][1] += a[i] * b.y; acc[i][2] += a[i] * b.z; acc[i][3] += a[i] * b.w; }
            }
        }
#pragma unroll
        for (int i = 0; i < 8; ++i) {
            const size_t row = (size_t)tm * 128 + ty * 8 + i; const int col = tn * 128 + tx * 4;
            if (OUTMODE == 0) {
                ushort4 o; o.x = f2bf(acc[i][0]); o.y = f2bf(acc[i][1]); o.z = f2bf(acc[i][2]); o.w = f2bf(acc[i][3]);
                *(ushort4*)((bf16_t*)Cv + row * ldc + col) = o;
            } else if (OUTMODE == 1) {
                *(float4*)((float*)Cv + row * ldc + col) = make_float4(acc[i][0], acc[i][1], acc[i][2], acc[i][3]);
            } else {
                const float4 r = *(const float4*)(R + row * ldr + col);
                *(float4*)((float*)Cv + row * ldc + col) = make_float4(r.x + acc[i][0], r.y + acc[i][1], r.z + acc[i][2], r.w + acc[i][3]);
            }
        }
    }
}

#define WS_HS WS_H
#define WS_VG WS_YPRE
#define WS_DEC (WS_YPRE + (size_t)MTOK * 256 * 2)

__device__ __forceinline__ float quad_sum(float v) {
    v += __int_as_float(__builtin_amdgcn_mov_dpp(__float_as_int(v), 0xB1, 0xF, 0xF, true));
    v += __int_as_float(__builtin_amdgcn_mov_dpp(__float_as_int(v), 0x4E, 0xF, 0xF, true));
    return v;
}
__device__ __forceinline__ float bflo(unsigned w) { return __uint_as_float(w << 16); }
__device__ __forceinline__ float bfhi(unsigned w) { return __uint_as_float(w & 0xffff0000u); }

__device__ __forceinline__ float oct_sum(float v) {
    v += __int_as_float(__builtin_amdgcn_mov_dpp(__float_as_int(v), 0xB1, 0xF, 0xF, true));
    v += __int_as_float(__builtin_amdgcn_mov_dpp(__float_as_int(v), 0x4E, 0xF, 0xF, true));
    v += __int_as_float(__builtin_amdgcn_mov_dpp(__float_as_int(v), 0x141, 0xF, 0xF, true));
    return v;
}
__device__ __forceinline__ void unpack8(const uint4 r, float (&o)[8]) {
    o[0] = bflo(r.x); o[1] = bfhi(r.x); o[2] = bflo(r.y); o[3] = bfhi(r.y); o[4] = bflo(r.z); o[5] = bfhi(r.z); o[6] = bflo(r.w); o[7] = bfhi(r.w);
}
__device__ __forceinline__ uint4 pack8(const float (&v)[8]) {
    uint4 o; o.x = pk_bf16(v[0], v[1]); o.y = pk_bf16(v[2], v[3]); o.z = pk_bf16(v[4], v[5]); o.w = pk_bf16(v[6], v[7]); return o;
}
__device__ __forceinline__ void load8f(const float* p, float (&o)[8]) {
    const float4 a = *(const float4*)p, b = *(const float4*)(p + 4);
    o[0] = a.x; o[1] = a.y; o[2] = a.z; o[3] = a.w; o[4] = b.x; o[5] = b.y; o[6] = b.z; o[7] = b.w;
}
__device__ __forceinline__ void conv8(const bf16_t* P, size_t tok, int t, int pcol, const float* w, int ldw, int cc, float (&acc)[8]) {
#pragma unroll
    for (int j = 0; j < 4; ++j) {
        if (t - 3 + j >= 0) {
            float xv[8], wv[8];
            unpack8(*(const uint4*)(P + (tok - (size_t)(3 - j)) * LDP + pcol), xv);
            load8f(w + j * ldw + cc, wv);
#pragma unroll
            for (int i = 0; i < 8; ++i) acc[i] = __builtin_fmaf(wv[i], xv[i], acc[i]);
        }
    }
}
__device__ __forceinline__ void conv8r(const uint4 (&xt)[4], int t, const float* w, int ldw, int cc, float (&acc)[8]) {
#pragma unroll
    for (int j = 0; j < 4; ++j) {
        float xv[8], wv[8];
        unpack8(xt[j], xv);
        load8f(w + j * ldw + cc, wv);
        const float m = (t - 3 + j >= 0) ? 1.f : 0.f;
#pragma unroll
        for (int i = 0; i < 8; ++i) acc[i] = __builtin_fmaf(wv[i] * m, xv[i], acc[i]);
    }
}
__device__ __forceinline__ void ph_scan_prep(const Ctx& p, int l) {
    const bf16_t* P = (const bf16_t*)(pws_() + WS_P);
    bf16_t* HS = (bf16_t*)(pws_() + WS_HS);
    bf16_t* VG = (bf16_t*)(pws_() + WS_VG);
    float* DEC = (float*)(pws_() + WS_DEC);
    float* SC = (float*)(pws_() + WS_SC);
    const float* scw = pin_(4) + (size_t)l * 4 * 512;
    const float* scb = pin_(5) + (size_t)l * 512;
    const float* gcw = pin_(10) + (size_t)l * 4 * 768;
    const float* wg = pin_(14) + (size_t)l * 16 * 128;
    const float* bg = pin_(15) + (size_t)l * 128;
    const int lane = tid_() & 63;
    const int hsc = lane & 3, wsc = (lane >> 2) & 3;
    const float k_dtb = pin_(6)[l * 4 + hsc], k_alog = __expf(pin_(7)[l * 4 + hsc]), k_galog = __expf(pin_(11)[l * 4 + hsc]), k_gdtb = pin_(12)[l * 4 + hsc];
    const int sccol = wsc < 2 ? PC_DT + hsc : (wsc == 2 ? PC_GA + hsc : PC_GB + hsc);
    for (int tok = gwave(); tok < MTOK; tok += nwaves()) {
        const int t = tok % SEQ;
        const size_t row = (size_t)tok * LDP;
        uint4 xa[4], xq[4], xv4[4];
#pragma unroll
        for (int j = 0; j < 4; ++j) {
            const size_t rj = (t - 3 + j >= 0) ? row - (size_t)(3 - j) * LDP : row;
            xa[j] = *(const uint4*)(P + rj + PC_XBC + 8 * lane);
            xq[j] = *(const uint4*)(P + rj + PC_GQKV + 8 * lane);
            xv4[j] = *(const uint4*)(P + rj + PC_GQKV + 512 + 8 * (lane & 31));
        }
        const uint4 gl0 = *(const uint4*)(P + row + PC_GLR), gl1 = *(const uint4*)(P + row + PC_GLR + 8);
        const float scraw = bf2f(P[row + sccol]);
        {
            float acc[8];
            load8f(scb + 8 * lane, acc);
            conv8r(xa, t, scw, 512, 8 * lane, acc);
#pragma unroll
            for (int i = 0; i < 8; ++i) acc[i] = silu_f(acc[i]);
            *(uint4*)(HS + (size_t)tok * 1024 + 8 * lane) = pack8(acc);
        }
        {
            float acc[8];
#pragma unroll
            for (int i = 0; i < 8; ++i) acc[i] = 0.f;
            conv8r(xq, t, gcw, 768, 8 * lane, acc);
            float ss = 0.f;
#pragma unroll
            for (int i = 0; i < 8; ++i) { acc[i] = silu_f(acc[i]); ss += acc[i] * acc[i]; }
            ss = oct_sum(ss);
            const float sc = rsqrtf(ss + EPS) * (lane < 32 ? 0.125f : 1.f);
#pragma unroll
            for (int i = 0; i < 8; ++i) acc[i] *= sc;
            *(uint4*)(HS + (size_t)tok * 1024 + 512 + 8 * lane) = pack8(acc);
        }
        {
            float acc[8];
#pragma unroll
            for (int i = 0; i < 8; ++i) acc[i] = 0.f;
            conv8r(xv4, t, gcw, 768, 512 + 8 * (lane & 31), acc);
#pragma unroll
            for (int i = 0; i < 8; ++i) acc[i] = silu_f(acc[i]);
            if (lane < 32) *(uint4*)(VG + (size_t)tok * 256 + 8 * lane) = pack8(acc);
        }
        {
            float v;
            if (wsc < 2) { const float dt = softplus_f(scraw + k_dtb); v = wsc == 0 ? dt : __expf(-dt * k_alog); }
            else if (wsc == 2) v = __expf(-k_galog * softplus_f(scraw + k_gdtb));
            else v = sigmoid_f(scraw);
            if (lane < 16) SC[(size_t)tok * 16 + lane] = v;
        }
        {
            float gl[16];
            { float a8[8], b8[8]; unpack8(gl0, a8); unpack8(gl1, b8);
#pragma unroll
              for (int i = 0; i < 8; ++i) { gl[i] = a8[i]; gl[8 + i] = b8[i]; } }
#pragma unroll
            for (int i = 0; i < 2; ++i) {
                const int c = lane + 64 * i;
                float acc = bg[c];
#pragma unroll
                for (int r = 0; r < 16; ++r) acc = __builtin_fmaf(gl[r], wg[r * 128 + c], acc);
                DEC[(size_t)tok * 128 + c] = __expf(logsigmoid_f(acc) * (1.f / 16.f));
            }
        }
    }
}

#define SCAN_LDS_WAVE 4608
typedef float f2_t __attribute__((ext_vector_type(2)));
__device__ __forceinline__ f2_t mk2(float a, float b) { f2_t r; r.x = a; r.y = b; return r; }
__device__ __forceinline__ void st8f(char* dst, const uint4 v) {
    *(float4*)dst = make_float4(bflo(v.x), bfhi(v.x), bflo(v.y), bfhi(v.y));
    *(float4*)(dst + 16) = make_float4(bflo(v.z), bfhi(v.z), bflo(v.w), bfhi(v.w));
}
__device__ __forceinline__ void ph_scans(const Ctx& p, int l, float* smem) {
    const bf16_t* P = (const bf16_t*)(pws_() + WS_P);
    const bf16_t* HS = (const bf16_t*)(pws_() + WS_HS);
    const bf16_t* VG = (const bf16_t*)(pws_() + WS_VG);
    const float* DEC = (const float*)(pws_() + WS_DEC);
    const float* SC = (const float*)(pws_() + WS_SC);
    bf16_t* Y = (bf16_t*)(pws_() + WS_Y);
    const int tid = tid_(), lane = tid & 63, wave = tid >> 6;
    if (nblk_() != 256) return;
    const int role = wave < 2 ? 0 : (wave < 6 ? 1 : 2);
    const int idx = (role == 0 ? wave : (role == 1 ? wave - 2 : wave - 6)) * 256 + bid_();
    const int bh = role == 1 ? (idx >> 3) : (idx >> 2), b = bh >> 2, h = bh & 3;
    const int colbase = role == 1 ? (idx & 7) * 8 : (idx & 3) * 16;
    const int cl = role == 1 ? (lane >> 3) : (lane >> 2);
    const int col = colbase + cl;
    const int sq = role == 1 ? (lane & 7) : (lane & 3);
    const size_t tb = (size_t)b * SEQ;
    bf16_t* dummy = (bf16_t*)(pws_() + WS_DUMMY) + (tid & 511) * 8;
    char* lw = (char*)smem + wave * SCAN_LDS_WAVE;
    char* lrow = lw;
    char* lcol = lw + 4096;
    float* lsc = (float*)(lw + 4352);
    const int fs = lane >> 3, fp = lane & 7;
    if (role == 0) {
        const int g = h >> 1;
        const float Dh = pin_(8)[l * 4 + h];
        uint4 f0, f1; unsigned fc = 0u; float fsc = 0.f;
        f2_t st[8];
#pragma unroll
        for (int i = 0; i < 8; ++i) st[i] = mk2(0.f, 0.f);
        auto fetch = [&](int t0) {
            const size_t tok = tb + t0 + fs;
            const bf16_t* src = HS + tok * 1024 + (fp < 4 ? 256 + g * 64 + fp * 16 : 384 + g * 64 + (fp - 4) * 16);
            f0 = *(const uint4*)src; f1 = *(const uint4*)(src + 8);
            fc = *(const unsigned*)(HS + tok * 1024 + h * 64 + colbase + fp * 2);
            if (lane < 16) fsc = SC[(tb + t0 + (lane >> 1)) * 16 + (lane & 1) * 4 + h];
        };
        fetch(0);
        for (int t0 = 0; t0 < SEQ; t0 += 8) {
            st8f(lrow + fs * 512 + fp * 64, f0); st8f(lrow + fs * 512 + fp * 64 + 32, f1);
            *(unsigned*)(lcol + fs * 32 + fp * 4) = fc;
            if (lane < 16) lsc[lane] = fsc;
            if (t0 + 8 < SEQ) fetch(t0 + 8);
#pragma unroll
            for (int i = 0; i < 8; ++i) {
                const char* rb = lrow + i * 512 + sq * 64;
                const float4 b0 = *(const float4*)rb, b1 = *(const float4*)(rb + 16), b2 = *(const float4*)(rb + 32), b3 = *(const float4*)(rb + 48);
                const float4 c0 = *(const float4*)(rb + 256), c1 = *(const float4*)(rb + 272), c2 = *(const float4*)(rb + 288), c3 = *(const float4*)(rb + 304);
                const float xv = bf2f(*(const bf16_t*)(lcol + i * 32 + cl * 2));
                const float2 sc2 = *(const float2*)(lsc + i * 2);
                const float xdt = xv * sc2.x;
                const f2_t xd2 = mk2(xdt, xdt), dA2 = mk2(sc2.y, sc2.y);
                const f2_t bb[8] = {mk2(b0.x, b0.y), mk2(b0.z, b0.w), mk2(b1.x, b1.y), mk2(b1.z, b1.w), mk2(b2.x, b2.y), mk2(b2.z, b2.w), mk2(b3.x, b3.y), mk2(b3.z, b3.w)};
                const f2_t cc[8] = {mk2(c0.x, c0.y), mk2(c0.z, c0.w), mk2(c1.x, c1.y), mk2(c1.z, c1.w), mk2(c2.x, c2.y), mk2(c2.z, c2.w), mk2(c3.x, c3.y), mk2(c3.z, c3.w)};
                f2_t ya = mk2(0.f, 0.f), yb = mk2(0.f, 0.f);
#pragma unroll
                for (int q = 0; q < 8; q += 2) {
                    st[q] = st[q] * dA2 + xd2 * bb[q]; st[q + 1] = st[q + 1] * dA2 + xd2 * bb[q + 1];
                    ya = cc[q] * st[q] + ya; yb = cc[q + 1] * st[q + 1] + yb;
                }
                const f2_t ys = ya + yb;
                const float y = quad_sum(ys.x + ys.y);
                *(sq == 0 ? Y + (tb + t0 + i) * DM + h * 64 + col : dummy + i) = f2bf(y + Dh * xv);
                if (i & 1) __builtin_amdgcn_sched_barrier(0);
            }
        }
    } else if (role == 1) {
        uint4 f0, f1; unsigned fc = 0u; float fsc = 0.f;
        f2_t S[4];
#pragma unroll
        for (int i = 0; i < 4; ++i) S[i] = mk2(0.f, 0.f);
        auto fetch = [&](int t0) {
            const size_t tok = tb + t0 + fs;
            const bf16_t* src = HS + tok * 1024 + (fp < 4 ? 512 + h * 64 + fp * 16 : 768 + h * 64 + (fp - 4) * 16);
            f0 = *(const uint4*)src; f1 = *(const uint4*)(src + 8);
            if (fp < 4) fc = *(const unsigned*)(VG + tok * 256 + h * 64 + colbase + fp * 2);
            if (lane < 16) fsc = SC[(tb + t0 + (lane >> 1)) * 16 + 8 + (lane & 1) * 4 + h];
        };
        fetch(0);
        for (int t0 = 0; t0 < SEQ; t0 += 8) {
            st8f(lrow + fs * 512 + fp * 64, f0); st8f(lrow + fs * 512 + fp * 64 + 32, f1);
            if (fp < 4) *(unsigned*)(lcol + fs * 32 + fp * 4) = fc;
            if (lane < 16) lsc[lane] = fsc;
            if (t0 + 8 < SEQ) fetch(t0 + 8);
#pragma unroll
            for (int i = 0; i < 8; ++i) {
                const char* rb = lrow + i * 512 + sq * 32;
                const float4 q0 = *(const float4*)rb, q1 = *(const float4*)(rb + 16);
                const float4 k0 = *(const float4*)(rb + 256), k1 = *(const float4*)(rb + 272);
                const float vv = bf2f(*(const bf16_t*)(lcol + i * 32 + cl * 2));
                const float2 sc2 = *(const float2*)(lsc + i * 2);
                const f2_t al2 = mk2(sc2.x, sc2.x);
                const f2_t kk[4] = {mk2(k0.x, k0.y), mk2(k0.z, k0.w), mk2(k1.x, k1.y), mk2(k1.z, k1.w)};
                const f2_t qq[4] = {mk2(q0.x, q0.y), mk2(q0.z, q0.w), mk2(q1.x, q1.y), mk2(q1.z, q1.w)};
                f2_t ra = mk2(0.f, 0.f), rb2 = mk2(0.f, 0.f);
#pragma unroll
                for (int q = 0; q < 4; q += 2) {
                    S[q] = S[q] * al2; S[q + 1] = S[q + 1] * al2;
                    ra = S[q] * kk[q] + ra; rb2 = S[q + 1] * kk[q + 1] + rb2;
                }
                const f2_t rs = ra + rb2;
                const float r = oct_sum(rs.x + rs.y);
                const float vn = sc2.y * (vv - r);
                const f2_t vn2 = mk2(vn, vn);
                f2_t oa2 = mk2(0.f, 0.f), ob2 = mk2(0.f, 0.f);
#pragma unroll
                for (int q = 0; q < 4; q += 2) {
                    S[q] = kk[q] * vn2 + S[q]; S[q + 1] = kk[q + 1] * vn2 + S[q + 1];
                    oa2 = S[q] * qq[q] + oa2; ob2 = S[q + 1] * qq[q + 1] + ob2;
                }
                const f2_t os = oa2 + ob2;
                const float ov = oct_sum(os.x + os.y);
                *(sq == 0 ? Y + (tb + t0 + i) * DM + 256 + h * 64 + col : dummy + i) = f2bf(ov);
                if (i & 1) __builtin_amdgcn_sched_barrier(0);
            }
        }
    } else {
        uint4 f0, f1; unsigned fc = 0u;
        f2_t S[4];
#pragma unroll
        for (int i = 0; i < 4; ++i) S[i] = mk2(0.f, 0.f);
        auto fetch = [&](int t0) {
            const size_t tok = tb + t0 + fs;
            if (fp < 4) { const float* src = DEC + tok * 128 + h * 32 + fp * 8; f0 = *(const uint4*)src; f1 = *(const uint4*)(src + 4); }
            else { const bf16_t* src = P + tok * LDP + (fp < 6 ? PC_LK + h * 32 + (fp - 4) * 16 : PC_LQ + h * 32 + (fp - 6) * 16); f0 = *(const uint4*)src; f1 = *(const uint4*)(src + 8); }
            fc = *(const unsigned*)(P + tok * LDP + PC_LV + h * 64 + colbase + fp * 2);
        };
        fetch(0);
        for (int t0 = 0; t0 < SEQ; t0 += 8) {
            if (fp < 4) { *(uint4*)(lrow + fs * 512 + fp * 32) = f0; *(uint4*)(lrow + fs * 512 + fp * 32 + 16) = f1; }
            else { st8f(lrow + fs * 512 + 128 + (fp - 4) * 64, f0); st8f(lrow + fs * 512 + 128 + (fp - 4) * 64 + 32, f1); }
            *(unsigned*)(lcol + fs * 32 + fp * 4) = fc;
            if (t0 + 8 < SEQ) fetch(t0 + 8);
#pragma unroll
            for (int i = 0; i < 8; ++i) {
                const char* rb = lrow + i * 512 + sq * 32;
                const float4 d0 = *(const float4*)rb, d1 = *(const float4*)(rb + 16);
                const float4 k0 = *(const float4*)(rb + 128), k1 = *(const float4*)(rb + 144);
                const float4 q0 = *(const float4*)(rb + 256), q1 = *(const float4*)(rb + 272);
                const float vv = bf2f(*(const bf16_t*)(lcol + i * 32 + cl * 2));
                const f2_t v2 = mk2(vv, vv);
                const f2_t dd[4] = {mk2(d0.x, d0.y), mk2(d0.z, d0.w), mk2(d1.x, d1.y), mk2(d1.z, d1.w)};
                const f2_t kk[4] = {mk2(k0.x, k0.y), mk2(k0.z, k0.w), mk2(k1.x, k1.y), mk2(k1.z, k1.w)};
                const f2_t qq[4] = {mk2(q0.x, q0.y), mk2(q0.z, q0.w), mk2(q1.x, q1.y), mk2(q1.z, q1.w)};
                f2_t oa2 = mk2(0.f, 0.f), ob2 = mk2(0.f, 0.f);
#pragma unroll
                for (int q = 0; q < 4; q += 2) {
                    S[q] = dd[q] * S[q] + kk[q] * v2; S[q + 1] = dd[q + 1] * S[q + 1] + kk[q + 1] * v2;
                    oa2 = S[q] * qq[q] + oa2; ob2 = S[q + 1] * qq[q + 1] + ob2;
                }
                const f2_t os = oa2 + ob2;
                const float ov = quad_sum(os.x + os.y);
                *(sq == 0 ? Y + (tb + t0 + i) * DM + 512 + h * 64 + col : dummy + i) = f2bf(ov * 0.17677669529663687f);
                if (i & 1) __builtin_amdgcn_sched_barrier(0);
            }
        }
    }
}

__device__ __forceinline__ void ph_mixer_finish(const Ctx& p, int l) {
    const bf16_t* P = (const bf16_t*)(pws_() + WS_P);
    bf16_t* Y = (bf16_t*)(pws_() + WS_Y);
    const float* sn = pin_(9) + (size_t)l * 256;
    const float* gn = pin_(13) + (size_t)l * 64;
    const float* ln = pin_(16) + (size_t)l * 64;
    const int lane = tid_() & 63;
    for (int tok = gwave(); tok < MTOK; tok += nwaves()) {
        const size_t row = (size_t)tok * LDP;
        {
            float v[8], gt[8], gw[8];
            unpack8(*(const uint4*)(Y + (size_t)tok * DM + 8 * lane), v);
            unpack8(*(const uint4*)(P + row + (lane < 32 ? PC_Z + 8 * lane : PC_GG + 8 * (lane - 32))), gt);
            load8f(lane < 32 ? sn + 8 * lane : gn + 8 * (lane & 7), gw);
            float ss = 0.f;
            if (lane < 32) {
#pragma unroll
                for (int i = 0; i < 8; ++i) { v[i] *= silu_f(gt[i]); ss += v[i] * v[i]; }
            } else {
#pragma unroll
                for (int i = 0; i < 8; ++i) ss += v[i] * v[i];
            }
            const float s8 = oct_sum(ss);
            float s32 = s8 + __int_as_float(__builtin_amdgcn_mov_dpp(__float_as_int(s8), 0x140, 0xF, 0xF, true));
            s32 += __shfl_xor(s32, 16, 64);
            const float rs = lane < 32 ? rsqrtf(s32 * (1.f / 256.f) + EPS) : rsqrtf(s8 * (1.f / 64.f) + EPS);
            float o[8];
#pragma unroll
            for (int i = 0; i < 8; ++i) o[i] = lane < 32 ? v[i] * rs * gw[i] : v[i] * rs * gw[i] * silu_f(gt[i]);
            *(uint4*)(Y + (size_t)tok * DM + 8 * lane) = pack8(o);
        }
        if (lane < 32) {
            float v[8], gt[8], gw[8];
            unpack8(*(const uint4*)(Y + (size_t)tok * DM + 512 + 8 * lane), v);
            unpack8(*(const uint4*)(P + row + PC_LR + 8 * lane), gt);
            load8f(ln + 8 * (lane & 7), gw);
            float ss = 0.f;
#pragma unroll
            for (int i = 0; i < 8; ++i) ss += v[i] * v[i];
            const float rs = rsqrtf(oct_sum(ss) * (1.f / 64.f) + EPS);
            float o[8];
#pragma unroll
            for (int i = 0; i < 8; ++i) o[i] = v[i] * rs * gw[i] * silu_f(gt[i]);
            *(uint4*)(Y + (size_t)tok * DM + 512 + 8 * lane) = pack8(o);
        }
    }
}

typedef short bf16x8_t __attribute__((ext_vector_type(8)));
typedef float f32x4_t __attribute__((ext_vector_type(4)));
union BF8 { bf16x8_t v; uint4 u; unsigned w[4]; };


__device__ __forceinline__ void ph_dsa_prep(const Ctx& p, int l) {
    const bf16_t* P = (const bf16_t*)(pws_() + WS_P);
    bf16_t* qn = (bf16_t*)(pws_() + WS_QN);
    bf16_t* kn = (bf16_t*)(pws_() + WS_KN);
    bf16_t* ikn = (bf16_t*)(pws_() + WS_IKN);
    bf16_t* vt = (bf16_t*)(pws_() + WS_VT);
    const float* qg = pin_(17) + (size_t)l * 64;
    const float* kg = pin_(18) + (size_t)l * 64;
    const float* ig = pin_(19) + (size_t)l * 32;
    const int lane = tid_() & 63;
    const int pcol = lane < 40 ? PC_DQ + 8 * lane : PC_IK + 8 * (lane & 3);
    float gw[8];
    load8f(lane < 32 ? qg + 8 * (lane & 7) : (lane < 40 ? kg + 8 * (lane & 7) : ig + 8 * (lane & 3)), gw);
    for (int grp = gwave(); grp < MTOK / 8; grp += nwaves()) {
        const size_t tok0 = (size_t)grp * 8;
        const int b = (int)(tok0 / SEQ), t0 = (int)(tok0 % SEQ);
        unsigned short vv[8];
#pragma unroll
        for (int i = 0; i < 8; ++i) {
            const size_t row = (tok0 + i) * LDP;
            vv[i] = P[row + PC_DV + lane];
            if (lane < 44) {
                float v[8];
                unpack8(*(const uint4*)(P + row + pcol), v);
                float ss = 0.f;
#pragma unroll
                for (int q = 0; q < 8; ++q) ss += v[q] * v[q];
                const float s4 = ss + __int_as_float(__builtin_amdgcn_mov_dpp(__float_as_int(ss), 0xB1, 0xF, 0xF, true));
                const float s4b = s4 + __int_as_float(__builtin_amdgcn_mov_dpp(__float_as_int(s4), 0x4E, 0xF, 0xF, true));
                const float s8 = s4b + __int_as_float(__builtin_amdgcn_mov_dpp(__float_as_int(s4b), 0x141, 0xF, 0xF, true));
                const float rs = lane < 40 ? rsqrtf(s8 * (1.f / 64.f) + EPS) * (lane < 32 ? 0.125f : 1.f) : rsqrtf(s4b * (1.f / 32.f) + EPS);
                float o[8];
#pragma unroll
                for (int q = 0; q < 8; ++q) o[q] = v[q] * rs * gw[q];
                const uint4 pk = pack8(o);
                if (lane < 32) *(uint4*)(qn + (tok0 + i) * 256 + 8 * lane) = pk;
                else if (lane < 40) *(uint4*)(kn + (tok0 + i) * 64 + 8 * (lane - 32)) = pk;
                else *(uint4*)(ikn + (tok0 + i) * 32 + 8 * (lane - 40)) = pk;
            }
        }
        uint4 o; o.x = (unsigned)vv[0] | ((unsigned)vv[1] << 16); o.y = (unsigned)vv[2] | ((unsigned)vv[3] << 16);
        o.z = (unsigned)vv[4] | ((unsigned)vv[5] << 16); o.w = (unsigned)vv[6] | ((unsigned)vv[7] << 16);
        *(uint4*)(vt + ((size_t)b * 64 + lane) * SEQ + t0) = o;
    }
}

#define DSA_STRIDE 2052
__device__ __forceinline__ void ph_dsa_main(const Ctx& p, int l, float* smem) {
    const bf16_t* P = (const bf16_t*)(pws_() + WS_P);
    bf16_t* Y = (bf16_t*)(pws_() + WS_Y);
    const bf16_t* QN = (const bf16_t*)(pws_() + WS_QN);
    const bf16_t* KN = (const bf16_t*)(pws_() + WS_KN);
    const bf16_t* IKN = (const bf16_t*)(pws_() + WS_IKN);
    const bf16_t* VT = (const bf16_t*)(pws_() + WS_VT);
    unsigned* sc = (unsigned*)smem;
    float* part = smem;
    float* plsum = smem + 8 * 64 * 64;
    unsigned* thr = (unsigned*)(smem + 35000);
    const int tid = tid_(), lane = tid & 63, w = tid >> 6, qi = lane & 15, g = lane >> 4;
    for (int task = bid_(); task < MTOK / 16; task += nblk_()) {
        const int c = 31 - task / 128, b = (task >> 2) & 31, sub = task & 3;
        const int t0 = c * 64 + sub * 16, nk = (c + 1) * 64;
        const size_t tok0 = (size_t)b * SEQ + t0;
        const bool dosel = nk > 256;
        if (dosel) {
            BF8 iqf[8]; float wq[8];
#pragma unroll
            for (int h = 0; h < 8; ++h) {
                iqf[h].u = *(const uint4*)(P + (tok0 + qi) * LDP + PC_IQ + h * 32 + 8 * g);
                wq[h] = bf2f(P[(tok0 + qi) * LDP + PC_IW + h]) * 0.0625f;
            }
            for (int kt = w; kt < nk / 16; kt += 8) {
                const int s0 = kt * 16;
                BF8 ka; ka.u = *(const uint4*)(IKN + ((size_t)b * SEQ + s0 + qi) * 32 + 8 * g);
                float acc[4] = {0.f, 0.f, 0.f, 0.f};
#pragma unroll
                for (int h = 0; h < 8; ++h) {
                    const f32x4_t d = __builtin_amdgcn_mfma_f32_16x16x32_bf16(ka.v, iqf[h].v, (f32x4_t){0.f, 0.f, 0.f, 0.f}, 0, 0, 0);
#pragma unroll
                    for (int r = 0; r < 4; ++r) acc[r] = __builtin_fmaf(wq[h], fmaxf(d[r], 0.f), acc[r]);
                }
                uint4 kv; kv.x = ford(acc[0]); kv.y = ford(acc[1]); kv.z = ford(acc[2]); kv.w = ford(acc[3]);
                *(uint4*)(sc + qi * DSA_STRIDE + s0 + 4 * g) = kv;
            }
        }
        __syncthreads();
        if (dosel) {
            const int nj = nk >> 6;
#pragma unroll 1
            for (int qq = 0; qq < 2; ++qq) {
                const int q = 2 * w + qq;
                unsigned kreg[32];
#pragma unroll
                for (int j = 0; j < 32; ++j) kreg[j] = (j < nj) ? sc[q * DSA_STRIDE + j * 64 + lane] : 0u;
                unsigned T = 0u; bool exact = false;
                for (int bit = 31; bit >= 0; --bit) {
                    const unsigned cand = T | (1u << bit);
                    int cnt = 0;
#pragma unroll
                    for (int j = 0; j < 32; ++j) cnt += __popcll(__ballot(kreg[j] >= cand));
                    if (cnt >= 256) { T = cand; if (cnt == 256) { exact = true; break; } }
                }
                int cut = 0x7fffffff;
                if (!exact) {
                    int cgt = 0, ceq = 0;
#pragma unroll
                    for (int j = 0; j < 32; ++j) { cgt += __popcll(__ballot(kreg[j] > T)); ceq += __popcll(__ballot(kreg[j] == T)); }
                    int need = 256 - cgt;
                    if (ceq > need) {
                        bool found = false;
#pragma unroll
                        for (int j = 0; j < 32; ++j) {
                            const unsigned long long m = __ballot(kreg[j] == T);
                            const int cj = __popcll(m);
                            if (!found) {
                                if (need <= cj) { for (int bpos = 0; bpos < 64; ++bpos) if ((m >> bpos) & 1ull) { if (--need == 0) { cut = j * 64 + bpos; break; } } found = true; }
                                else need -= cj;
                            }
                        }
                    }
                }
                if (lane == 0) { thr[q] = T; thr[16 + q] = (unsigned)cut; }
            }
        }
        __syncthreads();
        unsigned Tq = 0u; int cutq = 0x7fffffff;
        if (dosel) { Tq = thr[qi]; cutq = (int)thr[16 + qi]; }
        f32x4_t oacc[4][4]; float lsum[4];
#pragma unroll
        for (int h = 0; h < 4; ++h) { lsum[h] = 0.f;
#pragma unroll
            for (int dt = 0; dt < 4; ++dt) oacc[h][dt] = (f32x4_t){0.f, 0.f, 0.f, 0.f}; }
        const int krow = 8 * (qi >> 2) + (qi & 3);
        for (int st = w; st < nk / 32; st += 8) {
            const int s0 = st * 32;
            BF8 ka[2][2], va[4];
#pragma unroll
            for (int t = 0; t < 2; ++t)
#pragma unroll
                for (int s2 = 0; s2 < 2; ++s2) ka[t][s2].u = *(const uint4*)(KN + ((size_t)b * SEQ + s0 + krow + 4 * t) * 64 + 32 * s2 + 8 * g);
#pragma unroll
            for (int dt = 0; dt < 4; ++dt) va[dt].u = *(const uint4*)(VT + ((size_t)b * 64 + 16 * dt + qi) * SEQ + s0 + 8 * g);
            float mk[8];
            if (dosel) {
                const uint4 k0 = *(const uint4*)(sc + qi * DSA_STRIDE + s0 + 8 * g), k1 = *(const uint4*)(sc + qi * DSA_STRIDE + s0 + 8 * g + 4);
                const unsigned kk[8] = {k0.x, k0.y, k0.z, k0.w, k1.x, k1.y, k1.z, k1.w};
#pragma unroll
                for (int j = 0; j < 8; ++j) mk[j] = (kk[j] > Tq || (kk[j] == Tq && (s0 + 8 * g + j) <= cutq)) ? 1.f : 0.f;
            } else {
#pragma unroll
                for (int j = 0; j < 8; ++j) mk[j] = 1.f;
            }
#pragma unroll
            for (int h = 0; h < 4; ++h) {
                BF8 q0, q1;
                q0.u = *(const uint4*)(QN + (tok0 + qi) * 256 + h * 64 + 8 * g);
                q1.u = *(const uint4*)(QN + (tok0 + qi) * 256 + h * 64 + 32 + 8 * g);
                f32x4_t sacc[2];
#pragma unroll
                for (int t = 0; t < 2; ++t) {
                    sacc[t] = __builtin_amdgcn_mfma_f32_16x16x32_bf16(ka[t][0].v, q0.v, (f32x4_t){0.f, 0.f, 0.f, 0.f}, 0, 0, 0);
                    sacc[t] = __builtin_amdgcn_mfma_f32_16x16x32_bf16(ka[t][1].v, q1.v, sacc[t], 0, 0, 0);
                }
                float pe[8];
#pragma unroll
                for (int t = 0; t < 2; ++t)
#pragma unroll
                    for (int r = 0; r < 4; ++r) { pe[4 * t + r] = __expf(sacc[t][r]) * mk[4 * t + r]; lsum[h] += pe[4 * t + r]; }
                BF8 pf;
#pragma unroll
                for (int j = 0; j < 4; ++j) pf.w[j] = pk_bf16(pe[2 * j], pe[2 * j + 1]);
#pragma unroll
                for (int dt = 0; dt < 4; ++dt) oacc[h][dt] = __builtin_amdgcn_mfma_f32_16x16x32_bf16(va[dt].v, pf.v, oacc[h][dt], 0, 0, 0);
            }
        }
        __syncthreads();
#pragma unroll
        for (int h = 0; h < 4; ++h) {
            plsum[(w * 4 + h) * 64 + lane] = lsum[h];
#pragma unroll
            for (int dt = 0; dt < 4; ++dt)
#pragma unroll
                for (int r = 0; r < 4; ++r) part[(w * 64 + h * 16 + dt * 4 + r) * 64 + lane] = oacc[h][dt][r];
        }
        __syncthreads();
        {
            const int h = w >> 1;
            float lq = 0.f;
#pragma unroll
            for (int w2 = 0; w2 < 8; ++w2)
#pragma unroll
                for (int g2 = 0; g2 < 4; ++g2) lq += plsum[(w2 * 4 + h) * 64 + qi + 16 * g2];
            const float inv = 1.f / lq;
#pragma unroll
            for (int dd = 0; dd < 2; ++dd) {
                const int dt = (w & 1) * 2 + dd;
                float o[4];
#pragma unroll
                for (int r = 0; r < 4; ++r) {
                    float sacc = 0.f;
#pragma unroll
                    for (int w2 = 0; w2 < 8; ++w2) sacc += part[(w2 * 64 + h * 16 + dt * 4 + r) * 64 + lane];
                    o[r] = sacc * inv;
                }
                uint2 ov; ov.x = pk_bf16(o[0], o[1]); ov.y = pk_bf16(o[2], o[3]);
                *(uint2*)(Y + (tok0 + qi) * DM + 768 + h * 64 + 16 * dt + 4 * g) = ov;
            }
        }
        __syncthreads();
    }
}

__device__ __forceinline__ void ph_mem_prep(const Ctx& p, int l) {
    const float* Km = (const float*)(pws_() + WS_KM);
    const float* Vm = (const float*)(pws_() + WS_VM);
    bf16_t* KB = (bf16_t*)(pws_() + WS_KB);
    bf16_t* VTB = (bf16_t*)(pws_() + WS_VTB);
    const float* kg = pin_(28) + (size_t)l * 64;
    const int lane = tid_() & 63;
    for (int r = gwave(); r < MMEM; r += nwaves()) {
        const int b = r / NMEM, j = r % NMEM;
#pragma unroll
        for (int h = 0; h < 4; ++h) {
            const float v = Km[(size_t)r * 256 + h * 64 + lane];
            const float ss = wave_sum(v * v);
            KB[(((size_t)b * 4 + h) * NMEM + j) * 64 + lane] = f2bf(v * rsqrtf(ss * (1.f / 64.f) + EPS) * kg[lane]);
            VTB[(((size_t)b * 4 + h) * 64 + lane) * NMEM + j] = f2bf(Vm[(size_t)r * 256 + h * 64 + lane]);
        }
    }
}
__device__ __forceinline__ void ph_xattn(const Ctx& p, int l) {
    const float* Qx = (const float*)(pws_() + WS_QX);
    bf16_t* Ox = (bf16_t*)(pws_() + WS_OX);
    const bf16_t* KB = (const bf16_t*)(pws_() + WS_KB);
    const bf16_t* VTB = (const bf16_t*)(pws_() + WS_VTB);
    const float* qg = pin_(27) + (size_t)l * 64;
    const int lane = tid_() & 63, qi = lane & 15, g = lane >> 4;
    for (int task = gwave(); task < MTOK / 16; task += nwaves()) {
        const int tok0 = task * 16, b = tok0 / SEQ;
#pragma unroll 1
        for (int h = 0; h < 4; ++h) {
            BF8 qf[2];
            {
                float qv[2][8]; float ss = 0.f;
#pragma unroll
                for (int s2 = 0; s2 < 2; ++s2) {
                    const float4* qp = (const float4*)(Qx + (size_t)(tok0 + qi) * 256 + h * 64 + 32 * s2 + 8 * g);
                    const float4 a = qp[0], c = qp[1];
                    qv[s2][0] = a.x; qv[s2][1] = a.y; qv[s2][2] = a.z; qv[s2][3] = a.w; qv[s2][4] = c.x; qv[s2][5] = c.y; qv[s2][6] = c.z; qv[s2][7] = c.w;
#pragma unroll
                    for (int j = 0; j < 8; ++j) ss += qv[s2][j] * qv[s2][j];
                }
                ss += __shfl_xor(ss, 16, 64); ss += __shfl_xor(ss, 32, 64);
                const float rs = rsqrtf(ss * (1.f / 64.f) + EPS) * 0.125f;
#pragma unroll
                for (int s2 = 0; s2 < 2; ++s2) {
                    const float4 g0 = *(const float4*)(qg + 32 * s2 + 8 * g), g1 = *(const float4*)(qg + 32 * s2 + 8 * g + 4);
                    qf[s2].w[0] = pk_bf16(qv[s2][0] * rs * g0.x, qv[s2][1] * rs * g0.y); qf[s2].w[1] = pk_bf16(qv[s2][2] * rs * g0.z, qv[s2][3] * rs * g0.w);
                    qf[s2].w[2] = pk_bf16(qv[s2][4] * rs * g1.x, qv[s2][5] * rs * g1.y); qf[s2].w[3] = pk_bf16(qv[s2][6] * rs * g1.z, qv[s2][7] * rs * g1.w);
                }
            }
            const bf16_t* Kh = KB + ((size_t)b * 4 + h) * NMEM * 64;
            const bf16_t* Vh = VTB + ((size_t)b * 4 + h) * 64 * NMEM;
            f32x4_t oacc[4];
#pragma unroll
            for (int dt = 0; dt < 4; ++dt) oacc[dt] = (f32x4_t){0.f, 0.f, 0.f, 0.f};
            float lsum = 0.f;
            const int krow = 8 * (qi >> 2) + (qi & 3);
#pragma unroll 2
            for (int s0 = 0; s0 < NMEM; s0 += 32) {
                BF8 ka[2][2], va[4];
#pragma unroll
                for (int t = 0; t < 2; ++t)
#pragma unroll
                    for (int s2 = 0; s2 < 2; ++s2) ka[t][s2].u = *(const uint4*)(Kh + (size_t)(s0 + krow + 4 * t) * 64 + 32 * s2 + 8 * g);
#pragma unroll
                for (int dt = 0; dt < 4; ++dt) va[dt].u = *(const uint4*)(Vh + (size_t)(16 * dt + qi) * NMEM + s0 + 8 * g);
                f32x4_t sacc[2];
#pragma unroll
                for (int t = 0; t < 2; ++t) {
                    sacc[t] = (f32x4_t){0.f, 0.f, 0.f, 0.f};
                    sacc[t] = __builtin_amdgcn_mfma_f32_16x16x32_bf16(ka[t][0].v, qf[0].v, sacc[t], 0, 0, 0);
                    sacc[t] = __builtin_amdgcn_mfma_f32_16x16x32_bf16(ka[t][1].v, qf[1].v, sacc[t], 0, 0, 0);
                }
                float pe[8];
#pragma unroll
                for (int t = 0; t < 2; ++t)
#pragma unroll
                    for (int r = 0; r < 4; ++r) { pe[4 * t + r] = __expf(sacc[t][r]); lsum += pe[4 * t + r]; }
                BF8 pf;
#pragma unroll
                for (int j = 0; j < 4; ++j) pf.w[j] = pk_bf16(pe[2 * j], pe[2 * j + 1]);
#pragma unroll
                for (int dt = 0; dt < 4; ++dt) oacc[dt] = __builtin_amdgcn_mfma_f32_16x16x32_bf16(va[dt].v, pf.v, oacc[dt], 0, 0, 0);
            }
            lsum += __shfl_xor(lsum, 16, 64); lsum += __shfl_xor(lsum, 32, 64);
            const float inv = 1.f / lsum;
#pragma unroll
            for (int dt = 0; dt < 4; ++dt) {
                uint2 o; o.x = pk_bf16(oacc[dt][0] * inv, oacc[dt][1] * inv); o.y = pk_bf16(oacc[dt][2] * inv, oacc[dt][3] * inv);
                *(uint2*)(Ox + (size_t)(tok0 + qi) * 256 + h * 64 + 16 * dt + 4 * g) = o;
            }
        }
    }
}

template <int N> __device__ __forceinline__ void bitonic_sort_desc(unsigned (&a)[N]) {
#pragma unroll
    for (int k = 2; k <= N; k <<= 1)
#pragma unroll
        for (int j = k >> 1; j > 0; j >>= 1)
#pragma unroll
            for (int i = 0; i < N; ++i) {
                const int o = i ^ j;
                if (o > i) {
                    const bool desc = ((i & k) == 0);
                    const unsigned x = a[i], y = a[o];
                    const unsigned mx = x > y ? x : y, mn = x > y ? y : x;
                    a[i] = desc ? mx : mn; a[o] = desc ? mn : mx;
                }
            }
}
__device__ __forceinline__ void bitonic_merge16_desc(unsigned (&a)[16]) {
#pragma unroll
    for (int j = 8; j > 0; j >>= 1)
#pragma unroll
        for (int i = 0; i < 16; ++i) {
            const int o = i ^ j;
            if (o > i) { const unsigned x = a[i], y = a[o]; a[i] = x > y ? x : y; a[o] = x > y ? y : x; }
        }
}
__device__ __forceinline__ void top16_merge(unsigned (&a)[16], const unsigned (&b)[16]) {
#pragma unroll
    for (int i = 0; i < 16; ++i) a[i] = a[i] > b[15 - i] ? a[i] : b[15 - i];
    bitonic_merge16_desc(a);
}
__device__ __forceinline__ void top16_xlane(unsigned (&a)[16], int xm) {
    unsigned b[16];
#pragma unroll
    for (int i = 0; i < 16; ++i) b[i] = (unsigned)__shfl_xor((int)a[i], xm, 64);
    top16_merge(a, b);
}
__device__ __forceinline__ void ph_subkeys_convert(const Ctx& p) {
    const float* sk = pin_(31);
    bf16_t* o = (bf16_t*)(pws_() + WS_SKB);
    const size_t n = (size_t)DEPTH * 8 * 2 * 128 * 64;
    for (size_t i = (size_t)bid_() * 512 + tid_(); i < n; i += (size_t)nblk_() * 512) o[i] = f2bf(sk[i]);
}
__device__ __forceinline__ void ph_peer_topk(const Ctx& p, int l, float* smem) {
    const bf16_t* Qp = (const bf16_t*)(pws_() + WS_QP);
    const bf16_t* SK = (const bf16_t*)(pws_() + WS_SKB) + (size_t)l * 8 * 2 * 128 * 64;
    int* pidx = (int*)(pws_() + WS_PEI);
    float* pgt = (float*)(pws_() + WS_PEG);
    const int tid = tid_(), lane = tid & 63, wave = tid >> 6, qi = lane & 15, g = lane >> 4;
    int* tabw = (int*)smem + wave * 512 + qi * 32;
    for (int task = gwave(); task < MTOK / 16; task += nwaves()) {
        const size_t tok = (size_t)task * 16 + qi;
#pragma unroll 1
        for (int h = 0; h < 8; ++h) {
            unsigned L[2][16];
#pragma unroll
            for (int pp = 0; pp < 2; ++pp) {
                BF8 qf[2];
#pragma unroll
                for (int s2 = 0; s2 < 2; ++s2) qf[s2].u = *(const uint4*)(Qp + tok * DM + h * 128 + pp * 64 + 32 * s2 + 8 * g);
                const bf16_t* skp = SK + (size_t)(h * 2 + pp) * 128 * 64;
                unsigned va[16], vb[16];
#pragma unroll
                for (int tile = 0; tile < 8; ++tile) {
                    BF8 ka[2];
#pragma unroll
                    for (int s2 = 0; s2 < 2; ++s2) ka[s2].u = *(const uint4*)(skp + (size_t)(16 * tile + qi) * 64 + 32 * s2 + 8 * g);
                    f32x4_t d = __builtin_amdgcn_mfma_f32_16x16x32_bf16(ka[0].v, qf[0].v, (f32x4_t){0.f, 0.f, 0.f, 0.f}, 0, 0, 0);
                    d = __builtin_amdgcn_mfma_f32_16x16x32_bf16(ka[1].v, qf[1].v, d, 0, 0, 0);
#pragma unroll
                    for (int r = 0; r < 4; ++r) {
                        const unsigned key = (ford(d[r]) & ~127u) | (unsigned)(127 - (16 * tile + 4 * g + r));
                        if (tile < 4) va[tile * 4 + r] = key; else vb[(tile - 4) * 4 + r] = key;
                    }
                }
                bitonic_sort_desc<16>(va);
                bitonic_sort_desc<16>(vb);
                top16_merge(va, vb);
                top16_xlane(va, 16);
                top16_xlane(va, 32);
#pragma unroll
                for (int i = 0; i < 16; ++i) L[pp][i] = va[i];
            }
            if (g < 2) {
#pragma unroll
                for (int i = 0; i < 16; ++i) tabw[g * 16 + i] = 127 - (int)((g == 0 ? L[0][i] : L[1][i]) & 127u);
            }
            float s1[16], s2v[16];
#pragma unroll
            for (int i = 0; i < 16; ++i) { s1[i] = funord(L[0][i] & ~127u); s2v[i] = funord(L[1][i] & ~127u); }
            unsigned ca[16], cb[16];
#pragma unroll
            for (int i = 0; i < 16; ++i) { ca[i] = 0u; cb[i] = 0u; }
            {
                const float r0 = g == 0 ? s1[0] : (g == 1 ? s1[1] : (g == 2 ? s1[2] : s1[3]));
                const int nb0 = g == 0 ? 16 : (g == 1 ? 8 : (g == 2 ? 5 : 4));
#pragma unroll
                for (int bq = 0; bq < 16; ++bq) if (bq < nb0) ca[bq] = (ford(r0 + s2v[bq]) & ~255u) | (unsigned)(255 - (g * 16 + bq));
                const float r1 = g == 0 ? s1[4] : (g == 1 ? s1[5] : (g == 2 ? s1[6] : s1[7]));
                const int nb1 = g == 0 ? 3 : 2;
#pragma unroll
                for (int bq = 0; bq < 3; ++bq) if (bq < nb1) cb[bq] = (ford(r1 + s2v[bq]) & ~255u) | (unsigned)(255 - ((g + 4) * 16 + bq));
                const float r2 = g == 0 ? s1[8] : (g == 1 ? s1[9] : (g == 2 ? s1[10] : s1[11]));
                cb[3] = (ford(r2 + s2v[0]) & ~255u) | (unsigned)(255 - ((g + 8) * 16));
                const float r3 = g == 0 ? s1[12] : (g == 1 ? s1[13] : (g == 2 ? s1[14] : s1[15]));
                cb[4] = (ford(r3 + s2v[0]) & ~255u) | (unsigned)(255 - ((g + 12) * 16));
            }
            bitonic_sort_desc<16>(ca);
            bitonic_sort_desc<16>(cb);
            top16_merge(ca, cb);
            top16_xlane(ca, 16);
            top16_xlane(ca, 32);
            float tv[16]; float den = 0.f;
#pragma unroll
            for (int i = 0; i < 16; ++i) {
                const int f = 255 - (int)(ca[i] & 255u);
                const int a = f >> 4, bq = f & 15;
                tv[i] = funord(ca[i] & ~255u);
                (void)a; (void)bq;
            }
#pragma unroll
            for (int i = 0; i < 16; ++i) { tv[i] = __expf(tv[i] - funord(ca[0] & ~255u)); den += tv[i]; }
            const float inv = 1.f / den;
            int ev[4]; float gv[4];
#pragma unroll
            for (int r = 0; r < 4; ++r) {
                const unsigned key = g == 0 ? ca[r] : (g == 1 ? ca[4 + r] : (g == 2 ? ca[8 + r] : ca[12 + r]));
                const float tvv = g == 0 ? tv[r] : (g == 1 ? tv[4 + r] : (g == 2 ? tv[8 + r] : tv[12 + r]));
                const int f = 255 - (int)(key & 255u);
                ev[r] = tabw[f >> 4] * 128 + tabw[16 + (f & 15)];
                gv[r] = tvv * inv;
            }
            *(int4*)(pidx + tok * 128 + h * 16 + 4 * g) = make_int4(ev[0], ev[1], ev[2], ev[3]);
            *(float4*)(pgt + tok * 128 + h * 16 + 4 * g) = make_float4(gv[0], gv[1], gv[2], gv[3]);
        }
    }
}

typedef _Float16 h2_t __attribute__((ext_vector_type(2)));
__device__ __forceinline__ h2_t as_h2(unsigned u) { union { unsigned u; h2_t h; } c; c.u = u; return c.h; }
#define U_SCALE 1024.f
#define V_SCALE 256.f
typedef float f32x2_t __attribute__((ext_vector_type(2)));
__device__ __forceinline__ unsigned pack4_fp8(float4 a, float sc) {
    const float x = fminf(fmaxf(a.x * sc, -448.f), 448.f), y = fminf(fmaxf(a.y * sc, -448.f), 448.f);
    const float z = fminf(fmaxf(a.z * sc, -448.f), 448.f), w = fminf(fmaxf(a.w * sc, -448.f), 448.f);
    int r = __builtin_amdgcn_cvt_pk_fp8_f32(x, y, 0, false);
    r = __builtin_amdgcn_cvt_pk_fp8_f32(z, w, r, true);
    return (unsigned)r;
}
__device__ __forceinline__ void ph_tab_convert(const Ctx& p, int l) {
    const float4* u = (const float4*)(pin_(32) + (size_t)l * NEXP * DM);
    const float4* v = (const float4*)(pin_(33) + (size_t)l * NEXP * DM);
    unsigned* uo = (unsigned*)(pws_() + WS_UT16);
    unsigned* vo = (unsigned*)(pws_() + WS_VT16);
    const size_t n4 = (size_t)NEXP * DM / 4;
    for (size_t i = (size_t)bid_() * 512 + tid_(); i < n4; i += (size_t)nblk_() * 512) {
        uo[i] = pack4_fp8(u[i], U_SCALE);
        vo[i] = pack4_fp8(v[i], V_SCALE);
    }
}
#define WS_PD (WS_P)
template <int HALF>
__device__ __forceinline__ void ph_peer_u(const Ctx& p, int l) {
    const unsigned char* ut = (const unsigned char*)(pws_() + WS_UT16);
    const int* pidx = (const int*)(pws_() + WS_PEI);
    float* pgt = (float*)(pws_() + WS_PEG);
    float* pd_ = (float*)(pws_() + WS_PD);
    const bf16_t* H = (const bf16_t*)(pws_() + WS_H);
    const int lane = tid_() & 63;
    const bool r = lane & 32, bit4 = lane & 16, bit3 = lane & 8, bit2 = lane & 4, bit1 = lane & 2;
    const int coff = 512 * HALF + 16 * (lane & 31);
    const int pmine = 2 * (((lane >> 4) & 1) * 8 + ((lane >> 3) & 1) * 4 + ((lane >> 2) & 1) * 2 + ((lane >> 1) & 1)) + (lane >> 5);
    const int nw = nwaves();
    int tok = gwave();
    uint4 nr0 = *(const uint4*)(H + (size_t)tok * DM + coff), nr1 = *(const uint4*)(H + (size_t)tok * DM + coff + 8);
    int ne0 = pidx[(size_t)tok * 128 + lane], ne1 = pidx[(size_t)tok * 128 + 64 + lane];
    for (; tok < MTOK; tok += nw) {
        float hh[16];
        {
            const unsigned w[8] = {nr0.x, nr0.y, nr0.z, nr0.w, nr1.x, nr1.y, nr1.z, nr1.w};
#pragma unroll
            for (int q = 0; q < 8; ++q) { hh[2 * q] = __uint_as_float(w[q] << 16); hh[2 * q + 1] = __uint_as_float(w[q] & 0xffff0000u); }
        }
        const int e0 = ne0, e1 = ne1;
        if (tok + nw < MTOK) {
            const size_t tn = (size_t)(tok + nw);
            nr0 = *(const uint4*)(H + tn * DM + coff); nr1 = *(const uint4*)(H + tn * DM + coff + 8);
            ne0 = pidx[tn * 128 + lane]; ne1 = pidx[tn * 128 + 64 + lane];
        }
#pragma unroll 1
        for (int hb = 0; hb < 4; ++hb) {
            const int esrc = hb < 2 ? e0 : e1;
            const int lb = (hb & 1) * 32;
            uint4 ur[16];
#pragma unroll
            for (int i = 0; i < 16; ++i) {
                const int ea = __builtin_amdgcn_readlane(esrc, lb + 2 * i), eb = __builtin_amdgcn_readlane(esrc, lb + 2 * i + 1);
                const int e = r ? eb : ea;
                ur[i] = *(const uint4*)(ut + (size_t)e * DM + coff);
            }
            float pd[16];
#pragma unroll
            for (int i = 0; i < 16; ++i) {
                const unsigned w[4] = {ur[i].x, ur[i].y, ur[i].z, ur[i].w};
                float d0 = 0.f, d1 = 0.f;
#pragma unroll
                for (int q = 0; q < 4; ++q) {
                    const f32x2_t a = __builtin_amdgcn_cvt_pk_f32_fp8((int)w[q], false), c = __builtin_amdgcn_cvt_pk_f32_fp8((int)w[q], true);
                    d0 = __builtin_fmaf(a.x, hh[4 * q], d0); d1 = __builtin_fmaf(a.y, hh[4 * q + 1], d1);
                    d0 = __builtin_fmaf(c.x, hh[4 * q + 2], d0); d1 = __builtin_fmaf(c.y, hh[4 * q + 3], d1);
                }
                pd[i] = d0 + d1;
            }
            float r8[8], r4[4], r2[2], r1;
#pragma unroll
            for (int i = 0; i < 8; ++i) { const float mine = bit4 ? pd[i + 8] : pd[i], send = bit4 ? pd[i] : pd[i + 8]; r8[i] = mine + __shfl_xor(send, 16, 64); }
#pragma unroll
            for (int i = 0; i < 4; ++i) { const float mine = bit3 ? r8[i + 4] : r8[i], send = bit3 ? r8[i] : r8[i + 4]; r4[i] = mine + __shfl_xor(send, 8, 64); }
#pragma unroll
            for (int i = 0; i < 2; ++i) { const float mine = bit2 ? r4[i + 2] : r4[i], send = bit2 ? r4[i] : r4[i + 2]; r2[i] = mine + __shfl_xor(send, 4, 64); }
            { const float mine = bit1 ? r2[1] : r2[0], send = bit1 ? r2[0] : r2[1]; r1 = mine + __shfl_xor(send, 2, 64); }
            r1 += __shfl_xor(r1, 1, 64);
            const size_t pi = (size_t)tok * 128 + hb * 32 + pmine;
            if (HALF == 0) { if ((lane & 1) == 0) pd_[pi] = r1; }
            else if ((lane & 1) == 0) pgt[pi] = pgt[pi] * gelu_tanh_f((r1 + pd_[pi]) * (1.f / U_SCALE)) * (1.f / V_SCALE);
        }
    }
}
template <int HALF>
__device__ __forceinline__ void ph_peer_v(const Ctx& p, int l) {
    const unsigned char* vt = (const unsigned char*)(pws_() + WS_VT16);
    const int* pidx = (const int*)(pws_() + WS_PEI);
    const float* pgt = (const float*)(pws_() + WS_PEG);
    float* x = pout_();
    const int lane = tid_() & 63;
    const bool r = lane & 32;
    const int coff = 512 * HALF + 16 * (lane & 31);
    const int nw = nwaves();
    int tok = gwave();
    int ne0 = pidx[(size_t)tok * 128 + lane], ne1 = pidx[(size_t)tok * 128 + 64 + lane];
    float nc0 = pgt[(size_t)tok * 128 + lane], nc1 = pgt[(size_t)tok * 128 + 64 + lane];
    for (; tok < MTOK; tok += nw) {
        const int e0 = ne0, e1 = ne1;
        const float c0 = nc0, c1 = nc1;
        if (tok + nw < MTOK) {
            const size_t tn = (size_t)(tok + nw);
            ne0 = pidx[tn * 128 + lane]; ne1 = pidx[tn * 128 + 64 + lane];
            nc0 = pgt[tn * 128 + lane]; nc1 = pgt[tn * 128 + 64 + lane];
        }
        float out[16];
#pragma unroll
        for (int i = 0; i < 16; ++i) out[i] = 0.f;
#pragma unroll 1
        for (int hb = 0; hb < 4; ++hb) {
            const int esrc = hb < 2 ? e0 : e1;
            const float csrc = hb < 2 ? c0 : c1;
            const int lb = (hb & 1) * 32;
            uint4 vr[16];
#pragma unroll
            for (int i = 0; i < 16; ++i) {
                const int ea = __builtin_amdgcn_readlane(esrc, lb + 2 * i), eb = __builtin_amdgcn_readlane(esrc, lb + 2 * i + 1);
                const int e = r ? eb : ea;
                vr[i] = *(const uint4*)(vt + (size_t)e * DM + coff);
            }
#pragma unroll
            for (int i = 0; i < 16; ++i) {
                const float ca = __uint_as_float(__builtin_amdgcn_readlane(__float_as_uint(csrc), lb + 2 * i));
                const float cb = __uint_as_float(__builtin_amdgcn_readlane(__float_as_uint(csrc), lb + 2 * i + 1));
                const float cj = r ? cb : ca;
                const unsigned w[4] = {vr[i].x, vr[i].y, vr[i].z, vr[i].w};
#pragma unroll
                for (int q = 0; q < 4; ++q) {
                    const f32x2_t a = __builtin_amdgcn_cvt_pk_f32_fp8((int)w[q], false), c = __builtin_amdgcn_cvt_pk_f32_fp8((int)w[q], true);
                    out[4 * q] = __builtin_fmaf(a.x, cj, out[4 * q]); out[4 * q + 1] = __builtin_fmaf(a.y, cj, out[4 * q + 1]);
                    out[4 * q + 2] = __builtin_fmaf(c.x, cj, out[4 * q + 2]); out[4 * q + 3] = __builtin_fmaf(c.y, cj, out[4 * q + 3]);
                }
            }
        }
#pragma unroll
        for (int i = 0; i < 16; ++i) out[i] += __shfl_xor(out[i], 32, 64);
        if (!r) {
            float4* xp = (float4*)(x + (size_t)tok * DM + coff);
#pragma unroll
            for (int q = 0; q < 4; ++q) {
                float4 a = xp[q];
                a.x += out[4 * q]; a.y += out[4 * q + 1]; a.z += out[4 * q + 2]; a.w += out[4 * q + 3];
                xp[q] = a;
            }
        }
    }
}


#ifndef PROBE_MASK
#define PROBE_MASK 0
#endif
#if PROBE_MASK
#define GB(k) do { GRID_BARRIER(); const unsigned long long now_ = wall_clock64(); if ((PROBE_MASK >> (k)) & 1) { const unsigned long long dt_ = now_ - tprev_; while (wall_clock64() - now_ < 3ull * dt_) __builtin_amdgcn_s_sleep(8); } GRID_BARRIER(); tprev_ = wall_clock64(); } while (0)
#else
#define GB(k) GRID_BARRIER()
#endif
__global__ void __launch_bounds__(512, 2) k_mega(Params kp) {
    float* sm = dynsmem;
    {
        unsigned long long* tab = (unsigned long long*)((char*)dynsmem + PTAB_OFF);
        if (threadIdx.x < 34) tab[threadIdx.x] = (unsigned long long)kp.in[threadIdx.x];
        if (threadIdx.x == 34) tab[34] = (unsigned long long)kp.out;
        if (threadIdx.x == 35) tab[35] = (unsigned long long)kp.ws;
        if (threadIdx.x == 36) { tab[36] = 0ull; tab[37] = 0ull; }
    }
    __syncthreads();
    Ctx p; p.kp = &kp;
    (void)xcd_barrier_post((unsigned*)(pws_() + WS_BAR), (volatile LAS unsigned*)((char*)dynsmem + PTAB_OFF + 36 * 8));
#define GRID_BARRIER() do { XcdBarrier bar_; bar_.bar = (unsigned*)(pws_() + WS_BAR); bar_.x = xb_xcc_id(); bar_.st = (volatile LAS unsigned*)((char*)dynsmem + PTAB_OFF + 36 * 8); xcd_barrier(bar_); } while (0)
    ph_weight_prep(p, sm);
    ph_subkeys_convert(p);
    GRID_BARRIER();
#if PROBE_MASK
    unsigned long long tprev_ = wall_clock64();
#endif
#pragma unroll 1
    for (int l = 0; l < DEPTH; ++l) {
#define XIN_ (l == 0 ? pin_(0) : pout_())
#define HBUF_ ((const bf16_t*)(pws_() + WS_H))
        ph_rmsnorm(XIN_, pin_(2) + (size_t)l * DM, (bf16_t*)(pws_() + WS_H), MTOK);
        ph_rmsnorm(pin_(1), pin_(22) + (size_t)l * DM, (bf16_t*)(pws_() + WS_HM), MMEM);
        GB(1);
        { pg8::EpiBf16 E; E.O = (bf16_t*)(pws_() + WS_P); E.ldc = LDP; ph_gemm(HBUF_, (const bf16_t*)(pws_() + WT_IN) + (size_t)l * LDP * DM, MTOK, LDP, DM, E); }
        { pg8::EpiF32 E; E.C = (float*)(pws_() + WS_KM); E.R = nullptr; E.ldc = 256; ph_gemm((const bf16_t*)(pws_() + WS_HM), (const bf16_t*)(pws_() + WT_XK) + (size_t)l * 256 * DM, MMEM, 256, DM, E, 32); }
        { pg8::EpiF32 E; E.C = (float*)(pws_() + WS_VM); E.R = nullptr; E.ldc = 256; ph_gemm((const bf16_t*)(pws_() + WS_HM), (const bf16_t*)(pws_() + WT_XV) + (size_t)l * 256 * DM, MMEM, 256, DM, E, 64); }
        GB(2);
        ph_mem_prep(p, l);
        ph_dsa_prep(p, l);
        ph_scan_prep(p, l);
        GB(3);
        ph_scans(p, l, sm);
        GB(4);
        ph_mixer_finish(p, l);
        ph_dsa_main(p, l, sm);
        GB(5);
        { pg8::EpiF32 E; E.C = pout_(); E.R = XIN_; E.ldc = DM; ph_gemm((const bf16_t*)(pws_() + WS_Y), (const bf16_t*)(pws_() + WT_OUT) + (size_t)l * DM * DM, MTOK, DM, DM, E); }
        GB(6);
        ph_rmsnorm(pout_(), pin_(21) + (size_t)l * DM, (bf16_t*)(pws_() + WS_H), MTOK);
        GB(7);
        { pg8::EpiF32 E; E.C = (float*)(pws_() + WS_QX); E.R = nullptr; E.ldc = 256; ph_gemm(HBUF_, (const bf16_t*)(pws_() + WT_XQ) + (size_t)l * 256 * DM, MTOK, 256, DM, E); }
        GB(8);
        ph_xattn(p, l);
        GB(9);
        { pg8::EpiF32 E; E.C = pout_(); E.R = pout_(); E.ldc = DM; ph_gemm((const bf16_t*)(pws_() + WS_OX), (const bf16_t*)(pws_() + WT_XO) + (size_t)l * DM * 256, MTOK, DM, 256, E); }
        GB(10);
        ph_rmsnorm(pout_(), pin_(29) + (size_t)l * DM, (bf16_t*)(pws_() + WS_H), MTOK);
        ph_tab_convert(p, l);
        GB(11);
        { pg8::EpiBf16 E; E.O = (bf16_t*)(pws_() + WS_QP); E.ldc = DM; ph_gemm(HBUF_, (const bf16_t*)(pws_() + WT_PQ) + (size_t)l * DM * DM, MTOK, DM, DM, E); }
        GB(12);
        ph_peer_topk(p, l, sm);
        GB(13);
        ph_peer_u<0>(p, l);
        GB(14);
        ph_peer_u<1>(p, l);
        GB(15);
        ph_peer_v<0>(p, l);
        GB(16);
        ph_peer_v<1>(p, l);
        GB(17);
    }
}

extern "C" void kernel_launch(void* const* d_in, const int* in_sizes, int n_in, void* d_out, int out_size, void* d_ws, size_t ws_size, hipStream_t stream) {
    if (n_in != 34 || out_size != MTOK * DM || ws_size < WS_END) {
        fprintf(stderr, "kernel_launch: unexpected shapes (n_in %d out %d ws %zu need %zu)\n", n_in, out_size, ws_size, (size_t)WS_END);
        return;
    }
    static int grid = 0;
    if (!grid) {
        int dev = 0, cus = 0, per_cu = 0;
        (void)hipGetDevice(&dev);
        (void)hipDeviceGetAttribute(&cus, hipDeviceAttributeMultiprocessorCount, dev);
        (void)hipFuncSetAttribute((const void*)k_mega, hipFuncAttributeMaxDynamicSharedMemorySize, LDS_BYTES);
        (void)hipOccupancyMaxActiveBlocksPerMultiprocessor(&per_cu, (const void*)k_mega, 512, LDS_BYTES);
        if (per_cu < 1) fprintf(stderr, "kernel_launch: occupancy query reports %d blocks per CU\n", per_cu);
        grid = cus > 0 ? cus : 256;
    }
    Params p; memset(&p, 0, sizeof(p));
    for (int i = 0; i < 34; ++i) p.in[i] = (const float*)d_in[i];
    p.out = (float*)d_out; p.ws = (char*)d_ws;
    (void)hipMemsetAsync((char*)d_ws + WS_BAR, 0, XCD_BAR_WORDS * sizeof(unsigned), stream);
    hipLaunchKernelGGL(k_mega, dim3(grid), dim3(512), LDS_BYTES, stream, p);
}
```

```cpp
#include <hip/hip_runtime.h>
#include <stdint.h>
#include <stdio.h>
#include <string.h>

#define NB 32
#define SEQ 2048
#define DM 1024
#define MTOK (NB * SEQ)
#define DEPTH 4
#define NMEM 256
#define MMEM (NB * NMEM)
#define LDP 3328
#define NEXP 16384
#define EPS 1e-6f
#define PC_Z 0
#define PC_XBC 256
#define PC_GQKV 768
#define PC_GG 1536
#define PC_LQ 1792
#define PC_LK 1920
#define PC_LV 2048
#define PC_LR 2304
#define PC_DQ 2560
#define PC_DK 2816
#define PC_DV 2880
#define PC_IQ 2944
#define PC_IK 3200
#define PC_GLR 3232
#define PC_IW 3248
#define PC_DT 3256
#define PC_GA 3260
#define PC_GB 3264

typedef unsigned short bf16_t;

#define WS_BAR 0ull
#define WS_P 16384ull
#define SZ_P ((size_t)MTOK * LDP * 2)
#define WS_H (WS_P + SZ_P)
#define SZ_H ((size_t)MTOK * DM * 2)
#define WS_Y (WS_H + SZ_H)
#define SZ_Y ((size_t)MTOK * DM * 2)
#define WS_WP (WS_Y + SZ_Y)
#define SZ_WP ((size_t)DEPTH * DM * LDP * 4)
#define WT_IN (WS_WP)
#define WT_OUT (WT_IN + (size_t)DEPTH * LDP * DM * 2)
#define WT_XQ (WT_OUT + (size_t)DEPTH * DM * DM * 2)
#define WT_XK (WT_XQ + (size_t)DEPTH * 256 * DM * 2)
#define WT_XV (WT_XK + (size_t)DEPTH * 256 * DM * 2)
#define WT_XO (WT_XV + (size_t)DEPTH * 256 * DM * 2)
#define WT_PQ (WT_XO + (size_t)DEPTH * DM * 256 * 2)
#define WT_END (WT_PQ + (size_t)DEPTH * DM * DM * 2)
#define WS_QN (WS_WP + SZ_WP)
#define SZ_QN ((size_t)MTOK * 256 * 4)
#define WS_KN (WS_QN + SZ_QN)
#define SZ_KN ((size_t)MTOK * 64 * 4)
#define WS_IKN (WS_KN + SZ_KN)
#define SZ_IKN ((size_t)MTOK * 32 * 4)
#define WS_YPRE (WS_IKN + SZ_IKN)
#define SZ_YPRE ((size_t)MTOK * 256 * 4)
#define WS_HM (WS_YPRE + SZ_YPRE)
#define SZ_HM ((size_t)MMEM * DM * 2)
#define WS_KM (WS_HM + SZ_HM)
#define SZ_KM ((size_t)MMEM * 256 * 4)
#define WS_VM (WS_KM + SZ_KM)
#define SZ_VM ((size_t)MMEM * 256 * 4)
#define WS_KB (WS_VM + SZ_VM)
#define SZ_KB ((size_t)MMEM * 256 * 2)
#define WS_VTB (WS_KB + SZ_KB)
#define SZ_VTB ((size_t)MMEM * 256 * 2)
#define WS_VT (WS_VTB + SZ_VTB)
#define SZ_VT ((size_t)MTOK * 64 * 2)
#define WS_SKB (WS_VT + SZ_VT)
#define SZ_SKB ((size_t)DEPTH * 8 * 2 * 128 * 64 * 2)
#define WS_SC (WS_SKB + SZ_SKB)
#define SZ_SC ((size_t)MTOK * 16 * 4)
#define WS_DUMMY (WS_SC + SZ_SC)
#define SZ_DUMMY (65536ull)
#define WS_END (WS_DUMMY + SZ_DUMMY)
#define WS_QX (WS_P)
#define WS_OX (WS_P + (size_t)MTOK * 256 * 4)
#define WS_QP (WS_P)
#define WS_UT16 (WS_P + 260ull * 1024 * 1024)
#define WS_VT16 (WS_UT16 + (size_t)NEXP * DM * 2)
#define WS_PEI (WS_VT16 + (size_t)NEXP * DM * 2)
#define WS_PEG (WS_PEI + (size_t)MTOK * 128 * 4)
#define WS_PEND (WS_PEG + (size_t)MTOK * 128 * 4)
static_assert(WS_PEND <= WS_P + SZ_P, "P region aliases");

struct Params {
    const float* in[34];
    float* out;
    char* ws;
};

#define XB_TMO      128
#define XB_XCNT(j)  (256  + 64 * (j))
#define XB_XSUB(j)  (1280 + 64 * (j))
#define XB_XGEN(j)  (2304 + 64 * (j))
#define XB_TOP      3328
#define XB_TOPGEN   3392
#define XCD_BAR_WORDS 3456
#define XB_SPIN_CAP (1u << 18)
#define LAS __attribute__((address_space(3)))

__device__ __forceinline__ unsigned xb_ld(unsigned* p)              { return __hip_atomic_load(p, __ATOMIC_RELAXED, __HIP_MEMORY_SCOPE_AGENT); }
__device__ __forceinline__ unsigned xb_add(unsigned* p, unsigned v) { return __hip_atomic_fetch_add(p, v, __ATOMIC_RELAXED, __HIP_MEMORY_SCOPE_AGENT); }
__device__ __forceinline__ unsigned xb_xcc_id() { return (unsigned)__builtin_amdgcn_s_getreg((3 << 11) | 20) & 0xFu; }
#define XB_SPIN(cond, bar) do { unsigned _sp = 0; while (cond) { __builtin_amdgcn_s_sleep(1); \
    if ((++_sp & 255u) == 0u) { if (xb_ld(&(bar)[XB_TMO])) break; if (_sp > XB_SPIN_CAP) { atomicAdd(&(bar)[XB_TMO], 1u); break; } } } } while (0)

struct XcdBarrier {
    unsigned* bar; unsigned x;
    volatile LAS unsigned* st;
};

__device__ __forceinline__ XcdBarrier xcd_barrier_post(unsigned* bar, volatile LAS unsigned* st) {
    XcdBarrier b; b.bar = bar; b.x = xb_xcc_id(); b.st = st;
    if (threadIdx.x == 0) (void)xb_add(&bar[XB_XCNT(b.x)], 1u);
    return b;
}
__device__ __forceinline__ void xcd_barrier_complete(unsigned* bar, unsigned x, unsigned& nloc, unsigned& nx) {
    const unsigned G = gridDim.x * gridDim.y * gridDim.z;
    unsigned sum, cnt, mine, sp = 0u;
    for (;;) {
        sum = 0u; cnt = 0u; mine = 0u;
#pragma unroll
        for (unsigned j = 0; j < 16; ++j) { const unsigned c = xb_ld(&bar[XB_XCNT(j)]); sum += c; cnt += (c > 0u) ? 1u : 0u; mine = (j == x) ? c : mine; }
        if (sum == G) break;
        __builtin_amdgcn_s_sleep(1);
        if ((++sp & 255u) == 0u) { if (xb_ld(&bar[XB_TMO])) break; if (sp > XB_SPIN_CAP) { atomicAdd(&bar[XB_TMO], 1u); break; } }
    }
    nloc = mine > 0u ? mine : 1u; nx = cnt > 0u ? cnt : 1u;
}

__device__ __forceinline__ void xcd_barrier(const XcdBarrier& b) {
    asm volatile("s_waitcnt vmcnt(0)" ::: "memory");
    __syncthreads();
    if (threadIdx.x == 0) {
        unsigned* bar = b.bar;
        __builtin_amdgcn_s_waitcnt(0);
        unsigned nloc = b.st[0], nx = b.st[1];
        if (nloc == 0u) { xcd_barrier_complete(bar, b.x, nloc, nx); b.st[0] = nloc; b.st[1] = nx; }
        const unsigned old = xb_add(&bar[XB_XSUB(b.x)], 1u);
        const unsigned gen = old / nloc;
        if (old + 1u == (gen + 1u) * nloc) {
            __builtin_amdgcn_fence(__ATOMIC_RELEASE, "agent");
            asm volatile("s_waitcnt vmcnt(0)" ::: "memory");
            const unsigned og = xb_add(&bar[XB_TOP], 1u);
            const unsigned tg = og / nx;
            if (og + 1u == (tg + 1u) * nx) xb_add(&bar[XB_TOPGEN], 1u);
            else XB_SPIN(xb_ld(&bar[XB_TOPGEN]) == tg, bar);
            __builtin_amdgcn_fence(__ATOMIC_ACQUIRE, "agent");
            xb_add(&bar[XB_XGEN(b.x)], 1u);
            asm volatile("s_waitcnt vmcnt(0)" ::: "memory");
        } else {
            XB_SPIN(xb_ld(&bar[XB_XGEN(b.x)]) == gen, bar);
            __builtin_amdgcn_fence(__ATOMIC_ACQUIRE, "agent");
            asm volatile("s_waitcnt vmcnt(0)" ::: "memory");
        }
    }
    __syncthreads();
}


#define LDS_BYTES (144 * 1024)
#define PTAB_OFF (LDS_BYTES - 1024)
extern __shared__ __attribute__((aligned(16))) float dynsmem[];
struct Ctx { const Params* kp; };
#define pin_(i) (p.kp->in[i])
#define pout_() (p.kp->out)
#define pws_() (p.kp->ws)

__device__ __forceinline__ float bf2f(bf16_t v) { return __uint_as_float(((unsigned)v) << 16); }
__device__ __forceinline__ bf16_t f2bf(float f) { unsigned u = __float_as_uint(f); u += 0x7FFFu + ((u >> 16) & 1u); return (bf16_t)(u >> 16); }
__device__ __forceinline__ unsigned pk_bf16(float lo, float hi) { return (unsigned)f2bf(lo) | ((unsigned)f2bf(hi) << 16); }
__device__ __forceinline__ float wave_sum(float v) {
#pragma unroll
    for (int o = 32; o >= 1; o >>= 1) v += __shfl_xor(v, o, 64);
    return v;
}
__device__ __forceinline__ float wave_max(float v) {
#pragma unroll
    for (int o = 32; o >= 1; o >>= 1) v = fmaxf(v, __shfl_xor(v, o, 64));
    return v;
}
__device__ __forceinline__ float silu_f(float x) { return x / (1.f + __expf(-x)); }
__device__ __forceinline__ float sigmoid_f(float x) { return 1.f / (1.f + __expf(-x)); }
__device__ __forceinline__ float softplus_f(float x) { return x > 20.f ? x : log1pf(__expf(x)); }
__device__ __forceinline__ float logsigmoid_f(float x) { return -softplus_f(-x); }
__device__ __forceinline__ float gelu_tanh_f(float x) { const float u = 0.7978845608028654f * (x + 0.044715f * x * x * x); return 0.5f * x * (1.f + tanhf(u)); }
__device__ __forceinline__ unsigned ford(float f) { f = f + 0.0f; unsigned u = __float_as_uint(f); return (u & 0x80000000u) ? ~u : (u | 0x80000000u); }
__device__ __forceinline__ float funord(unsigned k) { unsigned u = (k & 0x80000000u) ? (k & 0x7fffffffu) : ~k; return __uint_as_float(u); }
__device__ __forceinline__ unsigned long long wave_max_u64(unsigned long long v) {
#pragma unroll
    for (int o = 32; o >= 1; o >>= 1) {
        unsigned lo = __shfl_xor((unsigned)v, o, 64), hi = __shfl_xor((unsigned)(v >> 32), o, 64);
        unsigned long long w = ((unsigned long long)hi << 32) | lo;
        v = w > v ? w : v;
    }
    return v;
}
__device__ __forceinline__ int tid_() { int t = threadIdx.x; asm volatile("" : "+v"(t)); return t; }
__device__ __forceinline__ int bid_() { int b = blockIdx.x; asm volatile("" : "+s"(b)); return b; }
__device__ __forceinline__ int nblk_() { int g = gridDim.x; asm volatile("" : "+s"(g)); return g; }
__device__ __forceinline__ int gwave() { return (bid_() * 512 + tid_()) >> 6; }
__device__ __forceinline__ int nwaves() { return nblk_() * 8; }

namespace pg8 {
#define PG8_LAS __attribute__((address_space(3)))
typedef unsigned short bf16_t;
typedef short bf16x8 __attribute__((ext_vector_type(8)));
typedef float f32x4 __attribute__((ext_vector_type(4)));
typedef unsigned u32x4 __attribute__((ext_vector_type(4)));
constexpr int BM = 256, BK = 64, HALF = 128, HTB = HALF * BK * 2  , STAGE_BYTES = 8 * HTB, NXCD = 8, WGM = 8;

__host__ __device__ __forceinline__ int lds_byte(int r, int c) { const int st = (r >> 4) * 2 + (c >> 5), rr = r & 15, cc = c & 31, ob = rr * 64 + cc * 2; return st * 1024 + (ob ^ (((ob >> 9) & 1) << 5)); }
__host__ __device__ __forceinline__ void stage_rc(int b, int& R, int& C) { const int st = b / 1024, sb = b % 1024, swz = sb ^ (((sb >> 9) & 1) << 5); R = (st >> 1) * 16 + swz / 64; C = (st & 1) * 32 + (swz % 64) / 2; }
__host__ __device__ __forceinline__ int perm32(int rho) { const int n = rho >> 4, i = rho & 15; return 8 * (i >> 2) + 4 * n + (i & 3); }

struct Unit { int pm, pn; };
struct Gemm { const bf16_t* A; const bf16_t* Bt; int M, N, K; };

struct StaticOrder {
    int nM, nN, nwg, G, c;
    __host__ __device__ void init(int M, int N, int G_, int c_) { nM = M / BM; nN = N / BM; nwg = nM * nN; G = G_; c = c_; }
    __host__ __device__ bool next(int i, Unit& u) const {
        const long L = (long)i * G + c; if (L >= nwg) return false;
        int wgid = (int)L; { const int q = nwg / NXCD, r = nwg % NXCD, xcd = wgid % NXCD, off = wgid / NXCD; wgid = (xcd < r ? xcd * (q + 1) : r * (q + 1) + (xcd - r) * q) + off; }
        const int nig = WGM * nN, gid = wgid / nig, fm = gid * WGM, gsz = (nM - fm) < WGM ? (nM - fm) : WGM;
        u.pm = fm + ((wgid % nig) % gsz); u.pn = (wgid % nig) / gsz; return true;
    }
    __device__ __forceinline__ void a_ready(const Unit&) const {}
    __device__ __forceinline__ void done(const Unit&) const {}
};

__device__ __forceinline__ unsigned cvt_pk_bf16(float lo, float hi) { unsigned r; asm volatile("v_cvt_pk_bf16_f32 %0, %1, %2" : "=v"(r) : "v"(lo), "v"(hi)); return r; }
struct EpiF32 {
    static constexpr bool PERM = false, AFTER_DRAIN = false;
    float* C; const float* R; int ldc;
    __device__ __forceinline__ void operator()(const f32x4 (&acc)[2][2][4][2], const Unit& u, int wr, int wc, int fr, int fq) const {
        const int row0 = u.pm * BM + wr * 64 + fr, col0 = u.pn * BM + wc * 32 + 4 * fq;
#pragma unroll
        for (int ai = 0; ai < 2; ++ai)
#pragma unroll
            for (int m = 0; m < 4; ++m) { const size_t off = (size_t)(row0 + ai * HALF + m * 16) * ldc + col0;
#pragma unroll
                for (int bj = 0; bj < 2; ++bj)
#pragma unroll
                    for (int n = 0; n < 2; ++n) { f32x4 v = acc[ai][bj][m][n]; if (R) v += *(const f32x4*)(R + off + bj * HALF + n * 16); *(f32x4*)(C + off + bj * HALF + n * 16) = v; } }
    }
};
struct EpiBf16 {
    static constexpr bool PERM = true, AFTER_DRAIN = false;
    bf16_t* O; int ldc;
    __device__ __forceinline__ void operator()(const f32x4 (&acc)[2][2][4][2], const Unit& u, int wr, int wc, int fr, int fq) const {
        const int row0 = u.pm * BM + wr * 64 + fr, col0 = u.pn * BM + wc * 32 + 8 * fq;
#pragma unroll
        for (int ai = 0; ai < 2; ++ai)
#pragma unroll
            for (int m = 0; m < 4; ++m) { bf16_t* rowp = O + (size_t)(row0 + ai * HALF + m * 16) * ldc + col0;
#pragma unroll
                for (int bj = 0; bj < 2; ++bj) { const f32x4 v0 = acc[ai][bj][m][0], v1 = acc[ai][bj][m][1];
                    u32x4 w; w.x = cvt_pk_bf16(v0[0], v0[1]); w.y = cvt_pk_bf16(v0[2], v0[3]); w.z = cvt_pk_bf16(v1[0], v1[1]); w.w = cvt_pk_bf16(v1[2], v1[3]);
                    *(u32x4*)(rowp + bj * HALF) = w; } }
    }
};

template <class Epi, class Sched, bool STAMP = false>
__device__ __forceinline__ void gemm_phase(PG8_LAS unsigned char* lds, const Gemm g, const Sched& S, const Epi& E, unsigned long long* stamps, const int tid) {
    const int wid = __builtin_amdgcn_readfirstlane(tid >> 6), lane = tid & 63, wr = wid >> 2, wc = wid & 3, fr = lane & 15, fq = lane >> 4;
    const int K = g.K, nt = K / BK;
    int ts_lo = 0, ts_hi = 0, nts = 0; const unsigned long long rt_entry = STAMP ? (unsigned long long)wall_clock64() : 0ull;
#define PG8_STAMP() do { if (STAMP && wid == 0 && nts < 64) { const unsigned long long _c = (unsigned long long)clock64(); \
        ts_lo = (lane == nts) ? (int)(unsigned)_c : ts_lo; ts_hi = (lane == nts) ? (int)(unsigned)(_c >> 32) : ts_hi; ++nts; } } while (0)
    PG8_STAMP();
    unsigned voffA[2], voffB[2];
#pragma unroll
    for (int i = 0; i < 2; ++i) { int R, C; stage_rc(tid * 16 + i * 8192, R, C); const int Rb = Epi::PERM ? ((R & ~31) + perm32(R & 31)) : R;
        voffA[i] = (unsigned)(R * K + C) * 2u; voffB[i] = (unsigned)(Rb * K + C) * 2u; }
    const size_t kstep = (size_t)(BK * 2);
    const size_t hstep = (size_t)HALF * K * 2;
    const size_t tstep = 2 * hstep;
    const unsigned ldsw = (unsigned)wid * 1024u;
    const int aoff = lds_byte(wr * 64 + fr, fq * 8), boff = lds_byte(wc * 32 + fr, fq * 8);
#define PG8_SA(b, h) (((b) * 2 + (h)) * HTB)
#define PG8_SB(b, h) ((4 + (b) * 2 + (h)) * HTB)
#define PG8_STAGE(bufoff, gbase, voff) do { _Pragma("unroll") for (int _i = 0; _i < 2; ++_i) \
        __builtin_amdgcn_global_load_lds((const unsigned*)((const char*)(gbase) + (voff)[_i]), (PG8_LAS unsigned*)(lds + (bufoff) + ldsw + _i * 8192), 16, 0, 0); } while (0)
#define PG8_LDA(dst, b, h) do { _Pragma("unroll") for (int m = 0; m < 4; ++m) _Pragma("unroll") for (int k = 0; k < 2; ++k) dst[m][k] = *(const PG8_LAS bf16x8*)(lds + PG8_SA(b, h) + aoff + m * 2048 + k * 1024); } while (0)
#define PG8_LDB(dst, b, h) do { _Pragma("unroll") for (int n = 0; n < 2; ++n) _Pragma("unroll") for (int k = 0; k < 2; ++k) dst[n][k] = *(const PG8_LAS bf16x8*)(lds + PG8_SB(b, h) + boff + n * 2048 + k * 1024); } while (0)
#define PG8_MMA(ai, bj, At, Bt) do { __builtin_amdgcn_s_setprio(1); _Pragma("unroll") for (int m = 0; m < 4; ++m) _Pragma("unroll") for (int n = 0; n < 2; ++n) _Pragma("unroll") for (int k = 0; k < 2; ++k) \
        acc[ai][bj][m][n] = __builtin_amdgcn_mfma_f32_16x16x32_bf16(Bt[n][k], At[m][k], acc[ai][bj][m][n], 0, 0, 0); __builtin_amdgcn_s_setprio(0); } while (0)
#define PG8_WAIT_V(n) asm volatile("s_waitcnt vmcnt(" #n ")" ::: "memory")
#define PG8_WAIT_L(n) asm volatile("s_waitcnt lgkmcnt(" #n ")" ::: "memory")
#define PG8_BAR __builtin_amdgcn_s_barrier()
#define PG8_SCHED __builtin_amdgcn_sched_barrier(0)
    Unit cur, nxt; int ui = 0;
    if (!S.next(0, cur)) return;
    f32x4 acc[2][2][4][2];
#pragma unroll
    for (int a = 0; a < 2; ++a)
#pragma unroll
        for (int b = 0; b < 2; ++b)
#pragma unroll
            for (int m = 0; m < 4; ++m)
#pragma unroll
                for (int n = 0; n < 2; ++n) acc[a][b][m][n] = (f32x4){0.f, 0.f, 0.f, 0.f};
    bf16x8 At[4][2], B0[2][2], B1[2][2];
    const char* cA = (const char*)g.A + (size_t)cur.pm * tstep; const char* cB = (const char*)g.Bt + (size_t)cur.pn * tstep;
    S.a_ready(cur);
    PG8_STAGE(PG8_SB(0, 0), cB, voffB); PG8_STAGE(PG8_SA(0, 0), cA, voffA); PG8_STAGE(PG8_SB(0, 1), cB + hstep, voffB); PG8_STAGE(PG8_SA(0, 1), cA + hstep, voffA);
    if (wr == 1) PG8_BAR;
    PG8_WAIT_V(4); PG8_BAR;
    PG8_STAGE(PG8_SB(1, 0), cB + kstep, voffB); PG8_STAGE(PG8_SA(1, 0), cA + kstep, voffA); PG8_STAGE(PG8_SB(1, 1), cB + hstep + kstep, voffB);
    PG8_WAIT_V(6); PG8_BAR;
    PG8_STAMP();
    for (;;) {
        const bool has_next = S.next(ui + 1, nxt);
        const char* nA = has_next ? (const char*)g.A + (size_t)nxt.pm * tstep : cA; const char* nB = has_next ? (const char*)g.Bt + (size_t)nxt.pn * tstep : cB;
        for (int t = 0; t < nt; t += 2) {
            const bool last = (t == nt - 2);
            const char* a1 = cA + (size_t)(t + 1) * kstep;
            const char* a2 = last ? nA : cA + (size_t)(t + 2) * kstep; const char* b2 = last ? nB : cB + (size_t)(t + 2) * kstep;
            const char* a3 = a2 + kstep; const char* b3 = b2 + kstep;
            if (last && has_next) S.a_ready(nxt);
            PG8_LDB(B0, 0, 0); PG8_SCHED; PG8_LDA(At, 0, 0); PG8_STAGE(PG8_SA(1, 1), a1 + hstep, voffA);
            PG8_WAIT_L(8); PG8_BAR; PG8_WAIT_L(0); PG8_MMA(0, 0, At, B0); PG8_BAR; PG8_SCHED;
            PG8_LDB(B1, 0, 1); PG8_STAGE(PG8_SB(0, 0), b2, voffB);
            PG8_BAR; PG8_WAIT_L(0); PG8_MMA(0, 1, At, B1); PG8_BAR;
            PG8_LDA(At, 0, 1); PG8_STAGE(PG8_SA(0, 0), a2, voffA);
            PG8_BAR; PG8_WAIT_L(0); PG8_MMA(1, 0, At, B0); PG8_BAR; PG8_SCHED;
            PG8_STAGE(PG8_SB(0, 1), b2 + hstep, voffB);
            PG8_WAIT_V(6); PG8_BAR; PG8_MMA(1, 1, At, B1); PG8_BAR;
            PG8_LDB(B0, 1, 0); PG8_SCHED; PG8_LDA(At, 1, 0); PG8_STAGE(PG8_SA(0, 1), a2 + hstep, voffA);
            PG8_WAIT_L(8); PG8_BAR; PG8_WAIT_L(0); PG8_MMA(0, 0, At, B0); PG8_BAR; PG8_SCHED;
            PG8_LDB(B1, 1, 1); PG8_STAGE(PG8_SB(1, 0), b3, voffB);
            PG8_BAR; PG8_WAIT_L(0); PG8_MMA(0, 1, At, B1); PG8_BAR;
            PG8_LDA(At, 1, 1); PG8_STAGE(PG8_SA(1, 0), a3, voffA);
            PG8_BAR; PG8_WAIT_L(0); PG8_MMA(1, 0, At, B0); PG8_BAR; PG8_SCHED;
            PG8_STAGE(PG8_SB(1, 1), b3 + hstep, voffB);
            PG8_WAIT_V(6); PG8_BAR; PG8_MMA(1, 1, At, B1); PG8_BAR;
        }
        PG8_STAMP();
        if constexpr (!Epi::AFTER_DRAIN) { E(acc, cur, wr, wc, fr, fq); S.done(cur); }
        PG8_STAMP();
        if (!has_next) break;
#pragma unroll
        for (int a = 0; a < 2; ++a)
#pragma unroll
            for (int b = 0; b < 2; ++b)
#pragma unroll
                for (int m = 0; m < 4; ++m)
#pragma unroll
                    for (int n = 0; n < 2; ++n) acc[a][b][m][n] = (f32x4){0.f, 0.f, 0.f, 0.f};
        cur = nxt; cA = nA; cB = nB; ++ui;
    }
    PG8_WAIT_V(0);
    if (wr == 0) PG8_BAR;
    PG8_BAR;
    if constexpr (Epi::AFTER_DRAIN) { E.fused(acc, cur, wr, wc, fr, fq, lds, wid, lane); S.done(cur); }
    PG8_STAMP();
    if (STAMP && wid == 0) { stamps[lane] = lane < nts ? (((unsigned long long)(unsigned)ts_hi << 32) | (unsigned)ts_lo) : 0ull;
        if (lane == 62) stamps[62] = rt_entry; if (lane == 63) stamps[63] = (unsigned long long)wall_clock64(); }
#undef PG8_STAMP
#undef PG8_SA
#undef PG8_SB
#undef PG8_STAGE
#undef PG8_LDA
#undef PG8_LDB
#undef PG8_MMA
#undef PG8_WAIT_V
#undef PG8_WAIT_L
#undef PG8_BAR
#undef PG8_SCHED
}
}

template <class Epi> __device__ __forceinline__ void ph_gemm(const bf16_t* A, const bf16_t* Bt, int M, int N, int K, const Epi& E, int crot = 0) {
    pg8::Gemm g; g.A = A; g.Bt = Bt; g.M = M; g.N = N; g.K = K;
    const int nb_ = nblk_();
    pg8::StaticOrder S; S.init(M, N, nb_, (bid_() + nb_ - crot) % nb_);
    pg8::gemm_phase<Epi, pg8::StaticOrder, false>((PG8_LAS unsigned char*)dynsmem, g, S, E, nullptr, tid_());
}

__device__ __forceinline__ int pcol_to_orig(int c) {
    if (c < 768) return c;
    if (c < 1536) return c - 768 + 772;
    if (c < 1792) return c - 1536 + 1548;
    if (c < 1920) return c - 1792 + 1804;
    if (c < 2048) return c - 1920 + 1932;
    if (c < 2304) return c - 2048 + 2060;
    if (c < 2560) return c - 2304 + 2332;
    if (c < 2816) return c - 2560 + 2588;
    if (c < 2880) return c - 2816 + 2844;
    if (c < 2944) return c - 2880 + 2908;
    if (c < 3200) return c - 2944 + 2972;
    if (c < 3232) return c - 3200 + 3228;
    if (c < 3248) return c - 3232 + 2316;
    if (c < 3256) return c - 3248 + 3260;
    if (c < 3260) return c - 3256 + 768;
    if (c < 3264) return c - 3260 + 1540;
    if (c < 3268) return c - 3264 + 1544;
    return -1;
}
__device__ __forceinline__ void wtrans_job(const float* W, int K, int ldw, bf16_t* Wt, int Npad, bool mapped, float* tile) {
    const int tid = tid_();
    const int tn = Npad / 64, tk = K / 64;
    for (int t = bid_(); t < tn * tk; t += nblk_()) {
        const int n0 = (t / tk) * 64, k0 = (t % tk) * 64;
        __syncthreads();
        for (int idx = tid; idx < 4096; idx += 512) {
            const int kk = idx >> 6, nn = idx & 63;
            const int col = mapped ? pcol_to_orig(n0 + nn) : (n0 + nn);
            tile[kk * 65 + nn] = col >= 0 ? W[(size_t)(k0 + kk) * ldw + col] : 0.f;
        }
        __syncthreads();
        for (int idx = tid; idx < 4096; idx += 512) {
            const int nn = idx >> 6, kk = idx & 63;
            Wt[(size_t)(n0 + nn) * K + k0 + kk] = f2bf(tile[kk * 65 + nn]);
        }
    }
}
__device__ __forceinline__ void ph_weight_prep(const Ctx& p, float* sm) {
#pragma unroll 1
    for (int j = 0; j < 7 * DEPTH; ++j) {
        const int l = j / 7, w = j % 7;
        const float* W; int K, ldw, Npad; bf16_t* Wt; bool mapped = false;
        if (w == 0) { W = pin_(3) + (size_t)l * DM * 3268; K = DM; ldw = 3268; Npad = LDP; Wt = (bf16_t*)(pws_() + WT_IN) + (size_t)l * LDP * DM; mapped = true; }
        else if (w == 1) { W = pin_(20) + (size_t)l * DM * DM; K = DM; ldw = DM; Npad = DM; Wt = (bf16_t*)(pws_() + WT_OUT) + (size_t)l * DM * DM; }
        else if (w == 2) { W = pin_(23) + (size_t)l * DM * 256; K = DM; ldw = 256; Npad = 256; Wt = (bf16_t*)(pws_() + WT_XQ) + (size_t)l * 256 * DM; }
        else if (w == 3) { W = pin_(24) + (size_t)l * DM * 256; K = DM; ldw = 256; Npad = 256; Wt = (bf16_t*)(pws_() + WT_XK) + (size_t)l * 256 * DM; }
        else if (w == 4) { W = pin_(25) + (size_t)l * DM * 256; K = DM; ldw = 256; Npad = 256; Wt = (bf16_t*)(pws_() + WT_XV) + (size_t)l * 256 * DM; }
        else if (w == 5) { W = pin_(26) + (size_t)l * 256 * DM; K = 256; ldw = DM; Npad = DM; Wt = (bf16_t*)(pws_() + WT_XO) + (size_t)l * DM * 256; }
        else { W = pin_(30) + (size_t)l * DM * DM; K = DM; ldw = DM; Npad = DM; Wt = (bf16_t*)(pws_() + WT_PQ) + (size_t)l * DM * DM; }
        wtrans_job(W, K, ldw, Wt, Npad, mapped, sm);
    }
}

__device__ __forceinline__ void ph_rmsnorm(const float* __restrict__ x, const float* __restrict__ g, bf16_t* __restrict__ out, int rows) {
    const int lane = tid_() & 63;
    for (int r = gwave(); r < rows; r += nwaves()) {
        const float4* xr = (const float4*)(x + (size_t)r * DM);
        float4 v[4]; float ss = 0.f;
#pragma unroll
        for (int i = 0; i < 4; ++i) { v[i] = xr[lane + 64 * i]; ss += v[i].x * v[i].x + v[i].y * v[i].y + v[i].z * v[i].z + v[i].w * v[i].w; }
        ss = wave_sum(ss);
        const float rs = rsqrtf(ss * (1.f / DM) + EPS);
#pragma unroll
        for (int i = 0; i < 4; ++i) {
            const float4 gg = ((const float4*)g)[lane + 64 * i];
            ushort4 o; o.x = f2bf(v[i].x * rs * gg.x); o.y = f2bf(v[i].y * rs * gg.y); o.z = f2bf(v[i].z * rs * gg.z); o.w = f2bf(v[i].w * rs * gg.w);
            *(ushort4*)(out + (size_t)r * DM + (size_t)(lane + 64 * i) * 4) = o;
        }
    }
}

template <int OUTMODE>
__device__ __forceinline__ void ph_sgemm(const bf16_t* __restrict__ A, int lda, const float* __restrict__ B, int ldb, void* Cv, int ldc, const float* R, int ldr,
                         int M, int N, int K, float* smem) {
    float* As = smem;
    float* Bs = smem + 16 * 132;
    const int tid = tid_(), tx = tid & 31, ty = tid >> 5;
    const int ntn = N / 128, ntiles = (M / 128) * ntn;
    for (int tile = bid_(); tile < ntiles; tile += nblk_()) {
        const int tm = tile / ntn, tn = tile % ntn;
        float acc[8][4];
#pragma unroll
        for (int i = 0; i < 8; ++i)
#pragma unroll
            for (int j = 0; j < 4; ++j) acc[i][j] = 0.f;
        const int arow = tid >> 2, akq = (tid & 3) * 4;
        const int bk = tid >> 5, bn = (tid & 31) * 4;
        for (int k0 = 0; k0 < K; k0 += 16) {
            const ushort4 av = *(const ushort4*)(A + (size_t)(tm * 128 + arow) * lda + k0 + akq);
            const float4 bv = *(const float4*)(B + (size_t)(k0 + bk) * ldb + tn * 128 + bn);
            __syncthreads();
            As[(akq + 0) * 132 + arow] = bf2f(av.x); As[(akq + 1) * 132 + arow] = bf2f(av.y);
            As[(akq + 2) * 132 + arow] = bf2f(av.z); As[(akq + 3) * 132 + arow] = bf2f(av.w);
            *(float4*)(Bs + bk * 132 + bn) = bv;
            __syncthreads();
#pragma unroll
            for (int k = 0; k < 16; ++k) {
                const float4 a0 = *(const float4*)(As + k * 132 + ty * 8), a1 = *(const float4*)(As + k * 132 + ty * 8 + 4);
                const float4 b = *(const float4*)(Bs + k * 132 + tx * 4);
                const float a[8] = {a0.x, a0.y, a0.z, a0.w, a1.x, a1.y, a1.z, a1.w};
#pragma unroll
                for (int i = 0; i < 8; ++i) { acc[i][0] += a[i] * b.x; acc[i][1] += a[i] * b.y; acc[i][2] += a[i] * b.z; acc[i][3] += a[i] * b.w; }
            }
        }
#pragma unroll
        for (int i = 0; i < 8; ++i) {
            const size_t row = (size_t)tm * 128 + ty * 8 + i; const int col = tn * 128 + tx * 4;
            if (OUTMODE == 0) {
                ushort4 o; o.x = f2bf(acc[i][0]); o.y = f2bf(acc[i][1]); o.z = f2bf(acc[i][2]); o.w = f2bf(acc[i][3]);
                *(ushort4*)((bf16_t*)Cv + row * ldc + col) = o;
            } else if (OUTMODE == 1) {
                *(float4*)((float*)Cv + row * ldc + col) = make_float4(acc[i][0], acc[i][1], acc[i][2], acc[i][3]);
            } else {
                const float4 r = *(const float4*)(R + row * ldr + col);
                *(float4*)((float*)Cv + row * ldc + col) = make_float4(r.x + acc[i][0], r.y + acc[i][1], r.z + acc[i][2], r.w + acc[i][3]);
            }
        }
    }
}

#define WS_HS WS_H
#define WS_VG WS_YPRE
#define WS_DEC (WS_YPRE + (size_t)MTOK * 256 * 2)

__device__ __forceinline__ float quad_sum(float v) {
    v += __int_as_float(__builtin_amdgcn_mov_dpp(__float_as_int(v), 0xB1, 0xF, 0xF, true));
    v += __int_as_float(__builtin_amdgcn_mov_dpp(__float_as_int(v), 0x4E, 0xF, 0xF, true));
    return v;
}
__device__ __forceinline__ float bflo(unsigned w) { return __uint_as_float(w << 16); }
__device__ __forceinline__ float bfhi(unsigned w) { return __uint_as_float(w & 0xffff0000u); }

__device__ __forceinline__ float oct_sum(float v) {
    v += __int_as_float(__builtin_amdgcn_mov_dpp(__float_as_int(v), 0xB1, 0xF, 0xF, true));
    v += __int_as_float(__builtin_amdgcn_mov_dpp(__float_as_int(v), 0x4E, 0xF, 0xF, true));
    v += __int_as_float(__builtin_amdgcn_mov_dpp(__float_as_int(v), 0x141, 0xF, 0xF, true));
    return v;
}
__device__ __forceinline__ void unpack8(const uint4 r, float (&o)[8]) {
    o[0] = bflo(r.x); o[1] = bfhi(r.x); o[2] = bflo(r.y); o[3] = bfhi(r.y); o[4] = bflo(r.z); o[5] = bfhi(r.z); o[6] = bflo(r.w); o[7] = bfhi(r.w);
}
__device__ __forceinline__ uint4 pack8(const float (&v)[8]) {
    uint4 o; o.x = pk_bf16(v[0], v[1]); o.y = pk_bf16(v[2], v[3]); o.z = pk_bf16(v[4], v[5]); o.w = pk_bf16(v[6], v[7]); return o;
}
__device__ __forceinline__ void load8f(const float* p, float (&o)[8]) {
    const float4 a = *(const float4*)p, b = *(const float4*)(p + 4);
    o[0] = a.x; o[1] = a.y; o[2] = a.z; o[3] = a.w; o[4] = b.x; o[5] = b.y; o[6] = b.z; o[7] = b.w;
}
__device__ __forceinline__ void conv8(const bf16_t* P, size_t tok, int t, int pcol, const float* w, int ldw, int cc, float (&acc)[8]) {
#pragma unroll
    for (int j = 0; j < 4; ++j) {
        if (t - 3 + j >= 0) {
            float xv[8], wv[8];
            unpack8(*(const uint4*)(P + (tok - (size_t)(3 - j)) * LDP + pcol), xv);
            load8f(w + j * ldw + cc, wv);
#pragma unroll
            for (int i = 0; i < 8; ++i) acc[i] = __builtin_fmaf(wv[i], xv[i], acc[i]);
        }
    }
}
__device__ __forceinline__ void conv8r(const uint4 (&xt)[4], int t, const float* w, int ldw, int cc, float (&acc)[8]) {
#pragma unroll
    for (int j = 0; j < 4; ++j) {
        float xv[8], wv[8];
        unpack8(xt[j], xv);
        load8f(w + j * ldw + cc, wv);
        const float m = (t - 3 + j >= 0) ? 1.f : 0.f;
#pragma unroll
        for (int i = 0; i < 8; ++i) acc[i] = __builtin_fmaf(wv[i] * m, xv[i], acc[i]);
    }
}
__device__ __forceinline__ void ph_scan_prep(const Ctx& p, int l) {
    const bf16_t* P = (const bf16_t*)(pws_() + WS_P);
    bf16_t* HS = (bf16_t*)(pws_() + WS_HS);
    bf16_t* VG = (bf16_t*)(pws_() + WS_VG);
    float* DEC = (float*)(pws_() + WS_DEC);
    float* SC = (float*)(pws_() + WS_SC);
    const float* scw = pin_(4) + (size_t)l * 4 * 512;
    const float* scb = pin_(5) + (size_t)l * 512;
    const float* gcw = pin_(10) + (size_t)l * 4 * 768;
    const float* wg = pin_(14) + (size_t)l * 16 * 128;
    const float* bg = pin_(15) + (size_t)l * 128;
    const int lane = tid_() & 63;
    const int hsc = lane & 3, wsc = (lane >> 2) & 3;
    const float k_dtb = pin_(6)[l * 4 + hsc], k_alog = __expf(pin_(7)[l * 4 + hsc]), k_galog = __expf(pin_(11)[l * 4 + hsc]), k_gdtb = pin_(12)[l * 4 + hsc];
    const int sccol = wsc < 2 ? PC_DT + hsc : (wsc == 2 ? PC_GA + hsc : PC_GB + hsc);
    for (int tok = gwave(); tok < MTOK; tok += nwaves()) {
        const int t = tok % SEQ;
        const size_t row = (size_t)tok * LDP;
        uint4 xa[4], xq[4], xv4[4];
#pragma unroll
        for (int j = 0; j < 4; ++j) {
            const size_t rj = (t - 3 + j >= 0) ? row - (size_t)(3 - j) * LDP : row;
            xa[j] = *(const uint4*)(P + rj + PC_XBC + 8 * lane);
            xq[j] = *(const uint4*)(P + rj + PC_GQKV + 8 * lane);
            xv4[j] = *(const uint4*)(P + rj + PC_GQKV + 512 + 8 * (lane & 31));
        }
        const uint4 gl0 = *(const uint4*)(P + row + PC_GLR), gl1 = *(const uint4*)(P + row + PC_GLR + 8);
        const float scraw = bf2f(P[row + sccol]);
        {
            float acc[8];
            load8f(scb + 8 * lane, acc);
            conv8r(xa, t, scw, 512, 8 * lane, acc);
#pragma unroll
            for (int i = 0; i < 8; ++i) acc[i] = silu_f(acc[i]);
            *(uint4*)(HS + (size_t)tok * 1024 + 8 * lane) = pack8(acc);
        }
        {
            float acc[8];
#pragma unroll
            for (int i = 0; i < 8; ++i) acc[i] = 0.f;
            conv8r(xq, t, gcw, 768, 8 * lane, acc);
            float ss = 0.f;
#pragma unroll
            for (int i = 0; i < 8; ++i) { acc[i] = silu_f(acc[i]); ss += acc[i] * acc[i]; }
            ss = oct_sum(ss);
            const float sc = rsqrtf(ss + EPS) * (lane < 32 ? 0.125f : 1.f);
#pragma unroll
            for (int i = 0; i < 8; ++i) acc[i] *= sc;
            *(uint4*)(HS + (size_t)tok * 1024 + 512 + 8 * lane) = pack8(acc);
        }
        {
            float acc[8];
#pragma unroll
            for (int i = 0; i < 8; ++i) acc[i] = 0.f;
            conv8r(xv4, t, gcw, 768, 512 + 8 * (lane & 31), acc);
#pragma unroll
            for (int i = 0; i < 8; ++i) acc[i] = silu_f(acc[i]);
            if (lane < 32) *(uint4*)(VG + (size_t)tok * 256 + 8 * lane) = pack8(acc);
        }
        {
            float v;
            if (wsc < 2) { const float dt = softplus_f(scraw + k_dtb); v = wsc == 0 ? dt : __expf(-dt * k_alog); }
            else if (wsc == 2) v = __expf(-k_galog * softplus_f(scraw + k_gdtb));
            else v = sigmoid_f(scraw);
            if (lane < 16) SC[(size_t)tok * 16 + lane] = v;
        }
        {
            float gl[16];
            { float a8[8], b8[8]; unpack8(gl0, a8); unpack8(gl1, b8);
#pragma unroll
              for (int i = 0; i < 8; ++i) { gl[i] = a8[i]; gl[8 + i] = b8[i]; } }
#pragma unroll
            for (int i = 0; i < 2; ++i) {
                const int c = lane + 64 * i;
                float acc = bg[c];
#pragma unroll
                for (int r = 0; r < 16; ++r) acc = __builtin_fmaf(gl[r], wg[r * 128 + c], acc);
                DEC[(size_t)tok * 128 + c] = __expf(logsigmoid_f(acc) * (1.f / 16.f));
            }
        }
    }
}

#define SCAN_LDS_WAVE 4608
typedef float f2_t __attribute__((ext_vector_type(2)));
__device__ __forceinline__ f2_t mk2(float a, float b) { f2_t r; r.x = a; r.y = b; return r; }
__device__ __forceinline__ void st8f(char* dst, const uint4 v) {
    *(float4*)dst = make_float4(bflo(v.x), bfhi(v.x), bflo(v.y), bfhi(v.y));
    *(float4*)(dst + 16) = make_float4(bflo(v.z), bfhi(v.z), bflo(v.w), bfhi(v.w));
}
__device__ __forceinline__ void ph_scans(const Ctx& p, int l, float* smem) {
    const bf16_t* P = (const bf16_t*)(pws_() + WS_P);
    const bf16_t* HS = (const bf16_t*)(pws_() + WS_HS);
    const bf16_t* VG = (const bf16_t*)(pws_() + WS_VG);
    const float* DEC = (const float*)(pws_() + WS_DEC);
    const float* SC = (const float*)(pws_() + WS_SC);
    bf16_t* Y = (bf16_t*)(pws_() + WS_Y);
    const int tid = tid_(), lane = tid & 63, wave = tid >> 6;
    if (nblk_() != 256) return;
    const int role = wave < 2 ? 0 : (wave < 6 ? 1 : 2);
    const int idx = (role == 0 ? wave : (role == 1 ? wave - 2 : wave - 6)) * 256 + bid_();
    const int bh = role == 1 ? (idx >> 3) : (idx >> 2), b = bh >> 2, h = bh & 3;
    const int colbase = role == 1 ? (idx & 7) * 8 : (idx & 3) * 16;
    const int cl = role == 1 ? (lane >> 3) : (lane >> 2);
    const int col = colbase + cl;
    const int sq = role == 1 ? (lane & 7) : (lane & 3);
    const size_t tb = (size_t)b * SEQ;
    bf16_t* dummy = (bf16_t*)(pws_() + WS_DUMMY) + (tid & 511) * 8;
    char* lw = (char*)smem + wave * SCAN_LDS_WAVE;
    char* lrow = lw;
    char* lcol = lw + 4096;
    float* lsc = (float*)(lw + 4352);
    const int fs = lane >> 3, fp = lane & 7;
    if (role == 0) {
        const int g = h >> 1;
        const float Dh = pin_(8)[l * 4 + h];
        uint4 f0, f1; unsigned fc = 0u; float fsc = 0.f;
        f2_t st[8];
#pragma unroll
        for (int i = 0; i < 8; ++i) st[i] = mk2(0.f, 0.f);
        auto fetch = [&](int t0) {
            const size_t tok = tb + t0 + fs;
            const bf16_t* src = HS + tok * 1024 + (fp < 4 ? 256 + g * 64 + fp * 16 : 384 + g * 64 + (fp - 4) * 16);
            f0 = *(const uint4*)src; f1 = *(const uint4*)(src + 8);
            fc = *(const unsigned*)(HS + tok * 1024 + h * 64 + colbase + fp * 2);
            if (lane < 16) fsc = SC[(tb + t0 + (lane >> 1)) * 16 + (lane & 1) * 4 + h];
        };
        fetch(0);
        for (int t0 = 0; t0 < SEQ; t0 += 8) {
            st8f(lrow + fs * 512 + fp * 64, f0); st8f(lrow + fs * 512 + fp * 64 + 32, f1);
            *(unsigned*)(lcol + fs * 32 + fp * 4) = fc;
            if (lane < 16) lsc[lane] = fsc;
            if (t0 + 8 < SEQ) fetch(t0 + 8);
#pragma unroll
            for (int i = 0; i < 8; ++i) {
                const char* rb = lrow + i * 512 + sq * 64;
                const float4 b0 = *(const float4*)rb, b1 = *(const float4*)(rb + 16), b2 = *(const float4*)(rb + 32), b3 = *(const float4*)(rb + 48);
                const float4 c0 = *(const float4*)(rb + 256), c1 = *(const float4*)(rb + 272), c2 = *(const float4*)(rb + 288), c3 = *(const float4*)(rb + 304);
                const float xv = bf2f(*(const bf16_t*)(lcol + i * 32 + cl * 2));
                const float2 sc2 = *(const float2*)(lsc + i * 2);
                const float xdt = xv * sc2.x;
                const f2_t xd2 = mk2(xdt, xdt), dA2 = mk2(sc2.y, sc2.y);
                const f2_t bb[8] = {mk2(b0.x, b0.y), mk2(b0.z, b0.w), mk2(b1.x, b1.y), mk2(b1.z, b1.w), mk2(b2.x, b2.y), mk2(b2.z, b2.w), mk2(b3.x, b3.y), mk2(b3.z, b3.w)};
                const f2_t cc[8] = {mk2(c0.x, c0.y), mk2(c0.z, c0.w), mk2(c1.x, c1.y), mk2(c1.z, c1.w), mk2(c2.x, c2.y), mk2(c2.z, c2.w), mk2(c3.x, c3.y), mk2(c3.z, c3.w)};
                f2_t ya = mk2(0.f, 0.f), yb = mk2(0.f, 0.f);
#pragma unroll
                for (int q = 0; q < 8; q += 2) {
                    st[q] = st[q] * dA2 + xd2 * bb[q]; st[q + 1] = st[q + 1] * dA2 + xd2 * bb[q + 1];
                    ya = cc[q] * st[q] + ya; yb = cc[q + 1] * st[q + 1] + yb;
                }
                const f2_t ys = ya + yb;
                const float y = quad_sum(ys.x + ys.y);
                *(sq == 0 ? Y + (tb + t0 + i) * DM + h * 64 + col : dummy + i) = f2bf(y + Dh * xv);
                if (i & 1) __builtin_amdgcn_sched_barrier(0);
            }
        }
    } else if (role == 1) {
        uint4 f0, f1; unsigned fc = 0u; float fsc = 0.f;
        f2_t S[4];
#pragma unroll
        for (int i = 0; i < 4; ++i) S[i] = mk2(0.f, 0.f);
        auto fetch = [&](int t0) {
            const size_t tok = tb + t0 + fs;
            const bf16_t* src = HS + tok * 1024 + (fp < 4 ? 512 + h * 64 + fp * 16 : 768 + h * 64 + (fp - 4) * 16);
            f0 = *(const uint4*)src; f1 = *(const uint4*)(src + 8);
            if (fp < 4) fc = *(const unsigned*)(VG + tok * 256 + h * 64 + colbase + fp * 2);
            if (lane < 16) fsc = SC[(tb + t0 + (lane >> 1)) * 16 + 8 + (lane & 1) * 4 + h];
        };
        fetch(0);
        for (int t0 = 0; t0 < SEQ; t0 += 8) {
            st8f(lrow + fs * 512 + fp * 64, f0); st8f(lrow + fs * 512 + fp * 64 + 32, f1);
            if (fp < 4) *(unsigned*)(lcol + fs * 32 + fp * 4) = fc;
            if (lane < 16) lsc[lane] = fsc;
            if (t0 + 8 < SEQ) fetch(t0 + 8);
#pragma unroll
            for (int i = 0; i < 8; ++i) {
                const char* rb = lrow + i * 512 + sq * 32;
                const float4 q0 = *(const float4*)rb, q1 = *(const float4*)(rb + 16);
                const float4 k0 = *(const float4*)(rb + 256), k1 = *(const float4*)(rb + 272);
                const float vv = bf2f(*(const bf16_t*)(lcol + i * 32 + cl * 2));
                const float2 sc2 = *(const float2*)(lsc + i * 2);
                const f2_t al2 = mk2(sc2.x, sc2.x);
                const f2_t kk[4] = {mk2(k0.x, k0.y), mk2(k0.z, k0.w), mk2(k1.x, k1.y), mk2(k1.z, k1.w)};
                const f2_t qq[4] = {mk2(q0.x, q0.y), mk2(q0.z, q0.w), mk2(q1.x, q1.y), mk2(q1.z, q1.w)};
                f2_t ra = mk2(0.f, 0.f), rb2 = mk2(0.f, 0.f);
#pragma unroll
                for (int q = 0; q < 4; q += 2) {
                    S[q] = S[q] * al2; S[q + 1] = S[q + 1] * al2;
                    ra = S[q] * kk[q] + ra; rb2 = S[q + 1] * kk[q + 1] + rb2;
                }
                const f2_t rs = ra + rb2;
                const float r = oct_sum(rs.x + rs.y);
                const float vn = sc2.y * (vv - r);
                const f2_t vn2 = mk2(vn, vn);
                f2_t oa2 = mk2(0.f, 0.f), ob2 = mk2(0.f, 0.f);
#pragma unroll
                for (int q = 0; q < 4; q += 2) {
                    S[q] = kk[q] * vn2 + S[q]; S[q + 1] = kk[q + 1] * vn2 + S[q + 1];
                    oa2 = S[q] * qq[q] + oa2; ob2 = S[q + 1] * qq[q + 1] + ob2;
                }
                const f2_t os = oa2 + ob2;
                const float ov = oct_sum(os.x + os.y);
                *(sq == 0 ? Y + (tb + t0 + i) * DM + 256 + h * 64 + col : dummy + i) = f2bf(ov);
                if (i & 1) __builtin_amdgcn_sched_barrier(0);
            }
        }
    } else {
        uint4 f0, f1; unsigned fc = 0u;
        f2_t S[4];
#pragma unroll
        for (int i = 0; i < 4; ++i) S[i] = mk2(0.f, 0.f);
        auto fetch = [&](int t0) {
            const size_t tok = tb + t0 + fs;
            if (fp < 4) { const float* src = DEC + tok * 128 + h * 32 + fp * 8; f0 = *(const uint4*)src; f1 = *(const uint4*)(src + 4); }
            else { const bf16_t* src = P + tok * LDP + (fp < 6 ? PC_LK + h * 32 + (fp - 4) * 16 : PC_LQ + h * 32 + (fp - 6) * 16); f0 = *(const uint4*)src; f1 = *(const uint4*)(src + 8); }
            fc = *(const unsigned*)(P + tok * LDP + PC_LV + h * 64 + colbase + fp * 2);
        };
        fetch(0);
        for (int t0 = 0; t0 < SEQ; t0 += 8) {
            if (fp < 4) { *(uint4*)(lrow + fs * 512 + fp * 32) = f0; *(uint4*)(lrow + fs * 512 + fp * 32 + 16) = f1; }
            else { st8f(lrow + fs * 512 + 128 + (fp - 4) * 64, f0); st8f(lrow + fs * 512 + 128 + (fp - 4) * 64 + 32, f1); }
            *(unsigned*)(lcol + fs * 32 + fp * 4) = fc;
            if (t0 + 8 < SEQ) fetch(t0 + 8);
#pragma unroll
            for (int i = 0; i < 8; ++i) {
                const char* rb = lrow + i * 512 + sq * 32;
                const float4 d0 = *(const float4*)rb, d1 = *(const float4*)(rb + 16);
                const float4 k0 = *(const float4*)(rb + 128), k1 = *(const float4*)(rb + 144);
                const float4 q0 = *(const float4*)(rb + 256), q1 = *(const float4*)(rb + 272);
                const float vv = bf2f(*(const bf16_t*)(lcol + i * 32 + cl * 2));
                const f2_t v2 = mk2(vv, vv);
                const f2_t dd[4] = {mk2(d0.x, d0.y), mk2(d0.z, d0.w), mk2(d1.x, d1.y), mk2(d1.z, d1.w)};
                const f2_t kk[4] = {mk2(k0.x, k0.y), mk2(k0.z, k0.w), mk2(k1.x, k1.y), mk2(k1.z, k1.w)};
                const f2_t qq[4] = {mk2(q0.x, q0.y), mk2(q0.z, q0.w), mk2(q1.x, q1.y), mk2(q1.z, q1.w)};
                f2_t oa2 = mk2(0.f, 0.f), ob2 = mk2(0.f, 0.f);
#pragma unroll
                for (int q = 0; q < 4; q += 2) {
                    S[q] = dd[q] * S[q] + kk[q] * v2; S[q + 1] = dd[q + 1] * S[q + 1] + kk[q + 1] * v2;
                    oa2 = S[q] * qq[q] + oa2; ob2 = S[q + 1] * qq[q + 1] + ob2;
                }
                const f2_t os = oa2 + ob2;
                const float ov = quad_sum(os.x + os.y);
                *(sq == 0 ? Y + (tb + t0 + i) * DM + 512 + h * 64 + col : dummy + i) = f2bf(ov * 0.17677669529663687f);
                if (i & 1) __builtin_amdgcn_sched_barrier(0);
            }
        }
    }
}

__device__ __forceinline__ void ph_mixer_finish(const Ctx& p, int l) {
    const bf16_t* P = (const bf16_t*)(pws_() + WS_P);
    bf16_t* Y = (bf16_t*)(pws_() + WS_Y);
    const float* sn = pin_(9) + (size_t)l * 256;
    const float* gn = pin_(13) + (size_t)l * 64;
    const float* ln = pin_(16) + (size_t)l * 64;
    const int lane = tid_() & 63;
    for (int tok = gwave(); tok < MTOK; tok += nwaves()) {
        const size_t row = (size_t)tok * LDP;
        {
            float v[8], gt[8], gw[8];
            unpack8(*(const uint4*)(Y + (size_t)tok * DM + 8 * lane), v);
            unpack8(*(const uint4*)(P + row + (lane < 32 ? PC_Z + 8 * lane : PC_GG + 8 * (lane - 32))), gt);
            load8f(lane < 32 ? sn + 8 * lane : gn + 8 * (lane & 7), gw);
            float ss = 0.f;
            if (lane < 32) {
#pragma unroll
                for (int i = 0; i < 8; ++i) { v[i] *= silu_f(gt[i]); ss += v[i] * v[i]; }
            } else {
#pragma unroll
                for (int i = 0; i < 8; ++i) ss += v[i] * v[i];
            }
            const float s8 = oct_sum(ss);
            float s32 = s8 + __int_as_float(__builtin_amdgcn_mov_dpp(__float_as_int(s8), 0x140, 0xF, 0xF, true));
            s32 += __shfl_xor(s32, 16, 64);
            const float rs = lane < 32 ? rsqrtf(s32 * (1.f / 256.f) + EPS) : rsqrtf(s8 * (1.f / 64.f) + EPS);
            float o[8];
#pragma unroll
            for (int i = 0; i < 8; ++i) o[i] = lane < 32 ? v[i] * rs * gw[i] : v[i] * rs * gw[i] * silu_f(gt[i]);
            *(uint4*)(Y + (size_t)tok * DM + 8 * lane) = pack8(o);
        }
        if (lane < 32) {
            float v[8], gt[8], gw[8];
            unpack8(*(const uint4*)(Y + (size_t)tok * DM + 512 + 8 * lane), v);
            unpack8(*(const uint4*)(P + row + PC_LR + 8 * lane), gt);
            load8f(ln + 8 * (lane & 7), gw);
            float ss = 0.f;
#pragma unroll
            for (int i = 0; i < 8; ++i) ss += v[i] * v[i];
            const float rs = rsqrtf(oct_sum(ss) * (1.f / 64.f) + EPS);
            float o[8];
#pragma unroll
            for (int i = 0; i < 8; ++i) o[i] = v[i] * rs * gw[i] * silu_f(gt[i]);
            *(uint4*)(Y + (size_t)tok * DM + 512 + 8 * lane) = pack8(o);
        }
    }
}

typedef short bf16x8_t __attribute__((ext_vector_type(8)));
typedef float f32x4_t __attribute__((ext_vector_type(4)));
union BF8 { bf16x8_t v; uint4 u; unsigned w[4]; };


__device__ __forceinline__ void ph_dsa_prep(const Ctx& p, int l) {
    const bf16_t* P = (const bf16_t*)(pws_() + WS_P);
    bf16_t* qn = (bf16_t*)(pws_() + WS_QN);
    bf16_t* kn = (bf16_t*)(pws_() + WS_KN);
    bf16_t* ikn = (bf16_t*)(pws_() + WS_IKN);
    bf16_t* vt = (bf16_t*)(pws_() + WS_VT);
    const float* qg = pin_(17) + (size_t)l * 64;
    const float* kg = pin_(18) + (size_t)l * 64;
    const float* ig = pin_(19) + (size_t)l * 32;
    const int lane = tid_() & 63;
    const int pcol = lane < 40 ? PC_DQ + 8 * lane : PC_IK + 8 * (lane & 3);
    float gw[8];
    load8f(lane < 32 ? qg + 8 * (lane & 7) : (lane < 40 ? kg + 8 * (lane & 7) : ig + 8 * (lane & 3)), gw);
    for (int grp = gwave(); grp < MTOK / 8; grp += nwaves()) {
        const size_t tok0 = (size_t)grp * 8;
        const int b = (int)(tok0 / SEQ), t0 = (int)(tok0 % SEQ);
        unsigned short vv[8];
#pragma unroll
        for (int i = 0; i < 8; ++i) {
            const size_t row = (tok0 + i) * LDP;
            vv[i] = P[row + PC_DV + lane];
            if (lane < 44) {
                float v[8];
                unpack8(*(const uint4*)(P + row + pcol), v);
                float ss = 0.f;
#pragma unroll
                for (int q = 0; q < 8; ++q) ss += v[q] * v[q];
                const float s4 = ss + __int_as_float(__builtin_amdgcn_mov_dpp(__float_as_int(ss), 0xB1, 0xF, 0xF, true));
                const float s4b = s4 + __int_as_float(__builtin_amdgcn_mov_dpp(__float_as_int(s4), 0x4E, 0xF, 0xF, true));
                const float s8 = s4b + __int_as_float(__builtin_amdgcn_mov_dpp(__float_as_int(s4b), 0x141, 0xF, 0xF, true));
                const float rs = lane < 40 ? rsqrtf(s8 * (1.f / 64.f) + EPS) * (lane < 32 ? 0.125f : 1.f) : rsqrtf(s4b * (1.f / 32.f) + EPS);
                float o[8];
#pragma unroll
                for (int q = 0; q < 8; ++q) o[q] = v[q] * rs * gw[q];
                const uint4 pk = pack8(o);
                if (lane < 32) *(uint4*)(qn + (tok0 + i) * 256 + 8 * lane) = pk;
                else if (lane < 40) *(uint4*)(kn + (tok0 + i) * 64 + 8 * (lane - 32)) = pk;
                else *(uint4*)(ikn + (tok0 + i) * 32 + 8 * (lane - 40)) = pk;
            }
        }
        uint4 o; o.x = (unsigned)vv[0] | ((unsigned)vv[1] << 16); o.y = (unsigned)vv[2] | ((unsigned)vv[3] << 16);
        o.z = (unsigned)vv[4] | ((unsigned)vv[5] << 16); o.w = (unsigned)vv[6] | ((unsigned)vv[7] << 16);
        *(uint4*)(vt + ((size_t)b * 64 + lane) * SEQ + t0) = o;
    }
}

#define DSA_STRIDE 2052
__device__ __forceinline__ void ph_dsa_main(const Ctx& p, int l, float* smem) {
    const bf16_t* P = (const bf16_t*)(pws_() + WS_P);
    bf16_t* Y = (bf16_t*)(pws_() + WS_Y);
    const bf16_t* QN = (const bf16_t*)(pws_() + WS_QN);
    const bf16_t* KN = (const bf16_t*)(pws_() + WS_KN);
    const bf16_t* IKN = (const bf16_t*)(pws_() + WS_IKN);
    const bf16_t* VT = (const bf16_t*)(pws_() + WS_VT);
    unsigned* sc = (unsigned*)smem;
    float* part = smem;
    float* plsum = smem + 8 * 64 * 64;
    unsigned* thr = (unsigned*)(smem + 35000);
    const int tid = tid_(), lane = tid & 63, w = tid >> 6, qi = lane & 15, g = lane >> 4;
    for (int task = bid_(); task < MTOK / 16; task += nblk_()) {
        const int c = 31 - task / 128, b = (task >> 2) & 31, sub = task & 3;
        const int t0 = c * 64 + sub * 16, nk = (c + 1) * 64;
        const size_t tok0 = (size_t)b * SEQ + t0;
        const bool dosel = nk > 256;
        if (dosel) {
            BF8 iqf[8]; float wq[8];
#pragma unroll
            for (int h = 0; h < 8; ++h) {
                iqf[h].u = *(const uint4*)(P + (tok0 + qi) * LDP + PC_IQ + h * 32 + 8 * g);
                wq[h] = bf2f(P[(tok0 + qi) * LDP + PC_IW + h]) * 0.0625f;
            }
            for (int kt = w; kt < nk / 16; kt += 8) {
                const int s0 = kt * 16;
                BF8 ka; ka.u = *(const uint4*)(IKN + ((size_t)b * SEQ + s0 + qi) * 32 + 8 * g);
                float acc[4] = {0.f, 0.f, 0.f, 0.f};
#pragma unroll
                for (int h = 0; h < 8; ++h) {
                    const f32x4_t d = __builtin_amdgcn_mfma_f32_16x16x32_bf16(ka.v, iqf[h].v, (f32x4_t){0.f, 0.f, 0.f, 0.f}, 0, 0, 0);
#pragma unroll
                    for (int r = 0; r < 4; ++r) acc[r] = __builtin_fmaf(wq[h], fmaxf(d[r], 0.f), acc[r]);
                }
                uint4 kv; kv.x = ford(acc[0]); kv.y = ford(acc[1]); kv.z = ford(acc[2]); kv.w = ford(acc[3]);
                *(uint4*)(sc + qi * DSA_STRIDE + s0 + 4 * g) = kv;
            }
        }
        __syncthreads();
        if (dosel) {
            const int nj = nk >> 6;
#pragma unroll 1
            for (int qq = 0; qq < 2; ++qq) {
                const int q = 2 * w + qq;
                unsigned kreg[32];
#pragma unroll
                for (int j = 0; j < 32; ++j) kreg[j] = (j < nj) ? sc[q * DSA_STRIDE + j * 64 + lane] : 0u;
                unsigned T = 0u; bool exact = false;
                for (int bit = 31; bit >= 0; --bit) {
                    const unsigned cand = T | (1u << bit);
                    int cnt = 0;
#pragma unroll
                    for (int j = 0; j < 32; ++j) cnt += __popcll(__ballot(kreg[j] >= cand));
                    if (cnt >= 256) { T = cand; if (cnt == 256) { exact = true; break; } }
                }
                int cut = 0x7fffffff;
                if (!exact) {
                    int cgt = 0, ceq = 0;
#pragma unroll
                    for (int j = 0; j < 32; ++j) { cgt += __popcll(__ballot(kreg[j] > T)); ceq += __popcll(__ballot(kreg[j] == T)); }
                    int need = 256 - cgt;
                    if (ceq > need) {
                        bool found = false;
#pragma unroll
                        for (int j = 0; j < 32; ++j) {
                            const unsigned long long m = __ballot(kreg[j] == T);
                            const int cj = __popcll(m);
                            if (!found) {
                                if (need <= cj) { for (int bpos = 0; bpos < 64; ++bpos) if ((m >> bpos) & 1ull) { if (--need == 0) { cut = j * 64 + bpos; break; } } found = true; }
                                else need -= cj;
                            }
                        }
                    }
                }
                if (lane == 0) { thr[q] = T; thr[16 + q] = (unsigned)cut; }
            }
        }
        __syncthreads();
        unsigned Tq = 0u; int cutq = 0x7fffffff;
        if (dosel) { Tq = thr[qi]; cutq = (int)thr[16 + qi]; }
        f32x4_t oacc[4][4]; float lsum[4];
#pragma unroll
        for (int h = 0; h < 4; ++h) { lsum[h] = 0.f;
#pragma unroll
            for (int dt = 0; dt < 4; ++dt) oacc[h][dt] = (f32x4_t){0.f, 0.f, 0.f, 0.f}; }
        const int krow = 8 * (qi >> 2) + (qi & 3);
        for (int st = w; st < nk / 32; st += 8) {
            const int s0 = st * 32;
            BF8 ka[2][2], va[4];
#pragma unroll
            for (int t = 0; t < 2; ++t)
#pragma unroll
                for (int s2 = 0; s2 < 2; ++s2) ka[t][s2].u = *(const uint4*)(KN + ((size_t)b * SEQ + s0 + krow + 4 * t) * 64 + 32 * s2 + 8 * g);
#pragma unroll
            for (int dt = 0; dt < 4; ++dt) va[dt].u = *(const uint4*)(VT + ((size_t)b * 64 + 16 * dt + qi) * SEQ + s0 + 8 * g);
            float mk[8];
            if (dosel) {
                const uint4 k0 = *(const uint4*)(sc + qi * DSA_STRIDE + s0 + 8 * g), k1 = *(const uint4*)(sc + qi * DSA_STRIDE + s0 + 8 * g + 4);
                const unsigned kk[8] = {k0.x, k0.y, k0.z, k0.w, k1.x, k1.y, k1.z, k1.w};
#pragma unroll
                for (int j = 0; j < 8; ++j) mk[j] = (kk[j] > Tq || (kk[j] == Tq && (s0 + 8 * g + j) <= cutq)) ? 1.f : 0.f;
            } else {
#pragma unroll
                for (int j = 0; j < 8; ++j) mk[j] = 1.f;
            }
#pragma unroll
            for (int h = 0; h < 4; ++h) {
                BF8 q0, q1;
                q0.u = *(const uint4*)(QN + (tok0 + qi) * 256 + h * 64 + 8 * g);
                q1.u = *(const uint4*)(QN + (tok0 + qi) * 256 + h * 64 + 32 + 8 * g);
                f32x4_t sacc[2];
#pragma unroll
                for (int t = 0; t < 2; ++t) {
                    sacc[t] = __builtin_amdgcn_mfma_f32_16x16x32_bf16(ka[t][0].v, q0.v, (f32x4_t){0.f, 0.f, 0.f, 0.f}, 0, 0, 0);
                    sacc[t] = __builtin_amdgcn_mfma_f32_16x16x32_bf16(ka[t][1].v, q1.v, sacc[t], 0, 0, 0);
                }
                float pe[8];
#pragma unroll
                for (int t = 0; t < 2; ++t)
#pragma unroll
                    for (int r = 0; r < 4; ++r) { pe[4 * t + r] = __expf(sacc[t][r]) * mk[4 * t + r]; lsum[h] += pe[4 * t + r]; }
                BF8 pf;
#pragma unroll
                for (int j = 0; j < 4; ++j) pf.w[j] = pk_bf16(pe[2 * j], pe[2 * j + 1]);
#pragma unroll
                for (int dt = 0; dt < 4; ++dt) oacc[h][dt] = __builtin_amdgcn_mfma_f32_16x16x32_bf16(va[dt].v, pf.v, oacc[h][dt], 0, 0, 0);
            }
        }
        __syncthreads();
#pragma unroll
        for (int h = 0; h < 4; ++h) {
            plsum[(w * 4 + h) * 64 + lane] = lsum[h];
#pragma unroll
            for (int dt = 0; dt < 4; ++dt)
#pragma unroll
                for (int r = 0; r < 4; ++r) part[(w * 64 + h * 16 + dt * 4 + r) * 64 + lane] = oacc[h][dt][r];
        }
        __syncthreads();
        {
            const int h = w >> 1;
            float lq = 0.f;
#pragma unroll
            for (int w2 = 0; w2 < 8; ++w2)
#pragma unroll
                for (int g2 = 0; g2 < 4; ++g2) lq += plsum[(w2 * 4 + h) * 64 + qi + 16 * g2];
            const float inv = 1.f / lq;
#pragma unroll
            for (int dd = 0; dd < 2; ++dd) {
                const int dt = (w & 1) * 2 + dd;
                float o[4];
#pragma unroll
                for (int r = 0; r < 4; ++r) {
                    float sacc = 0.f;
#pragma unroll
                    for (int w2 = 0; w2 < 8; ++w2) sacc += part[(w2 * 64 + h * 16 + dt * 4 + r) * 64 + lane];
                    o[r] = sacc * inv;
                }
                uint2 ov; ov.x = pk_bf16(o[0], o[1]); ov.y = pk_bf16(o[2], o[3]);
                *(uint2*)(Y + (tok0 + qi) * DM + 768 + h * 64 + 16 * dt + 4 * g) = ov;
            }
        }
        __syncthreads();
    }
}

__device__ __forceinline__ void ph_mem_prep(const Ctx& p, int l) {
    const float* Km = (const float*)(pws_() + WS_KM);
    const float* Vm = (const float*)(pws_() + WS_VM);
    bf16_t* KB = (bf16_t*)(pws_() + WS_KB);
    bf16_t* VTB = (bf16_t*)(pws_() + WS_VTB);
    const float* kg = pin_(28) + (size_t)l * 64;
    const int lane = tid_() & 63;
    for (int r = gwave(); r < MMEM; r += nwaves()) {
        const int b = r / NMEM, j = r % NMEM;
#pragma unroll
        for (int h = 0; h < 4; ++h) {
            const float v = Km[(size_t)r * 256 + h * 64 + lane];
            const float ss = wave_sum(v * v);
            KB[(((size_t)b * 4 + h) * NMEM + j) * 64 + lane] = f2bf(v * rsqrtf(ss * (1.f / 64.f) + EPS) * kg[lane]);
            VTB[(((size_t)b * 4 + h) * 64 + lane) * NMEM + j] = f2bf(Vm[(size_t)r * 256 + h * 64 + lane]);
        }
    }
}
__device__ __forceinline__ void ph_xattn(const Ctx& p, int l) {
    const float* Qx = (const float*)(pws_() + WS_QX);
    bf16_t* Ox = (bf16_t*)(pws_() + WS_OX);
    const bf16_t* KB = (const bf16_t*)(pws_() + WS_KB);
    const bf16_t* VTB = (const bf16_t*)(pws_() + WS_VTB);
    const float* qg = pin_(27) + (size_t)l * 64;
    const int lane = tid_() & 63, qi = lane & 15, g = lane >> 4;
    for (int task = gwave(); task < MTOK / 16; task += nwaves()) {
        const int tok0 = task * 16, b = tok0 / SEQ;
#pragma unroll 1
        for (int h = 0; h < 4; ++h) {
            BF8 qf[2];
            {
                float qv[2][8]; float ss = 0.f;
#pragma unroll
                for (int s2 = 0; s2 < 2; ++s2) {
                    const float4* qp = (const float4*)(Qx + (size_t)(tok0 + qi) * 256 + h * 64 + 32 * s2 + 8 * g);
                    const float4 a = qp[0], c = qp[1];
                    qv[s2][0] = a.x; qv[s2][1] = a.y; qv[s2][2] = a.z; qv[s2][3] = a.w; qv[s2][4] = c.x; qv[s2][5] = c.y; qv[s2][6] = c.z; qv[s2][7] = c.w;
#pragma unroll
                    for (int j = 0; j < 8; ++j) ss += qv[s2][j] * qv[s2][j];
                }
                ss += __shfl_xor(ss, 16, 64); ss += __shfl_xor(ss, 32, 64);
                const float rs = rsqrtf(ss * (1.f / 64.f) + EPS) * 0.125f;
#pragma unroll
                for (int s2 = 0; s2 < 2; ++s2) {
                    const float4 g0 = *(const float4*)(qg + 32 * s2 + 8 * g), g1 = *(const float4*)(qg + 32 * s2 + 8 * g + 4);
                    qf[s2].w[0] = pk_bf16(qv[s2][0] * rs * g0.x, qv[s2][1] * rs * g0.y); qf[s2].w[1] = pk_bf16(qv[s2][2] * rs * g0.z, qv[s2][3] * rs * g0.w);
                    qf[s2].w[2] = pk_bf16(qv[s2][4] * rs * g1.x, qv[s2][5] * rs * g1.y); qf[s2].w[3] = pk_bf16(qv[s2][6] * rs * g1.z, qv[s2][7] * rs * g1.w);
                }
            }
            const bf16_t* Kh = KB + ((size_t)b * 4 + h) * NMEM * 64;
            const bf16_t* Vh = VTB + ((size_t)b * 4 + h) * 64 * NMEM;
            f32x4_t oacc[4];
#pragma unroll
            for (int dt = 0; dt < 4; ++dt) oacc[dt] = (f32x4_t){0.f, 0.f, 0.f, 0.f};
            float lsum = 0.f;
            const int krow = 8 * (qi >> 2) + (qi & 3);
#pragma unroll 2
            for (int s0 = 0; s0 < NMEM; s0 += 32) {
                BF8 ka[2][2], va[4];
#pragma unroll
                for (int t = 0; t < 2; ++t)
#pragma unroll
                    for (int s2 = 0; s2 < 2; ++s2) ka[t][s2].u = *(const uint4*)(Kh + (size_t)(s0 + krow + 4 * t) * 64 + 32 * s2 + 8 * g);
#pragma unroll
                for (int dt = 0; dt < 4; ++dt) va[dt].u = *(const uint4*)(Vh + (size_t)(16 * dt + qi) * NMEM + s0 + 8 * g);
                f32x4_t sacc[2];
#pragma unroll
                for (int t = 0; t < 2; ++t) {
                    sacc[t] = (f32x4_t){0.f, 0.f, 0.f, 0.f};
                    sacc[t] = __builtin_amdgcn_mfma_f32_16x16x32_bf16(ka[t][0].v, qf[0].v, sacc[t], 0, 0, 0);
                    sacc[t] = __builtin_amdgcn_mfma_f32_16x16x32_bf16(ka[t][1].v, qf[1].v, sacc[t], 0, 0, 0);
                }
                float pe[8];
#pragma unroll
                for (int t = 0; t < 2; ++t)
#pragma unroll
                    for (int r = 0; r < 4; ++r) { pe[4 * t + r] = __expf(sacc[t][r]); lsum += pe[4 * t + r]; }
                BF8 pf;
#pragma unroll
                for (int j = 0; j < 4; ++j) pf.w[j] = pk_bf16(pe[2 * j], pe[2 * j + 1]);
#pragma unroll
                for (int dt = 0; dt < 4; ++dt) oacc[dt] = __builtin_amdgcn_mfma_f32_16x16x32_bf16(va[dt].v, pf.v, oacc[dt], 0, 0, 0);
            }
            lsum += __shfl_xor(lsum, 16, 64); lsum += __shfl_xor(lsum, 32, 64);
            const float inv = 1.f / lsum;
#pragma unroll
            for (int dt = 0; dt < 4; ++dt) {
                uint2 o; o.x = pk_bf16(oacc[dt][0] * inv, oacc[dt][1] * inv); o.y = pk_bf16(oacc[dt][2] * inv, oacc[dt][3] * inv);
                *(uint2*)(Ox + (size_t)(tok0 + qi) * 256 + h * 64 + 16 * dt + 4 * g) = o;
            }
        }
    }
}

template <int N> __device__ __forceinline__ void bitonic_sort_desc(unsigned (&a)[N]) {
#pragma unroll
    for (int k = 2; k <= N; k <<= 1)
#pragma unroll
        for (int j = k >> 1; j > 0; j >>= 1)
#pragma unroll
            for (int i = 0; i < N; ++i) {
                const int o = i ^ j;
                if (o > i) {
                    const bool desc = ((i & k) == 0);
                    const unsigned x = a[i], y = a[o];
                    const unsigned mx = x > y ? x : y, mn = x > y ? y : x;
                    a[i] = desc ? mx : mn; a[o] = desc ? mn : mx;
                }
            }
}
__device__ __forceinline__ void bitonic_merge16_desc(unsigned (&a)[16]) {
#pragma unroll
    for (int j = 8; j > 0; j >>= 1)
#pragma unroll
        for (int i = 0; i < 16; ++i) {
            const int o = i ^ j;
            if (o > i) { const unsigned x = a[i], y = a[o]; a[i] = x > y ? x : y; a[o] = x > y ? y : x; }
        }
}
__device__ __forceinline__ void top16_merge(unsigned (&a)[16], const unsigned (&b)[16]) {
#pragma unroll
    for (int i = 0; i < 16; ++i) a[i] = a[i] > b[15 - i] ? a[i] : b[15 - i];
    bitonic_merge16_desc(a);
}
__device__ __forceinline__ void top16_xlane(unsigned (&a)[16], int xm) {
    unsigned b[16];
#pragma unroll
    for (int i = 0; i < 16; ++i) b[i] = (unsigned)__shfl_xor((int)a[i], xm, 64);
    top16_merge(a, b);
}
__device__ __forceinline__ void ph_subkeys_convert(const Ctx& p) {
    const float* sk = pin_(31);
    bf16_t* o = (bf16_t*)(pws_() + WS_SKB);
    const size_t n = (size_t)DEPTH * 8 * 2 * 128 * 64;
    for (size_t i = (size_t)bid_() * 512 + tid_(); i < n; i += (size_t)nblk_() * 512) o[i] = f2bf(sk[i]);
}
__device__ __forceinline__ void ph_peer_topk(const Ctx& p, int l, float* smem) {
    const bf16_t* Qp = (const bf16_t*)(pws_() + WS_QP);
    const bf16_t* SK = (const bf16_t*)(pws_() + WS_SKB) + (size_t)l * 8 * 2 * 128 * 64;
    int* pidx = (int*)(pws_() + WS_PEI);
    float* pgt = (float*)(pws_() + WS_PEG);
    const int tid = tid_(), lane = tid & 63, wave = tid >> 6, qi = lane & 15, g = lane >> 4;
    int* tabw = (int*)smem + wave * 512 + qi * 32;
    for (int task = gwave(); task < MTOK / 16; task += nwaves()) {
        const size_t tok = (size_t)task * 16 + qi;
#pragma unroll 1
        for (int h = 0; h < 8; ++h) {
            unsigned L[2][16];
#pragma unroll
            for (int pp = 0; pp < 2; ++pp) {
                BF8 qf[2];
#pragma unroll
                for (int s2 = 0; s2 < 2; ++s2) qf[s2].u = *(const uint4*)(Qp + tok * DM + h * 128 + pp * 64 + 32 * s2 + 8 * g);
                const bf16_t* skp = SK + (size_t)(h * 2 + pp) * 128 * 64;
                unsigned va[16], vb[16];
#pragma unroll
                for (int tile = 0; tile < 8; ++tile) {
                    BF8 ka[2];
#pragma unroll
                    for (int s2 = 0; s2 < 2; ++s2) ka[s2].u = *(const uint4*)(skp + (size_t)(16 * tile + qi) * 64 + 32 * s2 + 8 * g);
                    f32x4_t d = __builtin_amdgcn_mfma_f32_16x16x32_bf16(ka[0].v, qf[0].v, (f32x4_t){0.f, 0.f, 0.f, 0.f}, 0, 0, 0);
                    d = __builtin_amdgcn_mfma_f32_16x16x32_bf16(ka[1].v, qf[1].v, d, 0, 0, 0);
#pragma unroll
                    for (int r = 0; r < 4; ++r) {
                        const unsigned key = (ford(d[r]) & ~127u) | (unsigned)(127 - (16 * tile + 4 * g + r));
                        if (tile < 4) va[tile * 4 + r] = key; else vb[(tile - 4) * 4 + r] = key;
                    }
                }
                bitonic_sort_desc<16>(va);
                bitonic_sort_desc<16>(vb);
                top16_merge(va, vb);
                top16_xlane(va, 16);
                top16_xlane(va, 32);
#pragma unroll
                for (int i = 0; i < 16; ++i) L[pp][i] = va[i];
            }
            if (g < 2) {
#pragma unroll
                for (int i = 0; i < 16; ++i) tabw[g * 16 + i] = 127 - (int)((g == 0 ? L[0][i] : L[1][i]) & 127u);
            }
            float s1[16], s2v[16];
#pragma unroll
            for (int i = 0; i < 16; ++i) { s1[i] = funord(L[0][i] & ~127u); s2v[i] = funord(L[1][i] & ~127u); }
            unsigned ca[16], cb[16];
#pragma unroll
            for (int i = 0; i < 16; ++i) { ca[i] = 0u; cb[i] = 0u; }
            {
                const float r0 = g == 0 ? s1[0] : (g == 1 ? s1[1] : (g == 2 ? s1[2] : s1[3]));
                const int nb0 = g == 0 ? 16 : (g == 1 ? 8 : (g == 2 ? 5 : 4));
#pragma unroll
                for (int bq = 0; bq < 16; ++bq) if (bq < nb0) ca[bq] = (ford(r0 + s2v[bq]) & ~255u) | (unsigned)(255 - (g * 16 + bq));
                const float r1 = g == 0 ? s1[4] : (g == 1 ? s1[5] : (g == 2 ? s1[6] : s1[7]));
                const int nb1 = g == 0 ? 3 : 2;
#pragma unroll
                for (int bq = 0; bq < 3; ++bq) if (bq < nb1) cb[bq] = (ford(r1 + s2v[bq]) & ~255u) | (unsigned)(255 - ((g + 4) * 16 + bq));
                const float r2 = g == 0 ? s1[8] : (g == 1 ? s1[9] : (g == 2 ? s1[10] : s1[11]));
                cb[3] = (ford(r2 + s2v[0]) & ~255u) | (unsigned)(255 - ((g + 8) * 16));
                const float r3 = g == 0 ? s1[12] : (g == 1 ? s1[13] : (g == 2 ? s1[14] : s1[15]));
                cb[4] = (ford(r3 + s2v[0]) & ~255u) | (unsigned)(255 - ((g + 12) * 16));
            }
            bitonic_sort_desc<16>(ca);
            bitonic_sort_desc<16>(cb);
            top16_merge(ca, cb);
            top16_xlane(ca, 16);
            top16_xlane(ca, 32);
            float tv[16]; float den = 0.f;
#pragma unroll
            for (int i = 0; i < 16; ++i) {
                const int f = 255 - (int)(ca[i] & 255u);
                const int a = f >> 4, bq = f & 15;
                tv[i] = funord(ca[i] & ~255u);
                (void)a; (void)bq;
            }
#pragma unroll
            for (int i = 0; i < 16; ++i) { tv[i] = __expf(tv[i] - funord(ca[0] & ~255u)); den += tv[i]; }
            const float inv = 1.f / den;
            int ev[4]; float gv[4];
#pragma unroll
            for (int r = 0; r < 4; ++r) {
                const unsigned key = g == 0 ? ca[r] : (g == 1 ? ca[4 + r] : (g == 2 ? ca[8 + r] : ca[12 + r]));
                const float tvv = g == 0 ? tv[r] : (g == 1 ? tv[4 + r] : (g == 2 ? tv[8 + r] : tv[12 + r]));
                const int f = 255 - (int)(key & 255u);
                ev[r] = tabw[f >> 4] * 128 + tabw[16 + (f & 15)];
                gv[r] = tvv * inv;
            }
            *(int4*)(pidx + tok * 128 + h * 16 + 4 * g) = make_int4(ev[0], ev[1], ev[2], ev[3]);
            *(float4*)(pgt + tok * 128 + h * 16 + 4 * g) = make_float4(gv[0], gv[1], gv[2], gv[3]);
        }
    }
}

typedef _Float16 h2_t __attribute__((ext_vector_type(2)));
__device__ __forceinline__ h2_t as_h2(unsigned u) { union { unsigned u; h2_t h; } c; c.u = u; return c.h; }
#define U_SCALE 1024.f
#define V_SCALE 256.f
typedef float f32x2_t __attribute__((ext_vector_type(2)));
__device__ __forceinline__ unsigned pack4_fp8(float4 a, float sc) {
    const float x = fminf(fmaxf(a.x * sc, -448.f), 448.f), y = fminf(fmaxf(a.y * sc, -448.f), 448.f);
    const float z = fminf(fmaxf(a.z * sc, -448.f), 448.f), w = fminf(fmaxf(a.w * sc, -448.f), 448.f);
    int r = __builtin_amdgcn_cvt_pk_fp8_f32(x, y, 0, false);
    r = __builtin_amdgcn_cvt_pk_fp8_f32(z, w, r, true);
    return (unsigned)r;
}
__device__ __forceinline__ void ph_tab_convert(const Ctx& p, int l) {
    const float4* u = (const float4*)(pin_(32) + (size_t)l * NEXP * DM);
    const float4* v = (const float4*)(pin_(33) + (size_t)l * NEXP * DM);
    unsigned* uo = (unsigned*)(pws_() + WS_UT16);
    unsigned* vo = (unsigned*)(pws_() + WS_VT16);
    const size_t n4 = (size_t)NEXP * DM / 4;
    for (size_t i = (size_t)bid_() * 512 + tid_(); i < n4; i += (size_t)nblk_() * 512) {
        uo[i] = pack4_fp8(u[i], U_SCALE);
        vo[i] = pack4_fp8(v[i], V_SCALE);
    }
}
#define WS_PD (WS_P)
template <int HALF>
__device__ __forceinline__ void ph_peer_u(const Ctx& p, int l) {
    const unsigned char* ut = (const unsigned char*)(pws_() + WS_UT16);
    const int* pidx = (const int*)(pws_() + WS_PEI);
    float* pgt = (float*)(pws_() + WS_PEG);
    float* pd_ = (float*)(pws_() + WS_PD);
    const bf16_t* H = (const bf16_t*)(pws_() + WS_H);
    const int lane = tid_() & 63;
    const bool r = lane & 32, bit4 = lane & 16, bit3 = lane & 8, bit2 = lane & 4;
    const int coff = 512 * HALF + 16 * (lane & 31);
    const int pmine = 2 * (((lane >> 4) & 1) * 4 + ((lane >> 3) & 1) * 2 + ((lane >> 2) & 1)) + (lane >> 5);
    const int nw = nwaves();
#define PU_ROWS(buf, esrc, lb) do { int es_ = esrc; asm volatile("" : "+v"(es_)); _Pragma("unroll") for (int i_ = 0; i_ < 8; ++i_) { \
        const int ea_ = __builtin_amdgcn_readlane(es_, (lb) + 2 * i_), eb_ = __builtin_amdgcn_readlane(es_, (lb) + 2 * i_ + 1); \
        buf[i_] = *(const uint4*)(ut + (size_t)(r ? eb_ : ea_) * DM + coff); } __builtin_amdgcn_sched_barrier(0); } while (0)
#define PU_COMP(buf, kb) do { float pd[8]; _Pragma("unroll") for (int i_ = 0; i_ < 8; ++i_) { \
            const unsigned w_[4] = {buf[i_].x, buf[i_].y, buf[i_].z, buf[i_].w}; float d0 = 0.f, d1 = 0.f; \
            _Pragma("unroll") for (int q = 0; q < 4; ++q) { \
                const f32x2_t a_ = __builtin_amdgcn_cvt_pk_f32_fp8((int)w_[q], false), c_ = __builtin_amdgcn_cvt_pk_f32_fp8((int)w_[q], true); \
                d0 = __builtin_fmaf(a_.x, hh[4 * q], d0); d1 = __builtin_fmaf(a_.y, hh[4 * q + 1], d1); \
                d0 = __builtin_fmaf(c_.x, hh[4 * q + 2], d0); d1 = __builtin_fmaf(c_.y, hh[4 * q + 3], d1); } \
            pd[i_] = d0 + d1; } \
        float r4[4], r2[2], r1; \
        _Pragma("unroll") for (int i_ = 0; i_ < 4; ++i_) { const float mine = bit4 ? pd[i_ + 4] : pd[i_], send = bit4 ? pd[i_] : pd[i_ + 4]; r4[i_] = mine + __shfl_xor(send, 16, 64); } \
        _Pragma("unroll") for (int i_ = 0; i_ < 2; ++i_) { const float mine = bit3 ? r4[i_ + 2] : r4[i_], send = bit3 ? r4[i_] : r4[i_ + 2]; r2[i_] = mine + __shfl_xor(send, 8, 64); } \
        { const float mine = bit2 ? r2[1] : r2[0], send = bit2 ? r2[0] : r2[1]; r1 = mine + __shfl_xor(send, 4, 64); } \
        r1 += __shfl_xor(r1, 2, 64); r1 += __shfl_xor(r1, 1, 64); \
        const size_t pi = (size_t)tok * 128 + (kb) * 16 + pmine; \
        if (HALF == 0) { if ((lane & 3) == 0) pd_[pi] = r1; } \
        else if ((lane & 3) == 0) pgt[pi] = pgt[pi] * gelu_tanh_f((r1 + pd_[pi]) * (1.f / U_SCALE)) * (1.f / V_SCALE); \
        __builtin_amdgcn_sched_barrier(0); } while (0)
    int tok = gwave();
    uint4 nr0 = *(const uint4*)(H + (size_t)tok * DM + coff), nr1 = *(const uint4*)(H + (size_t)tok * DM + coff + 8);
    int ne0 = pidx[(size_t)tok * 128 + lane], ne1 = pidx[(size_t)tok * 128 + 64 + lane];
    uint4 rA[8], rB[8];
    PU_ROWS(rA, ne0, 0);
    for (; tok < MTOK; tok += nw) {
        float hh[16];
        {
            const unsigned w[8] = {nr0.x, nr0.y, nr0.z, nr0.w, nr1.x, nr1.y, nr1.z, nr1.w};
#pragma unroll
            for (int q = 0; q < 8; ++q) { hh[2 * q] = __uint_as_float(w[q] << 16); hh[2 * q + 1] = __uint_as_float(w[q] & 0xffff0000u); }
        }
        const int e0 = ne0, e1 = ne1;
        {
            const size_t tn = (size_t)(tok + nw < MTOK ? tok + nw : tok);
            nr0 = *(const uint4*)(H + tn * DM + coff); nr1 = *(const uint4*)(H + tn * DM + coff + 8);
            ne0 = pidx[tn * 128 + lane]; ne1 = pidx[tn * 128 + 64 + lane];
        }
        PU_ROWS(rB, e0, 16); PU_COMP(rA, 0);
        PU_ROWS(rA, e0, 32); PU_COMP(rB, 1);
        PU_ROWS(rB, e0, 48); PU_COMP(rA, 2);
        PU_ROWS(rA, e1, 0);  PU_COMP(rB, 3);
        PU_ROWS(rB, e1, 16); PU_COMP(rA, 4);
        PU_ROWS(rA, e1, 32); PU_COMP(rB, 5);
        PU_ROWS(rB, e1, 48); PU_COMP(rA, 6);
        PU_ROWS(rA, ne0, 0);
        PU_COMP(rB, 7);
    }
#undef PU_ROWS
#undef PU_COMP
}
template <int HALF>
__device__ __forceinline__ void ph_peer_v(const Ctx& p, int l) {
    const unsigned char* vt = (const unsigned char*)(pws_() + WS_VT16);
    const int* pidx = (const int*)(pws_() + WS_PEI);
    const float* pgt = (const float*)(pws_() + WS_PEG);
    float* x = pout_();
    const int lane = tid_() & 63;
    const bool r = lane & 32;
    const int coff = 512 * HALF + 16 * (lane & 31);
    const int nw = nwaves();
    int tok = gwave();
    int ne0 = pidx[(size_t)tok * 128 + lane], ne1 = pidx[(size_t)tok * 128 + 64 + lane];
    float nc0 = pgt[(size_t)tok * 128 + lane], nc1 = pgt[(size_t)tok * 128 + 64 + lane];
    for (; tok < MTOK; tok += nw) {
        const int e0 = ne0, e1 = ne1;
        const float c0 = nc0, c1 = nc1;
        if (tok + nw < MTOK) {
            const size_t tn = (size_t)(tok + nw);
            ne0 = pidx[tn * 128 + lane]; ne1 = pidx[tn * 128 + 64 + lane];
            nc0 = pgt[tn * 128 + lane]; nc1 = pgt[tn * 128 + 64 + lane];
        }
        float out[16];
#pragma unroll
        for (int i = 0; i < 16; ++i) out[i] = 0.f;
#pragma unroll 1
        for (int hb = 0; hb < 4; ++hb) {
            const int esrc = hb < 2 ? e0 : e1;
            const float csrc = hb < 2 ? c0 : c1;
            const int lb = (hb & 1) * 32;
            uint4 vr[16];
#pragma unroll
            for (int i = 0; i < 16; ++i) {
                const int ea = __builtin_amdgcn_readlane(esrc, lb + 2 * i), eb = __builtin_amdgcn_readlane(esrc, lb + 2 * i + 1);
                const int e = r ? eb : ea;
                vr[i] = *(const uint4*)(vt + (size_t)e * DM + coff);
            }
#pragma unroll
            for (int i = 0; i < 16; ++i) {
                const float ca = __uint_as_float(__builtin_amdgcn_readlane(__float_as_uint(csrc), lb + 2 * i));
                const float cb = __uint_as_float(__builtin_amdgcn_readlane(__float_as_uint(csrc), lb + 2 * i + 1));
                const float cj = r ? cb : ca;
                const unsigned w[4] = {vr[i].x, vr[i].y, vr[i].z, vr[i].w};
#pragma unroll
                for (int q = 0; q < 4; ++q) {
                    const f32x2_t a = __builtin_amdgcn_cvt_pk_f32_fp8((int)w[q], false), c = __builtin_amdgcn_cvt_pk_f32_fp8((int)w[q], true);
                    out[4 * q] = __builtin_fmaf(a.x, cj, out[4 * q]); out[4 * q + 1] = __builtin_fmaf(a.y, cj, out[4 * q + 1]);
                    out[4 * q + 2] = __builtin_fmaf(c.x, cj, out[4 * q + 2]); out[4 * q + 3] = __builtin_fmaf(c.y, cj, out[4 * q + 3]);
                }
            }
        }
#pragma unroll
        for (int i = 0; i < 16; ++i) out[i] += __shfl_xor(out[i], 32, 64);
        if (!r) {
            float4* xp = (float4*)(x + (size_t)tok * DM + coff);
#pragma unroll
            for (int q = 0; q < 4; ++q) {
                float4 a = xp[q];
                a.x += out[4 * q]; a.y += out[4 * q + 1]; a.z += out[4 * q + 2]; a.w += out[4 * q + 3];
                xp[q] = a;
            }
        }
    }
}


#ifndef PROBE_MASK
#define PROBE_MASK 0
#endif
#if PROBE_MASK
#define GB(k) do { GRID_BARRIER(); const unsigned long long now_ = wall_clock64(); if ((PROBE_MASK >> (k)) & 1) { const unsigned long long dt_ = now_ - tprev_; while (wall_clock64() - now_ < 3ull * dt_) __builtin_amdgcn_s_sleep(8); } GRID_BARRIER(); tprev_ = wall_clock64(); } while (0)
#else
#define GB(k) GRID_BARRIER()
#endif
__global__ void __launch_bounds__(512, 2) k_mega(Params kp) {
    float* sm = dynsmem;
    {
        unsigned long long* tab = (unsigned long long*)((char*)dynsmem + PTAB_OFF);
        if (threadIdx.x < 34) tab[threadIdx.x] = (unsigned long long)kp.in[threadIdx.x];
        if (threadIdx.x == 34) tab[34] = (unsigned long long)kp.out;
        if (threadIdx.x == 35) tab[35] = (unsigned long long)kp.ws;
        if (threadIdx.x == 36) { tab[36] = 0ull; tab[37] = 0ull; }
    }
    __syncthreads();
    Ctx p; p.kp = &kp;
    (void)xcd_barrier_post((unsigned*)(pws_() + WS_BAR), (volatile LAS unsigned*)((char*)dynsmem + PTAB_OFF + 36 * 8));
#define GRID_BARRIER() do { XcdBarrier bar_; bar_.bar = (unsigned*)(pws_() + WS_BAR); bar_.x = xb_xcc_id(); bar_.st = (volatile LAS unsigned*)((char*)dynsmem + PTAB_OFF + 36 * 8); xcd_barrier(bar_); } while (0)
    ph_weight_prep(p, sm);
    ph_subkeys_convert(p);
    GRID_BARRIER();
#if PROBE_MASK
    unsigned long long tprev_ = wall_clock64();
#endif
#pragma unroll 1
    for (int l = 0; l < DEPTH; ++l) {
#define XIN_ (l == 0 ? pin_(0) : pout_())
#define HBUF_ ((const bf16_t*)(pws_() + WS_H))
        ph_rmsnorm(XIN_, pin_(2) + (size_t)l * DM, (bf16_t*)(pws_() + WS_H), MTOK);
        ph_rmsnorm(pin_(1), pin_(22) + (size_t)l * DM, (bf16_t*)(pws_() + WS_HM), MMEM);
        GB(1);
        { pg8::EpiBf16 E; E.O = (bf16_t*)(pws_() + WS_P); E.ldc = LDP; ph_gemm(HBUF_, (const bf16_t*)(pws_() + WT_IN) + (size_t)l * LDP * DM, MTOK, LDP, DM, E); }
        { pg8::EpiF32 E; E.C = (float*)(pws_() + WS_KM); E.R = nullptr; E.ldc = 256; ph_gemm((const bf16_t*)(pws_() + WS_HM), (const bf16_t*)(pws_() + WT_XK) + (size_t)l * 256 * DM, MMEM, 256, DM, E, 32); }
        { pg8::EpiF32 E; E.C = (float*)(pws_() + WS_VM); E.R = nullptr; E.ldc = 256; ph_gemm((const bf16_t*)(pws_() + WS_HM), (const bf16_t*)(pws_() + WT_XV) + (size_t)l * 256 * DM, MMEM, 256, DM, E, 64); }
        GB(2);
        ph_mem_prep(p, l);
        ph_dsa_prep(p, l);
        ph_scan_prep(p, l);
        GB(3);
        ph_scans(p, l, sm);
        GB(4);
        ph_mixer_finish(p, l);
        ph_dsa_main(p, l, sm);
        GB(5);
        { pg8::EpiF32 E; E.C = pout_(); E.R = XIN_; E.ldc = DM; ph_gemm((const bf16_t*)(pws_() + WS_Y), (const bf16_t*)(pws_() + WT_OUT) + (size_t)l * DM * DM, MTOK, DM, DM, E); }
        GB(6);
        ph_rmsnorm(pout_(), pin_(21) + (size_t)l * DM, (bf16_t*)(pws_() + WS_H), MTOK);
        GB(7);
        { pg8::EpiF32 E; E.C = (float*)(pws_() + WS_QX); E.R = nullptr; E.ldc = 256; ph_gemm(HBUF_, (const bf16_t*)(pws_() + WT_XQ) + (size_t)l * 256 * DM, MTOK, 256, DM, E); }
        GB(8);
        ph_xattn(p, l);
        GB(9);
        { pg8::EpiF32 E; E.C = pout_(); E.R = pout_(); E.ldc = DM; ph_gemm((const bf16_t*)(pws_() + WS_OX), (const bf16_t*)(pws_() + WT_XO) + (size_t)l * DM * 256, MTOK, DM, 256, E); }
        GB(10);
        ph_rmsnorm(pout_(), pin_(29) + (size_t)l * DM, (bf16_t*)(pws_() + WS_H), MTOK);
        ph_tab_convert(p, l);
        GB(11);
        { pg8::EpiBf16 E; E.O = (bf16_t*)(pws_() + WS_QP); E.ldc = DM; ph_gemm(HBUF_, (const bf16_t*)(pws_() + WT_PQ) + (size_t)l * DM * DM, MTOK, DM, DM, E); }
        GB(12);
        ph_peer_topk(p, l, sm);
        GB(13);
        ph_peer_u<0>(p, l);
        GB(14);
        ph_peer_u<1>(p, l);
        GB(15);
        ph_peer_v<0>(p, l);
        GB(16);
        ph_peer_v<1>(p, l);
        GB(17);
    }
}

extern "C" void kernel_launch(void* const* d_in, const int* in_sizes, int n_in, void* d_out, int out_size, void* d_ws, size_t ws_size, hipStream_t stream) {
    if (n_in != 34 || out_size != MTOK * DM || ws_size < WS_END) {
        fprintf(stderr, "kernel_launch: unexpected shapes (n_in %d out %d ws %zu need %zu)\n", n_in, out_size, ws_size, (size_t)WS_END);
        return;
    }
    static int grid = 0;
    if (!grid) {
        int dev = 0, cus = 0, per_cu = 0;
        (void)hipGetDevice(&dev);
        (void)hipDeviceGetAttribute(&cus, hipDeviceAttributeMultiprocessorCount, dev);
        (void)hipFuncSetAttribute((const void*)k_mega, hipFuncAttributeMaxDynamicSharedMemorySize, LDS_BYTES);
        (void)hipOccupancyMaxActiveBlocksPerMultiprocessor(&per_cu, (const void*)k_mega, 512, LDS_BYTES);
        if (per_cu < 1) fprintf(stderr, "kernel_launch: occupancy query reports %d blocks per CU\n", per_cu);
        grid = cus > 0 ? cus : 256;
    }
    Params p; memset(&p, 0, sizeof(p));
    for (int i = 0; i < 34; ++i) p.in[i] = (const float*)d_in[i];
    p.out = (float*)d_out; p.ws = (char*)d_ws;
    (void)hipMemsetAsync((char*)d_ws + WS_BAR, 0, XCD_BAR_WORDS * sizeof(unsigned), stream);
    hipLaunchKernelGGL(k_mega, dim3(grid), dim3(512), LDS_BYTES, stream, p);
}
```

```cpp
#include <hip/hip_runtime.h>
#include <stdint.h>
#include <stdio.h>
#include <string.h>

#define NB 32
#define SEQ 2048
#define DM 1024
#define MTOK (NB * SEQ)
#define DEPTH 4
#define NMEM 256
#define MMEM (NB * NMEM)
#define LDP 3328
#define NEXP 16384
#define EPS 1e-6f
#define PC_Z 0
#define PC_XBC 256
#define PC_GQKV 768
#define PC_GG 1536
#define PC_LQ 1792
#define PC_LK 1920
#define PC_LV 2048
#define PC_LR 2304
#define PC_DQ 2560
#define PC_DK 2816
#define PC_DV 2880
#define PC_IQ 2944
#define PC_IK 3200
#define PC_GLR 3232
#define PC_IW 3248
#define PC_DT 3256
#define PC_GA 3260
#define PC_GB 3264

typedef unsigned short bf16_t;

#define WS_BAR 0ull
#define WS_P 16384ull
#define SZ_P ((size_t)MTOK * LDP * 2)
#define WS_H (WS_P + SZ_P)
#define SZ_H ((size_t)MTOK * DM * 2)
#define WS_Y (WS_H + SZ_H)
#define SZ_Y ((size_t)MTOK * DM * 2)
#define WS_WP (WS_Y + SZ_Y)
#define SZ_WP ((size_t)DEPTH * DM * LDP * 4)
#define WT_IN (WS_WP)
#define WT_OUT (WT_IN + (size_t)DEPTH * LDP * DM * 2)
#define WT_XQ (WT_OUT + (size_t)DEPTH * DM * DM * 2)
#define WT_XK (WT_XQ + (size_t)DEPTH * 256 * DM * 2)
#define WT_XV (WT_XK + (size_t)DEPTH * 256 * DM * 2)
#define WT_XO (WT_XV + (size_t)DEPTH * 256 * DM * 2)
#define WT_PQ (WT_XO + (size_t)DEPTH * DM * 256 * 2)
#define WT_END (WT_PQ + (size_t)DEPTH * DM * DM * 2)
#define WS_QN (WS_WP + SZ_WP)
#define SZ_QN ((size_t)MTOK * 256 * 4)
#define WS_KN (WS_QN + SZ_QN)
#define SZ_KN ((size_t)MTOK * 64 * 4)
#define WS_IKN (WS_KN + SZ_KN)
#define SZ_IKN ((size_t)MTOK * 32 * 4)
#define WS_YPRE (WS_IKN + SZ_IKN)
#define SZ_YPRE ((size_t)MTOK * 256 * 4)
#define WS_HM (WS_YPRE + SZ_YPRE)
#define SZ_HM ((size_t)MMEM * DM * 2)
#define WS_KM (WS_HM + SZ_HM)
#define SZ_KM ((size_t)MMEM * 256 * 4)
#define WS_VM (WS_KM + SZ_KM)
#define SZ_VM ((size_t)MMEM * 256 * 4)
#define WS_KB (WS_VM + SZ_VM)
#define SZ_KB ((size_t)MMEM * 256 * 2)
#define WS_VTB (WS_KB + SZ_KB)
#define SZ_VTB ((size_t)MMEM * 256 * 2)
#define WS_VT (WS_VTB + SZ_VTB)
#define SZ_VT ((size_t)MTOK * 64 * 2)
#define WS_SKB (WS_VT + SZ_VT)
#define SZ_SKB ((size_t)DEPTH * 8 * 2 * 128 * 64 * 2)
#define WS_SC (WS_SKB + SZ_SKB)
#define SZ_SC ((size_t)MTOK * 16 * 4)
#define WS_DUMMY (WS_SC + SZ_SC)
#define SZ_DUMMY (65536ull)
#define WS_END (WS_DUMMY + SZ_DUMMY)
#define WS_QX (WS_P)
#define WS_OX (WS_P + (size_t)MTOK * 256 * 4)
#define WS_QP (WS_P + 96ull * 1024 * 1024)
#define WS_UT16 (WS_P + 260ull * 1024 * 1024)
#define WS_VT16 (WS_UT16 + (size_t)NEXP * DM * 2)
#define WS_PEI (WS_VT16 + (size_t)NEXP * DM * 2)
#define WS_PEG (WS_PEI + (size_t)MTOK * 128 * 4)
#define WS_PEND (WS_PEG + (size_t)MTOK * 128 * 4)
static_assert(WS_PEND <= WS_P + SZ_P, "P region aliases");

struct Params {
    const float* in[34];
    float* out;
    char* ws;
};

#define XB_TMO      128
#define XB_XCNT(j)  (256  + 64 * (j))
#define XB_XSUB(j)  (1280 + 64 * (j))
#define XB_XGEN(j)  (2304 + 64 * (j))
#define XB_TOP      3328
#define XB_TOPGEN   3392
#define XCD_BAR_WORDS 3456
#define XB_SPIN_CAP (1u << 18)
#define LAS __attribute__((address_space(3)))

__device__ __forceinline__ unsigned xb_ld(unsigned* p)              { return __hip_atomic_load(p, __ATOMIC_RELAXED, __HIP_MEMORY_SCOPE_AGENT); }
__device__ __forceinline__ unsigned xb_add(unsigned* p, unsigned v) { return __hip_atomic_fetch_add(p, v, __ATOMIC_RELAXED, __HIP_MEMORY_SCOPE_AGENT); }
__device__ __forceinline__ unsigned xb_xcc_id() { return (unsigned)__builtin_amdgcn_s_getreg((3 << 11) | 20) & 0xFu; }
#define XB_SPIN(cond, bar) do { unsigned _sp = 0; while (cond) { __builtin_amdgcn_s_sleep(1); \
    if ((++_sp & 255u) == 0u) { if (xb_ld(&(bar)[XB_TMO])) break; if (_sp > XB_SPIN_CAP) { atomicAdd(&(bar)[XB_TMO], 1u); break; } } } } while (0)

struct XcdBarrier {
    unsigned* bar; unsigned x;
    volatile LAS unsigned* st;
};

__device__ __forceinline__ XcdBarrier xcd_barrier_post(unsigned* bar, volatile LAS unsigned* st) {
    XcdBarrier b; b.bar = bar; b.x = xb_xcc_id(); b.st = st;
    if (threadIdx.x == 0) (void)xb_add(&bar[XB_XCNT(b.x)], 1u);
    return b;
}
__device__ __forceinline__ void xcd_barrier_complete(unsigned* bar, unsigned x, unsigned& nloc, unsigned& nx) {
    const unsigned G = gridDim.x * gridDim.y * gridDim.z;
    unsigned sum, cnt, mine, sp = 0u;
    for (;;) {
        sum = 0u; cnt = 0u; mine = 0u;
#pragma unroll
        for (unsigned j = 0; j < 16; ++j) { const unsigned c = xb_ld(&bar[XB_XCNT(j)]); sum += c; cnt += (c > 0u) ? 1u : 0u; mine = (j == x) ? c : mine; }
        if (sum == G) break;
        __builtin_amdgcn_s_sleep(1);
        if ((++sp & 255u) == 0u) { if (xb_ld(&bar[XB_TMO])) break; if (sp > XB_SPIN_CAP) { atomicAdd(&bar[XB_TMO], 1u); break; } }
    }
    nloc = mine > 0u ? mine : 1u; nx = cnt > 0u ? cnt : 1u;
}

__device__ __forceinline__ void xcd_barrier(const XcdBarrier& b) {
    asm volatile("s_waitcnt vmcnt(0)" ::: "memory");
    __syncthreads();
    if (threadIdx.x == 0) {
        unsigned* bar = b.bar;
        __builtin_amdgcn_s_waitcnt(0);
        unsigned nloc = b.st[0], nx = b.st[1];
        if (nloc == 0u) { xcd_barrier_complete(bar, b.x, nloc, nx); b.st[0] = nloc; b.st[1] = nx; }
        const unsigned old = xb_add(&bar[XB_XSUB(b.x)], 1u);
        const unsigned gen = old / nloc;
        if (old + 1u == (gen + 1u) * nloc) {
            __builtin_amdgcn_fence(__ATOMIC_RELEASE, "agent");
            asm volatile("s_waitcnt vmcnt(0)" ::: "memory");
            const unsigned og = xb_add(&bar[XB_TOP], 1u);
            const unsigned tg = og / nx;
            if (og + 1u == (tg + 1u) * nx) xb_add(&bar[XB_TOPGEN], 1u);
            else XB_SPIN(xb_ld(&bar[XB_TOPGEN]) == tg, bar);
            __builtin_amdgcn_fence(__ATOMIC_ACQUIRE, "agent");
            xb_add(&bar[XB_XGEN(b.x)], 1u);
            asm volatile("s_waitcnt vmcnt(0)" ::: "memory");
        } else {
            XB_SPIN(xb_ld(&bar[XB_XGEN(b.x)]) == gen, bar);
            __builtin_amdgcn_fence(__ATOMIC_ACQUIRE, "agent");
            asm volatile("s_waitcnt vmcnt(0)" ::: "memory");
        }
    }
    __syncthreads();
}


#define LDS_BYTES (144 * 1024)
#define PTAB_OFF (LDS_BYTES - 1024)
extern __shared__ __attribute__((aligned(16))) float dynsmem[];
struct Ctx { const Params* kp; };
#define pin_(i) (p.kp->in[i])
#define pout_() (p.kp->out)
#define pws_() (p.kp->ws)

__device__ __forceinline__ float bf2f(bf16_t v) { return __uint_as_float(((unsigned)v) << 16); }
__device__ __forceinline__ bf16_t f2bf(float f) { unsigned u = __float_as_uint(f); u += 0x7FFFu + ((u >> 16) & 1u); return (bf16_t)(u >> 16); }
__device__ __forceinline__ unsigned pk_bf16(float lo, float hi) { return (unsigned)f2bf(lo) | ((unsigned)f2bf(hi) << 16); }
__device__ __forceinline__ float wave_sum(float v) {
#pragma unroll
    for (int o = 32; o >= 1; o >>= 1) v += __shfl_xor(v, o, 64);
    return v;
}
__device__ __forceinline__ float wave_max(float v) {
#pragma unroll
    for (int o = 32; o >= 1; o >>= 1) v = fmaxf(v, __shfl_xor(v, o, 64));
    return v;
}
__device__ __forceinline__ float silu_f(float x) { return x / (1.f + __expf(-x)); }
__device__ __forceinline__ float sigmoid_f(float x) { return 1.f / (1.f + __expf(-x)); }
__device__ __forceinline__ float softplus_f(float x) { return x > 20.f ? x : log1pf(__expf(x)); }
__device__ __forceinline__ float logsigmoid_f(float x) { return -softplus_f(-x); }
__device__ __forceinline__ float gelu_tanh_f(float x) { const float u = 0.7978845608028654f * (x + 0.044715f * x * x * x); return 0.5f * x * (1.f + tanhf(u)); }
__device__ __forceinline__ unsigned ford(float f) { f = f + 0.0f; unsigned u = __float_as_uint(f); return (u & 0x80000000u) ? ~u : (u | 0x80000000u); }
__device__ __forceinline__ float funord(unsigned k) { unsigned u = (k & 0x80000000u) ? (k & 0x7fffffffu) : ~k; return __uint_as_float(u); }
__device__ __forceinline__ unsigned long long wave_max_u64(unsigned long long v) {
#pragma unroll
    for (int o = 32; o >= 1; o >>= 1) {
        unsigned lo = __shfl_xor((unsigned)v, o, 64), hi = __shfl_xor((unsigned)(v >> 32), o, 64);
        unsigned long long w = ((unsigned long long)hi << 32) | lo;
        v = w > v ? w : v;
    }
    return v;
}
__device__ __forceinline__ int tid_() { int t = threadIdx.x; asm volatile("" : "+v"(t)); return t; }
__device__ __forceinline__ int bid_() { int b = blockIdx.x; asm volatile("" : "+s"(b)); return b; }
__device__ __forceinline__ int nblk_() { int g = gridDim.x; asm volatile("" : "+s"(g)); return g; }
__device__ __forceinline__ int gwave() { return (bid_() * 512 + tid_()) >> 6; }
__device__ __forceinline__ int nwaves() { return nblk_() * 8; }

namespace pg8 {
#define PG8_LAS __attribute__((address_space(3)))
typedef unsigned short bf16_t;
typedef short bf16x8 __attribute__((ext_vector_type(8)));
typedef float f32x4 __attribute__((ext_vector_type(4)));
typedef unsigned u32x4 __attribute__((ext_vector_type(4)));
constexpr int BM = 256, BK = 64, HALF = 128, HTB = HALF * BK * 2  , STAGE_BYTES = 8 * HTB, NXCD = 8, WGM = 8;

__host__ __device__ __forceinline__ int lds_byte(int r, int c) { const int st = (r >> 4) * 2 + (c >> 5), rr = r & 15, cc = c & 31, ob = rr * 64 + cc * 2; return st * 1024 + (ob ^ (((ob >> 9) & 1) << 5)); }
__host__ __device__ __forceinline__ void stage_rc(int b, int& R, int& C) { const int st = b / 1024, sb = b % 1024, swz = sb ^ (((sb >> 9) & 1) << 5); R = (st >> 1) * 16 + swz / 64; C = (st & 1) * 32 + (swz % 64) / 2; }
__host__ __device__ __forceinline__ int perm32(int rho) { const int n = rho >> 4, i = rho & 15; return 8 * (i >> 2) + 4 * n + (i & 3); }

struct Unit { int pm, pn; };
struct Gemm { const bf16_t* A; const bf16_t* Bt; int M, N, K; };

struct StaticOrder {
    int nM, nN, nwg, G, c;
    __host__ __device__ void init(int M, int N, int G_, int c_) { nM = M / BM; nN = N / BM; nwg = nM * nN; G = G_; c = c_; }
    __host__ __device__ bool next(int i, Unit& u) const {
        const long L = (long)i * G + c; if (L >= nwg) return false;
        int wgid = (int)L; { const int q = nwg / NXCD, r = nwg % NXCD, xcd = wgid % NXCD, off = wgid / NXCD; wgid = (xcd < r ? xcd * (q + 1) : r * (q + 1) + (xcd - r) * q) + off; }
        const int nig = WGM * nN, gid = wgid / nig, fm = gid * WGM, gsz = (nM - fm) < WGM ? (nM - fm) : WGM;
        u.pm = fm + ((wgid % nig) % gsz); u.pn = (wgid % nig) / gsz; return true;
    }
    __device__ __forceinline__ void a_ready(const Unit&) const {}
    __device__ __forceinline__ void done(const Unit&) const {}
};

__device__ __forceinline__ unsigned cvt_pk_bf16(float lo, float hi) { unsigned r; asm volatile("v_cvt_pk_bf16_f32 %0, %1, %2" : "=v"(r) : "v"(lo), "v"(hi)); return r; }
struct EpiF32 {
    static constexpr bool PERM = false, AFTER_DRAIN = false;
    float* C; const float* R; int ldc;
    __device__ __forceinline__ void operator()(const f32x4 (&acc)[2][2][4][2], const Unit& u, int wr, int wc, int fr, int fq) const {
        const int row0 = u.pm * BM + wr * 64 + fr, col0 = u.pn * BM + wc * 32 + 4 * fq;
#pragma unroll
        for (int ai = 0; ai < 2; ++ai)
#pragma unroll
            for (int m = 0; m < 4; ++m) { const size_t off = (size_t)(row0 + ai * HALF + m * 16) * ldc + col0;
#pragma unroll
                for (int bj = 0; bj < 2; ++bj)
#pragma unroll
                    for (int n = 0; n < 2; ++n) { f32x4 v = acc[ai][bj][m][n]; if (R) v += *(const f32x4*)(R + off + bj * HALF + n * 16); *(f32x4*)(C + off + bj * HALF + n * 16) = v; } }
    }
};
struct EpiBf16 {
    static constexpr bool PERM = true, AFTER_DRAIN = false;
    bf16_t* O; int ldc;
    __device__ __forceinline__ void operator()(const f32x4 (&acc)[2][2][4][2], const Unit& u, int wr, int wc, int fr, int fq) const {
        const int row0 = u.pm * BM + wr * 64 + fr, col0 = u.pn * BM + wc * 32 + 8 * fq;
#pragma unroll
        for (int ai = 0; ai < 2; ++ai)
#pragma unroll
            for (int m = 0; m < 4; ++m) { bf16_t* rowp = O + (size_t)(row0 + ai * HALF + m * 16) * ldc + col0;
#pragma unroll
                for (int bj = 0; bj < 2; ++bj) { const f32x4 v0 = acc[ai][bj][m][0], v1 = acc[ai][bj][m][1];
                    u32x4 w; w.x = cvt_pk_bf16(v0[0], v0[1]); w.y = cvt_pk_bf16(v0[2], v0[3]); w.z = cvt_pk_bf16(v1[0], v1[1]); w.w = cvt_pk_bf16(v1[2], v1[3]);
                    *(u32x4*)(rowp + bj * HALF) = w; } }
    }
};

template <class Epi, class Sched, bool STAMP = false>
__device__ __forceinline__ void gemm_phase(PG8_LAS unsigned char* lds, const Gemm g, const Sched& S, const Epi& E, unsigned long long* stamps, const int tid) {
    const int wid = __builtin_amdgcn_readfirstlane(tid >> 6), lane = tid & 63, wr = wid >> 2, wc = wid & 3, fr = lane & 15, fq = lane >> 4;
    const int K = g.K, nt = K / BK;
    int ts_lo = 0, ts_hi = 0, nts = 0; const unsigned long long rt_entry = STAMP ? (unsigned long long)wall_clock64() : 0ull;
#define PG8_STAMP() do { if (STAMP && wid == 0 && nts < 64) { const unsigned long long _c = (unsigned long long)clock64(); \
        ts_lo = (lane == nts) ? (int)(unsigned)_c : ts_lo; ts_hi = (lane == nts) ? (int)(unsigned)(_c >> 32) : ts_hi; ++nts; } } while (0)
    PG8_STAMP();
    unsigned voffA[2], voffB[2];
#pragma unroll
    for (int i = 0; i < 2; ++i) { int R, C; stage_rc(tid * 16 + i * 8192, R, C); const int Rb = Epi::PERM ? ((R & ~31) + perm32(R & 31)) : R;
        voffA[i] = (unsigned)(R * K + C) * 2u; voffB[i] = (unsigned)(Rb * K + C) * 2u; }
    const size_t kstep = (size_t)(BK * 2);
    const size_t hstep = (size_t)HALF * K * 2;
    const size_t tstep = 2 * hstep;
    const unsigned ldsw = (unsigned)wid * 1024u;
    const int aoff = lds_byte(wr * 64 + fr, fq * 8), boff = lds_byte(wc * 32 + fr, fq * 8);
#define PG8_SA(b, h) (((b) * 2 + (h)) * HTB)
#define PG8_SB(b, h) ((4 + (b) * 2 + (h)) * HTB)
#define PG8_STAGE(bufoff, gbase, voff) do { _Pragma("unroll") for (int _i = 0; _i < 2; ++_i) \
        __builtin_amdgcn_global_load_lds((const unsigned*)((const char*)(gbase) + (voff)[_i]), (PG8_LAS unsigned*)(lds + (bufoff) + ldsw + _i * 8192), 16, 0, 0); } while (0)
#define PG8_LDA(dst, b, h) do { _Pragma("unroll") for (int m = 0; m < 4; ++m) _Pragma("unroll") for (int k = 0; k < 2; ++k) dst[m][k] = *(const PG8_LAS bf16x8*)(lds + PG8_SA(b, h) + aoff + m * 2048 + k * 1024); } while (0)
#define PG8_LDB(dst, b, h) do { _Pragma("unroll") for (int n = 0; n < 2; ++n) _Pragma("unroll") for (int k = 0; k < 2; ++k) dst[n][k] = *(const PG8_LAS bf16x8*)(lds + PG8_SB(b, h) + boff + n * 2048 + k * 1024); } while (0)
#define PG8_MMA(ai, bj, At, Bt) do { __builtin_amdgcn_s_setprio(1); _Pragma("unroll") for (int m = 0; m < 4; ++m) _Pragma("unroll") for (int n = 0; n < 2; ++n) _Pragma("unroll") for (int k = 0; k < 2; ++k) \
        acc[ai][bj][m][n] = __builtin_amdgcn_mfma_f32_16x16x32_bf16(Bt[n][k], At[m][k], acc[ai][bj][m][n], 0, 0, 0); __builtin_amdgcn_s_setprio(0); } while (0)
#define PG8_WAIT_V(n) asm volatile("s_waitcnt vmcnt(" #n ")" ::: "memory")
#define PG8_WAIT_L(n) asm volatile("s_waitcnt lgkmcnt(" #n ")" ::: "memory")
#define PG8_BAR __builtin_amdgcn_s_barrier()
#define PG8_SCHED __builtin_amdgcn_sched_barrier(0)
    Unit cur, nxt; int ui = 0;
    if (!S.next(0, cur)) return;
    f32x4 acc[2][2][4][2];
#pragma unroll
    for (int a = 0; a < 2; ++a)
#pragma unroll
        for (int b = 0; b < 2; ++b)
#pragma unroll
            for (int m = 0; m < 4; ++m)
#pragma unroll
                for (int n = 0; n < 2; ++n) acc[a][b][m][n] = (f32x4){0.f, 0.f, 0.f, 0.f};
    bf16x8 At[4][2], B0[2][2], B1[2][2];
    const char* cA = (const char*)g.A + (size_t)cur.pm * tstep; const char* cB = (const char*)g.Bt + (size_t)cur.pn * tstep;
    S.a_ready(cur);
    PG8_STAGE(PG8_SB(0, 0), cB, voffB); PG8_STAGE(PG8_SA(0, 0), cA, voffA); PG8_STAGE(PG8_SB(0, 1), cB + hstep, voffB); PG8_STAGE(PG8_SA(0, 1), cA + hstep, voffA);
    if (wr == 1) PG8_BAR;
    PG8_WAIT_V(4); PG8_BAR;
    PG8_STAGE(PG8_SB(1, 0), cB + kstep, voffB); PG8_STAGE(PG8_SA(1, 0), cA + kstep, voffA); PG8_STAGE(PG8_SB(1, 1), cB + hstep + kstep, voffB);
    PG8_WAIT_V(6); PG8_BAR;
    PG8_STAMP();
    for (;;) {
        const bool has_next = S.next(ui + 1, nxt);
        const char* nA = has_next ? (const char*)g.A + (size_t)nxt.pm * tstep : cA; const char* nB = has_next ? (const char*)g.Bt + (size_t)nxt.pn * tstep : cB;
        for (int t = 0; t < nt; t += 2) {
            const bool last = (t == nt - 2);
            const char* a1 = cA + (size_t)(t + 1) * kstep;
            const char* a2 = last ? nA : cA + (size_t)(t + 2) * kstep; const char* b2 = last ? nB : cB + (size_t)(t + 2) * kstep;
            const char* a3 = a2 + kstep; const char* b3 = b2 + kstep;
            if (last && has_next) S.a_ready(nxt);
            PG8_LDB(B0, 0, 0); PG8_SCHED; PG8_LDA(At, 0, 0); PG8_STAGE(PG8_SA(1, 1), a1 + hstep, voffA);
            PG8_WAIT_L(8); PG8_BAR; PG8_WAIT_L(0); PG8_MMA(0, 0, At, B0); PG8_BAR; PG8_SCHED;
            PG8_LDB(B1, 0, 1); PG8_STAGE(PG8_SB(0, 0), b2, voffB);
            PG8_BAR; PG8_WAIT_L(0); PG8_MMA(0, 1, At, B1); PG8_BAR;
            PG8_LDA(At, 0, 1); PG8_STAGE(PG8_SA(0, 0), a2, voffA);
            PG8_BAR; PG8_WAIT_L(0); PG8_MMA(1, 0, At, B0); PG8_BAR; PG8_SCHED;
            PG8_STAGE(PG8_SB(0, 1), b2 + hstep, voffB);
            PG8_WAIT_V(6); PG8_BAR; PG8_MMA(1, 1, At, B1); PG8_BAR;
            PG8_LDB(B0, 1, 0); PG8_SCHED; PG8_LDA(At, 1, 0); PG8_STAGE(PG8_SA(0, 1), a2 + hstep, voffA);
            PG8_WAIT_L(8); PG8_BAR; PG8_WAIT_L(0); PG8_MMA(0, 0, At, B0); PG8_BAR; PG8_SCHED;
            PG8_LDB(B1, 1, 1); PG8_STAGE(PG8_SB(1, 0), b3, voffB);
            PG8_BAR; PG8_WAIT_L(0); PG8_MMA(0, 1, At, B1); PG8_BAR;
            PG8_LDA(At, 1, 1); PG8_STAGE(PG8_SA(1, 0), a3, voffA);
            PG8_BAR; PG8_WAIT_L(0); PG8_MMA(1, 0, At, B0); PG8_BAR; PG8_SCHED;
            PG8_STAGE(PG8_SB(1, 1), b3 + hstep, voffB);
            PG8_WAIT_V(6); PG8_BAR; PG8_MMA(1, 1, At, B1); PG8_BAR;
        }
        PG8_STAMP();
        if constexpr (!Epi::AFTER_DRAIN) { E(acc, cur, wr, wc, fr, fq); S.done(cur); }
        PG8_STAMP();
        if (!has_next) break;
#pragma unroll
        for (int a = 0; a < 2; ++a)
#pragma unroll
            for (int b = 0; b < 2; ++b)
#pragma unroll
                for (int m = 0; m < 4; ++m)
#pragma unroll
                    for (int n = 0; n < 2; ++n) acc[a][b][m][n] = (f32x4){0.f, 0.f, 0.f, 0.f};
        cur = nxt; cA = nA; cB = nB; ++ui;
    }
    PG8_WAIT_V(0);
    if (wr == 0) PG8_BAR;
    PG8_BAR;
    if constexpr (Epi::AFTER_DRAIN) { E.fused(acc, cur, wr, wc, fr, fq, lds, wid, lane); S.done(cur); }
    PG8_STAMP();
    if (STAMP && wid == 0) { stamps[lane] = lane < nts ? (((unsigned long long)(unsigned)ts_hi << 32) | (unsigned)ts_lo) : 0ull;
        if (lane == 62) stamps[62] = rt_entry; if (lane == 63) stamps[63] = (unsigned long long)wall_clock64(); }
#undef PG8_STAMP
#undef PG8_SA
#undef PG8_SB
#undef PG8_STAGE
#undef PG8_LDA
#undef PG8_LDB
#undef PG8_MMA
#undef PG8_WAIT_V
#undef PG8_WAIT_L
#undef PG8_BAR
#undef PG8_SCHED
}
}

namespace pg8 {
struct PanelOrder {
    int pm, nN;
    __device__ void init(int pm_, int N) { pm = pm_; nN = N / BM; }
    __device__ bool next(int i, Unit& u) const { if (i >= nN) return false; u.pm = pm; u.pn = i; return true; }
    __device__ __forceinline__ void a_ready(const Unit&) const {}
    __device__ __forceinline__ void done(const Unit&) const {}
};
}
template <class Epi> __device__ __forceinline__ void ph_gemm_panel(const bf16_t* A, const bf16_t* Bt, int M, int N, int K, const Epi& E, int pm) {
    pg8::Gemm g; g.A = A; g.Bt = Bt; g.M = M; g.N = N; g.K = K;
    pg8::PanelOrder S; S.init(pm, N);
    pg8::gemm_phase<Epi, pg8::PanelOrder, false>((PG8_LAS unsigned char*)dynsmem, g, S, E, nullptr, tid_());
}
template <class Epi> __device__ __forceinline__ void ph_gemm(const bf16_t* A, const bf16_t* Bt, int M, int N, int K, const Epi& E, int crot = 0) {
    pg8::Gemm g; g.A = A; g.Bt = Bt; g.M = M; g.N = N; g.K = K;
    const int nb_ = nblk_();
    pg8::StaticOrder S; S.init(M, N, nb_, (bid_() + nb_ - crot) % nb_);
    pg8::gemm_phase<Epi, pg8::StaticOrder, false>((PG8_LAS unsigned char*)dynsmem, g, S, E, nullptr, tid_());
}

__device__ __forceinline__ int pcol_to_orig(int c) {
    if (c < 768) return c;
    if (c < 1536) return c - 768 + 772;
    if (c < 1792) return c - 1536 + 1548;
    if (c < 1920) return c - 1792 + 1804;
    if (c < 2048) return c - 1920 + 1932;
    if (c < 2304) return c - 2048 + 2060;
    if (c < 2560) return c - 2304 + 2332;
    if (c < 2816) return c - 2560 + 2588;
    if (c < 2880) return c - 2816 + 2844;
    if (c < 2944) return c - 2880 + 2908;
    if (c < 3200) return c - 2944 + 2972;
    if (c < 3232) return c - 3200 + 3228;
    if (c < 3248) return c - 3232 + 2316;
    if (c < 3256) return c - 3248 + 3260;
    if (c < 3260) return c - 3256 + 768;
    if (c < 3264) return c - 3260 + 1540;
    if (c < 3268) return c - 3264 + 1544;
    return -1;
}
__device__ __forceinline__ void wtrans_job(const float* W, int K, int ldw, bf16_t* Wt, int Npad, bool mapped, float* tile) {
    const int tid = tid_();
    const int tn = Npad / 64, tk = K / 64;
    for (int t = bid_(); t < tn * tk; t += nblk_()) {
        const int n0 = (t / tk) * 64, k0 = (t % tk) * 64;
        __syncthreads();
        for (int idx = tid; idx < 4096; idx += 512) {
            const int kk = idx >> 6, nn = idx & 63;
            const int col = mapped ? pcol_to_orig(n0 + nn) : (n0 + nn);
            tile[kk * 65 + nn] = col >= 0 ? W[(size_t)(k0 + kk) * ldw + col] : 0.f;
        }
        __syncthreads();
        for (int idx = tid; idx < 4096; idx += 512) {
            const int nn = idx >> 6, kk = idx & 63;
            Wt[(size_t)(n0 + nn) * K + k0 + kk] = f2bf(tile[kk * 65 + nn]);
        }
    }
}
__device__ __forceinline__ void ph_weight_prep(const Ctx& p, float* sm) {
#pragma unroll 1
    for (int j = 0; j < 7 * DEPTH; ++j) {
        const int l = j / 7, w = j % 7;
        const float* W; int K, ldw, Npad; bf16_t* Wt; bool mapped = false;
        if (w == 0) { W = pin_(3) + (size_t)l * DM * 3268; K = DM; ldw = 3268; Npad = LDP; Wt = (bf16_t*)(pws_() + WT_IN) + (size_t)l * LDP * DM; mapped = true; }
        else if (w == 1) { W = pin_(20) + (size_t)l * DM * DM; K = DM; ldw = DM; Npad = DM; Wt = (bf16_t*)(pws_() + WT_OUT) + (size_t)l * DM * DM; }
        else if (w == 2) { W = pin_(23) + (size_t)l * DM * 256; K = DM; ldw = 256; Npad = 256; Wt = (bf16_t*)(pws_() + WT_XQ) + (size_t)l * 256 * DM; }
        else if (w == 3) { W = pin_(24) + (size_t)l * DM * 256; K = DM; ldw = 256; Npad = 256; Wt = (bf16_t*)(pws_() + WT_XK) + (size_t)l * 256 * DM; }
        else if (w == 4) { W = pin_(25) + (size_t)l * DM * 256; K = DM; ldw = 256; Npad = 256; Wt = (bf16_t*)(pws_() + WT_XV) + (size_t)l * 256 * DM; }
        else if (w == 5) { W = pin_(26) + (size_t)l * 256 * DM; K = 256; ldw = DM; Npad = DM; Wt = (bf16_t*)(pws_() + WT_XO) + (size_t)l * DM * 256; }
        else { W = pin_(30) + (size_t)l * DM * DM; K = DM; ldw = DM; Npad = DM; Wt = (bf16_t*)(pws_() + WT_PQ) + (size_t)l * DM * DM; }
        wtrans_job(W, K, ldw, Wt, Npad, mapped, sm);
    }
}

__device__ __forceinline__ void ph_rmsnorm(const float* __restrict__ x, const float* __restrict__ g, bf16_t* __restrict__ out, int rows, int row0 = 0, int w0 = -1, int wstep = 0) {
    const int lane = tid_() & 63;
    if (w0 < 0) { w0 = gwave(); wstep = nwaves(); }
    for (int r = row0 + w0; r < row0 + rows; r += wstep) {
        const float4* xr = (const float4*)(x + (size_t)r * DM);
        float4 v[4]; float ss = 0.f;
#pragma unroll
        for (int i = 0; i < 4; ++i) { v[i] = xr[lane + 64 * i]; ss += v[i].x * v[i].x + v[i].y * v[i].y + v[i].z * v[i].z + v[i].w * v[i].w; }
        ss = wave_sum(ss);
        const float rs = rsqrtf(ss * (1.f / DM) + EPS);
#pragma unroll
        for (int i = 0; i < 4; ++i) {
            const float4 gg = ((const float4*)g)[lane + 64 * i];
            ushort4 o; o.x = f2bf(v[i].x * rs * gg.x); o.y = f2bf(v[i].y * rs * gg.y); o.z = f2bf(v[i].z * rs * gg.z); o.w = f2bf(v[i].w * rs * gg.w);
            *(ushort4*)(out + (size_t)r * DM + (size_t)(lane + 64 * i) * 4) = o;
        }
    }
}

template <int OUTMODE>
__device__ __forceinline__ void ph_sgemm(const bf16_t* __restrict__ A, int lda, const float* __restrict__ B, int ldb, void* Cv, int ldc, const float* R, int ldr,
                         int M, int N, int K, float* smem) {
    float* As = smem;
    float* Bs = smem + 16 * 132;
    const int tid = tid_(), tx = tid & 31, ty = tid >> 5;
    const int ntn = N / 128, ntiles = (M / 128) * ntn;
    for (int tile = bid_(); tile < ntiles; tile += nblk_()) {
        const int tm = tile / ntn, tn = tile % ntn;
        float acc[8][4];
#pragma unroll
        for (int i = 0; i < 8; ++i)
#pragma unroll
            for (int j = 0; j < 4; ++j) acc[i][j] = 0.f;
        const int arow = tid >> 2, akq = (tid & 3) * 4;
        const int bk = tid >> 5, bn = (tid & 31) * 4;
        for (int k0 = 0; k0 < K; k0 += 16) {
            const ushort4 av = *(const ushort4*)(A + (size_t)(tm * 128 + arow) * lda + k0 + akq);
            const float4 bv = *(const float4*)(B + (size_t)(k0 + bk) * ldb + tn * 128 + bn);
            __syncthreads();
            As[(akq + 0) * 132 + arow] = bf2f(av.x); As[(akq + 1) * 132 + arow] = bf2f(av.y);
            As[(akq + 2) * 132 + arow] = bf2f(av.z); As[(akq + 3) * 132 + arow] = bf2f(av.w);
            *(float4*)(Bs + bk * 132 + bn) = bv;
            __syncthreads();
#pragma unroll
            for (int k = 0; k < 16; ++k) {
                const float4 a0 = *(const float4*)(As + k * 132 + ty * 8), a1 = *(const float4*)(As + k * 132 + ty * 8 + 4);
                const float4 b = *(const float4*)(Bs + k * 132 + tx * 4);
                const float a[8] = {a0.x, a0.y, a0.z, a0.w, a1.x, a1.y, a1.z, a1.w};
#pragma unroll
                for (int i = 0; i < 8; ++i) { acc[i][0] += a[i] * b.x; acc[i][1] += a[i] * b.y; acc[i][2] += a[i] * b.z; acc[i][3] += a[i] * b.w; }
            }
        }
#pragma unroll
        for (int i = 0; i < 8; ++i) {
            const size_t row = (size_t)tm * 128 + ty * 8 + i; const int col = tn * 128 + tx * 4;
            if (OUTMODE == 0) {
                ushort4 o; o.x = f2bf(acc[i][0]); o.y = f2bf(acc[i][1]); o.z = f2bf(acc[i][2]); o.w = f2bf(acc[i][3]);
                *(ushort4*)((bf16_t*)Cv + row * ldc + col) = o;
            } else if (OUTMODE == 1) {
                *(float4*)((float*)Cv + row * ldc + col) = make_float4(acc[i][0], acc[i][1], acc[i][2], acc[i][3]);
            } else {
                const float4 r = *(const float4*)(R + row * ldr + col);
                *(float4*)((float*)Cv + row * ldc + col) = make_float4(r.x + acc[i][0], r.y + acc[i][1], r.z + acc[i][2], r.w + acc[i][3]);
            }
        }
    }
}

#define WS_HS WS_H
#define WS_VG WS_YPRE
#define WS_DEC (WS_YPRE + (size_t)MTOK * 256 * 2)

__device__ __forceinline__ float quad_sum(float v) {
    v += __int_as_float(__builtin_amdgcn_mov_dpp(__float_as_int(v), 0xB1, 0xF, 0xF, true));
    v += __int_as_float(__builtin_amdgcn_mov_dpp(__float_as_int(v), 0x4E, 0xF, 0xF, true));
    return v;
}
__device__ __forceinline__ float bflo(unsigned w) { return __uint_as_float(w << 16); }
__device__ __forceinline__ float bfhi(unsigned w) { return __uint_as_float(w & 0xffff0000u); }

__device__ __forceinline__ float oct_sum(float v) {
    v += __int_as_float(__builtin_amdgcn_mov_dpp(__float_as_int(v), 0xB1, 0xF, 0xF, true));
    v += __int_as_float(__builtin_amdgcn_mov_dpp(__float_as_int(v), 0x4E, 0xF, 0xF, true));
    v += __int_as_float(__builtin_amdgcn_mov_dpp(__float_as_int(v), 0x141, 0xF, 0xF, true));
    return v;
}
__device__ __forceinline__ void unpack8(const uint4 r, float (&o)[8]) {
    o[0] = bflo(r.x); o[1] = bfhi(r.x); o[2] = bflo(r.y); o[3] = bfhi(r.y); o[4] = bflo(r.z); o[5] = bfhi(r.z); o[6] = bflo(r.w); o[7] = bfhi(r.w);
}
__device__ __forceinline__ uint4 pack8(const float (&v)[8]) {
    uint4 o; o.x = pk_bf16(v[0], v[1]); o.y = pk_bf16(v[2], v[3]); o.z = pk_bf16(v[4], v[5]); o.w = pk_bf16(v[6], v[7]); return o;
}
__device__ __forceinline__ void load8f(const float* p, float (&o)[8]) {
    const float4 a = *(const float4*)p, b = *(const float4*)(p + 4);
    o[0] = a.x; o[1] = a.y; o[2] = a.z; o[3] = a.w; o[4] = b.x; o[5] = b.y; o[6] = b.z; o[7] = b.w;
}
__device__ __forceinline__ void conv8(const bf16_t* P, size_t tok, int t, int pcol, const float* w, int ldw, int cc, float (&acc)[8]) {
#pragma unroll
    for (int j = 0; j < 4; ++j) {
        if (t - 3 + j >= 0) {
            float xv[8], wv[8];
            unpack8(*(const uint4*)(P + (tok - (size_t)(3 - j)) * LDP + pcol), xv);
            load8f(w + j * ldw + cc, wv);
#pragma unroll
            for (int i = 0; i < 8; ++i) acc[i] = __builtin_fmaf(wv[i], xv[i], acc[i]);
        }
    }
}
__device__ __forceinline__ void conv8r(const uint4 (&xt)[4], int t, const float* w, int ldw, int cc, float (&acc)[8]) {
#pragma unroll
    for (int j = 0; j < 4; ++j) {
        float xv[8], wv[8];
        unpack8(xt[j], xv);
        load8f(w + j * ldw + cc, wv);
        const float m = (t - 3 + j >= 0) ? 1.f : 0.f;
#pragma unroll
        for (int i = 0; i < 8; ++i) acc[i] = __builtin_fmaf(wv[i] * m, xv[i], acc[i]);
    }
}
__device__ __forceinline__ void ph_scan_prep(const Ctx& p, int l) {
    const bf16_t* P = (const bf16_t*)(pws_() + WS_P);
    bf16_t* HS = (bf16_t*)(pws_() + WS_HS);
    bf16_t* VG = (bf16_t*)(pws_() + WS_VG);
    float* DEC = (float*)(pws_() + WS_DEC);
    float* SC = (float*)(pws_() + WS_SC);
    const float* scw = pin_(4) + (size_t)l * 4 * 512;
    const float* scb = pin_(5) + (size_t)l * 512;
    const float* gcw = pin_(10) + (size_t)l * 4 * 768;
    const float* wg = pin_(14) + (size_t)l * 16 * 128;
    const float* bg = pin_(15) + (size_t)l * 128;
    const int lane = tid_() & 63;
    const int hsc = lane & 3, wsc = (lane >> 2) & 3;
    const float k_dtb = pin_(6)[l * 4 + hsc], k_alog = __expf(pin_(7)[l * 4 + hsc]), k_galog = __expf(pin_(11)[l * 4 + hsc]), k_gdtb = pin_(12)[l * 4 + hsc];
    const int sccol = wsc < 2 ? PC_DT + hsc : (wsc == 2 ? PC_GA + hsc : PC_GB + hsc);
    for (int tok = gwave(); tok < MTOK; tok += nwaves()) {
        const int t = tok % SEQ;
        const size_t row = (size_t)tok * LDP;
        uint4 xa[4], xq[4], xv4[4];
#pragma unroll
        for (int j = 0; j < 4; ++j) {
            const size_t rj = (t - 3 + j >= 0) ? row - (size_t)(3 - j) * LDP : row;
            xa[j] = *(const uint4*)(P + rj + PC_XBC + 8 * lane);
            xq[j] = *(const uint4*)(P + rj + PC_GQKV + 8 * lane);
            xv4[j] = *(const uint4*)(P + rj + PC_GQKV + 512 + 8 * (lane & 31));
        }
        const uint4 gl0 = *(const uint4*)(P + row + PC_GLR), gl1 = *(const uint4*)(P + row + PC_GLR + 8);
        const float scraw = bf2f(P[row + sccol]);
        {
            float acc[8];
            load8f(scb + 8 * lane, acc);
            conv8r(xa, t, scw, 512, 8 * lane, acc);
#pragma unroll
            for (int i = 0; i < 8; ++i) acc[i] = silu_f(acc[i]);
            *(uint4*)(HS + (size_t)tok * 1024 + 8 * lane) = pack8(acc);
        }
        {
            float acc[8];
#pragma unroll
            for (int i = 0; i < 8; ++i) acc[i] = 0.f;
            conv8r(xq, t, gcw, 768, 8 * lane, acc);
            float ss = 0.f;
#pragma unroll
            for (int i = 0; i < 8; ++i) { acc[i] = silu_f(acc[i]); ss += acc[i] * acc[i]; }
            ss = oct_sum(ss);
            const float sc = rsqrtf(ss + EPS) * (lane < 32 ? 0.125f : 1.f);
#pragma unroll
            for (int i = 0; i < 8; ++i) acc[i] *= sc;
            *(uint4*)(HS + (size_t)tok * 1024 + 512 + 8 * lane) = pack8(acc);
        }
        {
            float acc[8];
#pragma unroll
            for (int i = 0; i < 8; ++i) acc[i] = 0.f;
            conv8r(xv4, t, gcw, 768, 512 + 8 * (lane & 31), acc);
#pragma unroll
            for (int i = 0; i < 8; ++i) acc[i] = silu_f(acc[i]);
            if (lane < 32) *(uint4*)(VG + (size_t)tok * 256 + 8 * lane) = pack8(acc);
        }
        {
            float v;
            if (wsc < 2) { const float dt = softplus_f(scraw + k_dtb); v = wsc == 0 ? dt : __expf(-dt * k_alog); }
            else if (wsc == 2) v = __expf(-k_galog * softplus_f(scraw + k_gdtb));
            else v = sigmoid_f(scraw);
            if (lane < 16) SC[(size_t)tok * 16 + lane] = v;
        }
        {
            float gl[16];
            { float a8[8], b8[8]; unpack8(gl0, a8); unpack8(gl1, b8);
#pragma unroll
              for (int i = 0; i < 8; ++i) { gl[i] = a8[i]; gl[8 + i] = b8[i]; } }
#pragma unroll
            for (int i = 0; i < 2; ++i) {
                const int c = lane + 64 * i;
                float acc = bg[c];
#pragma unroll
                for (int r = 0; r < 16; ++r) acc = __builtin_fmaf(gl[r], wg[r * 128 + c], acc);
                DEC[(size_t)tok * 128 + c] = __expf(logsigmoid_f(acc) * (1.f / 16.f));
            }
        }
    }
}

#define SCAN_LDS_WAVE 4608
typedef float f2_t __attribute__((ext_vector_type(2)));
__device__ __forceinline__ f2_t mk2(float a, float b) { f2_t r; r.x = a; r.y = b; return r; }
__device__ __forceinline__ void st8f(char* dst, const uint4 v) {
    *(float4*)dst = make_float4(bflo(v.x), bfhi(v.x), bflo(v.y), bfhi(v.y));
    *(float4*)(dst + 16) = make_float4(bflo(v.z), bfhi(v.z), bflo(v.w), bfhi(v.w));
}
__device__ __forceinline__ void ph_scans(const Ctx& p, int l, float* smem) {
    const bf16_t* P = (const bf16_t*)(pws_() + WS_P);
    const bf16_t* HS = (const bf16_t*)(pws_() + WS_HS);
    const bf16_t* VG = (const bf16_t*)(pws_() + WS_VG);
    const float* DEC = (const float*)(pws_() + WS_DEC);
    const float* SC = (const float*)(pws_() + WS_SC);
    bf16_t* Y = (bf16_t*)(pws_() + WS_Y);
    const int tid = tid_(), lane = tid & 63, wave = tid >> 6;
    if (nblk_() != 256) return;
    const int role = wave < 2 ? 0 : (wave < 6 ? 1 : 2);
    const int idx = (role == 0 ? wave : (role == 1 ? wave - 2 : wave - 6)) * 256 + bid_();
    const int bh = role == 1 ? (idx >> 3) : (idx >> 2), b = bh >> 2, h = bh & 3;
    const int colbase = role == 1 ? (idx & 7) * 8 : (idx & 3) * 16;
    const int cl = role == 1 ? (lane >> 3) : (lane >> 2);
    const int col = colbase + cl;
    const int sq = role == 1 ? (lane & 7) : (lane & 3);
    const size_t tb = (size_t)b * SEQ;
    bf16_t* dummy = (bf16_t*)(pws_() + WS_DUMMY) + (tid & 511) * 8;
    char* lw = (char*)smem + wave * SCAN_LDS_WAVE;
    char* lrow = lw;
    char* lcol = lw + 4096;
    float* lsc = (float*)(lw + 4352);
    const int fs = lane >> 3, fp = lane & 7;
    if (role == 0) {
        const int g = h >> 1;
        const float Dh = pin_(8)[l * 4 + h];
        uint4 f0, f1; unsigned fc = 0u; float fsc = 0.f;
        f2_t st[8];
#pragma unroll
        for (int i = 0; i < 8; ++i) st[i] = mk2(0.f, 0.f);
        auto fetch = [&](int t0) {
            const size_t tok = tb + t0 + fs;
            const bf16_t* src = HS + tok * 1024 + (fp < 4 ? 256 + g * 64 + fp * 16 : 384 + g * 64 + (fp - 4) * 16);
            f0 = *(const uint4*)src; f1 = *(const uint4*)(src + 8);
            fc = *(const unsigned*)(HS + tok * 1024 + h * 64 + colbase + fp * 2);
            if (lane < 16) fsc = SC[(tb + t0 + (lane >> 1)) * 16 + (lane & 1) * 4 + h];
        };
        fetch(0);
        for (int t0 = 0; t0 < SEQ; t0 += 8) {
            st8f(lrow + fs * 512 + fp * 64, f0); st8f(lrow + fs * 512 + fp * 64 + 32, f1);
            *(unsigned*)(lcol + fs * 32 + fp * 4) = fc;
            if (lane < 16) lsc[lane] = fsc;
            if (t0 + 8 < SEQ) fetch(t0 + 8);
#pragma unroll
            for (int i = 0; i < 8; ++i) {
                const char* rb = lrow + i * 512 + sq * 64;
                const float4 b0 = *(const float4*)rb, b1 = *(const float4*)(rb + 16), b2 = *(const float4*)(rb + 32), b3 = *(const float4*)(rb + 48);
                const float4 c0 = *(const float4*)(rb + 256), c1 = *(const float4*)(rb + 272), c2 = *(const float4*)(rb + 288), c3 = *(const float4*)(rb + 304);
                const float xv = bf2f(*(const bf16_t*)(lcol + i * 32 + cl * 2));
                const float2 sc2 = *(const float2*)(lsc + i * 2);
                const float xdt = xv * sc2.x;
                const f2_t xd2 = mk2(xdt, xdt), dA2 = mk2(sc2.y, sc2.y);
                const f2_t bb[8] = {mk2(b0.x, b0.y), mk2(b0.z, b0.w), mk2(b1.x, b1.y), mk2(b1.z, b1.w), mk2(b2.x, b2.y), mk2(b2.z, b2.w), mk2(b3.x, b3.y), mk2(b3.z, b3.w)};
                const f2_t cc[8] = {mk2(c0.x, c0.y), mk2(c0.z, c0.w), mk2(c1.x, c1.y), mk2(c1.z, c1.w), mk2(c2.x, c2.y), mk2(c2.z, c2.w), mk2(c3.x, c3.y), mk2(c3.z, c3.w)};
                f2_t ya = mk2(0.f, 0.f), yb = mk2(0.f, 0.f);
#pragma unroll
                for (int q = 0; q < 8; q += 2) {
                    st[q] = st[q] * dA2 + xd2 * bb[q]; st[q + 1] = st[q + 1] * dA2 + xd2 * bb[q + 1];
                    ya = cc[q] * st[q] + ya; yb = cc[q + 1] * st[q + 1] + yb;
                }
                const f2_t ys = ya + yb;
                const float y = quad_sum(ys.x + ys.y);
                *(sq == 0 ? Y + (tb + t0 + i) * DM + h * 64 + col : dummy + i) = f2bf(y + Dh * xv);
                if (i & 1) __builtin_amdgcn_sched_barrier(0);
            }
        }
    } else if (role == 1) {
        uint4 f0, f1; unsigned fc = 0u; float fsc = 0.f;
        f2_t S[4];
#pragma unroll
        for (int i = 0; i < 4; ++i) S[i] = mk2(0.f, 0.f);
        auto fetch = [&](int t0) {
            const size_t tok = tb + t0 + fs;
            const bf16_t* src = HS + tok * 1024 + (fp < 4 ? 512 + h * 64 + fp * 16 : 768 + h * 64 + (fp - 4) * 16);
            f0 = *(const uint4*)src; f1 = *(const uint4*)(src + 8);
            if (fp < 4) fc = *(const unsigned*)(VG + tok * 256 + h * 64 + colbase + fp * 2);
            if (lane < 16) fsc = SC[(tb + t0 + (lane >> 1)) * 16 + 8 + (lane & 1) * 4 + h];
        };
        fetch(0);
        for (int t0 = 0; t0 < SEQ; t0 += 8) {
            st8f(lrow + fs * 512 + fp * 64, f0); st8f(lrow + fs * 512 + fp * 64 + 32, f1);
            if (fp < 4) *(unsigned*)(lcol + fs * 32 + fp * 4) = fc;
            if (lane < 16) lsc[lane] = fsc;
            if (t0 + 8 < SEQ) fetch(t0 + 8);
#pragma unroll
            for (int i = 0; i < 8; ++i) {
                const char* rb = lrow + i * 512 + sq * 32;
                const float4 q0 = *(const float4*)rb, q1 = *(const float4*)(rb + 16);
                const float4 k0 = *(const float4*)(rb + 256), k1 = *(const float4*)(rb + 272);
                const float vv = bf2f(*(const bf16_t*)(lcol + i * 32 + cl * 2));
                const float2 sc2 = *(const float2*)(lsc + i * 2);
                const f2_t al2 = mk2(sc2.x, sc2.x);
                const f2_t kk[4] = {mk2(k0.x, k0.y), mk2(k0.z, k0.w), mk2(k1.x, k1.y), mk2(k1.z, k1.w)};
                const f2_t qq[4] = {mk2(q0.x, q0.y), mk2(q0.z, q0.w), mk2(q1.x, q1.y), mk2(q1.z, q1.w)};
                f2_t ra = mk2(0.f, 0.f), rb2 = mk2(0.f, 0.f);
#pragma unroll
                for (int q = 0; q < 4; q += 2) {
                    S[q] = S[q] * al2; S[q + 1] = S[q + 1] * al2;
                    ra = S[q] * kk[q] + ra; rb2 = S[q + 1] * kk[q + 1] + rb2;
                }
                const f2_t rs = ra + rb2;
                const float r = oct_sum(rs.x + rs.y);
                const float vn = sc2.y * (vv - r);
                const f2_t vn2 = mk2(vn, vn);
                f2_t oa2 = mk2(0.f, 0.f), ob2 = mk2(0.f, 0.f);
#pragma unroll
                for (int q = 0; q < 4; q += 2) {
                    S[q] = kk[q] * vn2 + S[q]; S[q + 1] = kk[q + 1] * vn2 + S[q + 1];
                    oa2 = S[q] * qq[q] + oa2; ob2 = S[q + 1] * qq[q + 1] + ob2;
                }
                const f2_t os = oa2 + ob2;
                const float ov = oct_sum(os.x + os.y);
                *(sq == 0 ? Y + (tb + t0 + i) * DM + 256 + h * 64 + col : dummy + i) = f2bf(ov);
                if (i & 1) __builtin_amdgcn_sched_barrier(0);
            }
        }
    } else {
        uint4 f0, f1; unsigned fc = 0u;
        f2_t S[4];
#pragma unroll
        for (int i = 0; i < 4; ++i) S[i] = mk2(0.f, 0.f);
        auto fetch = [&](int t0) {
            const size_t tok = tb + t0 + fs;
            if (fp < 4) { const float* src = DEC + tok * 128 + h * 32 + fp * 8; f0 = *(const uint4*)src; f1 = *(const uint4*)(src + 4); }
            else { const bf16_t* src = P + tok * LDP + (fp < 6 ? PC_LK + h * 32 + (fp - 4) * 16 : PC_LQ + h * 32 + (fp - 6) * 16); f0 = *(const uint4*)src; f1 = *(const uint4*)(src + 8); }
            fc = *(const unsigned*)(P + tok * LDP + PC_LV + h * 64 + colbase + fp * 2);
        };
        fetch(0);
        for (int t0 = 0; t0 < SEQ; t0 += 8) {
            if (fp < 4) { *(uint4*)(lrow + fs * 512 + fp * 32) = f0; *(uint4*)(lrow + fs * 512 + fp * 32 + 16) = f1; }
            else { st8f(lrow + fs * 512 + 128 + (fp - 4) * 64, f0); st8f(lrow + fs * 512 + 128 + (fp - 4) * 64 + 32, f1); }
            *(unsigned*)(lcol + fs * 32 + fp * 4) = fc;
            if (t0 + 8 < SEQ) fetch(t0 + 8);
#pragma unroll
            for (int i = 0; i < 8; ++i) {
                const char* rb = lrow + i * 512 + sq * 32;
                const float4 d0 = *(const float4*)rb, d1 = *(const float4*)(rb + 16);
                const float4 k0 = *(const float4*)(rb + 128), k1 = *(const float4*)(rb + 144);
                const float4 q0 = *(const float4*)(rb + 256), q1 = *(const float4*)(rb + 272);
                const float vv = bf2f(*(const bf16_t*)(lcol + i * 32 + cl * 2));
                const f2_t v2 = mk2(vv, vv);
                const f2_t dd[4] = {mk2(d0.x, d0.y), mk2(d0.z, d0.w), mk2(d1.x, d1.y), mk2(d1.z, d1.w)};
                const f2_t kk[4] = {mk2(k0.x, k0.y), mk2(k0.z, k0.w), mk2(k1.x, k1.y), mk2(k1.z, k1.w)};
                const f2_t qq[4] = {mk2(q0.x, q0.y), mk2(q0.z, q0.w), mk2(q1.x, q1.y), mk2(q1.z, q1.w)};
                f2_t oa2 = mk2(0.f, 0.f), ob2 = mk2(0.f, 0.f);
#pragma unroll
                for (int q = 0; q < 4; q += 2) {
                    S[q] = dd[q] * S[q] + kk[q] * v2; S[q + 1] = dd[q + 1] * S[q + 1] + kk[q + 1] * v2;
                    oa2 = S[q] * qq[q] + oa2; ob2 = S[q + 1] * qq[q + 1] + ob2;
                }
                const f2_t os = oa2 + ob2;
                const float ov = quad_sum(os.x + os.y);
                *(sq == 0 ? Y + (tb + t0 + i) * DM + 512 + h * 64 + col : dummy + i) = f2bf(ov * 0.17677669529663687f);
                if (i & 1) __builtin_amdgcn_sched_barrier(0);
            }
        }
    }
}

__device__ __forceinline__ void ph_mixer_finish(const Ctx& p, int l) {
    const bf16_t* P = (const bf16_t*)(pws_() + WS_P);
    bf16_t* Y = (bf16_t*)(pws_() + WS_Y);
    const float* sn = pin_(9) + (size_t)l * 256;
    const float* gn = pin_(13) + (size_t)l * 64;
    const float* ln = pin_(16) + (size_t)l * 64;
    const int lane = tid_() & 63;
    for (int tok = gwave(); tok < MTOK; tok += nwaves()) {
        const size_t row = (size_t)tok * LDP;
        {
            float v[8], gt[8], gw[8];
            unpack8(*(const uint4*)(Y + (size_t)tok * DM + 8 * lane), v);
            unpack8(*(const uint4*)(P + row + (lane < 32 ? PC_Z + 8 * lane : PC_GG + 8 * (lane - 32))), gt);
            load8f(lane < 32 ? sn + 8 * lane : gn + 8 * (lane & 7), gw);
            float ss = 0.f;
            if (lane < 32) {
#pragma unroll
                for (int i = 0; i < 8; ++i) { v[i] *= silu_f(gt[i]); ss += v[i] * v[i]; }
            } else {
#pragma unroll
                for (int i = 0; i < 8; ++i) ss += v[i] * v[i];
            }
            const float s8 = oct_sum(ss);
            float s32 = s8 + __int_as_float(__builtin_amdgcn_mov_dpp(__float_as_int(s8), 0x140, 0xF, 0xF, true));
            s32 += __shfl_xor(s32, 16, 64);
            const float rs = lane < 32 ? rsqrtf(s32 * (1.f / 256.f) + EPS) : rsqrtf(s8 * (1.f / 64.f) + EPS);
            float o[8];
#pragma unroll
            for (int i = 0; i < 8; ++i) o[i] = lane < 32 ? v[i] * rs * gw[i] : v[i] * rs * gw[i] * silu_f(gt[i]);
            *(uint4*)(Y + (size_t)tok * DM + 8 * lane) = pack8(o);
        }
        if (lane < 32) {
            float v[8], gt[8], gw[8];
            unpack8(*(const uint4*)(Y + (size_t)tok * DM + 512 + 8 * lane), v);
            unpack8(*(const uint4*)(P + row + PC_LR + 8 * lane), gt);
            load8f(ln + 8 * (lane & 7), gw);
            float ss = 0.f;
#pragma unroll
            for (int i = 0; i < 8; ++i) ss += v[i] * v[i];
            const float rs = rsqrtf(oct_sum(ss) * (1.f / 64.f) + EPS);
            float o[8];
#pragma unroll
            for (int i = 0; i < 8; ++i) o[i] = v[i] * rs * gw[i] * silu_f(gt[i]);
            *(uint4*)(Y + (size_t)tok * DM + 512 + 8 * lane) = pack8(o);
        }
    }
}

typedef short bf16x8_t __attribute__((ext_vector_type(8)));
typedef float f32x4_t __attribute__((ext_vector_type(4)));
union BF8 { bf16x8_t v; uint4 u; unsigned w[4]; };


__device__ __forceinline__ void ph_dsa_prep(const Ctx& p, int l) {
    const bf16_t* P = (const bf16_t*)(pws_() + WS_P);
    bf16_t* qn = (bf16_t*)(pws_() + WS_QN);
    bf16_t* kn = (bf16_t*)(pws_() + WS_KN);
    bf16_t* ikn = (bf16_t*)(pws_() + WS_IKN);
    bf16_t* vt = (bf16_t*)(pws_() + WS_VT);
    const float* qg = pin_(17) + (size_t)l * 64;
    const float* kg = pin_(18) + (size_t)l * 64;
    const float* ig = pin_(19) + (size_t)l * 32;
    const int lane = tid_() & 63;
    const int pcol = lane < 40 ? PC_DQ + 8 * lane : PC_IK + 8 * (lane & 3);
    float gw[8];
    load8f(lane < 32 ? qg + 8 * (lane & 7) : (lane < 40 ? kg + 8 * (lane & 7) : ig + 8 * (lane & 3)), gw);
    for (int grp = gwave(); grp < MTOK / 8; grp += nwaves()) {
        const size_t tok0 = (size_t)grp * 8;
        const int b = (int)(tok0 / SEQ), t0 = (int)(tok0 % SEQ);
        unsigned short vv[8];
#pragma unroll
        for (int i = 0; i < 8; ++i) {
            const size_t row = (tok0 + i) * LDP;
            vv[i] = P[row + PC_DV + lane];
            if (lane < 44) {
                float v[8];
                unpack8(*(const uint4*)(P + row + pcol), v);
                float ss = 0.f;
#pragma unroll
                for (int q = 0; q < 8; ++q) ss += v[q] * v[q];
                const float s4 = ss + __int_as_float(__builtin_amdgcn_mov_dpp(__float_as_int(ss), 0xB1, 0xF, 0xF, true));
                const float s4b = s4 + __int_as_float(__builtin_amdgcn_mov_dpp(__float_as_int(s4), 0x4E, 0xF, 0xF, true));
                const float s8 = s4b + __int_as_float(__builtin_amdgcn_mov_dpp(__float_as_int(s4b), 0x141, 0xF, 0xF, true));
                const float rs = lane < 40 ? rsqrtf(s8 * (1.f / 64.f) + EPS) * (lane < 32 ? 0.125f : 1.f) : rsqrtf(s4b * (1.f / 32.f) + EPS);
                float o[8];
#pragma unroll
                for (int q = 0; q < 8; ++q) o[q] = v[q] * rs * gw[q];
                const uint4 pk = pack8(o);
                if (lane < 32) *(uint4*)(qn + (tok0 + i) * 256 + 8 * lane) = pk;
                else if (lane < 40) *(uint4*)(kn + (tok0 + i) * 64 + 8 * (lane - 32)) = pk;
                else *(uint4*)(ikn + (tok0 + i) * 32 + 8 * (lane - 40)) = pk;
            }
        }
        uint4 o; o.x = (unsigned)vv[0] | ((unsigned)vv[1] << 16); o.y = (unsigned)vv[2] | ((unsigned)vv[3] << 16);
        o.z = (unsigned)vv[4] | ((unsigned)vv[5] << 16); o.w = (unsigned)vv[6] | ((unsigned)vv[7] << 16);
        *(uint4*)(vt + ((size_t)b * 64 + lane) * SEQ + t0) = o;
    }
}

#define DSA_STRIDE 2052
__device__ __forceinline__ void ph_dsa_main(const Ctx& p, int l, float* smem) {
    const bf16_t* P = (const bf16_t*)(pws_() + WS_P);
    bf16_t* Y = (bf16_t*)(pws_() + WS_Y);
    const bf16_t* QN = (const bf16_t*)(pws_() + WS_QN);
    const bf16_t* KN = (const bf16_t*)(pws_() + WS_KN);
    const bf16_t* IKN = (const bf16_t*)(pws_() + WS_IKN);
    const bf16_t* VT = (const bf16_t*)(pws_() + WS_VT);
    unsigned* sc = (unsigned*)smem;
    float* part = smem;
    float* plsum = smem + 8 * 64 * 64;
    unsigned* thr = (unsigned*)(smem + 35000);
    const int tid = tid_(), lane = tid & 63, w = tid >> 6, qi = lane & 15, g = lane >> 4;
    for (int task = bid_(); task < MTOK / 16; task += nblk_()) {
        const int c = 31 - task / 128, b = (task >> 2) & 31, sub = task & 3;
        const int t0 = c * 64 + sub * 16, nk = (c + 1) * 64;
        const size_t tok0 = (size_t)b * SEQ + t0;
        const bool dosel = nk > 256;
        if (dosel) {
            BF8 iqf[8]; float wq[8];
#pragma unroll
            for (int h = 0; h < 8; ++h) {
                iqf[h].u = *(const uint4*)(P + (tok0 + qi) * LDP + PC_IQ + h * 32 + 8 * g);
                wq[h] = bf2f(P[(tok0 + qi) * LDP + PC_IW + h]) * 0.0625f;
            }
            for (int kt = w; kt < nk / 16; kt += 8) {
                const int s0 = kt * 16;
                BF8 ka; ka.u = *(const uint4*)(IKN + ((size_t)b * SEQ + s0 + qi) * 32 + 8 * g);
                float acc[4] = {0.f, 0.f, 0.f, 0.f};
#pragma unroll
                for (int h = 0; h < 8; ++h) {
                    const f32x4_t d = __builtin_amdgcn_mfma_f32_16x16x32_bf16(ka.v, iqf[h].v, (f32x4_t){0.f, 0.f, 0.f, 0.f}, 0, 0, 0);
#pragma unroll
                    for (int r = 0; r < 4; ++r) acc[r] = __builtin_fmaf(wq[h], fmaxf(d[r], 0.f), acc[r]);
                }
                uint4 kv; kv.x = ford(acc[0]); kv.y = ford(acc[1]); kv.z = ford(acc[2]); kv.w = ford(acc[3]);
                *(uint4*)(sc + qi * DSA_STRIDE + s0 + 4 * g) = kv;
            }
        }
        __syncthreads();
        if (dosel) {
            const int nj = nk >> 6;
#pragma unroll 1
            for (int qq = 0; qq < 2; ++qq) {
                const int q = 2 * w + qq;
                unsigned kreg[32];
#pragma unroll
                for (int j = 0; j < 32; ++j) kreg[j] = (j < nj) ? sc[q * DSA_STRIDE + j * 64 + lane] : 0u;
                unsigned T = 0u; bool exact = false;
                for (int bit = 31; bit >= 0; --bit) {
                    const unsigned cand = T | (1u << bit);
                    int cnt = 0;
#pragma unroll
                    for (int j = 0; j < 32; ++j) cnt += __popcll(__ballot(kreg[j] >= cand));
                    if (cnt >= 256) { T = cand; if (cnt == 256) { exact = true; break; } }
                }
                int cut = 0x7fffffff;
                if (!exact) {
                    int cgt = 0, ceq = 0;
#pragma unroll
                    for (int j = 0; j < 32; ++j) { cgt += __popcll(__ballot(kreg[j] > T)); ceq += __popcll(__ballot(kreg[j] == T)); }
                    int need = 256 - cgt;
                    if (ceq > need) {
                        bool found = false;
#pragma unroll
                        for (int j = 0; j < 32; ++j) {
                            const unsigned long long m = __ballot(kreg[j] == T);
                            const int cj = __popcll(m);
                            if (!found) {
                                if (need <= cj) { for (int bpos = 0; bpos < 64; ++bpos) if ((m >> bpos) & 1ull) { if (--need == 0) { cut = j * 64 + bpos; break; } } found = true; }
                                else need -= cj;
                            }
                        }
                    }
                }
                if (lane == 0) { thr[q] = T; thr[16 + q] = (unsigned)cut; }
            }
        }
        __syncthreads();
        unsigned Tq = 0u; int cutq = 0x7fffffff;
        if (dosel) { Tq = thr[qi]; cutq = (int)thr[16 + qi]; }
        f32x4_t oacc[4][4]; float lsum[4];
#pragma unroll
        for (int h = 0; h < 4; ++h) { lsum[h] = 0.f;
#pragma unroll
            for (int dt = 0; dt < 4; ++dt) oacc[h][dt] = (f32x4_t){0.f, 0.f, 0.f, 0.f}; }
        const int krow = 8 * (qi >> 2) + (qi & 3);
        for (int st = w; st < nk / 32; st += 8) {
            const int s0 = st * 32;
            BF8 ka[2][2], va[4];
#pragma unroll
            for (int t = 0; t < 2; ++t)
#pragma unroll
                for (int s2 = 0; s2 < 2; ++s2) ka[t][s2].u = *(const uint4*)(KN + ((size_t)b * SEQ + s0 + krow + 4 * t) * 64 + 32 * s2 + 8 * g);
#pragma unroll
            for (int dt = 0; dt < 4; ++dt) va[dt].u = *(const uint4*)(VT + ((size_t)b * 64 + 16 * dt + qi) * SEQ + s0 + 8 * g);
            float mk[8];
            if (dosel) {
                const uint4 k0 = *(const uint4*)(sc + qi * DSA_STRIDE + s0 + 8 * g), k1 = *(const uint4*)(sc + qi * DSA_STRIDE + s0 + 8 * g + 4);
                const unsigned kk[8] = {k0.x, k0.y, k0.z, k0.w, k1.x, k1.y, k1.z, k1.w};
#pragma unroll
                for (int j = 0; j < 8; ++j) mk[j] = (kk[j] > Tq || (kk[j] == Tq && (s0 + 8 * g + j) <= cutq)) ? 1.f : 0.f;
            } else {
#pragma unroll
                for (int j = 0; j < 8; ++j) mk[j] = 1.f;
            }
#pragma unroll
            for (int h = 0; h < 4; ++h) {
                BF8 q0, q1;
                q0.u = *(const uint4*)(QN + (tok0 + qi) * 256 + h * 64 + 8 * g);
                q1.u = *(const uint4*)(QN + (tok0 + qi) * 256 + h * 64 + 32 + 8 * g);
                f32x4_t sacc[2];
#pragma unroll
                for (int t = 0; t < 2; ++t) {
                    sacc[t] = __builtin_amdgcn_mfma_f32_16x16x32_bf16(ka[t][0].v, q0.v, (f32x4_t){0.f, 0.f, 0.f, 0.f}, 0, 0, 0);
                    sacc[t] = __builtin_amdgcn_mfma_f32_16x16x32_bf16(ka[t][1].v, q1.v, sacc[t], 0, 0, 0);
                }
                float pe[8];
#pragma unroll
                for (int t = 0; t < 2; ++t)
#pragma unroll
                    for (int r = 0; r < 4; ++r) { pe[4 * t + r] = __expf(sacc[t][r]) * mk[4 * t + r]; lsum[h] += pe[4 * t + r]; }
                BF8 pf;
#pragma unroll
                for (int j = 0; j < 4; ++j) pf.w[j] = pk_bf16(pe[2 * j], pe[2 * j + 1]);
#pragma unroll
                for (int dt = 0; dt < 4; ++dt) oacc[h][dt] = __builtin_amdgcn_mfma_f32_16x16x32_bf16(va[dt].v, pf.v, oacc[h][dt], 0, 0, 0);
            }
        }
        __syncthreads();
#pragma unroll
        for (int h = 0; h < 4; ++h) {
            plsum[(w * 4 + h) * 64 + lane] = lsum[h];
#pragma unroll
            for (int dt = 0; dt < 4; ++dt)
#pragma unroll
                for (int r = 0; r < 4; ++r) part[(w * 64 + h * 16 + dt * 4 + r) * 64 + lane] = oacc[h][dt][r];
        }
        __syncthreads();
        {
            const int h = w >> 1;
            float lq = 0.f;
#pragma unroll
            for (int w2 = 0; w2 < 8; ++w2)
#pragma unroll
                for (int g2 = 0; g2 < 4; ++g2) lq += plsum[(w2 * 4 + h) * 64 + qi + 16 * g2];
            const float inv = 1.f / lq;
#pragma unroll
            for (int dd = 0; dd < 2; ++dd) {
                const int dt = (w & 1) * 2 + dd;
                float o[4];
#pragma unroll
                for (int r = 0; r < 4; ++r) {
                    float sacc = 0.f;
#pragma unroll
                    for (int w2 = 0; w2 < 8; ++w2) sacc += part[(w2 * 64 + h * 16 + dt * 4 + r) * 64 + lane];
                    o[r] = sacc * inv;
                }
                uint2 ov; ov.x = pk_bf16(o[0], o[1]); ov.y = pk_bf16(o[2], o[3]);
                *(uint2*)(Y + (tok0 + qi) * DM + 768 + h * 64 + 16 * dt + 4 * g) = ov;
            }
        }
        __syncthreads();
    }
}

__device__ __forceinline__ void ph_mem_prep(const Ctx& p, int l) {
    const float* Km = (const float*)(pws_() + WS_KM);
    const float* Vm = (const float*)(pws_() + WS_VM);
    bf16_t* KB = (bf16_t*)(pws_() + WS_KB);
    bf16_t* VTB = (bf16_t*)(pws_() + WS_VTB);
    const float* kg = pin_(28) + (size_t)l * 64;
    const int lane = tid_() & 63;
    for (int r = gwave(); r < MMEM; r += nwaves()) {
        const int b = r / NMEM, j = r % NMEM;
#pragma unroll
        for (int h = 0; h < 4; ++h) {
            const float v = Km[(size_t)r * 256 + h * 64 + lane];
            const float ss = wave_sum(v * v);
            KB[(((size_t)b * 4 + h) * NMEM + j) * 64 + lane] = f2bf(v * rsqrtf(ss * (1.f / 64.f) + EPS) * kg[lane]);
            VTB[(((size_t)b * 4 + h) * 64 + lane) * NMEM + j] = f2bf(Vm[(size_t)r * 256 + h * 64 + lane]);
        }
    }
}
__device__ __forceinline__ void ph_xattn(const Ctx& p, int l, int task0 = 0, int ntask = MTOK / 16, int w0 = -1, int wstep = 0) {
    const float* Qx = (const float*)(pws_() + WS_QX);
    bf16_t* Ox = (bf16_t*)(pws_() + WS_OX);
    const bf16_t* KB = (const bf16_t*)(pws_() + WS_KB);
    const bf16_t* VTB = (const bf16_t*)(pws_() + WS_VTB);
    const float* qg = pin_(27) + (size_t)l * 64;
    const int lane = tid_() & 63, qi = lane & 15, g = lane >> 4;
    if (w0 < 0) { w0 = gwave(); wstep = nwaves(); }
    for (int task = task0 + w0; task < task0 + ntask; task += wstep) {
        const int tok0 = task * 16, b = tok0 / SEQ;
#pragma unroll 1
        for (int h = 0; h < 4; ++h) {
            BF8 qf[2];
            {
                float qv[2][8]; float ss = 0.f;
#pragma unroll
                for (int s2 = 0; s2 < 2; ++s2) {
                    const float4* qp = (const float4*)(Qx + (size_t)(tok0 + qi) * 256 + h * 64 + 32 * s2 + 8 * g);
                    const float4 a = qp[0], c = qp[1];
                    qv[s2][0] = a.x; qv[s2][1] = a.y; qv[s2][2] = a.z; qv[s2][3] = a.w; qv[s2][4] = c.x; qv[s2][5] = c.y; qv[s2][6] = c.z; qv[s2][7] = c.w;
#pragma unroll
                    for (int j = 0; j < 8; ++j) ss += qv[s2][j] * qv[s2][j];
                }
                ss += __shfl_xor(ss, 16, 64); ss += __shfl_xor(ss, 32, 64);
                const float rs = rsqrtf(ss * (1.f / 64.f) + EPS) * 0.125f;
#pragma unroll
                for (int s2 = 0; s2 < 2; ++s2) {
                    const float4 g0 = *(const float4*)(qg + 32 * s2 + 8 * g), g1 = *(const float4*)(qg + 32 * s2 + 8 * g + 4);
                    qf[s2].w[0] = pk_bf16(qv[s2][0] * rs * g0.x, qv[s2][1] * rs * g0.y); qf[s2].w[1] = pk_bf16(qv[s2][2] * rs * g0.z, qv[s2][3] * rs * g0.w);
                    qf[s2].w[2] = pk_bf16(qv[s2][4] * rs * g1.x, qv[s2][5] * rs * g1.y); qf[s2].w[3] = pk_bf16(qv[s2][6] * rs * g1.z, qv[s2][7] * rs * g1.w);
                }
            }
            const bf16_t* Kh = KB + ((size_t)b * 4 + h) * NMEM * 64;
            const bf16_t* Vh = VTB + ((size_t)b * 4 + h) * 64 * NMEM;
            f32x4_t oacc[4];
#pragma unroll
            for (int dt = 0; dt < 4; ++dt) oacc[dt] = (f32x4_t){0.f, 0.f, 0.f, 0.f};
            float lsum = 0.f;
            const int krow = 8 * (qi >> 2) + (qi & 3);
#pragma unroll 2
            for (int s0 = 0; s0 < NMEM; s0 += 32) {
                BF8 ka[2][2], va[4];
#pragma unroll
                for (int t = 0; t < 2; ++t)
#pragma unroll
                    for (int s2 = 0; s2 < 2; ++s2) ka[t][s2].u = *(const uint4*)(Kh + (size_t)(s0 + krow + 4 * t) * 64 + 32 * s2 + 8 * g);
#pragma unroll
                for (int dt = 0; dt < 4; ++dt) va[dt].u = *(const uint4*)(Vh + (size_t)(16 * dt + qi) * NMEM + s0 + 8 * g);
                f32x4_t sacc[2];
#pragma unroll
                for (int t = 0; t < 2; ++t) {
                    sacc[t] = (f32x4_t){0.f, 0.f, 0.f, 0.f};
                    sacc[t] = __builtin_amdgcn_mfma_f32_16x16x32_bf16(ka[t][0].v, qf[0].v, sacc[t], 0, 0, 0);
                    sacc[t] = __builtin_amdgcn_mfma_f32_16x16x32_bf16(ka[t][1].v, qf[1].v, sacc[t], 0, 0, 0);
                }
                float pe[8];
#pragma unroll
                for (int t = 0; t < 2; ++t)
#pragma unroll
                    for (int r = 0; r < 4; ++r) { pe[4 * t + r] = __expf(sacc[t][r]); lsum += pe[4 * t + r]; }
                BF8 pf;
#pragma unroll
                for (int j = 0; j < 4; ++j) pf.w[j] = pk_bf16(pe[2 * j], pe[2 * j + 1]);
#pragma unroll
                for (int dt = 0; dt < 4; ++dt) oacc[dt] = __builtin_amdgcn_mfma_f32_16x16x32_bf16(va[dt].v, pf.v, oacc[dt], 0, 0, 0);
            }
            lsum += __shfl_xor(lsum, 16, 64); lsum += __shfl_xor(lsum, 32, 64);
            const float inv = 1.f / lsum;
#pragma unroll
            for (int dt = 0; dt < 4; ++dt) {
                uint2 o; o.x = pk_bf16(oacc[dt][0] * inv, oacc[dt][1] * inv); o.y = pk_bf16(oacc[dt][2] * inv, oacc[dt][3] * inv);
                *(uint2*)(Ox + (size_t)(tok0 + qi) * 256 + h * 64 + 16 * dt + 4 * g) = o;
            }
        }
    }
}

template <int N> __device__ __forceinline__ void bitonic_sort_desc(unsigned (&a)[N]) {
#pragma unroll
    for (int k = 2; k <= N; k <<= 1)
#pragma unroll
        for (int j = k >> 1; j > 0; j >>= 1)
#pragma unroll
            for (int i = 0; i < N; ++i) {
                const int o = i ^ j;
                if (o > i) {
                    const bool desc = ((i & k) == 0);
                    const unsigned x = a[i], y = a[o];
                    const unsigned mx = x > y ? x : y, mn = x > y ? y : x;
                    a[i] = desc ? mx : mn; a[o] = desc ? mn : mx;
                }
            }
}
__device__ __forceinline__ void bitonic_merge16_desc(unsigned (&a)[16]) {
#pragma unroll
    for (int j = 8; j > 0; j >>= 1)
#pragma unroll
        for (int i = 0; i < 16; ++i) {
            const int o = i ^ j;
            if (o > i) { const unsigned x = a[i], y = a[o]; a[i] = x > y ? x : y; a[o] = x > y ? y : x; }
        }
}
__device__ __forceinline__ void top16_merge(unsigned (&a)[16], const unsigned (&b)[16]) {
#pragma unroll
    for (int i = 0; i < 16; ++i) a[i] = a[i] > b[15 - i] ? a[i] : b[15 - i];
    bitonic_merge16_desc(a);
}
__device__ __forceinline__ void top16_xlane(unsigned (&a)[16], int xm) {
    unsigned b[16];
#pragma unroll
    for (int i = 0; i < 16; ++i) b[i] = (unsigned)__shfl_xor((int)a[i], xm, 64);
    top16_merge(a, b);
}
__device__ __forceinline__ void ph_subkeys_convert(const Ctx& p) {
    const float* sk = pin_(31);
    bf16_t* o = (bf16_t*)(pws_() + WS_SKB);
    const size_t n = (size_t)DEPTH * 8 * 2 * 128 * 64;
    for (size_t i = (size_t)bid_() * 512 + tid_(); i < n; i += (size_t)nblk_() * 512) o[i] = f2bf(sk[i]);
}
__device__ __forceinline__ void ph_peer_topk(const Ctx& p, int l, float* smem, int task0 = 0, int ntask = MTOK / 16, int w0 = -1, int wstep = 0) {
    const bf16_t* Qp = (const bf16_t*)(pws_() + WS_QP);
    const bf16_t* SK = (const bf16_t*)(pws_() + WS_SKB) + (size_t)l * 8 * 2 * 128 * 64;
    int* pidx = (int*)(pws_() + WS_PEI);
    float* pgt = (float*)(pws_() + WS_PEG);
    const int tid = tid_(), lane = tid & 63, wave = tid >> 6, qi = lane & 15, g = lane >> 4;
    int* tabw = (int*)smem + wave * 512 + qi * 32;
    if (w0 < 0) { w0 = gwave(); wstep = nwaves(); }
    for (int task = task0 + w0; task < task0 + ntask; task += wstep) {
        const size_t tok = (size_t)task * 16 + qi;
#pragma unroll 1
        for (int h = 0; h < 8; ++h) {
            unsigned L[2][16];
#pragma unroll
            for (int pp = 0; pp < 2; ++pp) {
                BF8 qf[2];
#pragma unroll
                for (int s2 = 0; s2 < 2; ++s2) qf[s2].u = *(const uint4*)(Qp + tok * DM + h * 128 + pp * 64 + 32 * s2 + 8 * g);
                const bf16_t* skp = SK + (size_t)(h * 2 + pp) * 128 * 64;
                unsigned va[16], vb[16];
#pragma unroll
                for (int tile = 0; tile < 8; ++tile) {
                    BF8 ka[2];
#pragma unroll
                    for (int s2 = 0; s2 < 2; ++s2) ka[s2].u = *(const uint4*)(skp + (size_t)(16 * tile + qi) * 64 + 32 * s2 + 8 * g);
                    f32x4_t d = __builtin_amdgcn_mfma_f32_16x16x32_bf16(ka[0].v, qf[0].v, (f32x4_t){0.f, 0.f, 0.f, 0.f}, 0, 0, 0);
                    d = __builtin_amdgcn_mfma_f32_16x16x32_bf16(ka[1].v, qf[1].v, d, 0, 0, 0);
#pragma unroll
                    for (int r = 0; r < 4; ++r) {
                        const unsigned key = (ford(d[r]) & ~127u) | (unsigned)(127 - (16 * tile + 4 * g + r));
                        if (tile < 4) va[tile * 4 + r] = key; else vb[(tile - 4) * 4 + r] = key;
                    }
                }
                bitonic_sort_desc<16>(va);
                bitonic_sort_desc<16>(vb);
                top16_merge(va, vb);
                top16_xlane(va, 16);
                top16_xlane(va, 32);
#pragma unroll
                for (int i = 0; i < 16; ++i) L[pp][i] = va[i];
            }
            if (g < 2) {
#pragma unroll
                for (int i = 0; i < 16; ++i) tabw[g * 16 + i] = 127 - (int)((g == 0 ? L[0][i] : L[1][i]) & 127u);
            }
            float s1[16], s2v[16];
#pragma unroll
            for (int i = 0; i < 16; ++i) { s1[i] = funord(L[0][i] & ~127u); s2v[i] = funord(L[1][i] & ~127u); }
            unsigned ca[16], cb[16];
#pragma unroll
            for (int i = 0; i < 16; ++i) { ca[i] = 0u; cb[i] = 0u; }
            {
                const float r0 = g == 0 ? s1[0] : (g == 1 ? s1[1] : (g == 2 ? s1[2] : s1[3]));
                const int nb0 = g == 0 ? 16 : (g == 1 ? 8 : (g == 2 ? 5 : 4));
#pragma unroll
                for (int bq = 0; bq < 16; ++bq) if (bq < nb0) ca[bq] = (ford(r0 + s2v[bq]) & ~255u) | (unsigned)(255 - (g * 16 + bq));
                const float r1 = g == 0 ? s1[4] : (g == 1 ? s1[5] : (g == 2 ? s1[6] : s1[7]));
                const int nb1 = g == 0 ? 3 : 2;
#pragma unroll
                for (int bq = 0; bq < 3; ++bq) if (bq < nb1) cb[bq] = (ford(r1 + s2v[bq]) & ~255u) | (unsigned)(255 - ((g + 4) * 16 + bq));
                const float r2 = g == 0 ? s1[8] : (g == 1 ? s1[9] : (g == 2 ? s1[10] : s1[11]));
                cb[3] = (ford(r2 + s2v[0]) & ~255u) | (unsigned)(255 - ((g + 8) * 16));
                const float r3 = g == 0 ? s1[12] : (g == 1 ? s1[13] : (g == 2 ? s1[14] : s1[15]));
                cb[4] = (ford(r3 + s2v[0]) & ~255u) | (unsigned)(255 - ((g + 12) * 16));
            }
            bitonic_sort_desc<16>(ca);
            bitonic_sort_desc<16>(cb);
            top16_merge(ca, cb);
            top16_xlane(ca, 16);
            top16_xlane(ca, 32);
            float tv[16]; float den = 0.f;
#pragma unroll
            for (int i = 0; i < 16; ++i) {
                const int f = 255 - (int)(ca[i] & 255u);
                const int a = f >> 4, bq = f & 15;
                tv[i] = funord(ca[i] & ~255u);
                (void)a; (void)bq;
            }
#pragma unroll
            for (int i = 0; i < 16; ++i) { tv[i] = __expf(tv[i] - funord(ca[0] & ~255u)); den += tv[i]; }
            const float inv = 1.f / den;
            int ev[4]; float gv[4];
#pragma unroll
            for (int r = 0; r < 4; ++r) {
                const unsigned key = g == 0 ? ca[r] : (g == 1 ? ca[4 + r] : (g == 2 ? ca[8 + r] : ca[12 + r]));
                const float tvv = g == 0 ? tv[r] : (g == 1 ? tv[4 + r] : (g == 2 ? tv[8 + r] : tv[12 + r]));
                const int f = 255 - (int)(key & 255u);
                ev[r] = tabw[f >> 4] * 128 + tabw[16 + (f & 15)];
                gv[r] = tvv * inv;
            }
            *(int4*)(pidx + tok * 128 + h * 16 + 4 * g) = make_int4(ev[0], ev[1], ev[2], ev[3]);
            *(float4*)(pgt + tok * 128 + h * 16 + 4 * g) = make_float4(gv[0], gv[1], gv[2], gv[3]);
        }
    }
}

typedef _Float16 h2_t __attribute__((ext_vector_type(2)));
__device__ __forceinline__ h2_t as_h2(unsigned u) { union { unsigned u; h2_t h; } c; c.u = u; return c.h; }
#define U_SCALE 1024.f
#define V_SCALE 256.f
typedef float f32x2_t __attribute__((ext_vector_type(2)));
__device__ __forceinline__ unsigned pack4_fp8(float4 a, float sc) {
    const float x = fminf(fmaxf(a.x * sc, -448.f), 448.f), y = fminf(fmaxf(a.y * sc, -448.f), 448.f);
    const float z = fminf(fmaxf(a.z * sc, -448.f), 448.f), w = fminf(fmaxf(a.w * sc, -448.f), 448.f);
    int r = __builtin_amdgcn_cvt_pk_fp8_f32(x, y, 0, false);
    r = __builtin_amdgcn_cvt_pk_fp8_f32(z, w, r, true);
    return (unsigned)r;
}
__device__ __forceinline__ void ph_tab_convert(const Ctx& p, int l) {
    const float4* u = (const float4*)(pin_(32) + (size_t)l * NEXP * DM);
    const float4* v = (const float4*)(pin_(33) + (size_t)l * NEXP * DM);
    unsigned* uo = (unsigned*)(pws_() + WS_UT16);
    unsigned* vo = (unsigned*)(pws_() + WS_VT16);
    const size_t n4 = (size_t)NEXP * DM / 4;
    for (size_t i = (size_t)bid_() * 512 + tid_(); i < n4; i += (size_t)nblk_() * 512) {
        uo[i] = pack4_fp8(u[i], U_SCALE);
        vo[i] = pack4_fp8(v[i], V_SCALE);
    }
}
#define WS_PD (WS_P)
template <int HALF>
__device__ __forceinline__ void ph_peer_u(const Ctx& p, int l) {
    const unsigned char* ut = (const unsigned char*)(pws_() + WS_UT16);
    const int* pidx = (const int*)(pws_() + WS_PEI);
    float* pgt = (float*)(pws_() + WS_PEG);
    float* pd_ = (float*)(pws_() + WS_PD);
    const bf16_t* H = (const bf16_t*)(pws_() + WS_H);
    const int lane = tid_() & 63;
    const bool r = lane & 32, bit4 = lane & 16, bit3 = lane & 8, bit2 = lane & 4;
    const int coff = 512 * HALF + 16 * (lane & 31);
    const int pmine = 2 * (((lane >> 4) & 1) * 4 + ((lane >> 3) & 1) * 2 + ((lane >> 2) & 1)) + (lane >> 5);
    const int nw = nwaves();
#define PU_ROWS(buf, esrc, lb) do { int es_ = esrc; asm volatile("" : "+v"(es_)); _Pragma("unroll") for (int i_ = 0; i_ < 8; ++i_) { \
        const int ea_ = __builtin_amdgcn_readlane(es_, (lb) + 2 * i_), eb_ = __builtin_amdgcn_readlane(es_, (lb) + 2 * i_ + 1); \
        buf[i_] = *(const uint4*)(ut + (size_t)(r ? eb_ : ea_) * DM + coff); } __builtin_amdgcn_sched_barrier(0); } while (0)
#define PU_COMP(buf, kb) do { float pd[8]; _Pragma("unroll") for (int i_ = 0; i_ < 8; ++i_) { \
            const unsigned w_[4] = {buf[i_].x, buf[i_].y, buf[i_].z, buf[i_].w}; float d0 = 0.f, d1 = 0.f; \
            _Pragma("unroll") for (int q = 0; q < 4; ++q) { \
                const f32x2_t a_ = __builtin_amdgcn_cvt_pk_f32_fp8((int)w_[q], false), c_ = __builtin_amdgcn_cvt_pk_f32_fp8((int)w_[q], true); \
                d0 = __builtin_fmaf(a_.x, hh[4 * q], d0); d1 = __builtin_fmaf(a_.y, hh[4 * q + 1], d1); \
                d0 = __builtin_fmaf(c_.x, hh[4 * q + 2], d0); d1 = __builtin_fmaf(c_.y, hh[4 * q + 3], d1); } \
            pd[i_] = d0 + d1; } \
        float r4[4], r2[2], r1; \
        _Pragma("unroll") for (int i_ = 0; i_ < 4; ++i_) { const float mine = bit4 ? pd[i_ + 4] : pd[i_], send = bit4 ? pd[i_] : pd[i_ + 4]; r4[i_] = mine + __shfl_xor(send, 16, 64); } \
        _Pragma("unroll") for (int i_ = 0; i_ < 2; ++i_) { const float mine = bit3 ? r4[i_ + 2] : r4[i_], send = bit3 ? r4[i_] : r4[i_ + 2]; r2[i_] = mine + __shfl_xor(send, 8, 64); } \
        { const float mine = bit2 ? r2[1] : r2[0], send = bit2 ? r2[0] : r2[1]; r1 = mine + __shfl_xor(send, 4, 64); } \
        r1 += __shfl_xor(r1, 2, 64); r1 += __shfl_xor(r1, 1, 64); \
        const size_t pi = (size_t)tok * 128 + (kb) * 16 + pmine; \
        if (HALF == 0) { if ((lane & 3) == 0) pd_[pi] = r1; } \
        else if ((lane & 3) == 0) pgt[pi] = pgt[pi] * gelu_tanh_f((r1 + pd_[pi]) * (1.f / U_SCALE)) * (1.f / V_SCALE); \
        __builtin_amdgcn_sched_barrier(0); } while (0)
    int tok = gwave();
    uint4 nr0 = *(const uint4*)(H + (size_t)tok * DM + coff), nr1 = *(const uint4*)(H + (size_t)tok * DM + coff + 8);
    int ne0 = pidx[(size_t)tok * 128 + lane], ne1 = pidx[(size_t)tok * 128 + 64 + lane];
    uint4 rA[8], rB[8];
    PU_ROWS(rA, ne0, 0);
    for (; tok < MTOK; tok += nw) {
        float hh[16];
        {
            const unsigned w[8] = {nr0.x, nr0.y, nr0.z, nr0.w, nr1.x, nr1.y, nr1.z, nr1.w};
#pragma unroll
            for (int q = 0; q < 8; ++q) { hh[2 * q] = __uint_as_float(w[q] << 16); hh[2 * q + 1] = __uint_as_float(w[q] & 0xffff0000u); }
        }
        const int e0 = ne0, e1 = ne1;
        {
            const size_t tn = (size_t)(tok + nw < MTOK ? tok + nw : tok);
            nr0 = *(const uint4*)(H + tn * DM + coff); nr1 = *(const uint4*)(H + tn * DM + coff + 8);
            ne0 = pidx[tn * 128 + lane]; ne1 = pidx[tn * 128 + 64 + lane];
        }
        PU_ROWS(rB, e0, 16); PU_COMP(rA, 0);
        PU_ROWS(rA, e0, 32); PU_COMP(rB, 1);
        PU_ROWS(rB, e0, 48); PU_COMP(rA, 2);
        PU_ROWS(rA, e1, 0);  PU_COMP(rB, 3);
        PU_ROWS(rB, e1, 16); PU_COMP(rA, 4);
        PU_ROWS(rA, e1, 32); PU_COMP(rB, 5);
        PU_ROWS(rB, e1, 48); PU_COMP(rA, 6);
        PU_ROWS(rA, ne0, 0);
        PU_COMP(rB, 7);
    }
#undef PU_ROWS
#undef PU_COMP
}
template <int HALF>
__device__ __forceinline__ void ph_peer_v(const Ctx& p, int l) {
    const unsigned char* vt = (const unsigned char*)(pws_() + WS_VT16);
    const int* pidx = (const int*)(pws_() + WS_PEI);
    const float* pgt = (const float*)(pws_() + WS_PEG);
    float* x = pout_();
    const int lane = tid_() & 63;
    const bool r = lane & 32;
    const int coff = 512 * HALF + 16 * (lane & 31);
    const int nw = nwaves();
    int tok = gwave();
    int ne0 = pidx[(size_t)tok * 128 + lane], ne1 = pidx[(size_t)tok * 128 + 64 + lane];
    float nc0 = pgt[(size_t)tok * 128 + lane], nc1 = pgt[(size_t)tok * 128 + 64 + lane];
    for (; tok < MTOK; tok += nw) {
        const int e0 = ne0, e1 = ne1;
        const float c0 = nc0, c1 = nc1;
        if (tok + nw < MTOK) {
            const size_t tn = (size_t)(tok + nw);
            ne0 = pidx[tn * 128 + lane]; ne1 = pidx[tn * 128 + 64 + lane];
            nc0 = pgt[tn * 128 + lane]; nc1 = pgt[tn * 128 + 64 + lane];
        }
        float out[16];
#pragma unroll
        for (int i = 0; i < 16; ++i) out[i] = 0.f;
#pragma unroll 1
        for (int hb = 0; hb < 4; ++hb) {
            const int esrc = hb < 2 ? e0 : e1;
            const float csrc = hb < 2 ? c0 : c1;
            const int lb = (hb & 1) * 32;
            uint4 vr[16];
#pragma unroll
            for (int i = 0; i < 16; ++i) {
                const int ea = __builtin_amdgcn_readlane(esrc, lb + 2 * i), eb = __builtin_amdgcn_readlane(esrc, lb + 2 * i + 1);
                const int e = r ? eb : ea;
                vr[i] = *(const uint4*)(vt + (size_t)e * DM + coff);
            }
#pragma unroll
            for (int i = 0; i < 16; ++i) {
                const float ca = __uint_as_float(__builtin_amdgcn_readlane(__float_as_uint(csrc), lb + 2 * i));
                const float cb = __uint_as_float(__builtin_amdgcn_readlane(__float_as_uint(csrc), lb + 2 * i + 1));
                const float cj = r ? cb : ca;
                const unsigned w[4] = {vr[i].x, vr[i].y, vr[i].z, vr[i].w};
#pragma unroll
                for (int q = 0; q < 4; ++q) {
                    const f32x2_t a = __builtin_amdgcn_cvt_pk_f32_fp8((int)w[q], false), c = __builtin_amdgcn_cvt_pk_f32_fp8((int)w[q], true);
                    out[4 * q] = __builtin_fmaf(a.x, cj, out[4 * q]); out[4 * q + 1] = __builtin_fmaf(a.y, cj, out[4 * q + 1]);
                    out[4 * q + 2] = __builtin_fmaf(c.x, cj, out[4 * q + 2]); out[4 * q + 3] = __builtin_fmaf(c.y, cj, out[4 * q + 3]);
                }
            }
        }
#pragma unroll
        for (int i = 0; i < 16; ++i) out[i] += __shfl_xor(out[i], 32, 64);
        if (!r) {
            float4* xp = (float4*)(x + (size_t)tok * DM + coff);
#pragma unroll
            for (int q = 0; q < 4; ++q) {
                float4 a = xp[q];
                a.x += out[4 * q]; a.y += out[4 * q + 1]; a.z += out[4 * q + 2]; a.w += out[4 * q + 3];
                xp[q] = a;
            }
        }
    }
}


#ifndef PROBE_MASK
#define PROBE_MASK 0
#endif
#if PROBE_MASK
#define GB(k) do { GRID_BARRIER(); const unsigned long long now_ = wall_clock64(); if ((PROBE_MASK >> (k)) & 1) { const unsigned long long dt_ = now_ - tprev_; while (wall_clock64() - now_ < 3ull * dt_) __builtin_amdgcn_s_sleep(8); } GRID_BARRIER(); tprev_ = wall_clock64(); } while (0)
#else
#define GB(k) GRID_BARRIER()
#endif
__global__ void __launch_bounds__(512, 2) k_mega(Params kp) {
    float* sm = dynsmem;
    {
        unsigned long long* tab = (unsigned long long*)((char*)dynsmem + PTAB_OFF);
        if (threadIdx.x < 34) tab[threadIdx.x] = (unsigned long long)kp.in[threadIdx.x];
        if (threadIdx.x == 34) tab[34] = (unsigned long long)kp.out;
        if (threadIdx.x == 35) tab[35] = (unsigned long long)kp.ws;
        if (threadIdx.x == 36) { tab[36] = 0ull; tab[37] = 0ull; }
    }
    __syncthreads();
    Ctx p; p.kp = &kp;
    (void)xcd_barrier_post((unsigned*)(pws_() + WS_BAR), (volatile LAS unsigned*)((char*)dynsmem + PTAB_OFF + 36 * 8));
#define GRID_BARRIER() do { XcdBarrier bar_; bar_.bar = (unsigned*)(pws_() + WS_BAR); bar_.x = xb_xcc_id(); bar_.st = (volatile LAS unsigned*)((char*)dynsmem + PTAB_OFF + 36 * 8); xcd_barrier(bar_); } while (0)
    ph_weight_prep(p, sm);
    ph_subkeys_convert(p);
    GRID_BARRIER();
#if PROBE_MASK
    unsigned long long tprev_ = wall_clock64();
#endif
#pragma unroll 1
    for (int l = 0; l < DEPTH; ++l) {
#define XIN_ (l == 0 ? pin_(0) : pout_())
#define HBUF_ ((const bf16_t*)(pws_() + WS_H))
        ph_rmsnorm(XIN_, pin_(2) + (size_t)l * DM, (bf16_t*)(pws_() + WS_H), MTOK);
        ph_rmsnorm(pin_(1), pin_(22) + (size_t)l * DM, (bf16_t*)(pws_() + WS_HM), MMEM);
        GB(1);
        { pg8::EpiBf16 E; E.O = (bf16_t*)(pws_() + WS_P); E.ldc = LDP; ph_gemm(HBUF_, (const bf16_t*)(pws_() + WT_IN) + (size_t)l * LDP * DM, MTOK, LDP, DM, E); }
        { pg8::EpiF32 E; E.C = (float*)(pws_() + WS_KM); E.R = nullptr; E.ldc = 256; ph_gemm((const bf16_t*)(pws_() + WS_HM), (const bf16_t*)(pws_() + WT_XK) + (size_t)l * 256 * DM, MMEM, 256, DM, E, 32); }
        { pg8::EpiF32 E; E.C = (float*)(pws_() + WS_VM); E.R = nullptr; E.ldc = 256; ph_gemm((const bf16_t*)(pws_() + WS_HM), (const bf16_t*)(pws_() + WT_XV) + (size_t)l * 256 * DM, MMEM, 256, DM, E, 64); }
        GB(2);
        ph_mem_prep(p, l);
        ph_dsa_prep(p, l);
        ph_scan_prep(p, l);
        GB(3);
        ph_scans(p, l, sm);
        GB(4);
        ph_mixer_finish(p, l);
        ph_dsa_main(p, l, sm);
        GB(5);
#define PANEL_SYNC() do { asm volatile("s_waitcnt vmcnt(0) lgkmcnt(0)" ::: "memory"); __syncthreads(); \
        if (threadIdx.x < 64) { __builtin_amdgcn_fence(__ATOMIC_ACQUIRE, "agent"); asm volatile("s_waitcnt vmcnt(0)" ::: "memory"); } \
        __syncthreads(); } while (0)
        ph_tab_convert(p, l);
        if (nblk_() == MTOK / 256) {
            const int pm = bid_(), wv = tid_() >> 6;
            { pg8::EpiF32 E; E.C = pout_(); E.R = XIN_; E.ldc = DM; ph_gemm_panel((const bf16_t*)(pws_() + WS_Y), (const bf16_t*)(pws_() + WT_OUT) + (size_t)l * DM * DM, MTOK, DM, DM, E, pm); }
            PANEL_SYNC();
            ph_rmsnorm(pout_(), pin_(21) + (size_t)l * DM, (bf16_t*)(pws_() + WS_H), 256, pm * 256, wv, 8);
            PANEL_SYNC();
            { pg8::EpiF32 E; E.C = (float*)(pws_() + WS_QX); E.R = nullptr; E.ldc = 256; ph_gemm_panel(HBUF_, (const bf16_t*)(pws_() + WT_XQ) + (size_t)l * 256 * DM, MTOK, 256, DM, E, pm); }
            PANEL_SYNC();
            ph_xattn(p, l, pm * 16, 16, wv, 8);
            PANEL_SYNC();
            { pg8::EpiF32 E; E.C = pout_(); E.R = pout_(); E.ldc = DM; ph_gemm_panel((const bf16_t*)(pws_() + WS_OX), (const bf16_t*)(pws_() + WT_XO) + (size_t)l * DM * 256, MTOK, DM, 256, E, pm); }
            PANEL_SYNC();
            ph_rmsnorm(pout_(), pin_(29) + (size_t)l * DM, (bf16_t*)(pws_() + WS_H), 256, pm * 256, wv, 8);
            PANEL_SYNC();
            { pg8::EpiBf16 E; E.O = (bf16_t*)(pws_() + WS_QP); E.ldc = DM; ph_gemm_panel(HBUF_, (const bf16_t*)(pws_() + WT_PQ) + (size_t)l * DM * DM, MTOK, DM, DM, E, pm); }
            PANEL_SYNC();
            ph_peer_topk(p, l, sm, pm * 16, 16, wv, 8);
        }
        GB(13);
        ph_peer_u<0>(p, l);
        GB(14);
        ph_peer_u<1>(p, l);
        GB(15);
        ph_peer_v<0>(p, l);
        GB(16);
        ph_peer_v<1>(p, l);
        GB(17);
    }
}

extern "C" void kernel_launch(void* const* d_in, const int* in_sizes, int n_in, void* d_out, int out_size, void* d_ws, size_t ws_size, hipStream_t stream) {
    if (n_in != 34 || out_size != MTOK * DM || ws_size < WS_END) {
        fprintf(stderr, "kernel_launch: unexpected shapes (n_in %d out %d ws %zu need %zu)\n", n_in, out_size, ws_size, (size_t)WS_END);
        return;
    }
    static int grid = 0;
    if (!grid) {
        int dev = 0, cus = 0, per_cu = 0;
        (void)hipGetDevice(&dev);
        (void)hipDeviceGetAttribute(&cus, hipDeviceAttributeMultiprocessorCount, dev);
        (void)hipFuncSetAttribute((const void*)k_mega, hipFuncAttributeMaxDynamicSharedMemorySize, LDS_BYTES);
        (void)hipOccupancyMaxActiveBlocksPerMultiprocessor(&per_cu, (const void*)k_mega, 512, LDS_BYTES);
        if (per_cu < 1) fprintf(stderr, "kernel_launch: occupancy query reports %d blocks per CU\n", per_cu);
        grid = cus > 0 ? cus : 256;
    }
    Params p; memset(&p, 0, sizeof(p));
    for (int i = 0; i < 34; ++i) p.in[i] = (const float*)d_in[i];
    p.out = (float*)d_out; p.ws = (char*)d_ws;
    (void)hipMemsetAsync((char*)d_ws + WS_BAR, 0, XCD_BAR_WORDS * sizeof(unsigned), stream);
    hipLaunchKernelGGL(k_mega, dim3(grid), dim3(512), LDS_BYTES, stream, p);
}
```

```cpp
#include <hip/hip_runtime.h>
#include <stdint.h>
#include <stdio.h>
#include <string.h>

#define NB 32
#define SEQ 2048
#define DM 1024
#define MTOK (NB * SEQ)
#define DEPTH 4
#define NMEM 256
#define MMEM (NB * NMEM)
#define LDP 3328
#define NEXP 16384
#define EPS 1e-6f
#define PC_Z 0
#define PC_XBC 256
#define PC_GQKV 768
#define PC_GG 1536
#define PC_LQ 1792
#define PC_LK 1920
#define PC_LV 2048
#define PC_LR 2304
#define PC_DQ 2560
#define PC_DK 2816
#define PC_DV 2880
#define PC_IQ 2944
#define PC_IK 3200
#define PC_GLR 3232
#define PC_IW 3248
#define PC_DT 3256
#define PC_GA 3260
#define PC_GB 3264

typedef unsigned short bf16_t;

#define WS_BAR 0ull
#define WS_P 16384ull
#define SZ_P ((size_t)MTOK * LDP * 2)
#define WS_H (WS_P + SZ_P)
#define SZ_H ((size_t)MTOK * DM * 2)
#define WS_Y (WS_H + SZ_H)
#define SZ_Y ((size_t)MTOK * DM * 2)
#define WS_WP (WS_Y + SZ_Y)
#define SZ_WP ((size_t)DEPTH * DM * LDP * 4)
#define WT_IN (WS_WP)
#define WT_OUT (WT_IN + (size_t)DEPTH * LDP * DM * 2)
#define WT_XQ (WT_OUT + (size_t)DEPTH * DM * DM * 2)
#define WT_XK (WT_XQ + (size_t)DEPTH * 256 * DM * 2)
#define WT_XV (WT_XK + (size_t)DEPTH * 256 * DM * 2)
#define WT_XO (WT_XV + (size_t)DEPTH * 256 * DM * 2)
#define WT_PQ (WT_XO + (size_t)DEPTH * DM * 256 * 2)
#define WT_END (WT_PQ + (size_t)DEPTH * DM * DM * 2)
#define WS_QN (WS_WP + SZ_WP)
#define SZ_QN ((size_t)MTOK * 256 * 4)
#define WS_KN (WS_QN + SZ_QN)
#define SZ_KN ((size_t)MTOK * 64 * 4)
#define WS_IKN (WS_KN + SZ_KN)
#define SZ_IKN ((size_t)MTOK * 32 * 4)
#define WS_YPRE (WS_IKN + SZ_IKN)
#define SZ_YPRE ((size_t)MTOK * 256 * 4)
#define WS_HM (WS_YPRE + SZ_YPRE)
#define SZ_HM ((size_t)MMEM * DM * 2)
#define WS_KM (WS_HM + SZ_HM)
#define SZ_KM ((size_t)MMEM * 256 * 4)
#define WS_VM (WS_KM + SZ_KM)
#define SZ_VM ((size_t)MMEM * 256 * 4)
#define WS_KB (WS_VM + SZ_VM)
#define SZ_KB ((size_t)MMEM * 256 * 2)
#define WS_VTB (WS_KB + SZ_KB)
#define SZ_VTB ((size_t)MMEM * 256 * 2)
#define WS_VT (WS_VTB + SZ_VTB)
#define SZ_VT ((size_t)MTOK * 64 * 2)
#define WS_SKB (WS_VT + SZ_VT)
#define SZ_SKB ((size_t)DEPTH * 8 * 2 * 128 * 64 * 2)
#define WS_SC (WS_SKB + SZ_SKB)
#define SZ_SC ((size_t)MTOK * 16 * 4)
#define WS_DUMMY (WS_SC + SZ_SC)
#define SZ_DUMMY (65536ull)
#define WS_U4 (WS_DUMMY + SZ_DUMMY)
#define WS_V4 (WS_U4 + (size_t)DEPTH * NEXP * 512)
#define WS_USC (WS_V4 + (size_t)DEPTH * NEXP * 512)
#define WS_VSC (WS_USC + (size_t)DEPTH * NEXP * 4)
#define WS_END (WS_VSC + (size_t)DEPTH * NEXP * 4)
#define WS_QX (WS_P)
#define WS_OX (WS_P + (size_t)MTOK * 256 * 4)
#define WS_QP (WS_P + 96ull * 1024 * 1024)
#define WS_H8 (WS_P + 224ull * 1024 * 1024)
#define WS_PEI (WS_H8 + (size_t)MTOK * DM)
#define WS_PEG (WS_PEI + (size_t)MTOK * 128 * 4)
#define WS_PUS (WS_PEG + (size_t)MTOK * 128 * 4)
#define WS_PEND (WS_PUS + (size_t)MTOK * 128 * 4)
static_assert(WS_PEND <= WS_P + SZ_P, "P region aliases");

struct Params {
    const float* in[34];
    float* out;
    char* ws;
};

#define XB_TMO      128
#define XB_XCNT(j)  (256  + 64 * (j))
#define XB_XSUB(j)  (1280 + 64 * (j))
#define XB_XGEN(j)  (2304 + 64 * (j))
#define XB_TOP      3328
#define XB_TOPGEN   3392
#define XCD_BAR_WORDS 3456
#define XB_SPIN_CAP (1u << 18)
#define LAS __attribute__((address_space(3)))

__device__ __forceinline__ unsigned xb_ld(unsigned* p)              { return __hip_atomic_load(p, __ATOMIC_RELAXED, __HIP_MEMORY_SCOPE_AGENT); }
__device__ __forceinline__ unsigned xb_add(unsigned* p, unsigned v) { return __hip_atomic_fetch_add(p, v, __ATOMIC_RELAXED, __HIP_MEMORY_SCOPE_AGENT); }
__device__ __forceinline__ unsigned xb_xcc_id() { return (unsigned)__builtin_amdgcn_s_getreg((3 << 11) | 20) & 0xFu; }
#define XB_SPIN(cond, bar) do { unsigned _sp = 0; while (cond) { __builtin_amdgcn_s_sleep(1); \
    if ((++_sp & 255u) == 0u) { if (xb_ld(&(bar)[XB_TMO])) break; if (_sp > XB_SPIN_CAP) { atomicAdd(&(bar)[XB_TMO], 1u); break; } } } } while (0)

struct XcdBarrier {
    unsigned* bar; unsigned x;
    volatile LAS unsigned* st;
};

__device__ __forceinline__ XcdBarrier xcd_barrier_post(unsigned* bar, volatile LAS unsigned* st) {
    XcdBarrier b; b.bar = bar; b.x = xb_xcc_id(); b.st = st;
    if (threadIdx.x == 0) (void)xb_add(&bar[XB_XCNT(b.x)], 1u);
    return b;
}
__device__ __forceinline__ void xcd_barrier_complete(unsigned* bar, unsigned x, unsigned& nloc, unsigned& nx) {
    const unsigned G = gridDim.x * gridDim.y * gridDim.z;
    unsigned sum, cnt, mine, sp = 0u;
    for (;;) {
        sum = 0u; cnt = 0u; mine = 0u;
#pragma unroll
        for (unsigned j = 0; j < 16; ++j) { const unsigned c = xb_ld(&bar[XB_XCNT(j)]); sum += c; cnt += (c > 0u) ? 1u : 0u; mine = (j == x) ? c : mine; }
        if (sum == G) break;
        __builtin_amdgcn_s_sleep(1);
        if ((++sp & 255u) == 0u) { if (xb_ld(&bar[XB_TMO])) break; if (sp > XB_SPIN_CAP) { atomicAdd(&bar[XB_TMO], 1u); break; } }
    }
    nloc = mine > 0u ? mine : 1u; nx = cnt > 0u ? cnt : 1u;
}

__device__ __forceinline__ void xcd_barrier(const XcdBarrier& b) {
    asm volatile("s_waitcnt vmcnt(0)" ::: "memory");
    __syncthreads();
    if (threadIdx.x == 0) {
        unsigned* bar = b.bar;
        __builtin_amdgcn_s_waitcnt(0);
        unsigned nloc = b.st[0], nx = b.st[1];
        if (nloc == 0u) { xcd_barrier_complete(bar, b.x, nloc, nx); b.st[0] = nloc; b.st[1] = nx; }
        const unsigned old = xb_add(&bar[XB_XSUB(b.x)], 1u);
        const unsigned gen = old / nloc;
        if (old + 1u == (gen + 1u) * nloc) {
            __builtin_amdgcn_fence(__ATOMIC_RELEASE, "agent");
            asm volatile("s_waitcnt vmcnt(0)" ::: "memory");
            const unsigned og = xb_add(&bar[XB_TOP], 1u);
            const unsigned tg = og / nx;
            if (og + 1u == (tg + 1u) * nx) xb_add(&bar[XB_TOPGEN], 1u);
            else XB_SPIN(xb_ld(&bar[XB_TOPGEN]) == tg, bar);
            __builtin_amdgcn_fence(__ATOMIC_ACQUIRE, "agent");
            xb_add(&bar[XB_XGEN(b.x)], 1u);
            asm volatile("s_waitcnt vmcnt(0)" ::: "memory");
        } else {
            XB_SPIN(xb_ld(&bar[XB_XGEN(b.x)]) == gen, bar);
            __builtin_amdgcn_fence(__ATOMIC_ACQUIRE, "agent");
            asm volatile("s_waitcnt vmcnt(0)" ::: "memory");
        }
    }
    __syncthreads();
}


#define LDS_BYTES (144 * 1024)
#define PTAB_OFF (LDS_BYTES - 1024)
extern __shared__ __attribute__((aligned(16))) float dynsmem[];
struct Ctx { const Params* kp; };
#define pin_(i) (p.kp->in[i])
#define pout_() (p.kp->out)
#define pws_() (p.kp->ws)

__device__ __forceinline__ float bf2f(bf16_t v) { return __uint_as_float(((unsigned)v) << 16); }
__device__ __forceinline__ bf16_t f2bf(float f) { unsigned u = __float_as_uint(f); u += 0x7FFFu + ((u >> 16) & 1u); return (bf16_t)(u >> 16); }
__device__ __forceinline__ unsigned pk_bf16(float lo, float hi) { return (unsigned)f2bf(lo) | ((unsigned)f2bf(hi) << 16); }
__device__ __forceinline__ float wave_sum(float v) {
#pragma unroll
    for (int o = 32; o >= 1; o >>= 1) v += __shfl_xor(v, o, 64);
    return v;
}
__device__ __forceinline__ float wave_max(float v) {
#pragma unroll
    for (int o = 32; o >= 1; o >>= 1) v = fmaxf(v, __shfl_xor(v, o, 64));
    return v;
}
__device__ __forceinline__ float silu_f(float x) { return x / (1.f + __expf(-x)); }
__device__ __forceinline__ float sigmoid_f(float x) { return 1.f / (1.f + __expf(-x)); }
__device__ __forceinline__ float softplus_f(float x) { return x > 20.f ? x : log1pf(__expf(x)); }
__device__ __forceinline__ float logsigmoid_f(float x) { return -softplus_f(-x); }
__device__ __forceinline__ float gelu_tanh_f(float x) { const float u = 0.7978845608028654f * (x + 0.044715f * x * x * x); return 0.5f * x * (1.f + tanhf(u)); }
__device__ __forceinline__ unsigned ford(float f) { f = f + 0.0f; unsigned u = __float_as_uint(f); return (u & 0x80000000u) ? ~u : (u | 0x80000000u); }
__device__ __forceinline__ float funord(unsigned k) { unsigned u = (k & 0x80000000u) ? (k & 0x7fffffffu) : ~k; return __uint_as_float(u); }
__device__ __forceinline__ unsigned long long wave_max_u64(unsigned long long v) {
#pragma unroll
    for (int o = 32; o >= 1; o >>= 1) {
        unsigned lo = __shfl_xor((unsigned)v, o, 64), hi = __shfl_xor((unsigned)(v >> 32), o, 64);
        unsigned long long w = ((unsigned long long)hi << 32) | lo;
        v = w > v ? w : v;
    }
    return v;
}
__device__ __forceinline__ int tid_() { int t = threadIdx.x; asm volatile("" : "+v"(t)); return t; }
__device__ __forceinline__ int bid_() { int b = blockIdx.x; asm volatile("" : "+s"(b)); return b; }
__device__ __forceinline__ int nblk_() { int g = gridDim.x; asm volatile("" : "+s"(g)); return g; }
__device__ __forceinline__ int gwave() { return (bid_() * 512 + tid_()) >> 6; }
__device__ __forceinline__ int nwaves() { return nblk_() * 8; }

namespace pg8 {
#define PG8_LAS __attribute__((address_space(3)))
typedef unsigned short bf16_t;
typedef short bf16x8 __attribute__((ext_vector_type(8)));
typedef float f32x4 __attribute__((ext_vector_type(4)));
typedef unsigned u32x4 __attribute__((ext_vector_type(4)));
constexpr int BM = 256, BK = 64, HALF = 128, HTB = HALF * BK * 2  , STAGE_BYTES = 8 * HTB, NXCD = 8, WGM = 8;

__host__ __device__ __forceinline__ int lds_byte(int r, int c) { const int st = (r >> 4) * 2 + (c >> 5), rr = r & 15, cc = c & 31, ob = rr * 64 + cc * 2; return st * 1024 + (ob ^ (((ob >> 9) & 1) << 5)); }
__host__ __device__ __forceinline__ void stage_rc(int b, int& R, int& C) { const int st = b / 1024, sb = b % 1024, swz = sb ^ (((sb >> 9) & 1) << 5); R = (st >> 1) * 16 + swz / 64; C = (st & 1) * 32 + (swz % 64) / 2; }
__host__ __device__ __forceinline__ int perm32(int rho) { const int n = rho >> 4, i = rho & 15; return 8 * (i >> 2) + 4 * n + (i & 3); }

struct Unit { int pm, pn; };
struct Gemm { const bf16_t* A; const bf16_t* Bt; int M, N, K; };

struct StaticOrder {
    int nM, nN, nwg, G, c;
    __host__ __device__ void init(int M, int N, int G_, int c_) { nM = M / BM; nN = N / BM; nwg = nM * nN; G = G_; c = c_; }
    __host__ __device__ bool next(int i, Unit& u) const {
        const long L = (long)i * G + c; if (L >= nwg) return false;
        int wgid = (int)L; { const int q = nwg / NXCD, r = nwg % NXCD, xcd = wgid % NXCD, off = wgid / NXCD; wgid = (xcd < r ? xcd * (q + 1) : r * (q + 1) + (xcd - r) * q) + off; }
        const int nig = WGM * nN, gid = wgid / nig, fm = gid * WGM, gsz = (nM - fm) < WGM ? (nM - fm) : WGM;
        u.pm = fm + ((wgid % nig) % gsz); u.pn = (wgid % nig) / gsz; return true;
    }
    __device__ __forceinline__ void a_ready(const Unit&) const {}
    __device__ __forceinline__ void done(const Unit&) const {}
};

__device__ __forceinline__ unsigned cvt_pk_bf16(float lo, float hi) { unsigned r; asm volatile("v_cvt_pk_bf16_f32 %0, %1, %2" : "=v"(r) : "v"(lo), "v"(hi)); return r; }
struct EpiF32 {
    static constexpr bool PERM = false, AFTER_DRAIN = false;
    float* C; const float* R; int ldc;
    __device__ __forceinline__ void operator()(const f32x4 (&acc)[2][2][4][2], const Unit& u, int wr, int wc, int fr, int fq) const {
        const int row0 = u.pm * BM + wr * 64 + fr, col0 = u.pn * BM + wc * 32 + 4 * fq;
#pragma unroll
        for (int ai = 0; ai < 2; ++ai)
#pragma unroll
            for (int m = 0; m < 4; ++m) { const size_t off = (size_t)(row0 + ai * HALF + m * 16) * ldc + col0;
#pragma unroll
                for (int bj = 0; bj < 2; ++bj)
#pragma unroll
                    for (int n = 0; n < 2; ++n) { f32x4 v = acc[ai][bj][m][n]; if (R) v += *(const f32x4*)(R + off + bj * HALF + n * 16); *(f32x4*)(C + off + bj * HALF + n * 16) = v; } }
    }
};
struct EpiBf16 {
    static constexpr bool PERM = true, AFTER_DRAIN = false;
    bf16_t* O; int ldc;
    __device__ __forceinline__ void operator()(const f32x4 (&acc)[2][2][4][2], const Unit& u, int wr, int wc, int fr, int fq) const {
        const int row0 = u.pm * BM + wr * 64 + fr, col0 = u.pn * BM + wc * 32 + 8 * fq;
#pragma unroll
        for (int ai = 0; ai < 2; ++ai)
#pragma unroll
            for (int m = 0; m < 4; ++m) { bf16_t* rowp = O + (size_t)(row0 + ai * HALF + m * 16) * ldc + col0;
#pragma unroll
                for (int bj = 0; bj < 2; ++bj) { const f32x4 v0 = acc[ai][bj][m][0], v1 = acc[ai][bj][m][1];
                    u32x4 w; w.x = cvt_pk_bf16(v0[0], v0[1]); w.y = cvt_pk_bf16(v0[2], v0[3]); w.z = cvt_pk_bf16(v1[0], v1[1]); w.w = cvt_pk_bf16(v1[2], v1[3]);
                    *(u32x4*)(rowp + bj * HALF) = w; } }
    }
};

template <class Epi, class Sched, bool STAMP = false>
__device__ __forceinline__ void gemm_phase(PG8_LAS unsigned char* lds, const Gemm g, const Sched& S, const Epi& E, unsigned long long* stamps, const int tid) {
    const int wid = __builtin_amdgcn_readfirstlane(tid >> 6), lane = tid & 63, wr = wid >> 2, wc = wid & 3, fr = lane & 15, fq = lane >> 4;
    const int K = g.K, nt = K / BK;
    int ts_lo = 0, ts_hi = 0, nts = 0; const unsigned long long rt_entry = STAMP ? (unsigned long long)wall_clock64() : 0ull;
#define PG8_STAMP() do { if (STAMP && wid == 0 && nts < 64) { const unsigned long long _c = (unsigned long long)clock64(); \
        ts_lo = (lane == nts) ? (int)(unsigned)_c : ts_lo; ts_hi = (lane == nts) ? (int)(unsigned)(_c >> 32) : ts_hi; ++nts; } } while (0)
    PG8_STAMP();
    unsigned voffA[2], voffB[2];
#pragma unroll
    for (int i = 0; i < 2; ++i) { int R, C; stage_rc(tid * 16 + i * 8192, R, C); const int Rb = Epi::PERM ? ((R & ~31) + perm32(R & 31)) : R;
        voffA[i] = (unsigned)(R * K + C) * 2u; voffB[i] = (unsigned)(Rb * K + C) * 2u; }
    const size_t kstep = (size_t)(BK * 2);
    const size_t hstep = (size_t)HALF * K * 2;
    const size_t tstep = 2 * hstep;
    const unsigned ldsw = (unsigned)wid * 1024u;
    const int aoff = lds_byte(wr * 64 + fr, fq * 8), boff = lds_byte(wc * 32 + fr, fq * 8);
#define PG8_SA(b, h) (((b) * 2 + (h)) * HTB)
#define PG8_SB(b, h) ((4 + (b) * 2 + (h)) * HTB)
#define PG8_STAGE(bufoff, gbase, voff) do { _Pragma("unroll") for (int _i = 0; _i < 2; ++_i) \
        __builtin_amdgcn_global_load_lds((const unsigned*)((const char*)(gbase) + (voff)[_i]), (PG8_LAS unsigned*)(lds + (bufoff) + ldsw + _i * 8192), 16, 0, 0); } while (0)
#define PG8_LDA(dst, b, h) do { _Pragma("unroll") for (int m = 0; m < 4; ++m) _Pragma("unroll") for (int k = 0; k < 2; ++k) dst[m][k] = *(const PG8_LAS bf16x8*)(lds + PG8_SA(b, h) + aoff + m * 2048 + k * 1024); } while (0)
#define PG8_LDB(dst, b, h) do { _Pragma("unroll") for (int n = 0; n < 2; ++n) _Pragma("unroll") for (int k = 0; k < 2; ++k) dst[n][k] = *(const PG8_LAS bf16x8*)(lds + PG8_SB(b, h) + boff + n * 2048 + k * 1024); } while (0)
#define PG8_MMA(ai, bj, At, Bt) do { __builtin_amdgcn_s_setprio(1); _Pragma("unroll") for (int m = 0; m < 4; ++m) _Pragma("unroll") for (int n = 0; n < 2; ++n) _Pragma("unroll") for (int k = 0; k < 2; ++k) \
        acc[ai][bj][m][n] = __builtin_amdgcn_mfma_f32_16x16x32_bf16(Bt[n][k], At[m][k], acc[ai][bj][m][n], 0, 0, 0); __builtin_amdgcn_s_setprio(0); } while (0)
#define PG8_WAIT_V(n) asm volatile("s_waitcnt vmcnt(" #n ")" ::: "memory")
#define PG8_WAIT_L(n) asm volatile("s_waitcnt lgkmcnt(" #n ")" ::: "memory")
#define PG8_BAR __builtin_amdgcn_s_barrier()
#define PG8_SCHED __builtin_amdgcn_sched_barrier(0)
    Unit cur, nxt; int ui = 0;
    if (!S.next(0, cur)) return;
    f32x4 acc[2][2][4][2];
#pragma unroll
    for (int a = 0; a < 2; ++a)
#pragma unroll
        for (int b = 0; b < 2; ++b)
#pragma unroll
            for (int m = 0; m < 4; ++m)
#pragma unroll
                for (int n = 0; n < 2; ++n) acc[a][b][m][n] = (f32x4){0.f, 0.f, 0.f, 0.f};
    bf16x8 At[4][2], B0[2][2], B1[2][2];
    const char* cA = (const char*)g.A + (size_t)cur.pm * tstep; const char* cB = (const char*)g.Bt + (size_t)cur.pn * tstep;
    S.a_ready(cur);
    PG8_STAGE(PG8_SB(0, 0), cB, voffB); PG8_STAGE(PG8_SA(0, 0), cA, voffA); PG8_STAGE(PG8_SB(0, 1), cB + hstep, voffB); PG8_STAGE(PG8_SA(0, 1), cA + hstep, voffA);
    if (wr == 1) PG8_BAR;
    PG8_WAIT_V(4); PG8_BAR;
    PG8_STAGE(PG8_SB(1, 0), cB + kstep, voffB); PG8_STAGE(PG8_SA(1, 0), cA + kstep, voffA); PG8_STAGE(PG8_SB(1, 1), cB + hstep + kstep, voffB);
    PG8_WAIT_V(6); PG8_BAR;
    PG8_STAMP();
    for (;;) {
        const bool has_next = S.next(ui + 1, nxt);
        const char* nA = has_next ? (const char*)g.A + (size_t)nxt.pm * tstep : cA; const char* nB = has_next ? (const char*)g.Bt + (size_t)nxt.pn * tstep : cB;
        for (int t = 0; t < nt; t += 2) {
            const bool last = (t == nt - 2);
            const char* a1 = cA + (size_t)(t + 1) * kstep;
            const char* a2 = last ? nA : cA + (size_t)(t + 2) * kstep; const char* b2 = last ? nB : cB + (size_t)(t + 2) * kstep;
            const char* a3 = a2 + kstep; const char* b3 = b2 + kstep;
            if (last && has_next) S.a_ready(nxt);
            PG8_LDB(B0, 0, 0); PG8_SCHED; PG8_LDA(At, 0, 0); PG8_STAGE(PG8_SA(1, 1), a1 + hstep, voffA);
            PG8_WAIT_L(8); PG8_BAR; PG8_WAIT_L(0); PG8_MMA(0, 0, At, B0); PG8_BAR; PG8_SCHED;
            PG8_LDB(B1, 0, 1); PG8_STAGE(PG8_SB(0, 0), b2, voffB);
            PG8_BAR; PG8_WAIT_L(0); PG8_MMA(0, 1, At, B1); PG8_BAR;
            PG8_LDA(At, 0, 1); PG8_STAGE(PG8_SA(0, 0), a2, voffA);
            PG8_BAR; PG8_WAIT_L(0); PG8_MMA(1, 0, At, B0); PG8_BAR; PG8_SCHED;
            PG8_STAGE(PG8_SB(0, 1), b2 + hstep, voffB);
            PG8_WAIT_V(6); PG8_BAR; PG8_MMA(1, 1, At, B1); PG8_BAR;
            PG8_LDB(B0, 1, 0); PG8_SCHED; PG8_LDA(At, 1, 0); PG8_STAGE(PG8_SA(0, 1), a2 + hstep, voffA);
            PG8_WAIT_L(8); PG8_BAR; PG8_WAIT_L(0); PG8_MMA(0, 0, At, B0); PG8_BAR; PG8_SCHED;
            PG8_LDB(B1, 1, 1); PG8_STAGE(PG8_SB(1, 0), b3, voffB);
            PG8_BAR; PG8_WAIT_L(0); PG8_MMA(0, 1, At, B1); PG8_BAR;
            PG8_LDA(At, 1, 1); PG8_STAGE(PG8_SA(1, 0), a3, voffA);
            PG8_BAR; PG8_WAIT_L(0); PG8_MMA(1, 0, At, B0); PG8_BAR; PG8_SCHED;
            PG8_STAGE(PG8_SB(1, 1), b3 + hstep, voffB);
            PG8_WAIT_V(6); PG8_BAR; PG8_MMA(1, 1, At, B1); PG8_BAR;
        }
        PG8_STAMP();
        if constexpr (!Epi::AFTER_DRAIN) { E(acc, cur, wr, wc, fr, fq); S.done(cur); }
        PG8_STAMP();
        if (!has_next) break;
#pragma unroll
        for (int a = 0; a < 2; ++a)
#pragma unroll
            for (int b = 0; b < 2; ++b)
#pragma unroll
                for (int m = 0; m < 4; ++m)
#pragma unroll
                    for (int n = 0; n < 2; ++n) acc[a][b][m][n] = (f32x4){0.f, 0.f, 0.f, 0.f};
        cur = nxt; cA = nA; cB = nB; ++ui;
    }
    PG8_WAIT_V(0);
    if (wr == 0) PG8_BAR;
    PG8_BAR;
    if constexpr (Epi::AFTER_DRAIN) { E.fused(acc, cur, wr, wc, fr, fq, lds, wid, lane); S.done(cur); }
    PG8_STAMP();
    if (STAMP && wid == 0) { stamps[lane] = lane < nts ? (((unsigned long long)(unsigned)ts_hi << 32) | (unsigned)ts_lo) : 0ull;
        if (lane == 62) stamps[62] = rt_entry; if (lane == 63) stamps[63] = (unsigned long long)wall_clock64(); }
#undef PG8_STAMP
#undef PG8_SA
#undef PG8_SB
#undef PG8_STAGE
#undef PG8_LDA
#undef PG8_LDB
#undef PG8_MMA
#undef PG8_WAIT_V
#undef PG8_WAIT_L
#undef PG8_BAR
#undef PG8_SCHED
}
}

namespace pg8 {
struct PanelOrder {
    int pm, nN;
    __device__ void init(int pm_, int N) { pm = pm_; nN = N / BM; }
    __device__ bool next(int i, Unit& u) const { if (i >= nN) return false; u.pm = pm; u.pn = i; return true; }
    __device__ __forceinline__ void a_ready(const Unit&) const {}
    __device__ __forceinline__ void done(const Unit&) const {}
};
}
template <class Epi> __device__ __forceinline__ void ph_gemm_panel(const bf16_t* A, const bf16_t* Bt, int M, int N, int K, const Epi& E, int pm) {
    pg8::Gemm g; g.A = A; g.Bt = Bt; g.M = M; g.N = N; g.K = K;
    pg8::PanelOrder S; S.init(pm, N);
    pg8::gemm_phase<Epi, pg8::PanelOrder, false>((PG8_LAS unsigned char*)dynsmem, g, S, E, nullptr, tid_());
}
template <class Epi> __device__ __forceinline__ void ph_gemm(const bf16_t* A, const bf16_t* Bt, int M, int N, int K, const Epi& E, int crot = 0) {
    pg8::Gemm g; g.A = A; g.Bt = Bt; g.M = M; g.N = N; g.K = K;
    const int nb_ = nblk_();
    pg8::StaticOrder S; S.init(M, N, nb_, (bid_() + nb_ - crot) % nb_);
    pg8::gemm_phase<Epi, pg8::StaticOrder, false>((PG8_LAS unsigned char*)dynsmem, g, S, E, nullptr, tid_());
}

__device__ __forceinline__ int pcol_to_orig(int c) {
    if (c < 768) return c;
    if (c < 1536) return c - 768 + 772;
    if (c < 1792) return c - 1536 + 1548;
    if (c < 1920) return c - 1792 + 1804;
    if (c < 2048) return c - 1920 + 1932;
    if (c < 2304) return c - 2048 + 2060;
    if (c < 2560) return c - 2304 + 2332;
    if (c < 2816) return c - 2560 + 2588;
    if (c < 2880) return c - 2816 + 2844;
    if (c < 2944) return c - 2880 + 2908;
    if (c < 3200) return c - 2944 + 2972;
    if (c < 3232) return c - 3200 + 3228;
    if (c < 3248) return c - 3232 + 2316;
    if (c < 3256) return c - 3248 + 3260;
    if (c < 3260) return c - 3256 + 768;
    if (c < 3264) return c - 3260 + 1540;
    if (c < 3268) return c - 3264 + 1544;
    return -1;
}
__device__ __forceinline__ void wtrans_job(const float* W, int K, int ldw, bf16_t* Wt, int Npad, bool mapped, float* tile) {
    const int tid = tid_();
    const int tn = Npad / 64, tk = K / 64;
    for (int t = bid_(); t < tn * tk; t += nblk_()) {
        const int n0 = (t / tk) * 64, k0 = (t % tk) * 64;
        __syncthreads();
        for (int idx = tid; idx < 4096; idx += 512) {
            const int kk = idx >> 6, nn = idx & 63;
            const int col = mapped ? pcol_to_orig(n0 + nn) : (n0 + nn);
            tile[kk * 65 + nn] = col >= 0 ? W[(size_t)(k0 + kk) * ldw + col] : 0.f;
        }
        __syncthreads();
        for (int idx = tid; idx < 4096; idx += 512) {
            const int nn = idx >> 6, kk = idx & 63;
            Wt[(size_t)(n0 + nn) * K + k0 + kk] = f2bf(tile[kk * 65 + nn]);
        }
    }
}
__device__ __forceinline__ void ph_weight_prep(const Ctx& p, float* sm) {
#pragma unroll 1
    for (int j = 0; j < 7 * DEPTH; ++j) {
        const int l = j / 7, w = j % 7;
        const float* W; int K, ldw, Npad; bf16_t* Wt; bool mapped = false;
        if (w == 0) { W = pin_(3) + (size_t)l * DM * 3268; K = DM; ldw = 3268; Npad = LDP; Wt = (bf16_t*)(pws_() + WT_IN) + (size_t)l * LDP * DM; mapped = true; }
        else if (w == 1) { W = pin_(20) + (size_t)l * DM * DM; K = DM; ldw = DM; Npad = DM; Wt = (bf16_t*)(pws_() + WT_OUT) + (size_t)l * DM * DM; }
        else if (w == 2) { W = pin_(23) + (size_t)l * DM * 256; K = DM; ldw = 256; Npad = 256; Wt = (bf16_t*)(pws_() + WT_XQ) + (size_t)l * 256 * DM; }
        else if (w == 3) { W = pin_(24) + (size_t)l * DM * 256; K = DM; ldw = 256; Npad = 256; Wt = (bf16_t*)(pws_() + WT_XK) + (size_t)l * 256 * DM; }
        else if (w == 4) { W = pin_(25) + (size_t)l * DM * 256; K = DM; ldw = 256; Npad = 256; Wt = (bf16_t*)(pws_() + WT_XV) + (size_t)l * 256 * DM; }
        else if (w == 5) { W = pin_(26) + (size_t)l * 256 * DM; K = 256; ldw = DM; Npad = DM; Wt = (bf16_t*)(pws_() + WT_XO) + (size_t)l * DM * 256; }
        else { W = pin_(30) + (size_t)l * DM * DM; K = DM; ldw = DM; Npad = DM; Wt = (bf16_t*)(pws_() + WT_PQ) + (size_t)l * DM * DM; }
        wtrans_job(W, K, ldw, Wt, Npad, mapped, sm);
    }
}

#define H8_SCALE 16.f
__device__ __forceinline__ unsigned pack4_fp8(float4 a, float sc);
__device__ __forceinline__ void ph_rmsnorm(const float* __restrict__ x, const float* __restrict__ g, bf16_t* __restrict__ out, int rows, int row0 = 0, int w0 = -1, int wstep = 0, unsigned char* out8 = nullptr) {
    const int lane = tid_() & 63;
    if (w0 < 0) { w0 = gwave(); wstep = nwaves(); }
    for (int r = row0 + w0; r < row0 + rows; r += wstep) {
        const float4* xr = (const float4*)(x + (size_t)r * DM);
        float4 v[4]; float ss = 0.f;
#pragma unroll
        for (int i = 0; i < 4; ++i) { v[i] = xr[lane + 64 * i]; ss += v[i].x * v[i].x + v[i].y * v[i].y + v[i].z * v[i].z + v[i].w * v[i].w; }
        ss = wave_sum(ss);
        const float rs = rsqrtf(ss * (1.f / DM) + EPS);
#pragma unroll
        for (int i = 0; i < 4; ++i) {
            const float4 gg = ((const float4*)g)[lane + 64 * i];
            ushort4 o; o.x = f2bf(v[i].x * rs * gg.x); o.y = f2bf(v[i].y * rs * gg.y); o.z = f2bf(v[i].z * rs * gg.z); o.w = f2bf(v[i].w * rs * gg.w);
            *(ushort4*)(out + (size_t)r * DM + (size_t)(lane + 64 * i) * 4) = o;
            if (out8) *(unsigned*)(out8 + (size_t)r * DM + (size_t)(lane + 64 * i) * 4) = pack4_fp8(make_float4(v[i].x * rs * gg.x, v[i].y * rs * gg.y, v[i].z * rs * gg.z, v[i].w * rs * gg.w), H8_SCALE);
        }
    }
}

template <int OUTMODE>
__device__ __forceinline__ void ph_sgemm(const bf16_t* __restrict__ A, int lda, const float* __restrict__ B, int ldb, void* Cv, int ldc, const float* R, int ldr,
                         int M, int N, int K, float* smem) {
    float* As = smem;
    float* Bs = smem + 16 * 132;
    const int tid = tid_(), tx = tid & 31, ty = tid >> 5;
    const int ntn = N / 128, ntiles = (M / 128) * ntn;
    for (int tile = bid_(); tile < ntiles; tile += nblk_()) {
        const int tm = tile / ntn, tn = tile % ntn;
        float acc[8][4];
#pragma unroll
        for (int i = 0; i < 8; ++i)
#pragma unroll
            for (int j = 0; j < 4; ++j) acc[i][j] = 0.f;
        const int arow = tid >> 2, akq = (tid & 3) * 4;
        const int bk = tid >> 5, bn = (tid & 31) * 4;
        for (int k0 = 0; k0 < K; k0 += 16) {
            const ushort4 av = *(const ushort4*)(A + (size_t)(tm * 128 + arow) * lda + k0 + akq);
            const float4 bv = *(const float4*)(B + (size_t)(k0 + bk) * ldb + tn * 128 + bn);
            __syncthreads();
            As[(akq + 0) * 132 + arow] = bf2f(av.x); As[(akq + 1) * 132 + arow] = bf2f(av.y);
            As[(akq + 2) * 132 + arow] = bf2f(av.z); As[(akq + 3) * 132 + arow] = bf2f(av.w);
            *(float4*)(Bs + bk * 132 + bn) = bv;
            __syncthreads();
#pragma unroll
            for (int k = 0; k < 16; ++k) {
                const float4 a0 = *(const float4*)(As + k * 132 + ty * 8), a1 = *(const float4*)(As + k * 132 + ty * 8 + 4);
                const float4 b = *(const float4*)(Bs + k * 132 + tx * 4);
                const float a[8] = {a0.x, a0.y, a0.z, a0.w, a1.x, a1.y, a1.z, a1.w};
#pragma unroll
                for (int i = 0; i < 8; ++i) { acc[i][0] += a[i] * b.x; acc[i][1] += a[i] * b.y; acc[i][2] += a[i] * b.z; acc[i][3] += a[i] * b.w; }
            }
        }
#pragma unroll
        for (int i = 0; i < 8; ++i) {
            const size_t row = (size_t)tm * 128 + ty * 8 + i; const int col = tn * 128 + tx * 4;
            if (OUTMODE == 0) {
                ushort4 o; o.x = f2bf(acc[i][0]); o.y = f2bf(acc[i][1]); o.z = f2bf(acc[i][2]); o.w = f2bf(acc[i][3]);
                *(ushort4*)((bf16_t*)Cv + row * ldc + col) = o;
            } else if (OUTMODE == 1) {
                *(float4*)((float*)Cv + row * ldc + col) = make_float4(acc[i][0], acc[i][1], acc[i][2], acc[i][3]);
            } else {
                const float4 r = *(const float4*)(R + row * ldr + col);
                *(float4*)((float*)Cv + row * ldc + col) = make_float4(r.x + acc[i][0], r.y + acc[i][1], r.z + acc[i][2], r.w + acc[i][3]);
            }
        }
    }
}

#define WS_HS WS_H
#define WS_VG WS_YPRE
#define WS_DEC (WS_YPRE + (size_t)MTOK * 256 * 2)

__device__ __forceinline__ float quad_sum(float v) {
    v += __int_as_float(__builtin_amdgcn_mov_dpp(__float_as_int(v), 0xB1, 0xF, 0xF, true));
    v += __int_as_float(__builtin_amdgcn_mov_dpp(__float_as_int(v), 0x4E, 0xF, 0xF, true));
    return v;
}
__device__ __forceinline__ float bflo(unsigned w) { return __uint_as_float(w << 16); }
__device__ __forceinline__ float bfhi(unsigned w) { return __uint_as_float(w & 0xffff0000u); }

__device__ __forceinline__ float oct_sum(float v) {
    v += __int_as_float(__builtin_amdgcn_mov_dpp(__float_as_int(v), 0xB1, 0xF, 0xF, true));
    v += __int_as_float(__builtin_amdgcn_mov_dpp(__float_as_int(v), 0x4E, 0xF, 0xF, true));
    v += __int_as_float(__builtin_amdgcn_mov_dpp(__float_as_int(v), 0x141, 0xF, 0xF, true));
    return v;
}
__device__ __forceinline__ void unpack8(const uint4 r, float (&o)[8]) {
    o[0] = bflo(r.x); o[1] = bfhi(r.x); o[2] = bflo(r.y); o[3] = bfhi(r.y); o[4] = bflo(r.z); o[5] = bfhi(r.z); o[6] = bflo(r.w); o[7] = bfhi(r.w);
}
__device__ __forceinline__ uint4 pack8(const float (&v)[8]) {
    uint4 o; o.x = pk_bf16(v[0], v[1]); o.y = pk_bf16(v[2], v[3]); o.z = pk_bf16(v[4], v[5]); o.w = pk_bf16(v[6], v[7]); return o;
}
__device__ __forceinline__ void load8f(const float* p, float (&o)[8]) {
    const float4 a = *(const float4*)p, b = *(const float4*)(p + 4);
    o[0] = a.x; o[1] = a.y; o[2] = a.z; o[3] = a.w; o[4] = b.x; o[5] = b.y; o[6] = b.z; o[7] = b.w;
}
__device__ __forceinline__ void conv8(const bf16_t* P, size_t tok, int t, int pcol, const float* w, int ldw, int cc, float (&acc)[8]) {
#pragma unroll
    for (int j = 0; j < 4; ++j) {
        if (t - 3 + j >= 0) {
            float xv[8], wv[8];
            unpack8(*(const uint4*)(P + (tok - (size_t)(3 - j)) * LDP + pcol), xv);
            load8f(w + j * ldw + cc, wv);
#pragma unroll
            for (int i = 0; i < 8; ++i) acc[i] = __builtin_fmaf(wv[i], xv[i], acc[i]);
        }
    }
}
__device__ __forceinline__ void conv8r(const uint4 (&xt)[4], int t, const float* w, int ldw, int cc, float (&acc)[8]) {
#pragma unroll
    for (int j = 0; j < 4; ++j) {
        float xv[8], wv[8];
        unpack8(xt[j], xv);
        load8f(w + j * ldw + cc, wv);
        const float m = (t - 3 + j >= 0) ? 1.f : 0.f;
#pragma unroll
        for (int i = 0; i < 8; ++i) acc[i] = __builtin_fmaf(wv[i] * m, xv[i], acc[i]);
    }
}
__device__ __forceinline__ void ph_scan_prep(const Ctx& p, int l) {
    const bf16_t* P = (const bf16_t*)(pws_() + WS_P);
    bf16_t* HS = (bf16_t*)(pws_() + WS_HS);
    bf16_t* VG = (bf16_t*)(pws_() + WS_VG);
    float* DEC = (float*)(pws_() + WS_DEC);
    float* SC = (float*)(pws_() + WS_SC);
    const float* scw = pin_(4) + (size_t)l * 4 * 512;
    const float* scb = pin_(5) + (size_t)l * 512;
    const float* gcw = pin_(10) + (size_t)l * 4 * 768;
    const float* wg = pin_(14) + (size_t)l * 16 * 128;
    const float* bg = pin_(15) + (size_t)l * 128;
    const int lane = tid_() & 63;
    const int hsc = lane & 3, wsc = (lane >> 2) & 3;
    const float k_dtb = pin_(6)[l * 4 + hsc], k_alog = __expf(pin_(7)[l * 4 + hsc]), k_galog = __expf(pin_(11)[l * 4 + hsc]), k_gdtb = pin_(12)[l * 4 + hsc];
    const int sccol = wsc < 2 ? PC_DT + hsc : (wsc == 2 ? PC_GA + hsc : PC_GB + hsc);
    for (int tok = gwave(); tok < MTOK; tok += nwaves()) {
        const int t = tok % SEQ;
        const size_t row = (size_t)tok * LDP;
        uint4 xa[4], xq[4], xv4[4];
#pragma unroll
        for (int j = 0; j < 4; ++j) {
            const size_t rj = (t - 3 + j >= 0) ? row - (size_t)(3 - j) * LDP : row;
            xa[j] = *(const uint4*)(P + rj + PC_XBC + 8 * lane);
            xq[j] = *(const uint4*)(P + rj + PC_GQKV + 8 * lane);
            xv4[j] = *(const uint4*)(P + rj + PC_GQKV + 512 + 8 * (lane & 31));
        }
        const uint4 gl0 = *(const uint4*)(P + row + PC_GLR), gl1 = *(const uint4*)(P + row + PC_GLR + 8);
        const float scraw = bf2f(P[row + sccol]);
        {
            float acc[8];
            load8f(scb + 8 * lane, acc);
            conv8r(xa, t, scw, 512, 8 * lane, acc);
#pragma unroll
            for (int i = 0; i < 8; ++i) acc[i] = silu_f(acc[i]);
            *(uint4*)(HS + (size_t)tok * 1024 + 8 * lane) = pack8(acc);
        }
        {
            float acc[8];
#pragma unroll
            for (int i = 0; i < 8; ++i) acc[i] = 0.f;
            conv8r(xq, t, gcw, 768, 8 * lane, acc);
            float ss = 0.f;
#pragma unroll
            for (int i = 0; i < 8; ++i) { acc[i] = silu_f(acc[i]); ss += acc[i] * acc[i]; }
            ss = oct_sum(ss);
            const float sc = rsqrtf(ss + EPS) * (lane < 32 ? 0.125f : 1.f);
#pragma unroll
            for (int i = 0; i < 8; ++i) acc[i] *= sc;
            *(uint4*)(HS + (size_t)tok * 1024 + 512 + 8 * lane) = pack8(acc);
        }
        {
            float acc[8];
#pragma unroll
            for (int i = 0; i < 8; ++i) acc[i] = 0.f;
            conv8r(xv4, t, gcw, 768, 512 + 8 * (lane & 31), acc);
#pragma unroll
            for (int i = 0; i < 8; ++i) acc[i] = silu_f(acc[i]);
            if (lane < 32) *(uint4*)(VG + (size_t)tok * 256 + 8 * lane) = pack8(acc);
        }
        {
            float v;
            if (wsc < 2) { const float dt = softplus_f(scraw + k_dtb); v = wsc == 0 ? dt : __expf(-dt * k_alog); }
            else if (wsc == 2) v = __expf(-k_galog * softplus_f(scraw + k_gdtb));
            else v = sigmoid_f(scraw);
            if (lane < 16) SC[(size_t)tok * 16 + lane] = v;
        }
        {
            float gl[16];
            { float a8[8], b8[8]; unpack8(gl0, a8); unpack8(gl1, b8);
#pragma unroll
              for (int i = 0; i < 8; ++i) { gl[i] = a8[i]; gl[8 + i] = b8[i]; } }
#pragma unroll
            for (int i = 0; i < 2; ++i) {
                const int c = lane + 64 * i;
                float acc = bg[c];
#pragma unroll
                for (int r = 0; r < 16; ++r) acc = __builtin_fmaf(gl[r], wg[r * 128 + c], acc);
                DEC[(size_t)tok * 128 + c] = __expf(logsigmoid_f(acc) * (1.f / 16.f));
            }
        }
    }
}

#define SCAN_LDS_WAVE 4608
typedef float f2_t __attribute__((ext_vector_type(2)));
__device__ __forceinline__ f2_t mk2(float a, float b) { f2_t r; r.x = a; r.y = b; return r; }
__device__ __forceinline__ void st8f(char* dst, const uint4 v) {
    *(float4*)dst = make_float4(bflo(v.x), bfhi(v.x), bflo(v.y), bfhi(v.y));
    *(float4*)(dst + 16) = make_float4(bflo(v.z), bfhi(v.z), bflo(v.w), bfhi(v.w));
}
__device__ __forceinline__ void ph_scans(const Ctx& p, int l, float* smem) {
    const bf16_t* P = (const bf16_t*)(pws_() + WS_P);
    const bf16_t* HS = (const bf16_t*)(pws_() + WS_HS);
    const bf16_t* VG = (const bf16_t*)(pws_() + WS_VG);
    const float* DEC = (const float*)(pws_() + WS_DEC);
    const float* SC = (const float*)(pws_() + WS_SC);
    bf16_t* Y = (bf16_t*)(pws_() + WS_Y);
    const int tid = tid_(), lane = tid & 63, wave = tid >> 6;
    if (nblk_() != 256) return;
    const int role = wave < 2 ? 0 : (wave < 6 ? 1 : 2);
    const int idx = (role == 0 ? wave : (role == 1 ? wave - 2 : wave - 6)) * 256 + bid_();
    const int bh = role == 1 ? (idx >> 3) : (idx >> 2), b = bh >> 2, h = bh & 3;
    const int colbase = role == 1 ? (idx & 7) * 8 : (idx & 3) * 16;
    const int cl = role == 1 ? (lane >> 3) : (lane >> 2);
    const int col = colbase + cl;
    const int sq = role == 1 ? (lane & 7) : (lane & 3);
    const size_t tb = (size_t)b * SEQ;
    bf16_t* dummy = (bf16_t*)(pws_() + WS_DUMMY) + (tid & 511) * 8;
    char* lw = (char*)smem + wave * SCAN_LDS_WAVE;
    char* lrow = lw;
    char* lcol = lw + 4096;
    float* lsc = (float*)(lw + 4352);
    const int fs = lane >> 3, fp = lane & 7;
    if (role == 0) {
        const int g = h >> 1;
        const float Dh = pin_(8)[l * 4 + h];
        uint4 f0, f1; unsigned fc = 0u; float fsc = 0.f;
        f2_t st[8];
#pragma unroll
        for (int i = 0; i < 8; ++i) st[i] = mk2(0.f, 0.f);
        auto fetch = [&](int t0) {
            const size_t tok = tb + t0 + fs;
            const bf16_t* src = HS + tok * 1024 + (fp < 4 ? 256 + g * 64 + fp * 16 : 384 + g * 64 + (fp - 4) * 16);
            f0 = *(const uint4*)src; f1 = *(const uint4*)(src + 8);
            fc = *(const unsigned*)(HS + tok * 1024 + h * 64 + colbase + fp * 2);
            if (lane < 16) fsc = SC[(tb + t0 + (lane >> 1)) * 16 + (lane & 1) * 4 + h];
        };
        fetch(0);
        for (int t0 = 0; t0 < SEQ; t0 += 8) {
            st8f(lrow + fs * 512 + fp * 64, f0); st8f(lrow + fs * 512 + fp * 64 + 32, f1);
            *(unsigned*)(lcol + fs * 32 + fp * 4) = fc;
            if (lane < 16) lsc[lane] = fsc;
            if (t0 + 8 < SEQ) fetch(t0 + 8);
#pragma unroll
            for (int i = 0; i < 8; ++i) {
                const char* rb = lrow + i * 512 + sq * 64;
                const float4 b0 = *(const float4*)rb, b1 = *(const float4*)(rb + 16), b2 = *(const float4*)(rb + 32), b3 = *(const float4*)(rb + 48);
                const float4 c0 = *(const float4*)(rb + 256), c1 = *(const float4*)(rb + 272), c2 = *(const float4*)(rb + 288), c3 = *(const float4*)(rb + 304);
                const float xv = bf2f(*(const bf16_t*)(lcol + i * 32 + cl * 2));
                const float2 sc2 = *(const float2*)(lsc + i * 2);
                const float xdt = xv * sc2.x;
                const f2_t xd2 = mk2(xdt, xdt), dA2 = mk2(sc2.y, sc2.y);
                const f2_t bb[8] = {mk2(b0.x, b0.y), mk2(b0.z, b0.w), mk2(b1.x, b1.y), mk2(b1.z, b1.w), mk2(b2.x, b2.y), mk2(b2.z, b2.w), mk2(b3.x, b3.y), mk2(b3.z, b3.w)};
                const f2_t cc[8] = {mk2(c0.x, c0.y), mk2(c0.z, c0.w), mk2(c1.x, c1.y), mk2(c1.z, c1.w), mk2(c2.x, c2.y), mk2(c2.z, c2.w), mk2(c3.x, c3.y), mk2(c3.z, c3.w)};
                f2_t ya = mk2(0.f, 0.f), yb = mk2(0.f, 0.f);
#pragma unroll
                for (int q = 0; q < 8; q += 2) {
                    st[q] = st[q] * dA2 + xd2 * bb[q]; st[q + 1] = st[q + 1] * dA2 + xd2 * bb[q + 1];
                    ya = cc[q] * st[q] + ya; yb = cc[q + 1] * st[q + 1] + yb;
                }
                const f2_t ys = ya + yb;
                const float y = quad_sum(ys.x + ys.y);
                *(sq == 0 ? Y + (tb + t0 + i) * DM + h * 64 + col : dummy + i) = f2bf(y + Dh * xv);
                if (i & 1) __builtin_amdgcn_sched_barrier(0);
            }
        }
    } else if (role == 1) {
        uint4 f0, f1; unsigned fc = 0u; float fsc = 0.f;
        f2_t S[4];
#pragma unroll
        for (int i = 0; i < 4; ++i) S[i] = mk2(0.f, 0.f);
        auto fetch = [&](int t0) {
            const size_t tok = tb + t0 + fs;
            const bf16_t* src = HS + tok * 1024 + (fp < 4 ? 512 + h * 64 + fp * 16 : 768 + h * 64 + (fp - 4) * 16);
            f0 = *(const uint4*)src; f1 = *(const uint4*)(src + 8);
            if (fp < 4) fc = *(const unsigned*)(VG + tok * 256 + h * 64 + colbase + fp * 2);
            if (lane < 16) fsc = SC[(tb + t0 + (lane >> 1)) * 16 + 8 + (lane & 1) * 4 + h];
        };
        fetch(0);
        for (int t0 = 0; t0 < SEQ; t0 += 8) {
            st8f(lrow + fs * 512 + fp * 64, f0); st8f(lrow + fs * 512 + fp * 64 + 32, f1);
            if (fp < 4) *(unsigned*)(lcol + fs * 32 + fp * 4) = fc;
            if (lane < 16) lsc[lane] = fsc;
            if (t0 + 8 < SEQ) fetch(t0 + 8);
#pragma unroll
            for (int i = 0; i < 8; ++i) {
                const char* rb = lrow + i * 512 + sq * 32;
                const float4 q0 = *(const float4*)rb, q1 = *(const float4*)(rb + 16);
                const float4 k0 = *(const float4*)(rb + 256), k1 = *(const float4*)(rb + 272);
                const float vv = bf2f(*(const bf16_t*)(lcol + i * 32 + cl * 2));
                const float2 sc2 = *(const float2*)(lsc + i * 2);
                const f2_t al2 = mk2(sc2.x, sc2.x);
                const f2_t kk[4] = {mk2(k0.x, k0.y), mk2(k0.z, k0.w), mk2(k1.x, k1.y), mk2(k1.z, k1.w)};
                const f2_t qq[4] = {mk2(q0.x, q0.y), mk2(q0.z, q0.w), mk2(q1.x, q1.y), mk2(q1.z, q1.w)};
                f2_t ra = mk2(0.f, 0.f), rb2 = mk2(0.f, 0.f);
#pragma unroll
                for (int q = 0; q < 4; q += 2) {
                    S[q] = S[q] * al2; S[q + 1] = S[q + 1] * al2;
                    ra = S[q] * kk[q] + ra; rb2 = S[q + 1] * kk[q + 1] + rb2;
                }
                const f2_t rs = ra + rb2;
                const float r = oct_sum(rs.x + rs.y);
                const float vn = sc2.y * (vv - r);
                const f2_t vn2 = mk2(vn, vn);
                f2_t oa2 = mk2(0.f, 0.f), ob2 = mk2(0.f, 0.f);
#pragma unroll
                for (int q = 0; q < 4; q += 2) {
                    S[q] = kk[q] * vn2 + S[q]; S[q + 1] = kk[q + 1] * vn2 + S[q + 1];
                    oa2 = S[q] * qq[q] + oa2; ob2 = S[q + 1] * qq[q + 1] + ob2;
                }
                const f2_t os = oa2 + ob2;
                const float ov = oct_sum(os.x + os.y);
                *(sq == 0 ? Y + (tb + t0 + i) * DM + 256 + h * 64 + col : dummy + i) = f2bf(ov);
                if (i & 1) __builtin_amdgcn_sched_barrier(0);
            }
        }
    } else {
        uint4 f0, f1; unsigned fc = 0u;
        f2_t S[4];
#pragma unroll
        for (int i = 0; i < 4; ++i) S[i] = mk2(0.f, 0.f);
        auto fetch = [&](int t0) {
            const size_t tok = tb + t0 + fs;
            if (fp < 4) { const float* src = DEC + tok * 128 + h * 32 + fp * 8; f0 = *(const uint4*)src; f1 = *(const uint4*)(src + 4); }
            else { const bf16_t* src = P + tok * LDP + (fp < 6 ? PC_LK + h * 32 + (fp - 4) * 16 : PC_LQ + h * 32 + (fp - 6) * 16); f0 = *(const uint4*)src; f1 = *(const uint4*)(src + 8); }
            fc = *(const unsigned*)(P + tok * LDP + PC_LV + h * 64 + colbase + fp * 2);
        };
        fetch(0);
        for (int t0 = 0; t0 < SEQ; t0 += 8) {
            if (fp < 4) { *(uint4*)(lrow + fs * 512 + fp * 32) = f0; *(uint4*)(lrow + fs * 512 + fp * 32 + 16) = f1; }
            else { st8f(lrow + fs * 512 + 128 + (fp - 4) * 64, f0); st8f(lrow + fs * 512 + 128 + (fp - 4) * 64 + 32, f1); }
            *(unsigned*)(lcol + fs * 32 + fp * 4) = fc;
            if (t0 + 8 < SEQ) fetch(t0 + 8);
#pragma unroll
            for (int i = 0; i < 8; ++i) {
                const char* rb = lrow + i * 512 + sq * 32;
                const float4 d0 = *(const float4*)rb, d1 = *(const float4*)(rb + 16);
                const float4 k0 = *(const float4*)(rb + 128), k1 = *(const float4*)(rb + 144);
                const float4 q0 = *(const float4*)(rb + 256), q1 = *(const float4*)(rb + 272);
                const float vv = bf2f(*(const bf16_t*)(lcol + i * 32 + cl * 2));
                const f2_t v2 = mk2(vv, vv);
                const f2_t dd[4] = {mk2(d0.x, d0.y), mk2(d0.z, d0.w), mk2(d1.x, d1.y), mk2(d1.z, d1.w)};
                const f2_t kk[4] = {mk2(k0.x, k0.y), mk2(k0.z, k0.w), mk2(k1.x, k1.y), mk2(k1.z, k1.w)};
                const f2_t qq[4] = {mk2(q0.x, q0.y), mk2(q0.z, q0.w), mk2(q1.x, q1.y), mk2(q1.z, q1.w)};
                f2_t oa2 = mk2(0.f, 0.f), ob2 = mk2(0.f, 0.f);
#pragma unroll
                for (int q = 0; q < 4; q += 2) {
                    S[q] = dd[q] * S[q] + kk[q] * v2; S[q + 1] = dd[q + 1] * S[q + 1] + kk[q + 1] * v2;
                    oa2 = S[q] * qq[q] + oa2; ob2 = S[q + 1] * qq[q + 1] + ob2;
                }
                const f2_t os = oa2 + ob2;
                const float ov = quad_sum(os.x + os.y);
                *(sq == 0 ? Y + (tb + t0 + i) * DM + 512 + h * 64 + col : dummy + i) = f2bf(ov * 0.17677669529663687f);
                if (i & 1) __builtin_amdgcn_sched_barrier(0);
            }
        }
    }
}

__device__ __forceinline__ void ph_mixer_finish(const Ctx& p, int l) {
    const bf16_t* P = (const bf16_t*)(pws_() + WS_P);
    bf16_t* Y = (bf16_t*)(pws_() + WS_Y);
    const float* sn = pin_(9) + (size_t)l * 256;
    const float* gn = pin_(13) + (size_t)l * 64;
    const float* ln = pin_(16) + (size_t)l * 64;
    const int lane = tid_() & 63;
    for (int tok = gwave(); tok < MTOK; tok += nwaves()) {
        const size_t row = (size_t)tok * LDP;
        {
            float v[8], gt[8], gw[8];
            unpack8(*(const uint4*)(Y + (size_t)tok * DM + 8 * lane), v);
            unpack8(*(const uint4*)(P + row + (lane < 32 ? PC_Z + 8 * lane : PC_GG + 8 * (lane - 32))), gt);
            load8f(lane < 32 ? sn + 8 * lane : gn + 8 * (lane & 7), gw);
            float ss = 0.f;
            if (lane < 32) {
#pragma unroll
                for (int i = 0; i < 8; ++i) { v[i] *= silu_f(gt[i]); ss += v[i] * v[i]; }
            } else {
#pragma unroll
                for (int i = 0; i < 8; ++i) ss += v[i] * v[i];
            }
            const float s8 = oct_sum(ss);
            float s32 = s8 + __int_as_float(__builtin_amdgcn_mov_dpp(__float_as_int(s8), 0x140, 0xF, 0xF, true));
            s32 += __shfl_xor(s32, 16, 64);
            const float rs = lane < 32 ? rsqrtf(s32 * (1.f / 256.f) + EPS) : rsqrtf(s8 * (1.f / 64.f) + EPS);
            float o[8];
#pragma unroll
            for (int i = 0; i < 8; ++i) o[i] = lane < 32 ? v[i] * rs * gw[i] : v[i] * rs * gw[i] * silu_f(gt[i]);
            *(uint4*)(Y + (size_t)tok * DM + 8 * lane) = pack8(o);
        }
        if (lane < 32) {
            float v[8], gt[8], gw[8];
            unpack8(*(const uint4*)(Y + (size_t)tok * DM + 512 + 8 * lane), v);
            unpack8(*(const uint4*)(P + row + PC_LR + 8 * lane), gt);
            load8f(ln + 8 * (lane & 7), gw);
            float ss = 0.f;
#pragma unroll
            for (int i = 0; i < 8; ++i) ss += v[i] * v[i];
            const float rs = rsqrtf(oct_sum(ss) * (1.f / 64.f) + EPS);
            float o[8];
#pragma unroll
            for (int i = 0; i < 8; ++i) o[i] = v[i] * rs * gw[i] * silu_f(gt[i]);
            *(uint4*)(Y + (size_t)tok * DM + 512 + 8 * lane) = pack8(o);
        }
    }
}

typedef short bf16x8_t __attribute__((ext_vector_type(8)));
typedef float f32x4_t __attribute__((ext_vector_type(4)));
union BF8 { bf16x8_t v; uint4 u; unsigned w[4]; };


__device__ __forceinline__ void ph_dsa_prep(const Ctx& p, int l) {
    const bf16_t* P = (const bf16_t*)(pws_() + WS_P);
    bf16_t* qn = (bf16_t*)(pws_() + WS_QN);
    bf16_t* kn = (bf16_t*)(pws_() + WS_KN);
    bf16_t* ikn = (bf16_t*)(pws_() + WS_IKN);
    bf16_t* vt = (bf16_t*)(pws_() + WS_VT);
    const float* qg = pin_(17) + (size_t)l * 64;
    const float* kg = pin_(18) + (size_t)l * 64;
    const float* ig = pin_(19) + (size_t)l * 32;
    const int lane = tid_() & 63;
    const int pcol = lane < 40 ? PC_DQ + 8 * lane : PC_IK + 8 * (lane & 3);
    float gw[8];
    load8f(lane < 32 ? qg + 8 * (lane & 7) : (lane < 40 ? kg + 8 * (lane & 7) : ig + 8 * (lane & 3)), gw);
    for (int grp = gwave(); grp < MTOK / 8; grp += nwaves()) {
        const size_t tok0 = (size_t)grp * 8;
        const int b = (int)(tok0 / SEQ), t0 = (int)(tok0 % SEQ);
        unsigned short vv[8];
#pragma unroll
        for (int i = 0; i < 8; ++i) {
            const size_t row = (tok0 + i) * LDP;
            vv[i] = P[row + PC_DV + lane];
            if (lane < 44) {
                float v[8];
                unpack8(*(const uint4*)(P + row + pcol), v);
                float ss = 0.f;
#pragma unroll
                for (int q = 0; q < 8; ++q) ss += v[q] * v[q];
                const float s4 = ss + __int_as_float(__builtin_amdgcn_mov_dpp(__float_as_int(ss), 0xB1, 0xF, 0xF, true));
                const float s4b = s4 + __int_as_float(__builtin_amdgcn_mov_dpp(__float_as_int(s4), 0x4E, 0xF, 0xF, true));
                const float s8 = s4b + __int_as_float(__builtin_amdgcn_mov_dpp(__float_as_int(s4b), 0x141, 0xF, 0xF, true));
                const float rs = lane < 40 ? rsqrtf(s8 * (1.f / 64.f) + EPS) * (lane < 32 ? 0.125f : 1.f) : rsqrtf(s4b * (1.f / 32.f) + EPS);
                float o[8];
#pragma unroll
                for (int q = 0; q < 8; ++q) o[q] = v[q] * rs * gw[q];
                const uint4 pk = pack8(o);
                if (lane < 32) *(uint4*)(qn + (tok0 + i) * 256 + 8 * lane) = pk;
                else if (lane < 40) *(uint4*)(kn + (tok0 + i) * 64 + 8 * (lane - 32)) = pk;
                else *(uint4*)(ikn + (tok0 + i) * 32 + 8 * (lane - 40)) = pk;
            }
        }
        uint4 o; o.x = (unsigned)vv[0] | ((unsigned)vv[1] << 16); o.y = (unsigned)vv[2] | ((unsigned)vv[3] << 16);
        o.z = (unsigned)vv[4] | ((unsigned)vv[5] << 16); o.w = (unsigned)vv[6] | ((unsigned)vv[7] << 16);
        *(uint4*)(vt + ((size_t)b * 64 + lane) * SEQ + t0) = o;
    }
}

#define DSA_STRIDE 2052
__device__ __forceinline__ void ph_dsa_main(const Ctx& p, int l, float* smem) {
    const bf16_t* P = (const bf16_t*)(pws_() + WS_P);
    bf16_t* Y = (bf16_t*)(pws_() + WS_Y);
    const bf16_t* QN = (const bf16_t*)(pws_() + WS_QN);
    const bf16_t* KN = (const bf16_t*)(pws_() + WS_KN);
    const bf16_t* IKN = (const bf16_t*)(pws_() + WS_IKN);
    const bf16_t* VT = (const bf16_t*)(pws_() + WS_VT);
    unsigned* sc = (unsigned*)smem;
    float* part = smem;
    float* plsum = smem + 8 * 64 * 64;
    unsigned* thr = (unsigned*)(smem + 35000);
    const int tid = tid_(), lane = tid & 63, w = tid >> 6, qi = lane & 15, g = lane >> 4;
    for (int task = bid_(); task < MTOK / 16; task += nblk_()) {
        const int c = 31 - task / 128, b = (task >> 2) & 31, sub = task & 3;
        const int t0 = c * 64 + sub * 16, nk = (c + 1) * 64;
        const size_t tok0 = (size_t)b * SEQ + t0;
        const bool dosel = nk > 256;
        if (dosel) {
            BF8 iqf[8]; float wq[8];
#pragma unroll
            for (int h = 0; h < 8; ++h) {
                iqf[h].u = *(const uint4*)(P + (tok0 + qi) * LDP + PC_IQ + h * 32 + 8 * g);
                wq[h] = bf2f(P[(tok0 + qi) * LDP + PC_IW + h]) * 0.0625f;
            }
            for (int kt = w; kt < nk / 16; kt += 8) {
                const int s0 = kt * 16;
                BF8 ka; ka.u = *(const uint4*)(IKN + ((size_t)b * SEQ + s0 + qi) * 32 + 8 * g);
                float acc[4] = {0.f, 0.f, 0.f, 0.f};
#pragma unroll
                for (int h = 0; h < 8; ++h) {
                    const f32x4_t d = __builtin_amdgcn_mfma_f32_16x16x32_bf16(ka.v, iqf[h].v, (f32x4_t){0.f, 0.f, 0.f, 0.f}, 0, 0, 0);
#pragma unroll
                    for (int r = 0; r < 4; ++r) acc[r] = __builtin_fmaf(wq[h], fmaxf(d[r], 0.f), acc[r]);
                }
                uint4 kv; kv.x = ford(acc[0]); kv.y = ford(acc[1]); kv.z = ford(acc[2]); kv.w = ford(acc[3]);
                *(uint4*)(sc + qi * DSA_STRIDE + s0 + 4 * g) = kv;
            }
        }
        __syncthreads();
        if (dosel) {
            const int nj = nk >> 6;
#pragma unroll 1
            for (int qq = 0; qq < 2; ++qq) {
                const int q = 2 * w + qq;
                unsigned kreg[32];
#pragma unroll
                for (int j = 0; j < 32; ++j) kreg[j] = (j < nj) ? sc[q * DSA_STRIDE + j * 64 + lane] : 0u;
                unsigned T = 0u; bool exact = false;
                for (int bit = 31; bit >= 0; --bit) {
                    const unsigned cand = T | (1u << bit);
                    int cnt = 0;
#pragma unroll
                    for (int j = 0; j < 32; ++j) cnt += __popcll(__ballot(kreg[j] >= cand));
                    if (cnt >= 256) { T = cand; if (cnt == 256) { exact = true; break; } }
                }
                int cut = 0x7fffffff;
                if (!exact) {
                    int cgt = 0, ceq = 0;
#pragma unroll
                    for (int j = 0; j < 32; ++j) { cgt += __popcll(__ballot(kreg[j] > T)); ceq += __popcll(__ballot(kreg[j] == T)); }
                    int need = 256 - cgt;
                    if (ceq > need) {
                        bool found = false;
#pragma unroll
                        for (int j = 0; j < 32; ++j) {
                            const unsigned long long m = __ballot(kreg[j] == T);
                            const int cj = __popcll(m);
                            if (!found) {
                                if (need <= cj) { for (int bpos = 0; bpos < 64; ++bpos) if ((m >> bpos) & 1ull) { if (--need == 0) { cut = j * 64 + bpos; break; } } found = true; }
                                else need -= cj;
                            }
                        }
                    }
                }
                if (lane == 0) { thr[q] = T; thr[16 + q] = (unsigned)cut; }
            }
        }
        __syncthreads();
        unsigned Tq = 0u; int cutq = 0x7fffffff;
        if (dosel) { Tq = thr[qi]; cutq = (int)thr[16 + qi]; }
        f32x4_t oacc[4][4]; float lsum[4];
#pragma unroll
        for (int h = 0; h < 4; ++h) { lsum[h] = 0.f;
#pragma unroll
            for (int dt = 0; dt < 4; ++dt) oacc[h][dt] = (f32x4_t){0.f, 0.f, 0.f, 0.f}; }
        const int krow = 8 * (qi >> 2) + (qi & 3);
        for (int st = w; st < nk / 32; st += 8) {
            const int s0 = st * 32;
            BF8 ka[2][2], va[4];
#pragma unroll
            for (int t = 0; t < 2; ++t)
#pragma unroll
                for (int s2 = 0; s2 < 2; ++s2) ka[t][s2].u = *(const uint4*)(KN + ((size_t)b * SEQ + s0 + krow + 4 * t) * 64 + 32 * s2 + 8 * g);
#pragma unroll
            for (int dt = 0; dt < 4; ++dt) va[dt].u = *(const uint4*)(VT + ((size_t)b * 64 + 16 * dt + qi) * SEQ + s0 + 8 * g);
            float mk[8];
            if (dosel) {
                const uint4 k0 = *(const uint4*)(sc + qi * DSA_STRIDE + s0 + 8 * g), k1 = *(const uint4*)(sc + qi * DSA_STRIDE + s0 + 8 * g + 4);
                const unsigned kk[8] = {k0.x, k0.y, k0.z, k0.w, k1.x, k1.y, k1.z, k1.w};
#pragma unroll
                for (int j = 0; j < 8; ++j) mk[j] = (kk[j] > Tq || (kk[j] == Tq && (s0 + 8 * g + j) <= cutq)) ? 1.f : 0.f;
            } else {
#pragma unroll
                for (int j = 0; j < 8; ++j) mk[j] = 1.f;
            }
#pragma unroll
            for (int h = 0; h < 4; ++h) {
                BF8 q0, q1;
                q0.u = *(const uint4*)(QN + (tok0 + qi) * 256 + h * 64 + 8 * g);
                q1.u = *(const uint4*)(QN + (tok0 + qi) * 256 + h * 64 + 32 + 8 * g);
                f32x4_t sacc[2];
#pragma unroll
                for (int t = 0; t < 2; ++t) {
                    sacc[t] = __builtin_amdgcn_mfma_f32_16x16x32_bf16(ka[t][0].v, q0.v, (f32x4_t){0.f, 0.f, 0.f, 0.f}, 0, 0, 0);
                    sacc[t] = __builtin_amdgcn_mfma_f32_16x16x32_bf16(ka[t][1].v, q1.v, sacc[t], 0, 0, 0);
                }
                float pe[8];
#pragma unroll
                for (int t = 0; t < 2; ++t)
#pragma unroll
                    for (int r = 0; r < 4; ++r) { pe[4 * t + r] = __expf(sacc[t][r]) * mk[4 * t + r]; lsum[h] += pe[4 * t + r]; }
                BF8 pf;
#pragma unroll
                for (int j = 0; j < 4; ++j) pf.w[j] = pk_bf16(pe[2 * j], pe[2 * j + 1]);
#pragma unroll
                for (int dt = 0; dt < 4; ++dt) oacc[h][dt] = __builtin_amdgcn_mfma_f32_16x16x32_bf16(va[dt].v, pf.v, oacc[h][dt], 0, 0, 0);
            }
        }
        __syncthreads();
#pragma unroll
        for (int h = 0; h < 4; ++h) {
            plsum[(w * 4 + h) * 64 + lane] = lsum[h];
#pragma unroll
            for (int dt = 0; dt < 4; ++dt)
#pragma unroll
                for (int r = 0; r < 4; ++r) part[(w * 64 + h * 16 + dt * 4 + r) * 64 + lane] = oacc[h][dt][r];
        }
        __syncthreads();
        {
            const int h = w >> 1;
            float lq = 0.f;
#pragma unroll
            for (int w2 = 0; w2 < 8; ++w2)
#pragma unroll
                for (int g2 = 0; g2 < 4; ++g2) lq += plsum[(w2 * 4 + h) * 64 + qi + 16 * g2];
            const float inv = 1.f / lq;
#pragma unroll
            for (int dd = 0; dd < 2; ++dd) {
                const int dt = (w & 1) * 2 + dd;
                float o[4];
#pragma unroll
                for (int r = 0; r < 4; ++r) {
                    float sacc = 0.f;
#pragma unroll
                    for (int w2 = 0; w2 < 8; ++w2) sacc += part[(w2 * 64 + h * 16 + dt * 4 + r) * 64 + lane];
                    o[r] = sacc * inv;
                }
                uint2 ov; ov.x = pk_bf16(o[0], o[1]); ov.y = pk_bf16(o[2], o[3]);
                *(uint2*)(Y + (tok0 + qi) * DM + 768 + h * 64 + 16 * dt + 4 * g) = ov;
            }
        }
        __syncthreads();
    }
}

__device__ __forceinline__ void ph_mem_prep(const Ctx& p, int l) {
    const float* Km = (const float*)(pws_() + WS_KM);
    const float* Vm = (const float*)(pws_() + WS_VM);
    bf16_t* KB = (bf16_t*)(pws_() + WS_KB);
    bf16_t* VTB = (bf16_t*)(pws_() + WS_VTB);
    const float* kg = pin_(28) + (size_t)l * 64;
    const int lane = tid_() & 63;
    for (int r = gwave(); r < MMEM; r += nwaves()) {
        const int b = r / NMEM, j = r % NMEM;
#pragma unroll
        for (int h = 0; h < 4; ++h) {
            const float v = Km[(size_t)r * 256 + h * 64 + lane];
            const float ss = wave_sum(v * v);
            KB[(((size_t)b * 4 + h) * NMEM + j) * 64 + lane] = f2bf(v * rsqrtf(ss * (1.f / 64.f) + EPS) * kg[lane]);
            VTB[(((size_t)b * 4 + h) * 64 + lane) * NMEM + j] = f2bf(Vm[(size_t)r * 256 + h * 64 + lane]);
        }
    }
}
__device__ __forceinline__ void ph_xattn(const Ctx& p, int l, int task0 = 0, int ntask = MTOK / 16, int w0 = -1, int wstep = 0) {
    const float* Qx = (const float*)(pws_() + WS_QX);
    bf16_t* Ox = (bf16_t*)(pws_() + WS_OX);
    const bf16_t* KB = (const bf16_t*)(pws_() + WS_KB);
    const bf16_t* VTB = (const bf16_t*)(pws_() + WS_VTB);
    const float* qg = pin_(27) + (size_t)l * 64;
    const int lane = tid_() & 63, qi = lane & 15, g = lane >> 4;
    if (w0 < 0) { w0 = gwave(); wstep = nwaves(); }
    for (int task = task0 + w0; task < task0 + ntask; task += wstep) {
        const int tok0 = task * 16, b = tok0 / SEQ;
#pragma unroll 1
        for (int h = 0; h < 4; ++h) {
            BF8 qf[2];
            {
                float qv[2][8]; float ss = 0.f;
#pragma unroll
                for (int s2 = 0; s2 < 2; ++s2) {
                    const float4* qp = (const float4*)(Qx + (size_t)(tok0 + qi) * 256 + h * 64 + 32 * s2 + 8 * g);
                    const float4 a = qp[0], c = qp[1];
                    qv[s2][0] = a.x; qv[s2][1] = a.y; qv[s2][2] = a.z; qv[s2][3] = a.w; qv[s2][4] = c.x; qv[s2][5] = c.y; qv[s2][6] = c.z; qv[s2][7] = c.w;
#pragma unroll
                    for (int j = 0; j < 8; ++j) ss += qv[s2][j] * qv[s2][j];
                }
                ss += __shfl_xor(ss, 16, 64); ss += __shfl_xor(ss, 32, 64);
                const float rs = rsqrtf(ss * (1.f / 64.f) + EPS) * 0.125f;
#pragma unroll
                for (int s2 = 0; s2 < 2; ++s2) {
                    const float4 g0 = *(const float4*)(qg + 32 * s2 + 8 * g), g1 = *(const float4*)(qg + 32 * s2 + 8 * g + 4);
                    qf[s2].w[0] = pk_bf16(qv[s2][0] * rs * g0.x, qv[s2][1] * rs * g0.y); qf[s2].w[1] = pk_bf16(qv[s2][2] * rs * g0.z, qv[s2][3] * rs * g0.w);
                    qf[s2].w[2] = pk_bf16(qv[s2][4] * rs * g1.x, qv[s2][5] * rs * g1.y); qf[s2].w[3] = pk_bf16(qv[s2][6] * rs * g1.z, qv[s2][7] * rs * g1.w);
                }
            }
            const bf16_t* Kh = KB + ((size_t)b * 4 + h) * NMEM * 64;
            const bf16_t* Vh = VTB + ((size_t)b * 4 + h) * 64 * NMEM;
            f32x4_t oacc[4];
#pragma unroll
            for (int dt = 0; dt < 4; ++dt) oacc[dt] = (f32x4_t){0.f, 0.f, 0.f, 0.f};
            float lsum = 0.f;
            const int krow = 8 * (qi >> 2) + (qi & 3);
#pragma unroll 2
            for (int s0 = 0; s0 < NMEM; s0 += 32) {
                BF8 ka[2][2], va[4];
#pragma unroll
                for (int t = 0; t < 2; ++t)
#pragma unroll
                    for (int s2 = 0; s2 < 2; ++s2) ka[t][s2].u = *(const uint4*)(Kh + (size_t)(s0 + krow + 4 * t) * 64 + 32 * s2 + 8 * g);
#pragma unroll
                for (int dt = 0; dt < 4; ++dt) va[dt].u = *(const uint4*)(Vh + (size_t)(16 * dt + qi) * NMEM + s0 + 8 * g);
                f32x4_t sacc[2];
#pragma unroll
                for (int t = 0; t < 2; ++t) {
                    sacc[t] = (f32x4_t){0.f, 0.f, 0.f, 0.f};
                    sacc[t] = __builtin_amdgcn_mfma_f32_16x16x32_bf16(ka[t][0].v, qf[0].v, sacc[t], 0, 0, 0);
                    sacc[t] = __builtin_amdgcn_mfma_f32_16x16x32_bf16(ka[t][1].v, qf[1].v, sacc[t], 0, 0, 0);
                }
                float pe[8];
#pragma unroll
                for (int t = 0; t < 2; ++t)
#pragma unroll
                    for (int r = 0; r < 4; ++r) { pe[4 * t + r] = __expf(sacc[t][r]); lsum += pe[4 * t + r]; }
                BF8 pf;
#pragma unroll
                for (int j = 0; j < 4; ++j) pf.w[j] = pk_bf16(pe[2 * j], pe[2 * j + 1]);
#pragma unroll
                for (int dt = 0; dt < 4; ++dt) oacc[dt] = __builtin_amdgcn_mfma_f32_16x16x32_bf16(va[dt].v, pf.v, oacc[dt], 0, 0, 0);
            }
            lsum += __shfl_xor(lsum, 16, 64); lsum += __shfl_xor(lsum, 32, 64);
            const float inv = 1.f / lsum;
#pragma unroll
            for (int dt = 0; dt < 4; ++dt) {
                uint2 o; o.x = pk_bf16(oacc[dt][0] * inv, oacc[dt][1] * inv); o.y = pk_bf16(oacc[dt][2] * inv, oacc[dt][3] * inv);
                *(uint2*)(Ox + (size_t)(tok0 + qi) * 256 + h * 64 + 16 * dt + 4 * g) = o;
            }
        }
    }
}

template <int N> __device__ __forceinline__ void bitonic_sort_desc(unsigned (&a)[N]) {
#pragma unroll
    for (int k = 2; k <= N; k <<= 1)
#pragma unroll
        for (int j = k >> 1; j > 0; j >>= 1)
#pragma unroll
            for (int i = 0; i < N; ++i) {
                const int o = i ^ j;
                if (o > i) {
                    const bool desc = ((i & k) == 0);
                    const unsigned x = a[i], y = a[o];
                    const unsigned mx = x > y ? x : y, mn = x > y ? y : x;
                    a[i] = desc ? mx : mn; a[o] = desc ? mn : mx;
                }
            }
}
__device__ __forceinline__ void bitonic_merge16_desc(unsigned (&a)[16]) {
#pragma unroll
    for (int j = 8; j > 0; j >>= 1)
#pragma unroll
        for (int i = 0; i < 16; ++i) {
            const int o = i ^ j;
            if (o > i) { const unsigned x = a[i], y = a[o]; a[i] = x > y ? x : y; a[o] = x > y ? y : x; }
        }
}
__device__ __forceinline__ void top16_merge(unsigned (&a)[16], const unsigned (&b)[16]) {
#pragma unroll
    for (int i = 0; i < 16; ++i) a[i] = a[i] > b[15 - i] ? a[i] : b[15 - i];
    bitonic_merge16_desc(a);
}
__device__ __forceinline__ void top16_xlane(unsigned (&a)[16], int xm) {
    unsigned b[16];
#pragma unroll
    for (int i = 0; i < 16; ++i) b[i] = (unsigned)__shfl_xor((int)a[i], xm, 64);
    top16_merge(a, b);
}
__device__ __forceinline__ void ph_subkeys_convert(const Ctx& p) {
    const float* sk = pin_(31);
    bf16_t* o = (bf16_t*)(pws_() + WS_SKB);
    const size_t n = (size_t)DEPTH * 8 * 2 * 128 * 64;
    for (size_t i = (size_t)bid_() * 512 + tid_(); i < n; i += (size_t)nblk_() * 512) o[i] = f2bf(sk[i]);
}
__device__ __forceinline__ void ph_peer_topk(const Ctx& p, int l, float* smem, int task0 = 0, int ntask = MTOK / 16, int w0 = -1, int wstep = 0) {
    const bf16_t* Qp = (const bf16_t*)(pws_() + WS_QP);
    const bf16_t* SK = (const bf16_t*)(pws_() + WS_SKB) + (size_t)l * 8 * 2 * 128 * 64;
    int* pidx = (int*)(pws_() + WS_PEI);
    float* pgt = (float*)(pws_() + WS_PEG);
    float* pus = (float*)(pws_() + WS_PUS);
    const float* usc = (const float*)(pws_() + WS_USC) + (size_t)l * NEXP;
    const float* vsc = (const float*)(pws_() + WS_VSC) + (size_t)l * NEXP;
    const int tid = tid_(), lane = tid & 63, wave = tid >> 6, qi = lane & 15, g = lane >> 4;
    int* tabw = (int*)smem + wave * 512 + qi * 32;
    if (w0 < 0) { w0 = gwave(); wstep = nwaves(); }
    for (int task = task0 + w0; task < task0 + ntask; task += wstep) {
        const size_t tok = (size_t)task * 16 + qi;
#pragma unroll 1
        for (int h = 0; h < 8; ++h) {
            unsigned L[2][16];
#pragma unroll
            for (int pp = 0; pp < 2; ++pp) {
                BF8 qf[2];
#pragma unroll
                for (int s2 = 0; s2 < 2; ++s2) qf[s2].u = *(const uint4*)(Qp + tok * DM + h * 128 + pp * 64 + 32 * s2 + 8 * g);
                const bf16_t* skp = SK + (size_t)(h * 2 + pp) * 128 * 64;
                unsigned va[16], vb[16];
#pragma unroll
                for (int tile = 0; tile < 8; ++tile) {
                    BF8 ka[2];
#pragma unroll
                    for (int s2 = 0; s2 < 2; ++s2) ka[s2].u = *(const uint4*)(skp + (size_t)(16 * tile + qi) * 64 + 32 * s2 + 8 * g);
                    f32x4_t d = __builtin_amdgcn_mfma_f32_16x16x32_bf16(ka[0].v, qf[0].v, (f32x4_t){0.f, 0.f, 0.f, 0.f}, 0, 0, 0);
                    d = __builtin_amdgcn_mfma_f32_16x16x32_bf16(ka[1].v, qf[1].v, d, 0, 0, 0);
#pragma unroll
                    for (int r = 0; r < 4; ++r) {
                        const unsigned key = (ford(d[r]) & ~127u) | (unsigned)(127 - (16 * tile + 4 * g + r));
                        if (tile < 4) va[tile * 4 + r] = key; else vb[(tile - 4) * 4 + r] = key;
                    }
                }
                bitonic_sort_desc<16>(va);
                bitonic_sort_desc<16>(vb);
                top16_merge(va, vb);
                top16_xlane(va, 16);
                top16_xlane(va, 32);
#pragma unroll
                for (int i = 0; i < 16; ++i) L[pp][i] = va[i];
            }
            if (g < 2) {
#pragma unroll
                for (int i = 0; i < 16; ++i) tabw[g * 16 + i] = 127 - (int)((g == 0 ? L[0][i] : L[1][i]) & 127u);
            }
            float s1[16], s2v[16];
#pragma unroll
            for (int i = 0; i < 16; ++i) { s1[i] = funord(L[0][i] & ~127u); s2v[i] = funord(L[1][i] & ~127u); }
            unsigned ca[16], cb[16];
#pragma unroll
            for (int i = 0; i < 16; ++i) { ca[i] = 0u; cb[i] = 0u; }
            {
                const float r0 = g == 0 ? s1[0] : (g == 1 ? s1[1] : (g == 2 ? s1[2] : s1[3]));
                const int nb0 = g == 0 ? 16 : (g == 1 ? 8 : (g == 2 ? 5 : 4));
#pragma unroll
                for (int bq = 0; bq < 16; ++bq) if (bq < nb0) ca[bq] = (ford(r0 + s2v[bq]) & ~255u) | (unsigned)(255 - (g * 16 + bq));
                const float r1 = g == 0 ? s1[4] : (g == 1 ? s1[5] : (g == 2 ? s1[6] : s1[7]));
                const int nb1 = g == 0 ? 3 : 2;
#pragma unroll
                for (int bq = 0; bq < 3; ++bq) if (bq < nb1) cb[bq] = (ford(r1 + s2v[bq]) & ~255u) | (unsigned)(255 - ((g + 4) * 16 + bq));
                const float r2 = g == 0 ? s1[8] : (g == 1 ? s1[9] : (g == 2 ? s1[10] : s1[11]));
                cb[3] = (ford(r2 + s2v[0]) & ~255u) | (unsigned)(255 - ((g + 8) * 16));
                const float r3 = g == 0 ? s1[12] : (g == 1 ? s1[13] : (g == 2 ? s1[14] : s1[15]));
                cb[4] = (ford(r3 + s2v[0]) & ~255u) | (unsigned)(255 - ((g + 12) * 16));
            }
            bitonic_sort_desc<16>(ca);
            bitonic_sort_desc<16>(cb);
            top16_merge(ca, cb);
            top16_xlane(ca, 16);
            top16_xlane(ca, 32);
            float tv[16]; float den = 0.f;
#pragma unroll
            for (int i = 0; i < 16; ++i) {
                const int f = 255 - (int)(ca[i] & 255u);
                const int a = f >> 4, bq = f & 15;
                tv[i] = funord(ca[i] & ~255u);
                (void)a; (void)bq;
            }
#pragma unroll
            for (int i = 0; i < 16; ++i) { tv[i] = __expf(tv[i] - funord(ca[0] & ~255u)); den += tv[i]; }
            const float inv = 1.f / den;
            int ev[4]; float gv[4];
#pragma unroll
            for (int r = 0; r < 4; ++r) {
                const unsigned key = g == 0 ? ca[r] : (g == 1 ? ca[4 + r] : (g == 2 ? ca[8 + r] : ca[12 + r]));
                const float tvv = g == 0 ? tv[r] : (g == 1 ? tv[4 + r] : (g == 2 ? tv[8 + r] : tv[12 + r]));
                const int f = 255 - (int)(key & 255u);
                ev[r] = tabw[f >> 4] * 128 + tabw[16 + (f & 15)];
                gv[r] = tvv * inv;
            }
            float us[4];
#pragma unroll
            for (int r = 0; r < 4; ++r) { us[r] = usc[ev[r]]; gv[r] *= vsc[ev[r]]; }
            *(int4*)(pidx + tok * 128 + h * 16 + 4 * g) = make_int4(ev[0], ev[1], ev[2], ev[3]);
            *(float4*)(pgt + tok * 128 + h * 16 + 4 * g) = make_float4(gv[0], gv[1], gv[2], gv[3]);
            *(float4*)(pus + tok * 128 + h * 16 + 4 * g) = make_float4(us[0], us[1], us[2], us[3]);
        }
    }
}

typedef float f32x2_t __attribute__((ext_vector_type(2)));
typedef int i32x8_t __attribute__((ext_vector_type(8)));
__device__ __forceinline__ unsigned pack4_fp8(float4 a, float sc) {
    const float x = fminf(fmaxf(a.x * sc, -448.f), 448.f), y = fminf(fmaxf(a.y * sc, -448.f), 448.f);
    const float z = fminf(fmaxf(a.z * sc, -448.f), 448.f), w = fminf(fmaxf(a.w * sc, -448.f), 448.f);
    int r = __builtin_amdgcn_cvt_pk_fp8_f32(x, y, 0, false);
    r = __builtin_amdgcn_cvt_pk_fp8_f32(z, w, r, true);
    return (unsigned)r;
}
__device__ __forceinline__ unsigned q4_e2m1(float y) {
    const float a = fabsf(y);
    const unsigned c = (unsigned)(a > 0.25f) + (unsigned)(a > 0.75f) + (unsigned)(a > 1.25f) + (unsigned)(a > 1.75f) + (unsigned)(a > 2.5f) + (unsigned)(a > 3.5f) + (unsigned)(a > 5.0f);
    return c | (y < 0.f ? 8u : 0u);
}
__device__ __forceinline__ void ph_tab_convert_all(const Ctx& p) {
    const int lane = tid_() & 63;
    for (int row = gwave(); row < 2 * DEPTH * NEXP; row += nwaves()) {
        const int tabv = row >= DEPTH * NEXP;
        const int rr = tabv ? row - DEPTH * NEXP : row;
        const float4* src = (const float4*)((tabv ? pin_(33) : pin_(32)) + (size_t)rr * DM);
        float4 v[4]; float am = 0.f;
#pragma unroll
        for (int i = 0; i < 4; ++i) { v[i] = src[lane + 64 * i]; am = fmaxf(am, fmaxf(fmaxf(fabsf(v[i].x), fabsf(v[i].y)), fmaxf(fabsf(v[i].z), fabsf(v[i].w)))); }
        am = wave_max(am);
        const float sc = am > 0.f ? am * (1.f / 6.f) : 1.f, inv = 1.f / sc;
        unsigned char* dst = (unsigned char*)(pws_() + (tabv ? WS_V4 : WS_U4)) + (size_t)rr * 512;
#pragma unroll
        for (int i = 0; i < 4; ++i) {
            const unsigned pk = q4_e2m1(v[i].x * inv) | (q4_e2m1(v[i].y * inv) << 4) | (q4_e2m1(v[i].z * inv) << 8) | (q4_e2m1(v[i].w * inv) << 12);
            const int off = tabv ? 16 * (lane >> 1) + 4 * i + 2 * (lane & 1) : 128 * i + 2 * lane;
            *(unsigned short*)(dst + off) = (unsigned short)pk;
        }
        if (lane == 0) ((float*)(pws_() + (tabv ? WS_VSC : WS_USC)))[rr] = sc;
    }
}
__device__ __forceinline__ void ph_peer_u4(const Ctx& p, int l, float* smem) {
    const unsigned char* ut = (const unsigned char*)(pws_() + WS_U4) + (size_t)l * NEXP * 512;
    const int* pidx = (const int*)(pws_() + WS_PEI);
    float* pgt = (float*)(pws_() + WS_PEG);
    const float* pus = (const float*)(pws_() + WS_PUS);
    const unsigned char* H8 = (const unsigned char*)(pws_() + WS_H8);
    const int lane = tid_() & 63, g = lane >> 4, i = lane & 15, wave = tid_() >> 6;
    unsigned char* hl = (unsigned char*)smem + wave * 2048;
    const int nw = nwaves();
    int tok = gwave();
    int ne0 = pidx[(size_t)tok * 128 + lane], ne1 = pidx[(size_t)tok * 128 + 64 + lane];
    *(uint4*)(hl + 16 * lane) = *(const uint4*)(H8 + (size_t)tok * DM + 16 * lane);
    uint4 rA[8], rB[8], rC[8], rD[8];
#define PU_ROWS(buf, esrc, hq) do { const int er_ = __builtin_amdgcn_ds_bpermute(((hq) * 16 + i) * 4, esrc); \
        const unsigned char* ap_ = ut + (size_t)er_ * 512 + 32 * g; \
        _Pragma("unroll") for (int j_ = 0; j_ < 4; ++j_) { buf[2 * j_] = *(const uint4*)(ap_ + 128 * j_); buf[2 * j_ + 1] = *(const uint4*)(ap_ + 128 * j_ + 16); } \
        __builtin_amdgcn_sched_barrier(0); } while (0)
#define PU_COMP(buf, hd) do { f32x4_t acc_ = {0.f, 0.f, 0.f, 0.f}; \
        _Pragma("unroll") for (int q_ = 0; q_ < 8; ++q_) { \
            const uint4 b0_ = *(const uint4*)(hb + 256 * (q_ >> 1) + 32 * (q_ & 1)), b1_ = *(const uint4*)(hb + 256 * (q_ >> 1) + 32 * (q_ & 1) + 128); \
            const i32x8_t a_ = {(int)buf[q_].x, (int)buf[q_].y, (int)buf[q_].z, (int)buf[q_].w, 0, 0, 0, 0}; \
            const i32x8_t b_ = {(int)b0_.x, (int)b0_.y, (int)b0_.z, (int)b0_.w, (int)b1_.x, (int)b1_.y, (int)b1_.z, (int)b1_.w}; \
            acc_ = __builtin_amdgcn_mfma_scale_f32_16x16x128_f8f6f4(a_, b_, acc_, 4, 0, 0, 0, 0, 0); \
            if (q_ & 1) __builtin_amdgcn_sched_barrier(0); } \
        if (i == (hd)) keep = acc_; \
        __builtin_amdgcn_sched_barrier(0); } while (0)
    PU_ROWS(rA, ne0, 0); PU_ROWS(rB, ne0, 1); PU_ROWS(rC, ne0, 2);
    int par = 0;
    for (; tok < MTOK; tok += nw, par ^= 1) {
        const int e0 = ne0, e1 = ne1;
        const size_t tn = (size_t)(tok + nw < MTOK ? tok + nw : tok);
        const uint4 hnext = *(const uint4*)(H8 + tn * DM + 16 * lane);
        ne0 = pidx[tn * 128 + lane]; ne1 = pidx[tn * 128 + 64 + lane];
        const size_t mi = (size_t)tok * 128 + (i & 7) * 16 + 4 * g;
        const float4 gm = *(const float4*)(pgt + mi), um = *(const float4*)(pus + mi);
        asm volatile("s_waitcnt lgkmcnt(0)" ::: "memory"); __builtin_amdgcn_wave_barrier();
        const unsigned char* hb = hl + par * 1024 + 64 * (g >> 1) + 16 * (g & 1);
        f32x4_t keep = {0.f, 0.f, 0.f, 0.f};
        PU_ROWS(rD, e0, 3); PU_COMP(rA, 0);
        PU_ROWS(rA, e1, 0); PU_COMP(rB, 1);
        PU_ROWS(rB, e1, 1); PU_COMP(rC, 2);
        PU_ROWS(rC, e1, 2); PU_COMP(rD, 3);
        PU_ROWS(rD, e1, 3); PU_COMP(rA, 4);
        PU_ROWS(rA, ne0, 0); PU_COMP(rB, 5);
        PU_ROWS(rB, ne0, 1); PU_COMP(rC, 6);
        PU_ROWS(rC, ne0, 2); PU_COMP(rD, 7);
        *(uint4*)(hl + (par ^ 1) * 1024 + 16 * lane) = hnext;
        if (i < 8) {
            float4 o;
            o.x = gm.x * gelu_tanh_f(keep[0] * um.x * (1.f / H8_SCALE)); o.y = gm.y * gelu_tanh_f(keep[1] * um.y * (1.f / H8_SCALE));
            o.z = gm.z * gelu_tanh_f(keep[2] * um.z * (1.f / H8_SCALE)); o.w = gm.w * gelu_tanh_f(keep[3] * um.w * (1.f / H8_SCALE));
            *(float4*)(pgt + mi) = o;
        }
    }
#undef PU_ROWS
#undef PU_COMP
}
__device__ __forceinline__ void ph_peer_v4(const Ctx& p, int l) {
    const unsigned char* vt = (const unsigned char*)(pws_() + WS_V4) + (size_t)l * NEXP * 512;
    const int* pidx = (const int*)(pws_() + WS_PEI);
    const float* pgt = (const float*)(pws_() + WS_PEG);
    float* x = pout_();
    const int lane = tid_() & 63;
    const bool r = lane & 32;
    const int coff = 16 * (lane & 31);
    const int nw = nwaves();
    int tok = gwave();
    int ne0 = pidx[(size_t)tok * 128 + lane], ne1 = pidx[(size_t)tok * 128 + 64 + lane];
    float nc0 = pgt[(size_t)tok * 128 + lane], nc1 = pgt[(size_t)tok * 128 + 64 + lane];
    for (; tok < MTOK; tok += nw) {
        const int e0 = ne0, e1 = ne1;
        const float c0 = nc0, c1 = nc1;
        if (tok + nw < MTOK) {
            const size_t tn = (size_t)(tok + nw);
            ne0 = pidx[tn * 128 + lane]; ne1 = pidx[tn * 128 + 64 + lane];
            nc0 = pgt[tn * 128 + lane]; nc1 = pgt[tn * 128 + 64 + lane];
        }
        f32x2_t out[16];
#pragma unroll
        for (int k = 0; k < 16; ++k) out[k] = (f32x2_t){0.f, 0.f};
#pragma unroll 1
        for (int hb = 0; hb < 4; ++hb) {
            const int esrc = hb < 2 ? e0 : e1;
            const float csrc = hb < 2 ? c0 : c1;
            const int lb = (hb & 1) * 32;
            uint4 vr[16];
#pragma unroll
            for (int k = 0; k < 16; ++k) {
                const int ea = __builtin_amdgcn_readlane(esrc, lb + 2 * k), eb = __builtin_amdgcn_readlane(esrc, lb + 2 * k + 1);
                const int e = r ? eb : ea;
                vr[k] = *(const uint4*)(vt + (size_t)e * 512 + coff);
            }
#pragma unroll
            for (int k = 0; k < 16; ++k) {
                const float ca = __uint_as_float(__builtin_amdgcn_readlane(__float_as_uint(csrc), lb + 2 * k));
                const float cb = __uint_as_float(__builtin_amdgcn_readlane(__float_as_uint(csrc), lb + 2 * k + 1));
                const float cj = r ? cb : ca;
                const f32x2_t c2 = {cj, cj};
#define PV_D4(W, q) do { \
                out[4 * (q) + 0] = __builtin_elementwise_fma(__builtin_amdgcn_cvt_scalef32_pk_f32_fp4(W, 1.0f, 0), c2, out[4 * (q) + 0]); \
                out[4 * (q) + 1] = __builtin_elementwise_fma(__builtin_amdgcn_cvt_scalef32_pk_f32_fp4(W, 1.0f, 1), c2, out[4 * (q) + 1]); \
                out[4 * (q) + 2] = __builtin_elementwise_fma(__builtin_amdgcn_cvt_scalef32_pk_f32_fp4(W, 1.0f, 2), c2, out[4 * (q) + 2]); \
                out[4 * (q) + 3] = __builtin_elementwise_fma(__builtin_amdgcn_cvt_scalef32_pk_f32_fp4(W, 1.0f, 3), c2, out[4 * (q) + 3]); } while (0)
                PV_D4(vr[k].x, 0); PV_D4(vr[k].y, 1); PV_D4(vr[k].z, 2); PV_D4(vr[k].w, 3);
#undef PV_D4
            }
        }
#pragma unroll
        for (int q = 0; q < 4; ++q) {
            float fin[4];
#pragma unroll
            for (int b = 0; b < 2; ++b)
#pragma unroll
                for (int c = 0; c < 2; ++c) {
                    const float lo = out[4 * q + b][c], hi = out[4 * q + 2 + b][c];
                    const float mine = r ? hi : lo, send = r ? lo : hi;
                    fin[2 * b + c] = mine + __shfl_xor(send, 32, 64);
                }
            float4* xp = (float4*)(x + (size_t)tok * DM + 256 * q + 8 * (lane & 31) + (r ? 4 : 0));
            float4 a = *xp;
            a.x += fin[0]; a.y += fin[1]; a.z += fin[2]; a.w += fin[3];
            *xp = a;
        }
    }
}


#ifndef PROBE_MASK
#define PROBE_MASK 0
#endif
#if PROBE_MASK
#define GB(k) do { GRID_BARRIER(); const unsigned long long now_ = wall_clock64(); if ((PROBE_MASK >> (k)) & 1) { const unsigned long long dt_ = now_ - tprev_; while (wall_clock64() - now_ < 3ull * dt_) __builtin_amdgcn_s_sleep(8); } GRID_BARRIER(); tprev_ = wall_clock64(); } while (0)
#else
#define GB(k) GRID_BARRIER()
#endif
__global__ void __launch_bounds__(512, 2) k_mega(Params kp) {
    float* sm = dynsmem;
    {
        unsigned long long* tab = (unsigned long long*)((char*)dynsmem + PTAB_OFF);
        if (threadIdx.x < 34) tab[threadIdx.x] = (unsigned long long)kp.in[threadIdx.x];
        if (threadIdx.x == 34) tab[34] = (unsigned long long)kp.out;
        if (threadIdx.x == 35) tab[35] = (unsigned long long)kp.ws;
        if (threadIdx.x == 36) { tab[36] = 0ull; tab[37] = 0ull; }
    }
    __syncthreads();
    Ctx p; p.kp = &kp;
    (void)xcd_barrier_post((unsigned*)(pws_() + WS_BAR), (volatile LAS unsigned*)((char*)dynsmem + PTAB_OFF + 36 * 8));
#define GRID_BARRIER() do { XcdBarrier bar_; bar_.bar = (unsigned*)(pws_() + WS_BAR); bar_.x = xb_xcc_id(); bar_.st = (volatile LAS unsigned*)((char*)dynsmem + PTAB_OFF + 36 * 8); xcd_barrier(bar_); } while (0)
    ph_weight_prep(p, sm);
    ph_subkeys_convert(p);
    ph_tab_convert_all(p);
    GRID_BARRIER();
#if PROBE_MASK
    unsigned long long tprev_ = wall_clock64();
#endif
#pragma unroll 1
    for (int l = 0; l < DEPTH; ++l) {
#define XIN_ (l == 0 ? pin_(0) : pout_())
#define HBUF_ ((const bf16_t*)(pws_() + WS_H))
        ph_rmsnorm(XIN_, pin_(2) + (size_t)l * DM, (bf16_t*)(pws_() + WS_H), MTOK);
        ph_rmsnorm(pin_(1), pin_(22) + (size_t)l * DM, (bf16_t*)(pws_() + WS_HM), MMEM);
        GB(1);
        { pg8::EpiBf16 E; E.O = (bf16_t*)(pws_() + WS_P); E.ldc = LDP; ph_gemm(HBUF_, (const bf16_t*)(pws_() + WT_IN) + (size_t)l * LDP * DM, MTOK, LDP, DM, E); }
        { pg8::EpiF32 E; E.C = (float*)(pws_() + WS_KM); E.R = nullptr; E.ldc = 256; ph_gemm((const bf16_t*)(pws_() + WS_HM), (const bf16_t*)(pws_() + WT_XK) + (size_t)l * 256 * DM, MMEM, 256, DM, E, 32); }
        { pg8::EpiF32 E; E.C = (float*)(pws_() + WS_VM); E.R = nullptr; E.ldc = 256; ph_gemm((const bf16_t*)(pws_() + WS_HM), (const bf16_t*)(pws_() + WT_XV) + (size_t)l * 256 * DM, MMEM, 256, DM, E, 64); }
        GB(2);
        ph_mem_prep(p, l);
        ph_dsa_prep(p, l);
        ph_scan_prep(p, l);
        GB(3);
        ph_scans(p, l, sm);
        GB(4);
        ph_mixer_finish(p, l);
        ph_dsa_main(p, l, sm);
        GB(5);
#define PANEL_SYNC() do { asm volatile("s_waitcnt vmcnt(0) lgkmcnt(0)" ::: "memory"); __syncthreads(); \
        if (threadIdx.x < 64) { __builtin_amdgcn_fence(__ATOMIC_ACQUIRE, "agent"); asm volatile("s_waitcnt vmcnt(0)" ::: "memory"); } \
        __syncthreads(); } while (0)
        if (nblk_() == MTOK / 256) {
            const int pm = bid_(), wv = tid_() >> 6;
            { pg8::EpiF32 E; E.C = pout_(); E.R = XIN_; E.ldc = DM; ph_gemm_panel((const bf16_t*)(pws_() + WS_Y), (const bf16_t*)(pws_() + WT_OUT) + (size_t)l * DM * DM, MTOK, DM, DM, E, pm); }
            PANEL_SYNC();
            ph_rmsnorm(pout_(), pin_(21) + (size_t)l * DM, (bf16_t*)(pws_() + WS_H), 256, pm * 256, wv, 8);
            PANEL_SYNC();
            { pg8::EpiF32 E; E.C = (float*)(pws_() + WS_QX); E.R = nullptr; E.ldc = 256; ph_gemm_panel(HBUF_, (const bf16_t*)(pws_() + WT_XQ) + (size_t)l * 256 * DM, MTOK, 256, DM, E, pm); }
            PANEL_SYNC();
            ph_xattn(p, l, pm * 16, 16, wv, 8);
            PANEL_SYNC();
            { pg8::EpiF32 E; E.C = pout_(); E.R = pout_(); E.ldc = DM; ph_gemm_panel((const bf16_t*)(pws_() + WS_OX), (const bf16_t*)(pws_() + WT_XO) + (size_t)l * DM * 256, MTOK, DM, 256, E, pm); }
            PANEL_SYNC();
            ph_rmsnorm(pout_(), pin_(29) + (size_t)l * DM, (bf16_t*)(pws_() + WS_H), 256, pm * 256, wv, 8, (unsigned char*)(pws_() + WS_H8));
            PANEL_SYNC();
            { pg8::EpiBf16 E; E.O = (bf16_t*)(pws_() + WS_QP); E.ldc = DM; ph_gemm_panel(HBUF_, (const bf16_t*)(pws_() + WT_PQ) + (size_t)l * DM * DM, MTOK, DM, DM, E, pm); }
            PANEL_SYNC();
            ph_peer_topk(p, l, sm, pm * 16, 16, wv, 8);
        }
        GB(13);
        ph_peer_u4(p, l, sm);
        GB(14);
        ph_peer_v4(p, l);
        GB(17);
    }
}

extern "C" void kernel_launch(void* const* d_in, const int* in_sizes, int n_in, void* d_out, int out_size, void* d_ws, size_t ws_size, hipStream_t stream) {
    if (n_in != 34 || out_size != MTOK * DM || ws_size < WS_END) {
        fprintf(stderr, "kernel_launch: unexpected shapes (n_in %d out %d ws %zu need %zu)\n", n_in, out_size, ws_size, (size_t)WS_END);
        return;
    }
    static int grid = 0;
    if (!grid) {
        int dev = 0, cus = 0, per_cu = 0;
        (void)hipGetDevice(&dev);
        (void)hipDeviceGetAttribute(&cus, hipDeviceAttributeMultiprocessorCount, dev);
        (void)hipFuncSetAttribute((const void*)k_mega, hipFuncAttributeMaxDynamicSharedMemorySize, LDS_BYTES);
        (void)hipOccupancyMaxActiveBlocksPerMultiprocessor(&per_cu, (const void*)k_mega, 512, LDS_BYTES);
        if (per_cu < 1) fprintf(stderr, "kernel_launch: occupancy query reports %d blocks per CU\n", per_cu);
        grid = cus > 0 ? cus : 256;
    }
    Params p; memset(&p, 0, sizeof(p));
    for (int i = 0; i < 34; ++i) p.in[i] = (const float*)d_in[i];
    p.out = (float*)d_out; p.ws = (char*)d_ws;
    (void)hipMemsetAsync((char*)d_ws + WS_BAR, 0, XCD_BAR_WORDS * sizeof(unsigned), stream);
    hipLaunchKernelGGL(k_mega, dim3(grid), dim3(512), LDS_BYTES, stream, p);
}
```

```cpp
#include <hip/hip_runtime.h>
#include <stdint.h>
#include <stdio.h>
#include <string.h>

#define NB 32
#define SEQ 2048
#define DM 1024
#define MTOK (NB * SEQ)
#define DEPTH 4
#define NMEM 256
#define MMEM (NB * NMEM)
#define LDP 3328
#define NEXP 16384
#define EPS 1e-6f
#define PC_Z 0
#define PC_XBC 256
#define PC_GQKV 768
#define PC_GG 1536
#define PC_LQ 1792
#define PC_LK 1920
#define PC_LV 2048
#define PC_LR 2304
#define PC_DQ 2560
#define PC_DK 2816
#define PC_DV 2880
#define PC_IQ 2944
#define PC_IK 3200
#define PC_GLR 3232
#define PC_IW 3248
#define PC_DT 3256
#define PC_GA 3260
#define PC_GB 3264

typedef unsigned short bf16_t;

#define WS_BAR 0ull
#define WS_P 16384ull
#define SZ_P ((size_t)MTOK * LDP * 2)
#define WS_H (WS_P + SZ_P)
#define SZ_H ((size_t)MTOK * DM * 2)
#define WS_Y (WS_H + SZ_H)
#define SZ_Y ((size_t)MTOK * DM * 2)
#define WS_WP (WS_Y + SZ_Y)
#define SZ_WP ((size_t)DEPTH * DM * LDP * 4)
#define WT_IN (WS_WP)
#define WT_OUT (WT_IN + (size_t)DEPTH * LDP * DM * 2)
#define WT_XQ (WT_OUT + (size_t)DEPTH * DM * DM * 2)
#define WT_XK (WT_XQ + (size_t)DEPTH * 256 * DM * 2)
#define WT_XV (WT_XK + (size_t)DEPTH * 256 * DM * 2)
#define WT_XO (WT_XV + (size_t)DEPTH * 256 * DM * 2)
#define WT_PQ (WT_XO + (size_t)DEPTH * DM * 256 * 2)
#define WT_END (WT_PQ + (size_t)DEPTH * DM * DM * 2)
#define WS_QN (WS_WP + SZ_WP)
#define SZ_QN ((size_t)MTOK * 256 * 4)
#define WS_KN (WS_QN + SZ_QN)
#define SZ_KN ((size_t)MTOK * 64 * 4)
#define WS_IKN (WS_KN + SZ_KN)
#define SZ_IKN ((size_t)MTOK * 32 * 4)
#define WS_YPRE (WS_IKN + SZ_IKN)
#define SZ_YPRE ((size_t)MTOK * 256 * 4)
#define WS_HM (WS_YPRE + SZ_YPRE)
#define SZ_HM ((size_t)MMEM * DM * 2)
#define WS_KM (WS_HM + SZ_HM)
#define SZ_KM ((size_t)MMEM * 256 * 4)
#define WS_VM (WS_KM + SZ_KM)
#define SZ_VM ((size_t)MMEM * 256 * 4)
#define WS_KB (WS_VM + SZ_VM)
#define SZ_KB ((size_t)MMEM * 256 * 2)
#define WS_VTB (WS_KB + SZ_KB)
#define SZ_VTB ((size_t)MMEM * 256 * 2)
#define WS_VT (WS_VTB + SZ_VTB)
#define SZ_VT ((size_t)MTOK * 64 * 2)
#define WS_SKB (WS_VT + SZ_VT)
#define SZ_SKB ((size_t)DEPTH * 8 * 2 * 128 * 64 * 2)
#define WS_SC (WS_SKB + SZ_SKB)
#define SZ_SC ((size_t)MTOK * 16 * 4)
#define WS_DUMMY (WS_SC + SZ_SC)
#define SZ_DUMMY (65536ull)
#define WS_U4 (WS_DUMMY + SZ_DUMMY)
#define WS_V4 (WS_U4 + (size_t)DEPTH * NEXP * 512)
#define WS_USC (WS_V4 + (size_t)DEPTH * NEXP * 512)
#define WS_VSC (WS_USC + (size_t)DEPTH * NEXP * 4)
#define WS_END (WS_VSC + (size_t)DEPTH * NEXP * 4)
#define WS_QX (WS_P)
#define WS_OX (WS_P + (size_t)MTOK * 256 * 4)
#define WS_QP (WS_P + 96ull * 1024 * 1024)
#define WS_H8 (WS_P + 224ull * 1024 * 1024)
#define WS_PEI (WS_H8 + (size_t)MTOK * DM)
#define WS_PEG (WS_PEI + (size_t)MTOK * 128 * 4)
#define WS_PUS (WS_PEG + (size_t)MTOK * 128 * 4)
#define WS_PEND (WS_PUS + (size_t)MTOK * 128 * 4)
static_assert(WS_PEND <= WS_P + SZ_P, "P region aliases");

struct Params {
    const float* in[34];
    float* out;
    char* ws;
};

#define XB_TMO      128
#define XB_XCNT(j)  (256  + 64 * (j))
#define XB_XSUB(j)  (1280 + 64 * (j))
#define XB_XGEN(j)  (2304 + 64 * (j))
#define XB_TOP      3328
#define XB_TOPGEN   3392
#define XCD_BAR_WORDS 3456
#define XB_SPIN_CAP (1u << 18)
#define LAS __attribute__((address_space(3)))

__device__ __forceinline__ unsigned xb_ld(unsigned* p)              { return __hip_atomic_load(p, __ATOMIC_RELAXED, __HIP_MEMORY_SCOPE_AGENT); }
__device__ __forceinline__ unsigned xb_add(unsigned* p, unsigned v) { return __hip_atomic_fetch_add(p, v, __ATOMIC_RELAXED, __HIP_MEMORY_SCOPE_AGENT); }
__device__ __forceinline__ unsigned xb_xcc_id() { return (unsigned)__builtin_amdgcn_s_getreg((3 << 11) | 20) & 0xFu; }
#define XB_SPIN(cond, bar) do { unsigned _sp = 0; while (cond) { __builtin_amdgcn_s_sleep(1); \
    if ((++_sp & 255u) == 0u) { if (xb_ld(&(bar)[XB_TMO])) break; if (_sp > XB_SPIN_CAP) { atomicAdd(&(bar)[XB_TMO], 1u); break; } } } } while (0)

struct XcdBarrier {
    unsigned* bar; unsigned x;
    volatile LAS unsigned* st;
};

__device__ __forceinline__ XcdBarrier xcd_barrier_post(unsigned* bar, volatile LAS unsigned* st) {
    XcdBarrier b; b.bar = bar; b.x = xb_xcc_id(); b.st = st;
    if (threadIdx.x == 0) (void)xb_add(&bar[XB_XCNT(b.x)], 1u);
    return b;
}
__device__ __forceinline__ void xcd_barrier_complete(unsigned* bar, unsigned x, unsigned& nloc, unsigned& nx) {
    const unsigned G = gridDim.x * gridDim.y * gridDim.z;
    unsigned sum, cnt, mine, sp = 0u;
    for (;;) {
        sum = 0u; cnt = 0u; mine = 0u;
#pragma unroll
        for (unsigned j = 0; j < 16; ++j) { const unsigned c = xb_ld(&bar[XB_XCNT(j)]); sum += c; cnt += (c > 0u) ? 1u : 0u; mine = (j == x) ? c : mine; }
        if (sum == G) break;
        __builtin_amdgcn_s_sleep(1);
        if ((++sp & 255u) == 0u) { if (xb_ld(&bar[XB_TMO])) break; if (sp > XB_SPIN_CAP) { atomicAdd(&bar[XB_TMO], 1u); break; } }
    }
    nloc = mine > 0u ? mine : 1u; nx = cnt > 0u ? cnt : 1u;
}

__device__ __forceinline__ void xcd_barrier(const XcdBarrier& b) {
    asm volatile("s_waitcnt vmcnt(0)" ::: "memory");
    __syncthreads();
    if (threadIdx.x == 0) {
        unsigned* bar = b.bar;
        __builtin_amdgcn_s_waitcnt(0);
        unsigned nloc = b.st[0], nx = b.st[1];
        if (nloc == 0u) { xcd_barrier_complete(bar, b.x, nloc, nx); b.st[0] = nloc; b.st[1] = nx; }
        const unsigned old = xb_add(&bar[XB_XSUB(b.x)], 1u);
        const unsigned gen = old / nloc;
        if (old + 1u == (gen + 1u) * nloc) {
            __builtin_amdgcn_fence(__ATOMIC_RELEASE, "agent");
            asm volatile("s_waitcnt vmcnt(0)" ::: "memory");
            const unsigned og = xb_add(&bar[XB_TOP], 1u);
            const unsigned tg = og / nx;
            if (og + 1u == (tg + 1u) * nx) xb_add(&bar[XB_TOPGEN], 1u);
            else XB_SPIN(xb_ld(&bar[XB_TOPGEN]) == tg, bar);
            __builtin_amdgcn_fence(__ATOMIC_ACQUIRE, "agent");
            xb_add(&bar[XB_XGEN(b.x)], 1u);
            asm volatile("s_waitcnt vmcnt(0)" ::: "memory");
        } else {
            XB_SPIN(xb_ld(&bar[XB_XGEN(b.x)]) == gen, bar);
            __builtin_amdgcn_fence(__ATOMIC_ACQUIRE, "agent");
            asm volatile("s_waitcnt vmcnt(0)" ::: "memory");
        }
    }
    __syncthreads();
}


#define LDS_BYTES (144 * 1024)
#define PTAB_OFF (LDS_BYTES - 1024)
extern __shared__ __attribute__((aligned(16))) float dynsmem[];
struct Ctx { const Params* kp; };
#define pin_(i) (p.kp->in[i])
#define pout_() (p.kp->out)
#define pws_() (p.kp->ws)

__device__ __forceinline__ float bf2f(bf16_t v) { return __uint_as_float(((unsigned)v) << 16); }
__device__ __forceinline__ bf16_t f2bf(float f) { unsigned u = __float_as_uint(f); u += 0x7FFFu + ((u >> 16) & 1u); return (bf16_t)(u >> 16); }
__device__ __forceinline__ unsigned pk_bf16(float lo, float hi) { return (unsigned)f2bf(lo) | ((unsigned)f2bf(hi) << 16); }
__device__ __forceinline__ float wave_sum(float v) {
#pragma unroll
    for (int o = 32; o >= 1; o >>= 1) v += __shfl_xor(v, o, 64);
    return v;
}
__device__ __forceinline__ float wave_max(float v) {
#pragma unroll
    for (int o = 32; o >= 1; o >>= 1) v = fmaxf(v, __shfl_xor(v, o, 64));
    return v;
}
__device__ __forceinline__ float silu_f(float x) { return x / (1.f + __expf(-x)); }
__device__ __forceinline__ float sigmoid_f(float x) { return 1.f / (1.f + __expf(-x)); }
__device__ __forceinline__ float softplus_f(float x) { return x > 20.f ? x : log1pf(__expf(x)); }
__device__ __forceinline__ float logsigmoid_f(float x) { return -softplus_f(-x); }
__device__ __forceinline__ float gelu_tanh_f(float x) { const float u = 0.7978845608028654f * (x + 0.044715f * x * x * x); return 0.5f * x * (1.f + tanhf(u)); }
__device__ __forceinline__ unsigned ford(float f) { f = f + 0.0f; unsigned u = __float_as_uint(f); return (u & 0x80000000u) ? ~u : (u | 0x80000000u); }
__device__ __forceinline__ float funord(unsigned k) { unsigned u = (k & 0x80000000u) ? (k & 0x7fffffffu) : ~k; return __uint_as_float(u); }
__device__ __forceinline__ unsigned long long wave_max_u64(unsigned long long v) {
#pragma unroll
    for (int o = 32; o >= 1; o >>= 1) {
        unsigned lo = __shfl_xor((unsigned)v, o, 64), hi = __shfl_xor((unsigned)(v >> 32), o, 64);
        unsigned long long w = ((unsigned long long)hi << 32) | lo;
        v = w > v ? w : v;
    }
    return v;
}
__device__ __forceinline__ int tid_() { int t = threadIdx.x; asm volatile("" : "+v"(t)); return t; }
__device__ __forceinline__ int bid_() { int b = blockIdx.x; asm volatile("" : "+s"(b)); return b; }
__device__ __forceinline__ int nblk_() { int g = gridDim.x; asm volatile("" : "+s"(g)); return g; }
__device__ __forceinline__ int gwave() { return (bid_() * 512 + tid_()) >> 6; }
__device__ __forceinline__ int nwaves() { return nblk_() * 8; }

namespace pg8 {
#define PG8_LAS __attribute__((address_space(3)))
typedef unsigned short bf16_t;
typedef short bf16x8 __attribute__((ext_vector_type(8)));
typedef float f32x4 __attribute__((ext_vector_type(4)));
typedef unsigned u32x4 __attribute__((ext_vector_type(4)));
constexpr int BM = 256, BK = 64, HALF = 128, HTB = HALF * BK * 2  , STAGE_BYTES = 8 * HTB, NXCD = 8, WGM = 8;

__host__ __device__ __forceinline__ int lds_byte(int r, int c) { const int st = (r >> 4) * 2 + (c >> 5), rr = r & 15, cc = c & 31, ob = rr * 64 + cc * 2; return st * 1024 + (ob ^ (((ob >> 9) & 1) << 5)); }
__host__ __device__ __forceinline__ void stage_rc(int b, int& R, int& C) { const int st = b / 1024, sb = b % 1024, swz = sb ^ (((sb >> 9) & 1) << 5); R = (st >> 1) * 16 + swz / 64; C = (st & 1) * 32 + (swz % 64) / 2; }
__host__ __device__ __forceinline__ int perm32(int rho) { const int n = rho >> 4, i = rho & 15; return 8 * (i >> 2) + 4 * n + (i & 3); }

struct Unit { int pm, pn; };
struct Gemm { const bf16_t* A; const bf16_t* Bt; int M, N, K; };

struct StaticOrder {
    int nM, nN, nwg, G, c;
    __host__ __device__ void init(int M, int N, int G_, int c_) { nM = M / BM; nN = N / BM; nwg = nM * nN; G = G_; c = c_; }
    __host__ __device__ bool next(int i, Unit& u) const {
        const long L = (long)i * G + c; if (L >= nwg) return false;
        int wgid = (int)L; { const int q = nwg / NXCD, r = nwg % NXCD, xcd = wgid % NXCD, off = wgid / NXCD; wgid = (xcd < r ? xcd * (q + 1) : r * (q + 1) + (xcd - r) * q) + off; }
        const int nig = WGM * nN, gid = wgid / nig, fm = gid * WGM, gsz = (nM - fm) < WGM ? (nM - fm) : WGM;
        u.pm = fm + ((wgid % nig) % gsz); u.pn = (wgid % nig) / gsz; return true;
    }
    __device__ __forceinline__ void a_ready(const Unit&) const {}
    __device__ __forceinline__ void done(const Unit&) const {}
};

__device__ __forceinline__ unsigned cvt_pk_bf16(float lo, float hi) { unsigned r; asm volatile("v_cvt_pk_bf16_f32 %0, %1, %2" : "=v"(r) : "v"(lo), "v"(hi)); return r; }
struct EpiF32 {
    static constexpr bool PERM = false, AFTER_DRAIN = false;
    float* C; const float* R; int ldc;
    __device__ __forceinline__ void operator()(const f32x4 (&acc)[2][2][4][2], const Unit& u, int wr, int wc, int fr, int fq) const {
        const int row0 = u.pm * BM + wr * 64 + fr, col0 = u.pn * BM + wc * 32 + 4 * fq;
#pragma unroll
        for (int ai = 0; ai < 2; ++ai)
#pragma unroll
            for (int m = 0; m < 4; ++m) { const size_t off = (size_t)(row0 + ai * HALF + m * 16) * ldc + col0;
#pragma unroll
                for (int bj = 0; bj < 2; ++bj)
#pragma unroll
                    for (int n = 0; n < 2; ++n) { f32x4 v = acc[ai][bj][m][n]; if (R) v += *(const f32x4*)(R + off + bj * HALF + n * 16); *(f32x4*)(C + off + bj * HALF + n * 16) = v; } }
    }
};
struct EpiBf16 {
    static constexpr bool PERM = true, AFTER_DRAIN = false;
    bf16_t* O; int ldc;
    __device__ __forceinline__ void operator()(const f32x4 (&acc)[2][2][4][2], const Unit& u, int wr, int wc, int fr, int fq) const {
        const int row0 = u.pm * BM + wr * 64 + fr, col0 = u.pn * BM + wc * 32 + 8 * fq;
#pragma unroll
        for (int ai = 0; ai < 2; ++ai)
#pragma unroll
            for (int m = 0; m < 4; ++m) { bf16_t* rowp = O + (size_t)(row0 + ai * HALF + m * 16) * ldc + col0;
#pragma unroll
                for (int bj = 0; bj < 2; ++bj) { const f32x4 v0 = acc[ai][bj][m][0], v1 = acc[ai][bj][m][1];
                    u32x4 w; w.x = cvt_pk_bf16(v0[0], v0[1]); w.y = cvt_pk_bf16(v0[2], v0[3]); w.z = cvt_pk_bf16(v1[0], v1[1]); w.w = cvt_pk_bf16(v1[2], v1[3]);
                    *(u32x4*)(rowp + bj * HALF) = w; } }
    }
};

template <class Epi, class Sched, bool STAMP = false>
__device__ __forceinline__ void gemm_phase(PG8_LAS unsigned char* lds, const Gemm g, const Sched& S, const Epi& E, unsigned long long* stamps, const int tid) {
    const int wid = __builtin_amdgcn_readfirstlane(tid >> 6), lane = tid & 63, wr = wid >> 2, wc = wid & 3, fr = lane & 15, fq = lane >> 4;
    const int K = g.K, nt = K / BK;
    int ts_lo = 0, ts_hi = 0, nts = 0; const unsigned long long rt_entry = STAMP ? (unsigned long long)wall_clock64() : 0ull;
#define PG8_STAMP() do { if (STAMP && wid == 0 && nts < 64) { const unsigned long long _c = (unsigned long long)clock64(); \
        ts_lo = (lane == nts) ? (int)(unsigned)_c : ts_lo; ts_hi = (lane == nts) ? (int)(unsigned)(_c >> 32) : ts_hi; ++nts; } } while (0)
    PG8_STAMP();
    unsigned voffA[2], voffB[2];
#pragma unroll
    for (int i = 0; i < 2; ++i) { int R, C; stage_rc(tid * 16 + i * 8192, R, C); const int Rb = Epi::PERM ? ((R & ~31) + perm32(R & 31)) : R;
        voffA[i] = (unsigned)(R * K + C) * 2u; voffB[i] = (unsigned)(Rb * K + C) * 2u; }
    const size_t kstep = (size_t)(BK * 2);
    const size_t hstep = (size_t)HALF * K * 2;
    const size_t tstep = 2 * hstep;
    const unsigned ldsw = (unsigned)wid * 1024u;
    const int aoff = lds_byte(wr * 64 + fr, fq * 8), boff = lds_byte(wc * 32 + fr, fq * 8);
#define PG8_SA(b, h) (((b) * 2 + (h)) * HTB)
#define PG8_SB(b, h) ((4 + (b) * 2 + (h)) * HTB)
#define PG8_STAGE(bufoff, gbase, voff) do { _Pragma("unroll") for (int _i = 0; _i < 2; ++_i) \
        __builtin_amdgcn_global_load_lds((const unsigned*)((const char*)(gbase) + (voff)[_i]), (PG8_LAS unsigned*)(lds + (bufoff) + ldsw + _i * 8192), 16, 0, 0); } while (0)
#define PG8_LDA(dst, b, h) do { _Pragma("unroll") for (int m = 0; m < 4; ++m) _Pragma("unroll") for (int k = 0; k < 2; ++k) dst[m][k] = *(const PG8_LAS bf16x8*)(lds + PG8_SA(b, h) + aoff + m * 2048 + k * 1024); } while (0)
#define PG8_LDB(dst, b, h) do { _Pragma("unroll") for (int n = 0; n < 2; ++n) _Pragma("unroll") for (int k = 0; k < 2; ++k) dst[n][k] = *(const PG8_LAS bf16x8*)(lds + PG8_SB(b, h) + boff + n * 2048 + k * 1024); } while (0)
#define PG8_MMA(ai, bj, At, Bt) do { __builtin_amdgcn_s_setprio(1); _Pragma("unroll") for (int m = 0; m < 4; ++m) _Pragma("unroll") for (int n = 0; n < 2; ++n) _Pragma("unroll") for (int k = 0; k < 2; ++k) \
        acc[ai][bj][m][n] = __builtin_amdgcn_mfma_f32_16x16x32_bf16(Bt[n][k], At[m][k], acc[ai][bj][m][n], 0, 0, 0); __builtin_amdgcn_s_setprio(0); } while (0)
#define PG8_WAIT_V(n) asm volatile("s_waitcnt vmcnt(" #n ")" ::: "memory")
#define PG8_WAIT_L(n) asm volatile("s_waitcnt lgkmcnt(" #n ")" ::: "memory")
#define PG8_BAR __builtin_amdgcn_s_barrier()
#define PG8_SCHED __builtin_amdgcn_sched_barrier(0)
    Unit cur, nxt; int ui = 0;
    if (!S.next(0, cur)) return;
    f32x4 acc[2][2][4][2];
#pragma unroll
    for (int a = 0; a < 2; ++a)
#pragma unroll
        for (int b = 0; b < 2; ++b)
#pragma unroll
            for (int m = 0; m < 4; ++m)
#pragma unroll
                for (int n = 0; n < 2; ++n) acc[a][b][m][n] = (f32x4){0.f, 0.f, 0.f, 0.f};
    bf16x8 At[4][2], B0[2][2], B1[2][2];
    const char* cA = (const char*)g.A + (size_t)cur.pm * tstep; const char* cB = (const char*)g.Bt + (size_t)cur.pn * tstep;
    S.a_ready(cur);
    PG8_STAGE(PG8_SB(0, 0), cB, voffB); PG8_STAGE(PG8_SA(0, 0), cA, voffA); PG8_STAGE(PG8_SB(0, 1), cB + hstep, voffB); PG8_STAGE(PG8_SA(0, 1), cA + hstep, voffA);
    if (wr == 1) PG8_BAR;
    PG8_WAIT_V(4); PG8_BAR;
    PG8_STAGE(PG8_SB(1, 0), cB + kstep, voffB); PG8_STAGE(PG8_SA(1, 0), cA + kstep, voffA); PG8_STAGE(PG8_SB(1, 1), cB + hstep + kstep, voffB);
    PG8_WAIT_V(6); PG8_BAR;
    PG8_STAMP();
    for (;;) {
        const bool has_next = S.next(ui + 1, nxt);
        const char* nA = has_next ? (const char*)g.A + (size_t)nxt.pm * tstep : cA; const char* nB = has_next ? (const char*)g.Bt + (size_t)nxt.pn * tstep : cB;
        for (int t = 0; t < nt; t += 2) {
            const bool last = (t == nt - 2);
            const char* a1 = cA + (size_t)(t + 1) * kstep;
            const char* a2 = last ? nA : cA + (size_t)(t + 2) * kstep; const char* b2 = last ? nB : cB + (size_t)(t + 2) * kstep;
            const char* a3 = a2 + kstep; const char* b3 = b2 + kstep;
            if (last && has_next) S.a_ready(nxt);
            PG8_LDB(B0, 0, 0); PG8_SCHED; PG8_LDA(At, 0, 0); PG8_STAGE(PG8_SA(1, 1), a1 + hstep, voffA);
            PG8_WAIT_L(8); PG8_BAR; PG8_WAIT_L(0); PG8_MMA(0, 0, At, B0); PG8_BAR; PG8_SCHED;
            PG8_LDB(B1, 0, 1); PG8_STAGE(PG8_SB(0, 0), b2, voffB);
            PG8_BAR; PG8_WAIT_L(0); PG8_MMA(0, 1, At, B1); PG8_BAR;
            PG8_LDA(At, 0, 1); PG8_STAGE(PG8_SA(0, 0), a2, voffA);
            PG8_BAR; PG8_WAIT_L(0); PG8_MMA(1, 0, At, B0); PG8_BAR; PG8_SCHED;
            PG8_STAGE(PG8_SB(0, 1), b2 + hstep, voffB);
            PG8_WAIT_V(6); PG8_BAR; PG8_MMA(1, 1, At, B1); PG8_BAR;
            PG8_LDB(B0, 1, 0); PG8_SCHED; PG8_LDA(At, 1, 0); PG8_STAGE(PG8_SA(0, 1), a2 + hstep, voffA);
            PG8_WAIT_L(8); PG8_BAR; PG8_WAIT_L(0); PG8_MMA(0, 0, At, B0); PG8_BAR; PG8_SCHED;
            PG8_LDB(B1, 1, 1); PG8_STAGE(PG8_SB(1, 0), b3, voffB);
            PG8_BAR; PG8_WAIT_L(0); PG8_MMA(0, 1, At, B1); PG8_BAR;
            PG8_LDA(At, 1, 1); PG8_STAGE(PG8_SA(1, 0), a3, voffA);
            PG8_BAR; PG8_WAIT_L(0); PG8_MMA(1, 0, At, B0); PG8_BAR; PG8_SCHED;
            PG8_STAGE(PG8_SB(1, 1), b3 + hstep, voffB);
            PG8_WAIT_V(6); PG8_BAR; PG8_MMA(1, 1, At, B1); PG8_BAR;
        }
        PG8_STAMP();
        if constexpr (!Epi::AFTER_DRAIN) { E(acc, cur, wr, wc, fr, fq); S.done(cur); }
        PG8_STAMP();
        if (!has_next) break;
#pragma unroll
        for (int a = 0; a < 2; ++a)
#pragma unroll
            for (int b = 0; b < 2; ++b)
#pragma unroll
                for (int m = 0; m < 4; ++m)
#pragma unroll
                    for (int n = 0; n < 2; ++n) acc[a][b][m][n] = (f32x4){0.f, 0.f, 0.f, 0.f};
        cur = nxt; cA = nA; cB = nB; ++ui;
    }
    PG8_WAIT_V(0);
    if (wr == 0) PG8_BAR;
    PG8_BAR;
    if constexpr (Epi::AFTER_DRAIN) { E.fused(acc, cur, wr, wc, fr, fq, lds, wid, lane); S.done(cur); }
    PG8_STAMP();
    if (STAMP && wid == 0) { stamps[lane] = lane < nts ? (((unsigned long long)(unsigned)ts_hi << 32) | (unsigned)ts_lo) : 0ull;
        if (lane == 62) stamps[62] = rt_entry; if (lane == 63) stamps[63] = (unsigned long long)wall_clock64(); }
#undef PG8_STAMP
#undef PG8_SA
#undef PG8_SB
#undef PG8_STAGE
#undef PG8_LDA
#undef PG8_LDB
#undef PG8_MMA
#undef PG8_WAIT_V
#undef PG8_WAIT_L
#undef PG8_BAR
#undef PG8_SCHED
}
}

namespace pg8 {
struct PanelOrder {
    int pm, nN;
    __device__ void init(int pm_, int N) { pm = pm_; nN = N / BM; }
    __device__ bool next(int i, Unit& u) const { if (i >= nN) return false; u.pm = pm; u.pn = i; return true; }
    __device__ __forceinline__ void a_ready(const Unit&) const {}
    __device__ __forceinline__ void done(const Unit&) const {}
};
}
template <class Epi> __device__ __forceinline__ void ph_gemm_panel(const bf16_t* A, const bf16_t* Bt, int M, int N, int K, const Epi& E, int pm) {
    pg8::Gemm g; g.A = A; g.Bt = Bt; g.M = M; g.N = N; g.K = K;
    pg8::PanelOrder S; S.init(pm, N);
    pg8::gemm_phase<Epi, pg8::PanelOrder, false>((PG8_LAS unsigned char*)dynsmem, g, S, E, nullptr, tid_());
}
template <class Epi> __device__ __forceinline__ void ph_gemm(const bf16_t* A, const bf16_t* Bt, int M, int N, int K, const Epi& E, int crot = 0) {
    pg8::Gemm g; g.A = A; g.Bt = Bt; g.M = M; g.N = N; g.K = K;
    const int nb_ = nblk_();
    pg8::StaticOrder S; S.init(M, N, nb_, (bid_() + nb_ - crot) % nb_);
    pg8::gemm_phase<Epi, pg8::StaticOrder, false>((PG8_LAS unsigned char*)dynsmem, g, S, E, nullptr, tid_());
}

__device__ __forceinline__ int pcol_to_orig(int c) {
    if (c < 768) return c;
    if (c < 1536) return c - 768 + 772;
    if (c < 1792) return c - 1536 + 1548;
    if (c < 1920) return c - 1792 + 1804;
    if (c < 2048) return c - 1920 + 1932;
    if (c < 2304) return c - 2048 + 2060;
    if (c < 2560) return c - 2304 + 2332;
    if (c < 2816) return c - 2560 + 2588;
    if (c < 2880) return c - 2816 + 2844;
    if (c < 2944) return c - 2880 + 2908;
    if (c < 3200) return c - 2944 + 2972;
    if (c < 3232) return c - 3200 + 3228;
    if (c < 3248) return c - 3232 + 2316;
    if (c < 3256) return c - 3248 + 3260;
    if (c < 3260) return c - 3256 + 768;
    if (c < 3264) return c - 3260 + 1540;
    if (c < 3268) return c - 3264 + 1544;
    return -1;
}
__device__ __forceinline__ void wtrans_job(const float* W, int K, int ldw, bf16_t* Wt, int Npad, bool mapped, float* tile) {
    const int tid = tid_();
    const int tn = Npad / 64, tk = K / 64;
    for (int t = bid_(); t < tn * tk; t += nblk_()) {
        const int n0 = (t / tk) * 64, k0 = (t % tk) * 64;
        __syncthreads();
        for (int idx = tid; idx < 4096; idx += 512) {
            const int kk = idx >> 6, nn = idx & 63;
            const int col = mapped ? pcol_to_orig(n0 + nn) : (n0 + nn);
            tile[kk * 65 + nn] = col >= 0 ? W[(size_t)(k0 + kk) * ldw + col] : 0.f;
        }
        __syncthreads();
        for (int idx = tid; idx < 4096; idx += 512) {
            const int nn = idx >> 6, kk = idx & 63;
            Wt[(size_t)(n0 + nn) * K + k0 + kk] = f2bf(tile[kk * 65 + nn]);
        }
    }
}
__device__ __forceinline__ void ph_weight_prep(const Ctx& p, float* sm) {
#pragma unroll 1
    for (int j = 0; j < 7 * DEPTH; ++j) {
        const int l = j / 7, w = j % 7;
        const float* W; int K, ldw, Npad; bf16_t* Wt; bool mapped = false;
        if (w == 0) { W = pin_(3) + (size_t)l * DM * 3268; K = DM; ldw = 3268; Npad = LDP; Wt = (bf16_t*)(pws_() + WT_IN) + (size_t)l * LDP * DM; mapped = true; }
        else if (w == 1) { W = pin_(20) + (size_t)l * DM * DM; K = DM; ldw = DM; Npad = DM; Wt = (bf16_t*)(pws_() + WT_OUT) + (size_t)l * DM * DM; }
        else if (w == 2) { W = pin_(23) + (size_t)l * DM * 256; K = DM; ldw = 256; Npad = 256; Wt = (bf16_t*)(pws_() + WT_XQ) + (size_t)l * 256 * DM; }
        else if (w == 3) { W = pin_(24) + (size_t)l * DM * 256; K = DM; ldw = 256; Npad = 256; Wt = (bf16_t*)(pws_() + WT_XK) + (size_t)l * 256 * DM; }
        else if (w == 4) { W = pin_(25) + (size_t)l * DM * 256; K = DM; ldw = 256; Npad = 256; Wt = (bf16_t*)(pws_() + WT_XV) + (size_t)l * 256 * DM; }
        else if (w == 5) { W = pin_(26) + (size_t)l * 256 * DM; K = 256; ldw = DM; Npad = DM; Wt = (bf16_t*)(pws_() + WT_XO) + (size_t)l * DM * 256; }
        else { W = pin_(30) + (size_t)l * DM * DM; K = DM; ldw = DM; Npad = DM; Wt = (bf16_t*)(pws_() + WT_PQ) + (size_t)l * DM * DM; }
        wtrans_job(W, K, ldw, Wt, Npad, mapped, sm);
    }
}

#define H8_SCALE 16.f
__device__ __forceinline__ unsigned pack4_fp8(float4 a, float sc);
__device__ __forceinline__ void ph_rmsnorm(const float* __restrict__ x, const float* __restrict__ g, bf16_t* __restrict__ out, int rows, int row0 = 0, int w0 = -1, int wstep = 0, unsigned char* out8 = nullptr) {
    const int lane = tid_() & 63;
    if (w0 < 0) { w0 = gwave(); wstep = nwaves(); }
    for (int r = row0 + w0; r < row0 + rows; r += wstep) {
        const float4* xr = (const float4*)(x + (size_t)r * DM);
        float4 v[4]; float ss = 0.f;
#pragma unroll
        for (int i = 0; i < 4; ++i) { v[i] = xr[lane + 64 * i]; ss += v[i].x * v[i].x + v[i].y * v[i].y + v[i].z * v[i].z + v[i].w * v[i].w; }
        ss = wave_sum(ss);
        const float rs = rsqrtf(ss * (1.f / DM) + EPS);
#pragma unroll
        for (int i = 0; i < 4; ++i) {
            const float4 gg = ((const float4*)g)[lane + 64 * i];
            ushort4 o; o.x = f2bf(v[i].x * rs * gg.x); o.y = f2bf(v[i].y * rs * gg.y); o.z = f2bf(v[i].z * rs * gg.z); o.w = f2bf(v[i].w * rs * gg.w);
            *(ushort4*)(out + (size_t)r * DM + (size_t)(lane + 64 * i) * 4) = o;
            if (out8) *(unsigned*)(out8 + (size_t)r * DM + (size_t)(lane + 64 * i) * 4) = pack4_fp8(make_float4(v[i].x * rs * gg.x, v[i].y * rs * gg.y, v[i].z * rs * gg.z, v[i].w * rs * gg.w), H8_SCALE);
        }
    }
}

template <int OUTMODE>
__device__ __forceinline__ void ph_sgemm(const bf16_t* __restrict__ A, int lda, const float* __restrict__ B, int ldb, void* Cv, int ldc, const float* R, int ldr,
                         int M, int N, int K, float* smem) {
    float* As = smem;
    float* Bs = smem + 16 * 132;
    const int tid = tid_(), tx = tid & 31, ty = tid >> 5;
    const int ntn = N / 128, ntiles = (M / 128) * ntn;
    for (int tile = bid_(); tile < ntiles; tile += nblk_()) {
        const int tm = tile / ntn, tn = tile % ntn;
        float acc[8][4];
#pragma unroll
        for (int i = 0; i < 8; ++i)
#pragma unroll
            for (int j = 0; j < 4; ++j) acc[i][j] = 0.f;
        const int arow = tid >> 2, akq = (tid & 3) * 4;
        const int bk = tid >> 5, bn = (tid & 31) * 4;
        for (int k0 = 0; k0 < K; k0 += 16) {
            const ushort4 av = *(const ushort4*)(A + (size_t)(tm * 128 + arow) * lda + k0 + akq);
            const float4 bv = *(const float4*)(B + (size_t)(k0 + bk) * ldb + tn * 128 + bn);
            __syncthreads();
            As[(akq + 0) * 132 + arow] = bf2f(av.x); As[(akq + 1) * 132 + arow] = bf2f(av.y);
            As[(akq + 2) * 132 + arow] = bf2f(av.z); As[(akq + 3) * 132 + arow] = bf2f(av.w);
            *(float4*)(Bs + bk * 132 + bn) = bv;
            __syncthreads();
#pragma unroll
            for (int k = 0; k < 16; ++k) {
                const float4 a0 = *(const float4*)(As + k * 132 + ty * 8), a1 = *(const float4*)(As + k * 132 + ty * 8 + 4);
                const float4 b = *(const float4*)(Bs + k * 132 + tx * 4);
                const float a[8] = {a0.x, a0.y, a0.z, a0.w, a1.x, a1.y, a1.z, a1.w};
#pragma unroll
                for (int i = 0; i < 8; ++i) { acc[i][0] += a[i] * b.x; acc[i][1] += a[i] * b.y; acc[i][2] += a[i] * b.z; acc[i][3] += a[i] * b.w; }
            }
        }
#pragma unroll
        for (int i = 0; i < 8; ++i) {
            const size_t row = (size_t)tm * 128 + ty * 8 + i; const int col = tn * 128 + tx * 4;
            if (OUTMODE == 0) {
                ushort4 o; o.x = f2bf(acc[i][0]); o.y = f2bf(acc[i][1]); o.z = f2bf(acc[i][2]); o.w = f2bf(acc[i][3]);
                *(ushort4*)((bf16_t*)Cv + row * ldc + col) = o;
            } else if (OUTMODE == 1) {
                *(float4*)((float*)Cv + row * ldc + col) = make_float4(acc[i][0], acc[i][1], acc[i][2], acc[i][3]);
            } else {
                const float4 r = *(const float4*)(R + row * ldr + col);
                *(float4*)((float*)Cv + row * ldc + col) = make_float4(r.x + acc[i][0], r.y + acc[i][1], r.z + acc[i][2], r.w + acc[i][3]);
            }
        }
    }
}

#define WS_HS WS_H
#define WS_VG WS_YPRE
#define WS_DEC (WS_YPRE + (size_t)MTOK * 256 * 2)

__device__ __forceinline__ float quad_sum(float v) {
    v += __int_as_float(__builtin_amdgcn_mov_dpp(__float_as_int(v), 0xB1, 0xF, 0xF, true));
    v += __int_as_float(__builtin_amdgcn_mov_dpp(__float_as_int(v), 0x4E, 0xF, 0xF, true));
    return v;
}
__device__ __forceinline__ float bflo(unsigned w) { return __uint_as_float(w << 16); }
__device__ __forceinline__ float bfhi(unsigned w) { return __uint_as_float(w & 0xffff0000u); }

__device__ __forceinline__ float oct_sum(float v) {
    v += __int_as_float(__builtin_amdgcn_mov_dpp(__float_as_int(v), 0xB1, 0xF, 0xF, true));
    v += __int_as_float(__builtin_amdgcn_mov_dpp(__float_as_int(v), 0x4E, 0xF, 0xF, true));
    v += __int_as_float(__builtin_amdgcn_mov_dpp(__float_as_int(v), 0x141, 0xF, 0xF, true));
    return v;
}
__device__ __forceinline__ void unpack8(const uint4 r, float (&o)[8]) {
    o[0] = bflo(r.x); o[1] = bfhi(r.x); o[2] = bflo(r.y); o[3] = bfhi(r.y); o[4] = bflo(r.z); o[5] = bfhi(r.z); o[6] = bflo(r.w); o[7] = bfhi(r.w);
}
__device__ __forceinline__ uint4 pack8(const float (&v)[8]) {
    uint4 o; o.x = pk_bf16(v[0], v[1]); o.y = pk_bf16(v[2], v[3]); o.z = pk_bf16(v[4], v[5]); o.w = pk_bf16(v[6], v[7]); return o;
}
__device__ __forceinline__ void load8f(const float* p, float (&o)[8]) {
    const float4 a = *(const float4*)p, b = *(const float4*)(p + 4);
    o[0] = a.x; o[1] = a.y; o[2] = a.z; o[3] = a.w; o[4] = b.x; o[5] = b.y; o[6] = b.z; o[7] = b.w;
}
__device__ __forceinline__ void conv8(const bf16_t* P, size_t tok, int t, int pcol, const float* w, int ldw, int cc, float (&acc)[8]) {
#pragma unroll
    for (int j = 0; j < 4; ++j) {
        if (t - 3 + j >= 0) {
            float xv[8], wv[8];
            unpack8(*(const uint4*)(P + (tok - (size_t)(3 - j)) * LDP + pcol), xv);
            load8f(w + j * ldw + cc, wv);
#pragma unroll
            for (int i = 0; i < 8; ++i) acc[i] = __builtin_fmaf(wv[i], xv[i], acc[i]);
        }
    }
}
__device__ __forceinline__ void conv8r(const uint4 (&xt)[4], int t, const float* w, int ldw, int cc, float (&acc)[8]) {
#pragma unroll
    for (int j = 0; j < 4; ++j) {
        float xv[8], wv[8];
        unpack8(xt[j], xv);
        load8f(w + j * ldw + cc, wv);
        const float m = (t - 3 + j >= 0) ? 1.f : 0.f;
#pragma unroll
        for (int i = 0; i < 8; ++i) acc[i] = __builtin_fmaf(wv[i] * m, xv[i], acc[i]);
    }
}
__device__ __forceinline__ void ph_scan_prep(const Ctx& p, int l) {
    const bf16_t* P = (const bf16_t*)(pws_() + WS_P);
    bf16_t* HS = (bf16_t*)(pws_() + WS_HS);
    bf16_t* VG = (bf16_t*)(pws_() + WS_VG);
    float* DEC = (float*)(pws_() + WS_DEC);
    float* SC = (float*)(pws_() + WS_SC);
    const float* scw = pin_(4) + (size_t)l * 4 * 512;
    const float* scb = pin_(5) + (size_t)l * 512;
    const float* gcw = pin_(10) + (size_t)l * 4 * 768;
    const float* wg = pin_(14) + (size_t)l * 16 * 128;
    const float* bg = pin_(15) + (size_t)l * 128;
    const int lane = tid_() & 63;
    const int hsc = lane & 3, wsc = (lane >> 2) & 3;
    const float k_dtb = pin_(6)[l * 4 + hsc], k_alog = __expf(pin_(7)[l * 4 + hsc]), k_galog = __expf(pin_(11)[l * 4 + hsc]), k_gdtb = pin_(12)[l * 4 + hsc];
    const int sccol = wsc < 2 ? PC_DT + hsc : (wsc == 2 ? PC_GA + hsc : PC_GB + hsc);
    for (int tok = gwave(); tok < MTOK; tok += nwaves()) {
        const int t = tok % SEQ;
        const size_t row = (size_t)tok * LDP;
        uint4 xa[4], xq[4], xv4[4];
#pragma unroll
        for (int j = 0; j < 4; ++j) {
            const size_t rj = (t - 3 + j >= 0) ? row - (size_t)(3 - j) * LDP : row;
            xa[j] = *(const uint4*)(P + rj + PC_XBC + 8 * lane);
            xq[j] = *(const uint4*)(P + rj + PC_GQKV + 8 * lane);
            xv4[j] = *(const uint4*)(P + rj + PC_GQKV + 512 + 8 * (lane & 31));
        }
        const uint4 gl0 = *(const uint4*)(P + row + PC_GLR), gl1 = *(const uint4*)(P + row + PC_GLR + 8);
        const float scraw = bf2f(P[row + sccol]);
        {
            float acc[8];
            load8f(scb + 8 * lane, acc);
            conv8r(xa, t, scw, 512, 8 * lane, acc);
#pragma unroll
            for (int i = 0; i < 8; ++i) acc[i] = silu_f(acc[i]);
            *(uint4*)(HS + (size_t)tok * 1024 + 8 * lane) = pack8(acc);
        }
        {
            float acc[8];
#pragma unroll
            for (int i = 0; i < 8; ++i) acc[i] = 0.f;
            conv8r(xq, t, gcw, 768, 8 * lane, acc);
            float ss = 0.f;
#pragma unroll
            for (int i = 0; i < 8; ++i) { acc[i] = silu_f(acc[i]); ss += acc[i] * acc[i]; }
            ss = oct_sum(ss);
            const float sc = rsqrtf(ss + EPS) * (lane < 32 ? 0.125f : 1.f);
#pragma unroll
            for (int i = 0; i < 8; ++i) acc[i] *= sc;
            *(uint4*)(HS + (size_t)tok * 1024 + 512 + 8 * lane) = pack8(acc);
        }
        {
            float acc[8];
#pragma unroll
            for (int i = 0; i < 8; ++i) acc[i] = 0.f;
            conv8r(xv4, t, gcw, 768, 512 + 8 * (lane & 31), acc);
#pragma unroll
            for (int i = 0; i < 8; ++i) acc[i] = silu_f(acc[i]);
            if (lane < 32) *(uint4*)(VG + (size_t)tok * 256 + 8 * lane) = pack8(acc);
        }
        {
            float v;
            if (wsc < 2) { const float dt = softplus_f(scraw + k_dtb); v = wsc == 0 ? dt : __expf(-dt * k_alog); }
            else if (wsc == 2) v = __expf(-k_galog * softplus_f(scraw + k_gdtb));
            else v = sigmoid_f(scraw);
            if (lane < 16) SC[(size_t)tok * 16 + lane] = v;
        }
        {
            float gl[16];
            { float a8[8], b8[8]; unpack8(gl0, a8); unpack8(gl1, b8);
#pragma unroll
              for (int i = 0; i < 8; ++i) { gl[i] = a8[i]; gl[8 + i] = b8[i]; } }
#pragma unroll
            for (int i = 0; i < 2; ++i) {
                const int c = lane + 64 * i;
                float acc = bg[c];
#pragma unroll
                for (int r = 0; r < 16; ++r) acc = __builtin_fmaf(gl[r], wg[r * 128 + c], acc);
                DEC[(size_t)tok * 128 + c] = __expf(logsigmoid_f(acc) * (1.f / 16.f));
            }
        }
    }
}

#define SCAN_LDS_WAVE 4608
typedef float f2_t __attribute__((ext_vector_type(2)));
__device__ __forceinline__ f2_t mk2(float a, float b) { f2_t r; r.x = a; r.y = b; return r; }
__device__ __forceinline__ void st8f(char* dst, const uint4 v) {
    *(float4*)dst = make_float4(bflo(v.x), bfhi(v.x), bflo(v.y), bfhi(v.y));
    *(float4*)(dst + 16) = make_float4(bflo(v.z), bfhi(v.z), bflo(v.w), bfhi(v.w));
}
__device__ __forceinline__ void ph_scans(const Ctx& p, int l, float* smem) {
    const bf16_t* P = (const bf16_t*)(pws_() + WS_P);
    const bf16_t* HS = (const bf16_t*)(pws_() + WS_HS);
    const bf16_t* VG = (const bf16_t*)(pws_() + WS_VG);
    const float* DEC = (const float*)(pws_() + WS_DEC);
    const float* SC = (const float*)(pws_() + WS_SC);
    bf16_t* Y = (bf16_t*)(pws_() + WS_Y);
    const int tid = tid_(), lane = tid & 63, wave = tid >> 6;
    if (nblk_() != 256) return;
    const int role = wave < 2 ? 0 : (wave < 6 ? 1 : 2);
    const int idx = (role == 0 ? wave : (role == 1 ? wave - 2 : wave - 6)) * 256 + bid_();
    const int bh = role == 1 ? (idx >> 3) : (idx >> 2), b = bh >> 2, h = bh & 3;
    const int colbase = role == 1 ? (idx & 7) * 8 : (idx & 3) * 16;
    const int cl = role == 1 ? (lane >> 3) : (lane >> 2);
    const int col = colbase + cl;
    const int sq = role == 1 ? (lane & 7) : (lane & 3);
    const size_t tb = (size_t)b * SEQ;
    bf16_t* dummy = (bf16_t*)(pws_() + WS_DUMMY) + (tid & 511) * 8;
    char* lw = (char*)smem + wave * SCAN_LDS_WAVE;
    char* lrow = lw;
    char* lcol = lw + 4096;
    float* lsc = (float*)(lw + 4352);
    const int fs = lane >> 3, fp = lane & 7;
    if (role == 0) {
        const int g = h >> 1;
        const float Dh = pin_(8)[l * 4 + h];
        uint4 f0, f1; unsigned fc = 0u; float fsc = 0.f;
        f2_t st[8];
#pragma unroll
        for (int i = 0; i < 8; ++i) st[i] = mk2(0.f, 0.f);
        auto fetch = [&](int t0) {
            const size_t tok = tb + t0 + fs;
            const bf16_t* src = HS + tok * 1024 + (fp < 4 ? 256 + g * 64 + fp * 16 : 384 + g * 64 + (fp - 4) * 16);
            f0 = *(const uint4*)src; f1 = *(const uint4*)(src + 8);
            fc = *(const unsigned*)(HS + tok * 1024 + h * 64 + colbase + fp * 2);
            if (lane < 16) fsc = SC[(tb + t0 + (lane >> 1)) * 16 + (lane & 1) * 4 + h];
        };
        fetch(0);
        for (int t0 = 0; t0 < SEQ; t0 += 8) {
            st8f(lrow + fs * 512 + fp * 64, f0); st8f(lrow + fs * 512 + fp * 64 + 32, f1);
            *(unsigned*)(lcol + fs * 32 + fp * 4) = fc;
            if (lane < 16) lsc[lane] = fsc;
            if (t0 + 8 < SEQ) fetch(t0 + 8);
#pragma unroll
            for (int i = 0; i < 8; ++i) {
                const char* rb = lrow + i * 512 + sq * 64;
                const float4 b0 = *(const float4*)rb, b1 = *(const float4*)(rb + 16), b2 = *(const float4*)(rb + 32), b3 = *(const float4*)(rb + 48);
                const float4 c0 = *(const float4*)(rb + 256), c1 = *(const float4*)(rb + 272), c2 = *(const float4*)(rb + 288), c3 = *(const float4*)(rb + 304);
                const float xv = bf2f(*(const bf16_t*)(lcol + i * 32 + cl * 2));
                const float2 sc2 = *(const float2*)(lsc + i * 2);
                const float xdt = xv * sc2.x;
                const f2_t xd2 = mk2(xdt, xdt), dA2 = mk2(sc2.y, sc2.y);
                const f2_t bb[8] = {mk2(b0.x, b0.y), mk2(b0.z, b0.w), mk2(b1.x, b1.y), mk2(b1.z, b1.w), mk2(b2.x, b2.y), mk2(b2.z, b2.w), mk2(b3.x, b3.y), mk2(b3.z, b3.w)};
                const f2_t cc[8] = {mk2(c0.x, c0.y), mk2(c0.z, c0.w), mk2(c1.x, c1.y), mk2(c1.z, c1.w), mk2(c2.x, c2.y), mk2(c2.z, c2.w), mk2(c3.x, c3.y), mk2(c3.z, c3.w)};
                f2_t ya = mk2(0.f, 0.f), yb = mk2(0.f, 0.f);
#pragma unroll
                for (int q = 0; q < 8; q += 2) {
                    st[q] = st[q] * dA2 + xd2 * bb[q]; st[q + 1] = st[q + 1] * dA2 + xd2 * bb[q + 1];
                    ya = cc[q] * st[q] + ya; yb = cc[q + 1] * st[q + 1] + yb;
                }
                const f2_t ys = ya + yb;
                const float y = quad_sum(ys.x + ys.y);
                *(sq == 0 ? Y + (tb + t0 + i) * DM + h * 64 + col : dummy + i) = f2bf(y + Dh * xv);
                if (i & 1) __builtin_amdgcn_sched_barrier(0);
            }
        }
    } else if (role == 1) {
        uint4 f0, f1; unsigned fc = 0u; float fsc = 0.f;
        f2_t S[4];
#pragma unroll
        for (int i = 0; i < 4; ++i) S[i] = mk2(0.f, 0.f);
        auto fetch = [&](int t0) {
            const size_t tok = tb + t0 + fs;
            const bf16_t* src = HS + tok * 1024 + (fp < 4 ? 512 + h * 64 + fp * 16 : 768 + h * 64 + (fp - 4) * 16);
            f0 = *(const uint4*)src; f1 = *(const uint4*)(src + 8);
            if (fp < 4) fc = *(const unsigned*)(VG + tok * 256 + h * 64 + colbase + fp * 2);
            if (lane < 16) fsc = SC[(tb + t0 + (lane >> 1)) * 16 + 8 + (lane & 1) * 4 + h];
        };
        fetch(0);
        for (int t0 = 0; t0 < SEQ; t0 += 8) {
            st8f(lrow + fs * 512 + fp * 64, f0); st8f(lrow + fs * 512 + fp * 64 + 32, f1);
            if (fp < 4) *(unsigned*)(lcol + fs * 32 + fp * 4) = fc;
            if (lane < 16) lsc[lane] = fsc;
            if (t0 + 8 < SEQ) fetch(t0 + 8);
#pragma unroll
            for (int i = 0; i < 8; ++i) {
                const char* rb = lrow + i * 512 + sq * 32;
                const float4 q0 = *(const float4*)rb, q1 = *(const float4*)(rb + 16);
                const float4 k0 = *(const float4*)(rb + 256), k1 = *(const float4*)(rb + 272);
                const float vv = bf2f(*(const bf16_t*)(lcol + i * 32 + cl * 2));
                const float2 sc2 = *(const float2*)(lsc + i * 2);
                const f2_t al2 = mk2(sc2.x, sc2.x);
                const f2_t kk[4] = {mk2(k0.x, k0.y), mk2(k0.z, k0.w), mk2(k1.x, k1.y), mk2(k1.z, k1.w)};
                const f2_t qq[4] = {mk2(q0.x, q0.y), mk2(q0.z, q0.w), mk2(q1.x, q1.y), mk2(q1.z, q1.w)};
                f2_t ra = mk2(0.f, 0.f), rb2 = mk2(0.f, 0.f);
#pragma unroll
                for (int q = 0; q < 4; q += 2) {
                    S[q] = S[q] * al2; S[q + 1] = S[q + 1] * al2;
                    ra = S[q] * kk[q] + ra; rb2 = S[q + 1] * kk[q + 1] + rb2;
                }
                const f2_t rs = ra + rb2;
                const float r = oct_sum(rs.x + rs.y);
                const float vn = sc2.y * (vv - r);
                const f2_t vn2 = mk2(vn, vn);
                f2_t oa2 = mk2(0.f, 0.f), ob2 = mk2(0.f, 0.f);
#pragma unroll
                for (int q = 0; q < 4; q += 2) {
                    S[q] = kk[q] * vn2 + S[q]; S[q + 1] = kk[q + 1] * vn2 + S[q + 1];
                    oa2 = S[q] * qq[q] + oa2; ob2 = S[q + 1] * qq[q + 1] + ob2;
                }
                const f2_t os = oa2 + ob2;
                const float ov = oct_sum(os.x + os.y);
                *(sq == 0 ? Y + (tb + t0 + i) * DM + 256 + h * 64 + col : dummy + i) = f2bf(ov);
                if (i & 1) __builtin_amdgcn_sched_barrier(0);
            }
        }
    } else {
        uint4 f0, f1; unsigned fc = 0u;
        f2_t S[4];
#pragma unroll
        for (int i = 0; i < 4; ++i) S[i] = mk2(0.f, 0.f);
        auto fetch = [&](int t0) {
            const size_t tok = tb + t0 + fs;
            if (fp < 4) { const float* src = DEC + tok * 128 + h * 32 + fp * 8; f0 = *(const uint4*)src; f1 = *(const uint4*)(src + 4); }
            else { const bf16_t* src = P + tok * LDP + (fp < 6 ? PC_LK + h * 32 + (fp - 4) * 16 : PC_LQ + h * 32 + (fp - 6) * 16); f0 = *(const uint4*)src; f1 = *(const uint4*)(src + 8); }
            fc = *(const unsigned*)(P + tok * LDP + PC_LV + h * 64 + colbase + fp * 2);
        };
        fetch(0);
        for (int t0 = 0; t0 < SEQ; t0 += 8) {
            if (fp < 4) { *(uint4*)(lrow + fs * 512 + fp * 32) = f0; *(uint4*)(lrow + fs * 512 + fp * 32 + 16) = f1; }
            else { st8f(lrow + fs * 512 + 128 + (fp - 4) * 64, f0); st8f(lrow + fs * 512 + 128 + (fp - 4) * 64 + 32, f1); }
            *(unsigned*)(lcol + fs * 32 + fp * 4) = fc;
            if (t0 + 8 < SEQ) fetch(t0 + 8);
#pragma unroll
            for (int i = 0; i < 8; ++i) {
                const char* rb = lrow + i * 512 + sq * 32;
                const float4 d0 = *(const float4*)rb, d1 = *(const float4*)(rb + 16);
                const float4 k0 = *(const float4*)(rb + 128), k1 = *(const float4*)(rb + 144);
                const float4 q0 = *(const float4*)(rb + 256), q1 = *(const float4*)(rb + 272);
                const float vv = bf2f(*(const bf16_t*)(lcol + i * 32 + cl * 2));
                const f2_t v2 = mk2(vv, vv);
                const f2_t dd[4] = {mk2(d0.x, d0.y), mk2(d0.z, d0.w), mk2(d1.x, d1.y), mk2(d1.z, d1.w)};
                const f2_t kk[4] = {mk2(k0.x, k0.y), mk2(k0.z, k0.w), mk2(k1.x, k1.y), mk2(k1.z, k1.w)};
                const f2_t qq[4] = {mk2(q0.x, q0.y), mk2(q0.z, q0.w), mk2(q1.x, q1.y), mk2(q1.z, q1.w)};
                f2_t oa2 = mk2(0.f, 0.f), ob2 = mk2(0.f, 0.f);
#pragma unroll
                for (int q = 0; q < 4; q += 2) {
                    S[q] = dd[q] * S[q] + kk[q] * v2; S[q + 1] = dd[q + 1] * S[q + 1] + kk[q + 1] * v2;
                    oa2 = S[q] * qq[q] + oa2; ob2 = S[q + 1] * qq[q + 1] + ob2;
                }
                const f2_t os = oa2 + ob2;
                const float ov = quad_sum(os.x + os.y);
                *(sq == 0 ? Y + (tb + t0 + i) * DM + 512 + h * 64 + col : dummy + i) = f2bf(ov * 0.17677669529663687f);
                if (i & 1) __builtin_amdgcn_sched_barrier(0);
            }
        }
    }
}

__device__ __forceinline__ void ph_mixer_finish(const Ctx& p, int l) {
    const bf16_t* P = (const bf16_t*)(pws_() + WS_P);
    bf16_t* Y = (bf16_t*)(pws_() + WS_Y);
    const float* sn = pin_(9) + (size_t)l * 256;
    const float* gn = pin_(13) + (size_t)l * 64;
    const float* ln = pin_(16) + (size_t)l * 64;
    const int lane = tid_() & 63;
    for (int tok = gwave(); tok < MTOK; tok += nwaves()) {
        const size_t row = (size_t)tok * LDP;
        {
            float v[8], gt[8], gw[8];
            unpack8(*(const uint4*)(Y + (size_t)tok * DM + 8 * lane), v);
            unpack8(*(const uint4*)(P + row + (lane < 32 ? PC_Z + 8 * lane : PC_GG + 8 * (lane - 32))), gt);
            load8f(lane < 32 ? sn + 8 * lane : gn + 8 * (lane & 7), gw);
            float ss = 0.f;
            if (lane < 32) {
#pragma unroll
                for (int i = 0; i < 8; ++i) { v[i] *= silu_f(gt[i]); ss += v[i] * v[i]; }
            } else {
#pragma unroll
                for (int i = 0; i < 8; ++i) ss += v[i] * v[i];
            }
            const float s8 = oct_sum(ss);
            float s32 = s8 + __int_as_float(__builtin_amdgcn_mov_dpp(__float_as_int(s8), 0x140, 0xF, 0xF, true));
            s32 += __shfl_xor(s32, 16, 64);
            const float rs = lane < 32 ? rsqrtf(s32 * (1.f / 256.f) + EPS) : rsqrtf(s8 * (1.f / 64.f) + EPS);
            float o[8];
#pragma unroll
            for (int i = 0; i < 8; ++i) o[i] = lane < 32 ? v[i] * rs * gw[i] : v[i] * rs * gw[i] * silu_f(gt[i]);
            *(uint4*)(Y + (size_t)tok * DM + 8 * lane) = pack8(o);
        }
        if (lane < 32) {
            float v[8], gt[8], gw[8];
            unpack8(*(const uint4*)(Y + (size_t)tok * DM + 512 + 8 * lane), v);
            unpack8(*(const uint4*)(P + row + PC_LR + 8 * lane), gt);
            load8f(ln + 8 * (lane & 7), gw);
            float ss = 0.f;
#pragma unroll
            for (int i = 0; i < 8; ++i) ss += v[i] * v[i];
            const float rs = rsqrtf(oct_sum(ss) * (1.f / 64.f) + EPS);
            float o[8];
#pragma unroll
            for (int i = 0; i < 8; ++i) o[i] = v[i] * rs * gw[i] * silu_f(gt[i]);
            *(uint4*)(Y + (size_t)tok * DM + 512 + 8 * lane) = pack8(o);
        }
    }
}

typedef short bf16x8_t __attribute__((ext_vector_type(8)));
typedef float f32x4_t __attribute__((ext_vector_type(4)));
union BF8 { bf16x8_t v; uint4 u; unsigned w[4]; };


__device__ __forceinline__ void ph_dsa_prep(const Ctx& p, int l) {
    const bf16_t* P = (const bf16_t*)(pws_() + WS_P);
    bf16_t* qn = (bf16_t*)(pws_() + WS_QN);
    bf16_t* kn = (bf16_t*)(pws_() + WS_KN);
    bf16_t* ikn = (bf16_t*)(pws_() + WS_IKN);
    bf16_t* vt = (bf16_t*)(pws_() + WS_VT);
    const float* qg = pin_(17) + (size_t)l * 64;
    const float* kg = pin_(18) + (size_t)l * 64;
    const float* ig = pin_(19) + (size_t)l * 32;
    const int lane = tid_() & 63;
    const int pcol = lane < 40 ? PC_DQ + 8 * lane : PC_IK + 8 * (lane & 3);
    float gw[8];
    load8f(lane < 32 ? qg + 8 * (lane & 7) : (lane < 40 ? kg + 8 * (lane & 7) : ig + 8 * (lane & 3)), gw);
    for (int grp = gwave(); grp < MTOK / 8; grp += nwaves()) {
        const size_t tok0 = (size_t)grp * 8;
        const int b = (int)(tok0 / SEQ), t0 = (int)(tok0 % SEQ);
        unsigned short vv[8];
#pragma unroll
        for (int i = 0; i < 8; ++i) {
            const size_t row = (tok0 + i) * LDP;
            vv[i] = P[row + PC_DV + lane];
            if (lane < 44) {
                float v[8];
                unpack8(*(const uint4*)(P + row + pcol), v);
                float ss = 0.f;
#pragma unroll
                for (int q = 0; q < 8; ++q) ss += v[q] * v[q];
                const float s4 = ss + __int_as_float(__builtin_amdgcn_mov_dpp(__float_as_int(ss), 0xB1, 0xF, 0xF, true));
                const float s4b = s4 + __int_as_float(__builtin_amdgcn_mov_dpp(__float_as_int(s4), 0x4E, 0xF, 0xF, true));
                const float s8 = s4b + __int_as_float(__builtin_amdgcn_mov_dpp(__float_as_int(s4b), 0x141, 0xF, 0xF, true));
                const float rs = lane < 40 ? rsqrtf(s8 * (1.f / 64.f) + EPS) * (lane < 32 ? 0.125f : 1.f) : rsqrtf(s4b * (1.f / 32.f) + EPS);
                float o[8];
#pragma unroll
                for (int q = 0; q < 8; ++q) o[q] = v[q] * rs * gw[q];
                const uint4 pk = pack8(o);
                if (lane < 32) *(uint4*)(qn + (tok0 + i) * 256 + 8 * lane) = pk;
                else if (lane < 40) *(uint4*)(kn + (tok0 + i) * 64 + 8 * (lane - 32)) = pk;
                else *(uint4*)(ikn + (tok0 + i) * 32 + 8 * (lane - 40)) = pk;
            }
        }
        uint4 o; o.x = (unsigned)vv[0] | ((unsigned)vv[1] << 16); o.y = (unsigned)vv[2] | ((unsigned)vv[3] << 16);
        o.z = (unsigned)vv[4] | ((unsigned)vv[5] << 16); o.w = (unsigned)vv[6] | ((unsigned)vv[7] << 16);
        *(uint4*)(vt + ((size_t)b * 64 + lane) * SEQ + t0) = o;
    }
}

#define DSA_STRIDE 2052
__device__ __forceinline__ void ph_dsa_main(const Ctx& p, int l, float* smem) {
    const bf16_t* P = (const bf16_t*)(pws_() + WS_P);
    bf16_t* Y = (bf16_t*)(pws_() + WS_Y);
    const bf16_t* QN = (const bf16_t*)(pws_() + WS_QN);
    const bf16_t* KN = (const bf16_t*)(pws_() + WS_KN);
    const bf16_t* IKN = (const bf16_t*)(pws_() + WS_IKN);
    const bf16_t* VT = (const bf16_t*)(pws_() + WS_VT);
    unsigned* sc = (unsigned*)smem;
    float* part = smem;
    float* plsum = smem + 8 * 64 * 64;
    unsigned* thr = (unsigned*)(smem + 35000);
    const int tid = tid_(), lane = tid & 63, w = tid >> 6, qi = lane & 15, g = lane >> 4;
    for (int task = bid_(); task < MTOK / 16; task += nblk_()) {
        const int c = 31 - task / 128, b = (task >> 2) & 31, sub = task & 3;
        const int t0 = c * 64 + sub * 16, nk = (c + 1) * 64;
        const size_t tok0 = (size_t)b * SEQ + t0;
        const bool dosel = nk > 256;
        if (dosel) {
            BF8 iqf[8]; float wq[8];
#pragma unroll
            for (int h = 0; h < 8; ++h) {
                iqf[h].u = *(const uint4*)(P + (tok0 + qi) * LDP + PC_IQ + h * 32 + 8 * g);
                wq[h] = bf2f(P[(tok0 + qi) * LDP + PC_IW + h]) * 0.0625f;
            }
            for (int kt = w; kt < nk / 16; kt += 8) {
                const int s0 = kt * 16;
                BF8 ka; ka.u = *(const uint4*)(IKN + ((size_t)b * SEQ + s0 + qi) * 32 + 8 * g);
                float acc[4] = {0.f, 0.f, 0.f, 0.f};
#pragma unroll
                for (int h = 0; h < 8; ++h) {
                    const f32x4_t d = __builtin_amdgcn_mfma_f32_16x16x32_bf16(ka.v, iqf[h].v, (f32x4_t){0.f, 0.f, 0.f, 0.f}, 0, 0, 0);
#pragma unroll
                    for (int r = 0; r < 4; ++r) acc[r] = __builtin_fmaf(wq[h], fmaxf(d[r], 0.f), acc[r]);
                }
                uint4 kv; kv.x = ford(acc[0]); kv.y = ford(acc[1]); kv.z = ford(acc[2]); kv.w = ford(acc[3]);
                *(uint4*)(sc + qi * DSA_STRIDE + s0 + 4 * g) = kv;
            }
        }
        __syncthreads();
        if (dosel) {
            const int nj = nk >> 6;
#pragma unroll 1
            for (int qq = 0; qq < 2; ++qq) {
                const int q = 2 * w + qq;
                unsigned kreg[32];
#pragma unroll
                for (int j = 0; j < 32; ++j) kreg[j] = (j < nj) ? sc[q * DSA_STRIDE + j * 64 + lane] : 0u;
                unsigned T = 0u; bool exact = false;
                for (int bit = 31; bit >= 0; --bit) {
                    const unsigned cand = T | (1u << bit);
                    int cnt = 0;
#pragma unroll
                    for (int j = 0; j < 32; ++j) cnt += __popcll(__ballot(kreg[j] >= cand));
                    if (cnt >= 256) { T = cand; if (cnt == 256) { exact = true; break; } }
                }
                int cut = 0x7fffffff;
                if (!exact) {
                    int cgt = 0, ceq = 0;
#pragma unroll
                    for (int j = 0; j < 32; ++j) { cgt += __popcll(__ballot(kreg[j] > T)); ceq += __popcll(__ballot(kreg[j] == T)); }
                    int need = 256 - cgt;
                    if (ceq > need) {
                        bool found = false;
#pragma unroll
                        for (int j = 0; j < 32; ++j) {
                            const unsigned long long m = __ballot(kreg[j] == T);
                            const int cj = __popcll(m);
                            if (!found) {
                                if (need <= cj) { for (int bpos = 0; bpos < 64; ++bpos) if ((m >> bpos) & 1ull) { if (--need == 0) { cut = j * 64 + bpos; break; } } found = true; }
                                else need -= cj;
                            }
                        }
                    }
                }
                if (lane == 0) { thr[q] = T; thr[16 + q] = (unsigned)cut; }
            }
        }
        __syncthreads();
        unsigned Tq = 0u; int cutq = 0x7fffffff;
        if (dosel) { Tq = thr[qi]; cutq = (int)thr[16 + qi]; }
        f32x4_t oacc[4][4]; float lsum[4];
#pragma unroll
        for (int h = 0; h < 4; ++h) { lsum[h] = 0.f;
#pragma unroll
            for (int dt = 0; dt < 4; ++dt) oacc[h][dt] = (f32x4_t){0.f, 0.f, 0.f, 0.f}; }
        const int krow = 8 * (qi >> 2) + (qi & 3);
        for (int st = w; st < nk / 32; st += 8) {
            const int s0 = st * 32;
            BF8 ka[2][2], va[4];
#pragma unroll
            for (int t = 0; t < 2; ++t)
#pragma unroll
                for (int s2 = 0; s2 < 2; ++s2) ka[t][s2].u = *(const uint4*)(KN + ((size_t)b * SEQ + s0 + krow + 4 * t) * 64 + 32 * s2 + 8 * g);
#pragma unroll
            for (int dt = 0; dt < 4; ++dt) va[dt].u = *(const uint4*)(VT + ((size_t)b * 64 + 16 * dt + qi) * SEQ + s0 + 8 * g);
            float mk[8];
            if (dosel) {
                const uint4 k0 = *(const uint4*)(sc + qi * DSA_STRIDE + s0 + 8 * g), k1 = *(const uint4*)(sc + qi * DSA_STRIDE + s0 + 8 * g + 4);
                const unsigned kk[8] = {k0.x, k0.y, k0.z, k0.w, k1.x, k1.y, k1.z, k1.w};
#pragma unroll
                for (int j = 0; j < 8; ++j) mk[j] = (kk[j] > Tq || (kk[j] == Tq && (s0 + 8 * g + j) <= cutq)) ? 1.f : 0.f;
            } else {
#pragma unroll
                for (int j = 0; j < 8; ++j) mk[j] = 1.f;
            }
#pragma unroll
            for (int h = 0; h < 4; ++h) {
                BF8 q0, q1;
                q0.u = *(const uint4*)(QN + (tok0 + qi) * 256 + h * 64 + 8 * g);
                q1.u = *(const uint4*)(QN + (tok0 + qi) * 256 + h * 64 + 32 + 8 * g);
                f32x4_t sacc[2];
#pragma unroll
                for (int t = 0; t < 2; ++t) {
                    sacc[t] = __builtin_amdgcn_mfma_f32_16x16x32_bf16(ka[t][0].v, q0.v, (f32x4_t){0.f, 0.f, 0.f, 0.f}, 0, 0, 0);
                    sacc[t] = __builtin_amdgcn_mfma_f32_16x16x32_bf16(ka[t][1].v, q1.v, sacc[t], 0, 0, 0);
                }
                float pe[8];
#pragma unroll
                for (int t = 0; t < 2; ++t)
#pragma unroll
                    for (int r = 0; r < 4; ++r) { pe[4 * t + r] = __expf(sacc[t][r]) * mk[4 * t + r]; lsum[h] += pe[4 * t + r]; }
                BF8 pf;
#pragma unroll
                for (int j = 0; j < 4; ++j) pf.w[j] = pk_bf16(pe[2 * j], pe[2 * j + 1]);
#pragma unroll
                for (int dt = 0; dt < 4; ++dt) oacc[h][dt] = __builtin_amdgcn_mfma_f32_16x16x32_bf16(va[dt].v, pf.v, oacc[h][dt], 0, 0, 0);
            }
        }
        __syncthreads();
#pragma unroll
        for (int h = 0; h < 4; ++h) {
            plsum[(w * 4 + h) * 64 + lane] = lsum[h];
#pragma unroll
            for (int dt = 0; dt < 4; ++dt)
#pragma unroll
                for (int r = 0; r < 4; ++r) part[(w * 64 + h * 16 + dt * 4 + r) * 64 + lane] = oacc[h][dt][r];
        }
        __syncthreads();
        {
            const int h = w >> 1;
            float lq = 0.f;
#pragma unroll
            for (int w2 = 0; w2 < 8; ++w2)
#pragma unroll
                for (int g2 = 0; g2 < 4; ++g2) lq += plsum[(w2 * 4 + h) * 64 + qi + 16 * g2];
            const float inv = 1.f / lq;
#pragma unroll
            for (int dd = 0; dd < 2; ++dd) {
                const int dt = (w & 1) * 2 + dd;
                float o[4];
#pragma unroll
                for (int r = 0; r < 4; ++r) {
                    float sacc = 0.f;
#pragma unroll
                    for (int w2 = 0; w2 < 8; ++w2) sacc += part[(w2 * 64 + h * 16 + dt * 4 + r) * 64 + lane];
                    o[r] = sacc * inv;
                }
                uint2 ov; ov.x = pk_bf16(o[0], o[1]); ov.y = pk_bf16(o[2], o[3]);
                *(uint2*)(Y + (tok0 + qi) * DM + 768 + h * 64 + 16 * dt + 4 * g) = ov;
            }
        }
        __syncthreads();
    }
}

__device__ __forceinline__ void ph_mem_prep(const Ctx& p, int l) {
    const float* Km = (const float*)(pws_() + WS_KM);
    const float* Vm = (const float*)(pws_() + WS_VM);
    bf16_t* KB = (bf16_t*)(pws_() + WS_KB);
    bf16_t* VTB = (bf16_t*)(pws_() + WS_VTB);
    const float* kg = pin_(28) + (size_t)l * 64;
    const int lane = tid_() & 63;
    for (int r = gwave(); r < MMEM; r += nwaves()) {
        const int b = r / NMEM, j = r % NMEM;
#pragma unroll
        for (int h = 0; h < 4; ++h) {
            const float v = Km[(size_t)r * 256 + h * 64 + lane];
            const float ss = wave_sum(v * v);
            KB[(((size_t)b * 4 + h) * NMEM + j) * 64 + lane] = f2bf(v * rsqrtf(ss * (1.f / 64.f) + EPS) * kg[lane]);
            VTB[(((size_t)b * 4 + h) * 64 + lane) * NMEM + j] = f2bf(Vm[(size_t)r * 256 + h * 64 + lane]);
        }
    }
}
__device__ __forceinline__ void ph_xattn(const Ctx& p, int l, int task0 = 0, int ntask = MTOK / 16, int w0 = -1, int wstep = 0) {
    const float* Qx = (const float*)(pws_() + WS_QX);
    bf16_t* Ox = (bf16_t*)(pws_() + WS_OX);
    const bf16_t* KB = (const bf16_t*)(pws_() + WS_KB);
    const bf16_t* VTB = (const bf16_t*)(pws_() + WS_VTB);
    const float* qg = pin_(27) + (size_t)l * 64;
    const int lane = tid_() & 63, qi = lane & 15, g = lane >> 4;
    if (w0 < 0) { w0 = gwave(); wstep = nwaves(); }
    for (int task = task0 + w0; task < task0 + ntask; task += wstep) {
        const int tok0 = task * 16, b = tok0 / SEQ;
#pragma unroll 1
        for (int h = 0; h < 4; ++h) {
            BF8 qf[2];
            {
                float qv[2][8]; float ss = 0.f;
#pragma unroll
                for (int s2 = 0; s2 < 2; ++s2) {
                    const float4* qp = (const float4*)(Qx + (size_t)(tok0 + qi) * 256 + h * 64 + 32 * s2 + 8 * g);
                    const float4 a = qp[0], c = qp[1];
                    qv[s2][0] = a.x; qv[s2][1] = a.y; qv[s2][2] = a.z; qv[s2][3] = a.w; qv[s2][4] = c.x; qv[s2][5] = c.y; qv[s2][6] = c.z; qv[s2][7] = c.w;
#pragma unroll
                    for (int j = 0; j < 8; ++j) ss += qv[s2][j] * qv[s2][j];
                }
                ss += __shfl_xor(ss, 16, 64); ss += __shfl_xor(ss, 32, 64);
                const float rs = rsqrtf(ss * (1.f / 64.f) + EPS) * 0.125f;
#pragma unroll
                for (int s2 = 0; s2 < 2; ++s2) {
                    const float4 g0 = *(const float4*)(qg + 32 * s2 + 8 * g), g1 = *(const float4*)(qg + 32 * s2 + 8 * g + 4);
                    qf[s2].w[0] = pk_bf16(qv[s2][0] * rs * g0.x, qv[s2][1] * rs * g0.y); qf[s2].w[1] = pk_bf16(qv[s2][2] * rs * g0.z, qv[s2][3] * rs * g0.w);
                    qf[s2].w[2] = pk_bf16(qv[s2][4] * rs * g1.x, qv[s2][5] * rs * g1.y); qf[s2].w[3] = pk_bf16(qv[s2][6] * rs * g1.z, qv[s2][7] * rs * g1.w);
                }
            }
            const bf16_t* Kh = KB + ((size_t)b * 4 + h) * NMEM * 64;
            const bf16_t* Vh = VTB + ((size_t)b * 4 + h) * 64 * NMEM;
            f32x4_t oacc[4];
#pragma unroll
            for (int dt = 0; dt < 4; ++dt) oacc[dt] = (f32x4_t){0.f, 0.f, 0.f, 0.f};
            float lsum = 0.f;
            const int krow = 8 * (qi >> 2) + (qi & 3);
#pragma unroll 2
            for (int s0 = 0; s0 < NMEM; s0 += 32) {
                BF8 ka[2][2], va[4];
#pragma unroll
                for (int t = 0; t < 2; ++t)
#pragma unroll
                    for (int s2 = 0; s2 < 2; ++s2) ka[t][s2].u = *(const uint4*)(Kh + (size_t)(s0 + krow + 4 * t) * 64 + 32 * s2 + 8 * g);
#pragma unroll
                for (int dt = 0; dt < 4; ++dt) va[dt].u = *(const uint4*)(Vh + (size_t)(16 * dt + qi) * NMEM + s0 + 8 * g);
                f32x4_t sacc[2];
#pragma unroll
                for (int t = 0; t < 2; ++t) {
                    sacc[t] = (f32x4_t){0.f, 0.f, 0.f, 0.f};
                    sacc[t] = __builtin_amdgcn_mfma_f32_16x16x32_bf16(ka[t][0].v, qf[0].v, sacc[t], 0, 0, 0);
                    sacc[t] = __builtin_amdgcn_mfma_f32_16x16x32_bf16(ka[t][1].v, qf[1].v, sacc[t], 0, 0, 0);
                }
                float pe[8];
#pragma unroll
                for (int t = 0; t < 2; ++t)
#pragma unroll
                    for (int r = 0; r < 4; ++r) { pe[4 * t + r] = __expf(sacc[t][r]); lsum += pe[4 * t + r]; }
                BF8 pf;
#pragma unroll
                for (int j = 0; j < 4; ++j) pf.w[j] = pk_bf16(pe[2 * j], pe[2 * j + 1]);
#pragma unroll
                for (int dt = 0; dt < 4; ++dt) oacc[dt] = __builtin_amdgcn_mfma_f32_16x16x32_bf16(va[dt].v, pf.v, oacc[dt], 0, 0, 0);
            }
            lsum += __shfl_xor(lsum, 16, 64); lsum += __shfl_xor(lsum, 32, 64);
            const float inv = 1.f / lsum;
#pragma unroll
            for (int dt = 0; dt < 4; ++dt) {
                uint2 o; o.x = pk_bf16(oacc[dt][0] * inv, oacc[dt][1] * inv); o.y = pk_bf16(oacc[dt][2] * inv, oacc[dt][3] * inv);
                *(uint2*)(Ox + (size_t)(tok0 + qi) * 256 + h * 64 + 16 * dt + 4 * g) = o;
            }
        }
    }
}

template <int N> __device__ __forceinline__ void bitonic_sort_desc(unsigned (&a)[N]) {
#pragma unroll
    for (int k = 2; k <= N; k <<= 1)
#pragma unroll
        for (int j = k >> 1; j > 0; j >>= 1)
#pragma unroll
            for (int i = 0; i < N; ++i) {
                const int o = i ^ j;
                if (o > i) {
                    const bool desc = ((i & k) == 0);
                    const unsigned x = a[i], y = a[o];
                    const unsigned mx = x > y ? x : y, mn = x > y ? y : x;
                    a[i] = desc ? mx : mn; a[o] = desc ? mn : mx;
                }
            }
}
__device__ __forceinline__ void bitonic_merge16_desc(unsigned (&a)[16]) {
#pragma unroll
    for (int j = 8; j > 0; j >>= 1)
#pragma unroll
        for (int i = 0; i < 16; ++i) {
            const int o = i ^ j;
            if (o > i) { const unsigned x = a[i], y = a[o]; a[i] = x > y ? x : y; a[o] = x > y ? y : x; }
        }
}
__device__ __forceinline__ void top16_merge(unsigned (&a)[16], const unsigned (&b)[16]) {
#pragma unroll
    for (int i = 0; i < 16; ++i) a[i] = a[i] > b[15 - i] ? a[i] : b[15 - i];
    bitonic_merge16_desc(a);
}
__device__ __forceinline__ void top16_xlane(unsigned (&a)[16], int xm) {
    unsigned b[16];
#pragma unroll
    for (int i = 0; i < 16; ++i) b[i] = (unsigned)__shfl_xor((int)a[i], xm, 64);
    top16_merge(a, b);
}
__device__ __forceinline__ void ph_subkeys_convert(const Ctx& p) {
    const float* sk = pin_(31);
    bf16_t* o = (bf16_t*)(pws_() + WS_SKB);
    const size_t n = (size_t)DEPTH * 8 * 2 * 128 * 64;
    for (size_t i = (size_t)bid_() * 512 + tid_(); i < n; i += (size_t)nblk_() * 512) o[i] = f2bf(sk[i]);
}
__device__ __forceinline__ void ph_peer_topk(const Ctx& p, int l, float* smem, int task0 = 0, int ntask = MTOK / 16, int w0 = -1, int wstep = 0) {
    const bf16_t* Qp = (const bf16_t*)(pws_() + WS_QP);
    const bf16_t* SK = (const bf16_t*)(pws_() + WS_SKB) + (size_t)l * 8 * 2 * 128 * 64;
    int* pidx = (int*)(pws_() + WS_PEI);
    float* pgt = (float*)(pws_() + WS_PEG);
    float* pus = (float*)(pws_() + WS_PUS);
    const float* usc = (const float*)(pws_() + WS_USC) + (size_t)l * NEXP;
    const float* vsc = (const float*)(pws_() + WS_VSC) + (size_t)l * NEXP;
    const int tid = tid_(), lane = tid & 63, wave = tid >> 6, qi = lane & 15, g = lane >> 4;
    int* tabw = (int*)smem + wave * 512 + qi * 32;
    if (w0 < 0) { w0 = gwave(); wstep = nwaves(); }
    for (int task = task0 + w0; task < task0 + ntask; task += wstep) {
        const size_t tok = (size_t)task * 16 + qi;
#pragma unroll 1
        for (int h = 0; h < 8; ++h) {
            unsigned L[2][16];
#pragma unroll
            for (int pp = 0; pp < 2; ++pp) {
                BF8 qf[2];
#pragma unroll
                for (int s2 = 0; s2 < 2; ++s2) qf[s2].u = *(const uint4*)(Qp + tok * DM + h * 128 + pp * 64 + 32 * s2 + 8 * g);
                const bf16_t* skp = SK + (size_t)(h * 2 + pp) * 128 * 64;
                unsigned va[16], vb[16];
#pragma unroll
                for (int tile = 0; tile < 8; ++tile) {
                    BF8 ka[2];
#pragma unroll
                    for (int s2 = 0; s2 < 2; ++s2) ka[s2].u = *(const uint4*)(skp + (size_t)(16 * tile + qi) * 64 + 32 * s2 + 8 * g);
                    f32x4_t d = __builtin_amdgcn_mfma_f32_16x16x32_bf16(ka[0].v, qf[0].v, (f32x4_t){0.f, 0.f, 0.f, 0.f}, 0, 0, 0);
                    d = __builtin_amdgcn_mfma_f32_16x16x32_bf16(ka[1].v, qf[1].v, d, 0, 0, 0);
#pragma unroll
                    for (int r = 0; r < 4; ++r) {
                        const unsigned key = (ford(d[r]) & ~127u) | (unsigned)(127 - (16 * tile + 4 * g + r));
                        if (tile < 4) va[tile * 4 + r] = key; else vb[(tile - 4) * 4 + r] = key;
                    }
                }
                bitonic_sort_desc<16>(va);
                bitonic_sort_desc<16>(vb);
                top16_merge(va, vb);
                top16_xlane(va, 16);
                top16_xlane(va, 32);
#pragma unroll
                for (int i = 0; i < 16; ++i) L[pp][i] = va[i];
            }
            if (g < 2) {
#pragma unroll
                for (int i = 0; i < 16; ++i) tabw[g * 16 + i] = 127 - (int)((g == 0 ? L[0][i] : L[1][i]) & 127u);
            }
            float s1[16], s2v[16];
#pragma unroll
            for (int i = 0; i < 16; ++i) { s1[i] = funord(L[0][i] & ~127u); s2v[i] = funord(L[1][i] & ~127u); }
            unsigned ca[16], cb[16];
#pragma unroll
            for (int i = 0; i < 16; ++i) { ca[i] = 0u; cb[i] = 0u; }
            {
                const float r0 = g == 0 ? s1[0] : (g == 1 ? s1[1] : (g == 2 ? s1[2] : s1[3]));
                const int nb0 = g == 0 ? 16 : (g == 1 ? 8 : (g == 2 ? 5 : 4));
#pragma unroll
                for (int bq = 0; bq < 16; ++bq) if (bq < nb0) ca[bq] = (ford(r0 + s2v[bq]) & ~255u) | (unsigned)(255 - (g * 16 + bq));
                const float r1 = g == 0 ? s1[4] : (g == 1 ? s1[5] : (g == 2 ? s1[6] : s1[7]));
                const int nb1 = g == 0 ? 3 : 2;
#pragma unroll
                for (int bq = 0; bq < 3; ++bq) if (bq < nb1) cb[bq] = (ford(r1 + s2v[bq]) & ~255u) | (unsigned)(255 - ((g + 4) * 16 + bq));
                const float r2 = g == 0 ? s1[8] : (g == 1 ? s1[9] : (g == 2 ? s1[10] : s1[11]));
                cb[3] = (ford(r2 + s2v[0]) & ~255u) | (unsigned)(255 - ((g + 8) * 16));
                const float r3 = g == 0 ? s1[12] : (g == 1 ? s1[13] : (g == 2 ? s1[14] : s1[15]));
                cb[4] = (ford(r3 + s2v[0]) & ~255u) | (unsigned)(255 - ((g + 12) * 16));
            }
            bitonic_sort_desc<16>(ca);
            bitonic_sort_desc<16>(cb);
            top16_merge(ca, cb);
            top16_xlane(ca, 16);
            top16_xlane(ca, 32);
            float tv[16]; float den = 0.f;
#pragma unroll
            for (int i = 0; i < 16; ++i) {
                const int f = 255 - (int)(ca[i] & 255u);
                const int a = f >> 4, bq = f & 15;
                tv[i] = funord(ca[i] & ~255u);
                (void)a; (void)bq;
            }
#pragma unroll
            for (int i = 0; i < 16; ++i) { tv[i] = __expf(tv[i] - funord(ca[0] & ~255u)); den += tv[i]; }
            const float inv = 1.f / den;
            int ev[4]; float gv[4];
#pragma unroll
            for (int r = 0; r < 4; ++r) {
                const unsigned key = g == 0 ? ca[r] : (g == 1 ? ca[4 + r] : (g == 2 ? ca[8 + r] : ca[12 + r]));
                const float tvv = g == 0 ? tv[r] : (g == 1 ? tv[4 + r] : (g == 2 ? tv[8 + r] : tv[12 + r]));
                const int f = 255 - (int)(key & 255u);
                ev[r] = tabw[f >> 4] * 128 + tabw[16 + (f & 15)];
                gv[r] = tvv * inv;
            }
            float us[4];
#pragma unroll
            for (int r = 0; r < 4; ++r) { us[r] = usc[ev[r]]; gv[r] *= vsc[ev[r]]; }
            *(int4*)(pidx + tok * 128 + h * 16 + 4 * g) = make_int4(ev[0], ev[1], ev[2], ev[3]);
            *(float4*)(pgt + tok * 128 + h * 16 + 4 * g) = make_float4(gv[0], gv[1], gv[2], gv[3]);
            *(float4*)(pus + tok * 128 + h * 16 + 4 * g) = make_float4(us[0], us[1], us[2], us[3]);
        }
    }
}

typedef float f32x2_t __attribute__((ext_vector_type(2)));
typedef int i32x8_t __attribute__((ext_vector_type(8)));
__device__ __forceinline__ unsigned pack4_fp8(float4 a, float sc) {
    const float x = fminf(fmaxf(a.x * sc, -448.f), 448.f), y = fminf(fmaxf(a.y * sc, -448.f), 448.f);
    const float z = fminf(fmaxf(a.z * sc, -448.f), 448.f), w = fminf(fmaxf(a.w * sc, -448.f), 448.f);
    int r = __builtin_amdgcn_cvt_pk_fp8_f32(x, y, 0, false);
    r = __builtin_amdgcn_cvt_pk_fp8_f32(z, w, r, true);
    return (unsigned)r;
}
__device__ __forceinline__ unsigned q4_e2m1(float y) {
    const float a = fabsf(y);
    const unsigned c = (unsigned)(a > 0.25f) + (unsigned)(a > 0.75f) + (unsigned)(a > 1.25f) + (unsigned)(a > 1.75f) + (unsigned)(a > 2.5f) + (unsigned)(a > 3.5f) + (unsigned)(a > 5.0f);
    return c | (y < 0.f ? 8u : 0u);
}
__device__ __forceinline__ void ph_tab_convert_all(const Ctx& p) {
    const int lane = tid_() & 63;
    for (int row = gwave(); row < 2 * DEPTH * NEXP; row += nwaves()) {
        const int tabv = row >= DEPTH * NEXP;
        const int rr = tabv ? row - DEPTH * NEXP : row;
        const float4* src = (const float4*)((tabv ? pin_(33) : pin_(32)) + (size_t)rr * DM);
        float4 v[4]; float am = 0.f;
#pragma unroll
        for (int i = 0; i < 4; ++i) { v[i] = src[lane + 64 * i]; am = fmaxf(am, fmaxf(fmaxf(fabsf(v[i].x), fabsf(v[i].y)), fmaxf(fabsf(v[i].z), fabsf(v[i].w)))); }
        am = wave_max(am);
        const float sc = am > 0.f ? am * (1.f / 6.f) : 1.f, inv = 1.f / sc;
        unsigned char* dst = (unsigned char*)(pws_() + (tabv ? WS_V4 : WS_U4)) + (size_t)rr * 512;
#pragma unroll
        for (int i = 0; i < 4; ++i) {
            const unsigned pk = q4_e2m1(v[i].x * inv) | (q4_e2m1(v[i].y * inv) << 4) | (q4_e2m1(v[i].z * inv) << 8) | (q4_e2m1(v[i].w * inv) << 12);
            const int off = tabv ? 16 * (lane >> 1) + 4 * i + 2 * (lane & 1) : 128 * i + 2 * lane;
            *(unsigned short*)(dst + off) = (unsigned short)pk;
        }
        if (lane == 0) ((float*)(pws_() + (tabv ? WS_VSC : WS_USC)))[rr] = sc;
    }
}
__device__ __forceinline__ float dpp_xor1(float v) { return __int_as_float(__builtin_amdgcn_update_dpp(0, __float_as_int(v), 0xB1, 0xF, 0xF, true)); }
__device__ __forceinline__ void ph_peer_u4(const Ctx& p, int l, float* smem) {
    const unsigned char* ut = (const unsigned char*)(pws_() + WS_U4) + (size_t)l * NEXP * 512;
    const int* pidx = (const int*)(pws_() + WS_PEI);
    float* pgt = (float*)(pws_() + WS_PEG);
    const float* pus = (const float*)(pws_() + WS_PUS);
    const unsigned char* H8 = (const unsigned char*)(pws_() + WS_H8);
    const int lane = tid_() & 63, g = lane >> 4, i = lane & 15, wave = tid_() >> 6;
    const bool odd = i & 1;
    unsigned char* hl = (unsigned char*)smem + wave * 2048;
    const int nw = nwaves();
    int tok = gwave();
    int ne0 = pidx[(size_t)tok * 128 + lane], ne1 = pidx[(size_t)tok * 128 + 64 + lane];
    *(uint4*)(hl + 16 * lane) = *(const uint4*)(H8 + (size_t)tok * DM + 16 * lane);
    uint4 rA[8], rB[8], rC[8], rD[8];
    const int roff = 64 * (i & 1) + 16 * g;
#define PU_ROWS(buf, esrc, hq) do { const int ea_ = __builtin_amdgcn_ds_bpermute(((hq) * 16 + (i >> 1)) * 4, esrc), eb_ = __builtin_amdgcn_ds_bpermute(((hq) * 16 + 8 + (i >> 1)) * 4, esrc); \
        const unsigned char* pa_ = ut + (size_t)ea_ * 512 + roff; const unsigned char* pb_ = ut + (size_t)eb_ * 512 + roff; \
        _Pragma("unroll") for (int q_ = 0; q_ < 4; ++q_) { buf[q_] = *(const uint4*)(pa_ + 128 * q_); buf[4 + q_] = *(const uint4*)(pb_ + 128 * q_); } \
        __builtin_amdgcn_sched_barrier(0); } while (0)
#define PU_COMP(buf, hd) do { f32x4_t a0_ = {0.f, 0.f, 0.f, 0.f}, a1_ = {0.f, 0.f, 0.f, 0.f}; \
        _Pragma("unroll") for (int q_ = 0; q_ < 4; ++q_) { \
            const uint4 b0_ = *(const uint4*)(hb + 256 * q_), b1_ = *(const uint4*)(hb + 256 * q_ + 64); \
            const i32x8_t b_ = {(int)b0_.x, (int)b0_.y, (int)b0_.z, (int)b0_.w, (int)b1_.x, (int)b1_.y, (int)b1_.z, (int)b1_.w}; \
            const i32x8_t x_ = {(int)buf[q_].x, (int)buf[q_].y, (int)buf[q_].z, (int)buf[q_].w, 0, 0, 0, 0}; \
            const i32x8_t y_ = {(int)buf[4 + q_].x, (int)buf[4 + q_].y, (int)buf[4 + q_].z, (int)buf[4 + q_].w, 0, 0, 0, 0}; \
            a0_ = __builtin_amdgcn_mfma_scale_f32_16x16x128_f8f6f4(x_, b_, a0_, 4, 0, 0, 0, 0, 0); \
            a1_ = __builtin_amdgcn_mfma_scale_f32_16x16x128_f8f6f4(y_, b_, a1_, 4, 0, 0, 0, 0, 0); \
            __builtin_amdgcn_sched_barrier(0); } \
        float t0a_ = odd ? a0_[1] : a0_[0], t0b_ = odd ? a0_[3] : a0_[2], t1a_ = odd ? a1_[1] : a1_[0], t1b_ = odd ? a1_[3] : a1_[2]; \
        t0a_ += dpp_xor1(t0a_); t0b_ += dpp_xor1(t0b_); t1a_ += dpp_xor1(t1a_); t1b_ += dpp_xor1(t1b_); \
        if ((i >> 1) == (hd)) { keep0 = odd ? t1a_ : t0a_; keep1 = odd ? t1b_ : t0b_; } \
        __builtin_amdgcn_sched_barrier(0); } while (0)
    PU_ROWS(rA, ne0, 0); PU_ROWS(rB, ne0, 1); PU_ROWS(rC, ne0, 2);
    int par = 0;
    for (; tok < MTOK; tok += nw, par ^= 1) {
        const int e0 = ne0, e1 = ne1;
        const size_t tn = (size_t)(tok + nw < MTOK ? tok + nw : tok);
        const uint4 hnext = *(const uint4*)(H8 + tn * DM + 16 * lane);
        ne0 = pidx[tn * 128 + lane]; ne1 = pidx[tn * 128 + 64 + lane];
        const size_t mi = (size_t)tok * 128 + (i >> 1) * 16 + 8 * (i & 1) + 2 * g;
        const float2 gm = *(const float2*)(pgt + mi), um = *(const float2*)(pus + mi);
        asm volatile("s_waitcnt lgkmcnt(0)" ::: "memory"); __builtin_amdgcn_wave_barrier();
        const unsigned char* hb = hl + par * 1024 + 128 * (i & 1) + 16 * g;
        float keep0 = 0.f, keep1 = 0.f;
        PU_ROWS(rD, e0, 3); PU_COMP(rA, 0);
        PU_ROWS(rA, e1, 0); PU_COMP(rB, 1);
        PU_ROWS(rB, e1, 1); PU_COMP(rC, 2);
        PU_ROWS(rC, e1, 2); PU_COMP(rD, 3);
        PU_ROWS(rD, e1, 3); PU_COMP(rA, 4);
        PU_ROWS(rA, ne0, 0); PU_COMP(rB, 5);
        PU_ROWS(rB, ne0, 1); PU_COMP(rC, 6);
        PU_ROWS(rC, ne0, 2); PU_COMP(rD, 7);
        *(uint4*)(hl + (par ^ 1) * 1024 + 16 * lane) = hnext;
        float2 o;
        o.x = gm.x * gelu_tanh_f(keep0 * um.x * (1.f / H8_SCALE)); o.y = gm.y * gelu_tanh_f(keep1 * um.y * (1.f / H8_SCALE));
        *(float2*)(pgt + mi) = o;
    }
#undef PU_ROWS
#undef PU_COMP
}
__device__ __forceinline__ void ph_peer_v4(const Ctx& p, int l) {
    const unsigned char* vt = (const unsigned char*)(pws_() + WS_V4) + (size_t)l * NEXP * 512;
    const int* pidx = (const int*)(pws_() + WS_PEI);
    const float* pgt = (const float*)(pws_() + WS_PEG);
    float* x = pout_();
    const int lane = tid_() & 63;
    const bool r = lane & 32;
    const int coff = 16 * (lane & 31);
    const int nw = nwaves();
    int tok = gwave();
    int ne0 = pidx[(size_t)tok * 128 + lane], ne1 = pidx[(size_t)tok * 128 + 64 + lane];
    float nc0 = pgt[(size_t)tok * 128 + lane], nc1 = pgt[(size_t)tok * 128 + 64 + lane];
    for (; tok < MTOK; tok += nw) {
        const int e0 = ne0, e1 = ne1;
        const float c0 = nc0, c1 = nc1;
        if (tok + nw < MTOK) {
            const size_t tn = (size_t)(tok + nw);
            ne0 = pidx[tn * 128 + lane]; ne1 = pidx[tn * 128 + 64 + lane];
            nc0 = pgt[tn * 128 + lane]; nc1 = pgt[tn * 128 + 64 + lane];
        }
        f32x2_t out[16];
#pragma unroll
        for (int k = 0; k < 16; ++k) out[k] = (f32x2_t){0.f, 0.f};
#pragma unroll 1
        for (int hb = 0; hb < 4; ++hb) {
            const int esrc = hb < 2 ? e0 : e1;
            const float csrc = hb < 2 ? c0 : c1;
            const int lb = (hb & 1) * 32;
            uint4 vr[16];
#pragma unroll
            for (int k = 0; k < 16; ++k) {
                const int ea = __builtin_amdgcn_readlane(esrc, lb + 2 * k), eb = __builtin_amdgcn_readlane(esrc, lb + 2 * k + 1);
                const int e = r ? eb : ea;
                vr[k] = *(const uint4*)(vt + (size_t)e * 512 + coff);
            }
#pragma unroll
            for (int k = 0; k < 16; ++k) {
                const float ca = __uint_as_float(__builtin_amdgcn_readlane(__float_as_uint(csrc), lb + 2 * k));
                const float cb = __uint_as_float(__builtin_amdgcn_readlane(__float_as_uint(csrc), lb + 2 * k + 1));
                const float cj = r ? cb : ca;
                const f32x2_t c2 = {cj, cj};
#define PV_D4(W, q) do { \
                out[4 * (q) + 0] = __builtin_elementwise_fma(__builtin_amdgcn_cvt_scalef32_pk_f32_fp4(W, 1.0f, 0), c2, out[4 * (q) + 0]); \
                out[4 * (q) + 1] = __builtin_elementwise_fma(__builtin_amdgcn_cvt_scalef32_pk_f32_fp4(W, 1.0f, 1), c2, out[4 * (q) + 1]); \
                out[4 * (q) + 2] = __builtin_elementwise_fma(__builtin_amdgcn_cvt_scalef32_pk_f32_fp4(W, 1.0f, 2), c2, out[4 * (q) + 2]); \
                out[4 * (q) + 3] = __builtin_elementwise_fma(__builtin_amdgcn_cvt_scalef32_pk_f32_fp4(W, 1.0f, 3), c2, out[4 * (q) + 3]); } while (0)
                PV_D4(vr[k].x, 0); PV_D4(vr[k].y, 1); PV_D4(vr[k].z, 2); PV_D4(vr[k].w, 3);
#undef PV_D4
            }
        }
#pragma unroll
        for (int q = 0; q < 4; ++q) {
            float fin[4];
#pragma unroll
            for (int b = 0; b < 2; ++b)
#pragma unroll
                for (int c = 0; c < 2; ++c) {
                    const float lo = out[4 * q + b][c], hi = out[4 * q + 2 + b][c];
                    const float mine = r ? hi : lo, send = r ? lo : hi;
                    fin[2 * b + c] = mine + __shfl_xor(send, 32, 64);
                }
            float4* xp = (float4*)(x + (size_t)tok * DM + 256 * q + 8 * (lane & 31) + (r ? 4 : 0));
            float4 a = *xp;
            a.x += fin[0]; a.y += fin[1]; a.z += fin[2]; a.w += fin[3];
            *xp = a;
        }
    }
}


#ifndef PROBE_MASK
#define PROBE_MASK 0
#endif
#if PROBE_MASK
#define GB(k) do { GRID_BARRIER(); const unsigned long long now_ = wall_clock64(); if ((PROBE_MASK >> (k)) & 1) { const unsigned long long dt_ = now_ - tprev_; while (wall_clock64() - now_ < 3ull * dt_) __builtin_amdgcn_s_sleep(8); } GRID_BARRIER(); tprev_ = wall_clock64(); } while (0)
#else
#define GB(k) GRID_BARRIER()
#endif
__global__ void __launch_bounds__(512, 2) k_mega(Params kp) {
    float* sm = dynsmem;
    {
        unsigned long long* tab = (unsigned long long*)((char*)dynsmem + PTAB_OFF);
        if (threadIdx.x < 34) tab[threadIdx.x] = (unsigned long long)kp.in[threadIdx.x];
        if (threadIdx.x == 34) tab[34] = (unsigned long long)kp.out;
        if (threadIdx.x == 35) tab[35] = (unsigned long long)kp.ws;
        if (threadIdx.x == 36) { tab[36] = 0ull; tab[37] = 0ull; }
    }
    __syncthreads();
    Ctx p; p.kp = &kp;
    (void)xcd_barrier_post((unsigned*)(pws_() + WS_BAR), (volatile LAS unsigned*)((char*)dynsmem + PTAB_OFF + 36 * 8));
#define GRID_BARRIER() do { XcdBarrier bar_; bar_.bar = (unsigned*)(pws_() + WS_BAR); bar_.x = xb_xcc_id(); bar_.st = (volatile LAS unsigned*)((char*)dynsmem + PTAB_OFF + 36 * 8); xcd_barrier(bar_); } while (0)
    ph_weight_prep(p, sm);
    ph_subkeys_convert(p);
    ph_tab_convert_all(p);
    GRID_BARRIER();
#if PROBE_MASK
    unsigned long long tprev_ = wall_clock64();
#endif
#pragma unroll 1
    for (int l = 0; l < DEPTH; ++l) {
#define XIN_ (l == 0 ? pin_(0) : pout_())
#define HBUF_ ((const bf16_t*)(pws_() + WS_H))
        ph_rmsnorm(XIN_, pin_(2) + (size_t)l * DM, (bf16_t*)(pws_() + WS_H), MTOK);
        ph_rmsnorm(pin_(1), pin_(22) + (size_t)l * DM, (bf16_t*)(pws_() + WS_HM), MMEM);
        GB(1);
        { pg8::EpiBf16 E; E.O = (bf16_t*)(pws_() + WS_P); E.ldc = LDP; ph_gemm(HBUF_, (const bf16_t*)(pws_() + WT_IN) + (size_t)l * LDP * DM, MTOK, LDP, DM, E); }
        { pg8::EpiF32 E; E.C = (float*)(pws_() + WS_KM); E.R = nullptr; E.ldc = 256; ph_gemm((const bf16_t*)(pws_() + WS_HM), (const bf16_t*)(pws_() + WT_XK) + (size_t)l * 256 * DM, MMEM, 256, DM, E, 32); }
        { pg8::EpiF32 E; E.C = (float*)(pws_() + WS_VM); E.R = nullptr; E.ldc = 256; ph_gemm((const bf16_t*)(pws_() + WS_HM), (const bf16_t*)(pws_() + WT_XV) + (size_t)l * 256 * DM, MMEM, 256, DM, E, 64); }
        GB(2);
        ph_mem_prep(p, l);
        ph_dsa_prep(p, l);
        ph_scan_prep(p, l);
        GB(3);
        ph_scans(p, l, sm);
        GB(4);
        ph_mixer_finish(p, l);
        ph_dsa_main(p, l, sm);
        GB(5);
#define PANEL_SYNC() do { asm volatile("s_waitcnt vmcnt(0) lgkmcnt(0)" ::: "memory"); __syncthreads(); \
        if (threadIdx.x < 64) { __builtin_amdgcn_fence(__ATOMIC_ACQUIRE, "agent"); asm volatile("s_waitcnt vmcnt(0)" ::: "memory"); } \
        __syncthreads(); } while (0)
        if (nblk_() == MTOK / 256) {
            const int pm = bid_(), wv = tid_() >> 6;
            { pg8::EpiF32 E; E.C = pout_(); E.R = XIN_; E.ldc = DM; ph_gemm_panel((const bf16_t*)(pws_() + WS_Y), (const bf16_t*)(pws_() + WT_OUT) + (size_t)l * DM * DM, MTOK, DM, DM, E, pm); }
            PANEL_SYNC();
            ph_rmsnorm(pout_(), pin_(21) + (size_t)l * DM, (bf16_t*)(pws_() + WS_H), 256, pm * 256, wv, 8);
            PANEL_SYNC();
            { pg8::EpiF32 E; E.C = (float*)(pws_() + WS_QX); E.R = nullptr; E.ldc = 256; ph_gemm_panel(HBUF_, (const bf16_t*)(pws_() + WT_XQ) + (size_t)l * 256 * DM, MTOK, 256, DM, E, pm); }
            PANEL_SYNC();
            ph_xattn(p, l, pm * 16, 16, wv, 8);
            PANEL_SYNC();
            { pg8::EpiF32 E; E.C = pout_(); E.R = pout_(); E.ldc = DM; ph_gemm_panel((const bf16_t*)(pws_() + WS_OX), (const bf16_t*)(pws_() + WT_XO) + (size_t)l * DM * 256, MTOK, DM, 256, E, pm); }
            PANEL_SYNC();
            ph_rmsnorm(pout_(), pin_(29) + (size_t)l * DM, (bf16_t*)(pws_() + WS_H), 256, pm * 256, wv, 8, (unsigned char*)(pws_() + WS_H8));
            PANEL_SYNC();
            { pg8::EpiBf16 E; E.O = (bf16_t*)(pws_() + WS_QP); E.ldc = DM; ph_gemm_panel(HBUF_, (const bf16_t*)(pws_() + WT_PQ) + (size_t)l * DM * DM, MTOK, DM, DM, E, pm); }
            PANEL_SYNC();
            ph_peer_topk(p, l, sm, pm * 16, 16, wv, 8);
        }
        GB(13);
        ph_peer_u4(p, l, sm);
        GB(14);
        ph_peer_v4(p, l);
        GB(17);
    }
}

extern "C" void kernel_launch(void* const* d_in, const int* in_sizes, int n_in, void* d_out, int out_size, void* d_ws, size_t ws_size, hipStream_t stream) {
    if (n_in != 34 || out_size != MTOK * DM || ws_size < WS_END) {
        fprintf(stderr, "kernel_launch: unexpected shapes (n_in %d out %d ws %zu need %zu)\n", n_in, out_size, ws_size, (size_t)WS_END);
        return;
    }
    static int grid = 0;
    if (!grid) {
        int dev = 0, cus = 0, per_cu = 0;
        (void)hipGetDevice(&dev);
        (void)hipDeviceGetAttribute(&cus, hipDeviceAttributeMultiprocessorCount, dev);
        (void)hipFuncSetAttribute((const void*)k_mega, hipFuncAttributeMaxDynamicSharedMemorySize, LDS_BYTES);
        (void)hipOccupancyMaxActiveBlocksPerMultiprocessor(&per_cu, (const void*)k_mega, 512, LDS_BYTES);
        if (per_cu < 1) fprintf(stderr, "kernel_launch: occupancy query reports %d blocks per CU\n", per_cu);
        grid = cus > 0 ? cus : 256;
    }
    Params p; memset(&p, 0, sizeof(p));
    for (int i = 0; i < 34; ++i) p.in[i] = (const float*)d_in[i];
    p.out = (float*)d_out; p.ws = (char*)d_ws;
    (void)hipMemsetAsync((char*)d_ws + WS_BAR, 0, XCD_BAR_WORDS * sizeof(unsigned), stream);
    hipLaunchKernelGGL(k_mega, dim3(grid), dim3(512), LDS_BYTES, stream, p);
}
```

```cpp
#include <hip/hip_runtime.h>
#include <stdint.h>
#include <stdio.h>
#include <string.h>

#define NB 32
#define SEQ 2048
#define DM 1024
#define MTOK (NB * SEQ)
#define DEPTH 4
#define NMEM 256
#define MMEM (NB * NMEM)
#define LDP 3328
#define NEXP 16384
#define EPS 1e-6f
#define PC_Z 0
#define PC_XBC 256
#define PC_GQKV 768
#define PC_GG 1536
#define PC_LQ 1792
#define PC_LK 1920
#define PC_LV 2048
#define PC_LR 2304
#define PC_DQ 2560
#define PC_DK 2816
#define PC_DV 2880
#define PC_IQ 2944
#define PC_IK 3200
#define PC_GLR 3232
#define PC_IW 3248
#define PC_DT 3256
#define PC_GA 3260
#define PC_GB 3264

typedef unsigned short bf16_t;

#define WS_BAR 0ull
#define WS_P 16384ull
#define SZ_P ((size_t)MTOK * LDP * 2)
#define WS_H (WS_P + SZ_P)
#define SZ_H ((size_t)MTOK * DM * 2)
#define WS_Y (WS_H + SZ_H)
#define SZ_Y ((size_t)MTOK * DM * 2)
#define WS_WP (WS_Y + SZ_Y)
#define SZ_WP ((size_t)DEPTH * DM * LDP * 4)
#define WT_IN (WS_WP)
#define WT_OUT (WT_IN + (size_t)DEPTH * LDP * DM * 2)
#define WT_XQ (WT_OUT + (size_t)DEPTH * DM * DM * 2)
#define WT_XK (WT_XQ + (size_t)DEPTH * 256 * DM * 2)
#define WT_XV (WT_XK + (size_t)DEPTH * 256 * DM * 2)
#define WT_XO (WT_XV + (size_t)DEPTH * 256 * DM * 2)
#define WT_PQ (WT_XO + (size_t)DEPTH * DM * 256 * 2)
#define WT_END (WT_PQ + (size_t)DEPTH * DM * DM * 2)
#define WS_QN (WS_WP + SZ_WP)
#define SZ_QN ((size_t)MTOK * 256 * 4)
#define WS_KN (WS_QN + SZ_QN)
#define SZ_KN ((size_t)MTOK * 64 * 4)
#define WS_IKN (WS_KN + SZ_KN)
#define SZ_IKN ((size_t)MTOK * 32 * 4)
#define WS_YPRE (WS_IKN + SZ_IKN)
#define SZ_YPRE ((size_t)MTOK * 256 * 4)
#define WS_HM (WS_YPRE + SZ_YPRE)
#define SZ_HM ((size_t)MMEM * DM * 2)
#define WS_KM (WS_HM + SZ_HM)
#define SZ_KM ((size_t)MMEM * 256 * 4)
#define WS_VM (WS_KM + SZ_KM)
#define SZ_VM ((size_t)MMEM * 256 * 4)
#define WS_KB (WS_VM + SZ_VM)
#define SZ_KB ((size_t)MMEM * 256 * 2)
#define WS_VTB (WS_KB + SZ_KB)
#define SZ_VTB ((size_t)MMEM * 256 * 2)
#define WS_VT (WS_VTB + SZ_VTB)
#define SZ_VT ((size_t)MTOK * 64 * 2)
#define WS_SKB (WS_VT + SZ_VT)
#define SZ_SKB ((size_t)DEPTH * 8 * 2 * 128 * 64 * 2)
#define WS_SC (WS_SKB + SZ_SKB)
#define SZ_SC ((size_t)MTOK * 16 * 4)
#define WS_DUMMY (WS_SC + SZ_SC)
#define SZ_DUMMY (65536ull)
#define WS_U4 (WS_DUMMY + SZ_DUMMY)
#define WS_V4 (WS_U4 + (size_t)DEPTH * NEXP * 512)
#define WS_USC (WS_V4 + (size_t)DEPTH * NEXP * 512)
#define WS_VSC (WS_USC + (size_t)DEPTH * NEXP * 4)
#define WS_END (WS_VSC + (size_t)DEPTH * NEXP * 4)
#define WS_QX (WS_P)
#define WS_OX (WS_P + (size_t)MTOK * 256 * 4)
#define WS_QP (WS_P + 96ull * 1024 * 1024)
#define WS_H8 (WS_P + 224ull * 1024 * 1024)
#define WS_PEI (WS_H8 + (size_t)MTOK * DM)
#define WS_PEG (WS_PEI + (size_t)MTOK * 128 * 4)
#define WS_PUS (WS_PEG + (size_t)MTOK * 128 * 4)
#define WS_PEND (WS_PUS + (size_t)MTOK * 128 * 4)
static_assert(WS_PEND <= WS_P + SZ_P, "P region aliases");

struct Params {
    const float* in[34];
    float* out;
    char* ws;
};

#define XB_TMO      128
#define XB_XCNT(j)  (256  + 64 * (j))
#define XB_XSUB(j)  (1280 + 64 * (j))
#define XB_XGEN(j)  (2304 + 64 * (j))
#define XB_TOP      3328
#define XB_TOPGEN   3392
#define XCD_BAR_WORDS 3456
#define XB_SPIN_CAP (1u << 18)
#define LAS __attribute__((address_space(3)))

__device__ __forceinline__ unsigned xb_ld(unsigned* p)              { return __hip_atomic_load(p, __ATOMIC_RELAXED, __HIP_MEMORY_SCOPE_AGENT); }
__device__ __forceinline__ unsigned xb_add(unsigned* p, unsigned v) { return __hip_atomic_fetch_add(p, v, __ATOMIC_RELAXED, __HIP_MEMORY_SCOPE_AGENT); }
__device__ __forceinline__ unsigned xb_xcc_id() { return (unsigned)__builtin_amdgcn_s_getreg((3 << 11) | 20) & 0xFu; }
#define XB_SPIN(cond, bar) do { unsigned _sp = 0; while (cond) { __builtin_amdgcn_s_sleep(1); \
    if ((++_sp & 255u) == 0u) { if (xb_ld(&(bar)[XB_TMO])) break; if (_sp > XB_SPIN_CAP) { atomicAdd(&(bar)[XB_TMO], 1u); break; } } } } while (0)

struct XcdBarrier {
    unsigned* bar; unsigned x;
    volatile LAS unsigned* st;
};

__device__ __forceinline__ XcdBarrier xcd_barrier_post(unsigned* bar, volatile LAS unsigned* st) {
    XcdBarrier b; b.bar = bar; b.x = xb_xcc_id(); b.st = st;
    if (threadIdx.x == 0) (void)xb_add(&bar[XB_XCNT(b.x)], 1u);
    return b;
}
__device__ __forceinline__ void xcd_barrier_complete(unsigned* bar, unsigned x, unsigned& nloc, unsigned& nx) {
    const unsigned G = gridDim.x * gridDim.y * gridDim.z;
    unsigned sum, cnt, mine, sp = 0u;
    for (;;) {
        sum = 0u; cnt = 0u; mine = 0u;
#pragma unroll
        for (unsigned j = 0; j < 16; ++j) { const unsigned c = xb_ld(&bar[XB_XCNT(j)]); sum += c; cnt += (c > 0u) ? 1u : 0u; mine = (j == x) ? c : mine; }
        if (sum == G) break;
        __builtin_amdgcn_s_sleep(1);
        if ((++sp & 255u) == 0u) { if (xb_ld(&bar[XB_TMO])) break; if (sp > XB_SPIN_CAP) { atomicAdd(&bar[XB_TMO], 1u); break; } }
    }
    nloc = mine > 0u ? mine : 1u; nx = cnt > 0u ? cnt : 1u;
}

__device__ __forceinline__ void xcd_barrier(const XcdBarrier& b) {
    asm volatile("s_waitcnt vmcnt(0)" ::: "memory");
    __syncthreads();
    if (threadIdx.x == 0) {
        unsigned* bar = b.bar;
        __builtin_amdgcn_s_waitcnt(0);
        unsigned nloc = b.st[0], nx = b.st[1];
        if (nloc == 0u) { xcd_barrier_complete(bar, b.x, nloc, nx); b.st[0] = nloc; b.st[1] = nx; }
        const unsigned old = xb_add(&bar[XB_XSUB(b.x)], 1u);
        const unsigned gen = old / nloc;
        if (old + 1u == (gen + 1u) * nloc) {
            __builtin_amdgcn_fence(__ATOMIC_RELEASE, "agent");
            asm volatile("s_waitcnt vmcnt(0)" ::: "memory");
            const unsigned og = xb_add(&bar[XB_TOP], 1u);
            const unsigned tg = og / nx;
            if (og + 1u == (tg + 1u) * nx) xb_add(&bar[XB_TOPGEN], 1u);
            else XB_SPIN(xb_ld(&bar[XB_TOPGEN]) == tg, bar);
            __builtin_amdgcn_fence(__ATOMIC_ACQUIRE, "agent");
            xb_add(&bar[XB_XGEN(b.x)], 1u);
            asm volatile("s_waitcnt vmcnt(0)" ::: "memory");
        } else {
            XB_SPIN(xb_ld(&bar[XB_XGEN(b.x)]) == gen, bar);
            __builtin_amdgcn_fence(__ATOMIC_ACQUIRE, "agent");
            asm volatile("s_waitcnt vmcnt(0)" ::: "memory");
        }
    }
    __syncthreads();
}


#define LDS_BYTES (144 * 1024)
#define PTAB_OFF (LDS_BYTES - 1024)
extern __shared__ __attribute__((aligned(16))) float dynsmem[];
struct Ctx { const Params* kp; };
#define pin_(i) (p.kp->in[i])
#define pout_() (p.kp->out)
#define pws_() (p.kp->ws)

__device__ __forceinline__ float bf2f(bf16_t v) { return __uint_as_float(((unsigned)v) << 16); }
__device__ __forceinline__ bf16_t f2bf(float f) { unsigned u = __float_as_uint(f); u += 0x7FFFu + ((u >> 16) & 1u); return (bf16_t)(u >> 16); }
__device__ __forceinline__ unsigned pk_bf16(float lo, float hi) { return (unsigned)f2bf(lo) | ((unsigned)f2bf(hi) << 16); }
__device__ __forceinline__ float wave_sum(float v) {
#pragma unroll
    for (int o = 32; o >= 1; o >>= 1) v += __shfl_xor(v, o, 64);
    return v;
}
__device__ __forceinline__ float wave_max(float v) {
#pragma unroll
    for (int o = 32; o >= 1; o >>= 1) v = fmaxf(v, __shfl_xor(v, o, 64));
    return v;
}
__device__ __forceinline__ float silu_f(float x) { return x / (1.f + __expf(-x)); }
__device__ __forceinline__ float sigmoid_f(float x) { return 1.f / (1.f + __expf(-x)); }
__device__ __forceinline__ float softplus_f(float x) { return x > 20.f ? x : log1pf(__expf(x)); }
__device__ __forceinline__ float logsigmoid_f(float x) { return -softplus_f(-x); }
__device__ __forceinline__ float gelu_tanh_f(float x) { const float u = 0.7978845608028654f * (x + 0.044715f * x * x * x); return 0.5f * x * (1.f + tanhf(u)); }
__device__ __forceinline__ unsigned ford(float f) { f = f + 0.0f; unsigned u = __float_as_uint(f); return (u & 0x80000000u) ? ~u : (u | 0x80000000u); }
__device__ __forceinline__ float funord(unsigned k) { unsigned u = (k & 0x80000000u) ? (k & 0x7fffffffu) : ~k; return __uint_as_float(u); }
__device__ __forceinline__ unsigned long long wave_max_u64(unsigned long long v) {
#pragma unroll
    for (int o = 32; o >= 1; o >>= 1) {
        unsigned lo = __shfl_xor((unsigned)v, o, 64), hi = __shfl_xor((unsigned)(v >> 32), o, 64);
        unsigned long long w = ((unsigned long long)hi << 32) | lo;
        v = w > v ? w : v;
    }
    return v;
}
__device__ __forceinline__ int tid_() { int t = threadIdx.x; asm volatile("" : "+v"(t)); return t; }
__device__ __forceinline__ int bid_() { int b = blockIdx.x; asm volatile("" : "+s"(b)); return b; }
__device__ __forceinline__ int nblk_() { int g = gridDim.x; asm volatile("" : "+s"(g)); return g; }
__device__ __forceinline__ int gwave() { return (bid_() * 512 + tid_()) >> 6; }
__device__ __forceinline__ int nwaves() { return nblk_() * 8; }

namespace pg8 {
#define PG8_LAS __attribute__((address_space(3)))
typedef unsigned short bf16_t;
typedef short bf16x8 __attribute__((ext_vector_type(8)));
typedef float f32x4 __attribute__((ext_vector_type(4)));
typedef unsigned u32x4 __attribute__((ext_vector_type(4)));
constexpr int BM = 256, BK = 64, HALF = 128, HTB = HALF * BK * 2  , STAGE_BYTES = 8 * HTB, NXCD = 8, WGM = 8;

__host__ __device__ __forceinline__ int lds_byte(int r, int c) { const int st = (r >> 4) * 2 + (c >> 5), rr = r & 15, cc = c & 31, ob = rr * 64 + cc * 2; return st * 1024 + (ob ^ (((ob >> 9) & 1) << 5)); }
__host__ __device__ __forceinline__ void stage_rc(int b, int& R, int& C) { const int st = b / 1024, sb = b % 1024, swz = sb ^ (((sb >> 9) & 1) << 5); R = (st >> 1) * 16 + swz / 64; C = (st & 1) * 32 + (swz % 64) / 2; }
__host__ __device__ __forceinline__ int perm32(int rho) { const int n = rho >> 4, i = rho & 15; return 8 * (i >> 2) + 4 * n + (i & 3); }

struct Unit { int pm, pn; };
struct Gemm { const bf16_t* A; const bf16_t* Bt; int M, N, K; };

struct StaticOrder {
    int nM, nN, nwg, G, c;
    __host__ __device__ void init(int M, int N, int G_, int c_) { nM = M / BM; nN = N / BM; nwg = nM * nN; G = G_; c = c_; }
    __host__ __device__ bool next(int i, Unit& u) const {
        const long L = (long)i * G + c; if (L >= nwg) return false;
        int wgid = (int)L; { const int q = nwg / NXCD, r = nwg % NXCD, xcd = wgid % NXCD, off = wgid / NXCD; wgid = (xcd < r ? xcd * (q + 1) : r * (q + 1) + (xcd - r) * q) + off; }
        const int nig = WGM * nN, gid = wgid / nig, fm = gid * WGM, gsz = (nM - fm) < WGM ? (nM - fm) : WGM;
        u.pm = fm + ((wgid % nig) % gsz); u.pn = (wgid % nig) / gsz; return true;
    }
    __device__ __forceinline__ void a_ready(const Unit&) const {}
    __device__ __forceinline__ void done(const Unit&) const {}
};

__device__ __forceinline__ unsigned cvt_pk_bf16(float lo, float hi) { unsigned r; asm volatile("v_cvt_pk_bf16_f32 %0, %1, %2" : "=v"(r) : "v"(lo), "v"(hi)); return r; }
struct EpiF32 {
    static constexpr bool PERM = false, AFTER_DRAIN = false;
    float* C; const float* R; int ldc;
    __device__ __forceinline__ void operator()(const f32x4 (&acc)[2][2][4][2], const Unit& u, int wr, int wc, int fr, int fq) const {
        const int row0 = u.pm * BM + wr * 64 + fr, col0 = u.pn * BM + wc * 32 + 4 * fq;
#pragma unroll
        for (int ai = 0; ai < 2; ++ai)
#pragma unroll
            for (int m = 0; m < 4; ++m) { const size_t off = (size_t)(row0 + ai * HALF + m * 16) * ldc + col0;
#pragma unroll
                for (int bj = 0; bj < 2; ++bj)
#pragma unroll
                    for (int n = 0; n < 2; ++n) { f32x4 v = acc[ai][bj][m][n]; if (R) v += *(const f32x4*)(R + off + bj * HALF + n * 16); *(f32x4*)(C + off + bj * HALF + n * 16) = v; } }
    }
};
struct EpiBf16 {
    static constexpr bool PERM = true, AFTER_DRAIN = false;
    bf16_t* O; int ldc;
    __device__ __forceinline__ void operator()(const f32x4 (&acc)[2][2][4][2], const Unit& u, int wr, int wc, int fr, int fq) const {
        const int row0 = u.pm * BM + wr * 64 + fr, col0 = u.pn * BM + wc * 32 + 8 * fq;
#pragma unroll
        for (int ai = 0; ai < 2; ++ai)
#pragma unroll
            for (int m = 0; m < 4; ++m) { bf16_t* rowp = O + (size_t)(row0 + ai * HALF + m * 16) * ldc + col0;
#pragma unroll
                for (int bj = 0; bj < 2; ++bj) { const f32x4 v0 = acc[ai][bj][m][0], v1 = acc[ai][bj][m][1];
                    u32x4 w; w.x = cvt_pk_bf16(v0[0], v0[1]); w.y = cvt_pk_bf16(v0[2], v0[3]); w.z = cvt_pk_bf16(v1[0], v1[1]); w.w = cvt_pk_bf16(v1[2], v1[3]);
                    *(u32x4*)(rowp + bj * HALF) = w; } }
    }
};

template <class Epi, class Sched, bool STAMP = false>
__device__ __forceinline__ void gemm_phase(PG8_LAS unsigned char* lds, const Gemm g, const Sched& S, const Epi& E, unsigned long long* stamps, const int tid) {
    const int wid = __builtin_amdgcn_readfirstlane(tid >> 6), lane = tid & 63, wr = wid >> 2, wc = wid & 3, fr = lane & 15, fq = lane >> 4;
    const int K = g.K, nt = K / BK;
    int ts_lo = 0, ts_hi = 0, nts = 0; const unsigned long long rt_entry = STAMP ? (unsigned long long)wall_clock64() : 0ull;
#define PG8_STAMP() do { if (STAMP && wid == 0 && nts < 64) { const unsigned long long _c = (unsigned long long)clock64(); \
        ts_lo = (lane == nts) ? (int)(unsigned)_c : ts_lo; ts_hi = (lane == nts) ? (int)(unsigned)(_c >> 32) : ts_hi; ++nts; } } while (0)
    PG8_STAMP();
    unsigned voffA[2], voffB[2];
#pragma unroll
    for (int i = 0; i < 2; ++i) { int R, C; stage_rc(tid * 16 + i * 8192, R, C); const int Rb = Epi::PERM ? ((R & ~31) + perm32(R & 31)) : R;
        voffA[i] = (unsigned)(R * K + C) * 2u; voffB[i] = (unsigned)(Rb * K + C) * 2u; }
    const size_t kstep = (size_t)(BK * 2);
    const size_t hstep = (size_t)HALF * K * 2;
    const size_t tstep = 2 * hstep;
    const unsigned ldsw = (unsigned)wid * 1024u;
    const int aoff = lds_byte(wr * 64 + fr, fq * 8), boff = lds_byte(wc * 32 + fr, fq * 8);
#define PG8_SA(b, h) (((b) * 2 + (h)) * HTB)
#define PG8_SB(b, h) ((4 + (b) * 2 + (h)) * HTB)
#define PG8_STAGE(bufoff, gbase, voff) do { _Pragma("unroll") for (int _i = 0; _i < 2; ++_i) \
        __builtin_amdgcn_global_load_lds((const unsigned*)((const char*)(gbase) + (voff)[_i]), (PG8_LAS unsigned*)(lds + (bufoff) + ldsw + _i * 8192), 16, 0, 0); } while (0)
#define PG8_LDA(dst, b, h) do { _Pragma("unroll") for (int m = 0; m < 4; ++m) _Pragma("unroll") for (int k = 0; k < 2; ++k) dst[m][k] = *(const PG8_LAS bf16x8*)(lds + PG8_SA(b, h) + aoff + m * 2048 + k * 1024); } while (0)
#define PG8_LDB(dst, b, h) do { _Pragma("unroll") for (int n = 0; n < 2; ++n) _Pragma("unroll") for (int k = 0; k < 2; ++k) dst[n][k] = *(const PG8_LAS bf16x8*)(lds + PG8_SB(b, h) + boff + n * 2048 + k * 1024); } while (0)
#define PG8_MMA(ai, bj, At, Bt) do { __builtin_amdgcn_s_setprio(1); _Pragma("unroll") for (int m = 0; m < 4; ++m) _Pragma("unroll") for (int n = 0; n < 2; ++n) _Pragma("unroll") for (int k = 0; k < 2; ++k) \
        acc[ai][bj][m][n] = __builtin_amdgcn_mfma_f32_16x16x32_bf16(Bt[n][k], At[m][k], acc[ai][bj][m][n], 0, 0, 0); __builtin_amdgcn_s_setprio(0); } while (0)
#define PG8_WAIT_V(n) asm volatile("s_waitcnt vmcnt(" #n ")" ::: "memory")
#define PG8_WAIT_L(n) asm volatile("s_waitcnt lgkmcnt(" #n ")" ::: "memory")
#define PG8_BAR __builtin_amdgcn_s_barrier()
#define PG8_SCHED __builtin_amdgcn_sched_barrier(0)
    Unit cur, nxt; int ui = 0;
    if (!S.next(0, cur)) return;
    f32x4 acc[2][2][4][2];
#pragma unroll
    for (int a = 0; a < 2; ++a)
#pragma unroll
        for (int b = 0; b < 2; ++b)
#pragma unroll
            for (int m = 0; m < 4; ++m)
#pragma unroll
                for (int n = 0; n < 2; ++n) acc[a][b][m][n] = (f32x4){0.f, 0.f, 0.f, 0.f};
    bf16x8 At[4][2], B0[2][2], B1[2][2];
    const char* cA = (const char*)g.A + (size_t)cur.pm * tstep; const char* cB = (const char*)g.Bt + (size_t)cur.pn * tstep;
    S.a_ready(cur);
    PG8_STAGE(PG8_SB(0, 0), cB, voffB); PG8_STAGE(PG8_SA(0, 0), cA, voffA); PG8_STAGE(PG8_SB(0, 1), cB + hstep, voffB); PG8_STAGE(PG8_SA(0, 1), cA + hstep, voffA);
    if (wr == 1) PG8_BAR;
    PG8_WAIT_V(4); PG8_BAR;
    PG8_STAGE(PG8_SB(1, 0), cB + kstep, voffB); PG8_STAGE(PG8_SA(1, 0), cA + kstep, voffA); PG8_STAGE(PG8_SB(1, 1), cB + hstep + kstep, voffB);
    PG8_WAIT_V(6); PG8_BAR;
    PG8_STAMP();
    for (;;) {
        const bool has_next = S.next(ui + 1, nxt);
        const char* nA = has_next ? (const char*)g.A + (size_t)nxt.pm * tstep : cA; const char* nB = has_next ? (const char*)g.Bt + (size_t)nxt.pn * tstep : cB;
        for (int t = 0; t < nt; t += 2) {
            const bool last = (t == nt - 2);
            const char* a1 = cA + (size_t)(t + 1) * kstep;
            const char* a2 = last ? nA : cA + (size_t)(t + 2) * kstep; const char* b2 = last ? nB : cB + (size_t)(t + 2) * kstep;
            const char* a3 = a2 + kstep; const char* b3 = b2 + kstep;
            if (last && has_next) S.a_ready(nxt);
            PG8_LDB(B0, 0, 0); PG8_SCHED; PG8_LDA(At, 0, 0); PG8_STAGE(PG8_SA(1, 1), a1 + hstep, voffA);
            PG8_WAIT_L(8); PG8_BAR; PG8_WAIT_L(0); PG8_MMA(0, 0, At, B0); PG8_BAR; PG8_SCHED;
            PG8_LDB(B1, 0, 1); PG8_STAGE(PG8_SB(0, 0), b2, voffB);
            PG8_BAR; PG8_WAIT_L(0); PG8_MMA(0, 1, At, B1); PG8_BAR;
            PG8_LDA(At, 0, 1); PG8_STAGE(PG8_SA(0, 0), a2, voffA);
            PG8_BAR; PG8_WAIT_L(0); PG8_MMA(1, 0, At, B0); PG8_BAR; PG8_SCHED;
            PG8_STAGE(PG8_SB(0, 1), b2 + hstep, voffB);
            PG8_WAIT_V(6); PG8_BAR; PG8_MMA(1, 1, At, B1); PG8_BAR;
            PG8_LDB(B0, 1, 0); PG8_SCHED; PG8_LDA(At, 1, 0); PG8_STAGE(PG8_SA(0, 1), a2 + hstep, voffA);
            PG8_WAIT_L(8); PG8_BAR; PG8_WAIT_L(0); PG8_MMA(0, 0, At, B0); PG8_BAR; PG8_SCHED;
            PG8_LDB(B1, 1, 1); PG8_STAGE(PG8_SB(1, 0), b3, voffB);
            PG8_BAR; PG8_WAIT_L(0); PG8_MMA(0, 1, At, B1); PG8_BAR;
            PG8_LDA(At, 1, 1); PG8_STAGE(PG8_SA(1, 0), a3, voffA);
            PG8_BAR; PG8_WAIT_L(0); PG8_MMA(1, 0, At, B0); PG8_BAR; PG8_SCHED;
            PG8_STAGE(PG8_SB(1, 1), b3 + hstep, voffB);
            PG8_WAIT_V(6); PG8_BAR; PG8_MMA(1, 1, At, B1); PG8_BAR;
        }
        PG8_STAMP();
        if constexpr (!Epi::AFTER_DRAIN) { E(acc, cur, wr, wc, fr, fq); S.done(cur); }
        PG8_STAMP();
        if (!has_next) break;
#pragma unroll
        for (int a = 0; a < 2; ++a)
#pragma unroll
            for (int b = 0; b < 2; ++b)
#pragma unroll
                for (int m = 0; m < 4; ++m)
#pragma unroll
                    for (int n = 0; n < 2; ++n) acc[a][b][m][n] = (f32x4){0.f, 0.f, 0.f, 0.f};
        cur = nxt; cA = nA; cB = nB; ++ui;
    }
    PG8_WAIT_V(0);
    if (wr == 0) PG8_BAR;
    PG8_BAR;
    if constexpr (Epi::AFTER_DRAIN) { E.fused(acc, cur, wr, wc, fr, fq, lds, wid, lane); S.done(cur); }
    PG8_STAMP();
    if (STAMP && wid == 0) { stamps[lane] = lane < nts ? (((unsigned long long)(unsigned)ts_hi << 32) | (unsigned)ts_lo) : 0ull;
        if (lane == 62) stamps[62] = rt_entry; if (lane == 63) stamps[63] = (unsigned long long)wall_clock64(); }
#undef PG8_STAMP
#undef PG8_SA
#undef PG8_SB
#undef PG8_STAGE
#undef PG8_LDA
#undef PG8_LDB
#undef PG8_MMA
#undef PG8_WAIT_V
#undef PG8_WAIT_L
#undef PG8_BAR
#undef PG8_SCHED
}
}

namespace pg8 {
struct PanelOrder {
    int pm, nN;
    __device__ void init(int pm_, int N) { pm = pm_; nN = N / BM; }
    __device__ bool next(int i, Unit& u) const { if (i >= nN) return false; u.pm = pm; u.pn = i; return true; }
    __device__ __forceinline__ void a_ready(const Unit&) const {}
    __device__ __forceinline__ void done(const Unit&) const {}
};
}
template <class Epi> __device__ __forceinline__ void ph_gemm_panel(const bf16_t* A, const bf16_t* Bt, int M, int N, int K, const Epi& E, int pm) {
    pg8::Gemm g; g.A = A; g.Bt = Bt; g.M = M; g.N = N; g.K = K;
    pg8::PanelOrder S; S.init(pm, N);
    pg8::gemm_phase<Epi, pg8::PanelOrder, false>((PG8_LAS unsigned char*)dynsmem, g, S, E, nullptr, tid_());
}
template <class Epi> __device__ __forceinline__ void ph_gemm(const bf16_t* A, const bf16_t* Bt, int M, int N, int K, const Epi& E, int crot = 0) {
    pg8::Gemm g; g.A = A; g.Bt = Bt; g.M = M; g.N = N; g.K = K;
    const int nb_ = nblk_();
    pg8::StaticOrder S; S.init(M, N, nb_, (bid_() + nb_ - crot) % nb_);
    pg8::gemm_phase<Epi, pg8::StaticOrder, false>((PG8_LAS unsigned char*)dynsmem, g, S, E, nullptr, tid_());
}

__device__ __forceinline__ int pcol_to_orig(int c) {
    if (c < 768) return c;
    if (c < 1536) return c - 768 + 772;
    if (c < 1792) return c - 1536 + 1548;
    if (c < 1920) return c - 1792 + 1804;
    if (c < 2048) return c - 1920 + 1932;
    if (c < 2304) return c - 2048 + 2060;
    if (c < 2560) return c - 2304 + 2332;
    if (c < 2816) return c - 2560 + 2588;
    if (c < 2880) return c - 2816 + 2844;
    if (c < 2944) return c - 2880 + 2908;
    if (c < 3200) return c - 2944 + 2972;
    if (c < 3232) return c - 3200 + 3228;
    if (c < 3248) return c - 3232 + 2316;
    if (c < 3256) return c - 3248 + 3260;
    if (c < 3260) return c - 3256 + 768;
    if (c < 3264) return c - 3260 + 1540;
    if (c < 3268) return c - 3264 + 1544;
    return -1;
}
__device__ __forceinline__ void wtrans_job(const float* W, int K, int ldw, bf16_t* Wt, int Npad, bool mapped, float* tile) {
    const int tid = tid_();
    const int tn = Npad / 64, tk = K / 64;
    for (int t = bid_(); t < tn * tk; t += nblk_()) {
        const int n0 = (t / tk) * 64, k0 = (t % tk) * 64;
        __syncthreads();
        for (int idx = tid; idx < 4096; idx += 512) {
            const int kk = idx >> 6, nn = idx & 63;
            const int col = mapped ? pcol_to_orig(n0 + nn) : (n0 + nn);
            tile[kk * 65 + nn] = col >= 0 ? W[(size_t)(k0 + kk) * ldw + col] : 0.f;
        }
        __syncthreads();
        for (int idx = tid; idx < 4096; idx += 512) {
            const int nn = idx >> 6, kk = idx & 63;
            Wt[(size_t)(n0 + nn) * K + k0 + kk] = f2bf(tile[kk * 65 + nn]);
        }
    }
}
__device__ __forceinline__ void ph_weight_prep(const Ctx& p, float* sm) {
#pragma unroll 1
    for (int j = 0; j < 7 * DEPTH; ++j) {
        const int l = j / 7, w = j % 7;
        const float* W; int K, ldw, Npad; bf16_t* Wt; bool mapped = false;
        if (w == 0) { W = pin_(3) + (size_t)l * DM * 3268; K = DM; ldw = 3268; Npad = LDP; Wt = (bf16_t*)(pws_() + WT_IN) + (size_t)l * LDP * DM; mapped = true; }
        else if (w == 1) { W = pin_(20) + (size_t)l * DM * DM; K = DM; ldw = DM; Npad = DM; Wt = (bf16_t*)(pws_() + WT_OUT) + (size_t)l * DM * DM; }
        else if (w == 2) { W = pin_(23) + (size_t)l * DM * 256; K = DM; ldw = 256; Npad = 256; Wt = (bf16_t*)(pws_() + WT_XQ) + (size_t)l * 256 * DM; }
        else if (w == 3) { W = pin_(24) + (size_t)l * DM * 256; K = DM; ldw = 256; Npad = 256; Wt = (bf16_t*)(pws_() + WT_XK) + (size_t)l * 256 * DM; }
        else if (w == 4) { W = pin_(25) + (size_t)l * DM * 256; K = DM; ldw = 256; Npad = 256; Wt = (bf16_t*)(pws_() + WT_XV) + (size_t)l * 256 * DM; }
        else if (w == 5) { W = pin_(26) + (size_t)l * 256 * DM; K = 256; ldw = DM; Npad = DM; Wt = (bf16_t*)(pws_() + WT_XO) + (size_t)l * DM * 256; }
        else { W = pin_(30) + (size_t)l * DM * DM; K = DM; ldw = DM; Npad = DM; Wt = (bf16_t*)(pws_() + WT_PQ) + (size_t)l * DM * DM; }
        wtrans_job(W, K, ldw, Wt, Npad, mapped, sm);
    }
}

#define H8_SCALE 16.f
__device__ __forceinline__ unsigned pack4_fp8(float4 a, float sc);
__device__ __forceinline__ void ph_rmsnorm(const float* __restrict__ x, const float* __restrict__ g, bf16_t* __restrict__ out, int rows, int row0 = 0, int w0 = -1, int wstep = 0, unsigned char* out8 = nullptr) {
    const int lane = tid_() & 63;
    if (w0 < 0) { w0 = gwave(); wstep = nwaves(); }
    for (int r = row0 + w0; r < row0 + rows; r += wstep) {
        const float4* xr = (const float4*)(x + (size_t)r * DM);
        float4 v[4]; float ss = 0.f;
#pragma unroll
        for (int i = 0; i < 4; ++i) { v[i] = xr[lane + 64 * i]; ss += v[i].x * v[i].x + v[i].y * v[i].y + v[i].z * v[i].z + v[i].w * v[i].w; }
        ss = wave_sum(ss);
        const float rs = rsqrtf(ss * (1.f / DM) + EPS);
#pragma unroll
        for (int i = 0; i < 4; ++i) {
            const float4 gg = ((const float4*)g)[lane + 64 * i];
            ushort4 o; o.x = f2bf(v[i].x * rs * gg.x); o.y = f2bf(v[i].y * rs * gg.y); o.z = f2bf(v[i].z * rs * gg.z); o.w = f2bf(v[i].w * rs * gg.w);
            *(ushort4*)(out + (size_t)r * DM + (size_t)(lane + 64 * i) * 4) = o;
            if (out8) *(unsigned*)(out8 + (size_t)r * DM + (size_t)(lane + 64 * i) * 4) = pack4_fp8(make_float4(v[i].x * rs * gg.x, v[i].y * rs * gg.y, v[i].z * rs * gg.z, v[i].w * rs * gg.w), H8_SCALE);
        }
    }
}

template <int OUTMODE>
__device__ __forceinline__ void ph_sgemm(const bf16_t* __restrict__ A, int lda, const float* __restrict__ B, int ldb, void* Cv, int ldc, const float* R, int ldr,
                         int M, int N, int K, float* smem) {
    float* As = smem;
    float* Bs = smem + 16 * 132;
    const int tid = tid_(), tx = tid & 31, ty = tid >> 5;
    const int ntn = N / 128, ntiles = (M / 128) * ntn;
    for (int tile = bid_(); tile < ntiles; tile += nblk_()) {
        const int tm = tile / ntn, tn = tile % ntn;
        float acc[8][4];
#pragma unroll
        for (int i = 0; i < 8; ++i)
#pragma unroll
            for (int j = 0; j < 4; ++j) acc[i][j] = 0.f;
        const int arow = tid >> 2, akq = (tid & 3) * 4;
        const int bk = tid >> 5, bn = (tid & 31) * 4;
        for (int k0 = 0; k0 < K; k0 += 16) {
            const ushort4 av = *(const ushort4*)(A + (size_t)(tm * 128 + arow) * lda + k0 + akq);
            const float4 bv = *(const float4*)(B + (size_t)(k0 + bk) * ldb + tn * 128 + bn);
            __syncthreads();
            As[(akq + 0) * 132 + arow] = bf2f(av.x); As[(akq + 1) * 132 + arow] = bf2f(av.y);
            As[(akq + 2) * 132 + arow] = bf2f(av.z); As[(akq + 3) * 132 + arow] = bf2f(av.w);
            *(float4*)(Bs + bk * 132 + bn) = bv;
            __syncthreads();
#pragma unroll
            for (int k = 0; k < 16; ++k) {
                const float4 a0 = *(const float4*)(As + k * 132 + ty * 8), a1 = *(const float4*)(As + k * 132 + ty * 8 + 4);
                const float4 b = *(const float4*)(Bs + k * 132 + tx * 4);
                const float a[8] = {a0.x, a0.y, a0.z, a0.w, a1.x, a1.y, a1.z, a1.w};
#pragma unroll
                for (int i = 0; i < 8; ++i) { acc[i][0] += a[i] * b.x; acc[i][1] += a[i] * b.y; acc[i][2] += a[i] * b.z; acc[i][3] += a[i] * b.w; }
            }
        }
#pragma unroll
        for (int i = 0; i < 8; ++i) {
            const size_t row = (size_t)tm * 128 + ty * 8 + i; const int col = tn * 128 + tx * 4;
            if (OUTMODE == 0) {
                ushort4 o; o.x = f2bf(acc[i][0]); o.y = f2bf(acc[i][1]); o.z = f2bf(acc[i][2]); o.w = f2bf(acc[i][3]);
                *(ushort4*)((bf16_t*)Cv + row * ldc + col) = o;
            } else if (OUTMODE == 1) {
                *(float4*)((float*)Cv + row * ldc + col) = make_float4(acc[i][0], acc[i][1], acc[i][2], acc[i][3]);
            } else {
                const float4 r = *(const float4*)(R + row * ldr + col);
                *(float4*)((float*)Cv + row * ldc + col) = make_float4(r.x + acc[i][0], r.y + acc[i][1], r.z + acc[i][2], r.w + acc[i][3]);
            }
        }
    }
}

#define WS_HS WS_H
#define WS_VG WS_YPRE
#define WS_DEC (WS_YPRE + (size_t)MTOK * 256 * 2)

__device__ __forceinline__ float quad_sum(float v) {
    v += __int_as_float(__builtin_amdgcn_mov_dpp(__float_as_int(v), 0xB1, 0xF, 0xF, true));
    v += __int_as_float(__builtin_amdgcn_mov_dpp(__float_as_int(v), 0x4E, 0xF, 0xF, true));
    return v;
}
__device__ __forceinline__ float bflo(unsigned w) { return __uint_as_float(w << 16); }
__device__ __forceinline__ float bfhi(unsigned w) { return __uint_as_float(w & 0xffff0000u); }

__device__ __forceinline__ float oct_sum(float v) {
    v += __int_as_float(__builtin_amdgcn_mov_dpp(__float_as_int(v), 0xB1, 0xF, 0xF, true));
    v += __int_as_float(__builtin_amdgcn_mov_dpp(__float_as_int(v), 0x4E, 0xF, 0xF, true));
    v += __int_as_float(__builtin_amdgcn_mov_dpp(__float_as_int(v), 0x141, 0xF, 0xF, true));
    return v;
}
__device__ __forceinline__ void unpack8(const uint4 r, float (&o)[8]) {
    o[0] = bflo(r.x); o[1] = bfhi(r.x); o[2] = bflo(r.y); o[3] = bfhi(r.y); o[4] = bflo(r.z); o[5] = bfhi(r.z); o[6] = bflo(r.w); o[7] = bfhi(r.w);
}
__device__ __forceinline__ uint4 pack8(const float (&v)[8]) {
    uint4 o; o.x = pk_bf16(v[0], v[1]); o.y = pk_bf16(v[2], v[3]); o.z = pk_bf16(v[4], v[5]); o.w = pk_bf16(v[6], v[7]); return o;
}
__device__ __forceinline__ void load8f(const float* p, float (&o)[8]) {
    const float4 a = *(const float4*)p, b = *(const float4*)(p + 4);
    o[0] = a.x; o[1] = a.y; o[2] = a.z; o[3] = a.w; o[4] = b.x; o[5] = b.y; o[6] = b.z; o[7] = b.w;
}
__device__ __forceinline__ void conv8(const bf16_t* P, size_t tok, int t, int pcol, const float* w, int ldw, int cc, float (&acc)[8]) {
#pragma unroll
    for (int j = 0; j < 4; ++j) {
        if (t - 3 + j >= 0) {
            float xv[8], wv[8];
            unpack8(*(const uint4*)(P + (tok - (size_t)(3 - j)) * LDP + pcol), xv);
            load8f(w + j * ldw + cc, wv);
#pragma unroll
            for (int i = 0; i < 8; ++i) acc[i] = __builtin_fmaf(wv[i], xv[i], acc[i]);
        }
    }
}
__device__ __forceinline__ void conv8r(const uint4 (&xt)[4], int t, const float* w, int ldw, int cc, float (&acc)[8]) {
#pragma unroll
    for (int j = 0; j < 4; ++j) {
        float xv[8], wv[8];
        unpack8(xt[j], xv);
        load8f(w + j * ldw + cc, wv);
        const float m = (t - 3 + j >= 0) ? 1.f : 0.f;
#pragma unroll
        for (int i = 0; i < 8; ++i) acc[i] = __builtin_fmaf(wv[i] * m, xv[i], acc[i]);
    }
}
__device__ __forceinline__ void ph_scan_prep(const Ctx& p, int l) {
    const bf16_t* P = (const bf16_t*)(pws_() + WS_P);
    bf16_t* HS = (bf16_t*)(pws_() + WS_HS);
    bf16_t* VG = (bf16_t*)(pws_() + WS_VG);
    float* DEC = (float*)(pws_() + WS_DEC);
    float* SC = (float*)(pws_() + WS_SC);
    const float* scw = pin_(4) + (size_t)l * 4 * 512;
    const float* scb = pin_(5) + (size_t)l * 512;
    const float* gcw = pin_(10) + (size_t)l * 4 * 768;
    const float* wg = pin_(14) + (size_t)l * 16 * 128;
    const float* bg = pin_(15) + (size_t)l * 128;
    const int lane = tid_() & 63;
    const int hsc = lane & 3, wsc = (lane >> 2) & 3;
    const float k_dtb = pin_(6)[l * 4 + hsc], k_alog = __expf(pin_(7)[l * 4 + hsc]), k_galog = __expf(pin_(11)[l * 4 + hsc]), k_gdtb = pin_(12)[l * 4 + hsc];
    const int sccol = wsc < 2 ? PC_DT + hsc : (wsc == 2 ? PC_GA + hsc : PC_GB + hsc);
    for (int tok = gwave(); tok < MTOK; tok += nwaves()) {
        const int t = tok % SEQ;
        const size_t row = (size_t)tok * LDP;
        uint4 xa[4], xq[4], xv4[4];
#pragma unroll
        for (int j = 0; j < 4; ++j) {
            const size_t rj = (t - 3 + j >= 0) ? row - (size_t)(3 - j) * LDP : row;
            xa[j] = *(const uint4*)(P + rj + PC_XBC + 8 * lane);
            xq[j] = *(const uint4*)(P + rj + PC_GQKV + 8 * lane);
            xv4[j] = *(const uint4*)(P + rj + PC_GQKV + 512 + 8 * (lane & 31));
        }
        const uint4 gl0 = *(const uint4*)(P + row + PC_GLR), gl1 = *(const uint4*)(P + row + PC_GLR + 8);
        const float scraw = bf2f(P[row + sccol]);
        {
            float acc[8];
            load8f(scb + 8 * lane, acc);
            conv8r(xa, t, scw, 512, 8 * lane, acc);
#pragma unroll
            for (int i = 0; i < 8; ++i) acc[i] = silu_f(acc[i]);
            *(uint4*)(HS + (size_t)tok * 1024 + 8 * lane) = pack8(acc);
        }
        {
            float acc[8];
#pragma unroll
            for (int i = 0; i < 8; ++i) acc[i] = 0.f;
            conv8r(xq, t, gcw, 768, 8 * lane, acc);
            float ss = 0.f;
#pragma unroll
            for (int i = 0; i < 8; ++i) { acc[i] = silu_f(acc[i]); ss += acc[i] * acc[i]; }
            ss = oct_sum(ss);
            const float sc = rsqrtf(ss + EPS) * (lane < 32 ? 0.125f : 1.f);
#pragma unroll
            for (int i = 0; i < 8; ++i) acc[i] *= sc;
            *(uint4*)(HS + (size_t)tok * 1024 + 512 + 8 * lane) = pack8(acc);
        }
        {
            float acc[8];
#pragma unroll
            for (int i = 0; i < 8; ++i) acc[i] = 0.f;
            conv8r(xv4, t, gcw, 768, 512 + 8 * (lane & 31), acc);
#pragma unroll
            for (int i = 0; i < 8; ++i) acc[i] = silu_f(acc[i]);
            if (lane < 32) *(uint4*)(VG + (size_t)tok * 256 + 8 * lane) = pack8(acc);
        }
        {
            float v;
            if (wsc < 2) { const float dt = softplus_f(scraw + k_dtb); v = wsc == 0 ? dt : __expf(-dt * k_alog); }
            else if (wsc == 2) v = __expf(-k_galog * softplus_f(scraw + k_gdtb));
            else v = sigmoid_f(scraw);
            if (lane < 16) SC[(size_t)tok * 16 + lane] = v;
        }
        {
            float gl[16];
            { float a8[8], b8[8]; unpack8(gl0, a8); unpack8(gl1, b8);
#pragma unroll
              for (int i = 0; i < 8; ++i) { gl[i] = a8[i]; gl[8 + i] = b8[i]; } }
#pragma unroll
            for (int i = 0; i < 2; ++i) {
                const int c = lane + 64 * i;
                float acc = bg[c];
#pragma unroll
                for (int r = 0; r < 16; ++r) acc = __builtin_fmaf(gl[r], wg[r * 128 + c], acc);
                DEC[(size_t)tok * 128 + c] = __expf(logsigmoid_f(acc) * (1.f / 16.f));
            }
        }
    }
}

#define SCAN_LDS_WAVE 4608
typedef float f2_t __attribute__((ext_vector_type(2)));
__device__ __forceinline__ f2_t mk2(float a, float b) { f2_t r; r.x = a; r.y = b; return r; }
__device__ __forceinline__ void st8f(char* dst, const uint4 v) {
    *(float4*)dst = make_float4(bflo(v.x), bfhi(v.x), bflo(v.y), bfhi(v.y));
    *(float4*)(dst + 16) = make_float4(bflo(v.z), bfhi(v.z), bflo(v.w), bfhi(v.w));
}
__device__ __forceinline__ void ph_scans(const Ctx& p, int l, float* smem) {
    const bf16_t* P = (const bf16_t*)(pws_() + WS_P);
    const bf16_t* HS = (const bf16_t*)(pws_() + WS_HS);
    const bf16_t* VG = (const bf16_t*)(pws_() + WS_VG);
    const float* DEC = (const float*)(pws_() + WS_DEC);
    const float* SC = (const float*)(pws_() + WS_SC);
    bf16_t* Y = (bf16_t*)(pws_() + WS_Y);
    const int tid = tid_(), lane = tid & 63, wave = tid >> 6;
    if (nblk_() != 256) return;
    const int role = wave < 2 ? 0 : (wave < 6 ? 1 : 2);
    const int idx = (role == 0 ? wave : (role == 1 ? wave - 2 : wave - 6)) * 256 + bid_();
    const int bh = role == 1 ? (idx >> 3) : (idx >> 2), b = bh >> 2, h = bh & 3;
    const int colbase = role == 1 ? (idx & 7) * 8 : (idx & 3) * 16;
    const int cl = role == 1 ? (lane >> 3) : (lane >> 2);
    const int col = colbase + cl;
    const int sq = role == 1 ? (lane & 7) : (lane & 3);
    const size_t tb = (size_t)b * SEQ;
    bf16_t* dummy = (bf16_t*)(pws_() + WS_DUMMY) + (tid & 511) * 8;
    char* lw = (char*)smem + wave * SCAN_LDS_WAVE;
    char* lrow = lw;
    char* lcol = lw + 4096;
    float* lsc = (float*)(lw + 4352);
    const int fs = lane >> 3, fp = lane & 7;
    if (role == 0) {
        const int g = h >> 1;
        const float Dh = pin_(8)[l * 4 + h];
        uint4 f0, f1; unsigned fc = 0u; float fsc = 0.f;
        f2_t st[8];
#pragma unroll
        for (int i = 0; i < 8; ++i) st[i] = mk2(0.f, 0.f);
        auto fetch = [&](int t0) {
            const size_t tok = tb + t0 + fs;
            const bf16_t* src = HS + tok * 1024 + (fp < 4 ? 256 + g * 64 + fp * 16 : 384 + g * 64 + (fp - 4) * 16);
            f0 = *(const uint4*)src; f1 = *(const uint4*)(src + 8);
            fc = *(const unsigned*)(HS + tok * 1024 + h * 64 + colbase + fp * 2);
            if (lane < 16) fsc = SC[(tb + t0 + (lane >> 1)) * 16 + (lane & 1) * 4 + h];
        };
        fetch(0);
        for (int t0 = 0; t0 < SEQ; t0 += 8) {
            st8f(lrow + fs * 512 + fp * 64, f0); st8f(lrow + fs * 512 + fp * 64 + 32, f1);
            *(unsigned*)(lcol + fs * 32 + fp * 4) = fc;
            if (lane < 16) lsc[lane] = fsc;
            if (t0 + 8 < SEQ) fetch(t0 + 8);
#pragma unroll
            for (int i = 0; i < 8; ++i) {
                const char* rb = lrow + i * 512 + sq * 64;
                const float4 b0 = *(const float4*)rb, b1 = *(const float4*)(rb + 16), b2 = *(const float4*)(rb + 32), b3 = *(const float4*)(rb + 48);
                const float4 c0 = *(const float4*)(rb + 256), c1 = *(const float4*)(rb + 272), c2 = *(const float4*)(rb + 288), c3 = *(const float4*)(rb + 304);
                const float xv = bf2f(*(const bf16_t*)(lcol + i * 32 + cl * 2));
                const float2 sc2 = *(const float2*)(lsc + i * 2);
                const float xdt = xv * sc2.x;
                const f2_t xd2 = mk2(xdt, xdt), dA2 = mk2(sc2.y, sc2.y);
                const f2_t bb[8] = {mk2(b0.x, b0.y), mk2(b0.z, b0.w), mk2(b1.x, b1.y), mk2(b1.z, b1.w), mk2(b2.x, b2.y), mk2(b2.z, b2.w), mk2(b3.x, b3.y), mk2(b3.z, b3.w)};
                const f2_t cc[8] = {mk2(c0.x, c0.y), mk2(c0.z, c0.w), mk2(c1.x, c1.y), mk2(c1.z, c1.w), mk2(c2.x, c2.y), mk2(c2.z, c2.w), mk2(c3.x, c3.y), mk2(c3.z, c3.w)};
                f2_t ya = mk2(0.f, 0.f), yb = mk2(0.f, 0.f);
#pragma unroll
                for (int q = 0; q < 8; q += 2) {
                    st[q] = st[q] * dA2 + xd2 * bb[q]; st[q + 1] = st[q + 1] * dA2 + xd2 * bb[q + 1];
                    ya = cc[q] * st[q] + ya; yb = cc[q + 1] * st[q + 1] + yb;
                }
                const f2_t ys = ya + yb;
                const float y = quad_sum(ys.x + ys.y);
                *(sq == 0 ? Y + (tb + t0 + i) * DM + h * 64 + col : dummy + i) = f2bf(y + Dh * xv);
                if (i & 1) __builtin_amdgcn_sched_barrier(0);
            }
        }
    } else if (role == 1) {
        uint4 f0, f1; unsigned fc = 0u; float fsc = 0.f;
        f2_t S[4];
#pragma unroll
        for (int i = 0; i < 4; ++i) S[i] = mk2(0.f, 0.f);
        auto fetch = [&](int t0) {
            const size_t tok = tb + t0 + fs;
            const bf16_t* src = HS + tok * 1024 + (fp < 4 ? 512 + h * 64 + fp * 16 : 768 + h * 64 + (fp - 4) * 16);
            f0 = *(const uint4*)src; f1 = *(const uint4*)(src + 8);
            if (fp < 4) fc = *(const unsigned*)(VG + tok * 256 + h * 64 + colbase + fp * 2);
            if (lane < 16) fsc = SC[(tb + t0 + (lane >> 1)) * 16 + 8 + (lane & 1) * 4 + h];
        };
        fetch(0);
        for (int t0 = 0; t0 < SEQ; t0 += 8) {
            st8f(lrow + fs * 512 + fp * 64, f0); st8f(lrow + fs * 512 + fp * 64 + 32, f1);
            if (fp < 4) *(unsigned*)(lcol + fs * 32 + fp * 4) = fc;
            if (lane < 16) lsc[lane] = fsc;
            if (t0 + 8 < SEQ) fetch(t0 + 8);
#pragma unroll
            for (int i = 0; i < 8; ++i) {
                const char* rb = lrow + i * 512 + sq * 32;
                const float4 q0 = *(const float4*)rb, q1 = *(const float4*)(rb + 16);
                const float4 k0 = *(const float4*)(rb + 256), k1 = *(const float4*)(rb + 272);
                const float vv = bf2f(*(const bf16_t*)(lcol + i * 32 + cl * 2));
                const float2 sc2 = *(const float2*)(lsc + i * 2);
                const f2_t al2 = mk2(sc2.x, sc2.x);
                const f2_t kk[4] = {mk2(k0.x, k0.y), mk2(k0.z, k0.w), mk2(k1.x, k1.y), mk2(k1.z, k1.w)};
                const f2_t qq[4] = {mk2(q0.x, q0.y), mk2(q0.z, q0.w), mk2(q1.x, q1.y), mk2(q1.z, q1.w)};
                f2_t ra = mk2(0.f, 0.f), rb2 = mk2(0.f, 0.f);
#pragma unroll
                for (int q = 0; q < 4; q += 2) {
                    S[q] = S[q] * al2; S[q + 1] = S[q + 1] * al2;
                    ra = S[q] * kk[q] + ra; rb2 = S[q + 1] * kk[q + 1] + rb2;
                }
                const f2_t rs = ra + rb2;
                const float r = oct_sum(rs.x + rs.y);
                const float vn = sc2.y * (vv - r);
                const f2_t vn2 = mk2(vn, vn);
                f2_t oa2 = mk2(0.f, 0.f), ob2 = mk2(0.f, 0.f);
#pragma unroll
                for (int q = 0; q < 4; q += 2) {
                    S[q] = kk[q] * vn2 + S[q]; S[q + 1] = kk[q + 1] * vn2 + S[q + 1];
                    oa2 = S[q] * qq[q] + oa2; ob2 = S[q + 1] * qq[q + 1] + ob2;
                }
                const f2_t os = oa2 + ob2;
                const float ov = oct_sum(os.x + os.y);
                *(sq == 0 ? Y + (tb + t0 + i) * DM + 256 + h * 64 + col : dummy + i) = f2bf(ov);
                if (i & 1) __builtin_amdgcn_sched_barrier(0);
            }
        }
    } else {
        uint4 f0, f1; unsigned fc = 0u;
        f2_t S[4];
#pragma unroll
        for (int i = 0; i < 4; ++i) S[i] = mk2(0.f, 0.f);
        auto fetch = [&](int t0) {
            const size_t tok = tb + t0 + fs;
            if (fp < 4) { const float* src = DEC + tok * 128 + h * 32 + fp * 8; f0 = *(const uint4*)src; f1 = *(const uint4*)(src + 4); }
            else { const bf16_t* src = P + tok * LDP + (fp < 6 ? PC_LK + h * 32 + (fp - 4) * 16 : PC_LQ + h * 32 + (fp - 6) * 16); f0 = *(const uint4*)src; f1 = *(const uint4*)(src + 8); }
            fc = *(const unsigned*)(P + tok * LDP + PC_LV + h * 64 + colbase + fp * 2);
        };
        fetch(0);
        for (int t0 = 0; t0 < SEQ; t0 += 8) {
            if (fp < 4) { *(uint4*)(lrow + fs * 512 + fp * 32) = f0; *(uint4*)(lrow + fs * 512 + fp * 32 + 16) = f1; }
            else { st8f(lrow + fs * 512 + 128 + (fp - 4) * 64, f0); st8f(lrow + fs * 512 + 128 + (fp - 4) * 64 + 32, f1); }
            *(unsigned*)(lcol + fs * 32 + fp * 4) = fc;
            if (t0 + 8 < SEQ) fetch(t0 + 8);
#pragma unroll
            for (int i = 0; i < 8; ++i) {
                const char* rb = lrow + i * 512 + sq * 32;
                const float4 d0 = *(const float4*)rb, d1 = *(const float4*)(rb + 16);
                const float4 k0 = *(const float4*)(rb + 128), k1 = *(const float4*)(rb + 144);
                const float4 q0 = *(const float4*)(rb + 256), q1 = *(const float4*)(rb + 272);
                const float vv = bf2f(*(const bf16_t*)(lcol + i * 32 + cl * 2));
                const f2_t v2 = mk2(vv, vv);
                const f2_t dd[4] = {mk2(d0.x, d0.y), mk2(d0.z, d0.w), mk2(d1.x, d1.y), mk2(d1.z, d1.w)};
                const f2_t kk[4] = {mk2(k0.x, k0.y), mk2(k0.z, k0.w), mk2(k1.x, k1.y), mk2(k1.z, k1.w)};
                const f2_t qq[4] = {mk2(q0.x, q0.y), mk2(q0.z, q0.w), mk2(q1.x, q1.y), mk2(q1.z, q1.w)};
                f2_t oa2 = mk2(0.f, 0.f), ob2 = mk2(0.f, 0.f);
#pragma unroll
                for (int q = 0; q < 4; q += 2) {
                    S[q] = dd[q] * S[q] + kk[q] * v2; S[q + 1] = dd[q + 1] * S[q + 1] + kk[q + 1] * v2;
                    oa2 = S[q] * qq[q] + oa2; ob2 = S[q + 1] * qq[q + 1] + ob2;
                }
                const f2_t os = oa2 + ob2;
                const float ov = quad_sum(os.x + os.y);
                *(sq == 0 ? Y + (tb + t0 + i) * DM + 512 + h * 64 + col : dummy + i) = f2bf(ov * 0.17677669529663687f);
                if (i & 1) __builtin_amdgcn_sched_barrier(0);
            }
        }
    }
}

__device__ __forceinline__ void ph_mixer_finish(const Ctx& p, int l) {
    const bf16_t* P = (const bf16_t*)(pws_() + WS_P);
    bf16_t* Y = (bf16_t*)(pws_() + WS_Y);
    const float* sn = pin_(9) + (size_t)l * 256;
    const float* gn = pin_(13) + (size_t)l * 64;
    const float* ln = pin_(16) + (size_t)l * 64;
    const int lane = tid_() & 63;
    for (int tok = gwave(); tok < MTOK; tok += nwaves()) {
        const size_t row = (size_t)tok * LDP;
        {
            float v[8], gt[8], gw[8];
            unpack8(*(const uint4*)(Y + (size_t)tok * DM + 8 * lane), v);
            unpack8(*(const uint4*)(P + row + (lane < 32 ? PC_Z + 8 * lane : PC_GG + 8 * (lane - 32))), gt);
            load8f(lane < 32 ? sn + 8 * lane : gn + 8 * (lane & 7), gw);
            float ss = 0.f;
            if (lane < 32) {
#pragma unroll
                for (int i = 0; i < 8; ++i) { v[i] *= silu_f(gt[i]); ss += v[i] * v[i]; }
            } else {
#pragma unroll
                for (int i = 0; i < 8; ++i) ss += v[i] * v[i];
            }
            const float s8 = oct_sum(ss);
            float s32 = s8 + __int_as_float(__builtin_amdgcn_mov_dpp(__float_as_int(s8), 0x140, 0xF, 0xF, true));
            s32 += __shfl_xor(s32, 16, 64);
            const float rs = lane < 32 ? rsqrtf(s32 * (1.f / 256.f) + EPS) : rsqrtf(s8 * (1.f / 64.f) + EPS);
            float o[8];
#pragma unroll
            for (int i = 0; i < 8; ++i) o[i] = lane < 32 ? v[i] * rs * gw[i] : v[i] * rs * gw[i] * silu_f(gt[i]);
            *(uint4*)(Y + (size_t)tok * DM + 8 * lane) = pack8(o);
        }
        if (lane < 32) {
            float v[8], gt[8], gw[8];
            unpack8(*(const uint4*)(Y + (size_t)tok * DM + 512 + 8 * lane), v);
            unpack8(*(const uint4*)(P + row + PC_LR + 8 * lane), gt);
            load8f(ln + 8 * (lane & 7), gw);
            float ss = 0.f;
#pragma unroll
            for (int i = 0; i < 8; ++i) ss += v[i] * v[i];
            const float rs = rsqrtf(oct_sum(ss) * (1.f / 64.f) + EPS);
            float o[8];
#pragma unroll
            for (int i = 0; i < 8; ++i) o[i] = v[i] * rs * gw[i] * silu_f(gt[i]);
            *(uint4*)(Y + (size_t)tok * DM + 512 + 8 * lane) = pack8(o);
        }
    }
}

typedef short bf16x8_t __attribute__((ext_vector_type(8)));
typedef float f32x4_t __attribute__((ext_vector_type(4)));
union BF8 { bf16x8_t v; uint4 u; unsigned w[4]; };


__device__ __forceinline__ void ph_dsa_prep(const Ctx& p, int l) {
    const bf16_t* P = (const bf16_t*)(pws_() + WS_P);
    bf16_t* qn = (bf16_t*)(pws_() + WS_QN);
    bf16_t* kn = (bf16_t*)(pws_() + WS_KN);
    bf16_t* ikn = (bf16_t*)(pws_() + WS_IKN);
    bf16_t* vt = (bf16_t*)(pws_() + WS_VT);
    const float* qg = pin_(17) + (size_t)l * 64;
    const float* kg = pin_(18) + (size_t)l * 64;
    const float* ig = pin_(19) + (size_t)l * 32;
    const int lane = tid_() & 63;
    const int pcol = lane < 40 ? PC_DQ + 8 * lane : PC_IK + 8 * (lane & 3);
    float gw[8];
    load8f(lane < 32 ? qg + 8 * (lane & 7) : (lane < 40 ? kg + 8 * (lane & 7) : ig + 8 * (lane & 3)), gw);
    for (int grp = gwave(); grp < MTOK / 8; grp += nwaves()) {
        const size_t tok0 = (size_t)grp * 8;
        const int b = (int)(tok0 / SEQ), t0 = (int)(tok0 % SEQ);
        unsigned short vv[8];
#pragma unroll
        for (int i = 0; i < 8; ++i) {
            const size_t row = (tok0 + i) * LDP;
            vv[i] = P[row + PC_DV + lane];
            if (lane < 44) {
                float v[8];
                unpack8(*(const uint4*)(P + row + pcol), v);
                float ss = 0.f;
#pragma unroll
                for (int q = 0; q < 8; ++q) ss += v[q] * v[q];
                const float s4 = ss + __int_as_float(__builtin_amdgcn_mov_dpp(__float_as_int(ss), 0xB1, 0xF, 0xF, true));
                const float s4b = s4 + __int_as_float(__builtin_amdgcn_mov_dpp(__float_as_int(s4), 0x4E, 0xF, 0xF, true));
                const float s8 = s4b + __int_as_float(__builtin_amdgcn_mov_dpp(__float_as_int(s4b), 0x141, 0xF, 0xF, true));
                const float rs = lane < 40 ? rsqrtf(s8 * (1.f / 64.f) + EPS) * (lane < 32 ? 0.125f : 1.f) : rsqrtf(s4b * (1.f / 32.f) + EPS);
                float o[8];
#pragma unroll
                for (int q = 0; q < 8; ++q) o[q] = v[q] * rs * gw[q];
                const uint4 pk = pack8(o);
                if (lane < 32) *(uint4*)(qn + (tok0 + i) * 256 + 8 * lane) = pk;
                else if (lane < 40) *(uint4*)(kn + (tok0 + i) * 64 + 8 * (lane - 32)) = pk;
                else *(uint4*)(ikn + (tok0 + i) * 32 + 8 * (lane - 40)) = pk;
            }
        }
        uint4 o; o.x = (unsigned)vv[0] | ((unsigned)vv[1] << 16); o.y = (unsigned)vv[2] | ((unsigned)vv[3] << 16);
        o.z = (unsigned)vv[4] | ((unsigned)vv[5] << 16); o.w = (unsigned)vv[6] | ((unsigned)vv[7] << 16);
        *(uint4*)(vt + ((size_t)b * 64 + lane) * SEQ + t0) = o;
    }
}

#define DSA_STRIDE 2052
__device__ __forceinline__ int wave_total_i(int v) {
    v += __builtin_amdgcn_update_dpp(0, v, 0x111, 0xf, 0xf, true);
    v += __builtin_amdgcn_update_dpp(0, v, 0x112, 0xf, 0xf, true);
    v += __builtin_amdgcn_update_dpp(0, v, 0x114, 0xf, 0xf, true);
    v += __builtin_amdgcn_update_dpp(0, v, 0x118, 0xf, 0xf, true);
    return __builtin_amdgcn_readlane(v, 15) + __builtin_amdgcn_readlane(v, 31) + __builtin_amdgcn_readlane(v, 47) + __builtin_amdgcn_readlane(v, 63);
}
template <int NJ>
__device__ __forceinline__ void dsa_select(const unsigned* scq, int nj, int lane, unsigned& T_out, int& cut_out) {
    unsigned kreg[NJ];
#pragma unroll
    for (int j = 0; j < NJ; ++j) kreg[j] = (j < nj) ? scq[j * 64 + lane] : 0u;
    unsigned T = 0u; bool exact = false;
    for (int bit = 31; bit >= 0; --bit) {
        const unsigned cand = T | (1u << bit);
        int c = 0;
#pragma unroll
        for (int j = 0; j < NJ; ++j) c += (kreg[j] >= cand) ? 1 : 0;
        const int cnt = wave_total_i(c);
        if (cnt >= 256) { T = cand; if (cnt == 256) { exact = true; break; } }
    }
    int cut = 0x7fffffff;
    if (!exact) {
        int cgt = 0, ceq = 0;
#pragma unroll
        for (int j = 0; j < NJ; ++j) { cgt += __popcll(__ballot(kreg[j] > T)); ceq += __popcll(__ballot(kreg[j] == T)); }
        int need = 256 - cgt;
        if (ceq > need) {
            bool found = false;
#pragma unroll
            for (int j = 0; j < NJ; ++j) {
                const unsigned long long m = __ballot(kreg[j] == T);
                const int cj = __popcll(m);
                if (!found) {
                    if (need <= cj) { for (int bpos = 0; bpos < 64; ++bpos) if ((m >> bpos) & 1ull) { if (--need == 0) { cut = j * 64 + bpos; break; } } found = true; }
                    else need -= cj;
                }
            }
        }
    }
    T_out = T; cut_out = cut;
}
__device__ __forceinline__ void ph_dsa_main(const Ctx& p, int l, float* smem) {
    const bf16_t* P = (const bf16_t*)(pws_() + WS_P);
    bf16_t* Y = (bf16_t*)(pws_() + WS_Y);
    const bf16_t* QN = (const bf16_t*)(pws_() + WS_QN);
    const bf16_t* KN = (const bf16_t*)(pws_() + WS_KN);
    const bf16_t* IKN = (const bf16_t*)(pws_() + WS_IKN);
    const bf16_t* VT = (const bf16_t*)(pws_() + WS_VT);
    unsigned* sc = (unsigned*)smem;
    float* part = smem;
    float* plsum = smem + 8 * 64 * 64;
    unsigned* thr = (unsigned*)(smem + 35000);
    const int tid = tid_(), lane = tid & 63, w = tid >> 6, qi = lane & 15, g = lane >> 4;
    for (int task = bid_(); task < MTOK / 16; task += nblk_()) {
        const int c = 31 - task / 128, b = (task >> 2) & 31, sub = task & 3;
        const int t0 = c * 64 + sub * 16, nk = (c + 1) * 64;
        const size_t tok0 = (size_t)b * SEQ + t0;
        const bool dosel = nk > 256;
        if (dosel) {
            BF8 iqf[8]; float wq[8];
#pragma unroll
            for (int h = 0; h < 8; ++h) {
                iqf[h].u = *(const uint4*)(P + (tok0 + qi) * LDP + PC_IQ + h * 32 + 8 * g);
                wq[h] = bf2f(P[(tok0 + qi) * LDP + PC_IW + h]) * 0.0625f;
            }
            for (int kt = w; kt < nk / 16; kt += 8) {
                const int s0 = kt * 16;
                BF8 ka; ka.u = *(const uint4*)(IKN + ((size_t)b * SEQ + s0 + qi) * 32 + 8 * g);
                float acc[4] = {0.f, 0.f, 0.f, 0.f};
#pragma unroll
                for (int h = 0; h < 8; ++h) {
                    const f32x4_t d = __builtin_amdgcn_mfma_f32_16x16x32_bf16(ka.v, iqf[h].v, (f32x4_t){0.f, 0.f, 0.f, 0.f}, 0, 0, 0);
#pragma unroll
                    for (int r = 0; r < 4; ++r) acc[r] = __builtin_fmaf(wq[h], fmaxf(d[r], 0.f), acc[r]);
                }
                uint4 kv; kv.x = ford(acc[0]); kv.y = ford(acc[1]); kv.z = ford(acc[2]); kv.w = ford(acc[3]);
                *(uint4*)(sc + qi * DSA_STRIDE + s0 + 4 * g) = kv;
            }
        }
        __syncthreads();
        if (dosel) {
            const int nj = nk >> 6;
#pragma unroll 1
            for (int qq = 0; qq < 2; ++qq) {
                const int q = 2 * w + qq;
                unsigned T; int cut;
                if (nj <= 8) dsa_select<8>(sc + q * DSA_STRIDE, nj, lane, T, cut);
                else if (nj <= 16) dsa_select<16>(sc + q * DSA_STRIDE, nj, lane, T, cut);
                else if (nj <= 24) dsa_select<24>(sc + q * DSA_STRIDE, nj, lane, T, cut);
                else dsa_select<32>(sc + q * DSA_STRIDE, nj, lane, T, cut);
                if (lane == 0) { thr[q] = T; thr[16 + q] = (unsigned)cut; }
            }
        }
        __syncthreads();
        unsigned Tq = 0u; int cutq = 0x7fffffff;
        if (dosel) { Tq = thr[qi]; cutq = (int)thr[16 + qi]; }
        f32x4_t oacc[4][4]; float lsum[4];
#pragma unroll
        for (int h = 0; h < 4; ++h) { lsum[h] = 0.f;
#pragma unroll
            for (int dt = 0; dt < 4; ++dt) oacc[h][dt] = (f32x4_t){0.f, 0.f, 0.f, 0.f}; }
        const int krow = 8 * (qi >> 2) + (qi & 3);
        for (int st = w; st < nk / 32; st += 8) {
            const int s0 = st * 32;
            BF8 ka[2][2], va[4];
#pragma unroll
            for (int t = 0; t < 2; ++t)
#pragma unroll
                for (int s2 = 0; s2 < 2; ++s2) ka[t][s2].u = *(const uint4*)(KN + ((size_t)b * SEQ + s0 + krow + 4 * t) * 64 + 32 * s2 + 8 * g);
#pragma unroll
            for (int dt = 0; dt < 4; ++dt) va[dt].u = *(const uint4*)(VT + ((size_t)b * 64 + 16 * dt + qi) * SEQ + s0 + 8 * g);
            float mk[8];
            if (dosel) {
                const uint4 k0 = *(const uint4*)(sc + qi * DSA_STRIDE + s0 + 8 * g), k1 = *(const uint4*)(sc + qi * DSA_STRIDE + s0 + 8 * g + 4);
                const unsigned kk[8] = {k0.x, k0.y, k0.z, k0.w, k1.x, k1.y, k1.z, k1.w};
#pragma unroll
                for (int j = 0; j < 8; ++j) mk[j] = (kk[j] > Tq || (kk[j] == Tq && (s0 + 8 * g + j) <= cutq)) ? 1.f : 0.f;
            } else {
#pragma unroll
                for (int j = 0; j < 8; ++j) mk[j] = 1.f;
            }
#pragma unroll
            for (int h = 0; h < 4; ++h) {
                BF8 q0, q1;
                q0.u = *(const uint4*)(QN + (tok0 + qi) * 256 + h * 64 + 8 * g);
                q1.u = *(const uint4*)(QN + (tok0 + qi) * 256 + h * 64 + 32 + 8 * g);
                f32x4_t sacc[2];
#pragma unroll
                for (int t = 0; t < 2; ++t) {
                    sacc[t] = __builtin_amdgcn_mfma_f32_16x16x32_bf16(ka[t][0].v, q0.v, (f32x4_t){0.f, 0.f, 0.f, 0.f}, 0, 0, 0);
                    sacc[t] = __builtin_amdgcn_mfma_f32_16x16x32_bf16(ka[t][1].v, q1.v, sacc[t], 0, 0, 0);
                }
                float pe[8];
#pragma unroll
                for (int t = 0; t < 2; ++t)
#pragma unroll
                    for (int r = 0; r < 4; ++r) { pe[4 * t + r] = __expf(sacc[t][r]) * mk[4 * t + r]; lsum[h] += pe[4 * t + r]; }
                BF8 pf;
#pragma unroll
                for (int j = 0; j < 4; ++j) pf.w[j] = pk_bf16(pe[2 * j], pe[2 * j + 1]);
#pragma unroll
                for (int dt = 0; dt < 4; ++dt) oacc[h][dt] = __builtin_amdgcn_mfma_f32_16x16x32_bf16(va[dt].v, pf.v, oacc[h][dt], 0, 0, 0);
            }
        }
        __syncthreads();
#pragma unroll
        for (int h = 0; h < 4; ++h) {
            plsum[(w * 4 + h) * 64 + lane] = lsum[h];
#pragma unroll
            for (int dt = 0; dt < 4; ++dt)
#pragma unroll
                for (int r = 0; r < 4; ++r) part[(w * 64 + h * 16 + dt * 4 + r) * 64 + lane] = oacc[h][dt][r];
        }
        __syncthreads();
        {
            const int h = w >> 1;
            float lq = 0.f;
#pragma unroll
            for (int w2 = 0; w2 < 8; ++w2)
#pragma unroll
                for (int g2 = 0; g2 < 4; ++g2) lq += plsum[(w2 * 4 + h) * 64 + qi + 16 * g2];
            const float inv = 1.f / lq;
#pragma unroll
            for (int dd = 0; dd < 2; ++dd) {
                const int dt = (w & 1) * 2 + dd;
                float o[4];
#pragma unroll
                for (int r = 0; r < 4; ++r) {
                    float sacc = 0.f;
#pragma unroll
                    for (int w2 = 0; w2 < 8; ++w2) sacc += part[(w2 * 64 + h * 16 + dt * 4 + r) * 64 + lane];
                    o[r] = sacc * inv;
                }
                uint2 ov; ov.x = pk_bf16(o[0], o[1]); ov.y = pk_bf16(o[2], o[3]);
                *(uint2*)(Y + (tok0 + qi) * DM + 768 + h * 64 + 16 * dt + 4 * g) = ov;
            }
        }
        __syncthreads();
    }
}

__device__ __forceinline__ void ph_mem_prep(const Ctx& p, int l) {
    const float* Km = (const float*)(pws_() + WS_KM);
    const float* Vm = (const float*)(pws_() + WS_VM);
    bf16_t* KB = (bf16_t*)(pws_() + WS_KB);
    bf16_t* VTB = (bf16_t*)(pws_() + WS_VTB);
    const float* kg = pin_(28) + (size_t)l * 64;
    const int lane = tid_() & 63;
    for (int r = gwave(); r < MMEM; r += nwaves()) {
        const int b = r / NMEM, j = r % NMEM;
#pragma unroll
        for (int h = 0; h < 4; ++h) {
            const float v = Km[(size_t)r * 256 + h * 64 + lane];
            const float ss = wave_sum(v * v);
            KB[(((size_t)b * 4 + h) * NMEM + j) * 64 + lane] = f2bf(v * rsqrtf(ss * (1.f / 64.f) + EPS) * kg[lane]);
            VTB[(((size_t)b * 4 + h) * 64 + lane) * NMEM + j] = f2bf(Vm[(size_t)r * 256 + h * 64 + lane]);
        }
    }
}
__device__ __forceinline__ void ph_xattn(const Ctx& p, int l, int task0 = 0, int ntask = MTOK / 16, int w0 = -1, int wstep = 0) {
    const float* Qx = (const float*)(pws_() + WS_QX);
    bf16_t* Ox = (bf16_t*)(pws_() + WS_OX);
    const bf16_t* KB = (const bf16_t*)(pws_() + WS_KB);
    const bf16_t* VTB = (const bf16_t*)(pws_() + WS_VTB);
    const float* qg = pin_(27) + (size_t)l * 64;
    const int lane = tid_() & 63, qi = lane & 15, g = lane >> 4;
    if (w0 < 0) { w0 = gwave(); wstep = nwaves(); }
    for (int task = task0 + w0; task < task0 + ntask; task += wstep) {
        const int tok0 = task * 16, b = tok0 / SEQ;
#pragma unroll 1
        for (int h = 0; h < 4; ++h) {
            BF8 qf[2];
            {
                float qv[2][8]; float ss = 0.f;
#pragma unroll
                for (int s2 = 0; s2 < 2; ++s2) {
                    const float4* qp = (const float4*)(Qx + (size_t)(tok0 + qi) * 256 + h * 64 + 32 * s2 + 8 * g);
                    const float4 a = qp[0], c = qp[1];
                    qv[s2][0] = a.x; qv[s2][1] = a.y; qv[s2][2] = a.z; qv[s2][3] = a.w; qv[s2][4] = c.x; qv[s2][5] = c.y; qv[s2][6] = c.z; qv[s2][7] = c.w;
#pragma unroll
                    for (int j = 0; j < 8; ++j) ss += qv[s2][j] * qv[s2][j];
                }
                ss += __shfl_xor(ss, 16, 64); ss += __shfl_xor(ss, 32, 64);
                const float rs = rsqrtf(ss * (1.f / 64.f) + EPS) * 0.125f;
#pragma unroll
                for (int s2 = 0; s2 < 2; ++s2) {
                    const float4 g0 = *(const float4*)(qg + 32 * s2 + 8 * g), g1 = *(const float4*)(qg + 32 * s2 + 8 * g + 4);
                    qf[s2].w[0] = pk_bf16(qv[s2][0] * rs * g0.x, qv[s2][1] * rs * g0.y); qf[s2].w[1] = pk_bf16(qv[s2][2] * rs * g0.z, qv[s2][3] * rs * g0.w);
                    qf[s2].w[2] = pk_bf16(qv[s2][4] * rs * g1.x, qv[s2][5] * rs * g1.y); qf[s2].w[3] = pk_bf16(qv[s2][6] * rs * g1.z, qv[s2][7] * rs * g1.w);
                }
            }
            const bf16_t* Kh = KB + ((size_t)b * 4 + h) * NMEM * 64;
            const bf16_t* Vh = VTB + ((size_t)b * 4 + h) * 64 * NMEM;
            f32x4_t oacc[4];
#pragma unroll
            for (int dt = 0; dt < 4; ++dt) oacc[dt] = (f32x4_t){0.f, 0.f, 0.f, 0.f};
            float lsum = 0.f;
            const int krow = 8 * (qi >> 2) + (qi & 3);
#pragma unroll 2
            for (int s0 = 0; s0 < NMEM; s0 += 32) {
                BF8 ka[2][2], va[4];
#pragma unroll
                for (int t = 0; t < 2; ++t)
#pragma unroll
                    for (int s2 = 0; s2 < 2; ++s2) ka[t][s2].u = *(const uint4*)(Kh + (size_t)(s0 + krow + 4 * t) * 64 + 32 * s2 + 8 * g);
#pragma unroll
                for (int dt = 0; dt < 4; ++dt) va[dt].u = *(const uint4*)(Vh + (size_t)(16 * dt + qi) * NMEM + s0 + 8 * g);
                f32x4_t sacc[2];
#pragma unroll
                for (int t = 0; t < 2; ++t) {
                    sacc[t] = (f32x4_t){0.f, 0.f, 0.f, 0.f};
                    sacc[t] = __builtin_amdgcn_mfma_f32_16x16x32_bf16(ka[t][0].v, qf[0].v, sacc[t], 0, 0, 0);
                    sacc[t] = __builtin_amdgcn_mfma_f32_16x16x32_bf16(ka[t][1].v, qf[1].v, sacc[t], 0, 0, 0);
                }
                float pe[8];
#pragma unroll
                for (int t = 0; t < 2; ++t)
#pragma unroll
                    for (int r = 0; r < 4; ++r) { pe[4 * t + r] = __expf(sacc[t][r]); lsum += pe[4 * t + r]; }
                BF8 pf;
#pragma unroll
                for (int j = 0; j < 4; ++j) pf.w[j] = pk_bf16(pe[2 * j], pe[2 * j + 1]);
#pragma unroll
                for (int dt = 0; dt < 4; ++dt) oacc[dt] = __builtin_amdgcn_mfma_f32_16x16x32_bf16(va[dt].v, pf.v, oacc[dt], 0, 0, 0);
            }
            lsum += __shfl_xor(lsum, 16, 64); lsum += __shfl_xor(lsum, 32, 64);
            const float inv = 1.f / lsum;
#pragma unroll
            for (int dt = 0; dt < 4; ++dt) {
                uint2 o; o.x = pk_bf16(oacc[dt][0] * inv, oacc[dt][1] * inv); o.y = pk_bf16(oacc[dt][2] * inv, oacc[dt][3] * inv);
                *(uint2*)(Ox + (size_t)(tok0 + qi) * 256 + h * 64 + 16 * dt + 4 * g) = o;
            }
        }
    }
}

template <int N> __device__ __forceinline__ void bitonic_sort_desc(unsigned (&a)[N]) {
#pragma unroll
    for (int k = 2; k <= N; k <<= 1)
#pragma unroll
        for (int j = k >> 1; j > 0; j >>= 1)
#pragma unroll
            for (int i = 0; i < N; ++i) {
                const int o = i ^ j;
                if (o > i) {
                    const bool desc = ((i & k) == 0);
                    const unsigned x = a[i], y = a[o];
                    const unsigned mx = x > y ? x : y, mn = x > y ? y : x;
                    a[i] = desc ? mx : mn; a[o] = desc ? mn : mx;
                }
            }
}
__device__ __forceinline__ void bitonic_merge16_desc(unsigned (&a)[16]) {
#pragma unroll
    for (int j = 8; j > 0; j >>= 1)
#pragma unroll
        for (int i = 0; i < 16; ++i) {
            const int o = i ^ j;
            if (o > i) { const unsigned x = a[i], y = a[o]; a[i] = x > y ? x : y; a[o] = x > y ? y : x; }
        }
}
__device__ __forceinline__ void top16_merge(unsigned (&a)[16], const unsigned (&b)[16]) {
#pragma unroll
    for (int i = 0; i < 16; ++i) a[i] = a[i] > b[15 - i] ? a[i] : b[15 - i];
    bitonic_merge16_desc(a);
}
__device__ __forceinline__ void top16_xlane(unsigned (&a)[16], int xm) {
    unsigned b[16];
#pragma unroll
    for (int i = 0; i < 16; ++i) b[i] = (unsigned)__shfl_xor((int)a[i], xm, 64);
    top16_merge(a, b);
}
__device__ __forceinline__ void ph_subkeys_convert(const Ctx& p) {
    const float* sk = pin_(31);
    bf16_t* o = (bf16_t*)(pws_() + WS_SKB);
    const size_t n = (size_t)DEPTH * 8 * 2 * 128 * 64;
    for (size_t i = (size_t)bid_() * 512 + tid_(); i < n; i += (size_t)nblk_() * 512) o[i] = f2bf(sk[i]);
}
__device__ __forceinline__ void ph_peer_topk(const Ctx& p, int l, float* smem, int task0 = 0, int ntask = MTOK / 16, int w0 = -1, int wstep = 0) {
    const bf16_t* Qp = (const bf16_t*)(pws_() + WS_QP);
    const bf16_t* SK = (const bf16_t*)(pws_() + WS_SKB) + (size_t)l * 8 * 2 * 128 * 64;
    int* pidx = (int*)(pws_() + WS_PEI);
    float* pgt = (float*)(pws_() + WS_PEG);
    float* pus = (float*)(pws_() + WS_PUS);
    const float* usc = (const float*)(pws_() + WS_USC) + (size_t)l * NEXP;
    const float* vsc = (const float*)(pws_() + WS_VSC) + (size_t)l * NEXP;
    const int tid = tid_(), lane = tid & 63, wave = tid >> 6, qi = lane & 15, g = lane >> 4;
    int* tabw = (int*)smem + wave * 512 + qi * 32;
    if (w0 < 0) { w0 = gwave(); wstep = nwaves(); }
    for (int task = task0 + w0; task < task0 + ntask; task += wstep) {
        const size_t tok = (size_t)task * 16 + qi;
#pragma unroll 1
        for (int h = 0; h < 8; ++h) {
            unsigned L[2][16];
#pragma unroll
            for (int pp = 0; pp < 2; ++pp) {
                BF8 qf[2];
#pragma unroll
                for (int s2 = 0; s2 < 2; ++s2) qf[s2].u = *(const uint4*)(Qp + tok * DM + h * 128 + pp * 64 + 32 * s2 + 8 * g);
                const bf16_t* skp = SK + (size_t)(h * 2 + pp) * 128 * 64;
                unsigned va[16], vb[16];
#pragma unroll
                for (int tile = 0; tile < 8; ++tile) {
                    BF8 ka[2];
#pragma unroll
                    for (int s2 = 0; s2 < 2; ++s2) ka[s2].u = *(const uint4*)(skp + (size_t)(16 * tile + qi) * 64 + 32 * s2 + 8 * g);
                    f32x4_t d = __builtin_amdgcn_mfma_f32_16x16x32_bf16(ka[0].v, qf[0].v, (f32x4_t){0.f, 0.f, 0.f, 0.f}, 0, 0, 0);
                    d = __builtin_amdgcn_mfma_f32_16x16x32_bf16(ka[1].v, qf[1].v, d, 0, 0, 0);
#pragma unroll
                    for (int r = 0; r < 4; ++r) {
                        const unsigned key = (ford(d[r]) & ~127u) | (unsigned)(127 - (16 * tile + 4 * g + r));
                        if (tile < 4) va[tile * 4 + r] = key; else vb[(tile - 4) * 4 + r] = key;
                    }
                }
                bitonic_sort_desc<16>(va);
                bitonic_sort_desc<16>(vb);
                top16_merge(va, vb);
                top16_xlane(va, 16);
                top16_xlane(va, 32);
#pragma unroll
                for (int i = 0; i < 16; ++i) L[pp][i] = va[i];
            }
            if (g < 2) {
#pragma unroll
                for (int i = 0; i < 16; ++i) tabw[g * 16 + i] = 127 - (int)((g == 0 ? L[0][i] : L[1][i]) & 127u);
            }
            float s1[16], s2v[16];
#pragma unroll
            for (int i = 0; i < 16; ++i) { s1[i] = funord(L[0][i] & ~127u); s2v[i] = funord(L[1][i] & ~127u); }
            unsigned ca[16], cb[16];
#pragma unroll
            for (int i = 0; i < 16; ++i) { ca[i] = 0u; cb[i] = 0u; }
            {
                const float r0 = g == 0 ? s1[0] : (g == 1 ? s1[1] : (g == 2 ? s1[2] : s1[3]));
                const int nb0 = g == 0 ? 16 : (g == 1 ? 8 : (g == 2 ? 5 : 4));
#pragma unroll
                for (int bq = 0; bq < 16; ++bq) if (bq < nb0) ca[bq] = (ford(r0 + s2v[bq]) & ~255u) | (unsigned)(255 - (g * 16 + bq));
                const float r1 = g == 0 ? s1[4] : (g == 1 ? s1[5] : (g == 2 ? s1[6] : s1[7]));
                const int nb1 = g == 0 ? 3 : 2;
#pragma unroll
                for (int bq = 0; bq < 3; ++bq) if (bq < nb1) cb[bq] = (ford(r1 + s2v[bq]) & ~255u) | (unsigned)(255 - ((g + 4) * 16 + bq));
                const float r2 = g == 0 ? s1[8] : (g == 1 ? s1[9] : (g == 2 ? s1[10] : s1[11]));
                cb[3] = (ford(r2 + s2v[0]) & ~255u) | (unsigned)(255 - ((g + 8) * 16));
                const float r3 = g == 0 ? s1[12] : (g == 1 ? s1[13] : (g == 2 ? s1[14] : s1[15]));
                cb[4] = (ford(r3 + s2v[0]) & ~255u) | (unsigned)(255 - ((g + 12) * 16));
            }
            bitonic_sort_desc<16>(ca);
            bitonic_sort_desc<16>(cb);
            top16_merge(ca, cb);
            top16_xlane(ca, 16);
            top16_xlane(ca, 32);
            float tv[16]; float den = 0.f;
#pragma unroll
            for (int i = 0; i < 16; ++i) {
                const int f = 255 - (int)(ca[i] & 255u);
                const int a = f >> 4, bq = f & 15;
                tv[i] = funord(ca[i] & ~255u);
                (void)a; (void)bq;
            }
#pragma unroll
            for (int i = 0; i < 16; ++i) { tv[i] = __expf(tv[i] - funord(ca[0] & ~255u)); den += tv[i]; }
            const float inv = 1.f / den;
            int ev[4]; float gv[4];
#pragma unroll
            for (int r = 0; r < 4; ++r) {
                const unsigned key = g == 0 ? ca[r] : (g == 1 ? ca[4 + r] : (g == 2 ? ca[8 + r] : ca[12 + r]));
                const float tvv = g == 0 ? tv[r] : (g == 1 ? tv[4 + r] : (g == 2 ? tv[8 + r] : tv[12 + r]));
                const int f = 255 - (int)(key & 255u);
                ev[r] = tabw[f >> 4] * 128 + tabw[16 + (f & 15)];
                gv[r] = tvv * inv;
            }
            float us[4];
#pragma unroll
            for (int r = 0; r < 4; ++r) { us[r] = usc[ev[r]]; gv[r] *= vsc[ev[r]]; }
            *(int4*)(pidx + tok * 128 + h * 16 + 4 * g) = make_int4(ev[0], ev[1], ev[2], ev[3]);
            *(float4*)(pgt + tok * 128 + h * 16 + 4 * g) = make_float4(gv[0], gv[1], gv[2], gv[3]);
            *(float4*)(pus + tok * 128 + h * 16 + 4 * g) = make_float4(us[0], us[1], us[2], us[3]);
        }
    }
}

typedef float f32x2_t __attribute__((ext_vector_type(2)));
typedef int i32x8_t __attribute__((ext_vector_type(8)));
__device__ __forceinline__ unsigned pack4_fp8(float4 a, float sc) {
    const float x = fminf(fmaxf(a.x * sc, -448.f), 448.f), y = fminf(fmaxf(a.y * sc, -448.f), 448.f);
    const float z = fminf(fmaxf(a.z * sc, -448.f), 448.f), w = fminf(fmaxf(a.w * sc, -448.f), 448.f);
    int r = __builtin_amdgcn_cvt_pk_fp8_f32(x, y, 0, false);
    r = __builtin_amdgcn_cvt_pk_fp8_f32(z, w, r, true);
    return (unsigned)r;
}
__device__ __forceinline__ unsigned q4_e2m1(float y) {
    const float a = fabsf(y);
    const unsigned c = (unsigned)(a > 0.25f) + (unsigned)(a > 0.75f) + (unsigned)(a > 1.25f) + (unsigned)(a > 1.75f) + (unsigned)(a > 2.5f) + (unsigned)(a > 3.5f) + (unsigned)(a > 5.0f);
    return c | (y < 0.f ? 8u : 0u);
}
__device__ __forceinline__ void ph_tab_convert_all(const Ctx& p) {
    const int lane = tid_() & 63;
    for (int row = gwave(); row < 2 * DEPTH * NEXP; row += nwaves()) {
        const int tabv = row >= DEPTH * NEXP;
        const int rr = tabv ? row - DEPTH * NEXP : row;
        const float4* src = (const float4*)((tabv ? pin_(33) : pin_(32)) + (size_t)rr * DM);
        float4 v[4]; float am = 0.f;
#pragma unroll
        for (int i = 0; i < 4; ++i) { v[i] = src[lane + 64 * i]; am = fmaxf(am, fmaxf(fmaxf(fabsf(v[i].x), fabsf(v[i].y)), fmaxf(fabsf(v[i].z), fabsf(v[i].w)))); }
        am = wave_max(am);
        const float sc = am > 0.f ? am * (1.f / 6.f) : 1.f, inv = 1.f / sc;
        unsigned char* dst = (unsigned char*)(pws_() + (tabv ? WS_V4 : WS_U4)) + (size_t)rr * 512;
#pragma unroll
        for (int i = 0; i < 4; ++i) {
            const unsigned pk = q4_e2m1(v[i].x * inv) | (q4_e2m1(v[i].y * inv) << 4) | (q4_e2m1(v[i].z * inv) << 8) | (q4_e2m1(v[i].w * inv) << 12);
            const int off = tabv ? 16 * (lane >> 1) + 4 * i + 2 * (lane & 1) : 128 * i + 2 * lane;
            *(unsigned short*)(dst + off) = (unsigned short)pk;
        }
        if (lane == 0) ((float*)(pws_() + (tabv ? WS_VSC : WS_USC)))[rr] = sc;
    }
}
__device__ __forceinline__ float dpp_xor1(float v) { return __int_as_float(__builtin_amdgcn_update_dpp(0, __float_as_int(v), 0xB1, 0xF, 0xF, true)); }
__device__ __forceinline__ void ph_peer_u4(const Ctx& p, int l, float* smem) {
    const unsigned char* ut = (const unsigned char*)(pws_() + WS_U4) + (size_t)l * NEXP * 512;
    const int* pidx = (const int*)(pws_() + WS_PEI);
    float* pgt = (float*)(pws_() + WS_PEG);
    const float* pus = (const float*)(pws_() + WS_PUS);
    const unsigned char* H8 = (const unsigned char*)(pws_() + WS_H8);
    const int lane = tid_() & 63, g = lane >> 4, i = lane & 15, wave = tid_() >> 6;
    const bool odd = i & 1;
    unsigned char* hl = (unsigned char*)smem + wave * 2048;
    const int nw = nwaves();
    int tok = gwave();
    int ne0 = pidx[(size_t)tok * 128 + lane], ne1 = pidx[(size_t)tok * 128 + 64 + lane];
    *(uint4*)(hl + 16 * lane) = *(const uint4*)(H8 + (size_t)tok * DM + 16 * lane);
    uint4 rA[8], rB[8], rC[8], rD[8];
    const int roff = 64 * (i & 1) + 16 * g;
#define PU_ROWS(buf, esrc, hq) do { const int ea_ = __builtin_amdgcn_ds_bpermute(((hq) * 16 + (i >> 1)) * 4, esrc), eb_ = __builtin_amdgcn_ds_bpermute(((hq) * 16 + 8 + (i >> 1)) * 4, esrc); \
        const unsigned char* pa_ = ut + (size_t)ea_ * 512 + roff; const unsigned char* pb_ = ut + (size_t)eb_ * 512 + roff; \
        _Pragma("unroll") for (int q_ = 0; q_ < 4; ++q_) { buf[q_] = *(const uint4*)(pa_ + 128 * q_); buf[4 + q_] = *(const uint4*)(pb_ + 128 * q_); } \
        __builtin_amdgcn_sched_barrier(0); } while (0)
#define PU_COMP(buf, hd) do { f32x4_t a0_ = {0.f, 0.f, 0.f, 0.f}, a1_ = {0.f, 0.f, 0.f, 0.f}; \
        _Pragma("unroll") for (int q_ = 0; q_ < 4; ++q_) { \
            const uint4 b0_ = *(const uint4*)(hb + 256 * q_), b1_ = *(const uint4*)(hb + 256 * q_ + 64); \
            const i32x8_t b_ = {(int)b0_.x, (int)b0_.y, (int)b0_.z, (int)b0_.w, (int)b1_.x, (int)b1_.y, (int)b1_.z, (int)b1_.w}; \
            const i32x8_t x_ = {(int)buf[q_].x, (int)buf[q_].y, (int)buf[q_].z, (int)buf[q_].w, 0, 0, 0, 0}; \
            const i32x8_t y_ = {(int)buf[4 + q_].x, (int)buf[4 + q_].y, (int)buf[4 + q_].z, (int)buf[4 + q_].w, 0, 0, 0, 0}; \
            a0_ = __builtin_amdgcn_mfma_scale_f32_16x16x128_f8f6f4(x_, b_, a0_, 4, 0, 0, 0, 0, 0); \
            a1_ = __builtin_amdgcn_mfma_scale_f32_16x16x128_f8f6f4(y_, b_, a1_, 4, 0, 0, 0, 0, 0); \
            __builtin_amdgcn_sched_barrier(0); } \
        float t0a_ = odd ? a0_[1] : a0_[0], t0b_ = odd ? a0_[3] : a0_[2], t1a_ = odd ? a1_[1] : a1_[0], t1b_ = odd ? a1_[3] : a1_[2]; \
        t0a_ += dpp_xor1(t0a_); t0b_ += dpp_xor1(t0b_); t1a_ += dpp_xor1(t1a_); t1b_ += dpp_xor1(t1b_); \
        if ((i >> 1) == (hd)) { keep0 = odd ? t1a_ : t0a_; keep1 = odd ? t1b_ : t0b_; } \
        __builtin_amdgcn_sched_barrier(0); } while (0)
    PU_ROWS(rA, ne0, 0); PU_ROWS(rB, ne0, 1); PU_ROWS(rC, ne0, 2);
    int par = 0;
    for (; tok < MTOK; tok += nw, par ^= 1) {
        const int e0 = ne0, e1 = ne1;
        const size_t tn = (size_t)(tok + nw < MTOK ? tok + nw : tok);
        const uint4 hnext = *(const uint4*)(H8 + tn * DM + 16 * lane);
        ne0 = pidx[tn * 128 + lane]; ne1 = pidx[tn * 128 + 64 + lane];
        const size_t mi = (size_t)tok * 128 + (i >> 1) * 16 + 8 * (i & 1) + 2 * g;
        const float2 gm = *(const float2*)(pgt + mi), um = *(const float2*)(pus + mi);
        asm volatile("s_waitcnt lgkmcnt(0)" ::: "memory"); __builtin_amdgcn_wave_barrier();
        const unsigned char* hb = hl + par * 1024 + 128 * (i & 1) + 16 * g;
        float keep0 = 0.f, keep1 = 0.f;
        PU_ROWS(rD, e0, 3); PU_COMP(rA, 0);
        PU_ROWS(rA, e1, 0); PU_COMP(rB, 1);
        PU_ROWS(rB, e1, 1); PU_COMP(rC, 2);
        PU_ROWS(rC, e1, 2); PU_COMP(rD, 3);
        PU_ROWS(rD, e1, 3); PU_COMP(rA, 4);
        PU_ROWS(rA, ne0, 0); PU_COMP(rB, 5);
        PU_ROWS(rB, ne0, 1); PU_COMP(rC, 6);
        PU_ROWS(rC, ne0, 2); PU_COMP(rD, 7);
        *(uint4*)(hl + (par ^ 1) * 1024 + 16 * lane) = hnext;
        float2 o;
        o.x = gm.x * gelu_tanh_f(keep0 * um.x * (1.f / H8_SCALE)); o.y = gm.y * gelu_tanh_f(keep1 * um.y * (1.f / H8_SCALE));
        *(float2*)(pgt + mi) = o;
    }
#undef PU_ROWS
#undef PU_COMP
}
__device__ __forceinline__ void ph_peer_v4(const Ctx& p, int l) {
    const unsigned char* vt = (const unsigned char*)(pws_() + WS_V4) + (size_t)l * NEXP * 512;
    const int* pidx = (const int*)(pws_() + WS_PEI);
    const float* pgt = (const float*)(pws_() + WS_PEG);
    float* x = pout_();
    const int lane = tid_() & 63;
    const bool r = lane & 32;
    const int coff = 16 * (lane & 31);
    const int nw = nwaves();
    int tok = gwave();
    int ne0 = pidx[(size_t)tok * 128 + lane], ne1 = pidx[(size_t)tok * 128 + 64 + lane];
    float nc0 = pgt[(size_t)tok * 128 + lane], nc1 = pgt[(size_t)tok * 128 + 64 + lane];
    uint4 vA[16], vB[16];
#define PV_ROWS(buf, esrc, lb) do { int es_ = esrc; asm volatile("" : "+v"(es_)); _Pragma("unroll") for (int k_ = 0; k_ < 16; ++k_) { \
        const int ea_ = __builtin_amdgcn_readlane(es_, (lb) + 2 * k_), eb_ = __builtin_amdgcn_readlane(es_, (lb) + 2 * k_ + 1); \
        buf[k_] = *(const uint4*)(vt + (size_t)(r ? eb_ : ea_) * 512 + coff); } __builtin_amdgcn_sched_barrier(0); } while (0)
#define PV_D4(W, q) do { \
        out[4 * (q) + 0] = __builtin_elementwise_fma(__builtin_amdgcn_cvt_scalef32_pk_f32_fp4(W, 1.0f, 0), c2_, out[4 * (q) + 0]); \
        out[4 * (q) + 1] = __builtin_elementwise_fma(__builtin_amdgcn_cvt_scalef32_pk_f32_fp4(W, 1.0f, 1), c2_, out[4 * (q) + 1]); \
        out[4 * (q) + 2] = __builtin_elementwise_fma(__builtin_amdgcn_cvt_scalef32_pk_f32_fp4(W, 1.0f, 2), c2_, out[4 * (q) + 2]); \
        out[4 * (q) + 3] = __builtin_elementwise_fma(__builtin_amdgcn_cvt_scalef32_pk_f32_fp4(W, 1.0f, 3), c2_, out[4 * (q) + 3]); } while (0)
#define PV_COMP(buf, csrc, lb) do { unsigned cs_ = __float_as_uint(csrc); asm volatile("" : "+v"(cs_)); _Pragma("unroll") for (int k_ = 0; k_ < 16; ++k_) { \
        const float ca_ = __uint_as_float(__builtin_amdgcn_readlane(cs_, (lb) + 2 * k_)), cb_ = __uint_as_float(__builtin_amdgcn_readlane(cs_, (lb) + 2 * k_ + 1)); \
        const float cj_ = r ? cb_ : ca_; const f32x2_t c2_ = {cj_, cj_}; \
        PV_D4(buf[k_].x, 0); PV_D4(buf[k_].y, 1); PV_D4(buf[k_].z, 2); PV_D4(buf[k_].w, 3); } __builtin_amdgcn_sched_barrier(0); } while (0)
    PV_ROWS(vA, ne0, 0);
    for (; tok < MTOK; tok += nw) {
        const int e0 = ne0, e1 = ne1;
        const float c0 = nc0, c1 = nc1;
        {
            const size_t tn = (size_t)(tok + nw < MTOK ? tok + nw : tok);
            ne0 = pidx[tn * 128 + lane]; ne1 = pidx[tn * 128 + 64 + lane];
            nc0 = pgt[tn * 128 + lane]; nc1 = pgt[tn * 128 + 64 + lane];
        }
        f32x2_t out[16];
#pragma unroll
        for (int k = 0; k < 16; ++k) out[k] = (f32x2_t){0.f, 0.f};
        PV_ROWS(vB, e0, 32); PV_COMP(vA, c0, 0);
        PV_ROWS(vA, e1, 0);  PV_COMP(vB, c0, 32);
        PV_ROWS(vB, e1, 32); PV_COMP(vA, c1, 0);
        PV_ROWS(vA, ne0, 0); PV_COMP(vB, c1, 32);
#pragma unroll
        for (int q = 0; q < 4; ++q) {
            float fin[4];
#pragma unroll
            for (int b = 0; b < 2; ++b)
#pragma unroll
                for (int c = 0; c < 2; ++c) {
                    const float lo = out[4 * q + b][c], hi = out[4 * q + 2 + b][c];
                    const float mine = r ? hi : lo, send = r ? lo : hi;
                    fin[2 * b + c] = mine + __shfl_xor(send, 32, 64);
                }
            float4* xp = (float4*)(x + (size_t)tok * DM + 256 * q + 8 * (lane & 31) + (r ? 4 : 0));
            float4 a = *xp;
            a.x += fin[0]; a.y += fin[1]; a.z += fin[2]; a.w += fin[3];
            *xp = a;
        }
    }
#undef PV_ROWS
#undef PV_COMP
#undef PV_D4
}


#ifndef PROBE_MASK
#define PROBE_MASK 0
#endif
#if PROBE_MASK
#define GB(k) do { GRID_BARRIER(); const unsigned long long now_ = wall_clock64(); if ((PROBE_MASK >> (k)) & 1) { const unsigned long long dt_ = now_ - tprev_; while (wall_clock64() - now_ < 3ull * dt_) __builtin_amdgcn_s_sleep(8); } GRID_BARRIER(); tprev_ = wall_clock64(); } while (0)
#else
#define GB(k) GRID_BARRIER()
#endif
__global__ void __launch_bounds__(512, 2) k_mega(Params kp) {
    float* sm = dynsmem;
    {
        unsigned long long* tab = (unsigned long long*)((char*)dynsmem + PTAB_OFF);
        if (threadIdx.x < 34) tab[threadIdx.x] = (unsigned long long)kp.in[threadIdx.x];
        if (threadIdx.x == 34) tab[34] = (unsigned long long)kp.out;
        if (threadIdx.x == 35) tab[35] = (unsigned long long)kp.ws;
        if (threadIdx.x == 36) { tab[36] = 0ull; tab[37] = 0ull; }
    }
    __syncthreads();
    Ctx p; p.kp = &kp;
    (void)xcd_barrier_post((unsigned*)(pws_() + WS_BAR), (volatile LAS unsigned*)((char*)dynsmem + PTAB_OFF + 36 * 8));
#define GRID_BARRIER() do { XcdBarrier bar_; bar_.bar = (unsigned*)(pws_() + WS_BAR); bar_.x = xb_xcc_id(); bar_.st = (volatile LAS unsigned*)((char*)dynsmem + PTAB_OFF + 36 * 8); xcd_barrier(bar_); } while (0)
    ph_weight_prep(p, sm);
    ph_subkeys_convert(p);
    ph_tab_convert_all(p);
    GRID_BARRIER();
#if PROBE_MASK
    unsigned long long tprev_ = wall_clock64();
#endif
#pragma unroll 1
    for (int l = 0; l < DEPTH; ++l) {
#define XIN_ (l == 0 ? pin_(0) : pout_())
#define HBUF_ ((const bf16_t*)(pws_() + WS_H))
        ph_rmsnorm(XIN_, pin_(2) + (size_t)l * DM, (bf16_t*)(pws_() + WS_H), MTOK);
        ph_rmsnorm(pin_(1), pin_(22) + (size_t)l * DM, (bf16_t*)(pws_() + WS_HM), MMEM);
        GB(1);
        { pg8::EpiBf16 E; E.O = (bf16_t*)(pws_() + WS_P); E.ldc = LDP; ph_gemm(HBUF_, (const bf16_t*)(pws_() + WT_IN) + (size_t)l * LDP * DM, MTOK, LDP, DM, E); }
        { pg8::EpiF32 E; E.C = (float*)(pws_() + WS_KM); E.R = nullptr; E.ldc = 256; ph_gemm((const bf16_t*)(pws_() + WS_HM), (const bf16_t*)(pws_() + WT_XK) + (size_t)l * 256 * DM, MMEM, 256, DM, E, 32); }
        { pg8::EpiF32 E; E.C = (float*)(pws_() + WS_VM); E.R = nullptr; E.ldc = 256; ph_gemm((const bf16_t*)(pws_() + WS_HM), (const bf16_t*)(pws_() + WT_XV) + (size_t)l * 256 * DM, MMEM, 256, DM, E, 64); }
        GB(2);
        ph_mem_prep(p, l);
        ph_dsa_prep(p, l);
        ph_scan_prep(p, l);
        GB(3);
        ph_scans(p, l, sm);
        GB(4);
        ph_mixer_finish(p, l);
        ph_dsa_main(p, l, sm);
        GB(5);
#define PANEL_SYNC() do { asm volatile("s_waitcnt vmcnt(0) lgkmcnt(0)" ::: "memory"); __syncthreads(); \
        if (threadIdx.x < 64) { __builtin_amdgcn_fence(__ATOMIC_ACQUIRE, "agent"); asm volatile("s_waitcnt vmcnt(0)" ::: "memory"); } \
        __syncthreads(); } while (0)
        if (nblk_() == MTOK / 256) {
            const int pm = bid_(), wv = tid_() >> 6;
            { pg8::EpiF32 E; E.C = pout_(); E.R = XIN_; E.ldc = DM; ph_gemm_panel((const bf16_t*)(pws_() + WS_Y), (const bf16_t*)(pws_() + WT_OUT) + (size_t)l * DM * DM, MTOK, DM, DM, E, pm); }
            PANEL_SYNC();
            ph_rmsnorm(pout_(), pin_(21) + (size_t)l * DM, (bf16_t*)(pws_() + WS_H), 256, pm * 256, wv, 8);
            PANEL_SYNC();
            { pg8::EpiF32 E; E.C = (float*)(pws_() + WS_QX); E.R = nullptr; E.ldc = 256; ph_gemm_panel(HBUF_, (const bf16_t*)(pws_() + WT_XQ) + (size_t)l * 256 * DM, MTOK, 256, DM, E, pm); }
            PANEL_SYNC();
            ph_xattn(p, l, pm * 16, 16, wv, 8);
            PANEL_SYNC();
            { pg8::EpiF32 E; E.C = pout_(); E.R = pout_(); E.ldc = DM; ph_gemm_panel((const bf16_t*)(pws_() + WS_OX), (const bf16_t*)(pws_() + WT_XO) + (size_t)l * DM * 256, MTOK, DM, 256, E, pm); }
            PANEL_SYNC();
            ph_rmsnorm(pout_(), pin_(29) + (size_t)l * DM, (bf16_t*)(pws_() + WS_H), 256, pm * 256, wv, 8, (unsigned char*)(pws_() + WS_H8));
            PANEL_SYNC();
            { pg8::EpiBf16 E; E.O = (bf16_t*)(pws_() + WS_QP); E.ldc = DM; ph_gemm_panel(HBUF_, (const bf16_t*)(pws_() + WT_PQ) + (size_t)l * DM * DM, MTOK, DM, DM, E, pm); }
            PANEL_SYNC();
            ph_peer_topk(p, l, sm, pm * 16, 16, wv, 8);
        }
        GB(13);
        ph_peer_u4(p, l, sm);
        GB(14);
        ph_peer_v4(p, l);
        GB(17);
    }
}

extern "C" void kernel_launch(void* const* d_in, const int* in_sizes, int n_in, void* d_out, int out_size, void* d_ws, size_t ws_size, hipStream_t stream) {
    if (n_in != 34 || out_size != MTOK * DM || ws_size < WS_END) {
        fprintf(stderr, "kernel_launch: unexpected shapes (n_in %d out %d ws %zu need %zu)\n", n_in, out_size, ws_size, (size_t)WS_END);
        return;
    }
    static int grid = 0;
    if (!grid) {
        int dev = 0, cus = 0, per_cu = 0;
        (void)hipGetDevice(&dev);
        (void)hipDeviceGetAttribute(&cus, hipDeviceAttributeMultiprocessorCount, dev);
        (void)hipFuncSetAttribute((const void*)k_mega, hipFuncAttributeMaxDynamicSharedMemorySize, LDS_BYTES);
        (void)hipOccupancyMaxActiveBlocksPerMultiprocessor(&per_cu, (const void*)k_mega, 512, LDS_BYTES);
        if (per_cu < 1) fprintf(stderr, "kernel_launch: occupancy query reports %d blocks per CU\n", per_cu);
        grid = cus > 0 ? cus : 256;
    }
    Params p; memset(&p, 0, sizeof(p));
    for (int i = 0; i < 34; ++i) p.in[i] = (const float*)d_in[i];
    p.out = (float*)d_out; p.ws = (char*)d_ws;
    (void)hipMemsetAsync((char*)d_ws + WS_BAR, 0, XCD_BAR_WORDS * sizeof(unsigned), stream);
    hipLaunchKernelGGL(k_mega, dim3(grid), dim3(512), LDS_BYTES, stream, p);
}
```

```cpp
#include <hip/hip_runtime.h>
#include <stdint.h>
#include <stdio.h>
#include <string.h>

#define NB 32
#define SEQ 2048
#define DM 1024
#define MTOK (NB * SEQ)
#define DEPTH 4
#define NMEM 256
#define MMEM (NB * NMEM)
#define LDP 3328
#define NEXP 16384
#define EPS 1e-6f
#define PC_Z 0
#define PC_XBC 256
#define PC_GQKV 768
#define PC_GG 1536
#define PC_LQ 1792
#define PC_LK 1920
#define PC_LV 2048
#define PC_LR 2304
#define PC_DQ 2560
#define PC_DK 2816
#define PC_DV 2880
#define PC_IQ 2944
#define PC_IK 3200
#define PC_GLR 3232
#define PC_IW 3248
#define PC_DT 3256
#define PC_GA 3260
#define PC_GB 3264

typedef unsigned short bf16_t;

#define WS_BAR 0ull
#define WS_P 16384ull
#define SZ_P ((size_t)MTOK * LDP * 2)
#define WS_H (WS_P + SZ_P)
#define SZ_H ((size_t)MTOK * DM * 2)
#define WS_Y (WS_H + SZ_H)
#define SZ_Y ((size_t)MTOK * DM * 2)
#define WS_WP (WS_Y + SZ_Y)
#define SZ_WP ((size_t)DEPTH * DM * LDP * 4)
#define WT_IN (WS_WP)
#define WT_OUT (WT_IN + (size_t)DEPTH * LDP * DM * 2)
#define WT_XQ (WT_OUT + (size_t)DEPTH * DM * DM * 2)
#define WT_XK (WT_XQ + (size_t)DEPTH * 256 * DM * 2)
#define WT_XV (WT_XK + (size_t)DEPTH * 256 * DM * 2)
#define WT_XO (WT_XV + (size_t)DEPTH * 256 * DM * 2)
#define WT_PQ (WT_XO + (size_t)DEPTH * DM * 256 * 2)
#define WT_END (WT_PQ + (size_t)DEPTH * DM * DM * 2)
#define WS_QN (WS_WP + SZ_WP)
#define SZ_QN ((size_t)MTOK * 256 * 4)
#define WS_KN (WS_QN + SZ_QN)
#define SZ_KN ((size_t)MTOK * 64 * 4)
#define WS_IKN (WS_KN + SZ_KN)
#define SZ_IKN ((size_t)MTOK * 32 * 4)
#define WS_YPRE (WS_IKN + SZ_IKN)
#define SZ_YPRE ((size_t)MTOK * 256 * 4)
#define WS_HM (WS_YPRE + SZ_YPRE)
#define SZ_HM ((size_t)MMEM * DM * 2)
#define WS_KM (WS_HM + SZ_HM)
#define SZ_KM ((size_t)MMEM * 256 * 4)
#define WS_VM (WS_KM + SZ_KM)
#define SZ_VM ((size_t)MMEM * 256 * 4)
#define WS_KB (WS_VM + SZ_VM)
#define SZ_KB ((size_t)MMEM * 256 * 2)
#define WS_VTB (WS_KB + SZ_KB)
#define SZ_VTB ((size_t)MMEM * 256 * 2)
#define WS_VT (WS_VTB + SZ_VTB)
#define SZ_VT ((size_t)MTOK * 64 * 2)
#define WS_SKB (WS_VT + SZ_VT)
#define SZ_SKB ((size_t)DEPTH * 8 * 2 * 128 * 64 * 2)
#define WS_SC (WS_SKB + SZ_SKB)
#define SZ_SC ((size_t)MTOK * 16 * 4)
#define WS_DUMMY (WS_SC + SZ_SC)
#define SZ_DUMMY (65536ull)
#define WS_U4 (WS_DUMMY + SZ_DUMMY)
#define WS_V4 (WS_U4 + (size_t)DEPTH * NEXP * 512)
#define WS_USC (WS_V4 + (size_t)DEPTH * NEXP * 512)
#define WS_VSC (WS_USC + (size_t)DEPTH * NEXP * 4)
#define WS_END (WS_VSC + (size_t)DEPTH * NEXP * 4)
#define WS_QX (WS_P)
#define WS_OX (WS_P + (size_t)MTOK * 256 * 4)
#define WS_QP (WS_P + 96ull * 1024 * 1024)
#define WS_H8 (WS_P + 224ull * 1024 * 1024)
#define WS_PEI (WS_H8 + (size_t)MTOK * DM)
#define WS_PEG (WS_PEI + (size_t)MTOK * 128 * 4)
#define WS_PUS (WS_PEG + (size_t)MTOK * 128 * 4)
#define WS_PEND (WS_PUS + (size_t)MTOK * 128 * 4)
static_assert(WS_PEND <= WS_P + SZ_P, "P region aliases");

struct Params {
    const float* in[34];
    float* out;
    char* ws;
};

#define XB_TMO      128
#define XB_XCNT(j)  (256  + 64 * (j))
#define XB_XSUB(j)  (1280 + 64 * (j))
#define XB_XGEN(j)  (2304 + 64 * (j))
#define XB_TOP      3328
#define XB_TOPGEN   3392
#define XCD_BAR_WORDS 3456
#define XB_SPIN_CAP (1u << 18)
#define LAS __attribute__((address_space(3)))

__device__ __forceinline__ unsigned xb_ld(unsigned* p)              { return __hip_atomic_load(p, __ATOMIC_RELAXED, __HIP_MEMORY_SCOPE_AGENT); }
__device__ __forceinline__ unsigned xb_add(unsigned* p, unsigned v) { return __hip_atomic_fetch_add(p, v, __ATOMIC_RELAXED, __HIP_MEMORY_SCOPE_AGENT); }
__device__ __forceinline__ unsigned xb_xcc_id() { return (unsigned)__builtin_amdgcn_s_getreg((3 << 11) | 20) & 0xFu; }
#define XB_SPIN(cond, bar) do { unsigned _sp = 0; while (cond) { __builtin_amdgcn_s_sleep(1); \
    if ((++_sp & 255u) == 0u) { if (xb_ld(&(bar)[XB_TMO])) break; if (_sp > XB_SPIN_CAP) { atomicAdd(&(bar)[XB_TMO], 1u); break; } } } } while (0)

struct XcdBarrier {
    unsigned* bar; unsigned x;
    volatile LAS unsigned* st;
};

__device__ __forceinline__ XcdBarrier xcd_barrier_post(unsigned* bar, volatile LAS unsigned* st) {
    XcdBarrier b; b.bar = bar; b.x = xb_xcc_id(); b.st = st;
    if (threadIdx.x == 0) (void)xb_add(&bar[XB_XCNT(b.x)], 1u);
    return b;
}
__device__ __forceinline__ void xcd_barrier_complete(unsigned* bar, unsigned x, unsigned& nloc, unsigned& nx) {
    const unsigned G = gridDim.x * gridDim.y * gridDim.z;
    unsigned sum, cnt, mine, sp = 0u;
    for (;;) {
        sum = 0u; cnt = 0u; mine = 0u;
#pragma unroll
        for (unsigned j = 0; j < 16; ++j) { const unsigned c = xb_ld(&bar[XB_XCNT(j)]); sum += c; cnt += (c > 0u) ? 1u : 0u; mine = (j == x) ? c : mine; }
        if (sum == G) break;
        __builtin_amdgcn_s_sleep(1);
        if ((++sp & 255u) == 0u) { if (xb_ld(&bar[XB_TMO])) break; if (sp > XB_SPIN_CAP) { atomicAdd(&bar[XB_TMO], 1u); break; } }
    }
    nloc = mine > 0u ? mine : 1u; nx = cnt > 0u ? cnt : 1u;
}

__device__ __forceinline__ void xcd_barrier(const XcdBarrier& b) {
    asm volatile("s_waitcnt vmcnt(0)" ::: "memory");
    __syncthreads();
    if (threadIdx.x == 0) {
        unsigned* bar = b.bar;
        __builtin_amdgcn_s_waitcnt(0);
        unsigned nloc = b.st[0], nx = b.st[1];
        if (nloc == 0u) { xcd_barrier_complete(bar, b.x, nloc, nx); b.st[0] = nloc; b.st[1] = nx; }
        const unsigned old = xb_add(&bar[XB_XSUB(b.x)], 1u);
        const unsigned gen = old / nloc;
        if (old + 1u == (gen + 1u) * nloc) {
            __builtin_amdgcn_fence(__ATOMIC_RELEASE, "agent");
            asm volatile("s_waitcnt vmcnt(0)" ::: "memory");
            const unsigned og = xb_add(&bar[XB_TOP], 1u);
            const unsigned tg = og / nx;
            if (og + 1u == (tg + 1u) * nx) xb_add(&bar[XB_TOPGEN], 1u);
            else XB_SPIN(xb_ld(&bar[XB_TOPGEN]) == tg, bar);
            __builtin_amdgcn_fence(__ATOMIC_ACQUIRE, "agent");
            xb_add(&bar[XB_XGEN(b.x)], 1u);
            asm volatile("s_waitcnt vmcnt(0)" ::: "memory");
        } else {
            XB_SPIN(xb_ld(&bar[XB_XGEN(b.x)]) == gen, bar);
            __builtin_amdgcn_fence(__ATOMIC_ACQUIRE, "agent");
            asm volatile("s_waitcnt vmcnt(0)" ::: "memory");
        }
    }
    __syncthreads();
}


#define LDS_BYTES (144 * 1024)
#define PTAB_OFF (LDS_BYTES - 1024)
extern __shared__ __attribute__((aligned(16))) float dynsmem[];
struct Ctx { const Params* kp; };
#define pin_(i) (p.kp->in[i])
#define pout_() (p.kp->out)
#define pws_() (p.kp->ws)

__device__ __forceinline__ float bf2f(bf16_t v) { return __uint_as_float(((unsigned)v) << 16); }
__device__ __forceinline__ bf16_t f2bf(float f) { unsigned u = __float_as_uint(f); u += 0x7FFFu + ((u >> 16) & 1u); return (bf16_t)(u >> 16); }
__device__ __forceinline__ unsigned pk_bf16(float lo, float hi) { return (unsigned)f2bf(lo) | ((unsigned)f2bf(hi) << 16); }
__device__ __forceinline__ float wave_sum(float v) {
#pragma unroll
    for (int o = 32; o >= 1; o >>= 1) v += __shfl_xor(v, o, 64);
    return v;
}
__device__ __forceinline__ float wave_max(float v) {
#pragma unroll
    for (int o = 32; o >= 1; o >>= 1) v = fmaxf(v, __shfl_xor(v, o, 64));
    return v;
}
__device__ __forceinline__ float silu_f(float x) { return x * __builtin_amdgcn_rcpf(1.f + __expf(-x)); }
__device__ __forceinline__ float sigmoid_f(float x) { return __builtin_amdgcn_rcpf(1.f + __expf(-x)); }
__device__ __forceinline__ float softplus_f(float x) { return x > 20.f ? x : log1pf(__expf(x)); }
__device__ __forceinline__ float logsigmoid_f(float x) { return -softplus_f(-x); }
__device__ __forceinline__ float gelu_tanh_f(float x) { const float u = 0.7978845608028654f * (x + 0.044715f * x * x * x); return 0.5f * x * (1.f + tanhf(u)); }
__device__ __forceinline__ unsigned ford(float f) { f = f + 0.0f; unsigned u = __float_as_uint(f); return (u & 0x80000000u) ? ~u : (u | 0x80000000u); }
__device__ __forceinline__ float funord(unsigned k) { unsigned u = (k & 0x80000000u) ? (k & 0x7fffffffu) : ~k; return __uint_as_float(u); }
__device__ __forceinline__ unsigned long long wave_max_u64(unsigned long long v) {
#pragma unroll
    for (int o = 32; o >= 1; o >>= 1) {
        unsigned lo = __shfl_xor((unsigned)v, o, 64), hi = __shfl_xor((unsigned)(v >> 32), o, 64);
        unsigned long long w = ((unsigned long long)hi << 32) | lo;
        v = w > v ? w : v;
    }
    return v;
}
__device__ __forceinline__ int tid_() { int t = threadIdx.x; asm volatile("" : "+v"(t)); return t; }
__device__ __forceinline__ int bid_() { int b = blockIdx.x; asm volatile("" : "+s"(b)); return b; }
__device__ __forceinline__ int nblk_() { int g = gridDim.x; asm volatile("" : "+s"(g)); return g; }
__device__ __forceinline__ int gwave() { return (bid_() * 512 + tid_()) >> 6; }
__device__ __forceinline__ int nwaves() { return nblk_() * 8; }

namespace pg8 {
#define PG8_LAS __attribute__((address_space(3)))
typedef unsigned short bf16_t;
typedef short bf16x8 __attribute__((ext_vector_type(8)));
typedef float f32x4 __attribute__((ext_vector_type(4)));
typedef unsigned u32x4 __attribute__((ext_vector_type(4)));
constexpr int BM = 256, BK = 64, HALF = 128, HTB = HALF * BK * 2  , STAGE_BYTES = 8 * HTB, NXCD = 8, WGM = 8;

__host__ __device__ __forceinline__ int lds_byte(int r, int c) { const int st = (r >> 4) * 2 + (c >> 5), rr = r & 15, cc = c & 31, ob = rr * 64 + cc * 2; return st * 1024 + (ob ^ (((ob >> 9) & 1) << 5)); }
__host__ __device__ __forceinline__ void stage_rc(int b, int& R, int& C) { const int st = b / 1024, sb = b % 1024, swz = sb ^ (((sb >> 9) & 1) << 5); R = (st >> 1) * 16 + swz / 64; C = (st & 1) * 32 + (swz % 64) / 2; }
__host__ __device__ __forceinline__ int perm32(int rho) { const int n = rho >> 4, i = rho & 15; return 8 * (i >> 2) + 4 * n + (i & 3); }

struct Unit { int pm, pn; };
struct Gemm { const bf16_t* A; const bf16_t* Bt; int M, N, K; };

struct StaticOrder {
    int nM, nN, nwg, G, c;
    __host__ __device__ void init(int M, int N, int G_, int c_) { nM = M / BM; nN = N / BM; nwg = nM * nN; G = G_; c = c_; }
    __host__ __device__ bool next(int i, Unit& u) const {
        const long L = (long)i * G + c; if (L >= nwg) return false;
        int wgid = (int)L; { const int q = nwg / NXCD, r = nwg % NXCD, xcd = wgid % NXCD, off = wgid / NXCD; wgid = (xcd < r ? xcd * (q + 1) : r * (q + 1) + (xcd - r) * q) + off; }
        const int nig = WGM * nN, gid = wgid / nig, fm = gid * WGM, gsz = (nM - fm) < WGM ? (nM - fm) : WGM;
        u.pm = fm + ((wgid % nig) % gsz); u.pn = (wgid % nig) / gsz; return true;
    }
    __device__ __forceinline__ void a_ready(const Unit&) const {}
    __device__ __forceinline__ void done(const Unit&) const {}
};

__device__ __forceinline__ unsigned cvt_pk_bf16(float lo, float hi) { unsigned r; asm volatile("v_cvt_pk_bf16_f32 %0, %1, %2" : "=v"(r) : "v"(lo), "v"(hi)); return r; }
struct EpiF32 {
    static constexpr bool PERM = false, AFTER_DRAIN = false;
    float* C; const float* R; int ldc;
    __device__ __forceinline__ void operator()(const f32x4 (&acc)[2][2][4][2], const Unit& u, int wr, int wc, int fr, int fq) const {
        const int row0 = u.pm * BM + wr * 64 + fr, col0 = u.pn * BM + wc * 32 + 4 * fq;
#pragma unroll
        for (int ai = 0; ai < 2; ++ai)
#pragma unroll
            for (int m = 0; m < 4; ++m) { const size_t off = (size_t)(row0 + ai * HALF + m * 16) * ldc + col0;
                f32x4 rv[2][2];
#pragma unroll
                for (int bj = 0; bj < 2; ++bj)
#pragma unroll
                    for (int n = 0; n < 2; ++n) rv[bj][n] = R ? *(const f32x4*)(R + off + bj * HALF + n * 16) : (f32x4){0.f, 0.f, 0.f, 0.f};
#pragma unroll
                for (int bj = 0; bj < 2; ++bj)
#pragma unroll
                    for (int n = 0; n < 2; ++n) *(f32x4*)(C + off + bj * HALF + n * 16) = acc[ai][bj][m][n] + rv[bj][n]; }
    }
};
struct EpiBf16 {
    static constexpr bool PERM = true, AFTER_DRAIN = false;
    bf16_t* O; int ldc;
    __device__ __forceinline__ void operator()(const f32x4 (&acc)[2][2][4][2], const Unit& u, int wr, int wc, int fr, int fq) const {
        const int row0 = u.pm * BM + wr * 64 + fr, col0 = u.pn * BM + wc * 32 + 8 * fq;
#pragma unroll
        for (int ai = 0; ai < 2; ++ai)
#pragma unroll
            for (int m = 0; m < 4; ++m) { bf16_t* rowp = O + (size_t)(row0 + ai * HALF + m * 16) * ldc + col0;
#pragma unroll
                for (int bj = 0; bj < 2; ++bj) { const f32x4 v0 = acc[ai][bj][m][0], v1 = acc[ai][bj][m][1];
                    u32x4 w; w.x = cvt_pk_bf16(v0[0], v0[1]); w.y = cvt_pk_bf16(v0[2], v0[3]); w.z = cvt_pk_bf16(v1[0], v1[1]); w.w = cvt_pk_bf16(v1[2], v1[3]);
                    *(u32x4*)(rowp + bj * HALF) = w; } }
    }
};

template <class Epi, class Sched, bool STAMP = false>
__device__ __forceinline__ void gemm_phase(PG8_LAS unsigned char* lds, const Gemm g, const Sched& S, const Epi& E, unsigned long long* stamps, const int tid) {
    const int wid = __builtin_amdgcn_readfirstlane(tid >> 6), lane = tid & 63, wr = wid >> 2, wc = wid & 3, fr = lane & 15, fq = lane >> 4;
    const int K = g.K, nt = K / BK;
    int ts_lo = 0, ts_hi = 0, nts = 0; const unsigned long long rt_entry = STAMP ? (unsigned long long)wall_clock64() : 0ull;
#define PG8_STAMP() do { if (STAMP && wid == 0 && nts < 64) { const unsigned long long _c = (unsigned long long)clock64(); \
        ts_lo = (lane == nts) ? (int)(unsigned)_c : ts_lo; ts_hi = (lane == nts) ? (int)(unsigned)(_c >> 32) : ts_hi; ++nts; } } while (0)
    PG8_STAMP();
    unsigned voffA[2], voffB[2];
#pragma unroll
    for (int i = 0; i < 2; ++i) { int R, C; stage_rc(tid * 16 + i * 8192, R, C); const int Rb = Epi::PERM ? ((R & ~31) + perm32(R & 31)) : R;
        voffA[i] = (unsigned)(R * K + C) * 2u; voffB[i] = (unsigned)(Rb * K + C) * 2u; }
    const size_t kstep = (size_t)(BK * 2);
    const size_t hstep = (size_t)HALF * K * 2;
    const size_t tstep = 2 * hstep;
    const unsigned ldsw = (unsigned)wid * 1024u;
    const int aoff = lds_byte(wr * 64 + fr, fq * 8), boff = lds_byte(wc * 32 + fr, fq * 8);
#define PG8_SA(b, h) (((b) * 2 + (h)) * HTB)
#define PG8_SB(b, h) ((4 + (b) * 2 + (h)) * HTB)
#define PG8_STAGE(bufoff, gbase, voff) do { _Pragma("unroll") for (int _i = 0; _i < 2; ++_i) \
        __builtin_amdgcn_global_load_lds((const unsigned*)((const char*)(gbase) + (voff)[_i]), (PG8_LAS unsigned*)(lds + (bufoff) + ldsw + _i * 8192), 16, 0, 0); } while (0)
#define PG8_LDA(dst, b, h) do { _Pragma("unroll") for (int m = 0; m < 4; ++m) _Pragma("unroll") for (int k = 0; k < 2; ++k) dst[m][k] = *(const PG8_LAS bf16x8*)(lds + PG8_SA(b, h) + aoff + m * 2048 + k * 1024); } while (0)
#define PG8_LDB(dst, b, h) do { _Pragma("unroll") for (int n = 0; n < 2; ++n) _Pragma("unroll") for (int k = 0; k < 2; ++k) dst[n][k] = *(const PG8_LAS bf16x8*)(lds + PG8_SB(b, h) + boff + n * 2048 + k * 1024); } while (0)
#define PG8_MMA(ai, bj, At, Bt) do { __builtin_amdgcn_s_setprio(1); _Pragma("unroll") for (int m = 0; m < 4; ++m) _Pragma("unroll") for (int n = 0; n < 2; ++n) _Pragma("unroll") for (int k = 0; k < 2; ++k) \
        acc[ai][bj][m][n] = __builtin_amdgcn_mfma_f32_16x16x32_bf16(Bt[n][k], At[m][k], acc[ai][bj][m][n], 0, 0, 0); __builtin_amdgcn_s_setprio(0); } while (0)
#define PG8_WAIT_V(n) asm volatile("s_waitcnt vmcnt(" #n ")" ::: "memory")
#define PG8_WAIT_L(n) asm volatile("s_waitcnt lgkmcnt(" #n ")" ::: "memory")
#define PG8_BAR __builtin_amdgcn_s_barrier()
#define PG8_SCHED __builtin_amdgcn_sched_barrier(0)
    Unit cur, nxt; int ui = 0;
    if (!S.next(0, cur)) return;
    f32x4 acc[2][2][4][2];
#pragma unroll
    for (int a = 0; a < 2; ++a)
#pragma unroll
        for (int b = 0; b < 2; ++b)
#pragma unroll
            for (int m = 0; m < 4; ++m)
#pragma unroll
                for (int n = 0; n < 2; ++n) acc[a][b][m][n] = (f32x4){0.f, 0.f, 0.f, 0.f};
    bf16x8 At[4][2], B0[2][2], B1[2][2];
    const char* cA = (const char*)g.A + (size_t)cur.pm * tstep; const char* cB = (const char*)g.Bt + (size_t)cur.pn * tstep;
    S.a_ready(cur);
    PG8_STAGE(PG8_SB(0, 0), cB, voffB); PG8_STAGE(PG8_SA(0, 0), cA, voffA); PG8_STAGE(PG8_SB(0, 1), cB + hstep, voffB); PG8_STAGE(PG8_SA(0, 1), cA + hstep, voffA);
    if (wr == 1) PG8_BAR;
    PG8_WAIT_V(4); PG8_BAR;
    PG8_STAGE(PG8_SB(1, 0), cB + kstep, voffB); PG8_STAGE(PG8_SA(1, 0), cA + kstep, voffA); PG8_STAGE(PG8_SB(1, 1), cB + hstep + kstep, voffB);
    PG8_WAIT_V(6); PG8_BAR;
    PG8_STAMP();
    for (;;) {
        const bool has_next = S.next(ui + 1, nxt);
        const char* nA = has_next ? (const char*)g.A + (size_t)nxt.pm * tstep : cA; const char* nB = has_next ? (const char*)g.Bt + (size_t)nxt.pn * tstep : cB;
        for (int t = 0; t < nt; t += 2) {
            const bool last = (t == nt - 2);
            const char* a1 = cA + (size_t)(t + 1) * kstep;
            const char* a2 = last ? nA : cA + (size_t)(t + 2) * kstep; const char* b2 = last ? nB : cB + (size_t)(t + 2) * kstep;
            const char* a3 = a2 + kstep; const char* b3 = b2 + kstep;
            if (last && has_next) S.a_ready(nxt);
            PG8_LDB(B0, 0, 0); PG8_SCHED; PG8_LDA(At, 0, 0); PG8_STAGE(PG8_SA(1, 1), a1 + hstep, voffA);
            PG8_WAIT_L(8); PG8_BAR; PG8_WAIT_L(0); PG8_MMA(0, 0, At, B0); PG8_BAR; PG8_SCHED;
            PG8_LDB(B1, 0, 1); PG8_STAGE(PG8_SB(0, 0), b2, voffB);
            PG8_BAR; PG8_WAIT_L(0); PG8_MMA(0, 1, At, B1); PG8_BAR;
            PG8_LDA(At, 0, 1); PG8_STAGE(PG8_SA(0, 0), a2, voffA);
            PG8_BAR; PG8_WAIT_L(0); PG8_MMA(1, 0, At, B0); PG8_BAR; PG8_SCHED;
            PG8_STAGE(PG8_SB(0, 1), b2 + hstep, voffB);
            PG8_WAIT_V(6); PG8_BAR; PG8_MMA(1, 1, At, B1); PG8_BAR;
            PG8_LDB(B0, 1, 0); PG8_SCHED; PG8_LDA(At, 1, 0); PG8_STAGE(PG8_SA(0, 1), a2 + hstep, voffA);
            PG8_WAIT_L(8); PG8_BAR; PG8_WAIT_L(0); PG8_MMA(0, 0, At, B0); PG8_BAR; PG8_SCHED;
            PG8_LDB(B1, 1, 1); PG8_STAGE(PG8_SB(1, 0), b3, voffB);
            PG8_BAR; PG8_WAIT_L(0); PG8_MMA(0, 1, At, B1); PG8_BAR;
            PG8_LDA(At, 1, 1); PG8_STAGE(PG8_SA(1, 0), a3, voffA);
            PG8_BAR; PG8_WAIT_L(0); PG8_MMA(1, 0, At, B0); PG8_BAR; PG8_SCHED;
            PG8_STAGE(PG8_SB(1, 1), b3 + hstep, voffB);
            PG8_WAIT_V(6); PG8_BAR; PG8_MMA(1, 1, At, B1); PG8_BAR;
        }
        PG8_STAMP();
        if constexpr (!Epi::AFTER_DRAIN) { E(acc, cur, wr, wc, fr, fq); S.done(cur); }
        PG8_STAMP();
        if (!has_next) break;
#pragma unroll
        for (int a = 0; a < 2; ++a)
#pragma unroll
            for (int b = 0; b < 2; ++b)
#pragma unroll
                for (int m = 0; m < 4; ++m)
#pragma unroll
                    for (int n = 0; n < 2; ++n) acc[a][b][m][n] = (f32x4){0.f, 0.f, 0.f, 0.f};
        cur = nxt; cA = nA; cB = nB; ++ui;
    }
    PG8_WAIT_V(0);
    if (wr == 0) PG8_BAR;
    PG8_BAR;
    if constexpr (Epi::AFTER_DRAIN) { E.fused(acc, cur, wr, wc, fr, fq, lds, wid, lane); S.done(cur); }
    PG8_STAMP();
    if (STAMP && wid == 0) { stamps[lane] = lane < nts ? (((unsigned long long)(unsigned)ts_hi << 32) | (unsigned)ts_lo) : 0ull;
        if (lane == 62) stamps[62] = rt_entry; if (lane == 63) stamps[63] = (unsigned long long)wall_clock64(); }
#undef PG8_STAMP
#undef PG8_SA
#undef PG8_SB
#undef PG8_STAGE
#undef PG8_LDA
#undef PG8_LDB
#undef PG8_MMA
#undef PG8_WAIT_V
#undef PG8_WAIT_L
#undef PG8_BAR
#undef PG8_SCHED
}
}

namespace pg8 {
struct PanelOrder {
    int pm, nN;
    __device__ void init(int pm_, int N) { pm = pm_; nN = N / BM; }
    __device__ bool next(int i, Unit& u) const { if (i >= nN) return false; u.pm = pm; u.pn = i; return true; }
    __device__ __forceinline__ void a_ready(const Unit&) const {}
    __device__ __forceinline__ void done(const Unit&) const {}
};
}
template <class Epi> __device__ __forceinline__ void ph_gemm_panel(const bf16_t* A, const bf16_t* Bt, int M, int N, int K, const Epi& E, int pm) {
    pg8::Gemm g; g.A = A; g.Bt = Bt; g.M = M; g.N = N; g.K = K;
    pg8::PanelOrder S; S.init(pm, N);
    pg8::gemm_phase<Epi, pg8::PanelOrder, false>((PG8_LAS unsigned char*)dynsmem, g, S, E, nullptr, tid_());
}
template <class Epi> __device__ __forceinline__ void ph_gemm(const bf16_t* A, const bf16_t* Bt, int M, int N, int K, const Epi& E, int crot = 0) {
    pg8::Gemm g; g.A = A; g.Bt = Bt; g.M = M; g.N = N; g.K = K;
    const int nb_ = nblk_();
    pg8::StaticOrder S; S.init(M, N, nb_, (bid_() + nb_ - crot) % nb_);
    pg8::gemm_phase<Epi, pg8::StaticOrder, false>((PG8_LAS unsigned char*)dynsmem, g, S, E, nullptr, tid_());
}

__device__ __forceinline__ int pcol_to_orig(int c) {
    if (c < 768) return c;
    if (c < 1536) return c - 768 + 772;
    if (c < 1792) return c - 1536 + 1548;
    if (c < 1920) return c - 1792 + 1804;
    if (c < 2048) return c - 1920 + 1932;
    if (c < 2304) return c - 2048 + 2060;
    if (c < 2560) return c - 2304 + 2332;
    if (c < 2816) return c - 2560 + 2588;
    if (c < 2880) return c - 2816 + 2844;
    if (c < 2944) return c - 2880 + 2908;
    if (c < 3200) return c - 2944 + 2972;
    if (c < 3232) return c - 3200 + 3228;
    if (c < 3248) return c - 3232 + 2316;
    if (c < 3256) return c - 3248 + 3260;
    if (c < 3260) return c - 3256 + 768;
    if (c < 3264) return c - 3260 + 1540;
    if (c < 3268) return c - 3264 + 1544;
    return -1;
}
__device__ __forceinline__ void wtrans_job(const float* W, int K, int ldw, bf16_t* Wt, int Npad, bool mapped, float* tile) {
    const int tid = tid_();
    const int tn = Npad / 64, tk = K / 64;
    for (int t = bid_(); t < tn * tk; t += nblk_()) {
        const int n0 = (t / tk) * 64, k0 = (t % tk) * 64;
        __syncthreads();
        for (int idx = tid; idx < 4096; idx += 512) {
            const int kk = idx >> 6, nn = idx & 63;
            const int col = mapped ? pcol_to_orig(n0 + nn) : (n0 + nn);
            tile[kk * 65 + nn] = col >= 0 ? W[(size_t)(k0 + kk) * ldw + col] : 0.f;
        }
        __syncthreads();
        for (int idx = tid; idx < 4096; idx += 512) {
            const int nn = idx >> 6, kk = idx & 63;
            Wt[(size_t)(n0 + nn) * K + k0 + kk] = f2bf(tile[kk * 65 + nn]);
        }
    }
}
__device__ __forceinline__ void ph_weight_prep(const Ctx& p, float* sm) {
#pragma unroll 1
    for (int j = 0; j < 7 * DEPTH; ++j) {
        const int l = j / 7, w = j % 7;
        const float* W; int K, ldw, Npad; bf16_t* Wt; bool mapped = false;
        if (w == 0) { W = pin_(3) + (size_t)l * DM * 3268; K = DM; ldw = 3268; Npad = LDP; Wt = (bf16_t*)(pws_() + WT_IN) + (size_t)l * LDP * DM; mapped = true; }
        else if (w == 1) { W = pin_(20) + (size_t)l * DM * DM; K = DM; ldw = DM; Npad = DM; Wt = (bf16_t*)(pws_() + WT_OUT) + (size_t)l * DM * DM; }
        else if (w == 2) { W = pin_(23) + (size_t)l * DM * 256; K = DM; ldw = 256; Npad = 256; Wt = (bf16_t*)(pws_() + WT_XQ) + (size_t)l * 256 * DM; }
        else if (w == 3) { W = pin_(24) + (size_t)l * DM * 256; K = DM; ldw = 256; Npad = 256; Wt = (bf16_t*)(pws_() + WT_XK) + (size_t)l * 256 * DM; }
        else if (w == 4) { W = pin_(25) + (size_t)l * DM * 256; K = DM; ldw = 256; Npad = 256; Wt = (bf16_t*)(pws_() + WT_XV) + (size_t)l * 256 * DM; }
        else if (w == 5) { W = pin_(26) + (size_t)l * 256 * DM; K = 256; ldw = DM; Npad = DM; Wt = (bf16_t*)(pws_() + WT_XO) + (size_t)l * DM * 256; }
        else { W = pin_(30) + (size_t)l * DM * DM; K = DM; ldw = DM; Npad = DM; Wt = (bf16_t*)(pws_() + WT_PQ) + (size_t)l * DM * DM; }
        wtrans_job(W, K, ldw, Wt, Npad, mapped, sm);
    }
}

#define H8_SCALE 16.f
__device__ __forceinline__ unsigned pack4_fp8(float4 a, float sc);
__device__ __forceinline__ void ph_rmsnorm(const float* __restrict__ x, const float* __restrict__ g, bf16_t* __restrict__ out, int rows, int row0 = 0, int w0 = -1, int wstep = 0, unsigned char* out8 = nullptr) {
    const int lane = tid_() & 63;
    if (w0 < 0) { w0 = gwave(); wstep = nwaves(); }
    float4 gq[4];
#pragma unroll
    for (int i = 0; i < 4; ++i) gq[i] = ((const float4*)g)[lane + 64 * i];
    for (int r = row0 + w0; r < row0 + rows; r += wstep) {
        const float4* xr = (const float4*)(x + (size_t)r * DM);
        float4 v[4]; float ss = 0.f;
#pragma unroll
        for (int i = 0; i < 4; ++i) { v[i] = xr[lane + 64 * i]; ss += v[i].x * v[i].x + v[i].y * v[i].y + v[i].z * v[i].z + v[i].w * v[i].w; }
        ss = wave_sum(ss);
        const float rs = rsqrtf(ss * (1.f / DM) + EPS);
#pragma unroll
        for (int i = 0; i < 4; ++i) {
            const float4 gg = gq[i];
            ushort4 o; o.x = f2bf(v[i].x * rs * gg.x); o.y = f2bf(v[i].y * rs * gg.y); o.z = f2bf(v[i].z * rs * gg.z); o.w = f2bf(v[i].w * rs * gg.w);
            *(ushort4*)(out + (size_t)r * DM + (size_t)(lane + 64 * i) * 4) = o;
            if (out8) *(unsigned*)(out8 + (size_t)r * DM + (size_t)(lane + 64 * i) * 4) = pack4_fp8(make_float4(v[i].x * rs * gg.x, v[i].y * rs * gg.y, v[i].z * rs * gg.z, v[i].w * rs * gg.w), H8_SCALE);
        }
    }
}

template <int OUTMODE>
__device__ __forceinline__ void ph_sgemm(const bf16_t* __restrict__ A, int lda, const float* __restrict__ B, int ldb, void* Cv, int ldc, const float* R, int ldr,
                         int M, int N, int K, float* smem) {
    float* As = smem;
    float* Bs = smem + 16 * 132;
    const int tid = tid_(), tx = tid & 31, ty = tid >> 5;
    const int ntn = N / 128, ntiles = (M / 128) * ntn;
    for (int tile = bid_(); tile < ntiles; tile += nblk_()) {
        const int tm = tile / ntn, tn = tile % ntn;
        float acc[8][4];
#pragma unroll
        for (int i = 0; i < 8; ++i)
#pragma unroll
            for (int j = 0; j < 4; ++j) acc[i][j] = 0.f;
        const int arow = tid >> 2, akq = (tid & 3) * 4;
        const int bk = tid >> 5, bn = (tid & 31) * 4;
        for (int k0 = 0; k0 < K; k0 += 16) {
            const ushort4 av = *(const ushort4*)(A + (size_t)(tm * 128 + arow) * lda + k0 + akq);
            const float4 bv = *(const float4*)(B + (size_t)(k0 + bk) * ldb + tn * 128 + bn);
            __syncthreads();
            As[(akq + 0) * 132 + arow] = bf2f(av.x); As[(akq + 1) * 132 + arow] = bf2f(av.y);
            As[(akq + 2) * 132 + arow] = bf2f(av.z); As[(akq + 3) * 132 + arow] = bf2f(av.w);
            *(float4*)(Bs + bk * 132 + bn) = bv;
            __syncthreads();
#pragma unroll
            for (int k = 0; k < 16; ++k) {
                const float4 a0 = *(const float4*)(As + k * 132 + ty * 8), a1 = *(const float4*)(As + k * 132 + ty * 8 + 4);
                const float4 b = *(const float4*)(Bs + k * 132 + tx * 4);
                const float a[8] = {a0.x, a0.y, a0.z, a0.w, a1.x, a1.y, a1.z, a1.w};
#pragma unroll
                for (int i = 0; i < 8; ++i) { acc[i][0] += a[i] * b.x; acc[i][1] += a[i] * b.y; acc[i][2] += a[i] * b.z; acc[i][3] += a[i] * b.w; }
            }
        }
#pragma unroll
        for (int i = 0; i < 8; ++i) {
            const size_t row = (size_t)tm * 128 + ty * 8 + i; const int col = tn * 128 + tx * 4;
            if (OUTMODE == 0) {
                ushort4 o; o.x = f2bf(acc[i][0]); o.y = f2bf(acc[i][1]); o.z = f2bf(acc[i][2]); o.w = f2bf(acc[i][3]);
                *(ushort4*)((bf16_t*)Cv + row * ldc + col) = o;
            } else if (OUTMODE == 1) {
                *(float4*)((float*)Cv + row * ldc + col) = make_float4(acc[i][0], acc[i][1], acc[i][2], acc[i][3]);
            } else {
                const float4 r = *(const float4*)(R + row * ldr + col);
                *(float4*)((float*)Cv + row * ldc + col) = make_float4(r.x + acc[i][0], r.y + acc[i][1], r.z + acc[i][2], r.w + acc[i][3]);
            }
        }
    }
}

#define WS_HS WS_H
#define WS_VG WS_YPRE
#define WS_DEC (WS_YPRE + (size_t)MTOK * 256 * 2)

__device__ __forceinline__ float quad_sum(float v) {
    v += __int_as_float(__builtin_amdgcn_mov_dpp(__float_as_int(v), 0xB1, 0xF, 0xF, true));
    v += __int_as_float(__builtin_amdgcn_mov_dpp(__float_as_int(v), 0x4E, 0xF, 0xF, true));
    return v;
}
__device__ __forceinline__ float bflo(unsigned w) { return __uint_as_float(w << 16); }
__device__ __forceinline__ float bfhi(unsigned w) { return __uint_as_float(w & 0xffff0000u); }

__device__ __forceinline__ float oct_sum(float v) {
    v += __int_as_float(__builtin_amdgcn_mov_dpp(__float_as_int(v), 0xB1, 0xF, 0xF, true));
    v += __int_as_float(__builtin_amdgcn_mov_dpp(__float_as_int(v), 0x4E, 0xF, 0xF, true));
    v += __int_as_float(__builtin_amdgcn_mov_dpp(__float_as_int(v), 0x141, 0xF, 0xF, true));
    return v;
}
__device__ __forceinline__ void unpack8(const uint4 r, float (&o)[8]) {
    o[0] = bflo(r.x); o[1] = bfhi(r.x); o[2] = bflo(r.y); o[3] = bfhi(r.y); o[4] = bflo(r.z); o[5] = bfhi(r.z); o[6] = bflo(r.w); o[7] = bfhi(r.w);
}
__device__ __forceinline__ uint4 pack8(const float (&v)[8]) {
    uint4 o; o.x = pk_bf16(v[0], v[1]); o.y = pk_bf16(v[2], v[3]); o.z = pk_bf16(v[4], v[5]); o.w = pk_bf16(v[6], v[7]); return o;
}
__device__ __forceinline__ void load8f(const float* p, float (&o)[8]) {
    const float4 a = *(const float4*)p, b = *(const float4*)(p + 4);
    o[0] = a.x; o[1] = a.y; o[2] = a.z; o[3] = a.w; o[4] = b.x; o[5] = b.y; o[6] = b.z; o[7] = b.w;
}
__device__ __forceinline__ void conv8(const bf16_t* P, size_t tok, int t, int pcol, const float* w, int ldw, int cc, float (&acc)[8]) {
#pragma unroll
    for (int j = 0; j < 4; ++j) {
        if (t - 3 + j >= 0) {
            float xv[8], wv[8];
            unpack8(*(const uint4*)(P + (tok - (size_t)(3 - j)) * LDP + pcol), xv);
            load8f(w + j * ldw + cc, wv);
#pragma unroll
            for (int i = 0; i < 8; ++i) acc[i] = __builtin_fmaf(wv[i], xv[i], acc[i]);
        }
    }
}
__device__ __forceinline__ void conv8r(const uint4 (&xt)[4], int t, const float* w, int ldw, int cc, float (&acc)[8]) {
#pragma unroll
    for (int j = 0; j < 4; ++j) {
        float xv[8], wv[8];
        unpack8(xt[j], xv);
        load8f(w + j * ldw + cc, wv);
        const float m = (t - 3 + j >= 0) ? 1.f : 0.f;
#pragma unroll
        for (int i = 0; i < 8; ++i) acc[i] = __builtin_fmaf(wv[i] * m, xv[i], acc[i]);
    }
}
__device__ __forceinline__ void conv8w(const uint4 (&xt)[4], int t, const float (&wv)[4][8], float (&acc)[8]) {
#pragma unroll
    for (int j = 0; j < 4; ++j) {
        float xv[8];
        unpack8(xt[j], xv);
        const float m = (t - 3 + j >= 0) ? 1.f : 0.f;
#pragma unroll
        for (int i = 0; i < 8; ++i) acc[i] = __builtin_fmaf(wv[j][i] * m, xv[i], acc[i]);
    }
}
__device__ __forceinline__ void ph_scan_prep(const Ctx& p, int l) {
    const bf16_t* P = (const bf16_t*)(pws_() + WS_P);
    bf16_t* HS = (bf16_t*)(pws_() + WS_HS);
    bf16_t* VG = (bf16_t*)(pws_() + WS_VG);
    float* DEC = (float*)(pws_() + WS_DEC);
    float* SC = (float*)(pws_() + WS_SC);
    const float* scw = pin_(4) + (size_t)l * 4 * 512;
    const float* scb = pin_(5) + (size_t)l * 512;
    const float* gcw = pin_(10) + (size_t)l * 4 * 768;
    const float* wg = pin_(14) + (size_t)l * 16 * 128;
    const float* bg = pin_(15) + (size_t)l * 128;
    const int lane = tid_() & 63;
    const int hsc = lane & 3, wsc = (lane >> 2) & 3;
    const float k_dtb = pin_(6)[l * 4 + hsc], k_alog = __expf(pin_(7)[l * 4 + hsc]), k_galog = __expf(pin_(11)[l * 4 + hsc]), k_gdtb = pin_(12)[l * 4 + hsc];
    const int sccol = wsc < 2 ? PC_DT + hsc : (wsc == 2 ? PC_GA + hsc : PC_GB + hsc);
    const int nw = nwaves();
    {
        uint4 nxa[4], ngl0, ngl1; unsigned short nsc;
#define SP_LOAD(tk) do { const int t_ = (tk) % SEQ; const size_t row_ = (size_t)(tk) * LDP; \
        _Pragma("unroll") for (int j = 0; j < 4; ++j) { const size_t rj = (t_ - 3 + j >= 0) ? row_ - (size_t)(3 - j) * LDP : row_; nxa[j] = *(const uint4*)(P + rj + PC_XBC + 8 * lane); } \
        ngl0 = *(const uint4*)(P + row_ + PC_GLR); ngl1 = *(const uint4*)(P + row_ + PC_GLR + 8); nsc = P[row_ + sccol]; } while (0)
        float wsx[4][8], bsx[8], wgl[2][16], bgl[2];
#pragma unroll
        for (int j = 0; j < 4; ++j) load8f(scw + j * 512 + 8 * lane, wsx[j]);
        load8f(scb + 8 * lane, bsx);
#pragma unroll
        for (int i = 0; i < 2; ++i) { bgl[i] = bg[lane + 64 * i];
#pragma unroll
            for (int r = 0; r < 16; ++r) wgl[i][r] = wg[r * 128 + lane + 64 * i]; }
        int tok = gwave();
        SP_LOAD(tok);
        for (; tok < MTOK; tok += nw) {
            const int t = tok % SEQ;
            uint4 xa[4];
#pragma unroll
            for (int j = 0; j < 4; ++j) xa[j] = nxa[j];
            const uint4 gl0 = ngl0, gl1 = ngl1;
            const float scraw = bf2f(nsc);
            { const int tn = tok + nw < MTOK ? tok + nw : tok; SP_LOAD(tn); }
            __builtin_amdgcn_sched_barrier(0);
            {
                float acc[8];
#pragma unroll
                for (int i = 0; i < 8; ++i) acc[i] = bsx[i];
                conv8w(xa, t, wsx, acc);
#pragma unroll
                for (int i = 0; i < 8; ++i) acc[i] = silu_f(acc[i]);
                *(uint4*)(HS + (size_t)tok * 1024 + 8 * lane) = pack8(acc);
            }
            {
                float v;
                if (wsc < 2) { const float dt = softplus_f(scraw + k_dtb); v = wsc == 0 ? dt : __expf(-dt * k_alog); }
                else if (wsc == 2) v = __expf(-k_galog * softplus_f(scraw + k_gdtb));
                else v = sigmoid_f(scraw);
                if (lane < 16) SC[(size_t)tok * 16 + lane] = v;
            }
            {
                float gl[16];
                { float a8[8], b8[8]; unpack8(gl0, a8); unpack8(gl1, b8);
#pragma unroll
                  for (int i = 0; i < 8; ++i) { gl[i] = a8[i]; gl[8 + i] = b8[i]; } }
#pragma unroll
                for (int i = 0; i < 2; ++i) {
                    const int c = lane + 64 * i;
                    float acc = bgl[i];
#pragma unroll
                    for (int r = 0; r < 16; ++r) acc = __builtin_fmaf(gl[r], wgl[i][r], acc);
                    DEC[(size_t)tok * 128 + c] = __expf(logsigmoid_f(acc) * (1.f / 16.f));
                }
            }
        }
#undef SP_LOAD
    }
    {
        uint4 nxq[4], nxv4[4];
#define SP_LOAD(tk) do { const int t_ = (tk) % SEQ; const size_t row_ = (size_t)(tk) * LDP; \
        _Pragma("unroll") for (int j = 0; j < 4; ++j) { const size_t rj = (t_ - 3 + j >= 0) ? row_ - (size_t)(3 - j) * LDP : row_; \
            nxq[j] = *(const uint4*)(P + rj + PC_GQKV + 8 * lane); nxv4[j] = *(const uint4*)(P + rj + PC_GQKV + 512 + 8 * (lane & 31)); } } while (0)
        float wq[4][8], wv[4][8];
#pragma unroll
        for (int j = 0; j < 4; ++j) { load8f(gcw + j * 768 + 8 * lane, wq[j]); load8f(gcw + j * 768 + 512 + 8 * (lane & 31), wv[j]); }
        int tok = gwave();
        SP_LOAD(tok);
        for (; tok < MTOK; tok += nw) {
            const int t = tok % SEQ;
            uint4 xq[4], xv4[4];
#pragma unroll
            for (int j = 0; j < 4; ++j) { xq[j] = nxq[j]; xv4[j] = nxv4[j]; }
            { const int tn = tok + nw < MTOK ? tok + nw : tok; SP_LOAD(tn); }
            __builtin_amdgcn_sched_barrier(0);
            {
                float acc[8];
#pragma unroll
                for (int i = 0; i < 8; ++i) acc[i] = 0.f;
                conv8w(xq, t, wq, acc);
                float ss = 0.f;
#pragma unroll
                for (int i = 0; i < 8; ++i) { acc[i] = silu_f(acc[i]); ss += acc[i] * acc[i]; }
                ss = oct_sum(ss);
                const float sc = rsqrtf(ss + EPS) * (lane < 32 ? 0.125f : 1.f);
#pragma unroll
                for (int i = 0; i < 8; ++i) acc[i] *= sc;
                *(uint4*)(HS + (size_t)tok * 1024 + 512 + 8 * lane) = pack8(acc);
            }
            {
                float acc[8];
#pragma unroll
                for (int i = 0; i < 8; ++i) acc[i] = 0.f;
                conv8w(xv4, t, wv, acc);
#pragma unroll
                for (int i = 0; i < 8; ++i) acc[i] = silu_f(acc[i]);
                if (lane < 32) *(uint4*)(VG + (size_t)tok * 256 + 8 * lane) = pack8(acc);
            }
        }
#undef SP_LOAD
    }
}

#define SCAN_LDS_WAVE 4608
typedef float f2_t __attribute__((ext_vector_type(2)));
__device__ __forceinline__ f2_t mk2(float a, float b) { f2_t r; r.x = a; r.y = b; return r; }
__device__ __forceinline__ void st8f(char* dst, const uint4 v) {
    *(float4*)dst = make_float4(bflo(v.x), bfhi(v.x), bflo(v.y), bfhi(v.y));
    *(float4*)(dst + 16) = make_float4(bflo(v.z), bfhi(v.z), bflo(v.w), bfhi(v.w));
}
__device__ __forceinline__ void ph_scans(const Ctx& p, int l, float* smem) {
    const bf16_t* P = (const bf16_t*)(pws_() + WS_P);
    const bf16_t* HS = (const bf16_t*)(pws_() + WS_HS);
    const bf16_t* VG = (const bf16_t*)(pws_() + WS_VG);
    const float* DEC = (const float*)(pws_() + WS_DEC);
    const float* SC = (const float*)(pws_() + WS_SC);
    bf16_t* Y = (bf16_t*)(pws_() + WS_Y);
    const int tid = tid_(), lane = tid & 63, wave = tid >> 6;
    if (nblk_() != 256) return;
    const int role = wave < 2 ? 0 : (wave < 6 ? 1 : 2);
    const int idx = (role == 0 ? wave : (role == 1 ? wave - 2 : wave - 6)) * 256 + bid_();
    const int bh = role == 1 ? (idx >> 3) : (idx >> 2), b = bh >> 2, h = bh & 3;
    const int colbase = role == 1 ? (idx & 7) * 8 : (idx & 3) * 16;
    const int cl = role == 1 ? (lane >> 3) : (lane >> 2);
    const int col = colbase + cl;
    const int sq = role == 1 ? (lane & 7) : (lane & 3);
    const size_t tb = (size_t)b * SEQ;
    bf16_t* dummy = (bf16_t*)(pws_() + WS_DUMMY) + (tid & 511) * 8;
    char* lw = (char*)smem + wave * SCAN_LDS_WAVE;
    char* lrow = lw;
    char* lcol = lw + 4096;
    float* lsc = (float*)(lw + 4352);
    const int fs = lane >> 3, fp = lane & 7;
    if (role == 0) {
        const int g = h >> 1;
        const float Dh = pin_(8)[l * 4 + h];
        uint4 f0, f1; unsigned fc = 0u; float fsc = 0.f;
        f2_t st[8];
#pragma unroll
        for (int i = 0; i < 8; ++i) st[i] = mk2(0.f, 0.f);
        auto fetch = [&](int t0) {
            const size_t tok = tb + t0 + fs;
            const bf16_t* src = HS + tok * 1024 + (fp < 4 ? 256 + g * 64 + fp * 16 : 384 + g * 64 + (fp - 4) * 16);
            f0 = *(const uint4*)src; f1 = *(const uint4*)(src + 8);
            fc = *(const unsigned*)(HS + tok * 1024 + h * 64 + colbase + fp * 2);
            if (lane < 16) fsc = SC[(tb + t0 + (lane >> 1)) * 16 + (lane & 1) * 4 + h];
        };
        fetch(0);
        for (int t0 = 0; t0 < SEQ; t0 += 8) {
            st8f(lrow + fs * 512 + fp * 64, f0); st8f(lrow + fs * 512 + fp * 64 + 32, f1);
            *(unsigned*)(lcol + fs * 32 + fp * 4) = fc;
            if (lane < 16) lsc[lane] = fsc;
            if (t0 + 8 < SEQ) fetch(t0 + 8);
#pragma unroll
            for (int i = 0; i < 8; ++i) {
                const char* rb = lrow + i * 512 + sq * 64;
                const float4 b0 = *(const float4*)rb, b1 = *(const float4*)(rb + 16), b2 = *(const float4*)(rb + 32), b3 = *(const float4*)(rb + 48);
                const float4 c0 = *(const float4*)(rb + 256), c1 = *(const float4*)(rb + 272), c2 = *(const float4*)(rb + 288), c3 = *(const float4*)(rb + 304);
                const float xv = bf2f(*(const bf16_t*)(lcol + i * 32 + cl * 2));
                const float2 sc2 = *(const float2*)(lsc + i * 2);
                const float xdt = xv * sc2.x;
                const f2_t xd2 = mk2(xdt, xdt), dA2 = mk2(sc2.y, sc2.y);
                const f2_t bb[8] = {mk2(b0.x, b0.y), mk2(b0.z, b0.w), mk2(b1.x, b1.y), mk2(b1.z, b1.w), mk2(b2.x, b2.y), mk2(b2.z, b2.w), mk2(b3.x, b3.y), mk2(b3.z, b3.w)};
                const f2_t cc[8] = {mk2(c0.x, c0.y), mk2(c0.z, c0.w), mk2(c1.x, c1.y), mk2(c1.z, c1.w), mk2(c2.x, c2.y), mk2(c2.z, c2.w), mk2(c3.x, c3.y), mk2(c3.z, c3.w)};
                f2_t ya = mk2(0.f, 0.f), yb = mk2(0.f, 0.f);
#pragma unroll
                for (int q = 0; q < 8; q += 2) {
                    st[q] = st[q] * dA2 + xd2 * bb[q]; st[q + 1] = st[q + 1] * dA2 + xd2 * bb[q + 1];
                    ya = cc[q] * st[q] + ya; yb = cc[q + 1] * st[q + 1] + yb;
                }
                const f2_t ys = ya + yb;
                const float y = quad_sum(ys.x + ys.y);
                *(sq == 0 ? Y + (tb + t0 + i) * DM + h * 64 + col : dummy + i) = f2bf(y + Dh * xv);
                if (i & 1) __builtin_amdgcn_sched_barrier(0);
            }
        }
    } else if (role == 1) {
        uint4 f0, f1; unsigned fc = 0u; float fsc = 0.f;
        f2_t S[4];
#pragma unroll
        for (int i = 0; i < 4; ++i) S[i] = mk2(0.f, 0.f);
        auto fetch = [&](int t0) {
            const size_t tok = tb + t0 + fs;
            const bf16_t* src = HS + tok * 1024 + (fp < 4 ? 512 + h * 64 + fp * 16 : 768 + h * 64 + (fp - 4) * 16);
            f0 = *(const uint4*)src; f1 = *(const uint4*)(src + 8);
            if (fp < 4) fc = *(const unsigned*)(VG + tok * 256 + h * 64 + colbase + fp * 2);
            if (lane < 16) fsc = SC[(tb + t0 + (lane >> 1)) * 16 + 8 + (lane & 1) * 4 + h];
        };
        fetch(0);
        for (int t0 = 0; t0 < SEQ; t0 += 8) {
            st8f(lrow + fs * 512 + fp * 64, f0); st8f(lrow + fs * 512 + fp * 64 + 32, f1);
            if (fp < 4) *(unsigned*)(lcol + fs * 32 + fp * 4) = fc;
            if (lane < 16) lsc[lane] = fsc;
            if (t0 + 8 < SEQ) fetch(t0 + 8);
#pragma unroll
            for (int i = 0; i < 8; ++i) {
                const char* rb = lrow + i * 512 + sq * 32;
                const float4 q0 = *(const float4*)rb, q1 = *(const float4*)(rb + 16);
                const float4 k0 = *(const float4*)(rb + 256), k1 = *(const float4*)(rb + 272);
                const float vv = bf2f(*(const bf16_t*)(lcol + i * 32 + cl * 2));
                const float2 sc2 = *(const float2*)(lsc + i * 2);
                const f2_t al2 = mk2(sc2.x, sc2.x);
                const f2_t kk[4] = {mk2(k0.x, k0.y), mk2(k0.z, k0.w), mk2(k1.x, k1.y), mk2(k1.z, k1.w)};
                const f2_t qq[4] = {mk2(q0.x, q0.y), mk2(q0.z, q0.w), mk2(q1.x, q1.y), mk2(q1.z, q1.w)};
                f2_t ra = mk2(0.f, 0.f), rb2 = mk2(0.f, 0.f);
#pragma unroll
                for (int q = 0; q < 4; q += 2) {
                    S[q] = S[q] * al2; S[q + 1] = S[q + 1] * al2;
                    ra = S[q] * kk[q] + ra; rb2 = S[q + 1] * kk[q + 1] + rb2;
                }
                const f2_t rs = ra + rb2;
                const float r = oct_sum(rs.x + rs.y);
                const float vn = sc2.y * (vv - r);
                const f2_t vn2 = mk2(vn, vn);
                f2_t oa2 = mk2(0.f, 0.f), ob2 = mk2(0.f, 0.f);
#pragma unroll
                for (int q = 0; q < 4; q += 2) {
                    S[q] = kk[q] * vn2 + S[q]; S[q + 1] = kk[q + 1] * vn2 + S[q + 1];
                    oa2 = S[q] * qq[q] + oa2; ob2 = S[q + 1] * qq[q + 1] + ob2;
                }
                const f2_t os = oa2 + ob2;
                const float ov = oct_sum(os.x + os.y);
                *(sq == 0 ? Y + (tb + t0 + i) * DM + 256 + h * 64 + col : dummy + i) = f2bf(ov);
                if (i & 1) __builtin_amdgcn_sched_barrier(0);
            }
        }
    } else {
        uint4 f0, f1; unsigned fc = 0u;
        f2_t S[4];
#pragma unroll
        for (int i = 0; i < 4; ++i) S[i] = mk2(0.f, 0.f);
        auto fetch = [&](int t0) {
            const size_t tok = tb + t0 + fs;
            if (fp < 4) { const float* src = DEC + tok * 128 + h * 32 + fp * 8; f0 = *(const uint4*)src; f1 = *(const uint4*)(src + 4); }
            else { const bf16_t* src = P + tok * LDP + (fp < 6 ? PC_LK + h * 32 + (fp - 4) * 16 : PC_LQ + h * 32 + (fp - 6) * 16); f0 = *(const uint4*)src; f1 = *(const uint4*)(src + 8); }
            fc = *(const unsigned*)(P + tok * LDP + PC_LV + h * 64 + colbase + fp * 2);
        };
        fetch(0);
        for (int t0 = 0; t0 < SEQ; t0 += 8) {
            if (fp < 4) { *(uint4*)(lrow + fs * 512 + fp * 32) = f0; *(uint4*)(lrow + fs * 512 + fp * 32 + 16) = f1; }
            else { st8f(lrow + fs * 512 + 128 + (fp - 4) * 64, f0); st8f(lrow + fs * 512 + 128 + (fp - 4) * 64 + 32, f1); }
            *(unsigned*)(lcol + fs * 32 + fp * 4) = fc;
            if (t0 + 8 < SEQ) fetch(t0 + 8);
#pragma unroll
            for (int i = 0; i < 8; ++i) {
                const char* rb = lrow + i * 512 + sq * 32;
                const float4 d0 = *(const float4*)rb, d1 = *(const float4*)(rb + 16);
                const float4 k0 = *(const float4*)(rb + 128), k1 = *(const float4*)(rb + 144);
                const float4 q0 = *(const float4*)(rb + 256), q1 = *(const float4*)(rb + 272);
                const float vv = bf2f(*(const bf16_t*)(lcol + i * 32 + cl * 2));
                const f2_t v2 = mk2(vv, vv);
                const f2_t dd[4] = {mk2(d0.x, d0.y), mk2(d0.z, d0.w), mk2(d1.x, d1.y), mk2(d1.z, d1.w)};
                const f2_t kk[4] = {mk2(k0.x, k0.y), mk2(k0.z, k0.w), mk2(k1.x, k1.y), mk2(k1.z, k1.w)};
                const f2_t qq[4] = {mk2(q0.x, q0.y), mk2(q0.z, q0.w), mk2(q1.x, q1.y), mk2(q1.z, q1.w)};
                f2_t oa2 = mk2(0.f, 0.f), ob2 = mk2(0.f, 0.f);
#pragma unroll
                for (int q = 0; q < 4; q += 2) {
                    S[q] = dd[q] * S[q] + kk[q] * v2; S[q + 1] = dd[q + 1] * S[q + 1] + kk[q + 1] * v2;
                    oa2 = S[q] * qq[q] + oa2; ob2 = S[q + 1] * qq[q + 1] + ob2;
                }
                const f2_t os = oa2 + ob2;
                const float ov = quad_sum(os.x + os.y);
                *(sq == 0 ? Y + (tb + t0 + i) * DM + 512 + h * 64 + col : dummy + i) = f2bf(ov * 0.17677669529663687f);
                if (i & 1) __builtin_amdgcn_sched_barrier(0);
            }
        }
    }
}

__device__ __forceinline__ void ph_mixer_finish(const Ctx& p, int l) {
    const bf16_t* P = (const bf16_t*)(pws_() + WS_P);
    bf16_t* Y = (bf16_t*)(pws_() + WS_Y);
    const float* sn = pin_(9) + (size_t)l * 256;
    const float* gn = pin_(13) + (size_t)l * 64;
    const float* ln = pin_(16) + (size_t)l * 64;
    const int lane = tid_() & 63;
    float gw1[8], gw2[8];
    load8f(lane < 32 ? sn + 8 * lane : gn + 8 * (lane & 7), gw1);
    load8f(ln + 8 * (lane & 7), gw2);
    const int nw = nwaves();
    int tok = gwave();
    uint4 nya, nga, nyb, ngb;
#define MF_LOAD(tk) do { const size_t row_ = (size_t)(tk) * LDP; \
        nya = *(const uint4*)(Y + (size_t)(tk) * DM + 8 * lane); \
        nga = *(const uint4*)(P + row_ + (lane < 32 ? PC_Z + 8 * lane : PC_GG + 8 * (lane - 32))); \
        nyb = *(const uint4*)(Y + (size_t)(tk) * DM + 512 + 8 * (lane & 31)); \
        ngb = *(const uint4*)(P + row_ + PC_LR + 8 * (lane & 31)); } while (0)
    MF_LOAD(tok);
    for (; tok < MTOK; tok += nw) {
        const uint4 ya = nya, ga = nga, yb = nyb, gb = ngb;
        { const int tn = tok + nw < MTOK ? tok + nw : tok; MF_LOAD(tn); }
        __builtin_amdgcn_sched_barrier(0);
        {
            float v[8], gt[8];
            unpack8(ya, v);
            unpack8(ga, gt);
            float ss = 0.f;
            if (lane < 32) {
#pragma unroll
                for (int i = 0; i < 8; ++i) { v[i] *= silu_f(gt[i]); ss += v[i] * v[i]; }
            } else {
#pragma unroll
                for (int i = 0; i < 8; ++i) ss += v[i] * v[i];
            }
            const float s8 = oct_sum(ss);
            float s32 = s8 + __int_as_float(__builtin_amdgcn_mov_dpp(__float_as_int(s8), 0x140, 0xF, 0xF, true));
            s32 += __shfl_xor(s32, 16, 64);
            const float rs = lane < 32 ? rsqrtf(s32 * (1.f / 256.f) + EPS) : rsqrtf(s8 * (1.f / 64.f) + EPS);
            float o[8];
#pragma unroll
            for (int i = 0; i < 8; ++i) o[i] = lane < 32 ? v[i] * rs * gw1[i] : v[i] * rs * gw1[i] * silu_f(gt[i]);
            *(uint4*)(Y + (size_t)tok * DM + 8 * lane) = pack8(o);
        }
        if (lane < 32) {
            float v[8], gt[8];
            unpack8(yb, v);
            unpack8(gb, gt);
            float ss = 0.f;
#pragma unroll
            for (int i = 0; i < 8; ++i) ss += v[i] * v[i];
            const float rs = rsqrtf(oct_sum(ss) * (1.f / 64.f) + EPS);
            float o[8];
#pragma unroll
            for (int i = 0; i < 8; ++i) o[i] = v[i] * rs * gw2[i] * silu_f(gt[i]);
            *(uint4*)(Y + (size_t)tok * DM + 512 + 8 * lane) = pack8(o);
        }
    }
#undef MF_LOAD
}

typedef short bf16x8_t __attribute__((ext_vector_type(8)));
typedef float f32x4_t __attribute__((ext_vector_type(4)));
union BF8 { bf16x8_t v; uint4 u; unsigned w[4]; };


__device__ __forceinline__ void ph_dsa_prep(const Ctx& p, int l) {
    const bf16_t* P = (const bf16_t*)(pws_() + WS_P);
    bf16_t* qn = (bf16_t*)(pws_() + WS_QN);
    bf16_t* kn = (bf16_t*)(pws_() + WS_KN);
    bf16_t* ikn = (bf16_t*)(pws_() + WS_IKN);
    bf16_t* vt = (bf16_t*)(pws_() + WS_VT);
    const float* qg = pin_(17) + (size_t)l * 64;
    const float* kg = pin_(18) + (size_t)l * 64;
    const float* ig = pin_(19) + (size_t)l * 32;
    const int lane = tid_() & 63;
    const int pcol = lane < 40 ? PC_DQ + 8 * lane : PC_IK + 8 * (lane & 3);
    float gw[8];
    load8f(lane < 32 ? qg + 8 * (lane & 7) : (lane < 40 ? kg + 8 * (lane & 7) : ig + 8 * (lane & 3)), gw);
    for (int grp = gwave(); grp < MTOK / 8; grp += nwaves()) {
        const size_t tok0 = (size_t)grp * 8;
        const int b = (int)(tok0 / SEQ), t0 = (int)(tok0 % SEQ);
        unsigned short vv[8];
#pragma unroll
        for (int i = 0; i < 8; ++i) {
            const size_t row = (tok0 + i) * LDP;
            vv[i] = P[row + PC_DV + lane];
            if (lane < 44) {
                float v[8];
                unpack8(*(const uint4*)(P + row + pcol), v);
                float ss = 0.f;
#pragma unroll
                for (int q = 0; q < 8; ++q) ss += v[q] * v[q];
                const float s4 = ss + __int_as_float(__builtin_amdgcn_mov_dpp(__float_as_int(ss), 0xB1, 0xF, 0xF, true));
                const float s4b = s4 + __int_as_float(__builtin_amdgcn_mov_dpp(__float_as_int(s4), 0x4E, 0xF, 0xF, true));
                const float s8 = s4b + __int_as_float(__builtin_amdgcn_mov_dpp(__float_as_int(s4b), 0x141, 0xF, 0xF, true));
                const float rs = lane < 40 ? rsqrtf(s8 * (1.f / 64.f) + EPS) * (lane < 32 ? 0.125f : 1.f) : rsqrtf(s4b * (1.f / 32.f) + EPS);
                float o[8];
#pragma unroll
                for (int q = 0; q < 8; ++q) o[q] = v[q] * rs * gw[q];
                const uint4 pk = pack8(o);
                if (lane < 32) *(uint4*)(qn + (tok0 + i) * 256 + 8 * lane) = pk;
                else if (lane < 40) *(uint4*)(kn + (tok0 + i) * 64 + 8 * (lane - 32)) = pk;
                else *(uint4*)(ikn + (tok0 + i) * 32 + 8 * (lane - 40)) = pk;
            }
        }
        uint4 o; o.x = (unsigned)vv[0] | ((unsigned)vv[1] << 16); o.y = (unsigned)vv[2] | ((unsigned)vv[3] << 16);
        o.z = (unsigned)vv[4] | ((unsigned)vv[5] << 16); o.w = (unsigned)vv[6] | ((unsigned)vv[7] << 16);
        *(uint4*)(vt + ((size_t)b * 64 + lane) * SEQ + t0) = o;
    }
}

#define DSA_STRIDE 2052
__device__ __forceinline__ int wave_total_i(int v) {
    v += __builtin_amdgcn_update_dpp(0, v, 0x111, 0xf, 0xf, true);
    v += __builtin_amdgcn_update_dpp(0, v, 0x112, 0xf, 0xf, true);
    v += __builtin_amdgcn_update_dpp(0, v, 0x114, 0xf, 0xf, true);
    v += __builtin_amdgcn_update_dpp(0, v, 0x118, 0xf, 0xf, true);
    return __builtin_amdgcn_readlane(v, 15) + __builtin_amdgcn_readlane(v, 31) + __builtin_amdgcn_readlane(v, 47) + __builtin_amdgcn_readlane(v, 63);
}
template <int NJ>
__device__ __forceinline__ void dsa_select(const unsigned* scq, int nj, int lane, unsigned& T_out, int& cut_out) {
    unsigned kreg[NJ];
#pragma unroll
    for (int j = 0; j < NJ; ++j) kreg[j] = (j < nj) ? scq[j * 64 + lane] : 0u;
    unsigned T = 0u; bool exact = false;
    for (int bit = 31; bit >= 0; --bit) {
        const unsigned cand = T | (1u << bit);
        int c = 0;
#pragma unroll
        for (int j = 0; j < NJ; ++j) c += (kreg[j] >= cand) ? 1 : 0;
        const int cnt = wave_total_i(c);
        if (cnt >= 256) { T = cand; if (cnt == 256) { exact = true; break; } }
    }
    int cut = 0x7fffffff;
    if (!exact) {
        int cgt = 0, ceq = 0;
#pragma unroll
        for (int j = 0; j < NJ; ++j) { cgt += __popcll(__ballot(kreg[j] > T)); ceq += __popcll(__ballot(kreg[j] == T)); }
        int need = 256 - cgt;
        if (ceq > need) {
            bool found = false;
#pragma unroll
            for (int j = 0; j < NJ; ++j) {
                const unsigned long long m = __ballot(kreg[j] == T);
                const int cj = __popcll(m);
                if (!found) {
                    if (need <= cj) { for (int bpos = 0; bpos < 64; ++bpos) if ((m >> bpos) & 1ull) { if (--need == 0) { cut = j * 64 + bpos; break; } } found = true; }
                    else need -= cj;
                }
            }
        }
    }
    T_out = T; cut_out = cut;
}
__device__ __forceinline__ void ph_dsa_main(const Ctx& p, int l, float* smem) {
    const bf16_t* P = (const bf16_t*)(pws_() + WS_P);
    bf16_t* Y = (bf16_t*)(pws_() + WS_Y);
    const bf16_t* QN = (const bf16_t*)(pws_() + WS_QN);
    const bf16_t* KN = (const bf16_t*)(pws_() + WS_KN);
    const bf16_t* IKN = (const bf16_t*)(pws_() + WS_IKN);
    const bf16_t* VT = (const bf16_t*)(pws_() + WS_VT);
    unsigned* sc = (unsigned*)smem;
    float* part = smem;
    float* plsum = smem + 8 * 64 * 64;
    unsigned* thr = (unsigned*)(smem + 35000);
    for (int task = bid_(); task < MTOK / 16; task += nblk_()) {
        const int tid = tid_(), lane = tid & 63, w = tid >> 6, qi = lane & 15, g = lane >> 4;
        const int c = 31 - task / 128, b = (task >> 2) & 31, sub = task & 3;
        const int t0 = c * 64 + sub * 16, nk = (c + 1) * 64;
        const size_t tok0 = (size_t)b * SEQ + t0;
        const bool dosel = nk > 256;
        if (dosel) {
            BF8 iqf[8]; float wq[8];
#pragma unroll
            for (int h = 0; h < 8; ++h) {
                iqf[h].u = *(const uint4*)(P + (tok0 + qi) * LDP + PC_IQ + h * 32 + 8 * g);
                wq[h] = bf2f(P[(tok0 + qi) * LDP + PC_IW + h]) * 0.0625f;
            }
            BF8 kan; kan.u = *(const uint4*)(IKN + ((size_t)b * SEQ + w * 16 + qi) * 32 + 8 * g);
            for (int kt = w; kt < nk / 16; kt += 8) {
                const int s0 = kt * 16;
                BF8 ka = kan;
                { const int ktn = kt + 8 < nk / 16 ? kt + 8 : kt; kan.u = *(const uint4*)(IKN + ((size_t)b * SEQ + ktn * 16 + qi) * 32 + 8 * g); }
                float acc[4] = {0.f, 0.f, 0.f, 0.f};
#pragma unroll
                for (int h = 0; h < 8; ++h) {
                    const f32x4_t d = __builtin_amdgcn_mfma_f32_16x16x32_bf16(ka.v, iqf[h].v, (f32x4_t){0.f, 0.f, 0.f, 0.f}, 0, 0, 0);
#pragma unroll
                    for (int r = 0; r < 4; ++r) acc[r] = __builtin_fmaf(wq[h], fmaxf(d[r], 0.f), acc[r]);
                }
                uint4 kv; kv.x = ford(acc[0]); kv.y = ford(acc[1]); kv.z = ford(acc[2]); kv.w = ford(acc[3]);
                *(uint4*)(sc + qi * DSA_STRIDE + s0 + 4 * g) = kv;
            }
        }
        __syncthreads();
        if (dosel) {
            const int nj = nk >> 6;
#pragma unroll 1
            for (int qq = 0; qq < 2; ++qq) {
                const int q = 2 * w + qq;
                unsigned T; int cut;
                if (nj <= 8) dsa_select<8>(sc + q * DSA_STRIDE, nj, lane, T, cut);
                else if (nj <= 16) dsa_select<16>(sc + q * DSA_STRIDE, nj, lane, T, cut);
                else if (nj <= 24) dsa_select<24>(sc + q * DSA_STRIDE, nj, lane, T, cut);
                else dsa_select<32>(sc + q * DSA_STRIDE, nj, lane, T, cut);
                if (lane == 0) { thr[q] = T; thr[16 + q] = (unsigned)cut; }
            }
        }
        __syncthreads();
        unsigned Tq = 0u; int cutq = 0x7fffffff;
        if (dosel) { Tq = thr[qi]; cutq = (int)thr[16 + qi]; }
        f32x4_t oacc[4][4]; float lsum[4];
#pragma unroll
        for (int h = 0; h < 4; ++h) { lsum[h] = 0.f;
#pragma unroll
            for (int dt = 0; dt < 4; ++dt) oacc[h][dt] = (f32x4_t){0.f, 0.f, 0.f, 0.f}; }
        const int krow = 8 * (qi >> 2) + (qi & 3);
        BF8 kan[2][2], van[4];
#define DSA_KV(st_) do { const int s0_ = (st_) * 32; \
            _Pragma("unroll") for (int t = 0; t < 2; ++t) _Pragma("unroll") for (int s2 = 0; s2 < 2; ++s2) kan[t][s2].u = *(const uint4*)(KN + ((size_t)b * SEQ + s0_ + krow + 4 * t) * 64 + 32 * s2 + 8 * g); \
            _Pragma("unroll") for (int dt = 0; dt < 4; ++dt) van[dt].u = *(const uint4*)(VT + ((size_t)b * 64 + 16 * dt + qi) * SEQ + s0_ + 8 * g); } while (0)
        if (w < nk / 32) DSA_KV(w);
        for (int st = w; st < nk / 32; st += 8) {
            const int s0 = st * 32;
            BF8 ka[2][2], va[4];
#pragma unroll
            for (int t = 0; t < 2; ++t)
#pragma unroll
                for (int s2 = 0; s2 < 2; ++s2) ka[t][s2] = kan[t][s2];
#pragma unroll
            for (int dt = 0; dt < 4; ++dt) va[dt] = van[dt];
            { const int stn = st + 8 < nk / 32 ? st + 8 : st; DSA_KV(stn); }
            float mk[8];
            if (dosel) {
                const uint4 k0 = *(const uint4*)(sc + qi * DSA_STRIDE + s0 + 8 * g), k1 = *(const uint4*)(sc + qi * DSA_STRIDE + s0 + 8 * g + 4);
                const unsigned kk[8] = {k0.x, k0.y, k0.z, k0.w, k1.x, k1.y, k1.z, k1.w};
#pragma unroll
                for (int j = 0; j < 8; ++j) mk[j] = (kk[j] > Tq || (kk[j] == Tq && (s0 + 8 * g + j) <= cutq)) ? 1.f : 0.f;
            } else {
#pragma unroll
                for (int j = 0; j < 8; ++j) mk[j] = 1.f;
            }
#pragma unroll
            for (int h = 0; h < 4; ++h) {
                BF8 q0, q1;
                q0.u = *(const uint4*)(QN + (tok0 + qi) * 256 + h * 64 + 8 * g);
                q1.u = *(const uint4*)(QN + (tok0 + qi) * 256 + h * 64 + 32 + 8 * g);
                f32x4_t sacc[2];
#pragma unroll
                for (int t = 0; t < 2; ++t) {
                    sacc[t] = __builtin_amdgcn_mfma_f32_16x16x32_bf16(ka[t][0].v, q0.v, (f32x4_t){0.f, 0.f, 0.f, 0.f}, 0, 0, 0);
                    sacc[t] = __builtin_amdgcn_mfma_f32_16x16x32_bf16(ka[t][1].v, q1.v, sacc[t], 0, 0, 0);
                }
                float pe[8];
#pragma unroll
                for (int t = 0; t < 2; ++t)
#pragma unroll
                    for (int r = 0; r < 4; ++r) { pe[4 * t + r] = __expf(sacc[t][r]) * mk[4 * t + r]; lsum[h] += pe[4 * t + r]; }
                BF8 pf;
#pragma unroll
                for (int j = 0; j < 4; ++j) pf.w[j] = pk_bf16(pe[2 * j], pe[2 * j + 1]);
#pragma unroll
                for (int dt = 0; dt < 4; ++dt) oacc[h][dt] = __builtin_amdgcn_mfma_f32_16x16x32_bf16(va[dt].v, pf.v, oacc[h][dt], 0, 0, 0);
            }
        }
#undef DSA_KV
        __syncthreads();
#pragma unroll
        for (int h = 0; h < 4; ++h) {
            plsum[(w * 4 + h) * 64 + lane] = lsum[h];
#pragma unroll
            for (int dt = 0; dt < 4; ++dt)
#pragma unroll
                for (int r = 0; r < 4; ++r) part[(w * 64 + h * 16 + dt * 4 + r) * 64 + lane] = oacc[h][dt][r];
        }
        __syncthreads();
        {
            const int h = w >> 1;
            float lq = 0.f;
#pragma unroll
            for (int w2 = 0; w2 < 8; ++w2)
#pragma unroll
                for (int g2 = 0; g2 < 4; ++g2) lq += plsum[(w2 * 4 + h) * 64 + qi + 16 * g2];
            const float inv = 1.f / lq;
#pragma unroll
            for (int dd = 0; dd < 2; ++dd) {
                const int dt = (w & 1) * 2 + dd;
                float o[4];
#pragma unroll
                for (int r = 0; r < 4; ++r) {
                    float sacc = 0.f;
#pragma unroll
                    for (int w2 = 0; w2 < 8; ++w2) sacc += part[(w2 * 64 + h * 16 + dt * 4 + r) * 64 + lane];
                    o[r] = sacc * inv;
                }
                uint2 ov; ov.x = pk_bf16(o[0], o[1]); ov.y = pk_bf16(o[2], o[3]);
                *(uint2*)(Y + (tok0 + qi) * DM + 768 + h * 64 + 16 * dt + 4 * g) = ov;
            }
        }
        __syncthreads();
    }
}

__device__ __forceinline__ void ph_mem_prep(const Ctx& p, int l) {
    const float* Km = (const float*)(pws_() + WS_KM);
    const float* Vm = (const float*)(pws_() + WS_VM);
    bf16_t* KB = (bf16_t*)(pws_() + WS_KB);
    bf16_t* VTB = (bf16_t*)(pws_() + WS_VTB);
    const float* kg = pin_(28) + (size_t)l * 64;
    const int lane = tid_() & 63;
    for (int r = gwave(); r < MMEM; r += nwaves()) {
        const int b = r / NMEM, j = r % NMEM;
#pragma unroll
        for (int h = 0; h < 4; ++h) {
            const float v = Km[(size_t)r * 256 + h * 64 + lane];
            const float ss = wave_sum(v * v);
            KB[(((size_t)b * 4 + h) * NMEM + j) * 64 + lane] = f2bf(v * rsqrtf(ss * (1.f / 64.f) + EPS) * kg[lane]);
            VTB[(((size_t)b * 4 + h) * 64 + lane) * NMEM + j] = f2bf(Vm[(size_t)r * 256 + h * 64 + lane]);
        }
    }
}
__device__ __forceinline__ void ph_xattn(const Ctx& p, int l, int task0 = 0, int ntask = MTOK / 16, int w0 = -1, int wstep = 0) {
    const float* Qx = (const float*)(pws_() + WS_QX);
    bf16_t* Ox = (bf16_t*)(pws_() + WS_OX);
    const bf16_t* KB = (const bf16_t*)(pws_() + WS_KB);
    const bf16_t* VTB = (const bf16_t*)(pws_() + WS_VTB);
    const float* qg = pin_(27) + (size_t)l * 64;
    const int lane = tid_() & 63, qi = lane & 15, g = lane >> 4;
    if (w0 < 0) { w0 = gwave(); wstep = nwaves(); }
    for (int task = task0 + w0; task < task0 + ntask; task += wstep) {
        const int tok0 = task * 16, b = tok0 / SEQ;
#pragma unroll 1
        for (int h = 0; h < 4; ++h) {
            BF8 qf[2];
            {
                float qv[2][8]; float ss = 0.f;
#pragma unroll
                for (int s2 = 0; s2 < 2; ++s2) {
                    const float4* qp = (const float4*)(Qx + (size_t)(tok0 + qi) * 256 + h * 64 + 32 * s2 + 8 * g);
                    const float4 a = qp[0], c = qp[1];
                    qv[s2][0] = a.x; qv[s2][1] = a.y; qv[s2][2] = a.z; qv[s2][3] = a.w; qv[s2][4] = c.x; qv[s2][5] = c.y; qv[s2][6] = c.z; qv[s2][7] = c.w;
#pragma unroll
                    for (int j = 0; j < 8; ++j) ss += qv[s2][j] * qv[s2][j];
                }
                ss += __shfl_xor(ss, 16, 64); ss += __shfl_xor(ss, 32, 64);
                const float rs = rsqrtf(ss * (1.f / 64.f) + EPS) * 0.125f;
#pragma unroll
                for (int s2 = 0; s2 < 2; ++s2) {
                    const float4 g0 = *(const float4*)(qg + 32 * s2 + 8 * g), g1 = *(const float4*)(qg + 32 * s2 + 8 * g + 4);
                    qf[s2].w[0] = pk_bf16(qv[s2][0] * rs * g0.x, qv[s2][1] * rs * g0.y); qf[s2].w[1] = pk_bf16(qv[s2][2] * rs * g0.z, qv[s2][3] * rs * g0.w);
                    qf[s2].w[2] = pk_bf16(qv[s2][4] * rs * g1.x, qv[s2][5] * rs * g1.y); qf[s2].w[3] = pk_bf16(qv[s2][6] * rs * g1.z, qv[s2][7] * rs * g1.w);
                }
            }
            const bf16_t* Kh = KB + ((size_t)b * 4 + h) * NMEM * 64;
            const bf16_t* Vh = VTB + ((size_t)b * 4 + h) * 64 * NMEM;
            f32x4_t oacc[4];
#pragma unroll
            for (int dt = 0; dt < 4; ++dt) oacc[dt] = (f32x4_t){0.f, 0.f, 0.f, 0.f};
            float lsum = 0.f;
            const int krow = 8 * (qi >> 2) + (qi & 3);
#pragma unroll 2
            for (int s0 = 0; s0 < NMEM; s0 += 32) {
                BF8 ka[2][2], va[4];
#pragma unroll
                for (int t = 0; t < 2; ++t)
#pragma unroll
                    for (int s2 = 0; s2 < 2; ++s2) ka[t][s2].u = *(const uint4*)(Kh + (size_t)(s0 + krow + 4 * t) * 64 + 32 * s2 + 8 * g);
#pragma unroll
                for (int dt = 0; dt < 4; ++dt) va[dt].u = *(const uint4*)(Vh + (size_t)(16 * dt + qi) * NMEM + s0 + 8 * g);
                f32x4_t sacc[2];
#pragma unroll
                for (int t = 0; t < 2; ++t) {
                    sacc[t] = (f32x4_t){0.f, 0.f, 0.f, 0.f};
                    sacc[t] = __builtin_amdgcn_mfma_f32_16x16x32_bf16(ka[t][0].v, qf[0].v, sacc[t], 0, 0, 0);
                    sacc[t] = __builtin_amdgcn_mfma_f32_16x16x32_bf16(ka[t][1].v, qf[1].v, sacc[t], 0, 0, 0);
                }
                float pe[8];
#pragma unroll
                for (int t = 0; t < 2; ++t)
#pragma unroll
                    for (int r = 0; r < 4; ++r) { pe[4 * t + r] = __expf(sacc[t][r]); lsum += pe[4 * t + r]; }
                BF8 pf;
#pragma unroll
                for (int j = 0; j < 4; ++j) pf.w[j] = pk_bf16(pe[2 * j], pe[2 * j + 1]);
#pragma unroll
                for (int dt = 0; dt < 4; ++dt) oacc[dt] = __builtin_amdgcn_mfma_f32_16x16x32_bf16(va[dt].v, pf.v, oacc[dt], 0, 0, 0);
            }
            lsum += __shfl_xor(lsum, 16, 64); lsum += __shfl_xor(lsum, 32, 64);
            const float inv = 1.f / lsum;
#pragma unroll
            for (int dt = 0; dt < 4; ++dt) {
                uint2 o; o.x = pk_bf16(oacc[dt][0] * inv, oacc[dt][1] * inv); o.y = pk_bf16(oacc[dt][2] * inv, oacc[dt][3] * inv);
                *(uint2*)(Ox + (size_t)(tok0 + qi) * 256 + h * 64 + 16 * dt + 4 * g) = o;
            }
        }
    }
}

template <int N> __device__ __forceinline__ void bitonic_sort_desc(unsigned (&a)[N]) {
#pragma unroll
    for (int k = 2; k <= N; k <<= 1)
#pragma unroll
        for (int j = k >> 1; j > 0; j >>= 1)
#pragma unroll
            for (int i = 0; i < N; ++i) {
                const int o = i ^ j;
                if (o > i) {
                    const bool desc = ((i & k) == 0);
                    const unsigned x = a[i], y = a[o];
                    const unsigned mx = x > y ? x : y, mn = x > y ? y : x;
                    a[i] = desc ? mx : mn; a[o] = desc ? mn : mx;
                }
            }
}
__device__ __forceinline__ void bitonic_merge16_desc(unsigned (&a)[16]) {
#pragma unroll
    for (int j = 8; j > 0; j >>= 1)
#pragma unroll
        for (int i = 0; i < 16; ++i) {
            const int o = i ^ j;
            if (o > i) { const unsigned x = a[i], y = a[o]; a[i] = x > y ? x : y; a[o] = x > y ? y : x; }
        }
}
__device__ __forceinline__ void top16_merge(unsigned (&a)[16], const unsigned (&b)[16]) {
#pragma unroll
    for (int i = 0; i < 16; ++i) a[i] = a[i] > b[15 - i] ? a[i] : b[15 - i];
    bitonic_merge16_desc(a);
}
__device__ __forceinline__ void top16_xlane(unsigned (&a)[16], int xm) {
    unsigned b[16];
#pragma unroll
    for (int i = 0; i < 16; ++i) b[i] = (unsigned)__shfl_xor((int)a[i], xm, 64);
    top16_merge(a, b);
}
__device__ __forceinline__ void ph_subkeys_convert(const Ctx& p) {
    const float* sk = pin_(31);
    bf16_t* o = (bf16_t*)(pws_() + WS_SKB);
    const size_t n = (size_t)DEPTH * 8 * 2 * 128 * 64;
    for (size_t i = (size_t)bid_() * 512 + tid_(); i < n; i += (size_t)nblk_() * 512) o[i] = f2bf(sk[i]);
}
__device__ __forceinline__ void ph_peer_topk(const Ctx& p, int l, float* smem, int task0 = 0, int ntask = MTOK / 16, int w0 = -1, int wstep = 0) {
    const bf16_t* Qp = (const bf16_t*)(pws_() + WS_QP);
    const bf16_t* SK = (const bf16_t*)(pws_() + WS_SKB) + (size_t)l * 8 * 2 * 128 * 64;
    int* pidx = (int*)(pws_() + WS_PEI);
    float* pgt = (float*)(pws_() + WS_PEG);
    float* pus = (float*)(pws_() + WS_PUS);
    const float* usc = (const float*)(pws_() + WS_USC) + (size_t)l * NEXP;
    const float* vsc = (const float*)(pws_() + WS_VSC) + (size_t)l * NEXP;
    const int tid = tid_(), lane = tid & 63, wave = tid >> 6, qi = lane & 15, g = lane >> 4;
    int* tabw = (int*)smem + wave * 512 + qi * 32;
    if (w0 < 0) { w0 = gwave(); wstep = nwaves(); }
    for (int task = task0 + w0; task < task0 + ntask; task += wstep) {
        const size_t tok = (size_t)task * 16 + qi;
#pragma unroll 1
        for (int h = 0; h < 8; ++h) {
            unsigned L[2][16];
#pragma unroll
            for (int pp = 0; pp < 2; ++pp) {
                BF8 qf[2];
#pragma unroll
                for (int s2 = 0; s2 < 2; ++s2) qf[s2].u = *(const uint4*)(Qp + tok * DM + h * 128 + pp * 64 + 32 * s2 + 8 * g);
                const bf16_t* skp = SK + (size_t)(h * 2 + pp) * 128 * 64;
                unsigned va[16], vb[16];
#pragma unroll
                for (int tile = 0; tile < 8; ++tile) {
                    BF8 ka[2];
#pragma unroll
                    for (int s2 = 0; s2 < 2; ++s2) ka[s2].u = *(const uint4*)(skp + (size_t)(16 * tile + qi) * 64 + 32 * s2 + 8 * g);
                    f32x4_t d = __builtin_amdgcn_mfma_f32_16x16x32_bf16(ka[0].v, qf[0].v, (f32x4_t){0.f, 0.f, 0.f, 0.f}, 0, 0, 0);
                    d = __builtin_amdgcn_mfma_f32_16x16x32_bf16(ka[1].v, qf[1].v, d, 0, 0, 0);
#pragma unroll
                    for (int r = 0; r < 4; ++r) {
                        const unsigned key = (ford(d[r]) & ~127u) | (unsigned)(127 - (16 * tile + 4 * g + r));
                        if (tile < 4) va[tile * 4 + r] = key; else vb[(tile - 4) * 4 + r] = key;
                    }
                }
                bitonic_sort_desc<16>(va);
                bitonic_sort_desc<16>(vb);
                top16_merge(va, vb);
                top16_xlane(va, 16);
                top16_xlane(va, 32);
#pragma unroll
                for (int i = 0; i < 16; ++i) L[pp][i] = va[i];
            }
            if (g < 2) {
#pragma unroll
                for (int i = 0; i < 16; ++i) tabw[g * 16 + i] = 127 - (int)((g == 0 ? L[0][i] : L[1][i]) & 127u);
            }
            float s1[16], s2v[16];
#pragma unroll
            for (int i = 0; i < 16; ++i) { s1[i] = funord(L[0][i] & ~127u); s2v[i] = funord(L[1][i] & ~127u); }
            unsigned ca[16], cb[16];
#pragma unroll
            for (int i = 0; i < 16; ++i) { ca[i] = 0u; cb[i] = 0u; }
            {
                const float r0 = g == 0 ? s1[0] : (g == 1 ? s1[1] : (g == 2 ? s1[2] : s1[3]));
                const int nb0 = g == 0 ? 16 : (g == 1 ? 8 : (g == 2 ? 5 : 4));
#pragma unroll
                for (int bq = 0; bq < 16; ++bq) if (bq < nb0) ca[bq] = (ford(r0 + s2v[bq]) & ~255u) | (unsigned)(255 - (g * 16 + bq));
                const float r1 = g == 0 ? s1[4] : (g == 1 ? s1[5] : (g == 2 ? s1[6] : s1[7]));
                const int nb1 = g == 0 ? 3 : 2;
#pragma unroll
                for (int bq = 0; bq < 3; ++bq) if (bq < nb1) cb[bq] = (ford(r1 + s2v[bq]) & ~255u) | (unsigned)(255 - ((g + 4) * 16 + bq));
                const float r2 = g == 0 ? s1[8] : (g == 1 ? s1[9] : (g == 2 ? s1[10] : s1[11]));
                cb[3] = (ford(r2 + s2v[0]) & ~255u) | (unsigned)(255 - ((g + 8) * 16));
                const float r3 = g == 0 ? s1[12] : (g == 1 ? s1[13] : (g == 2 ? s1[14] : s1[15]));
                cb[4] = (ford(r3 + s2v[0]) & ~255u) | (unsigned)(255 - ((g + 12) * 16));
            }
            bitonic_sort_desc<16>(ca);
            bitonic_sort_desc<16>(cb);
            top16_merge(ca, cb);
            top16_xlane(ca, 16);
            top16_xlane(ca, 32);
            float tv[16]; float den = 0.f;
#pragma unroll
            for (int i = 0; i < 16; ++i) {
                const int f = 255 - (int)(ca[i] & 255u);
                const int a = f >> 4, bq = f & 15;
                tv[i] = funord(ca[i] & ~255u);
                (void)a; (void)bq;
            }
#pragma unroll
            for (int i = 0; i < 16; ++i) { tv[i] = __expf(tv[i] - funord(ca[0] & ~255u)); den += tv[i]; }
            const float inv = 1.f / den;
            int ev[4]; float gv[4];
#pragma unroll
            for (int r = 0; r < 4; ++r) {
                const unsigned key = g == 0 ? ca[r] : (g == 1 ? ca[4 + r] : (g == 2 ? ca[8 + r] : ca[12 + r]));
                const float tvv = g == 0 ? tv[r] : (g == 1 ? tv[4 + r] : (g == 2 ? tv[8 + r] : tv[12 + r]));
                const int f = 255 - (int)(key & 255u);
                ev[r] = tabw[f >> 4] * 128 + tabw[16 + (f & 15)];
                gv[r] = tvv * inv;
            }
            float us[4];
#pragma unroll
            for (int r = 0; r < 4; ++r) { us[r] = usc[ev[r]]; gv[r] *= vsc[ev[r]]; }
            *(int4*)(pidx + tok * 128 + h * 16 + 4 * g) = make_int4(ev[0], ev[1], ev[2], ev[3]);
            *(float4*)(pgt + tok * 128 + h * 16 + 4 * g) = make_float4(gv[0], gv[1], gv[2], gv[3]);
            *(float4*)(pus + tok * 128 + h * 16 + 4 * g) = make_float4(us[0], us[1], us[2], us[3]);
        }
    }
}

typedef float f32x2_t __attribute__((ext_vector_type(2)));
typedef int i32x8_t __attribute__((ext_vector_type(8)));
__device__ __forceinline__ unsigned pack4_fp8(float4 a, float sc) {
    const float x = fminf(fmaxf(a.x * sc, -448.f), 448.f), y = fminf(fmaxf(a.y * sc, -448.f), 448.f);
    const float z = fminf(fmaxf(a.z * sc, -448.f), 448.f), w = fminf(fmaxf(a.w * sc, -448.f), 448.f);
    int r = __builtin_amdgcn_cvt_pk_fp8_f32(x, y, 0, false);
    r = __builtin_amdgcn_cvt_pk_fp8_f32(z, w, r, true);
    return (unsigned)r;
}
__device__ __forceinline__ unsigned q4_e2m1(float y) {
    const float a = fabsf(y);
    const unsigned c = (unsigned)(a > 0.25f) + (unsigned)(a > 0.75f) + (unsigned)(a > 1.25f) + (unsigned)(a > 1.75f) + (unsigned)(a > 2.5f) + (unsigned)(a > 3.5f) + (unsigned)(a > 5.0f);
    return c | (y < 0.f ? 8u : 0u);
}
__device__ __forceinline__ void ph_tab_convert_all(const Ctx& p) {
    const int lane = tid_() & 63;
    for (int row = gwave(); row < 2 * DEPTH * NEXP; row += nwaves()) {
        const int tabv = row >= DEPTH * NEXP;
        const int rr = tabv ? row - DEPTH * NEXP : row;
        const float4* src = (const float4*)((tabv ? pin_(33) : pin_(32)) + (size_t)rr * DM);
        float4 v[4]; float am = 0.f;
#pragma unroll
        for (int i = 0; i < 4; ++i) { v[i] = src[lane + 64 * i]; am = fmaxf(am, fmaxf(fmaxf(fabsf(v[i].x), fabsf(v[i].y)), fmaxf(fabsf(v[i].z), fabsf(v[i].w)))); }
        am = wave_max(am);
        const float sc = am > 0.f ? am * (1.f / 6.f) : 1.f, inv = 1.f / sc;
        unsigned char* dst = (unsigned char*)(pws_() + (tabv ? WS_V4 : WS_U4)) + (size_t)rr * 512;
#pragma unroll
        for (int i = 0; i < 4; ++i) {
            const unsigned pk = q4_e2m1(v[i].x * inv) | (q4_e2m1(v[i].y * inv) << 4) | (q4_e2m1(v[i].z * inv) << 8) | (q4_e2m1(v[i].w * inv) << 12);
            const int off = tabv ? 16 * (lane >> 1) + 4 * i + 2 * (lane & 1) : 128 * i + 2 * lane;
            *(unsigned short*)(dst + off) = (unsigned short)pk;
        }
        if (lane == 0) ((float*)(pws_() + (tabv ? WS_VSC : WS_USC)))[rr] = sc;
    }
}
__device__ __forceinline__ float dpp_xor1(float v) { return __int_as_float(__builtin_amdgcn_update_dpp(0, __float_as_int(v), 0xB1, 0xF, 0xF, true)); }
__device__ __forceinline__ void ph_peer_u4(const Ctx& p, int l, float* smem) {
    const unsigned char* ut = (const unsigned char*)(pws_() + WS_U4) + (size_t)l * NEXP * 512;
    const int* pidx = (const int*)(pws_() + WS_PEI);
    float* pgt = (float*)(pws_() + WS_PEG);
    const float* pus = (const float*)(pws_() + WS_PUS);
    const unsigned char* H8 = (const unsigned char*)(pws_() + WS_H8);
    const int lane = tid_() & 63, g = lane >> 4, i = lane & 15, wave = tid_() >> 6;
    const bool odd = i & 1;
    unsigned char* hl = (unsigned char*)smem + wave * 2048;
    const int nw = nwaves();
    int tok = gwave();
    int ne0 = pidx[(size_t)tok * 128 + lane], ne1 = pidx[(size_t)tok * 128 + 64 + lane];
    *(uint4*)(hl + 16 * lane) = *(const uint4*)(H8 + (size_t)tok * DM + 16 * lane);
    uint4 rA[8], rB[8], rC[8], rD[8];
    const int roff = 64 * (i & 1) + 16 * g;
#define PU_ROWS(buf, esrc, hq) do { const int ea_ = __builtin_amdgcn_ds_bpermute(((hq) * 16 + (i >> 1)) * 4, esrc), eb_ = __builtin_amdgcn_ds_bpermute(((hq) * 16 + 8 + (i >> 1)) * 4, esrc); \
        const unsigned char* pa_ = ut + (size_t)ea_ * 512 + roff; const unsigned char* pb_ = ut + (size_t)eb_ * 512 + roff; \
        _Pragma("unroll") for (int q_ = 0; q_ < 4; ++q_) { buf[q_] = *(const uint4*)(pa_ + 128 * q_); buf[4 + q_] = *(const uint4*)(pb_ + 128 * q_); } \
        __builtin_amdgcn_sched_barrier(0); } while (0)
#define PU_COMP(buf, hd) do { f32x4_t a0_ = {0.f, 0.f, 0.f, 0.f}, a1_ = {0.f, 0.f, 0.f, 0.f}; \
        _Pragma("unroll") for (int q_ = 0; q_ < 4; ++q_) { \
            const uint4 b0_ = *(const uint4*)(hb + 256 * q_), b1_ = *(const uint4*)(hb + 256 * q_ + 64); \
            const i32x8_t b_ = {(int)b0_.x, (int)b0_.y, (int)b0_.z, (int)b0_.w, (int)b1_.x, (int)b1_.y, (int)b1_.z, (int)b1_.w}; \
            const i32x8_t x_ = {(int)buf[q_].x, (int)buf[q_].y, (int)buf[q_].z, (int)buf[q_].w, 0, 0, 0, 0}; \
            const i32x8_t y_ = {(int)buf[4 + q_].x, (int)buf[4 + q_].y, (int)buf[4 + q_].z, (int)buf[4 + q_].w, 0, 0, 0, 0}; \
            a0_ = __builtin_amdgcn_mfma_scale_f32_16x16x128_f8f6f4(x_, b_, a0_, 4, 0, 0, 0, 0, 0); \
            a1_ = __builtin_amdgcn_mfma_scale_f32_16x16x128_f8f6f4(y_, b_, a1_, 4, 0, 0, 0, 0, 0); \
            __builtin_amdgcn_sched_barrier(0); } \
        float t0a_ = odd ? a0_[1] : a0_[0], t0b_ = odd ? a0_[3] : a0_[2], t1a_ = odd ? a1_[1] : a1_[0], t1b_ = odd ? a1_[3] : a1_[2]; \
        t0a_ += dpp_xor1(t0a_); t0b_ += dpp_xor1(t0b_); t1a_ += dpp_xor1(t1a_); t1b_ += dpp_xor1(t1b_); \
        if ((i >> 1) == (hd)) { keep0 = odd ? t1a_ : t0a_; keep1 = odd ? t1b_ : t0b_; } \
        __builtin_amdgcn_sched_barrier(0); } while (0)
    PU_ROWS(rA, ne0, 0); PU_ROWS(rB, ne0, 1); PU_ROWS(rC, ne0, 2);
    int par = 0;
    for (; tok < MTOK; tok += nw, par ^= 1) {
        const int e0 = ne0, e1 = ne1;
        const size_t tn = (size_t)(tok + nw < MTOK ? tok + nw : tok);
        const uint4 hnext = *(const uint4*)(H8 + tn * DM + 16 * lane);
        ne0 = pidx[tn * 128 + lane]; ne1 = pidx[tn * 128 + 64 + lane];
        const size_t mi = (size_t)tok * 128 + (i >> 1) * 16 + 8 * (i & 1) + 2 * g;
        const float2 gm = *(const float2*)(pgt + mi), um = *(const float2*)(pus + mi);
        asm volatile("s_waitcnt lgkmcnt(0)" ::: "memory"); __builtin_amdgcn_wave_barrier();
        const unsigned char* hb = hl + par * 1024 + 128 * (i & 1) + 16 * g;
        float keep0 = 0.f, keep1 = 0.f;
        PU_ROWS(rD, e0, 3); PU_COMP(rA, 0);
        PU_ROWS(rA, e1, 0); PU_COMP(rB, 1);
        PU_ROWS(rB, e1, 1); PU_COMP(rC, 2);
        PU_ROWS(rC, e1, 2); PU_COMP(rD, 3);
        PU_ROWS(rD, e1, 3); PU_COMP(rA, 4);
        PU_ROWS(rA, ne0, 0); PU_COMP(rB, 5);
        PU_ROWS(rB, ne0, 1); PU_COMP(rC, 6);
        PU_ROWS(rC, ne0, 2); PU_COMP(rD, 7);
        *(uint4*)(hl + (par ^ 1) * 1024 + 16 * lane) = hnext;
        float2 o;
        o.x = gm.x * gelu_tanh_f(keep0 * um.x * (1.f / H8_SCALE)); o.y = gm.y * gelu_tanh_f(keep1 * um.y * (1.f / H8_SCALE));
        *(float2*)(pgt + mi) = o;
    }
#undef PU_ROWS
#undef PU_COMP
}
template <bool NORM>
__device__ __forceinline__ void ph_peer_v4(const Ctx& p, int l) {
    const unsigned char* vt = (const unsigned char*)(pws_() + WS_V4) + (size_t)l * NEXP * 512;
    const int* pidx = (const int*)(pws_() + WS_PEI);
    const float* pgt = (const float*)(pws_() + WS_PEG);
    float* x = pout_();
    const int lane = tid_() & 63;
    const bool r = lane & 32;
    const int coff = 16 * (lane & 31);
    const int nw = nwaves();
    int tok = gwave();
    int ne0 = pidx[(size_t)tok * 128 + lane], ne1 = pidx[(size_t)tok * 128 + 64 + lane];
    float nc0 = pgt[(size_t)tok * 128 + lane], nc1 = pgt[(size_t)tok * 128 + 64 + lane];
    uint4 vA[16], vB[16];
    float4 gn[4];
    if (NORM) {
#pragma unroll
        for (int q = 0; q < 4; ++q) gn[q] = *(const float4*)(pin_(2) + (size_t)(l + 1) * DM + 256 * q + 8 * (lane & 31) + (r ? 4 : 0));
    }
#define PV_ROWS(buf, esrc, lb) do { int es_ = esrc; asm volatile("" : "+v"(es_)); _Pragma("unroll") for (int k_ = 0; k_ < 16; ++k_) { \
        const int ea_ = __builtin_amdgcn_readlane(es_, (lb) + 2 * k_), eb_ = __builtin_amdgcn_readlane(es_, (lb) + 2 * k_ + 1); \
        buf[k_] = *(const uint4*)(vt + (size_t)(r ? eb_ : ea_) * 512 + coff); } __builtin_amdgcn_sched_barrier(0); } while (0)
#define PV_D4(W, q) do { \
        out[4 * (q) + 0] = __builtin_elementwise_fma(__builtin_amdgcn_cvt_scalef32_pk_f32_fp4(W, 1.0f, 0), c2_, out[4 * (q) + 0]); \
        out[4 * (q) + 1] = __builtin_elementwise_fma(__builtin_amdgcn_cvt_scalef32_pk_f32_fp4(W, 1.0f, 1), c2_, out[4 * (q) + 1]); \
        out[4 * (q) + 2] = __builtin_elementwise_fma(__builtin_amdgcn_cvt_scalef32_pk_f32_fp4(W, 1.0f, 2), c2_, out[4 * (q) + 2]); \
        out[4 * (q) + 3] = __builtin_elementwise_fma(__builtin_amdgcn_cvt_scalef32_pk_f32_fp4(W, 1.0f, 3), c2_, out[4 * (q) + 3]); } while (0)
#define PV_COMP(buf, csrc, lb) do { unsigned cs_ = __float_as_uint(csrc); asm volatile("" : "+v"(cs_)); _Pragma("unroll") for (int k_ = 0; k_ < 16; ++k_) { \
        const float ca_ = __uint_as_float(__builtin_amdgcn_readlane(cs_, (lb) + 2 * k_)), cb_ = __uint_as_float(__builtin_amdgcn_readlane(cs_, (lb) + 2 * k_ + 1)); \
        const float cj_ = r ? cb_ : ca_; const f32x2_t c2_ = {cj_, cj_}; \
        PV_D4(buf[k_].x, 0); PV_D4(buf[k_].y, 1); PV_D4(buf[k_].z, 2); PV_D4(buf[k_].w, 3); } __builtin_amdgcn_sched_barrier(0); } while (0)
    PV_ROWS(vA, ne0, 0);
    for (; tok < MTOK; tok += nw) {
        const int e0 = ne0, e1 = ne1;
        const float c0 = nc0, c1 = nc1;
        {
            const size_t tn = (size_t)(tok + nw < MTOK ? tok + nw : tok);
            ne0 = pidx[tn * 128 + lane]; ne1 = pidx[tn * 128 + 64 + lane];
            nc0 = pgt[tn * 128 + lane]; nc1 = pgt[tn * 128 + 64 + lane];
        }
        f32x2_t out[16];
#pragma unroll
        for (int k = 0; k < 16; ++k) out[k] = (f32x2_t){0.f, 0.f};
        PV_ROWS(vB, e0, 32); PV_COMP(vA, c0, 0);
        PV_ROWS(vA, e1, 0);  PV_COMP(vB, c0, 32);
        PV_ROWS(vB, e1, 32); PV_COMP(vA, c1, 0);
        PV_ROWS(vA, ne0, 0); PV_COMP(vB, c1, 32);
        float4 xn[4]; float ss = 0.f;
#pragma unroll
        for (int q = 0; q < 4; ++q) {
            float fin[4];
#pragma unroll
            for (int b = 0; b < 2; ++b)
#pragma unroll
                for (int c = 0; c < 2; ++c) {
                    const float lo = out[4 * q + b][c], hi = out[4 * q + 2 + b][c];
                    const float mine = r ? hi : lo, send = r ? lo : hi;
                    fin[2 * b + c] = mine + __shfl_xor(send, 32, 64);
                }
            float4* xp = (float4*)(x + (size_t)tok * DM + 256 * q + 8 * (lane & 31) + (r ? 4 : 0));
            float4 a = *xp;
            a.x += fin[0]; a.y += fin[1]; a.z += fin[2]; a.w += fin[3];
            *xp = a;
            if (NORM) { xn[q] = a; ss += a.x * a.x + a.y * a.y + a.z * a.z + a.w * a.w; }
        }
        if (NORM) {
            ss = wave_sum(ss);
            const float rs = rsqrtf(ss * (1.f / DM) + EPS);
            bf16_t* hrow = (bf16_t*)(pws_() + WS_H) + (size_t)tok * DM + 8 * (lane & 31) + (r ? 4 : 0);
#pragma unroll
            for (int q = 0; q < 4; ++q) {
                ushort4 o; o.x = f2bf(xn[q].x * rs * gn[q].x); o.y = f2bf(xn[q].y * rs * gn[q].y); o.z = f2bf(xn[q].z * rs * gn[q].z); o.w = f2bf(xn[q].w * rs * gn[q].w);
                *(ushort4*)(hrow + 256 * q) = o;
            }
        }
    }
#undef PV_ROWS
#undef PV_COMP
#undef PV_D4
}


#ifndef PROBE_MASK
#define PROBE_MASK 0
#endif
#if PROBE_MASK
#define GB(k) do { GRID_BARRIER(); const unsigned long long now_ = wall_clock64(); if ((PROBE_MASK >> (k)) & 1) { const unsigned long long dt_ = now_ - tprev_; while (wall_clock64() - now_ < 3ull * dt_) __builtin_amdgcn_s_sleep(8); } GRID_BARRIER(); tprev_ = wall_clock64(); } while (0)
#else
#define GB(k) GRID_BARRIER()
#endif
__global__ void __launch_bounds__(512, 2) k_mega(Params kp) {
    float* sm = dynsmem;
    {
        unsigned long long* tab = (unsigned long long*)((char*)dynsmem + PTAB_OFF);
        if (threadIdx.x < 34) tab[threadIdx.x] = (unsigned long long)kp.in[threadIdx.x];
        if (threadIdx.x == 34) tab[34] = (unsigned long long)kp.out;
        if (threadIdx.x == 35) tab[35] = (unsigned long long)kp.ws;
        if (threadIdx.x == 36) { tab[36] = 0ull; tab[37] = 0ull; }
    }
    __syncthreads();
    Ctx p; p.kp = &kp;
    (void)xcd_barrier_post((unsigned*)(pws_() + WS_BAR), (volatile LAS unsigned*)((char*)dynsmem + PTAB_OFF + 36 * 8));
#define GRID_BARRIER() do { XcdBarrier bar_; bar_.bar = (unsigned*)(pws_() + WS_BAR); bar_.x = xb_xcc_id(); bar_.st = (volatile LAS unsigned*)((char*)dynsmem + PTAB_OFF + 36 * 8); xcd_barrier(bar_); } while (0)
    ph_weight_prep(p, sm);
    ph_subkeys_convert(p);
    ph_tab_convert_all(p);
    ph_rmsnorm(pin_(0), pin_(2), (bf16_t*)(pws_() + WS_H), MTOK);
    ph_rmsnorm(pin_(1), pin_(22), (bf16_t*)(pws_() + WS_HM), MMEM);
    GRID_BARRIER();
#if PROBE_MASK
    unsigned long long tprev_ = wall_clock64();
#endif
#pragma unroll 1
    for (int l = 0; l < DEPTH; ++l) {
#define XIN_ (l == 0 ? pin_(0) : pout_())
#define HBUF_ ((const bf16_t*)(pws_() + WS_H))
        { pg8::EpiBf16 E; E.O = (bf16_t*)(pws_() + WS_P); E.ldc = LDP; ph_gemm(HBUF_, (const bf16_t*)(pws_() + WT_IN) + (size_t)l * LDP * DM, MTOK, LDP, DM, E); }
        { pg8::EpiF32 E; E.C = (float*)(pws_() + WS_KM); E.R = nullptr; E.ldc = 256; ph_gemm((const bf16_t*)(pws_() + WS_HM), (const bf16_t*)(pws_() + WT_XK) + (size_t)l * 256 * DM, MMEM, 256, DM, E, 32); }
        { pg8::EpiF32 E; E.C = (float*)(pws_() + WS_VM); E.R = nullptr; E.ldc = 256; ph_gemm((const bf16_t*)(pws_() + WS_HM), (const bf16_t*)(pws_() + WT_XV) + (size_t)l * 256 * DM, MMEM, 256, DM, E, 64); }
        GB(2);
        ph_mem_prep(p, l);
        ph_dsa_prep(p, l);
        ph_scan_prep(p, l);
        GB(3);
        ph_scans(p, l, sm);
        GB(4);
        ph_mixer_finish(p, l);
        ph_dsa_main(p, l, sm);
        GB(5);
#define PANEL_SYNC() do { asm volatile("s_waitcnt vmcnt(0) lgkmcnt(0)" ::: "memory"); __syncthreads(); \
        if (threadIdx.x < 64) { __builtin_amdgcn_fence(__ATOMIC_ACQUIRE, "agent"); asm volatile("s_waitcnt vmcnt(0)" ::: "memory"); } \
        __syncthreads(); } while (0)
        if (nblk_() == MTOK / 256) {
            const int pm = bid_(), wv = tid_() >> 6;
            { pg8::EpiF32 E; E.C = pout_(); E.R = XIN_; E.ldc = DM; ph_gemm_panel((const bf16_t*)(pws_() + WS_Y), (const bf16_t*)(pws_() + WT_OUT) + (size_t)l * DM * DM, MTOK, DM, DM, E, pm); }
            PANEL_SYNC();
            ph_rmsnorm(pout_(), pin_(21) + (size_t)l * DM, (bf16_t*)(pws_() + WS_H), 256, pm * 256, wv, 8);
            PANEL_SYNC();
            { pg8::EpiF32 E; E.C = (float*)(pws_() + WS_QX); E.R = nullptr; E.ldc = 256; ph_gemm_panel(HBUF_, (const bf16_t*)(pws_() + WT_XQ) + (size_t)l * 256 * DM, MTOK, 256, DM, E, pm); }
            PANEL_SYNC();
            ph_xattn(p, l, pm * 16, 16, wv, 8);
            PANEL_SYNC();
            { pg8::EpiF32 E; E.C = pout_(); E.R = pout_(); E.ldc = DM; ph_gemm_panel((const bf16_t*)(pws_() + WS_OX), (const bf16_t*)(pws_() + WT_XO) + (size_t)l * DM * 256, MTOK, DM, 256, E, pm); }
            PANEL_SYNC();
            ph_rmsnorm(pout_(), pin_(29) + (size_t)l * DM, (bf16_t*)(pws_() + WS_H), 256, pm * 256, wv, 8, (unsigned char*)(pws_() + WS_H8));
            PANEL_SYNC();
            { pg8::EpiBf16 E; E.O = (bf16_t*)(pws_() + WS_QP); E.ldc = DM; ph_gemm_panel(HBUF_, (const bf16_t*)(pws_() + WT_PQ) + (size_t)l * DM * DM, MTOK, DM, DM, E, pm); }
            PANEL_SYNC();
            ph_peer_topk(p, l, sm, pm * 16, 16, wv, 8);
        }
        GB(13);
        ph_peer_u4(p, l, sm);
        GB(14);
        if (l + 1 < DEPTH) {
            ph_peer_v4<true>(p, l);
            ph_rmsnorm(pin_(1), pin_(22) + (size_t)(l + 1) * DM, (bf16_t*)(pws_() + WS_HM), MMEM);
        } else ph_peer_v4<false>(p, l);
        GB(17);
    }
}

extern "C" void kernel_launch(void* const* d_in, const int* in_sizes, int n_in, void* d_out, int out_size, void* d_ws, size_t ws_size, hipStream_t stream) {
    if (n_in != 34 || out_size != MTOK * DM || ws_size < WS_END) {
        fprintf(stderr, "kernel_launch: unexpected shapes (n_in %d out %d ws %zu need %zu)\n", n_in, out_size, ws_size, (size_t)WS_END);
        return;
    }
    static int grid = 0;
    if (!grid) {
        int dev = 0, cus = 0, per_cu = 0;
        (void)hipGetDevice(&dev);
        (void)hipDeviceGetAttribute(&cus, hipDeviceAttributeMultiprocessorCount, dev);
        (void)hipFuncSetAttribute((const void*)k_mega, hipFuncAttributeMaxDynamicSharedMemorySize, LDS_BYTES);
        (void)hipOccupancyMaxActiveBlocksPerMultiprocessor(&per_cu, (const void*)k_mega, 512, LDS_BYTES);
        if (per_cu < 1) fprintf(stderr, "kernel_launch: occupancy query reports %d blocks per CU\n", per_cu);
        grid = cus > 0 ? cus : 256;
    }
    Params p; memset(&p, 0, sizeof(p));
    for (int i = 0; i < 34; ++i) p.in[i] = (const float*)d_in[i];
    p.out = (float*)d_out; p.ws = (char*)d_ws;
    (void)hipMemsetAsync((char*)d_ws + WS_BAR, 0, XCD_BAR_WORDS * sizeof(unsigned), stream);
    hipLaunchKernelGGL(k_mega, dim3(grid), dim3(512), LDS_BYTES, stream, p);
}
```

```cpp
#include <hip/hip_runtime.h>
#include <stdint.h>
#include <stdio.h>
#include <string.h>

#define NB 32
#define SEQ 2048
#define DM 1024
#define MTOK (NB * SEQ)
#define DEPTH 4
#define NMEM 256
#define MMEM (NB * NMEM)
#define LDP 3328
#define NEXP 16384
#define EPS 1e-6f
#define PC_Z 0
#define PC_XBC 256
#define PC_GQKV 768
#define PC_GG 1536
#define PC_LQ 1792
#define PC_LK 1920
#define PC_LV 2048
#define PC_LR 2304
#define PC_DQ 2560
#define PC_DK 2816
#define PC_DV 2880
#define PC_IQ 2944
#define PC_IK 3200
#define PC_GLR 3232
#define PC_IW 3248
#define PC_DT 3256
#define PC_GA 3260
#define PC_GB 3264

typedef unsigned short bf16_t;

#define WS_BAR 0ull
#define WS_P 16384ull
#define SZ_P ((size_t)MTOK * LDP * 2)
#define WS_H (WS_P + SZ_P)
#define SZ_H ((size_t)MTOK * DM * 2)
#define WS_Y (WS_H + SZ_H)
#define SZ_Y ((size_t)MTOK * DM * 2)
#define WS_WP (WS_Y + SZ_Y)
#define SZ_WP ((size_t)DEPTH * DM * LDP * 4)
#define WT_IN (WS_WP)
#define WT_OUT (WT_IN + (size_t)DEPTH * LDP * DM * 2)
#define WT_XQ (WT_OUT + (size_t)DEPTH * DM * DM * 2)
#define WT_XK (WT_XQ + (size_t)DEPTH * 256 * DM * 2)
#define WT_XV (WT_XK + (size_t)DEPTH * 256 * DM * 2)
#define WT_XO (WT_XV + (size_t)DEPTH * 256 * DM * 2)
#define WT_PQ (WT_XO + (size_t)DEPTH * DM * 256 * 2)
#define WT_END (WT_PQ + (size_t)DEPTH * DM * DM * 2)
#define WS_QN (WS_WP + SZ_WP)
#define SZ_QN ((size_t)MTOK * 256 * 4)
#define WS_KN (WS_QN + SZ_QN)
#define SZ_KN ((size_t)MTOK * 64 * 4)
#define WS_IKN (WS_KN + SZ_KN)
#define SZ_IKN ((size_t)MTOK * 32 * 4)
#define WS_YPRE (WS_IKN + SZ_IKN)
#define SZ_YPRE ((size_t)MTOK * 256 * 4)
#define WS_HM (WS_YPRE + SZ_YPRE)
#define SZ_HM ((size_t)MMEM * DM * 2)
#define WS_KM (WS_HM + SZ_HM)
#define SZ_KM ((size_t)MMEM * 256 * 4)
#define WS_VM (WS_KM + SZ_KM)
#define SZ_VM ((size_t)MMEM * 256 * 4)
#define WS_KB (WS_VM + SZ_VM)
#define SZ_KB ((size_t)MMEM * 256 * 2)
#define WS_VTB (WS_KB + SZ_KB)
#define SZ_VTB ((size_t)MMEM * 256 * 2)
#define WS_VT (WS_VTB + SZ_VTB)
#define SZ_VT ((size_t)MTOK * 64 * 2)
#define WS_SKB (WS_VT + SZ_VT)
#define SZ_SKB ((size_t)DEPTH * 8 * 2 * 128 * 64 * 2)
#define WS_SC (WS_SKB + SZ_SKB)
#define SZ_SC ((size_t)MTOK * 16 * 4)
#define WS_DUMMY (WS_SC + SZ_SC)
#define SZ_DUMMY (65536ull)
#define WS_U4 (WS_DUMMY + SZ_DUMMY)
#define WS_V4 (WS_U4 + (size_t)DEPTH * NEXP * 512)
#define WS_USC (WS_V4 + (size_t)DEPTH * NEXP * 512)
#define WS_VSC (WS_USC + (size_t)DEPTH * NEXP * 4)
#define WS_END (WS_VSC + (size_t)DEPTH * NEXP * 4)
#define WS_QX (WS_P)
#define WS_OX (WS_P + (size_t)MTOK * 256 * 4)
#define WS_QP (WS_P + 96ull * 1024 * 1024)
#define WS_H8 (WS_P + 224ull * 1024 * 1024)
#define WS_PEI (WS_H8 + (size_t)MTOK * DM)
#define WS_PEG (WS_PEI + (size_t)MTOK * 128 * 4)
#define WS_PUS (WS_PEG + (size_t)MTOK * 128 * 4)
#define WS_PEND (WS_PUS + (size_t)MTOK * 128 * 4)
static_assert(WS_PEND <= WS_P + SZ_P, "P region aliases");

struct Params {
    const float* in[34];
    float* out;
    char* ws;
};

#define XB_TMO      128
#define XB_XCNT(j)  (256  + 64 * (j))
#define XB_XSUB(j)  (1280 + 64 * (j))
#define XB_XGEN(j)  (2304 + 64 * (j))
#define XB_TOP      3328
#define XB_TOPGEN   3392
#define XCD_BAR_WORDS 3456
#define XB_SPIN_CAP (1u << 18)
#define LAS __attribute__((address_space(3)))

__device__ __forceinline__ unsigned xb_ld(unsigned* p)              { return __hip_atomic_load(p, __ATOMIC_RELAXED, __HIP_MEMORY_SCOPE_AGENT); }
__device__ __forceinline__ unsigned xb_add(unsigned* p, unsigned v) { return __hip_atomic_fetch_add(p, v, __ATOMIC_RELAXED, __HIP_MEMORY_SCOPE_AGENT); }
__device__ __forceinline__ unsigned xb_xcc_id() { return (unsigned)__builtin_amdgcn_s_getreg((3 << 11) | 20) & 0xFu; }
#define XB_SPIN(cond, bar) do { unsigned _sp = 0; while (cond) { __builtin_amdgcn_s_sleep(1); \
    if ((++_sp & 255u) == 0u) { if (xb_ld(&(bar)[XB_TMO])) break; if (_sp > XB_SPIN_CAP) { atomicAdd(&(bar)[XB_TMO], 1u); break; } } } } while (0)

struct XcdBarrier {
    unsigned* bar; unsigned x;
    volatile LAS unsigned* st;
};

__device__ __forceinline__ XcdBarrier xcd_barrier_post(unsigned* bar, volatile LAS unsigned* st) {
    XcdBarrier b; b.bar = bar; b.x = xb_xcc_id(); b.st = st;
    if (threadIdx.x == 0) (void)xb_add(&bar[XB_XCNT(b.x)], 1u);
    return b;
}
__device__ __forceinline__ void xcd_barrier_complete(unsigned* bar, unsigned x, unsigned& nloc, unsigned& nx) {
    const unsigned G = gridDim.x * gridDim.y * gridDim.z;
    unsigned sum, cnt, mine, sp = 0u;
    for (;;) {
        sum = 0u; cnt = 0u; mine = 0u;
#pragma unroll
        for (unsigned j = 0; j < 16; ++j) { const unsigned c = xb_ld(&bar[XB_XCNT(j)]); sum += c; cnt += (c > 0u) ? 1u : 0u; mine = (j == x) ? c : mine; }
        if (sum == G) break;
        __builtin_amdgcn_s_sleep(1);
        if ((++sp & 255u) == 0u) { if (xb_ld(&bar[XB_TMO])) break; if (sp > XB_SPIN_CAP) { atomicAdd(&bar[XB_TMO], 1u); break; } }
    }
    nloc = mine > 0u ? mine : 1u; nx = cnt > 0u ? cnt : 1u;
}

__device__ __forceinline__ void xcd_barrier(const XcdBarrier& b) {
    asm volatile("s_waitcnt vmcnt(0)" ::: "memory");
    __syncthreads();
    if (threadIdx.x == 0) {
        unsigned* bar = b.bar;
        __builtin_amdgcn_s_waitcnt(0);
        unsigned nloc = b.st[0], nx = b.st[1];
        if (nloc == 0u) { xcd_barrier_complete(bar, b.x, nloc, nx); b.st[0] = nloc; b.st[1] = nx; }
        const unsigned old = xb_add(&bar[XB_XSUB(b.x)], 1u);
        const unsigned gen = old / nloc;
        if (old + 1u == (gen + 1u) * nloc) {
            __builtin_amdgcn_fence(__ATOMIC_RELEASE, "agent");
            asm volatile("s_waitcnt vmcnt(0)" ::: "memory");
            const unsigned og = xb_add(&bar[XB_TOP], 1u);
            const unsigned tg = og / nx;
            if (og + 1u == (tg + 1u) * nx) xb_add(&bar[XB_TOPGEN], 1u);
            else XB_SPIN(xb_ld(&bar[XB_TOPGEN]) == tg, bar);
            __builtin_amdgcn_fence(__ATOMIC_ACQUIRE, "agent");
            xb_add(&bar[XB_XGEN(b.x)], 1u);
            asm volatile("s_waitcnt vmcnt(0)" ::: "memory");
        } else {
            XB_SPIN(xb_ld(&bar[XB_XGEN(b.x)]) == gen, bar);
            __builtin_amdgcn_fence(__ATOMIC_ACQUIRE, "agent");
            asm volatile("s_waitcnt vmcnt(0)" ::: "memory");
        }
    }
    __syncthreads();
}


#define LDS_BYTES (144 * 1024)
#define PTAB_OFF (LDS_BYTES - 1024)
extern __shared__ __attribute__((aligned(16))) float dynsmem[];
struct Ctx { const Params* kp; };
#define pin_(i) (p.kp->in[i])
#define pout_() (p.kp->out)
#define pws_() (p.kp->ws)

__device__ __forceinline__ float bf2f(bf16_t v) { return __uint_as_float(((unsigned)v) << 16); }
__device__ __forceinline__ bf16_t f2bf(float f) { unsigned u = __float_as_uint(f); u += 0x7FFFu + ((u >> 16) & 1u); return (bf16_t)(u >> 16); }
__device__ __forceinline__ unsigned pk_bf16(float lo, float hi) { return (unsigned)f2bf(lo) | ((unsigned)f2bf(hi) << 16); }
__device__ __forceinline__ float wave_sum(float v) {
#pragma unroll
    for (int o = 32; o >= 1; o >>= 1) v += __shfl_xor(v, o, 64);
    return v;
}
__device__ __forceinline__ float wave_max(float v) {
#pragma unroll
    for (int o = 32; o >= 1; o >>= 1) v = fmaxf(v, __shfl_xor(v, o, 64));
    return v;
}
__device__ __forceinline__ float silu_f(float x) { return x * __builtin_amdgcn_rcpf(1.f + __expf(-x)); }
__device__ __forceinline__ float sigmoid_f(float x) { return __builtin_amdgcn_rcpf(1.f + __expf(-x)); }
__device__ __forceinline__ float softplus_f(float x) { return x > 20.f ? x : log1pf(__expf(x)); }
__device__ __forceinline__ float logsigmoid_f(float x) { return -softplus_f(-x); }
__device__ __forceinline__ float gelu_tanh_f(float x) { const float u = 0.7978845608028654f * (x + 0.044715f * x * x * x); return 0.5f * x * (1.f + tanhf(u)); }
__device__ __forceinline__ unsigned ford(float f) { f = f + 0.0f; unsigned u = __float_as_uint(f); return (u & 0x80000000u) ? ~u : (u | 0x80000000u); }
__device__ __forceinline__ float funord(unsigned k) { unsigned u = (k & 0x80000000u) ? (k & 0x7fffffffu) : ~k; return __uint_as_float(u); }
__device__ __forceinline__ unsigned long long wave_max_u64(unsigned long long v) {
#pragma unroll
    for (int o = 32; o >= 1; o >>= 1) {
        unsigned lo = __shfl_xor((unsigned)v, o, 64), hi = __shfl_xor((unsigned)(v >> 32), o, 64);
        unsigned long long w = ((unsigned long long)hi << 32) | lo;
        v = w > v ? w : v;
    }
    return v;
}
__device__ __forceinline__ int tid_() { int t = threadIdx.x; asm volatile("" : "+v"(t)); return t; }
__device__ __forceinline__ int bid_() { int b = blockIdx.x; asm volatile("" : "+s"(b)); return b; }
__device__ __forceinline__ int nblk_() { int g = gridDim.x; asm volatile("" : "+s"(g)); return g; }
__device__ __forceinline__ int gwave() { return (bid_() * 512 + tid_()) >> 6; }
__device__ __forceinline__ int nwaves() { return nblk_() * 8; }

namespace pg8 {
#define PG8_LAS __attribute__((address_space(3)))
typedef unsigned short bf16_t;
typedef short bf16x8 __attribute__((ext_vector_type(8)));
typedef float f32x4 __attribute__((ext_vector_type(4)));
typedef unsigned u32x4 __attribute__((ext_vector_type(4)));
constexpr int BM = 256, BK = 64, HALF = 128, HTB = HALF * BK * 2  , STAGE_BYTES = 8 * HTB, NXCD = 8, WGM = 8;

__host__ __device__ __forceinline__ int lds_byte(int r, int c) { const int st = (r >> 4) * 2 + (c >> 5), rr = r & 15, cc = c & 31, ob = rr * 64 + cc * 2; return st * 1024 + (ob ^ (((ob >> 9) & 1) << 5)); }
__host__ __device__ __forceinline__ void stage_rc(int b, int& R, int& C) { const int st = b / 1024, sb = b % 1024, swz = sb ^ (((sb >> 9) & 1) << 5); R = (st >> 1) * 16 + swz / 64; C = (st & 1) * 32 + (swz % 64) / 2; }
__host__ __device__ __forceinline__ int perm32(int rho) { const int n = rho >> 4, i = rho & 15; return 8 * (i >> 2) + 4 * n + (i & 3); }

struct Unit { int pm, pn; };
struct Gemm { const bf16_t* A; const bf16_t* Bt; int M, N, K; };

struct StaticOrder {
    int nM, nN, nwg, G, c;
    __host__ __device__ void init(int M, int N, int G_, int c_) { nM = M / BM; nN = N / BM; nwg = nM * nN; G = G_; c = c_; }
    __host__ __device__ bool next(int i, Unit& u) const {
        const long L = (long)i * G + c; if (L >= nwg) return false;
        int wgid = (int)L; { const int q = nwg / NXCD, r = nwg % NXCD, xcd = wgid % NXCD, off = wgid / NXCD; wgid = (xcd < r ? xcd * (q + 1) : r * (q + 1) + (xcd - r) * q) + off; }
        const int nig = WGM * nN, gid = wgid / nig, fm = gid * WGM, gsz = (nM - fm) < WGM ? (nM - fm) : WGM;
        u.pm = fm + ((wgid % nig) % gsz); u.pn = (wgid % nig) / gsz; return true;
    }
    __device__ __forceinline__ void a_ready(const Unit&) const {}
    __device__ __forceinline__ void done(const Unit&) const {}
};

__device__ __forceinline__ unsigned cvt_pk_bf16(float lo, float hi) { unsigned r; asm volatile("v_cvt_pk_bf16_f32 %0, %1, %2" : "=v"(r) : "v"(lo), "v"(hi)); return r; }
struct EpiF32 {
    static constexpr bool PERM = false, AFTER_DRAIN = false;
    float* C; const float* R; int ldc;
    __device__ __forceinline__ void operator()(const f32x4 (&acc)[2][2][4][2], const Unit& u, int wr, int wc, int fr, int fq) const {
        const int row0 = u.pm * BM + wr * 64 + fr, col0 = u.pn * BM + wc * 32 + 4 * fq;
#pragma unroll
        for (int ai = 0; ai < 2; ++ai)
#pragma unroll
            for (int m = 0; m < 4; ++m) { const size_t off = (size_t)(row0 + ai * HALF + m * 16) * ldc + col0;
                f32x4 rv[2][2];
#pragma unroll
                for (int bj = 0; bj < 2; ++bj)
#pragma unroll
                    for (int n = 0; n < 2; ++n) rv[bj][n] = R ? *(const f32x4*)(R + off + bj * HALF + n * 16) : (f32x4){0.f, 0.f, 0.f, 0.f};
#pragma unroll
                for (int bj = 0; bj < 2; ++bj)
#pragma unroll
                    for (int n = 0; n < 2; ++n) *(f32x4*)(C + off + bj * HALF + n * 16) = acc[ai][bj][m][n] + rv[bj][n]; }
    }
};
struct EpiBf16 {
    static constexpr bool PERM = true, AFTER_DRAIN = false;
    bf16_t* O; int ldc;
    __device__ __forceinline__ void operator()(const f32x4 (&acc)[2][2][4][2], const Unit& u, int wr, int wc, int fr, int fq) const {
        const int row0 = u.pm * BM + wr * 64 + fr, col0 = u.pn * BM + wc * 32 + 8 * fq;
#pragma unroll
        for (int ai = 0; ai < 2; ++ai)
#pragma unroll
            for (int m = 0; m < 4; ++m) { bf16_t* rowp = O + (size_t)(row0 + ai * HALF + m * 16) * ldc + col0;
#pragma unroll
                for (int bj = 0; bj < 2; ++bj) { const f32x4 v0 = acc[ai][bj][m][0], v1 = acc[ai][bj][m][1];
                    u32x4 w; w.x = cvt_pk_bf16(v0[0], v0[1]); w.y = cvt_pk_bf16(v0[2], v0[3]); w.z = cvt_pk_bf16(v1[0], v1[1]); w.w = cvt_pk_bf16(v1[2], v1[3]);
                    *(u32x4*)(rowp + bj * HALF) = w; } }
    }
};

template <class Epi, class Sched, bool STAMP = false>
__device__ __forceinline__ void gemm_phase(PG8_LAS unsigned char* lds, const Gemm g, const Sched& S, const Epi& E, unsigned long long* stamps, const int tid) {
    const int wid = __builtin_amdgcn_readfirstlane(tid >> 6), lane = tid & 63, wr = wid >> 2, wc = wid & 3, fr = lane & 15, fq = lane >> 4;
    const int K = g.K, nt = K / BK;
    int ts_lo = 0, ts_hi = 0, nts = 0; const unsigned long long rt_entry = STAMP ? (unsigned long long)wall_clock64() : 0ull;
#define PG8_STAMP() do { if (STAMP && wid == 0 && nts < 64) { const unsigned long long _c = (unsigned long long)clock64(); \
        ts_lo = (lane == nts) ? (int)(unsigned)_c : ts_lo; ts_hi = (lane == nts) ? (int)(unsigned)(_c >> 32) : ts_hi; ++nts; } } while (0)
    PG8_STAMP();
    unsigned voffA[2], voffB[2];
#pragma unroll
    for (int i = 0; i < 2; ++i) { int R, C; stage_rc(tid * 16 + i * 8192, R, C); const int Rb = Epi::PERM ? ((R & ~31) + perm32(R & 31)) : R;
        voffA[i] = (unsigned)(R * K + C) * 2u; voffB[i] = (unsigned)(Rb * K + C) * 2u; }
    const size_t kstep = (size_t)(BK * 2);
    const size_t hstep = (size_t)HALF * K * 2;
    const size_t tstep = 2 * hstep;
    const unsigned ldsw = (unsigned)wid * 1024u;
    const int aoff = lds_byte(wr * 64 + fr, fq * 8), boff = lds_byte(wc * 32 + fr, fq * 8);
#define PG8_SA(b, h) (((b) * 2 + (h)) * HTB)
#define PG8_SB(b, h) ((4 + (b) * 2 + (h)) * HTB)
#define PG8_STAGE(bufoff, gbase, voff) do { _Pragma("unroll") for (int _i = 0; _i < 2; ++_i) \
        __builtin_amdgcn_global_load_lds((const unsigned*)((const char*)(gbase) + (voff)[_i]), (PG8_LAS unsigned*)(lds + (bufoff) + ldsw + _i * 8192), 16, 0, 0); } while (0)
#define PG8_LDA(dst, b, h) do { _Pragma("unroll") for (int m = 0; m < 4; ++m) _Pragma("unroll") for (int k = 0; k < 2; ++k) dst[m][k] = *(const PG8_LAS bf16x8*)(lds + PG8_SA(b, h) + aoff + m * 2048 + k * 1024); } while (0)
#define PG8_LDB(dst, b, h) do { _Pragma("unroll") for (int n = 0; n < 2; ++n) _Pragma("unroll") for (int k = 0; k < 2; ++k) dst[n][k] = *(const PG8_LAS bf16x8*)(lds + PG8_SB(b, h) + boff + n * 2048 + k * 1024); } while (0)
#define PG8_MMA(ai, bj, At, Bt) do { __builtin_amdgcn_s_setprio(1); _Pragma("unroll") for (int m = 0; m < 4; ++m) _Pragma("unroll") for (int n = 0; n < 2; ++n) _Pragma("unroll") for (int k = 0; k < 2; ++k) \
        acc[ai][bj][m][n] = __builtin_amdgcn_mfma_f32_16x16x32_bf16(Bt[n][k], At[m][k], acc[ai][bj][m][n], 0, 0, 0); __builtin_amdgcn_s_setprio(0); } while (0)
#define PG8_WAIT_V(n) asm volatile("s_waitcnt vmcnt(" #n ")" ::: "memory")
#define PG8_WAIT_L(n) asm volatile("s_waitcnt lgkmcnt(" #n ")" ::: "memory")
#define PG8_BAR __builtin_amdgcn_s_barrier()
#define PG8_SCHED __builtin_amdgcn_sched_barrier(0)
    Unit cur, nxt; int ui = 0;
    if (!S.next(0, cur)) return;
    f32x4 acc[2][2][4][2];
#pragma unroll
    for (int a = 0; a < 2; ++a)
#pragma unroll
        for (int b = 0; b < 2; ++b)
#pragma unroll
            for (int m = 0; m < 4; ++m)
#pragma unroll
                for (int n = 0; n < 2; ++n) acc[a][b][m][n] = (f32x4){0.f, 0.f, 0.f, 0.f};
    bf16x8 At[4][2], B0[2][2], B1[2][2];
    const char* cA = (const char*)g.A + (size_t)cur.pm * tstep; const char* cB = (const char*)g.Bt + (size_t)cur.pn * tstep;
    S.a_ready(cur);
    PG8_STAGE(PG8_SB(0, 0), cB, voffB); PG8_STAGE(PG8_SA(0, 0), cA, voffA); PG8_STAGE(PG8_SB(0, 1), cB + hstep, voffB); PG8_STAGE(PG8_SA(0, 1), cA + hstep, voffA);
    if (wr == 1) PG8_BAR;
    PG8_WAIT_V(4); PG8_BAR;
    PG8_STAGE(PG8_SB(1, 0), cB + kstep, voffB); PG8_STAGE(PG8_SA(1, 0), cA + kstep, voffA); PG8_STAGE(PG8_SB(1, 1), cB + hstep + kstep, voffB);
    PG8_WAIT_V(6); PG8_BAR;
    PG8_STAMP();
    for (;;) {
        const bool has_next = S.next(ui + 1, nxt);
        const char* nA = has_next ? (const char*)g.A + (size_t)nxt.pm * tstep : cA; const char* nB = has_next ? (const char*)g.Bt + (size_t)nxt.pn * tstep : cB;
        for (int t = 0; t < nt; t += 2) {
            const bool last = (t == nt - 2);
            const char* a1 = cA + (size_t)(t + 1) * kstep;
            const char* a2 = last ? nA : cA + (size_t)(t + 2) * kstep; const char* b2 = last ? nB : cB + (size_t)(t + 2) * kstep;
            const char* a3 = a2 + kstep; const char* b3 = b2 + kstep;
            if (last && has_next) S.a_ready(nxt);
            PG8_LDB(B0, 0, 0); PG8_SCHED; PG8_LDA(At, 0, 0); PG8_STAGE(PG8_SA(1, 1), a1 + hstep, voffA);
            PG8_WAIT_L(8); PG8_BAR; PG8_WAIT_L(0); PG8_MMA(0, 0, At, B0); PG8_BAR; PG8_SCHED;
            PG8_LDB(B1, 0, 1); PG8_STAGE(PG8_SB(0, 0), b2, voffB);
            PG8_BAR; PG8_WAIT_L(0); PG8_MMA(0, 1, At, B1); PG8_BAR;
            PG8_LDA(At, 0, 1); PG8_STAGE(PG8_SA(0, 0), a2, voffA);
            PG8_BAR; PG8_WAIT_L(0); PG8_MMA(1, 0, At, B0); PG8_BAR; PG8_SCHED;
            PG8_STAGE(PG8_SB(0, 1), b2 + hstep, voffB);
            PG8_WAIT_V(6); PG8_BAR; PG8_MMA(1, 1, At, B1); PG8_BAR;
            PG8_LDB(B0, 1, 0); PG8_SCHED; PG8_LDA(At, 1, 0); PG8_STAGE(PG8_SA(0, 1), a2 + hstep, voffA);
            PG8_WAIT_L(8); PG8_BAR; PG8_WAIT_L(0); PG8_MMA(0, 0, At, B0); PG8_BAR; PG8_SCHED;
            PG8_LDB(B1, 1, 1); PG8_STAGE(PG8_SB(1, 0), b3, voffB);
            PG8_BAR; PG8_WAIT_L(0); PG8_MMA(0, 1, At, B1); PG8_BAR;
            PG8_LDA(At, 1, 1); PG8_STAGE(PG8_SA(1, 0), a3, voffA);
            PG8_BAR; PG8_WAIT_L(0); PG8_MMA(1, 0, At, B0); PG8_BAR; PG8_SCHED;
            PG8_STAGE(PG8_SB(1, 1), b3 + hstep, voffB);
            PG8_WAIT_V(6); PG8_BAR; PG8_MMA(1, 1, At, B1); PG8_BAR;
        }
        PG8_STAMP();
        if constexpr (!Epi::AFTER_DRAIN) { E(acc, cur, wr, wc, fr, fq); S.done(cur); }
        PG8_STAMP();
        if (!has_next) break;
#pragma unroll
        for (int a = 0; a < 2; ++a)
#pragma unroll
            for (int b = 0; b < 2; ++b)
#pragma unroll
                for (int m = 0; m < 4; ++m)
#pragma unroll
                    for (int n = 0; n < 2; ++n) acc[a][b][m][n] = (f32x4){0.f, 0.f, 0.f, 0.f};
        cur = nxt; cA = nA; cB = nB; ++ui;
    }
    PG8_WAIT_V(0);
    if (wr == 0) PG8_BAR;
    PG8_BAR;
    if constexpr (Epi::AFTER_DRAIN) { E.fused(acc, cur, wr, wc, fr, fq, lds, wid, lane); S.done(cur); }
    PG8_STAMP();
    if (STAMP && wid == 0) { stamps[lane] = lane < nts ? (((unsigned long long)(unsigned)ts_hi << 32) | (unsigned)ts_lo) : 0ull;
        if (lane == 62) stamps[62] = rt_entry; if (lane == 63) stamps[63] = (unsigned long long)wall_clock64(); }
#undef PG8_STAMP
#undef PG8_SA
#undef PG8_SB
#undef PG8_STAGE
#undef PG8_LDA
#undef PG8_LDB
#undef PG8_MMA
#undef PG8_WAIT_V
#undef PG8_WAIT_L
#undef PG8_BAR
#undef PG8_SCHED
}
}

namespace pg8 {
struct PanelOrder {
    int pm, nN;
    __device__ void init(int pm_, int N) { pm = pm_; nN = N / BM; }
    __device__ bool next(int i, Unit& u) const { if (i >= nN) return false; u.pm = pm; u.pn = i; return true; }
    __device__ __forceinline__ void a_ready(const Unit&) const {}
    __device__ __forceinline__ void done(const Unit&) const {}
};
}
template <class Epi> __device__ __forceinline__ void ph_gemm_panel(const bf16_t* A, const bf16_t* Bt, int M, int N, int K, const Epi& E, int pm) {
    pg8::Gemm g; g.A = A; g.Bt = Bt; g.M = M; g.N = N; g.K = K;
    pg8::PanelOrder S; S.init(pm, N);
    pg8::gemm_phase<Epi, pg8::PanelOrder, false>((PG8_LAS unsigned char*)dynsmem, g, S, E, nullptr, tid_());
}
template <class Epi> __device__ __forceinline__ void ph_gemm(const bf16_t* A, const bf16_t* Bt, int M, int N, int K, const Epi& E, int crot = 0) {
    pg8::Gemm g; g.A = A; g.Bt = Bt; g.M = M; g.N = N; g.K = K;
    const int nb_ = nblk_();
    pg8::StaticOrder S; S.init(M, N, nb_, (bid_() + nb_ - crot) % nb_);
    pg8::gemm_phase<Epi, pg8::StaticOrder, false>((PG8_LAS unsigned char*)dynsmem, g, S, E, nullptr, tid_());
}

__device__ __forceinline__ int pcol_to_orig(int c) {
    if (c < 768) return c;
    if (c < 1536) return c - 768 + 772;
    if (c < 1792) return c - 1536 + 1548;
    if (c < 1920) return c - 1792 + 1804;
    if (c < 2048) return c - 1920 + 1932;
    if (c < 2304) return c - 2048 + 2060;
    if (c < 2560) return c - 2304 + 2332;
    if (c < 2816) return c - 2560 + 2588;
    if (c < 2880) return c - 2816 + 2844;
    if (c < 2944) return c - 2880 + 2908;
    if (c < 3200) return c - 2944 + 2972;
    if (c < 3232) return c - 3200 + 3228;
    if (c < 3248) return c - 3232 + 2316;
    if (c < 3256) return c - 3248 + 3260;
    if (c < 3260) return c - 3256 + 768;
    if (c < 3264) return c - 3260 + 1540;
    if (c < 3268) return c - 3264 + 1544;
    return -1;
}
__device__ __forceinline__ void wtrans_job(const float* W, int K, int ldw, bf16_t* Wt, int Npad, bool mapped, float* tile) {
    const int tid = tid_();
    const int tn = Npad / 64, tk = K / 64;
    for (int t = bid_(); t < tn * tk; t += nblk_()) {
        const int n0 = (t / tk) * 64, k0 = (t % tk) * 64;
        __syncthreads();
        for (int idx = tid; idx < 4096; idx += 512) {
            const int kk = idx >> 6, nn = idx & 63;
            const int col = mapped ? pcol_to_orig(n0 + nn) : (n0 + nn);
            tile[kk * 65 + nn] = col >= 0 ? W[(size_t)(k0 + kk) * ldw + col] : 0.f;
        }
        __syncthreads();
        for (int idx = tid; idx < 4096; idx += 512) {
            const int nn = idx >> 6, kk = idx & 63;
            Wt[(size_t)(n0 + nn) * K + k0 + kk] = f2bf(tile[kk * 65 + nn]);
        }
    }
}
__device__ __forceinline__ void ph_weight_prep(const Ctx& p, float* sm) {
#pragma unroll 1
    for (int j = 0; j < 7 * DEPTH; ++j) {
        const int l = j / 7, w = j % 7;
        const float* W; int K, ldw, Npad; bf16_t* Wt; bool mapped = false;
        if (w == 0) { W = pin_(3) + (size_t)l * DM * 3268; K = DM; ldw = 3268; Npad = LDP; Wt = (bf16_t*)(pws_() + WT_IN) + (size_t)l * LDP * DM; mapped = true; }
        else if (w == 1) { W = pin_(20) + (size_t)l * DM * DM; K = DM; ldw = DM; Npad = DM; Wt = (bf16_t*)(pws_() + WT_OUT) + (size_t)l * DM * DM; }
        else if (w == 2) { W = pin_(23) + (size_t)l * DM * 256; K = DM; ldw = 256; Npad = 256; Wt = (bf16_t*)(pws_() + WT_XQ) + (size_t)l * 256 * DM; }
        else if (w == 3) { W = pin_(24) + (size_t)l * DM * 256; K = DM; ldw = 256; Npad = 256; Wt = (bf16_t*)(pws_() + WT_XK) + (size_t)l * 256 * DM; }
        else if (w == 4) { W = pin_(25) + (size_t)l * DM * 256; K = DM; ldw = 256; Npad = 256; Wt = (bf16_t*)(pws_() + WT_XV) + (size_t)l * 256 * DM; }
        else if (w == 5) { W = pin_(26) + (size_t)l * 256 * DM; K = 256; ldw = DM; Npad = DM; Wt = (bf16_t*)(pws_() + WT_XO) + (size_t)l * DM * 256; }
        else { W = pin_(30) + (size_t)l * DM * DM; K = DM; ldw = DM; Npad = DM; Wt = (bf16_t*)(pws_() + WT_PQ) + (size_t)l * DM * DM; }
        wtrans_job(W, K, ldw, Wt, Npad, mapped, sm);
    }
}

#define H8_SCALE 16.f
__device__ __forceinline__ unsigned pack4_fp8(float4 a, float sc);
__device__ __forceinline__ void ph_rmsnorm(const float* __restrict__ x, const float* __restrict__ g, bf16_t* __restrict__ out, int rows, int row0 = 0, int w0 = -1, int wstep = 0, unsigned char* out8 = nullptr) {
    const int lane = tid_() & 63;
    if (w0 < 0) { w0 = gwave(); wstep = nwaves(); }
    float4 gq[4];
#pragma unroll
    for (int i = 0; i < 4; ++i) gq[i] = ((const float4*)g)[lane + 64 * i];
    for (int r = row0 + w0; r < row0 + rows; r += wstep) {
        const float4* xr = (const float4*)(x + (size_t)r * DM);
        float4 v[4]; float ss = 0.f;
#pragma unroll
        for (int i = 0; i < 4; ++i) { v[i] = xr[lane + 64 * i]; ss += v[i].x * v[i].x + v[i].y * v[i].y + v[i].z * v[i].z + v[i].w * v[i].w; }
        ss = wave_sum(ss);
        const float rs = rsqrtf(ss * (1.f / DM) + EPS);
#pragma unroll
        for (int i = 0; i < 4; ++i) {
            const float4 gg = gq[i];
            ushort4 o; o.x = f2bf(v[i].x * rs * gg.x); o.y = f2bf(v[i].y * rs * gg.y); o.z = f2bf(v[i].z * rs * gg.z); o.w = f2bf(v[i].w * rs * gg.w);
            *(ushort4*)(out + (size_t)r * DM + (size_t)(lane + 64 * i) * 4) = o;
            if (out8) *(unsigned*)(out8 + (size_t)r * DM + (size_t)(lane + 64 * i) * 4) = pack4_fp8(make_float4(v[i].x * rs * gg.x, v[i].y * rs * gg.y, v[i].z * rs * gg.z, v[i].w * rs * gg.w), H8_SCALE);
        }
    }
}

template <int OUTMODE>
__device__ __forceinline__ void ph_sgemm(const bf16_t* __restrict__ A, int lda, const float* __restrict__ B, int ldb, void* Cv, int ldc, const float* R, int ldr,
                         int M, int N, int K, float* smem) {
    float* As = smem;
    float* Bs = smem + 16 * 132;
    const int tid = tid_(), tx = tid & 31, ty = tid >> 5;
    const int ntn = N / 128, ntiles = (M / 128) * ntn;
    for (int tile = bid_(); tile < ntiles; tile += nblk_()) {
        const int tm = tile / ntn, tn = tile % ntn;
        float acc[8][4];
#pragma unroll
        for (int i = 0; i < 8; ++i)
#pragma unroll
            for (int j = 0; j < 4; ++j) acc[i][j] = 0.f;
        const int arow = tid >> 2, akq = (tid & 3) * 4;
        const int bk = tid >> 5, bn = (tid & 31) * 4;
        for (int k0 = 0; k0 < K; k0 += 16) {
            const ushort4 av = *(const ushort4*)(A + (size_t)(tm * 128 + arow) * lda + k0 + akq);
            const float4 bv = *(const float4*)(B + (size_t)(k0 + bk) * ldb + tn * 128 + bn);
            __syncthreads();
            As[(akq + 0) * 132 + arow] = bf2f(av.x); As[(akq + 1) * 132 + arow] = bf2f(av.y);
            As[(akq + 2) * 132 + arow] = bf2f(av.z); As[(akq + 3) * 132 + arow] = bf2f(av.w);
            *(float4*)(Bs + bk * 132 + bn) = bv;
            __syncthreads();
#pragma unroll
            for (int k = 0; k < 16; ++k) {
                const float4 a0 = *(const float4*)(As + k * 132 + ty * 8), a1 = *(const float4*)(As + k * 132 + ty * 8 + 4);
                const float4 b = *(const float4*)(Bs + k * 132 + tx * 4);
                const float a[8] = {a0.x, a0.y, a0.z, a0.w, a1.x, a1.y, a1.z, a1.w};
#pragma unroll
                for (int i = 0; i < 8; ++i) { acc[i][0] += a[i] * b.x; acc[i][1] += a[i] * b.y; acc[i][2] += a[i] * b.z; acc[i][3] += a[i] * b.w; }
            }
        }
#pragma unroll
        for (int i = 0; i < 8; ++i) {
            const size_t row = (size_t)tm * 128 + ty * 8 + i; const int col = tn * 128 + tx * 4;
            if (OUTMODE == 0) {
                ushort4 o; o.x = f2bf(acc[i][0]); o.y = f2bf(acc[i][1]); o.z = f2bf(acc[i][2]); o.w = f2bf(acc[i][3]);
                *(ushort4*)((bf16_t*)Cv + row * ldc + col) = o;
            } else if (OUTMODE == 1) {
                *(float4*)((float*)Cv + row * ldc + col) = make_float4(acc[i][0], acc[i][1], acc[i][2], acc[i][3]);
            } else {
                const float4 r = *(const float4*)(R + row * ldr + col);
                *(float4*)((float*)Cv + row * ldc + col) = make_float4(r.x + acc[i][0], r.y + acc[i][1], r.z + acc[i][2], r.w + acc[i][3]);
            }
        }
    }
}

#define WS_HS WS_H
#define WS_VG WS_YPRE
#define WS_DEC (WS_YPRE + (size_t)MTOK * 256 * 2)

__device__ __forceinline__ float quad_sum(float v) {
    v += __int_as_float(__builtin_amdgcn_mov_dpp(__float_as_int(v), 0xB1, 0xF, 0xF, true));
    v += __int_as_float(__builtin_amdgcn_mov_dpp(__float_as_int(v), 0x4E, 0xF, 0xF, true));
    return v;
}
__device__ __forceinline__ float bflo(unsigned w) { return __uint_as_float(w << 16); }
__device__ __forceinline__ float bfhi(unsigned w) { return __uint_as_float(w & 0xffff0000u); }

__device__ __forceinline__ float oct_sum(float v) {
    v += __int_as_float(__builtin_amdgcn_mov_dpp(__float_as_int(v), 0xB1, 0xF, 0xF, true));
    v += __int_as_float(__builtin_amdgcn_mov_dpp(__float_as_int(v), 0x4E, 0xF, 0xF, true));
    v += __int_as_float(__builtin_amdgcn_mov_dpp(__float_as_int(v), 0x141, 0xF, 0xF, true));
    return v;
}
__device__ __forceinline__ void unpack8(const uint4 r, float (&o)[8]) {
    o[0] = bflo(r.x); o[1] = bfhi(r.x); o[2] = bflo(r.y); o[3] = bfhi(r.y); o[4] = bflo(r.z); o[5] = bfhi(r.z); o[6] = bflo(r.w); o[7] = bfhi(r.w);
}
__device__ __forceinline__ uint4 pack8(const float (&v)[8]) {
    uint4 o; o.x = pk_bf16(v[0], v[1]); o.y = pk_bf16(v[2], v[3]); o.z = pk_bf16(v[4], v[5]); o.w = pk_bf16(v[6], v[7]); return o;
}
__device__ __forceinline__ void load8f(const float* p, float (&o)[8]) {
    const float4 a = *(const float4*)p, b = *(const float4*)(p + 4);
    o[0] = a.x; o[1] = a.y; o[2] = a.z; o[3] = a.w; o[4] = b.x; o[5] = b.y; o[6] = b.z; o[7] = b.w;
}
__device__ __forceinline__ void conv8(const bf16_t* P, size_t tok, int t, int pcol, const float* w, int ldw, int cc, float (&acc)[8]) {
#pragma unroll
    for (int j = 0; j < 4; ++j) {
        if (t - 3 + j >= 0) {
            float xv[8], wv[8];
            unpack8(*(const uint4*)(P + (tok - (size_t)(3 - j)) * LDP + pcol), xv);
            load8f(w + j * ldw + cc, wv);
#pragma unroll
            for (int i = 0; i < 8; ++i) acc[i] = __builtin_fmaf(wv[i], xv[i], acc[i]);
        }
    }
}
__device__ __forceinline__ void conv8r(const uint4 (&xt)[4], int t, const float* w, int ldw, int cc, float (&acc)[8]) {
#pragma unroll
    for (int j = 0; j < 4; ++j) {
        float xv[8], wv[8];
        unpack8(xt[j], xv);
        load8f(w + j * ldw + cc, wv);
        const float m = (t - 3 + j >= 0) ? 1.f : 0.f;
#pragma unroll
        for (int i = 0; i < 8; ++i) acc[i] = __builtin_fmaf(wv[i] * m, xv[i], acc[i]);
    }
}
__device__ __forceinline__ void conv8w(const uint4 (&xt)[4], int t, const float (&wv)[4][8], float (&acc)[8]) {
#pragma unroll
    for (int j = 0; j < 4; ++j) {
        float xv[8];
        unpack8(xt[j], xv);
        const float m = (t - 3 + j >= 0) ? 1.f : 0.f;
#pragma unroll
        for (int i = 0; i < 8; ++i) acc[i] = __builtin_fmaf(wv[j][i] * m, xv[i], acc[i]);
    }
}
__device__ __forceinline__ void ph_scan_prep(const Ctx& p, int l) {
    const bf16_t* P = (const bf16_t*)(pws_() + WS_P);
    bf16_t* HS = (bf16_t*)(pws_() + WS_HS);
    bf16_t* VG = (bf16_t*)(pws_() + WS_VG);
    float* DEC = (float*)(pws_() + WS_DEC);
    float* SC = (float*)(pws_() + WS_SC);
    const float* scw = pin_(4) + (size_t)l * 4 * 512;
    const float* scb = pin_(5) + (size_t)l * 512;
    const float* gcw = pin_(10) + (size_t)l * 4 * 768;
    const float* wg = pin_(14) + (size_t)l * 16 * 128;
    const float* bg = pin_(15) + (size_t)l * 128;
    const int lane = tid_() & 63;
    const int hsc = lane & 3, wsc = (lane >> 2) & 3;
    const float k_dtb = pin_(6)[l * 4 + hsc], k_alog = __expf(pin_(7)[l * 4 + hsc]), k_galog = __expf(pin_(11)[l * 4 + hsc]), k_gdtb = pin_(12)[l * 4 + hsc];
    const int sccol = wsc < 2 ? PC_DT + hsc : (wsc == 2 ? PC_GA + hsc : PC_GB + hsc);
    const int nw = nwaves();
    {
        uint4 nxa[4], ngl0, ngl1; unsigned short nsc;
#define SP_LOAD(tk) do { const int t_ = (tk) % SEQ; const size_t row_ = (size_t)(tk) * LDP; \
        _Pragma("unroll") for (int j = 0; j < 4; ++j) { const size_t rj = (t_ - 3 + j >= 0) ? row_ - (size_t)(3 - j) * LDP : row_; nxa[j] = *(const uint4*)(P + rj + PC_XBC + 8 * lane); } \
        ngl0 = *(const uint4*)(P + row_ + PC_GLR); ngl1 = *(const uint4*)(P + row_ + PC_GLR + 8); nsc = P[row_ + sccol]; } while (0)
        float wsx[4][8], bsx[8], wgl[2][16], bgl[2];
#pragma unroll
        for (int j = 0; j < 4; ++j) load8f(scw + j * 512 + 8 * lane, wsx[j]);
        load8f(scb + 8 * lane, bsx);
#pragma unroll
        for (int i = 0; i < 2; ++i) { bgl[i] = bg[lane + 64 * i];
#pragma unroll
            for (int r = 0; r < 16; ++r) wgl[i][r] = wg[r * 128 + lane + 64 * i]; }
        int tok = gwave();
        SP_LOAD(tok);
        for (; tok < MTOK; tok += nw) {
            const int t = tok % SEQ;
            uint4 xa[4];
#pragma unroll
            for (int j = 0; j < 4; ++j) xa[j] = nxa[j];
            const uint4 gl0 = ngl0, gl1 = ngl1;
            const float scraw = bf2f(nsc);
            { const int tn = tok + nw < MTOK ? tok + nw : tok; SP_LOAD(tn); }
            __builtin_amdgcn_sched_barrier(0);
            {
                float acc[8];
#pragma unroll
                for (int i = 0; i < 8; ++i) acc[i] = bsx[i];
                conv8w(xa, t, wsx, acc);
#pragma unroll
                for (int i = 0; i < 8; ++i) acc[i] = silu_f(acc[i]);
                *(uint4*)(HS + (size_t)tok * 1024 + 8 * lane) = pack8(acc);
            }
            {
                float v;
                if (wsc < 2) { const float dt = softplus_f(scraw + k_dtb); v = wsc == 0 ? dt : __expf(-dt * k_alog); }
                else if (wsc == 2) v = __expf(-k_galog * softplus_f(scraw + k_gdtb));
                else v = sigmoid_f(scraw);
                if (lane < 16) SC[(size_t)tok * 16 + lane] = v;
            }
            {
                float gl[16];
                { float a8[8], b8[8]; unpack8(gl0, a8); unpack8(gl1, b8);
#pragma unroll
                  for (int i = 0; i < 8; ++i) { gl[i] = a8[i]; gl[8 + i] = b8[i]; } }
#pragma unroll
                for (int i = 0; i < 2; ++i) {
                    const int c = lane + 64 * i;
                    float acc = bgl[i];
#pragma unroll
                    for (int r = 0; r < 16; ++r) acc = __builtin_fmaf(gl[r], wgl[i][r], acc);
                    DEC[(size_t)tok * 128 + c] = __expf(logsigmoid_f(acc) * (1.f / 16.f));
                }
            }
        }
#undef SP_LOAD
    }
    {
        uint4 nxq[4], nxv4[4];
#define SP_LOAD(tk) do { const int t_ = (tk) % SEQ; const size_t row_ = (size_t)(tk) * LDP; \
        _Pragma("unroll") for (int j = 0; j < 4; ++j) { const size_t rj = (t_ - 3 + j >= 0) ? row_ - (size_t)(3 - j) * LDP : row_; \
            nxq[j] = *(const uint4*)(P + rj + PC_GQKV + 8 * lane); nxv4[j] = *(const uint4*)(P + rj + PC_GQKV + 512 + 8 * (lane & 31)); } } while (0)
        float wq[4][8], wv[4][8];
#pragma unroll
        for (int j = 0; j < 4; ++j) { load8f(gcw + j * 768 + 8 * lane, wq[j]); load8f(gcw + j * 768 + 512 + 8 * (lane & 31), wv[j]); }
        int tok = gwave();
        SP_LOAD(tok);
        for (; tok < MTOK; tok += nw) {
            const int t = tok % SEQ;
            uint4 xq[4], xv4[4];
#pragma unroll
            for (int j = 0; j < 4; ++j) { xq[j] = nxq[j]; xv4[j] = nxv4[j]; }
            { const int tn = tok + nw < MTOK ? tok + nw : tok; SP_LOAD(tn); }
            __builtin_amdgcn_sched_barrier(0);
            {
                float acc[8];
#pragma unroll
                for (int i = 0; i < 8; ++i) acc[i] = 0.f;
                conv8w(xq, t, wq, acc);
                float ss = 0.f;
#pragma unroll
                for (int i = 0; i < 8; ++i) { acc[i] = silu_f(acc[i]); ss += acc[i] * acc[i]; }
                ss = oct_sum(ss);
                const float sc = rsqrtf(ss + EPS) * (lane < 32 ? 0.125f : 1.f);
#pragma unroll
                for (int i = 0; i < 8; ++i) acc[i] *= sc;
                *(uint4*)(HS + (size_t)tok * 1024 + 512 + 8 * lane) = pack8(acc);
            }
            {
                float acc[8];
#pragma unroll
                for (int i = 0; i < 8; ++i) acc[i] = 0.f;
                conv8w(xv4, t, wv, acc);
#pragma unroll
                for (int i = 0; i < 8; ++i) acc[i] = silu_f(acc[i]);
                if (lane < 32) *(uint4*)(VG + (size_t)tok * 256 + 8 * lane) = pack8(acc);
            }
        }
#undef SP_LOAD
    }
}

#define SCAN_LDS_WAVE 4608
typedef float f2_t __attribute__((ext_vector_type(2)));
__device__ __forceinline__ f2_t mk2(float a, float b) { f2_t r; r.x = a; r.y = b; return r; }
__device__ __forceinline__ void st8f(char* dst, const uint4 v) {
    *(float4*)dst = make_float4(bflo(v.x), bfhi(v.x), bflo(v.y), bfhi(v.y));
    *(float4*)(dst + 16) = make_float4(bflo(v.z), bfhi(v.z), bflo(v.w), bfhi(v.w));
}
__device__ __forceinline__ void ph_scans(const Ctx& p, int l, float* smem) {
    const bf16_t* P = (const bf16_t*)(pws_() + WS_P);
    const bf16_t* HS = (const bf16_t*)(pws_() + WS_HS);
    const bf16_t* VG = (const bf16_t*)(pws_() + WS_VG);
    const float* DEC = (const float*)(pws_() + WS_DEC);
    const float* SC = (const float*)(pws_() + WS_SC);
    bf16_t* Y = (bf16_t*)(pws_() + WS_Y);
    const int tid = tid_(), lane = tid & 63, wave = tid >> 6;
    if (nblk_() != 256) return;
    const int role = wave < 2 ? 0 : (wave < 6 ? 1 : 2);
    const int idx = (role == 0 ? wave : (role == 1 ? wave - 2 : wave - 6)) * 256 + bid_();
    const int bh = role == 1 ? (idx >> 3) : (idx >> 2), b = bh >> 2, h = bh & 3;
    const int colbase = role == 1 ? (idx & 7) * 8 : (idx & 3) * 16;
    const int cl = role == 1 ? (lane >> 3) : (lane >> 2);
    const int col = colbase + cl;
    const int sq = role == 1 ? (lane & 7) : (lane & 3);
    const size_t tb = (size_t)b * SEQ;
    bf16_t* dummy = (bf16_t*)(pws_() + WS_DUMMY) + (tid & 511) * 8;
    char* lw = (char*)smem + wave * SCAN_LDS_WAVE;
    char* lrow = lw;
    char* lcol = lw + 4096;
    float* lsc = (float*)(lw + 4352);
    const int fs = lane >> 3, fp = lane & 7;
    if (role == 0) {
        const int g = h >> 1;
        const float Dh = pin_(8)[l * 4 + h];
        uint4 f0, f1; unsigned fc = 0u; float fsc = 0.f;
        f2_t st[8];
#pragma unroll
        for (int i = 0; i < 8; ++i) st[i] = mk2(0.f, 0.f);
        auto fetch = [&](int t0) {
            const size_t tok = tb + t0 + fs;
            const bf16_t* src = HS + tok * 1024 + (fp < 4 ? 256 + g * 64 + fp * 16 : 384 + g * 64 + (fp - 4) * 16);
            f0 = *(const uint4*)src; f1 = *(const uint4*)(src + 8);
            fc = *(const unsigned*)(HS + tok * 1024 + h * 64 + colbase + fp * 2);
            if (lane < 16) fsc = SC[(tb + t0 + (lane >> 1)) * 16 + (lane & 1) * 4 + h];
        };
        fetch(0);
        for (int t0 = 0; t0 < SEQ; t0 += 8) {
            st8f(lrow + fs * 512 + fp * 64, f0); st8f(lrow + fs * 512 + fp * 64 + 32, f1);
            *(unsigned*)(lcol + fs * 32 + fp * 4) = fc;
            if (lane < 16) lsc[lane] = fsc;
            if (t0 + 8 < SEQ) fetch(t0 + 8);
#pragma unroll
            for (int i = 0; i < 8; ++i) {
                const char* rb = lrow + i * 512 + sq * 64;
                const float4 b0 = *(const float4*)rb, b1 = *(const float4*)(rb + 16), b2 = *(const float4*)(rb + 32), b3 = *(const float4*)(rb + 48);
                const float4 c0 = *(const float4*)(rb + 256), c1 = *(const float4*)(rb + 272), c2 = *(const float4*)(rb + 288), c3 = *(const float4*)(rb + 304);
                const float xv = bf2f(*(const bf16_t*)(lcol + i * 32 + cl * 2));
                const float2 sc2 = *(const float2*)(lsc + i * 2);
                const float xdt = xv * sc2.x;
                const f2_t xd2 = mk2(xdt, xdt), dA2 = mk2(sc2.y, sc2.y);
                const f2_t bb[8] = {mk2(b0.x, b0.y), mk2(b0.z, b0.w), mk2(b1.x, b1.y), mk2(b1.z, b1.w), mk2(b2.x, b2.y), mk2(b2.z, b2.w), mk2(b3.x, b3.y), mk2(b3.z, b3.w)};
                const f2_t cc[8] = {mk2(c0.x, c0.y), mk2(c0.z, c0.w), mk2(c1.x, c1.y), mk2(c1.z, c1.w), mk2(c2.x, c2.y), mk2(c2.z, c2.w), mk2(c3.x, c3.y), mk2(c3.z, c3.w)};
                f2_t ya = mk2(0.f, 0.f), yb = mk2(0.f, 0.f);
#pragma unroll
                for (int q = 0; q < 8; q += 2) {
                    st[q] = st[q] * dA2 + xd2 * bb[q]; st[q + 1] = st[q + 1] * dA2 + xd2 * bb[q + 1];
                    ya = cc[q] * st[q] + ya; yb = cc[q + 1] * st[q + 1] + yb;
                }
                const f2_t ys = ya + yb;
                const float y = quad_sum(ys.x + ys.y);
                *(sq == 0 ? Y + (tb + t0 + i) * DM + h * 64 + col : dummy + i) = f2bf(y + Dh * xv);
                if (i & 1) __builtin_amdgcn_sched_barrier(0);
            }
        }
    } else if (role == 1) {
        uint4 f0, f1; unsigned fc = 0u; float fsc = 0.f;
        f2_t S[4];
#pragma unroll
        for (int i = 0; i < 4; ++i) S[i] = mk2(0.f, 0.f);
        auto fetch = [&](int t0) {
            const size_t tok = tb + t0 + fs;
            const bf16_t* src = HS + tok * 1024 + (fp < 4 ? 512 + h * 64 + fp * 16 : 768 + h * 64 + (fp - 4) * 16);
            f0 = *(const uint4*)src; f1 = *(const uint4*)(src + 8);
            if (fp < 4) fc = *(const unsigned*)(VG + tok * 256 + h * 64 + colbase + fp * 2);
            if (lane < 16) fsc = SC[(tb + t0 + (lane >> 1)) * 16 + 8 + (lane & 1) * 4 + h];
        };
        fetch(0);
        for (int t0 = 0; t0 < SEQ; t0 += 8) {
            st8f(lrow + fs * 512 + fp * 64, f0); st8f(lrow + fs * 512 + fp * 64 + 32, f1);
            if (fp < 4) *(unsigned*)(lcol + fs * 32 + fp * 4) = fc;
            if (lane < 16) lsc[lane] = fsc;
            if (t0 + 8 < SEQ) fetch(t0 + 8);
#pragma unroll
            for (int i = 0; i < 8; ++i) {
                const char* rb = lrow + i * 512 + sq * 32;
                const float4 q0 = *(const float4*)rb, q1 = *(const float4*)(rb + 16);
                const float4 k0 = *(const float4*)(rb + 256), k1 = *(const float4*)(rb + 272);
                const float vv = bf2f(*(const bf16_t*)(lcol + i * 32 + cl * 2));
                const float2 sc2 = *(const float2*)(lsc + i * 2);
                const f2_t al2 = mk2(sc2.x, sc2.x);
                const f2_t kk[4] = {mk2(k0.x, k0.y), mk2(k0.z, k0.w), mk2(k1.x, k1.y), mk2(k1.z, k1.w)};
                const f2_t qq[4] = {mk2(q0.x, q0.y), mk2(q0.z, q0.w), mk2(q1.x, q1.y), mk2(q1.z, q1.w)};
                f2_t ra = mk2(0.f, 0.f), rb2 = mk2(0.f, 0.f);
#pragma unroll
                for (int q = 0; q < 4; q += 2) {
                    S[q] = S[q] * al2; S[q + 1] = S[q + 1] * al2;
                    ra = S[q] * kk[q] + ra; rb2 = S[q + 1] * kk[q + 1] + rb2;
                }
                const f2_t rs = ra + rb2;
                const float r = oct_sum(rs.x + rs.y);
                const float vn = sc2.y * (vv - r);
                const f2_t vn2 = mk2(vn, vn);
                f2_t oa2 = mk2(0.f, 0.f), ob2 = mk2(0.f, 0.f);
#pragma unroll
                for (int q = 0; q < 4; q += 2) {
                    S[q] = kk[q] * vn2 + S[q]; S[q + 1] = kk[q + 1] * vn2 + S[q + 1];
                    oa2 = S[q] * qq[q] + oa2; ob2 = S[q + 1] * qq[q + 1] + ob2;
                }
                const f2_t os = oa2 + ob2;
                const float ov = oct_sum(os.x + os.y);
                *(sq == 0 ? Y + (tb + t0 + i) * DM + 256 + h * 64 + col : dummy + i) = f2bf(ov);
                if (i & 1) __builtin_amdgcn_sched_barrier(0);
            }
        }
    } else {
        uint4 f0, f1; unsigned fc = 0u;
        f2_t S[4];
#pragma unroll
        for (int i = 0; i < 4; ++i) S[i] = mk2(0.f, 0.f);
        auto fetch = [&](int t0) {
            const size_t tok = tb + t0 + fs;
            if (fp < 4) { const float* src = DEC + tok * 128 + h * 32 + fp * 8; f0 = *(const uint4*)src; f1 = *(const uint4*)(src + 4); }
            else { const bf16_t* src = P + tok * LDP + (fp < 6 ? PC_LK + h * 32 + (fp - 4) * 16 : PC_LQ + h * 32 + (fp - 6) * 16); f0 = *(const uint4*)src; f1 = *(const uint4*)(src + 8); }
            fc = *(const unsigned*)(P + tok * LDP + PC_LV + h * 64 + colbase + fp * 2);
        };
        fetch(0);
        for (int t0 = 0; t0 < SEQ; t0 += 8) {
            if (fp < 4) { *(uint4*)(lrow + fs * 512 + fp * 32) = f0; *(uint4*)(lrow + fs * 512 + fp * 32 + 16) = f1; }
            else { st8f(lrow + fs * 512 + 128 + (fp - 4) * 64, f0); st8f(lrow + fs * 512 + 128 + (fp - 4) * 64 + 32, f1); }
            *(unsigned*)(lcol + fs * 32 + fp * 4) = fc;
            if (t0 + 8 < SEQ) fetch(t0 + 8);
#pragma unroll
            for (int i = 0; i < 8; ++i) {
                const char* rb = lrow + i * 512 + sq * 32;
                const float4 d0 = *(const float4*)rb, d1 = *(const float4*)(rb + 16);
                const float4 k0 = *(const float4*)(rb + 128), k1 = *(const float4*)(rb + 144);
                const float4 q0 = *(const float4*)(rb + 256), q1 = *(const float4*)(rb + 272);
                const float vv = bf2f(*(const bf16_t*)(lcol + i * 32 + cl * 2));
                const f2_t v2 = mk2(vv, vv);
                const f2_t dd[4] = {mk2(d0.x, d0.y), mk2(d0.z, d0.w), mk2(d1.x, d1.y), mk2(d1.z, d1.w)};
                const f2_t kk[4] = {mk2(k0.x, k0.y), mk2(k0.z, k0.w), mk2(k1.x, k1.y), mk2(k1.z, k1.w)};
                const f2_t qq[4] = {mk2(q0.x, q0.y), mk2(q0.z, q0.w), mk2(q1.x, q1.y), mk2(q1.z, q1.w)};
                f2_t oa2 = mk2(0.f, 0.f), ob2 = mk2(0.f, 0.f);
#pragma unroll
                for (int q = 0; q < 4; q += 2) {
                    S[q] = dd[q] * S[q] + kk[q] * v2; S[q + 1] = dd[q + 1] * S[q + 1] + kk[q + 1] * v2;
                    oa2 = S[q] * qq[q] + oa2; ob2 = S[q + 1] * qq[q + 1] + ob2;
                }
                const f2_t os = oa2 + ob2;
                const float ov = quad_sum(os.x + os.y);
                *(sq == 0 ? Y + (tb + t0 + i) * DM + 512 + h * 64 + col : dummy + i) = f2bf(ov * 0.17677669529663687f);
                if (i & 1) __builtin_amdgcn_sched_barrier(0);
            }
        }
    }
}

__device__ __forceinline__ void ph_mixer_finish(const Ctx& p, int l) {
    const bf16_t* P = (const bf16_t*)(pws_() + WS_P);
    bf16_t* Y = (bf16_t*)(pws_() + WS_Y);
    const float* sn = pin_(9) + (size_t)l * 256;
    const float* gn = pin_(13) + (size_t)l * 64;
    const float* ln = pin_(16) + (size_t)l * 64;
    const int lane = tid_() & 63;
    float gw1[8], gw2[8];
    load8f(lane < 32 ? sn + 8 * lane : gn + 8 * (lane & 7), gw1);
    load8f(ln + 8 * (lane & 7), gw2);
    const int nw = nwaves();
    int tok = gwave();
    uint4 nya, nga, nyb, ngb;
#define MF_LOAD(tk) do { const size_t row_ = (size_t)(tk) * LDP; \
        nya = *(const uint4*)(Y + (size_t)(tk) * DM + 8 * lane); \
        nga = *(const uint4*)(P + row_ + (lane < 32 ? PC_Z + 8 * lane : PC_GG + 8 * (lane - 32))); \
        nyb = *(const uint4*)(Y + (size_t)(tk) * DM + 512 + 8 * (lane & 31)); \
        ngb = *(const uint4*)(P + row_ + PC_LR + 8 * (lane & 31)); } while (0)
    MF_LOAD(tok);
    for (; tok < MTOK; tok += nw) {
        const uint4 ya = nya, ga = nga, yb = nyb, gb = ngb;
        { const int tn = tok + nw < MTOK ? tok + nw : tok; MF_LOAD(tn); }
        __builtin_amdgcn_sched_barrier(0);
        {
            float v[8], gt[8];
            unpack8(ya, v);
            unpack8(ga, gt);
            float ss = 0.f;
            if (lane < 32) {
#pragma unroll
                for (int i = 0; i < 8; ++i) { v[i] *= silu_f(gt[i]); ss += v[i] * v[i]; }
            } else {
#pragma unroll
                for (int i = 0; i < 8; ++i) ss += v[i] * v[i];
            }
            const float s8 = oct_sum(ss);
            float s32 = s8 + __int_as_float(__builtin_amdgcn_mov_dpp(__float_as_int(s8), 0x140, 0xF, 0xF, true));
            s32 += __shfl_xor(s32, 16, 64);
            const float rs = lane < 32 ? rsqrtf(s32 * (1.f / 256.f) + EPS) : rsqrtf(s8 * (1.f / 64.f) + EPS);
            float o[8];
#pragma unroll
            for (int i = 0; i < 8; ++i) o[i] = lane < 32 ? v[i] * rs * gw1[i] : v[i] * rs * gw1[i] * silu_f(gt[i]);
            *(uint4*)(Y + (size_t)tok * DM + 8 * lane) = pack8(o);
        }
        if (lane < 32) {
            float v[8], gt[8];
            unpack8(yb, v);
            unpack8(gb, gt);
            float ss = 0.f;
#pragma unroll
            for (int i = 0; i < 8; ++i) ss += v[i] * v[i];
            const float rs = rsqrtf(oct_sum(ss) * (1.f / 64.f) + EPS);
            float o[8];
#pragma unroll
            for (int i = 0; i < 8; ++i) o[i] = v[i] * rs * gw2[i] * silu_f(gt[i]);
            *(uint4*)(Y + (size_t)tok * DM + 512 + 8 * lane) = pack8(o);
        }
    }
#undef MF_LOAD
}

typedef short bf16x8_t __attribute__((ext_vector_type(8)));
typedef float f32x4_t __attribute__((ext_vector_type(4)));
union BF8 { bf16x8_t v; uint4 u; unsigned w[4]; };


__device__ __forceinline__ void ph_dsa_prep(const Ctx& p, int l) {
    const bf16_t* P = (const bf16_t*)(pws_() + WS_P);
    bf16_t* qn = (bf16_t*)(pws_() + WS_QN);
    bf16_t* kn = (bf16_t*)(pws_() + WS_KN);
    bf16_t* ikn = (bf16_t*)(pws_() + WS_IKN);
    bf16_t* vt = (bf16_t*)(pws_() + WS_VT);
    const float* qg = pin_(17) + (size_t)l * 64;
    const float* kg = pin_(18) + (size_t)l * 64;
    const float* ig = pin_(19) + (size_t)l * 32;
    const int lane = tid_() & 63;
    const int pcol = lane < 40 ? PC_DQ + 8 * lane : PC_IK + 8 * (lane & 3);
    float gw[8];
    load8f(lane < 32 ? qg + 8 * (lane & 7) : (lane < 40 ? kg + 8 * (lane & 7) : ig + 8 * (lane & 3)), gw);
    for (int grp = gwave(); grp < MTOK / 8; grp += nwaves()) {
        const size_t tok0 = (size_t)grp * 8;
        const int b = (int)(tok0 / SEQ), t0 = (int)(tok0 % SEQ);
        unsigned short vv[8];
#pragma unroll
        for (int i = 0; i < 8; ++i) {
            const size_t row = (tok0 + i) * LDP;
            vv[i] = P[row + PC_DV + lane];
            if (lane < 44) {
                float v[8];
                unpack8(*(const uint4*)(P + row + pcol), v);
                float ss = 0.f;
#pragma unroll
                for (int q = 0; q < 8; ++q) ss += v[q] * v[q];
                const float s4 = ss + __int_as_float(__builtin_amdgcn_mov_dpp(__float_as_int(ss), 0xB1, 0xF, 0xF, true));
                const float s4b = s4 + __int_as_float(__builtin_amdgcn_mov_dpp(__float_as_int(s4), 0x4E, 0xF, 0xF, true));
                const float s8 = s4b + __int_as_float(__builtin_amdgcn_mov_dpp(__float_as_int(s4b), 0x141, 0xF, 0xF, true));
                const float rs = lane < 40 ? rsqrtf(s8 * (1.f / 64.f) + EPS) * (lane < 32 ? 0.125f : 1.f) : rsqrtf(s4b * (1.f / 32.f) + EPS);
                float o[8];
#pragma unroll
                for (int q = 0; q < 8; ++q) o[q] = v[q] * rs * gw[q];
                const uint4 pk = pack8(o);
                if (lane < 32) *(uint4*)(qn + (tok0 + i) * 256 + 8 * lane) = pk;
                else if (lane < 40) *(uint4*)(kn + (tok0 + i) * 64 + 8 * (lane - 32)) = pk;
                else *(uint4*)(ikn + (tok0 + i) * 32 + 8 * (lane - 40)) = pk;
            }
        }
        uint4 o; o.x = (unsigned)vv[0] | ((unsigned)vv[1] << 16); o.y = (unsigned)vv[2] | ((unsigned)vv[3] << 16);
        o.z = (unsigned)vv[4] | ((unsigned)vv[5] << 16); o.w = (unsigned)vv[6] | ((unsigned)vv[7] << 16);
        *(uint4*)(vt + ((size_t)b * 64 + lane) * SEQ + t0) = o;
    }
}

#define DSA_STRIDE 2052
__device__ __forceinline__ int wave_total_i(int v) {
    v += __builtin_amdgcn_update_dpp(0, v, 0x111, 0xf, 0xf, true);
    v += __builtin_amdgcn_update_dpp(0, v, 0x112, 0xf, 0xf, true);
    v += __builtin_amdgcn_update_dpp(0, v, 0x114, 0xf, 0xf, true);
    v += __builtin_amdgcn_update_dpp(0, v, 0x118, 0xf, 0xf, true);
    return __builtin_amdgcn_readlane(v, 15) + __builtin_amdgcn_readlane(v, 31) + __builtin_amdgcn_readlane(v, 47) + __builtin_amdgcn_readlane(v, 63);
}
template <int NJ>
__device__ __forceinline__ void dsa_select(const unsigned* scq, int nj, int lane, unsigned& T_out, int& cut_out) {
    unsigned kreg[NJ];
#pragma unroll
    for (int j = 0; j < NJ; ++j) kreg[j] = (j < nj) ? scq[j * 64 + lane] : 0u;
    unsigned T = 0u; bool exact = false;
    for (int bit = 31; bit >= 0; --bit) {
        const unsigned cand = T | (1u << bit);
        int c = 0;
#pragma unroll
        for (int j = 0; j < NJ; ++j) c += (kreg[j] >= cand) ? 1 : 0;
        const int cnt = wave_total_i(c);
        if (cnt >= 256) { T = cand; if (cnt == 256) { exact = true; break; } }
    }
    int cut = 0x7fffffff;
    if (!exact) {
        int cgt = 0, ceq = 0;
#pragma unroll
        for (int j = 0; j < NJ; ++j) { cgt += __popcll(__ballot(kreg[j] > T)); ceq += __popcll(__ballot(kreg[j] == T)); }
        int need = 256 - cgt;
        if (ceq > need) {
            bool found = false;
#pragma unroll
            for (int j = 0; j < NJ; ++j) {
                const unsigned long long m = __ballot(kreg[j] == T);
                const int cj = __popcll(m);
                if (!found) {
                    if (need <= cj) { for (int bpos = 0; bpos < 64; ++bpos) if ((m >> bpos) & 1ull) { if (--need == 0) { cut = j * 64 + bpos; break; } } found = true; }
                    else need -= cj;
                }
            }
        }
    }
    T_out = T; cut_out = cut;
}
__device__ __forceinline__ void ph_dsa_main(const Ctx& p, int l, float* smem) {
    const bf16_t* P = (const bf16_t*)(pws_() + WS_P);
    bf16_t* Y = (bf16_t*)(pws_() + WS_Y);
    const bf16_t* QN = (const bf16_t*)(pws_() + WS_QN);
    const bf16_t* KN = (const bf16_t*)(pws_() + WS_KN);
    const bf16_t* IKN = (const bf16_t*)(pws_() + WS_IKN);
    const bf16_t* VT = (const bf16_t*)(pws_() + WS_VT);
    unsigned* sc = (unsigned*)smem;
    float* part = smem;
    float* plsum = smem + 8 * 64 * 64;
    unsigned* thr = (unsigned*)(smem + 35000);
    for (int task = bid_(); task < MTOK / 16; task += nblk_()) {
        const int tid = tid_(), lane = tid & 63, w = tid >> 6, qi = lane & 15, g = lane >> 4;
        const int c = 31 - task / 128, b = (task >> 2) & 31, sub = task & 3;
        const int t0 = c * 64 + sub * 16, nk = (c + 1) * 64;
        const size_t tok0 = (size_t)b * SEQ + t0;
        const bool dosel = nk > 256;
        if (dosel) {
            BF8 iqf[8]; float wq[8];
#pragma unroll
            for (int h = 0; h < 8; ++h) {
                iqf[h].u = *(const uint4*)(P + (tok0 + qi) * LDP + PC_IQ + h * 32 + 8 * g);
                wq[h] = bf2f(P[(tok0 + qi) * LDP + PC_IW + h]) * 0.0625f;
            }
            BF8 kan; kan.u = *(const uint4*)(IKN + ((size_t)b * SEQ + w * 16 + qi) * 32 + 8 * g);
            for (int kt = w; kt < nk / 16; kt += 8) {
                const int s0 = kt * 16;
                BF8 ka = kan;
                { const int ktn = kt + 8 < nk / 16 ? kt + 8 : kt; kan.u = *(const uint4*)(IKN + ((size_t)b * SEQ + ktn * 16 + qi) * 32 + 8 * g); }
                float acc[4] = {0.f, 0.f, 0.f, 0.f};
#pragma unroll
                for (int h = 0; h < 8; ++h) {
                    const f32x4_t d = __builtin_amdgcn_mfma_f32_16x16x32_bf16(ka.v, iqf[h].v, (f32x4_t){0.f, 0.f, 0.f, 0.f}, 0, 0, 0);
#pragma unroll
                    for (int r = 0; r < 4; ++r) acc[r] = __builtin_fmaf(wq[h], fmaxf(d[r], 0.f), acc[r]);
                }
                uint4 kv; kv.x = ford(acc[0]); kv.y = ford(acc[1]); kv.z = ford(acc[2]); kv.w = ford(acc[3]);
                *(uint4*)(sc + qi * DSA_STRIDE + s0 + 4 * g) = kv;
            }
        }
        __syncthreads();
        if (dosel) {
            const int nj = nk >> 6;
#pragma unroll 1
            for (int qq = 0; qq < 2; ++qq) {
                const int q = 2 * w + qq;
                unsigned T; int cut;
                if (nj <= 8) dsa_select<8>(sc + q * DSA_STRIDE, nj, lane, T, cut);
                else if (nj <= 16) dsa_select<16>(sc + q * DSA_STRIDE, nj, lane, T, cut);
                else if (nj <= 24) dsa_select<24>(sc + q * DSA_STRIDE, nj, lane, T, cut);
                else dsa_select<32>(sc + q * DSA_STRIDE, nj, lane, T, cut);
                if (lane == 0) { thr[q] = T; thr[16 + q] = (unsigned)cut; }
            }
        }
        __syncthreads();
        unsigned Tq = 0u; int cutq = 0x7fffffff;
        if (dosel) { Tq = thr[qi]; cutq = (int)thr[16 + qi]; }
        f32x4_t oacc[4][4]; float lsum[4];
#pragma unroll
        for (int h = 0; h < 4; ++h) { lsum[h] = 0.f;
#pragma unroll
            for (int dt = 0; dt < 4; ++dt) oacc[h][dt] = (f32x4_t){0.f, 0.f, 0.f, 0.f}; }
        const int krow = 8 * (qi >> 2) + (qi & 3);
        BF8 kan[2][2], van[4];
#define DSA_KV(st_) do { const int s0_ = (st_) * 32; \
            _Pragma("unroll") for (int t = 0; t < 2; ++t) _Pragma("unroll") for (int s2 = 0; s2 < 2; ++s2) kan[t][s2].u = *(const uint4*)(KN + ((size_t)b * SEQ + s0_ + krow + 4 * t) * 64 + 32 * s2 + 8 * g); \
            _Pragma("unroll") for (int dt = 0; dt < 4; ++dt) van[dt].u = *(const uint4*)(VT + ((size_t)b * 64 + 16 * dt + qi) * SEQ + s0_ + 8 * g); } while (0)
        if (w < nk / 32) DSA_KV(w);
        for (int st = w; st < nk / 32; st += 8) {
            const int s0 = st * 32;
            BF8 ka[2][2], va[4];
#pragma unroll
            for (int t = 0; t < 2; ++t)
#pragma unroll
                for (int s2 = 0; s2 < 2; ++s2) ka[t][s2] = kan[t][s2];
#pragma unroll
            for (int dt = 0; dt < 4; ++dt) va[dt] = van[dt];
            { const int stn = st + 8 < nk / 32 ? st + 8 : st; DSA_KV(stn); }
            float mk[8];
            if (dosel) {
                const uint4 k0 = *(const uint4*)(sc + qi * DSA_STRIDE + s0 + 8 * g), k1 = *(const uint4*)(sc + qi * DSA_STRIDE + s0 + 8 * g + 4);
                const unsigned kk[8] = {k0.x, k0.y, k0.z, k0.w, k1.x, k1.y, k1.z, k1.w};
#pragma unroll
                for (int j = 0; j < 8; ++j) mk[j] = (kk[j] > Tq || (kk[j] == Tq && (s0 + 8 * g + j) <= cutq)) ? 1.f : 0.f;
            } else {
#pragma unroll
                for (int j = 0; j < 8; ++j) mk[j] = 1.f;
            }
#pragma unroll
            for (int h = 0; h < 4; ++h) {
                BF8 q0, q1;
                q0.u = *(const uint4*)(QN + (tok0 + qi) * 256 + h * 64 + 8 * g);
                q1.u = *(const uint4*)(QN + (tok0 + qi) * 256 + h * 64 + 32 + 8 * g);
                f32x4_t sacc[2];
#pragma unroll
                for (int t = 0; t < 2; ++t) {
                    sacc[t] = __builtin_amdgcn_mfma_f32_16x16x32_bf16(ka[t][0].v, q0.v, (f32x4_t){0.f, 0.f, 0.f, 0.f}, 0, 0, 0);
                    sacc[t] = __builtin_amdgcn_mfma_f32_16x16x32_bf16(ka[t][1].v, q1.v, sacc[t], 0, 0, 0);
                }
                float pe[8];
#pragma unroll
                for (int t = 0; t < 2; ++t)
#pragma unroll
                    for (int r = 0; r < 4; ++r) { pe[4 * t + r] = __expf(sacc[t][r]) * mk[4 * t + r]; lsum[h] += pe[4 * t + r]; }
                BF8 pf;
#pragma unroll
                for (int j = 0; j < 4; ++j) pf.w[j] = pk_bf16(pe[2 * j], pe[2 * j + 1]);
#pragma unroll
                for (int dt = 0; dt < 4; ++dt) oacc[h][dt] = __builtin_amdgcn_mfma_f32_16x16x32_bf16(va[dt].v, pf.v, oacc[h][dt], 0, 0, 0);
            }
        }
#undef DSA_KV
        __syncthreads();
#pragma unroll
        for (int h = 0; h < 4; ++h) {
            plsum[(w * 4 + h) * 64 + lane] = lsum[h];
#pragma unroll
            for (int dt = 0; dt < 4; ++dt)
#pragma unroll
                for (int r = 0; r < 4; ++r) part[(w * 64 + h * 16 + dt * 4 + r) * 64 + lane] = oacc[h][dt][r];
        }
        __syncthreads();
        {
            const int h = w >> 1;
            float lq = 0.f;
#pragma unroll
            for (int w2 = 0; w2 < 8; ++w2)
#pragma unroll
                for (int g2 = 0; g2 < 4; ++g2) lq += plsum[(w2 * 4 + h) * 64 + qi + 16 * g2];
            const float inv = 1.f / lq;
#pragma unroll
            for (int dd = 0; dd < 2; ++dd) {
                const int dt = (w & 1) * 2 + dd;
                float o[4];
#pragma unroll
                for (int r = 0; r < 4; ++r) {
                    float sacc = 0.f;
#pragma unroll
                    for (int w2 = 0; w2 < 8; ++w2) sacc += part[(w2 * 64 + h * 16 + dt * 4 + r) * 64 + lane];
                    o[r] = sacc * inv;
                }
                uint2 ov; ov.x = pk_bf16(o[0], o[1]); ov.y = pk_bf16(o[2], o[3]);
                *(uint2*)(Y + (tok0 + qi) * DM + 768 + h * 64 + 16 * dt + 4 * g) = ov;
            }
        }
        __syncthreads();
    }
}

__device__ __forceinline__ void ph_mem_prep(const Ctx& p, int l) {
    const float* Km = (const float*)(pws_() + WS_KM);
    const float* Vm = (const float*)(pws_() + WS_VM);
    bf16_t* KB = (bf16_t*)(pws_() + WS_KB);
    bf16_t* VTB = (bf16_t*)(pws_() + WS_VTB);
    const float* kg = pin_(28) + (size_t)l * 64;
    const int lane = tid_() & 63;
    for (int r = gwave(); r < MMEM; r += nwaves()) {
        const int b = r / NMEM, j = r % NMEM;
#pragma unroll
        for (int h = 0; h < 4; ++h) {
            const float v = Km[(size_t)r * 256 + h * 64 + lane];
            const float ss = wave_sum(v * v);
            KB[(((size_t)b * 4 + h) * NMEM + j) * 64 + lane] = f2bf(v * rsqrtf(ss * (1.f / 64.f) + EPS) * kg[lane]);
            VTB[(((size_t)b * 4 + h) * 64 + lane) * NMEM + j] = f2bf(Vm[(size_t)r * 256 + h * 64 + lane]);
        }
    }
}
__device__ __forceinline__ void ph_xattn(const Ctx& p, int l, int task0 = 0, int ntask = MTOK / 16, int w0 = -1, int wstep = 0) {
    const float* Qx = (const float*)(pws_() + WS_QX);
    bf16_t* Ox = (bf16_t*)(pws_() + WS_OX);
    const bf16_t* KB = (const bf16_t*)(pws_() + WS_KB);
    const bf16_t* VTB = (const bf16_t*)(pws_() + WS_VTB);
    const float* qg = pin_(27) + (size_t)l * 64;
    const int lane = tid_() & 63, qi = lane & 15, g = lane >> 4;
    if (w0 < 0) { w0 = gwave(); wstep = nwaves(); }
    for (int task = task0 + w0; task < task0 + ntask; task += wstep) {
        const int tok0 = task * 16, b = tok0 / SEQ;
#pragma unroll 1
        for (int h = 0; h < 4; ++h) {
            BF8 qf[2];
            {
                float qv[2][8]; float ss = 0.f;
#pragma unroll
                for (int s2 = 0; s2 < 2; ++s2) {
                    const float4* qp = (const float4*)(Qx + (size_t)(tok0 + qi) * 256 + h * 64 + 32 * s2 + 8 * g);
                    const float4 a = qp[0], c = qp[1];
                    qv[s2][0] = a.x; qv[s2][1] = a.y; qv[s2][2] = a.z; qv[s2][3] = a.w; qv[s2][4] = c.x; qv[s2][5] = c.y; qv[s2][6] = c.z; qv[s2][7] = c.w;
#pragma unroll
                    for (int j = 0; j < 8; ++j) ss += qv[s2][j] * qv[s2][j];
                }
                ss += __shfl_xor(ss, 16, 64); ss += __shfl_xor(ss, 32, 64);
                const float rs = rsqrtf(ss * (1.f / 64.f) + EPS) * 0.125f;
#pragma unroll
                for (int s2 = 0; s2 < 2; ++s2) {
                    const float4 g0 = *(const float4*)(qg + 32 * s2 + 8 * g), g1 = *(const float4*)(qg + 32 * s2 + 8 * g + 4);
                    qf[s2].w[0] = pk_bf16(qv[s2][0] * rs * g0.x, qv[s2][1] * rs * g0.y); qf[s2].w[1] = pk_bf16(qv[s2][2] * rs * g0.z, qv[s2][3] * rs * g0.w);
                    qf[s2].w[2] = pk_bf16(qv[s2][4] * rs * g1.x, qv[s2][5] * rs * g1.y); qf[s2].w[3] = pk_bf16(qv[s2][6] * rs * g1.z, qv[s2][7] * rs * g1.w);
                }
            }
            const bf16_t* Kh = KB + ((size_t)b * 4 + h) * NMEM * 64;
            const bf16_t* Vh = VTB + ((size_t)b * 4 + h) * 64 * NMEM;
            f32x4_t oacc[4];
#pragma unroll
            for (int dt = 0; dt < 4; ++dt) oacc[dt] = (f32x4_t){0.f, 0.f, 0.f, 0.f};
            float lsum = 0.f;
            const int krow = 8 * (qi >> 2) + (qi & 3);
#pragma unroll 2
            for (int s0 = 0; s0 < NMEM; s0 += 32) {
                BF8 ka[2][2], va[4];
#pragma unroll
                for (int t = 0; t < 2; ++t)
#pragma unroll
                    for (int s2 = 0; s2 < 2; ++s2) ka[t][s2].u = *(const uint4*)(Kh + (size_t)(s0 + krow + 4 * t) * 64 + 32 * s2 + 8 * g);
#pragma unroll
                for (int dt = 0; dt < 4; ++dt) va[dt].u = *(const uint4*)(Vh + (size_t)(16 * dt + qi) * NMEM + s0 + 8 * g);
                f32x4_t sacc[2];
#pragma unroll
                for (int t = 0; t < 2; ++t) {
                    sacc[t] = (f32x4_t){0.f, 0.f, 0.f, 0.f};
                    sacc[t] = __builtin_amdgcn_mfma_f32_16x16x32_bf16(ka[t][0].v, qf[0].v, sacc[t], 0, 0, 0);
                    sacc[t] = __builtin_amdgcn_mfma_f32_16x16x32_bf16(ka[t][1].v, qf[1].v, sacc[t], 0, 0, 0);
                }
                float pe[8];
#pragma unroll
                for (int t = 0; t < 2; ++t)
#pragma unroll
                    for (int r = 0; r < 4; ++r) { pe[4 * t + r] = __expf(sacc[t][r]); lsum += pe[4 * t + r]; }
                BF8 pf;
#pragma unroll
                for (int j = 0; j < 4; ++j) pf.w[j] = pk_bf16(pe[2 * j], pe[2 * j + 1]);
#pragma unroll
                for (int dt = 0; dt < 4; ++dt) oacc[dt] = __builtin_amdgcn_mfma_f32_16x16x32_bf16(va[dt].v, pf.v, oacc[dt], 0, 0, 0);
            }
            lsum += __shfl_xor(lsum, 16, 64); lsum += __shfl_xor(lsum, 32, 64);
            const float inv = 1.f / lsum;
#pragma unroll
            for (int dt = 0; dt < 4; ++dt) {
                uint2 o; o.x = pk_bf16(oacc[dt][0] * inv, oacc[dt][1] * inv); o.y = pk_bf16(oacc[dt][2] * inv, oacc[dt][3] * inv);
                *(uint2*)(Ox + (size_t)(tok0 + qi) * 256 + h * 64 + 16 * dt + 4 * g) = o;
            }
        }
    }
}

template <int N> __device__ __forceinline__ void bitonic_sort_desc(unsigned (&a)[N]) {
#pragma unroll
    for (int k = 2; k <= N; k <<= 1)
#pragma unroll
        for (int j = k >> 1; j > 0; j >>= 1)
#pragma unroll
            for (int i = 0; i < N; ++i) {
                const int o = i ^ j;
                if (o > i) {
                    const bool desc = ((i & k) == 0);
                    const unsigned x = a[i], y = a[o];
                    const unsigned mx = x > y ? x : y, mn = x > y ? y : x;
                    a[i] = desc ? mx : mn; a[o] = desc ? mn : mx;
                }
            }
}
__device__ __forceinline__ void bitonic_merge16_desc(unsigned (&a)[16]) {
#pragma unroll
    for (int j = 8; j > 0; j >>= 1)
#pragma unroll
        for (int i = 0; i < 16; ++i) {
            const int o = i ^ j;
            if (o > i) { const unsigned x = a[i], y = a[o]; a[i] = x > y ? x : y; a[o] = x > y ? y : x; }
        }
}
__device__ __forceinline__ void top16_merge(unsigned (&a)[16], const unsigned (&b)[16]) {
#pragma unroll
    for (int i = 0; i < 16; ++i) a[i] = a[i] > b[15 - i] ? a[i] : b[15 - i];
    bitonic_merge16_desc(a);
}
__device__ __forceinline__ void top16_xlane(unsigned (&a)[16], int xm) {
    unsigned b[16];
#pragma unroll
    for (int i = 0; i < 16; ++i) b[i] = (unsigned)__shfl_xor((int)a[i], xm, 64);
    top16_merge(a, b);
}
__device__ __forceinline__ void ph_subkeys_convert(const Ctx& p) {
    const float* sk = pin_(31);
    bf16_t* o = (bf16_t*)(pws_() + WS_SKB);
    const size_t n = (size_t)DEPTH * 8 * 2 * 128 * 64;
    for (size_t i = (size_t)bid_() * 512 + tid_(); i < n; i += (size_t)nblk_() * 512) o[i] = f2bf(sk[i]);
}
__device__ __forceinline__ void ph_peer_topk(const Ctx& p, int l, float* smem, int task0 = 0, int ntask = MTOK / 16, int w0 = -1, int wstep = 0) {
    const bf16_t* Qp = (const bf16_t*)(pws_() + WS_QP);
    const bf16_t* SK = (const bf16_t*)(pws_() + WS_SKB) + (size_t)l * 8 * 2 * 128 * 64;
    int* pidx = (int*)(pws_() + WS_PEI);
    float* pgt = (float*)(pws_() + WS_PEG);
    float* pus = (float*)(pws_() + WS_PUS);
    const float* usc = (const float*)(pws_() + WS_USC) + (size_t)l * NEXP;
    const float* vsc = (const float*)(pws_() + WS_VSC) + (size_t)l * NEXP;
    const int tid = tid_(), lane = tid & 63, wave = tid >> 6, qi = lane & 15, g = lane >> 4;
    int* tabw = (int*)smem + wave * 512 + qi * 32;
    if (w0 < 0) { w0 = gwave(); wstep = nwaves(); }
    for (int task = task0 + w0; task < task0 + ntask; task += wstep) {
        const size_t tok = (size_t)task * 16 + qi;
#pragma unroll 1
        for (int h = 0; h < 8; ++h) {
            unsigned L[2][16];
#pragma unroll
            for (int pp = 0; pp < 2; ++pp) {
                BF8 qf[2];
#pragma unroll
                for (int s2 = 0; s2 < 2; ++s2) qf[s2].u = *(const uint4*)(Qp + tok * DM + h * 128 + pp * 64 + 32 * s2 + 8 * g);
                const bf16_t* skp = SK + (size_t)(h * 2 + pp) * 128 * 64;
                unsigned va[16], vb[16];
                BF8 kall[8][2];
#pragma unroll
                for (int tile = 0; tile < 8; ++tile)
#pragma unroll
                    for (int s2 = 0; s2 < 2; ++s2) kall[tile][s2].u = *(const uint4*)(skp + (size_t)(16 * tile + qi) * 64 + 32 * s2 + 8 * g);
                __builtin_amdgcn_sched_barrier(0);
#pragma unroll
                for (int tile = 0; tile < 8; ++tile) {
                    f32x4_t d = __builtin_amdgcn_mfma_f32_16x16x32_bf16(kall[tile][0].v, qf[0].v, (f32x4_t){0.f, 0.f, 0.f, 0.f}, 0, 0, 0);
                    d = __builtin_amdgcn_mfma_f32_16x16x32_bf16(kall[tile][1].v, qf[1].v, d, 0, 0, 0);
#pragma unroll
                    for (int r = 0; r < 4; ++r) {
                        const unsigned key = (ford(d[r]) & ~127u) | (unsigned)(127 - (16 * tile + 4 * g + r));
                        if (tile < 4) va[tile * 4 + r] = key; else vb[(tile - 4) * 4 + r] = key;
                    }
                }
                bitonic_sort_desc<16>(va);
                bitonic_sort_desc<16>(vb);
                top16_merge(va, vb);
                top16_xlane(va, 16);
                top16_xlane(va, 32);
#pragma unroll
                for (int i = 0; i < 16; ++i) L[pp][i] = va[i];
            }
            if (g < 2) {
#pragma unroll
                for (int i = 0; i < 16; ++i) tabw[g * 16 + i] = 127 - (int)((g == 0 ? L[0][i] : L[1][i]) & 127u);
            }
            float s1[16], s2v[16];
#pragma unroll
            for (int i = 0; i < 16; ++i) { s1[i] = funord(L[0][i] & ~127u); s2v[i] = funord(L[1][i] & ~127u); }
            unsigned ca[16], cb[16];
#pragma unroll
            for (int i = 0; i < 16; ++i) { ca[i] = 0u; cb[i] = 0u; }
            {
                const float r0 = g == 0 ? s1[0] : (g == 1 ? s1[1] : (g == 2 ? s1[2] : s1[3]));
                const int nb0 = g == 0 ? 16 : (g == 1 ? 8 : (g == 2 ? 5 : 4));
#pragma unroll
                for (int bq = 0; bq < 16; ++bq) if (bq < nb0) ca[bq] = (ford(r0 + s2v[bq]) & ~255u) | (unsigned)(255 - (g * 16 + bq));
                const float r1 = g == 0 ? s1[4] : (g == 1 ? s1[5] : (g == 2 ? s1[6] : s1[7]));
                const int nb1 = g == 0 ? 3 : 2;
#pragma unroll
                for (int bq = 0; bq < 3; ++bq) if (bq < nb1) cb[bq] = (ford(r1 + s2v[bq]) & ~255u) | (unsigned)(255 - ((g + 4) * 16 + bq));
                const float r2 = g == 0 ? s1[8] : (g == 1 ? s1[9] : (g == 2 ? s1[10] : s1[11]));
                cb[3] = (ford(r2 + s2v[0]) & ~255u) | (unsigned)(255 - ((g + 8) * 16));
                const float r3 = g == 0 ? s1[12] : (g == 1 ? s1[13] : (g == 2 ? s1[14] : s1[15]));
                cb[4] = (ford(r3 + s2v[0]) & ~255u) | (unsigned)(255 - ((g + 12) * 16));
            }
            bitonic_sort_desc<16>(ca);
            bitonic_sort_desc<16>(cb);
            top16_merge(ca, cb);
            top16_xlane(ca, 16);
            top16_xlane(ca, 32);
            float tv[16]; float den = 0.f;
#pragma unroll
            for (int i = 0; i < 16; ++i) {
                const int f = 255 - (int)(ca[i] & 255u);
                const int a = f >> 4, bq = f & 15;
                tv[i] = funord(ca[i] & ~255u);
                (void)a; (void)bq;
            }
#pragma unroll
            for (int i = 0; i < 16; ++i) { tv[i] = __expf(tv[i] - funord(ca[0] & ~255u)); den += tv[i]; }
            const float inv = 1.f / den;
            int ev[4]; float gv[4];
#pragma unroll
            for (int r = 0; r < 4; ++r) {
                const unsigned key = g == 0 ? ca[r] : (g == 1 ? ca[4 + r] : (g == 2 ? ca[8 + r] : ca[12 + r]));
                const float tvv = g == 0 ? tv[r] : (g == 1 ? tv[4 + r] : (g == 2 ? tv[8 + r] : tv[12 + r]));
                const int f = 255 - (int)(key & 255u);
                ev[r] = tabw[f >> 4] * 128 + tabw[16 + (f & 15)];
                gv[r] = tvv * inv;
            }
            float us[4];
#pragma unroll
            for (int r = 0; r < 4; ++r) { us[r] = usc[ev[r]]; gv[r] *= vsc[ev[r]]; }
            *(int4*)(pidx + tok * 128 + h * 16 + 4 * g) = make_int4(ev[0], ev[1], ev[2], ev[3]);
            *(float4*)(pgt + tok * 128 + h * 16 + 4 * g) = make_float4(gv[0], gv[1], gv[2], gv[3]);
            *(float4*)(pus + tok * 128 + h * 16 + 4 * g) = make_float4(us[0], us[1], us[2], us[3]);
        }
    }
}

typedef float f32x2_t __attribute__((ext_vector_type(2)));
typedef int i32x8_t __attribute__((ext_vector_type(8)));
__device__ __forceinline__ unsigned pack4_fp8(float4 a, float sc) {
    const float x = fminf(fmaxf(a.x * sc, -448.f), 448.f), y = fminf(fmaxf(a.y * sc, -448.f), 448.f);
    const float z = fminf(fmaxf(a.z * sc, -448.f), 448.f), w = fminf(fmaxf(a.w * sc, -448.f), 448.f);
    int r = __builtin_amdgcn_cvt_pk_fp8_f32(x, y, 0, false);
    r = __builtin_amdgcn_cvt_pk_fp8_f32(z, w, r, true);
    return (unsigned)r;
}
__device__ __forceinline__ unsigned q4_e2m1(float y) {
    const float a = fabsf(y);
    const unsigned c = (unsigned)(a > 0.25f) + (unsigned)(a > 0.75f) + (unsigned)(a > 1.25f) + (unsigned)(a > 1.75f) + (unsigned)(a > 2.5f) + (unsigned)(a > 3.5f) + (unsigned)(a > 5.0f);
    return c | (y < 0.f ? 8u : 0u);
}
__device__ __forceinline__ void ph_tab_convert_all(const Ctx& p) {
    const int lane = tid_() & 63;
    for (int row = gwave(); row < 2 * DEPTH * NEXP; row += nwaves()) {
        const int tabv = row >= DEPTH * NEXP;
        const int rr = tabv ? row - DEPTH * NEXP : row;
        const float4* src = (const float4*)((tabv ? pin_(33) : pin_(32)) + (size_t)rr * DM);
        float4 v[4]; float am = 0.f;
#pragma unroll
        for (int i = 0; i < 4; ++i) { v[i] = src[lane + 64 * i]; am = fmaxf(am, fmaxf(fmaxf(fabsf(v[i].x), fabsf(v[i].y)), fmaxf(fabsf(v[i].z), fabsf(v[i].w)))); }
        am = wave_max(am);
        const float sc = am > 0.f ? am * (1.f / 6.f) : 1.f, inv = 1.f / sc;
        unsigned char* dst = (unsigned char*)(pws_() + (tabv ? WS_V4 : WS_U4)) + (size_t)rr * 512;
#pragma unroll
        for (int i = 0; i < 4; ++i) {
            const unsigned pk = q4_e2m1(v[i].x * inv) | (q4_e2m1(v[i].y * inv) << 4) | (q4_e2m1(v[i].z * inv) << 8) | (q4_e2m1(v[i].w * inv) << 12);
            const int off = tabv ? 16 * (lane >> 1) + 4 * i + 2 * (lane & 1) : 128 * i + 2 * lane;
            *(unsigned short*)(dst + off) = (unsigned short)pk;
        }
        if (lane == 0) ((float*)(pws_() + (tabv ? WS_VSC : WS_USC)))[rr] = sc;
    }
}
__device__ __forceinline__ float dpp_xor1(float v) { return __int_as_float(__builtin_amdgcn_update_dpp(0, __float_as_int(v), 0xB1, 0xF, 0xF, true)); }
__device__ __forceinline__ void ph_peer_u4(const Ctx& p, int l, float* smem) {
    const unsigned char* ut = (const unsigned char*)(pws_() + WS_U4) + (size_t)l * NEXP * 512;
    const int* pidx = (const int*)(pws_() + WS_PEI);
    float* pgt = (float*)(pws_() + WS_PEG);
    const float* pus = (const float*)(pws_() + WS_PUS);
    const unsigned char* H8 = (const unsigned char*)(pws_() + WS_H8);
    const int lane = tid_() & 63, g = lane >> 4, i = lane & 15, wave = tid_() >> 6;
    const bool odd = i & 1;
    unsigned char* hl = (unsigned char*)smem + wave * 2048;
    const int nw = nwaves();
    int tok = gwave();
    int ne0 = pidx[(size_t)tok * 128 + lane], ne1 = pidx[(size_t)tok * 128 + 64 + lane];
    *(uint4*)(hl + 16 * lane) = *(const uint4*)(H8 + (size_t)tok * DM + 16 * lane);
    uint4 rA[8], rB[8], rC[8], rD[8];
    const int roff = 64 * (i & 1) + 16 * g;
#define PU_ROWS(buf, esrc, hq) do { const int ea_ = __builtin_amdgcn_ds_bpermute(((hq) * 16 + (i >> 1)) * 4, esrc), eb_ = __builtin_amdgcn_ds_bpermute(((hq) * 16 + 8 + (i >> 1)) * 4, esrc); \
        const unsigned char* pa_ = ut + (size_t)ea_ * 512 + roff; const unsigned char* pb_ = ut + (size_t)eb_ * 512 + roff; \
        _Pragma("unroll") for (int q_ = 0; q_ < 4; ++q_) { buf[q_] = *(const uint4*)(pa_ + 128 * q_); buf[4 + q_] = *(const uint4*)(pb_ + 128 * q_); } \
        __builtin_amdgcn_sched_barrier(0); } while (0)
#define PU_COMP(buf, hd) do { f32x4_t a0_ = {0.f, 0.f, 0.f, 0.f}, a1_ = {0.f, 0.f, 0.f, 0.f}; \
        _Pragma("unroll") for (int q_ = 0; q_ < 4; ++q_) { \
            const uint4 b0_ = *(const uint4*)(hb + 256 * q_), b1_ = *(const uint4*)(hb + 256 * q_ + 64); \
            const i32x8_t b_ = {(int)b0_.x, (int)b0_.y, (int)b0_.z, (int)b0_.w, (int)b1_.x, (int)b1_.y, (int)b1_.z, (int)b1_.w}; \
            const i32x8_t x_ = {(int)buf[q_].x, (int)buf[q_].y, (int)buf[q_].z, (int)buf[q_].w, 0, 0, 0, 0}; \
            const i32x8_t y_ = {(int)buf[4 + q_].x, (int)buf[4 + q_].y, (int)buf[4 + q_].z, (int)buf[4 + q_].w, 0, 0, 0, 0}; \
            a0_ = __builtin_amdgcn_mfma_scale_f32_16x16x128_f8f6f4(x_, b_, a0_, 4, 0, 0, 0, 0, 0); \
            a1_ = __builtin_amdgcn_mfma_scale_f32_16x16x128_f8f6f4(y_, b_, a1_, 4, 0, 0, 0, 0, 0); \
            __builtin_amdgcn_sched_barrier(0); } \
        float t0a_ = odd ? a0_[1] : a0_[0], t0b_ = odd ? a0_[3] : a0_[2], t1a_ = odd ? a1_[1] : a1_[0], t1b_ = odd ? a1_[3] : a1_[2]; \
        t0a_ += dpp_xor1(t0a_); t0b_ += dpp_xor1(t0b_); t1a_ += dpp_xor1(t1a_); t1b_ += dpp_xor1(t1b_); \
        if ((i >> 1) == (hd)) { keep0 = odd ? t1a_ : t0a_; keep1 = odd ? t1b_ : t0b_; } \
        __builtin_amdgcn_sched_barrier(0); } while (0)
    PU_ROWS(rA, ne0, 0); PU_ROWS(rB, ne0, 1); PU_ROWS(rC, ne0, 2);
    int par = 0;
    for (; tok < MTOK; tok += nw, par ^= 1) {
        const int e0 = ne0, e1 = ne1;
        const size_t tn = (size_t)(tok + nw < MTOK ? tok + nw : tok);
        const uint4 hnext = *(const uint4*)(H8 + tn * DM + 16 * lane);
        ne0 = pidx[tn * 128 + lane]; ne1 = pidx[tn * 128 + 64 + lane];
        const size_t mi = (size_t)tok * 128 + (i >> 1) * 16 + 8 * (i & 1) + 2 * g;
        const float2 gm = *(const float2*)(pgt + mi), um = *(const float2*)(pus + mi);
        asm volatile("s_waitcnt lgkmcnt(0)" ::: "memory"); __builtin_amdgcn_wave_barrier();
        const unsigned char* hb = hl + par * 1024 + 128 * (i & 1) + 16 * g;
        float keep0 = 0.f, keep1 = 0.f;
        PU_ROWS(rD, e0, 3); PU_COMP(rA, 0);
        PU_ROWS(rA, e1, 0); PU_COMP(rB, 1);
        PU_ROWS(rB, e1, 1); PU_COMP(rC, 2);
        PU_ROWS(rC, e1, 2); PU_COMP(rD, 3);
        PU_ROWS(rD, e1, 3); PU_COMP(rA, 4);
        PU_ROWS(rA, ne0, 0); PU_COMP(rB, 5);
        PU_ROWS(rB, ne0, 1); PU_COMP(rC, 6);
        PU_ROWS(rC, ne0, 2); PU_COMP(rD, 7);
        *(uint4*)(hl + (par ^ 1) * 1024 + 16 * lane) = hnext;
        float2 o;
        o.x = gm.x * gelu_tanh_f(keep0 * um.x * (1.f / H8_SCALE)); o.y = gm.y * gelu_tanh_f(keep1 * um.y * (1.f / H8_SCALE));
        *(float2*)(pgt + mi) = o;
    }
#undef PU_ROWS
#undef PU_COMP
}
template <bool NORM>
__device__ __forceinline__ void ph_peer_v4(const Ctx& p, int l) {
    const unsigned char* vt = (const unsigned char*)(pws_() + WS_V4) + (size_t)l * NEXP * 512;
    const int* pidx = (const int*)(pws_() + WS_PEI);
    const float* pgt = (const float*)(pws_() + WS_PEG);
    float* x = pout_();
    const int lane = tid_() & 63;
    const bool r = lane & 32;
    const int coff = 16 * (lane & 31);
    const int nw = nwaves();
    int tok = gwave();
    int ne0 = pidx[(size_t)tok * 128 + lane], ne1 = pidx[(size_t)tok * 128 + 64 + lane];
    float nc0 = pgt[(size_t)tok * 128 + lane], nc1 = pgt[(size_t)tok * 128 + 64 + lane];
    uint4 vA[16], vB[16];
    float4 gn[4];
    if (NORM) {
#pragma unroll
        for (int q = 0; q < 4; ++q) gn[q] = *(const float4*)(pin_(2) + (size_t)(l + 1) * DM + 256 * q + 8 * (lane & 31) + (r ? 4 : 0));
    }
#define PV_ROWS(buf, esrc, lb) do { int es_ = esrc; asm volatile("" : "+v"(es_)); _Pragma("unroll") for (int k_ = 0; k_ < 16; ++k_) { \
        const int ea_ = __builtin_amdgcn_readlane(es_, (lb) + 2 * k_), eb_ = __builtin_amdgcn_readlane(es_, (lb) + 2 * k_ + 1); \
        buf[k_] = *(const uint4*)(vt + (size_t)(r ? eb_ : ea_) * 512 + coff); } __builtin_amdgcn_sched_barrier(0); } while (0)
#define PV_D4(W, q) do { \
        out[4 * (q) + 0] = __builtin_elementwise_fma(__builtin_amdgcn_cvt_scalef32_pk_f32_fp4(W, 1.0f, 0), c2_, out[4 * (q) + 0]); \
        out[4 * (q) + 1] = __builtin_elementwise_fma(__builtin_amdgcn_cvt_scalef32_pk_f32_fp4(W, 1.0f, 1), c2_, out[4 * (q) + 1]); \
        out[4 * (q) + 2] = __builtin_elementwise_fma(__builtin_amdgcn_cvt_scalef32_pk_f32_fp4(W, 1.0f, 2), c2_, out[4 * (q) + 2]); \
        out[4 * (q) + 3] = __builtin_elementwise_fma(__builtin_amdgcn_cvt_scalef32_pk_f32_fp4(W, 1.0f, 3), c2_, out[4 * (q) + 3]); } while (0)
#define PV_COMP(buf, csrc, lb) do { unsigned cs_ = __float_as_uint(csrc); asm volatile("" : "+v"(cs_)); _Pragma("unroll") for (int k_ = 0; k_ < 16; ++k_) { \
        const float ca_ = __uint_as_float(__builtin_amdgcn_readlane(cs_, (lb) + 2 * k_)), cb_ = __uint_as_float(__builtin_amdgcn_readlane(cs_, (lb) + 2 * k_ + 1)); \
        const float cj_ = r ? cb_ : ca_; const f32x2_t c2_ = {cj_, cj_}; \
        PV_D4(buf[k_].x, 0); PV_D4(buf[k_].y, 1); PV_D4(buf[k_].z, 2); PV_D4(buf[k_].w, 3); } __builtin_amdgcn_sched_barrier(0); } while (0)
    PV_ROWS(vA, ne0, 0);
    for (; tok < MTOK; tok += nw) {
        const int e0 = ne0, e1 = ne1;
        const float c0 = nc0, c1 = nc1;
        {
            const size_t tn = (size_t)(tok + nw < MTOK ? tok + nw : tok);
            ne0 = pidx[tn * 128 + lane]; ne1 = pidx[tn * 128 + 64 + lane];
            nc0 = pgt[tn * 128 + lane]; nc1 = pgt[tn * 128 + 64 + lane];
        }
        f32x2_t out[16];
#pragma unroll
        for (int k = 0; k < 16; ++k) out[k] = (f32x2_t){0.f, 0.f};
        PV_ROWS(vB, e0, 32); PV_COMP(vA, c0, 0);
        PV_ROWS(vA, e1, 0);  PV_COMP(vB, c0, 32);
        PV_ROWS(vB, e1, 32); PV_COMP(vA, c1, 0);
        PV_ROWS(vA, ne0, 0); PV_COMP(vB, c1, 32);
        float4 xn[4]; float ss = 0.f;
#pragma unroll
        for (int q = 0; q < 4; ++q) {
            float fin[4];
#pragma unroll
            for (int b = 0; b < 2; ++b)
#pragma unroll
                for (int c = 0; c < 2; ++c) {
                    const float lo = out[4 * q + b][c], hi = out[4 * q + 2 + b][c];
                    const float mine = r ? hi : lo, send = r ? lo : hi;
                    fin[2 * b + c] = mine + __shfl_xor(send, 32, 64);
                }
            float4* xp = (float4*)(x + (size_t)tok * DM + 256 * q + 8 * (lane & 31) + (r ? 4 : 0));
            float4 a = *xp;
            a.x += fin[0]; a.y += fin[1]; a.z += fin[2]; a.w += fin[3];
            *xp = a;
            if (NORM) { xn[q] = a; ss += a.x * a.x + a.y * a.y + a.z * a.z + a.w * a.w; }
        }
        if (NORM) {
            ss = wave_sum(ss);
            const float rs = rsqrtf(ss * (1.f / DM) + EPS);
            bf16_t* hrow = (bf16_t*)(pws_() + WS_H) + (size_t)tok * DM + 8 * (lane & 31) + (r ? 4 : 0);
#pragma unroll
            for (int q = 0; q < 4; ++q) {
                ushort4 o; o.x = f2bf(xn[q].x * rs * gn[q].x); o.y = f2bf(xn[q].y * rs * gn[q].y); o.z = f2bf(xn[q].z * rs * gn[q].z); o.w = f2bf(xn[q].w * rs * gn[q].w);
                *(ushort4*)(hrow + 256 * q) = o;
            }
        }
    }
#undef PV_ROWS
#undef PV_COMP
#undef PV_D4
}


#ifndef PROBE_MASK
#define PROBE_MASK 0
#endif
#if PROBE_MASK
#define GB(k) do { GRID_BARRIER(); const unsigned long long now_ = wall_clock64(); if ((PROBE_MASK >> (k)) & 1) { const unsigned long long dt_ = now_ - tprev_; while (wall_clock64() - now_ < 3ull * dt_) __builtin_amdgcn_s_sleep(8); } GRID_BARRIER(); tprev_ = wall_clock64(); } while (0)
#else
#define GB(k) GRID_BARRIER()
#endif
__global__ void __launch_bounds__(512, 2) k_mega(Params kp) {
    float* sm = dynsmem;
    {
        unsigned long long* tab = (unsigned long long*)((char*)dynsmem + PTAB_OFF);
        if (threadIdx.x < 34) tab[threadIdx.x] = (unsigned long long)kp.in[threadIdx.x];
        if (threadIdx.x == 34) tab[34] = (unsigned long long)kp.out;
        if (threadIdx.x == 35) tab[35] = (unsigned long long)kp.ws;
        if (threadIdx.x == 36) { tab[36] = 0ull; tab[37] = 0ull; }
    }
    __syncthreads();
    Ctx p; p.kp = &kp;
    (void)xcd_barrier_post((unsigned*)(pws_() + WS_BAR), (volatile LAS unsigned*)((char*)dynsmem + PTAB_OFF + 36 * 8));
#define GRID_BARRIER() do { XcdBarrier bar_; bar_.bar = (unsigned*)(pws_() + WS_BAR); bar_.x = xb_xcc_id(); bar_.st = (volatile LAS unsigned*)((char*)dynsmem + PTAB_OFF + 36 * 8); xcd_barrier(bar_); } while (0)
    ph_weight_prep(p, sm);
    ph_subkeys_convert(p);
    ph_tab_convert_all(p);
    ph_rmsnorm(pin_(0), pin_(2), (bf16_t*)(pws_() + WS_H), MTOK);
    ph_rmsnorm(pin_(1), pin_(22), (bf16_t*)(pws_() + WS_HM), MMEM);
    GRID_BARRIER();
#if PROBE_MASK
    unsigned long long tprev_ = wall_clock64();
#endif
#pragma unroll 1
    for (int l = 0; l < DEPTH; ++l) {
#define XIN_ (l == 0 ? pin_(0) : pout_())
#define HBUF_ ((const bf16_t*)(pws_() + WS_H))
        { pg8::EpiBf16 E; E.O = (bf16_t*)(pws_() + WS_P); E.ldc = LDP; ph_gemm(HBUF_, (const bf16_t*)(pws_() + WT_IN) + (size_t)l * LDP * DM, MTOK, LDP, DM, E); }
        { pg8::EpiF32 E; E.C = (float*)(pws_() + WS_KM); E.R = nullptr; E.ldc = 256; ph_gemm((const bf16_t*)(pws_() + WS_HM), (const bf16_t*)(pws_() + WT_XK) + (size_t)l * 256 * DM, MMEM, 256, DM, E, 32); }
        { pg8::EpiF32 E; E.C = (float*)(pws_() + WS_VM); E.R = nullptr; E.ldc = 256; ph_gemm((const bf16_t*)(pws_() + WS_HM), (const bf16_t*)(pws_() + WT_XV) + (size_t)l * 256 * DM, MMEM, 256, DM, E, 64); }
        GB(2);
        ph_mem_prep(p, l);
        ph_dsa_prep(p, l);
        ph_scan_prep(p, l);
        GB(3);
        ph_scans(p, l, sm);
        GB(4);
        ph_mixer_finish(p, l);
        ph_dsa_main(p, l, sm);
        GB(5);
#define PANEL_SYNC() do { asm volatile("s_waitcnt vmcnt(0) lgkmcnt(0)" ::: "memory"); __syncthreads(); \
        if (threadIdx.x < 64) { __builtin_amdgcn_fence(__ATOMIC_ACQUIRE, "agent"); asm volatile("s_waitcnt vmcnt(0)" ::: "memory"); } \
        __syncthreads(); } while (0)
        if (nblk_() == MTOK / 256) {
            const int pm = bid_(), wv = tid_() >> 6;
            { pg8::EpiF32 E; E.C = pout_(); E.R = XIN_; E.ldc = DM; ph_gemm_panel((const bf16_t*)(pws_() + WS_Y), (const bf16_t*)(pws_() + WT_OUT) + (size_t)l * DM * DM, MTOK, DM, DM, E, pm); }
            PANEL_SYNC();
            ph_rmsnorm(pout_(), pin_(21) + (size_t)l * DM, (bf16_t*)(pws_() + WS_H), 256, pm * 256, wv, 8);
            PANEL_SYNC();
            { pg8::EpiF32 E; E.C = (float*)(pws_() + WS_QX); E.R = nullptr; E.ldc = 256; ph_gemm_panel(HBUF_, (const bf16_t*)(pws_() + WT_XQ) + (size_t)l * 256 * DM, MTOK, 256, DM, E, pm); }
            PANEL_SYNC();
            ph_xattn(p, l, pm * 16, 16, wv, 8);
            PANEL_SYNC();
            { pg8::EpiF32 E; E.C = pout_(); E.R = pout_(); E.ldc = DM; ph_gemm_panel((const bf16_t*)(pws_() + WS_OX), (const bf16_t*)(pws_() + WT_XO) + (size_t)l * DM * 256, MTOK, DM, 256, E, pm); }
            PANEL_SYNC();
            ph_rmsnorm(pout_(), pin_(29) + (size_t)l * DM, (bf16_t*)(pws_() + WS_H), 256, pm * 256, wv, 8, (unsigned char*)(pws_() + WS_H8));
            PANEL_SYNC();
            { pg8::EpiBf16 E; E.O = (bf16_t*)(pws_() + WS_QP); E.ldc = DM; ph_gemm_panel(HBUF_, (const bf16_t*)(pws_() + WT_PQ) + (size_t)l * DM * DM, MTOK, DM, DM, E, pm); }
            PANEL_SYNC();
            ph_peer_topk(p, l, sm, pm * 16, 16, wv, 8);
        }
        GB(13);
        ph_peer_u4(p, l, sm);
        GB(14);
        if (l + 1 < DEPTH) {
            ph_peer_v4<true>(p, l);
            ph_rmsnorm(pin_(1), pin_(22) + (size_t)(l + 1) * DM, (bf16_t*)(pws_() + WS_HM), MMEM);
        } else ph_peer_v4<false>(p, l);
        GB(17);
    }
}

extern "C" void kernel_launch(void* const* d_in, const int* in_sizes, int n_in, void* d_out, int out_size, void* d_ws, size_t ws_size, hipStream_t stream) {
    if (n_in != 34 || out_size != MTOK * DM || ws_size < WS_END) {
        fprintf(stderr, "kernel_launch: unexpected shapes (n_in %d out %d ws %zu need %zu)\n", n_in, out_size, ws_size, (size_t)WS_END);
        return;
    }
    static int grid = 0;
    if (!grid) {
        int dev = 0, cus = 0, per_cu = 0;
        (void)hipGetDevice(&dev);
        (void)hipDeviceGetAttribute(&cus, hipDeviceAttributeMultiprocessorCount, dev);
        (void)hipFuncSetAttribute((const void*)k_mega, hipFuncAttributeMaxDynamicSharedMemorySize, LDS_BYTES);
        (void)hipOccupancyMaxActiveBlocksPerMultiprocessor(&per_cu, (const void*)k_mega, 512, LDS_BYTES);
        if (per_cu < 1) fprintf(stderr, "kernel_launch: occupancy query reports %d blocks per CU\n", per_cu);
        grid = cus > 0 ? cus : 256;
    }
    Params p; memset(&p, 0, sizeof(p));
    for (int i = 0; i < 34; ++i) p.in[i] = (const float*)d_in[i];
    p.out = (float*)d_out; p.ws = (char*)d_ws;
    (void)hipMemsetAsync((char*)d_ws + WS_BAR, 0, XCD_BAR_WORDS * sizeof(unsigned), stream);
    hipLaunchKernelGGL(k_mega, dim3(grid), dim3(512), LDS_BYTES, stream, p);
}
```

```cpp
#include <hip/hip_runtime.h>
#include <stdint.h>
#include <stdio.h>
#include <string.h>

#define NB 32
#define SEQ 2048
#define DM 1024
#define MTOK (NB * SEQ)
#define DEPTH 4
#define NMEM 256
#define MMEM (NB * NMEM)
#define LDP 3328
#define NEXP 16384
#define EPS 1e-6f
#define PC_Z 0
#define PC_XBC 256
#define PC_GQKV 768
#define PC_GG 1536
#define PC_LQ 1792
#define PC_LK 1920
#define PC_LV 2048
#define PC_LR 2304
#define PC_DQ 2560
#define PC_DK 2816
#define PC_DV 2880
#define PC_IQ 2944
#define PC_IK 3200
#define PC_GLR 3232
#define PC_IW 3248
#define PC_DT 3256
#define PC_GA 3260
#define PC_GB 3264

typedef unsigned short bf16_t;

#define WS_BAR 0ull
#define WS_P 16384ull
#define SZ_P ((size_t)MTOK * LDP * 2)
#define WS_H (WS_P + SZ_P)
#define SZ_H ((size_t)MTOK * DM * 2)
#define WS_Y (WS_H + SZ_H)
#define SZ_Y ((size_t)MTOK * DM * 2)
#define WS_WP (WS_Y + SZ_Y)
#define SZ_WP ((size_t)DEPTH * DM * LDP * 4)
#define WT_IN (WS_WP)
#define WT_OUT (WT_IN + (size_t)DEPTH * LDP * DM * 2)
#define WT_XQ (WT_OUT + (size_t)DEPTH * DM * DM * 2)
#define WT_XK (WT_XQ + (size_t)DEPTH * 256 * DM * 2)
#define WT_XV (WT_XK + (size_t)DEPTH * 256 * DM * 2)
#define WT_XO (WT_XV + (size_t)DEPTH * 256 * DM * 2)
#define WT_PQ (WT_XO + (size_t)DEPTH * DM * 256 * 2)
#define WT_END (WT_PQ + (size_t)DEPTH * DM * DM * 2)
#define WS_QN (WS_WP + SZ_WP)
#define SZ_QN ((size_t)MTOK * 256 * 4)
#define WS_KN (WS_QN + SZ_QN)
#define SZ_KN ((size_t)MTOK * 64 * 4)
#define WS_IKN (WS_KN + SZ_KN)
#define SZ_IKN ((size_t)MTOK * 32 * 4)
#define WS_YPRE (WS_IKN + SZ_IKN)
#define SZ_YPRE ((size_t)MTOK * 256 * 4)
#define WS_HM (WS_YPRE + SZ_YPRE)
#define SZ_HM ((size_t)MMEM * DM * 2)
#define WS_KM (WS_HM + SZ_HM)
#define SZ_KM ((size_t)MMEM * 256 * 4)
#define WS_VM (WS_KM + SZ_KM)
#define SZ_VM ((size_t)MMEM * 256 * 4)
#define WS_KB (WS_VM + SZ_VM)
#define SZ_KB ((size_t)MMEM * 256 * 2)
#define WS_VTB (WS_KB + SZ_KB)
#define SZ_VTB ((size_t)MMEM * 256 * 2)
#define WS_VT (WS_VTB + SZ_VTB)
#define SZ_VT ((size_t)MTOK * 64 * 2)
#define WS_SKB (WS_VT + SZ_VT)
#define SZ_SKB ((size_t)DEPTH * 8 * 2 * 128 * 64 * 2)
#define WS_SC (WS_SKB + SZ_SKB)
#define SZ_SC ((size_t)MTOK * 16 * 4)
#define WS_DUMMY (WS_SC + SZ_SC)
#define SZ_DUMMY (65536ull)
#define WS_U4 (WS_DUMMY + SZ_DUMMY)
#define WS_V4 (WS_U4 + (size_t)DEPTH * NEXP * 512)
#define WS_USC (WS_V4 + (size_t)DEPTH * NEXP * 512)
#define WS_VSC (WS_USC + (size_t)DEPTH * NEXP * 4)
#define WS_END (WS_VSC + (size_t)DEPTH * NEXP * 4)
#define WS_QX (WS_P)
#define WS_OX (WS_P + (size_t)MTOK * 256 * 4)
#define WS_QP (WS_P + 96ull * 1024 * 1024)
#define WS_H8 (WS_P + 224ull * 1024 * 1024)
#define WS_PEI (WS_H8 + (size_t)MTOK * DM)
#define WS_PEG (WS_PEI + (size_t)MTOK * 128 * 4)
#define WS_PUS (WS_PEG + (size_t)MTOK * 128 * 4)
#define WS_PEND (WS_PUS + (size_t)MTOK * 128 * 4)
static_assert(WS_PEND <= WS_P + SZ_P, "P region aliases");

struct Params {
    const float* in[34];
    float* out;
    char* ws;
};

#define XB_TMO      128
#define XB_XCNT(j)  (256  + 64 * (j))
#define XB_XSUB(j)  (1280 + 64 * (j))
#define XB_XGEN(j)  (2304 + 64 * (j))
#define XB_TOP      3328
#define XB_TOPGEN   3392
#define XCD_BAR_WORDS 3456
#define XB_SPIN_CAP (1u << 18)
#define LAS __attribute__((address_space(3)))

__device__ __forceinline__ unsigned xb_ld(unsigned* p)              { return __hip_atomic_load(p, __ATOMIC_RELAXED, __HIP_MEMORY_SCOPE_AGENT); }
__device__ __forceinline__ unsigned xb_add(unsigned* p, unsigned v) { return __hip_atomic_fetch_add(p, v, __ATOMIC_RELAXED, __HIP_MEMORY_SCOPE_AGENT); }
__device__ __forceinline__ unsigned xb_xcc_id() { return (unsigned)__builtin_amdgcn_s_getreg((3 << 11) | 20) & 0xFu; }
#define XB_SPIN(cond, bar) do { unsigned _sp = 0; while (cond) { __builtin_amdgcn_s_sleep(1); \
    if ((++_sp & 255u) == 0u) { if (xb_ld(&(bar)[XB_TMO])) break; if (_sp > XB_SPIN_CAP) { atomicAdd(&(bar)[XB_TMO], 1u); break; } } } } while (0)

struct XcdBarrier {
    unsigned* bar; unsigned x;
    volatile LAS unsigned* st;
};

__device__ __forceinline__ XcdBarrier xcd_barrier_post(unsigned* bar, volatile LAS unsigned* st) {
    XcdBarrier b; b.bar = bar; b.x = xb_xcc_id(); b.st = st;
    if (threadIdx.x == 0) (void)xb_add(&bar[XB_XCNT(b.x)], 1u);
    return b;
}
__device__ __forceinline__ void xcd_barrier_complete(unsigned* bar, unsigned x, unsigned& nloc, unsigned& nx) {
    const unsigned G = gridDim.x * gridDim.y * gridDim.z;
    unsigned sum, cnt, mine, sp = 0u;
    for (;;) {
        sum = 0u; cnt = 0u; mine = 0u;
#pragma unroll
        for (unsigned j = 0; j < 16; ++j) { const unsigned c = xb_ld(&bar[XB_XCNT(j)]); sum += c; cnt += (c > 0u) ? 1u : 0u; mine = (j == x) ? c : mine; }
        if (sum == G) break;
        __builtin_amdgcn_s_sleep(1);
        if ((++sp & 255u) == 0u) { if (xb_ld(&bar[XB_TMO])) break; if (sp > XB_SPIN_CAP) { atomicAdd(&bar[XB_TMO], 1u); break; } }
    }
    nloc = mine > 0u ? mine : 1u; nx = cnt > 0u ? cnt : 1u;
}

__device__ __forceinline__ void xcd_barrier(const XcdBarrier& b) {
    asm volatile("s_waitcnt vmcnt(0)" ::: "memory");
    __syncthreads();
    if (threadIdx.x == 0) {
        unsigned* bar = b.bar;
        __builtin_amdgcn_s_waitcnt(0);
        unsigned nloc = b.st[0], nx = b.st[1];
        if (nloc == 0u) { xcd_barrier_complete(bar, b.x, nloc, nx); b.st[0] = nloc; b.st[1] = nx; }
        const unsigned old = xb_add(&bar[XB_XSUB(b.x)], 1u);
        const unsigned gen = old / nloc;
        if (old + 1u == (gen + 1u) * nloc) {
            __builtin_amdgcn_fence(__ATOMIC_RELEASE, "agent");
            asm volatile("s_waitcnt vmcnt(0)" ::: "memory");
            const unsigned og = xb_add(&bar[XB_TOP], 1u);
            const unsigned tg = og / nx;
            if (og + 1u == (tg + 1u) * nx) xb_add(&bar[XB_TOPGEN], 1u);
            else XB_SPIN(xb_ld(&bar[XB_TOPGEN]) == tg, bar);
            __builtin_amdgcn_fence(__ATOMIC_ACQUIRE, "agent");
            xb_add(&bar[XB_XGEN(b.x)], 1u);
            asm volatile("s_waitcnt vmcnt(0)" ::: "memory");
        } else {
            XB_SPIN(xb_ld(&bar[XB_XGEN(b.x)]) == gen, bar);
            __builtin_amdgcn_fence(__ATOMIC_ACQUIRE, "agent");
            asm volatile("s_waitcnt vmcnt(0)" ::: "memory");
        }
    }
    __syncthreads();
}


#define LDS_BYTES (144 * 1024)
#define PTAB_OFF (LDS_BYTES - 1024)
extern __shared__ __attribute__((aligned(16))) float dynsmem[];
struct Ctx { const Params* kp; };
#define pin_(i) (p.kp->in[i])
#define pout_() (p.kp->out)
#define pws_() (p.kp->ws)

__device__ __forceinline__ float bf2f(bf16_t v) { return __uint_as_float(((unsigned)v) << 16); }
typedef float cvf32x2_t __attribute__((ext_vector_type(2)));
typedef __bf16 cvbf16x2_t __attribute__((ext_vector_type(2)));
__device__ __forceinline__ unsigned pk_bf16(float lo, float hi) {
    const cvf32x2_t f = {lo, hi}; union { cvbf16x2_t b; unsigned u; } c; c.b = __builtin_convertvector(f, cvbf16x2_t); return c.u;
}
__device__ __forceinline__ bf16_t f2bf(float f) { return (bf16_t)pk_bf16(f, f); }
__device__ __forceinline__ float wave_sum(float v) {
#pragma unroll
    for (int o = 32; o >= 1; o >>= 1) v += __shfl_xor(v, o, 64);
    return v;
}
__device__ __forceinline__ float wave_max(float v) {
#pragma unroll
    for (int o = 32; o >= 1; o >>= 1) v = fmaxf(v, __shfl_xor(v, o, 64));
    return v;
}
__device__ __forceinline__ float silu_f(float x) { return x * __builtin_amdgcn_rcpf(1.f + __expf(-x)); }
__device__ __forceinline__ float sigmoid_f(float x) { return __builtin_amdgcn_rcpf(1.f + __expf(-x)); }
__device__ __forceinline__ float softplus_f(float x) { return x > 20.f ? x : log1pf(__expf(x)); }
__device__ __forceinline__ float logsigmoid_f(float x) { return -softplus_f(-x); }
__device__ __forceinline__ float gelu_tanh_f(float x) { const float u = 0.7978845608028654f * (x + 0.044715f * x * x * x); return 0.5f * x * (1.f + tanhf(u)); }
__device__ __forceinline__ unsigned ford(float f) { f = f + 0.0f; unsigned u = __float_as_uint(f); return (u & 0x80000000u) ? ~u : (u | 0x80000000u); }
__device__ __forceinline__ float funord(unsigned k) { unsigned u = (k & 0x80000000u) ? (k & 0x7fffffffu) : ~k; return __uint_as_float(u); }
__device__ __forceinline__ unsigned long long wave_max_u64(unsigned long long v) {
#pragma unroll
    for (int o = 32; o >= 1; o >>= 1) {
        unsigned lo = __shfl_xor((unsigned)v, o, 64), hi = __shfl_xor((unsigned)(v >> 32), o, 64);
        unsigned long long w = ((unsigned long long)hi << 32) | lo;
        v = w > v ? w : v;
    }
    return v;
}
__device__ __forceinline__ int tid_() { int t = threadIdx.x; asm volatile("" : "+v"(t)); return t; }
__device__ __forceinline__ int bid_() { int b = blockIdx.x; asm volatile("" : "+s"(b)); return b; }
__device__ __forceinline__ int nblk_() { int g = gridDim.x; asm volatile("" : "+s"(g)); return g; }
__device__ __forceinline__ int gwave() { return (bid_() * 512 + tid_()) >> 6; }
__device__ __forceinline__ int nwaves() { return nblk_() * 8; }

namespace pg8 {
#define PG8_LAS __attribute__((address_space(3)))
typedef unsigned short bf16_t;
typedef short bf16x8 __attribute__((ext_vector_type(8)));
typedef float f32x4 __attribute__((ext_vector_type(4)));
typedef unsigned u32x4 __attribute__((ext_vector_type(4)));
constexpr int BM = 256, BK = 64, HALF = 128, HTB = HALF * BK * 2  , STAGE_BYTES = 8 * HTB, NXCD = 8, WGM = 8;

__host__ __device__ __forceinline__ int lds_byte(int r, int c) { const int st = (r >> 4) * 2 + (c >> 5), rr = r & 15, cc = c & 31, ob = rr * 64 + cc * 2; return st * 1024 + (ob ^ (((ob >> 9) & 1) << 5)); }
__host__ __device__ __forceinline__ void stage_rc(int b, int& R, int& C) { const int st = b / 1024, sb = b % 1024, swz = sb ^ (((sb >> 9) & 1) << 5); R = (st >> 1) * 16 + swz / 64; C = (st & 1) * 32 + (swz % 64) / 2; }
__host__ __device__ __forceinline__ int perm32(int rho) { const int n = rho >> 4, i = rho & 15; return 8 * (i >> 2) + 4 * n + (i & 3); }

struct Unit { int pm, pn; };
struct Gemm { const bf16_t* A; const bf16_t* Bt; int M, N, K; };

struct StaticOrder {
    int nM, nN, nwg, G, c;
    __host__ __device__ void init(int M, int N, int G_, int c_) { nM = M / BM; nN = N / BM; nwg = nM * nN; G = G_; c = c_; }
    __host__ __device__ bool next(int i, Unit& u) const {
        const long L = (long)i * G + c; if (L >= nwg) return false;
        int wgid = (int)L; { const int q = nwg / NXCD, r = nwg % NXCD, xcd = wgid % NXCD, off = wgid / NXCD; wgid = (xcd < r ? xcd * (q + 1) : r * (q + 1) + (xcd - r) * q) + off; }
        const int nig = WGM * nN, gid = wgid / nig, fm = gid * WGM, gsz = (nM - fm) < WGM ? (nM - fm) : WGM;
        u.pm = fm + ((wgid % nig) % gsz); u.pn = (wgid % nig) / gsz; return true;
    }
    __device__ __forceinline__ void a_ready(const Unit&) const {}
    __device__ __forceinline__ void done(const Unit&) const {}
};

__device__ __forceinline__ unsigned cvt_pk_bf16(float lo, float hi) { return ::pk_bf16(lo, hi); }
struct EpiF32 {
    static constexpr bool PERM = false, AFTER_DRAIN = false;
    float* C; const float* R; int ldc;
    __device__ __forceinline__ void operator()(const f32x4 (&acc)[2][2][4][2], const Unit& u, int wr, int wc, int fr, int fq) const {
        const int row0 = u.pm * BM + wr * 64 + fr, col0 = u.pn * BM + wc * 32 + 4 * fq;
#pragma unroll
        for (int ai = 0; ai < 2; ++ai)
#pragma unroll
            for (int m = 0; m < 4; ++m) { const size_t off = (size_t)(row0 + ai * HALF + m * 16) * ldc + col0;
                f32x4 rv[2][2];
#pragma unroll
                for (int bj = 0; bj < 2; ++bj)
#pragma unroll
                    for (int n = 0; n < 2; ++n) rv[bj][n] = R ? *(const f32x4*)(R + off + bj * HALF + n * 16) : (f32x4){0.f, 0.f, 0.f, 0.f};
#pragma unroll
                for (int bj = 0; bj < 2; ++bj)
#pragma unroll
                    for (int n = 0; n < 2; ++n) *(f32x4*)(C + off + bj * HALF + n * 16) = acc[ai][bj][m][n] + rv[bj][n]; }
    }
};
struct EpiBf16 {
    static constexpr bool PERM = true, AFTER_DRAIN = false;
    bf16_t* O; int ldc;
    __device__ __forceinline__ void operator()(const f32x4 (&acc)[2][2][4][2], const Unit& u, int wr, int wc, int fr, int fq) const {
        const int row0 = u.pm * BM + wr * 64 + fr, col0 = u.pn * BM + wc * 32 + 8 * fq;
#pragma unroll
        for (int ai = 0; ai < 2; ++ai)
#pragma unroll
            for (int m = 0; m < 4; ++m) { bf16_t* rowp = O + (size_t)(row0 + ai * HALF + m * 16) * ldc + col0;
#pragma unroll
                for (int bj = 0; bj < 2; ++bj) { const f32x4 v0 = acc[ai][bj][m][0], v1 = acc[ai][bj][m][1];
                    u32x4 w; w.x = cvt_pk_bf16(v0[0], v0[1]); w.y = cvt_pk_bf16(v0[2], v0[3]); w.z = cvt_pk_bf16(v1[0], v1[1]); w.w = cvt_pk_bf16(v1[2], v1[3]);
                    *(u32x4*)(rowp + bj * HALF) = w; } }
    }
};

template <class Epi, class Sched, bool STAMP = false>
__device__ __forceinline__ void gemm_phase(PG8_LAS unsigned char* lds, const Gemm g, const Sched& S, const Epi& E, unsigned long long* stamps, const int tid) {
    const int wid = __builtin_amdgcn_readfirstlane(tid >> 6), lane = tid & 63, wr = wid >> 2, wc = wid & 3, fr = lane & 15, fq = lane >> 4;
    const int K = g.K, nt = K / BK;
    int ts_lo = 0, ts_hi = 0, nts = 0; const unsigned long long rt_entry = STAMP ? (unsigned long long)wall_clock64() : 0ull;
#define PG8_STAMP() do { if (STAMP && wid == 0 && nts < 64) { const unsigned long long _c = (unsigned long long)clock64(); \
        ts_lo = (lane == nts) ? (int)(unsigned)_c : ts_lo; ts_hi = (lane == nts) ? (int)(unsigned)(_c >> 32) : ts_hi; ++nts; } } while (0)
    PG8_STAMP();
    unsigned voffA[2], voffB[2];
#pragma unroll
    for (int i = 0; i < 2; ++i) { int R, C; stage_rc(tid * 16 + i * 8192, R, C); const int Rb = Epi::PERM ? ((R & ~31) + perm32(R & 31)) : R;
        voffA[i] = (unsigned)(R * K + C) * 2u; voffB[i] = (unsigned)(Rb * K + C) * 2u; }
    const size_t kstep = (size_t)(BK * 2);
    const size_t hstep = (size_t)HALF * K * 2;
    const size_t tstep = 2 * hstep;
    const unsigned ldsw = (unsigned)wid * 1024u;
    const int aoff = lds_byte(wr * 64 + fr, fq * 8), boff = lds_byte(wc * 32 + fr, fq * 8);
#define PG8_SA(b, h) (((b) * 2 + (h)) * HTB)
#define PG8_SB(b, h) ((4 + (b) * 2 + (h)) * HTB)
#define PG8_STAGE(bufoff, gbase, voff) do { _Pragma("unroll") for (int _i = 0; _i < 2; ++_i) \
        __builtin_amdgcn_global_load_lds((const unsigned*)((const char*)(gbase) + (voff)[_i]), (PG8_LAS unsigned*)(lds + (bufoff) + ldsw + _i * 8192), 16, 0, 0); } while (0)
#define PG8_LDA(dst, b, h) do { _Pragma("unroll") for (int m = 0; m < 4; ++m) _Pragma("unroll") for (int k = 0; k < 2; ++k) dst[m][k] = *(const PG8_LAS bf16x8*)(lds + PG8_SA(b, h) + aoff + m * 2048 + k * 1024); } while (0)
#define PG8_LDB(dst, b, h) do { _Pragma("unroll") for (int n = 0; n < 2; ++n) _Pragma("unroll") for (int k = 0; k < 2; ++k) dst[n][k] = *(const PG8_LAS bf16x8*)(lds + PG8_SB(b, h) + boff + n * 2048 + k * 1024); } while (0)
#define PG8_MMA(ai, bj, At, Bt) do { __builtin_amdgcn_s_setprio(1); _Pragma("unroll") for (int m = 0; m < 4; ++m) _Pragma("unroll") for (int n = 0; n < 2; ++n) _Pragma("unroll") for (int k = 0; k < 2; ++k) \
        acc[ai][bj][m][n] = __builtin_amdgcn_mfma_f32_16x16x32_bf16(Bt[n][k], At[m][k], acc[ai][bj][m][n], 0, 0, 0); __builtin_amdgcn_s_setprio(0); } while (0)
#define PG8_WAIT_V(n) asm volatile("s_waitcnt vmcnt(" #n ")" ::: "memory")
#define PG8_WAIT_L(n) asm volatile("s_waitcnt lgkmcnt(" #n ")" ::: "memory")
#define PG8_BAR __builtin_amdgcn_s_barrier()
#define PG8_SCHED __builtin_amdgcn_sched_barrier(0)
    Unit cur, nxt; int ui = 0;
    if (!S.next(0, cur)) return;
    f32x4 acc[2][2][4][2];
#pragma unroll
    for (int a = 0; a < 2; ++a)
#pragma unroll
        for (int b = 0; b < 2; ++b)
#pragma unroll
            for (int m = 0; m < 4; ++m)
#pragma unroll
                for (int n = 0; n < 2; ++n) acc[a][b][m][n] = (f32x4){0.f, 0.f, 0.f, 0.f};
    bf16x8 At[4][2], B0[2][2], B1[2][2];
    const char* cA = (const char*)g.A + (size_t)cur.pm * tstep; const char* cB = (const char*)g.Bt + (size_t)cur.pn * tstep;
    S.a_ready(cur);
    PG8_STAGE(PG8_SB(0, 0), cB, voffB); PG8_STAGE(PG8_SA(0, 0), cA, voffA); PG8_STAGE(PG8_SB(0, 1), cB + hstep, voffB); PG8_STAGE(PG8_SA(0, 1), cA + hstep, voffA);
    if (wr == 1) PG8_BAR;
    PG8_WAIT_V(4); PG8_BAR;
    PG8_STAGE(PG8_SB(1, 0), cB + kstep, voffB); PG8_STAGE(PG8_SA(1, 0), cA + kstep, voffA); PG8_STAGE(PG8_SB(1, 1), cB + hstep + kstep, voffB);
    PG8_WAIT_V(6); PG8_BAR;
    PG8_STAMP();
    for (;;) {
        const bool has_next = S.next(ui + 1, nxt);
        const char* nA = has_next ? (const char*)g.A + (size_t)nxt.pm * tstep : cA; const char* nB = has_next ? (const char*)g.Bt + (size_t)nxt.pn * tstep : cB;
        for (int t = 0; t < nt; t += 2) {
            const bool last = (t == nt - 2);
            const char* a1 = cA + (size_t)(t + 1) * kstep;
            const char* a2 = last ? nA : cA + (size_t)(t + 2) * kstep; const char* b2 = last ? nB : cB + (size_t)(t + 2) * kstep;
            const char* a3 = a2 + kstep; const char* b3 = b2 + kstep;
            if (last && has_next) S.a_ready(nxt);
            PG8_LDB(B0, 0, 0); PG8_SCHED; PG8_LDA(At, 0, 0); PG8_STAGE(PG8_SA(1, 1), a1 + hstep, voffA);
            PG8_WAIT_L(8); PG8_BAR; PG8_WAIT_L(0); PG8_MMA(0, 0, At, B0); PG8_BAR; PG8_SCHED;
            PG8_LDB(B1, 0, 1); PG8_STAGE(PG8_SB(0, 0), b2, voffB);
            PG8_BAR; PG8_WAIT_L(0); PG8_MMA(0, 1, At, B1); PG8_BAR;
            PG8_LDA(At, 0, 1); PG8_STAGE(PG8_SA(0, 0), a2, voffA);
            PG8_BAR; PG8_WAIT_L(0); PG8_MMA(1, 0, At, B0); PG8_BAR; PG8_SCHED;
            PG8_STAGE(PG8_SB(0, 1), b2 + hstep, voffB);
            PG8_WAIT_V(6); PG8_BAR; PG8_MMA(1, 1, At, B1); PG8_BAR;
            PG8_LDB(B0, 1, 0); PG8_SCHED; PG8_LDA(At, 1, 0); PG8_STAGE(PG8_SA(0, 1), a2 + hstep, voffA);
            PG8_WAIT_L(8); PG8_BAR; PG8_WAIT_L(0); PG8_MMA(0, 0, At, B0); PG8_BAR; PG8_SCHED;
            PG8_LDB(B1, 1, 1); PG8_STAGE(PG8_SB(1, 0), b3, voffB);
            PG8_BAR; PG8_WAIT_L(0); PG8_MMA(0, 1, At, B1); PG8_BAR;
            PG8_LDA(At, 1, 1); PG8_STAGE(PG8_SA(1, 0), a3, voffA);
            PG8_BAR; PG8_WAIT_L(0); PG8_MMA(1, 0, At, B0); PG8_BAR; PG8_SCHED;
            PG8_STAGE(PG8_SB(1, 1), b3 + hstep, voffB);
            PG8_WAIT_V(6); PG8_BAR; PG8_MMA(1, 1, At, B1); PG8_BAR;
        }
        PG8_STAMP();
        if constexpr (!Epi::AFTER_DRAIN) { E(acc, cur, wr, wc, fr, fq); S.done(cur); }
        PG8_STAMP();
        if (!has_next) break;
#pragma unroll
        for (int a = 0; a < 2; ++a)
#pragma unroll
            for (int b = 0; b < 2; ++b)
#pragma unroll
                for (int m = 0; m < 4; ++m)
#pragma unroll
                    for (int n = 0; n < 2; ++n) acc[a][b][m][n] = (f32x4){0.f, 0.f, 0.f, 0.f};
        cur = nxt; cA = nA; cB = nB; ++ui;
    }
    PG8_WAIT_V(0);
    if (wr == 0) PG8_BAR;
    PG8_BAR;
    if constexpr (Epi::AFTER_DRAIN) { E.fused(acc, cur, wr, wc, fr, fq, lds, wid, lane); S.done(cur); }
    PG8_STAMP();
    if (STAMP && wid == 0) { stamps[lane] = lane < nts ? (((unsigned long long)(unsigned)ts_hi << 32) | (unsigned)ts_lo) : 0ull;
        if (lane == 62) stamps[62] = rt_entry; if (lane == 63) stamps[63] = (unsigned long long)wall_clock64(); }
#undef PG8_STAMP
#undef PG8_SA
#undef PG8_SB
#undef PG8_STAGE
#undef PG8_LDA
#undef PG8_LDB
#undef PG8_MMA
#undef PG8_WAIT_V
#undef PG8_WAIT_L
#undef PG8_BAR
#undef PG8_SCHED
}
}

namespace pg8 {
struct PanelOrder {
    int pm, nN;
    __device__ void init(int pm_, int N) { pm = pm_; nN = N / BM; }
    __device__ bool next(int i, Unit& u) const { if (i >= nN) return false; u.pm = pm; u.pn = i; return true; }
    __device__ __forceinline__ void a_ready(const Unit&) const {}
    __device__ __forceinline__ void done(const Unit&) const {}
};
}
template <class Epi> __device__ __forceinline__ void ph_gemm_panel(const bf16_t* A, const bf16_t* Bt, int M, int N, int K, const Epi& E, int pm) {
    pg8::Gemm g; g.A = A; g.Bt = Bt; g.M = M; g.N = N; g.K = K;
    pg8::PanelOrder S; S.init(pm, N);
    pg8::gemm_phase<Epi, pg8::PanelOrder, false>((PG8_LAS unsigned char*)dynsmem, g, S, E, nullptr, tid_());
}
template <class Epi> __device__ __forceinline__ void ph_gemm(const bf16_t* A, const bf16_t* Bt, int M, int N, int K, const Epi& E, int crot = 0) {
    pg8::Gemm g; g.A = A; g.Bt = Bt; g.M = M; g.N = N; g.K = K;
    const int nb_ = nblk_();
    pg8::StaticOrder S; S.init(M, N, nb_, (bid_() + nb_ - crot) % nb_);
    pg8::gemm_phase<Epi, pg8::StaticOrder, false>((PG8_LAS unsigned char*)dynsmem, g, S, E, nullptr, tid_());
}

__device__ __forceinline__ int pcol_to_orig(int c) {
    if (c < 768) return c;
    if (c < 1536) return c - 768 + 772;
    if (c < 1792) return c - 1536 + 1548;
    if (c < 1920) return c - 1792 + 1804;
    if (c < 2048) return c - 1920 + 1932;
    if (c < 2304) return c - 2048 + 2060;
    if (c < 2560) return c - 2304 + 2332;
    if (c < 2816) return c - 2560 + 2588;
    if (c < 2880) return c - 2816 + 2844;
    if (c < 2944) return c - 2880 + 2908;
    if (c < 3200) return c - 2944 + 2972;
    if (c < 3232) return c - 3200 + 3228;
    if (c < 3248) return c - 3232 + 2316;
    if (c < 3256) return c - 3248 + 3260;
    if (c < 3260) return c - 3256 + 768;
    if (c < 3264) return c - 3260 + 1540;
    if (c < 3268) return c - 3264 + 1544;
    return -1;
}
__device__ __forceinline__ void wtrans_job(const float* W, int K, int ldw, bf16_t* Wt, int Npad, bool mapped, float* tile) {
    const int tid = tid_();
    const int tn = Npad / 64, tk = K / 64;
    for (int t = bid_(); t < tn * tk; t += nblk_()) {
        const int n0 = (t / tk) * 64, k0 = (t % tk) * 64;
        __syncthreads();
        for (int idx = tid; idx < 4096; idx += 512) {
            const int kk = idx >> 6, nn = idx & 63;
            const int col = mapped ? pcol_to_orig(n0 + nn) : (n0 + nn);
            tile[kk * 65 + nn] = col >= 0 ? W[(size_t)(k0 + kk) * ldw + col] : 0.f;
        }
        __syncthreads();
        for (int idx = tid; idx < 4096; idx += 512) {
            const int nn = idx >> 6, kk = idx & 63;
            Wt[(size_t)(n0 + nn) * K + k0 + kk] = f2bf(tile[kk * 65 + nn]);
        }
    }
}
__device__ __forceinline__ void ph_weight_prep(const Ctx& p, float* sm) {
#pragma unroll 1
    for (int j = 0; j < 7 * DEPTH; ++j) {
        const int l = j / 7, w = j % 7;
        const float* W; int K, ldw, Npad; bf16_t* Wt; bool mapped = false;
        if (w == 0) { W = pin_(3) + (size_t)l * DM * 3268; K = DM; ldw = 3268; Npad = LDP; Wt = (bf16_t*)(pws_() + WT_IN) + (size_t)l * LDP * DM; mapped = true; }
        else if (w == 1) { W = pin_(20) + (size_t)l * DM * DM; K = DM; ldw = DM; Npad = DM; Wt = (bf16_t*)(pws_() + WT_OUT) + (size_t)l * DM * DM; }
        else if (w == 2) { W = pin_(23) + (size_t)l * DM * 256; K = DM; ldw = 256; Npad = 256; Wt = (bf16_t*)(pws_() + WT_XQ) + (size_t)l * 256 * DM; }
        else if (w == 3) { W = pin_(24) + (size_t)l * DM * 256; K = DM; ldw = 256; Npad = 256; Wt = (bf16_t*)(pws_() + WT_XK) + (size_t)l * 256 * DM; }
        else if (w == 4) { W = pin_(25) + (size_t)l * DM * 256; K = DM; ldw = 256; Npad = 256; Wt = (bf16_t*)(pws_() + WT_XV) + (size_t)l * 256 * DM; }
        else if (w == 5) { W = pin_(26) + (size_t)l * 256 * DM; K = 256; ldw = DM; Npad = DM; Wt = (bf16_t*)(pws_() + WT_XO) + (size_t)l * DM * 256; }
        else { W = pin_(30) + (size_t)l * DM * DM; K = DM; ldw = DM; Npad = DM; Wt = (bf16_t*)(pws_() + WT_PQ) + (size_t)l * DM * DM; }
        wtrans_job(W, K, ldw, Wt, Npad, mapped, sm);
    }
}

#define H8_SCALE 16.f
__device__ __forceinline__ unsigned pack4_fp8(float4 a, float sc);
__device__ __forceinline__ void ph_rmsnorm(const float* __restrict__ x, const float* __restrict__ g, bf16_t* __restrict__ out, int rows, int row0 = 0, int w0 = -1, int wstep = 0, unsigned char* out8 = nullptr) {
    const int lane = tid_() & 63;
    if (w0 < 0) { w0 = gwave(); wstep = nwaves(); }
    float4 gq[4];
#pragma unroll
    for (int i = 0; i < 4; ++i) gq[i] = ((const float4*)g)[lane + 64 * i];
    const int rend = row0 + rows;
    for (int r0 = row0 + w0; r0 < rend; r0 += 4 * wstep) {
        float4 v[4][4];
#pragma unroll
        for (int k = 0; k < 4; ++k) {
            const int r = r0 + k * wstep < rend ? r0 + k * wstep : r0;
#pragma unroll
            for (int i = 0; i < 4; ++i) v[k][i] = ((const float4*)(x + (size_t)r * DM))[lane + 64 * i];
        }
        float ss[4];
#pragma unroll
        for (int k = 0; k < 4; ++k) { ss[k] = 0.f;
#pragma unroll
            for (int i = 0; i < 4; ++i) ss[k] += v[k][i].x * v[k][i].x + v[k][i].y * v[k][i].y + v[k][i].z * v[k][i].z + v[k][i].w * v[k][i].w; }
#pragma unroll
        for (int o = 32; o >= 1; o >>= 1) {
#pragma unroll
            for (int k = 0; k < 4; ++k) ss[k] += __shfl_xor(ss[k], o, 64);
        }
#pragma unroll
        for (int k = 0; k < 4; ++k) {
            const int r = r0 + k * wstep;
            if (r < rend) {
                const float rs = rsqrtf(ss[k] * (1.f / DM) + EPS);
#pragma unroll
                for (int i = 0; i < 4; ++i) {
                    const float4 gg = gq[i];
                    const float4 w = make_float4(v[k][i].x * rs * gg.x, v[k][i].y * rs * gg.y, v[k][i].z * rs * gg.z, v[k][i].w * rs * gg.w);
                    uint2 o; o.x = pk_bf16(w.x, w.y); o.y = pk_bf16(w.z, w.w);
                    *(uint2*)(out + (size_t)r * DM + (size_t)(lane + 64 * i) * 4) = o;
                    if (out8) *(unsigned*)(out8 + (size_t)r * DM + (size_t)(lane + 64 * i) * 4) = pack4_fp8(w, H8_SCALE);
                }
            }
        }
    }
}

template <int OUTMODE>
__device__ __forceinline__ void ph_sgemm(const bf16_t* __restrict__ A, int lda, const float* __restrict__ B, int ldb, void* Cv, int ldc, const float* R, int ldr,
                         int M, int N, int K, float* smem) {
    float* As = smem;
    float* Bs = smem + 16 * 132;
    const int tid = tid_(), tx = tid & 31, ty = tid >> 5;
    const int ntn = N / 128, ntiles = (M / 128) * ntn;
    for (int tile = bid_(); tile < ntiles; tile += nblk_()) {
        const int tm = tile / ntn, tn = tile % ntn;
        float acc[8][4];
#pragma unroll
        for (int i = 0; i < 8; ++i)
#pragma unroll
            for (int j = 0; j < 4; ++j) acc[i][j] = 0.f;
        const int arow = tid >> 2, akq = (tid & 3) * 4;
        const int bk = tid >> 5, bn = (tid & 31) * 4;
        for (int k0 = 0; k0 < K; k0 += 16) {
            const ushort4 av = *(const ushort4*)(A + (size_t)(tm * 128 + arow) * lda + k0 + akq);
            const float4 bv = *(const float4*)(B + (size_t)(k0 + bk) * ldb + tn * 128 + bn);
            __syncthreads();
            As[(akq + 0) * 132 + arow] = bf2f(av.x); As[(akq + 1) * 132 + arow] = bf2f(av.y);
            As[(akq + 2) * 132 + arow] = bf2f(av.z); As[(akq + 3) * 132 + arow] = bf2f(av.w);
            *(float4*)(Bs + bk * 132 + bn) = bv;
            __syncthreads();
#pragma unroll
            for (int k = 0; k < 16; ++k) {
                const float4 a0 = *(const float4*)(As + k * 132 + ty * 8), a1 = *(const float4*)(As + k * 132 + ty * 8 + 4);
                const float4 b = *(const float4*)(Bs + k * 132 + tx * 4);
                const float a[8] = {a0.x, a0.y, a0.z, a0.w, a1.x, a1.y, a1.z, a1.w};
#pragma unroll
                for (int i = 0; i < 8; ++i) { acc[i][0] += a[i] * b.x; acc[i][1] += a[i] * b.y; acc[i][2] += a[i] * b.z; acc[i][3] += a[i] * b.w; }
            }
        }
#pragma unroll
        for (int i = 0; i < 8; ++i) {
            const size_t row = (size_t)tm * 128 + ty * 8 + i; const int col = tn * 128 + tx * 4;
            if (OUTMODE == 0) {
                ushort4 o; o.x = f2bf(acc[i][0]); o.y = f2bf(acc[i][1]); o.z = f2bf(acc[i][2]); o.w = f2bf(acc[i][3]);
                *(ushort4*)((bf16_t*)Cv + row * ldc + col) = o;
            } else if (OUTMODE == 1) {
                *(float4*)((float*)Cv + row * ldc + col) = make_float4(acc[i][0], acc[i][1], acc[i][2], acc[i][3]);
            } else {
                const float4 r = *(const float4*)(R + row * ldr + col);
                *(float4*)((float*)Cv + row * ldc + col) = make_float4(r.x + acc[i][0], r.y + acc[i][1], r.z + acc[i][2], r.w + acc[i][3]);
            }
        }
    }
}

#define WS_HS WS_H
#define WS_VG WS_YPRE
#define WS_DEC (WS_YPRE + (size_t)MTOK * 256 * 2)

__device__ __forceinline__ float quad_sum(float v) {
    v += __int_as_float(__builtin_amdgcn_mov_dpp(__float_as_int(v), 0xB1, 0xF, 0xF, true));
    v += __int_as_float(__builtin_amdgcn_mov_dpp(__float_as_int(v), 0x4E, 0xF, 0xF, true));
    return v;
}
__device__ __forceinline__ float bflo(unsigned w) { return __uint_as_float(w << 16); }
__device__ __forceinline__ float bfhi(unsigned w) { return __uint_as_float(w & 0xffff0000u); }

__device__ __forceinline__ float oct_sum(float v) {
    v += __int_as_float(__builtin_amdgcn_mov_dpp(__float_as_int(v), 0xB1, 0xF, 0xF, true));
    v += __int_as_float(__builtin_amdgcn_mov_dpp(__float_as_int(v), 0x4E, 0xF, 0xF, true));
    v += __int_as_float(__builtin_amdgcn_mov_dpp(__float_as_int(v), 0x141, 0xF, 0xF, true));
    return v;
}
__device__ __forceinline__ void unpack8(const uint4 r, float (&o)[8]) {
    o[0] = bflo(r.x); o[1] = bfhi(r.x); o[2] = bflo(r.y); o[3] = bfhi(r.y); o[4] = bflo(r.z); o[5] = bfhi(r.z); o[6] = bflo(r.w); o[7] = bfhi(r.w);
}
__device__ __forceinline__ uint4 pack8(const float (&v)[8]) {
    uint4 o; o.x = pk_bf16(v[0], v[1]); o.y = pk_bf16(v[2], v[3]); o.z = pk_bf16(v[4], v[5]); o.w = pk_bf16(v[6], v[7]); return o;
}
__device__ __forceinline__ void load8f(const float* p, float (&o)[8]) {
    const float4 a = *(const float4*)p, b = *(const float4*)(p + 4);
    o[0] = a.x; o[1] = a.y; o[2] = a.z; o[3] = a.w; o[4] = b.x; o[5] = b.y; o[6] = b.z; o[7] = b.w;
}
__device__ __forceinline__ void conv8(const bf16_t* P, size_t tok, int t, int pcol, const float* w, int ldw, int cc, float (&acc)[8]) {
#pragma unroll
    for (int j = 0; j < 4; ++j) {
        if (t - 3 + j >= 0) {
            float xv[8], wv[8];
            unpack8(*(const uint4*)(P + (tok - (size_t)(3 - j)) * LDP + pcol), xv);
            load8f(w + j * ldw + cc, wv);
#pragma unroll
            for (int i = 0; i < 8; ++i) acc[i] = __builtin_fmaf(wv[i], xv[i], acc[i]);
        }
    }
}
__device__ __forceinline__ void conv8r(const uint4 (&xt)[4], int t, const float* w, int ldw, int cc, float (&acc)[8]) {
#pragma unroll
    for (int j = 0; j < 4; ++j) {
        float xv[8], wv[8];
        unpack8(xt[j], xv);
        load8f(w + j * ldw + cc, wv);
        const float m = (t - 3 + j >= 0) ? 1.f : 0.f;
#pragma unroll
        for (int i = 0; i < 8; ++i) acc[i] = __builtin_fmaf(wv[i] * m, xv[i], acc[i]);
    }
}
__device__ __forceinline__ void conv8w(const uint4 (&xt)[4], int t, const float (&wv)[4][8], float (&acc)[8]) {
#pragma unroll
    for (int j = 0; j < 4; ++j) {
        float xv[8];
        unpack8(xt[j], xv);
        const float m = (t - 3 + j >= 0) ? 1.f : 0.f;
#pragma unroll
        for (int i = 0; i < 8; ++i) acc[i] = __builtin_fmaf(wv[j][i] * m, xv[i], acc[i]);
    }
}
__device__ __forceinline__ void ph_scan_prep(const Ctx& p, int l) {
    const bf16_t* P = (const bf16_t*)(pws_() + WS_P);
    bf16_t* HS = (bf16_t*)(pws_() + WS_HS);
    bf16_t* VG = (bf16_t*)(pws_() + WS_VG);
    float* DEC = (float*)(pws_() + WS_DEC);
    float* SC = (float*)(pws_() + WS_SC);
    const float* scw = pin_(4) + (size_t)l * 4 * 512;
    const float* scb = pin_(5) + (size_t)l * 512;
    const float* gcw = pin_(10) + (size_t)l * 4 * 768;
    const float* wg = pin_(14) + (size_t)l * 16 * 128;
    const float* bg = pin_(15) + (size_t)l * 128;
    const int lane = tid_() & 63;
    const int hsc = lane & 3, wsc = (lane >> 2) & 3;
    const float k_dtb = pin_(6)[l * 4 + hsc], k_alog = __expf(pin_(7)[l * 4 + hsc]), k_galog = __expf(pin_(11)[l * 4 + hsc]), k_gdtb = pin_(12)[l * 4 + hsc];
    const int sccol = wsc < 2 ? PC_DT + hsc : (wsc == 2 ? PC_GA + hsc : PC_GB + hsc);
    const int nw = nwaves();
    {
        uint4 nxa[4], ngl0, ngl1; unsigned short nsc;
#define SP_LOAD(tk) do { const int t_ = (tk) % SEQ; const size_t row_ = (size_t)(tk) * LDP; \
        _Pragma("unroll") for (int j = 0; j < 4; ++j) { const size_t rj = (t_ - 3 + j >= 0) ? row_ - (size_t)(3 - j) * LDP : row_; nxa[j] = *(const uint4*)(P + rj + PC_XBC + 8 * lane); } \
        ngl0 = *(const uint4*)(P + row_ + PC_GLR); ngl1 = *(const uint4*)(P + row_ + PC_GLR + 8); nsc = P[row_ + sccol]; } while (0)
        float wsx[4][8], bsx[8], wgl[2][16], bgl[2];
#pragma unroll
        for (int j = 0; j < 4; ++j) load8f(scw + j * 512 + 8 * lane, wsx[j]);
        load8f(scb + 8 * lane, bsx);
#pragma unroll
        for (int i = 0; i < 2; ++i) { bgl[i] = bg[lane + 64 * i];
#pragma unroll
            for (int r = 0; r < 16; ++r) wgl[i][r] = wg[r * 128 + lane + 64 * i]; }
        int tok = gwave();
        SP_LOAD(tok);
        for (; tok < MTOK; tok += nw) {
            const int t = tok % SEQ;
            uint4 xa[4];
#pragma unroll
            for (int j = 0; j < 4; ++j) xa[j] = nxa[j];
            const uint4 gl0 = ngl0, gl1 = ngl1;
            const float scraw = bf2f(nsc);
            { const int tn = tok + nw < MTOK ? tok + nw : tok; SP_LOAD(tn); }
            __builtin_amdgcn_sched_barrier(0);
            {
                float acc[8];
#pragma unroll
                for (int i = 0; i < 8; ++i) acc[i] = bsx[i];
                conv8w(xa, t, wsx, acc);
#pragma unroll
                for (int i = 0; i < 8; ++i) acc[i] = silu_f(acc[i]);
                *(uint4*)(HS + (size_t)tok * 1024 + 8 * lane) = pack8(acc);
            }
            {
                float v;
                if (wsc < 2) { const float dt = softplus_f(scraw + k_dtb); v = wsc == 0 ? dt : __expf(-dt * k_alog); }
                else if (wsc == 2) v = __expf(-k_galog * softplus_f(scraw + k_gdtb));
                else v = sigmoid_f(scraw);
                if (lane < 16) SC[(size_t)tok * 16 + lane] = v;
            }
            {
                float gl[16];
                { float a8[8], b8[8]; unpack8(gl0, a8); unpack8(gl1, b8);
#pragma unroll
                  for (int i = 0; i < 8; ++i) { gl[i] = a8[i]; gl[8 + i] = b8[i]; } }
#pragma unroll
                for (int i = 0; i < 2; ++i) {
                    const int c = lane + 64 * i;
                    float acc = bgl[i];
#pragma unroll
                    for (int r = 0; r < 16; ++r) acc = __builtin_fmaf(gl[r], wgl[i][r], acc);
                    DEC[(size_t)tok * 128 + c] = __expf(logsigmoid_f(acc) * (1.f / 16.f));
                }
            }
        }
#undef SP_LOAD
    }
    {
        uint4 nxq[4], nxv4[4];
#define SP_LOAD(tk) do { const int t_ = (tk) % SEQ; const size_t row_ = (size_t)(tk) * LDP; \
        _Pragma("unroll") for (int j = 0; j < 4; ++j) { const size_t rj = (t_ - 3 + j >= 0) ? row_ - (size_t)(3 - j) * LDP : row_; \
            nxq[j] = *(const uint4*)(P + rj + PC_GQKV + 8 * lane); nxv4[j] = *(const uint4*)(P + rj + PC_GQKV + 512 + 8 * (lane & 31)); } } while (0)
        float wq[4][8], wv[4][8];
#pragma unroll
        for (int j = 0; j < 4; ++j) { load8f(gcw + j * 768 + 8 * lane, wq[j]); load8f(gcw + j * 768 + 512 + 8 * (lane & 31), wv[j]); }
        int tok = gwave();
        SP_LOAD(tok);
        for (; tok < MTOK; tok += nw) {
            const int t = tok % SEQ;
            uint4 xq[4], xv4[4];
#pragma unroll
            for (int j = 0; j < 4; ++j) { xq[j] = nxq[j]; xv4[j] = nxv4[j]; }
            { const int tn = tok + nw < MTOK ? tok + nw : tok; SP_LOAD(tn); }
            __builtin_amdgcn_sched_barrier(0);
            {
                float acc[8];
#pragma unroll
                for (int i = 0; i < 8; ++i) acc[i] = 0.f;
                conv8w(xq, t, wq, acc);
                float ss = 0.f;
#pragma unroll
                for (int i = 0; i < 8; ++i) { acc[i] = silu_f(acc[i]); ss += acc[i] * acc[i]; }
                ss = oct_sum(ss);
                const float sc = rsqrtf(ss + EPS) * (lane < 32 ? 0.125f : 1.f);
#pragma unroll
                for (int i = 0; i < 8; ++i) acc[i] *= sc;
                *(uint4*)(HS + (size_t)tok * 1024 + 512 + 8 * lane) = pack8(acc);
            }
            {
                float acc[8];
#pragma unroll
                for (int i = 0; i < 8; ++i) acc[i] = 0.f;
                conv8w(xv4, t, wv, acc);
#pragma unroll
                for (int i = 0; i < 8; ++i) acc[i] = silu_f(acc[i]);
                if (lane < 32) *(uint4*)(VG + (size_t)tok * 256 + 8 * lane) = pack8(acc);
            }
        }
#undef SP_LOAD
    }
}

#define SCAN_LDS_WAVE 4608
typedef float f2_t __attribute__((ext_vector_type(2)));
__device__ __forceinline__ f2_t mk2(float a, float b) { f2_t r; r.x = a; r.y = b; return r; }
__device__ __forceinline__ void st8f(char* dst, const uint4 v) {
    *(float4*)dst = make_float4(bflo(v.x), bfhi(v.x), bflo(v.y), bfhi(v.y));
    *(float4*)(dst + 16) = make_float4(bflo(v.z), bfhi(v.z), bflo(v.w), bfhi(v.w));
}
__device__ __forceinline__ void ph_scans(const Ctx& p, int l, float* smem) {
    const bf16_t* P = (const bf16_t*)(pws_() + WS_P);
    const bf16_t* HS = (const bf16_t*)(pws_() + WS_HS);
    const bf16_t* VG = (const bf16_t*)(pws_() + WS_VG);
    const float* DEC = (const float*)(pws_() + WS_DEC);
    const float* SC = (const float*)(pws_() + WS_SC);
    bf16_t* Y = (bf16_t*)(pws_() + WS_Y);
    const int tid = tid_(), lane = tid & 63, wave = tid >> 6;
    if (nblk_() != 256) return;
    const int role = wave < 2 ? 0 : (wave < 6 ? 1 : 2);
    const int idx = (role == 0 ? wave : (role == 1 ? wave - 2 : wave - 6)) * 256 + bid_();
    const int bh = role == 1 ? (idx >> 3) : (idx >> 2), b = bh >> 2, h = bh & 3;
    const int colbase = role == 1 ? (idx & 7) * 8 : (idx & 3) * 16;
    const int cl = role == 1 ? (lane >> 3) : (lane >> 2);
    const int col = colbase + cl;
    const int sq = role == 1 ? (lane & 7) : (lane & 3);
    const size_t tb = (size_t)b * SEQ;
    bf16_t* dummy = (bf16_t*)(pws_() + WS_DUMMY) + (tid & 511) * 8;
    char* lw = (char*)smem + wave * SCAN_LDS_WAVE;
    char* lrow = lw;
    char* lcol = lw + 4096;
    float* lsc = (float*)(lw + 4352);
    const int fs = lane >> 3, fp = lane & 7;
    if (role == 0) {
        const int g = h >> 1;
        const float Dh = pin_(8)[l * 4 + h];
        uint4 f0, f1; unsigned fc = 0u; float fsc = 0.f;
        f2_t st[8];
#pragma unroll
        for (int i = 0; i < 8; ++i) st[i] = mk2(0.f, 0.f);
        auto fetch = [&](int t0) {
            const size_t tok = tb + t0 + fs;
            const bf16_t* src = HS + tok * 1024 + (fp < 4 ? 256 + g * 64 + fp * 16 : 384 + g * 64 + (fp - 4) * 16);
            f0 = *(const uint4*)src; f1 = *(const uint4*)(src + 8);
            fc = *(const unsigned*)(HS + tok * 1024 + h * 64 + colbase + fp * 2);
            if (lane < 16) fsc = SC[(tb + t0 + (lane >> 1)) * 16 + (lane & 1) * 4 + h];
        };
        fetch(0);
        for (int t0 = 0; t0 < SEQ; t0 += 8) {
            st8f(lrow + fs * 512 + fp * 64, f0); st8f(lrow + fs * 512 + fp * 64 + 32, f1);
            *(unsigned*)(lcol + fs * 32 + fp * 4) = fc;
            if (lane < 16) lsc[lane] = fsc;
            if (t0 + 8 < SEQ) fetch(t0 + 8);
#pragma unroll
            for (int i = 0; i < 8; ++i) {
                const char* rb = lrow + i * 512 + sq * 64;
                const float4 b0 = *(const float4*)rb, b1 = *(const float4*)(rb + 16), b2 = *(const float4*)(rb + 32), b3 = *(const float4*)(rb + 48);
                const float4 c0 = *(const float4*)(rb + 256), c1 = *(const float4*)(rb + 272), c2 = *(const float4*)(rb + 288), c3 = *(const float4*)(rb + 304);
                const float xv = bf2f(*(const bf16_t*)(lcol + i * 32 + cl * 2));
                const float2 sc2 = *(const float2*)(lsc + i * 2);
                const float xdt = xv * sc2.x;
                const f2_t xd2 = mk2(xdt, xdt), dA2 = mk2(sc2.y, sc2.y);
                const f2_t bb[8] = {mk2(b0.x, b0.y), mk2(b0.z, b0.w), mk2(b1.x, b1.y), mk2(b1.z, b1.w), mk2(b2.x, b2.y), mk2(b2.z, b2.w), mk2(b3.x, b3.y), mk2(b3.z, b3.w)};
                const f2_t cc[8] = {mk2(c0.x, c0.y), mk2(c0.z, c0.w), mk2(c1.x, c1.y), mk2(c1.z, c1.w), mk2(c2.x, c2.y), mk2(c2.z, c2.w), mk2(c3.x, c3.y), mk2(c3.z, c3.w)};
                f2_t ya = mk2(0.f, 0.f), yb = mk2(0.f, 0.f);
#pragma unroll
                for (int q = 0; q < 8; q += 2) {
                    st[q] = st[q] * dA2 + xd2 * bb[q]; st[q + 1] = st[q + 1] * dA2 + xd2 * bb[q + 1];
                    ya = cc[q] * st[q] + ya; yb = cc[q + 1] * st[q + 1] + yb;
                }
                const f2_t ys = ya + yb;
                const float y = quad_sum(ys.x + ys.y);
                *(sq == 0 ? Y + (tb + t0 + i) * DM + h * 64 + col : dummy + i) = f2bf(y + Dh * xv);
                if (i & 1) __builtin_amdgcn_sched_barrier(0);
            }
        }
    } else if (role == 1) {
        uint4 f0, f1; unsigned fc = 0u; float fsc = 0.f;
        f2_t S[4];
#pragma unroll
        for (int i = 0; i < 4; ++i) S[i] = mk2(0.f, 0.f);
        auto fetch = [&](int t0) {
            const size_t tok = tb + t0 + fs;
            const bf16_t* src = HS + tok * 1024 + (fp < 4 ? 512 + h * 64 + fp * 16 : 768 + h * 64 + (fp - 4) * 16);
            f0 = *(const uint4*)src; f1 = *(const uint4*)(src + 8);
            if (fp < 4) fc = *(const unsigned*)(VG + tok * 256 + h * 64 + colbase + fp * 2);
            if (lane < 16) fsc = SC[(tb + t0 + (lane >> 1)) * 16 + 8 + (lane & 1) * 4 + h];
        };
        fetch(0);
        for (int t0 = 0; t0 < SEQ; t0 += 8) {
            st8f(lrow + fs * 512 + fp * 64, f0); st8f(lrow + fs * 512 + fp * 64 + 32, f1);
            if (fp < 4) *(unsigned*)(lcol + fs * 32 + fp * 4) = fc;
            if (lane < 16) lsc[lane] = fsc;
            if (t0 + 8 < SEQ) fetch(t0 + 8);
#pragma unroll
            for (int i = 0; i < 8; ++i) {
                const char* rb = lrow + i * 512 + sq * 32;
                const float4 q0 = *(const float4*)rb, q1 = *(const float4*)(rb + 16);
                const float4 k0 = *(const float4*)(rb + 256), k1 = *(const float4*)(rb + 272);
                const float vv = bf2f(*(const bf16_t*)(lcol + i * 32 + cl * 2));
                const float2 sc2 = *(const float2*)(lsc + i * 2);
                const f2_t al2 = mk2(sc2.x, sc2.x);
                const f2_t kk[4] = {mk2(k0.x, k0.y), mk2(k0.z, k0.w), mk2(k1.x, k1.y), mk2(k1.z, k1.w)};
                const f2_t qq[4] = {mk2(q0.x, q0.y), mk2(q0.z, q0.w), mk2(q1.x, q1.y), mk2(q1.z, q1.w)};
                f2_t ra = mk2(0.f, 0.f), rb2 = mk2(0.f, 0.f);
#pragma unroll
                for (int q = 0; q < 4; q += 2) {
                    S[q] = S[q] * al2; S[q + 1] = S[q + 1] * al2;
                    ra = S[q] * kk[q] + ra; rb2 = S[q + 1] * kk[q + 1] + rb2;
                }
                const f2_t rs = ra + rb2;
                const float r = oct_sum(rs.x + rs.y);
                const float vn = sc2.y * (vv - r);
                const f2_t vn2 = mk2(vn, vn);
                f2_t oa2 = mk2(0.f, 0.f), ob2 = mk2(0.f, 0.f);
#pragma unroll
                for (int q = 0; q < 4; q += 2) {
                    S[q] = kk[q] * vn2 + S[q]; S[q + 1] = kk[q + 1] * vn2 + S[q + 1];
                    oa2 = S[q] * qq[q] + oa2; ob2 = S[q + 1] * qq[q + 1] + ob2;
                }
                const f2_t os = oa2 + ob2;
                const float ov = oct_sum(os.x + os.y);
                *(sq == 0 ? Y + (tb + t0 + i) * DM + 256 + h * 64 + col : dummy + i) = f2bf(ov);
                if (i & 1) __builtin_amdgcn_sched_barrier(0);
            }
        }
    } else {
        uint4 f0, f1; unsigned fc = 0u;
        f2_t S[4];
#pragma unroll
        for (int i = 0; i < 4; ++i) S[i] = mk2(0.f, 0.f);
        auto fetch = [&](int t0) {
            const size_t tok = tb + t0 + fs;
            if (fp < 4) { const float* src = DEC + tok * 128 + h * 32 + fp * 8; f0 = *(const uint4*)src; f1 = *(const uint4*)(src + 4); }
            else { const bf16_t* src = P + tok * LDP + (fp < 6 ? PC_LK + h * 32 + (fp - 4) * 16 : PC_LQ + h * 32 + (fp - 6) * 16); f0 = *(const uint4*)src; f1 = *(const uint4*)(src + 8); }
            fc = *(const unsigned*)(P + tok * LDP + PC_LV + h * 64 + colbase + fp * 2);
        };
        fetch(0);
        for (int t0 = 0; t0 < SEQ; t0 += 8) {
            if (fp < 4) { *(uint4*)(lrow + fs * 512 + fp * 32) = f0; *(uint4*)(lrow + fs * 512 + fp * 32 + 16) = f1; }
            else { st8f(lrow + fs * 512 + 128 + (fp - 4) * 64, f0); st8f(lrow + fs * 512 + 128 + (fp - 4) * 64 + 32, f1); }
            *(unsigned*)(lcol + fs * 32 + fp * 4) = fc;
            if (t0 + 8 < SEQ) fetch(t0 + 8);
#pragma unroll
            for (int i = 0; i < 8; ++i) {
                const char* rb = lrow + i * 512 + sq * 32;
                const float4 d0 = *(const float4*)rb, d1 = *(const float4*)(rb + 16);
                const float4 k0 = *(const float4*)(rb + 128), k1 = *(const float4*)(rb + 144);
                const float4 q0 = *(const float4*)(rb + 256), q1 = *(const float4*)(rb + 272);
                const float vv = bf2f(*(const bf16_t*)(lcol + i * 32 + cl * 2));
                const f2_t v2 = mk2(vv, vv);
                const f2_t dd[4] = {mk2(d0.x, d0.y), mk2(d0.z, d0.w), mk2(d1.x, d1.y), mk2(d1.z, d1.w)};
                const f2_t kk[4] = {mk2(k0.x, k0.y), mk2(k0.z, k0.w), mk2(k1.x, k1.y), mk2(k1.z, k1.w)};
                const f2_t qq[4] = {mk2(q0.x, q0.y), mk2(q0.z, q0.w), mk2(q1.x, q1.y), mk2(q1.z, q1.w)};
                f2_t oa2 = mk2(0.f, 0.f), ob2 = mk2(0.f, 0.f);
#pragma unroll
                for (int q = 0; q < 4; q += 2) {
                    S[q] = dd[q] * S[q] + kk[q] * v2; S[q + 1] = dd[q + 1] * S[q + 1] + kk[q + 1] * v2;
                    oa2 = S[q] * qq[q] + oa2; ob2 = S[q + 1] * qq[q + 1] + ob2;
                }
                const f2_t os = oa2 + ob2;
                const float ov = quad_sum(os.x + os.y);
                *(sq == 0 ? Y + (tb + t0 + i) * DM + 512 + h * 64 + col : dummy + i) = f2bf(ov * 0.17677669529663687f);
                if (i & 1) __builtin_amdgcn_sched_barrier(0);
            }
        }
    }
}

__device__ __forceinline__ void ph_mixer_finish(const Ctx& p, int l) {
    const bf16_t* P = (const bf16_t*)(pws_() + WS_P);
    bf16_t* Y = (bf16_t*)(pws_() + WS_Y);
    const float* sn = pin_(9) + (size_t)l * 256;
    const float* gn = pin_(13) + (size_t)l * 64;
    const float* ln = pin_(16) + (size_t)l * 64;
    const int lane = tid_() & 63;
    float gw1[8], gw2[8];
    load8f(lane < 32 ? sn + 8 * lane : gn + 8 * (lane & 7), gw1);
    load8f(ln + 8 * (lane & 7), gw2);
    const int nw = nwaves();
    int tok = gwave();
    uint4 nya, nga, nyb, ngb;
#define MF_LOAD(tk) do { const size_t row_ = (size_t)(tk) * LDP; \
        nya = *(const uint4*)(Y + (size_t)(tk) * DM + 8 * lane); \
        nga = *(const uint4*)(P + row_ + (lane < 32 ? PC_Z + 8 * lane : PC_GG + 8 * (lane - 32))); \
        nyb = *(const uint4*)(Y + (size_t)(tk) * DM + 512 + 8 * (lane & 31)); \
        ngb = *(const uint4*)(P + row_ + PC_LR + 8 * (lane & 31)); } while (0)
    MF_LOAD(tok);
    for (; tok < MTOK; tok += nw) {
        const uint4 ya = nya, ga = nga, yb = nyb, gb = ngb;
        { const int tn = tok + nw < MTOK ? tok + nw : tok; MF_LOAD(tn); }
        __builtin_amdgcn_sched_barrier(0);
        {
            float v[8], gt[8];
            unpack8(ya, v);
            unpack8(ga, gt);
            float ss = 0.f;
            if (lane < 32) {
#pragma unroll
                for (int i = 0; i < 8; ++i) { v[i] *= silu_f(gt[i]); ss += v[i] * v[i]; }
            } else {
#pragma unroll
                for (int i = 0; i < 8; ++i) ss += v[i] * v[i];
            }
            const float s8 = oct_sum(ss);
            float s32 = s8 + __int_as_float(__builtin_amdgcn_mov_dpp(__float_as_int(s8), 0x140, 0xF, 0xF, true));
            s32 += __shfl_xor(s32, 16, 64);
            const float rs = lane < 32 ? rsqrtf(s32 * (1.f / 256.f) + EPS) : rsqrtf(s8 * (1.f / 64.f) + EPS);
            float o[8];
#pragma unroll
            for (int i = 0; i < 8; ++i) o[i] = lane < 32 ? v[i] * rs * gw1[i] : v[i] * rs * gw1[i] * silu_f(gt[i]);
            *(uint4*)(Y + (size_t)tok * DM + 8 * lane) = pack8(o);
        }
        if (lane < 32) {
            float v[8], gt[8];
            unpack8(yb, v);
            unpack8(gb, gt);
            float ss = 0.f;
#pragma unroll
            for (int i = 0; i < 8; ++i) ss += v[i] * v[i];
            const float rs = rsqrtf(oct_sum(ss) * (1.f / 64.f) + EPS);
            float o[8];
#pragma unroll
            for (int i = 0; i < 8; ++i) o[i] = v[i] * rs * gw2[i] * silu_f(gt[i]);
            *(uint4*)(Y + (size_t)tok * DM + 512 + 8 * lane) = pack8(o);
        }
    }
#undef MF_LOAD
}

typedef short bf16x8_t __attribute__((ext_vector_type(8)));
typedef float f32x4_t __attribute__((ext_vector_type(4)));
union BF8 { bf16x8_t v; uint4 u; unsigned w[4]; };


__device__ __forceinline__ void ph_dsa_prep(const Ctx& p, int l) {
    const bf16_t* P = (const bf16_t*)(pws_() + WS_P);
    bf16_t* qn = (bf16_t*)(pws_() + WS_QN);
    bf16_t* kn = (bf16_t*)(pws_() + WS_KN);
    bf16_t* ikn = (bf16_t*)(pws_() + WS_IKN);
    bf16_t* vt = (bf16_t*)(pws_() + WS_VT);
    const float* qg = pin_(17) + (size_t)l * 64;
    const float* kg = pin_(18) + (size_t)l * 64;
    const float* ig = pin_(19) + (size_t)l * 32;
    const int lane = tid_() & 63;
    const int pcol = lane < 40 ? PC_DQ + 8 * lane : PC_IK + 8 * (lane & 3);
    float gw[8];
    load8f(lane < 32 ? qg + 8 * (lane & 7) : (lane < 40 ? kg + 8 * (lane & 7) : ig + 8 * (lane & 3)), gw);
    for (int grp = gwave(); grp < MTOK / 8; grp += nwaves()) {
        const size_t tok0 = (size_t)grp * 8;
        const int b = (int)(tok0 / SEQ), t0 = (int)(tok0 % SEQ);
        unsigned short vv[8];
#pragma unroll
        for (int i = 0; i < 8; ++i) {
            const size_t row = (tok0 + i) * LDP;
            vv[i] = P[row + PC_DV + lane];
            if (lane < 44) {
                float v[8];
                unpack8(*(const uint4*)(P + row + pcol), v);
                float ss = 0.f;
#pragma unroll
                for (int q = 0; q < 8; ++q) ss += v[q] * v[q];
                const float s4 = ss + __int_as_float(__builtin_amdgcn_mov_dpp(__float_as_int(ss), 0xB1, 0xF, 0xF, true));
                const float s4b = s4 + __int_as_float(__builtin_amdgcn_mov_dpp(__float_as_int(s4), 0x4E, 0xF, 0xF, true));
                const float s8 = s4b + __int_as_float(__builtin_amdgcn_mov_dpp(__float_as_int(s4b), 0x141, 0xF, 0xF, true));
                const float rs = lane < 40 ? rsqrtf(s8 * (1.f / 64.f) + EPS) * (lane < 32 ? 0.125f : 1.f) : rsqrtf(s4b * (1.f / 32.f) + EPS);
                float o[8];
#pragma unroll
                for (int q = 0; q < 8; ++q) o[q] = v[q] * rs * gw[q];
                const uint4 pk = pack8(o);
                if (lane < 32) *(uint4*)(qn + (tok0 + i) * 256 + 8 * lane) = pk;
                else if (lane < 40) *(uint4*)(kn + (tok0 + i) * 64 + 8 * (lane - 32)) = pk;
                else *(uint4*)(ikn + (tok0 + i) * 32 + 8 * (lane - 40)) = pk;
            }
        }
        uint4 o; o.x = (unsigned)vv[0] | ((unsigned)vv[1] << 16); o.y = (unsigned)vv[2] | ((unsigned)vv[3] << 16);
        o.z = (unsigned)vv[4] | ((unsigned)vv[5] << 16); o.w = (unsigned)vv[6] | ((unsigned)vv[7] << 16);
        *(uint4*)(vt + ((size_t)b * 64 + lane) * SEQ + t0) = o;
    }
}

#define DSA_STRIDE 2052
__device__ __forceinline__ int wave_total_i(int v) {
    v += __builtin_amdgcn_update_dpp(0, v, 0x111, 0xf, 0xf, true);
    v += __builtin_amdgcn_update_dpp(0, v, 0x112, 0xf, 0xf, true);
    v += __builtin_amdgcn_update_dpp(0, v, 0x114, 0xf, 0xf, true);
    v += __builtin_amdgcn_update_dpp(0, v, 0x118, 0xf, 0xf, true);
    return __builtin_amdgcn_readlane(v, 15) + __builtin_amdgcn_readlane(v, 31) + __builtin_amdgcn_readlane(v, 47) + __builtin_amdgcn_readlane(v, 63);
}
template <int NJ>
__device__ __forceinline__ void dsa_select(const unsigned* scq, int nj, int lane, unsigned& T_out, int& cut_out) {
    unsigned kreg[NJ];
#pragma unroll
    for (int j = 0; j < NJ; ++j) kreg[j] = (j < nj) ? scq[j * 64 + lane] : 0u;
    unsigned T = 0u; bool exact = false;
    for (int bit = 31; bit >= 0; --bit) {
        const unsigned cand = T | (1u << bit);
        int c = 0;
#pragma unroll
        for (int j = 0; j < NJ; ++j) c += (kreg[j] >= cand) ? 1 : 0;
        const int cnt = wave_total_i(c);
        if (cnt >= 256) { T = cand; if (cnt == 256) { exact = true; break; } }
    }
    int cut = 0x7fffffff;
    if (!exact) {
        int cgt = 0, ceq = 0;
#pragma unroll
        for (int j = 0; j < NJ; ++j) { cgt += __popcll(__ballot(kreg[j] > T)); ceq += __popcll(__ballot(kreg[j] == T)); }
        int need = 256 - cgt;
        if (ceq > need) {
            bool found = false;
#pragma unroll
            for (int j = 0; j < NJ; ++j) {
                const unsigned long long m = __ballot(kreg[j] == T);
                const int cj = __popcll(m);
                if (!found) {
                    if (need <= cj) { for (int bpos = 0; bpos < 64; ++bpos) if ((m >> bpos) & 1ull) { if (--need == 0) { cut = j * 64 + bpos; break; } } found = true; }
                    else need -= cj;
                }
            }
        }
    }
    T_out = T; cut_out = cut;
}
__device__ __forceinline__ void ph_dsa_main(const Ctx& p, int l, float* smem) {
    const bf16_t* P = (const bf16_t*)(pws_() + WS_P);
    bf16_t* Y = (bf16_t*)(pws_() + WS_Y);
    const bf16_t* QN = (const bf16_t*)(pws_() + WS_QN);
    const bf16_t* KN = (const bf16_t*)(pws_() + WS_KN);
    const bf16_t* IKN = (const bf16_t*)(pws_() + WS_IKN);
    const bf16_t* VT = (const bf16_t*)(pws_() + WS_VT);
    unsigned* sc = (unsigned*)smem;
    float* part = smem;
    float* plsum = smem + 8 * 64 * 64;
    unsigned* thr = (unsigned*)(smem + 35000);
    for (int task = bid_(); task < MTOK / 16; task += nblk_()) {
        const int tid = tid_(), lane = tid & 63, w = tid >> 6, qi = lane & 15, g = lane >> 4;
        const int c = 31 - task / 128, b = (task >> 2) & 31, sub = task & 3;
        const int t0 = c * 64 + sub * 16, nk = (c + 1) * 64;
        const size_t tok0 = (size_t)b * SEQ + t0;
        const bool dosel = nk > 256;
        if (dosel) {
            BF8 iqf[8]; float wq[8];
#pragma unroll
            for (int h = 0; h < 8; ++h) {
                iqf[h].u = *(const uint4*)(P + (tok0 + qi) * LDP + PC_IQ + h * 32 + 8 * g);
                wq[h] = bf2f(P[(tok0 + qi) * LDP + PC_IW + h]) * 0.0625f;
            }
            BF8 kan; kan.u = *(const uint4*)(IKN + ((size_t)b * SEQ + w * 16 + qi) * 32 + 8 * g);
            for (int kt = w; kt < nk / 16; kt += 8) {
                const int s0 = kt * 16;
                BF8 ka = kan;
                { const int ktn = kt + 8 < nk / 16 ? kt + 8 : kt; kan.u = *(const uint4*)(IKN + ((size_t)b * SEQ + ktn * 16 + qi) * 32 + 8 * g); }
                float acc[4] = {0.f, 0.f, 0.f, 0.f};
#pragma unroll
                for (int h = 0; h < 8; ++h) {
                    const f32x4_t d = __builtin_amdgcn_mfma_f32_16x16x32_bf16(ka.v, iqf[h].v, (f32x4_t){0.f, 0.f, 0.f, 0.f}, 0, 0, 0);
#pragma unroll
                    for (int r = 0; r < 4; ++r) acc[r] = __builtin_fmaf(wq[h], fmaxf(d[r], 0.f), acc[r]);
                }
                uint4 kv; kv.x = ford(acc[0]); kv.y = ford(acc[1]); kv.z = ford(acc[2]); kv.w = ford(acc[3]);
                *(uint4*)(sc + qi * DSA_STRIDE + s0 + 4 * g) = kv;
            }
        }
        __syncthreads();
        if (dosel) {
            const int nj = nk >> 6;
#pragma unroll 1
            for (int qq = 0; qq < 2; ++qq) {
                const int q = 2 * w + qq;
                unsigned T; int cut;
                if (nj <= 8) dsa_select<8>(sc + q * DSA_STRIDE, nj, lane, T, cut);
                else if (nj <= 16) dsa_select<16>(sc + q * DSA_STRIDE, nj, lane, T, cut);
                else if (nj <= 24) dsa_select<24>(sc + q * DSA_STRIDE, nj, lane, T, cut);
                else dsa_select<32>(sc + q * DSA_STRIDE, nj, lane, T, cut);
                if (lane == 0) { thr[q] = T; thr[16 + q] = (unsigned)cut; }
            }
        }
        __syncthreads();
        unsigned Tq = 0u; int cutq = 0x7fffffff;
        if (dosel) { Tq = thr[qi]; cutq = (int)thr[16 + qi]; }
        f32x4_t oacc[4][4]; float lsum[4];
#pragma unroll
        for (int h = 0; h < 4; ++h) { lsum[h] = 0.f;
#pragma unroll
            for (int dt = 0; dt < 4; ++dt) oacc[h][dt] = (f32x4_t){0.f, 0.f, 0.f, 0.f}; }
        const int krow = 8 * (qi >> 2) + (qi & 3);
        BF8 kan[2][2], van[4];
#define DSA_KV(st_) do { const int s0_ = (st_) * 32; \
            _Pragma("unroll") for (int t = 0; t < 2; ++t) _Pragma("unroll") for (int s2 = 0; s2 < 2; ++s2) kan[t][s2].u = *(const uint4*)(KN + ((size_t)b * SEQ + s0_ + krow + 4 * t) * 64 + 32 * s2 + 8 * g); \
            _Pragma("unroll") for (int dt = 0; dt < 4; ++dt) van[dt].u = *(const uint4*)(VT + ((size_t)b * 64 + 16 * dt + qi) * SEQ + s0_ + 8 * g); } while (0)
        if (w < nk / 32) DSA_KV(w);
        for (int st = w; st < nk / 32; st += 8) {
            const int s0 = st * 32;
            BF8 ka[2][2], va[4];
#pragma unroll
            for (int t = 0; t < 2; ++t)
#pragma unroll
                for (int s2 = 0; s2 < 2; ++s2) ka[t][s2] = kan[t][s2];
#pragma unroll
            for (int dt = 0; dt < 4; ++dt) va[dt] = van[dt];
            { const int stn = st + 8 < nk / 32 ? st + 8 : st; DSA_KV(stn); }
            float mk[8];
            if (dosel) {
                const uint4 k0 = *(const uint4*)(sc + qi * DSA_STRIDE + s0 + 8 * g), k1 = *(const uint4*)(sc + qi * DSA_STRIDE + s0 + 8 * g + 4);
                const unsigned kk[8] = {k0.x, k0.y, k0.z, k0.w, k1.x, k1.y, k1.z, k1.w};
#pragma unroll
                for (int j = 0; j < 8; ++j) mk[j] = (kk[j] > Tq || (kk[j] == Tq && (s0 + 8 * g + j) <= cutq)) ? 1.f : 0.f;
            } else {
#pragma unroll
                for (int j = 0; j < 8; ++j) mk[j] = 1.f;
            }
#pragma unroll
            for (int h = 0; h < 4; ++h) {
                BF8 q0, q1;
                q0.u = *(const uint4*)(QN + (tok0 + qi) * 256 + h * 64 + 8 * g);
                q1.u = *(const uint4*)(QN + (tok0 + qi) * 256 + h * 64 + 32 + 8 * g);
                f32x4_t sacc[2];
#pragma unroll
                for (int t = 0; t < 2; ++t) {
                    sacc[t] = __builtin_amdgcn_mfma_f32_16x16x32_bf16(ka[t][0].v, q0.v, (f32x4_t){0.f, 0.f, 0.f, 0.f}, 0, 0, 0);
                    sacc[t] = __builtin_amdgcn_mfma_f32_16x16x32_bf16(ka[t][1].v, q1.v, sacc[t], 0, 0, 0);
                }
                float pe[8];
#pragma unroll
                for (int t = 0; t < 2; ++t)
#pragma unroll
                    for (int r = 0; r < 4; ++r) { pe[4 * t + r] = __expf(sacc[t][r]) * mk[4 * t + r]; lsum[h] += pe[4 * t + r]; }
                BF8 pf;
#pragma unroll
                for (int j = 0; j < 4; ++j) pf.w[j] = pk_bf16(pe[2 * j], pe[2 * j + 1]);
#pragma unroll
                for (int dt = 0; dt < 4; ++dt) oacc[h][dt] = __builtin_amdgcn_mfma_f32_16x16x32_bf16(va[dt].v, pf.v, oacc[h][dt], 0, 0, 0);
            }
        }
#undef DSA_KV
        __syncthreads();
#pragma unroll
        for (int h = 0; h < 4; ++h) {
            plsum[(w * 4 + h) * 64 + lane] = lsum[h];
#pragma unroll
            for (int dt = 0; dt < 4; ++dt)
#pragma unroll
                for (int r = 0; r < 4; ++r) part[(w * 64 + h * 16 + dt * 4 + r) * 64 + lane] = oacc[h][dt][r];
        }
        __syncthreads();
        {
            const int h = w >> 1;
            float lq = 0.f;
#pragma unroll
            for (int w2 = 0; w2 < 8; ++w2)
#pragma unroll
                for (int g2 = 0; g2 < 4; ++g2) lq += plsum[(w2 * 4 + h) * 64 + qi + 16 * g2];
            const float inv = 1.f / lq;
#pragma unroll
            for (int dd = 0; dd < 2; ++dd) {
                const int dt = (w & 1) * 2 + dd;
                float o[4];
#pragma unroll
                for (int r = 0; r < 4; ++r) {
                    float sacc = 0.f;
#pragma unroll
                    for (int w2 = 0; w2 < 8; ++w2) sacc += part[(w2 * 64 + h * 16 + dt * 4 + r) * 64 + lane];
                    o[r] = sacc * inv;
                }
                uint2 ov; ov.x = pk_bf16(o[0], o[1]); ov.y = pk_bf16(o[2], o[3]);
                *(uint2*)(Y + (tok0 + qi) * DM + 768 + h * 64 + 16 * dt + 4 * g) = ov;
            }
        }
        __syncthreads();
    }
}

__device__ __forceinline__ void ph_mem_prep(const Ctx& p, int l) {
    const float* Km = (const float*)(pws_() + WS_KM);
    const float* Vm = (const float*)(pws_() + WS_VM);
    bf16_t* KB = (bf16_t*)(pws_() + WS_KB);
    bf16_t* VTB = (bf16_t*)(pws_() + WS_VTB);
    const float* kg = pin_(28) + (size_t)l * 64;
    const int lane = tid_() & 63;
    for (int r = gwave(); r < MMEM; r += nwaves()) {
        const int b = r / NMEM, j = r % NMEM;
#pragma unroll
        for (int h = 0; h < 4; ++h) {
            const float v = Km[(size_t)r * 256 + h * 64 + lane];
            const float ss = wave_sum(v * v);
            KB[(((size_t)b * 4 + h) * NMEM + j) * 64 + lane] = f2bf(v * rsqrtf(ss * (1.f / 64.f) + EPS) * kg[lane]);
            VTB[(((size_t)b * 4 + h) * 64 + lane) * NMEM + j] = f2bf(Vm[(size_t)r * 256 + h * 64 + lane]);
        }
    }
}
__device__ __forceinline__ void ph_xattn(const Ctx& p, int l, int task0 = 0, int ntask = MTOK / 16, int w0 = -1, int wstep = 0) {
    const float* Qx = (const float*)(pws_() + WS_QX);
    bf16_t* Ox = (bf16_t*)(pws_() + WS_OX);
    const bf16_t* KB = (const bf16_t*)(pws_() + WS_KB);
    const bf16_t* VTB = (const bf16_t*)(pws_() + WS_VTB);
    const float* qg = pin_(27) + (size_t)l * 64;
    const int lane = tid_() & 63, qi = lane & 15, g = lane >> 4;
    if (w0 < 0) { w0 = gwave(); wstep = nwaves(); }
    for (int task = task0 + w0; task < task0 + ntask; task += wstep) {
        const int tok0 = task * 16, b = tok0 / SEQ;
#pragma unroll 1
        for (int h = 0; h < 4; ++h) {
            BF8 qf[2];
            {
                float qv[2][8]; float ss = 0.f;
#pragma unroll
                for (int s2 = 0; s2 < 2; ++s2) {
                    const float4* qp = (const float4*)(Qx + (size_t)(tok0 + qi) * 256 + h * 64 + 32 * s2 + 8 * g);
                    const float4 a = qp[0], c = qp[1];
                    qv[s2][0] = a.x; qv[s2][1] = a.y; qv[s2][2] = a.z; qv[s2][3] = a.w; qv[s2][4] = c.x; qv[s2][5] = c.y; qv[s2][6] = c.z; qv[s2][7] = c.w;
#pragma unroll
                    for (int j = 0; j < 8; ++j) ss += qv[s2][j] * qv[s2][j];
                }
                ss += __shfl_xor(ss, 16, 64); ss += __shfl_xor(ss, 32, 64);
                const float rs = rsqrtf(ss * (1.f / 64.f) + EPS) * 0.125f;
#pragma unroll
                for (int s2 = 0; s2 < 2; ++s2) {
                    const float4 g0 = *(const float4*)(qg + 32 * s2 + 8 * g), g1 = *(const float4*)(qg + 32 * s2 + 8 * g + 4);
                    qf[s2].w[0] = pk_bf16(qv[s2][0] * rs * g0.x, qv[s2][1] * rs * g0.y); qf[s2].w[1] = pk_bf16(qv[s2][2] * rs * g0.z, qv[s2][3] * rs * g0.w);
                    qf[s2].w[2] = pk_bf16(qv[s2][4] * rs * g1.x, qv[s2][5] * rs * g1.y); qf[s2].w[3] = pk_bf16(qv[s2][6] * rs * g1.z, qv[s2][7] * rs * g1.w);
                }
            }
            const bf16_t* Kh = KB + ((size_t)b * 4 + h) * NMEM * 64;
            const bf16_t* Vh = VTB + ((size_t)b * 4 + h) * 64 * NMEM;
            f32x4_t oacc[4];
#pragma unroll
            for (int dt = 0; dt < 4; ++dt) oacc[dt] = (f32x4_t){0.f, 0.f, 0.f, 0.f};
            float lsum = 0.f;
            const int krow = 8 * (qi >> 2) + (qi & 3);
#pragma unroll 2
            for (int s0 = 0; s0 < NMEM; s0 += 32) {
                BF8 ka[2][2], va[4];
#pragma unroll
                for (int t = 0; t < 2; ++t)
#pragma unroll
                    for (int s2 = 0; s2 < 2; ++s2) ka[t][s2].u = *(const uint4*)(Kh + (size_t)(s0 + krow + 4 * t) * 64 + 32 * s2 + 8 * g);
#pragma unroll
                for (int dt = 0; dt < 4; ++dt) va[dt].u = *(const uint4*)(Vh + (size_t)(16 * dt + qi) * NMEM + s0 + 8 * g);
                f32x4_t sacc[2];
#pragma unroll
                for (int t = 0; t < 2; ++t) {
                    sacc[t] = (f32x4_t){0.f, 0.f, 0.f, 0.f};
                    sacc[t] = __builtin_amdgcn_mfma_f32_16x16x32_bf16(ka[t][0].v, qf[0].v, sacc[t], 0, 0, 0);
                    sacc[t] = __builtin_amdgcn_mfma_f32_16x16x32_bf16(ka[t][1].v, qf[1].v, sacc[t], 0, 0, 0);
                }
                float pe[8];
#pragma unroll
                for (int t = 0; t < 2; ++t)
#pragma unroll
                    for (int r = 0; r < 4; ++r) { pe[4 * t + r] = __expf(sacc[t][r]); lsum += pe[4 * t + r]; }
                BF8 pf;
#pragma unroll
                for (int j = 0; j < 4; ++j) pf.w[j] = pk_bf16(pe[2 * j], pe[2 * j + 1]);
#pragma unroll
                for (int dt = 0; dt < 4; ++dt) oacc[dt] = __builtin_amdgcn_mfma_f32_16x16x32_bf16(va[dt].v, pf.v, oacc[dt], 0, 0, 0);
            }
            lsum += __shfl_xor(lsum, 16, 64); lsum += __shfl_xor(lsum, 32, 64);
            const float inv = 1.f / lsum;
#pragma unroll
            for (int dt = 0; dt < 4; ++dt) {
                uint2 o; o.x = pk_bf16(oacc[dt][0] * inv, oacc[dt][1] * inv); o.y = pk_bf16(oacc[dt][2] * inv, oacc[dt][3] * inv);
                *(uint2*)(Ox + (size_t)(tok0 + qi) * 256 + h * 64 + 16 * dt + 4 * g) = o;
            }
        }
    }
}

template <int N> __device__ __forceinline__ void bitonic_sort_desc(unsigned (&a)[N]) {
#pragma unroll
    for (int k = 2; k <= N; k <<= 1)
#pragma unroll
        for (int j = k >> 1; j > 0; j >>= 1)
#pragma unroll
            for (int i = 0; i < N; ++i) {
                const int o = i ^ j;
                if (o > i) {
                    const bool desc = ((i & k) == 0);
                    const unsigned x = a[i], y = a[o];
                    const unsigned mx = x > y ? x : y, mn = x > y ? y : x;
                    a[i] = desc ? mx : mn; a[o] = desc ? mn : mx;
                }
            }
}
__device__ __forceinline__ void bitonic_merge16_desc(unsigned (&a)[16]) {
#pragma unroll
    for (int j = 8; j > 0; j >>= 1)
#pragma unroll
        for (int i = 0; i < 16; ++i) {
            const int o = i ^ j;
            if (o > i) { const unsigned x = a[i], y = a[o]; a[i] = x > y ? x : y; a[o] = x > y ? y : x; }
        }
}
__device__ __forceinline__ void top16_merge(unsigned (&a)[16], const unsigned (&b)[16]) {
#pragma unroll
    for (int i = 0; i < 16; ++i) a[i] = a[i] > b[15 - i] ? a[i] : b[15 - i];
    bitonic_merge16_desc(a);
}
__device__ __forceinline__ void top16_xlane(unsigned (&a)[16], int xm) {
    unsigned b[16];
#pragma unroll
    for (int i = 0; i < 16; ++i) b[i] = (unsigned)__shfl_xor((int)a[i], xm, 64);
    top16_merge(a, b);
}
__device__ __forceinline__ void ph_subkeys_convert(const Ctx& p) {
    const float* sk = pin_(31);
    bf16_t* o = (bf16_t*)(pws_() + WS_SKB);
    const size_t n = (size_t)DEPTH * 8 * 2 * 128 * 64;
    for (size_t i = (size_t)bid_() * 512 + tid_(); i < n; i += (size_t)nblk_() * 512) o[i] = f2bf(sk[i]);
}
__device__ __forceinline__ void ph_peer_topk(const Ctx& p, int l, float* smem, int task0 = 0, int ntask = MTOK / 16, int w0 = -1, int wstep = 0) {
    const bf16_t* Qp = (const bf16_t*)(pws_() + WS_QP);
    const bf16_t* SK = (const bf16_t*)(pws_() + WS_SKB) + (size_t)l * 8 * 2 * 128 * 64;
    int* pidx = (int*)(pws_() + WS_PEI);
    float* pgt = (float*)(pws_() + WS_PEG);
    float* pus = (float*)(pws_() + WS_PUS);
    const float* usc = (const float*)(pws_() + WS_USC) + (size_t)l * NEXP;
    const float* vsc = (const float*)(pws_() + WS_VSC) + (size_t)l * NEXP;
    const int tid = tid_(), lane = tid & 63, wave = tid >> 6, qi = lane & 15, g = lane >> 4;
    int* tabw = (int*)smem + wave * 512 + qi * 32;
    if (w0 < 0) { w0 = gwave(); wstep = nwaves(); }
    for (int task = task0 + w0; task < task0 + ntask; task += wstep) {
        const size_t tok = (size_t)task * 16 + qi;
#pragma unroll 1
        for (int h = 0; h < 8; ++h) {
            unsigned L[2][16];
#pragma unroll
            for (int pp = 0; pp < 2; ++pp) {
                BF8 qf[2];
#pragma unroll
                for (int s2 = 0; s2 < 2; ++s2) qf[s2].u = *(const uint4*)(Qp + tok * DM + h * 128 + pp * 64 + 32 * s2 + 8 * g);
                const bf16_t* skp = SK + (size_t)(h * 2 + pp) * 128 * 64;
                unsigned va[16], vb[16];
                BF8 kall[8][2];
#pragma unroll
                for (int tile = 0; tile < 8; ++tile)
#pragma unroll
                    for (int s2 = 0; s2 < 2; ++s2) kall[tile][s2].u = *(const uint4*)(skp + (size_t)(16 * tile + qi) * 64 + 32 * s2 + 8 * g);
                __builtin_amdgcn_sched_barrier(0);
#pragma unroll
                for (int tile = 0; tile < 8; ++tile) {
                    f32x4_t d = __builtin_amdgcn_mfma_f32_16x16x32_bf16(kall[tile][0].v, qf[0].v, (f32x4_t){0.f, 0.f, 0.f, 0.f}, 0, 0, 0);
                    d = __builtin_amdgcn_mfma_f32_16x16x32_bf16(kall[tile][1].v, qf[1].v, d, 0, 0, 0);
#pragma unroll
                    for (int r = 0; r < 4; ++r) {
                        const unsigned key = (ford(d[r]) & ~127u) | (unsigned)(127 - (16 * tile + 4 * g + r));
                        if (tile < 4) va[tile * 4 + r] = key; else vb[(tile - 4) * 4 + r] = key;
                    }
                }
                bitonic_sort_desc<16>(va);
                bitonic_sort_desc<16>(vb);
                top16_merge(va, vb);
                top16_xlane(va, 16);
                top16_xlane(va, 32);
#pragma unroll
                for (int i = 0; i < 16; ++i) L[pp][i] = va[i];
            }
            if (g < 2) {
#pragma unroll
                for (int i = 0; i < 16; ++i) tabw[g * 16 + i] = 127 - (int)((g == 0 ? L[0][i] : L[1][i]) & 127u);
            }
            float s1[16], s2v[16];
#pragma unroll
            for (int i = 0; i < 16; ++i) { s1[i] = funord(L[0][i] & ~127u); s2v[i] = funord(L[1][i] & ~127u); }
            unsigned ca[16], cb[16];
#pragma unroll
            for (int i = 0; i < 16; ++i) { ca[i] = 0u; cb[i] = 0u; }
            {
                const float r0 = g == 0 ? s1[0] : (g == 1 ? s1[1] : (g == 2 ? s1[2] : s1[3]));
                const int nb0 = g == 0 ? 16 : (g == 1 ? 8 : (g == 2 ? 5 : 4));
#pragma unroll
                for (int bq = 0; bq < 16; ++bq) if (bq < nb0) ca[bq] = (ford(r0 + s2v[bq]) & ~255u) | (unsigned)(255 - (g * 16 + bq));
                const float r1 = g == 0 ? s1[4] : (g == 1 ? s1[5] : (g == 2 ? s1[6] : s1[7]));
                const int nb1 = g == 0 ? 3 : 2;
#pragma unroll
                for (int bq = 0; bq < 3; ++bq) if (bq < nb1) cb[bq] = (ford(r1 + s2v[bq]) & ~255u) | (unsigned)(255 - ((g + 4) * 16 + bq));
                const float r2 = g == 0 ? s1[8] : (g == 1 ? s1[9] : (g == 2 ? s1[10] : s1[11]));
                cb[3] = (ford(r2 + s2v[0]) & ~255u) | (unsigned)(255 - ((g + 8) * 16));
                const float r3 = g == 0 ? s1[12] : (g == 1 ? s1[13] : (g == 2 ? s1[14] : s1[15]));
                cb[4] = (ford(r3 + s2v[0]) & ~255u) | (unsigned)(255 - ((g + 12) * 16));
            }
            bitonic_sort_desc<16>(ca);
            bitonic_sort_desc<16>(cb);
            top16_merge(ca, cb);
            top16_xlane(ca, 16);
            top16_xlane(ca, 32);
            float tv[16]; float den = 0.f;
#pragma unroll
            for (int i = 0; i < 16; ++i) {
                const int f = 255 - (int)(ca[i] & 255u);
                const int a = f >> 4, bq = f & 15;
                tv[i] = funord(ca[i] & ~255u);
                (void)a; (void)bq;
            }
#pragma unroll
            for (int i = 0; i < 16; ++i) { tv[i] = __expf(tv[i] - funord(ca[0] & ~255u)); den += tv[i]; }
            const float inv = 1.f / den;
            int ev[4]; float gv[4];
#pragma unroll
            for (int r = 0; r < 4; ++r) {
                const unsigned key = g == 0 ? ca[r] : (g == 1 ? ca[4 + r] : (g == 2 ? ca[8 + r] : ca[12 + r]));
                const float tvv = g == 0 ? tv[r] : (g == 1 ? tv[4 + r] : (g == 2 ? tv[8 + r] : tv[12 + r]));
                const int f = 255 - (int)(key & 255u);
                ev[r] = tabw[f >> 4] * 128 + tabw[16 + (f & 15)];
                gv[r] = tvv * inv;
            }
            float us[4];
#pragma unroll
            for (int r = 0; r < 4; ++r) { us[r] = usc[ev[r]]; gv[r] *= vsc[ev[r]]; }
            *(int4*)(pidx + tok * 128 + h * 16 + 4 * g) = make_int4(ev[0], ev[1], ev[2], ev[3]);
            *(float4*)(pgt + tok * 128 + h * 16 + 4 * g) = make_float4(gv[0], gv[1], gv[2], gv[3]);
            *(float4*)(pus + tok * 128 + h * 16 + 4 * g) = make_float4(us[0], us[1], us[2], us[3]);
        }
    }
}

typedef float f32x2_t __attribute__((ext_vector_type(2)));
typedef int i32x8_t __attribute__((ext_vector_type(8)));
__device__ __forceinline__ unsigned pack4_fp8(float4 a, float sc) {
    const float x = fminf(fmaxf(a.x * sc, -448.f), 448.f), y = fminf(fmaxf(a.y * sc, -448.f), 448.f);
    const float z = fminf(fmaxf(a.z * sc, -448.f), 448.f), w = fminf(fmaxf(a.w * sc, -448.f), 448.f);
    int r = __builtin_amdgcn_cvt_pk_fp8_f32(x, y, 0, false);
    r = __builtin_amdgcn_cvt_pk_fp8_f32(z, w, r, true);
    return (unsigned)r;
}
__device__ __forceinline__ unsigned q4_e2m1(float y) {
    const float a = fabsf(y);
    const unsigned c = (unsigned)(a > 0.25f) + (unsigned)(a > 0.75f) + (unsigned)(a > 1.25f) + (unsigned)(a > 1.75f) + (unsigned)(a > 2.5f) + (unsigned)(a > 3.5f) + (unsigned)(a > 5.0f);
    return c | (y < 0.f ? 8u : 0u);
}
__device__ __forceinline__ void ph_tab_convert_all(const Ctx& p) {
    const int lane = tid_() & 63;
    for (int row = gwave(); row < 2 * DEPTH * NEXP; row += nwaves()) {
        const int tabv = row >= DEPTH * NEXP;
        const int rr = tabv ? row - DEPTH * NEXP : row;
        const float4* src = (const float4*)((tabv ? pin_(33) : pin_(32)) + (size_t)rr * DM);
        float4 v[4]; float am = 0.f;
#pragma unroll
        for (int i = 0; i < 4; ++i) { v[i] = src[lane + 64 * i]; am = fmaxf(am, fmaxf(fmaxf(fabsf(v[i].x), fabsf(v[i].y)), fmaxf(fabsf(v[i].z), fabsf(v[i].w)))); }
        am = wave_max(am);
        const float sc = am > 0.f ? am * (1.f / 6.f) : 1.f, inv = 1.f / sc;
        unsigned char* dst = (unsigned char*)(pws_() + (tabv ? WS_V4 : WS_U4)) + (size_t)rr * 512;
#pragma unroll
        for (int i = 0; i < 4; ++i) {
            const unsigned pk = q4_e2m1(v[i].x * inv) | (q4_e2m1(v[i].y * inv) << 4) | (q4_e2m1(v[i].z * inv) << 8) | (q4_e2m1(v[i].w * inv) << 12);
            const int off = tabv ? 16 * (lane >> 1) + 4 * i + 2 * (lane & 1) : 128 * i + 2 * lane;
            *(unsigned short*)(dst + off) = (unsigned short)pk;
        }
        if (lane == 0) ((float*)(pws_() + (tabv ? WS_VSC : WS_USC)))[rr] = sc;
    }
}
__device__ __forceinline__ float dpp_xor1(float v) { return __int_as_float(__builtin_amdgcn_update_dpp(0, __float_as_int(v), 0xB1, 0xF, 0xF, true)); }
__device__ __forceinline__ void ph_peer_u4(const Ctx& p, int l, float* smem) {
    const unsigned char* ut = (const unsigned char*)(pws_() + WS_U4) + (size_t)l * NEXP * 512;
    const int* pidx = (const int*)(pws_() + WS_PEI);
    float* pgt = (float*)(pws_() + WS_PEG);
    const float* pus = (const float*)(pws_() + WS_PUS);
    const unsigned char* H8 = (const unsigned char*)(pws_() + WS_H8);
    const int lane = tid_() & 63, g = lane >> 4, i = lane & 15, wave = tid_() >> 6;
    const bool odd = i & 1;
    unsigned char* hl = (unsigned char*)smem + wave * 2048;
    const int nw = nwaves();
    int tok = gwave();
    int ne0 = pidx[(size_t)tok * 128 + lane], ne1 = pidx[(size_t)tok * 128 + 64 + lane];
    *(uint4*)(hl + 16 * lane) = *(const uint4*)(H8 + (size_t)tok * DM + 16 * lane);
    uint4 rA[8], rB[8], rC[8], rD[8];
    const int roff = 64 * (i & 1) + 16 * g;
#define PU_ROWS(buf, esrc, hq) do { const int ea_ = __builtin_amdgcn_ds_bpermute(((hq) * 16 + (i >> 1)) * 4, esrc), eb_ = __builtin_amdgcn_ds_bpermute(((hq) * 16 + 8 + (i >> 1)) * 4, esrc); \
        const unsigned char* pa_ = ut + (size_t)ea_ * 512 + roff; const unsigned char* pb_ = ut + (size_t)eb_ * 512 + roff; \
        _Pragma("unroll") for (int q_ = 0; q_ < 4; ++q_) { buf[q_] = *(const uint4*)(pa_ + 128 * q_); buf[4 + q_] = *(const uint4*)(pb_ + 128 * q_); } \
        __builtin_amdgcn_sched_barrier(0); } while (0)
#define PU_COMP(buf, hd) do { f32x4_t a0_ = {0.f, 0.f, 0.f, 0.f}, a1_ = {0.f, 0.f, 0.f, 0.f}; \
        _Pragma("unroll") for (int q_ = 0; q_ < 4; ++q_) { \
            const uint4 b0_ = *(const uint4*)(hb + 256 * q_), b1_ = *(const uint4*)(hb + 256 * q_ + 64); \
            const i32x8_t b_ = {(int)b0_.x, (int)b0_.y, (int)b0_.z, (int)b0_.w, (int)b1_.x, (int)b1_.y, (int)b1_.z, (int)b1_.w}; \
            const i32x8_t x_ = {(int)buf[q_].x, (int)buf[q_].y, (int)buf[q_].z, (int)buf[q_].w, 0, 0, 0, 0}; \
            const i32x8_t y_ = {(int)buf[4 + q_].x, (int)buf[4 + q_].y, (int)buf[4 + q_].z, (int)buf[4 + q_].w, 0, 0, 0, 0}; \
            a0_ = __builtin_amdgcn_mfma_scale_f32_16x16x128_f8f6f4(x_, b_, a0_, 4, 0, 0, 0, 0, 0); \
            a1_ = __builtin_amdgcn_mfma_scale_f32_16x16x128_f8f6f4(y_, b_, a1_, 4, 0, 0, 0, 0, 0); \
            __builtin_amdgcn_sched_barrier(0); } \
        float t0a_ = odd ? a0_[1] : a0_[0], t0b_ = odd ? a0_[3] : a0_[2], t1a_ = odd ? a1_[1] : a1_[0], t1b_ = odd ? a1_[3] : a1_[2]; \
        t0a_ += dpp_xor1(t0a_); t0b_ += dpp_xor1(t0b_); t1a_ += dpp_xor1(t1a_); t1b_ += dpp_xor1(t1b_); \
        if ((i >> 1) == (hd)) { keep0 = odd ? t1a_ : t0a_; keep1 = odd ? t1b_ : t0b_; } \
        __builtin_amdgcn_sched_barrier(0); } while (0)
    PU_ROWS(rA, ne0, 0); PU_ROWS(rB, ne0, 1); PU_ROWS(rC, ne0, 2);
    int par = 0;
    for (; tok < MTOK; tok += nw, par ^= 1) {
        const int e0 = ne0, e1 = ne1;
        const size_t tn = (size_t)(tok + nw < MTOK ? tok + nw : tok);
        const uint4 hnext = *(const uint4*)(H8 + tn * DM + 16 * lane);
        ne0 = pidx[tn * 128 + lane]; ne1 = pidx[tn * 128 + 64 + lane];
        const size_t mi = (size_t)tok * 128 + (i >> 1) * 16 + 8 * (i & 1) + 2 * g;
        const float2 gm = *(const float2*)(pgt + mi), um = *(const float2*)(pus + mi);
        asm volatile("s_waitcnt lgkmcnt(0)" ::: "memory"); __builtin_amdgcn_wave_barrier();
        const unsigned char* hb = hl + par * 1024 + 128 * (i & 1) + 16 * g;
        float keep0 = 0.f, keep1 = 0.f;
        PU_ROWS(rD, e0, 3); PU_COMP(rA, 0);
        PU_ROWS(rA, e1, 0); PU_COMP(rB, 1);
        PU_ROWS(rB, e1, 1); PU_COMP(rC, 2);
        PU_ROWS(rC, e1, 2); PU_COMP(rD, 3);
        PU_ROWS(rD, e1, 3); PU_COMP(rA, 4);
        PU_ROWS(rA, ne0, 0); PU_COMP(rB, 5);
        PU_ROWS(rB, ne0, 1); PU_COMP(rC, 6);
        PU_ROWS(rC, ne0, 2); PU_COMP(rD, 7);
        *(uint4*)(hl + (par ^ 1) * 1024 + 16 * lane) = hnext;
        float2 o;
        o.x = gm.x * gelu_tanh_f(keep0 * um.x * (1.f / H8_SCALE)); o.y = gm.y * gelu_tanh_f(keep1 * um.y * (1.f / H8_SCALE));
        *(float2*)(pgt + mi) = o;
    }
#undef PU_ROWS
#undef PU_COMP
}
template <bool NORM>
__device__ __forceinline__ void ph_peer_v4(const Ctx& p, int l) {
    const unsigned char* vt = (const unsigned char*)(pws_() + WS_V4) + (size_t)l * NEXP * 512;
    const int* pidx = (const int*)(pws_() + WS_PEI);
    const float* pgt = (const float*)(pws_() + WS_PEG);
    float* x = pout_();
    const int lane = tid_() & 63;
    const bool r = lane & 32;
    const int coff = 16 * (lane & 31);
    const int nw = nwaves();
    int tok = gwave();
    int ne0 = pidx[(size_t)tok * 128 + lane], ne1 = pidx[(size_t)tok * 128 + 64 + lane];
    float nc0 = pgt[(size_t)tok * 128 + lane], nc1 = pgt[(size_t)tok * 128 + 64 + lane];
    uint4 vA[16], vB[16];
    float4 gn[4];
    if (NORM) {
#pragma unroll
        for (int q = 0; q < 4; ++q) gn[q] = *(const float4*)(pin_(2) + (size_t)(l + 1) * DM + 256 * q + 8 * (lane & 31) + (r ? 4 : 0));
    }
#define PV_ROWS(buf, esrc, lb) do { int es_ = esrc; asm volatile("" : "+v"(es_)); _Pragma("unroll") for (int k_ = 0; k_ < 16; ++k_) { \
        const int ea_ = __builtin_amdgcn_readlane(es_, (lb) + 2 * k_), eb_ = __builtin_amdgcn_readlane(es_, (lb) + 2 * k_ + 1); \
        buf[k_] = *(const uint4*)(vt + (size_t)(r ? eb_ : ea_) * 512 + coff); } __builtin_amdgcn_sched_barrier(0); } while (0)
#define PV_D4(W, q) do { \
        out[4 * (q) + 0] = __builtin_elementwise_fma(__builtin_amdgcn_cvt_scalef32_pk_f32_fp4(W, 1.0f, 0), c2_, out[4 * (q) + 0]); \
        out[4 * (q) + 1] = __builtin_elementwise_fma(__builtin_amdgcn_cvt_scalef32_pk_f32_fp4(W, 1.0f, 1), c2_, out[4 * (q) + 1]); \
        out[4 * (q) + 2] = __builtin_elementwise_fma(__builtin_amdgcn_cvt_scalef32_pk_f32_fp4(W, 1.0f, 2), c2_, out[4 * (q) + 2]); \
        out[4 * (q) + 3] = __builtin_elementwise_fma(__builtin_amdgcn_cvt_scalef32_pk_f32_fp4(W, 1.0f, 3), c2_, out[4 * (q) + 3]); } while (0)
#define PV_COMP(buf, csrc, lb) do { unsigned cs_ = __float_as_uint(csrc); asm volatile("" : "+v"(cs_)); _Pragma("unroll") for (int k_ = 0; k_ < 16; ++k_) { \
        const float ca_ = __uint_as_float(__builtin_amdgcn_readlane(cs_, (lb) + 2 * k_)), cb_ = __uint_as_float(__builtin_amdgcn_readlane(cs_, (lb) + 2 * k_ + 1)); \
        const float cj_ = r ? cb_ : ca_; const f32x2_t c2_ = {cj_, cj_}; \
        PV_D4(buf[k_].x, 0); PV_D4(buf[k_].y, 1); PV_D4(buf[k_].z, 2); PV_D4(buf[k_].w, 3); } __builtin_amdgcn_sched_barrier(0); } while (0)
    PV_ROWS(vA, ne0, 0);
    for (; tok < MTOK; tok += nw) {
        const int e0 = ne0, e1 = ne1;
        const float c0 = nc0, c1 = nc1;
        {
            const size_t tn = (size_t)(tok + nw < MTOK ? tok + nw : tok);
            ne0 = pidx[tn * 128 + lane]; ne1 = pidx[tn * 128 + 64 + lane];
            nc0 = pgt[tn * 128 + lane]; nc1 = pgt[tn * 128 + 64 + lane];
        }
        f32x2_t out[16];
#pragma unroll
        for (int k = 0; k < 16; ++k) out[k] = (f32x2_t){0.f, 0.f};
        PV_ROWS(vB, e0, 32); PV_COMP(vA, c0, 0);
        PV_ROWS(vA, e1, 0);  PV_COMP(vB, c0, 32);
        PV_ROWS(vB, e1, 32); PV_COMP(vA, c1, 0);
        PV_ROWS(vA, ne0, 0); PV_COMP(vB, c1, 32);
        float4 xn[4]; float ss = 0.f;
#pragma unroll
        for (int q = 0; q < 4; ++q) {
            float fin[4];
#pragma unroll
            for (int b = 0; b < 2; ++b)
#pragma unroll
                for (int c = 0; c < 2; ++c) {
                    const float lo = out[4 * q + b][c], hi = out[4 * q + 2 + b][c];
                    const float mine = r ? hi : lo, send = r ? lo : hi;
                    fin[2 * b + c] = mine + __shfl_xor(send, 32, 64);
                }
            float4* xp = (float4*)(x + (size_t)tok * DM + 256 * q + 8 * (lane & 31) + (r ? 4 : 0));
            float4 a = *xp;
            a.x += fin[0]; a.y += fin[1]; a.z += fin[2]; a.w += fin[3];
            *xp = a;
            if (NORM) { xn[q] = a; ss += a.x * a.x + a.y * a.y + a.z * a.z + a.w * a.w; }
        }
        if (NORM) {
            ss = wave_sum(ss);
            const float rs = rsqrtf(ss * (1.f / DM) + EPS);
            bf16_t* hrow = (bf16_t*)(pws_() + WS_H) + (size_t)tok * DM + 8 * (lane & 31) + (r ? 4 : 0);
#pragma unroll
            for (int q = 0; q < 4; ++q) {
                uint2 o; o.x = pk_bf16(xn[q].x * rs * gn[q].x, xn[q].y * rs * gn[q].y); o.y = pk_bf16(xn[q].z * rs * gn[q].z, xn[q].w * rs * gn[q].w);
                *(uint2*)(hrow + 256 * q) = o;
            }
        }
    }
#undef PV_ROWS
#undef PV_COMP
#undef PV_D4
}


#ifndef PROBE_MASK
#define PROBE_MASK 0
#endif
#if PROBE_MASK
#define GB(k) do { GRID_BARRIER(); const unsigned long long now_ = wall_clock64(); if ((PROBE_MASK >> (k)) & 1) { const unsigned long long dt_ = now_ - tprev_; while (wall_clock64() - now_ < 3ull * dt_) __builtin_amdgcn_s_sleep(8); } GRID_BARRIER(); tprev_ = wall_clock64(); } while (0)
#else
#define GB(k) GRID_BARRIER()
#endif
__global__ void __launch_bounds__(512, 2) k_mega(Params kp) {
    float* sm = dynsmem;
    {
        unsigned long long* tab = (unsigned long long*)((char*)dynsmem + PTAB_OFF);
        if (threadIdx.x < 34) tab[threadIdx.x] = (unsigned long long)kp.in[threadIdx.x];
        if (threadIdx.x == 34) tab[34] = (unsigned long long)kp.out;
        if (threadIdx.x == 35) tab[35] = (unsigned long long)kp.ws;
        if (threadIdx.x == 36) { tab[36] = 0ull; tab[37] = 0ull; }
    }
    __syncthreads();
    Ctx p; p.kp = &kp;
    (void)xcd_barrier_post((unsigned*)(pws_() + WS_BAR), (volatile LAS unsigned*)((char*)dynsmem + PTAB_OFF + 36 * 8));
#define GRID_BARRIER() do { XcdBarrier bar_; bar_.bar = (unsigned*)(pws_() + WS_BAR); bar_.x = xb_xcc_id(); bar_.st = (volatile LAS unsigned*)((char*)dynsmem + PTAB_OFF + 36 * 8); xcd_barrier(bar_); } while (0)
    ph_weight_prep(p, sm);
    ph_subkeys_convert(p);
    ph_tab_convert_all(p);
    ph_rmsnorm(pin_(0), pin_(2), (bf16_t*)(pws_() + WS_H), MTOK);
    ph_rmsnorm(pin_(1), pin_(22), (bf16_t*)(pws_() + WS_HM), MMEM);
    GRID_BARRIER();
#if PROBE_MASK
    unsigned long long tprev_ = wall_clock64();
#endif
#pragma unroll 1
    for (int l = 0; l < DEPTH; ++l) {
#define XIN_ (l == 0 ? pin_(0) : pout_())
#define HBUF_ ((const bf16_t*)(pws_() + WS_H))
        { pg8::EpiBf16 E; E.O = (bf16_t*)(pws_() + WS_P); E.ldc = LDP; ph_gemm(HBUF_, (const bf16_t*)(pws_() + WT_IN) + (size_t)l * LDP * DM, MTOK, LDP, DM, E); }
        { pg8::EpiF32 E; E.C = (float*)(pws_() + WS_KM); E.R = nullptr; E.ldc = 256; ph_gemm((const bf16_t*)(pws_() + WS_HM), (const bf16_t*)(pws_() + WT_XK) + (size_t)l * 256 * DM, MMEM, 256, DM, E, 32); }
        { pg8::EpiF32 E; E.C = (float*)(pws_() + WS_VM); E.R = nullptr; E.ldc = 256; ph_gemm((const bf16_t*)(pws_() + WS_HM), (const bf16_t*)(pws_() + WT_XV) + (size_t)l * 256 * DM, MMEM, 256, DM, E, 64); }
        GB(2);
        ph_mem_prep(p, l);
        ph_dsa_prep(p, l);
        ph_scan_prep(p, l);
        GB(3);
        ph_scans(p, l, sm);
        GB(4);
        ph_mixer_finish(p, l);
        ph_dsa_main(p, l, sm);
        GB(5);
#define PANEL_SYNC() do { asm volatile("s_waitcnt vmcnt(0) lgkmcnt(0)" ::: "memory"); __syncthreads(); \
        if (threadIdx.x < 64) { __builtin_amdgcn_fence(__ATOMIC_ACQUIRE, "agent"); asm volatile("s_waitcnt vmcnt(0)" ::: "memory"); } \
        __syncthreads(); } while (0)
        if (nblk_() == MTOK / 256) {
            const int pm = bid_(), wv = tid_() >> 6;
            { pg8::EpiF32 E; E.C = pout_(); E.R = XIN_; E.ldc = DM; ph_gemm_panel((const bf16_t*)(pws_() + WS_Y), (const bf16_t*)(pws_() + WT_OUT) + (size_t)l * DM * DM, MTOK, DM, DM, E, pm); }
            PANEL_SYNC();
            ph_rmsnorm(pout_(), pin_(21) + (size_t)l * DM, (bf16_t*)(pws_() + WS_H), 256, pm * 256, wv, 8);
            PANEL_SYNC();
            { pg8::EpiF32 E; E.C = (float*)(pws_() + WS_QX); E.R = nullptr; E.ldc = 256; ph_gemm_panel(HBUF_, (const bf16_t*)(pws_() + WT_XQ) + (size_t)l * 256 * DM, MTOK, 256, DM, E, pm); }
            PANEL_SYNC();
            ph_xattn(p, l, pm * 16, 16, wv, 8);
            PANEL_SYNC();
            { pg8::EpiF32 E; E.C = pout_(); E.R = pout_(); E.ldc = DM; ph_gemm_panel((const bf16_t*)(pws_() + WS_OX), (const bf16_t*)(pws_() + WT_XO) + (size_t)l * DM * 256, MTOK, DM, 256, E, pm); }
            PANEL_SYNC();
            ph_rmsnorm(pout_(), pin_(29) + (size_t)l * DM, (bf16_t*)(pws_() + WS_H), 256, pm * 256, wv, 8, (unsigned char*)(pws_() + WS_H8));
            PANEL_SYNC();
            { pg8::EpiBf16 E; E.O = (bf16_t*)(pws_() + WS_QP); E.ldc = DM; ph_gemm_panel(HBUF_, (const bf16_t*)(pws_() + WT_PQ) + (size_t)l * DM * DM, MTOK, DM, DM, E, pm); }
            PANEL_SYNC();
            ph_peer_topk(p, l, sm, pm * 16, 16, wv, 8);
        }
        GB(13);
        ph_peer_u4(p, l, sm);
        GB(14);
        if (l + 1 < DEPTH) {
            ph_peer_v4<true>(p, l);
            ph_rmsnorm(pin_(1), pin_(22) + (size_t)(l + 1) * DM, (bf16_t*)(pws_() + WS_HM), MMEM);
        } else ph_peer_v4<false>(p, l);
        GB(17);
    }
}

extern "C" void kernel_launch(void* const* d_in, const int* in_sizes, int n_in, void* d_out, int out_size, void* d_ws, size_t ws_size, hipStream_t stream) {
    if (n_in != 34 || out_size != MTOK * DM || ws_size < WS_END) {
        fprintf(stderr, "kernel_launch: unexpected shapes (n_in %d out %d ws %zu need %zu)\n", n_in, out_size, ws_size, (size_t)WS_END);
        return;
    }
    static int grid = 0;
    if (!grid) {
        int dev = 0, cus = 0, per_cu = 0;
        (void)hipGetDevice(&dev);
        (void)hipDeviceGetAttribute(&cus, hipDeviceAttributeMultiprocessorCount, dev);
        (void)hipFuncSetAttribute((const void*)k_mega, hipFuncAttributeMaxDynamicSharedMemorySize, LDS_BYTES);
        (void)hipOccupancyMaxActiveBlocksPerMultiprocessor(&per_cu, (const void*)k_mega, 512, LDS_BYTES);
        if (per_cu < 1) fprintf(stderr, "kernel_launch: occupancy query reports %d blocks per CU\n", per_cu);
        grid = cus > 0 ? cus : 256;
    }
    Params p; memset(&p, 0, sizeof(p));
    for (int i = 0; i < 34; ++i) p.in[i] = (const float*)d_in[i];
    p.out = (float*)d_out; p.ws = (char*)d_ws;
    (void)hipMemsetAsync((char*)d_ws + WS_BAR, 0, XCD_BAR_WORDS * sizeof(unsigned), stream);
    hipLaunchKernelGGL(k_mega, dim3(grid), dim3(512), LDS_BYTES, stream, p);
}
```

```cpp
#include <hip/hip_runtime.h>
#include <stdint.h>
#include <stdio.h>
#include <string.h>

#define NB 32
#define SEQ 2048
#define DM 1024
#define MTOK (NB * SEQ)
#define DEPTH 4
#define NMEM 256
#define MMEM (NB * NMEM)
#define LDP 3328
#define NEXP 16384
#define EPS 1e-6f
#define PC_Z 0
#define PC_XBC 256
#define PC_GQKV 768
#define PC_GG 1536
#define PC_LQ 1792
#define PC_LK 1920
#define PC_LV 2048
#define PC_LR 2304
#define PC_DQ 2560
#define PC_DK 2816
#define PC_DV 2880
#define PC_IQ 2944
#define PC_IK 3200
#define PC_GLR 3232
#define PC_IW 3248
#define PC_DT 3256
#define PC_GA 3260
#define PC_GB 3264

typedef unsigned short bf16_t;

#define WS_BAR 0ull
#define WS_P 16384ull
#define SZ_P ((size_t)MTOK * LDP * 2)
#define WS_H (WS_P + SZ_P)
#define SZ_H ((size_t)MTOK * DM * 2)
#define WS_Y (WS_H + SZ_H)
#define SZ_Y ((size_t)MTOK * DM * 2)
#define WS_WP (WS_Y + SZ_Y)
#define SZ_WP ((size_t)DEPTH * DM * LDP * 4)
#define WT_IN (WS_WP)
#define WT_OUT (WT_IN + (size_t)DEPTH * LDP * DM * 2)
#define WT_XQ (WT_OUT + (size_t)DEPTH * DM * DM * 2)
#define WT_XK (WT_XQ + (size_t)DEPTH * 256 * DM * 2)
#define WT_XV (WT_XK + (size_t)DEPTH * 256 * DM * 2)
#define WT_XO (WT_XV + (size_t)DEPTH * 256 * DM * 2)
#define WT_PQ (WT_XO + (size_t)DEPTH * DM * 256 * 2)
#define WT_END (WT_PQ + (size_t)DEPTH * DM * DM * 2)
#define WS_QN (WS_WP + SZ_WP)
#define SZ_QN ((size_t)MTOK * 256 * 4)
#define WS_KN (WS_QN + SZ_QN)
#define SZ_KN ((size_t)MTOK * 64 * 4)
#define WS_IKN (WS_KN + SZ_KN)
#define SZ_IKN ((size_t)MTOK * 32 * 4)
#define WS_YPRE (WS_IKN + SZ_IKN)
#define SZ_YPRE ((size_t)MTOK * 256 * 4)
#define WS_HM (WS_YPRE + SZ_YPRE)
#define SZ_HM ((size_t)MMEM * DM * 2)
#define WS_KM (WS_HM + SZ_HM)
#define SZ_KM ((size_t)MMEM * 256 * 4)
#define WS_VM (WS_KM + SZ_KM)
#define SZ_VM ((size_t)MMEM * 256 * 4)
#define WS_KB (WS_VM + SZ_VM)
#define SZ_KB ((size_t)MMEM * 256 * 2)
#define WS_VTB (WS_KB + SZ_KB)
#define SZ_VTB ((size_t)MMEM * 256 * 2)
#define WS_VT (WS_VTB + SZ_VTB)
#define SZ_VT ((size_t)MTOK * 64 * 2)
#define WS_SKB (WS_VT + SZ_VT)
#define SZ_SKB ((size_t)DEPTH * 8 * 2 * 128 * 64 * 2)
#define WS_SC (WS_SKB + SZ_SKB)
#define SZ_SC ((size_t)MTOK * 16 * 4)
#define WS_DUMMY (WS_SC + SZ_SC)
#define SZ_DUMMY (65536ull)
#define WS_U4 (WS_DUMMY + SZ_DUMMY)
#define WS_V4 (WS_U4 + (size_t)DEPTH * NEXP * 512)
#define WS_USC (WS_V4 + (size_t)DEPTH * NEXP * 512)
#define WS_VSC (WS_USC + (size_t)DEPTH * NEXP * 4)
#define WS_END (WS_VSC + (size_t)DEPTH * NEXP * 4)
#define WS_QX (WS_P)
#define WS_OX (WS_P + (size_t)MTOK * 256 * 4)
#define WS_QP (WS_P + 96ull * 1024 * 1024)
#define WS_H8 (WS_P + 224ull * 1024 * 1024)
#define WS_PEI (WS_H8 + (size_t)MTOK * DM)
#define WS_PEG (WS_PEI + (size_t)MTOK * 128 * 4)
#define WS_PUS (WS_PEG + (size_t)MTOK * 128 * 4)
#define WS_PEND (WS_PUS + (size_t)MTOK * 128 * 4)
static_assert(WS_PEND <= WS_P + SZ_P, "P region aliases");

struct Params {
    const float* in[34];
    float* out;
    char* ws;
};

#define XB_TMO      128
#define XB_XCNT(j)  (256  + 64 * (j))
#define XB_XSUB(j)  (1280 + 64 * (j))
#define XB_XGEN(j)  (2304 + 64 * (j))
#define XB_TOP      3328
#define XB_TOPGEN   3392
#define XCD_BAR_WORDS 3456
#define XB_SPIN_CAP (1u << 18)
#define LAS __attribute__((address_space(3)))

__device__ __forceinline__ unsigned xb_ld(unsigned* p)              { return __hip_atomic_load(p, __ATOMIC_RELAXED, __HIP_MEMORY_SCOPE_AGENT); }
__device__ __forceinline__ unsigned xb_add(unsigned* p, unsigned v) { return __hip_atomic_fetch_add(p, v, __ATOMIC_RELAXED, __HIP_MEMORY_SCOPE_AGENT); }
__device__ __forceinline__ unsigned xb_xcc_id() { return (unsigned)__builtin_amdgcn_s_getreg((3 << 11) | 20) & 0xFu; }
#define XB_SPIN(cond, bar) do { unsigned _sp = 0; while (cond) { __builtin_amdgcn_s_sleep(1); \
    if ((++_sp & 255u) == 0u) { if (xb_ld(&(bar)[XB_TMO])) break; if (_sp > XB_SPIN_CAP) { atomicAdd(&(bar)[XB_TMO], 1u); break; } } } } while (0)

struct XcdBarrier {
    unsigned* bar; unsigned x;
    volatile LAS unsigned* st;
};

__device__ __forceinline__ XcdBarrier xcd_barrier_post(unsigned* bar, volatile LAS unsigned* st) {
    XcdBarrier b; b.bar = bar; b.x = xb_xcc_id(); b.st = st;
    if (threadIdx.x == 0) (void)xb_add(&bar[XB_XCNT(b.x)], 1u);
    return b;
}
__device__ __forceinline__ void xcd_barrier_complete(unsigned* bar, unsigned x, unsigned& nloc, unsigned& nx) {
    const unsigned G = gridDim.x * gridDim.y * gridDim.z;
    unsigned sum, cnt, mine, sp = 0u;
    for (;;) {
        sum = 0u; cnt = 0u; mine = 0u;
#pragma unroll
        for (unsigned j = 0; j < 16; ++j) { const unsigned c = xb_ld(&bar[XB_XCNT(j)]); sum += c; cnt += (c > 0u) ? 1u : 0u; mine = (j == x) ? c : mine; }
        if (sum == G) break;
        __builtin_amdgcn_s_sleep(1);
        if ((++sp & 255u) == 0u) { if (xb_ld(&bar[XB_TMO])) break; if (sp > XB_SPIN_CAP) { atomicAdd(&bar[XB_TMO], 1u); break; } }
    }
    nloc = mine > 0u ? mine : 1u; nx = cnt > 0u ? cnt : 1u;
}

__device__ __forceinline__ void xcd_barrier(const XcdBarrier& b) {
    asm volatile("s_waitcnt vmcnt(0)" ::: "memory");
    __syncthreads();
    if (threadIdx.x == 0) {
        unsigned* bar = b.bar;
        __builtin_amdgcn_s_waitcnt(0);
        unsigned nloc = b.st[0], nx = b.st[1];
        if (nloc == 0u) { xcd_barrier_complete(bar, b.x, nloc, nx); b.st[0] = nloc; b.st[1] = nx; }
        const unsigned old = xb_add(&bar[XB_XSUB(b.x)], 1u);
        const unsigned gen = old / nloc;
        if (old + 1u == (gen + 1u) * nloc) {
            __builtin_amdgcn_fence(__ATOMIC_RELEASE, "agent");
            asm volatile("s_waitcnt vmcnt(0)" ::: "memory");
            const unsigned og = xb_add(&bar[XB_TOP], 1u);
            const unsigned tg = og / nx;
            if (og + 1u == (tg + 1u) * nx) xb_add(&bar[XB_TOPGEN], 1u);
            else XB_SPIN(xb_ld(&bar[XB_TOPGEN]) == tg, bar);
            __builtin_amdgcn_fence(__ATOMIC_ACQUIRE, "agent");
            xb_add(&bar[XB_XGEN(b.x)], 1u);
            asm volatile("s_waitcnt vmcnt(0)" ::: "memory");
        } else {
            XB_SPIN(xb_ld(&bar[XB_XGEN(b.x)]) == gen, bar);
            __builtin_amdgcn_fence(__ATOMIC_ACQUIRE, "agent");
            asm volatile("s_waitcnt vmcnt(0)" ::: "memory");
        }
    }
    __syncthreads();
}


#define LDS_BYTES (144 * 1024)
#define PTAB_OFF (LDS_BYTES - 1024)
extern __shared__ __attribute__((aligned(16))) float dynsmem[];
struct Ctx { const Params* kp; };
#define pin_(i) (p.kp->in[i])
#define pout_() (p.kp->out)
#define pws_() (p.kp->ws)

__device__ __forceinline__ float bf2f(bf16_t v) { return __uint_as_float(((unsigned)v) << 16); }
typedef float cvf32x2_t __attribute__((ext_vector_type(2)));
typedef __bf16 cvbf16x2_t __attribute__((ext_vector_type(2)));
__device__ __forceinline__ unsigned pk_bf16(float lo, float hi) {
    const cvf32x2_t f = {lo, hi}; union { cvbf16x2_t b; unsigned u; } c; c.b = __builtin_convertvector(f, cvbf16x2_t); return c.u;
}
__device__ __forceinline__ bf16_t f2bf(float f) { return (bf16_t)pk_bf16(f, f); }
__device__ __forceinline__ float wave_sum(float v) {
#pragma unroll
    for (int o = 32; o >= 1; o >>= 1) v += __shfl_xor(v, o, 64);
    return v;
}
__device__ __forceinline__ float wave_max(float v) {
#pragma unroll
    for (int o = 32; o >= 1; o >>= 1) v = fmaxf(v, __shfl_xor(v, o, 64));
    return v;
}
__device__ __forceinline__ float silu_f(float x) { return x * __builtin_amdgcn_rcpf(1.f + __expf(-x)); }
__device__ __forceinline__ float sigmoid_f(float x) { return __builtin_amdgcn_rcpf(1.f + __expf(-x)); }
__device__ __forceinline__ float softplus_f(float x) { return x > 20.f ? x : log1pf(__expf(x)); }
__device__ __forceinline__ float logsigmoid_f(float x) { return -softplus_f(-x); }
__device__ __forceinline__ float gelu_tanh_f(float x) { const float u = 0.7978845608028654f * (x + 0.044715f * x * x * x); return 0.5f * x * (1.f + tanhf(u)); }
__device__ __forceinline__ unsigned ford(float f) { f = f + 0.0f; unsigned u = __float_as_uint(f); return (u & 0x80000000u) ? ~u : (u | 0x80000000u); }
__device__ __forceinline__ float funord(unsigned k) { unsigned u = (k & 0x80000000u) ? (k & 0x7fffffffu) : ~k; return __uint_as_float(u); }
__device__ __forceinline__ unsigned long long wave_max_u64(unsigned long long v) {
#pragma unroll
    for (int o = 32; o >= 1; o >>= 1) {
        unsigned lo = __shfl_xor((unsigned)v, o, 64), hi = __shfl_xor((unsigned)(v >> 32), o, 64);
        unsigned long long w = ((unsigned long long)hi << 32) | lo;
        v = w > v ? w : v;
    }
    return v;
}
__device__ __forceinline__ int tid_() { int t = threadIdx.x; asm volatile("" : "+v"(t)); return t; }
__device__ __forceinline__ int bid_() { int b = blockIdx.x; asm volatile("" : "+s"(b)); return b; }
__device__ __forceinline__ int nblk_() { int g = gridDim.x; asm volatile("" : "+s"(g)); return g; }
__device__ __forceinline__ int gwave() { return (bid_() * 512 + tid_()) >> 6; }
__device__ __forceinline__ int nwaves() { return nblk_() * 8; }

namespace pg8 {
#define PG8_LAS __attribute__((address_space(3)))
typedef unsigned short bf16_t;
typedef short bf16x8 __attribute__((ext_vector_type(8)));
typedef float f32x4 __attribute__((ext_vector_type(4)));
typedef unsigned u32x4 __attribute__((ext_vector_type(4)));
constexpr int BM = 256, BK = 64, HALF = 128, HTB = HALF * BK * 2  , STAGE_BYTES = 8 * HTB, NXCD = 8, WGM = 8;

__host__ __device__ __forceinline__ int lds_byte(int r, int c) { const int st = (r >> 4) * 2 + (c >> 5), rr = r & 15, cc = c & 31, ob = rr * 64 + cc * 2; return st * 1024 + (ob ^ (((ob >> 9) & 1) << 5)); }
__host__ __device__ __forceinline__ void stage_rc(int b, int& R, int& C) { const int st = b / 1024, sb = b % 1024, swz = sb ^ (((sb >> 9) & 1) << 5); R = (st >> 1) * 16 + swz / 64; C = (st & 1) * 32 + (swz % 64) / 2; }
__host__ __device__ __forceinline__ int perm32(int rho) { const int n = rho >> 4, i = rho & 15; return 8 * (i >> 2) + 4 * n + (i & 3); }

struct Unit { int pm, pn; };
struct Gemm { const bf16_t* A; const bf16_t* Bt; int M, N, K; };

struct StaticOrder {
    int nM, nN, nwg, G, c;
    __host__ __device__ void init(int M, int N, int G_, int c_) { nM = M / BM; nN = N / BM; nwg = nM * nN; G = G_; c = c_; }
    __host__ __device__ bool next(int i, Unit& u) const {
        const long L = (long)i * G + c; if (L >= nwg) return false;
        int wgid = (int)L; { const int q = nwg / NXCD, r = nwg % NXCD, xcd = wgid % NXCD, off = wgid / NXCD; wgid = (xcd < r ? xcd * (q + 1) : r * (q + 1) + (xcd - r) * q) + off; }
        const int nig = WGM * nN, gid = wgid / nig, fm = gid * WGM, gsz = (nM - fm) < WGM ? (nM - fm) : WGM;
        u.pm = fm + ((wgid % nig) % gsz); u.pn = (wgid % nig) / gsz; return true;
    }
    __device__ __forceinline__ void a_ready(const Unit&) const {}
    __device__ __forceinline__ void done(const Unit&) const {}
};

__device__ __forceinline__ unsigned cvt_pk_bf16(float lo, float hi) { return ::pk_bf16(lo, hi); }
struct EpiF32 {
    static constexpr bool PERM = false, AFTER_DRAIN = false;
    float* C; const float* R; int ldc;
    __device__ __forceinline__ void operator()(const f32x4 (&acc)[2][2][4][2], const Unit& u, int wr, int wc, int fr, int fq) const {
        const int row0 = u.pm * BM + wr * 64 + fr, col0 = u.pn * BM + wc * 32 + 4 * fq;
#pragma unroll
        for (int ai = 0; ai < 2; ++ai)
#pragma unroll
            for (int m = 0; m < 4; ++m) { const size_t off = (size_t)(row0 + ai * HALF + m * 16) * ldc + col0;
                f32x4 rv[2][2];
#pragma unroll
                for (int bj = 0; bj < 2; ++bj)
#pragma unroll
                    for (int n = 0; n < 2; ++n) rv[bj][n] = R ? *(const f32x4*)(R + off + bj * HALF + n * 16) : (f32x4){0.f, 0.f, 0.f, 0.f};
#pragma unroll
                for (int bj = 0; bj < 2; ++bj)
#pragma unroll
                    for (int n = 0; n < 2; ++n) *(f32x4*)(C + off + bj * HALF + n * 16) = acc[ai][bj][m][n] + rv[bj][n]; }
    }
};
struct EpiBf16 {
    static constexpr bool PERM = true, AFTER_DRAIN = false;
    bf16_t* O; int ldc;
    __device__ __forceinline__ void operator()(const f32x4 (&acc)[2][2][4][2], const Unit& u, int wr, int wc, int fr, int fq) const {
        const int row0 = u.pm * BM + wr * 64 + fr, col0 = u.pn * BM + wc * 32 + 8 * fq;
#pragma unroll
        for (int ai = 0; ai < 2; ++ai)
#pragma unroll
            for (int m = 0; m < 4; ++m) { bf16_t* rowp = O + (size_t)(row0 + ai * HALF + m * 16) * ldc + col0;
#pragma unroll
                for (int bj = 0; bj < 2; ++bj) { const f32x4 v0 = acc[ai][bj][m][0], v1 = acc[ai][bj][m][1];
                    u32x4 w; w.x = cvt_pk_bf16(v0[0], v0[1]); w.y = cvt_pk_bf16(v0[2], v0[3]); w.z = cvt_pk_bf16(v1[0], v1[1]); w.w = cvt_pk_bf16(v1[2], v1[3]);
                    *(u32x4*)(rowp + bj * HALF) = w; } }
    }
};

template <class Epi, class Sched, bool STAMP = false>
__device__ __forceinline__ void gemm_phase(PG8_LAS unsigned char* lds, const Gemm g, const Sched& S, const Epi& E, unsigned long long* stamps, const int tid) {
    const int wid = __builtin_amdgcn_readfirstlane(tid >> 6), lane = tid & 63, wr = wid >> 2, wc = wid & 3, fr = lane & 15, fq = lane >> 4;
    const int K = g.K, nt = K / BK;
    int ts_lo = 0, ts_hi = 0, nts = 0; const unsigned long long rt_entry = STAMP ? (unsigned long long)wall_clock64() : 0ull;
#define PG8_STAMP() do { if (STAMP && wid == 0 && nts < 64) { const unsigned long long _c = (unsigned long long)clock64(); \
        ts_lo = (lane == nts) ? (int)(unsigned)_c : ts_lo; ts_hi = (lane == nts) ? (int)(unsigned)(_c >> 32) : ts_hi; ++nts; } } while (0)
    PG8_STAMP();
    unsigned voffA[2], voffB[2];
#pragma unroll
    for (int i = 0; i < 2; ++i) { int R, C; stage_rc(tid * 16 + i * 8192, R, C); const int Rb = Epi::PERM ? ((R & ~31) + perm32(R & 31)) : R;
        voffA[i] = (unsigned)(R * K + C) * 2u; voffB[i] = (unsigned)(Rb * K + C) * 2u; }
    const size_t kstep = (size_t)(BK * 2);
    const size_t hstep = (size_t)HALF * K * 2;
    const size_t tstep = 2 * hstep;
    const unsigned ldsw = (unsigned)wid * 1024u;
    const int aoff = lds_byte(wr * 64 + fr, fq * 8), boff = lds_byte(wc * 32 + fr, fq * 8);
#define PG8_SA(b, h) (((b) * 2 + (h)) * HTB)
#define PG8_SB(b, h) ((4 + (b) * 2 + (h)) * HTB)
#define PG8_STAGE(bufoff, gbase, voff) do { _Pragma("unroll") for (int _i = 0; _i < 2; ++_i) \
        __builtin_amdgcn_global_load_lds((const unsigned*)((const char*)(gbase) + (voff)[_i]), (PG8_LAS unsigned*)(lds + (bufoff) + ldsw + _i * 8192), 16, 0, 0); } while (0)
#define PG8_LDA(dst, b, h) do { _Pragma("unroll") for (int m = 0; m < 4; ++m) _Pragma("unroll") for (int k = 0; k < 2; ++k) dst[m][k] = *(const PG8_LAS bf16x8*)(lds + PG8_SA(b, h) + aoff + m * 2048 + k * 1024); } while (0)
#define PG8_LDB(dst, b, h) do { _Pragma("unroll") for (int n = 0; n < 2; ++n) _Pragma("unroll") for (int k = 0; k < 2; ++k) dst[n][k] = *(const PG8_LAS bf16x8*)(lds + PG8_SB(b, h) + boff + n * 2048 + k * 1024); } while (0)
#define PG8_MMA(ai, bj, At, Bt) do { __builtin_amdgcn_s_setprio(1); _Pragma("unroll") for (int m = 0; m < 4; ++m) _Pragma("unroll") for (int n = 0; n < 2; ++n) _Pragma("unroll") for (int k = 0; k < 2; ++k) \
        acc[ai][bj][m][n] = __builtin_amdgcn_mfma_f32_16x16x32_bf16(Bt[n][k], At[m][k], acc[ai][bj][m][n], 0, 0, 0); __builtin_amdgcn_s_setprio(0); } while (0)
#define PG8_WAIT_V(n) asm volatile("s_waitcnt vmcnt(" #n ")" ::: "memory")
#define PG8_WAIT_L(n) asm volatile("s_waitcnt lgkmcnt(" #n ")" ::: "memory")
#define PG8_BAR __builtin_amdgcn_s_barrier()
#define PG8_SCHED __builtin_amdgcn_sched_barrier(0)
    Unit cur, nxt; int ui = 0;
    if (!S.next(0, cur)) return;
    f32x4 acc[2][2][4][2];
#pragma unroll
    for (int a = 0; a < 2; ++a)
#pragma unroll
        for (int b = 0; b < 2; ++b)
#pragma unroll
            for (int m = 0; m < 4; ++m)
#pragma unroll
                for (int n = 0; n < 2; ++n) acc[a][b][m][n] = (f32x4){0.f, 0.f, 0.f, 0.f};
    bf16x8 At[4][2], B0[2][2], B1[2][2];
    const char* cA = (const char*)g.A + (size_t)cur.pm * tstep; const char* cB = (const char*)g.Bt + (size_t)cur.pn * tstep;
    S.a_ready(cur);
    PG8_STAGE(PG8_SB(0, 0), cB, voffB); PG8_STAGE(PG8_SA(0, 0), cA, voffA); PG8_STAGE(PG8_SB(0, 1), cB + hstep, voffB); PG8_STAGE(PG8_SA(0, 1), cA + hstep, voffA);
    if (wr == 1) PG8_BAR;
    PG8_WAIT_V(4); PG8_BAR;
    PG8_STAGE(PG8_SB(1, 0), cB + kstep, voffB); PG8_STAGE(PG8_SA(1, 0), cA + kstep, voffA); PG8_STAGE(PG8_SB(1, 1), cB + hstep + kstep, voffB);
    PG8_WAIT_V(6); PG8_BAR;
    PG8_STAMP();
    for (;;) {
        const bool has_next = S.next(ui + 1, nxt);
        const char* nA = has_next ? (const char*)g.A + (size_t)nxt.pm * tstep : cA; const char* nB = has_next ? (const char*)g.Bt + (size_t)nxt.pn * tstep : cB;
        for (int t = 0; t < nt; t += 2) {
            const bool last = (t == nt - 2);
            const char* a1 = cA + (size_t)(t + 1) * kstep;
            const char* a2 = last ? nA : cA + (size_t)(t + 2) * kstep; const char* b2 = last ? nB : cB + (size_t)(t + 2) * kstep;
            const char* a3 = a2 + kstep; const char* b3 = b2 + kstep;
            if (last && has_next) S.a_ready(nxt);
            PG8_LDB(B0, 0, 0); PG8_SCHED; PG8_LDA(At, 0, 0); PG8_STAGE(PG8_SA(1, 1), a1 + hstep, voffA);
            PG8_WAIT_L(8); PG8_BAR; PG8_WAIT_L(0); PG8_MMA(0, 0, At, B0); PG8_BAR; PG8_SCHED;
            PG8_LDB(B1, 0, 1); PG8_STAGE(PG8_SB(0, 0), b2, voffB);
            PG8_BAR; PG8_WAIT_L(0); PG8_MMA(0, 1, At, B1); PG8_BAR;
            PG8_LDA(At, 0, 1); PG8_STAGE(PG8_SA(0, 0), a2, voffA);
            PG8_BAR; PG8_WAIT_L(0); PG8_MMA(1, 0, At, B0); PG8_BAR; PG8_SCHED;
            PG8_STAGE(PG8_SB(0, 1), b2 + hstep, voffB);
            PG8_WAIT_V(6); PG8_BAR; PG8_MMA(1, 1, At, B1); PG8_BAR;
            PG8_LDB(B0, 1, 0); PG8_SCHED; PG8_LDA(At, 1, 0); PG8_STAGE(PG8_SA(0, 1), a2 + hstep, voffA);
            PG8_WAIT_L(8); PG8_BAR; PG8_WAIT_L(0); PG8_MMA(0, 0, At, B0); PG8_BAR; PG8_SCHED;
            PG8_LDB(B1, 1, 1); PG8_STAGE(PG8_SB(1, 0), b3, voffB);
            PG8_BAR; PG8_WAIT_L(0); PG8_MMA(0, 1, At, B1); PG8_BAR;
            PG8_LDA(At, 1, 1); PG8_STAGE(PG8_SA(1, 0), a3, voffA);
            PG8_BAR; PG8_WAIT_L(0); PG8_MMA(1, 0, At, B0); PG8_BAR; PG8_SCHED;
            PG8_STAGE(PG8_SB(1, 1), b3 + hstep, voffB);
            PG8_WAIT_V(6); PG8_BAR; PG8_MMA(1, 1, At, B1); PG8_BAR;
        }
        PG8_STAMP();
        if constexpr (!Epi::AFTER_DRAIN) { E(acc, cur, wr, wc, fr, fq); S.done(cur); }
        PG8_STAMP();
        if (!has_next) break;
#pragma unroll
        for (int a = 0; a < 2; ++a)
#pragma unroll
            for (int b = 0; b < 2; ++b)
#pragma unroll
                for (int m = 0; m < 4; ++m)
#pragma unroll
                    for (int n = 0; n < 2; ++n) acc[a][b][m][n] = (f32x4){0.f, 0.f, 0.f, 0.f};
        cur = nxt; cA = nA; cB = nB; ++ui;
    }
    PG8_WAIT_V(0);
    if (wr == 0) PG8_BAR;
    PG8_BAR;
    if constexpr (Epi::AFTER_DRAIN) { E.fused(acc, cur, wr, wc, fr, fq, lds, wid, lane); S.done(cur); }
    PG8_STAMP();
    if (STAMP && wid == 0) { stamps[lane] = lane < nts ? (((unsigned long long)(unsigned)ts_hi << 32) | (unsigned)ts_lo) : 0ull;
        if (lane == 62) stamps[62] = rt_entry; if (lane == 63) stamps[63] = (unsigned long long)wall_clock64(); }
#undef PG8_STAMP
#undef PG8_SA
#undef PG8_SB
#undef PG8_STAGE
#undef PG8_LDA
#undef PG8_LDB
#undef PG8_MMA
#undef PG8_WAIT_V
#undef PG8_WAIT_L
#undef PG8_BAR
#undef PG8_SCHED
}
}

namespace pg8 {
struct PanelOrder {
    int pm, nN;
    __device__ void init(int pm_, int N) { pm = pm_; nN = N / BM; }
    __device__ bool next(int i, Unit& u) const { if (i >= nN) return false; u.pm = pm; u.pn = i; return true; }
    __device__ __forceinline__ void a_ready(const Unit&) const {}
    __device__ __forceinline__ void done(const Unit&) const {}
};
}
template <class Epi> __device__ __forceinline__ void ph_gemm_panel(const bf16_t* A, const bf16_t* Bt, int M, int N, int K, const Epi& E, int pm) {
    pg8::Gemm g; g.A = A; g.Bt = Bt; g.M = M; g.N = N; g.K = K;
    pg8::PanelOrder S; S.init(pm, N);
    pg8::gemm_phase<Epi, pg8::PanelOrder, false>((PG8_LAS unsigned char*)dynsmem, g, S, E, nullptr, tid_());
}
template <class Epi> __device__ __forceinline__ void ph_gemm(const bf16_t* A, const bf16_t* Bt, int M, int N, int K, const Epi& E, int crot = 0) {
    pg8::Gemm g; g.A = A; g.Bt = Bt; g.M = M; g.N = N; g.K = K;
    const int nb_ = nblk_();
    pg8::StaticOrder S; S.init(M, N, nb_, (bid_() + nb_ - crot) % nb_);
    pg8::gemm_phase<Epi, pg8::StaticOrder, false>((PG8_LAS unsigned char*)dynsmem, g, S, E, nullptr, tid_());
}

__device__ __forceinline__ int pcol_to_orig(int c) {
    if (c < 768) return c;
    if (c < 1536) return c - 768 + 772;
    if (c < 1792) return c - 1536 + 1548;
    if (c < 1920) return c - 1792 + 1804;
    if (c < 2048) return c - 1920 + 1932;
    if (c < 2304) return c - 2048 + 2060;
    if (c < 2560) return c - 2304 + 2332;
    if (c < 2816) return c - 2560 + 2588;
    if (c < 2880) return c - 2816 + 2844;
    if (c < 2944) return c - 2880 + 2908;
    if (c < 3200) return c - 2944 + 2972;
    if (c < 3232) return c - 3200 + 3228;
    if (c < 3248) return c - 3232 + 2316;
    if (c < 3256) return c - 3248 + 3260;
    if (c < 3260) return c - 3256 + 768;
    if (c < 3264) return c - 3260 + 1540;
    if (c < 3268) return c - 3264 + 1544;
    return -1;
}
__device__ __forceinline__ void wtrans_job(const float* W, int K, int ldw, bf16_t* Wt, int Npad, bool mapped, float* tile) {
    const int tid = tid_();
    const int tn = Npad / 64, tk = K / 64;
    for (int t = bid_(); t < tn * tk; t += nblk_()) {
        const int n0 = (t / tk) * 64, k0 = (t % tk) * 64;
        __syncthreads();
        for (int idx = tid; idx < 4096; idx += 512) {
            const int kk = idx >> 6, nn = idx & 63;
            const int col = mapped ? pcol_to_orig(n0 + nn) : (n0 + nn);
            tile[kk * 65 + nn] = col >= 0 ? W[(size_t)(k0 + kk) * ldw + col] : 0.f;
        }
        __syncthreads();
        for (int idx = tid; idx < 4096; idx += 512) {
            const int nn = idx >> 6, kk = idx & 63;
            Wt[(size_t)(n0 + nn) * K + k0 + kk] = f2bf(tile[kk * 65 + nn]);
        }
    }
}
__device__ __forceinline__ void ph_weight_prep(const Ctx& p, float* sm) {
#pragma unroll 1
    for (int j = 0; j < 7 * DEPTH; ++j) {
        const int l = j / 7, w = j % 7;
        const float* W; int K, ldw, Npad; bf16_t* Wt; bool mapped = false;
        if (w == 0) { W = pin_(3) + (size_t)l * DM * 3268; K = DM; ldw = 3268; Npad = LDP; Wt = (bf16_t*)(pws_() + WT_IN) + (size_t)l * LDP * DM; mapped = true; }
        else if (w == 1) { W = pin_(20) + (size_t)l * DM * DM; K = DM; ldw = DM; Npad = DM; Wt = (bf16_t*)(pws_() + WT_OUT) + (size_t)l * DM * DM; }
        else if (w == 2) { W = pin_(23) + (size_t)l * DM * 256; K = DM; ldw = 256; Npad = 256; Wt = (bf16_t*)(pws_() + WT_XQ) + (size_t)l * 256 * DM; }
        else if (w == 3) { W = pin_(24) + (size_t)l * DM * 256; K = DM; ldw = 256; Npad = 256; Wt = (bf16_t*)(pws_() + WT_XK) + (size_t)l * 256 * DM; }
        else if (w == 4) { W = pin_(25) + (size_t)l * DM * 256; K = DM; ldw = 256; Npad = 256; Wt = (bf16_t*)(pws_() + WT_XV) + (size_t)l * 256 * DM; }
        else if (w == 5) { W = pin_(26) + (size_t)l * 256 * DM; K = 256; ldw = DM; Npad = DM; Wt = (bf16_t*)(pws_() + WT_XO) + (size_t)l * DM * 256; }
        else { W = pin_(30) + (size_t)l * DM * DM; K = DM; ldw = DM; Npad = DM; Wt = (bf16_t*)(pws_() + WT_PQ) + (size_t)l * DM * DM; }
        wtrans_job(W, K, ldw, Wt, Npad, mapped, sm);
    }
}

#define H8_SCALE 16.f
__device__ __forceinline__ unsigned pack4_fp8(float4 a, float sc);
__device__ __forceinline__ void ph_rmsnorm(const float* __restrict__ x, const float* __restrict__ g, bf16_t* __restrict__ out, int rows, int row0 = 0, int w0 = -1, int wstep = 0, unsigned char* out8 = nullptr) {
    const int lane = tid_() & 63;
    if (w0 < 0) { w0 = gwave(); wstep = nwaves(); }
    float4 gq[4];
#pragma unroll
    for (int i = 0; i < 4; ++i) gq[i] = ((const float4*)g)[lane + 64 * i];
    const int rend = row0 + rows;
    for (int r0 = row0 + w0; r0 < rend; r0 += 4 * wstep) {
        float4 v[4][4];
#pragma unroll
        for (int k = 0; k < 4; ++k) {
            const int r = r0 + k * wstep < rend ? r0 + k * wstep : r0;
#pragma unroll
            for (int i = 0; i < 4; ++i) v[k][i] = ((const float4*)(x + (size_t)r * DM))[lane + 64 * i];
        }
        float ss[4];
#pragma unroll
        for (int k = 0; k < 4; ++k) { ss[k] = 0.f;
#pragma unroll
            for (int i = 0; i < 4; ++i) ss[k] += v[k][i].x * v[k][i].x + v[k][i].y * v[k][i].y + v[k][i].z * v[k][i].z + v[k][i].w * v[k][i].w; }
#pragma unroll
        for (int o = 32; o >= 1; o >>= 1) {
#pragma unroll
            for (int k = 0; k < 4; ++k) ss[k] += __shfl_xor(ss[k], o, 64);
        }
#pragma unroll
        for (int k = 0; k < 4; ++k) {
            const int r = r0 + k * wstep;
            if (r < rend) {
                const float rs = rsqrtf(ss[k] * (1.f / DM) + EPS);
#pragma unroll
                for (int i = 0; i < 4; ++i) {
                    const float4 gg = gq[i];
                    const float4 w = make_float4(v[k][i].x * rs * gg.x, v[k][i].y * rs * gg.y, v[k][i].z * rs * gg.z, v[k][i].w * rs * gg.w);
                    uint2 o; o.x = pk_bf16(w.x, w.y); o.y = pk_bf16(w.z, w.w);
                    *(uint2*)(out + (size_t)r * DM + (size_t)(lane + 64 * i) * 4) = o;
                    if (out8) *(unsigned*)(out8 + (size_t)r * DM + (size_t)(lane + 64 * i) * 4) = pack4_fp8(w, H8_SCALE);
                }
            }
        }
    }
}

template <int OUTMODE>
__device__ __forceinline__ void ph_sgemm(const bf16_t* __restrict__ A, int lda, const float* __restrict__ B, int ldb, void* Cv, int ldc, const float* R, int ldr,
                         int M, int N, int K, float* smem) {
    float* As = smem;
    float* Bs = smem + 16 * 132;
    const int tid = tid_(), tx = tid & 31, ty = tid >> 5;
    const int ntn = N / 128, ntiles = (M / 128) * ntn;
    for (int tile = bid_(); tile < ntiles; tile += nblk_()) {
        const int tm = tile / ntn, tn = tile % ntn;
        float acc[8][4];
#pragma unroll
        for (int i = 0; i < 8; ++i)
#pragma unroll
            for (int j = 0; j < 4; ++j) acc[i][j] = 0.f;
        const int arow = tid >> 2, akq = (tid & 3) * 4;
        const int bk = tid >> 5, bn = (tid & 31) * 4;
        for (int k0 = 0; k0 < K; k0 += 16) {
            const ushort4 av = *(const ushort4*)(A + (size_t)(tm * 128 + arow) * lda + k0 + akq);
            const float4 bv = *(const float4*)(B + (size_t)(k0 + bk) * ldb + tn * 128 + bn);
            __syncthreads();
            As[(akq + 0) * 132 + arow] = bf2f(av.x); As[(akq + 1) * 132 + arow] = bf2f(av.y);
            As[(akq + 2) * 132 + arow] = bf2f(av.z); As[(akq + 3) * 132 + arow] = bf2f(av.w);
            *(float4*)(Bs + bk * 132 + bn) = bv;
            __syncthreads();
#pragma unroll
            for (int k = 0; k < 16; ++k) {
                const float4 a0 = *(const float4*)(As + k * 132 + ty * 8), a1 = *(const float4*)(As + k * 132 + ty * 8 + 4);
                const float4 b = *(const float4*)(Bs + k * 132 + tx * 4);
                const float a[8] = {a0.x, a0.y, a0.z, a0.w, a1.x, a1.y, a1.z, a1.w};
#pragma unroll
                for (int i = 0; i < 8; ++i) { acc[i][0] += a[i] * b.x; acc[i][1] += a[i] * b.y; acc[i][2] += a[i] * b.z; acc[i][3] += a[i] * b.w; }
            }
        }
#pragma unroll
        for (int i = 0; i < 8; ++i) {
            const size_t row = (size_t)tm * 128 + ty * 8 + i; const int col = tn * 128 + tx * 4;
            if (OUTMODE == 0) {
                ushort4 o; o.x = f2bf(acc[i][0]); o.y = f2bf(acc[i][1]); o.z = f2bf(acc[i][2]); o.w = f2bf(acc[i][3]);
                *(ushort4*)((bf16_t*)Cv + row * ldc + col) = o;
            } else if (OUTMODE == 1) {
                *(float4*)((float*)Cv + row * ldc + col) = make_float4(acc[i][0], acc[i][1], acc[i][2], acc[i][3]);
            } else {
                const float4 r = *(const float4*)(R + row * ldr + col);
                *(float4*)((float*)Cv + row * ldc + col) = make_float4(r.x + acc[i][0], r.y + acc[i][1], r.z + acc[i][2], r.w + acc[i][3]);
            }
        }
    }
}

#define WS_HS WS_H
#define WS_VG WS_YPRE
#define WS_DEC (WS_YPRE + (size_t)MTOK * 256 * 2)

__device__ __forceinline__ float quad_sum(float v) {
    v += __int_as_float(__builtin_amdgcn_mov_dpp(__float_as_int(v), 0xB1, 0xF, 0xF, true));
    v += __int_as_float(__builtin_amdgcn_mov_dpp(__float_as_int(v), 0x4E, 0xF, 0xF, true));
    return v;
}
__device__ __forceinline__ float bflo(unsigned w) { return __uint_as_float(w << 16); }
__device__ __forceinline__ float bfhi(unsigned w) { return __uint_as_float(w & 0xffff0000u); }

__device__ __forceinline__ float oct_sum(float v) {
    v += __int_as_float(__builtin_amdgcn_mov_dpp(__float_as_int(v), 0xB1, 0xF, 0xF, true));
    v += __int_as_float(__builtin_amdgcn_mov_dpp(__float_as_int(v), 0x4E, 0xF, 0xF, true));
    v += __int_as_float(__builtin_amdgcn_mov_dpp(__float_as_int(v), 0x141, 0xF, 0xF, true));
    return v;
}
__device__ __forceinline__ void unpack8(const uint4 r, float (&o)[8]) {
    o[0] = bflo(r.x); o[1] = bfhi(r.x); o[2] = bflo(r.y); o[3] = bfhi(r.y); o[4] = bflo(r.z); o[5] = bfhi(r.z); o[6] = bflo(r.w); o[7] = bfhi(r.w);
}
__device__ __forceinline__ uint4 pack8(const float (&v)[8]) {
    uint4 o; o.x = pk_bf16(v[0], v[1]); o.y = pk_bf16(v[2], v[3]); o.z = pk_bf16(v[4], v[5]); o.w = pk_bf16(v[6], v[7]); return o;
}
__device__ __forceinline__ void load8f(const float* p, float (&o)[8]) {
    const float4 a = *(const float4*)p, b = *(const float4*)(p + 4);
    o[0] = a.x; o[1] = a.y; o[2] = a.z; o[3] = a.w; o[4] = b.x; o[5] = b.y; o[6] = b.z; o[7] = b.w;
}
__device__ __forceinline__ void conv8(const bf16_t* P, size_t tok, int t, int pcol, const float* w, int ldw, int cc, float (&acc)[8]) {
#pragma unroll
    for (int j = 0; j < 4; ++j) {
        if (t - 3 + j >= 0) {
            float xv[8], wv[8];
            unpack8(*(const uint4*)(P + (tok - (size_t)(3 - j)) * LDP + pcol), xv);
            load8f(w + j * ldw + cc, wv);
#pragma unroll
            for (int i = 0; i < 8; ++i) acc[i] = __builtin_fmaf(wv[i], xv[i], acc[i]);
        }
    }
}
__device__ __forceinline__ void conv8r(const uint4 (&xt)[4], int t, const float* w, int ldw, int cc, float (&acc)[8]) {
#pragma unroll
    for (int j = 0; j < 4; ++j) {
        float xv[8], wv[8];
        unpack8(xt[j], xv);
        load8f(w + j * ldw + cc, wv);
        const float m = (t - 3 + j >= 0) ? 1.f : 0.f;
#pragma unroll
        for (int i = 0; i < 8; ++i) acc[i] = __builtin_fmaf(wv[i] * m, xv[i], acc[i]);
    }
}
__device__ __forceinline__ void conv8w(const uint4 (&xt)[4], int t, const float (&wv)[4][8], float (&acc)[8]) {
#pragma unroll
    for (int j = 0; j < 4; ++j) {
        float xv[8];
        unpack8(xt[j], xv);
        const float m = (t - 3 + j >= 0) ? 1.f : 0.f;
#pragma unroll
        for (int i = 0; i < 8; ++i) acc[i] = __builtin_fmaf(wv[j][i] * m, xv[i], acc[i]);
    }
}
__device__ __forceinline__ void ph_scan_prep(const Ctx& p, int l) {
    const bf16_t* P = (const bf16_t*)(pws_() + WS_P);
    bf16_t* HS = (bf16_t*)(pws_() + WS_HS);
    bf16_t* VG = (bf16_t*)(pws_() + WS_VG);
    float* DEC = (float*)(pws_() + WS_DEC);
    float* SC = (float*)(pws_() + WS_SC);
    const float* scw = pin_(4) + (size_t)l * 4 * 512;
    const float* scb = pin_(5) + (size_t)l * 512;
    const float* gcw = pin_(10) + (size_t)l * 4 * 768;
    const float* wg = pin_(14) + (size_t)l * 16 * 128;
    const float* bg = pin_(15) + (size_t)l * 128;
    const int lane = tid_() & 63;
    const int hsc = lane & 3, wsc = (lane >> 2) & 3;
    const float k_dtb = pin_(6)[l * 4 + hsc], k_alog = __expf(pin_(7)[l * 4 + hsc]), k_galog = __expf(pin_(11)[l * 4 + hsc]), k_gdtb = pin_(12)[l * 4 + hsc];
    const int sccol = wsc < 2 ? PC_DT + hsc : (wsc == 2 ? PC_GA + hsc : PC_GB + hsc);
    const int nw = nwaves();
    {
        uint4 nxa[4], ngl0, ngl1; unsigned short nsc;
#define SP_LOAD(tk) do { const int t_ = (tk) % SEQ; const size_t row_ = (size_t)(tk) * LDP; \
        _Pragma("unroll") for (int j = 0; j < 4; ++j) { const size_t rj = (t_ - 3 + j >= 0) ? row_ - (size_t)(3 - j) * LDP : row_; nxa[j] = *(const uint4*)(P + rj + PC_XBC + 8 * lane); } \
        ngl0 = *(const uint4*)(P + row_ + PC_GLR); ngl1 = *(const uint4*)(P + row_ + PC_GLR + 8); nsc = P[row_ + sccol]; } while (0)
        float wsx[4][8], bsx[8], wgl[2][16], bgl[2];
#pragma unroll
        for (int j = 0; j < 4; ++j) load8f(scw + j * 512 + 8 * lane, wsx[j]);
        load8f(scb + 8 * lane, bsx);
#pragma unroll
        for (int i = 0; i < 2; ++i) { bgl[i] = bg[lane + 64 * i];
#pragma unroll
            for (int r = 0; r < 16; ++r) wgl[i][r] = wg[r * 128 + lane + 64 * i]; }
        int tok = gwave();
        SP_LOAD(tok);
        for (; tok < MTOK; tok += nw) {
            const int t = tok % SEQ;
            uint4 xa[4];
#pragma unroll
            for (int j = 0; j < 4; ++j) xa[j] = nxa[j];
            const uint4 gl0 = ngl0, gl1 = ngl1;
            const float scraw = bf2f(nsc);
            { const int tn = tok + nw < MTOK ? tok + nw : tok; SP_LOAD(tn); }
            __builtin_amdgcn_sched_barrier(0);
            {
                float acc[8];
#pragma unroll
                for (int i = 0; i < 8; ++i) acc[i] = bsx[i];
                conv8w(xa, t, wsx, acc);
#pragma unroll
                for (int i = 0; i < 8; ++i) acc[i] = silu_f(acc[i]);
                *(uint4*)(HS + (size_t)tok * 1024 + 8 * lane) = pack8(acc);
            }
            {
                float v;
                if (wsc < 2) { const float dt = softplus_f(scraw + k_dtb); v = wsc == 0 ? dt : __expf(-dt * k_alog); }
                else if (wsc == 2) v = __expf(-k_galog * softplus_f(scraw + k_gdtb));
                else v = sigmoid_f(scraw);
                if (lane < 16) SC[(size_t)tok * 16 + lane] = v;
            }
            {
                float gl[16];
                { float a8[8], b8[8]; unpack8(gl0, a8); unpack8(gl1, b8);
#pragma unroll
                  for (int i = 0; i < 8; ++i) { gl[i] = a8[i]; gl[8 + i] = b8[i]; } }
#pragma unroll
                for (int i = 0; i < 2; ++i) {
                    const int c = lane + 64 * i;
                    float acc = bgl[i];
#pragma unroll
                    for (int r = 0; r < 16; ++r) acc = __builtin_fmaf(gl[r], wgl[i][r], acc);
                    DEC[(size_t)tok * 128 + c] = __expf(logsigmoid_f(acc) * (1.f / 16.f));
                }
            }
        }
#undef SP_LOAD
    }
    {
        uint4 nxq[4], nxv4[4];
#define SP_LOAD(tk) do { const int t_ = (tk) % SEQ; const size_t row_ = (size_t)(tk) * LDP; \
        _Pragma("unroll") for (int j = 0; j < 4; ++j) { const size_t rj = (t_ - 3 + j >= 0) ? row_ - (size_t)(3 - j) * LDP : row_; \
            nxq[j] = *(const uint4*)(P + rj + PC_GQKV + 8 * lane); nxv4[j] = *(const uint4*)(P + rj + PC_GQKV + 512 + 8 * (lane & 31)); } } while (0)
        float wq[4][8], wv[4][8];
#pragma unroll
        for (int j = 0; j < 4; ++j) { load8f(gcw + j * 768 + 8 * lane, wq[j]); load8f(gcw + j * 768 + 512 + 8 * (lane & 31), wv[j]); }
        int tok = gwave();
        SP_LOAD(tok);
        for (; tok < MTOK; tok += nw) {
            const int t = tok % SEQ;
            uint4 xq[4], xv4[4];
#pragma unroll
            for (int j = 0; j < 4; ++j) { xq[j] = nxq[j]; xv4[j] = nxv4[j]; }
            { const int tn = tok + nw < MTOK ? tok + nw : tok; SP_LOAD(tn); }
            __builtin_amdgcn_sched_barrier(0);
            {
                float acc[8];
#pragma unroll
                for (int i = 0; i < 8; ++i) acc[i] = 0.f;
                conv8w(xq, t, wq, acc);
                float ss = 0.f;
#pragma unroll
                for (int i = 0; i < 8; ++i) { acc[i] = silu_f(acc[i]); ss += acc[i] * acc[i]; }
                ss = oct_sum(ss);
                const float sc = rsqrtf(ss + EPS) * (lane < 32 ? 0.125f : 1.f);
#pragma unroll
                for (int i = 0; i < 8; ++i) acc[i] *= sc;
                *(uint4*)(HS + (size_t)tok * 1024 + 512 + 8 * lane) = pack8(acc);
            }
            {
                float acc[8];
#pragma unroll
                for (int i = 0; i < 8; ++i) acc[i] = 0.f;
                conv8w(xv4, t, wv, acc);
#pragma unroll
                for (int i = 0; i < 8; ++i) acc[i] = silu_f(acc[i]);
                if (lane < 32) *(uint4*)(VG + (size_t)tok * 256 + 8 * lane) = pack8(acc);
            }
        }
#undef SP_LOAD
    }
}

#define SCAN_LDS_WAVE 4608
typedef float f2_t __attribute__((ext_vector_type(2)));
__device__ __forceinline__ f2_t mk2(float a, float b) { f2_t r; r.x = a; r.y = b; return r; }
__device__ __forceinline__ void st8f(char* dst, const uint4 v) {
    *(float4*)dst = make_float4(bflo(v.x), bfhi(v.x), bflo(v.y), bfhi(v.y));
    *(float4*)(dst + 16) = make_float4(bflo(v.z), bfhi(v.z), bflo(v.w), bfhi(v.w));
}
__device__ __forceinline__ void ph_scans(const Ctx& p, int l, float* smem) {
    const bf16_t* P = (const bf16_t*)(pws_() + WS_P);
    const bf16_t* HS = (const bf16_t*)(pws_() + WS_HS);
    const bf16_t* VG = (const bf16_t*)(pws_() + WS_VG);
    const float* DEC = (const float*)(pws_() + WS_DEC);
    const float* SC = (const float*)(pws_() + WS_SC);
    bf16_t* Y = (bf16_t*)(pws_() + WS_Y);
    const int tid = tid_(), lane = tid & 63, wave = tid >> 6;
    if (nblk_() != 256) return;
    const int role = wave < 2 ? 0 : (wave < 6 ? 1 : 2);
    const int idx = (role == 0 ? wave : (role == 1 ? wave - 2 : wave - 6)) * 256 + bid_();
    const int bh = role == 1 ? (idx >> 3) : (idx >> 2), b = bh >> 2, h = bh & 3;
    const int colbase = role == 1 ? (idx & 7) * 8 : (idx & 3) * 16;
    const int cl = role == 1 ? (lane >> 3) : (lane >> 2);
    const int col = colbase + cl;
    const int sq = role == 1 ? (lane & 7) : (lane & 3);
    const size_t tb = (size_t)b * SEQ;
    bf16_t* dummy = (bf16_t*)(pws_() + WS_DUMMY) + (tid & 511) * 8;
    char* lw = (char*)smem + wave * SCAN_LDS_WAVE;
    char* lrow = lw;
    char* lcol = lw + 4096;
    float* lsc = (float*)(lw + 4352);
    const int fs = lane >> 3, fp = lane & 7;
    if (role == 0) {
        const int g = h >> 1;
        const float Dh = pin_(8)[l * 4 + h];
        uint4 f0, f1; unsigned fc = 0u; float fsc = 0.f;
        f2_t st[8];
#pragma unroll
        for (int i = 0; i < 8; ++i) st[i] = mk2(0.f, 0.f);
        auto fetch = [&](int t0) {
            const size_t tok = tb + t0 + fs;
            const bf16_t* src = HS + tok * 1024 + (fp < 4 ? 256 + g * 64 + fp * 16 : 384 + g * 64 + (fp - 4) * 16);
            f0 = *(const uint4*)src; f1 = *(const uint4*)(src + 8);
            fc = *(const unsigned*)(HS + tok * 1024 + h * 64 + colbase + fp * 2);
            if (lane < 16) fsc = SC[(tb + t0 + (lane >> 1)) * 16 + (lane & 1) * 4 + h];
        };
        fetch(0);
        for (int t0 = 0; t0 < SEQ; t0 += 8) {
            st8f(lrow + fs * 512 + fp * 64, f0); st8f(lrow + fs * 512 + fp * 64 + 32, f1);
            *(unsigned*)(lcol + fs * 32 + fp * 4) = fc;
            if (lane < 16) lsc[lane] = fsc;
            if (t0 + 8 < SEQ) fetch(t0 + 8);
#pragma unroll
            for (int i = 0; i < 8; ++i) {
                const char* rb = lrow + i * 512 + sq * 64;
                const float4 b0 = *(const float4*)rb, b1 = *(const float4*)(rb + 16), b2 = *(const float4*)(rb + 32), b3 = *(const float4*)(rb + 48);
                const float4 c0 = *(const float4*)(rb + 256), c1 = *(const float4*)(rb + 272), c2 = *(const float4*)(rb + 288), c3 = *(const float4*)(rb + 304);
                const float xv = bf2f(*(const bf16_t*)(lcol + i * 32 + cl * 2));
                const float2 sc2 = *(const float2*)(lsc + i * 2);
                const float xdt = xv * sc2.x;
                const f2_t xd2 = mk2(xdt, xdt), dA2 = mk2(sc2.y, sc2.y);
                const f2_t bb[8] = {mk2(b0.x, b0.y), mk2(b0.z, b0.w), mk2(b1.x, b1.y), mk2(b1.z, b1.w), mk2(b2.x, b2.y), mk2(b2.z, b2.w), mk2(b3.x, b3.y), mk2(b3.z, b3.w)};
                const f2_t cc[8] = {mk2(c0.x, c0.y), mk2(c0.z, c0.w), mk2(c1.x, c1.y), mk2(c1.z, c1.w), mk2(c2.x, c2.y), mk2(c2.z, c2.w), mk2(c3.x, c3.y), mk2(c3.z, c3.w)};
                f2_t ya = mk2(0.f, 0.f), yb = mk2(0.f, 0.f);
#pragma unroll
                for (int q = 0; q < 8; q += 2) {
                    st[q] = st[q] * dA2 + xd2 * bb[q]; st[q + 1] = st[q + 1] * dA2 + xd2 * bb[q + 1];
                    ya = cc[q] * st[q] + ya; yb = cc[q + 1] * st[q + 1] + yb;
                }
                const f2_t ys = ya + yb;
                const float y = quad_sum(ys.x + ys.y);
                *(sq == 0 ? Y + (tb + t0 + i) * DM + h * 64 + col : dummy + i) = f2bf(y + Dh * xv);
                if (i & 1) __builtin_amdgcn_sched_barrier(0);
            }
        }
    } else if (role == 1) {
        uint4 f0, f1; unsigned fc = 0u; float fsc = 0.f;
        f2_t S[4];
#pragma unroll
        for (int i = 0; i < 4; ++i) S[i] = mk2(0.f, 0.f);
        auto fetch = [&](int t0) {
            const size_t tok = tb + t0 + fs;
            const bf16_t* src = HS + tok * 1024 + (fp < 4 ? 512 + h * 64 + fp * 16 : 768 + h * 64 + (fp - 4) * 16);
            f0 = *(const uint4*)src; f1 = *(const uint4*)(src + 8);
            if (fp < 4) fc = *(const unsigned*)(VG + tok * 256 + h * 64 + colbase + fp * 2);
            if (lane < 16) fsc = SC[(tb + t0 + (lane >> 1)) * 16 + 8 + (lane & 1) * 4 + h];
        };
        fetch(0);
        for (int t0 = 0; t0 < SEQ; t0 += 8) {
            st8f(lrow + fs * 512 + fp * 64, f0); st8f(lrow + fs * 512 + fp * 64 + 32, f1);
            if (fp < 4) *(unsigned*)(lcol + fs * 32 + fp * 4) = fc;
            if (lane < 16) lsc[lane] = fsc;
            if (t0 + 8 < SEQ) fetch(t0 + 8);
#pragma unroll
            for (int i = 0; i < 8; ++i) {
                const char* rb = lrow + i * 512 + sq * 32;
                const float4 q0 = *(const float4*)rb, q1 = *(const float4*)(rb + 16);
                const float4 k0 = *(const float4*)(rb + 256), k1 = *(const float4*)(rb + 272);
                const float vv = bf2f(*(const bf16_t*)(lcol + i * 32 + cl * 2));
                const float2 sc2 = *(const float2*)(lsc + i * 2);
                const f2_t al2 = mk2(sc2.x, sc2.x);
                const f2_t kk[4] = {mk2(k0.x, k0.y), mk2(k0.z, k0.w), mk2(k1.x, k1.y), mk2(k1.z, k1.w)};
                const f2_t qq[4] = {mk2(q0.x, q0.y), mk2(q0.z, q0.w), mk2(q1.x, q1.y), mk2(q1.z, q1.w)};
                f2_t ra = mk2(0.f, 0.f), rb2 = mk2(0.f, 0.f);
#pragma unroll
                for (int q = 0; q < 4; q += 2) {
                    S[q] = S[q] * al2; S[q + 1] = S[q + 1] * al2;
                    ra = S[q] * kk[q] + ra; rb2 = S[q + 1] * kk[q + 1] + rb2;
                }
                const f2_t rs = ra + rb2;
                const float r = oct_sum(rs.x + rs.y);
                const float vn = sc2.y * (vv - r);
                const f2_t vn2 = mk2(vn, vn);
                f2_t oa2 = mk2(0.f, 0.f), ob2 = mk2(0.f, 0.f);
#pragma unroll
                for (int q = 0; q < 4; q += 2) {
                    S[q] = kk[q] * vn2 + S[q]; S[q + 1] = kk[q + 1] * vn2 + S[q + 1];
                    oa2 = S[q] * qq[q] + oa2; ob2 = S[q + 1] * qq[q + 1] + ob2;
                }
                const f2_t os = oa2 + ob2;
                const float ov = oct_sum(os.x + os.y);
                *(sq == 0 ? Y + (tb + t0 + i) * DM + 256 + h * 64 + col : dummy + i) = f2bf(ov);
                if (i & 1) __builtin_amdgcn_sched_barrier(0);
            }
        }
    } else {
        uint4 f0, f1; unsigned fc = 0u;
        f2_t S[4];
#pragma unroll
        for (int i = 0; i < 4; ++i) S[i] = mk2(0.f, 0.f);
        auto fetch = [&](int t0) {
            const size_t tok = tb + t0 + fs;
            if (fp < 4) { const float* src = DEC + tok * 128 + h * 32 + fp * 8; f0 = *(const uint4*)src; f1 = *(const uint4*)(src + 4); }
            else { const bf16_t* src = P + tok * LDP + (fp < 6 ? PC_LK + h * 32 + (fp - 4) * 16 : PC_LQ + h * 32 + (fp - 6) * 16); f0 = *(const uint4*)src; f1 = *(const uint4*)(src + 8); }
            fc = *(const unsigned*)(P + tok * LDP + PC_LV + h * 64 + colbase + fp * 2);
        };
        fetch(0);
        for (int t0 = 0; t0 < SEQ; t0 += 8) {
            if (fp < 4) { *(uint4*)(lrow + fs * 512 + fp * 32) = f0; *(uint4*)(lrow + fs * 512 + fp * 32 + 16) = f1; }
            else { st8f(lrow + fs * 512 + 128 + (fp - 4) * 64, f0); st8f(lrow + fs * 512 + 128 + (fp - 4) * 64 + 32, f1); }
            *(unsigned*)(lcol + fs * 32 + fp * 4) = fc;
            if (t0 + 8 < SEQ) fetch(t0 + 8);
#pragma unroll
            for (int i = 0; i < 8; ++i) {
                const char* rb = lrow + i * 512 + sq * 32;
                const float4 d0 = *(const float4*)rb, d1 = *(const float4*)(rb + 16);
                const float4 k0 = *(const float4*)(rb + 128), k1 = *(const float4*)(rb + 144);
                const float4 q0 = *(const float4*)(rb + 256), q1 = *(const float4*)(rb + 272);
                const float vv = bf2f(*(const bf16_t*)(lcol + i * 32 + cl * 2));
                const f2_t v2 = mk2(vv, vv);
                const f2_t dd[4] = {mk2(d0.x, d0.y), mk2(d0.z, d0.w), mk2(d1.x, d1.y), mk2(d1.z, d1.w)};
                const f2_t kk[4] = {mk2(k0.x, k0.y), mk2(k0.z, k0.w), mk2(k1.x, k1.y), mk2(k1.z, k1.w)};
                const f2_t qq[4] = {mk2(q0.x, q0.y), mk2(q0.z, q0.w), mk2(q1.x, q1.y), mk2(q1.z, q1.w)};
                f2_t oa2 = mk2(0.f, 0.f), ob2 = mk2(0.f, 0.f);
#pragma unroll
                for (int q = 0; q < 4; q += 2) {
                    S[q] = dd[q] * S[q] + kk[q] * v2; S[q + 1] = dd[q + 1] * S[q + 1] + kk[q + 1] * v2;
                    oa2 = S[q] * qq[q] + oa2; ob2 = S[q + 1] * qq[q + 1] + ob2;
                }
                const f2_t os = oa2 + ob2;
                const float ov = quad_sum(os.x + os.y);
                *(sq == 0 ? Y + (tb + t0 + i) * DM + 512 + h * 64 + col : dummy + i) = f2bf(ov * 0.17677669529663687f);
                if (i & 1) __builtin_amdgcn_sched_barrier(0);
            }
        }
    }
}

__device__ __forceinline__ void ph_mixer_finish(const Ctx& p, int l) {
    const bf16_t* P = (const bf16_t*)(pws_() + WS_P);
    bf16_t* Y = (bf16_t*)(pws_() + WS_Y);
    const float* sn = pin_(9) + (size_t)l * 256;
    const float* gn = pin_(13) + (size_t)l * 64;
    const float* ln = pin_(16) + (size_t)l * 64;
    const int lane = tid_() & 63;
    float gw1[8], gw2[8];
    load8f(lane < 32 ? sn + 8 * lane : gn + 8 * (lane & 7), gw1);
    load8f(ln + 8 * (lane & 7), gw2);
    const int nw = nwaves();
    int tok = gwave();
    uint4 nya, nga, nyb, ngb;
#define MF_LOAD(tk) do { const size_t row_ = (size_t)(tk) * LDP; \
        nya = *(const uint4*)(Y + (size_t)(tk) * DM + 8 * lane); \
        nga = *(const uint4*)(P + row_ + (lane < 32 ? PC_Z + 8 * lane : PC_GG + 8 * (lane - 32))); \
        nyb = *(const uint4*)(Y + (size_t)(tk) * DM + 512 + 8 * (lane & 31)); \
        ngb = *(const uint4*)(P + row_ + PC_LR + 8 * (lane & 31)); } while (0)
    MF_LOAD(tok);
    for (; tok < MTOK; tok += nw) {
        const uint4 ya = nya, ga = nga, yb = nyb, gb = ngb;
        { const int tn = tok + nw < MTOK ? tok + nw : tok; MF_LOAD(tn); }
        __builtin_amdgcn_sched_barrier(0);
        {
            float v[8], gt[8];
            unpack8(ya, v);
            unpack8(ga, gt);
            float ss = 0.f;
            if (lane < 32) {
#pragma unroll
                for (int i = 0; i < 8; ++i) { v[i] *= silu_f(gt[i]); ss += v[i] * v[i]; }
            } else {
#pragma unroll
                for (int i = 0; i < 8; ++i) ss += v[i] * v[i];
            }
            const float s8 = oct_sum(ss);
            float s32 = s8 + __int_as_float(__builtin_amdgcn_mov_dpp(__float_as_int(s8), 0x140, 0xF, 0xF, true));
            s32 += __shfl_xor(s32, 16, 64);
            const float rs = lane < 32 ? rsqrtf(s32 * (1.f / 256.f) + EPS) : rsqrtf(s8 * (1.f / 64.f) + EPS);
            float o[8];
#pragma unroll
            for (int i = 0; i < 8; ++i) o[i] = lane < 32 ? v[i] * rs * gw1[i] : v[i] * rs * gw1[i] * silu_f(gt[i]);
            *(uint4*)(Y + (size_t)tok * DM + 8 * lane) = pack8(o);
        }
        if (lane < 32) {
            float v[8], gt[8];
            unpack8(yb, v);
            unpack8(gb, gt);
            float ss = 0.f;
#pragma unroll
            for (int i = 0; i < 8; ++i) ss += v[i] * v[i];
            const float rs = rsqrtf(oct_sum(ss) * (1.f / 64.f) + EPS);
            float o[8];
#pragma unroll
            for (int i = 0; i < 8; ++i) o[i] = v[i] * rs * gw2[i] * silu_f(gt[i]);
            *(uint4*)(Y + (size_t)tok * DM + 512 + 8 * lane) = pack8(o);
        }
    }
#undef MF_LOAD
}

typedef short bf16x8_t __attribute__((ext_vector_type(8)));
typedef float f32x4_t __attribute__((ext_vector_type(4)));
union BF8 { bf16x8_t v; uint4 u; unsigned w[4]; };


__device__ __forceinline__ void ph_dsa_prep(const Ctx& p, int l) {
    const bf16_t* P = (const bf16_t*)(pws_() + WS_P);
    bf16_t* qn = (bf16_t*)(pws_() + WS_QN);
    bf16_t* kn = (bf16_t*)(pws_() + WS_KN);
    bf16_t* ikn = (bf16_t*)(pws_() + WS_IKN);
    bf16_t* vt = (bf16_t*)(pws_() + WS_VT);
    const float* qg = pin_(17) + (size_t)l * 64;
    const float* kg = pin_(18) + (size_t)l * 64;
    const float* ig = pin_(19) + (size_t)l * 32;
    const int lane = tid_() & 63;
    const int pcol = lane < 40 ? PC_DQ + 8 * lane : PC_IK + 8 * (lane & 3);
    float gw[8];
    load8f(lane < 32 ? qg + 8 * (lane & 7) : (lane < 40 ? kg + 8 * (lane & 7) : ig + 8 * (lane & 3)), gw);
    for (int grp = gwave(); grp < MTOK / 8; grp += nwaves()) {
        const size_t tok0 = (size_t)grp * 8;
        const int b = (int)(tok0 / SEQ), t0 = (int)(tok0 % SEQ);
        unsigned short vv[8];
#pragma unroll
        for (int i = 0; i < 8; ++i) {
            const size_t row = (tok0 + i) * LDP;
            vv[i] = P[row + PC_DV + lane];
            if (lane < 44) {
                float v[8];
                unpack8(*(const uint4*)(P + row + pcol), v);
                float ss = 0.f;
#pragma unroll
                for (int q = 0; q < 8; ++q) ss += v[q] * v[q];
                const float s4 = ss + __int_as_float(__builtin_amdgcn_mov_dpp(__float_as_int(ss), 0xB1, 0xF, 0xF, true));
                const float s4b = s4 + __int_as_float(__builtin_amdgcn_mov_dpp(__float_as_int(s4), 0x4E, 0xF, 0xF, true));
                const float s8 = s4b + __int_as_float(__builtin_amdgcn_mov_dpp(__float_as_int(s4b), 0x141, 0xF, 0xF, true));
                const float rs = lane < 40 ? rsqrtf(s8 * (1.f / 64.f) + EPS) * (lane < 32 ? 0.125f : 1.f) : rsqrtf(s4b * (1.f / 32.f) + EPS);
                float o[8];
#pragma unroll
                for (int q = 0; q < 8; ++q) o[q] = v[q] * rs * gw[q];
                const uint4 pk = pack8(o);
                if (lane < 32) *(uint4*)(qn + (tok0 + i) * 256 + 8 * lane) = pk;
                else if (lane < 40) *(uint4*)(kn + (tok0 + i) * 64 + 8 * (lane - 32)) = pk;
                else *(uint4*)(ikn + (tok0 + i) * 32 + 8 * (lane - 40)) = pk;
            }
        }
        uint4 o; o.x = (unsigned)vv[0] | ((unsigned)vv[1] << 16); o.y = (unsigned)vv[2] | ((unsigned)vv[3] << 16);
        o.z = (unsigned)vv[4] | ((unsigned)vv[5] << 16); o.w = (unsigned)vv[6] | ((unsigned)vv[7] << 16);
        *(uint4*)(vt + ((size_t)b * 64 + lane) * SEQ + t0) = o;
    }
}

#define DSA_STRIDE 2052
__device__ __forceinline__ int wave_total_i(int v) {
    v += __builtin_amdgcn_update_dpp(0, v, 0x111, 0xf, 0xf, true);
    v += __builtin_amdgcn_update_dpp(0, v, 0x112, 0xf, 0xf, true);
    v += __builtin_amdgcn_update_dpp(0, v, 0x114, 0xf, 0xf, true);
    v += __builtin_amdgcn_update_dpp(0, v, 0x118, 0xf, 0xf, true);
    return __builtin_amdgcn_readlane(v, 15) + __builtin_amdgcn_readlane(v, 31) + __builtin_amdgcn_readlane(v, 47) + __builtin_amdgcn_readlane(v, 63);
}
template <int NJ>
__device__ __forceinline__ void dsa_select(const unsigned* scq, int nj, int lane, unsigned& T_out, int& cut_out) {
    unsigned kreg[NJ];
#pragma unroll
    for (int j = 0; j < NJ; ++j) kreg[j] = (j < nj) ? scq[j * 64 + lane] : 0u;
    unsigned T = 0u; bool exact = false;
    for (int bit = 31; bit >= 0; --bit) {
        const unsigned cand = T | (1u << bit);
        int c = 0;
#pragma unroll
        for (int j = 0; j < NJ; ++j) c += (kreg[j] >= cand) ? 1 : 0;
        const int cnt = wave_total_i(c);
        if (cnt >= 256) { T = cand; if (cnt == 256) { exact = true; break; } }
    }
    int cut = 0x7fffffff;
    if (!exact) {
        int cgt = 0, ceq = 0;
#pragma unroll
        for (int j = 0; j < NJ; ++j) { cgt += __popcll(__ballot(kreg[j] > T)); ceq += __popcll(__ballot(kreg[j] == T)); }
        int need = 256 - cgt;
        if (ceq > need) {
            bool found = false;
#pragma unroll
            for (int j = 0; j < NJ; ++j) {
                const unsigned long long m = __ballot(kreg[j] == T);
                const int cj = __popcll(m);
                if (!found) {
                    if (need <= cj) { for (int bpos = 0; bpos < 64; ++bpos) if ((m >> bpos) & 1ull) { if (--need == 0) { cut = j * 64 + bpos; break; } } found = true; }
                    else need -= cj;
                }
            }
        }
    }
    T_out = T; cut_out = cut;
}
__device__ __forceinline__ void ph_dsa_main(const Ctx& p, int l, float* smem) {
    const bf16_t* P = (const bf16_t*)(pws_() + WS_P);
    bf16_t* Y = (bf16_t*)(pws_() + WS_Y);
    const bf16_t* QN = (const bf16_t*)(pws_() + WS_QN);
    const bf16_t* KN = (const bf16_t*)(pws_() + WS_KN);
    const bf16_t* IKN = (const bf16_t*)(pws_() + WS_IKN);
    const bf16_t* VT = (const bf16_t*)(pws_() + WS_VT);
    unsigned* sc = (unsigned*)smem;
    float* part = smem;
    float* plsum = smem + 8 * 64 * 64;
    unsigned* thr = (unsigned*)(smem + 35000);
    for (int task = bid_(); task < MTOK / 16; task += nblk_()) {
        const int tid = tid_(), lane = tid & 63, w = tid >> 6, qi = lane & 15, g = lane >> 4;
        const int c = 31 - task / 128, b = (task >> 2) & 31, sub = task & 3;
        const int t0 = c * 64 + sub * 16, nk = (c + 1) * 64;
        const size_t tok0 = (size_t)b * SEQ + t0;
        const bool dosel = nk > 256;
        if (dosel) {
            BF8 iqf[8]; float wq[8];
#pragma unroll
            for (int h = 0; h < 8; ++h) {
                iqf[h].u = *(const uint4*)(P + (tok0 + qi) * LDP + PC_IQ + h * 32 + 8 * g);
                wq[h] = bf2f(P[(tok0 + qi) * LDP + PC_IW + h]) * 0.0625f;
            }
            BF8 kan; kan.u = *(const uint4*)(IKN + ((size_t)b * SEQ + w * 16 + qi) * 32 + 8 * g);
            for (int kt = w; kt < nk / 16; kt += 8) {
                const int s0 = kt * 16;
                BF8 ka = kan;
                { const int ktn = kt + 8 < nk / 16 ? kt + 8 : kt; kan.u = *(const uint4*)(IKN + ((size_t)b * SEQ + ktn * 16 + qi) * 32 + 8 * g); }
                float acc[4] = {0.f, 0.f, 0.f, 0.f};
#pragma unroll
                for (int h = 0; h < 8; ++h) {
                    const f32x4_t d = __builtin_amdgcn_mfma_f32_16x16x32_bf16(ka.v, iqf[h].v, (f32x4_t){0.f, 0.f, 0.f, 0.f}, 0, 0, 0);
#pragma unroll
                    for (int r = 0; r < 4; ++r) acc[r] = __builtin_fmaf(wq[h], fmaxf(d[r], 0.f), acc[r]);
                }
                uint4 kv; kv.x = ford(acc[0]); kv.y = ford(acc[1]); kv.z = ford(acc[2]); kv.w = ford(acc[3]);
                *(uint4*)(sc + qi * DSA_STRIDE + s0 + 4 * g) = kv;
            }
        }
        __syncthreads();
        if (dosel) {
            const int nj = nk >> 6;
#pragma unroll 1
            for (int qq = 0; qq < 2; ++qq) {
                const int q = 2 * w + qq;
                unsigned T; int cut;
                if (nj <= 8) dsa_select<8>(sc + q * DSA_STRIDE, nj, lane, T, cut);
                else if (nj <= 16) dsa_select<16>(sc + q * DSA_STRIDE, nj, lane, T, cut);
                else if (nj <= 24) dsa_select<24>(sc + q * DSA_STRIDE, nj, lane, T, cut);
                else dsa_select<32>(sc + q * DSA_STRIDE, nj, lane, T, cut);
                if (lane == 0) { thr[q] = T; thr[16 + q] = (unsigned)cut; }
            }
        }
        __syncthreads();
        unsigned Tq = 0u; int cutq = 0x7fffffff;
        if (dosel) { Tq = thr[qi]; cutq = (int)thr[16 + qi]; }
        f32x4_t oacc[4][4]; float lsum[4];
#pragma unroll
        for (int h = 0; h < 4; ++h) { lsum[h] = 0.f;
#pragma unroll
            for (int dt = 0; dt < 4; ++dt) oacc[h][dt] = (f32x4_t){0.f, 0.f, 0.f, 0.f}; }
        const int krow = 8 * (qi >> 2) + (qi & 3);
        BF8 kan[2][2], van[4];
#define DSA_KV(st_) do { const int s0_ = (st_) * 32; \
            _Pragma("unroll") for (int t = 0; t < 2; ++t) _Pragma("unroll") for (int s2 = 0; s2 < 2; ++s2) kan[t][s2].u = *(const uint4*)(KN + ((size_t)b * SEQ + s0_ + krow + 4 * t) * 64 + 32 * s2 + 8 * g); \
            _Pragma("unroll") for (int dt = 0; dt < 4; ++dt) van[dt].u = *(const uint4*)(VT + ((size_t)b * 64 + 16 * dt + qi) * SEQ + s0_ + 8 * g); } while (0)
        if (w < nk / 32) DSA_KV(w);
        for (int st = w; st < nk / 32; st += 8) {
            const int s0 = st * 32;
            BF8 ka[2][2], va[4];
#pragma unroll
            for (int t = 0; t < 2; ++t)
#pragma unroll
                for (int s2 = 0; s2 < 2; ++s2) ka[t][s2] = kan[t][s2];
#pragma unroll
            for (int dt = 0; dt < 4; ++dt) va[dt] = van[dt];
            { const int stn = st + 8 < nk / 32 ? st + 8 : st; DSA_KV(stn); }
            float mk[8];
            if (dosel) {
                const uint4 k0 = *(const uint4*)(sc + qi * DSA_STRIDE + s0 + 8 * g), k1 = *(const uint4*)(sc + qi * DSA_STRIDE + s0 + 8 * g + 4);
                const unsigned kk[8] = {k0.x, k0.y, k0.z, k0.w, k1.x, k1.y, k1.z, k1.w};
#pragma unroll
                for (int j = 0; j < 8; ++j) mk[j] = (kk[j] > Tq || (kk[j] == Tq && (s0 + 8 * g + j) <= cutq)) ? 1.f : 0.f;
            } else {
#pragma unroll
                for (int j = 0; j < 8; ++j) mk[j] = 1.f;
            }
#pragma unroll
            for (int h = 0; h < 4; ++h) {
                BF8 q0, q1;
                q0.u = *(const uint4*)(QN + (tok0 + qi) * 256 + h * 64 + 8 * g);
                q1.u = *(const uint4*)(QN + (tok0 + qi) * 256 + h * 64 + 32 + 8 * g);
                f32x4_t sacc[2];
#pragma unroll
                for (int t = 0; t < 2; ++t) {
                    sacc[t] = __builtin_amdgcn_mfma_f32_16x16x32_bf16(ka[t][0].v, q0.v, (f32x4_t){0.f, 0.f, 0.f, 0.f}, 0, 0, 0);
                    sacc[t] = __builtin_amdgcn_mfma_f32_16x16x32_bf16(ka[t][1].v, q1.v, sacc[t], 0, 0, 0);
                }
                float pe[8];
#pragma unroll
                for (int t = 0; t < 2; ++t)
#pragma unroll
                    for (int r = 0; r < 4; ++r) { pe[4 * t + r] = __expf(sacc[t][r]) * mk[4 * t + r]; lsum[h] += pe[4 * t + r]; }
                BF8 pf;
#pragma unroll
                for (int j = 0; j < 4; ++j) pf.w[j] = pk_bf16(pe[2 * j], pe[2 * j + 1]);
#pragma unroll
                for (int dt = 0; dt < 4; ++dt) oacc[h][dt] = __builtin_amdgcn_mfma_f32_16x16x32_bf16(va[dt].v, pf.v, oacc[h][dt], 0, 0, 0);
            }
        }
#undef DSA_KV
        __syncthreads();
#pragma unroll
        for (int h = 0; h < 4; ++h) {
            plsum[(w * 4 + h) * 64 + lane] = lsum[h];
#pragma unroll
            for (int dt = 0; dt < 4; ++dt)
#pragma unroll
                for (int r = 0; r < 4; ++r) part[(w * 64 + h * 16 + dt * 4 + r) * 64 + lane] = oacc[h][dt][r];
        }
        __syncthreads();
        {
            const int h = w >> 1;
            float lq = 0.f;
#pragma unroll
            for (int w2 = 0; w2 < 8; ++w2)
#pragma unroll
                for (int g2 = 0; g2 < 4; ++g2) lq += plsum[(w2 * 4 + h) * 64 + qi + 16 * g2];
            const float inv = 1.f / lq;
#pragma unroll
            for (int dd = 0; dd < 2; ++dd) {
                const int dt = (w & 1) * 2 + dd;
                float o[4];
#pragma unroll
                for (int r = 0; r < 4; ++r) {
                    float sacc = 0.f;
#pragma unroll
                    for (int w2 = 0; w2 < 8; ++w2) sacc += part[(w2 * 64 + h * 16 + dt * 4 + r) * 64 + lane];
                    o[r] = sacc * inv;
                }
                uint2 ov; ov.x = pk_bf16(o[0], o[1]); ov.y = pk_bf16(o[2], o[3]);
                *(uint2*)(Y + (tok0 + qi) * DM + 768 + h * 64 + 16 * dt + 4 * g) = ov;
            }
        }
        __syncthreads();
    }
}

__device__ __forceinline__ void ph_mem_prep(const Ctx& p, int l) {
    const float* Km = (const float*)(pws_() + WS_KM);
    const float* Vm = (const float*)(pws_() + WS_VM);
    bf16_t* KB = (bf16_t*)(pws_() + WS_KB);
    bf16_t* VTB = (bf16_t*)(pws_() + WS_VTB);
    const float* kg = pin_(28) + (size_t)l * 64;
    const int lane = tid_() & 63;
    for (int r = gwave(); r < MMEM; r += nwaves()) {
        const int b = r / NMEM, j = r % NMEM;
#pragma unroll
        for (int h = 0; h < 4; ++h) {
            const float v = Km[(size_t)r * 256 + h * 64 + lane];
            const float ss = wave_sum(v * v);
            KB[(((size_t)b * 4 + h) * NMEM + j) * 64 + lane] = f2bf(v * rsqrtf(ss * (1.f / 64.f) + EPS) * kg[lane]);
            VTB[(((size_t)b * 4 + h) * 64 + lane) * NMEM + j] = f2bf(Vm[(size_t)r * 256 + h * 64 + lane]);
        }
    }
}
__device__ __forceinline__ void ph_xattn(const Ctx& p, int l, int task0 = 0, int ntask = MTOK / 16, int w0 = -1, int wstep = 0) {
    const float* Qx = (const float*)(pws_() + WS_QX);
    bf16_t* Ox = (bf16_t*)(pws_() + WS_OX);
    const bf16_t* KB = (const bf16_t*)(pws_() + WS_KB);
    const bf16_t* VTB = (const bf16_t*)(pws_() + WS_VTB);
    const float* qg = pin_(27) + (size_t)l * 64;
    const int lane = tid_() & 63, qi = lane & 15, g = lane >> 4;
    if (w0 < 0) { w0 = gwave(); wstep = nwaves(); }
    for (int task = task0 + w0; task < task0 + ntask; task += wstep) {
        const int tok0 = task * 16, b = tok0 / SEQ;
#pragma unroll 1
        for (int h = 0; h < 4; ++h) {
            BF8 qf[2];
            {
                float qv[2][8]; float ss = 0.f;
#pragma unroll
                for (int s2 = 0; s2 < 2; ++s2) {
                    const float4* qp = (const float4*)(Qx + (size_t)(tok0 + qi) * 256 + h * 64 + 32 * s2 + 8 * g);
                    const float4 a = qp[0], c = qp[1];
                    qv[s2][0] = a.x; qv[s2][1] = a.y; qv[s2][2] = a.z; qv[s2][3] = a.w; qv[s2][4] = c.x; qv[s2][5] = c.y; qv[s2][6] = c.z; qv[s2][7] = c.w;
#pragma unroll
                    for (int j = 0; j < 8; ++j) ss += qv[s2][j] * qv[s2][j];
                }
                ss += __shfl_xor(ss, 16, 64); ss += __shfl_xor(ss, 32, 64);
                const float rs = rsqrtf(ss * (1.f / 64.f) + EPS) * 0.125f;
#pragma unroll
                for (int s2 = 0; s2 < 2; ++s2) {
                    const float4 g0 = *(const float4*)(qg + 32 * s2 + 8 * g), g1 = *(const float4*)(qg + 32 * s2 + 8 * g + 4);
                    qf[s2].w[0] = pk_bf16(qv[s2][0] * rs * g0.x, qv[s2][1] * rs * g0.y); qf[s2].w[1] = pk_bf16(qv[s2][2] * rs * g0.z, qv[s2][3] * rs * g0.w);
                    qf[s2].w[2] = pk_bf16(qv[s2][4] * rs * g1.x, qv[s2][5] * rs * g1.y); qf[s2].w[3] = pk_bf16(qv[s2][6] * rs * g1.z, qv[s2][7] * rs * g1.w);
                }
            }
            const bf16_t* Kh = KB + ((size_t)b * 4 + h) * NMEM * 64;
            const bf16_t* Vh = VTB + ((size_t)b * 4 + h) * 64 * NMEM;
            f32x4_t oacc[4];
#pragma unroll
            for (int dt = 0; dt < 4; ++dt) oacc[dt] = (f32x4_t){0.f, 0.f, 0.f, 0.f};
            float lsum = 0.f;
            const int krow = 8 * (qi >> 2) + (qi & 3);
#pragma unroll 2
            for (int s0 = 0; s0 < NMEM; s0 += 32) {
                BF8 ka[2][2], va[4];
#pragma unroll
                for (int t = 0; t < 2; ++t)
#pragma unroll
                    for (int s2 = 0; s2 < 2; ++s2) ka[t][s2].u = *(const uint4*)(Kh + (size_t)(s0 + krow + 4 * t) * 64 + 32 * s2 + 8 * g);
#pragma unroll
                for (int dt = 0; dt < 4; ++dt) va[dt].u = *(const uint4*)(Vh + (size_t)(16 * dt + qi) * NMEM + s0 + 8 * g);
                f32x4_t sacc[2];
#pragma unroll
                for (int t = 0; t < 2; ++t) {
                    sacc[t] = (f32x4_t){0.f, 0.f, 0.f, 0.f};
                    sacc[t] = __builtin_amdgcn_mfma_f32_16x16x32_bf16(ka[t][0].v, qf[0].v, sacc[t], 0, 0, 0);
                    sacc[t] = __builtin_amdgcn_mfma_f32_16x16x32_bf16(ka[t][1].v, qf[1].v, sacc[t], 0, 0, 0);
                }
                float pe[8];
#pragma unroll
                for (int t = 0; t < 2; ++t)
#pragma unroll
                    for (int r = 0; r < 4; ++r) { pe[4 * t + r] = __expf(sacc[t][r]); lsum += pe[4 * t + r]; }
                BF8 pf;
#pragma unroll
                for (int j = 0; j < 4; ++j) pf.w[j] = pk_bf16(pe[2 * j], pe[2 * j + 1]);
#pragma unroll
                for (int dt = 0; dt < 4; ++dt) oacc[dt] = __builtin_amdgcn_mfma_f32_16x16x32_bf16(va[dt].v, pf.v, oacc[dt], 0, 0, 0);
            }
            lsum += __shfl_xor(lsum, 16, 64); lsum += __shfl_xor(lsum, 32, 64);
            const float inv = 1.f / lsum;
#pragma unroll
            for (int dt = 0; dt < 4; ++dt) {
                uint2 o; o.x = pk_bf16(oacc[dt][0] * inv, oacc[dt][1] * inv); o.y = pk_bf16(oacc[dt][2] * inv, oacc[dt][3] * inv);
                *(uint2*)(Ox + (size_t)(tok0 + qi) * 256 + h * 64 + 16 * dt + 4 * g) = o;
            }
        }
    }
}

template <int N> __device__ __forceinline__ void bitonic_sort_desc(unsigned (&a)[N]) {
#pragma unroll
    for (int k = 2; k <= N; k <<= 1)
#pragma unroll
        for (int j = k >> 1; j > 0; j >>= 1)
#pragma unroll
            for (int i = 0; i < N; ++i) {
                const int o = i ^ j;
                if (o > i) {
                    const bool desc = ((i & k) == 0);
                    const unsigned x = a[i], y = a[o];
                    const unsigned mx = x > y ? x : y, mn = x > y ? y : x;
                    a[i] = desc ? mx : mn; a[o] = desc ? mn : mx;
                }
            }
}
__device__ __forceinline__ void bitonic_merge16_desc(unsigned (&a)[16]) {
#pragma unroll
    for (int j = 8; j > 0; j >>= 1)
#pragma unroll
        for (int i = 0; i < 16; ++i) {
            const int o = i ^ j;
            if (o > i) { const unsigned x = a[i], y = a[o]; a[i] = x > y ? x : y; a[o] = x > y ? y : x; }
        }
}
__device__ __forceinline__ void top16_merge(unsigned (&a)[16], const unsigned (&b)[16]) {
#pragma unroll
    for (int i = 0; i < 16; ++i) a[i] = a[i] > b[15 - i] ? a[i] : b[15 - i];
    bitonic_merge16_desc(a);
}
__device__ __forceinline__ void top16_xlane(unsigned (&a)[16], int xm) {
    unsigned b[16];
#pragma unroll
    for (int i = 0; i < 16; ++i) b[i] = (unsigned)__shfl_xor((int)a[i], xm, 64);
    top16_merge(a, b);
}
__device__ __forceinline__ void ph_subkeys_convert(const Ctx& p) {
    const float* sk = pin_(31);
    bf16_t* o = (bf16_t*)(pws_() + WS_SKB);
    const size_t n = (size_t)DEPTH * 8 * 2 * 128 * 64;
    for (size_t i = (size_t)bid_() * 512 + tid_(); i < n; i += (size_t)nblk_() * 512) o[i] = f2bf(sk[i]);
}
__device__ __forceinline__ void ph_peer_topk(const Ctx& p, int l, float* smem, int task0 = 0, int ntask = MTOK / 16, int w0 = -1, int wstep = 0) {
    const bf16_t* Qp = (const bf16_t*)(pws_() + WS_QP);
    const bf16_t* SK = (const bf16_t*)(pws_() + WS_SKB) + (size_t)l * 8 * 2 * 128 * 64;
    int* pidx = (int*)(pws_() + WS_PEI);
    float* pgt = (float*)(pws_() + WS_PEG);
    float* pus = (float*)(pws_() + WS_PUS);
    const float* usc = (const float*)(pws_() + WS_USC) + (size_t)l * NEXP;
    const float* vsc = (const float*)(pws_() + WS_VSC) + (size_t)l * NEXP;
    const int tid = tid_(), lane = tid & 63, wave = tid >> 6, qi = lane & 15, g = lane >> 4;
    int* tabw = (int*)smem + wave * 512 + qi * 32;
    if (w0 < 0) { w0 = gwave(); wstep = nwaves(); }
    for (int task = task0 + w0; task < task0 + ntask; task += wstep) {
        const size_t tok = (size_t)task * 16 + qi;
#pragma unroll 1
        for (int h = 0; h < 8; ++h) {
            unsigned L[2][16];
#pragma unroll
            for (int pp = 0; pp < 2; ++pp) {
                BF8 qf[2];
#pragma unroll
                for (int s2 = 0; s2 < 2; ++s2) qf[s2].u = *(const uint4*)(Qp + tok * DM + h * 128 + pp * 64 + 32 * s2 + 8 * g);
                const bf16_t* skp = SK + (size_t)(h * 2 + pp) * 128 * 64;
                unsigned va[16], vb[16];
                BF8 kall[8][2];
#pragma unroll
                for (int tile = 0; tile < 8; ++tile)
#pragma unroll
                    for (int s2 = 0; s2 < 2; ++s2) kall[tile][s2].u = *(const uint4*)(skp + (size_t)(16 * tile + qi) * 64 + 32 * s2 + 8 * g);
                __builtin_amdgcn_sched_barrier(0);
#pragma unroll
                for (int tile = 0; tile < 8; ++tile) {
                    f32x4_t d = __builtin_amdgcn_mfma_f32_16x16x32_bf16(kall[tile][0].v, qf[0].v, (f32x4_t){0.f, 0.f, 0.f, 0.f}, 0, 0, 0);
                    d = __builtin_amdgcn_mfma_f32_16x16x32_bf16(kall[tile][1].v, qf[1].v, d, 0, 0, 0);
#pragma unroll
                    for (int r = 0; r < 4; ++r) {
                        const unsigned key = (ford(d[r]) & ~127u) | (unsigned)(127 - (16 * tile + 4 * g + r));
                        if (tile < 4) va[tile * 4 + r] = key; else vb[(tile - 4) * 4 + r] = key;
                    }
                }
                bitonic_sort_desc<16>(va);
                bitonic_sort_desc<16>(vb);
                top16_merge(va, vb);
                top16_xlane(va, 16);
                top16_xlane(va, 32);
#pragma unroll
                for (int i = 0; i < 16; ++i) L[pp][i] = va[i];
            }
            if (g < 2) {
#pragma unroll
                for (int i = 0; i < 16; ++i) tabw[g * 16 + i] = 127 - (int)((g == 0 ? L[0][i] : L[1][i]) & 127u);
            }
            float s1[16], s2v[16];
#pragma unroll
            for (int i = 0; i < 16; ++i) { s1[i] = funord(L[0][i] & ~127u); s2v[i] = funord(L[1][i] & ~127u); }
            unsigned ca[16], cb[16];
#pragma unroll
            for (int i = 0; i < 16; ++i) { ca[i] = 0u; cb[i] = 0u; }
            {
                const float r0 = g == 0 ? s1[0] : (g == 1 ? s1[1] : (g == 2 ? s1[2] : s1[3]));
                const int nb0 = g == 0 ? 16 : (g == 1 ? 8 : (g == 2 ? 5 : 4));
#pragma unroll
                for (int bq = 0; bq < 16; ++bq) if (bq < nb0) ca[bq] = (ford(r0 + s2v[bq]) & ~255u) | (unsigned)(255 - (g * 16 + bq));
                const float r1 = g == 0 ? s1[4] : (g == 1 ? s1[5] : (g == 2 ? s1[6] : s1[7]));
                const int nb1 = g == 0 ? 3 : 2;
#pragma unroll
                for (int bq = 0; bq < 3; ++bq) if (bq < nb1) cb[bq] = (ford(r1 + s2v[bq]) & ~255u) | (unsigned)(255 - ((g + 4) * 16 + bq));
                const float r2 = g == 0 ? s1[8] : (g == 1 ? s1[9] : (g == 2 ? s1[10] : s1[11]));
                cb[3] = (ford(r2 + s2v[0]) & ~255u) | (unsigned)(255 - ((g + 8) * 16));
                const float r3 = g == 0 ? s1[12] : (g == 1 ? s1[13] : (g == 2 ? s1[14] : s1[15]));
                cb[4] = (ford(r3 + s2v[0]) & ~255u) | (unsigned)(255 - ((g + 12) * 16));
            }
            bitonic_sort_desc<16>(ca);
            bitonic_sort_desc<16>(cb);
            top16_merge(ca, cb);
            top16_xlane(ca, 16);
            top16_xlane(ca, 32);
            float tv[16]; float den = 0.f;
#pragma unroll
            for (int i = 0; i < 16; ++i) {
                const int f = 255 - (int)(ca[i] & 255u);
                const int a = f >> 4, bq = f & 15;
                tv[i] = funord(ca[i] & ~255u);
                (void)a; (void)bq;
            }
#pragma unroll
            for (int i = 0; i < 16; ++i) { tv[i] = __expf(tv[i] - funord(ca[0] & ~255u)); den += tv[i]; }
            const float inv = 1.f / den;
            int ev[4]; float gv[4];
#pragma unroll
            for (int r = 0; r < 4; ++r) {
                const unsigned key = g == 0 ? ca[r] : (g == 1 ? ca[4 + r] : (g == 2 ? ca[8 + r] : ca[12 + r]));
                const float tvv = g == 0 ? tv[r] : (g == 1 ? tv[4 + r] : (g == 2 ? tv[8 + r] : tv[12 + r]));
                const int f = 255 - (int)(key & 255u);
                ev[r] = tabw[f >> 4] * 128 + tabw[16 + (f & 15)];
                gv[r] = tvv * inv;
            }
            float us[4];
#pragma unroll
            for (int r = 0; r < 4; ++r) { us[r] = usc[ev[r]]; gv[r] *= vsc[ev[r]]; }
            *(int4*)(pidx + tok * 128 + h * 16 + 4 * g) = make_int4(ev[0], ev[1], ev[2], ev[3]);
            *(float4*)(pgt + tok * 128 + h * 16 + 4 * g) = make_float4(gv[0], gv[1], gv[2], gv[3]);
            *(float4*)(pus + tok * 128 + h * 16 + 4 * g) = make_float4(us[0], us[1], us[2], us[3]);
        }
    }
}

typedef float f32x2_t __attribute__((ext_vector_type(2)));
typedef int i32x8_t __attribute__((ext_vector_type(8)));
__device__ __forceinline__ unsigned pack4_fp8(float4 a, float sc) {
    const float x = fminf(fmaxf(a.x * sc, -448.f), 448.f), y = fminf(fmaxf(a.y * sc, -448.f), 448.f);
    const float z = fminf(fmaxf(a.z * sc, -448.f), 448.f), w = fminf(fmaxf(a.w * sc, -448.f), 448.f);
    int r = __builtin_amdgcn_cvt_pk_fp8_f32(x, y, 0, false);
    r = __builtin_amdgcn_cvt_pk_fp8_f32(z, w, r, true);
    return (unsigned)r;
}
__device__ __forceinline__ unsigned q4_e2m1(float y) {
    const float a = fabsf(y);
    const unsigned c = (unsigned)(a > 0.25f) + (unsigned)(a > 0.75f) + (unsigned)(a > 1.25f) + (unsigned)(a > 1.75f) + (unsigned)(a > 2.5f) + (unsigned)(a > 3.5f) + (unsigned)(a > 5.0f);
    return c | (y < 0.f ? 8u : 0u);
}
__device__ __forceinline__ void ph_tab_convert_all(const Ctx& p) {
    const int lane = tid_() & 63;
    for (int row = gwave(); row < 2 * DEPTH * NEXP; row += nwaves()) {
        const int tabv = row >= DEPTH * NEXP;
        const int rr = tabv ? row - DEPTH * NEXP : row;
        const float4* src = (const float4*)((tabv ? pin_(33) : pin_(32)) + (size_t)rr * DM);
        float4 v[4]; float am = 0.f;
#pragma unroll
        for (int i = 0; i < 4; ++i) { v[i] = src[lane + 64 * i]; am = fmaxf(am, fmaxf(fmaxf(fabsf(v[i].x), fabsf(v[i].y)), fmaxf(fabsf(v[i].z), fabsf(v[i].w)))); }
        am = wave_max(am);
        const float sc = am > 0.f ? am * (1.f / 6.f) : 1.f, inv = 1.f / sc;
        unsigned char* dst = (unsigned char*)(pws_() + (tabv ? WS_V4 : WS_U4)) + (size_t)rr * 512;
#pragma unroll
        for (int i = 0; i < 4; ++i) {
            const unsigned pk = q4_e2m1(v[i].x * inv) | (q4_e2m1(v[i].y * inv) << 4) | (q4_e2m1(v[i].z * inv) << 8) | (q4_e2m1(v[i].w * inv) << 12);
            const int off = tabv ? 16 * (lane >> 1) + 4 * i + 2 * (lane & 1) : 128 * i + 2 * lane;
            *(unsigned short*)(dst + off) = (unsigned short)pk;
        }
        if (lane == 0) ((float*)(pws_() + (tabv ? WS_VSC : WS_USC)))[rr] = sc;
    }
}
__device__ __forceinline__ float dpp_xor1(float v) { return __int_as_float(__builtin_amdgcn_update_dpp(0, __float_as_int(v), 0xB1, 0xF, 0xF, true)); }
__device__ __forceinline__ void ph_peer_u4(const Ctx& p, int l, float* smem) {
    const unsigned char* ut = (const unsigned char*)(pws_() + WS_U4) + (size_t)l * NEXP * 512;
    const int* pidx = (const int*)(pws_() + WS_PEI);
    float* pgt = (float*)(pws_() + WS_PEG);
    const float* pus = (const float*)(pws_() + WS_PUS);
    const unsigned char* H8 = (const unsigned char*)(pws_() + WS_H8);
    const int lane = tid_() & 63, g = lane >> 4, i = lane & 15, wave = tid_() >> 6;
    const bool odd = i & 1;
    unsigned char* hl = (unsigned char*)smem + wave * 2048;
    const int nw = nwaves();
    int tok = gwave();
    int ne0 = pidx[(size_t)tok * 128 + lane], ne1 = pidx[(size_t)tok * 128 + 64 + lane];
    *(uint4*)(hl + 16 * lane) = *(const uint4*)(H8 + (size_t)tok * DM + 16 * lane);
    uint4 rA[8], rB[8], rC[8], rD[8];
    const int roff = 64 * (i & 1) + 16 * g;
#define PU_ROWS(buf, esrc, hq) do { const int ea_ = __builtin_amdgcn_ds_bpermute(((hq) * 16 + (i >> 1)) * 4, esrc), eb_ = __builtin_amdgcn_ds_bpermute(((hq) * 16 + 8 + (i >> 1)) * 4, esrc); \
        const unsigned char* pa_ = ut + (size_t)ea_ * 512 + roff; const unsigned char* pb_ = ut + (size_t)eb_ * 512 + roff; \
        _Pragma("unroll") for (int q_ = 0; q_ < 4; ++q_) { buf[q_] = *(const uint4*)(pa_ + 128 * q_); buf[4 + q_] = *(const uint4*)(pb_ + 128 * q_); } \
        __builtin_amdgcn_sched_barrier(0); } while (0)
#define PU_COMP(buf, hd) do { f32x4_t a0_ = {0.f, 0.f, 0.f, 0.f}, a1_ = {0.f, 0.f, 0.f, 0.f}; \
        _Pragma("unroll") for (int q_ = 0; q_ < 4; ++q_) { \
            const uint4 b0_ = *(const uint4*)(hb + 256 * q_), b1_ = *(const uint4*)(hb + 256 * q_ + 64); \
            const i32x8_t b_ = {(int)b0_.x, (int)b0_.y, (int)b0_.z, (int)b0_.w, (int)b1_.x, (int)b1_.y, (int)b1_.z, (int)b1_.w}; \
            const i32x8_t x_ = {(int)buf[q_].x, (int)buf[q_].y, (int)buf[q_].z, (int)buf[q_].w, 0, 0, 0, 0}; \
            const i32x8_t y_ = {(int)buf[4 + q_].x, (int)buf[4 + q_].y, (int)buf[4 + q_].z, (int)buf[4 + q_].w, 0, 0, 0, 0}; \
            a0_ = __builtin_amdgcn_mfma_scale_f32_16x16x128_f8f6f4(x_, b_, a0_, 4, 0, 0, 0, 0, 0); \
            a1_ = __builtin_amdgcn_mfma_scale_f32_16x16x128_f8f6f4(y_, b_, a1_, 4, 0, 0, 0, 0, 0); \
            __builtin_amdgcn_sched_barrier(0); } \
        float t0a_ = odd ? a0_[1] : a0_[0], t0b_ = odd ? a0_[3] : a0_[2], t1a_ = odd ? a1_[1] : a1_[0], t1b_ = odd ? a1_[3] : a1_[2]; \
        t0a_ += dpp_xor1(t0a_); t0b_ += dpp_xor1(t0b_); t1a_ += dpp_xor1(t1a_); t1b_ += dpp_xor1(t1b_); \
        if ((i >> 1) == (hd)) { keep0 = odd ? t1a_ : t0a_; keep1 = odd ? t1b_ : t0b_; } \
        __builtin_amdgcn_sched_barrier(0); } while (0)
    PU_ROWS(rA, ne0, 0); PU_ROWS(rB, ne0, 1); PU_ROWS(rC, ne0, 2);
    int par = 0;
    for (; tok < MTOK; tok += nw, par ^= 1) {
        const int e0 = ne0, e1 = ne1;
        const size_t tn = (size_t)(tok + nw < MTOK ? tok + nw : tok);
        const uint4 hnext = *(const uint4*)(H8 + tn * DM + 16 * lane);
        ne0 = pidx[tn * 128 + lane]; ne1 = pidx[tn * 128 + 64 + lane];
        const size_t mi = (size_t)tok * 128 + (i >> 1) * 16 + 8 * (i & 1) + 2 * g;
        const float2 gm = *(const float2*)(pgt + mi), um = *(const float2*)(pus + mi);
        asm volatile("s_waitcnt lgkmcnt(0)" ::: "memory"); __builtin_amdgcn_wave_barrier();
        const unsigned char* hb = hl + par * 1024 + 128 * (i & 1) + 16 * g;
        float keep0 = 0.f, keep1 = 0.f;
        PU_ROWS(rD, e0, 3); PU_COMP(rA, 0);
        PU_ROWS(rA, e1, 0); PU_COMP(rB, 1);
        PU_ROWS(rB, e1, 1); PU_COMP(rC, 2);
        PU_ROWS(rC, e1, 2); PU_COMP(rD, 3);
        PU_ROWS(rD, e1, 3); PU_COMP(rA, 4);
        PU_ROWS(rA, ne0, 0); PU_COMP(rB, 5);
        PU_ROWS(rB, ne0, 1); PU_COMP(rC, 6);
        PU_ROWS(rC, ne0, 2); PU_COMP(rD, 7);
        *(uint4*)(hl + (par ^ 1) * 1024 + 16 * lane) = hnext;
        float2 o;
        o.x = gm.x * gelu_tanh_f(keep0 * um.x * (1.f / H8_SCALE)); o.y = gm.y * gelu_tanh_f(keep1 * um.y * (1.f / H8_SCALE));
        *(float2*)(pgt + mi) = o;
    }
#undef PU_ROWS
#undef PU_COMP
}
template <bool NORM>
__device__ __forceinline__ void ph_peer_v4(const Ctx& p, int l) {
    const unsigned char* vt = (const unsigned char*)(pws_() + WS_V4) + (size_t)l * NEXP * 512;
    const int* pidx = (const int*)(pws_() + WS_PEI);
    const float* pgt = (const float*)(pws_() + WS_PEG);
    float* x = pout_();
    const int lane = tid_() & 63;
    const bool r = lane & 32;
    const int coff = 16 * (lane & 31);
    const int nw = nwaves();
    int tok = gwave();
    int ne0 = pidx[(size_t)tok * 128 + lane], ne1 = pidx[(size_t)tok * 128 + 64 + lane];
    float nc0 = pgt[(size_t)tok * 128 + lane], nc1 = pgt[(size_t)tok * 128 + 64 + lane];
    uint4 vA[16], vB[16];
    const int hsel = r ? 4 : 0;
    float4 gn[4];
    if (NORM) {
#pragma unroll
        for (int q = 0; q < 4; ++q) gn[q] = *(const float4*)(pin_(2) + (size_t)(l + 1) * DM + 256 * q + 8 * (lane & 31) + (r ? 4 : 0));
    }
#define PV_ROWS(buf, esrc, lb) do { _Pragma("unroll") for (int k_ = 0; k_ < 16; ++k_) { \
        const int e_ = __builtin_amdgcn_ds_bpermute(hsel + 4 * ((lb) + 2 * k_), esrc);        \
        buf[k_] = *(const uint4*)(vt + (size_t)e_ * 512 + coff); } __builtin_amdgcn_sched_barrier(0); } while (0)
#define PV_D4(W, q) do { \
        out[4 * (q) + 0] = __builtin_elementwise_fma(__builtin_amdgcn_cvt_scalef32_pk_f32_fp4(W, 1.0f, 0), c2_, out[4 * (q) + 0]); \
        out[4 * (q) + 1] = __builtin_elementwise_fma(__builtin_amdgcn_cvt_scalef32_pk_f32_fp4(W, 1.0f, 1), c2_, out[4 * (q) + 1]); \
        out[4 * (q) + 2] = __builtin_elementwise_fma(__builtin_amdgcn_cvt_scalef32_pk_f32_fp4(W, 1.0f, 2), c2_, out[4 * (q) + 2]); \
        out[4 * (q) + 3] = __builtin_elementwise_fma(__builtin_amdgcn_cvt_scalef32_pk_f32_fp4(W, 1.0f, 3), c2_, out[4 * (q) + 3]); } while (0)
#define PV_COMP(buf, csrc, lb) do { _Pragma("unroll") for (int k_ = 0; k_ < 16; ++k_) { \
        const float cj_ = __int_as_float(__builtin_amdgcn_ds_bpermute(hsel + 4 * ((lb) + 2 * k_), __float_as_int(csrc))); const f32x2_t c2_ = {cj_, cj_}; \
        PV_D4(buf[k_].x, 0); PV_D4(buf[k_].y, 1); PV_D4(buf[k_].z, 2); PV_D4(buf[k_].w, 3); } __builtin_amdgcn_sched_barrier(0); } while (0)
    PV_ROWS(vA, ne0, 0);
    for (; tok < MTOK; tok += nw) {
        const int e0 = ne0, e1 = ne1;
        const float c0 = nc0, c1 = nc1;
        {
            const size_t tn = (size_t)(tok + nw < MTOK ? tok + nw : tok);
            ne0 = pidx[tn * 128 + lane]; ne1 = pidx[tn * 128 + 64 + lane];
            nc0 = pgt[tn * 128 + lane]; nc1 = pgt[tn * 128 + 64 + lane];
        }
        f32x2_t out[16];
#pragma unroll
        for (int k = 0; k < 16; ++k) out[k] = (f32x2_t){0.f, 0.f};
        PV_ROWS(vB, e0, 32); PV_COMP(vA, c0, 0);
        PV_ROWS(vA, e1, 0);  PV_COMP(vB, c0, 32);
        PV_ROWS(vB, e1, 32); PV_COMP(vA, c1, 0);
        PV_ROWS(vA, ne0, 0); PV_COMP(vB, c1, 32);
        float4 xn[4]; float ss = 0.f;
#pragma unroll
        for (int q = 0; q < 4; ++q) {
            float fin[4];
#pragma unroll
            for (int b = 0; b < 2; ++b)
#pragma unroll
                for (int c = 0; c < 2; ++c) {
                    const float lo = out[4 * q + b][c], hi = out[4 * q + 2 + b][c];
                    const float mine = r ? hi : lo, send = r ? lo : hi;
                    fin[2 * b + c] = mine + __shfl_xor(send, 32, 64);
                }
            float4* xp = (float4*)(x + (size_t)tok * DM + 256 * q + 8 * (lane & 31) + (r ? 4 : 0));
            float4 a = *xp;
            a.x += fin[0]; a.y += fin[1]; a.z += fin[2]; a.w += fin[3];
            *xp = a;
            if (NORM) { xn[q] = a; ss += a.x * a.x + a.y * a.y + a.z * a.z + a.w * a.w; }
        }
        if (NORM) {
            ss = wave_sum(ss);
            const float rs = rsqrtf(ss * (1.f / DM) + EPS);
            bf16_t* hrow = (bf16_t*)(pws_() + WS_H) + (size_t)tok * DM + 8 * (lane & 31) + (r ? 4 : 0);
#pragma unroll
            for (int q = 0; q < 4; ++q) {
                uint2 o; o.x = pk_bf16(xn[q].x * rs * gn[q].x, xn[q].y * rs * gn[q].y); o.y = pk_bf16(xn[q].z * rs * gn[q].z, xn[q].w * rs * gn[q].w);
                *(uint2*)(hrow + 256 * q) = o;
            }
        }
    }
#undef PV_ROWS
#undef PV_COMP
#undef PV_D4
}


#ifndef PROBE_MASK
#define PROBE_MASK 0
#endif
#if PROBE_MASK
#define GB(k) do { GRID_BARRIER(); const unsigned long long now_ = wall_clock64(); if ((PROBE_MASK >> (k)) & 1) { const unsigned long long dt_ = now_ - tprev_; while (wall_clock64() - now_ < 3ull * dt_) __builtin_amdgcn_s_sleep(8); } GRID_BARRIER(); tprev_ = wall_clock64(); } while (0)
#else
#define GB(k) GRID_BARRIER()
#endif
__global__ void __launch_bounds__(512, 2) k_mega(Params kp) {
    float* sm = dynsmem;
    {
        unsigned long long* tab = (unsigned long long*)((char*)dynsmem + PTAB_OFF);
        if (threadIdx.x < 34) tab[threadIdx.x] = (unsigned long long)kp.in[threadIdx.x];
        if (threadIdx.x == 34) tab[34] = (unsigned long long)kp.out;
        if (threadIdx.x == 35) tab[35] = (unsigned long long)kp.ws;
        if (threadIdx.x == 36) { tab[36] = 0ull; tab[37] = 0ull; }
    }
    __syncthreads();
    Ctx p; p.kp = &kp;
    (void)xcd_barrier_post((unsigned*)(pws_() + WS_BAR), (volatile LAS unsigned*)((char*)dynsmem + PTAB_OFF + 36 * 8));
#define GRID_BARRIER() do { XcdBarrier bar_; bar_.bar = (unsigned*)(pws_() + WS_BAR); bar_.x = xb_xcc_id(); bar_.st = (volatile LAS unsigned*)((char*)dynsmem + PTAB_OFF + 36 * 8); xcd_barrier(bar_); } while (0)
    ph_weight_prep(p, sm);
    ph_subkeys_convert(p);
    ph_tab_convert_all(p);
    ph_rmsnorm(pin_(0), pin_(2), (bf16_t*)(pws_() + WS_H), MTOK);
    ph_rmsnorm(pin_(1), pin_(22), (bf16_t*)(pws_() + WS_HM), MMEM);
    GRID_BARRIER();
#if PROBE_MASK
    unsigned long long tprev_ = wall_clock64();
#endif
#pragma unroll 1
    for (int l = 0; l < DEPTH; ++l) {
#define XIN_ (l == 0 ? pin_(0) : pout_())
#define HBUF_ ((const bf16_t*)(pws_() + WS_H))
        { pg8::EpiBf16 E; E.O = (bf16_t*)(pws_() + WS_P); E.ldc = LDP; ph_gemm(HBUF_, (const bf16_t*)(pws_() + WT_IN) + (size_t)l * LDP * DM, MTOK, LDP, DM, E); }
        { pg8::EpiF32 E; E.C = (float*)(pws_() + WS_KM); E.R = nullptr; E.ldc = 256; ph_gemm((const bf16_t*)(pws_() + WS_HM), (const bf16_t*)(pws_() + WT_XK) + (size_t)l * 256 * DM, MMEM, 256, DM, E, 32); }
        { pg8::EpiF32 E; E.C = (float*)(pws_() + WS_VM); E.R = nullptr; E.ldc = 256; ph_gemm((const bf16_t*)(pws_() + WS_HM), (const bf16_t*)(pws_() + WT_XV) + (size_t)l * 256 * DM, MMEM, 256, DM, E, 64); }
        GB(2);
        ph_mem_prep(p, l);
        ph_dsa_prep(p, l);
        ph_scan_prep(p, l);
        GB(3);
        ph_scans(p, l, sm);
        GB(4);
        ph_mixer_finish(p, l);
        ph_dsa_main(p, l, sm);
        GB(5);
#define PANEL_SYNC() do { asm volatile("s_waitcnt vmcnt(0) lgkmcnt(0)" ::: "memory"); __syncthreads(); \
        if (threadIdx.x < 64) { __builtin_amdgcn_fence(__ATOMIC_ACQUIRE, "agent"); asm volatile("s_waitcnt vmcnt(0)" ::: "memory"); } \
        __syncthreads(); } while (0)
        { pg8::EpiF32 E; E.C = pout_(); E.R = XIN_; E.ldc = DM; ph_gemm((const bf16_t*)(pws_() + WS_Y), (const bf16_t*)(pws_() + WT_OUT) + (size_t)l * DM * DM, MTOK, DM, DM, E); }
        GB(6);
        if (nblk_() == MTOK / 256) {
            const int pm = bid_(), wv = tid_() >> 6;
            ph_rmsnorm(pout_(), pin_(21) + (size_t)l * DM, (bf16_t*)(pws_() + WS_H), 256, pm * 256, wv, 8);
            PANEL_SYNC();
            { pg8::EpiF32 E; E.C = (float*)(pws_() + WS_QX); E.R = nullptr; E.ldc = 256; ph_gemm_panel(HBUF_, (const bf16_t*)(pws_() + WT_XQ) + (size_t)l * 256 * DM, MTOK, 256, DM, E, pm); }
            PANEL_SYNC();
            ph_xattn(p, l, pm * 16, 16, wv, 8);
            PANEL_SYNC();
            { pg8::EpiF32 E; E.C = pout_(); E.R = pout_(); E.ldc = DM; ph_gemm_panel((const bf16_t*)(pws_() + WS_OX), (const bf16_t*)(pws_() + WT_XO) + (size_t)l * DM * 256, MTOK, DM, 256, E, pm); }
            PANEL_SYNC();
            ph_rmsnorm(pout_(), pin_(29) + (size_t)l * DM, (bf16_t*)(pws_() + WS_H), 256, pm * 256, wv, 8, (unsigned char*)(pws_() + WS_H8));
            PANEL_SYNC();
            { pg8::EpiBf16 E; E.O = (bf16_t*)(pws_() + WS_QP); E.ldc = DM; ph_gemm_panel(HBUF_, (const bf16_t*)(pws_() + WT_PQ) + (size_t)l * DM * DM, MTOK, DM, DM, E, pm); }
            PANEL_SYNC();
            ph_peer_topk(p, l, sm, pm * 16, 16, wv, 8);
        }
        GB(13);
        ph_peer_u4(p, l, sm);
        GB(14);
        if (l + 1 < DEPTH) {
            ph_peer_v4<true>(p, l);
            ph_rmsnorm(pin_(1), pin_(22) + (size_t)(l + 1) * DM, (bf16_t*)(pws_() + WS_HM), MMEM);
        } else ph_peer_v4<false>(p, l);
        GB(17);
    }
}

extern "C" void kernel_launch(void* const* d_in, const int* in_sizes, int n_in, void* d_out, int out_size, void* d_ws, size_t ws_size, hipStream_t stream) {
    if (n_in != 34 || out_size != MTOK * DM || ws_size < WS_END) {
        fprintf(stderr, "kernel_launch: unexpected shapes (n_in %d out %d ws %zu need %zu)\n", n_in, out_size, ws_size, (size_t)WS_END);
        return;
    }
    static int grid = 0;
    if (!grid) {
        int dev = 0, cus = 0, per_cu = 0;
        (void)hipGetDevice(&dev);
        (void)hipDeviceGetAttribute(&cus, hipDeviceAttributeMultiprocessorCount, dev);
        (void)hipFuncSetAttribute((const void*)k_mega, hipFuncAttributeMaxDynamicSharedMemorySize, LDS_BYTES);
        (void)hipOccupancyMaxActiveBlocksPerMultiprocessor(&per_cu, (const void*)k_mega, 512, LDS_BYTES);
        if (per_cu < 1) fprintf(stderr, "kernel_launch: occupancy query reports %d blocks per CU\n", per_cu);
        grid = cus > 0 ? cus : 256;
    }
    Params p; memset(&p, 0, sizeof(p));
    for (int i = 0; i < 34; ++i) p.in[i] = (const float*)d_in[i];
    p.out = (float*)d_out; p.ws = (char*)d_ws;
    (void)hipMemsetAsync((char*)d_ws + WS_BAR, 0, XCD_BAR_WORDS * sizeof(unsigned), stream);
    hipLaunchKernelGGL(k_mega, dim3(grid), dim3(512), LDS_BYTES, stream, p);
}
```

```cpp
#include <hip/hip_runtime.h>
#include <stdint.h>
#include <stdio.h>
#include <string.h>

#define NB 32
#define SEQ 2048
#define DM 1024
#define MTOK (NB * SEQ)
#define DEPTH 4
#define NMEM 256
#define MMEM (NB * NMEM)
#define LDP 3328
#define NEXP 16384
#define EPS 1e-6f
#define PC_Z 0
#define PC_XBC 256
#define PC_GQKV 768
#define PC_GG 1536
#define PC_LQ 1792
#define PC_LK 1920
#define PC_LV 2048
#define PC_LR 2304
#define PC_DQ 2560
#define PC_DK 2816
#define PC_DV 2880
#define PC_IQ 2944
#define PC_IK 3200
#define PC_GLR 3232
#define PC_IW 3248
#define PC_DT 3256
#define PC_GA 3260
#define PC_GB 3264

typedef unsigned short bf16_t;

#define WS_BAR 0ull
#define WS_P 16384ull
#define SZ_P ((size_t)MTOK * LDP * 2)
#define WS_H (WS_P + SZ_P)
#define SZ_H ((size_t)MTOK * DM * 2)
#define WS_Y (WS_H + SZ_H)
#define SZ_Y ((size_t)MTOK * DM * 2)
#define WS_WP (WS_Y + SZ_Y)
#define SZ_WP ((size_t)DEPTH * DM * LDP * 4)
#define WT_IN (WS_WP)
#define WT_OUT (WT_IN + (size_t)DEPTH * LDP * DM * 2)
#define WT_XQ (WT_OUT + (size_t)DEPTH * DM * DM * 2)
#define WT_XK (WT_XQ + (size_t)DEPTH * 256 * DM * 2)
#define WT_XV (WT_XK + (size_t)DEPTH * 256 * DM * 2)
#define WT_XO (WT_XV + (size_t)DEPTH * 256 * DM * 2)
#define WT_PQ (WT_XO + (size_t)DEPTH * DM * 256 * 2)
#define WT_END (WT_PQ + (size_t)DEPTH * DM * DM * 2)
#define WS_QN (WS_WP + SZ_WP)
#define SZ_QN ((size_t)MTOK * 256 * 4)
#define WS_KN (WS_QN + SZ_QN)
#define SZ_KN ((size_t)MTOK * 64 * 4)
#define WS_IKN (WS_KN + SZ_KN)
#define SZ_IKN ((size_t)MTOK * 32 * 4)
#define WS_YPRE (WS_IKN + SZ_IKN)
#define SZ_YPRE ((size_t)MTOK * 256 * 4)
#define WS_HM (WS_YPRE + SZ_YPRE)
#define SZ_HM ((size_t)MMEM * DM * 2)
#define WS_KM (WS_HM + SZ_HM)
#define SZ_KM ((size_t)MMEM * 256 * 4)
#define WS_VM (WS_KM + SZ_KM)
#define SZ_VM ((size_t)MMEM * 256 * 4)
#define WS_KB (WS_VM + SZ_VM)
#define SZ_KB ((size_t)MMEM * 256 * 2)
#define WS_VTB (WS_KB + SZ_KB)
#define SZ_VTB ((size_t)MMEM * 256 * 2)
#define WS_VT (WS_VTB + SZ_VTB)
#define SZ_VT ((size_t)MTOK * 64 * 2)
#define WS_SKB (WS_VT + SZ_VT)
#define SZ_SKB ((size_t)DEPTH * 8 * 2 * 128 * 64 * 2)
#define WS_SC (WS_SKB + SZ_SKB)
#define SZ_SC ((size_t)MTOK * 16 * 4)
#define WS_DUMMY (WS_SC + SZ_SC)
#define SZ_DUMMY (65536ull)
#define WS_U4 (WS_DUMMY + SZ_DUMMY)
#define WS_V4 (WS_U4 + (size_t)DEPTH * NEXP * 512)
#define WS_USC (WS_V4 + (size_t)DEPTH * NEXP * 512)
#define WS_VSC (WS_USC + (size_t)DEPTH * NEXP * 4)
#define WS_END (WS_VSC + (size_t)DEPTH * NEXP * 4)
#define WS_QX (WS_P)
#define WS_OX (WS_P + (size_t)MTOK * 256 * 4)
#define WS_QP (WS_P + 96ull * 1024 * 1024)
#define WS_H8 (WS_P + 224ull * 1024 * 1024)
#define WS_PEI (WS_H8 + (size_t)MTOK * DM)
#define WS_PEG (WS_PEI + (size_t)MTOK * 128 * 4)
#define WS_PUS (WS_PEG + (size_t)MTOK * 128 * 4)
#define WS_PEND (WS_PUS + (size_t)MTOK * 128 * 4)
static_assert(WS_PEND <= WS_P + SZ_P, "P region aliases");

struct Params {
    const float* in[34];
    float* out;
    char* ws;
};

#define XB_TMO      128
#define XB_XCNT(j)  (256  + 64 * (j))
#define XB_XSUB(j)  (1280 + 64 * (j))
#define XB_XGEN(j)  (2304 + 64 * (j))
#define XB_TOP      3328
#define XB_TOPGEN   3392
#define XCD_BAR_WORDS 3456
#define XB_SPIN_CAP (1u << 18)
#define LAS __attribute__((address_space(3)))

__device__ __forceinline__ unsigned xb_ld(unsigned* p)              { return __hip_atomic_load(p, __ATOMIC_RELAXED, __HIP_MEMORY_SCOPE_AGENT); }
__device__ __forceinline__ unsigned xb_add(unsigned* p, unsigned v) { return __hip_atomic_fetch_add(p, v, __ATOMIC_RELAXED, __HIP_MEMORY_SCOPE_AGENT); }
__device__ __forceinline__ unsigned xb_xcc_id() { return (unsigned)__builtin_amdgcn_s_getreg((3 << 11) | 20) & 0xFu; }
#define XB_SPIN(cond, bar) do { unsigned _sp = 0; while (cond) { __builtin_amdgcn_s_sleep(1); \
    if ((++_sp & 255u) == 0u) { if (xb_ld(&(bar)[XB_TMO])) break; if (_sp > XB_SPIN_CAP) { atomicAdd(&(bar)[XB_TMO], 1u); break; } } } } while (0)

struct XcdBarrier {
    unsigned* bar; unsigned x;
    volatile LAS unsigned* st;
};

__device__ __forceinline__ XcdBarrier xcd_barrier_post(unsigned* bar, volatile LAS unsigned* st) {
    XcdBarrier b; b.bar = bar; b.x = xb_xcc_id(); b.st = st;
    if (threadIdx.x == 0) (void)xb_add(&bar[XB_XCNT(b.x)], 1u);
    return b;
}
__device__ __forceinline__ void xcd_barrier_complete(unsigned* bar, unsigned x, unsigned& nloc, unsigned& nx) {
    const unsigned G = gridDim.x * gridDim.y * gridDim.z;
    unsigned sum, cnt, mine, sp = 0u;
    for (;;) {
        sum = 0u; cnt = 0u; mine = 0u;
#pragma unroll
        for (unsigned j = 0; j < 16; ++j) { const unsigned c = xb_ld(&bar[XB_XCNT(j)]); sum += c; cnt += (c > 0u) ? 1u : 0u; mine = (j == x) ? c : mine; }
        if (sum == G) break;
        __builtin_amdgcn_s_sleep(1);
        if ((++sp & 255u) == 0u) { if (xb_ld(&bar[XB_TMO])) break; if (sp > XB_SPIN_CAP) { atomicAdd(&bar[XB_TMO], 1u); break; } }
    }
    nloc = mine > 0u ? mine : 1u; nx = cnt > 0u ? cnt : 1u;
}

__device__ __forceinline__ void xcd_barrier(const XcdBarrier& b) {
    asm volatile("s_waitcnt vmcnt(0)" ::: "memory");
    __syncthreads();
    if (threadIdx.x == 0) {
        unsigned* bar = b.bar;
        __builtin_amdgcn_s_waitcnt(0);
        unsigned nloc = b.st[0], nx = b.st[1];
        if (nloc == 0u) { xcd_barrier_complete(bar, b.x, nloc, nx); b.st[0] = nloc; b.st[1] = nx; }
        const unsigned old = xb_add(&bar[XB_XSUB(b.x)], 1u);
        const unsigned gen = old / nloc;
        if (old + 1u == (gen + 1u) * nloc) {
            __builtin_amdgcn_fence(__ATOMIC_RELEASE, "agent");
            asm volatile("s_waitcnt vmcnt(0)" ::: "memory");
            const unsigned og = xb_add(&bar[XB_TOP], 1u);
            const unsigned tg = og / nx;
            if (og + 1u == (tg + 1u) * nx) xb_add(&bar[XB_TOPGEN], 1u);
            else XB_SPIN(xb_ld(&bar[XB_TOPGEN]) == tg, bar);
            __builtin_amdgcn_fence(__ATOMIC_ACQUIRE, "agent");
            xb_add(&bar[XB_XGEN(b.x)], 1u);
            asm volatile("s_waitcnt vmcnt(0)" ::: "memory");
        } else {
            XB_SPIN(xb_ld(&bar[XB_XGEN(b.x)]) == gen, bar);
            __builtin_amdgcn_fence(__ATOMIC_ACQUIRE, "agent");
            asm volatile("s_waitcnt vmcnt(0)" ::: "memory");
        }
    }
    __syncthreads();
}


#define LDS_BYTES (144 * 1024)
#define PTAB_OFF (LDS_BYTES - 1024)
extern __shared__ __attribute__((aligned(16))) float dynsmem[];
struct Ctx { const Params* kp; };
#define pin_(i) (p.kp->in[i])
#define pout_() (p.kp->out)
#define pws_() (p.kp->ws)

__device__ __forceinline__ float bf2f(bf16_t v) { return __uint_as_float(((unsigned)v) << 16); }
typedef float cvf32x2_t __attribute__((ext_vector_type(2)));
typedef __bf16 cvbf16x2_t __attribute__((ext_vector_type(2)));
__device__ __forceinline__ unsigned pk_bf16(float lo, float hi) {
    const cvf32x2_t f = {lo, hi}; union { cvbf16x2_t b; unsigned u; } c; c.b = __builtin_convertvector(f, cvbf16x2_t); return c.u;
}
__device__ __forceinline__ bf16_t f2bf(float f) { return (bf16_t)pk_bf16(f, f); }
__device__ __forceinline__ float wave_sum(float v) {
#pragma unroll
    for (int o = 32; o >= 1; o >>= 1) v += __shfl_xor(v, o, 64);
    return v;
}
__device__ __forceinline__ float wave_max(float v) {
#pragma unroll
    for (int o = 32; o >= 1; o >>= 1) v = fmaxf(v, __shfl_xor(v, o, 64));
    return v;
}
__device__ __forceinline__ float silu_f(float x) { return x * __builtin_amdgcn_rcpf(1.f + __expf(-x)); }
__device__ __forceinline__ float sigmoid_f(float x) { return __builtin_amdgcn_rcpf(1.f + __expf(-x)); }
__device__ __forceinline__ float softplus_f(float x) { return x > 20.f ? x : log1pf(__expf(x)); }
__device__ __forceinline__ float logsigmoid_f(float x) { return -softplus_f(-x); }
__device__ __forceinline__ float gelu_tanh_f(float x) { const float u = 0.7978845608028654f * (x + 0.044715f * x * x * x); return 0.5f * x * (1.f + tanhf(u)); }
__device__ __forceinline__ unsigned ford(float f) { f = f + 0.0f; unsigned u = __float_as_uint(f); return (u & 0x80000000u) ? ~u : (u | 0x80000000u); }
__device__ __forceinline__ float funord(unsigned k) { unsigned u = (k & 0x80000000u) ? (k & 0x7fffffffu) : ~k; return __uint_as_float(u); }
__device__ __forceinline__ unsigned long long wave_max_u64(unsigned long long v) {
#pragma unroll
    for (int o = 32; o >= 1; o >>= 1) {
        unsigned lo = __shfl_xor((unsigned)v, o, 64), hi = __shfl_xor((unsigned)(v >> 32), o, 64);
        unsigned long long w = ((unsigned long long)hi << 32) | lo;
        v = w > v ? w : v;
    }
    return v;
}
__device__ __forceinline__ int tid_() { int t = threadIdx.x; asm volatile("" : "+v"(t)); return t; }
__device__ __forceinline__ int bid_() { int b = blockIdx.x; asm volatile("" : "+s"(b)); return b; }
__device__ __forceinline__ int nblk_() { int g = gridDim.x; asm volatile("" : "+s"(g)); return g; }
__device__ __forceinline__ int gwave() { return (bid_() * 512 + tid_()) >> 6; }
__device__ __forceinline__ int nwaves() { return nblk_() * 8; }

namespace pg8 {
#define PG8_LAS __attribute__((address_space(3)))
typedef unsigned short bf16_t;
typedef short bf16x8 __attribute__((ext_vector_type(8)));
typedef float f32x4 __attribute__((ext_vector_type(4)));
typedef unsigned u32x4 __attribute__((ext_vector_type(4)));
constexpr int BM = 256, BK = 64, HALF = 128, HTB = HALF * BK * 2  , STAGE_BYTES = 8 * HTB, NXCD = 8, WGM = 8;

__host__ __device__ __forceinline__ int lds_byte(int r, int c) { const int st = (r >> 4) * 2 + (c >> 5), rr = r & 15, cc = c & 31, ob = rr * 64 + cc * 2; return st * 1024 + (ob ^ (((ob >> 9) & 1) << 5)); }
__host__ __device__ __forceinline__ void stage_rc(int b, int& R, int& C) { const int st = b / 1024, sb = b % 1024, swz = sb ^ (((sb >> 9) & 1) << 5); R = (st >> 1) * 16 + swz / 64; C = (st & 1) * 32 + (swz % 64) / 2; }
__host__ __device__ __forceinline__ int perm32(int rho) { const int n = rho >> 4, i = rho & 15; return 8 * (i >> 2) + 4 * n + (i & 3); }

struct Unit { int pm, pn; };
struct Gemm { const bf16_t* A; const bf16_t* Bt; int M, N, K; };

struct StaticOrder {
    int nM, nN, nwg, G, c;
    __host__ __device__ void init(int M, int N, int G_, int c_) { nM = M / BM; nN = N / BM; nwg = nM * nN; G = G_; c = c_; }
    __host__ __device__ bool next(int i, Unit& u) const {
        const long L = (long)i * G + c; if (L >= nwg) return false;
        int wgid = (int)L; { const int q = nwg / NXCD, r = nwg % NXCD, xcd = wgid % NXCD, off = wgid / NXCD; wgid = (xcd < r ? xcd * (q + 1) : r * (q + 1) + (xcd - r) * q) + off; }
        const int nig = WGM * nN, gid = wgid / nig, fm = gid * WGM, gsz = (nM - fm) < WGM ? (nM - fm) : WGM;
        u.pm = fm + ((wgid % nig) % gsz); u.pn = (wgid % nig) / gsz; return true;
    }
    __device__ __forceinline__ void a_ready(const Unit&) const {}
    __device__ __forceinline__ void done(const Unit&) const {}
};

__device__ __forceinline__ unsigned cvt_pk_bf16(float lo, float hi) { return ::pk_bf16(lo, hi); }
struct EpiF32 {
    static constexpr bool PERM = false, AFTER_DRAIN = false;
    float* C; const float* R; int ldc;
    __device__ __forceinline__ void operator()(const f32x4 (&acc)[2][2][4][2], const Unit& u, int wr, int wc, int fr, int fq) const {
        const int row0 = u.pm * BM + wr * 64 + fr, col0 = u.pn * BM + wc * 32 + 4 * fq;
#pragma unroll
        for (int ai = 0; ai < 2; ++ai)
#pragma unroll
            for (int m = 0; m < 4; ++m) { const size_t off = (size_t)(row0 + ai * HALF + m * 16) * ldc + col0;
                f32x4 rv[2][2];
#pragma unroll
                for (int bj = 0; bj < 2; ++bj)
#pragma unroll
                    for (int n = 0; n < 2; ++n) rv[bj][n] = R ? *(const f32x4*)(R + off + bj * HALF + n * 16) : (f32x4){0.f, 0.f, 0.f, 0.f};
#pragma unroll
                for (int bj = 0; bj < 2; ++bj)
#pragma unroll
                    for (int n = 0; n < 2; ++n) *(f32x4*)(C + off + bj * HALF + n * 16) = acc[ai][bj][m][n] + rv[bj][n]; }
    }
};
struct EpiBf16 {
    static constexpr bool PERM = true, AFTER_DRAIN = false;
    bf16_t* O; int ldc;
    __device__ __forceinline__ void operator()(const f32x4 (&acc)[2][2][4][2], const Unit& u, int wr, int wc, int fr, int fq) const {
        const int row0 = u.pm * BM + wr * 64 + fr, col0 = u.pn * BM + wc * 32 + 8 * fq;
#pragma unroll
        for (int ai = 0; ai < 2; ++ai)
#pragma unroll
            for (int m = 0; m < 4; ++m) { bf16_t* rowp = O + (size_t)(row0 + ai * HALF + m * 16) * ldc + col0;
#pragma unroll
                for (int bj = 0; bj < 2; ++bj) { const f32x4 v0 = acc[ai][bj][m][0], v1 = acc[ai][bj][m][1];
                    u32x4 w; w.x = cvt_pk_bf16(v0[0], v0[1]); w.y = cvt_pk_bf16(v0[2], v0[3]); w.z = cvt_pk_bf16(v1[0], v1[1]); w.w = cvt_pk_bf16(v1[2], v1[3]);
                    *(u32x4*)(rowp + bj * HALF) = w; } }
    }
};

template <class Epi, class Sched, bool STAMP = false>
__device__ __forceinline__ void gemm_phase(PG8_LAS unsigned char* lds, const Gemm g, const Sched& S, const Epi& E, unsigned long long* stamps, const int tid) {
    const int wid = __builtin_amdgcn_readfirstlane(tid >> 6), lane = tid & 63, wr = wid >> 2, wc = wid & 3, fr = lane & 15, fq = lane >> 4;
    const int K = g.K, nt = K / BK;
    int ts_lo = 0, ts_hi = 0, nts = 0; const unsigned long long rt_entry = STAMP ? (unsigned long long)wall_clock64() : 0ull;
#define PG8_STAMP() do { if (STAMP && wid == 0 && nts < 64) { const unsigned long long _c = (unsigned long long)clock64(); \
        ts_lo = (lane == nts) ? (int)(unsigned)_c : ts_lo; ts_hi = (lane == nts) ? (int)(unsigned)(_c >> 32) : ts_hi; ++nts; } } while (0)
    PG8_STAMP();
    unsigned voffA[2], voffB[2];
#pragma unroll
    for (int i = 0; i < 2; ++i) { int R, C; stage_rc(tid * 16 + i * 8192, R, C); const int Rb = Epi::PERM ? ((R & ~31) + perm32(R & 31)) : R;
        voffA[i] = (unsigned)(R * K + C) * 2u; voffB[i] = (unsigned)(Rb * K + C) * 2u; }
    const size_t kstep = (size_t)(BK * 2);
    const size_t hstep = (size_t)HALF * K * 2;
    const size_t tstep = 2 * hstep;
    const unsigned ldsw = (unsigned)wid * 1024u;
    const int aoff = lds_byte(wr * 64 + fr, fq * 8), boff = lds_byte(wc * 32 + fr, fq * 8);
#define PG8_SA(b, h) (((b) * 2 + (h)) * HTB)
#define PG8_SB(b, h) ((4 + (b) * 2 + (h)) * HTB)
#define PG8_STAGE(bufoff, gbase, voff) do { _Pragma("unroll") for (int _i = 0; _i < 2; ++_i) \
        __builtin_amdgcn_global_load_lds((const unsigned*)((const char*)(gbase) + (voff)[_i]), (PG8_LAS unsigned*)(lds + (bufoff) + ldsw + _i * 8192), 16, 0, 0); } while (0)
#define PG8_LDA(dst, b, h) do { _Pragma("unroll") for (int m = 0; m < 4; ++m) _Pragma("unroll") for (int k = 0; k < 2; ++k) dst[m][k] = *(const PG8_LAS bf16x8*)(lds + PG8_SA(b, h) + aoff + m * 2048 + k * 1024); } while (0)
#define PG8_LDB(dst, b, h) do { _Pragma("unroll") for (int n = 0; n < 2; ++n) _Pragma("unroll") for (int k = 0; k < 2; ++k) dst[n][k] = *(const PG8_LAS bf16x8*)(lds + PG8_SB(b, h) + boff + n * 2048 + k * 1024); } while (0)
#define PG8_MMA(ai, bj, At, Bt) do { __builtin_amdgcn_s_setprio(1); _Pragma("unroll") for (int m = 0; m < 4; ++m) _Pragma("unroll") for (int n = 0; n < 2; ++n) _Pragma("unroll") for (int k = 0; k < 2; ++k) \
        acc[ai][bj][m][n] = __builtin_amdgcn_mfma_f32_16x16x32_bf16(Bt[n][k], At[m][k], acc[ai][bj][m][n], 0, 0, 0); __builtin_amdgcn_s_setprio(0); } while (0)
#define PG8_WAIT_V(n) asm volatile("s_waitcnt vmcnt(" #n ")" ::: "memory")
#define PG8_WAIT_L(n) asm volatile("s_waitcnt lgkmcnt(" #n ")" ::: "memory")
#define PG8_BAR __builtin_amdgcn_s_barrier()
#define PG8_SCHED __builtin_amdgcn_sched_barrier(0)
    Unit cur, nxt; int ui = 0;
    if (!S.next(0, cur)) return;
    f32x4 acc[2][2][4][2];
#pragma unroll
    for (int a = 0; a < 2; ++a)
#pragma unroll
        for (int b = 0; b < 2; ++b)
#pragma unroll
            for (int m = 0; m < 4; ++m)
#pragma unroll
                for (int n = 0; n < 2; ++n) acc[a][b][m][n] = (f32x4){0.f, 0.f, 0.f, 0.f};
    bf16x8 At[4][2], B0[2][2], B1[2][2];
    const char* cA = (const char*)g.A + (size_t)cur.pm * tstep; const char* cB = (const char*)g.Bt + (size_t)cur.pn * tstep;
    S.a_ready(cur);
    PG8_STAGE(PG8_SB(0, 0), cB, voffB); PG8_STAGE(PG8_SA(0, 0), cA, voffA); PG8_STAGE(PG8_SB(0, 1), cB + hstep, voffB); PG8_STAGE(PG8_SA(0, 1), cA + hstep, voffA);
    if (wr == 1) PG8_BAR;
    PG8_WAIT_V(4); PG8_BAR;
    PG8_STAGE(PG8_SB(1, 0), cB + kstep, voffB); PG8_STAGE(PG8_SA(1, 0), cA + kstep, voffA); PG8_STAGE(PG8_SB(1, 1), cB + hstep + kstep, voffB);
    PG8_WAIT_V(6); PG8_BAR;
    PG8_STAMP();
    for (;;) {
        const bool has_next = S.next(ui + 1, nxt);
        const char* nA = has_next ? (const char*)g.A + (size_t)nxt.pm * tstep : cA; const char* nB = has_next ? (const char*)g.Bt + (size_t)nxt.pn * tstep : cB;
        for (int t = 0; t < nt; t += 2) {
            const bool last = (t == nt - 2);
            const char* a1 = cA + (size_t)(t + 1) * kstep;
            const char* a2 = last ? nA : cA + (size_t)(t + 2) * kstep; const char* b2 = last ? nB : cB + (size_t)(t + 2) * kstep;
            const char* a3 = a2 + kstep; const char* b3 = b2 + kstep;
            if (last && has_next) S.a_ready(nxt);
            PG8_LDB(B0, 0, 0); PG8_SCHED; PG8_LDA(At, 0, 0); PG8_STAGE(PG8_SA(1, 1), a1 + hstep, voffA);
            PG8_WAIT_L(8); PG8_BAR; PG8_WAIT_L(0); PG8_MMA(0, 0, At, B0); PG8_BAR; PG8_SCHED;
            PG8_LDB(B1, 0, 1); PG8_STAGE(PG8_SB(0, 0), b2, voffB);
            PG8_BAR; PG8_WAIT_L(0); PG8_MMA(0, 1, At, B1); PG8_BAR;
            PG8_LDA(At, 0, 1); PG8_STAGE(PG8_SA(0, 0), a2, voffA);
            PG8_BAR; PG8_WAIT_L(0); PG8_MMA(1, 0, At, B0); PG8_BAR; PG8_SCHED;
            PG8_STAGE(PG8_SB(0, 1), b2 + hstep, voffB);
            PG8_WAIT_V(6); PG8_BAR; PG8_MMA(1, 1, At, B1); PG8_BAR;
            PG8_LDB(B0, 1, 0); PG8_SCHED; PG8_LDA(At, 1, 0); PG8_STAGE(PG8_SA(0, 1), a2 + hstep, voffA);
            PG8_WAIT_L(8); PG8_BAR; PG8_WAIT_L(0); PG8_MMA(0, 0, At, B0); PG8_BAR; PG8_SCHED;
            PG8_LDB(B1, 1, 1); PG8_STAGE(PG8_SB(1, 0), b3, voffB);
            PG8_BAR; PG8_WAIT_L(0); PG8_MMA(0, 1, At, B1); PG8_BAR;
            PG8_LDA(At, 1, 1); PG8_STAGE(PG8_SA(1, 0), a3, voffA);
            PG8_BAR; PG8_WAIT_L(0); PG8_MMA(1, 0, At, B0); PG8_BAR; PG8_SCHED;
            PG8_STAGE(PG8_SB(1, 1), b3 + hstep, voffB);
            PG8_WAIT_V(6); PG8_BAR; PG8_MMA(1, 1, At, B1); PG8_BAR;
        }
        PG8_STAMP();
        if constexpr (!Epi::AFTER_DRAIN) { E(acc, cur, wr, wc, fr, fq); S.done(cur); }
        PG8_STAMP();
        if (!has_next) break;
#pragma unroll
        for (int a = 0; a < 2; ++a)
#pragma unroll
            for (int b = 0; b < 2; ++b)
#pragma unroll
                for (int m = 0; m < 4; ++m)
#pragma unroll
                    for (int n = 0; n < 2; ++n) acc[a][b][m][n] = (f32x4){0.f, 0.f, 0.f, 0.f};
        cur = nxt; cA = nA; cB = nB; ++ui;
    }
    PG8_WAIT_V(0);
    if (wr == 0) PG8_BAR;
    PG8_BAR;
    if constexpr (Epi::AFTER_DRAIN) { E.fused(acc, cur, wr, wc, fr, fq, lds, wid, lane); S.done(cur); }
    PG8_STAMP();
    if (STAMP && wid == 0) { stamps[lane] = lane < nts ? (((unsigned long long)(unsigned)ts_hi << 32) | (unsigned)ts_lo) : 0ull;
        if (lane == 62) stamps[62] = rt_entry; if (lane == 63) stamps[63] = (unsigned long long)wall_clock64(); }
#undef PG8_STAMP
#undef PG8_SA
#undef PG8_SB
#undef PG8_STAGE
#undef PG8_LDA
#undef PG8_LDB
#undef PG8_MMA
#undef PG8_WAIT_V
#undef PG8_WAIT_L
#undef PG8_BAR
#undef PG8_SCHED
}
}

namespace pg8 {
struct PanelOrder {
    int pm, nN;
    __device__ void init(int pm_, int N) { pm = pm_; nN = N / BM; }
    __device__ bool next(int i, Unit& u) const { if (i >= nN) return false; u.pm = pm; u.pn = i; return true; }
    __device__ __forceinline__ void a_ready(const Unit&) const {}
    __device__ __forceinline__ void done(const Unit&) const {}
};
}
template <class Epi> __device__ __forceinline__ void ph_gemm_panel(const bf16_t* A, const bf16_t* Bt, int M, int N, int K, const Epi& E, int pm) {
    pg8::Gemm g; g.A = A; g.Bt = Bt; g.M = M; g.N = N; g.K = K;
    pg8::PanelOrder S; S.init(pm, N);
    pg8::gemm_phase<Epi, pg8::PanelOrder, false>((PG8_LAS unsigned char*)dynsmem, g, S, E, nullptr, tid_());
}
template <class Epi> __device__ __forceinline__ void ph_gemm(const bf16_t* A, const bf16_t* Bt, int M, int N, int K, const Epi& E, int crot = 0) {
    pg8::Gemm g; g.A = A; g.Bt = Bt; g.M = M; g.N = N; g.K = K;
    const int nb_ = nblk_();
    pg8::StaticOrder S; S.init(M, N, nb_, (bid_() + nb_ - crot) % nb_);
    pg8::gemm_phase<Epi, pg8::StaticOrder, false>((PG8_LAS unsigned char*)dynsmem, g, S, E, nullptr, tid_());
}

__device__ __forceinline__ int pcol_to_orig(int c) {
    if (c < 768) return c;
    if (c < 1536) return c - 768 + 772;
    if (c < 1792) return c - 1536 + 1548;
    if (c < 1920) return c - 1792 + 1804;
    if (c < 2048) return c - 1920 + 1932;
    if (c < 2304) return c - 2048 + 2060;
    if (c < 2560) return c - 2304 + 2332;
    if (c < 2816) return c - 2560 + 2588;
    if (c < 2880) return c - 2816 + 2844;
    if (c < 2944) return c - 2880 + 2908;
    if (c < 3200) return c - 2944 + 2972;
    if (c < 3232) return c - 3200 + 3228;
    if (c < 3248) return c - 3232 + 2316;
    if (c < 3256) return c - 3248 + 3260;
    if (c < 3260) return c - 3256 + 768;
    if (c < 3264) return c - 3260 + 1540;
    if (c < 3268) return c - 3264 + 1544;
    return -1;
}
__device__ __forceinline__ void wtrans_job(const float* W, int K, int ldw, bf16_t* Wt, int Npad, bool mapped, float* smem, int goff) {
    const int lane = tid_() & 63, wave = tid_() >> 6;
    float* tile = smem + wave * (64 * 65);
    const int tn = Npad / 64, tk = K / 64, nt = tn * tk, nw = nwaves();
    int t = (gwave() - goff) % nw; if (t < 0) t += nw;
    for (; t < nt; t += nw) {
        const int n0 = (t / tk) * 64, k0 = (t % tk) * 64;
        const int nn4 = 4 * (lane & 15);
        const int col = mapped ? pcol_to_orig(n0 + nn4) : (n0 + nn4);
        float4 v[16];
#pragma unroll
        for (int r = 0; r < 16; ++r) {
            const int kk = 4 * r + (lane >> 4);
            v[r] = col >= 0 ? *(const float4*)(W + (size_t)(k0 + kk) * ldw + col) : make_float4(0.f, 0.f, 0.f, 0.f);
        }
        asm volatile("s_waitcnt lgkmcnt(0)" ::: "memory"); __builtin_amdgcn_wave_barrier();
#pragma unroll
        for (int r = 0; r < 16; ++r) {
            float* d = tile + (4 * r + (lane >> 4)) * 65 + nn4;
            d[0] = v[r].x; d[1] = v[r].y; d[2] = v[r].z; d[3] = v[r].w;
        }
        asm volatile("s_waitcnt lgkmcnt(0)" ::: "memory"); __builtin_amdgcn_wave_barrier();
        const int kk8 = 8 * (lane & 7);
#pragma unroll
        for (int r = 0; r < 8; ++r) {
            const int nn = 8 * r + (lane >> 3);
            float o[8];
#pragma unroll
            for (int i = 0; i < 8; ++i) o[i] = tile[(kk8 + i) * 65 + nn];
            uint4 w; w.x = pk_bf16(o[0], o[1]); w.y = pk_bf16(o[2], o[3]); w.z = pk_bf16(o[4], o[5]); w.w = pk_bf16(o[6], o[7]);
            *(uint4*)(Wt + (size_t)(n0 + nn) * K + k0 + kk8) = w;
        }
    }
}
__device__ __forceinline__ void ph_weight_prep(const Ctx& p, float* sm) {
    int goff = 0;
#pragma unroll 1
    for (int j = 0; j < 7 * DEPTH; ++j) {
        const int l = j / 7, w = j % 7;
        const float* W; int K, ldw, Npad; bf16_t* Wt; bool mapped = false;
        if (w == 0) { W = pin_(3) + (size_t)l * DM * 3268; K = DM; ldw = 3268; Npad = LDP; Wt = (bf16_t*)(pws_() + WT_IN) + (size_t)l * LDP * DM; mapped = true; }
        else if (w == 1) { W = pin_(20) + (size_t)l * DM * DM; K = DM; ldw = DM; Npad = DM; Wt = (bf16_t*)(pws_() + WT_OUT) + (size_t)l * DM * DM; }
        else if (w == 2) { W = pin_(23) + (size_t)l * DM * 256; K = DM; ldw = 256; Npad = 256; Wt = (bf16_t*)(pws_() + WT_XQ) + (size_t)l * 256 * DM; }
        else if (w == 3) { W = pin_(24) + (size_t)l * DM * 256; K = DM; ldw = 256; Npad = 256; Wt = (bf16_t*)(pws_() + WT_XK) + (size_t)l * 256 * DM; }
        else if (w == 4) { W = pin_(25) + (size_t)l * DM * 256; K = DM; ldw = 256; Npad = 256; Wt = (bf16_t*)(pws_() + WT_XV) + (size_t)l * 256 * DM; }
        else if (w == 5) { W = pin_(26) + (size_t)l * 256 * DM; K = 256; ldw = DM; Npad = DM; Wt = (bf16_t*)(pws_() + WT_XO) + (size_t)l * DM * 256; }
        else { W = pin_(30) + (size_t)l * DM * DM; K = DM; ldw = DM; Npad = DM; Wt = (bf16_t*)(pws_() + WT_PQ) + (size_t)l * DM * DM; }
        wtrans_job(W, K, ldw, Wt, Npad, mapped, sm, goff);
        goff += (Npad / 64) * (K / 64);
    }
}

#define H8_SCALE 16.f
__device__ __forceinline__ unsigned pack4_fp8(float4 a, float sc);
__device__ __forceinline__ void ph_rmsnorm(const float* __restrict__ x, const float* __restrict__ g, bf16_t* __restrict__ out, int rows, int row0 = 0, int w0 = -1, int wstep = 0, unsigned char* out8 = nullptr) {
    const int lane = tid_() & 63;
    if (w0 < 0) { w0 = gwave(); wstep = nwaves(); }
    float4 gq[4];
#pragma unroll
    for (int i = 0; i < 4; ++i) gq[i] = ((const float4*)g)[lane + 64 * i];
    const int rend = row0 + rows;
    for (int r0 = row0 + w0; r0 < rend; r0 += 4 * wstep) {
        float4 v[4][4];
#pragma unroll
        for (int k = 0; k < 4; ++k) {
            const int r = r0 + k * wstep < rend ? r0 + k * wstep : r0;
#pragma unroll
            for (int i = 0; i < 4; ++i) v[k][i] = ((const float4*)(x + (size_t)r * DM))[lane + 64 * i];
        }
        float ss[4];
#pragma unroll
        for (int k = 0; k < 4; ++k) { ss[k] = 0.f;
#pragma unroll
            for (int i = 0; i < 4; ++i) ss[k] += v[k][i].x * v[k][i].x + v[k][i].y * v[k][i].y + v[k][i].z * v[k][i].z + v[k][i].w * v[k][i].w; }
#pragma unroll
        for (int o = 32; o >= 1; o >>= 1) {
#pragma unroll
            for (int k = 0; k < 4; ++k) ss[k] += __shfl_xor(ss[k], o, 64);
        }
#pragma unroll
        for (int k = 0; k < 4; ++k) {
            const int r = r0 + k * wstep;
            if (r < rend) {
                const float rs = rsqrtf(ss[k] * (1.f / DM) + EPS);
#pragma unroll
                for (int i = 0; i < 4; ++i) {
                    const float4 gg = gq[i];
                    const float4 w = make_float4(v[k][i].x * rs * gg.x, v[k][i].y * rs * gg.y, v[k][i].z * rs * gg.z, v[k][i].w * rs * gg.w);
                    uint2 o; o.x = pk_bf16(w.x, w.y); o.y = pk_bf16(w.z, w.w);
                    *(uint2*)(out + (size_t)r * DM + (size_t)(lane + 64 * i) * 4) = o;
                    if (out8) *(unsigned*)(out8 + (size_t)r * DM + (size_t)(lane + 64 * i) * 4) = pack4_fp8(w, H8_SCALE);
                }
            }
        }
    }
}

template <int OUTMODE>
__device__ __forceinline__ void ph_sgemm(const bf16_t* __restrict__ A, int lda, const float* __restrict__ B, int ldb, void* Cv, int ldc, const float* R, int ldr,
                         int M, int N, int K, float* smem) {
    float* As = smem;
    float* Bs = smem + 16 * 132;
    const int tid = tid_(), tx = tid & 31, ty = tid >> 5;
    const int ntn = N / 128, ntiles = (M / 128) * ntn;
    for (int tile = bid_(); tile < ntiles; tile += nblk_()) {
        const int tm = tile / ntn, tn = tile % ntn;
        float acc[8][4];
#pragma unroll
        for (int i = 0; i < 8; ++i)
#pragma unroll
            for (int j = 0; j < 4; ++j) acc[i][j] = 0.f;
        const int arow = tid >> 2, akq = (tid & 3) * 4;
        const int bk = tid >> 5, bn = (tid & 31) * 4;
        for (int k0 = 0; k0 < K; k0 += 16) {
            const ushort4 av = *(const ushort4*)(A + (size_t)(tm * 128 + arow) * lda + k0 + akq);
            const float4 bv = *(const float4*)(B + (size_t)(k0 + bk) * ldb + tn * 128 + bn);
            __syncthreads();
            As[(akq + 0) * 132 + arow] = bf2f(av.x); As[(akq + 1) * 132 + arow] = bf2f(av.y);
            As[(akq + 2) * 132 + arow] = bf2f(av.z); As[(akq + 3) * 132 + arow] = bf2f(av.w);
            *(float4*)(Bs + bk * 132 + bn) = bv;
            __syncthreads();
#pragma unroll
            for (int k = 0; k < 16; ++k) {
                const float4 a0 = *(const float4*)(As + k * 132 + ty * 8), a1 = *(const float4*)(As + k * 132 + ty * 8 + 4);
                const float4 b = *(const float4*)(Bs + k * 132 + tx * 4);
                const float a[8] = {a0.x, a0.y, a0.z, a0.w, a1.x, a1.y, a1.z, a1.w};
#pragma unroll
                for (int i = 0; i < 8; ++i) { acc[i][0] += a[i] * b.x; acc[i][1] += a[i] * b.y; acc[i][2] += a[i] * b.z; acc[i][3] += a[i] * b.w; }
            }
        }
#pragma unroll
        for (int i = 0; i < 8; ++i) {
            const size_t row = (size_t)tm * 128 + ty * 8 + i; const int col = tn * 128 + tx * 4;
            if (OUTMODE == 0) {
                ushort4 o; o.x = f2bf(acc[i][0]); o.y = f2bf(acc[i][1]); o.z = f2bf(acc[i][2]); o.w = f2bf(acc[i][3]);
                *(ushort4*)((bf16_t*)Cv + row * ldc + col) = o;
            } else if (OUTMODE == 1) {
                *(float4*)((float*)Cv + row * ldc + col) = make_float4(acc[i][0], acc[i][1], acc[i][2], acc[i][3]);
            } else {
                const float4 r = *(const float4*)(R + row * ldr + col);
                *(float4*)((float*)Cv + row * ldc + col) = make_float4(r.x + acc[i][0], r.y + acc[i][1], r.z + acc[i][2], r.w + acc[i][3]);
            }
        }
    }
}

#define WS_HS WS_H
#define WS_VG WS_YPRE
#define WS_DEC (WS_YPRE + (size_t)MTOK * 256 * 2)

__device__ __forceinline__ float quad_sum(float v) {
    v += __int_as_float(__builtin_amdgcn_mov_dpp(__float_as_int(v), 0xB1, 0xF, 0xF, true));
    v += __int_as_float(__builtin_amdgcn_mov_dpp(__float_as_int(v), 0x4E, 0xF, 0xF, true));
    return v;
}
__device__ __forceinline__ float bflo(unsigned w) { return __uint_as_float(w << 16); }
__device__ __forceinline__ float bfhi(unsigned w) { return __uint_as_float(w & 0xffff0000u); }

__device__ __forceinline__ float oct_sum(float v) {
    v += __int_as_float(__builtin_amdgcn_mov_dpp(__float_as_int(v), 0xB1, 0xF, 0xF, true));
    v += __int_as_float(__builtin_amdgcn_mov_dpp(__float_as_int(v), 0x4E, 0xF, 0xF, true));
    v += __int_as_float(__builtin_amdgcn_mov_dpp(__float_as_int(v), 0x141, 0xF, 0xF, true));
    return v;
}
__device__ __forceinline__ void unpack8(const uint4 r, float (&o)[8]) {
    o[0] = bflo(r.x); o[1] = bfhi(r.x); o[2] = bflo(r.y); o[3] = bfhi(r.y); o[4] = bflo(r.z); o[5] = bfhi(r.z); o[6] = bflo(r.w); o[7] = bfhi(r.w);
}
__device__ __forceinline__ uint4 pack8(const float (&v)[8]) {
    uint4 o; o.x = pk_bf16(v[0], v[1]); o.y = pk_bf16(v[2], v[3]); o.z = pk_bf16(v[4], v[5]); o.w = pk_bf16(v[6], v[7]); return o;
}
__device__ __forceinline__ void load8f(const float* p, float (&o)[8]) {
    const float4 a = *(const float4*)p, b = *(const float4*)(p + 4);
    o[0] = a.x; o[1] = a.y; o[2] = a.z; o[3] = a.w; o[4] = b.x; o[5] = b.y; o[6] = b.z; o[7] = b.w;
}
__device__ __forceinline__ void conv8(const bf16_t* P, size_t tok, int t, int pcol, const float* w, int ldw, int cc, float (&acc)[8]) {
#pragma unroll
    for (int j = 0; j < 4; ++j) {
        if (t - 3 + j >= 0) {
            float xv[8], wv[8];
            unpack8(*(const uint4*)(P + (tok - (size_t)(3 - j)) * LDP + pcol), xv);
            load8f(w + j * ldw + cc, wv);
#pragma unroll
            for (int i = 0; i < 8; ++i) acc[i] = __builtin_fmaf(wv[i], xv[i], acc[i]);
        }
    }
}
__device__ __forceinline__ void conv8r(const uint4 (&xt)[4], int t, const float* w, int ldw, int cc, float (&acc)[8]) {
#pragma unroll
    for (int j = 0; j < 4; ++j) {
        float xv[8], wv[8];
        unpack8(xt[j], xv);
        load8f(w + j * ldw + cc, wv);
        const float m = (t - 3 + j >= 0) ? 1.f : 0.f;
#pragma unroll
        for (int i = 0; i < 8; ++i) acc[i] = __builtin_fmaf(wv[i] * m, xv[i], acc[i]);
    }
}
__device__ __forceinline__ void conv8w(const uint4 (&xt)[4], int t, const float (&wv)[4][8], float (&acc)[8]) {
#pragma unroll
    for (int j = 0; j < 4; ++j) {
        float xv[8];
        unpack8(xt[j], xv);
        const float m = (t - 3 + j >= 0) ? 1.f : 0.f;
#pragma unroll
        for (int i = 0; i < 8; ++i) acc[i] = __builtin_fmaf(wv[j][i] * m, xv[i], acc[i]);
    }
}
__device__ __forceinline__ void ph_scan_prep(const Ctx& p, int l) {
    const bf16_t* P = (const bf16_t*)(pws_() + WS_P);
    bf16_t* HS = (bf16_t*)(pws_() + WS_HS);
    bf16_t* VG = (bf16_t*)(pws_() + WS_VG);
    float* DEC = (float*)(pws_() + WS_DEC);
    float* SC = (float*)(pws_() + WS_SC);
    const float* scw = pin_(4) + (size_t)l * 4 * 512;
    const float* scb = pin_(5) + (size_t)l * 512;
    const float* gcw = pin_(10) + (size_t)l * 4 * 768;
    const float* wg = pin_(14) + (size_t)l * 16 * 128;
    const float* bg = pin_(15) + (size_t)l * 128;
    const int lane = tid_() & 63;
    const int hsc = lane & 3, wsc = (lane >> 2) & 3;
    const float k_dtb = pin_(6)[l * 4 + hsc], k_alog = __expf(pin_(7)[l * 4 + hsc]), k_galog = __expf(pin_(11)[l * 4 + hsc]), k_gdtb = pin_(12)[l * 4 + hsc];
    const int sccol = wsc < 2 ? PC_DT + hsc : (wsc == 2 ? PC_GA + hsc : PC_GB + hsc);
    const int nw = nwaves();
    {
        uint4 nxa[4], ngl0, ngl1; unsigned short nsc;
#define SP_LOAD(tk) do { const int t_ = (tk) % SEQ; const size_t row_ = (size_t)(tk) * LDP; \
        _Pragma("unroll") for (int j = 0; j < 4; ++j) { const size_t rj = (t_ - 3 + j >= 0) ? row_ - (size_t)(3 - j) * LDP : row_; nxa[j] = *(const uint4*)(P + rj + PC_XBC + 8 * lane); } \
        ngl0 = *(const uint4*)(P + row_ + PC_GLR); ngl1 = *(const uint4*)(P + row_ + PC_GLR + 8); nsc = P[row_ + sccol]; } while (0)
        float wsx[4][8], bsx[8], wgl[2][16], bgl[2];
#pragma unroll
        for (int j = 0; j < 4; ++j) load8f(scw + j * 512 + 8 * lane, wsx[j]);
        load8f(scb + 8 * lane, bsx);
#pragma unroll
        for (int i = 0; i < 2; ++i) { bgl[i] = bg[lane + 64 * i];
#pragma unroll
            for (int r = 0; r < 16; ++r) wgl[i][r] = wg[r * 128 + lane + 64 * i]; }
        int tok = gwave();
        SP_LOAD(tok);
        for (; tok < MTOK; tok += nw) {
            const int t = tok % SEQ;
            uint4 xa[4];
#pragma unroll
            for (int j = 0; j < 4; ++j) xa[j] = nxa[j];
            const uint4 gl0 = ngl0, gl1 = ngl1;
            const float scraw = bf2f(nsc);
            { const int tn = tok + nw < MTOK ? tok + nw : tok; SP_LOAD(tn); }
            __builtin_amdgcn_sched_barrier(0);
            {
                float acc[8];
#pragma unroll
                for (int i = 0; i < 8; ++i) acc[i] = bsx[i];
                conv8w(xa, t, wsx, acc);
#pragma unroll
                for (int i = 0; i < 8; ++i) acc[i] = silu_f(acc[i]);
                *(uint4*)(HS + (size_t)tok * 1024 + 8 * lane) = pack8(acc);
            }
            {
                float v;
                if (wsc < 2) { const float dt = softplus_f(scraw + k_dtb); v = wsc == 0 ? dt : __expf(-dt * k_alog); }
                else if (wsc == 2) v = __expf(-k_galog * softplus_f(scraw + k_gdtb));
                else v = sigmoid_f(scraw);
                if (lane < 16) SC[(size_t)tok * 16 + lane] = v;
            }
            {
                float gl[16];
                { float a8[8], b8[8]; unpack8(gl0, a8); unpack8(gl1, b8);
#pragma unroll
                  for (int i = 0; i < 8; ++i) { gl[i] = a8[i]; gl[8 + i] = b8[i]; } }
#pragma unroll
                for (int i = 0; i < 2; ++i) {
                    const int c = lane + 64 * i;
                    float acc = bgl[i];
#pragma unroll
                    for (int r = 0; r < 16; ++r) acc = __builtin_fmaf(gl[r], wgl[i][r], acc);
                    DEC[(size_t)tok * 128 + c] = __expf(logsigmoid_f(acc) * (1.f / 16.f));
                }
            }
        }
#undef SP_LOAD
    }
    {
        uint4 nxq[4], nxv4[4];
#define SP_LOAD(tk) do { const int t_ = (tk) % SEQ; const size_t row_ = (size_t)(tk) * LDP; \
        _Pragma("unroll") for (int j = 0; j < 4; ++j) { const size_t rj = (t_ - 3 + j >= 0) ? row_ - (size_t)(3 - j) * LDP : row_; \
            nxq[j] = *(const uint4*)(P + rj + PC_GQKV + 8 * lane); nxv4[j] = *(const uint4*)(P + rj + PC_GQKV + 512 + 8 * (lane & 31)); } } while (0)
        float wq[4][8], wv[4][8];
#pragma unroll
        for (int j = 0; j < 4; ++j) { load8f(gcw + j * 768 + 8 * lane, wq[j]); load8f(gcw + j * 768 + 512 + 8 * (lane & 31), wv[j]); }
        int tok = gwave();
        SP_LOAD(tok);
        for (; tok < MTOK; tok += nw) {
            const int t = tok % SEQ;
            uint4 xq[4], xv4[4];
#pragma unroll
            for (int j = 0; j < 4; ++j) { xq[j] = nxq[j]; xv4[j] = nxv4[j]; }
            { const int tn = tok + nw < MTOK ? tok + nw : tok; SP_LOAD(tn); }
            __builtin_amdgcn_sched_barrier(0);
            {
                float acc[8];
#pragma unroll
                for (int i = 0; i < 8; ++i) acc[i] = 0.f;
                conv8w(xq, t, wq, acc);
                float ss = 0.f;
#pragma unroll
                for (int i = 0; i < 8; ++i) { acc[i] = silu_f(acc[i]); ss += acc[i] * acc[i]; }
                ss = oct_sum(ss);
                const float sc = rsqrtf(ss + EPS) * (lane < 32 ? 0.125f : 1.f);
#pragma unroll
                for (int i = 0; i < 8; ++i) acc[i] *= sc;
                *(uint4*)(HS + (size_t)tok * 1024 + 512 + 8 * lane) = pack8(acc);
            }
            {
                float acc[8];
#pragma unroll
                for (int i = 0; i < 8; ++i) acc[i] = 0.f;
                conv8w(xv4, t, wv, acc);
#pragma unroll
                for (int i = 0; i < 8; ++i) acc[i] = silu_f(acc[i]);
                if (lane < 32) *(uint4*)(VG + (size_t)tok * 256 + 8 * lane) = pack8(acc);
            }
        }
#undef SP_LOAD
    }
}

#define SCAN_LDS_WAVE 4608
typedef float f2_t __attribute__((ext_vector_type(2)));
__device__ __forceinline__ f2_t mk2(float a, float b) { f2_t r; r.x = a; r.y = b; return r; }
__device__ __forceinline__ void st8f(char* dst, const uint4 v) {
    *(float4*)dst = make_float4(bflo(v.x), bfhi(v.x), bflo(v.y), bfhi(v.y));
    *(float4*)(dst + 16) = make_float4(bflo(v.z), bfhi(v.z), bflo(v.w), bfhi(v.w));
}
__device__ __forceinline__ void ph_scans(const Ctx& p, int l, float* smem) {
    const bf16_t* P = (const bf16_t*)(pws_() + WS_P);
    const bf16_t* HS = (const bf16_t*)(pws_() + WS_HS);
    const bf16_t* VG = (const bf16_t*)(pws_() + WS_VG);
    const float* DEC = (const float*)(pws_() + WS_DEC);
    const float* SC = (const float*)(pws_() + WS_SC);
    bf16_t* Y = (bf16_t*)(pws_() + WS_Y);
    const int tid = tid_(), lane = tid & 63, wave = tid >> 6;
    if (nblk_() != 256) return;
    const int role = wave < 2 ? 0 : (wave < 6 ? 1 : 2);
    const int idx = (role == 0 ? wave : (role == 1 ? wave - 2 : wave - 6)) * 256 + bid_();
    const int bh = role == 1 ? (idx >> 3) : (idx >> 2), b = bh >> 2, h = bh & 3;
    const int colbase = role == 1 ? (idx & 7) * 8 : (idx & 3) * 16;
    const int cl = role == 1 ? (lane >> 3) : (lane >> 2);
    const int col = colbase + cl;
    const int sq = role == 1 ? (lane & 7) : (lane & 3);
    const size_t tb = (size_t)b * SEQ;
    bf16_t* dummy = (bf16_t*)(pws_() + WS_DUMMY) + (tid & 511) * 8;
    char* lw = (char*)smem + wave * SCAN_LDS_WAVE;
    char* lrow = lw;
    char* lcol = lw + 4096;
    float* lsc = (float*)(lw + 4352);
    const int fs = lane >> 3, fp = lane & 7;
    if (role == 0) {
        const int g = h >> 1;
        const float Dh = pin_(8)[l * 4 + h];
        uint4 f0, f1; unsigned fc = 0u; float fsc = 0.f;
        f2_t st[8];
#pragma unroll
        for (int i = 0; i < 8; ++i) st[i] = mk2(0.f, 0.f);
        auto fetch = [&](int t0) {
            const size_t tok = tb + t0 + fs;
            const bf16_t* src = HS + tok * 1024 + (fp < 4 ? 256 + g * 64 + fp * 16 : 384 + g * 64 + (fp - 4) * 16);
            f0 = *(const uint4*)src; f1 = *(const uint4*)(src + 8);
            fc = *(const unsigned*)(HS + tok * 1024 + h * 64 + colbase + fp * 2);
            if (lane < 16) fsc = SC[(tb + t0 + (lane >> 1)) * 16 + (lane & 1) * 4 + h];
        };
        fetch(0);
        for (int t0 = 0; t0 < SEQ; t0 += 8) {
            st8f(lrow + fs * 512 + fp * 64, f0); st8f(lrow + fs * 512 + fp * 64 + 32, f1);
            *(unsigned*)(lcol + fs * 32 + fp * 4) = fc;
            if (lane < 16) lsc[lane] = fsc;
            if (t0 + 8 < SEQ) fetch(t0 + 8);
#pragma unroll
            for (int i = 0; i < 8; ++i) {
                const char* rb = lrow + i * 512 + sq * 64;
                const float4 b0 = *(const float4*)rb, b1 = *(const float4*)(rb + 16), b2 = *(const float4*)(rb + 32), b3 = *(const float4*)(rb + 48);
                const float4 c0 = *(const float4*)(rb + 256), c1 = *(const float4*)(rb + 272), c2 = *(const float4*)(rb + 288), c3 = *(const float4*)(rb + 304);
                const float xv = bf2f(*(const bf16_t*)(lcol + i * 32 + cl * 2));
                const float2 sc2 = *(const float2*)(lsc + i * 2);
                const float xdt = xv * sc2.x;
                const f2_t xd2 = mk2(xdt, xdt), dA2 = mk2(sc2.y, sc2.y);
                const f2_t bb[8] = {mk2(b0.x, b0.y), mk2(b0.z, b0.w), mk2(b1.x, b1.y), mk2(b1.z, b1.w), mk2(b2.x, b2.y), mk2(b2.z, b2.w), mk2(b3.x, b3.y), mk2(b3.z, b3.w)};
                const f2_t cc[8] = {mk2(c0.x, c0.y), mk2(c0.z, c0.w), mk2(c1.x, c1.y), mk2(c1.z, c1.w), mk2(c2.x, c2.y), mk2(c2.z, c2.w), mk2(c3.x, c3.y), mk2(c3.z, c3.w)};
                f2_t ya = mk2(0.f, 0.f), yb = mk2(0.f, 0.f);
#pragma unroll
                for (int q = 0; q < 8; q += 2) {
                    st[q] = st[q] * dA2 + xd2 * bb[q]; st[q + 1] = st[q + 1] * dA2 + xd2 * bb[q + 1];
                    ya = cc[q] * st[q] + ya; yb = cc[q + 1] * st[q + 1] + yb;
                }
                const f2_t ys = ya + yb;
                const float y = quad_sum(ys.x + ys.y);
                *(sq == 0 ? Y + (tb + t0 + i) * DM + h * 64 + col : dummy + i) = f2bf(y + Dh * xv);
                if (i & 1) __builtin_amdgcn_sched_barrier(0);
            }
        }
    } else if (role == 1) {
        uint4 f0, f1; unsigned fc = 0u; float fsc = 0.f;
        f2_t S[4];
#pragma unroll
        for (int i = 0; i < 4; ++i) S[i] = mk2(0.f, 0.f);
        auto fetch = [&](int t0) {
            const size_t tok = tb + t0 + fs;
            const bf16_t* src = HS + tok * 1024 + (fp < 4 ? 512 + h * 64 + fp * 16 : 768 + h * 64 + (fp - 4) * 16);
            f0 = *(const uint4*)src; f1 = *(const uint4*)(src + 8);
            if (fp < 4) fc = *(const unsigned*)(VG + tok * 256 + h * 64 + colbase + fp * 2);
            if (lane < 16) fsc = SC[(tb + t0 + (lane >> 1)) * 16 + 8 + (lane & 1) * 4 + h];
        };
        fetch(0);
        for (int t0 = 0; t0 < SEQ; t0 += 8) {
            st8f(lrow + fs * 512 + fp * 64, f0); st8f(lrow + fs * 512 + fp * 64 + 32, f1);
            if (fp < 4) *(unsigned*)(lcol + fs * 32 + fp * 4) = fc;
            if (lane < 16) lsc[lane] = fsc;
            if (t0 + 8 < SEQ) fetch(t0 + 8);
#pragma unroll
            for (int i = 0; i < 8; ++i) {
                const char* rb = lrow + i * 512 + sq * 32;
                const float4 q0 = *(const float4*)rb, q1 = *(const float4*)(rb + 16);
                const float4 k0 = *(const float4*)(rb + 256), k1 = *(const float4*)(rb + 272);
                const float vv = bf2f(*(const bf16_t*)(lcol + i * 32 + cl * 2));
                const float2 sc2 = *(const float2*)(lsc + i * 2);
                const f2_t al2 = mk2(sc2.x, sc2.x);
                const f2_t kk[4] = {mk2(k0.x, k0.y), mk2(k0.z, k0.w), mk2(k1.x, k1.y), mk2(k1.z, k1.w)};
                const f2_t qq[4] = {mk2(q0.x, q0.y), mk2(q0.z, q0.w), mk2(q1.x, q1.y), mk2(q1.z, q1.w)};
                f2_t ra = mk2(0.f, 0.f), rb2 = mk2(0.f, 0.f);
#pragma unroll
                for (int q = 0; q < 4; q += 2) {
                    S[q] = S[q] * al2; S[q + 1] = S[q + 1] * al2;
                    ra = S[q] * kk[q] + ra; rb2 = S[q + 1] * kk[q + 1] + rb2;
                }
                const f2_t rs = ra + rb2;
                const float r = oct_sum(rs.x + rs.y);
                const float vn = sc2.y * (vv - r);
                const f2_t vn2 = mk2(vn, vn);
                f2_t oa2 = mk2(0.f, 0.f), ob2 = mk2(0.f, 0.f);
#pragma unroll
                for (int q = 0; q < 4; q += 2) {
                    S[q] = kk[q] * vn2 + S[q]; S[q + 1] = kk[q + 1] * vn2 + S[q + 1];
                    oa2 = S[q] * qq[q] + oa2; ob2 = S[q + 1] * qq[q + 1] + ob2;
                }
                const f2_t os = oa2 + ob2;
                const float ov = oct_sum(os.x + os.y);
                *(sq == 0 ? Y + (tb + t0 + i) * DM + 256 + h * 64 + col : dummy + i) = f2bf(ov);
                if (i & 1) __builtin_amdgcn_sched_barrier(0);
            }
        }
    } else {
        uint4 f0, f1; unsigned fc = 0u;
        f2_t S[4];
#pragma unroll
        for (int i = 0; i < 4; ++i) S[i] = mk2(0.f, 0.f);
        auto fetch = [&](int t0) {
            const size_t tok = tb + t0 + fs;
            if (fp < 4) { const float* src = DEC + tok * 128 + h * 32 + fp * 8; f0 = *(const uint4*)src; f1 = *(const uint4*)(src + 4); }
            else { const bf16_t* src = P + tok * LDP + (fp < 6 ? PC_LK + h * 32 + (fp - 4) * 16 : PC_LQ + h * 32 + (fp - 6) * 16); f0 = *(const uint4*)src; f1 = *(const uint4*)(src + 8); }
            fc = *(const unsigned*)(P + tok * LDP + PC_LV + h * 64 + colbase + fp * 2);
        };
        fetch(0);
        for (int t0 = 0; t0 < SEQ; t0 += 8) {
            if (fp < 4) { *(uint4*)(lrow + fs * 512 + fp * 32) = f0; *(uint4*)(lrow + fs * 512 + fp * 32 + 16) = f1; }
            else { st8f(lrow + fs * 512 + 128 + (fp - 4) * 64, f0); st8f(lrow + fs * 512 + 128 + (fp - 4) * 64 + 32, f1); }
            *(unsigned*)(lcol + fs * 32 + fp * 4) = fc;
            if (t0 + 8 < SEQ) fetch(t0 + 8);
#pragma unroll
            for (int i = 0; i < 8; ++i) {
                const char* rb = lrow + i * 512 + sq * 32;
                const float4 d0 = *(const float4*)rb, d1 = *(const float4*)(rb + 16);
                const float4 k0 = *(const float4*)(rb + 128), k1 = *(const float4*)(rb + 144);
                const float4 q0 = *(const float4*)(rb + 256), q1 = *(const float4*)(rb + 272);
                const float vv = bf2f(*(const bf16_t*)(lcol + i * 32 + cl * 2));
                const f2_t v2 = mk2(vv, vv);
                const f2_t dd[4] = {mk2(d0.x, d0.y), mk2(d0.z, d0.w), mk2(d1.x, d1.y), mk2(d1.z, d1.w)};
                const f2_t kk[4] = {mk2(k0.x, k0.y), mk2(k0.z, k0.w), mk2(k1.x, k1.y), mk2(k1.z, k1.w)};
                const f2_t qq[4] = {mk2(q0.x, q0.y), mk2(q0.z, q0.w), mk2(q1.x, q1.y), mk2(q1.z, q1.w)};
                f2_t oa2 = mk2(0.f, 0.f), ob2 = mk2(0.f, 0.f);
#pragma unroll
                for (int q = 0; q < 4; q += 2) {
                    S[q] = dd[q] * S[q] + kk[q] * v2; S[q + 1] = dd[q + 1] * S[q + 1] + kk[q + 1] * v2;
                    oa2 = S[q] * qq[q] + oa2; ob2 = S[q + 1] * qq[q + 1] + ob2;
                }
                const f2_t os = oa2 + ob2;
                const float ov = quad_sum(os.x + os.y);
                *(sq == 0 ? Y + (tb + t0 + i) * DM + 512 + h * 64 + col : dummy + i) = f2bf(ov * 0.17677669529663687f);
                if (i & 1) __builtin_amdgcn_sched_barrier(0);
            }
        }
    }
}

__device__ __forceinline__ void ph_mixer_finish(const Ctx& p, int l) {
    const bf16_t* P = (const bf16_t*)(pws_() + WS_P);
    bf16_t* Y = (bf16_t*)(pws_() + WS_Y);
    const float* sn = pin_(9) + (size_t)l * 256;
    const float* gn = pin_(13) + (size_t)l * 64;
    const float* ln = pin_(16) + (size_t)l * 64;
    const int lane = tid_() & 63;
    float gw1[8], gw2[8];
    load8f(lane < 32 ? sn + 8 * lane : gn + 8 * (lane & 7), gw1);
    load8f(ln + 8 * (lane & 7), gw2);
    const int nw = nwaves();
    int tok = gwave();
    uint4 nya, nga, nyb, ngb;
#define MF_LOAD(tk) do { const size_t row_ = (size_t)(tk) * LDP; \
        nya = *(const uint4*)(Y + (size_t)(tk) * DM + 8 * lane); \
        nga = *(const uint4*)(P + row_ + (lane < 32 ? PC_Z + 8 * lane : PC_GG + 8 * (lane - 32))); \
        nyb = *(const uint4*)(Y + (size_t)(tk) * DM + 512 + 8 * (lane & 31)); \
        ngb = *(const uint4*)(P + row_ + PC_LR + 8 * (lane & 31)); } while (0)
    MF_LOAD(tok);
    for (; tok < MTOK; tok += nw) {
        const uint4 ya = nya, ga = nga, yb = nyb, gb = ngb;
        { const int tn = tok + nw < MTOK ? tok + nw : tok; MF_LOAD(tn); }
        __builtin_amdgcn_sched_barrier(0);
        {
            float v[8], gt[8];
            unpack8(ya, v);
            unpack8(ga, gt);
            float ss = 0.f;
            if (lane < 32) {
#pragma unroll
                for (int i = 0; i < 8; ++i) { v[i] *= silu_f(gt[i]); ss += v[i] * v[i]; }
            } else {
#pragma unroll
                for (int i = 0; i < 8; ++i) ss += v[i] * v[i];
            }
            const float s8 = oct_sum(ss);
            float s32 = s8 + __int_as_float(__builtin_amdgcn_mov_dpp(__float_as_int(s8), 0x140, 0xF, 0xF, true));
            s32 += __shfl_xor(s32, 16, 64);
            const float rs = lane < 32 ? rsqrtf(s32 * (1.f / 256.f) + EPS) : rsqrtf(s8 * (1.f / 64.f) + EPS);
            float o[8];
#pragma unroll
            for (int i = 0; i < 8; ++i) o[i] = lane < 32 ? v[i] * rs * gw1[i] : v[i] * rs * gw1[i] * silu_f(gt[i]);
            *(uint4*)(Y + (size_t)tok * DM + 8 * lane) = pack8(o);
        }
        if (lane < 32) {
            float v[8], gt[8];
            unpack8(yb, v);
            unpack8(gb, gt);
            float ss = 0.f;
#pragma unroll
            for (int i = 0; i < 8; ++i) ss += v[i] * v[i];
            const float rs = rsqrtf(oct_sum(ss) * (1.f / 64.f) + EPS);
            float o[8];
#pragma unroll
            for (int i = 0; i < 8; ++i) o[i] = v[i] * rs * gw2[i] * silu_f(gt[i]);
            *(uint4*)(Y + (size_t)tok * DM + 512 + 8 * lane) = pack8(o);
        }
    }
#undef MF_LOAD
}

typedef short bf16x8_t __attribute__((ext_vector_type(8)));
typedef float f32x4_t __attribute__((ext_vector_type(4)));
union BF8 { bf16x8_t v; uint4 u; unsigned w[4]; };


__device__ __forceinline__ void ph_dsa_prep(const Ctx& p, int l) {
    const bf16_t* P = (const bf16_t*)(pws_() + WS_P);
    bf16_t* qn = (bf16_t*)(pws_() + WS_QN);
    bf16_t* kn = (bf16_t*)(pws_() + WS_KN);
    bf16_t* ikn = (bf16_t*)(pws_() + WS_IKN);
    bf16_t* vt = (bf16_t*)(pws_() + WS_VT);
    const float* qg = pin_(17) + (size_t)l * 64;
    const float* kg = pin_(18) + (size_t)l * 64;
    const float* ig = pin_(19) + (size_t)l * 32;
    const int lane = tid_() & 63;
    const int pcol = lane < 40 ? PC_DQ + 8 * lane : PC_IK + 8 * (lane & 3);
    float gw[8];
    load8f(lane < 32 ? qg + 8 * (lane & 7) : (lane < 40 ? kg + 8 * (lane & 7) : ig + 8 * (lane & 3)), gw);
    for (int grp = gwave(); grp < MTOK / 8; grp += nwaves()) {
        const size_t tok0 = (size_t)grp * 8;
        const int b = (int)(tok0 / SEQ), t0 = (int)(tok0 % SEQ);
        unsigned short vv[8];
#pragma unroll
        for (int i = 0; i < 8; ++i) {
            const size_t row = (tok0 + i) * LDP;
            vv[i] = P[row + PC_DV + lane];
            if (lane < 44) {
                float v[8];
                unpack8(*(const uint4*)(P + row + pcol), v);
                float ss = 0.f;
#pragma unroll
                for (int q = 0; q < 8; ++q) ss += v[q] * v[q];
                const float s4 = ss + __int_as_float(__builtin_amdgcn_mov_dpp(__float_as_int(ss), 0xB1, 0xF, 0xF, true));
                const float s4b = s4 + __int_as_float(__builtin_amdgcn_mov_dpp(__float_as_int(s4), 0x4E, 0xF, 0xF, true));
                const float s8 = s4b + __int_as_float(__builtin_amdgcn_mov_dpp(__float_as_int(s4b), 0x141, 0xF, 0xF, true));
                const float rs = lane < 40 ? rsqrtf(s8 * (1.f / 64.f) + EPS) * (lane < 32 ? 0.125f : 1.f) : rsqrtf(s4b * (1.f / 32.f) + EPS);
                float o[8];
#pragma unroll
                for (int q = 0; q < 8; ++q) o[q] = v[q] * rs * gw[q];
                const uint4 pk = pack8(o);
                if (lane < 32) *(uint4*)(qn + (tok0 + i) * 256 + 8 * lane) = pk;
                else if (lane < 40) *(uint4*)(kn + (tok0 + i) * 64 + 8 * (lane - 32)) = pk;
                else *(uint4*)(ikn + (tok0 + i) * 32 + 8 * (lane - 40)) = pk;
            }
        }
        uint4 o; o.x = (unsigned)vv[0] | ((unsigned)vv[1] << 16); o.y = (unsigned)vv[2] | ((unsigned)vv[3] << 16);
        o.z = (unsigned)vv[4] | ((unsigned)vv[5] << 16); o.w = (unsigned)vv[6] | ((unsigned)vv[7] << 16);
        *(uint4*)(vt + ((size_t)b * 64 + lane) * SEQ + t0) = o;
    }
}

#define DSA_STRIDE 2052
__device__ __forceinline__ int wave_total_i(int v) {
    v += __builtin_amdgcn_update_dpp(0, v, 0x111, 0xf, 0xf, true);
    v += __builtin_amdgcn_update_dpp(0, v, 0x112, 0xf, 0xf, true);
    v += __builtin_amdgcn_update_dpp(0, v, 0x114, 0xf, 0xf, true);
    v += __builtin_amdgcn_update_dpp(0, v, 0x118, 0xf, 0xf, true);
    return __builtin_amdgcn_readlane(v, 15) + __builtin_amdgcn_readlane(v, 31) + __builtin_amdgcn_readlane(v, 47) + __builtin_amdgcn_readlane(v, 63);
}
template <int NJ>
__device__ __forceinline__ void dsa_select(const unsigned* scq, int nj, int lane, unsigned& T_out, int& cut_out) {
    unsigned kreg[NJ];
#pragma unroll
    for (int j = 0; j < NJ; ++j) kreg[j] = (j < nj) ? scq[j * 64 + lane] : 0u;
    unsigned T = 0u; bool exact = false;
    for (int bit = 31; bit >= 0; --bit) {
        const unsigned cand = T | (1u << bit);
        int c = 0;
#pragma unroll
        for (int j = 0; j < NJ; ++j) c += (kreg[j] >= cand) ? 1 : 0;
        const int cnt = wave_total_i(c);
        if (cnt >= 256) { T = cand; if (cnt == 256) { exact = true; break; } }
    }
    int cut = 0x7fffffff;
    if (!exact) {
        int cgt = 0, ceq = 0;
#pragma unroll
        for (int j = 0; j < NJ; ++j) { cgt += __popcll(__ballot(kreg[j] > T)); ceq += __popcll(__ballot(kreg[j] == T)); }
        int need = 256 - cgt;
        if (ceq > need) {
            bool found = false;
#pragma unroll
            for (int j = 0; j < NJ; ++j) {
                const unsigned long long m = __ballot(kreg[j] == T);
                const int cj = __popcll(m);
                if (!found) {
                    if (need <= cj) { for (int bpos = 0; bpos < 64; ++bpos) if ((m >> bpos) & 1ull) { if (--need == 0) { cut = j * 64 + bpos; break; } } found = true; }
                    else need -= cj;
                }
            }
        }
    }
    T_out = T; cut_out = cut;
}
__device__ __forceinline__ void ph_dsa_main(const Ctx& p, int l, float* smem) {
    const bf16_t* P = (const bf16_t*)(pws_() + WS_P);
    bf16_t* Y = (bf16_t*)(pws_() + WS_Y);
    const bf16_t* QN = (const bf16_t*)(pws_() + WS_QN);
    const bf16_t* KN = (const bf16_t*)(pws_() + WS_KN);
    const bf16_t* IKN = (const bf16_t*)(pws_() + WS_IKN);
    const bf16_t* VT = (const bf16_t*)(pws_() + WS_VT);
    unsigned* sc = (unsigned*)smem;
    float* part = smem;
    float* plsum = smem + 8 * 64 * 64;
    unsigned* thr = (unsigned*)(smem + 35000);
    for (int task = bid_(); task < MTOK / 16; task += nblk_()) {
        const int tid = tid_(), lane = tid & 63, w = tid >> 6, qi = lane & 15, g = lane >> 4;
        const int c = 31 - task / 128, b = (task >> 2) & 31, sub = task & 3;
        const int t0 = c * 64 + sub * 16, nk = (c + 1) * 64;
        const size_t tok0 = (size_t)b * SEQ + t0;
        const bool dosel = nk > 256;
        if (dosel) {
            BF8 iqf[8]; float wq[8];
#pragma unroll
            for (int h = 0; h < 8; ++h) {
                iqf[h].u = *(const uint4*)(P + (tok0 + qi) * LDP + PC_IQ + h * 32 + 8 * g);
                wq[h] = bf2f(P[(tok0 + qi) * LDP + PC_IW + h]) * 0.0625f;
            }
            BF8 kan; kan.u = *(const uint4*)(IKN + ((size_t)b * SEQ + w * 16 + qi) * 32 + 8 * g);
            for (int kt = w; kt < nk / 16; kt += 8) {
                const int s0 = kt * 16;
                BF8 ka = kan;
                { const int ktn = kt + 8 < nk / 16 ? kt + 8 : kt; kan.u = *(const uint4*)(IKN + ((size_t)b * SEQ + ktn * 16 + qi) * 32 + 8 * g); }
                float acc[4] = {0.f, 0.f, 0.f, 0.f};
#pragma unroll
                for (int h = 0; h < 8; ++h) {
                    const f32x4_t d = __builtin_amdgcn_mfma_f32_16x16x32_bf16(ka.v, iqf[h].v, (f32x4_t){0.f, 0.f, 0.f, 0.f}, 0, 0, 0);
#pragma unroll
                    for (int r = 0; r < 4; ++r) acc[r] = __builtin_fmaf(wq[h], fmaxf(d[r], 0.f), acc[r]);
                }
                uint4 kv; kv.x = ford(acc[0]); kv.y = ford(acc[1]); kv.z = ford(acc[2]); kv.w = ford(acc[3]);
                *(uint4*)(sc + qi * DSA_STRIDE + s0 + 4 * g) = kv;
            }
        }
        __syncthreads();
        if (dosel) {
            const int nj = nk >> 6;
#pragma unroll 1
            for (int qq = 0; qq < 2; ++qq) {
                const int q = 2 * w + qq;
                unsigned T; int cut;
                if (nj <= 8) dsa_select<8>(sc + q * DSA_STRIDE, nj, lane, T, cut);
                else if (nj <= 16) dsa_select<16>(sc + q * DSA_STRIDE, nj, lane, T, cut);
                else if (nj <= 24) dsa_select<24>(sc + q * DSA_STRIDE, nj, lane, T, cut);
                else dsa_select<32>(sc + q * DSA_STRIDE, nj, lane, T, cut);
                if (lane == 0) { thr[q] = T; thr[16 + q] = (unsigned)cut; }
            }
        }
        __syncthreads();
        unsigned Tq = 0u; int cutq = 0x7fffffff;
        if (dosel) { Tq = thr[qi]; cutq = (int)thr[16 + qi]; }
        f32x4_t oacc[4][4]; float lsum[4];
#pragma unroll
        for (int h = 0; h < 4; ++h) { lsum[h] = 0.f;
#pragma unroll
            for (int dt = 0; dt < 4; ++dt) oacc[h][dt] = (f32x4_t){0.f, 0.f, 0.f, 0.f}; }
        const int krow = 8 * (qi >> 2) + (qi & 3);
        BF8 kan[2][2], van[4];
#define DSA_KV(st_) do { const int s0_ = (st_) * 32; \
            _Pragma("unroll") for (int t = 0; t < 2; ++t) _Pragma("unroll") for (int s2 = 0; s2 < 2; ++s2) kan[t][s2].u = *(const uint4*)(KN + ((size_t)b * SEQ + s0_ + krow + 4 * t) * 64 + 32 * s2 + 8 * g); \
            _Pragma("unroll") for (int dt = 0; dt < 4; ++dt) van[dt].u = *(const uint4*)(VT + ((size_t)b * 64 + 16 * dt + qi) * SEQ + s0_ + 8 * g); } while (0)
        if (w < nk / 32) DSA_KV(w);
        for (int st = w; st < nk / 32; st += 8) {
            const int s0 = st * 32;
            BF8 ka[2][2], va[4];
#pragma unroll
            for (int t = 0; t < 2; ++t)
#pragma unroll
                for (int s2 = 0; s2 < 2; ++s2) ka[t][s2] = kan[t][s2];
#pragma unroll
            for (int dt = 0; dt < 4; ++dt) va[dt] = van[dt];
            { const int stn = st + 8 < nk / 32 ? st + 8 : st; DSA_KV(stn); }
            float mk[8];
            if (dosel) {
                const uint4 k0 = *(const uint4*)(sc + qi * DSA_STRIDE + s0 + 8 * g), k1 = *(const uint4*)(sc + qi * DSA_STRIDE + s0 + 8 * g + 4);
                const unsigned kk[8] = {k0.x, k0.y, k0.z, k0.w, k1.x, k1.y, k1.z, k1.w};
#pragma unroll
                for (int j = 0; j < 8; ++j) mk[j] = (kk[j] > Tq || (kk[j] == Tq && (s0 + 8 * g + j) <= cutq)) ? 1.f : 0.f;
            } else {
#pragma unroll
                for (int j = 0; j < 8; ++j) mk[j] = 1.f;
            }
#pragma unroll
            for (int h = 0; h < 4; ++h) {
                BF8 q0, q1;
                q0.u = *(const uint4*)(QN + (tok0 + qi) * 256 + h * 64 + 8 * g);
                q1.u = *(const uint4*)(QN + (tok0 + qi) * 256 + h * 64 + 32 + 8 * g);
                f32x4_t sacc[2];
#pragma unroll
                for (int t = 0; t < 2; ++t) {
                    sacc[t] = __builtin_amdgcn_mfma_f32_16x16x32_bf16(ka[t][0].v, q0.v, (f32x4_t){0.f, 0.f, 0.f, 0.f}, 0, 0, 0);
                    sacc[t] = __builtin_amdgcn_mfma_f32_16x16x32_bf16(ka[t][1].v, q1.v, sacc[t], 0, 0, 0);
                }
                float pe[8];
#pragma unroll
                for (int t = 0; t < 2; ++t)
#pragma unroll
                    for (int r = 0; r < 4; ++r) { pe[4 * t + r] = __expf(sacc[t][r]) * mk[4 * t + r]; lsum[h] += pe[4 * t + r]; }
                BF8 pf;
#pragma unroll
                for (int j = 0; j < 4; ++j) pf.w[j] = pk_bf16(pe[2 * j], pe[2 * j + 1]);
#pragma unroll
                for (int dt = 0; dt < 4; ++dt) oacc[h][dt] = __builtin_amdgcn_mfma_f32_16x16x32_bf16(va[dt].v, pf.v, oacc[h][dt], 0, 0, 0);
            }
        }
#undef DSA_KV
        __syncthreads();
#pragma unroll
        for (int h = 0; h < 4; ++h) {
            plsum[(w * 4 + h) * 64 + lane] = lsum[h];
#pragma unroll
            for (int dt = 0; dt < 4; ++dt)
#pragma unroll
                for (int r = 0; r < 4; ++r) part[(w * 64 + h * 16 + dt * 4 + r) * 64 + lane] = oacc[h][dt][r];
        }
        __syncthreads();
        {
            const int h = w >> 1;
            float lq = 0.f;
#pragma unroll
            for (int w2 = 0; w2 < 8; ++w2)
#pragma unroll
                for (int g2 = 0; g2 < 4; ++g2) lq += plsum[(w2 * 4 + h) * 64 + qi + 16 * g2];
            const float inv = 1.f / lq;
#pragma unroll
            for (int dd = 0; dd < 2; ++dd) {
                const int dt = (w & 1) * 2 + dd;
                float o[4];
#pragma unroll
                for (int r = 0; r < 4; ++r) {
                    float sacc = 0.f;
#pragma unroll
                    for (int w2 = 0; w2 < 8; ++w2) sacc += part[(w2 * 64 + h * 16 + dt * 4 + r) * 64 + lane];
                    o[r] = sacc * inv;
                }
                uint2 ov; ov.x = pk_bf16(o[0], o[1]); ov.y = pk_bf16(o[2], o[3]);
                *(uint2*)(Y + (tok0 + qi) * DM + 768 + h * 64 + 16 * dt + 4 * g) = ov;
            }
        }
        __syncthreads();
    }
}

__device__ __forceinline__ void ph_mem_prep(const Ctx& p, int l) {
    const float* Km = (const float*)(pws_() + WS_KM);
    const float* Vm = (const float*)(pws_() + WS_VM);
    bf16_t* KB = (bf16_t*)(pws_() + WS_KB);
    bf16_t* VTB = (bf16_t*)(pws_() + WS_VTB);
    const float* kg = pin_(28) + (size_t)l * 64;
    const int lane = tid_() & 63;
    for (int r = gwave(); r < MMEM; r += nwaves()) {
        const int b = r / NMEM, j = r % NMEM;
#pragma unroll
        for (int h = 0; h < 4; ++h) {
            const float v = Km[(size_t)r * 256 + h * 64 + lane];
            const float ss = wave_sum(v * v);
            KB[(((size_t)b * 4 + h) * NMEM + j) * 64 + lane] = f2bf(v * rsqrtf(ss * (1.f / 64.f) + EPS) * kg[lane]);
            VTB[(((size_t)b * 4 + h) * 64 + lane) * NMEM + j] = f2bf(Vm[(size_t)r * 256 + h * 64 + lane]);
        }
    }
}
__device__ __forceinline__ void ph_xattn(const Ctx& p, int l, int task0 = 0, int ntask = MTOK / 16, int w0 = -1, int wstep = 0) {
    const float* Qx = (const float*)(pws_() + WS_QX);
    bf16_t* Ox = (bf16_t*)(pws_() + WS_OX);
    const bf16_t* KB = (const bf16_t*)(pws_() + WS_KB);
    const bf16_t* VTB = (const bf16_t*)(pws_() + WS_VTB);
    const float* qg = pin_(27) + (size_t)l * 64;
    const int lane = tid_() & 63, qi = lane & 15, g = lane >> 4;
    if (w0 < 0) { w0 = gwave(); wstep = nwaves(); }
    for (int task = task0 + w0; task < task0 + ntask; task += wstep) {
        const int tok0 = task * 16, b = tok0 / SEQ;
#pragma unroll 1
        for (int h = 0; h < 4; ++h) {
            BF8 qf[2];
            {
                float qv[2][8]; float ss = 0.f;
#pragma unroll
                for (int s2 = 0; s2 < 2; ++s2) {
                    const float4* qp = (const float4*)(Qx + (size_t)(tok0 + qi) * 256 + h * 64 + 32 * s2 + 8 * g);
                    const float4 a = qp[0], c = qp[1];
                    qv[s2][0] = a.x; qv[s2][1] = a.y; qv[s2][2] = a.z; qv[s2][3] = a.w; qv[s2][4] = c.x; qv[s2][5] = c.y; qv[s2][6] = c.z; qv[s2][7] = c.w;
#pragma unroll
                    for (int j = 0; j < 8; ++j) ss += qv[s2][j] * qv[s2][j];
                }
                ss += __shfl_xor(ss, 16, 64); ss += __shfl_xor(ss, 32, 64);
                const float rs = rsqrtf(ss * (1.f / 64.f) + EPS) * 0.125f;
#pragma unroll
                for (int s2 = 0; s2 < 2; ++s2) {
                    const float4 g0 = *(const float4*)(qg + 32 * s2 + 8 * g), g1 = *(const float4*)(qg + 32 * s2 + 8 * g + 4);
                    qf[s2].w[0] = pk_bf16(qv[s2][0] * rs * g0.x, qv[s2][1] * rs * g0.y); qf[s2].w[1] = pk_bf16(qv[s2][2] * rs * g0.z, qv[s2][3] * rs * g0.w);
                    qf[s2].w[2] = pk_bf16(qv[s2][4] * rs * g1.x, qv[s2][5] * rs * g1.y); qf[s2].w[3] = pk_bf16(qv[s2][6] * rs * g1.z, qv[s2][7] * rs * g1.w);
                }
            }
            const bf16_t* Kh = KB + ((size_t)b * 4 + h) * NMEM * 64;
            const bf16_t* Vh = VTB + ((size_t)b * 4 + h) * 64 * NMEM;
            f32x4_t oacc[4];
#pragma unroll
            for (int dt = 0; dt < 4; ++dt) oacc[dt] = (f32x4_t){0.f, 0.f, 0.f, 0.f};
            float lsum = 0.f;
            const int krow = 8 * (qi >> 2) + (qi & 3);
#pragma unroll 2
            for (int s0 = 0; s0 < NMEM; s0 += 32) {
                BF8 ka[2][2], va[4];
#pragma unroll
                for (int t = 0; t < 2; ++t)
#pragma unroll
                    for (int s2 = 0; s2 < 2; ++s2) ka[t][s2].u = *(const uint4*)(Kh + (size_t)(s0 + krow + 4 * t) * 64 + 32 * s2 + 8 * g);
#pragma unroll
                for (int dt = 0; dt < 4; ++dt) va[dt].u = *(const uint4*)(Vh + (size_t)(16 * dt + qi) * NMEM + s0 + 8 * g);
                f32x4_t sacc[2];
#pragma unroll
                for (int t = 0; t < 2; ++t) {
                    sacc[t] = (f32x4_t){0.f, 0.f, 0.f, 0.f};
                    sacc[t] = __builtin_amdgcn_mfma_f32_16x16x32_bf16(ka[t][0].v, qf[0].v, sacc[t], 0, 0, 0);
                    sacc[t] = __builtin_amdgcn_mfma_f32_16x16x32_bf16(ka[t][1].v, qf[1].v, sacc[t], 0, 0, 0);
                }
                float pe[8];
#pragma unroll
                for (int t = 0; t < 2; ++t)
#pragma unroll
                    for (int r = 0; r < 4; ++r) { pe[4 * t + r] = __expf(sacc[t][r]); lsum += pe[4 * t + r]; }
                BF8 pf;
#pragma unroll
                for (int j = 0; j < 4; ++j) pf.w[j] = pk_bf16(pe[2 * j], pe[2 * j + 1]);
#pragma unroll
                for (int dt = 0; dt < 4; ++dt) oacc[dt] = __builtin_amdgcn_mfma_f32_16x16x32_bf16(va[dt].v, pf.v, oacc[dt], 0, 0, 0);
            }
            lsum += __shfl_xor(lsum, 16, 64); lsum += __shfl_xor(lsum, 32, 64);
            const float inv = 1.f / lsum;
#pragma unroll
            for (int dt = 0; dt < 4; ++dt) {
                uint2 o; o.x = pk_bf16(oacc[dt][0] * inv, oacc[dt][1] * inv); o.y = pk_bf16(oacc[dt][2] * inv, oacc[dt][3] * inv);
                *(uint2*)(Ox + (size_t)(tok0 + qi) * 256 + h * 64 + 16 * dt + 4 * g) = o;
            }
        }
    }
}

template <int N> __device__ __forceinline__ void bitonic_sort_desc(unsigned (&a)[N]) {
#pragma unroll
    for (int k = 2; k <= N; k <<= 1)
#pragma unroll
        for (int j = k >> 1; j > 0; j >>= 1)
#pragma unroll
            for (int i = 0; i < N; ++i) {
                const int o = i ^ j;
                if (o > i) {
                    const bool desc = ((i & k) == 0);
                    const unsigned x = a[i], y = a[o];
                    const unsigned mx = x > y ? x : y, mn = x > y ? y : x;
                    a[i] = desc ? mx : mn; a[o] = desc ? mn : mx;
                }
            }
}
__device__ __forceinline__ void bitonic_merge16_desc(unsigned (&a)[16]) {
#pragma unroll
    for (int j = 8; j > 0; j >>= 1)
#pragma unroll
        for (int i = 0; i < 16; ++i) {
            const int o = i ^ j;
            if (o > i) { const unsigned x = a[i], y = a[o]; a[i] = x > y ? x : y; a[o] = x > y ? y : x; }
        }
}
__device__ __forceinline__ void top16_merge(unsigned (&a)[16], const unsigned (&b)[16]) {
#pragma unroll
    for (int i = 0; i < 16; ++i) a[i] = a[i] > b[15 - i] ? a[i] : b[15 - i];
    bitonic_merge16_desc(a);
}
__device__ __forceinline__ void top16_xlane(unsigned (&a)[16], int xm) {
    unsigned b[16];
#pragma unroll
    for (int i = 0; i < 16; ++i) b[i] = (unsigned)__shfl_xor((int)a[i], xm, 64);
    top16_merge(a, b);
}
__device__ __forceinline__ void ph_subkeys_convert(const Ctx& p) {
    const float* sk = pin_(31);
    bf16_t* o = (bf16_t*)(pws_() + WS_SKB);
    const size_t n = (size_t)DEPTH * 8 * 2 * 128 * 64;
    for (size_t i = (size_t)bid_() * 512 + tid_(); i < n; i += (size_t)nblk_() * 512) o[i] = f2bf(sk[i]);
}
__device__ __forceinline__ void ph_peer_topk(const Ctx& p, int l, float* smem, int task0 = 0, int ntask = MTOK / 16, int w0 = -1, int wstep = 0) {
    const bf16_t* Qp = (const bf16_t*)(pws_() + WS_QP);
    const bf16_t* SK = (const bf16_t*)(pws_() + WS_SKB) + (size_t)l * 8 * 2 * 128 * 64;
    int* pidx = (int*)(pws_() + WS_PEI);
    float* pgt = (float*)(pws_() + WS_PEG);
    float* pus = (float*)(pws_() + WS_PUS);
    const float* usc = (const float*)(pws_() + WS_USC) + (size_t)l * NEXP;
    const float* vsc = (const float*)(pws_() + WS_VSC) + (size_t)l * NEXP;
    const int tid = tid_(), lane = tid & 63, wave = tid >> 6, qi = lane & 15, g = lane >> 4;
    int* tabw = (int*)smem + wave * 512 + qi * 32;
    if (w0 < 0) { w0 = gwave(); wstep = nwaves(); }
    for (int task = task0 + w0; task < task0 + ntask; task += wstep) {
        const size_t tok = (size_t)task * 16 + qi;
#pragma unroll 1
        for (int h = 0; h < 8; ++h) {
            unsigned L[2][16];
#pragma unroll
            for (int pp = 0; pp < 2; ++pp) {
                BF8 qf[2];
#pragma unroll
                for (int s2 = 0; s2 < 2; ++s2) qf[s2].u = *(const uint4*)(Qp + tok * DM + h * 128 + pp * 64 + 32 * s2 + 8 * g);
                const bf16_t* skp = SK + (size_t)(h * 2 + pp) * 128 * 64;
                unsigned va[16], vb[16];
                BF8 kall[8][2];
#pragma unroll
                for (int tile = 0; tile < 8; ++tile)
#pragma unroll
                    for (int s2 = 0; s2 < 2; ++s2) kall[tile][s2].u = *(const uint4*)(skp + (size_t)(16 * tile + qi) * 64 + 32 * s2 + 8 * g);
                __builtin_amdgcn_sched_barrier(0);
#pragma unroll
                for (int tile = 0; tile < 8; ++tile) {
                    f32x4_t d = __builtin_amdgcn_mfma_f32_16x16x32_bf16(kall[tile][0].v, qf[0].v, (f32x4_t){0.f, 0.f, 0.f, 0.f}, 0, 0, 0);
                    d = __builtin_amdgcn_mfma_f32_16x16x32_bf16(kall[tile][1].v, qf[1].v, d, 0, 0, 0);
#pragma unroll
                    for (int r = 0; r < 4; ++r) {
                        const unsigned key = (ford(d[r]) & ~127u) | (unsigned)(127 - (16 * tile + 4 * g + r));
                        if (tile < 4) va[tile * 4 + r] = key; else vb[(tile - 4) * 4 + r] = key;
                    }
                }
                bitonic_sort_desc<16>(va);
                bitonic_sort_desc<16>(vb);
                top16_merge(va, vb);
                top16_xlane(va, 16);
                top16_xlane(va, 32);
#pragma unroll
                for (int i = 0; i < 16; ++i) L[pp][i] = va[i];
            }
            if (g < 2) {
#pragma unroll
                for (int i = 0; i < 16; ++i) tabw[g * 16 + i] = 127 - (int)((g == 0 ? L[0][i] : L[1][i]) & 127u);
            }
            float s1[16], s2v[16];
#pragma unroll
            for (int i = 0; i < 16; ++i) { s1[i] = funord(L[0][i] & ~127u); s2v[i] = funord(L[1][i] & ~127u); }
            unsigned ca[16], cb[16];
#pragma unroll
            for (int i = 0; i < 16; ++i) { ca[i] = 0u; cb[i] = 0u; }
            {
                const float r0 = g == 0 ? s1[0] : (g == 1 ? s1[1] : (g == 2 ? s1[2] : s1[3]));
                const int nb0 = g == 0 ? 16 : (g == 1 ? 8 : (g == 2 ? 5 : 4));
#pragma unroll
                for (int bq = 0; bq < 16; ++bq) if (bq < nb0) ca[bq] = (ford(r0 + s2v[bq]) & ~255u) | (unsigned)(255 - (g * 16 + bq));
                const float r1 = g == 0 ? s1[4] : (g == 1 ? s1[5] : (g == 2 ? s1[6] : s1[7]));
                const int nb1 = g == 0 ? 3 : 2;
#pragma unroll
                for (int bq = 0; bq < 3; ++bq) if (bq < nb1) cb[bq] = (ford(r1 + s2v[bq]) & ~255u) | (unsigned)(255 - ((g + 4) * 16 + bq));
                const float r2 = g == 0 ? s1[8] : (g == 1 ? s1[9] : (g == 2 ? s1[10] : s1[11]));
                cb[3] = (ford(r2 + s2v[0]) & ~255u) | (unsigned)(255 - ((g + 8) * 16));
                const float r3 = g == 0 ? s1[12] : (g == 1 ? s1[13] : (g == 2 ? s1[14] : s1[15]));
                cb[4] = (ford(r3 + s2v[0]) & ~255u) | (unsigned)(255 - ((g + 12) * 16));
            }
            bitonic_sort_desc<16>(ca);
            bitonic_sort_desc<16>(cb);
            top16_merge(ca, cb);
            top16_xlane(ca, 16);
            top16_xlane(ca, 32);
            float tv[16]; float den = 0.f;
#pragma unroll
            for (int i = 0; i < 16; ++i) {
                const int f = 255 - (int)(ca[i] & 255u);
                const int a = f >> 4, bq = f & 15;
                tv[i] = funord(ca[i] & ~255u);
                (void)a; (void)bq;
            }
#pragma unroll
            for (int i = 0; i < 16; ++i) { tv[i] = __expf(tv[i] - funord(ca[0] & ~255u)); den += tv[i]; }
            const float inv = 1.f / den;
            int ev[4]; float gv[4];
#pragma unroll
            for (int r = 0; r < 4; ++r) {
                const unsigned key = g == 0 ? ca[r] : (g == 1 ? ca[4 + r] : (g == 2 ? ca[8 + r] : ca[12 + r]));
                const float tvv = g == 0 ? tv[r] : (g == 1 ? tv[4 + r] : (g == 2 ? tv[8 + r] : tv[12 + r]));
                const int f = 255 - (int)(key & 255u);
                ev[r] = tabw[f >> 4] * 128 + tabw[16 + (f & 15)];
                gv[r] = tvv * inv;
            }
            float us[4];
#pragma unroll
            for (int r = 0; r < 4; ++r) { us[r] = usc[ev[r]]; gv[r] *= vsc[ev[r]]; }
            *(int4*)(pidx + tok * 128 + h * 16 + 4 * g) = make_int4(ev[0], ev[1], ev[2], ev[3]);
            *(float4*)(pgt + tok * 128 + h * 16 + 4 * g) = make_float4(gv[0], gv[1], gv[2], gv[3]);
            *(float4*)(pus + tok * 128 + h * 16 + 4 * g) = make_float4(us[0], us[1], us[2], us[3]);
        }
    }
}

typedef float f32x2_t __attribute__((ext_vector_type(2)));
typedef int i32x8_t __attribute__((ext_vector_type(8)));
__device__ __forceinline__ unsigned pack4_fp8(float4 a, float sc) {
    const float x = fminf(fmaxf(a.x * sc, -448.f), 448.f), y = fminf(fmaxf(a.y * sc, -448.f), 448.f);
    const float z = fminf(fmaxf(a.z * sc, -448.f), 448.f), w = fminf(fmaxf(a.w * sc, -448.f), 448.f);
    int r = __builtin_amdgcn_cvt_pk_fp8_f32(x, y, 0, false);
    r = __builtin_amdgcn_cvt_pk_fp8_f32(z, w, r, true);
    return (unsigned)r;
}
__device__ __forceinline__ unsigned q4_e2m1(float y) {
    const float a = fabsf(y);
    const unsigned c = (unsigned)(a > 0.25f) + (unsigned)(a > 0.75f) + (unsigned)(a > 1.25f) + (unsigned)(a > 1.75f) + (unsigned)(a > 2.5f) + (unsigned)(a > 3.5f) + (unsigned)(a > 5.0f);
    return c | (y < 0.f ? 8u : 0u);
}
__device__ __forceinline__ void ph_tab_convert_all(const Ctx& p) {
    const int lane = tid_() & 63;
    for (int row = gwave(); row < 2 * DEPTH * NEXP; row += nwaves()) {
        const int tabv = row >= DEPTH * NEXP;
        const int rr = tabv ? row - DEPTH * NEXP : row;
        const float4* src = (const float4*)((tabv ? pin_(33) : pin_(32)) + (size_t)rr * DM);
        float4 v[4]; float am = 0.f;
#pragma unroll
        for (int i = 0; i < 4; ++i) { v[i] = src[lane + 64 * i]; am = fmaxf(am, fmaxf(fmaxf(fabsf(v[i].x), fabsf(v[i].y)), fmaxf(fabsf(v[i].z), fabsf(v[i].w)))); }
        am = wave_max(am);
        const float sc = am > 0.f ? am * (1.f / 6.f) : 1.f, inv = 1.f / sc;
        unsigned char* dst = (unsigned char*)(pws_() + (tabv ? WS_V4 : WS_U4)) + (size_t)rr * 512;
#pragma unroll
        for (int i = 0; i < 4; ++i) {
            const unsigned pk = q4_e2m1(v[i].x * inv) | (q4_e2m1(v[i].y * inv) << 4) | (q4_e2m1(v[i].z * inv) << 8) | (q4_e2m1(v[i].w * inv) << 12);
            const int off = tabv ? 16 * (lane >> 1) + 4 * i + 2 * (lane & 1) : 128 * i + 2 * lane;
            *(unsigned short*)(dst + off) = (unsigned short)pk;
        }
        if (lane == 0) ((float*)(pws_() + (tabv ? WS_VSC : WS_USC)))[rr] = sc;
    }
}
__device__ __forceinline__ float dpp_xor1(float v) { return __int_as_float(__builtin_amdgcn_update_dpp(0, __float_as_int(v), 0xB1, 0xF, 0xF, true)); }
__device__ __forceinline__ void ph_peer_u4(const Ctx& p, int l, float* smem) {
    const unsigned char* ut = (const unsigned char*)(pws_() + WS_U4) + (size_t)l * NEXP * 512;
    const int* pidx = (const int*)(pws_() + WS_PEI);
    float* pgt = (float*)(pws_() + WS_PEG);
    const float* pus = (const float*)(pws_() + WS_PUS);
    const unsigned char* H8 = (const unsigned char*)(pws_() + WS_H8);
    const int lane = tid_() & 63, g = lane >> 4, i = lane & 15, wave = tid_() >> 6;
    const bool odd = i & 1;
    unsigned char* hl = (unsigned char*)smem + wave * 2048;
    const int nw = nwaves();
    int tok = gwave();
    int ne0 = pidx[(size_t)tok * 128 + lane], ne1 = pidx[(size_t)tok * 128 + 64 + lane];
    *(uint4*)(hl + 16 * lane) = *(const uint4*)(H8 + (size_t)tok * DM + 16 * lane);
    uint4 rA[8], rB[8], rC[8], rD[8];
    const int roff = 64 * (i & 1) + 16 * g;
#define PU_ROWS(buf, esrc, hq) do { const int ea_ = __builtin_amdgcn_ds_bpermute(((hq) * 16 + (i >> 1)) * 4, esrc), eb_ = __builtin_amdgcn_ds_bpermute(((hq) * 16 + 8 + (i >> 1)) * 4, esrc); \
        const unsigned char* pa_ = ut + (size_t)ea_ * 512 + roff; const unsigned char* pb_ = ut + (size_t)eb_ * 512 + roff; \
        _Pragma("unroll") for (int q_ = 0; q_ < 4; ++q_) { buf[q_] = *(const uint4*)(pa_ + 128 * q_); buf[4 + q_] = *(const uint4*)(pb_ + 128 * q_); } \
        __builtin_amdgcn_sched_barrier(0); } while (0)
#define PU_COMP(buf, hd) do { f32x4_t a0_ = {0.f, 0.f, 0.f, 0.f}, a1_ = {0.f, 0.f, 0.f, 0.f}; \
        _Pragma("unroll") for (int q_ = 0; q_ < 4; ++q_) { \
            const uint4 b0_ = *(const uint4*)(hb + 256 * q_), b1_ = *(const uint4*)(hb + 256 * q_ + 64); \
            const i32x8_t b_ = {(int)b0_.x, (int)b0_.y, (int)b0_.z, (int)b0_.w, (int)b1_.x, (int)b1_.y, (int)b1_.z, (int)b1_.w}; \
            const i32x8_t x_ = {(int)buf[q_].x, (int)buf[q_].y, (int)buf[q_].z, (int)buf[q_].w, 0, 0, 0, 0}; \
            const i32x8_t y_ = {(int)buf[4 + q_].x, (int)buf[4 + q_].y, (int)buf[4 + q_].z, (int)buf[4 + q_].w, 0, 0, 0, 0}; \
            a0_ = __builtin_amdgcn_mfma_scale_f32_16x16x128_f8f6f4(x_, b_, a0_, 4, 0, 0, 0, 0, 0); \
            a1_ = __builtin_amdgcn_mfma_scale_f32_16x16x128_f8f6f4(y_, b_, a1_, 4, 0, 0, 0, 0, 0); \
            __builtin_amdgcn_sched_barrier(0); } \
        float t0a_ = odd ? a0_[1] : a0_[0], t0b_ = odd ? a0_[3] : a0_[2], t1a_ = odd ? a1_[1] : a1_[0], t1b_ = odd ? a1_[3] : a1_[2]; \
        t0a_ += dpp_xor1(t0a_); t0b_ += dpp_xor1(t0b_); t1a_ += dpp_xor1(t1a_); t1b_ += dpp_xor1(t1b_); \
        if ((i >> 1) == (hd)) { keep0 = odd ? t1a_ : t0a_; keep1 = odd ? t1b_ : t0b_; } \
        __builtin_amdgcn_sched_barrier(0); } while (0)
    PU_ROWS(rA, ne0, 0); PU_ROWS(rB, ne0, 1); PU_ROWS(rC, ne0, 2);
    int par = 0;
    for (; tok < MTOK; tok += nw, par ^= 1) {
        const int e0 = ne0, e1 = ne1;
        const size_t tn = (size_t)(tok + nw < MTOK ? tok + nw : tok);
        const uint4 hnext = *(const uint4*)(H8 + tn * DM + 16 * lane);
        ne0 = pidx[tn * 128 + lane]; ne1 = pidx[tn * 128 + 64 + lane];
        const size_t mi = (size_t)tok * 128 + (i >> 1) * 16 + 8 * (i & 1) + 2 * g;
        const float2 gm = *(const float2*)(pgt + mi), um = *(const float2*)(pus + mi);
        asm volatile("s_waitcnt lgkmcnt(0)" ::: "memory"); __builtin_amdgcn_wave_barrier();
        const unsigned char* hb = hl + par * 1024 + 128 * (i & 1) + 16 * g;
        float keep0 = 0.f, keep1 = 0.f;
        PU_ROWS(rD, e0, 3); PU_COMP(rA, 0);
        PU_ROWS(rA, e1, 0); PU_COMP(rB, 1);
        PU_ROWS(rB, e1, 1); PU_COMP(rC, 2);
        PU_ROWS(rC, e1, 2); PU_COMP(rD, 3);
        PU_ROWS(rD, e1, 3); PU_COMP(rA, 4);
        PU_ROWS(rA, ne0, 0); PU_COMP(rB, 5);
        PU_ROWS(rB, ne0, 1); PU_COMP(rC, 6);
        PU_ROWS(rC, ne0, 2); PU_COMP(rD, 7);
        *(uint4*)(hl + (par ^ 1) * 1024 + 16 * lane) = hnext;
        float2 o;
        o.x = gm.x * gelu_tanh_f(keep0 * um.x * (1.f / H8_SCALE)); o.y = gm.y * gelu_tanh_f(keep1 * um.y * (1.f / H8_SCALE));
        *(float2*)(pgt + mi) = o;
    }
#undef PU_ROWS
#undef PU_COMP
}
template <bool NORM>
__device__ __forceinline__ void ph_peer_v4(const Ctx& p, int l) {
    const unsigned char* vt = (const unsigned char*)(pws_() + WS_V4) + (size_t)l * NEXP * 512;
    const int* pidx = (const int*)(pws_() + WS_PEI);
    const float* pgt = (const float*)(pws_() + WS_PEG);
    float* x = pout_();
    const int lane = tid_() & 63;
    const bool r = lane & 32;
    const int coff = 16 * (lane & 31);
    const int nw = nwaves();
    int tok = gwave();
    int ne0 = pidx[(size_t)tok * 128 + lane], ne1 = pidx[(size_t)tok * 128 + 64 + lane];
    float nc0 = pgt[(size_t)tok * 128 + lane], nc1 = pgt[(size_t)tok * 128 + 64 + lane];
    uint4 vA[16], vB[16];
    const int hsel = r ? 4 : 0;
    float4 gn[4];
    if (NORM) {
#pragma unroll
        for (int q = 0; q < 4; ++q) gn[q] = *(const float4*)(pin_(2) + (size_t)(l + 1) * DM + 256 * q + 8 * (lane & 31) + (r ? 4 : 0));
    }
#define PV_ROWS(buf, esrc, lb) do { _Pragma("unroll") for (int k_ = 0; k_ < 16; ++k_) { \
        const int e_ = __builtin_amdgcn_ds_bpermute(hsel + 4 * ((lb) + 2 * k_), esrc);        \
        buf[k_] = *(const uint4*)(vt + (size_t)e_ * 512 + coff); } __builtin_amdgcn_sched_barrier(0); } while (0)
#define PV_D4(W, q) do { \
        out[4 * (q) + 0] = __builtin_elementwise_fma(__builtin_amdgcn_cvt_scalef32_pk_f32_fp4(W, 1.0f, 0), c2_, out[4 * (q) + 0]); \
        out[4 * (q) + 1] = __builtin_elementwise_fma(__builtin_amdgcn_cvt_scalef32_pk_f32_fp4(W, 1.0f, 1), c2_, out[4 * (q) + 1]); \
        out[4 * (q) + 2] = __builtin_elementwise_fma(__builtin_amdgcn_cvt_scalef32_pk_f32_fp4(W, 1.0f, 2), c2_, out[4 * (q) + 2]); \
        out[4 * (q) + 3] = __builtin_elementwise_fma(__builtin_amdgcn_cvt_scalef32_pk_f32_fp4(W, 1.0f, 3), c2_, out[4 * (q) + 3]); } while (0)
#define PV_COMP(buf, csrc, lb) do { _Pragma("unroll") for (int k_ = 0; k_ < 16; ++k_) { \
        const float cj_ = __int_as_float(__builtin_amdgcn_ds_bpermute(hsel + 4 * ((lb) + 2 * k_), __float_as_int(csrc))); const f32x2_t c2_ = {cj_, cj_}; \
        PV_D4(buf[k_].x, 0); PV_D4(buf[k_].y, 1); PV_D4(buf[k_].z, 2); PV_D4(buf[k_].w, 3); } __builtin_amdgcn_sched_barrier(0); } while (0)
    PV_ROWS(vA, ne0, 0);
    for (; tok < MTOK; tok += nw) {
        const int e0 = ne0, e1 = ne1;
        const float c0 = nc0, c1 = nc1;
        {
            const size_t tn = (size_t)(tok + nw < MTOK ? tok + nw : tok);
            ne0 = pidx[tn * 128 + lane]; ne1 = pidx[tn * 128 + 64 + lane];
            nc0 = pgt[tn * 128 + lane]; nc1 = pgt[tn * 128 + 64 + lane];
        }
        f32x2_t out[16];
#pragma unroll
        for (int k = 0; k < 16; ++k) out[k] = (f32x2_t){0.f, 0.f};
        PV_ROWS(vB, e0, 32); PV_COMP(vA, c0, 0);
        PV_ROWS(vA, e1, 0);  PV_COMP(vB, c0, 32);
        PV_ROWS(vB, e1, 32); PV_COMP(vA, c1, 0);
        PV_ROWS(vA, ne0, 0); PV_COMP(vB, c1, 32);
        float4 xn[4]; float ss = 0.f;
#pragma unroll
        for (int q = 0; q < 4; ++q) {
            float fin[4];
#pragma unroll
            for (int b = 0; b < 2; ++b)
#pragma unroll
                for (int c = 0; c < 2; ++c) {
                    const float lo = out[4 * q + b][c], hi = out[4 * q + 2 + b][c];
                    const float mine = r ? hi : lo, send = r ? lo : hi;
                    fin[2 * b + c] = mine + __shfl_xor(send, 32, 64);
                }
            float4* xp = (float4*)(x + (size_t)tok * DM + 256 * q + 8 * (lane & 31) + (r ? 4 : 0));
            float4 a = *xp;
            a.x += fin[0]; a.y += fin[1]; a.z += fin[2]; a.w += fin[3];
            *xp = a;
            if (NORM) { xn[q] = a; ss += a.x * a.x + a.y * a.y + a.z * a.z + a.w * a.w; }
        }
        if (NORM) {
            ss = wave_sum(ss);
            const float rs = rsqrtf(ss * (1.f / DM) + EPS);
            bf16_t* hrow = (bf16_t*)(pws_() + WS_H) + (size_t)tok * DM + 8 * (lane & 31) + (r ? 4 : 0);
#pragma unroll
            for (int q = 0; q < 4; ++q) {
                uint2 o; o.x = pk_bf16(xn[q].x * rs * gn[q].x, xn[q].y * rs * gn[q].y); o.y = pk_bf16(xn[q].z * rs * gn[q].z, xn[q].w * rs * gn[q].w);
                *(uint2*)(hrow + 256 * q) = o;
            }
        }
    }
#undef PV_ROWS
#undef PV_COMP
#undef PV_D4
}


#ifndef PROBE_MASK
#define PROBE_MASK 0
#endif
#if PROBE_MASK
#define GB(k) do { GRID_BARRIER(); const unsigned long long now_ = wall_clock64(); if ((PROBE_MASK >> (k)) & 1) { const unsigned long long dt_ = now_ - tprev_; while (wall_clock64() - now_ < 3ull * dt_) __builtin_amdgcn_s_sleep(8); } GRID_BARRIER(); tprev_ = wall_clock64(); } while (0)
#else
#define GB(k) GRID_BARRIER()
#endif
__global__ void __launch_bounds__(512, 2) k_mega(Params kp) {
    float* sm = dynsmem;
    {
        unsigned long long* tab = (unsigned long long*)((char*)dynsmem + PTAB_OFF);
        if (threadIdx.x < 34) tab[threadIdx.x] = (unsigned long long)kp.in[threadIdx.x];
        if (threadIdx.x == 34) tab[34] = (unsigned long long)kp.out;
        if (threadIdx.x == 35) tab[35] = (unsigned long long)kp.ws;
        if (threadIdx.x == 36) { tab[36] = 0ull; tab[37] = 0ull; }
    }
    __syncthreads();
    Ctx p; p.kp = &kp;
    (void)xcd_barrier_post((unsigned*)(pws_() + WS_BAR), (volatile LAS unsigned*)((char*)dynsmem + PTAB_OFF + 36 * 8));
#define GRID_BARRIER() do { XcdBarrier bar_; bar_.bar = (unsigned*)(pws_() + WS_BAR); bar_.x = xb_xcc_id(); bar_.st = (volatile LAS unsigned*)((char*)dynsmem + PTAB_OFF + 36 * 8); xcd_barrier(bar_); } while (0)
    ph_weight_prep(p, sm);
    ph_subkeys_convert(p);
    ph_tab_convert_all(p);
    ph_rmsnorm(pin_(0), pin_(2), (bf16_t*)(pws_() + WS_H), MTOK);
    ph_rmsnorm(pin_(1), pin_(22), (bf16_t*)(pws_() + WS_HM), MMEM);
    GRID_BARRIER();
#if PROBE_MASK
    unsigned long long tprev_ = wall_clock64();
#endif
#pragma unroll 1
    for (int l = 0; l < DEPTH; ++l) {
#define XIN_ (l == 0 ? pin_(0) : pout_())
#define HBUF_ ((const bf16_t*)(pws_() + WS_H))
        { pg8::EpiBf16 E; E.O = (bf16_t*)(pws_() + WS_P); E.ldc = LDP; ph_gemm(HBUF_, (const bf16_t*)(pws_() + WT_IN) + (size_t)l * LDP * DM, MTOK, LDP, DM, E); }
        { pg8::EpiF32 E; E.C = (float*)(pws_() + WS_KM); E.R = nullptr; E.ldc = 256; ph_gemm((const bf16_t*)(pws_() + WS_HM), (const bf16_t*)(pws_() + WT_XK) + (size_t)l * 256 * DM, MMEM, 256, DM, E, 32); }
        { pg8::EpiF32 E; E.C = (float*)(pws_() + WS_VM); E.R = nullptr; E.ldc = 256; ph_gemm((const bf16_t*)(pws_() + WS_HM), (const bf16_t*)(pws_() + WT_XV) + (size_t)l * 256 * DM, MMEM, 256, DM, E, 64); }
        GB(2);
        ph_mem_prep(p, l);
        ph_dsa_prep(p, l);
        ph_scan_prep(p, l);
        GB(3);
        ph_scans(p, l, sm);
        GB(4);
        ph_mixer_finish(p, l);
        ph_dsa_main(p, l, sm);
        GB(5);
#define PANEL_SYNC() do { asm volatile("s_waitcnt vmcnt(0) lgkmcnt(0)" ::: "memory"); __syncthreads(); \
        if (threadIdx.x < 64) { __builtin_amdgcn_fence(__ATOMIC_ACQUIRE, "agent"); asm volatile("s_waitcnt vmcnt(0)" ::: "memory"); } \
        __syncthreads(); } while (0)
        { pg8::EpiF32 E; E.C = pout_(); E.R = XIN_; E.ldc = DM; ph_gemm((const bf16_t*)(pws_() + WS_Y), (const bf16_t*)(pws_() + WT_OUT) + (size_t)l * DM * DM, MTOK, DM, DM, E); }
        GB(6);
        if (nblk_() == MTOK / 256) {
            const int pm = bid_(), wv = tid_() >> 6;
            ph_rmsnorm(pout_(), pin_(21) + (size_t)l * DM, (bf16_t*)(pws_() + WS_H), 256, pm * 256, wv, 8);
            PANEL_SYNC();
            { pg8::EpiF32 E; E.C = (float*)(pws_() + WS_QX); E.R = nullptr; E.ldc = 256; ph_gemm_panel(HBUF_, (const bf16_t*)(pws_() + WT_XQ) + (size_t)l * 256 * DM, MTOK, 256, DM, E, pm); }
            PANEL_SYNC();
            ph_xattn(p, l, pm * 16, 16, wv, 8);
            PANEL_SYNC();
            { pg8::EpiF32 E; E.C = pout_(); E.R = pout_(); E.ldc = DM; ph_gemm_panel((const bf16_t*)(pws_() + WS_OX), (const bf16_t*)(pws_() + WT_XO) + (size_t)l * DM * 256, MTOK, DM, 256, E, pm); }
            PANEL_SYNC();
            ph_rmsnorm(pout_(), pin_(29) + (size_t)l * DM, (bf16_t*)(pws_() + WS_H), 256, pm * 256, wv, 8, (unsigned char*)(pws_() + WS_H8));
            PANEL_SYNC();
            { pg8::EpiBf16 E; E.O = (bf16_t*)(pws_() + WS_QP); E.ldc = DM; ph_gemm_panel(HBUF_, (const bf16_t*)(pws_() + WT_PQ) + (size_t)l * DM * DM, MTOK, DM, DM, E, pm); }
            PANEL_SYNC();
            ph_peer_topk(p, l, sm, pm * 16, 16, wv, 8);
        }
        GB(13);
        ph_peer_u4(p, l, sm);
        GB(14);
        if (l + 1 < DEPTH) {
            ph_peer_v4<true>(p, l);
            ph_rmsnorm(pin_(1), pin_(22) + (size_t)(l + 1) * DM, (bf16_t*)(pws_() + WS_HM), MMEM);
        } else ph_peer_v4<false>(p, l);
        GB(17);
    }
}

extern "C" void kernel_launch(void* const* d_in, const int* in_sizes, int n_in, void* d_out, int out_size, void* d_ws, size_t ws_size, hipStream_t stream) {
    if (n_in != 34 || out_size != MTOK * DM || ws_size < WS_END) {
        fprintf(stderr, "kernel_launch: unexpected shapes (n_in %d out %d ws %zu need %zu)\n", n_in, out_size, ws_size, (size_t)WS_END);
        return;
    }
    static int grid = 0;
    if (!grid) {
        int dev = 0, cus = 0, per_cu = 0;
        (void)hipGetDevice(&dev);
        (void)hipDeviceGetAttribute(&cus, hipDeviceAttributeMultiprocessorCount, dev);
        (void)hipFuncSetAttribute((const void*)k_mega, hipFuncAttributeMaxDynamicSharedMemorySize, LDS_BYTES);
        (void)hipOccupancyMaxActiveBlocksPerMultiprocessor(&per_cu, (const void*)k_mega, 512, LDS_BYTES);
        if (per_cu < 1) fprintf(stderr, "kernel_launch: occupancy query reports %d blocks per CU\n", per_cu);
        grid = cus > 0 ? cus : 256;
    }
    Params p; memset(&p, 0, sizeof(p));
    for (int i = 0; i < 34; ++i) p.in[i] = (const float*)d_in[i];
    p.out = (float*)d_out; p.ws = (char*)d_ws;
    (void)hipMemsetAsync((char*)d_ws + WS_BAR, 0, XCD_BAR_WORDS * sizeof(unsigned), stream);
    hipLaunchKernelGGL(k_mega, dim3(grid), dim3(512), LDS_BYTES, stream, p);
}
```
